# Optimizing an MI355X kernel written in HIP

```python
import jax, jax.numpy as jnp
from jax import lax
import numpy as np

D_MODEL = 1024
BATCH = 8
SEQ = 4096
DEPTH = 4

HEAD_DIM = 64
N_HEADS_GROUP = 4
GROUP_WIDTH = N_HEADS_GROUP * HEAD_DIM
N_MIXERS = 4
D_MIX = N_MIXERS * GROUP_WIDTH
D_PLE = 256

RWKV_DECAY_RANK = 32
RWKV_ICL_RANK = 32
RWKV_GATE_RANK = 64
RWKV_GN_EPS = 64e-5
RWKV_WIDTHS = (GROUP_WIDTH, GROUP_WIDTH, GROUP_WIDTH, RWKV_DECAY_RANK, RWKV_ICL_RANK, RWKV_GATE_RANK)
D_IN_A = 3 * GROUP_WIDTH + RWKV_DECAY_RANK + RWKV_ICL_RANK + RWKV_GATE_RANK

GLA_KEY_DIM = 32
GLA_QK_WIDTH = N_HEADS_GROUP * GLA_KEY_DIM
GLA_GATE_RANK = 16
GLA_TAU = 16.0
GLA_CHUNK = 64
GLA_WIDTHS = (GLA_QK_WIDTH, GLA_QK_WIDTH, GROUP_WIDTH, GLA_GATE_RANK, GROUP_WIDTH)
D_IN_B = 2 * GLA_QK_WIDTH + 2 * GROUP_WIDTH + GLA_GATE_RANK

MLSTM_CONV = 4
MLSTM_CHUNK = 64
MLSTM_WIDTHS = (GROUP_WIDTH, GROUP_WIDTH, GROUP_WIDTH, GROUP_WIDTH, N_HEADS_GROUP, N_HEADS_GROUP)
D_IN_C = 4 * GROUP_WIDTH + 2 * N_HEADS_GROUP

MLA_Q_RANK = 256
MLA_KV_RANK = 128
MLA_NOPE = 64
MLA_ROPE = 32
MLA_V = HEAD_DIM
MLA_WIDTHS = (MLA_Q_RANK, MLA_KV_RANK, MLA_ROPE)
D_IN_D = MLA_Q_RANK + MLA_KV_RANK + MLA_ROPE
ROPE_THETA = 10000.0
ATTN_BLOCK = 128

D_IN = D_IN_A + D_IN_B + D_IN_C + D_IN_D

N_EXPERT_GROUPS = 4
EXPERTS_PER_GROUP = 8
N_EXPERTS = N_EXPERT_GROUPS * EXPERTS_PER_GROUP
TOP_K = 2
D_EXPERT = 512
MOE_BLOCK = 256

DN_ALPHA = (2.0 * DEPTH) ** 0.25
DN_BETA = (8.0 * DEPTH) ** -0.25
LN_EPS = 1e-5
NORM_EPS = 1e-6

kernel_name = 'hybrid_parallel_groups_hmoe_deepnorm'


def split_last(t, widths):
    return jnp.split(t, np.cumsum(widths)[:-1].tolist(), axis=-1)


def heads(t, d):
    return t.reshape(t.shape[:-1] + (t.shape[-1] // d, d))


def layer_norm(x, g, b, eps):
    xf = x.astype(jnp.float32)
    xc = xf - jnp.mean(xf, axis=-1, keepdims=True)
    y = xc * lax.rsqrt(jnp.mean(xc * xc, axis=-1, keepdims=True) + eps) * g
    if b is not None:
        y = y + b
    return y.astype(x.dtype)


def rms_norm(x, g, eps):
    xf = x.astype(jnp.float32)
    return (xf * lax.rsqrt(jnp.mean(xf * xf, axis=-1, keepdims=True) + eps) * g).astype(x.dtype)


def token_shift(x):
    return jnp.pad(x, ((0, 0), (1, 0), (0, 0)))[:, :-1]


def causal_depthwise_conv(x, w, b):
    width, ch = w.shape
    y = lax.conv_general_dilated(x, w[:, None, :].astype(x.dtype), window_strides=(1,),
                                 padding=((width - 1, 0),), dimension_numbers=('NWC', 'WIO', 'NWC'),
                                 feature_group_count=ch)
    return y + b


def rope_cos_sin(positions):
    inv_freq = ROPE_THETA ** (-jnp.arange(0, MLA_ROPE, 2, dtype=jnp.float32) / MLA_ROPE)
    ang = positions.astype(jnp.float32)[..., None] * inv_freq
    return jnp.cos(ang), jnp.sin(ang)


def apply_rope(x, cos, sin):
    x1, x2 = jnp.split(x, 2, axis=-1)
    return jnp.concatenate([x1 * cos - x2 * sin, x1 * sin + x2 * cos], axis=-1).astype(x.dtype)


def rwkv7_scan(r, w, k, v, a, b):
    bsz, _, nh, n = r.shape

    def step(state, inp):
        r_t, w_t, k_t, v_t, a_t, b_t = inp
        sa = jnp.einsum('bhvk,bhk->bhv', state, a_t)
        state = state * w_t[:, :, None, :] + sa[..., None] * b_t[:, :, None, :] + v_t[..., None] * k_t[:, :, None, :]
        return state, jnp.einsum('bhvk,bhk->bhv', state, r_t)

    seq = tuple(jnp.moveaxis(t, 1, 0) for t in (r, w, k, v, a, b))
    _, y = lax.scan(step, jnp.zeros((bsz, nh, n, n), jnp.float32), seq)
    return jnp.moveaxis(y, 0, 1)


def rwkv7_group(u, mu, w0, w_up, a0, a_up, g_up, k_k, k_a, r_k, gn_g, gn_b):
    bsz, s, _ = u.shape
    u = u + (token_shift(u) - u) * mu
    r, k, v, wd, ad, gd = split_last(u, RWKV_WIDTHS)
    log_neg_logw = -jax.nn.softplus(-(w0 + jnp.tanh(wd) @ w_up)) - 0.5
    decay = jnp.exp(-jnp.exp(log_neg_logw.astype(jnp.float32)))
    a = jax.nn.sigmoid(a0 + ad @ a_up)
    g = jax.nn.sigmoid(gd) @ g_up
    kk = heads(k * k_k, HEAD_DIM).astype(jnp.float32)
    kk = kk / jnp.maximum(jnp.sqrt(jnp.sum(kk * kk, axis=-1, keepdims=True)), 1e-12)
    k = k * (1.0 + (a - 1.0) * k_a)
    rh, kh, vh, ah = (heads(t, HEAD_DIM).astype(jnp.float32) for t in (r, k, v, a))
    y = rwkv7_scan(rh, heads(decay, HEAD_DIM), kh, vh, -kk, kk * ah)
    y = layer_norm(y, gn_g.reshape(N_HEADS_GROUP, HEAD_DIM), gn_b.reshape(N_HEADS_GROUP, HEAD_DIM), RWKV_GN_EPS)
    y = y + jnp.sum(rh * kh * r_k, axis=-1, keepdims=True) * vh
    return (y.reshape(bsz, s, GROUP_WIDTH) * g).astype(u.dtype)


def gla_chunked(q, k, v, log_a):
    bsz, s, nh, dk = q.shape
    dv = v.shape[-1]
    n = s // GLA_CHUNK

    def chunks(t):
        return jnp.moveaxis(t.astype(jnp.float32).reshape(bsz, n, GLA_CHUNK, nh, t.shape[-1]), 1, 0)

    causal = jnp.tril(jnp.ones((GLA_CHUNK, GLA_CHUNK), dtype=bool))[None, :, :, None, None]

    def step(state, inp):
        qc, kc, vc, lac = inp
        b = jnp.cumsum(lac, axis=1)
        rel = jnp.exp(jnp.where(causal, b[:, :, None] - b[:, None, :], -jnp.inf))
        scores = jnp.einsum('bihd,bjhd,bijhd->bhij', qc, kc, rel)
        o = jnp.einsum('bhij,bjhv->bihv', scores, vc) + jnp.einsum('bihd,bhdv->bihv', qc * jnp.exp(b), state)
        b_end = b[:, -1]
        state = state * jnp.exp(b_end)[..., None] + jnp.einsum('bjhd,bjhv->bhdv', kc * jnp.exp(b_end[:, None] - b), vc)
        return state, o

    _, o = lax.scan(step, jnp.zeros((bsz, nh, dk, dv), jnp.float32), (chunks(q), chunks(k), chunks(v), chunks(log_a)))
    return jnp.moveaxis(o, 0, 1).reshape(bsz, s, nh, dv)


def gla_group(u, alpha_up, alpha_b, norm_g):
    bsz, s, _ = u.shape
    q, k, v, ad, gate = split_last(u, GLA_WIDTHS)
    log_a = jax.nn.log_sigmoid((ad @ alpha_up + alpha_b).astype(jnp.float32)) / GLA_TAU
    o = gla_chunked(heads(q, GLA_KEY_DIM) * GLA_KEY_DIM ** -0.5, heads(k, GLA_KEY_DIM),
                    heads(v, HEAD_DIM), heads(log_a, GLA_KEY_DIM))
    o = rms_norm(o, norm_g.reshape(N_HEADS_GROUP, HEAD_DIM), NORM_EPS)
    return (o.reshape(bsz, s, GROUP_WIDTH) * jax.nn.silu(gate)).astype(u.dtype)


def mlstm_chunked(q, k, v, log_i, log_f):
    bsz, s, nh, d = q.shape
    c = MLSTM_CHUNK
    n = s // c

    def chunks(t):
        return jnp.moveaxis(t.reshape((bsz, n, c) + t.shape[2:]), 1, 0)

    causal = jnp.tril(jnp.ones((c, c), dtype=bool))

    def step(carry, inp):
        mem, nrm, m = carry
        qc, kc, vc, li, lf = inp
        li = jnp.swapaxes(li, 1, 2)
        f_cum = jnp.cumsum(jnp.swapaxes(lf, 1, 2), axis=-1)
        log_w = jnp.where(causal, f_cum[..., :, None] - f_cum[..., None, :] + li[..., None, :], -jnp.inf)
        log_carry = f_cum + m[..., None]
        m_row = jnp.maximum(jnp.max(log_w, axis=-1), log_carry)
        sc = jnp.einsum('bihd,bjhd->bhij', qc, kc) * jnp.exp(log_w - m_row[..., None])
        w_c = jnp.exp(log_carry - m_row)
        num = jnp.einsum('bhij,bjhd->bhid', sc, vc) + w_c[..., None] * jnp.einsum('bihd,bhde->bhie', qc, mem)
        den = jnp.sum(sc, axis=-1) + w_c * jnp.einsum('bihd,bhd->bhi', qc, nrm)
        h = num / jnp.maximum(jnp.abs(den), jnp.exp(-m_row))[..., None]
        f_end = f_cum[..., -1]
        log_kv = f_end[..., None] - f_cum + li
        m_new = jnp.maximum(f_end + m, jnp.max(log_kv, axis=-1))
        kw = jnp.exp(log_kv - m_new[..., None])
        carry_decay = jnp.exp(f_end + m - m_new)
        mem = carry_decay[..., None, None] * mem + jnp.einsum('bhj,bjhd,bjhe->bhde', kw, kc, vc)
        nrm = carry_decay[..., None] * nrm + jnp.einsum('bhj,bjhd->bhd', kw, kc)
        return (mem, nrm, m_new), jnp.swapaxes(h, 1, 2)

    init = (jnp.zeros((bsz, nh, d, d), jnp.float32), jnp.zeros((bsz, nh, d), jnp.float32),
            jnp.zeros((bsz, nh), jnp.float32))
    _, h = lax.scan(step, init, tuple(chunks(t) for t in (q, k, v, log_i, log_f)))
    return jnp.moveaxis(h, 0, 1).reshape(bsz, s, nh, d)


def mlstm_group(u, conv_w, conv_b, i_b, f_b, norm_g):
    bsz, s, _ = u.shape
    q, k, v, o, ig, fg = split_last(u, MLSTM_WIDTHS)
    qk = jax.nn.silu(causal_depthwise_conv(jnp.concatenate([q, k], axis=-1), conv_w, conv_b))
    q, k = jnp.split(qk, 2, axis=-1)
    log_i = (ig + i_b).astype(jnp.float32)
    log_f = jax.nn.log_sigmoid((fg + f_b).astype(jnp.float32))
    h = mlstm_chunked(heads(q, HEAD_DIM).astype(jnp.float32),
                      heads(k, HEAD_DIM).astype(jnp.float32) * HEAD_DIM ** -0.5,
                      heads(v, HEAD_DIM).astype(jnp.float32), log_i, log_f)
    h = layer_norm(h, norm_g.reshape(N_HEADS_GROUP, HEAD_DIM), None, LN_EPS)
    return (h.reshape(bsz, s, GROUP_WIDTH) * jax.nn.sigmoid(o)).astype(u.dtype)


def mla_group(u, cos, sin, q_norm_g, w_uq, kv_norm_g, w_ukv):
    bsz, s, _ = u.shape
    cq, ckv, kr = split_last(u, MLA_WIDTHS)
    q = heads(rms_norm(cq, q_norm_g, NORM_EPS) @ w_uq, MLA_NOPE + MLA_ROPE)
    kv = heads(rms_norm(ckv, kv_norm_g, NORM_EPS) @ w_ukv, MLA_NOPE + MLA_V)
    q_nope, q_rope = jnp.split(q, [MLA_NOPE], axis=-1)
    k_nope, v = jnp.split(kv, [MLA_NOPE], axis=-1)
    q = jnp.concatenate([q_nope, apply_rope(q_rope, cos[:, :, None], sin[:, :, None])], axis=-1)
    k_rope = apply_rope(kr, cos, sin)[:, :, None]
    k = jnp.concatenate([k_nope, jnp.broadcast_to(k_rope, (bsz, s, N_HEADS_GROUP, MLA_ROPE))], axis=-1)
    scale = (MLA_NOPE + MLA_ROPE) ** -0.5
    outs = []
    for start in range(0, s, ATTN_BLOCK):
        end = start + ATTN_BLOCK
        sc = jnp.einsum('bqhd,bkhd->bhqk', q[:, start:end], k[:, :end]).astype(jnp.float32) * scale
        mask = jnp.arange(end)[None, :] <= jnp.arange(start, end)[:, None]
        probs = jax.nn.softmax(jnp.where(mask, sc, -jnp.inf), axis=-1).astype(v.dtype)
        outs.append(jnp.einsum('bhqk,bkhd->bqhd', probs, v[:, :end]))
    return jnp.concatenate(outs, axis=1).reshape(bsz, s, GROUP_WIDTH)


def hier_moe(x, w_rg, b_rg, w_re, b_re, w_gate, w_up, w_down):
    bsz, s, d = x.shape
    t_tok = bsz * s
    n_assign = t_tok * TOP_K
    xt = x.reshape(t_tok, d)
    group_prob = jax.nn.softmax((xt @ w_rg + b_rg).astype(jnp.float32), axis=-1)
    group_p, group_idx = lax.top_k(group_prob, 1)
    e_logits = (xt @ w_re + b_re).astype(jnp.float32).reshape(t_tok, N_EXPERT_GROUPS, EXPERTS_PER_GROUP)
    e_logits = jnp.take_along_axis(e_logits, group_idx[:, :, None], axis=1)[:, 0]
    expert_p, local_idx = lax.top_k(jax.nn.softmax(e_logits, axis=-1), TOP_K)
    gate = group_p * expert_p / jnp.sum(expert_p, axis=-1, keepdims=True)
    expert_idx = group_idx * EXPERTS_PER_GROUP + local_idx
    flat_e = expert_idx.reshape(n_assign)
    flat_t = jnp.repeat(jnp.arange(t_tok, dtype=jnp.int32), TOP_K)
    flat_g = gate.reshape(n_assign)
    order = jnp.argsort(flat_e)
    sorted_e = flat_e[order]
    counts = jnp.bincount(flat_e, length=N_EXPERTS)
    starts = jnp.cumsum(counts) - counts
    padded = (counts + MOE_BLOCK - 1) // MOE_BLOCK * MOE_BLOCK
    pad_ends = jnp.cumsum(padded)
    dest = pad_ends[sorted_e] - padded[sorted_e] + jnp.arange(n_assign) - starts[sorted_e]
    n_rows = -(-(n_assign + N_EXPERTS * (MOE_BLOCK - 1)) // MOE_BLOCK) * MOE_BLOCK
    n_blocks = n_rows // MOE_BLOCK
    row_tok = jnp.full((n_rows,), t_tok, jnp.int32).at[dest].set(flat_t[order])
    row_gate = jnp.zeros((n_rows,), x.dtype).at[dest].set(flat_g[order].astype(x.dtype))
    block_expert = jnp.minimum(jnp.searchsorted(pad_ends, jnp.arange(n_blocks) * MOE_BLOCK, side='right'), N_EXPERTS - 1)
    x_rows = jnp.concatenate([xt, jnp.zeros((1, d), xt.dtype)], axis=0)[row_tok].reshape(n_blocks, MOE_BLOCK, d)

    def expert_block(args):
        xb, e = args
        return (jax.nn.silu(xb @ w_gate[e]) * (xb @ w_up[e])) @ w_down[e]

    y_rows = lax.map(expert_block, (x_rows, block_expert)).reshape(n_rows, d)
    y = jax.ops.segment_sum(y_rows * row_gate[:, None], row_tok, num_segments=t_tok + 1)[:t_tok]
    return y.reshape(bsz, s, d)


def setup_inputs(seed: int = 0) -> dict:
    key = jax.random.key(seed)
    keys = iter(jax.random.split(key, 64))
    L = DEPTH
    f32 = jnp.float32
    D = D_MODEL

    def nrm(shape, scale):
        return jax.random.normal(next(keys), shape, f32) * scale

    x = nrm((BATCH, SEQ, D), 1.0)
    p = nrm((DEPTH, BATCH, SEQ, D_PLE), 1.0)
    positions = (jax.random.randint(next(keys), (BATCH, 1), 0, 1024, dtype=jnp.int32)
                 + jnp.arange(SEQ, dtype=jnp.int32)[None, :])
    return {
        'x': x,
        'p': p,
        'positions': positions,
        'w_in': nrm((L, D, D_IN), D ** -0.5),
        'rwkv_mu': jax.random.uniform(next(keys), (L, D_IN_A), f32),
        'rwkv_w0': nrm((L, GROUP_WIDTH), 0.5),
        'rwkv_w_up': nrm((L, RWKV_DECAY_RANK, GROUP_WIDTH), 0.5 * RWKV_DECAY_RANK ** -0.5),
        'rwkv_a0': nrm((L, GROUP_WIDTH), 0.5),
        'rwkv_a_up': nrm((L, RWKV_ICL_RANK, GROUP_WIDTH), 0.5 * RWKV_ICL_RANK ** -0.5),
        'rwkv_g_up': nrm((L, RWKV_GATE_RANK, GROUP_WIDTH), RWKV_GATE_RANK ** -0.5),
        'rwkv_k_k': 0.85 + nrm((L, GROUP_WIDTH), 0.02),
        'rwkv_k_a': 1.0 + nrm((L, GROUP_WIDTH), 0.02),
        'rwkv_r_k': nrm((L, N_HEADS_GROUP, HEAD_DIM), 0.1),
        'rwkv_gn_g': 1.0 + nrm((L, GROUP_WIDTH), 0.02),
        'rwkv_gn_b': nrm((L, GROUP_WIDTH), 0.02),
        'gla_alpha_up': nrm((L, GLA_GATE_RANK, GLA_QK_WIDTH), GLA_GATE_RANK ** -0.5),
        'gla_alpha_b': nrm((L, GLA_QK_WIDTH), 0.5),
        'gla_norm_g': 1.0 + nrm((L, GROUP_WIDTH), 0.02),
        'mlstm_conv_w': nrm((L, MLSTM_CONV, 2 * GROUP_WIDTH), MLSTM_CONV ** -0.5),
        'mlstm_conv_b': nrm((L, 2 * GROUP_WIDTH), 0.02),
        'mlstm_i_b': nrm((L, N_HEADS_GROUP), 0.1),
        'mlstm_f_b': jnp.linspace(3.0, 6.0, N_HEADS_GROUP, dtype=f32) + nrm((L, N_HEADS_GROUP), 0.1),
        'mlstm_norm_g': 1.0 + nrm((L, GROUP_WIDTH), 0.02),
        'mla_q_norm_g': 1.0 + nrm((L, MLA_Q_RANK), 0.02),
        'mla_w_uq': nrm((L, MLA_Q_RANK, N_HEADS_GROUP * (MLA_NOPE + MLA_ROPE)), MLA_Q_RANK ** -0.5),
        'mla_kv_norm_g': 1.0 + nrm((L, MLA_KV_RANK), 0.02),
        'mla_w_ukv': nrm((L, MLA_KV_RANK, N_HEADS_GROUP * (MLA_NOPE + MLA_V)), MLA_KV_RANK ** -0.5),
        'w_out': nrm((L, D_MIX, D), DN_BETA * D_MIX ** -0.5),
        'ln1_g': 1.0 + nrm((L, D), 0.02),
        'ln1_b': nrm((L, D), 0.02),
        'moe_w_rg': nrm((L, D, N_EXPERT_GROUPS), D ** -0.5),
        'moe_b_rg': nrm((L, N_EXPERT_GROUPS), 0.01),
        'moe_w_re': nrm((L, D, N_EXPERTS), D ** -0.5),
        'moe_b_re': nrm((L, N_EXPERTS), 0.01),
        'moe_w_gate': nrm((L, N_EXPERTS, D, D_EXPERT), D ** -0.5),
        'moe_w_up': nrm((L, N_EXPERTS, D, D_EXPERT), DN_BETA * D ** -0.5),
        'moe_w_down': nrm((L, N_EXPERTS, D_EXPERT, D), DN_BETA * D_EXPERT ** -0.5),
        'ple_w_gate': nrm((L, D, D), D ** -0.5),
        'ple_b_gate': nrm((L, D), 0.02),
        'ple_w': nrm((L, D_PLE, D), DN_BETA * D_PLE ** -0.5),
        'ln2_g': 1.0 + nrm((L, D), 0.02),
        'ln2_b': nrm((L, D), 0.02),
    }


def reference(x, p, positions, w_in, rwkv_mu, rwkv_w0, rwkv_w_up, rwkv_a0, rwkv_a_up, rwkv_g_up,
              rwkv_k_k, rwkv_k_a, rwkv_r_k, rwkv_gn_g, rwkv_gn_b, gla_alpha_up, gla_alpha_b, gla_norm_g,
              mlstm_conv_w, mlstm_conv_b, mlstm_i_b, mlstm_f_b, mlstm_norm_g, mla_q_norm_g, mla_w_uq,
              mla_kv_norm_g, mla_w_ukv, w_out, ln1_g, ln1_b, moe_w_rg, moe_b_rg, moe_w_re, moe_b_re,
              moe_w_gate, moe_w_up, moe_w_down, ple_w_gate, ple_b_gate, ple_w, ln2_g, ln2_b):
    cos, sin = rope_cos_sin(positions)
    for i in range(DEPTH):
        u = x @ w_in[i]
        ua, ub, uc, ud = split_last(u, (D_IN_A, D_IN_B, D_IN_C, D_IN_D))
        ya = rwkv7_group(ua, rwkv_mu[i], rwkv_w0[i], rwkv_w_up[i], rwkv_a0[i], rwkv_a_up[i], rwkv_g_up[i],
                         rwkv_k_k[i], rwkv_k_a[i], rwkv_r_k[i], rwkv_gn_g[i], rwkv_gn_b[i])
        yb = gla_group(ub, gla_alpha_up[i], gla_alpha_b[i], gla_norm_g[i])
        yc = mlstm_group(uc, mlstm_conv_w[i], mlstm_conv_b[i], mlstm_i_b[i], mlstm_f_b[i], mlstm_norm_g[i])
        yd = mla_group(ud, cos, sin, mla_q_norm_g[i], mla_w_uq[i], mla_kv_norm_g[i], mla_w_ukv[i])
        mix = jnp.concatenate([ya, yb, yc, yd], axis=-1) @ w_out[i]
        x = layer_norm(DN_ALPHA * x + mix, ln1_g[i], ln1_b[i], LN_EPS)
        ffn = hier_moe(x, moe_w_rg[i], moe_b_rg[i], moe_w_re[i], moe_b_re[i],
                       moe_w_gate[i], moe_w_up[i], moe_w_down[i])
        ple = jax.nn.sigmoid(x @ ple_w_gate[i] + ple_b_gate[i]) * (p[i] @ ple_w[i])
        x = layer_norm(DN_ALPHA * x + ffn + ple, ln2_g[i], ln2_b[i], LN_EPS)
    return x
```

```cpp
#ifndef CPU_TEST
#include <hip/hip_runtime.h>
#include <cstdio>
#include <cstdint>
#define HD __device__ __forceinline__
#define HDM __device__ __forceinline__
#define LANES 64
#else
#include <cmath>
#include <cstdio>
#include <cstdint>
#include <cstring>
#include <algorithm>
#define HD static inline
#define HDM inline
#define LANES 1
#endif

#ifndef CFG_SMALL
constexpr int BATCH = 8, SEQ = 4096, DM = 1024, DEPTH = 4, DPLE = 256, DEXP = 512;
#else
constexpr int BATCH = 2, SEQ = 256, DM = 128, DEPTH = 2, DPLE = 32, DEXP = 128;
#endif
constexpr int T = BATCH * SEQ;
constexpr int DMIX = 1024, GW = 256, HD64 = 64, NH = 4;
constexpr int DIN = 3128, DINP = 3328;
constexpr int UA = 0, UA_R = 0, UA_K = 256, UA_V = 512, UA_WD = 768, UA_AD = 800, UA_GD = 832, DINA = 896;
constexpr int UB = 896, UB_Q = 896, UB_K = 1024, UB_V = 1152, UB_AD = 1408, UB_G = 1424;
constexpr int UC = 1680, UC_Q = 1680, UC_K = 1936, UC_V = 2192, UC_O = 2448, UC_IG = 2704, UC_FG = 2708;
constexpr int UD = 2712, UD_CQ = 2712, UD_CKV = 2968, UD_KR = 3096;
constexpr int NEXP = 32, NGRP = 4, EPG = 8;
constexpr int MAXROWS = 2 * T + NEXP * 256;
constexpr float DN_ALPHA = 1.681792830507429f;
constexpr float LN_EPS = 1e-5f, NORM_EPS = 1e-6f, RWKV_GN_EPS = 64e-5f;
static_assert(DEPTH == 4 || DEPTH == 2, "alpha below assumes depth");
HD float dn_alpha() { return DEPTH == 4 ? 1.681792830507429f : 1.4142135623730951f; }

enum { I_X = 0, I_P, I_POS, I_WIN, I_MU, I_W0, I_WUP, I_A0, I_AUP, I_GUP, I_KK, I_KA, I_RK, I_GNG, I_GNB, I_GLA_UP, I_GLA_B, I_GLA_G,
       I_CONVW, I_CONVB, I_IB, I_FB, I_MLN_G, I_QNG, I_WUQ, I_KVNG, I_WUKV, I_WOUT, I_LN1G, I_LN1B, I_WRG, I_BRG, I_WRE, I_BRE,
       I_WG, I_WU, I_WD, I_PLEG, I_PLEBG, I_PLEW, I_LN2G, I_LN2B, N_IN };

typedef unsigned short bf16_t;
HD float bf2f(bf16_t h) { unsigned u = (unsigned)h << 16; return __builtin_bit_cast(float, u); }
HD bf16_t f2bf(float f) { unsigned u = __builtin_bit_cast(unsigned, f); return (bf16_t)((u + 0x7fffu + ((u >> 16) & 1u)) >> 16); }
HD unsigned pk2(float lo, float hi) { return (unsigned)f2bf(lo) | ((unsigned)f2bf(hi) << 16); }
typedef float f4v __attribute__((vector_size(16)));
typedef unsigned u4v __attribute__((vector_size(16)));
HD void ld8bf(const bf16_t* p, float* o) { const u4v w = *(const u4v*)p;
    for (int j = 0; j < 4; ++j) { o[2 * j] = __builtin_bit_cast(float, w[j] << 16); o[2 * j + 1] = __builtin_bit_cast(float, w[j] & 0xffff0000u); } }
HD void st8bf(bf16_t* p, const float* a) { u4v w; for (int j = 0; j < 4; ++j) w[j] = pk2(a[2 * j], a[2 * j + 1]); *(u4v*)p = w; }

constexpr size_t MiB = (size_t)1 << 20;
constexpr size_t al256(size_t x) { return (x + 255) & ~(size_t)255; }
constexpr size_t WS_CTL = 0, CTL_BYTES = 1 * MiB;
constexpr size_t WS_WIN = WS_CTL + CTL_BYTES;
constexpr size_t WS_WOUT = WS_WIN + al256((size_t)DINP * DM * 2);
constexpr size_t WS_WPG = WS_WOUT + al256((size_t)DM * DMIX * 2);
constexpr size_t WS_WP = WS_WPG + al256((size_t)DM * DM * 2);
constexpr size_t WS_WGU = WS_WP + al256((size_t)DM * DPLE * 2);
constexpr size_t WS_WD = WS_WGU + al256((size_t)NEXP * 2 * DEXP * DM * 2);
constexpr size_t WS_X = WS_WD + al256((size_t)NEXP * DM * DEXP * 2);
constexpr size_t WS_XB = WS_X + al256((size_t)T * DM * 4);
constexpr size_t WS_U = WS_XB + al256((size_t)T * DM * 2);
constexpr size_t WS_MIX = WS_U + al256((size_t)T * DINP * 2);
constexpr size_t WS_PB = WS_MIX + al256((size_t)T * DMIX * 2);
constexpr size_t WS_SCR = WS_PB + al256((size_t)T * DPLE * 2);
constexpr size_t TV = al256((size_t)T * GW * 4);
constexpr size_t WS_RW_R = WS_SCR, WS_RW_W = WS_RW_R + TV, WS_RW_K = WS_RW_W + TV, WS_RW_V = WS_RW_K + TV, WS_RW_A = WS_RW_V + TV,
                 WS_RW_B = WS_RW_A + TV, WS_RW_G = WS_RW_B + TV;
constexpr size_t WS_YA = WS_RW_G + TV, WS_YB = WS_YA + TV, WS_YC = WS_YB + TV;
constexpr size_t WS_DEN = WS_YC + TV;
constexpr size_t WS_QK = WS_DEN + al256((size_t)T * 4 * 4);
constexpr size_t WS_GA = WS_QK + al256((size_t)T * 512 * 4);
constexpr size_t WS_LG = WS_GA + al256((size_t)T * 128 * 4);
constexpr size_t WS_AQ = WS_LG + al256((size_t)T * 8 * 4);
constexpr size_t WS_AK = WS_AQ + al256((size_t)T * 384 * 2);
constexpr size_t WS_AV = WS_AK + al256((size_t)T * 384 * 2);
constexpr size_t WS_MIXER_END = WS_AV + al256((size_t)T * 256 * 2);
constexpr size_t WS_XG = WS_SCR;
constexpr size_t WS_H = WS_XG + al256((size_t)MAXROWS * DM * 2);
constexpr size_t WS_YBUF = WS_H + al256((size_t)MAXROWS * DEXP * 2);
constexpr size_t WS_PP = WS_YBUF + al256((size_t)2 * T * DM * 2);
constexpr size_t WS_TOKINFO = WS_PP + al256((size_t)T * DM * 2);
constexpr size_t WS_LIST = WS_TOKINFO + al256((size_t)T * 16);
constexpr size_t WS_ROWINFO = WS_LIST + al256((size_t)NEXP * T * 4);
constexpr size_t WS_ROWGATE = WS_ROWINFO + al256((size_t)MAXROWS * 4);
constexpr size_t WS_MOE_END = WS_ROWGATE + al256((size_t)MAXROWS * 4);
constexpr size_t WS_END = WS_MIXER_END > WS_MOE_END ? WS_MIXER_END : WS_MOE_END;
constexpr int CW_BAR = 4096;
constexpr int CW_CNT = 16384;

struct Ctx {
    const void* in[N_IN];
    float* out;
    unsigned char* ws;
};
#define INF(i) ((const float*)C.in[i])
#define WSP(T_, off) ((T_*)(C.ws + (off)))

#ifndef CPU_TEST
HD float wave_sum(float v) {
#pragma unroll
    for (int o = 1; o < 64; o <<= 1) v += __shfl_xor(v, o);
    return v;
}
HD float wave_max(float v) {
#pragma unroll
    for (int o = 1; o < 64; o <<= 1) v = fmaxf(v, __shfl_xor(v, o));
    return v;
}
HD unsigned atom_add(unsigned* p, unsigned v) { return atomicAdd(p, v); }
#define WSYNC() __builtin_amdgcn_wave_barrier(); asm volatile("s_waitcnt lgkmcnt(0)" ::: "memory")
typedef __attribute__((address_space(3))) float* wsh_t;
#else
HD float wave_sum(float v) { return v; }
HD float wave_max(float v) { return v; }
HD unsigned atom_add(unsigned* p, unsigned v) { unsigned o = *p; *p += v; return o; }
#define WSYNC()
typedef float* wsh_t;
#endif
HD float sigmoidf_(float x) { return 1.f / (1.f + expf(-x)); }
HD float softplusf_(float x) { return x > 20.f ? x : (x < -20.f ? expf(x) : log1pf(expf(x))); }
HD float siluf_(float x) { return x * sigmoidf_(x); }

HD int rowmap(int mode, int n) { return mode == 0 ? n : (mode == 1 ? (n >> 7) * 256 + (n & 127) : (n >> 7) * 256 + 128 + (n & 127)); }
HD void transpose_item(const float* W, int K, int N, int ldw, bf16_t* WT, int ldk, int mode, int item, int lane, wsh_t scr) {
    const int nblk = (N + 31) / 32, kb = item / nblk, nb = item % nblk, k0 = 64 * kb, n0 = 32 * nb;
    for (int idx = lane; idx < 2048; idx += LANES) { const int kk = idx >> 5, nn = idx & 31; const int n = n0 + nn;
        scr[kk * 33 + nn] = (n < N) ? W[(size_t)(k0 + kk) * ldw + n] : 0.f; }
    WSYNC();
    for (int idx = lane; idx < 256; idx += LANES) { const int n = idx >> 3, c = idx & 7;
        unsigned o[4];
        for (int j = 0; j < 4; ++j) o[j] = pk2(scr[(8 * c + 2 * j) * 33 + n], scr[(8 * c + 2 * j + 1) * 33 + n]);
        unsigned* dst = (unsigned*)(WT + (size_t)rowmap(mode, n0 + n) * ldk + k0 + 8 * c);
        dst[0] = o[0]; dst[1] = o[1]; dst[2] = o[2]; dst[3] = o[3]; }
    WSYNC();
}
HD void stage_convert(const Ctx& C, int l, int gw, int ngw, int lane, wsh_t scr) {
    constexpr int NB_IN = DINP / 32;
    constexpr int I_IN = (DM / 64) * NB_IN, I_OUT = (DMIX / 64) * (DM / 32), I_PG = (DM / 64) * (DM / 32), I_PW = (DPLE / 64 > 0 ? DPLE / 64 : 1) * (DM / 32);
    constexpr int I_G1 = (DM / 64) * (DEXP / 32), I_D1 = (DEXP / 64) * (DM / 32);
    constexpr int NIT = I_IN + I_OUT + I_PG + I_PW + NEXP * (2 * I_G1 + I_D1);
    static_assert(DPLE % 32 == 0 && DEXP % 64 == 0, "shapes");
    for (int it = gw; it < NIT; it += ngw) {
        int r = it;
        if (r < I_IN) {
            const int nblk = NB_IN, kb = r / nblk, nb = r % nblk, k0 = 64 * kb, n0 = 32 * nb;
            const float* W = INF(I_WIN) + (size_t)l * DM * DIN; bf16_t* WT = WSP(bf16_t, WS_WIN);
            for (int idx = lane; idx < 2048; idx += LANES) { const int kk = idx >> 5, nn = idx & 31; const int n = n0 + nn;
                scr[kk * 33 + nn] = (n < DIN) ? W[(size_t)(k0 + kk) * DIN + n] : 0.f; }
            WSYNC();
            for (int idx = lane; idx < 256; idx += LANES) { const int n = idx >> 3, c = idx & 7; unsigned o[4];
                for (int j = 0; j < 4; ++j) o[j] = pk2(scr[(8 * c + 2 * j) * 33 + n], scr[(8 * c + 2 * j + 1) * 33 + n]);
                unsigned* dst = (unsigned*)(WT + (size_t)(n0 + n) * DM + k0 + 8 * c); dst[0] = o[0]; dst[1] = o[1]; dst[2] = o[2]; dst[3] = o[3]; }
            WSYNC();
            continue; }
        r -= I_IN;
        if (r < I_OUT) { transpose_item(INF(I_WOUT) + (size_t)l * DMIX * DM, DMIX, DM, DM, WSP(bf16_t, WS_WOUT), DMIX, 0, r, lane, scr); continue; } r -= I_OUT;
        if (r < I_PG) { transpose_item(INF(I_PLEG) + (size_t)l * DM * DM, DM, DM, DM, WSP(bf16_t, WS_WPG), DM, 0, r, lane, scr); continue; } r -= I_PG;
        if (r < I_PW) {
            if (DPLE >= 64) transpose_item(INF(I_PLEW) + (size_t)l * DPLE * DM, DPLE, DM, DM, WSP(bf16_t, WS_WP), DPLE, 0, r, lane, scr);
            continue; } r -= I_PW;
        const int e = r / (2 * I_G1 + I_D1); r -= e * (2 * I_G1 + I_D1);
        if (r < I_G1) { transpose_item(INF(I_WG) + ((size_t)l * NEXP + e) * DM * DEXP, DM, DEXP, DEXP, WSP(bf16_t, WS_WGU) + (size_t)e * 2 * DEXP * DM, DM, 1, r, lane, scr); continue; } r -= I_G1;
        if (r < I_G1) { transpose_item(INF(I_WU) + ((size_t)l * NEXP + e) * DM * DEXP, DM, DEXP, DEXP, WSP(bf16_t, WS_WGU) + (size_t)e * 2 * DEXP * DM, DM, 2, r, lane, scr); continue; } r -= I_G1;
        transpose_item(INF(I_WD) + ((size_t)l * NEXP + e) * DEXP * DM, DEXP, DM, DM, WSP(bf16_t, WS_WD) + (size_t)e * DM * DEXP, DEXP, 0, r, lane, scr);
    }
    {   const float* p = INF(I_P) + (size_t)l * T * DPLE; bf16_t* pb = WSP(bf16_t, WS_PB);
        const size_t n4 = (size_t)T * DPLE / 4;
        for (size_t i = (size_t)gw * LANES + lane; i < n4; i += (size_t)ngw * LANES) {
            const float* s = p + 4 * i; unsigned* d = (unsigned*)(pb + 4 * i); d[0] = pk2(s[0], s[1]); d[1] = pk2(s[2], s[3]); } }
    if (l == 0) { const float* x = INF(I_X); bf16_t* xb = WSP(bf16_t, WS_XB);
        const size_t n4 = (size_t)T * DM / 4;
        for (size_t i = (size_t)gw * LANES + lane; i < n4; i += (size_t)ngw * LANES) {
            const float* s = x + 4 * i; unsigned* d = (unsigned*)(xb + 4 * i); d[0] = pk2(s[0], s[1]); d[1] = pk2(s[2], s[3]); } }
#ifdef CFG_SMALL
    if (DPLE < 64) {
        const float* W = INF(I_PLEW) + (size_t)l * DPLE * DM; bf16_t* WT = WSP(bf16_t, WS_WP);
        for (int i = gw * LANES + lane; i < DPLE * DM; i += ngw * LANES) { const int k = i / DM, n = i % DM; WT[(size_t)n * DPLE + k] = f2bf(W[i]); } }
#endif
}

HD float ubf(const bf16_t* u, int t, int c) { return bf2f(u[(size_t)t * DINP + c]); }
HD void stage_prep(const Ctx& C, int l, int gw, int ngw, int lane, wsh_t sh) {
    const bf16_t* u = WSP(bf16_t, WS_U);
    const float* mu = INF(I_MU) + l * DINA; const float* w0 = INF(I_W0) + l * GW; const float* wup = INF(I_WUP) + l * 32 * GW;
    const float* a0 = INF(I_A0) + l * GW; const float* aup = INF(I_AUP) + l * 32 * GW; const float* gup = INF(I_GUP) + l * 64 * GW;
    const float* kkw = INF(I_KK) + l * GW; const float* kaw = INF(I_KA) + l * GW;
    const float* glaup = INF(I_GLA_UP) + l * 16 * 128; const float* glab = INF(I_GLA_B) + l * 128;
    const float* convw = INF(I_CONVW) + l * 4 * 512; const float* convb = INF(I_CONVB) + l * 512;
    const float* ib = INF(I_IB) + l * 4; const float* fb = INF(I_FB) + l * 4;
    const float* qng = INF(I_QNG) + l * 256; const float* wuq = INF(I_WUQ) + (size_t)l * 256 * 384;
    const float* kvng = INF(I_KVNG) + l * 128; const float* wukv = INF(I_WUKV) + (size_t)l * 128 * 512;
    const int* pos = (const int*)C.in[I_POS];
    float* oR = WSP(float, WS_RW_R); float* oW = WSP(float, WS_RW_W); float* oK = WSP(float, WS_RW_K); float* oV = WSP(float, WS_RW_V);
    float* oA = WSP(float, WS_RW_A); float* oB = WSP(float, WS_RW_B); float* oG = WSP(float, WS_RW_G);
    float* oQK = WSP(float, WS_QK); float* oGA = WSP(float, WS_GA); float* oLG = WSP(float, WS_LG);
    bf16_t* oAQ = WSP(bf16_t, WS_AQ); bf16_t* oAK = WSP(bf16_t, WS_AK); bf16_t* oAV = WSP(bf16_t, WS_AV);
    for (int t = gw; t < T; t += ngw) {
        const int s = t % SEQ;
        for (int j = lane; j < 128; j += LANES) { const int c = UA_WD + j; const float cur = ubf(u, t, c), prev = s > 0 ? ubf(u, t - 1, c) : 0.f;
            const float v = cur + (prev - cur) * mu[c]; sh[j] = j < 32 ? tanhf(v) : (j < 64 ? v : sigmoidf_(v)); }
        WSYNC();
        for (int h = 0; h < NH; ++h) {
            float kkraw[HD64 / LANES]; float kv_[HD64 / LANES], av_[HD64 / LANES]; float ss = 0.f;
            for (int i = 0; i < HD64 / LANES; ++i) { const int c = h * 64 + i * LANES + lane;
                float z = w0[c], za = a0[c], g = 0.f;
_Pragma("unroll 8")
                for (int j = 0; j < 32; ++j) { z += sh[j] * wup[j * GW + c]; za += sh[32 + j] * aup[j * GW + c]; }
_Pragma("unroll 8")
                for (int j = 0; j < 64; ++j) g += sh[64 + j] * gup[j * GW + c];
                const float lnl = -softplusf_(-z) - 0.5f; const float decay = expf(-expf(lnl)); const float a = sigmoidf_(za);
                float r, k, v;
                { const float cur = ubf(u, t, UA_R + c), prev = s > 0 ? ubf(u, t - 1, UA_R + c) : 0.f; r = cur + (prev - cur) * mu[UA_R + c]; }
                { const float cur = ubf(u, t, UA_K + c), prev = s > 0 ? ubf(u, t - 1, UA_K + c) : 0.f; k = cur + (prev - cur) * mu[UA_K + c]; }
                { const float cur = ubf(u, t, UA_V + c), prev = s > 0 ? ubf(u, t - 1, UA_V + c) : 0.f; v = cur + (prev - cur) * mu[UA_V + c]; }
                kkraw[i] = k * kkw[c]; ss += kkraw[i] * kkraw[i];
                kv_[i] = k * (1.f + (a - 1.f) * kaw[c]); av_[i] = a;
                const size_t o = (size_t)t * GW + c; oR[o] = r; oW[o] = decay; oK[o] = kv_[i]; oV[o] = v; oG[o] = g; }
            ss = wave_sum(ss); const float inv = 1.f / fmaxf(sqrtf(ss), 1e-12f);
            for (int i = 0; i < HD64 / LANES; ++i) { const int c = h * 64 + i * LANES + lane; const size_t o = (size_t)t * GW + c; const float kk = kkraw[i] * inv;
                oA[o] = -kk; oB[o] = kk * av_[i]; }
        }
        WSYNC();
        for (int c = lane; c < 128; c += LANES) { float z = glab[c];
            for (int j = 0; j < 16; ++j) z += ubf(u, t, UB_AD + j) * glaup[j * 128 + c];
            oGA[(size_t)t * 128 + c] = -softplusf_(-z) * (1.f / 16.f); }
        for (int c = lane; c < 512; c += LANES) { float y = convb[c];
            for (int j = 0; j < 4; ++j) { const int sp = s - 3 + j; if (sp >= 0) y += convw[j * 512 + c] * ubf(u, t - 3 + j, UC_Q + c); }
            float q = siluf_(y); if (c >= 256) q *= 0.125f; oQK[(size_t)t * 512 + c] = q; }
        for (int c = lane; c < 8; c += LANES) { const float v = ubf(u, t, UC_IG + c);
            oLG[(size_t)t * 8 + c] = c < 4 ? v + ib[c] : -softplusf_(-(v + fb[c - 4])); }
        {   float ssq = 0.f, sskv = 0.f;
            for (int j = lane; j < 256; j += LANES) { const float v = ubf(u, t, UD_CQ + j); ssq += v * v; }
            for (int j = lane; j < 128; j += LANES) { const float v = ubf(u, t, UD_CKV + j); sskv += v * v; }
            ssq = wave_sum(ssq); sskv = wave_sum(sskv);
            const float rq = 1.f / sqrtf(ssq * (1.f / 256.f) + NORM_EPS), rkv = 1.f / sqrtf(sskv * (1.f / 128.f) + NORM_EPS);
            for (int j = lane; j < 256; j += LANES) sh[j] = ubf(u, t, UD_CQ + j) * rq * qng[j];
            for (int j = lane; j < 128; j += LANES) sh[256 + j] = ubf(u, t, UD_CKV + j) * rkv * kvng[j];
            WSYNC();
            for (int n = lane; n < 384; n += LANES) { float acc = 0.f;
_Pragma("unroll 8")
                for (int k = 0; k < 256; ++k) acc += sh[k] * wuq[(size_t)k * 384 + n]; sh[384 + n] = acc; }
            for (int n = lane; n < 512; n += LANES) { float acc = 0.f;
_Pragma("unroll 8")
                for (int k = 0; k < 128; ++k) acc += sh[256 + k] * wukv[(size_t)k * 512 + n]; sh[768 + n] = acc; }
            for (int i = lane; i < 16; i += LANES) { const float invf = powf(10000.f, -(float)i / 16.f); const float ang = (float)pos[t] * invf; sh[1280 + i] = cosf(ang); sh[1296 + i] = sinf(ang); }
            for (int i = lane; i < 32; i += LANES) sh[1312 + i] = ubf(u, t, UD_KR + i);
            WSYNC();
            const float qscale = 0.10206207261596575f;
            for (int idx = lane; idx < 384; idx += LANES) { const int h = idx / 96, d = idx % 96; float v;
                if (d < 64) v = sh[384 + idx];
                else { const int i = (d - 64) & 15; const float x1 = sh[384 + h * 96 + 64 + i], x2 = sh[384 + h * 96 + 80 + i]; const float c_ = sh[1280 + i], s_ = sh[1296 + i];
                    v = (d - 64) < 16 ? x1 * c_ - x2 * s_ : x1 * s_ + x2 * c_; }
                oAQ[(size_t)t * 384 + idx] = f2bf(v * qscale); }
            for (int idx = lane; idx < 384; idx += LANES) { const int h = idx / 96, d = idx % 96; float v;
                if (d < 64) v = sh[768 + h * 128 + d];
                else { const int i = (d - 64) & 15; const float x1 = sh[1312 + i], x2 = sh[1328 + i]; const float c_ = sh[1280 + i], s_ = sh[1296 + i];
                    v = (d - 64) < 16 ? x1 * c_ - x2 * s_ : x1 * s_ + x2 * c_; }
                oAK[(size_t)t * 384 + idx] = f2bf(v); }
            for (int idx = lane; idx < 256; idx += LANES) { const int h = idx / 64, d = idx % 64; oAV[(size_t)t * 256 + idx] = f2bf(sh[768 + h * 128 + 64 + d]); }
            WSYNC();
        }
    }
}

HD void rwkv_scan_thread(const Ctx& C, int b, int h, int v) {
    const float* pR = WSP(float, WS_RW_R); const float* pW = WSP(float, WS_RW_W); const float* pK = WSP(float, WS_RW_K); const float* pV = WSP(float, WS_RW_V);
    const float* pA = WSP(float, WS_RW_A); const float* pB = WSP(float, WS_RW_B); float* Y = WSP(float, WS_YA);
    float S[64];
#pragma unroll
    for (int k = 0; k < 64; ++k) S[k] = 0.f;
    for (int s = 0; s < SEQ; ++s) {
        const size_t o = ((size_t)b * SEQ + s) * GW + h * 64;
        const float vv = pV[o + v];
        float sa0 = 0.f, sa1 = 0.f, sa2 = 0.f, sa3 = 0.f;
#pragma unroll
        for (int k = 0; k < 64; k += 4) { const f4v a = *(const f4v*)(pA + o + k); sa0 += S[k] * a[0]; sa1 += S[k + 1] * a[1]; sa2 += S[k + 2] * a[2]; sa3 += S[k + 3] * a[3]; }
        const float sa = (sa0 + sa1) + (sa2 + sa3);
        float y0 = 0.f, y1 = 0.f, y2 = 0.f, y3 = 0.f;
#pragma unroll
        for (int k = 0; k < 64; k += 4) {
            const f4v w = *(const f4v*)(pW + o + k), bb = *(const f4v*)(pB + o + k), kk = *(const f4v*)(pK + o + k), r = *(const f4v*)(pR + o + k);
            S[k] = S[k] * w[0] + sa * bb[0] + vv * kk[0]; y0 += S[k] * r[0];
            S[k + 1] = S[k + 1] * w[1] + sa * bb[1] + vv * kk[1]; y1 += S[k + 1] * r[1];
            S[k + 2] = S[k + 2] * w[2] + sa * bb[2] + vv * kk[2]; y2 += S[k + 2] * r[2];
            S[k + 3] = S[k + 3] * w[3] + sa * bb[3] + vv * kk[3]; y3 += S[k + 3] * r[3];
            if ((k & 12) == 12) asm volatile("" ::: "memory"); }
        Y[o + v] = (y0 + y1) + (y2 + y3);
    }
}
HD void gla_scan_thread(const Ctx& C, int b, int h, int v) {
    const bf16_t* u = WSP(bf16_t, WS_U); const float* GA = WSP(float, WS_GA); float* Y = WSP(float, WS_YB);
    float S[32];
#pragma unroll
    for (int k = 0; k < 32; ++k) S[k] = 0.f;
    for (int s = 0; s < SEQ; ++s) {
        const int t = b * SEQ + s;
        const float vv = ubf(u, t, UB_V + h * 64 + v);
        float acc = 0.f;
#pragma unroll
        for (int k8 = 0; k8 < 32; k8 += 8) { float kf[8], qf[8];
            ld8bf(u + (size_t)t * DINP + UB_K + h * 32 + k8, kf); ld8bf(u + (size_t)t * DINP + UB_Q + h * 32 + k8, qf);
            const f4v g0 = *(const f4v*)(GA + (size_t)t * 128 + h * 32 + k8), g1 = *(const f4v*)(GA + (size_t)t * 128 + h * 32 + k8 + 4);
#pragma unroll
            for (int j = 0; j < 8; ++j) { const float a = expf(j < 4 ? g0[j & 3] : g1[j & 3]); S[k8 + j] = a * S[k8 + j] + kf[j] * vv; acc += qf[j] * S[k8 + j]; } }
        Y[(size_t)t * GW + h * 64 + v] = acc * 0.17677669529663687f;
    }
}
HD void mlstm_scan_thread(const Ctx& C, int b, int h, int e) {
    const bf16_t* u = WSP(bf16_t, WS_U); const float* QK = WSP(float, WS_QK); const float* LG = WSP(float, WS_LG);
    float* Y = WSP(float, WS_YC); float* DEN = WSP(float, WS_DEN);
    float S[64];
#pragma unroll
    for (int k = 0; k < 64; ++k) S[k] = 0.f;
    for (int s = 0; s < SEQ; ++s) {
        const int t = b * SEQ + s;
        const float ig = expf(LG[(size_t)t * 8 + h]), fg = expf(LG[(size_t)t * 8 + 4 + h]);
        const float vv = (e < 64 ? ubf(u, t, UC_V + h * 64 + e) : 1.f) * ig;
        float acc = 0.f;
#pragma unroll
        for (int k = 0; k < 64; k += 4) { const f4v kk = *(const f4v*)(QK + (size_t)t * 512 + 256 + h * 64 + k), qq = *(const f4v*)(QK + (size_t)t * 512 + h * 64 + k);
#pragma unroll
            for (int j = 0; j < 4; ++j) { S[k + j] = fg * S[k + j] + kk[j] * vv; acc += qq[j] * S[k + j]; } }
        if (e < 64) Y[(size_t)t * GW + h * 64 + e] = acc; else DEN[(size_t)t * 4 + h] = acc;
    }
}
HD void attn_thread(const Ctx& C, int b, int h, int q, int kmax  ) {
    const bf16_t* Q = WSP(bf16_t, WS_AQ); const bf16_t* K = WSP(bf16_t, WS_AK); const bf16_t* V = WSP(bf16_t, WS_AV); bf16_t* mix = WSP(bf16_t, WS_MIX);
    const int t = b * SEQ + q;
    unsigned qp[48]; float o[64];
#pragma unroll
    for (int d = 0; d < 48; d += 4) { const u4v w = *(const u4v*)(Q + (size_t)t * 384 + h * 96 + 2 * d); qp[d] = w[0]; qp[d + 1] = w[1]; qp[d + 2] = w[2]; qp[d + 3] = w[3]; }
#pragma unroll
    for (int d = 0; d < 64; ++d) o[d] = 0.f;
    float m = -1e30f, lsum = 0.f;
    for (int j = 0; j <= kmax; ++j) {
        const size_t tk = (size_t)b * SEQ + j;
        float sc0 = 0.f, sc1 = 0.f;
#pragma unroll
        for (int d = 0; d < 96; d += 8) { float kf[8]; ld8bf(K + tk * 384 + h * 96 + d, kf);
#pragma unroll
            for (int i = 0; i < 8; i += 2) { const unsigned qw = qp[(d + i) >> 1];
                sc0 += __builtin_bit_cast(float, qw << 16) * kf[i]; sc1 += __builtin_bit_cast(float, qw & 0xffff0000u) * kf[i + 1]; }
            if ((d & 24) == 24) asm volatile("" ::: "memory"); }
        const float sc = sc0 + sc1;
        if (j <= q) {
            const float mn = fmaxf(m, sc); const float corr = expf(m - mn), p = expf(sc - mn);
            lsum = lsum * corr + p;
#pragma unroll
            for (int d = 0; d < 64; d += 8) { float vf[8]; ld8bf(V + tk * 256 + h * 64 + d, vf);
#pragma unroll
                for (int i = 0; i < 8; ++i) o[d + i] = o[d + i] * corr + p * vf[i];
                if (d & 8) asm volatile("" ::: "memory"); }
            m = mn; }
    }
    const float inv = 1.f / lsum;
#pragma unroll
    for (int d = 0; d < 64; d += 8) { float a[8];
#pragma unroll
        for (int i = 0; i < 8; ++i) a[i] = o[d + i] * inv;
        st8bf(mix + (size_t)t * DMIX + 768 + h * 64 + d, a); }
}

HD void stage_post(const Ctx& C, int l, int gw, int ngw, int lane) {
    const bf16_t* u = WSP(bf16_t, WS_U); bf16_t* mix = WSP(bf16_t, WS_MIX);
    const float* YA = WSP(float, WS_YA); const float* YB = WSP(float, WS_YB); const float* YC = WSP(float, WS_YC); const float* DEN = WSP(float, WS_DEN);
    const float* pR = WSP(float, WS_RW_R); const float* pK = WSP(float, WS_RW_K); const float* pV = WSP(float, WS_RW_V); const float* pG = WSP(float, WS_RW_G);
    const float* rk = INF(I_RK) + l * GW; const float* gng = INF(I_GNG) + l * GW; const float* gnb = INF(I_GNB) + l * GW;
    const float* glag = INF(I_GLA_G) + l * GW; const float* mlng = INF(I_MLN_G) + l * GW;
    constexpr int PL = HD64 / LANES;
    for (int t = gw; t < T; t += ngw) {
        for (int h = 0; h < NH; ++h) {
            {   float y[PL], s1 = 0.f, bon = 0.f;
                for (int i = 0; i < PL; ++i) { const int c = h * 64 + i * LANES + lane; const size_t o = (size_t)t * GW + c; y[i] = YA[o]; s1 += y[i]; bon += pR[o] * pK[o] * rk[c]; }
                s1 = wave_sum(s1); bon = wave_sum(bon); const float mean = s1 * (1.f / 64.f); float s2 = 0.f;
                for (int i = 0; i < PL; ++i) { y[i] -= mean; s2 += y[i] * y[i]; }
                s2 = wave_sum(s2); const float rstd = 1.f / sqrtf(s2 * (1.f / 64.f) + RWKV_GN_EPS);
                for (int i = 0; i < PL; ++i) { const int c = h * 64 + i * LANES + lane; const size_t o = (size_t)t * GW + c;
                    const float v = (y[i] * rstd * gng[c] + gnb[c] + bon * pV[o]) * pG[o]; mix[(size_t)t * DMIX + c] = f2bf(v); } }
            {   float y[PL], s2 = 0.f;
                for (int i = 0; i < PL; ++i) { const int c = h * 64 + i * LANES + lane; y[i] = YB[(size_t)t * GW + c]; s2 += y[i] * y[i]; }
                s2 = wave_sum(s2); const float rstd = 1.f / sqrtf(s2 * (1.f / 64.f) + NORM_EPS);
                for (int i = 0; i < PL; ++i) { const int c = h * 64 + i * LANES + lane;
                    const float v = y[i] * rstd * glag[c] * siluf_(ubf(u, t, UB_G + c)); mix[(size_t)t * DMIX + 256 + c] = f2bf(v); } }
            {   const float den = DEN[(size_t)t * 4 + h]; const float dinv = 1.f / fmaxf(fabsf(den), 1.f);
                float y[PL], s1 = 0.f;
                for (int i = 0; i < PL; ++i) { const int c = h * 64 + i * LANES + lane; y[i] = YC[(size_t)t * GW + c] * dinv; s1 += y[i]; }
                s1 = wave_sum(s1); const float mean = s1 * (1.f / 64.f); float s2 = 0.f;
                for (int i = 0; i < PL; ++i) { y[i] -= mean; s2 += y[i] * y[i]; }
                s2 = wave_sum(s2); const float rstd = 1.f / sqrtf(s2 * (1.f / 64.f) + LN_EPS);
                for (int i = 0; i < PL; ++i) { const int c = h * 64 + i * LANES + lane;
                    const float v = y[i] * rstd * mlng[c] * sigmoidf_(ubf(u, t, UC_O + c)); mix[(size_t)t * DMIX + 512 + c] = f2bf(v); } }
        }
    }
}

HD void ln_row(const float* src, const float* g, const float* b, float* dstf, bf16_t* dstb, int lane, float* keep  ) {
    constexpr int PL = DM / LANES;
    float s1 = 0.f;
#pragma unroll
    for (int i = 0; i < PL; ++i) { keep[i] = src[i * LANES + lane]; s1 += keep[i]; }
    s1 = wave_sum(s1); const float mean = s1 * (1.f / DM); float s2 = 0.f;
#pragma unroll
    for (int i = 0; i < PL; ++i) { keep[i] -= mean; s2 += keep[i] * keep[i]; }
    s2 = wave_sum(s2); const float rstd = 1.f / sqrtf(s2 * (1.f / DM) + LN_EPS);
#pragma unroll
    for (int i = 0; i < PL; ++i) { const int c = i * LANES + lane; keep[i] = keep[i] * rstd * g[c] + b[c]; dstf[c] = keep[i]; dstb[c] = f2bf(keep[i]); }
}
HD void stage_ln1_router(const Ctx& C, int l, int gw, int ngw, int lane, wsh_t sh) {
    float* X1 = C.out; bf16_t* xb = WSP(bf16_t, WS_XB);
    const float* g = INF(I_LN1G) + l * DM; const float* b = INF(I_LN1B) + l * DM;
    const float* wrg = INF(I_WRG) + (size_t)l * DM * NGRP; const float* brg = INF(I_BRG) + l * NGRP;
    const float* wre = INF(I_WRE) + (size_t)l * DM * NEXP; const float* bre = INF(I_BRE) + l * NEXP;
    unsigned* cnt = WSP(unsigned, WS_CTL) + CW_CNT + l * NEXP * 64;
    int* tokinfo = WSP(int, WS_TOKINFO); int* list = WSP(int, WS_LIST);
    constexpr int PL = DM / LANES;
    for (int t = gw; t < T; t += ngw) {
        {   float keep[PL];
            ln_row(X1 + (size_t)t * DM, g, b, X1 + (size_t)t * DM, xb + (size_t)t * DM, lane, keep);
#pragma unroll
            for (int i = 0; i < PL; ++i) sh[i * LANES + lane] = keep[i]; }
        WSYNC();
        float lg[NGRP], le[NEXP];
#pragma unroll
        for (int j = 0; j < NGRP; ++j) lg[j] = 0.f;
#pragma unroll
        for (int j = 0; j < NEXP; ++j) le[j] = 0.f;
#pragma unroll 1
        for (int i = 0; i < PL; ++i) { const int c = i * LANES + lane; const float xv = sh[c];
            const f4v wg = *(const f4v*)(wrg + (size_t)c * NGRP);
#pragma unroll
            for (int j = 0; j < NGRP; ++j) lg[j] += xv * wg[j];
#pragma unroll
            for (int j = 0; j < NEXP; j += 4) { const f4v we = *(const f4v*)(wre + (size_t)c * NEXP + j);
                le[j] += xv * we[0]; le[j + 1] += xv * we[1]; le[j + 2] += xv * we[2]; le[j + 3] += xv * we[3]; } }
        WSYNC();
#pragma unroll
        for (int j = 0; j < NGRP; ++j) lg[j] = wave_sum(lg[j]) + brg[j];
#pragma unroll
        for (int j = 0; j < NEXP; ++j) le[j] = wave_sum(le[j]) + bre[j];
        int gi = 0; float gm = lg[0];
#pragma unroll
        for (int j = 1; j < NGRP; ++j) if (lg[j] > gm) { gm = lg[j]; gi = j; }
        float gs = 0.f;
#pragma unroll
        for (int j = 0; j < NGRP; ++j) gs += expf(lg[j] - gm);
        const float group_p = 1.f / gs;
        float el[EPG];
#pragma unroll
        for (int j = 0; j < EPG; ++j) { float v = le[j];
#pragma unroll
            for (int g2 = 1; g2 < NGRP; ++g2) v = (gi == g2) ? le[g2 * EPG + j] : v;
            el[j] = v; }
        int e0 = 0; float m0 = el[0];
#pragma unroll
        for (int j = 1; j < EPG; ++j) if (el[j] > m0) { m0 = el[j]; e0 = j; }
        int e1 = -1; float m1 = -3.0e38f;
#pragma unroll
        for (int j = 0; j < EPG; ++j) if (j != e0 && el[j] > m1) { m1 = el[j]; e1 = j; }
        const float p1 = expf(m1 - m0); const float g0 = group_p / (1.f + p1), g1 = group_p * p1 / (1.f + p1);
        if (lane == 0) {
            const int E0 = gi * EPG + e0, E1 = gi * EPG + e1;
            tokinfo[(size_t)t * 4 + 0] = E0; tokinfo[(size_t)t * 4 + 1] = E1;
            ((float*)tokinfo)[(size_t)t * 4 + 2] = g0; ((float*)tokinfo)[(size_t)t * 4 + 3] = g1;
            const unsigned s0 = atom_add(cnt + E0 * 64, 1u); list[(size_t)E0 * T + s0] = t * 2 + 0;
            const unsigned s1 = atom_add(cnt + E1 * 64, 1u); list[(size_t)E1 * T + s1] = t * 2 + 1;
        }
    }
}
HD void moe_bases(const Ctx& C, int l, int* base  ) {
    const unsigned* cnt = WSP(unsigned, WS_CTL) + CW_CNT + l * NEXP * 64;
    int acc = 0;
    for (int e = 0; e < NEXP; ++e) { base[e] = acc; acc += ((int)cnt[e * 64] + 255) & ~255; }
    base[NEXP] = acc;
}
HD int moe_expert_of_row(const int* base, int row) { int e = 0; for (int j = 1; j < NEXP; ++j) if (row >= base[j]) e = j; return e; }
HD int moe_lookup(const unsigned* cnt, int row, int& e, int& be, int& ce) {
    int acc = 0; e = 0; be = 0; ce = 0;
    for (int j = 0; j < NEXP; ++j) { const int c = (int)cnt[j * 64]; if (row >= acc) { e = j; be = acc; ce = c; } acc += (c + 255) & ~255; }
    return acc;
}
HD void stage_gather(const Ctx& C, int l, int gw, int ngw, int lane) {
    const unsigned* cnt = WSP(unsigned, WS_CTL) + CW_CNT + l * NEXP * 64;
    const int* list = WSP(int, WS_LIST); const int* tokinfo = WSP(int, WS_TOKINFO);
    const bf16_t* xb = WSP(bf16_t, WS_XB); bf16_t* xg = WSP(bf16_t, WS_XG); int* rowinfo = WSP(int, WS_ROWINFO); float* rowgate = WSP(float, WS_ROWGATE);
    int e, be, ce; const int total = moe_lookup(cnt, 0, e, be, ce);
    for (int row = gw; row < total; row += ngw) {
        moe_lookup(cnt, row, e, be, ce);
        const int slot = row - be;
        if (slot < ce) { const int ent = list[(size_t)e * T + slot]; const int tok = ent >> 1;
            for (int c = lane * 8; c < DM; c += LANES * 8) *(u4v*)(xg + (size_t)row * DM + c) = *(const u4v*)(xb + (size_t)tok * DM + c);
            if (lane == 0) { rowinfo[row] = ent; rowgate[row] = ((const float*)tokinfo)[(size_t)tok * 4 + 2 + (ent & 1)]; } }
        else { const u4v z = {0u, 0u, 0u, 0u}; for (int c = lane * 8; c < DM; c += LANES * 8) *(u4v*)(xg + (size_t)row * DM + c) = z;
            if (lane == 0) { rowinfo[row] = -1; rowgate[row] = 0.f; } }
    }
}
HD void stage_ln2(const Ctx& C, int l, int gw, int ngw, int lane) {
    const float* src = WSP(float, WS_X); float* dst = (l == DEPTH - 1) ? C.out : WSP(float, WS_X); bf16_t* xb = WSP(bf16_t, WS_XB);
    const float* g = INF(I_LN2G) + l * DM; const float* b = INF(I_LN2B) + l * DM;
    constexpr int PL = DM / LANES;
    for (int t = gw; t < T; t += ngw) { float keep[PL]; ln_row(src + (size_t)t * DM, g, b, dst + (size_t)t * DM, xb + (size_t)t * DM, lane, keep); }
}

struct EpiU {
    static constexpr bool PERM = true; static constexpr int MODE = 0;
    bf16_t* o;
    HDM void put8(int row, int col, const float* a) const { st8bf(o + (size_t)row * DINP + col, a); }
};
struct EpiPP {
    static constexpr bool PERM = true; static constexpr int MODE = 0;
    bf16_t* o;
    HDM void put8(int row, int col, const float* a) const { st8bf(o + (size_t)row * DM + col, a); }
};
struct EpiPre1 {
    static constexpr bool PERM = false; static constexpr int MODE = 0;
    const float* x; float* o;
    HDM void put4(int row, int col, const float* a) const { const float al = dn_alpha(); const f4v xr = *(const f4v*)(x + (size_t)row * DM + col);
        f4v r; for (int j = 0; j < 4; ++j) r[j] = al * xr[j] + a[j]; *(f4v*)(o + (size_t)row * DM + col) = r; }
};
struct EpiH {
    static constexpr bool PERM = true; static constexpr int MODE = 1;
    bf16_t* o;
    HDM void put8gu(int row, int hcol, const float* g, const float* u) const { float v[8]; for (int j = 0; j < 8; ++j) v[j] = siluf_(g[j]) * u[j];
        st8bf(o + (size_t)row * DEXP + hcol, v); }
};
struct EpiY {
    static constexpr bool PERM = true; static constexpr int MODE = 0;
    const int* rowinfo; const float* rowgate; bf16_t* o;
    HDM void put8(int row, int col, const float* a) const { const int ent = rowinfo[row]; if (ent < 0) return; const float g = rowgate[row];
        float v[8]; for (int j = 0; j < 8; ++j) v[j] = g * a[j]; st8bf(o + (size_t)ent * DM + col, v); }
};
struct EpiPre2 {
    static constexpr bool PERM = false; static constexpr int MODE = 0;
    const float* x1; const bf16_t* ybuf; const bf16_t* pp; const float* bg; float* o;
    HDM void put4(int row, int col, const float* a) const { const float al = dn_alpha(); const size_t i = (size_t)row * DM + col;
        const f4v xr = *(const f4v*)(x1 + i); const f4v bgv = *(const f4v*)(bg + col);
        const unsigned* y0 = (const unsigned*)(ybuf + (size_t)(2 * row) * DM + col); const unsigned* y1 = (const unsigned*)(ybuf + (size_t)(2 * row + 1) * DM + col); const unsigned* pq = (const unsigned*)(pp + i);
        const unsigned y00 = y0[0], y01 = y0[1], y10 = y1[0], y11 = y1[1], p0 = pq[0], p1 = pq[1];
        float yv[4] = { __builtin_bit_cast(float, y00 << 16) + __builtin_bit_cast(float, y10 << 16), __builtin_bit_cast(float, y00 & 0xffff0000u) + __builtin_bit_cast(float, y10 & 0xffff0000u),
                        __builtin_bit_cast(float, y01 << 16) + __builtin_bit_cast(float, y11 << 16), __builtin_bit_cast(float, y01 & 0xffff0000u) + __builtin_bit_cast(float, y11 & 0xffff0000u) };
        float pv[4] = { __builtin_bit_cast(float, p0 << 16), __builtin_bit_cast(float, p0 & 0xffff0000u), __builtin_bit_cast(float, p1 << 16), __builtin_bit_cast(float, p1 & 0xffff0000u) };
        f4v r; for (int j = 0; j < 4; ++j) r[j] = al * xr[j] + yv[j] + sigmoidf_(a[j] + bgv[j]) * pv[j];
        *(f4v*)(o + i) = r; }
};

#ifndef CPU_TEST
namespace pg8 {
#define PG8_LAS __attribute__((address_space(3)))
typedef short bf16x8 __attribute__((ext_vector_type(8)));
typedef float f32x4 __attribute__((ext_vector_type(4)));
constexpr int BM = 256, BK = 64, HALF = 128, HTB = HALF * BK * 2, STAGE_BYTES = 8 * HTB;
__device__ __forceinline__ int lds_byte(int r, int c) { const int st = (r >> 4) * 2 + (c >> 5), rr = r & 15, cc = c & 31, ob = rr * 64 + cc * 2; return st * 1024 + (ob ^ (((ob >> 9) & 1) << 5)); }
__device__ __forceinline__ void stage_rc(int b, int& R, int& C) { const int st = b / 1024, sb = b % 1024, swz = sb ^ (((sb >> 9) & 1) << 5); R = (st >> 1) * 16 + swz / 64; C = (st & 1) * 32 + (swz % 64) / 2; }
__device__ __forceinline__ int perm32(int rho) { const int n = rho >> 4, i = rho & 15; return 8 * (i >> 2) + 4 * n + (i & 3); }
struct Unit { int pm, pn; long aoff, boff; };
struct Gemm { const bf16_t* A; const bf16_t* Bt; int lda, ldb, K; };

template <class F> __device__ __forceinline__ void run_epi(const F& f, const f32x4 (&acc)[2][2][4][2], const Unit& u, int wr, int wc, int fr, int fq) {
#pragma unroll
    for (int ai = 0; ai < 2; ++ai)
#pragma unroll
        for (int m = 0; m < 4; ++m) { const int row = u.pm * BM + ai * HALF + wr * 64 + m * 16 + fr;
            if constexpr (F::MODE == 1) { const int hcol = u.pn * 128 + wc * 32 + 8 * fq; float g[8], up[8];
#pragma unroll
                for (int j = 0; j < 4; ++j) { g[j] = acc[ai][0][m][0][j]; g[4 + j] = acc[ai][0][m][1][j]; up[j] = acc[ai][1][m][0][j]; up[4 + j] = acc[ai][1][m][1][j]; }
                f.put8gu(row, hcol, g, up); }
            else if constexpr (F::PERM) {
#pragma unroll
                for (int bj = 0; bj < 2; ++bj) { const int col = u.pn * BM + bj * HALF + wc * 32 + 8 * fq; float a[8];
#pragma unroll
                    for (int j = 0; j < 4; ++j) { a[j] = acc[ai][bj][m][0][j]; a[4 + j] = acc[ai][bj][m][1][j]; }
                    f.put8(row, col, a); } }
            else {
#pragma unroll
                for (int bj = 0; bj < 2; ++bj)
#pragma unroll
                    for (int n = 0; n < 2; ++n) { const int col = u.pn * BM + bj * HALF + wc * 32 + 16 * n + 4 * fq; float a[4];
#pragma unroll
                        for (int j = 0; j < 4; ++j) a[j] = acc[ai][bj][m][n][j];
                        f.put4(row, col, a); } }
        }
}

template <class Epi, class Sched>
__device__ __forceinline__ void gemm_phase(PG8_LAS unsigned char* lds, const Gemm g, const Sched& S, const Epi& E) {
    int tid = threadIdx.x; asm volatile("" : "+v"(tid));
    const int wid = __builtin_amdgcn_readfirstlane(tid >> 6), lane = tid & 63, wr = wid >> 2, wc = wid & 3, fr = lane & 15, fq = lane >> 4;
    const int K = g.K, nt = K / BK;
    unsigned voffA[2], voffB[2];
#pragma unroll
    for (int i = 0; i < 2; ++i) { int R, C; stage_rc(tid * 16 + i * 8192, R, C); const int Rb = Epi::PERM ? ((R & ~31) + perm32(R & 31)) : R;
        voffA[i] = (unsigned)(R * g.lda + C) * 2u; voffB[i] = (unsigned)(Rb * g.ldb + C) * 2u; }
    const size_t kstep = (size_t)(BK * 2);
    const size_t hstepA = (size_t)HALF * g.lda * 2, hstepB = (size_t)HALF * g.ldb * 2;
    const unsigned ldsw = (unsigned)wid * 1024u;
    const int aoff = lds_byte(wr * 64 + fr, fq * 8), boff = lds_byte(wc * 32 + fr, fq * 8);
#define PG8_SA(b, h) (((b) * 2 + (h)) * HTB)
#define PG8_SB(b, h) ((4 + (b) * 2 + (h)) * HTB)
#define PG8_STAGE(bufoff, gbase, voff) do { _Pragma("unroll") for (int _i = 0; _i < 2; ++_i) \
        __builtin_amdgcn_global_load_lds((const unsigned*)((const char*)(gbase) + (voff)[_i]), (PG8_LAS unsigned*)(lds + (bufoff) + ldsw + _i * 8192), 16, 0, 0); } while (0)
#define PG8_LDA(dst, b, h) do { _Pragma("unroll") for (int m = 0; m < 4; ++m) _Pragma("unroll") for (int k = 0; k < 2; ++k) dst[m][k] = *(const PG8_LAS bf16x8*)(lds + PG8_SA(b, h) + aoff + m * 2048 + k * 1024); } while (0)
#define PG8_LDB(dst, b, h) do { _Pragma("unroll") for (int n = 0; n < 2; ++n) _Pragma("unroll") for (int k = 0; k < 2; ++k) dst[n][k] = *(const PG8_LAS bf16x8*)(lds + PG8_SB(b, h) + boff + n * 2048 + k * 1024); } while (0)
#define PG8_MMA(ai, bj, At, Bt) do { __builtin_amdgcn_s_setprio(1); _Pragma("unroll") for (int m = 0; m < 4; ++m) _Pragma("unroll") for (int n = 0; n < 2; ++n) _Pragma("unroll") for (int k = 0; k < 2; ++k) \
        acc[ai][bj][m][n] = __builtin_amdgcn_mfma_f32_16x16x32_bf16(Bt[n][k], At[m][k], acc[ai][bj][m][n], 0, 0, 0); __builtin_amdgcn_s_setprio(0); } while (0)
#define PG8_WAIT_V(n) asm volatile("s_waitcnt vmcnt(" #n ")" ::: "memory")
#define PG8_WAIT_L(n) asm volatile("s_waitcnt lgkmcnt(" #n ")" ::: "memory")
#define PG8_BAR __builtin_amdgcn_s_barrier()
#define PG8_SCHED __builtin_amdgcn_sched_barrier(0)
    Unit cur, nxt; int ui = 0;
    if (!S.next(0, cur)) return;
    f32x4 acc[2][2][4][2];
#pragma unroll
    for (int a = 0; a < 2; ++a)
#pragma unroll
        for (int b = 0; b < 2; ++b)
#pragma unroll
            for (int m = 0; m < 4; ++m)
#pragma unroll
                for (int n = 0; n < 2; ++n) acc[a][b][m][n] = (f32x4){0.f, 0.f, 0.f, 0.f};
    bf16x8 At[4][2], B0[2][2], B1[2][2];
    const char* cA = (const char*)g.A + cur.aoff; const char* cB = (const char*)g.Bt + cur.boff;
    PG8_STAGE(PG8_SB(0, 0), cB, voffB); PG8_STAGE(PG8_SA(0, 0), cA, voffA); PG8_STAGE(PG8_SB(0, 1), cB + hstepB, voffB); PG8_STAGE(PG8_SA(0, 1), cA + hstepA, voffA);
    if (wr == 1) PG8_BAR;
    PG8_WAIT_V(4); PG8_BAR;
    PG8_STAGE(PG8_SB(1, 0), cB + kstep, voffB); PG8_STAGE(PG8_SA(1, 0), cA + kstep, voffA); PG8_STAGE(PG8_SB(1, 1), cB + hstepB + kstep, voffB);
    PG8_WAIT_V(6); PG8_BAR;
    for (;;) {
        const bool has_next = S.next(ui + 1, nxt);
        const char* nA = has_next ? (const char*)g.A + nxt.aoff : cA; const char* nB = has_next ? (const char*)g.Bt + nxt.boff : cB;
_Pragma("unroll 1")
        for (int t = 0; t < nt; t += 2) {
            const bool last = (t == nt - 2);
            const char* a1 = cA + (size_t)(t + 1) * kstep;
            const char* a2 = last ? nA : cA + (size_t)(t + 2) * kstep; const char* b2 = last ? nB : cB + (size_t)(t + 2) * kstep;
            const char* a3 = a2 + kstep; const char* b3 = b2 + kstep;
            PG8_LDB(B0, 0, 0); PG8_SCHED; PG8_LDA(At, 0, 0); PG8_STAGE(PG8_SA(1, 1), a1 + hstepA, voffA);
            PG8_WAIT_L(8); PG8_BAR; PG8_WAIT_L(0); PG8_MMA(0, 0, At, B0); PG8_BAR; PG8_SCHED;
            PG8_LDB(B1, 0, 1); PG8_STAGE(PG8_SB(0, 0), b2, voffB);
            PG8_BAR; PG8_WAIT_L(0); PG8_MMA(0, 1, At, B1); PG8_BAR;
            PG8_LDA(At, 0, 1); PG8_STAGE(PG8_SA(0, 0), a2, voffA);
            PG8_BAR; PG8_WAIT_L(0); PG8_MMA(1, 0, At, B0); PG8_BAR; PG8_SCHED;
            PG8_STAGE(PG8_SB(0, 1), b2 + hstepB, voffB);
            PG8_WAIT_V(6); PG8_BAR; PG8_MMA(1, 1, At, B1); PG8_BAR;
            PG8_LDB(B0, 1, 0); PG8_SCHED; PG8_LDA(At, 1, 0); PG8_STAGE(PG8_SA(0, 1), a2 + hstepA, voffA);
            PG8_WAIT_L(8); PG8_BAR; PG8_WAIT_L(0); PG8_MMA(0, 0, At, B0); PG8_BAR; PG8_SCHED;
            PG8_LDB(B1, 1, 1); PG8_STAGE(PG8_SB(1, 0), b3, voffB);
            PG8_BAR; PG8_WAIT_L(0); PG8_MMA(0, 1, At, B1); PG8_BAR;
            PG8_LDA(At, 1, 1); PG8_STAGE(PG8_SA(1, 0), a3, voffA);
            PG8_BAR; PG8_WAIT_L(0); PG8_MMA(1, 0, At, B0); PG8_BAR; PG8_SCHED;
            PG8_STAGE(PG8_SB(1, 1), b3 + hstepB, voffB);
            PG8_WAIT_V(6); PG8_BAR; PG8_MMA(1, 1, At, B1); PG8_BAR;
        }
        run_epi(E, acc, cur, wr, wc, fr, fq);
        if (!has_next) break;
#pragma unroll
        for (int a = 0; a < 2; ++a)
#pragma unroll
            for (int b = 0; b < 2; ++b)
#pragma unroll
                for (int m = 0; m < 4; ++m)
#pragma unroll
                    for (int n = 0; n < 2; ++n) acc[a][b][m][n] = (f32x4){0.f, 0.f, 0.f, 0.f};
        cur = nxt; cA = nA; cB = nB; ++ui;
    }
    PG8_WAIT_V(0);
    if (wr == 0) PG8_BAR;
    PG8_BAR;
#undef PG8_SA
#undef PG8_SB
#undef PG8_STAGE
#undef PG8_LDA
#undef PG8_LDB
#undef PG8_MMA
#undef PG8_WAIT_V
#undef PG8_WAIT_L
#undef PG8_BAR
#undef PG8_SCHED
}
struct DenseOrder {
    int nM, nN, G, c; long astep, bstep;
    __device__ __forceinline__ bool next(int i, Unit& u) const {
        const long L = (long)i * G + c; if (L >= (long)nM * nN) return false;
        const int w = (int)L; const int nig = 8 * nN, gid = w / nig, fm = gid * 8, gsz = (nM - fm) < 8 ? (nM - fm) : 8;
        u.pm = fm + ((w % nig) % gsz); u.pn = (w % nig) / gsz; u.aoff = (long)u.pm * astep; u.boff = (long)u.pn * bstep; return true; }
};
struct MoeOrder {
    const PG8_LAS int* tbl; int nM, nN, G, c; long astep, bstep, estep;
    __device__ __forceinline__ bool next(int i, Unit& u) const {
        const long L = (long)i * G + c; if (L >= (long)nM * nN) return false;
        const int w = (int)L; u.pm = w / nN; u.pn = w % nN; const int e = tbl[u.pm];
        u.aoff = (long)u.pm * astep; u.boff = (long)e * estep + (long)u.pn * bstep; return true; }
};
}
#endif

constexpr int PH_PER_LAYER = 12;
constexpr int NPHASES = DEPTH * PH_PER_LAYER;

#ifndef CPU_TEST
#define XB_TMO      128
#define XB_XCNT(j)  (256  + 64 * (j))
#define XB_XSUB(j)  (1280 + 64 * (j))
#define XB_XGEN(j)  (2304 + 64 * (j))
#define XB_TOP      3328
#define XB_TOPGEN   3392
#define XCD_BAR_WORDS 3456
#define XB_SPIN_CAP (1u << 18)
#define LAS __attribute__((address_space(3)))
__device__ __forceinline__ unsigned xb_ld(unsigned* p)              { return __hip_atomic_load(p, __ATOMIC_RELAXED, __HIP_MEMORY_SCOPE_AGENT); }
__device__ __forceinline__ unsigned xb_add(unsigned* p, unsigned v) { return __hip_atomic_fetch_add(p, v, __ATOMIC_RELAXED, __HIP_MEMORY_SCOPE_AGENT); }
__device__ __forceinline__ unsigned xb_xcc_id() { return (unsigned)__builtin_amdgcn_s_getreg((3 << 11) | 20) & 0xFu; }
#define XB_SPIN(cond, bar) do { unsigned _sp = 0; while (cond) { __builtin_amdgcn_s_sleep(1); \
    if ((++_sp & 255u) == 0u) { if (xb_ld(&(bar)[XB_TMO])) break; if (_sp > XB_SPIN_CAP) { atomicAdd(&(bar)[XB_TMO], 1u); break; } } } } while (0)
struct XcdBarrier { unsigned* bar; unsigned x; volatile LAS unsigned* st; };
__device__ __forceinline__ XcdBarrier xcd_barrier_post(unsigned* bar, volatile LAS unsigned* st) {
    XcdBarrier b; b.bar = bar; b.x = xb_xcc_id(); b.st = st;
    if (threadIdx.x == 0) (void)xb_add(&bar[XB_XCNT(b.x)], 1u);
    return b;
}
__device__ __forceinline__ void xcd_barrier_complete(unsigned* bar, unsigned x, unsigned& nloc, unsigned& nx) {
    const unsigned G = gridDim.x * gridDim.y * gridDim.z;
    unsigned sum, cnt, mine, sp = 0u;
    for (;;) {
        sum = 0u; cnt = 0u; mine = 0u;
#pragma unroll
        for (unsigned j = 0; j < 16; ++j) { const unsigned c = xb_ld(&bar[XB_XCNT(j)]); sum += c; cnt += (c > 0u) ? 1u : 0u; mine = (j == x) ? c : mine; }
        if (sum == G) break;
        __builtin_amdgcn_s_sleep(1);
        if ((++sp & 255u) == 0u) { if (xb_ld(&bar[XB_TMO])) break; if (sp > XB_SPIN_CAP) { atomicAdd(&bar[XB_TMO], 1u); break; } }
    }
    nloc = mine > 0u ? mine : 1u; nx = cnt > 0u ? cnt : 1u;
}
__device__ __forceinline__ void xcd_barrier(const XcdBarrier& b) {
    asm volatile("s_waitcnt vmcnt(0)" ::: "memory");
    __syncthreads();
    if (threadIdx.x == 0) {
        unsigned* bar = b.bar;
        __builtin_amdgcn_s_waitcnt(0);
        unsigned nloc = b.st[0], nx = b.st[1];
        if (nloc == 0u) { xcd_barrier_complete(bar, b.x, nloc, nx); b.st[0] = nloc; b.st[1] = nx; }
        const unsigned old = xb_add(&bar[XB_XSUB(b.x)], 1u);
        const unsigned gen = old / nloc;
        if (old + 1u == (gen + 1u) * nloc) {
            __builtin_amdgcn_fence(__ATOMIC_RELEASE, "agent");
            asm volatile("s_waitcnt vmcnt(0)" ::: "memory");
            const unsigned og = xb_add(&bar[XB_TOP], 1u);
            const unsigned tg = og / nx;
            if (og + 1u == (tg + 1u) * nx) xb_add(&bar[XB_TOPGEN], 1u);
            else XB_SPIN(xb_ld(&bar[XB_TOPGEN]) == tg, bar);
            __builtin_amdgcn_fence(__ATOMIC_ACQUIRE, "agent");
            xb_add(&bar[XB_XGEN(b.x)], 1u);
            asm volatile("s_waitcnt vmcnt(0)" ::: "memory");
        } else {
            XB_SPIN(xb_ld(&bar[XB_XGEN(b.x)]) == gen, bar);
            __builtin_amdgcn_fence(__ATOMIC_ACQUIRE, "agent");
            asm volatile("s_waitcnt vmcnt(0)" ::: "memory");
        }
    }
    __syncthreads();
}

constexpr int NWAVES = 8;
constexpr int RING_BYTES = 131072, MISC_OFF = RING_BYTES + 320, LDS_BYTES = 147456;
struct Args { Ctx C; int ph_lo, ph_hi; };
__device__ __forceinline__ int moe_fill_table(const Ctx& C, int l, LAS int* tbl, int tid) {
    const unsigned* cnt = WSP(unsigned, WS_CTL) + CW_CNT + l * NEXP * 64;
    int e, be, ce; const int total = moe_lookup(cnt, tid * 256, e, be, ce);
    if (tid < 320) tbl[tid] = e;
    __syncthreads();
    return total >> 8;
}

__global__ void __launch_bounds__(NWAVES * 64, 2) mega(Args args) {
    extern __shared__ __attribute__((aligned(16))) unsigned char lds_raw[];
    LAS unsigned char* lds = (LAS unsigned char*)lds_raw;
    const Ctx& C = args.C;
    const int G = gridDim.x, bx = blockIdx.x;
    const int ngw = G * NWAVES;
    volatile LAS unsigned* MISC = (volatile LAS unsigned*)(lds + MISC_OFF);
    for (int i = threadIdx.x; i < (LDS_BYTES - RING_BYTES) / 4; i += NWAVES * 64) ((LAS unsigned*)(lds + RING_BYTES))[i] = 0u;
    __syncthreads();
    XcdBarrier bar = xcd_barrier_post(WSP(unsigned, WS_CTL) + CW_BAR, MISC + 8);
    LAS int* tbl = (LAS int*)(lds + RING_BYTES + 1024);
    const int lo = args.ph_lo, hi = args.ph_hi;

    for (int l = 0; l < DEPTH; ++l) {
        const int p0 = l * PH_PER_LAYER;
#ifndef PHASE_MASK
#define PHASE_MASK 0xFFF
#endif
#define IN(k) (((PHASE_MASK >> (k)) & 1) && lo <= p0 + (k) && p0 + (k) < hi)
#define LAUNDER() int tid = threadIdx.x; asm volatile("" : "+v"(tid)); const int lane = tid & 63; const int wave = __builtin_amdgcn_readfirstlane(tid >> 6); const int gw = bx * NWAVES + wave; (void)gw; (void)lane; \
        wsh_t wsh = (wsh_t)(lds + wave * 16384); (void)wsh
#define SEAM(k) do { if (p0 + (k) + 1 < hi) xcd_barrier(bar); } while (0)
        if (IN(0)) { LAUNDER(); stage_convert(C, l, gw, ngw, lane, wsh); SEAM(0); }
        if (IN(1)) { LAUNDER();
            pg8::Gemm g{WSP(bf16_t, WS_XB), WSP(bf16_t, WS_WIN), DM, DM, DM};
            pg8::DenseOrder S{T / 256, DINP / 256, G, bx, (long)256 * DM * 2, (long)256 * DM * 2};
            EpiU E{WSP(bf16_t, WS_U)};
            pg8::gemm_phase(lds, g, S, E); SEAM(1); }
        if (IN(2)) { LAUNDER(); stage_prep(C, l, gw, ngw, lane, wsh); SEAM(2); }
        if (IN(3)) { LAUNDER();
            if (wave == 0 && bx < 97) {
                if (bx < 32) rwkv_scan_thread(C, bx >> 2, bx & 3, lane);
                else if (bx < 64) gla_scan_thread(C, (bx - 32) >> 2, (bx - 32) & 3, lane);
                else if (bx < 96) mlstm_scan_thread(C, (bx - 64) >> 2, (bx - 64) & 3, lane);
                else if (lane < 32) mlstm_scan_thread(C, lane >> 2, lane & 3, 64);
            } else {
                const int aw = (bx < 97) ? bx * 7 + (wave - 1) : 97 * 7 + (bx - 97) * 8 + wave;
                const int naw = 97 * 7 + (G - 97) * 8;
                constexpr int NQB = SEQ / 64;
                for (int it = aw; it < BATCH * NH * NQB; it += naw) {
                    const int qb = NQB - 1 - it / (BATCH * NH), bh = it % (BATCH * NH);
                    attn_thread(C, bh >> 2, bh & 3, qb * 64 + lane, qb * 64 + 63); }
            }
            SEAM(3); }
        if (IN(4)) { LAUNDER(); stage_post(C, l, gw, ngw, lane); SEAM(4); }
        if (IN(5)) { LAUNDER();
            pg8::Gemm g{WSP(bf16_t, WS_MIX), WSP(bf16_t, WS_WOUT), DMIX, DMIX, DMIX};
            pg8::DenseOrder S{T / 256, DM / 256, G, bx, (long)256 * DMIX * 2, (long)256 * DMIX * 2};
            EpiPre1 E{l == 0 ? INF(I_X) : WSP(float, WS_X), C.out};
            pg8::gemm_phase(lds, g, S, E); SEAM(5); }
        if (IN(6)) { LAUNDER(); stage_ln1_router(C, l, gw, ngw, lane, wsh); SEAM(6); }
        if (IN(7)) { LAUNDER();
            stage_gather(C, l, gw, ngw, lane);
            pg8::Gemm g{WSP(bf16_t, WS_PB), WSP(bf16_t, WS_WP), DPLE, DPLE, DPLE};
            pg8::DenseOrder S{T / 256, DM / 256, G, bx, (long)256 * DPLE * 2, (long)256 * DPLE * 2};
            EpiPP E{WSP(bf16_t, WS_PP)};
            pg8::gemm_phase(lds, g, S, E); SEAM(7); }
        if (IN(8)) { LAUNDER();
            pg8::Gemm g{WSP(bf16_t, WS_XG), WSP(bf16_t, WS_WGU), DM, DM, DM};
            const int ntile = moe_fill_table(C, l, tbl, tid);
            pg8::MoeOrder S{tbl, ntile, 2 * DEXP / 256, G, bx, (long)256 * DM * 2, (long)256 * DM * 2, (long)2 * DEXP * DM * 2};
            EpiH E{WSP(bf16_t, WS_H)};
            pg8::gemm_phase(lds, g, S, E); SEAM(8); }
        if (IN(9)) { LAUNDER();
            pg8::Gemm g{WSP(bf16_t, WS_H), WSP(bf16_t, WS_WD), DEXP, DEXP, DEXP};
            const int ntile = moe_fill_table(C, l, tbl, tid);
            pg8::MoeOrder S{tbl, ntile, DM / 256, G, bx, (long)256 * DEXP * 2, (long)256 * DEXP * 2, (long)DM * DEXP * 2};
            EpiY E{WSP(int, WS_ROWINFO), WSP(float, WS_ROWGATE), WSP(bf16_t, WS_YBUF)};
            pg8::gemm_phase(lds, g, S, E); SEAM(9); }
        if (IN(10)) { LAUNDER();
            pg8::Gemm g{WSP(bf16_t, WS_XB), WSP(bf16_t, WS_WPG), DM, DM, DM};
            pg8::DenseOrder S{T / 256, DM / 256, G, bx, (long)256 * DM * 2, (long)256 * DM * 2};
            EpiPre2 E{C.out, WSP(bf16_t, WS_YBUF), WSP(bf16_t, WS_PP), INF(I_PLEBG) + l * DM, WSP(float, WS_X)};
            pg8::gemm_phase(lds, g, S, E); SEAM(10); }
        if (IN(11)) { LAUNDER(); stage_ln2(C, l, gw, ngw, lane); SEAM(11); }
#undef IN
#undef SEAM
    }
}

extern "C" void kernel_launch(void* const* d_in, const int* in_sizes, int n_in, void* d_out, int out_size, void* d_ws, size_t ws_size, hipStream_t stream) {
    static int grid = 0;
    if (grid == 0) {
        if (n_in != N_IN || out_size != T * DM || ws_size < WS_END) { fprintf(stderr, "kernel_launch: bad sizes n_in %d out %d ws %zu need %zu\n", n_in, out_size, ws_size, (size_t)WS_END); grid = -1; return; }
        int dev = 0, cus = 0, per_cu = 0;
        hipGetDevice(&dev); hipDeviceGetAttribute(&cus, hipDeviceAttributeMultiprocessorCount, dev);
        if (hipFuncSetAttribute((const void*)mega, hipFuncAttributeMaxDynamicSharedMemorySize, LDS_BYTES) != hipSuccess) { fprintf(stderr, "hipFuncSetAttribute failed\n"); grid = -1; return; }
        if (hipOccupancyMaxActiveBlocksPerMultiprocessor(&per_cu, (const void*)mega, NWAVES * 64, LDS_BYTES) != hipSuccess || per_cu < 1) { fprintf(stderr, "occupancy query: %d\n", per_cu); }
        (void)hipGetLastError();
        grid = cus;
    }
    if (grid < 0) return;
    hipMemsetAsync((char*)d_ws + WS_CTL, 0, CTL_BYTES, stream);
    Args a{};
    for (int i = 0; i < N_IN; ++i) a.C.in[i] = d_in[i];
    a.C.out = (float*)d_out; a.C.ws = (unsigned char*)d_ws;
#ifndef ONE_LAUNCH
    for (int ph = 0; ph < NPHASES; ++ph) { a.ph_lo = ph; a.ph_hi = ph + 1; hipLaunchKernelGGL(mega, dim3(grid), dim3(NWAVES * 64), LDS_BYTES, stream, a); }
#else
    a.ph_lo = 0; a.ph_hi = NPHASES; hipLaunchKernelGGL(mega, dim3(grid), dim3(NWAVES * 64), LDS_BYTES, stream, a);
#endif
}
#else
template <class E> static void cpu_gemm(const bf16_t* A, int lda, const bf16_t* Bt, int ldb, int K, int M, int N, const E& e, const int* base = nullptr, long estep = 0) {
    for (int row = 0; row < M; ++row) {
        const bf16_t* B = Bt;
        if (base) B = Bt + (size_t)moe_expert_of_row(base, row) * estep;
        if constexpr (E::MODE == 1) {
            for (int hc = 0; hc < N / 2; hc += 8) { float g[8], u[8];
                for (int j = 0; j < 8; ++j) { float ag = 0.f, au = 0.f; const bf16_t* bg = B + (size_t)rowmap(1, hc + j) * ldb; const bf16_t* bu = B + (size_t)rowmap(2, hc + j) * ldb;
                    for (int k = 0; k < K; ++k) { const float a = bf2f(A[(size_t)row * lda + k]); ag += a * bf2f(bg[k]); au += a * bf2f(bu[k]); } g[j] = ag; u[j] = au; }
                e.put8gu(row, hc, g, u); }
        } else if constexpr (E::PERM) {
            for (int c = 0; c < N; c += 8) { float a8[8];
                for (int j = 0; j < 8; ++j) { float acc = 0.f; for (int k = 0; k < K; ++k) acc += bf2f(A[(size_t)row * lda + k]) * bf2f(B[(size_t)(c + j) * ldb + k]); a8[j] = acc; }
                e.put8(row, c, a8); }
        } else {
            for (int c = 0; c < N; c += 4) { float a4[4];
                for (int j = 0; j < 4; ++j) { float acc = 0.f; for (int k = 0; k < K; ++k) acc += bf2f(A[(size_t)row * lda + k]) * bf2f(B[(size_t)(c + j) * ldb + k]); a4[j] = acc; }
                e.put4(row, c, a4); }
        }
    }
}
static void cpu_forward(const Ctx& C) {
    static float shbuf[4096];
    for (int l = 0; l < DEPTH; ++l) {
        stage_convert(C, l, 0, 1, 0, shbuf);
        { EpiU E{WSP(bf16_t, WS_U)}; cpu_gemm(WSP(bf16_t, WS_XB), DM, WSP(bf16_t, WS_WIN), DM, DM, T, DINP, E); }
        stage_prep(C, l, 0, 1, 0, shbuf);
        for (int b = 0; b < BATCH; ++b) for (int h = 0; h < NH; ++h) {
            for (int v = 0; v < 64; ++v) { rwkv_scan_thread(C, b, h, v); gla_scan_thread(C, b, h, v); }
            for (int e = 0; e < 65; ++e) mlstm_scan_thread(C, b, h, e);
            for (int q = 0; q < SEQ; ++q) attn_thread(C, b, h, q, q); }
        stage_post(C, l, 0, 1, 0);
        { EpiPre1 E{l == 0 ? INF(I_X) : WSP(float, WS_X), C.out}; cpu_gemm(WSP(bf16_t, WS_MIX), DMIX, WSP(bf16_t, WS_WOUT), DMIX, DMIX, T, DM, E); }
        stage_ln1_router(C, l, 0, 1, 0, shbuf);
        stage_gather(C, l, 0, 1, 0);
        { EpiPP E{WSP(bf16_t, WS_PP)}; cpu_gemm(WSP(bf16_t, WS_PB), DPLE, WSP(bf16_t, WS_WP), DPLE, DPLE, T, DM, E); }
        int base[NEXP + 1]; moe_bases(C, l, base);
        { EpiH E{WSP(bf16_t, WS_H)}; cpu_gemm(WSP(bf16_t, WS_XG), DM, WSP(bf16_t, WS_WGU), DM, DM, base[NEXP], 2 * DEXP, E, base, (long)2 * DEXP * DM); }
        { EpiY E{WSP(int, WS_ROWINFO), WSP(float, WS_ROWGATE), WSP(bf16_t, WS_YBUF)}; cpu_gemm(WSP(bf16_t, WS_H), DEXP, WSP(bf16_t, WS_WD), DEXP, DEXP, base[NEXP], DM, E, base, (long)DM * DEXP); }
        { EpiPre2 E{C.out, WSP(bf16_t, WS_YBUF), WSP(bf16_t, WS_PP), INF(I_PLEBG) + l * DM, WSP(float, WS_X)}; cpu_gemm(WSP(bf16_t, WS_XB), DM, WSP(bf16_t, WS_WPG), DM, DM, T, DM, E); }
        stage_ln2(C, l, 0, 1, 0);
    }
}
#endif
```

```cpp
#ifndef CPU_TEST
#include <hip/hip_runtime.h>
#include <cstdio>
#include <cstdint>
#define HD __device__ __forceinline__
#define HDM __device__ __forceinline__
#define LANES 64
#else
#include <cmath>
#include <cstdio>
#include <cstdint>
#include <cstring>
#include <algorithm>
#define HD static inline
#define HDM inline
#define LANES 1
#endif

#define ONE_LAUNCH 1
#ifndef CFG_SMALL
constexpr int BATCH = 8, SEQ = 4096, DM = 1024, DEPTH = 4, DPLE = 256, DEXP = 512;
#else
constexpr int BATCH = 2, SEQ = 256, DM = 128, DEPTH = 2, DPLE = 32, DEXP = 128;
#endif
constexpr int T = BATCH * SEQ;
constexpr int DMIX = 1024, GW = 256, HD64 = 64, NH = 4;
constexpr int DIN = 3128, DINP = 3328;
constexpr int UA = 0, UA_R = 0, UA_K = 256, UA_V = 512, UA_WD = 768, UA_AD = 800, UA_GD = 832, DINA = 896;
constexpr int UB = 896, UB_Q = 896, UB_K = 1024, UB_V = 1152, UB_AD = 1408, UB_G = 1424;
constexpr int UC = 1680, UC_Q = 1680, UC_K = 1936, UC_V = 2192, UC_O = 2448, UC_IG = 2704, UC_FG = 2708;
constexpr int UD = 2712, UD_CQ = 2712, UD_CKV = 2968, UD_KR = 3096;
constexpr int NEXP = 32, NGRP = 4, EPG = 8;
constexpr int MAXROWS = 2 * T + NEXP * 256;
constexpr float DN_ALPHA = 1.681792830507429f;
constexpr float LN_EPS = 1e-5f, NORM_EPS = 1e-6f, RWKV_GN_EPS = 64e-5f;
static_assert(DEPTH == 4 || DEPTH == 2, "alpha below assumes depth");
HD float dn_alpha() { return DEPTH == 4 ? 1.681792830507429f : 1.4142135623730951f; }

enum { I_X = 0, I_P, I_POS, I_WIN, I_MU, I_W0, I_WUP, I_A0, I_AUP, I_GUP, I_KK, I_KA, I_RK, I_GNG, I_GNB, I_GLA_UP, I_GLA_B, I_GLA_G,
       I_CONVW, I_CONVB, I_IB, I_FB, I_MLN_G, I_QNG, I_WUQ, I_KVNG, I_WUKV, I_WOUT, I_LN1G, I_LN1B, I_WRG, I_BRG, I_WRE, I_BRE,
       I_WG, I_WU, I_WD, I_PLEG, I_PLEBG, I_PLEW, I_LN2G, I_LN2B, N_IN };

typedef unsigned short bf16_t;
HD float bf2f(bf16_t h) { unsigned u = (unsigned)h << 16; return __builtin_bit_cast(float, u); }
HD bf16_t f2bf(float f) { unsigned u = __builtin_bit_cast(unsigned, f); return (bf16_t)((u + 0x7fffu + ((u >> 16) & 1u)) >> 16); }
HD unsigned pk2(float lo, float hi) { return (unsigned)f2bf(lo) | ((unsigned)f2bf(hi) << 16); }
typedef float f4v __attribute__((vector_size(16)));
typedef unsigned u4v __attribute__((vector_size(16)));
HD void ld8bf(const bf16_t* p, float* o) { const u4v w = *(const u4v*)p;
    for (int j = 0; j < 4; ++j) { o[2 * j] = __builtin_bit_cast(float, w[j] << 16); o[2 * j + 1] = __builtin_bit_cast(float, w[j] & 0xffff0000u); } }
HD void st8bf(bf16_t* p, const float* a) { u4v w; for (int j = 0; j < 4; ++j) w[j] = pk2(a[2 * j], a[2 * j + 1]); *(u4v*)p = w; }

constexpr size_t MiB = (size_t)1 << 20;
constexpr size_t al256(size_t x) { return (x + 255) & ~(size_t)255; }
constexpr size_t WS_CTL = 0, CTL_BYTES = 1 * MiB;
constexpr size_t WS_WIN = WS_CTL + CTL_BYTES;
constexpr size_t WS_WOUT = WS_WIN + al256((size_t)DINP * DM * 2);
constexpr size_t WS_WPG = WS_WOUT + al256((size_t)DM * DMIX * 2);
constexpr size_t WS_WP = WS_WPG + al256((size_t)DM * DM * 2);
constexpr size_t WS_WGU = WS_WP + al256((size_t)DM * DPLE * 2);
constexpr size_t WS_WD = WS_WGU + al256((size_t)NEXP * 2 * DEXP * DM * 2);
constexpr size_t WS_X = WS_WD + al256((size_t)NEXP * DM * DEXP * 2);
constexpr size_t WS_XB = WS_X + al256((size_t)T * DM * 4);
constexpr size_t WS_U = WS_XB + al256((size_t)T * DM * 2);
constexpr size_t WS_MIX = WS_U + al256((size_t)T * DINP * 2);
constexpr size_t WS_PB = WS_MIX + al256((size_t)T * DMIX * 2);
constexpr size_t WS_SCR = WS_PB + al256((size_t)T * DPLE * 2);
constexpr size_t TV = al256((size_t)T * GW * 4);
constexpr size_t WS_RW_R = WS_SCR, WS_RW_W = WS_RW_R + TV, WS_RW_K = WS_RW_W + TV, WS_RW_V = WS_RW_K + TV, WS_RW_A = WS_RW_V + TV,
                 WS_RW_B = WS_RW_A + TV, WS_RW_G = WS_RW_B + TV;
constexpr size_t WS_YA = WS_RW_G + TV, WS_YB = WS_YA + TV, WS_YC = WS_YB + TV;
constexpr size_t WS_DEN = WS_YC + TV;
constexpr size_t WS_QK = WS_DEN + al256((size_t)T * 4 * 4);
constexpr size_t WS_GA = WS_QK + al256((size_t)T * 512 * 4);
constexpr size_t WS_LG = WS_GA + al256((size_t)T * 128 * 4);
constexpr size_t WS_AQ = WS_LG + al256((size_t)T * 8 * 4);
constexpr size_t WS_AK = WS_AQ + al256((size_t)T * 384 * 2);
constexpr size_t WS_AV = WS_AK + al256((size_t)T * 384 * 2);
constexpr size_t WS_MIXER_END = WS_AV + al256((size_t)T * 256 * 2);
constexpr size_t WS_XG = WS_SCR;
constexpr size_t WS_H = WS_XG + al256((size_t)MAXROWS * DM * 2);
constexpr size_t WS_YBUF = WS_H + al256((size_t)MAXROWS * DEXP * 2);
constexpr size_t WS_PP = WS_YBUF + al256((size_t)2 * T * DM * 2);
constexpr size_t WS_TOKINFO = WS_PP + al256((size_t)T * DM * 2);
constexpr size_t WS_LIST = WS_TOKINFO + al256((size_t)T * 16);
constexpr size_t WS_ROWINFO = WS_LIST + al256((size_t)NEXP * T * 4);
constexpr size_t WS_ROWGATE = WS_ROWINFO + al256((size_t)MAXROWS * 4);
constexpr size_t WS_MOE_END = WS_ROWGATE + al256((size_t)MAXROWS * 4);
constexpr size_t WS_END = WS_MIXER_END > WS_MOE_END ? WS_MIXER_END : WS_MOE_END;
constexpr int CW_BAR = 4096;
constexpr int CW_CNT = 16384;

struct Ctx {
    const void* in[N_IN];
    float* out;
    unsigned char* ws;
};
#define INF(i) ((const float*)C.in[i])
#define WSP(T_, off) ((T_*)(C.ws + (off)))

#ifndef CPU_TEST
HD float wave_sum(float v) {
#pragma unroll
    for (int o = 1; o < 64; o <<= 1) v += __shfl_xor(v, o);
    return v;
}
HD float wave_max(float v) {
#pragma unroll
    for (int o = 1; o < 64; o <<= 1) v = fmaxf(v, __shfl_xor(v, o));
    return v;
}
HD unsigned atom_add(unsigned* p, unsigned v) { return atomicAdd(p, v); }
#define WSYNC() __builtin_amdgcn_wave_barrier(); asm volatile("s_waitcnt lgkmcnt(0)" ::: "memory")
typedef __attribute__((address_space(3))) float* wsh_t;
#else
HD float wave_sum(float v) { return v; }
HD float wave_max(float v) { return v; }
HD unsigned atom_add(unsigned* p, unsigned v) { unsigned o = *p; *p += v; return o; }
#define WSYNC()
typedef float* wsh_t;
#endif
HD float sigmoidf_(float x) { return 1.f / (1.f + expf(-x)); }
HD float softplusf_(float x) { return x > 20.f ? x : (x < -20.f ? expf(x) : log1pf(expf(x))); }
HD float siluf_(float x) { return x * sigmoidf_(x); }

HD int rowmap(int mode, int n) { return mode == 0 ? n : (mode == 1 ? (n >> 7) * 256 + (n & 127) : (n >> 7) * 256 + 128 + (n & 127)); }
HD void transpose_item(const float* W, int K, int N, int ldw, bf16_t* WT, int ldk, int mode, int item, int lane, wsh_t scr) {
    const int nblk = (N + 31) / 32, kb = item / nblk, nb = item % nblk, k0 = 64 * kb, n0 = 32 * nb;
    for (int idx = lane; idx < 2048; idx += LANES) { const int kk = idx >> 5, nn = idx & 31; const int n = n0 + nn;
        scr[kk * 33 + nn] = (n < N) ? W[(size_t)(k0 + kk) * ldw + n] : 0.f; }
    WSYNC();
    for (int idx = lane; idx < 256; idx += LANES) { const int n = idx >> 3, c = idx & 7;
        unsigned o[4];
        for (int j = 0; j < 4; ++j) o[j] = pk2(scr[(8 * c + 2 * j) * 33 + n], scr[(8 * c + 2 * j + 1) * 33 + n]);
        unsigned* dst = (unsigned*)(WT + (size_t)rowmap(mode, n0 + n) * ldk + k0 + 8 * c);
        dst[0] = o[0]; dst[1] = o[1]; dst[2] = o[2]; dst[3] = o[3]; }
    WSYNC();
}
HD void stage_convert(const Ctx& C, int l, int gw, int ngw, int lane, wsh_t scr) {
    constexpr int NB_IN = DINP / 32;
    constexpr int I_IN = (DM / 64) * NB_IN, I_OUT = (DMIX / 64) * (DM / 32), I_PG = (DM / 64) * (DM / 32), I_PW = (DPLE / 64 > 0 ? DPLE / 64 : 1) * (DM / 32);
    constexpr int I_G1 = (DM / 64) * (DEXP / 32), I_D1 = (DEXP / 64) * (DM / 32);
    constexpr int NIT = I_IN + I_OUT + I_PG + I_PW + NEXP * (2 * I_G1 + I_D1);
    static_assert(DPLE % 32 == 0 && DEXP % 64 == 0, "shapes");
    for (int it = gw; it < NIT; it += ngw) {
        int r = it;
        if (r < I_IN) {
            const int nblk = NB_IN, kb = r / nblk, nb = r % nblk, k0 = 64 * kb, n0 = 32 * nb;
            const float* W = INF(I_WIN) + (size_t)l * DM * DIN; bf16_t* WT = WSP(bf16_t, WS_WIN);
            for (int idx = lane; idx < 2048; idx += LANES) { const int kk = idx >> 5, nn = idx & 31; const int n = n0 + nn;
                scr[kk * 33 + nn] = (n < DIN) ? W[(size_t)(k0 + kk) * DIN + n] : 0.f; }
            WSYNC();
            for (int idx = lane; idx < 256; idx += LANES) { const int n = idx >> 3, c = idx & 7; unsigned o[4];
                for (int j = 0; j < 4; ++j) o[j] = pk2(scr[(8 * c + 2 * j) * 33 + n], scr[(8 * c + 2 * j + 1) * 33 + n]);
                unsigned* dst = (unsigned*)(WT + (size_t)(n0 + n) * DM + k0 + 8 * c); dst[0] = o[0]; dst[1] = o[1]; dst[2] = o[2]; dst[3] = o[3]; }
            WSYNC();
            continue; }
        r -= I_IN;
        if (r < I_OUT) { transpose_item(INF(I_WOUT) + (size_t)l * DMIX * DM, DMIX, DM, DM, WSP(bf16_t, WS_WOUT), DMIX, 0, r, lane, scr); continue; } r -= I_OUT;
        if (r < I_PG) { transpose_item(INF(I_PLEG) + (size_t)l * DM * DM, DM, DM, DM, WSP(bf16_t, WS_WPG), DM, 0, r, lane, scr); continue; } r -= I_PG;
        if (r < I_PW) {
            if (DPLE >= 64) transpose_item(INF(I_PLEW) + (size_t)l * DPLE * DM, DPLE, DM, DM, WSP(bf16_t, WS_WP), DPLE, 0, r, lane, scr);
            continue; } r -= I_PW;
        const int e = r / (2 * I_G1 + I_D1); r -= e * (2 * I_G1 + I_D1);
        if (r < I_G1) { transpose_item(INF(I_WG) + ((size_t)l * NEXP + e) * DM * DEXP, DM, DEXP, DEXP, WSP(bf16_t, WS_WGU) + (size_t)e * 2 * DEXP * DM, DM, 1, r, lane, scr); continue; } r -= I_G1;
        if (r < I_G1) { transpose_item(INF(I_WU) + ((size_t)l * NEXP + e) * DM * DEXP, DM, DEXP, DEXP, WSP(bf16_t, WS_WGU) + (size_t)e * 2 * DEXP * DM, DM, 2, r, lane, scr); continue; } r -= I_G1;
        transpose_item(INF(I_WD) + ((size_t)l * NEXP + e) * DEXP * DM, DEXP, DM, DM, WSP(bf16_t, WS_WD) + (size_t)e * DM * DEXP, DEXP, 0, r, lane, scr);
    }
    {   const float* p = INF(I_P) + (size_t)l * T * DPLE; bf16_t* pb = WSP(bf16_t, WS_PB);
        const size_t n4 = (size_t)T * DPLE / 4;
        for (size_t i = (size_t)gw * LANES + lane; i < n4; i += (size_t)ngw * LANES) {
            const float* s = p + 4 * i; unsigned* d = (unsigned*)(pb + 4 * i); d[0] = pk2(s[0], s[1]); d[1] = pk2(s[2], s[3]); } }
    if (l == 0) { const float* x = INF(I_X); bf16_t* xb = WSP(bf16_t, WS_XB);
        const size_t n4 = (size_t)T * DM / 4;
        for (size_t i = (size_t)gw * LANES + lane; i < n4; i += (size_t)ngw * LANES) {
            const float* s = x + 4 * i; unsigned* d = (unsigned*)(xb + 4 * i); d[0] = pk2(s[0], s[1]); d[1] = pk2(s[2], s[3]); } }
#ifdef CFG_SMALL
    if (DPLE < 64) {
        const float* W = INF(I_PLEW) + (size_t)l * DPLE * DM; bf16_t* WT = WSP(bf16_t, WS_WP);
        for (int i = gw * LANES + lane; i < DPLE * DM; i += ngw * LANES) { const int k = i / DM, n = i % DM; WT[(size_t)n * DPLE + k] = f2bf(W[i]); } }
#endif
}

HD float ubf(const bf16_t* u, int t, int c) { return bf2f(u[(size_t)t * DINP + c]); }
HD void stage_prep(const Ctx& C, int l, int gw, int ngw, int lane, wsh_t sh) {
    const bf16_t* u = WSP(bf16_t, WS_U);
    const float* mu = INF(I_MU) + l * DINA; const float* w0 = INF(I_W0) + l * GW; const float* wup = INF(I_WUP) + l * 32 * GW;
    const float* a0 = INF(I_A0) + l * GW; const float* aup = INF(I_AUP) + l * 32 * GW; const float* gup = INF(I_GUP) + l * 64 * GW;
    const float* kkw = INF(I_KK) + l * GW; const float* kaw = INF(I_KA) + l * GW;
    const float* glaup = INF(I_GLA_UP) + l * 16 * 128; const float* glab = INF(I_GLA_B) + l * 128;
    const float* convw = INF(I_CONVW) + l * 4 * 512; const float* convb = INF(I_CONVB) + l * 512;
    const float* ib = INF(I_IB) + l * 4; const float* fb = INF(I_FB) + l * 4;
    const float* qng = INF(I_QNG) + l * 256; const float* wuq = INF(I_WUQ) + (size_t)l * 256 * 384;
    const float* kvng = INF(I_KVNG) + l * 128; const float* wukv = INF(I_WUKV) + (size_t)l * 128 * 512;
    const int* pos = (const int*)C.in[I_POS];
    float* oR = WSP(float, WS_RW_R); float* oW = WSP(float, WS_RW_W); float* oK = WSP(float, WS_RW_K); float* oV = WSP(float, WS_RW_V);
    float* oA = WSP(float, WS_RW_A); float* oB = WSP(float, WS_RW_B); float* oG = WSP(float, WS_RW_G);
    float* oQK = WSP(float, WS_QK); float* oGA = WSP(float, WS_GA); float* oLG = WSP(float, WS_LG);
    bf16_t* oAQ = WSP(bf16_t, WS_AQ); bf16_t* oAK = WSP(bf16_t, WS_AK); bf16_t* oAV = WSP(bf16_t, WS_AV);
    for (int t = gw; t < T; t += ngw) {
        const int s = t % SEQ;
        for (int j = lane; j < 128; j += LANES) { const int c = UA_WD + j; const float cur = ubf(u, t, c), prev = s > 0 ? ubf(u, t - 1, c) : 0.f;
            const float v = cur + (prev - cur) * mu[c]; sh[j] = j < 32 ? tanhf(v) : (j < 64 ? v : sigmoidf_(v)); }
        WSYNC();
        for (int h = 0; h < NH; ++h) {
            float kkraw[HD64 / LANES]; float kv_[HD64 / LANES], av_[HD64 / LANES]; float ss = 0.f;
            for (int i = 0; i < HD64 / LANES; ++i) { const int c = h * 64 + i * LANES + lane;
                float z = w0[c], za = a0[c], g = 0.f;
_Pragma("unroll 8")
                for (int j = 0; j < 32; ++j) { z += sh[j] * wup[j * GW + c]; za += sh[32 + j] * aup[j * GW + c]; }
_Pragma("unroll 8")
                for (int j = 0; j < 64; ++j) g += sh[64 + j] * gup[j * GW + c];
                const float lnl = -softplusf_(-z) - 0.5f; const float decay = expf(-expf(lnl)); const float a = sigmoidf_(za);
                float r, k, v;
                { const float cur = ubf(u, t, UA_R + c), prev = s > 0 ? ubf(u, t - 1, UA_R + c) : 0.f; r = cur + (prev - cur) * mu[UA_R + c]; }
                { const float cur = ubf(u, t, UA_K + c), prev = s > 0 ? ubf(u, t - 1, UA_K + c) : 0.f; k = cur + (prev - cur) * mu[UA_K + c]; }
                { const float cur = ubf(u, t, UA_V + c), prev = s > 0 ? ubf(u, t - 1, UA_V + c) : 0.f; v = cur + (prev - cur) * mu[UA_V + c]; }
                kkraw[i] = k * kkw[c]; ss += kkraw[i] * kkraw[i];
                kv_[i] = k * (1.f + (a - 1.f) * kaw[c]); av_[i] = a;
                const size_t o = (size_t)t * GW + c; oR[o] = r; oW[o] = decay; oK[o] = kv_[i]; oV[o] = v; oG[o] = g; }
            ss = wave_sum(ss); const float inv = 1.f / fmaxf(sqrtf(ss), 1e-12f);
            for (int i = 0; i < HD64 / LANES; ++i) { const int c = h * 64 + i * LANES + lane; const size_t o = (size_t)t * GW + c; const float kk = kkraw[i] * inv;
                oA[o] = -kk; oB[o] = kk * av_[i]; }
        }
        WSYNC();
        for (int c = lane; c < 128; c += LANES) { float z = glab[c];
            for (int j = 0; j < 16; ++j) z += ubf(u, t, UB_AD + j) * glaup[j * 128 + c];
            oGA[(size_t)t * 128 + c] = -softplusf_(-z) * (1.f / 16.f); }
        for (int c = lane; c < 512; c += LANES) { float y = convb[c];
            for (int j = 0; j < 4; ++j) { const int sp = s - 3 + j; if (sp >= 0) y += convw[j * 512 + c] * ubf(u, t - 3 + j, UC_Q + c); }
            float q = siluf_(y); if (c >= 256) q *= 0.125f; oQK[(size_t)t * 512 + c] = q; }
        for (int c = lane; c < 8; c += LANES) { const float v = ubf(u, t, UC_IG + c);
            oLG[(size_t)t * 8 + c] = c < 4 ? v + ib[c] : -softplusf_(-(v + fb[c - 4])); }
        {   float ssq = 0.f, sskv = 0.f;
            for (int j = lane; j < 256; j += LANES) { const float v = ubf(u, t, UD_CQ + j); ssq += v * v; }
            for (int j = lane; j < 128; j += LANES) { const float v = ubf(u, t, UD_CKV + j); sskv += v * v; }
            ssq = wave_sum(ssq); sskv = wave_sum(sskv);
            const float rq = 1.f / sqrtf(ssq * (1.f / 256.f) + NORM_EPS), rkv = 1.f / sqrtf(sskv * (1.f / 128.f) + NORM_EPS);
            for (int j = lane; j < 256; j += LANES) sh[j] = ubf(u, t, UD_CQ + j) * rq * qng[j];
            for (int j = lane; j < 128; j += LANES) sh[256 + j] = ubf(u, t, UD_CKV + j) * rkv * kvng[j];
            WSYNC();
            for (int n = lane; n < 384; n += LANES) { float acc = 0.f;
_Pragma("unroll 8")
                for (int k = 0; k < 256; ++k) acc += sh[k] * wuq[(size_t)k * 384 + n]; sh[384 + n] = acc; }
            for (int n = lane; n < 512; n += LANES) { float acc = 0.f;
_Pragma("unroll 8")
                for (int k = 0; k < 128; ++k) acc += sh[256 + k] * wukv[(size_t)k * 512 + n]; sh[768 + n] = acc; }
            for (int i = lane; i < 16; i += LANES) { const float invf = powf(10000.f, -(float)i / 16.f); const float ang = (float)pos[t] * invf; sh[1280 + i] = cosf(ang); sh[1296 + i] = sinf(ang); }
            for (int i = lane; i < 32; i += LANES) sh[1312 + i] = ubf(u, t, UD_KR + i);
            WSYNC();
            const float qscale = 0.10206207261596575f;
            for (int idx = lane; idx < 384; idx += LANES) { const int h = idx / 96, d = idx % 96; float v;
                if (d < 64) v = sh[384 + idx];
                else { const int i = (d - 64) & 15; const float x1 = sh[384 + h * 96 + 64 + i], x2 = sh[384 + h * 96 + 80 + i]; const float c_ = sh[1280 + i], s_ = sh[1296 + i];
                    v = (d - 64) < 16 ? x1 * c_ - x2 * s_ : x1 * s_ + x2 * c_; }
                oAQ[(size_t)t * 384 + idx] = f2bf(v * qscale); }
            for (int idx = lane; idx < 384; idx += LANES) { const int h = idx / 96, d = idx % 96; float v;
                if (d < 64) v = sh[768 + h * 128 + d];
                else { const int i = (d - 64) & 15; const float x1 = sh[1312 + i], x2 = sh[1328 + i]; const float c_ = sh[1280 + i], s_ = sh[1296 + i];
                    v = (d - 64) < 16 ? x1 * c_ - x2 * s_ : x1 * s_ + x2 * c_; }
                oAK[(size_t)t * 384 + idx] = f2bf(v); }
            for (int idx = lane; idx < 256; idx += LANES) { const int h = idx / 64, d = idx % 64; oAV[(size_t)t * 256 + idx] = f2bf(sh[768 + h * 128 + 64 + d]); }
            WSYNC();
        }
    }
}

HD void rwkv_scan_thread(const Ctx& C, int b, int h, int v) {
    const float* pR = WSP(float, WS_RW_R); const float* pW = WSP(float, WS_RW_W); const float* pK = WSP(float, WS_RW_K); const float* pV = WSP(float, WS_RW_V);
    const float* pA = WSP(float, WS_RW_A); const float* pB = WSP(float, WS_RW_B); float* Y = WSP(float, WS_YA);
    float S[64];
#pragma unroll
    for (int k = 0; k < 64; ++k) S[k] = 0.f;
    for (int s = 0; s < SEQ; ++s) {
        const size_t o = ((size_t)b * SEQ + s) * GW + h * 64;
        const float vv = pV[o + v];
        float sa0 = 0.f, sa1 = 0.f, sa2 = 0.f, sa3 = 0.f;
#pragma unroll
        for (int k = 0; k < 64; k += 4) { const f4v a = *(const f4v*)(pA + o + k); sa0 += S[k] * a[0]; sa1 += S[k + 1] * a[1]; sa2 += S[k + 2] * a[2]; sa3 += S[k + 3] * a[3]; }
        const float sa = (sa0 + sa1) + (sa2 + sa3);
        float y0 = 0.f, y1 = 0.f, y2 = 0.f, y3 = 0.f;
#pragma unroll
        for (int k = 0; k < 64; k += 4) {
            const f4v w = *(const f4v*)(pW + o + k), bb = *(const f4v*)(pB + o + k), kk = *(const f4v*)(pK + o + k), r = *(const f4v*)(pR + o + k);
            S[k] = S[k] * w[0] + sa * bb[0] + vv * kk[0]; y0 += S[k] * r[0];
            S[k + 1] = S[k + 1] * w[1] + sa * bb[1] + vv * kk[1]; y1 += S[k + 1] * r[1];
            S[k + 2] = S[k + 2] * w[2] + sa * bb[2] + vv * kk[2]; y2 += S[k + 2] * r[2];
            S[k + 3] = S[k + 3] * w[3] + sa * bb[3] + vv * kk[3]; y3 += S[k + 3] * r[3];
            if ((k & 12) == 12) asm volatile("" ::: "memory"); }
        Y[o + v] = (y0 + y1) + (y2 + y3);
    }
}
HD void gla_scan_thread(const Ctx& C, int b, int h, int v) {
    const bf16_t* u = WSP(bf16_t, WS_U); const float* GA = WSP(float, WS_GA); float* Y = WSP(float, WS_YB);
    float S[32];
#pragma unroll
    for (int k = 0; k < 32; ++k) S[k] = 0.f;
    for (int s = 0; s < SEQ; ++s) {
        const int t = b * SEQ + s;
        const float vv = ubf(u, t, UB_V + h * 64 + v);
        float acc = 0.f;
#pragma unroll
        for (int k8 = 0; k8 < 32; k8 += 8) { float kf[8], qf[8];
            ld8bf(u + (size_t)t * DINP + UB_K + h * 32 + k8, kf); ld8bf(u + (size_t)t * DINP + UB_Q + h * 32 + k8, qf);
            const f4v g0 = *(const f4v*)(GA + (size_t)t * 128 + h * 32 + k8), g1 = *(const f4v*)(GA + (size_t)t * 128 + h * 32 + k8 + 4);
#pragma unroll
            for (int j = 0; j < 8; ++j) { const float a = expf(j < 4 ? g0[j & 3] : g1[j & 3]); S[k8 + j] = a * S[k8 + j] + kf[j] * vv; acc += qf[j] * S[k8 + j]; } }
        Y[(size_t)t * GW + h * 64 + v] = acc * 0.17677669529663687f;
    }
}
HD void mlstm_scan_thread(const Ctx& C, int b, int h, int e) {
    const bf16_t* u = WSP(bf16_t, WS_U); const float* QK = WSP(float, WS_QK); const float* LG = WSP(float, WS_LG);
    float* Y = WSP(float, WS_YC); float* DEN = WSP(float, WS_DEN);
    float S[64];
#pragma unroll
    for (int k = 0; k < 64; ++k) S[k] = 0.f;
    for (int s = 0; s < SEQ; ++s) {
        const int t = b * SEQ + s;
        const float ig = expf(LG[(size_t)t * 8 + h]), fg = expf(LG[(size_t)t * 8 + 4 + h]);
        const float vv = (e < 64 ? ubf(u, t, UC_V + h * 64 + e) : 1.f) * ig;
        float acc = 0.f;
#pragma unroll
        for (int k = 0; k < 64; k += 4) { const f4v kk = *(const f4v*)(QK + (size_t)t * 512 + 256 + h * 64 + k), qq = *(const f4v*)(QK + (size_t)t * 512 + h * 64 + k);
#pragma unroll
            for (int j = 0; j < 4; ++j) { S[k + j] = fg * S[k + j] + kk[j] * vv; acc += qq[j] * S[k + j]; } }
        if (e < 64) Y[(size_t)t * GW + h * 64 + e] = acc; else DEN[(size_t)t * 4 + h] = acc;
    }
}
HD void attn_thread(const Ctx& C, int b, int h, int q, int kmax  ) {
    const bf16_t* Q = WSP(bf16_t, WS_AQ); const bf16_t* K = WSP(bf16_t, WS_AK); const bf16_t* V = WSP(bf16_t, WS_AV); bf16_t* mix = WSP(bf16_t, WS_MIX);
    const int t = b * SEQ + q;
    unsigned qp[48]; float o[64];
#pragma unroll
    for (int d = 0; d < 48; d += 4) { const u4v w = *(const u4v*)(Q + (size_t)t * 384 + h * 96 + 2 * d); qp[d] = w[0]; qp[d + 1] = w[1]; qp[d + 2] = w[2]; qp[d + 3] = w[3]; }
#pragma unroll
    for (int d = 0; d < 64; ++d) o[d] = 0.f;
    float m = -1e30f, lsum = 0.f;
    for (int j = 0; j <= kmax; ++j) {
        const size_t tk = (size_t)b * SEQ + j;
        float sc0 = 0.f, sc1 = 0.f;
#pragma unroll
        for (int d = 0; d < 96; d += 8) { float kf[8]; ld8bf(K + tk * 384 + h * 96 + d, kf);
#pragma unroll
            for (int i = 0; i < 8; i += 2) { const unsigned qw = qp[(d + i) >> 1];
                sc0 += __builtin_bit_cast(float, qw << 16) * kf[i]; sc1 += __builtin_bit_cast(float, qw & 0xffff0000u) * kf[i + 1]; }
            if ((d & 24) == 24) asm volatile("" ::: "memory"); }
        const float sc = sc0 + sc1;
        if (j <= q) {
            const float mn = fmaxf(m, sc); const float corr = expf(m - mn), p = expf(sc - mn);
            lsum = lsum * corr + p;
#pragma unroll
            for (int d = 0; d < 64; d += 8) { float vf[8]; ld8bf(V + tk * 256 + h * 64 + d, vf);
#pragma unroll
                for (int i = 0; i < 8; ++i) o[d + i] = o[d + i] * corr + p * vf[i];
                if (d & 8) asm volatile("" ::: "memory"); }
            m = mn; }
    }
    const float inv = 1.f / lsum;
#pragma unroll
    for (int d = 0; d < 64; d += 8) { float a[8];
#pragma unroll
        for (int i = 0; i < 8; ++i) a[i] = o[d + i] * inv;
        st8bf(mix + (size_t)t * DMIX + 768 + h * 64 + d, a); }
}

HD void stage_post(const Ctx& C, int l, int gw, int ngw, int lane) {
    const bf16_t* u = WSP(bf16_t, WS_U); bf16_t* mix = WSP(bf16_t, WS_MIX);
    const float* YA = WSP(float, WS_YA); const float* YB = WSP(float, WS_YB); const float* YC = WSP(float, WS_YC); const float* DEN = WSP(float, WS_DEN);
    const float* pR = WSP(float, WS_RW_R); const float* pK = WSP(float, WS_RW_K); const float* pV = WSP(float, WS_RW_V); const float* pG = WSP(float, WS_RW_G);
    const float* rk = INF(I_RK) + l * GW; const float* gng = INF(I_GNG) + l * GW; const float* gnb = INF(I_GNB) + l * GW;
    const float* glag = INF(I_GLA_G) + l * GW; const float* mlng = INF(I_MLN_G) + l * GW;
    constexpr int PL = HD64 / LANES;
    for (int t = gw; t < T; t += ngw) {
        for (int h = 0; h < NH; ++h) {
            {   float y[PL], s1 = 0.f, bon = 0.f;
                for (int i = 0; i < PL; ++i) { const int c = h * 64 + i * LANES + lane; const size_t o = (size_t)t * GW + c; y[i] = YA[o]; s1 += y[i]; bon += pR[o] * pK[o] * rk[c]; }
                s1 = wave_sum(s1); bon = wave_sum(bon); const float mean = s1 * (1.f / 64.f); float s2 = 0.f;
                for (int i = 0; i < PL; ++i) { y[i] -= mean; s2 += y[i] * y[i]; }
                s2 = wave_sum(s2); const float rstd = 1.f / sqrtf(s2 * (1.f / 64.f) + RWKV_GN_EPS);
                for (int i = 0; i < PL; ++i) { const int c = h * 64 + i * LANES + lane; const size_t o = (size_t)t * GW + c;
                    const float v = (y[i] * rstd * gng[c] + gnb[c] + bon * pV[o]) * pG[o]; mix[(size_t)t * DMIX + c] = f2bf(v); } }
            {   float y[PL], s2 = 0.f;
                for (int i = 0; i < PL; ++i) { const int c = h * 64 + i * LANES + lane; y[i] = YB[(size_t)t * GW + c]; s2 += y[i] * y[i]; }
                s2 = wave_sum(s2); const float rstd = 1.f / sqrtf(s2 * (1.f / 64.f) + NORM_EPS);
                for (int i = 0; i < PL; ++i) { const int c = h * 64 + i * LANES + lane;
                    const float v = y[i] * rstd * glag[c] * siluf_(ubf(u, t, UB_G + c)); mix[(size_t)t * DMIX + 256 + c] = f2bf(v); } }
            {   const float den = DEN[(size_t)t * 4 + h]; const float dinv = 1.f / fmaxf(fabsf(den), 1.f);
                float y[PL], s1 = 0.f;
                for (int i = 0; i < PL; ++i) { const int c = h * 64 + i * LANES + lane; y[i] = YC[(size_t)t * GW + c] * dinv; s1 += y[i]; }
                s1 = wave_sum(s1); const float mean = s1 * (1.f / 64.f); float s2 = 0.f;
                for (int i = 0; i < PL; ++i) { y[i] -= mean; s2 += y[i] * y[i]; }
                s2 = wave_sum(s2); const float rstd = 1.f / sqrtf(s2 * (1.f / 64.f) + LN_EPS);
                for (int i = 0; i < PL; ++i) { const int c = h * 64 + i * LANES + lane;
                    const float v = y[i] * rstd * mlng[c] * sigmoidf_(ubf(u, t, UC_O + c)); mix[(size_t)t * DMIX + 512 + c] = f2bf(v); } }
        }
    }
}

HD void ln_row(const float* src, const float* g, const float* b, float* dstf, bf16_t* dstb, int lane, float* keep  ) {
    constexpr int PL = DM / LANES;
    float s1 = 0.f;
#pragma unroll
    for (int i = 0; i < PL; ++i) { keep[i] = src[i * LANES + lane]; s1 += keep[i]; }
    s1 = wave_sum(s1); const float mean = s1 * (1.f / DM); float s2 = 0.f;
#pragma unroll
    for (int i = 0; i < PL; ++i) { keep[i] -= mean; s2 += keep[i] * keep[i]; }
    s2 = wave_sum(s2); const float rstd = 1.f / sqrtf(s2 * (1.f / DM) + LN_EPS);
#pragma unroll
    for (int i = 0; i < PL; ++i) { const int c = i * LANES + lane; keep[i] = keep[i] * rstd * g[c] + b[c]; dstf[c] = keep[i]; dstb[c] = f2bf(keep[i]); }
}
HD void stage_ln1_router(const Ctx& C, int l, int gw, int ngw, int lane, wsh_t sh) {
    float* X1 = C.out; bf16_t* xb = WSP(bf16_t, WS_XB);
    const float* g = INF(I_LN1G) + l * DM; const float* b = INF(I_LN1B) + l * DM;
    const float* wrg = INF(I_WRG) + (size_t)l * DM * NGRP; const float* brg = INF(I_BRG) + l * NGRP;
    const float* wre = INF(I_WRE) + (size_t)l * DM * NEXP; const float* bre = INF(I_BRE) + l * NEXP;
    unsigned* cnt = WSP(unsigned, WS_CTL) + CW_CNT + l * NEXP * 64;
    int* tokinfo = WSP(int, WS_TOKINFO); int* list = WSP(int, WS_LIST);
    constexpr int PL = DM / LANES;
    for (int t = gw; t < T; t += ngw) {
        {   float keep[PL];
            ln_row(X1 + (size_t)t * DM, g, b, X1 + (size_t)t * DM, xb + (size_t)t * DM, lane, keep);
#pragma unroll
            for (int i = 0; i < PL; ++i) sh[i * LANES + lane] = keep[i]; }
        WSYNC();
        float lg[NGRP], le[NEXP];
#pragma unroll
        for (int j = 0; j < NGRP; ++j) lg[j] = 0.f;
#pragma unroll
        for (int j = 0; j < NEXP; ++j) le[j] = 0.f;
#pragma unroll 1
        for (int i = 0; i < PL; ++i) { const int c = i * LANES + lane; const float xv = sh[c];
            const f4v wg = *(const f4v*)(wrg + (size_t)c * NGRP);
#pragma unroll
            for (int j = 0; j < NGRP; ++j) lg[j] += xv * wg[j];
#pragma unroll
            for (int j = 0; j < NEXP; j += 4) { const f4v we = *(const f4v*)(wre + (size_t)c * NEXP + j);
                le[j] += xv * we[0]; le[j + 1] += xv * we[1]; le[j + 2] += xv * we[2]; le[j + 3] += xv * we[3]; } }
        WSYNC();
#pragma unroll
        for (int j = 0; j < NGRP; ++j) lg[j] = wave_sum(lg[j]) + brg[j];
#pragma unroll
        for (int j = 0; j < NEXP; ++j) le[j] = wave_sum(le[j]) + bre[j];
        int gi = 0; float gm = lg[0];
#pragma unroll
        for (int j = 1; j < NGRP; ++j) if (lg[j] > gm) { gm = lg[j]; gi = j; }
        float gs = 0.f;
#pragma unroll
        for (int j = 0; j < NGRP; ++j) gs += expf(lg[j] - gm);
        const float group_p = 1.f / gs;
        float el[EPG];
#pragma unroll
        for (int j = 0; j < EPG; ++j) { float v = le[j];
#pragma unroll
            for (int g2 = 1; g2 < NGRP; ++g2) v = (gi == g2) ? le[g2 * EPG + j] : v;
            el[j] = v; }
        int e0 = 0; float m0 = el[0];
#pragma unroll
        for (int j = 1; j < EPG; ++j) if (el[j] > m0) { m0 = el[j]; e0 = j; }
        int e1 = -1; float m1 = -3.0e38f;
#pragma unroll
        for (int j = 0; j < EPG; ++j) if (j != e0 && el[j] > m1) { m1 = el[j]; e1 = j; }
        const float p1 = expf(m1 - m0); const float g0 = group_p / (1.f + p1), g1 = group_p * p1 / (1.f + p1);
        if (lane == 0) {
            const int E0 = gi * EPG + e0, E1 = gi * EPG + e1;
            tokinfo[(size_t)t * 4 + 0] = E0; tokinfo[(size_t)t * 4 + 1] = E1;
            ((float*)tokinfo)[(size_t)t * 4 + 2] = g0; ((float*)tokinfo)[(size_t)t * 4 + 3] = g1;
            const unsigned s0 = atom_add(cnt + E0 * 64, 1u); list[(size_t)E0 * T + s0] = t * 2 + 0;
            const unsigned s1 = atom_add(cnt + E1 * 64, 1u); list[(size_t)E1 * T + s1] = t * 2 + 1;
        }
    }
}
HD void moe_bases(const Ctx& C, int l, int* base  ) {
    const unsigned* cnt = WSP(unsigned, WS_CTL) + CW_CNT + l * NEXP * 64;
    int acc = 0;
    for (int e = 0; e < NEXP; ++e) { base[e] = acc; acc += ((int)cnt[e * 64] + 255) & ~255; }
    base[NEXP] = acc;
}
HD int moe_expert_of_row(const int* base, int row) { int e = 0; for (int j = 1; j < NEXP; ++j) if (row >= base[j]) e = j; return e; }
HD int moe_lookup(const unsigned* cnt, int row, int& e, int& be, int& ce) {
    int acc = 0; e = 0; be = 0; ce = 0;
    for (int j = 0; j < NEXP; ++j) { const int c = (int)cnt[j * 64]; if (row >= acc) { e = j; be = acc; ce = c; } acc += (c + 255) & ~255; }
    return acc;
}
HD void stage_gather(const Ctx& C, int l, int gw, int ngw, int lane) {
    const unsigned* cnt = WSP(unsigned, WS_CTL) + CW_CNT + l * NEXP * 64;
    const int* list = WSP(int, WS_LIST); const int* tokinfo = WSP(int, WS_TOKINFO);
    const bf16_t* xb = WSP(bf16_t, WS_XB); bf16_t* xg = WSP(bf16_t, WS_XG); int* rowinfo = WSP(int, WS_ROWINFO); float* rowgate = WSP(float, WS_ROWGATE);
    int e, be, ce; const int total = moe_lookup(cnt, 0, e, be, ce);
    for (int row = gw; row < total; row += ngw) {
        moe_lookup(cnt, row, e, be, ce);
        const int slot = row - be;
        if (slot < ce) { const int ent = list[(size_t)e * T + slot]; const int tok = ent >> 1;
            for (int c = lane * 8; c < DM; c += LANES * 8) *(u4v*)(xg + (size_t)row * DM + c) = *(const u4v*)(xb + (size_t)tok * DM + c);
            if (lane == 0) { rowinfo[row] = ent; rowgate[row] = ((const float*)tokinfo)[(size_t)tok * 4 + 2 + (ent & 1)]; } }
        else { const u4v z = {0u, 0u, 0u, 0u}; for (int c = lane * 8; c < DM; c += LANES * 8) *(u4v*)(xg + (size_t)row * DM + c) = z;
            if (lane == 0) { rowinfo[row] = -1; rowgate[row] = 0.f; } }
    }
}
HD void stage_ln2(const Ctx& C, int l, int gw, int ngw, int lane) {
    const float* src = WSP(float, WS_X); float* dst = (l == DEPTH - 1) ? C.out : WSP(float, WS_X); bf16_t* xb = WSP(bf16_t, WS_XB);
    const float* g = INF(I_LN2G) + l * DM; const float* b = INF(I_LN2B) + l * DM;
    constexpr int PL = DM / LANES;
    for (int t = gw; t < T; t += ngw) { float keep[PL]; ln_row(src + (size_t)t * DM, g, b, dst + (size_t)t * DM, xb + (size_t)t * DM, lane, keep); }
}

struct EpiU {
    static constexpr bool PERM = true; static constexpr int MODE = 0;
    bf16_t* o;
    HDM void put8(int row, int col, const float* a) const { st8bf(o + (size_t)row * DINP + col, a); }
};
struct EpiPP {
    static constexpr bool PERM = true; static constexpr int MODE = 0;
    bf16_t* o;
    HDM void put8(int row, int col, const float* a) const { st8bf(o + (size_t)row * DM + col, a); }
};
struct EpiPre1 {
    static constexpr bool PERM = false; static constexpr int MODE = 0;
    const float* x; float* o;
    HDM void put4(int row, int col, const float* a) const { const float al = dn_alpha(); const f4v xr = *(const f4v*)(x + (size_t)row * DM + col);
        f4v r; for (int j = 0; j < 4; ++j) r[j] = al * xr[j] + a[j]; *(f4v*)(o + (size_t)row * DM + col) = r; }
};
struct EpiH {
    static constexpr bool PERM = true; static constexpr int MODE = 1;
    bf16_t* o;
    HDM void put8gu(int row, int hcol, const float* g, const float* u) const { float v[8]; for (int j = 0; j < 8; ++j) v[j] = siluf_(g[j]) * u[j];
        st8bf(o + (size_t)row * DEXP + hcol, v); }
};
struct EpiY {
    static constexpr bool PERM = true; static constexpr int MODE = 0;
    const int* rowinfo; const float* rowgate; bf16_t* o;
    HDM void put8(int row, int col, const float* a) const { const int ent = rowinfo[row]; if (ent < 0) return; const float g = rowgate[row];
        float v[8]; for (int j = 0; j < 8; ++j) v[j] = g * a[j]; st8bf(o + (size_t)ent * DM + col, v); }
};
struct EpiPre2 {
    static constexpr bool PERM = false; static constexpr int MODE = 0;
    const float* x1; const bf16_t* ybuf; const bf16_t* pp; const float* bg; float* o;
    HDM void put4(int row, int col, const float* a) const { const float al = dn_alpha(); const size_t i = (size_t)row * DM + col;
        const f4v xr = *(const f4v*)(x1 + i); const f4v bgv = *(const f4v*)(bg + col);
        const unsigned* y0 = (const unsigned*)(ybuf + (size_t)(2 * row) * DM + col); const unsigned* y1 = (const unsigned*)(ybuf + (size_t)(2 * row + 1) * DM + col); const unsigned* pq = (const unsigned*)(pp + i);
        const unsigned y00 = y0[0], y01 = y0[1], y10 = y1[0], y11 = y1[1], p0 = pq[0], p1 = pq[1];
        float yv[4] = { __builtin_bit_cast(float, y00 << 16) + __builtin_bit_cast(float, y10 << 16), __builtin_bit_cast(float, y00 & 0xffff0000u) + __builtin_bit_cast(float, y10 & 0xffff0000u),
                        __builtin_bit_cast(float, y01 << 16) + __builtin_bit_cast(float, y11 << 16), __builtin_bit_cast(float, y01 & 0xffff0000u) + __builtin_bit_cast(float, y11 & 0xffff0000u) };
        float pv[4] = { __builtin_bit_cast(float, p0 << 16), __builtin_bit_cast(float, p0 & 0xffff0000u), __builtin_bit_cast(float, p1 << 16), __builtin_bit_cast(float, p1 & 0xffff0000u) };
        f4v r; for (int j = 0; j < 4; ++j) r[j] = al * xr[j] + yv[j] + sigmoidf_(a[j] + bgv[j]) * pv[j];
        *(f4v*)(o + i) = r; }
};

#ifndef CPU_TEST
namespace pg8 {
#define PG8_LAS __attribute__((address_space(3)))
typedef short bf16x8 __attribute__((ext_vector_type(8)));
typedef float f32x4 __attribute__((ext_vector_type(4)));
constexpr int BM = 256, BK = 64, HALF = 128, HTB = HALF * BK * 2, STAGE_BYTES = 8 * HTB;
__device__ __forceinline__ int lds_byte(int r, int c) { const int st = (r >> 4) * 2 + (c >> 5), rr = r & 15, cc = c & 31, ob = rr * 64 + cc * 2; return st * 1024 + (ob ^ (((ob >> 9) & 1) << 5)); }
__device__ __forceinline__ void stage_rc(int b, int& R, int& C) { const int st = b / 1024, sb = b % 1024, swz = sb ^ (((sb >> 9) & 1) << 5); R = (st >> 1) * 16 + swz / 64; C = (st & 1) * 32 + (swz % 64) / 2; }
__device__ __forceinline__ int perm32(int rho) { const int n = rho >> 4, i = rho & 15; return 8 * (i >> 2) + 4 * n + (i & 3); }
struct Unit { int pm, pn; long aoff, boff; };
struct Gemm { const bf16_t* A; const bf16_t* Bt; int lda, ldb, K; };

template <class F> __device__ __forceinline__ void run_epi(const F& f, const f32x4 (&acc)[2][2][4][2], const Unit& u, int wr, int wc, int fr, int fq) {
#pragma unroll
    for (int ai = 0; ai < 2; ++ai)
#pragma unroll
        for (int m = 0; m < 4; ++m) { const int row = u.pm * BM + ai * HALF + wr * 64 + m * 16 + fr;
            if constexpr (F::MODE == 1) { const int hcol = u.pn * 128 + wc * 32 + 8 * fq; float g[8], up[8];
#pragma unroll
                for (int j = 0; j < 4; ++j) { g[j] = acc[ai][0][m][0][j]; g[4 + j] = acc[ai][0][m][1][j]; up[j] = acc[ai][1][m][0][j]; up[4 + j] = acc[ai][1][m][1][j]; }
                f.put8gu(row, hcol, g, up); }
            else if constexpr (F::PERM) {
#pragma unroll
                for (int bj = 0; bj < 2; ++bj) { const int col = u.pn * BM + bj * HALF + wc * 32 + 8 * fq; float a[8];
#pragma unroll
                    for (int j = 0; j < 4; ++j) { a[j] = acc[ai][bj][m][0][j]; a[4 + j] = acc[ai][bj][m][1][j]; }
                    f.put8(row, col, a); } }
            else {
#pragma unroll
                for (int bj = 0; bj < 2; ++bj)
#pragma unroll
                    for (int n = 0; n < 2; ++n) { const int col = u.pn * BM + bj * HALF + wc * 32 + 16 * n + 4 * fq; float a[4];
#pragma unroll
                        for (int j = 0; j < 4; ++j) a[j] = acc[ai][bj][m][n][j];
                        f.put4(row, col, a); } }
        }
}

template <class Epi, class Sched>
__device__ __forceinline__ void gemm_phase(PG8_LAS unsigned char* lds, const Gemm g, const Sched& S, const Epi& E) {
    int tid = threadIdx.x; asm volatile("" : "+v"(tid));
    const int wid = __builtin_amdgcn_readfirstlane(tid >> 6), lane = tid & 63, wr = wid >> 2, wc = wid & 3, fr = lane & 15, fq = lane >> 4;
    const int K = g.K, nt = K / BK;
    unsigned voffA[2], voffB[2];
#pragma unroll
    for (int i = 0; i < 2; ++i) { int R, C; stage_rc(tid * 16 + i * 8192, R, C); const int Rb = Epi::PERM ? ((R & ~31) + perm32(R & 31)) : R;
        voffA[i] = (unsigned)(R * g.lda + C) * 2u; voffB[i] = (unsigned)(Rb * g.ldb + C) * 2u; }
    const size_t kstep = (size_t)(BK * 2);
    const size_t hstepA = (size_t)HALF * g.lda * 2, hstepB = (size_t)HALF * g.ldb * 2;
    const unsigned ldsw = (unsigned)wid * 1024u;
    const int aoff = lds_byte(wr * 64 + fr, fq * 8), boff = lds_byte(wc * 32 + fr, fq * 8);
#define PG8_SA(b, h) (((b) * 2 + (h)) * HTB)
#define PG8_SB(b, h) ((4 + (b) * 2 + (h)) * HTB)
#define PG8_STAGE(bufoff, gbase, voff) do { _Pragma("unroll") for (int _i = 0; _i < 2; ++_i) \
        __builtin_amdgcn_global_load_lds((const unsigned*)((const char*)(gbase) + (voff)[_i]), (PG8_LAS unsigned*)(lds + (bufoff) + ldsw + _i * 8192), 16, 0, 0); } while (0)
#define PG8_LDA(dst, b, h) do { _Pragma("unroll") for (int m = 0; m < 4; ++m) _Pragma("unroll") for (int k = 0; k < 2; ++k) dst[m][k] = *(const PG8_LAS bf16x8*)(lds + PG8_SA(b, h) + aoff + m * 2048 + k * 1024); } while (0)
#define PG8_LDB(dst, b, h) do { _Pragma("unroll") for (int n = 0; n < 2; ++n) _Pragma("unroll") for (int k = 0; k < 2; ++k) dst[n][k] = *(const PG8_LAS bf16x8*)(lds + PG8_SB(b, h) + boff + n * 2048 + k * 1024); } while (0)
#define PG8_MMA(ai, bj, At, Bt) do { __builtin_amdgcn_s_setprio(1); _Pragma("unroll") for (int m = 0; m < 4; ++m) _Pragma("unroll") for (int n = 0; n < 2; ++n) _Pragma("unroll") for (int k = 0; k < 2; ++k) \
        acc[ai][bj][m][n] = __builtin_amdgcn_mfma_f32_16x16x32_bf16(Bt[n][k], At[m][k], acc[ai][bj][m][n], 0, 0, 0); __builtin_amdgcn_s_setprio(0); } while (0)
#define PG8_WAIT_V(n) asm volatile("s_waitcnt vmcnt(" #n ")" ::: "memory")
#define PG8_WAIT_L(n) asm volatile("s_waitcnt lgkmcnt(" #n ")" ::: "memory")
#define PG8_BAR __builtin_amdgcn_s_barrier()
#define PG8_SCHED __builtin_amdgcn_sched_barrier(0)
    Unit cur, nxt; int ui = 0;
    if (!S.next(0, cur)) return;
    f32x4 acc[2][2][4][2];
#pragma unroll
    for (int a = 0; a < 2; ++a)
#pragma unroll
        for (int b = 0; b < 2; ++b)
#pragma unroll
            for (int m = 0; m < 4; ++m)
#pragma unroll
                for (int n = 0; n < 2; ++n) acc[a][b][m][n] = (f32x4){0.f, 0.f, 0.f, 0.f};
    bf16x8 At[4][2], B0[2][2], B1[2][2];
    const char* cA = (const char*)g.A + cur.aoff; const char* cB = (const char*)g.Bt + cur.boff;
    PG8_STAGE(PG8_SB(0, 0), cB, voffB); PG8_STAGE(PG8_SA(0, 0), cA, voffA); PG8_STAGE(PG8_SB(0, 1), cB + hstepB, voffB); PG8_STAGE(PG8_SA(0, 1), cA + hstepA, voffA);
    if (wr == 1) PG8_BAR;
    PG8_WAIT_V(4); PG8_BAR;
    PG8_STAGE(PG8_SB(1, 0), cB + kstep, voffB); PG8_STAGE(PG8_SA(1, 0), cA + kstep, voffA); PG8_STAGE(PG8_SB(1, 1), cB + hstepB + kstep, voffB);
    PG8_WAIT_V(6); PG8_BAR;
    for (;;) {
        const bool has_next = S.next(ui + 1, nxt);
        const char* nA = has_next ? (const char*)g.A + nxt.aoff : cA; const char* nB = has_next ? (const char*)g.Bt + nxt.boff : cB;
_Pragma("unroll 1")
        for (int t = 0; t < nt; t += 2) {
            const bool last = (t == nt - 2);
            const char* a1 = cA + (size_t)(t + 1) * kstep;
            const char* a2 = last ? nA : cA + (size_t)(t + 2) * kstep; const char* b2 = last ? nB : cB + (size_t)(t + 2) * kstep;
            const char* a3 = a2 + kstep; const char* b3 = b2 + kstep;
            PG8_LDB(B0, 0, 0); PG8_SCHED; PG8_LDA(At, 0, 0); PG8_STAGE(PG8_SA(1, 1), a1 + hstepA, voffA);
            PG8_WAIT_L(8); PG8_BAR; PG8_WAIT_L(0); PG8_MMA(0, 0, At, B0); PG8_BAR; PG8_SCHED;
            PG8_LDB(B1, 0, 1); PG8_STAGE(PG8_SB(0, 0), b2, voffB);
            PG8_BAR; PG8_WAIT_L(0); PG8_MMA(0, 1, At, B1); PG8_BAR;
            PG8_LDA(At, 0, 1); PG8_STAGE(PG8_SA(0, 0), a2, voffA);
            PG8_BAR; PG8_WAIT_L(0); PG8_MMA(1, 0, At, B0); PG8_BAR; PG8_SCHED;
            PG8_STAGE(PG8_SB(0, 1), b2 + hstepB, voffB);
            PG8_WAIT_V(6); PG8_BAR; PG8_MMA(1, 1, At, B1); PG8_BAR;
            PG8_LDB(B0, 1, 0); PG8_SCHED; PG8_LDA(At, 1, 0); PG8_STAGE(PG8_SA(0, 1), a2 + hstepA, voffA);
            PG8_WAIT_L(8); PG8_BAR; PG8_WAIT_L(0); PG8_MMA(0, 0, At, B0); PG8_BAR; PG8_SCHED;
            PG8_LDB(B1, 1, 1); PG8_STAGE(PG8_SB(1, 0), b3, voffB);
            PG8_BAR; PG8_WAIT_L(0); PG8_MMA(0, 1, At, B1); PG8_BAR;
            PG8_LDA(At, 1, 1); PG8_STAGE(PG8_SA(1, 0), a3, voffA);
            PG8_BAR; PG8_WAIT_L(0); PG8_MMA(1, 0, At, B0); PG8_BAR; PG8_SCHED;
            PG8_STAGE(PG8_SB(1, 1), b3 + hstepB, voffB);
            PG8_WAIT_V(6); PG8_BAR; PG8_MMA(1, 1, At, B1); PG8_BAR;
        }
        run_epi(E, acc, cur, wr, wc, fr, fq);
        if (!has_next) break;
#pragma unroll
        for (int a = 0; a < 2; ++a)
#pragma unroll
            for (int b = 0; b < 2; ++b)
#pragma unroll
                for (int m = 0; m < 4; ++m)
#pragma unroll
                    for (int n = 0; n < 2; ++n) acc[a][b][m][n] = (f32x4){0.f, 0.f, 0.f, 0.f};
        cur = nxt; cA = nA; cB = nB; ++ui;
    }
    PG8_WAIT_V(0);
    if (wr == 0) PG8_BAR;
    PG8_BAR;
#undef PG8_SA
#undef PG8_SB
#undef PG8_STAGE
#undef PG8_LDA
#undef PG8_LDB
#undef PG8_MMA
#undef PG8_WAIT_V
#undef PG8_WAIT_L
#undef PG8_BAR
#undef PG8_SCHED
}
struct DenseOrder {
    int nM, nN, G, c; long astep, bstep;
    __device__ __forceinline__ bool next(int i, Unit& u) const {
        const long L = (long)i * G + c; if (L >= (long)nM * nN) return false;
        const int w = (int)L; const int nig = 8 * nN, gid = w / nig, fm = gid * 8, gsz = (nM - fm) < 8 ? (nM - fm) : 8;
        u.pm = fm + ((w % nig) % gsz); u.pn = (w % nig) / gsz; u.aoff = (long)u.pm * astep; u.boff = (long)u.pn * bstep; return true; }
};
struct MoeOrder {
    const PG8_LAS int* tbl; int nM, nN, G, c; long astep, bstep, estep;
    __device__ __forceinline__ bool next(int i, Unit& u) const {
        const long L = (long)i * G + c; if (L >= (long)nM * nN) return false;
        const int w = (int)L; u.pm = w / nN; u.pn = w % nN; const int e = tbl[u.pm];
        u.aoff = (long)u.pm * astep; u.boff = (long)e * estep + (long)u.pn * bstep; return true; }
};
}
#endif

constexpr int PH_PER_LAYER = 12;
constexpr int NPHASES = DEPTH * PH_PER_LAYER;

#ifndef CPU_TEST
#define XB_TMO      128
#define XB_XCNT(j)  (256  + 64 * (j))
#define XB_XSUB(j)  (1280 + 64 * (j))
#define XB_XGEN(j)  (2304 + 64 * (j))
#define XB_TOP      3328
#define XB_TOPGEN   3392
#define XCD_BAR_WORDS 3456
#define XB_SPIN_CAP (1u << 18)
#define LAS __attribute__((address_space(3)))
__device__ __forceinline__ unsigned xb_ld(unsigned* p)              { return __hip_atomic_load(p, __ATOMIC_RELAXED, __HIP_MEMORY_SCOPE_AGENT); }
__device__ __forceinline__ unsigned xb_add(unsigned* p, unsigned v) { return __hip_atomic_fetch_add(p, v, __ATOMIC_RELAXED, __HIP_MEMORY_SCOPE_AGENT); }
__device__ __forceinline__ unsigned xb_xcc_id() { return (unsigned)__builtin_amdgcn_s_getreg((3 << 11) | 20) & 0xFu; }
#define XB_SPIN(cond, bar) do { unsigned _sp = 0; while (cond) { __builtin_amdgcn_s_sleep(1); \
    if ((++_sp & 255u) == 0u) { if (xb_ld(&(bar)[XB_TMO])) break; if (_sp > XB_SPIN_CAP) { atomicAdd(&(bar)[XB_TMO], 1u); break; } } } } while (0)
struct XcdBarrier { unsigned* bar; unsigned x; volatile LAS unsigned* st; };
__device__ __forceinline__ XcdBarrier xcd_barrier_post(unsigned* bar, volatile LAS unsigned* st) {
    XcdBarrier b; b.bar = bar; b.x = xb_xcc_id(); b.st = st;
    if (threadIdx.x == 0) (void)xb_add(&bar[XB_XCNT(b.x)], 1u);
    return b;
}
__device__ __forceinline__ void xcd_barrier_complete(unsigned* bar, unsigned x, unsigned& nloc, unsigned& nx) {
    const unsigned G = gridDim.x * gridDim.y * gridDim.z;
    unsigned sum, cnt, mine, sp = 0u;
    for (;;) {
        sum = 0u; cnt = 0u; mine = 0u;
#pragma unroll
        for (unsigned j = 0; j < 16; ++j) { const unsigned c = xb_ld(&bar[XB_XCNT(j)]); sum += c; cnt += (c > 0u) ? 1u : 0u; mine = (j == x) ? c : mine; }
        if (sum == G) break;
        __builtin_amdgcn_s_sleep(1);
        if ((++sp & 255u) == 0u) { if (xb_ld(&bar[XB_TMO])) break; if (sp > XB_SPIN_CAP) { atomicAdd(&bar[XB_TMO], 1u); break; } }
    }
    nloc = mine > 0u ? mine : 1u; nx = cnt > 0u ? cnt : 1u;
}
__device__ __forceinline__ void xcd_barrier(const XcdBarrier& b) {
    asm volatile("s_waitcnt vmcnt(0)" ::: "memory");
    __syncthreads();
    if (threadIdx.x == 0) {
        unsigned* bar = b.bar;
        __builtin_amdgcn_s_waitcnt(0);
        unsigned nloc = b.st[0], nx = b.st[1];
        if (nloc == 0u) { xcd_barrier_complete(bar, b.x, nloc, nx); b.st[0] = nloc; b.st[1] = nx; }
        const unsigned old = xb_add(&bar[XB_XSUB(b.x)], 1u);
        const unsigned gen = old / nloc;
        if (old + 1u == (gen + 1u) * nloc) {
            __builtin_amdgcn_fence(__ATOMIC_RELEASE, "agent");
            asm volatile("s_waitcnt vmcnt(0)" ::: "memory");
            const unsigned og = xb_add(&bar[XB_TOP], 1u);
            const unsigned tg = og / nx;
            if (og + 1u == (tg + 1u) * nx) xb_add(&bar[XB_TOPGEN], 1u);
            else XB_SPIN(xb_ld(&bar[XB_TOPGEN]) == tg, bar);
            __builtin_amdgcn_fence(__ATOMIC_ACQUIRE, "agent");
            xb_add(&bar[XB_XGEN(b.x)], 1u);
            asm volatile("s_waitcnt vmcnt(0)" ::: "memory");
        } else {
            XB_SPIN(xb_ld(&bar[XB_XGEN(b.x)]) == gen, bar);
            __builtin_amdgcn_fence(__ATOMIC_ACQUIRE, "agent");
            asm volatile("s_waitcnt vmcnt(0)" ::: "memory");
        }
    }
    __syncthreads();
}

constexpr int NWAVES = 8;
constexpr int RING_BYTES = 131072, MISC_OFF = RING_BYTES + 320, LDS_BYTES = 147456;
struct Args { Ctx C; int ph_lo, ph_hi; };
__device__ __forceinline__ int moe_fill_table(const Ctx& C, int l, LAS int* tbl, int tid) {
    const unsigned* cnt = WSP(unsigned, WS_CTL) + CW_CNT + l * NEXP * 64;
    int e, be, ce; const int total = moe_lookup(cnt, tid * 256, e, be, ce);
    if (tid < 320) tbl[tid] = e;
    __syncthreads();
    return total >> 8;
}

__global__ void __launch_bounds__(NWAVES * 64, 2) mega(Args args) {
    extern __shared__ __attribute__((aligned(16))) unsigned char lds_raw[];
    LAS unsigned char* lds = (LAS unsigned char*)lds_raw;
    const Ctx& C = args.C;
    const int G = gridDim.x, bx = blockIdx.x;
    const int ngw = G * NWAVES;
    volatile LAS unsigned* MISC = (volatile LAS unsigned*)(lds + MISC_OFF);
    for (int i = threadIdx.x; i < (LDS_BYTES - RING_BYTES) / 4; i += NWAVES * 64) ((LAS unsigned*)(lds + RING_BYTES))[i] = 0u;
    __syncthreads();
    XcdBarrier bar = xcd_barrier_post(WSP(unsigned, WS_CTL) + CW_BAR, MISC + 8);
    LAS int* tbl = (LAS int*)(lds + RING_BYTES + 1024);
    const int lo = args.ph_lo, hi = args.ph_hi;

    for (int l = 0; l < DEPTH; ++l) {
        const int p0 = l * PH_PER_LAYER;
#ifndef PHASE_MASK
#define PHASE_MASK 0xFFF
#endif
#define IN(k) (((PHASE_MASK >> (k)) & 1) && lo <= p0 + (k) && p0 + (k) < hi)
#define LAUNDER() int tid = threadIdx.x; asm volatile("" : "+v"(tid)); const int lane = tid & 63; const int wave = __builtin_amdgcn_readfirstlane(tid >> 6); const int gw = bx * NWAVES + wave; (void)gw; (void)lane; \
        wsh_t wsh = (wsh_t)(lds + wave * 16384); (void)wsh
#define SEAM(k) do { if (p0 + (k) + 1 < hi) xcd_barrier(bar); } while (0)
        if (IN(0)) { LAUNDER(); stage_convert(C, l, gw, ngw, lane, wsh); SEAM(0); }
        if (IN(1)) { LAUNDER();
            pg8::Gemm g{WSP(bf16_t, WS_XB), WSP(bf16_t, WS_WIN), DM, DM, DM};
            pg8::DenseOrder S{T / 256, DINP / 256, G, bx, (long)256 * DM * 2, (long)256 * DM * 2};
            EpiU E{WSP(bf16_t, WS_U)};
            pg8::gemm_phase(lds, g, S, E); SEAM(1); }
        if (IN(2)) { LAUNDER(); stage_prep(C, l, gw, ngw, lane, wsh); SEAM(2); }
        if (IN(3)) { LAUNDER();
            if (wave == 0 && bx < 97) {
                if (bx < 32) rwkv_scan_thread(C, bx >> 2, bx & 3, lane);
                else if (bx < 64) gla_scan_thread(C, (bx - 32) >> 2, (bx - 32) & 3, lane);
                else if (bx < 96) mlstm_scan_thread(C, (bx - 64) >> 2, (bx - 64) & 3, lane);
                else if (lane < 32) mlstm_scan_thread(C, lane >> 2, lane & 3, 64);
            } else {
                const int aw = (bx < 97) ? bx * 7 + (wave - 1) : 97 * 7 + (bx - 97) * 8 + wave;
                const int naw = 97 * 7 + (G - 97) * 8;
                constexpr int NQB = SEQ / 64;
                for (int it = aw; it < BATCH * NH * NQB; it += naw) {
                    const int qb = NQB - 1 - it / (BATCH * NH), bh = it % (BATCH * NH);
                    attn_thread(C, bh >> 2, bh & 3, qb * 64 + lane, qb * 64 + 63); }
            }
            SEAM(3); }
        if (IN(4)) { LAUNDER(); stage_post(C, l, gw, ngw, lane); SEAM(4); }
        if (IN(5)) { LAUNDER();
            pg8::Gemm g{WSP(bf16_t, WS_MIX), WSP(bf16_t, WS_WOUT), DMIX, DMIX, DMIX};
            pg8::DenseOrder S{T / 256, DM / 256, G, bx, (long)256 * DMIX * 2, (long)256 * DMIX * 2};
            EpiPre1 E{l == 0 ? INF(I_X) : WSP(float, WS_X), C.out};
            pg8::gemm_phase(lds, g, S, E); SEAM(5); }
        if (IN(6)) { LAUNDER(); stage_ln1_router(C, l, gw, ngw, lane, wsh); SEAM(6); }
        if (IN(7)) { LAUNDER();
            stage_gather(C, l, gw, ngw, lane);
            pg8::Gemm g{WSP(bf16_t, WS_PB), WSP(bf16_t, WS_WP), DPLE, DPLE, DPLE};
            pg8::DenseOrder S{T / 256, DM / 256, G, bx, (long)256 * DPLE * 2, (long)256 * DPLE * 2};
            EpiPP E{WSP(bf16_t, WS_PP)};
            pg8::gemm_phase(lds, g, S, E); SEAM(7); }
        if (IN(8)) { LAUNDER();
            pg8::Gemm g{WSP(bf16_t, WS_XG), WSP(bf16_t, WS_WGU), DM, DM, DM};
            const int ntile = moe_fill_table(C, l, tbl, tid);
            pg8::MoeOrder S{tbl, ntile, 2 * DEXP / 256, G, bx, (long)256 * DM * 2, (long)256 * DM * 2, (long)2 * DEXP * DM * 2};
            EpiH E{WSP(bf16_t, WS_H)};
            pg8::gemm_phase(lds, g, S, E); SEAM(8); }
        if (IN(9)) { LAUNDER();
            pg8::Gemm g{WSP(bf16_t, WS_H), WSP(bf16_t, WS_WD), DEXP, DEXP, DEXP};
            const int ntile = moe_fill_table(C, l, tbl, tid);
            pg8::MoeOrder S{tbl, ntile, DM / 256, G, bx, (long)256 * DEXP * 2, (long)256 * DEXP * 2, (long)DM * DEXP * 2};
            EpiY E{WSP(int, WS_ROWINFO), WSP(float, WS_ROWGATE), WSP(bf16_t, WS_YBUF)};
            pg8::gemm_phase(lds, g, S, E); SEAM(9); }
        if (IN(10)) { LAUNDER();
            pg8::Gemm g{WSP(bf16_t, WS_XB), WSP(bf16_t, WS_WPG), DM, DM, DM};
            pg8::DenseOrder S{T / 256, DM / 256, G, bx, (long)256 * DM * 2, (long)256 * DM * 2};
            EpiPre2 E{C.out, WSP(bf16_t, WS_YBUF), WSP(bf16_t, WS_PP), INF(I_PLEBG) + l * DM, WSP(float, WS_X)};
            pg8::gemm_phase(lds, g, S, E); SEAM(10); }
        if (IN(11)) { LAUNDER(); stage_ln2(C, l, gw, ngw, lane); SEAM(11); }
#undef IN
#undef SEAM
    }
}

extern "C" void kernel_launch(void* const* d_in, const int* in_sizes, int n_in, void* d_out, int out_size, void* d_ws, size_t ws_size, hipStream_t stream) {
    static int grid = 0;
    if (grid == 0) {
        if (n_in != N_IN || out_size != T * DM || ws_size < WS_END) { fprintf(stderr, "kernel_launch: bad sizes n_in %d out %d ws %zu need %zu\n", n_in, out_size, ws_size, (size_t)WS_END); grid = -1; return; }
        int dev = 0, cus = 0, per_cu = 0;
        hipGetDevice(&dev); hipDeviceGetAttribute(&cus, hipDeviceAttributeMultiprocessorCount, dev);
        if (hipFuncSetAttribute((const void*)mega, hipFuncAttributeMaxDynamicSharedMemorySize, LDS_BYTES) != hipSuccess) { fprintf(stderr, "hipFuncSetAttribute failed\n"); grid = -1; return; }
        if (hipOccupancyMaxActiveBlocksPerMultiprocessor(&per_cu, (const void*)mega, NWAVES * 64, LDS_BYTES) != hipSuccess || per_cu < 1) { fprintf(stderr, "occupancy query: %d\n", per_cu); }
        (void)hipGetLastError();
        grid = cus;
    }
    if (grid < 0) return;
    hipMemsetAsync((char*)d_ws + WS_CTL, 0, CTL_BYTES, stream);
    Args a{};
    for (int i = 0; i < N_IN; ++i) a.C.in[i] = d_in[i];
    a.C.out = (float*)d_out; a.C.ws = (unsigned char*)d_ws;
#ifndef ONE_LAUNCH
    for (int ph = 0; ph < NPHASES; ++ph) { a.ph_lo = ph; a.ph_hi = ph + 1; hipLaunchKernelGGL(mega, dim3(grid), dim3(NWAVES * 64), LDS_BYTES, stream, a); }
#else
    a.ph_lo = 0; a.ph_hi = NPHASES; hipLaunchKernelGGL(mega, dim3(grid), dim3(NWAVES * 64), LDS_BYTES, stream, a);
#endif
}
#else
template <class E> static void cpu_gemm(const bf16_t* A, int lda, const bf16_t* Bt, int ldb, int K, int M, int N, const E& e, const int* base = nullptr, long estep = 0) {
    for (int row = 0; row < M; ++row) {
        const bf16_t* B = Bt;
        if (base) B = Bt + (size_t)moe_expert_of_row(base, row) * estep;
        if constexpr (E::MODE == 1) {
            for (int hc = 0; hc < N / 2; hc += 8) { float g[8], u[8];
                for (int j = 0; j < 8; ++j) { float ag = 0.f, au = 0.f; const bf16_t* bg = B + (size_t)rowmap(1, hc + j) * ldb; const bf16_t* bu = B + (size_t)rowmap(2, hc + j) * ldb;
                    for (int k = 0; k < K; ++k) { const float a = bf2f(A[(size_t)row * lda + k]); ag += a * bf2f(bg[k]); au += a * bf2f(bu[k]); } g[j] = ag; u[j] = au; }
                e.put8gu(row, hc, g, u); }
        } else if constexpr (E::PERM) {
            for (int c = 0; c < N; c += 8) { float a8[8];
                for (int j = 0; j < 8; ++j) { float acc = 0.f; for (int k = 0; k < K; ++k) acc += bf2f(A[(size_t)row * lda + k]) * bf2f(B[(size_t)(c + j) * ldb + k]); a8[j] = acc; }
                e.put8(row, c, a8); }
        } else {
            for (int c = 0; c < N; c += 4) { float a4[4];
                for (int j = 0; j < 4; ++j) { float acc = 0.f; for (int k = 0; k < K; ++k) acc += bf2f(A[(size_t)row * lda + k]) * bf2f(B[(size_t)(c + j) * ldb + k]); a4[j] = acc; }
                e.put4(row, c, a4); }
        }
    }
}
static void cpu_forward(const Ctx& C) {
    static float shbuf[4096];
    for (int l = 0; l < DEPTH; ++l) {
        stage_convert(C, l, 0, 1, 0, shbuf);
        { EpiU E{WSP(bf16_t, WS_U)}; cpu_gemm(WSP(bf16_t, WS_XB), DM, WSP(bf16_t, WS_WIN), DM, DM, T, DINP, E); }
        stage_prep(C, l, 0, 1, 0, shbuf);
        for (int b = 0; b < BATCH; ++b) for (int h = 0; h < NH; ++h) {
            for (int v = 0; v < 64; ++v) { rwkv_scan_thread(C, b, h, v); gla_scan_thread(C, b, h, v); }
            for (int e = 0; e < 65; ++e) mlstm_scan_thread(C, b, h, e);
            for (int q = 0; q < SEQ; ++q) attn_thread(C, b, h, q, q); }
        stage_post(C, l, 0, 1, 0);
        { EpiPre1 E{l == 0 ? INF(I_X) : WSP(float, WS_X), C.out}; cpu_gemm(WSP(bf16_t, WS_MIX), DMIX, WSP(bf16_t, WS_WOUT), DMIX, DMIX, T, DM, E); }
        stage_ln1_router(C, l, 0, 1, 0, shbuf);
        stage_gather(C, l, 0, 1, 0);
        { EpiPP E{WSP(bf16_t, WS_PP)}; cpu_gemm(WSP(bf16_t, WS_PB), DPLE, WSP(bf16_t, WS_WP), DPLE, DPLE, T, DM, E); }
        int base[NEXP + 1]; moe_bases(C, l, base);
        { EpiH E{WSP(bf16_t, WS_H)}; cpu_gemm(WSP(bf16_t, WS_XG), DM, WSP(bf16_t, WS_WGU), DM, DM, base[NEXP], 2 * DEXP, E, base, (long)2 * DEXP * DM); }
        { EpiY E{WSP(int, WS_ROWINFO), WSP(float, WS_ROWGATE), WSP(bf16_t, WS_YBUF)}; cpu_gemm(WSP(bf16_t, WS_H), DEXP, WSP(bf16_t, WS_WD), DEXP, DEXP, base[NEXP], DM, E, base, (long)DM * DEXP); }
        { EpiPre2 E{C.out, WSP(bf16_t, WS_YBUF), WSP(bf16_t, WS_PP), INF(I_PLEBG) + l * DM, WSP(float, WS_X)}; cpu_gemm(WSP(bf16_t, WS_XB), DM, WSP(bf16_t, WS_WPG), DM, DM, T, DM, E); }
        stage_ln2(C, l, 0, 1, 0);
    }
}
#endif
```

```cpp
#ifndef CPU_TEST
#include <hip/hip_runtime.h>
#include <cstdio>
#include <cstdint>
#define HD __device__ __forceinline__
#define HDM __device__ __forceinline__
#define LANES 64
#else
#include <cmath>
#include <cstdio>
#include <cstdint>
#include <cstring>
#include <algorithm>
#define HD static inline
#define HDM inline
#define LANES 1
#endif

#define ONE_LAUNCH 1
#ifndef CFG_SMALL
constexpr int BATCH = 8, SEQ = 4096, DM = 1024, DEPTH = 4, DPLE = 256, DEXP = 512;
#else
constexpr int BATCH = 2, SEQ = 256, DM = 128, DEPTH = 2, DPLE = 32, DEXP = 128;
#endif
constexpr int T = BATCH * SEQ;
constexpr int DMIX = 1024, GW = 256, HD64 = 64, NH = 4;
constexpr int DIN = 3128, DINP = 3328;
constexpr int UA = 0, UA_R = 0, UA_K = 256, UA_V = 512, UA_WD = 768, UA_AD = 800, UA_GD = 832, DINA = 896;
constexpr int UB = 896, UB_Q = 896, UB_K = 1024, UB_V = 1152, UB_AD = 1408, UB_G = 1424;
constexpr int UC = 1680, UC_Q = 1680, UC_K = 1936, UC_V = 2192, UC_O = 2448, UC_IG = 2704, UC_FG = 2708;
constexpr int UD = 2712, UD_CQ = 2712, UD_CKV = 2968, UD_KR = 3096;
constexpr int NEXP = 32, NGRP = 4, EPG = 8;
constexpr int MAXROWS = 2 * T + NEXP * 256;
constexpr float DN_ALPHA = 1.681792830507429f;
constexpr float LN_EPS = 1e-5f, NORM_EPS = 1e-6f, RWKV_GN_EPS = 64e-5f;
static_assert(DEPTH == 4 || DEPTH == 2, "alpha below assumes depth");
HD float dn_alpha() { return DEPTH == 4 ? 1.681792830507429f : 1.4142135623730951f; }

enum { I_X = 0, I_P, I_POS, I_WIN, I_MU, I_W0, I_WUP, I_A0, I_AUP, I_GUP, I_KK, I_KA, I_RK, I_GNG, I_GNB, I_GLA_UP, I_GLA_B, I_GLA_G,
       I_CONVW, I_CONVB, I_IB, I_FB, I_MLN_G, I_QNG, I_WUQ, I_KVNG, I_WUKV, I_WOUT, I_LN1G, I_LN1B, I_WRG, I_BRG, I_WRE, I_BRE,
       I_WG, I_WU, I_WD, I_PLEG, I_PLEBG, I_PLEW, I_LN2G, I_LN2B, N_IN };

typedef unsigned short bf16_t;
HD float bf2f(bf16_t h) { unsigned u = (unsigned)h << 16; return __builtin_bit_cast(float, u); }
HD bf16_t f2bf(float f) { unsigned u = __builtin_bit_cast(unsigned, f); return (bf16_t)((u + 0x7fffu + ((u >> 16) & 1u)) >> 16); }
HD unsigned pk2(float lo, float hi) { return (unsigned)f2bf(lo) | ((unsigned)f2bf(hi) << 16); }
typedef float f4v __attribute__((vector_size(16)));
typedef unsigned u4v __attribute__((vector_size(16)));
HD void ld8bf(const bf16_t* p, float* o) { const u4v w = *(const u4v*)p;
    for (int j = 0; j < 4; ++j) { o[2 * j] = __builtin_bit_cast(float, w[j] << 16); o[2 * j + 1] = __builtin_bit_cast(float, w[j] & 0xffff0000u); } }
HD void st8bf(bf16_t* p, const float* a) { u4v w; for (int j = 0; j < 4; ++j) w[j] = pk2(a[2 * j], a[2 * j + 1]); *(u4v*)p = w; }

constexpr size_t MiB = (size_t)1 << 20;
constexpr size_t al256(size_t x) { return (x + 255) & ~(size_t)255; }
constexpr size_t WS_CTL = 0, CTL_BYTES = 1 * MiB;
constexpr size_t WS_WIN = WS_CTL + CTL_BYTES;
constexpr size_t WS_WOUT = WS_WIN + al256((size_t)DINP * DM * 2);
constexpr size_t WS_WPG = WS_WOUT + al256((size_t)DM * DMIX * 2);
constexpr size_t WS_WP = WS_WPG + al256((size_t)DM * DM * 2);
constexpr size_t WS_WGU = WS_WP + al256((size_t)DM * DPLE * 2);
constexpr size_t WS_WD = WS_WGU + al256((size_t)NEXP * 2 * DEXP * DM * 2);
constexpr size_t WS_X = WS_WD + al256((size_t)NEXP * DM * DEXP * 2);
constexpr size_t WS_XB = WS_X + al256((size_t)T * DM * 4);
constexpr size_t WS_U = WS_XB + al256((size_t)T * DM * 2);
constexpr size_t WS_MIX = WS_U + al256((size_t)T * DINP * 2);
constexpr size_t WS_PB = WS_MIX + al256((size_t)T * DMIX * 2);
constexpr size_t WS_SCR = WS_PB + al256((size_t)T * DPLE * 2);
constexpr size_t TV = al256((size_t)T * GW * 4);
constexpr size_t WS_RW_R = WS_SCR, WS_RW_W = WS_RW_R + TV, WS_RW_K = WS_RW_W + TV, WS_RW_V = WS_RW_K + TV, WS_RW_A = WS_RW_V + TV,
                 WS_RW_B = WS_RW_A + TV, WS_RW_G = WS_RW_B + TV;
constexpr size_t WS_YA = WS_RW_G + TV, WS_YB = WS_YA + TV, WS_YC = WS_YB + TV;
constexpr size_t WS_DEN = WS_YC + TV;
constexpr size_t WS_QK = WS_DEN + al256((size_t)T * 4 * 4);
constexpr size_t WS_GA = WS_QK + al256((size_t)T * 512 * 4);
constexpr size_t WS_LG = WS_GA + al256((size_t)T * 128 * 4);
constexpr size_t WS_AQ = WS_LG + al256((size_t)T * 8 * 4);
constexpr size_t WS_AK = WS_AQ + al256((size_t)T * 384 * 2);
constexpr size_t WS_AV = WS_AK + al256((size_t)T * 384 * 2);
constexpr size_t WS_MIXER_END = WS_AV + al256((size_t)T * 256 * 2);
constexpr size_t WS_XG = WS_SCR;
constexpr size_t WS_H = WS_XG + al256((size_t)MAXROWS * DM * 2);
constexpr size_t WS_YBUF = WS_H + al256((size_t)MAXROWS * DEXP * 2);
constexpr size_t WS_PP = WS_YBUF + al256((size_t)2 * T * DM * 2);
constexpr size_t WS_TOKINFO = WS_PP + al256((size_t)T * DM * 2);
constexpr size_t WS_LIST = WS_TOKINFO + al256((size_t)T * 16);
constexpr size_t WS_ROWINFO = WS_LIST + al256((size_t)NEXP * T * 4);
constexpr size_t WS_ROWGATE = WS_ROWINFO + al256((size_t)MAXROWS * 4);
constexpr size_t WS_MOE_END = WS_ROWGATE + al256((size_t)MAXROWS * 4);
constexpr size_t WS_END = WS_MIXER_END > WS_MOE_END ? WS_MIXER_END : WS_MOE_END;
constexpr int CW_BAR = 4096;
constexpr int CW_ATT = 8192;
constexpr int CW_CNT = 16384;

struct Ctx {
    const void* in[N_IN];
    float* out;
    unsigned char* ws;
};
#define INF(i) ((const float*)C.in[i])
#define WSP(T_, off) ((T_*)(C.ws + (off)))

#ifndef CPU_TEST
HD float wave_sum(float v) {
#pragma unroll
    for (int o = 1; o < 64; o <<= 1) v += __shfl_xor(v, o);
    return v;
}
HD float wave_max(float v) {
#pragma unroll
    for (int o = 1; o < 64; o <<= 1) v = fmaxf(v, __shfl_xor(v, o));
    return v;
}
HD unsigned atom_add(unsigned* p, unsigned v) { return atomicAdd(p, v); }
#define WSYNC() __builtin_amdgcn_wave_barrier(); asm volatile("s_waitcnt lgkmcnt(0)" ::: "memory")
typedef __attribute__((address_space(3))) float* wsh_t;
#else
HD float wave_sum(float v) { return v; }
HD float wave_max(float v) { return v; }
HD unsigned atom_add(unsigned* p, unsigned v) { unsigned o = *p; *p += v; return o; }
#define WSYNC()
typedef float* wsh_t;
#endif
HD float sigmoidf_(float x) { return 1.f / (1.f + expf(-x)); }
HD float softplusf_(float x) { return x > 20.f ? x : (x < -20.f ? expf(x) : log1pf(expf(x))); }
HD float siluf_(float x) { return x * sigmoidf_(x); }

HD int rowmap(int mode, int n) { return mode == 0 ? n : (mode == 1 ? (n >> 7) * 256 + (n & 127) : (n >> 7) * 256 + 128 + (n & 127)); }
HD void transpose_item(const float* W, int K, int N, int ldw, bf16_t* WT, int ldk, int mode, int item, int lane, wsh_t scr) {
    const int nblk = (N + 31) / 32, kb = item / nblk, nb = item % nblk, k0 = 64 * kb, n0 = 32 * nb;
    for (int idx = lane; idx < 2048; idx += LANES) { const int kk = idx >> 5, nn = idx & 31; const int n = n0 + nn;
        scr[kk * 33 + nn] = (n < N) ? W[(size_t)(k0 + kk) * ldw + n] : 0.f; }
    WSYNC();
    for (int idx = lane; idx < 256; idx += LANES) { const int n = idx >> 3, c = idx & 7;
        unsigned o[4];
        for (int j = 0; j < 4; ++j) o[j] = pk2(scr[(8 * c + 2 * j) * 33 + n], scr[(8 * c + 2 * j + 1) * 33 + n]);
        unsigned* dst = (unsigned*)(WT + (size_t)rowmap(mode, n0 + n) * ldk + k0 + 8 * c);
        dst[0] = o[0]; dst[1] = o[1]; dst[2] = o[2]; dst[3] = o[3]; }
    WSYNC();
}
HD void stage_convert(const Ctx& C, int l, int gw, int ngw, int lane, wsh_t scr) {
    constexpr int NB_IN = DINP / 32;
    constexpr int I_IN = (DM / 64) * NB_IN, I_OUT = (DMIX / 64) * (DM / 32), I_PG = (DM / 64) * (DM / 32), I_PW = (DPLE / 64 > 0 ? DPLE / 64 : 1) * (DM / 32);
    constexpr int I_G1 = (DM / 64) * (DEXP / 32), I_D1 = (DEXP / 64) * (DM / 32);
    constexpr int NIT = I_IN + I_OUT + I_PG + I_PW + NEXP * (2 * I_G1 + I_D1);
    static_assert(DPLE % 32 == 0 && DEXP % 64 == 0, "shapes");
    for (int it = gw; it < NIT; it += ngw) {
        int r = it;
        if (r < I_IN) {
            const int nblk = NB_IN, kb = r / nblk, nb = r % nblk, k0 = 64 * kb, n0 = 32 * nb;
            const float* W = INF(I_WIN) + (size_t)l * DM * DIN; bf16_t* WT = WSP(bf16_t, WS_WIN);
            for (int idx = lane; idx < 2048; idx += LANES) { const int kk = idx >> 5, nn = idx & 31; const int n = n0 + nn;
                scr[kk * 33 + nn] = (n < DIN) ? W[(size_t)(k0 + kk) * DIN + n] : 0.f; }
            WSYNC();
            for (int idx = lane; idx < 256; idx += LANES) { const int n = idx >> 3, c = idx & 7; unsigned o[4];
                for (int j = 0; j < 4; ++j) o[j] = pk2(scr[(8 * c + 2 * j) * 33 + n], scr[(8 * c + 2 * j + 1) * 33 + n]);
                unsigned* dst = (unsigned*)(WT + (size_t)(n0 + n) * DM + k0 + 8 * c); dst[0] = o[0]; dst[1] = o[1]; dst[2] = o[2]; dst[3] = o[3]; }
            WSYNC();
            continue; }
        r -= I_IN;
        if (r < I_OUT) { transpose_item(INF(I_WOUT) + (size_t)l * DMIX * DM, DMIX, DM, DM, WSP(bf16_t, WS_WOUT), DMIX, 0, r, lane, scr); continue; } r -= I_OUT;
        if (r < I_PG) { transpose_item(INF(I_PLEG) + (size_t)l * DM * DM, DM, DM, DM, WSP(bf16_t, WS_WPG), DM, 0, r, lane, scr); continue; } r -= I_PG;
        if (r < I_PW) {
            if (DPLE >= 64) transpose_item(INF(I_PLEW) + (size_t)l * DPLE * DM, DPLE, DM, DM, WSP(bf16_t, WS_WP), DPLE, 0, r, lane, scr);
            continue; } r -= I_PW;
        const int e = r / (2 * I_G1 + I_D1); r -= e * (2 * I_G1 + I_D1);
        if (r < I_G1) { transpose_item(INF(I_WG) + ((size_t)l * NEXP + e) * DM * DEXP, DM, DEXP, DEXP, WSP(bf16_t, WS_WGU) + (size_t)e * 2 * DEXP * DM, DM, 1, r, lane, scr); continue; } r -= I_G1;
        if (r < I_G1) { transpose_item(INF(I_WU) + ((size_t)l * NEXP + e) * DM * DEXP, DM, DEXP, DEXP, WSP(bf16_t, WS_WGU) + (size_t)e * 2 * DEXP * DM, DM, 2, r, lane, scr); continue; } r -= I_G1;
        transpose_item(INF(I_WD) + ((size_t)l * NEXP + e) * DEXP * DM, DEXP, DM, DM, WSP(bf16_t, WS_WD) + (size_t)e * DM * DEXP, DEXP, 0, r, lane, scr);
    }
    {   const float* p = INF(I_P) + (size_t)l * T * DPLE; bf16_t* pb = WSP(bf16_t, WS_PB);
        const size_t n4 = (size_t)T * DPLE / 4;
        for (size_t i = (size_t)gw * LANES + lane; i < n4; i += (size_t)ngw * LANES) {
            const float* s = p + 4 * i; unsigned* d = (unsigned*)(pb + 4 * i); d[0] = pk2(s[0], s[1]); d[1] = pk2(s[2], s[3]); } }
    if (l == 0) { const float* x = INF(I_X); bf16_t* xb = WSP(bf16_t, WS_XB);
        const size_t n4 = (size_t)T * DM / 4;
        for (size_t i = (size_t)gw * LANES + lane; i < n4; i += (size_t)ngw * LANES) {
            const float* s = x + 4 * i; unsigned* d = (unsigned*)(xb + 4 * i); d[0] = pk2(s[0], s[1]); d[1] = pk2(s[2], s[3]); } }
#ifdef CFG_SMALL
    if (DPLE < 64) {
        const float* W = INF(I_PLEW) + (size_t)l * DPLE * DM; bf16_t* WT = WSP(bf16_t, WS_WP);
        for (int i = gw * LANES + lane; i < DPLE * DM; i += ngw * LANES) { const int k = i / DM, n = i % DM; WT[(size_t)n * DPLE + k] = f2bf(W[i]); } }
#endif
}

HD float ubf(const bf16_t* u, int t, int c) { return bf2f(u[(size_t)t * DINP + c]); }
HD void stage_prep(const Ctx& C, int l, int gw, int ngw, int lane, wsh_t sh) {
    const bf16_t* u = WSP(bf16_t, WS_U);
    const float* mu = INF(I_MU) + l * DINA; const float* w0 = INF(I_W0) + l * GW; const float* wup = INF(I_WUP) + l * 32 * GW;
    const float* a0 = INF(I_A0) + l * GW; const float* aup = INF(I_AUP) + l * 32 * GW; const float* gup = INF(I_GUP) + l * 64 * GW;
    const float* kkw = INF(I_KK) + l * GW; const float* kaw = INF(I_KA) + l * GW;
    const float* glaup = INF(I_GLA_UP) + l * 16 * 128; const float* glab = INF(I_GLA_B) + l * 128;
    const float* convw = INF(I_CONVW) + l * 4 * 512; const float* convb = INF(I_CONVB) + l * 512;
    const float* ib = INF(I_IB) + l * 4; const float* fb = INF(I_FB) + l * 4;
    const float* qng = INF(I_QNG) + l * 256; const float* wuq = INF(I_WUQ) + (size_t)l * 256 * 384;
    const float* kvng = INF(I_KVNG) + l * 128; const float* wukv = INF(I_WUKV) + (size_t)l * 128 * 512;
    const int* pos = (const int*)C.in[I_POS];
    float* oR = WSP(float, WS_RW_R); float* oW = WSP(float, WS_RW_W); float* oK = WSP(float, WS_RW_K); float* oV = WSP(float, WS_RW_V);
    float* oA = WSP(float, WS_RW_A); float* oB = WSP(float, WS_RW_B); float* oG = WSP(float, WS_RW_G);
    float* oQK = WSP(float, WS_QK); float* oGA = WSP(float, WS_GA); float* oLG = WSP(float, WS_LG);
    bf16_t* oAQ = WSP(bf16_t, WS_AQ); bf16_t* oAK = WSP(bf16_t, WS_AK); bf16_t* oAV = WSP(bf16_t, WS_AV);
    for (int t = gw; t < T; t += ngw) {
        const int s = t % SEQ;
        for (int j = lane; j < 128; j += LANES) { const int c = UA_WD + j; const float cur = ubf(u, t, c), prev = s > 0 ? ubf(u, t - 1, c) : 0.f;
            const float v = cur + (prev - cur) * mu[c]; sh[j] = j < 32 ? tanhf(v) : (j < 64 ? v : sigmoidf_(v)); }
        WSYNC();
        for (int h = 0; h < NH; ++h) {
            float kkraw[HD64 / LANES]; float kv_[HD64 / LANES], av_[HD64 / LANES]; float ss = 0.f;
            for (int i = 0; i < HD64 / LANES; ++i) { const int c = h * 64 + i * LANES + lane;
                float z = w0[c], za = a0[c], g = 0.f;
_Pragma("unroll 8")
                for (int j = 0; j < 32; ++j) { z += sh[j] * wup[j * GW + c]; za += sh[32 + j] * aup[j * GW + c]; }
_Pragma("unroll 8")
                for (int j = 0; j < 64; ++j) g += sh[64 + j] * gup[j * GW + c];
                const float lnl = -softplusf_(-z) - 0.5f; const float decay = expf(-expf(lnl)); const float a = sigmoidf_(za);
                float r, k, v;
                { const float cur = ubf(u, t, UA_R + c), prev = s > 0 ? ubf(u, t - 1, UA_R + c) : 0.f; r = cur + (prev - cur) * mu[UA_R + c]; }
                { const float cur = ubf(u, t, UA_K + c), prev = s > 0 ? ubf(u, t - 1, UA_K + c) : 0.f; k = cur + (prev - cur) * mu[UA_K + c]; }
                { const float cur = ubf(u, t, UA_V + c), prev = s > 0 ? ubf(u, t - 1, UA_V + c) : 0.f; v = cur + (prev - cur) * mu[UA_V + c]; }
                kkraw[i] = k * kkw[c]; ss += kkraw[i] * kkraw[i];
                kv_[i] = k * (1.f + (a - 1.f) * kaw[c]); av_[i] = a;
                const size_t o = (size_t)t * GW + c; oR[o] = r; oW[o] = decay; oK[o] = kv_[i]; oV[o] = v; oG[o] = g; }
            ss = wave_sum(ss); const float inv = 1.f / fmaxf(sqrtf(ss), 1e-12f);
            for (int i = 0; i < HD64 / LANES; ++i) { const int c = h * 64 + i * LANES + lane; const size_t o = (size_t)t * GW + c; const float kk = kkraw[i] * inv;
                oA[o] = -kk; oB[o] = kk * av_[i]; }
        }
        WSYNC();
        for (int c = lane; c < 128; c += LANES) { float z = glab[c];
            for (int j = 0; j < 16; ++j) z += ubf(u, t, UB_AD + j) * glaup[j * 128 + c];
            oGA[(size_t)t * 128 + c] = -softplusf_(-z) * (1.f / 16.f); }
        for (int c = lane; c < 512; c += LANES) { float y = convb[c];
            for (int j = 0; j < 4; ++j) { const int sp = s - 3 + j; if (sp >= 0) y += convw[j * 512 + c] * ubf(u, t - 3 + j, UC_Q + c); }
            float q = siluf_(y); if (c >= 256) q *= 0.125f; oQK[(size_t)t * 512 + c] = q; }
        for (int c = lane; c < 8; c += LANES) { const float v = ubf(u, t, UC_IG + c);
            oLG[(size_t)t * 8 + c] = c < 4 ? v + ib[c] : -softplusf_(-(v + fb[c - 4])); }
        {   float ssq = 0.f, sskv = 0.f;
            for (int j = lane; j < 256; j += LANES) { const float v = ubf(u, t, UD_CQ + j); ssq += v * v; }
            for (int j = lane; j < 128; j += LANES) { const float v = ubf(u, t, UD_CKV + j); sskv += v * v; }
            ssq = wave_sum(ssq); sskv = wave_sum(sskv);
            const float rq = 1.f / sqrtf(ssq * (1.f / 256.f) + NORM_EPS), rkv = 1.f / sqrtf(sskv * (1.f / 128.f) + NORM_EPS);
            for (int j = lane; j < 256; j += LANES) sh[j] = ubf(u, t, UD_CQ + j) * rq * qng[j];
            for (int j = lane; j < 128; j += LANES) sh[256 + j] = ubf(u, t, UD_CKV + j) * rkv * kvng[j];
            WSYNC();
            for (int n = lane; n < 384; n += LANES) { float acc = 0.f;
_Pragma("unroll 8")
                for (int k = 0; k < 256; ++k) acc += sh[k] * wuq[(size_t)k * 384 + n]; sh[384 + n] = acc; }
            for (int n = lane; n < 512; n += LANES) { float acc = 0.f;
_Pragma("unroll 8")
                for (int k = 0; k < 128; ++k) acc += sh[256 + k] * wukv[(size_t)k * 512 + n]; sh[768 + n] = acc; }
            for (int i = lane; i < 16; i += LANES) { const float invf = powf(10000.f, -(float)i / 16.f); const float ang = (float)pos[t] * invf; sh[1280 + i] = cosf(ang); sh[1296 + i] = sinf(ang); }
            for (int i = lane; i < 32; i += LANES) sh[1312 + i] = ubf(u, t, UD_KR + i);
            WSYNC();
            const float qscale = 0.10206207261596575f * 1.4426950408889634f;
            for (int idx = lane; idx < 384; idx += LANES) { const int h = idx / 96, d = idx % 96; float v;
                if (d < 64) v = sh[384 + idx];
                else { const int i = (d - 64) & 15; const float x1 = sh[384 + h * 96 + 64 + i], x2 = sh[384 + h * 96 + 80 + i]; const float c_ = sh[1280 + i], s_ = sh[1296 + i];
                    v = (d - 64) < 16 ? x1 * c_ - x2 * s_ : x1 * s_ + x2 * c_; }
                oAQ[(size_t)t * 384 + idx] = f2bf(v * qscale); }
            for (int idx = lane; idx < 384; idx += LANES) { const int h = idx / 96, d = idx % 96; float v;
                if (d < 64) v = sh[768 + h * 128 + d];
                else { const int i = (d - 64) & 15; const float x1 = sh[1312 + i], x2 = sh[1328 + i]; const float c_ = sh[1280 + i], s_ = sh[1296 + i];
                    v = (d - 64) < 16 ? x1 * c_ - x2 * s_ : x1 * s_ + x2 * c_; }
                oAK[(size_t)t * 384 + idx] = f2bf(v); }
            for (int idx = lane; idx < 256; idx += LANES) { const int h = idx / 64, d = idx % 64; oAV[(size_t)t * 256 + idx] = f2bf(sh[768 + h * 128 + 64 + d]); }
            WSYNC();
        }
    }
}

HD void rwkv_scan_thread(const Ctx& C, int b, int h, int v) {
    const float* pR = WSP(float, WS_RW_R); const float* pW = WSP(float, WS_RW_W); const float* pK = WSP(float, WS_RW_K); const float* pV = WSP(float, WS_RW_V);
    const float* pA = WSP(float, WS_RW_A); const float* pB = WSP(float, WS_RW_B); float* Y = WSP(float, WS_YA);
    float S[64];
#pragma unroll
    for (int k = 0; k < 64; ++k) S[k] = 0.f;
    for (int s = 0; s < SEQ; ++s) {
        const size_t o = ((size_t)b * SEQ + s) * GW + h * 64;
        const float vv = pV[o + v];
        float sa0 = 0.f, sa1 = 0.f, sa2 = 0.f, sa3 = 0.f;
#pragma unroll
        for (int k = 0; k < 64; k += 4) { const f4v a = *(const f4v*)(pA + o + k); sa0 += S[k] * a[0]; sa1 += S[k + 1] * a[1]; sa2 += S[k + 2] * a[2]; sa3 += S[k + 3] * a[3]; }
        const float sa = (sa0 + sa1) + (sa2 + sa3);
        float y0 = 0.f, y1 = 0.f, y2 = 0.f, y3 = 0.f;
#pragma unroll
        for (int k = 0; k < 64; k += 4) {
            const f4v w = *(const f4v*)(pW + o + k), bb = *(const f4v*)(pB + o + k), kk = *(const f4v*)(pK + o + k), r = *(const f4v*)(pR + o + k);
            S[k] = S[k] * w[0] + sa * bb[0] + vv * kk[0]; y0 += S[k] * r[0];
            S[k + 1] = S[k + 1] * w[1] + sa * bb[1] + vv * kk[1]; y1 += S[k + 1] * r[1];
            S[k + 2] = S[k + 2] * w[2] + sa * bb[2] + vv * kk[2]; y2 += S[k + 2] * r[2];
            S[k + 3] = S[k + 3] * w[3] + sa * bb[3] + vv * kk[3]; y3 += S[k + 3] * r[3];
            if ((k & 12) == 12) asm volatile("" ::: "memory"); }
        Y[o + v] = (y0 + y1) + (y2 + y3);
    }
}
HD void gla_scan_thread(const Ctx& C, int b, int h, int v) {
    const bf16_t* u = WSP(bf16_t, WS_U); const float* GA = WSP(float, WS_GA); float* Y = WSP(float, WS_YB);
    float S[32];
#pragma unroll
    for (int k = 0; k < 32; ++k) S[k] = 0.f;
    for (int s = 0; s < SEQ; ++s) {
        const int t = b * SEQ + s;
        const float vv = ubf(u, t, UB_V + h * 64 + v);
        float acc = 0.f;
#pragma unroll
        for (int k8 = 0; k8 < 32; k8 += 8) { float kf[8], qf[8];
            ld8bf(u + (size_t)t * DINP + UB_K + h * 32 + k8, kf); ld8bf(u + (size_t)t * DINP + UB_Q + h * 32 + k8, qf);
            const f4v g0 = *(const f4v*)(GA + (size_t)t * 128 + h * 32 + k8), g1 = *(const f4v*)(GA + (size_t)t * 128 + h * 32 + k8 + 4);
#pragma unroll
            for (int j = 0; j < 8; ++j) { const float a = expf(j < 4 ? g0[j & 3] : g1[j & 3]); S[k8 + j] = a * S[k8 + j] + kf[j] * vv; acc += qf[j] * S[k8 + j]; } }
        Y[(size_t)t * GW + h * 64 + v] = acc * 0.17677669529663687f;
    }
}
HD void mlstm_scan_thread(const Ctx& C, int b, int h, int e) {
    const bf16_t* u = WSP(bf16_t, WS_U); const float* QK = WSP(float, WS_QK); const float* LG = WSP(float, WS_LG);
    float* Y = WSP(float, WS_YC); float* DEN = WSP(float, WS_DEN);
    float S[64];
#pragma unroll
    for (int k = 0; k < 64; ++k) S[k] = 0.f;
    for (int s = 0; s < SEQ; ++s) {
        const int t = b * SEQ + s;
        const float ig = expf(LG[(size_t)t * 8 + h]), fg = expf(LG[(size_t)t * 8 + 4 + h]);
        const float vv = (e < 64 ? ubf(u, t, UC_V + h * 64 + e) : 1.f) * ig;
        float acc = 0.f;
#pragma unroll
        for (int k = 0; k < 64; k += 4) { const f4v kk = *(const f4v*)(QK + (size_t)t * 512 + 256 + h * 64 + k), qq = *(const f4v*)(QK + (size_t)t * 512 + h * 64 + k);
#pragma unroll
            for (int j = 0; j < 4; ++j) { S[k + j] = fg * S[k + j] + kk[j] * vv; acc += qq[j] * S[k + j]; } }
        if (e < 64) Y[(size_t)t * GW + h * 64 + e] = acc; else DEN[(size_t)t * 4 + h] = acc;
    }
}
HD void attn_thread(const Ctx& C, int b, int h, int q, int kmax  ) {
    const bf16_t* Q = WSP(bf16_t, WS_AQ); const bf16_t* K = WSP(bf16_t, WS_AK); const bf16_t* V = WSP(bf16_t, WS_AV); bf16_t* mix = WSP(bf16_t, WS_MIX);
    const int t = b * SEQ + q;
    unsigned qp[48]; float o[64];
#pragma unroll
    for (int d = 0; d < 48; d += 4) { const u4v w = *(const u4v*)(Q + (size_t)t * 384 + h * 96 + 2 * d); qp[d] = w[0]; qp[d + 1] = w[1]; qp[d + 2] = w[2]; qp[d + 3] = w[3]; }
#pragma unroll
    for (int d = 0; d < 64; ++d) o[d] = 0.f;
    float m = -1e30f, lsum = 0.f;
    for (int j = 0; j <= kmax; ++j) {
        const size_t tk = (size_t)b * SEQ + j;
        float sc0 = 0.f, sc1 = 0.f;
#pragma unroll
        for (int d = 0; d < 96; d += 8) { float kf[8]; ld8bf(K + tk * 384 + h * 96 + d, kf);
#pragma unroll
            for (int i = 0; i < 8; i += 2) { const unsigned qw = qp[(d + i) >> 1];
                sc0 += __builtin_bit_cast(float, qw << 16) * kf[i]; sc1 += __builtin_bit_cast(float, qw & 0xffff0000u) * kf[i + 1]; }
            if ((d & 24) == 24) asm volatile("" ::: "memory"); }
        const float sc = sc0 + sc1;
        if (j <= q) {
            const float mn = fmaxf(m, sc); const float corr = exp2f(m - mn), p = exp2f(sc - mn);
            lsum = lsum * corr + p;
#pragma unroll
            for (int d = 0; d < 64; d += 8) { float vf[8]; ld8bf(V + tk * 256 + h * 64 + d, vf);
#pragma unroll
                for (int i = 0; i < 8; ++i) o[d + i] = o[d + i] * corr + p * vf[i];
                if (d & 8) asm volatile("" ::: "memory"); }
            m = mn; }
    }
    const float inv = 1.f / lsum;
#pragma unroll
    for (int d = 0; d < 64; d += 8) { float a[8];
#pragma unroll
        for (int i = 0; i < 8; ++i) a[i] = o[d + i] * inv;
        st8bf(mix + (size_t)t * DMIX + 768 + h * 64 + d, a); }
}

HD void stage_post(const Ctx& C, int l, int gw, int ngw, int lane) {
    const bf16_t* u = WSP(bf16_t, WS_U); bf16_t* mix = WSP(bf16_t, WS_MIX);
    const float* YA = WSP(float, WS_YA); const float* YB = WSP(float, WS_YB); const float* YC = WSP(float, WS_YC); const float* DEN = WSP(float, WS_DEN);
    const float* pR = WSP(float, WS_RW_R); const float* pK = WSP(float, WS_RW_K); const float* pV = WSP(float, WS_RW_V); const float* pG = WSP(float, WS_RW_G);
    const float* rk = INF(I_RK) + l * GW; const float* gng = INF(I_GNG) + l * GW; const float* gnb = INF(I_GNB) + l * GW;
    const float* glag = INF(I_GLA_G) + l * GW; const float* mlng = INF(I_MLN_G) + l * GW;
    constexpr int PL = HD64 / LANES;
    for (int t = gw; t < T; t += ngw) {
        for (int h = 0; h < NH; ++h) {
            {   float y[PL], s1 = 0.f, bon = 0.f;
                for (int i = 0; i < PL; ++i) { const int c = h * 64 + i * LANES + lane; const size_t o = (size_t)t * GW + c; y[i] = YA[o]; s1 += y[i]; bon += pR[o] * pK[o] * rk[c]; }
                s1 = wave_sum(s1); bon = wave_sum(bon); const float mean = s1 * (1.f / 64.f); float s2 = 0.f;
                for (int i = 0; i < PL; ++i) { y[i] -= mean; s2 += y[i] * y[i]; }
                s2 = wave_sum(s2); const float rstd = 1.f / sqrtf(s2 * (1.f / 64.f) + RWKV_GN_EPS);
                for (int i = 0; i < PL; ++i) { const int c = h * 64 + i * LANES + lane; const size_t o = (size_t)t * GW + c;
                    const float v = (y[i] * rstd * gng[c] + gnb[c] + bon * pV[o]) * pG[o]; mix[(size_t)t * DMIX + c] = f2bf(v); } }
            {   float y[PL], s2 = 0.f;
                for (int i = 0; i < PL; ++i) { const int c = h * 64 + i * LANES + lane; y[i] = YB[(size_t)t * GW + c]; s2 += y[i] * y[i]; }
                s2 = wave_sum(s2); const float rstd = 1.f / sqrtf(s2 * (1.f / 64.f) + NORM_EPS);
                for (int i = 0; i < PL; ++i) { const int c = h * 64 + i * LANES + lane;
                    const float v = y[i] * rstd * glag[c] * siluf_(ubf(u, t, UB_G + c)); mix[(size_t)t * DMIX + 256 + c] = f2bf(v); } }
            {   const float den = DEN[(size_t)t * 4 + h]; const float dinv = 1.f / fmaxf(fabsf(den), 1.f);
                float y[PL], s1 = 0.f;
                for (int i = 0; i < PL; ++i) { const int c = h * 64 + i * LANES + lane; y[i] = YC[(size_t)t * GW + c] * dinv; s1 += y[i]; }
                s1 = wave_sum(s1); const float mean = s1 * (1.f / 64.f); float s2 = 0.f;
                for (int i = 0; i < PL; ++i) { y[i] -= mean; s2 += y[i] * y[i]; }
                s2 = wave_sum(s2); const float rstd = 1.f / sqrtf(s2 * (1.f / 64.f) + LN_EPS);
                for (int i = 0; i < PL; ++i) { const int c = h * 64 + i * LANES + lane;
                    const float v = y[i] * rstd * mlng[c] * sigmoidf_(ubf(u, t, UC_O + c)); mix[(size_t)t * DMIX + 512 + c] = f2bf(v); } }
        }
    }
}

HD void ln_row(const float* src, const float* g, const float* b, float* dstf, bf16_t* dstb, int lane, float* keep  ) {
    constexpr int PL = DM / LANES;
    float s1 = 0.f;
#pragma unroll
    for (int i = 0; i < PL; ++i) { keep[i] = src[i * LANES + lane]; s1 += keep[i]; }
    s1 = wave_sum(s1); const float mean = s1 * (1.f / DM); float s2 = 0.f;
#pragma unroll
    for (int i = 0; i < PL; ++i) { keep[i] -= mean; s2 += keep[i] * keep[i]; }
    s2 = wave_sum(s2); const float rstd = 1.f / sqrtf(s2 * (1.f / DM) + LN_EPS);
#pragma unroll
    for (int i = 0; i < PL; ++i) { const int c = i * LANES + lane; keep[i] = keep[i] * rstd * g[c] + b[c]; dstf[c] = keep[i]; dstb[c] = f2bf(keep[i]); }
}
HD void stage_ln1_router(const Ctx& C, int l, int gw, int ngw, int lane, wsh_t sh) {
    float* X1 = C.out; bf16_t* xb = WSP(bf16_t, WS_XB);
    const float* g = INF(I_LN1G) + l * DM; const float* b = INF(I_LN1B) + l * DM;
    const float* wrg = INF(I_WRG) + (size_t)l * DM * NGRP; const float* brg = INF(I_BRG) + l * NGRP;
    const float* wre = INF(I_WRE) + (size_t)l * DM * NEXP; const float* bre = INF(I_BRE) + l * NEXP;
    unsigned* cnt = WSP(unsigned, WS_CTL) + CW_CNT + l * NEXP * 64;
    int* tokinfo = WSP(int, WS_TOKINFO); int* list = WSP(int, WS_LIST);
    constexpr int PL = DM / LANES;
    for (int t = gw; t < T; t += ngw) {
        {   float keep[PL];
            ln_row(X1 + (size_t)t * DM, g, b, X1 + (size_t)t * DM, xb + (size_t)t * DM, lane, keep);
#pragma unroll
            for (int i = 0; i < PL; ++i) sh[i * LANES + lane] = keep[i]; }
        WSYNC();
        float lg[NGRP], le[NEXP];
#pragma unroll
        for (int j = 0; j < NGRP; ++j) lg[j] = 0.f;
#pragma unroll
        for (int j = 0; j < NEXP; ++j) le[j] = 0.f;
#pragma unroll 1
        for (int i = 0; i < PL; ++i) { const int c = i * LANES + lane; const float xv = sh[c];
            const f4v wg = *(const f4v*)(wrg + (size_t)c * NGRP);
#pragma unroll
            for (int j = 0; j < NGRP; ++j) lg[j] += xv * wg[j];
#pragma unroll
            for (int j = 0; j < NEXP; j += 4) { const f4v we = *(const f4v*)(wre + (size_t)c * NEXP + j);
                le[j] += xv * we[0]; le[j + 1] += xv * we[1]; le[j + 2] += xv * we[2]; le[j + 3] += xv * we[3]; } }
        WSYNC();
#pragma unroll
        for (int j = 0; j < NGRP; ++j) lg[j] = wave_sum(lg[j]) + brg[j];
#pragma unroll
        for (int j = 0; j < NEXP; ++j) le[j] = wave_sum(le[j]) + bre[j];
        int gi = 0; float gm = lg[0];
#pragma unroll
        for (int j = 1; j < NGRP; ++j) if (lg[j] > gm) { gm = lg[j]; gi = j; }
        float gs = 0.f;
#pragma unroll
        for (int j = 0; j < NGRP; ++j) gs += expf(lg[j] - gm);
        const float group_p = 1.f / gs;
        float el[EPG];
#pragma unroll
        for (int j = 0; j < EPG; ++j) { float v = le[j];
#pragma unroll
            for (int g2 = 1; g2 < NGRP; ++g2) v = (gi == g2) ? le[g2 * EPG + j] : v;
            el[j] = v; }
        int e0 = 0; float m0 = el[0];
#pragma unroll
        for (int j = 1; j < EPG; ++j) if (el[j] > m0) { m0 = el[j]; e0 = j; }
        int e1 = -1; float m1 = -3.0e38f;
#pragma unroll
        for (int j = 0; j < EPG; ++j) if (j != e0 && el[j] > m1) { m1 = el[j]; e1 = j; }
        const float p1 = expf(m1 - m0); const float g0 = group_p / (1.f + p1), g1 = group_p * p1 / (1.f + p1);
        if (lane == 0) {
            const int E0 = gi * EPG + e0, E1 = gi * EPG + e1;
            tokinfo[(size_t)t * 4 + 0] = E0; tokinfo[(size_t)t * 4 + 1] = E1;
            ((float*)tokinfo)[(size_t)t * 4 + 2] = g0; ((float*)tokinfo)[(size_t)t * 4 + 3] = g1;
            const unsigned s0 = atom_add(cnt + E0 * 64, 1u); list[(size_t)E0 * T + s0] = t * 2 + 0;
            const unsigned s1 = atom_add(cnt + E1 * 64, 1u); list[(size_t)E1 * T + s1] = t * 2 + 1;
        }
    }
}
HD void moe_bases(const Ctx& C, int l, int* base  ) {
    const unsigned* cnt = WSP(unsigned, WS_CTL) + CW_CNT + l * NEXP * 64;
    int acc = 0;
    for (int e = 0; e < NEXP; ++e) { base[e] = acc; acc += ((int)cnt[e * 64] + 255) & ~255; }
    base[NEXP] = acc;
}
HD int moe_expert_of_row(const int* base, int row) { int e = 0; for (int j = 1; j < NEXP; ++j) if (row >= base[j]) e = j; return e; }
HD int moe_lookup(const unsigned* cnt, int row, int& e, int& be, int& ce) {
    int acc = 0; e = 0; be = 0; ce = 0;
    for (int j = 0; j < NEXP; ++j) { const int c = (int)cnt[j * 64]; if (row >= acc) { e = j; be = acc; ce = c; } acc += (c + 255) & ~255; }
    return acc;
}
HD void stage_gather(const Ctx& C, int l, int gw, int ngw, int lane) {
    const unsigned* cnt = WSP(unsigned, WS_CTL) + CW_CNT + l * NEXP * 64;
    const int* list = WSP(int, WS_LIST); const int* tokinfo = WSP(int, WS_TOKINFO);
    const bf16_t* xb = WSP(bf16_t, WS_XB); bf16_t* xg = WSP(bf16_t, WS_XG); int* rowinfo = WSP(int, WS_ROWINFO); float* rowgate = WSP(float, WS_ROWGATE);
    int e, be, ce; const int total = moe_lookup(cnt, 0, e, be, ce);
    for (int row = gw; row < total; row += ngw) {
        moe_lookup(cnt, row, e, be, ce);
        const int slot = row - be;
        if (slot < ce) { const int ent = list[(size_t)e * T + slot]; const int tok = ent >> 1;
            for (int c = lane * 8; c < DM; c += LANES * 8) *(u4v*)(xg + (size_t)row * DM + c) = *(const u4v*)(xb + (size_t)tok * DM + c);
            if (lane == 0) { rowinfo[row] = ent; rowgate[row] = ((const float*)tokinfo)[(size_t)tok * 4 + 2 + (ent & 1)]; } }
        else { const u4v z = {0u, 0u, 0u, 0u}; for (int c = lane * 8; c < DM; c += LANES * 8) *(u4v*)(xg + (size_t)row * DM + c) = z;
            if (lane == 0) { rowinfo[row] = -1; rowgate[row] = 0.f; } }
    }
}
HD void stage_ln2(const Ctx& C, int l, int gw, int ngw, int lane) {
    const float* src = WSP(float, WS_X); float* dst = (l == DEPTH - 1) ? C.out : WSP(float, WS_X); bf16_t* xb = WSP(bf16_t, WS_XB);
    const float* g = INF(I_LN2G) + l * DM; const float* b = INF(I_LN2B) + l * DM;
    constexpr int PL = DM / LANES;
    for (int t = gw; t < T; t += ngw) { float keep[PL]; ln_row(src + (size_t)t * DM, g, b, dst + (size_t)t * DM, xb + (size_t)t * DM, lane, keep); }
}

struct EpiU {
    static constexpr bool PERM = true; static constexpr int MODE = 0;
    bf16_t* o;
    HDM void put8(int row, int col, const float* a) const { st8bf(o + (size_t)row * DINP + col, a); }
};
struct EpiPP {
    static constexpr bool PERM = true; static constexpr int MODE = 0;
    bf16_t* o;
    HDM void put8(int row, int col, const float* a) const { st8bf(o + (size_t)row * DM + col, a); }
};
struct EpiPre1 {
    static constexpr bool PERM = false; static constexpr int MODE = 0;
    const float* x; float* o;
    HDM void put4(int row, int col, const float* a) const { const float al = dn_alpha(); const f4v xr = *(const f4v*)(x + (size_t)row * DM + col);
        f4v r; for (int j = 0; j < 4; ++j) r[j] = al * xr[j] + a[j]; *(f4v*)(o + (size_t)row * DM + col) = r; }
};
struct EpiH {
    static constexpr bool PERM = true; static constexpr int MODE = 1;
    bf16_t* o;
    HDM void put8gu(int row, int hcol, const float* g, const float* u) const { float v[8]; for (int j = 0; j < 8; ++j) v[j] = siluf_(g[j]) * u[j];
        st8bf(o + (size_t)row * DEXP + hcol, v); }
};
struct EpiY {
    static constexpr bool PERM = true; static constexpr int MODE = 0;
    const int* rowinfo; const float* rowgate; bf16_t* o;
    HDM void put8(int row, int col, const float* a) const { const int ent = rowinfo[row]; if (ent < 0) return; const float g = rowgate[row];
        float v[8]; for (int j = 0; j < 8; ++j) v[j] = g * a[j]; st8bf(o + (size_t)ent * DM + col, v); }
};
struct EpiPre2 {
    static constexpr bool PERM = false; static constexpr int MODE = 0;
    const float* x1; const bf16_t* ybuf; const bf16_t* pp; const float* bg; float* o;
    HDM void put4(int row, int col, const float* a) const { const float al = dn_alpha(); const size_t i = (size_t)row * DM + col;
        const f4v xr = *(const f4v*)(x1 + i); const f4v bgv = *(const f4v*)(bg + col);
        const unsigned* y0 = (const unsigned*)(ybuf + (size_t)(2 * row) * DM + col); const unsigned* y1 = (const unsigned*)(ybuf + (size_t)(2 * row + 1) * DM + col); const unsigned* pq = (const unsigned*)(pp + i);
        const unsigned y00 = y0[0], y01 = y0[1], y10 = y1[0], y11 = y1[1], p0 = pq[0], p1 = pq[1];
        float yv[4] = { __builtin_bit_cast(float, y00 << 16) + __builtin_bit_cast(float, y10 << 16), __builtin_bit_cast(float, y00 & 0xffff0000u) + __builtin_bit_cast(float, y10 & 0xffff0000u),
                        __builtin_bit_cast(float, y01 << 16) + __builtin_bit_cast(float, y11 << 16), __builtin_bit_cast(float, y01 & 0xffff0000u) + __builtin_bit_cast(float, y11 & 0xffff0000u) };
        float pv[4] = { __builtin_bit_cast(float, p0 << 16), __builtin_bit_cast(float, p0 & 0xffff0000u), __builtin_bit_cast(float, p1 << 16), __builtin_bit_cast(float, p1 & 0xffff0000u) };
        f4v r; for (int j = 0; j < 4; ++j) r[j] = al * xr[j] + yv[j] + sigmoidf_(a[j] + bgv[j]) * pv[j];
        *(f4v*)(o + i) = r; }
};

#ifndef CPU_TEST
namespace pg8 {
#define PG8_LAS __attribute__((address_space(3)))
typedef short bf16x8 __attribute__((ext_vector_type(8)));
typedef float f32x4 __attribute__((ext_vector_type(4)));
constexpr int BM = 256, BK = 64, HALF = 128, HTB = HALF * BK * 2, STAGE_BYTES = 8 * HTB;
__device__ __forceinline__ int lds_byte(int r, int c) { const int st = (r >> 4) * 2 + (c >> 5), rr = r & 15, cc = c & 31, ob = rr * 64 + cc * 2; return st * 1024 + (ob ^ (((ob >> 9) & 1) << 5)); }
__device__ __forceinline__ void stage_rc(int b, int& R, int& C) { const int st = b / 1024, sb = b % 1024, swz = sb ^ (((sb >> 9) & 1) << 5); R = (st >> 1) * 16 + swz / 64; C = (st & 1) * 32 + (swz % 64) / 2; }
__device__ __forceinline__ int perm32(int rho) { const int n = rho >> 4, i = rho & 15; return 8 * (i >> 2) + 4 * n + (i & 3); }
struct Unit { int pm, pn; long aoff, boff; };
struct Gemm { const bf16_t* A; const bf16_t* Bt; int lda, ldb, K; };

template <class F> __device__ __forceinline__ void run_epi(const F& f, const f32x4 (&acc)[2][2][4][2], const Unit& u, int wr, int wc, int fr, int fq) {
#pragma unroll
    for (int ai = 0; ai < 2; ++ai)
#pragma unroll
        for (int m = 0; m < 4; ++m) { const int row = u.pm * BM + ai * HALF + wr * 64 + m * 16 + fr;
            if constexpr (F::MODE == 1) { const int hcol = u.pn * 128 + wc * 32 + 8 * fq; float g[8], up[8];
#pragma unroll
                for (int j = 0; j < 4; ++j) { g[j] = acc[ai][0][m][0][j]; g[4 + j] = acc[ai][0][m][1][j]; up[j] = acc[ai][1][m][0][j]; up[4 + j] = acc[ai][1][m][1][j]; }
                f.put8gu(row, hcol, g, up); }
            else if constexpr (F::PERM) {
#pragma unroll
                for (int bj = 0; bj < 2; ++bj) { const int col = u.pn * BM + bj * HALF + wc * 32 + 8 * fq; float a[8];
#pragma unroll
                    for (int j = 0; j < 4; ++j) { a[j] = acc[ai][bj][m][0][j]; a[4 + j] = acc[ai][bj][m][1][j]; }
                    f.put8(row, col, a); } }
            else {
#pragma unroll
                for (int bj = 0; bj < 2; ++bj)
#pragma unroll
                    for (int n = 0; n < 2; ++n) { const int col = u.pn * BM + bj * HALF + wc * 32 + 16 * n + 4 * fq; float a[4];
#pragma unroll
                        for (int j = 0; j < 4; ++j) a[j] = acc[ai][bj][m][n][j];
                        f.put4(row, col, a); } }
        }
}

template <class Epi, class Sched>
__device__ __forceinline__ void gemm_phase(PG8_LAS unsigned char* lds, const Gemm g, const Sched& S, const Epi& E) {
    int tid = threadIdx.x; asm volatile("" : "+v"(tid));
    const int wid = __builtin_amdgcn_readfirstlane(tid >> 6), lane = tid & 63, wr = wid >> 2, wc = wid & 3, fr = lane & 15, fq = lane >> 4;
    const int K = g.K, nt = K / BK;
    unsigned voffA[2], voffB[2];
#pragma unroll
    for (int i = 0; i < 2; ++i) { int R, C; stage_rc(tid * 16 + i * 8192, R, C); const int Rb = Epi::PERM ? ((R & ~31) + perm32(R & 31)) : R;
        voffA[i] = (unsigned)(R * g.lda + C) * 2u; voffB[i] = (unsigned)(Rb * g.ldb + C) * 2u; }
    const size_t kstep = (size_t)(BK * 2);
    const size_t hstepA = (size_t)HALF * g.lda * 2, hstepB = (size_t)HALF * g.ldb * 2;
    const unsigned ldsw = (unsigned)wid * 1024u;
    const int aoff = lds_byte(wr * 64 + fr, fq * 8), boff = lds_byte(wc * 32 + fr, fq * 8);
#define PG8_SA(b, h) (((b) * 2 + (h)) * HTB)
#define PG8_SB(b, h) ((4 + (b) * 2 + (h)) * HTB)
#define PG8_STAGE(bufoff, gbase, voff) do { _Pragma("unroll") for (int _i = 0; _i < 2; ++_i) \
        __builtin_amdgcn_global_load_lds((const unsigned*)((const char*)(gbase) + (voff)[_i]), (PG8_LAS unsigned*)(lds + (bufoff) + ldsw + _i * 8192), 16, 0, 0); } while (0)
#define PG8_LDA(dst, b, h) do { _Pragma("unroll") for (int m = 0; m < 4; ++m) _Pragma("unroll") for (int k = 0; k < 2; ++k) dst[m][k] = *(const PG8_LAS bf16x8*)(lds + PG8_SA(b, h) + aoff + m * 2048 + k * 1024); } while (0)
#define PG8_LDB(dst, b, h) do { _Pragma("unroll") for (int n = 0; n < 2; ++n) _Pragma("unroll") for (int k = 0; k < 2; ++k) dst[n][k] = *(const PG8_LAS bf16x8*)(lds + PG8_SB(b, h) + boff + n * 2048 + k * 1024); } while (0)
#define PG8_MMA(ai, bj, At, Bt) do { __builtin_amdgcn_s_setprio(1); _Pragma("unroll") for (int m = 0; m < 4; ++m) _Pragma("unroll") for (int n = 0; n < 2; ++n) _Pragma("unroll") for (int k = 0; k < 2; ++k) \
        acc[ai][bj][m][n] = __builtin_amdgcn_mfma_f32_16x16x32_bf16(Bt[n][k], At[m][k], acc[ai][bj][m][n], 0, 0, 0); __builtin_amdgcn_s_setprio(0); } while (0)
#define PG8_WAIT_V(n) asm volatile("s_waitcnt vmcnt(" #n ")" ::: "memory")
#define PG8_WAIT_L(n) asm volatile("s_waitcnt lgkmcnt(" #n ")" ::: "memory")
#define PG8_BAR __builtin_amdgcn_s_barrier()
#define PG8_SCHED __builtin_amdgcn_sched_barrier(0)
    Unit cur, nxt; int ui = 0;
    if (!S.next(0, cur)) return;
    f32x4 acc[2][2][4][2];
#pragma unroll
    for (int a = 0; a < 2; ++a)
#pragma unroll
        for (int b = 0; b < 2; ++b)
#pragma unroll
            for (int m = 0; m < 4; ++m)
#pragma unroll
                for (int n = 0; n < 2; ++n) acc[a][b][m][n] = (f32x4){0.f, 0.f, 0.f, 0.f};
    bf16x8 At[4][2], B0[2][2], B1[2][2];
    const char* cA = (const char*)g.A + cur.aoff; const char* cB = (const char*)g.Bt + cur.boff;
    PG8_STAGE(PG8_SB(0, 0), cB, voffB); PG8_STAGE(PG8_SA(0, 0), cA, voffA); PG8_STAGE(PG8_SB(0, 1), cB + hstepB, voffB); PG8_STAGE(PG8_SA(0, 1), cA + hstepA, voffA);
    if (wr == 1) PG8_BAR;
    PG8_WAIT_V(4); PG8_BAR;
    PG8_STAGE(PG8_SB(1, 0), cB + kstep, voffB); PG8_STAGE(PG8_SA(1, 0), cA + kstep, voffA); PG8_STAGE(PG8_SB(1, 1), cB + hstepB + kstep, voffB);
    PG8_WAIT_V(6); PG8_BAR;
    for (;;) {
        const bool has_next = S.next(ui + 1, nxt);
        const char* nA = has_next ? (const char*)g.A + nxt.aoff : cA; const char* nB = has_next ? (const char*)g.Bt + nxt.boff : cB;
_Pragma("unroll 1")
        for (int t = 0; t < nt; t += 2) {
            const bool last = (t == nt - 2);
            const char* a1 = cA + (size_t)(t + 1) * kstep;
            const char* a2 = last ? nA : cA + (size_t)(t + 2) * kstep; const char* b2 = last ? nB : cB + (size_t)(t + 2) * kstep;
            const char* a3 = a2 + kstep; const char* b3 = b2 + kstep;
            PG8_LDB(B0, 0, 0); PG8_SCHED; PG8_LDA(At, 0, 0); PG8_STAGE(PG8_SA(1, 1), a1 + hstepA, voffA);
            PG8_WAIT_L(8); PG8_BAR; PG8_WAIT_L(0); PG8_MMA(0, 0, At, B0); PG8_BAR; PG8_SCHED;
            PG8_LDB(B1, 0, 1); PG8_STAGE(PG8_SB(0, 0), b2, voffB);
            PG8_BAR; PG8_WAIT_L(0); PG8_MMA(0, 1, At, B1); PG8_BAR;
            PG8_LDA(At, 0, 1); PG8_STAGE(PG8_SA(0, 0), a2, voffA);
            PG8_BAR; PG8_WAIT_L(0); PG8_MMA(1, 0, At, B0); PG8_BAR; PG8_SCHED;
            PG8_STAGE(PG8_SB(0, 1), b2 + hstepB, voffB);
            PG8_WAIT_V(6); PG8_BAR; PG8_MMA(1, 1, At, B1); PG8_BAR;
            PG8_LDB(B0, 1, 0); PG8_SCHED; PG8_LDA(At, 1, 0); PG8_STAGE(PG8_SA(0, 1), a2 + hstepA, voffA);
            PG8_WAIT_L(8); PG8_BAR; PG8_WAIT_L(0); PG8_MMA(0, 0, At, B0); PG8_BAR; PG8_SCHED;
            PG8_LDB(B1, 1, 1); PG8_STAGE(PG8_SB(1, 0), b3, voffB);
            PG8_BAR; PG8_WAIT_L(0); PG8_MMA(0, 1, At, B1); PG8_BAR;
            PG8_LDA(At, 1, 1); PG8_STAGE(PG8_SA(1, 0), a3, voffA);
            PG8_BAR; PG8_WAIT_L(0); PG8_MMA(1, 0, At, B0); PG8_BAR; PG8_SCHED;
            PG8_STAGE(PG8_SB(1, 1), b3 + hstepB, voffB);
            PG8_WAIT_V(6); PG8_BAR; PG8_MMA(1, 1, At, B1); PG8_BAR;
        }
        run_epi(E, acc, cur, wr, wc, fr, fq);
        if (!has_next) break;
#pragma unroll
        for (int a = 0; a < 2; ++a)
#pragma unroll
            for (int b = 0; b < 2; ++b)
#pragma unroll
                for (int m = 0; m < 4; ++m)
#pragma unroll
                    for (int n = 0; n < 2; ++n) acc[a][b][m][n] = (f32x4){0.f, 0.f, 0.f, 0.f};
        cur = nxt; cA = nA; cB = nB; ++ui;
    }
    PG8_WAIT_V(0);
    if (wr == 0) PG8_BAR;
    PG8_BAR;
#undef PG8_SA
#undef PG8_SB
#undef PG8_STAGE
#undef PG8_LDA
#undef PG8_LDB
#undef PG8_MMA
#undef PG8_WAIT_V
#undef PG8_WAIT_L
#undef PG8_BAR
#undef PG8_SCHED
}
struct DenseOrder {
    int nM, nN, G, c; long astep, bstep;
    __device__ __forceinline__ bool next(int i, Unit& u) const {
        const long L = (long)i * G + c; if (L >= (long)nM * nN) return false;
        const int w = (int)L; const int nig = 8 * nN, gid = w / nig, fm = gid * 8, gsz = (nM - fm) < 8 ? (nM - fm) : 8;
        u.pm = fm + ((w % nig) % gsz); u.pn = (w % nig) / gsz; u.aoff = (long)u.pm * astep; u.boff = (long)u.pn * bstep; return true; }
};
struct MoeOrder {
    const PG8_LAS int* tbl; int nM, nN, G, c; long astep, bstep, estep;
    __device__ __forceinline__ bool next(int i, Unit& u) const {
        const long L = (long)i * G + c; if (L >= (long)nM * nN) return false;
        const int w = (int)L; u.pm = w / nN; u.pn = w % nN; const int e = tbl[u.pm];
        u.aoff = (long)u.pm * astep; u.boff = (long)e * estep + (long)u.pn * bstep; return true; }
};
}
#endif

#ifndef CPU_TEST
namespace att {
typedef short bf16x8 __attribute__((ext_vector_type(8)));
typedef short s16x4 __attribute__((ext_vector_type(4)));
typedef float f32x16 __attribute__((ext_vector_type(16)));
typedef float f32x2_t __attribute__((ext_vector_type(2))); typedef __bf16 bf16x2_t __attribute__((ext_vector_type(2)));
typedef unsigned u32x4 __attribute__((ext_vector_type(4)));
typedef unsigned u32x2 __attribute__((ext_vector_type(2)));
#define ATT_LAS __attribute__((address_space(3)))
constexpr int KP = 104, VP = 68;
constexpr int KBUF = 64 * KP * 2, VBUF = 64 * VP * 2;
constexpr int LDS_NEED = 2 * KBUF + 2 * VBUF;
__device__ __forceinline__ unsigned cvtpk(float lo, float hi) { f32x2_t v = {lo, hi}; bf16x2_t b = __builtin_convertvector(v, bf16x2_t); return __builtin_bit_cast(unsigned, b); }
__device__ __forceinline__ int crow(int r, int hi) { return (r & 3) + 8 * (r >> 2) + 4 * hi; }
__device__ __forceinline__ void unit(ATT_LAS unsigned char* lds, const bf16_t* Q, const bf16_t* K, const bf16_t* V, bf16_t* mix, int b, int h, int qb) {
    int tid = threadIdx.x; asm volatile("" : "+v"(tid));
    const int lane = tid & 63, w = __builtin_amdgcn_readfirstlane(tid >> 6), r32 = lane & 31, hi = lane >> 5;
    const size_t tb = (size_t)b * SEQ;
    const int q = qb * 256 + w * 32 + r32;
    bf16x8 qr[6];
    { const bf16_t* qrow = Q + (tb + q) * 384 + h * 96 + 8 * hi;
#pragma unroll
      for (int ks = 0; ks < 6; ++ks) qr[ks] = *(const bf16x8*)(qrow + 16 * ks); }
    f32x16 o0, o1;
#pragma unroll
    for (int r = 0; r < 16; ++r) { o0[r] = 0.f; o1[r] = 0.f; }
    float m = -1e30f, lsum = 0.f;
    const int NT = 4 * (qb + 1);
    const int kr0 = tid / 12, kp0 = tid % 12, kr1 = (tid + 512) / 12, kp1 = (tid + 512) % 12; const bool has1 = tid < 256;
    const int vk = tid >> 3, vp = tid & 7;
    const bf16_t* gK0 = K + (tb + kr0) * 384 + h * 96 + kp0 * 8; const bf16_t* gK1 = K + (tb + kr1) * 384 + h * 96 + kp1 * 8;
    const bf16_t* gV = V + (tb + vk) * 256 + h * 64 + vp * 8;
    u32x4 sk0, sk1, sv; sk1 = (u32x4){0u, 0u, 0u, 0u};
    sk0 = *(const u32x4*)gK0; if (has1) sk1 = *(const u32x4*)gK1; sv = *(const u32x4*)gV;
#define ATT_WRITE(buf) do { \
        *(ATT_LAS u32x4*)(lds + (buf) * KBUF + (kr0 * KP + kp0 * 8) * 2) = sk0; \
        if (has1) *(ATT_LAS u32x4*)(lds + (buf) * KBUF + (kr1 * KP + kp1 * 8) * 2) = sk1; \
        ATT_LAS unsigned short* vt_ = (ATT_LAS unsigned short*)(lds + 2 * KBUF + (buf) * VBUF); \
        _Pragma("unroll") for (int j = 0; j < 4; ++j) { vt_[(8 * vp + 2 * j) * VP + vk] = (unsigned short)(sv[j] & 0xffffu); vt_[(8 * vp + 2 * j + 1) * VP + vk] = (unsigned short)(sv[j] >> 16); } } while (0)
    ATT_WRITE(0);
    __syncthreads();
    for (int t = 0; t < NT; ++t) {
        const int buf = t & 1;
        if (t + 1 < NT) { const size_t adv = (size_t)(t + 1) * 64; sk0 = *(const u32x4*)(gK0 + adv * 384); if (has1) sk1 = *(const u32x4*)(gK1 + adv * 384); sv = *(const u32x4*)(gV + adv * 256); }
        f32x16 p0, p1;
#pragma unroll
        for (int r = 0; r < 16; ++r) { p0[r] = 0.f; p1[r] = 0.f; }
        { ATT_LAS const unsigned char* kb = lds + buf * KBUF + (r32 * KP + 8 * hi) * 2;
#pragma unroll
          for (int ks = 0; ks < 6; ++ks) { const bf16x8 a0 = *(ATT_LAS const bf16x8*)(kb + ks * 32), a1 = *(ATT_LAS const bf16x8*)(kb + 32 * KP * 2 + ks * 32);
              p0 = __builtin_amdgcn_mfma_f32_32x32x16_bf16(a0, qr[ks], p0, 0, 0, 0); p1 = __builtin_amdgcn_mfma_f32_32x32x16_bf16(a1, qr[ks], p1, 0, 0, 0); } }
        if (t >= NT - 4) {
            const int k0 = t * 64;
#pragma unroll
            for (int r = 0; r < 16; ++r) { const int kk = k0 + crow(r, hi); if (kk > q) p0[r] = -1e30f; if (kk + 32 > q) p1[r] = -1e30f; } }
        float rm = p0[0];
#pragma unroll
        for (int r = 1; r < 16; ++r) rm = fmaxf(rm, p0[r]);
#pragma unroll
        for (int r = 0; r < 16; ++r) rm = fmaxf(rm, p1[r]);
        rm = fmaxf(rm, __shfl_xor(rm, 32));
        const float mn = fmaxf(m, rm); const float alpha = __builtin_amdgcn_exp2f(m - mn); m = mn;
        float ps = 0.f;
#pragma unroll
        for (int r = 0; r < 16; ++r) { p0[r] = __builtin_amdgcn_exp2f(p0[r] - mn); p1[r] = __builtin_amdgcn_exp2f(p1[r] - mn); ps += p0[r] + p1[r]; }
        lsum = lsum * alpha + ps;
#pragma unroll
        for (int r = 0; r < 16; ++r) { o0[r] *= alpha; o1[r] *= alpha; }
        { ATT_LAS const unsigned char* vb = lds + 2 * KBUF + buf * VBUF + (r32 * VP + 4 * hi) * 2;
#pragma unroll
          for (int s = 0; s < 4; ++s) {
              u32x4 pw;
              if (s == 0) pw = (u32x4){cvtpk(p0[0], p0[1]), cvtpk(p0[2], p0[3]), cvtpk(p0[4], p0[5]), cvtpk(p0[6], p0[7])};
              else if (s == 1) pw = (u32x4){cvtpk(p0[8], p0[9]), cvtpk(p0[10], p0[11]), cvtpk(p0[12], p0[13]), cvtpk(p0[14], p0[15])};
              else if (s == 2) pw = (u32x4){cvtpk(p1[0], p1[1]), cvtpk(p1[2], p1[3]), cvtpk(p1[4], p1[5]), cvtpk(p1[6], p1[7])};
              else pw = (u32x4){cvtpk(p1[8], p1[9]), cvtpk(p1[10], p1[11]), cvtpk(p1[12], p1[13]), cvtpk(p1[14], p1[15])};
              const bf16x8 pb = __builtin_bit_cast(bf16x8, pw);
              const u32x2 a00 = *(ATT_LAS const u32x2*)(vb + s * 32), a01 = *(ATT_LAS const u32x2*)(vb + s * 32 + 16);
              const u32x2 a10 = *(ATT_LAS const u32x2*)(vb + 32 * VP * 2 + s * 32), a11 = *(ATT_LAS const u32x2*)(vb + 32 * VP * 2 + s * 32 + 16);
              const bf16x8 va0 = __builtin_bit_cast(bf16x8, (u32x4){a00[0], a00[1], a01[0], a01[1]}), va1 = __builtin_bit_cast(bf16x8, (u32x4){a10[0], a10[1], a11[0], a11[1]});
              o0 = __builtin_amdgcn_mfma_f32_32x32x16_bf16(va0, pb, o0, 0, 0, 0); o1 = __builtin_amdgcn_mfma_f32_32x32x16_bf16(va1, pb, o1, 0, 0, 0); } }
        if (t + 1 < NT) ATT_WRITE(buf ^ 1);
        __syncthreads();
    }
#undef ATT_WRITE
    lsum += __shfl_xor(lsum, 32);
    const float inv = 1.f / lsum;
    bf16_t* orow = mix + (tb + q) * DMIX + 768 + h * 64;
#pragma unroll
    for (int rg = 0; rg < 4; ++rg) {
        u32x2 w0 = {cvtpk(o0[4 * rg] * inv, o0[4 * rg + 1] * inv), cvtpk(o0[4 * rg + 2] * inv, o0[4 * rg + 3] * inv)};
        u32x2 w1 = {cvtpk(o1[4 * rg] * inv, o1[4 * rg + 1] * inv), cvtpk(o1[4 * rg + 2] * inv, o1[4 * rg + 3] * inv)};
        *(u32x2*)(orow + 8 * rg + 4 * hi) = w0; *(u32x2*)(orow + 32 + 8 * rg + 4 * hi) = w1; }
}
}
#endif

constexpr int PH_PER_LAYER = 12;
constexpr int NPHASES = DEPTH * PH_PER_LAYER;

#ifndef CPU_TEST
#define XB_TMO      128
#define XB_XCNT(j)  (256  + 64 * (j))
#define XB_XSUB(j)  (1280 + 64 * (j))
#define XB_XGEN(j)  (2304 + 64 * (j))
#define XB_TOP      3328
#define XB_TOPGEN   3392
#define XCD_BAR_WORDS 3456
#define XB_SPIN_CAP (1u << 18)
#define LAS __attribute__((address_space(3)))
__device__ __forceinline__ unsigned xb_ld(unsigned* p)              { return __hip_atomic_load(p, __ATOMIC_RELAXED, __HIP_MEMORY_SCOPE_AGENT); }
__device__ __forceinline__ unsigned xb_add(unsigned* p, unsigned v) { return __hip_atomic_fetch_add(p, v, __ATOMIC_RELAXED, __HIP_MEMORY_SCOPE_AGENT); }
__device__ __forceinline__ unsigned xb_xcc_id() { return (unsigned)__builtin_amdgcn_s_getreg((3 << 11) | 20) & 0xFu; }
#define XB_SPIN(cond, bar) do { unsigned _sp = 0; while (cond) { __builtin_amdgcn_s_sleep(1); \
    if ((++_sp & 255u) == 0u) { if (xb_ld(&(bar)[XB_TMO])) break; if (_sp > XB_SPIN_CAP) { atomicAdd(&(bar)[XB_TMO], 1u); break; } } } } while (0)
struct XcdBarrier { unsigned* bar; unsigned x; volatile LAS unsigned* st; };
__device__ __forceinline__ XcdBarrier xcd_barrier_post(unsigned* bar, volatile LAS unsigned* st) {
    XcdBarrier b; b.bar = bar; b.x = xb_xcc_id(); b.st = st;
    if (threadIdx.x == 0) (void)xb_add(&bar[XB_XCNT(b.x)], 1u);
    return b;
}
__device__ __forceinline__ void xcd_barrier_complete(unsigned* bar, unsigned x, unsigned& nloc, unsigned& nx) {
    const unsigned G = gridDim.x * gridDim.y * gridDim.z;
    unsigned sum, cnt, mine, sp = 0u;
    for (;;) {
        sum = 0u; cnt = 0u; mine = 0u;
#pragma unroll
        for (unsigned j = 0; j < 16; ++j) { const unsigned c = xb_ld(&bar[XB_XCNT(j)]); sum += c; cnt += (c > 0u) ? 1u : 0u; mine = (j == x) ? c : mine; }
        if (sum == G) break;
        __builtin_amdgcn_s_sleep(1);
        if ((++sp & 255u) == 0u) { if (xb_ld(&bar[XB_TMO])) break; if (sp > XB_SPIN_CAP) { atomicAdd(&bar[XB_TMO], 1u); break; } }
    }
    nloc = mine > 0u ? mine : 1u; nx = cnt > 0u ? cnt : 1u;
}
__device__ __forceinline__ void xcd_barrier(const XcdBarrier& b) {
    asm volatile("s_waitcnt vmcnt(0)" ::: "memory");
    __syncthreads();
    if (threadIdx.x == 0) {
        unsigned* bar = b.bar;
        __builtin_amdgcn_s_waitcnt(0);
        unsigned nloc = b.st[0], nx = b.st[1];
        if (nloc == 0u) { xcd_barrier_complete(bar, b.x, nloc, nx); b.st[0] = nloc; b.st[1] = nx; }
        const unsigned old = xb_add(&bar[XB_XSUB(b.x)], 1u);
        const unsigned gen = old / nloc;
        if (old + 1u == (gen + 1u) * nloc) {
            __builtin_amdgcn_fence(__ATOMIC_RELEASE, "agent");
            asm volatile("s_waitcnt vmcnt(0)" ::: "memory");
            const unsigned og = xb_add(&bar[XB_TOP], 1u);
            const unsigned tg = og / nx;
            if (og + 1u == (tg + 1u) * nx) xb_add(&bar[XB_TOPGEN], 1u);
            else XB_SPIN(xb_ld(&bar[XB_TOPGEN]) == tg, bar);
            __builtin_amdgcn_fence(__ATOMIC_ACQUIRE, "agent");
            xb_add(&bar[XB_XGEN(b.x)], 1u);
            asm volatile("s_waitcnt vmcnt(0)" ::: "memory");
        } else {
            XB_SPIN(xb_ld(&bar[XB_XGEN(b.x)]) == gen, bar);
            __builtin_amdgcn_fence(__ATOMIC_ACQUIRE, "agent");
            asm volatile("s_waitcnt vmcnt(0)" ::: "memory");
        }
    }
    __syncthreads();
}

constexpr int NWAVES = 8;
constexpr int RING_BYTES = 131072, MISC_OFF = RING_BYTES + 320, LDS_BYTES = 147456;
struct Args { Ctx C; int ph_lo, ph_hi; };
__device__ __forceinline__ int moe_fill_table(const Ctx& C, int l, LAS int* tbl, int tid) {
    const unsigned* cnt = WSP(unsigned, WS_CTL) + CW_CNT + l * NEXP * 64;
    int e, be, ce; const int total = moe_lookup(cnt, tid * 256, e, be, ce);
    if (tid < 320) tbl[tid] = e;
    __syncthreads();
    return total >> 8;
}

__global__ void __launch_bounds__(NWAVES * 64, 2) mega(Args args) {
    extern __shared__ __attribute__((aligned(16))) unsigned char lds_raw[];
    LAS unsigned char* lds = (LAS unsigned char*)lds_raw;
    const Ctx& C = args.C;
    const int G = gridDim.x, bx = blockIdx.x;
    const int ngw = G * NWAVES;
    volatile LAS unsigned* MISC = (volatile LAS unsigned*)(lds + MISC_OFF);
    for (int i = threadIdx.x; i < (LDS_BYTES - RING_BYTES) / 4; i += NWAVES * 64) ((LAS unsigned*)(lds + RING_BYTES))[i] = 0u;
    __syncthreads();
    XcdBarrier bar = xcd_barrier_post(WSP(unsigned, WS_CTL) + CW_BAR, MISC + 8);
    LAS int* tbl = (LAS int*)(lds + RING_BYTES + 1024);
    const int lo = args.ph_lo, hi = args.ph_hi;

    for (int l = 0; l < DEPTH; ++l) {
        const int p0 = l * PH_PER_LAYER;
#ifndef PHASE_MASK
#define PHASE_MASK 0xFFF
#endif
#define IN(k) (((PHASE_MASK >> (k)) & 1) && lo <= p0 + (k) && p0 + (k) < hi)
#define LAUNDER() int tid = threadIdx.x; asm volatile("" : "+v"(tid)); const int lane = tid & 63; const int wave = __builtin_amdgcn_readfirstlane(tid >> 6); const int gw = bx * NWAVES + wave; (void)gw; (void)lane; \
        wsh_t wsh = (wsh_t)(lds + wave * 16384); (void)wsh
#define SEAM(k) do { if (p0 + (k) + 1 < hi) xcd_barrier(bar); } while (0)
        if (IN(0)) { LAUNDER(); stage_convert(C, l, gw, ngw, lane, wsh); SEAM(0); }
        if (IN(1)) { LAUNDER();
            pg8::Gemm g{WSP(bf16_t, WS_XB), WSP(bf16_t, WS_WIN), DM, DM, DM};
            pg8::DenseOrder S{T / 256, DINP / 256, G, bx, (long)256 * DM * 2, (long)256 * DM * 2};
            EpiU E{WSP(bf16_t, WS_U)};
            pg8::gemm_phase(lds, g, S, E); SEAM(1); }
        if (IN(2)) { LAUNDER(); stage_prep(C, l, gw, ngw, lane, wsh); SEAM(2); }
        if (IN(3)) { LAUNDER();
            if (bx < 97) {
                if (wave == 0) {
                    if (bx < 32) rwkv_scan_thread(C, bx >> 2, bx & 3, lane);
                    else if (bx < 64) gla_scan_thread(C, (bx - 32) >> 2, (bx - 32) & 3, lane);
                    else if (bx < 96) mlstm_scan_thread(C, (bx - 64) >> 2, (bx - 64) & 3, lane);
                    else if (lane < 32) mlstm_scan_thread(C, lane >> 2, lane & 3, 64);
                }
            } else {
                LAS int* slot = (LAS int*)(lds + RING_BYTES + 512);
                unsigned* ctr = WSP(unsigned, WS_CTL) + CW_ATT + l * 64;
                constexpr int NQB = SEQ / 256, NUNIT = BATCH * NH * NQB;
                for (;;) {
                    if (tid == 0) *slot = (int)atomicAdd(ctr, 1u);
                    __syncthreads();
                    const int uidx = *slot;
                    __syncthreads();
                    if (uidx >= NUNIT) break;
                    const int qb = NQB - 1 - uidx / (BATCH * NH), bh = uidx % (BATCH * NH);
                    att::unit(lds, WSP(bf16_t, WS_AQ), WSP(bf16_t, WS_AK), WSP(bf16_t, WS_AV), WSP(bf16_t, WS_MIX), bh >> 2, bh & 3, qb);
                }
            }
            SEAM(3); }
        if (IN(4)) { LAUNDER(); stage_post(C, l, gw, ngw, lane); SEAM(4); }
        if (IN(5)) { LAUNDER();
            pg8::Gemm g{WSP(bf16_t, WS_MIX), WSP(bf16_t, WS_WOUT), DMIX, DMIX, DMIX};
            pg8::DenseOrder S{T / 256, DM / 256, G, bx, (long)256 * DMIX * 2, (long)256 * DMIX * 2};
            EpiPre1 E{l == 0 ? INF(I_X) : WSP(float, WS_X), C.out};
            pg8::gemm_phase(lds, g, S, E); SEAM(5); }
        if (IN(6)) { LAUNDER(); stage_ln1_router(C, l, gw, ngw, lane, wsh); SEAM(6); }
        if (IN(7)) { LAUNDER();
            stage_gather(C, l, gw, ngw, lane);
            pg8::Gemm g{WSP(bf16_t, WS_PB), WSP(bf16_t, WS_WP), DPLE, DPLE, DPLE};
            pg8::DenseOrder S{T / 256, DM / 256, G, bx, (long)256 * DPLE * 2, (long)256 * DPLE * 2};
            EpiPP E{WSP(bf16_t, WS_PP)};
            pg8::gemm_phase(lds, g, S, E); SEAM(7); }
        if (IN(8)) { LAUNDER();
            pg8::Gemm g{WSP(bf16_t, WS_XG), WSP(bf16_t, WS_WGU), DM, DM, DM};
            const int ntile = moe_fill_table(C, l, tbl, tid);
            pg8::MoeOrder S{tbl, ntile, 2 * DEXP / 256, G, bx, (long)256 * DM * 2, (long)256 * DM * 2, (long)2 * DEXP * DM * 2};
            EpiH E{WSP(bf16_t, WS_H)};
            pg8::gemm_phase(lds, g, S, E); SEAM(8); }
        if (IN(9)) { LAUNDER();
            pg8::Gemm g{WSP(bf16_t, WS_H), WSP(bf16_t, WS_WD), DEXP, DEXP, DEXP};
            const int ntile = moe_fill_table(C, l, tbl, tid);
            pg8::MoeOrder S{tbl, ntile, DM / 256, G, bx, (long)256 * DEXP * 2, (long)256 * DEXP * 2, (long)DM * DEXP * 2};
            EpiY E{WSP(int, WS_ROWINFO), WSP(float, WS_ROWGATE), WSP(bf16_t, WS_YBUF)};
            pg8::gemm_phase(lds, g, S, E); SEAM(9); }
        if (IN(10)) { LAUNDER();
            pg8::Gemm g{WSP(bf16_t, WS_XB), WSP(bf16_t, WS_WPG), DM, DM, DM};
            pg8::DenseOrder S{T / 256, DM / 256, G, bx, (long)256 * DM * 2, (long)256 * DM * 2};
            EpiPre2 E{C.out, WSP(bf16_t, WS_YBUF), WSP(bf16_t, WS_PP), INF(I_PLEBG) + l * DM, WSP(float, WS_X)};
            pg8::gemm_phase(lds, g, S, E); SEAM(10); }
        if (IN(11)) { LAUNDER(); stage_ln2(C, l, gw, ngw, lane); SEAM(11); }
#undef IN
#undef SEAM
    }
}

extern "C" void kernel_launch(void* const* d_in, const int* in_sizes, int n_in, void* d_out, int out_size, void* d_ws, size_t ws_size, hipStream_t stream) {
    static int grid = 0;
    if (grid == 0) {
        if (n_in != N_IN || out_size != T * DM || ws_size < WS_END) { fprintf(stderr, "kernel_launch: bad sizes n_in %d out %d ws %zu need %zu\n", n_in, out_size, ws_size, (size_t)WS_END); grid = -1; return; }
        int dev = 0, cus = 0, per_cu = 0;
        hipGetDevice(&dev); hipDeviceGetAttribute(&cus, hipDeviceAttributeMultiprocessorCount, dev);
        if (hipFuncSetAttribute((const void*)mega, hipFuncAttributeMaxDynamicSharedMemorySize, LDS_BYTES) != hipSuccess) { fprintf(stderr, "hipFuncSetAttribute failed\n"); grid = -1; return; }
        if (hipOccupancyMaxActiveBlocksPerMultiprocessor(&per_cu, (const void*)mega, NWAVES * 64, LDS_BYTES) != hipSuccess || per_cu < 1) { fprintf(stderr, "occupancy query: %d\n", per_cu); }
        (void)hipGetLastError();
        grid = cus;
    }
    if (grid < 0) return;
    hipMemsetAsync((char*)d_ws + WS_CTL, 0, CTL_BYTES, stream);
    Args a{};
    for (int i = 0; i < N_IN; ++i) a.C.in[i] = d_in[i];
    a.C.out = (float*)d_out; a.C.ws = (unsigned char*)d_ws;
#ifndef ONE_LAUNCH
    for (int ph = 0; ph < NPHASES; ++ph) { a.ph_lo = ph; a.ph_hi = ph + 1; hipLaunchKernelGGL(mega, dim3(grid), dim3(NWAVES * 64), LDS_BYTES, stream, a); }
#else
    a.ph_lo = 0; a.ph_hi = NPHASES; hipLaunchKernelGGL(mega, dim3(grid), dim3(NWAVES * 64), LDS_BYTES, stream, a);
#endif
}
#else
template <class E> static void cpu_gemm(const bf16_t* A, int lda, const bf16_t* Bt, int ldb, int K, int M, int N, const E& e, const int* base = nullptr, long estep = 0) {
    for (int row = 0; row < M; ++row) {
        const bf16_t* B = Bt;
        if (base) B = Bt + (size_t)moe_expert_of_row(base, row) * estep;
        if constexpr (E::MODE == 1) {
            for (int hc = 0; hc < N / 2; hc += 8) { float g[8], u[8];
                for (int j = 0; j < 8; ++j) { float ag = 0.f, au = 0.f; const bf16_t* bg = B + (size_t)rowmap(1, hc + j) * ldb; const bf16_t* bu = B + (size_t)rowmap(2, hc + j) * ldb;
                    for (int k = 0; k < K; ++k) { const float a = bf2f(A[(size_t)row * lda + k]); ag += a * bf2f(bg[k]); au += a * bf2f(bu[k]); } g[j] = ag; u[j] = au; }
                e.put8gu(row, hc, g, u); }
        } else if constexpr (E::PERM) {
            for (int c = 0; c < N; c += 8) { float a8[8];
                for (int j = 0; j < 8; ++j) { float acc = 0.f; for (int k = 0; k < K; ++k) acc += bf2f(A[(size_t)row * lda + k]) * bf2f(B[(size_t)(c + j) * ldb + k]); a8[j] = acc; }
                e.put8(row, c, a8); }
        } else {
            for (int c = 0; c < N; c += 4) { float a4[4];
                for (int j = 0; j < 4; ++j) { float acc = 0.f; for (int k = 0; k < K; ++k) acc += bf2f(A[(size_t)row * lda + k]) * bf2f(B[(size_t)(c + j) * ldb + k]); a4[j] = acc; }
                e.put4(row, c, a4); }
        }
    }
}
static void cpu_forward(const Ctx& C) {
    static float shbuf[4096];
    for (int l = 0; l < DEPTH; ++l) {
        stage_convert(C, l, 0, 1, 0, shbuf);
        { EpiU E{WSP(bf16_t, WS_U)}; cpu_gemm(WSP(bf16_t, WS_XB), DM, WSP(bf16_t, WS_WIN), DM, DM, T, DINP, E); }
        stage_prep(C, l, 0, 1, 0, shbuf);
        for (int b = 0; b < BATCH; ++b) for (int h = 0; h < NH; ++h) {
            for (int v = 0; v < 64; ++v) { rwkv_scan_thread(C, b, h, v); gla_scan_thread(C, b, h, v); }
            for (int e = 0; e < 65; ++e) mlstm_scan_thread(C, b, h, e);
            for (int q = 0; q < SEQ; ++q) attn_thread(C, b, h, q, q); }
        stage_post(C, l, 0, 1, 0);
        { EpiPre1 E{l == 0 ? INF(I_X) : WSP(float, WS_X), C.out}; cpu_gemm(WSP(bf16_t, WS_MIX), DMIX, WSP(bf16_t, WS_WOUT), DMIX, DMIX, T, DM, E); }
        stage_ln1_router(C, l, 0, 1, 0, shbuf);
        stage_gather(C, l, 0, 1, 0);
        { EpiPP E{WSP(bf16_t, WS_PP)}; cpu_gemm(WSP(bf16_t, WS_PB), DPLE, WSP(bf16_t, WS_WP), DPLE, DPLE, T, DM, E); }
        int base[NEXP + 1]; moe_bases(C, l, base);
        { EpiH E{WSP(bf16_t, WS_H)}; cpu_gemm(WSP(bf16_t, WS_XG), DM, WSP(bf16_t, WS_WGU), DM, DM, base[NEXP], 2 * DEXP, E, base, (long)2 * DEXP * DM); }
        { EpiY E{WSP(int, WS_ROWINFO), WSP(float, WS_ROWGATE), WSP(bf16_t, WS_YBUF)}; cpu_gemm(WSP(bf16_t, WS_H), DEXP, WSP(bf16_t, WS_WD), DEXP, DEXP, base[NEXP], DM, E, base, (long)DM * DEXP); }
        { EpiPre2 E{C.out, WSP(bf16_t, WS_YBUF), WSP(bf16_t, WS_PP), INF(I_PLEBG) + l * DM, WSP(float, WS_X)}; cpu_gemm(WSP(bf16_t, WS_XB), DM, WSP(bf16_t, WS_WPG), DM, DM, T, DM, E); }
        stage_ln2(C, l, 0, 1, 0);
    }
}
#endif
```

```cpp
#ifndef CPU_TEST
#include <hip/hip_runtime.h>
#include <cstdio>
#include <cstdint>
#define HD __device__ __forceinline__
#define HDM __device__ __forceinline__
#define LANES 64
#else
#include <cmath>
#include <cstdio>
#include <cstdint>
#include <cstring>
#include <algorithm>
#define HD static inline
#define HDM inline
#define LANES 1
#endif

#define ONE_LAUNCH 1
#ifndef CFG_SMALL
constexpr int BATCH = 8, SEQ = 4096, DM = 1024, DEPTH = 4, DPLE = 256, DEXP = 512;
#else
constexpr int BATCH = 2, SEQ = 256, DM = 128, DEPTH = 2, DPLE = 32, DEXP = 128;
#endif
constexpr int T = BATCH * SEQ;
constexpr int DMIX = 1024, GW = 256, HD64 = 64, NH = 4;
constexpr int DIN = 3128, DINP = 3328;
constexpr int UA = 0, UA_R = 0, UA_K = 256, UA_V = 512, UA_WD = 768, UA_AD = 800, UA_GD = 832, DINA = 896;
constexpr int UB = 896, UB_Q = 896, UB_K = 1024, UB_V = 1152, UB_AD = 1408, UB_G = 1424;
constexpr int UC = 1680, UC_Q = 1680, UC_K = 1936, UC_V = 2192, UC_O = 2448, UC_IG = 2704, UC_FG = 2708;
constexpr int UD = 2712, UD_CQ = 2712, UD_CKV = 2968, UD_KR = 3096;
constexpr int NEXP = 32, NGRP = 4, EPG = 8;
constexpr int MAXROWS = 2 * T + NEXP * 256;
constexpr float DN_ALPHA = 1.681792830507429f;
constexpr float LN_EPS = 1e-5f, NORM_EPS = 1e-6f, RWKV_GN_EPS = 64e-5f;
static_assert(DEPTH == 4 || DEPTH == 2, "alpha below assumes depth");
HD float dn_alpha() { return DEPTH == 4 ? 1.681792830507429f : 1.4142135623730951f; }

enum { I_X = 0, I_P, I_POS, I_WIN, I_MU, I_W0, I_WUP, I_A0, I_AUP, I_GUP, I_KK, I_KA, I_RK, I_GNG, I_GNB, I_GLA_UP, I_GLA_B, I_GLA_G,
       I_CONVW, I_CONVB, I_IB, I_FB, I_MLN_G, I_QNG, I_WUQ, I_KVNG, I_WUKV, I_WOUT, I_LN1G, I_LN1B, I_WRG, I_BRG, I_WRE, I_BRE,
       I_WG, I_WU, I_WD, I_PLEG, I_PLEBG, I_PLEW, I_LN2G, I_LN2B, N_IN };

typedef unsigned short bf16_t;
HD float bf2f(bf16_t h) { unsigned u = (unsigned)h << 16; return __builtin_bit_cast(float, u); }
HD bf16_t f2bf(float f) { unsigned u = __builtin_bit_cast(unsigned, f); return (bf16_t)((u + 0x7fffu + ((u >> 16) & 1u)) >> 16); }
HD unsigned pk2(float lo, float hi) { return (unsigned)f2bf(lo) | ((unsigned)f2bf(hi) << 16); }
typedef float f4v __attribute__((vector_size(16)));
typedef unsigned u4v __attribute__((vector_size(16)));
HD void ld8bf(const bf16_t* p, float* o) { const u4v w = *(const u4v*)p;
    for (int j = 0; j < 4; ++j) { o[2 * j] = __builtin_bit_cast(float, w[j] << 16); o[2 * j + 1] = __builtin_bit_cast(float, w[j] & 0xffff0000u); } }
HD void st8bf(bf16_t* p, const float* a) { u4v w; for (int j = 0; j < 4; ++j) w[j] = pk2(a[2 * j], a[2 * j + 1]); *(u4v*)p = w; }

constexpr size_t MiB = (size_t)1 << 20;
constexpr size_t al256(size_t x) { return (x + 255) & ~(size_t)255; }
constexpr size_t WS_CTL = 0, CTL_BYTES = 1 * MiB;
constexpr size_t WS_WIN = WS_CTL + CTL_BYTES;
constexpr size_t WS_WOUT = WS_WIN + al256((size_t)DINP * DM * 2);
constexpr size_t WS_WPG = WS_WOUT + al256((size_t)DM * DMIX * 2);
constexpr size_t WS_WP = WS_WPG + al256((size_t)DM * DM * 2);
constexpr size_t WS_WGU = WS_WP + al256((size_t)DM * DPLE * 2);
constexpr size_t WS_WD = WS_WGU + al256((size_t)NEXP * 2 * DEXP * DM * 2);
constexpr size_t WS_X = WS_WD + al256((size_t)NEXP * DM * DEXP * 2);
constexpr size_t WS_XB = WS_X + al256((size_t)T * DM * 4);
constexpr size_t WS_U = WS_XB + al256((size_t)T * DM * 2);
constexpr size_t WS_MIX = WS_U + al256((size_t)T * DINP * 2);
constexpr size_t WS_PB = WS_MIX + al256((size_t)T * DMIX * 2);
constexpr size_t WS_SCR = WS_PB + al256((size_t)T * DPLE * 2);
constexpr size_t TV = al256((size_t)T * GW * 4);
constexpr size_t WS_RW_R = WS_SCR, WS_RW_W = WS_RW_R + TV, WS_RW_K = WS_RW_W + TV, WS_RW_V = WS_RW_K + TV, WS_RW_A = WS_RW_V + TV,
                 WS_RW_B = WS_RW_A + TV, WS_RW_G = WS_RW_B + TV;
constexpr size_t WS_YA = WS_RW_G + TV, WS_YB = WS_YA + TV, WS_YC = WS_YB + TV;
constexpr size_t WS_DEN = WS_YC + TV;
constexpr size_t WS_QK = WS_DEN + al256((size_t)T * 4 * 4);
constexpr size_t WS_GA = WS_QK + al256((size_t)T * 512 * 4);
constexpr size_t WS_LG = WS_GA + al256((size_t)T * 128 * 4);
constexpr size_t WS_AQ = WS_LG + al256((size_t)T * 8 * 4);
constexpr size_t WS_AK = WS_AQ + al256((size_t)T * 384 * 2);
constexpr size_t WS_AV = WS_AK + al256((size_t)T * 384 * 2);
constexpr size_t WS_MIXER_END = WS_AV + al256((size_t)T * 256 * 2);
constexpr size_t WS_XG = WS_SCR;
constexpr size_t WS_H = WS_XG + al256((size_t)MAXROWS * DM * 2);
constexpr size_t WS_YBUF = WS_H + al256((size_t)MAXROWS * DEXP * 2);
constexpr size_t WS_PP = WS_YBUF + al256((size_t)2 * T * DM * 2);
constexpr size_t WS_TOKINFO = WS_PP + al256((size_t)T * DM * 2);
constexpr size_t WS_LIST = WS_TOKINFO + al256((size_t)T * 16);
constexpr size_t WS_ROWINFO = WS_LIST + al256((size_t)NEXP * T * 4);
constexpr size_t WS_ROWGATE = WS_ROWINFO + al256((size_t)MAXROWS * 4);
constexpr size_t WS_MOE_END = WS_ROWGATE + al256((size_t)MAXROWS * 4);
constexpr size_t WS_END = WS_MIXER_END > WS_MOE_END ? WS_MIXER_END : WS_MOE_END;
constexpr int CW_BAR = 4096;
constexpr int CW_ATT = 8192;
constexpr int CW_CNT = 16384;

struct Ctx {
    const void* in[N_IN];
    float* out;
    unsigned char* ws;
};
#define INF(i) ((const float*)C.in[i])
#define WSP(T_, off) ((T_*)(C.ws + (off)))

#ifndef CPU_TEST
HD float wave_sum(float v) {
#pragma unroll
    for (int o = 1; o < 64; o <<= 1) v += __shfl_xor(v, o);
    return v;
}
HD float wave_max(float v) {
#pragma unroll
    for (int o = 1; o < 64; o <<= 1) v = fmaxf(v, __shfl_xor(v, o));
    return v;
}
HD unsigned atom_add(unsigned* p, unsigned v) { return atomicAdd(p, v); }
#define WSYNC() __builtin_amdgcn_wave_barrier(); asm volatile("s_waitcnt lgkmcnt(0)" ::: "memory")
typedef __attribute__((address_space(3))) float* wsh_t;
#else
HD float wave_sum(float v) { return v; }
HD float wave_max(float v) { return v; }
HD unsigned atom_add(unsigned* p, unsigned v) { unsigned o = *p; *p += v; return o; }
#define WSYNC()
typedef float* wsh_t;
#endif
HD float sigmoidf_(float x) { return 1.f / (1.f + expf(-x)); }
HD float softplusf_(float x) { return x > 20.f ? x : (x < -20.f ? expf(x) : log1pf(expf(x))); }
HD float siluf_(float x) { return x * sigmoidf_(x); }

HD int rowmap(int mode, int n) { return mode == 0 ? n : (mode == 1 ? (n >> 7) * 256 + (n & 127) : (n >> 7) * 256 + 128 + (n & 127)); }
HD void transpose_item(const float* W, int K, int N, int ldw, bf16_t* WT, int ldk, int mode, int item, int lane, wsh_t scr) {
    const int nblk = (N + 31) / 32, kb = item / nblk, nb = item % nblk, k0 = 64 * kb, n0 = 32 * nb;
    for (int idx = lane; idx < 2048; idx += LANES) { const int kk = idx >> 5, nn = idx & 31; const int n = n0 + nn;
        scr[kk * 33 + nn] = (n < N) ? W[(size_t)(k0 + kk) * ldw + n] : 0.f; }
    WSYNC();
    for (int idx = lane; idx < 256; idx += LANES) { const int n = idx >> 3, c = idx & 7;
        unsigned o[4];
        for (int j = 0; j < 4; ++j) o[j] = pk2(scr[(8 * c + 2 * j) * 33 + n], scr[(8 * c + 2 * j + 1) * 33 + n]);
        unsigned* dst = (unsigned*)(WT + (size_t)rowmap(mode, n0 + n) * ldk + k0 + 8 * c);
        dst[0] = o[0]; dst[1] = o[1]; dst[2] = o[2]; dst[3] = o[3]; }
    WSYNC();
}
HD void stage_convert(const Ctx& C, int l, int gw, int ngw, int lane, wsh_t scr) {
    constexpr int NB_IN = DINP / 32;
    constexpr int I_IN = (DM / 64) * NB_IN, I_OUT = (DMIX / 64) * (DM / 32), I_PG = (DM / 64) * (DM / 32), I_PW = (DPLE / 64 > 0 ? DPLE / 64 : 1) * (DM / 32);
    constexpr int I_G1 = (DM / 64) * (DEXP / 32), I_D1 = (DEXP / 64) * (DM / 32);
    constexpr int NIT = I_IN + I_OUT + I_PG + I_PW + NEXP * (2 * I_G1 + I_D1);
    static_assert(DPLE % 32 == 0 && DEXP % 64 == 0, "shapes");
    for (int it = gw; it < NIT; it += ngw) {
        int r = it;
        if (r < I_IN) {
            const int nblk = NB_IN, kb = r / nblk, nb = r % nblk, k0 = 64 * kb, n0 = 32 * nb;
            const float* W = INF(I_WIN) + (size_t)l * DM * DIN; bf16_t* WT = WSP(bf16_t, WS_WIN);
            for (int idx = lane; idx < 2048; idx += LANES) { const int kk = idx >> 5, nn = idx & 31; const int n = n0 + nn;
                scr[kk * 33 + nn] = (n < DIN) ? W[(size_t)(k0 + kk) * DIN + n] : 0.f; }
            WSYNC();
            for (int idx = lane; idx < 256; idx += LANES) { const int n = idx >> 3, c = idx & 7; unsigned o[4];
                for (int j = 0; j < 4; ++j) o[j] = pk2(scr[(8 * c + 2 * j) * 33 + n], scr[(8 * c + 2 * j + 1) * 33 + n]);
                unsigned* dst = (unsigned*)(WT + (size_t)(n0 + n) * DM + k0 + 8 * c); dst[0] = o[0]; dst[1] = o[1]; dst[2] = o[2]; dst[3] = o[3]; }
            WSYNC();
            continue; }
        r -= I_IN;
        if (r < I_OUT) { transpose_item(INF(I_WOUT) + (size_t)l * DMIX * DM, DMIX, DM, DM, WSP(bf16_t, WS_WOUT), DMIX, 0, r, lane, scr); continue; } r -= I_OUT;
        if (r < I_PG) { transpose_item(INF(I_PLEG) + (size_t)l * DM * DM, DM, DM, DM, WSP(bf16_t, WS_WPG), DM, 0, r, lane, scr); continue; } r -= I_PG;
        if (r < I_PW) {
            if (DPLE >= 64) transpose_item(INF(I_PLEW) + (size_t)l * DPLE * DM, DPLE, DM, DM, WSP(bf16_t, WS_WP), DPLE, 0, r, lane, scr);
            continue; } r -= I_PW;
        const int e = r / (2 * I_G1 + I_D1); r -= e * (2 * I_G1 + I_D1);
        if (r < I_G1) { transpose_item(INF(I_WG) + ((size_t)l * NEXP + e) * DM * DEXP, DM, DEXP, DEXP, WSP(bf16_t, WS_WGU) + (size_t)e * 2 * DEXP * DM, DM, 1, r, lane, scr); continue; } r -= I_G1;
        if (r < I_G1) { transpose_item(INF(I_WU) + ((size_t)l * NEXP + e) * DM * DEXP, DM, DEXP, DEXP, WSP(bf16_t, WS_WGU) + (size_t)e * 2 * DEXP * DM, DM, 2, r, lane, scr); continue; } r -= I_G1;
        transpose_item(INF(I_WD) + ((size_t)l * NEXP + e) * DEXP * DM, DEXP, DM, DM, WSP(bf16_t, WS_WD) + (size_t)e * DM * DEXP, DEXP, 0, r, lane, scr);
    }
    {   const float* p = INF(I_P) + (size_t)l * T * DPLE; bf16_t* pb = WSP(bf16_t, WS_PB);
        const size_t n4 = (size_t)T * DPLE / 4;
        for (size_t i = (size_t)gw * LANES + lane; i < n4; i += (size_t)ngw * LANES) {
            const float* s = p + 4 * i; unsigned* d = (unsigned*)(pb + 4 * i); d[0] = pk2(s[0], s[1]); d[1] = pk2(s[2], s[3]); } }
    if (l == 0) { const float* x = INF(I_X); bf16_t* xb = WSP(bf16_t, WS_XB);
        const size_t n4 = (size_t)T * DM / 4;
        for (size_t i = (size_t)gw * LANES + lane; i < n4; i += (size_t)ngw * LANES) {
            const float* s = x + 4 * i; unsigned* d = (unsigned*)(xb + 4 * i); d[0] = pk2(s[0], s[1]); d[1] = pk2(s[2], s[3]); } }
#ifdef CFG_SMALL
    if (DPLE < 64) {
        const float* W = INF(I_PLEW) + (size_t)l * DPLE * DM; bf16_t* WT = WSP(bf16_t, WS_WP);
        for (int i = gw * LANES + lane; i < DPLE * DM; i += ngw * LANES) { const int k = i / DM, n = i % DM; WT[(size_t)n * DPLE + k] = f2bf(W[i]); } }
#endif
}

HD float ubf(const bf16_t* u, int t, int c) { return bf2f(u[(size_t)t * DINP + c]); }
HD void stage_prep(const Ctx& C, int l, int gw, int ngw, int lane, wsh_t sh) {
    const bf16_t* u = WSP(bf16_t, WS_U);
    const float* mu = INF(I_MU) + l * DINA; const float* w0 = INF(I_W0) + l * GW; const float* wup = INF(I_WUP) + l * 32 * GW;
    const float* a0 = INF(I_A0) + l * GW; const float* aup = INF(I_AUP) + l * 32 * GW; const float* gup = INF(I_GUP) + l * 64 * GW;
    const float* kkw = INF(I_KK) + l * GW; const float* kaw = INF(I_KA) + l * GW;
    const float* glaup = INF(I_GLA_UP) + l * 16 * 128; const float* glab = INF(I_GLA_B) + l * 128;
    const float* convw = INF(I_CONVW) + l * 4 * 512; const float* convb = INF(I_CONVB) + l * 512;
    const float* ib = INF(I_IB) + l * 4; const float* fb = INF(I_FB) + l * 4;
    const float* qng = INF(I_QNG) + l * 256; const float* wuq = INF(I_WUQ) + (size_t)l * 256 * 384;
    const float* kvng = INF(I_KVNG) + l * 128; const float* wukv = INF(I_WUKV) + (size_t)l * 128 * 512;
    const int* pos = (const int*)C.in[I_POS];
    float* oR = WSP(float, WS_RW_R); float* oW = WSP(float, WS_RW_W); float* oK = WSP(float, WS_RW_K); float* oV = WSP(float, WS_RW_V);
    float* oA = WSP(float, WS_RW_A); float* oB = WSP(float, WS_RW_B); float* oG = WSP(float, WS_RW_G);
    float* oQK = WSP(float, WS_QK); float* oGA = WSP(float, WS_GA); float* oLG = WSP(float, WS_LG);
    bf16_t* oAQ = WSP(bf16_t, WS_AQ); bf16_t* oAK = WSP(bf16_t, WS_AK); bf16_t* oAV = WSP(bf16_t, WS_AV);
    for (int t = gw; t < T; t += ngw) {
        const int s = t % SEQ;
        for (int j = lane; j < 128; j += LANES) { const int c = UA_WD + j; const float cur = ubf(u, t, c), prev = s > 0 ? ubf(u, t - 1, c) : 0.f;
            const float v = cur + (prev - cur) * mu[c]; sh[j] = j < 32 ? tanhf(v) : (j < 64 ? v : sigmoidf_(v)); }
        WSYNC();
        for (int h = 0; h < NH; ++h) {
            float kkraw[HD64 / LANES]; float kv_[HD64 / LANES], av_[HD64 / LANES]; float ss = 0.f;
            for (int i = 0; i < HD64 / LANES; ++i) { const int c = h * 64 + i * LANES + lane;
                float z = w0[c], za = a0[c], g = 0.f;
_Pragma("unroll 8")
                for (int j = 0; j < 32; ++j) { z += sh[j] * wup[j * GW + c]; za += sh[32 + j] * aup[j * GW + c]; }
_Pragma("unroll 8")
                for (int j = 0; j < 64; ++j) g += sh[64 + j] * gup[j * GW + c];
                const float lnl = -softplusf_(-z) - 0.5f; const float decay = expf(-expf(lnl)); const float a = sigmoidf_(za);
                float r, k, v;
                { const float cur = ubf(u, t, UA_R + c), prev = s > 0 ? ubf(u, t - 1, UA_R + c) : 0.f; r = cur + (prev - cur) * mu[UA_R + c]; }
                { const float cur = ubf(u, t, UA_K + c), prev = s > 0 ? ubf(u, t - 1, UA_K + c) : 0.f; k = cur + (prev - cur) * mu[UA_K + c]; }
                { const float cur = ubf(u, t, UA_V + c), prev = s > 0 ? ubf(u, t - 1, UA_V + c) : 0.f; v = cur + (prev - cur) * mu[UA_V + c]; }
                kkraw[i] = k * kkw[c]; ss += kkraw[i] * kkraw[i];
                kv_[i] = k * (1.f + (a - 1.f) * kaw[c]); av_[i] = a;
                const size_t o = (size_t)t * GW + c; oR[o] = r; oW[o] = decay; oK[o] = kv_[i]; oV[o] = v; oG[o] = g; }
            ss = wave_sum(ss); const float inv = 1.f / fmaxf(sqrtf(ss), 1e-12f);
            for (int i = 0; i < HD64 / LANES; ++i) { const int c = h * 64 + i * LANES + lane; const size_t o = (size_t)t * GW + c; const float kk = kkraw[i] * inv;
                oA[o] = -kk; oB[o] = kk * av_[i]; }
        }
        WSYNC();
        for (int c = lane; c < 128; c += LANES) { float z = glab[c];
            for (int j = 0; j < 16; ++j) z += ubf(u, t, UB_AD + j) * glaup[j * 128 + c];
            oGA[(size_t)t * 128 + c] = -softplusf_(-z) * (1.f / 16.f); }
        for (int c = lane; c < 512; c += LANES) { float y = convb[c];
            for (int j = 0; j < 4; ++j) { const int sp = s - 3 + j; if (sp >= 0) y += convw[j * 512 + c] * ubf(u, t - 3 + j, UC_Q + c); }
            float q = siluf_(y); if (c >= 256) q *= 0.125f; oQK[(size_t)t * 512 + c] = q; }
        for (int c = lane; c < 8; c += LANES) { const float v = ubf(u, t, UC_IG + c);
            oLG[(size_t)t * 8 + c] = c < 4 ? v + ib[c] : -softplusf_(-(v + fb[c - 4])); }
        {   float ssq = 0.f, sskv = 0.f;
            for (int j = lane; j < 256; j += LANES) { const float v = ubf(u, t, UD_CQ + j); ssq += v * v; }
            for (int j = lane; j < 128; j += LANES) { const float v = ubf(u, t, UD_CKV + j); sskv += v * v; }
            ssq = wave_sum(ssq); sskv = wave_sum(sskv);
            const float rq = 1.f / sqrtf(ssq * (1.f / 256.f) + NORM_EPS), rkv = 1.f / sqrtf(sskv * (1.f / 128.f) + NORM_EPS);
            for (int j = lane; j < 256; j += LANES) sh[j] = ubf(u, t, UD_CQ + j) * rq * qng[j];
            for (int j = lane; j < 128; j += LANES) sh[256 + j] = ubf(u, t, UD_CKV + j) * rkv * kvng[j];
            WSYNC();
            for (int n = lane; n < 384; n += LANES) { float acc = 0.f;
_Pragma("unroll 8")
                for (int k = 0; k < 256; ++k) acc += sh[k] * wuq[(size_t)k * 384 + n]; sh[384 + n] = acc; }
            for (int n = lane; n < 512; n += LANES) { float acc = 0.f;
_Pragma("unroll 8")
                for (int k = 0; k < 128; ++k) acc += sh[256 + k] * wukv[(size_t)k * 512 + n]; sh[768 + n] = acc; }
            for (int i = lane; i < 16; i += LANES) { const float invf = powf(10000.f, -(float)i / 16.f); const float ang = (float)pos[t] * invf; sh[1280 + i] = cosf(ang); sh[1296 + i] = sinf(ang); }
            for (int i = lane; i < 32; i += LANES) sh[1312 + i] = ubf(u, t, UD_KR + i);
            WSYNC();
            const float qscale = 0.10206207261596575f * 1.4426950408889634f;
            for (int idx = lane; idx < 384; idx += LANES) { const int h = idx / 96, d = idx % 96; float v;
                if (d < 64) v = sh[384 + idx];
                else { const int i = (d - 64) & 15; const float x1 = sh[384 + h * 96 + 64 + i], x2 = sh[384 + h * 96 + 80 + i]; const float c_ = sh[1280 + i], s_ = sh[1296 + i];
                    v = (d - 64) < 16 ? x1 * c_ - x2 * s_ : x1 * s_ + x2 * c_; }
                oAQ[(size_t)t * 384 + idx] = f2bf(v * qscale); }
            for (int idx = lane; idx < 384; idx += LANES) { const int h = idx / 96, d = idx % 96; float v;
                if (d < 64) v = sh[768 + h * 128 + d];
                else { const int i = (d - 64) & 15; const float x1 = sh[1312 + i], x2 = sh[1328 + i]; const float c_ = sh[1280 + i], s_ = sh[1296 + i];
                    v = (d - 64) < 16 ? x1 * c_ - x2 * s_ : x1 * s_ + x2 * c_; }
                oAK[(size_t)t * 384 + idx] = f2bf(v); }
            for (int idx = lane; idx < 256; idx += LANES) { const int h = idx / 64, d = idx % 64; oAV[(size_t)t * 256 + idx] = f2bf(sh[768 + h * 128 + 64 + d]); }
            WSYNC();
        }
    }
}

HD void rwkv_scan_thread(const Ctx& C, int b, int h, int v) {
    const float* pR = WSP(float, WS_RW_R); const float* pW = WSP(float, WS_RW_W); const float* pK = WSP(float, WS_RW_K); const float* pV = WSP(float, WS_RW_V);
    const float* pA = WSP(float, WS_RW_A); const float* pB = WSP(float, WS_RW_B); float* Y = WSP(float, WS_YA);
    float S[64];
#pragma unroll
    for (int k = 0; k < 64; ++k) S[k] = 0.f;
    for (int s = 0; s < SEQ; ++s) {
        const size_t o = ((size_t)b * SEQ + s) * GW + h * 64;
        const float vv = pV[o + v];
        float sa0 = 0.f, sa1 = 0.f, sa2 = 0.f, sa3 = 0.f;
#pragma unroll
        for (int k = 0; k < 64; k += 4) { const f4v a = *(const f4v*)(pA + o + k); sa0 += S[k] * a[0]; sa1 += S[k + 1] * a[1]; sa2 += S[k + 2] * a[2]; sa3 += S[k + 3] * a[3]; }
        const float sa = (sa0 + sa1) + (sa2 + sa3);
        float y0 = 0.f, y1 = 0.f, y2 = 0.f, y3 = 0.f;
#pragma unroll
        for (int k = 0; k < 64; k += 4) {
            const f4v w = *(const f4v*)(pW + o + k), bb = *(const f4v*)(pB + o + k), kk = *(const f4v*)(pK + o + k), r = *(const f4v*)(pR + o + k);
            S[k] = S[k] * w[0] + sa * bb[0] + vv * kk[0]; y0 += S[k] * r[0];
            S[k + 1] = S[k + 1] * w[1] + sa * bb[1] + vv * kk[1]; y1 += S[k + 1] * r[1];
            S[k + 2] = S[k + 2] * w[2] + sa * bb[2] + vv * kk[2]; y2 += S[k + 2] * r[2];
            S[k + 3] = S[k + 3] * w[3] + sa * bb[3] + vv * kk[3]; y3 += S[k + 3] * r[3];
            if ((k & 12) == 12) asm volatile("" ::: "memory"); }
        Y[o + v] = (y0 + y1) + (y2 + y3);
    }
}
HD void gla_scan_thread(const Ctx& C, int b, int h, int v) {
    const bf16_t* u = WSP(bf16_t, WS_U); const float* GA = WSP(float, WS_GA); float* Y = WSP(float, WS_YB);
    float S[32];
#pragma unroll
    for (int k = 0; k < 32; ++k) S[k] = 0.f;
    for (int s = 0; s < SEQ; ++s) {
        const int t = b * SEQ + s;
        const float vv = ubf(u, t, UB_V + h * 64 + v);
        float acc = 0.f;
#pragma unroll
        for (int k8 = 0; k8 < 32; k8 += 8) { float kf[8], qf[8];
            ld8bf(u + (size_t)t * DINP + UB_K + h * 32 + k8, kf); ld8bf(u + (size_t)t * DINP + UB_Q + h * 32 + k8, qf);
            const f4v g0 = *(const f4v*)(GA + (size_t)t * 128 + h * 32 + k8), g1 = *(const f4v*)(GA + (size_t)t * 128 + h * 32 + k8 + 4);
#pragma unroll
            for (int j = 0; j < 8; ++j) { const float a = expf(j < 4 ? g0[j & 3] : g1[j & 3]); S[k8 + j] = a * S[k8 + j] + kf[j] * vv; acc += qf[j] * S[k8 + j]; } }
        Y[(size_t)t * GW + h * 64 + v] = acc * 0.17677669529663687f;
    }
}
HD void mlstm_scan_thread(const Ctx& C, int b, int h, int e) {
    const bf16_t* u = WSP(bf16_t, WS_U); const float* QK = WSP(float, WS_QK); const float* LG = WSP(float, WS_LG);
    float* Y = WSP(float, WS_YC); float* DEN = WSP(float, WS_DEN);
    float S[64];
#pragma unroll
    for (int k = 0; k < 64; ++k) S[k] = 0.f;
    for (int s = 0; s < SEQ; ++s) {
        const int t = b * SEQ + s;
        const float ig = expf(LG[(size_t)t * 8 + h]), fg = expf(LG[(size_t)t * 8 + 4 + h]);
        const float vv = (e < 64 ? ubf(u, t, UC_V + h * 64 + e) : 1.f) * ig;
        float acc = 0.f;
#pragma unroll
        for (int k = 0; k < 64; k += 4) { const f4v kk = *(const f4v*)(QK + (size_t)t * 512 + 256 + h * 64 + k), qq = *(const f4v*)(QK + (size_t)t * 512 + h * 64 + k);
#pragma unroll
            for (int j = 0; j < 4; ++j) { S[k + j] = fg * S[k + j] + kk[j] * vv; acc += qq[j] * S[k + j]; } }
        if (e < 64) Y[(size_t)t * GW + h * 64 + e] = acc; else DEN[(size_t)t * 4 + h] = acc;
    }
}
HD void attn_thread(const Ctx& C, int b, int h, int q, int kmax  ) {
    const bf16_t* Q = WSP(bf16_t, WS_AQ); const bf16_t* K = WSP(bf16_t, WS_AK); const bf16_t* V = WSP(bf16_t, WS_AV); bf16_t* mix = WSP(bf16_t, WS_MIX);
    const int t = b * SEQ + q;
    unsigned qp[48]; float o[64];
#pragma unroll
    for (int d = 0; d < 48; d += 4) { const u4v w = *(const u4v*)(Q + (size_t)t * 384 + h * 96 + 2 * d); qp[d] = w[0]; qp[d + 1] = w[1]; qp[d + 2] = w[2]; qp[d + 3] = w[3]; }
#pragma unroll
    for (int d = 0; d < 64; ++d) o[d] = 0.f;
    float m = -1e30f, lsum = 0.f;
    for (int j = 0; j <= kmax; ++j) {
        const size_t tk = (size_t)b * SEQ + j;
        float sc0 = 0.f, sc1 = 0.f;
#pragma unroll
        for (int d = 0; d < 96; d += 8) { float kf[8]; ld8bf(K + tk * 384 + h * 96 + d, kf);
#pragma unroll
            for (int i = 0; i < 8; i += 2) { const unsigned qw = qp[(d + i) >> 1];
                sc0 += __builtin_bit_cast(float, qw << 16) * kf[i]; sc1 += __builtin_bit_cast(float, qw & 0xffff0000u) * kf[i + 1]; }
            if ((d & 24) == 24) asm volatile("" ::: "memory"); }
        const float sc = sc0 + sc1;
        if (j <= q) {
            const float mn = fmaxf(m, sc); const float corr = exp2f(m - mn), p = exp2f(sc - mn);
            lsum = lsum * corr + p;
#pragma unroll
            for (int d = 0; d < 64; d += 8) { float vf[8]; ld8bf(V + tk * 256 + h * 64 + d, vf);
#pragma unroll
                for (int i = 0; i < 8; ++i) o[d + i] = o[d + i] * corr + p * vf[i];
                if (d & 8) asm volatile("" ::: "memory"); }
            m = mn; }
    }
    const float inv = 1.f / lsum;
#pragma unroll
    for (int d = 0; d < 64; d += 8) { float a[8];
#pragma unroll
        for (int i = 0; i < 8; ++i) a[i] = o[d + i] * inv;
        st8bf(mix + (size_t)t * DMIX + 768 + h * 64 + d, a); }
}

HD void stage_post(const Ctx& C, int l, int gw, int ngw, int lane) {
    const bf16_t* u = WSP(bf16_t, WS_U); bf16_t* mix = WSP(bf16_t, WS_MIX);
    const float* YA = WSP(float, WS_YA); const float* YB = WSP(float, WS_YB); const float* YC = WSP(float, WS_YC); const float* DEN = WSP(float, WS_DEN);
    const float* pR = WSP(float, WS_RW_R); const float* pK = WSP(float, WS_RW_K); const float* pV = WSP(float, WS_RW_V); const float* pG = WSP(float, WS_RW_G);
    const float* rk = INF(I_RK) + l * GW; const float* gng = INF(I_GNG) + l * GW; const float* gnb = INF(I_GNB) + l * GW;
    const float* glag = INF(I_GLA_G) + l * GW; const float* mlng = INF(I_MLN_G) + l * GW;
    constexpr int PL = HD64 / LANES;
    for (int t = gw; t < T; t += ngw) {
        for (int h = 0; h < NH; ++h) {
            {   float y[PL], s1 = 0.f, bon = 0.f;
                for (int i = 0; i < PL; ++i) { const int c = h * 64 + i * LANES + lane; const size_t o = (size_t)t * GW + c; y[i] = YA[o]; s1 += y[i]; bon += pR[o] * pK[o] * rk[c]; }
                s1 = wave_sum(s1); bon = wave_sum(bon); const float mean = s1 * (1.f / 64.f); float s2 = 0.f;
                for (int i = 0; i < PL; ++i) { y[i] -= mean; s2 += y[i] * y[i]; }
                s2 = wave_sum(s2); const float rstd = 1.f / sqrtf(s2 * (1.f / 64.f) + RWKV_GN_EPS);
                for (int i = 0; i < PL; ++i) { const int c = h * 64 + i * LANES + lane; const size_t o = (size_t)t * GW + c;
                    const float v = (y[i] * rstd * gng[c] + gnb[c] + bon * pV[o]) * pG[o]; mix[(size_t)t * DMIX + c] = f2bf(v); } }
            {   float y[PL], s2 = 0.f;
                for (int i = 0; i < PL; ++i) { const int c = h * 64 + i * LANES + lane; y[i] = YB[(size_t)t * GW + c]; s2 += y[i] * y[i]; }
                s2 = wave_sum(s2); const float rstd = 1.f / sqrtf(s2 * (1.f / 64.f) + NORM_EPS);
                for (int i = 0; i < PL; ++i) { const int c = h * 64 + i * LANES + lane;
                    const float v = y[i] * rstd * glag[c] * siluf_(ubf(u, t, UB_G + c)); mix[(size_t)t * DMIX + 256 + c] = f2bf(v); } }
            {   const float den = DEN[(size_t)t * 4 + h]; const float dinv = 1.f / fmaxf(fabsf(den), 1.f);
                float y[PL], s1 = 0.f;
                for (int i = 0; i < PL; ++i) { const int c = h * 64 + i * LANES + lane; y[i] = YC[(size_t)t * GW + c] * dinv; s1 += y[i]; }
                s1 = wave_sum(s1); const float mean = s1 * (1.f / 64.f); float s2 = 0.f;
                for (int i = 0; i < PL; ++i) { y[i] -= mean; s2 += y[i] * y[i]; }
                s2 = wave_sum(s2); const float rstd = 1.f / sqrtf(s2 * (1.f / 64.f) + LN_EPS);
                for (int i = 0; i < PL; ++i) { const int c = h * 64 + i * LANES + lane;
                    const float v = y[i] * rstd * mlng[c] * sigmoidf_(ubf(u, t, UC_O + c)); mix[(size_t)t * DMIX + 512 + c] = f2bf(v); } }
        }
    }
}

HD void ln_row(const float* src, const float* g, const float* b, float* dstf, bf16_t* dstb, int lane, float* keep  ) {
    constexpr int PL = DM / LANES;
    float s1 = 0.f;
#pragma unroll
    for (int i = 0; i < PL; ++i) { keep[i] = src[i * LANES + lane]; s1 += keep[i]; }
    s1 = wave_sum(s1); const float mean = s1 * (1.f / DM); float s2 = 0.f;
#pragma unroll
    for (int i = 0; i < PL; ++i) { keep[i] -= mean; s2 += keep[i] * keep[i]; }
    s2 = wave_sum(s2); const float rstd = 1.f / sqrtf(s2 * (1.f / DM) + LN_EPS);
#pragma unroll
    for (int i = 0; i < PL; ++i) { const int c = i * LANES + lane; keep[i] = keep[i] * rstd * g[c] + b[c]; dstf[c] = keep[i]; dstb[c] = f2bf(keep[i]); }
}
HD void stage_ln1_router(const Ctx& C, int l, int gw, int ngw, int lane, wsh_t sh) {
    float* X1 = C.out; bf16_t* xb = WSP(bf16_t, WS_XB);
    const float* g = INF(I_LN1G) + l * DM; const float* b = INF(I_LN1B) + l * DM;
    const float* wrg = INF(I_WRG) + (size_t)l * DM * NGRP; const float* brg = INF(I_BRG) + l * NGRP;
    const float* wre = INF(I_WRE) + (size_t)l * DM * NEXP; const float* bre = INF(I_BRE) + l * NEXP;
    unsigned* cnt = WSP(unsigned, WS_CTL) + CW_CNT + l * NEXP * 64;
    int* tokinfo = WSP(int, WS_TOKINFO); int* list = WSP(int, WS_LIST);
    constexpr int PL = DM / LANES;
    for (int t = gw; t < T; t += ngw) {
        {   float keep[PL];
            ln_row(X1 + (size_t)t * DM, g, b, X1 + (size_t)t * DM, xb + (size_t)t * DM, lane, keep);
#pragma unroll
            for (int i = 0; i < PL; ++i) sh[i * LANES + lane] = keep[i]; }
        WSYNC();
        float lg[NGRP], le[NEXP];
#pragma unroll
        for (int j = 0; j < NGRP; ++j) lg[j] = 0.f;
#pragma unroll
        for (int j = 0; j < NEXP; ++j) le[j] = 0.f;
#pragma unroll 1
        for (int i = 0; i < PL; ++i) { const int c = i * LANES + lane; const float xv = sh[c];
            const f4v wg = *(const f4v*)(wrg + (size_t)c * NGRP);
#pragma unroll
            for (int j = 0; j < NGRP; ++j) lg[j] += xv * wg[j];
#pragma unroll
            for (int j = 0; j < NEXP; j += 4) { const f4v we = *(const f4v*)(wre + (size_t)c * NEXP + j);
                le[j] += xv * we[0]; le[j + 1] += xv * we[1]; le[j + 2] += xv * we[2]; le[j + 3] += xv * we[3]; } }
        WSYNC();
#pragma unroll
        for (int j = 0; j < NGRP; ++j) lg[j] = wave_sum(lg[j]) + brg[j];
#pragma unroll
        for (int j = 0; j < NEXP; ++j) le[j] = wave_sum(le[j]) + bre[j];
        int gi = 0; float gm = lg[0];
#pragma unroll
        for (int j = 1; j < NGRP; ++j) if (lg[j] > gm) { gm = lg[j]; gi = j; }
        float gs = 0.f;
#pragma unroll
        for (int j = 0; j < NGRP; ++j) gs += expf(lg[j] - gm);
        const float group_p = 1.f / gs;
        float el[EPG];
#pragma unroll
        for (int j = 0; j < EPG; ++j) { float v = le[j];
#pragma unroll
            for (int g2 = 1; g2 < NGRP; ++g2) v = (gi == g2) ? le[g2 * EPG + j] : v;
            el[j] = v; }
        int e0 = 0; float m0 = el[0];
#pragma unroll
        for (int j = 1; j < EPG; ++j) if (el[j] > m0) { m0 = el[j]; e0 = j; }
        int e1 = -1; float m1 = -3.0e38f;
#pragma unroll
        for (int j = 0; j < EPG; ++j) if (j != e0 && el[j] > m1) { m1 = el[j]; e1 = j; }
        const float p1 = expf(m1 - m0); const float g0 = group_p / (1.f + p1), g1 = group_p * p1 / (1.f + p1);
        if (lane == 0) {
            const int E0 = gi * EPG + e0, E1 = gi * EPG + e1;
            tokinfo[(size_t)t * 4 + 0] = E0; tokinfo[(size_t)t * 4 + 1] = E1;
            ((float*)tokinfo)[(size_t)t * 4 + 2] = g0; ((float*)tokinfo)[(size_t)t * 4 + 3] = g1;
            const unsigned s0 = atom_add(cnt + E0 * 64, 1u); list[(size_t)E0 * T + s0] = t * 2 + 0;
            const unsigned s1 = atom_add(cnt + E1 * 64, 1u); list[(size_t)E1 * T + s1] = t * 2 + 1;
        }
    }
}
HD void moe_bases(const Ctx& C, int l, int* base  ) {
    const unsigned* cnt = WSP(unsigned, WS_CTL) + CW_CNT + l * NEXP * 64;
    int acc = 0;
    for (int e = 0; e < NEXP; ++e) { base[e] = acc; acc += ((int)cnt[e * 64] + 255) & ~255; }
    base[NEXP] = acc;
}
HD int moe_expert_of_row(const int* base, int row) { int e = 0; for (int j = 1; j < NEXP; ++j) if (row >= base[j]) e = j; return e; }
HD int moe_lookup(const unsigned* cnt, int row, int& e, int& be, int& ce) {
    int acc = 0; e = 0; be = 0; ce = 0;
    for (int j = 0; j < NEXP; ++j) { const int c = (int)cnt[j * 64]; if (row >= acc) { e = j; be = acc; ce = c; } acc += (c + 255) & ~255; }
    return acc;
}
HD void stage_gather(const Ctx& C, int l, int gw, int ngw, int lane) {
    const unsigned* cnt = WSP(unsigned, WS_CTL) + CW_CNT + l * NEXP * 64;
    const int* list = WSP(int, WS_LIST); const int* tokinfo = WSP(int, WS_TOKINFO);
    const bf16_t* xb = WSP(bf16_t, WS_XB); bf16_t* xg = WSP(bf16_t, WS_XG); int* rowinfo = WSP(int, WS_ROWINFO); float* rowgate = WSP(float, WS_ROWGATE);
    int e, be, ce; const int total = moe_lookup(cnt, 0, e, be, ce);
    for (int row = gw; row < total; row += ngw) {
        moe_lookup(cnt, row, e, be, ce);
        const int slot = row - be;
        if (slot < ce) { const int ent = list[(size_t)e * T + slot]; const int tok = ent >> 1;
            for (int c = lane * 8; c < DM; c += LANES * 8) *(u4v*)(xg + (size_t)row * DM + c) = *(const u4v*)(xb + (size_t)tok * DM + c);
            if (lane == 0) { rowinfo[row] = ent; rowgate[row] = ((const float*)tokinfo)[(size_t)tok * 4 + 2 + (ent & 1)]; } }
        else { const u4v z = {0u, 0u, 0u, 0u}; for (int c = lane * 8; c < DM; c += LANES * 8) *(u4v*)(xg + (size_t)row * DM + c) = z;
            if (lane == 0) { rowinfo[row] = -1; rowgate[row] = 0.f; } }
    }
}
HD void stage_ln2(const Ctx& C, int l, int gw, int ngw, int lane) {
    const float* src = WSP(float, WS_X); float* dst = (l == DEPTH - 1) ? C.out : WSP(float, WS_X); bf16_t* xb = WSP(bf16_t, WS_XB);
    const float* g = INF(I_LN2G) + l * DM; const float* b = INF(I_LN2B) + l * DM;
    constexpr int PL = DM / LANES;
    for (int t = gw; t < T; t += ngw) { float keep[PL]; ln_row(src + (size_t)t * DM, g, b, dst + (size_t)t * DM, xb + (size_t)t * DM, lane, keep); }
}

struct EpiU {
    static constexpr bool PERM = true; static constexpr int MODE = 0;
    bf16_t* o;
    HDM void put8(int row, int col, const float* a) const { st8bf(o + (size_t)row * DINP + col, a); }
};
struct EpiPP {
    static constexpr bool PERM = true; static constexpr int MODE = 0;
    bf16_t* o;
    HDM void put8(int row, int col, const float* a) const { st8bf(o + (size_t)row * DM + col, a); }
};
struct EpiPre1 {
    static constexpr bool PERM = false; static constexpr int MODE = 0;
    const float* x; float* o;
    HDM void put4(int row, int col, const float* a) const { const float al = dn_alpha(); const f4v xr = *(const f4v*)(x + (size_t)row * DM + col);
        f4v r; for (int j = 0; j < 4; ++j) r[j] = al * xr[j] + a[j]; *(f4v*)(o + (size_t)row * DM + col) = r; }
};
struct EpiH {
    static constexpr bool PERM = true; static constexpr int MODE = 1;
    bf16_t* o;
    HDM void put8gu(int row, int hcol, const float* g, const float* u) const { float v[8]; for (int j = 0; j < 8; ++j) v[j] = siluf_(g[j]) * u[j];
        st8bf(o + (size_t)row * DEXP + hcol, v); }
};
struct EpiY {
    static constexpr bool PERM = true; static constexpr int MODE = 0;
    const int* rowinfo; const float* rowgate; bf16_t* o;
    HDM void put8(int row, int col, const float* a) const { const int ent = rowinfo[row]; if (ent < 0) return; const float g = rowgate[row];
        float v[8]; for (int j = 0; j < 8; ++j) v[j] = g * a[j]; st8bf(o + (size_t)ent * DM + col, v); }
};
struct EpiPre2 {
    static constexpr bool PERM = false; static constexpr int MODE = 0;
    const float* x1; const bf16_t* ybuf; const bf16_t* pp; const float* bg; float* o;
    HDM void put4(int row, int col, const float* a) const { const float al = dn_alpha(); const size_t i = (size_t)row * DM + col;
        const f4v xr = *(const f4v*)(x1 + i); const f4v bgv = *(const f4v*)(bg + col);
        const unsigned* y0 = (const unsigned*)(ybuf + (size_t)(2 * row) * DM + col); const unsigned* y1 = (const unsigned*)(ybuf + (size_t)(2 * row + 1) * DM + col); const unsigned* pq = (const unsigned*)(pp + i);
        const unsigned y00 = y0[0], y01 = y0[1], y10 = y1[0], y11 = y1[1], p0 = pq[0], p1 = pq[1];
        float yv[4] = { __builtin_bit_cast(float, y00 << 16) + __builtin_bit_cast(float, y10 << 16), __builtin_bit_cast(float, y00 & 0xffff0000u) + __builtin_bit_cast(float, y10 & 0xffff0000u),
                        __builtin_bit_cast(float, y01 << 16) + __builtin_bit_cast(float, y11 << 16), __builtin_bit_cast(float, y01 & 0xffff0000u) + __builtin_bit_cast(float, y11 & 0xffff0000u) };
        float pv[4] = { __builtin_bit_cast(float, p0 << 16), __builtin_bit_cast(float, p0 & 0xffff0000u), __builtin_bit_cast(float, p1 << 16), __builtin_bit_cast(float, p1 & 0xffff0000u) };
        f4v r; for (int j = 0; j < 4; ++j) r[j] = al * xr[j] + yv[j] + sigmoidf_(a[j] + bgv[j]) * pv[j];
        *(f4v*)(o + i) = r; }
};

#ifndef CPU_TEST
namespace pg8 {
#define PG8_LAS __attribute__((address_space(3)))
typedef short bf16x8 __attribute__((ext_vector_type(8)));
typedef float f32x4 __attribute__((ext_vector_type(4)));
constexpr int BM = 256, BK = 64, HALF = 128, HTB = HALF * BK * 2, STAGE_BYTES = 8 * HTB;
__device__ __forceinline__ int lds_byte(int r, int c) { const int st = (r >> 4) * 2 + (c >> 5), rr = r & 15, cc = c & 31, ob = rr * 64 + cc * 2; return st * 1024 + (ob ^ (((ob >> 9) & 1) << 5)); }
__device__ __forceinline__ void stage_rc(int b, int& R, int& C) { const int st = b / 1024, sb = b % 1024, swz = sb ^ (((sb >> 9) & 1) << 5); R = (st >> 1) * 16 + swz / 64; C = (st & 1) * 32 + (swz % 64) / 2; }
__device__ __forceinline__ int perm32(int rho) { const int n = rho >> 4, i = rho & 15; return 8 * (i >> 2) + 4 * n + (i & 3); }
struct Unit { int pm, pn; long aoff, boff; };
struct Gemm { const bf16_t* A; const bf16_t* Bt; int lda, ldb, K; };

template <class F> __device__ __forceinline__ void run_epi(const F& f, const f32x4 (&acc)[2][2][4][2], const Unit& u, int wr, int wc, int fr, int fq) {
#pragma unroll
    for (int ai = 0; ai < 2; ++ai)
#pragma unroll
        for (int m = 0; m < 4; ++m) { const int row = u.pm * BM + ai * HALF + wr * 64 + m * 16 + fr;
            if constexpr (F::MODE == 1) { const int hcol = u.pn * 128 + wc * 32 + 8 * fq; float g[8], up[8];
#pragma unroll
                for (int j = 0; j < 4; ++j) { g[j] = acc[ai][0][m][0][j]; g[4 + j] = acc[ai][0][m][1][j]; up[j] = acc[ai][1][m][0][j]; up[4 + j] = acc[ai][1][m][1][j]; }
                f.put8gu(row, hcol, g, up); }
            else if constexpr (F::PERM) {
#pragma unroll
                for (int bj = 0; bj < 2; ++bj) { const int col = u.pn * BM + bj * HALF + wc * 32 + 8 * fq; float a[8];
#pragma unroll
                    for (int j = 0; j < 4; ++j) { a[j] = acc[ai][bj][m][0][j]; a[4 + j] = acc[ai][bj][m][1][j]; }
                    f.put8(row, col, a); } }
            else {
#pragma unroll
                for (int bj = 0; bj < 2; ++bj)
#pragma unroll
                    for (int n = 0; n < 2; ++n) { const int col = u.pn * BM + bj * HALF + wc * 32 + 16 * n + 4 * fq; float a[4];
#pragma unroll
                        for (int j = 0; j < 4; ++j) a[j] = acc[ai][bj][m][n][j];
                        f.put4(row, col, a); } }
        }
}

template <class Epi, class Sched>
__device__ __forceinline__ void gemm_phase(PG8_LAS unsigned char* lds, const Gemm g, const Sched& S, const Epi& E) {
    int tid = threadIdx.x; asm volatile("" : "+v"(tid));
    const int wid = __builtin_amdgcn_readfirstlane(tid >> 6), lane = tid & 63, wr = wid >> 2, wc = wid & 3, fr = lane & 15, fq = lane >> 4;
    const int K = g.K, nt = K / BK;
    unsigned voffA[2], voffB[2];
#pragma unroll
    for (int i = 0; i < 2; ++i) { int R, C; stage_rc(tid * 16 + i * 8192, R, C); const int Rb = Epi::PERM ? ((R & ~31) + perm32(R & 31)) : R;
        voffA[i] = (unsigned)(R * g.lda + C) * 2u; voffB[i] = (unsigned)(Rb * g.ldb + C) * 2u; }
    const size_t kstep = (size_t)(BK * 2);
    const size_t hstepA = (size_t)HALF * g.lda * 2, hstepB = (size_t)HALF * g.ldb * 2;
    const unsigned ldsw = (unsigned)wid * 1024u;
    const int aoff = lds_byte(wr * 64 + fr, fq * 8), boff = lds_byte(wc * 32 + fr, fq * 8);
#define PG8_SA(b, h) (((b) * 2 + (h)) * HTB)
#define PG8_SB(b, h) ((4 + (b) * 2 + (h)) * HTB)
#define PG8_STAGE(bufoff, gbase, voff) do { _Pragma("unroll") for (int _i = 0; _i < 2; ++_i) \
        __builtin_amdgcn_global_load_lds((const unsigned*)((const char*)(gbase) + (voff)[_i]), (PG8_LAS unsigned*)(lds + (bufoff) + ldsw + _i * 8192), 16, 0, 0); } while (0)
#define PG8_LDA(dst, b, h) do { _Pragma("unroll") for (int m = 0; m < 4; ++m) _Pragma("unroll") for (int k = 0; k < 2; ++k) dst[m][k] = *(const PG8_LAS bf16x8*)(lds + PG8_SA(b, h) + aoff + m * 2048 + k * 1024); } while (0)
#define PG8_LDB(dst, b, h) do { _Pragma("unroll") for (int n = 0; n < 2; ++n) _Pragma("unroll") for (int k = 0; k < 2; ++k) dst[n][k] = *(const PG8_LAS bf16x8*)(lds + PG8_SB(b, h) + boff + n * 2048 + k * 1024); } while (0)
#define PG8_MMA(ai, bj, At, Bt) do { __builtin_amdgcn_s_setprio(1); _Pragma("unroll") for (int m = 0; m < 4; ++m) _Pragma("unroll") for (int n = 0; n < 2; ++n) _Pragma("unroll") for (int k = 0; k < 2; ++k) \
        acc[ai][bj][m][n] = __builtin_amdgcn_mfma_f32_16x16x32_bf16(Bt[n][k], At[m][k], acc[ai][bj][m][n], 0, 0, 0); __builtin_amdgcn_s_setprio(0); } while (0)
#define PG8_WAIT_V(n) asm volatile("s_waitcnt vmcnt(" #n ")" ::: "memory")
#define PG8_WAIT_L(n) asm volatile("s_waitcnt lgkmcnt(" #n ")" ::: "memory")
#define PG8_BAR __builtin_amdgcn_s_barrier()
#define PG8_SCHED __builtin_amdgcn_sched_barrier(0)
    Unit cur, nxt; int ui = 0;
    if (!S.next(0, cur)) return;
    f32x4 acc[2][2][4][2];
#pragma unroll
    for (int a = 0; a < 2; ++a)
#pragma unroll
        for (int b = 0; b < 2; ++b)
#pragma unroll
            for (int m = 0; m < 4; ++m)
#pragma unroll
                for (int n = 0; n < 2; ++n) acc[a][b][m][n] = (f32x4){0.f, 0.f, 0.f, 0.f};
    bf16x8 At[4][2], B0[2][2], B1[2][2];
    const char* cA = (const char*)g.A + cur.aoff; const char* cB = (const char*)g.Bt + cur.boff;
    PG8_STAGE(PG8_SB(0, 0), cB, voffB); PG8_STAGE(PG8_SA(0, 0), cA, voffA); PG8_STAGE(PG8_SB(0, 1), cB + hstepB, voffB); PG8_STAGE(PG8_SA(0, 1), cA + hstepA, voffA);
    if (wr == 1) PG8_BAR;
    PG8_WAIT_V(4); PG8_BAR;
    PG8_STAGE(PG8_SB(1, 0), cB + kstep, voffB); PG8_STAGE(PG8_SA(1, 0), cA + kstep, voffA); PG8_STAGE(PG8_SB(1, 1), cB + hstepB + kstep, voffB);
    PG8_WAIT_V(6); PG8_BAR;
    for (;;) {
        const bool has_next = S.next(ui + 1, nxt);
        const char* nA = has_next ? (const char*)g.A + nxt.aoff : cA; const char* nB = has_next ? (const char*)g.Bt + nxt.boff : cB;
_Pragma("unroll 1")
        for (int t = 0; t < nt; t += 2) {
            const bool last = (t == nt - 2);
            const char* a1 = cA + (size_t)(t + 1) * kstep;
            const char* a2 = last ? nA : cA + (size_t)(t + 2) * kstep; const char* b2 = last ? nB : cB + (size_t)(t + 2) * kstep;
            const char* a3 = a2 + kstep; const char* b3 = b2 + kstep;
            PG8_LDB(B0, 0, 0); PG8_SCHED; PG8_LDA(At, 0, 0); PG8_STAGE(PG8_SA(1, 1), a1 + hstepA, voffA);
            PG8_WAIT_L(8); PG8_BAR; PG8_WAIT_L(0); PG8_MMA(0, 0, At, B0); PG8_BAR; PG8_SCHED;
            PG8_LDB(B1, 0, 1); PG8_STAGE(PG8_SB(0, 0), b2, voffB);
            PG8_BAR; PG8_WAIT_L(0); PG8_MMA(0, 1, At, B1); PG8_BAR;
            PG8_LDA(At, 0, 1); PG8_STAGE(PG8_SA(0, 0), a2, voffA);
            PG8_BAR; PG8_WAIT_L(0); PG8_MMA(1, 0, At, B0); PG8_BAR; PG8_SCHED;
            PG8_STAGE(PG8_SB(0, 1), b2 + hstepB, voffB);
            PG8_WAIT_V(6); PG8_BAR; PG8_MMA(1, 1, At, B1); PG8_BAR;
            PG8_LDB(B0, 1, 0); PG8_SCHED; PG8_LDA(At, 1, 0); PG8_STAGE(PG8_SA(0, 1), a2 + hstepA, voffA);
            PG8_WAIT_L(8); PG8_BAR; PG8_WAIT_L(0); PG8_MMA(0, 0, At, B0); PG8_BAR; PG8_SCHED;
            PG8_LDB(B1, 1, 1); PG8_STAGE(PG8_SB(1, 0), b3, voffB);
            PG8_BAR; PG8_WAIT_L(0); PG8_MMA(0, 1, At, B1); PG8_BAR;
            PG8_LDA(At, 1, 1); PG8_STAGE(PG8_SA(1, 0), a3, voffA);
            PG8_BAR; PG8_WAIT_L(0); PG8_MMA(1, 0, At, B0); PG8_BAR; PG8_SCHED;
            PG8_STAGE(PG8_SB(1, 1), b3 + hstepB, voffB);
            PG8_WAIT_V(6); PG8_BAR; PG8_MMA(1, 1, At, B1); PG8_BAR;
        }
        run_epi(E, acc, cur, wr, wc, fr, fq);
        if (!has_next) break;
#pragma unroll
        for (int a = 0; a < 2; ++a)
#pragma unroll
            for (int b = 0; b < 2; ++b)
#pragma unroll
                for (int m = 0; m < 4; ++m)
#pragma unroll
                    for (int n = 0; n < 2; ++n) acc[a][b][m][n] = (f32x4){0.f, 0.f, 0.f, 0.f};
        cur = nxt; cA = nA; cB = nB; ++ui;
    }
    PG8_WAIT_V(0);
    if (wr == 0) PG8_BAR;
    PG8_BAR;
#undef PG8_SA
#undef PG8_SB
#undef PG8_STAGE
#undef PG8_LDA
#undef PG8_LDB
#undef PG8_MMA
#undef PG8_WAIT_V
#undef PG8_WAIT_L
#undef PG8_BAR
#undef PG8_SCHED
}
struct DenseOrder {
    int nM, nN, G, c; long astep, bstep;
    __device__ __forceinline__ bool next(int i, Unit& u) const {
        const long L = (long)i * G + c; if (L >= (long)nM * nN) return false;
        const int w = (int)L; const int nig = 8 * nN, gid = w / nig, fm = gid * 8, gsz = (nM - fm) < 8 ? (nM - fm) : 8;
        u.pm = fm + ((w % nig) % gsz); u.pn = (w % nig) / gsz; u.aoff = (long)u.pm * astep; u.boff = (long)u.pn * bstep; return true; }
};
struct MoeOrder {
    const PG8_LAS int* tbl; int nM, nN, G, c; long astep, bstep, estep;
    __device__ __forceinline__ bool next(int i, Unit& u) const {
        const long L = (long)i * G + c; if (L >= (long)nM * nN) return false;
        const int w = (int)L; u.pm = w / nN; u.pn = w % nN; const int e = tbl[u.pm];
        u.aoff = (long)u.pm * astep; u.boff = (long)e * estep + (long)u.pn * bstep; return true; }
};
}
#endif

#ifndef CPU_TEST
namespace att {
typedef short bf16x8 __attribute__((ext_vector_type(8)));
typedef short s16x4 __attribute__((ext_vector_type(4)));
typedef float f32x16 __attribute__((ext_vector_type(16)));
typedef float f32x2_t __attribute__((ext_vector_type(2))); typedef __bf16 bf16x2_t __attribute__((ext_vector_type(2)));
typedef unsigned u32x4 __attribute__((ext_vector_type(4)));
typedef unsigned u32x2 __attribute__((ext_vector_type(2)));
#define ATT_LAS __attribute__((address_space(3)))
constexpr int KP = 104, VP = 68;
constexpr int KBUF = 64 * KP * 2, VBUF = 64 * VP * 2;
constexpr int LDS_NEED = 2 * KBUF + 2 * VBUF;
__device__ __forceinline__ unsigned cvtpk(float lo, float hi) { f32x2_t v = {lo, hi}; bf16x2_t b = __builtin_convertvector(v, bf16x2_t); return __builtin_bit_cast(unsigned, b); }
__device__ __forceinline__ int crow(int r, int hi) { return (r & 3) + 8 * (r >> 2) + 4 * hi; }
__device__ __forceinline__ void unit(ATT_LAS unsigned char* lds, const bf16_t* Q, const bf16_t* K, const bf16_t* V, bf16_t* mix, int b, int h, int qb) {
    int tid = threadIdx.x; asm volatile("" : "+v"(tid));
    const int lane = tid & 63, w = __builtin_amdgcn_readfirstlane(tid >> 6), r32 = lane & 31, hi = lane >> 5;
    const size_t tb = (size_t)b * SEQ;
    const int q = qb * 256 + w * 32 + r32;
    bf16x8 qr[6];
    { const bf16_t* qrow = Q + (tb + q) * 384 + h * 96 + 8 * hi;
#pragma unroll
      for (int ks = 0; ks < 6; ++ks) qr[ks] = *(const bf16x8*)(qrow + 16 * ks); }
    f32x16 o0, o1;
#pragma unroll
    for (int r = 0; r < 16; ++r) { o0[r] = 0.f; o1[r] = 0.f; }
    float m = -1e30f, lsum = 0.f;
    const int NT = 4 * (qb + 1);
    const int kr0 = tid / 12, kp0 = tid % 12, kr1 = (tid + 512) / 12, kp1 = (tid + 512) % 12; const bool has1 = tid < 256;
    const int vk = tid >> 3, vp = tid & 7;
    const bf16_t* gK0 = K + (tb + kr0) * 384 + h * 96 + kp0 * 8; const bf16_t* gK1 = K + (tb + kr1) * 384 + h * 96 + kp1 * 8;
    const bf16_t* gV = V + (tb + vk) * 256 + h * 64 + vp * 8;
    u32x4 sk0, sk1, sv; sk1 = (u32x4){0u, 0u, 0u, 0u};
    sk0 = *(const u32x4*)gK0; if (has1) sk1 = *(const u32x4*)gK1; sv = *(const u32x4*)gV;
#define ATT_WRITE(buf) do { \
        *(ATT_LAS u32x4*)(lds + (buf) * KBUF + (kr0 * KP + kp0 * 8) * 2) = sk0; \
        if (has1) *(ATT_LAS u32x4*)(lds + (buf) * KBUF + (kr1 * KP + kp1 * 8) * 2) = sk1; \
        ATT_LAS unsigned short* vt_ = (ATT_LAS unsigned short*)(lds + 2 * KBUF + (buf) * VBUF); \
        _Pragma("unroll") for (int j = 0; j < 4; ++j) { vt_[(8 * vp + 2 * j) * VP + vk] = (unsigned short)(sv[j] & 0xffffu); vt_[(8 * vp + 2 * j + 1) * VP + vk] = (unsigned short)(sv[j] >> 16); } } while (0)
    ATT_WRITE(0);
    __syncthreads();
    for (int t = 0; t < NT; ++t) {
        const int buf = t & 1;
        if (t + 1 < NT) { const size_t adv = (size_t)(t + 1) * 64; sk0 = *(const u32x4*)(gK0 + adv * 384); if (has1) sk1 = *(const u32x4*)(gK1 + adv * 384); sv = *(const u32x4*)(gV + adv * 256); }
        f32x16 p0, p1;
#pragma unroll
        for (int r = 0; r < 16; ++r) { p0[r] = 0.f; p1[r] = 0.f; }
        { ATT_LAS const unsigned char* kb = lds + buf * KBUF + (r32 * KP + 8 * hi) * 2;
#pragma unroll
          for (int ks = 0; ks < 6; ++ks) { const bf16x8 a0 = *(ATT_LAS const bf16x8*)(kb + ks * 32), a1 = *(ATT_LAS const bf16x8*)(kb + 32 * KP * 2 + ks * 32);
              p0 = __builtin_amdgcn_mfma_f32_32x32x16_bf16(a0, qr[ks], p0, 0, 0, 0); p1 = __builtin_amdgcn_mfma_f32_32x32x16_bf16(a1, qr[ks], p1, 0, 0, 0); } }
        if (t >= NT - 4) {
            const int k0 = t * 64;
#pragma unroll
            for (int r = 0; r < 16; ++r) { const int kk = k0 + crow(r, hi); if (kk > q) p0[r] = -1e30f; if (kk + 32 > q) p1[r] = -1e30f; } }
        float rm = p0[0];
#pragma unroll
        for (int r = 1; r < 16; ++r) rm = fmaxf(rm, p0[r]);
#pragma unroll
        for (int r = 0; r < 16; ++r) rm = fmaxf(rm, p1[r]);
        rm = fmaxf(rm, __shfl_xor(rm, 32));
        const float mn = fmaxf(m, rm); const float alpha = __builtin_amdgcn_exp2f(m - mn); m = mn;
        float ps = 0.f;
#pragma unroll
        for (int r = 0; r < 16; ++r) { p0[r] = __builtin_amdgcn_exp2f(p0[r] - mn); p1[r] = __builtin_amdgcn_exp2f(p1[r] - mn); ps += p0[r] + p1[r]; }
        lsum = lsum * alpha + ps;
#pragma unroll
        for (int r = 0; r < 16; ++r) { o0[r] *= alpha; o1[r] *= alpha; }
        { ATT_LAS const unsigned char* vb = lds + 2 * KBUF + buf * VBUF + (r32 * VP + 4 * hi) * 2;
#pragma unroll
          for (int s = 0; s < 4; ++s) {
              u32x4 pw;
              if (s == 0) pw = (u32x4){cvtpk(p0[0], p0[1]), cvtpk(p0[2], p0[3]), cvtpk(p0[4], p0[5]), cvtpk(p0[6], p0[7])};
              else if (s == 1) pw = (u32x4){cvtpk(p0[8], p0[9]), cvtpk(p0[10], p0[11]), cvtpk(p0[12], p0[13]), cvtpk(p0[14], p0[15])};
              else if (s == 2) pw = (u32x4){cvtpk(p1[0], p1[1]), cvtpk(p1[2], p1[3]), cvtpk(p1[4], p1[5]), cvtpk(p1[6], p1[7])};
              else pw = (u32x4){cvtpk(p1[8], p1[9]), cvtpk(p1[10], p1[11]), cvtpk(p1[12], p1[13]), cvtpk(p1[14], p1[15])};
              const bf16x8 pb = __builtin_bit_cast(bf16x8, pw);
              const u32x2 a00 = *(ATT_LAS const u32x2*)(vb + s * 32), a01 = *(ATT_LAS const u32x2*)(vb + s * 32 + 16);
              const u32x2 a10 = *(ATT_LAS const u32x2*)(vb + 32 * VP * 2 + s * 32), a11 = *(ATT_LAS const u32x2*)(vb + 32 * VP * 2 + s * 32 + 16);
              const bf16x8 va0 = __builtin_bit_cast(bf16x8, (u32x4){a00[0], a00[1], a01[0], a01[1]}), va1 = __builtin_bit_cast(bf16x8, (u32x4){a10[0], a10[1], a11[0], a11[1]});
              o0 = __builtin_amdgcn_mfma_f32_32x32x16_bf16(va0, pb, o0, 0, 0, 0); o1 = __builtin_amdgcn_mfma_f32_32x32x16_bf16(va1, pb, o1, 0, 0, 0); } }
        if (t + 1 < NT) ATT_WRITE(buf ^ 1);
        __syncthreads();
    }
#undef ATT_WRITE
    lsum += __shfl_xor(lsum, 32);
    const float inv = 1.f / lsum;
    bf16_t* orow = mix + (tb + q) * DMIX + 768 + h * 64;
#pragma unroll
    for (int rg = 0; rg < 4; ++rg) {
        u32x2 w0 = {cvtpk(o0[4 * rg] * inv, o0[4 * rg + 1] * inv), cvtpk(o0[4 * rg + 2] * inv, o0[4 * rg + 3] * inv)};
        u32x2 w1 = {cvtpk(o1[4 * rg] * inv, o1[4 * rg + 1] * inv), cvtpk(o1[4 * rg + 2] * inv, o1[4 * rg + 3] * inv)};
        *(u32x2*)(orow + 8 * rg + 4 * hi) = w0; *(u32x2*)(orow + 32 + 8 * rg + 4 * hi) = w1; }
}
}
#endif

#ifndef CPU_TEST
namespace lin {
using att::bf16x8; using att::f32x16; using att::u32x4; using att::u32x2; using att::cvtpk; using att::crow;
constexpr int PT = 68;
template <int DK, int NDV> struct Lay {
    static constexpr int PQ = DK + 8;
    static constexpr int OFF_Q = 0, OFF_K = OFF_Q + 64 * PQ * 2, OFF_KH = OFF_K + 64 * PQ * 2, OFF_VT = OFF_KH + DK * PT * 2, OFF_DEC = OFF_VT + NDV * PT * 2, BUF = OFF_DEC + 256;
};
__device__ __forceinline__ bf16x8 ldA16(ATT_LAS const unsigned char* p) { return *(ATT_LAS const bf16x8*)p; }
__device__ __forceinline__ bf16x8 ldP8(ATT_LAS const unsigned char* p) { const u32x2 a = *(ATT_LAS const u32x2*)p, b = *(ATT_LAS const u32x2*)(p + 16); return __builtin_bit_cast(bf16x8, (u32x4){a[0], a[1], b[0], b[1]}); }
__device__ __forceinline__ bf16x8 pack8(const f32x16& x, int s) {
    u32x4 p;
    if (s == 0) p = (u32x4){cvtpk(x[0], x[1]), cvtpk(x[2], x[3]), cvtpk(x[4], x[5]), cvtpk(x[6], x[7])};
    else p = (u32x4){cvtpk(x[8], x[9]), cvtpk(x[10], x[11]), cvtpk(x[12], x[13]), cvtpk(x[14], x[15])};
    return __builtin_bit_cast(bf16x8, p); }
#define MF32(a, b, c) __builtin_amdgcn_mfma_f32_32x32x16_bf16((a), (b), (c), 0, 0, 0)
template <int DK, int NDV> __device__ __forceinline__ void compute(ATT_LAS const unsigned char* B, int ib, int dvb, int r32, int hi, f32x16 (&H)[DK / 32], f32x16& O) {
    typedef Lay<DK, NDV> L;
    f32x16 X[2];
#pragma unroll
    for (int r = 0; r < 16; ++r) { X[0][r] = 0.f; X[1][r] = 0.f; O[r] = 0.f; }
#pragma unroll
    for (int jb = 0; jb < 2; ++jb) if (jb <= ib) {
#pragma unroll
        for (int s = 0; s < DK / 16; ++s)
            X[jb] = MF32(ldA16(B + L::OFF_K + ((32 * jb + r32) * L::PQ + 16 * s + 8 * hi) * 2), ldA16(B + L::OFF_Q + ((32 * ib + r32) * L::PQ + 16 * s + 8 * hi) * 2), X[jb]);
        if (jb == ib) {
#pragma unroll
            for (int r = 0; r < 16; ++r) if (crow(r, hi) > r32) X[jb][r] = 0.f; } }
    bf16x8 vf[2][2];
#pragma unroll
    for (int jb = 0; jb < 2; ++jb)
#pragma unroll
        for (int s = 0; s < 2; ++s) vf[jb][s] = ldP8(B + L::OFF_VT + ((32 * dvb + r32) * PT + 32 * jb + 16 * s + 4 * hi) * 2);
#pragma unroll
    for (int jb = 0; jb < 2; ++jb) if (jb <= ib) {
#pragma unroll
        for (int s = 0; s < 2; ++s) O = MF32(pack8(X[jb], s), vf[jb][s], O); }
#pragma unroll
    for (int db = 0; db < DK / 32; ++db)
#pragma unroll
        for (int s = 0; s < 2; ++s) O = MF32(ldP8(B + L::OFF_Q + ((32 * ib + r32) * L::PQ + 32 * db + 16 * s + 4 * hi) * 2), pack8(H[db], s), O);
#pragma unroll
    for (int db = 0; db < DK / 32; ++db) {
        ATT_LAS const float* dec = (ATT_LAS const float*)(B + L::OFF_DEC);
#pragma unroll
        for (int r = 0; r < 16; ++r) H[db][r] *= dec[32 * db + crow(r, hi)];
#pragma unroll
        for (int jb = 0; jb < 2; ++jb)
#pragma unroll
            for (int s = 0; s < 2; ++s) H[db] = MF32(ldP8(B + L::OFF_KH + ((32 * db + r32) * PT + 32 * jb + 16 * s + 4 * hi) * 2), vf[jb][s], H[db]); }
}
__device__ __forceinline__ float scan64(float v, int lane) {
#pragma unroll
    for (int o = 1; o < 64; o <<= 1) { const float t = __shfl_up(v, o); if (lane >= o) v += t; }
    return v; }
__device__ __forceinline__ float bfl(unsigned w) { return __builtin_bit_cast(float, w << 16); }
__device__ __forceinline__ float bfh(unsigned w) { return __builtin_bit_cast(float, w & 0xffff0000u); }
__device__ __forceinline__ void vt_write(ATT_LAS unsigned char* B, int off_vt, int tok, int part, const u32x4& sv) {
    ATT_LAS unsigned short* vt = (ATT_LAS unsigned short*)(B + off_vt);
#pragma unroll
    for (int j = 0; j < 4; ++j) { vt[(8 * part + 2 * j) * PT + tok] = (unsigned short)(sv[j] & 0xffffu); vt[(8 * part + 2 * j + 1) * PT + tok] = (unsigned short)(sv[j] >> 16); } }

__device__ __forceinline__ void gla_run(ATT_LAS unsigned char* lds, const Ctx& C, int l, int b, int h) {
    typedef Lay<32, 64> L;
    int tid = threadIdx.x; asm volatile("" : "+v"(tid));
    const int lane = tid & 63, w = __builtin_amdgcn_readfirstlane(tid >> 6), r32 = lane & 31, hi = lane >> 5;
    const bf16_t* u = WSP(bf16_t, WS_U); float* Y = WSP(float, WS_YB);
    const float* aup = INF(I_GLA_UP) + l * 16 * 128 + h * 32 + 4 * w; const float* ab = INF(I_GLA_B) + l * 128 + h * 32 + 4 * w;
    const size_t tb = (size_t)b * SEQ;
    f32x16 H[1], O;
#pragma unroll
    for (int r = 0; r < 16; ++r) H[0][r] = 0.f;
    const int ib = w >> 1, dvb = w & 1;
    const int vtok = tid >> 3, vpart = tid & 7;
    u32x4 pa0, pa1, pv; u32x2 pq, pk;
#define GLA_FETCH(c) do { const size_t t_ = tb + (size_t)(c) * 64 + lane; const bf16_t* ur = u + t_ * DINP; \
        pa0 = *(const u32x4*)(ur + UB_AD); pa1 = *(const u32x4*)(ur + UB_AD + 8); pq = *(const u32x2*)(ur + UB_Q + h * 32 + 4 * w); pk = *(const u32x2*)(ur + UB_K + h * 32 + 4 * w); \
        pv = *(const u32x4*)(u + (tb + (size_t)(c) * 64 + vtok) * DINP + UB_V + h * 64 + vpart * 8); } while (0)
#define GLA_PREP(buf) do { ATT_LAS unsigned char* B_ = lds + (buf) * L::BUF; \
        float adv[16]; _Pragma("unroll") for (int j = 0; j < 4; ++j) { adv[2 * j] = bfl(pa0[j]); adv[2 * j + 1] = bfh(pa0[j]); adv[8 + 2 * j] = bfl(pa1[j]); adv[9 + 2 * j] = bfh(pa1[j]); } \
        const float qv[4] = {bfl(pq[0]), bfh(pq[0]), bfl(pq[1]), bfh(pq[1])}, kv[4] = {bfl(pk[0]), bfh(pk[0]), bfl(pk[1]), bfh(pk[1])}; \
        float qo[4], ko[4]; \
        _Pragma("unroll") for (int d = 0; d < 4; ++d) { float z = ab[d]; _Pragma("unroll") for (int j = 0; j < 16; ++j) z += adv[j] * aup[j * 128 + d]; \
            const float la = -softplusf_(-z) * (1.f / 16.f); const float bc = scan64(la, lane); const float be = __shfl(bc, 63); \
            qo[d] = qv[d] * __expf(bc) * 0.17677669529663687f; ko[d] = kv[d] * __expf(-bc); const float kh = kv[d] * __expf(be - bc); \
            ((ATT_LAS unsigned short*)(B_ + L::OFF_KH))[(4 * w + d) * PT + lane] = f2bf(kh); \
            if (lane == 63) ((ATT_LAS float*)(B_ + L::OFF_DEC))[4 * w + d] = __expf(be); } \
        *(ATT_LAS u32x2*)(B_ + L::OFF_Q + (lane * L::PQ + 4 * w) * 2) = (u32x2){cvtpk(qo[0], qo[1]), cvtpk(qo[2], qo[3])}; \
        *(ATT_LAS u32x2*)(B_ + L::OFF_K + (lane * L::PQ + 4 * w) * 2) = (u32x2){cvtpk(ko[0], ko[1]), cvtpk(ko[2], ko[3])}; \
        vt_write(B_, L::OFF_VT, vtok, vpart, pv); } while (0)
    constexpr int NC = SEQ / 64;
    GLA_FETCH(0); GLA_PREP(0); GLA_FETCH(1);
    __syncthreads();
    for (int c = 0; c < NC; ++c) {
        if (c + 1 < NC) { GLA_PREP((c + 1) & 1); if (c + 2 < NC) GLA_FETCH(c + 2); }
        if (w < 4) {
            compute<32, 64>(lds + (c & 1) * L::BUF, ib, dvb, r32, hi, H, O);
            float* yo = Y + (tb + (size_t)c * 64 + 32 * ib) * GW + h * 64 + 32 * dvb + r32;
#pragma unroll
            for (int r = 0; r < 16; ++r) yo[(size_t)crow(r, hi) * GW] = O[r]; }
        __syncthreads();
    }
#undef GLA_FETCH
#undef GLA_PREP
}
__device__ __forceinline__ void mlstm_run(ATT_LAS unsigned char* lds, const Ctx& C, int l, int b, int h) {
    typedef Lay<64, 96> L;
    int tid = threadIdx.x; asm volatile("" : "+v"(tid));
    const int lane = tid & 63, w = __builtin_amdgcn_readfirstlane(tid >> 6), r32 = lane & 31, hi = lane >> 5;
    const bf16_t* u = WSP(bf16_t, WS_U); float* Y = WSP(float, WS_YC); float* DEN = WSP(float, WS_DEN);
    const float* cw = INF(I_CONVW) + l * 4 * 512 + h * 64 + 8 * w; const float* cb = INF(I_CONVB) + l * 512 + h * 64 + 8 * w;
    const float ibias = INF(I_IB)[l * 4 + h], fbias = INF(I_FB)[l * 4 + h];
    const size_t tb = (size_t)b * SEQ;
    f32x16 H[2], O;
#pragma unroll
    for (int r = 0; r < 16; ++r) { H[0][r] = 0.f; H[1][r] = 0.f; }
    const int ib = w / 3, dvb = w % 3;
    const int vtok = tid >> 3, vpart = tid & 7;
    for (int i = tid; i < 32 * PT; i += 512) { const unsigned short v = (i < PT) ? (unsigned short)0x3f80 : (unsigned short)0;
        ((ATT_LAS unsigned short*)(lds + L::OFF_VT))[64 * PT + i] = v; ((ATT_LAS unsigned short*)(lds + L::BUF + L::OFF_VT))[64 * PT + i] = v; }
    u32x4 xq[4], xk[4], pg, pv;
#define ML_FETCH(c) do { const int s_ = (c) * 64 + lane; const bf16_t* ur = u + (tb + s_) * DINP; \
        _Pragma("unroll") for (int j = 0; j < 4; ++j) { const bool ok = s_ - 3 + j >= 0; const bf16_t* up = ur + (ptrdiff_t)(j - 3) * DINP; \
            xq[j] = ok ? *(const u32x4*)(up + UC_Q + h * 64 + 8 * w) : (u32x4){0u, 0u, 0u, 0u}; xk[j] = ok ? *(const u32x4*)(up + UC_K + h * 64 + 8 * w) : (u32x4){0u, 0u, 0u, 0u}; } \
        pg = *(const u32x4*)(ur + UC_IG); pv = *(const u32x4*)(u + (tb + (size_t)(c) * 64 + vtok) * DINP + UC_V + h * 64 + vpart * 8); } while (0)
#define ML_PREP(buf) do { ATT_LAS unsigned char* B_ = lds + (buf) * L::BUF; \
        const unsigned gi_ = pg[h >> 1], gf_ = pg[2 + (h >> 1)]; const float ig = ((h & 1) ? bfh(gi_) : bfl(gi_)) + ibias; const float lf = -softplusf_(-(((h & 1) ? bfh(gf_) : bfl(gf_)) + fbias)); \
        const float F = scan64(lf, lane); const float Fe = __shfl(F, 63); const float eF = __expf(F), wk = __expf(ig - F) * 0.125f, wkh = __expf(Fe - F + ig) * 0.125f; \
        float qo[8], ko[8]; \
        _Pragma("unroll") for (int ch = 0; ch < 8; ++ch) { float yq = cb[ch], yk = cb[256 + ch]; \
            _Pragma("unroll") for (int j = 0; j < 4; ++j) { const unsigned wq_ = xq[j][ch >> 1], wk_ = xk[j][ch >> 1]; \
                yq += cw[j * 512 + ch] * ((ch & 1) ? bfh(wq_) : bfl(wq_)); yk += cw[j * 512 + 256 + ch] * ((ch & 1) ? bfh(wk_) : bfl(wk_)); } \
            const float sq = siluf_(yq), sk = siluf_(yk); qo[ch] = sq * eF; ko[ch] = sk * wk; \
            ((ATT_LAS unsigned short*)(B_ + L::OFF_KH))[(8 * w + ch) * PT + lane] = f2bf(sk * wkh); } \
        *(ATT_LAS u32x4*)(B_ + L::OFF_Q + (lane * L::PQ + 8 * w) * 2) = (u32x4){cvtpk(qo[0], qo[1]), cvtpk(qo[2], qo[3]), cvtpk(qo[4], qo[5]), cvtpk(qo[6], qo[7])}; \
        *(ATT_LAS u32x4*)(B_ + L::OFF_K + (lane * L::PQ + 8 * w) * 2) = (u32x4){cvtpk(ko[0], ko[1]), cvtpk(ko[2], ko[3]), cvtpk(ko[4], ko[5]), cvtpk(ko[6], ko[7])}; \
        if (w == 0) ((ATT_LAS float*)(B_ + L::OFF_DEC))[lane] = __expf(Fe); \
        vt_write(B_, L::OFF_VT, vtok, vpart, pv); } while (0)
    constexpr int NC = SEQ / 64;
    ML_FETCH(0); ML_PREP(0); ML_FETCH(1);
    __syncthreads();
    for (int c = 0; c < NC; ++c) {
        if (c + 1 < NC) { ML_PREP((c + 1) & 1); if (c + 2 < NC) ML_FETCH(c + 2); }
        if (w < 6) {
            compute<64, 96>(lds + (c & 1) * L::BUF, ib, dvb, r32, hi, H, O);
            const size_t t0 = tb + (size_t)c * 64 + 32 * ib;
            if (dvb < 2) { float* yo = Y + t0 * GW + h * 64 + 32 * dvb + r32;
#pragma unroll
                for (int r = 0; r < 16; ++r) yo[(size_t)crow(r, hi) * GW] = O[r]; }
            else if (r32 == 0) {
#pragma unroll
                for (int r = 0; r < 16; ++r) DEN[(t0 + crow(r, hi)) * 4 + h] = O[r]; } }
        __syncthreads();
    }
#undef ML_FETCH
#undef ML_PREP
}
#undef MF32
}
#endif

#ifndef CPU_TEST
namespace rwk {
constexpr int NB = 16;
constexpr int VEC = 6 * 64;
constexpr int BUFB = NB * VEC * 4;
__device__ __forceinline__ float dpp_add(float v, int ctrl_sel) {
    int x = __builtin_bit_cast(int, v), y;
    if (ctrl_sel == 0) y = __builtin_amdgcn_update_dpp(0, x, 0xB1, 0xF, 0xF, true);
    else if (ctrl_sel == 1) y = __builtin_amdgcn_update_dpp(0, x, 0x4E, 0xF, 0xF, true);
    else if (ctrl_sel == 2) y = __builtin_amdgcn_update_dpp(0, x, 0x141, 0xF, 0xF, true);
    else y = __builtin_amdgcn_update_dpp(0, x, 0x140, 0xF, 0xF, true);
    return v + __builtin_bit_cast(float, y); }
__device__ __forceinline__ float red16(float v) { v = dpp_add(v, 0); v = dpp_add(v, 1); v = dpp_add(v, 2); v = dpp_add(v, 3); return v; }
__device__ __forceinline__ void run(ATT_LAS unsigned char* lds, const Ctx& C, int b, int h, int rg) {
    int tid = threadIdx.x; asm volatile("" : "+v"(tid));
    const int lane = tid & 63, w = __builtin_amdgcn_readfirstlane(tid >> 6);
    const float* src[6] = {WSP(float, WS_RW_A), WSP(float, WS_RW_W), WSP(float, WS_RW_B), WSP(float, WS_RW_K), WSP(float, WS_RW_R), WSP(float, WS_RW_V)};
    float* Y = WSP(float, WS_YA);
    const size_t tb = (size_t)b * SEQ;
    const int lt = tid - 256;
#define RW_LOAD(batch, buf) do { _Pragma("unroll") for (int i = 0; i < 6; ++i) { const int p = lt + 256 * i; const int st = p / 96, vc = (p % 96) >> 4, pt = p & 15; \
        const float* sp = (vc == 0 ? src[0] : vc == 1 ? src[1] : vc == 2 ? src[2] : vc == 3 ? src[3] : vc == 4 ? src[4] : src[5]); \
        const f4v v4 = *(const f4v*)(sp + (tb + (size_t)(batch) * NB + st) * GW + h * 64 + pt * 4); \
        *(ATT_LAS f4v*)(lds + (buf) * BUFB + (st * VEC + vc * 64 + pt * 4) * 4) = v4; } } while (0)
    constexpr int NBATCH = SEQ / NB;
    if (w >= 4) RW_LOAD(0, 0);
    __syncthreads();
    const int row = 16 * rg + 4 * w + (lane >> 4), cg = lane & 15;
    float S0 = 0.f, S1 = 0.f, S2 = 0.f, S3 = 0.f;
    for (int bt = 0; bt < NBATCH; ++bt) {
        if (w >= 4) { if (bt + 1 < NBATCH) RW_LOAD(bt + 1, (bt + 1) & 1); }
        else {
            ATT_LAS const float* B = (ATT_LAS const float*)(lds + (bt & 1) * BUFB);
#pragma unroll 4
            for (int st = 0; st < NB; ++st) {
                ATT_LAS const float* P = B + st * VEC;
                const f4v a = *(ATT_LAS const f4v*)(P + 4 * cg), wv = *(ATT_LAS const f4v*)(P + 64 + 4 * cg), bb = *(ATT_LAS const f4v*)(P + 128 + 4 * cg),
                          kk = *(ATT_LAS const f4v*)(P + 192 + 4 * cg), r = *(ATT_LAS const f4v*)(P + 256 + 4 * cg);
                const float vv = P[320 + row];
                const float sa = red16((S0 * a[0] + S1 * a[1]) + (S2 * a[2] + S3 * a[3]));
                S0 = S0 * wv[0] + (sa * bb[0] + vv * kk[0]); S1 = S1 * wv[1] + (sa * bb[1] + vv * kk[1]);
                S2 = S2 * wv[2] + (sa * bb[2] + vv * kk[2]); S3 = S3 * wv[3] + (sa * bb[3] + vv * kk[3]);
                const float y = red16((S0 * r[0] + S1 * r[1]) + (S2 * r[2] + S3 * r[3]));
                if (cg == 0) Y[(tb + (size_t)bt * NB + st) * GW + h * 64 + row] = y;
            }
        }
        __syncthreads();
    }
#undef RW_LOAD
}
}
#endif

constexpr int PH_PER_LAYER = 12;
constexpr int NPHASES = DEPTH * PH_PER_LAYER;

#ifndef CPU_TEST
#define XB_TMO      128
#define XB_XCNT(j)  (256  + 64 * (j))
#define XB_XSUB(j)  (1280 + 64 * (j))
#define XB_XGEN(j)  (2304 + 64 * (j))
#define XB_TOP      3328
#define XB_TOPGEN   3392
#define XCD_BAR_WORDS 3456
#define XB_SPIN_CAP (1u << 18)
#define LAS __attribute__((address_space(3)))
__device__ __forceinline__ unsigned xb_ld(unsigned* p)              { return __hip_atomic_load(p, __ATOMIC_RELAXED, __HIP_MEMORY_SCOPE_AGENT); }
__device__ __forceinline__ unsigned xb_add(unsigned* p, unsigned v) { return __hip_atomic_fetch_add(p, v, __ATOMIC_RELAXED, __HIP_MEMORY_SCOPE_AGENT); }
__device__ __forceinline__ unsigned xb_xcc_id() { return (unsigned)__builtin_amdgcn_s_getreg((3 << 11) | 20) & 0xFu; }
#define XB_SPIN(cond, bar) do { unsigned _sp = 0; while (cond) { __builtin_amdgcn_s_sleep(1); \
    if ((++_sp & 255u) == 0u) { if (xb_ld(&(bar)[XB_TMO])) break; if (_sp > XB_SPIN_CAP) { atomicAdd(&(bar)[XB_TMO], 1u); break; } } } } while (0)
struct XcdBarrier { unsigned* bar; unsigned x; volatile LAS unsigned* st; };
__device__ __forceinline__ XcdBarrier xcd_barrier_post(unsigned* bar, volatile LAS unsigned* st) {
    XcdBarrier b; b.bar = bar; b.x = xb_xcc_id(); b.st = st;
    if (threadIdx.x == 0) (void)xb_add(&bar[XB_XCNT(b.x)], 1u);
    return b;
}
__device__ __forceinline__ void xcd_barrier_complete(unsigned* bar, unsigned x, unsigned& nloc, unsigned& nx) {
    const unsigned G = gridDim.x * gridDim.y * gridDim.z;
    unsigned sum, cnt, mine, sp = 0u;
    for (;;) {
        sum = 0u; cnt = 0u; mine = 0u;
#pragma unroll
        for (unsigned j = 0; j < 16; ++j) { const unsigned c = xb_ld(&bar[XB_XCNT(j)]); sum += c; cnt += (c > 0u) ? 1u : 0u; mine = (j == x) ? c : mine; }
        if (sum == G) break;
        __builtin_amdgcn_s_sleep(1);
        if ((++sp & 255u) == 0u) { if (xb_ld(&bar[XB_TMO])) break; if (sp > XB_SPIN_CAP) { atomicAdd(&bar[XB_TMO], 1u); break; } }
    }
    nloc = mine > 0u ? mine : 1u; nx = cnt > 0u ? cnt : 1u;
}
__device__ __forceinline__ void xcd_barrier(const XcdBarrier& b) {
    asm volatile("s_waitcnt vmcnt(0)" ::: "memory");
    __syncthreads();
    if (threadIdx.x == 0) {
        unsigned* bar = b.bar;
        __builtin_amdgcn_s_waitcnt(0);
        unsigned nloc = b.st[0], nx = b.st[1];
        if (nloc == 0u) { xcd_barrier_complete(bar, b.x, nloc, nx); b.st[0] = nloc; b.st[1] = nx; }
        const unsigned old = xb_add(&bar[XB_XSUB(b.x)], 1u);
        const unsigned gen = old / nloc;
        if (old + 1u == (gen + 1u) * nloc) {
            __builtin_amdgcn_fence(__ATOMIC_RELEASE, "agent");
            asm volatile("s_waitcnt vmcnt(0)" ::: "memory");
            const unsigned og = xb_add(&bar[XB_TOP], 1u);
            const unsigned tg = og / nx;
            if (og + 1u == (tg + 1u) * nx) xb_add(&bar[XB_TOPGEN], 1u);
            else XB_SPIN(xb_ld(&bar[XB_TOPGEN]) == tg, bar);
            __builtin_amdgcn_fence(__ATOMIC_ACQUIRE, "agent");
            xb_add(&bar[XB_XGEN(b.x)], 1u);
            asm volatile("s_waitcnt vmcnt(0)" ::: "memory");
        } else {
            XB_SPIN(xb_ld(&bar[XB_XGEN(b.x)]) == gen, bar);
            __builtin_amdgcn_fence(__ATOMIC_ACQUIRE, "agent");
            asm volatile("s_waitcnt vmcnt(0)" ::: "memory");
        }
    }
    __syncthreads();
}

constexpr int NWAVES = 8;
constexpr int RING_BYTES = 131072, MISC_OFF = RING_BYTES + 320, LDS_BYTES = 147456;
struct Args { Ctx C; int ph_lo, ph_hi; };
__device__ __forceinline__ int moe_fill_table(const Ctx& C, int l, LAS int* tbl, int tid) {
    const unsigned* cnt = WSP(unsigned, WS_CTL) + CW_CNT + l * NEXP * 64;
    int e, be, ce; const int total = moe_lookup(cnt, tid * 256, e, be, ce);
    if (tid < 320) tbl[tid] = e;
    __syncthreads();
    return total >> 8;
}

__global__ void __launch_bounds__(NWAVES * 64, 2) mega(Args args) {
    extern __shared__ __attribute__((aligned(16))) unsigned char lds_raw[];
    LAS unsigned char* lds = (LAS unsigned char*)lds_raw;
    const Ctx& C = args.C;
    const int G = gridDim.x, bx = blockIdx.x;
    const int ngw = G * NWAVES;
    volatile LAS unsigned* MISC = (volatile LAS unsigned*)(lds + MISC_OFF);
    for (int i = threadIdx.x; i < (LDS_BYTES - RING_BYTES) / 4; i += NWAVES * 64) ((LAS unsigned*)(lds + RING_BYTES))[i] = 0u;
    __syncthreads();
    XcdBarrier bar = xcd_barrier_post(WSP(unsigned, WS_CTL) + CW_BAR, MISC + 8);
    LAS int* tbl = (LAS int*)(lds + RING_BYTES + 1024);
    const int lo = args.ph_lo, hi = args.ph_hi;

    for (int l = 0; l < DEPTH; ++l) {
        const int p0 = l * PH_PER_LAYER;
#ifndef PHASE_MASK
#define PHASE_MASK 0xFFF
#endif
#define IN(k) (((PHASE_MASK >> (k)) & 1) && lo <= p0 + (k) && p0 + (k) < hi)
#define LAUNDER() int tid = threadIdx.x; asm volatile("" : "+v"(tid)); const int lane = tid & 63; const int wave = __builtin_amdgcn_readfirstlane(tid >> 6); const int gw = bx * NWAVES + wave; (void)gw; (void)lane; \
        wsh_t wsh = (wsh_t)(lds + wave * 16384); (void)wsh
#define SEAM(k) do { if (p0 + (k) + 1 < hi) xcd_barrier(bar); } while (0)
        if (IN(0)) { LAUNDER(); stage_convert(C, l, gw, ngw, lane, wsh); SEAM(0); }
        if (IN(1)) { LAUNDER();
            pg8::Gemm g{WSP(bf16_t, WS_XB), WSP(bf16_t, WS_WIN), DM, DM, DM};
            pg8::DenseOrder S{T / 256, DINP / 256, G, bx, (long)256 * DM * 2, (long)256 * DM * 2};
            EpiU E{WSP(bf16_t, WS_U)};
            pg8::gemm_phase(lds, g, S, E); SEAM(1); }
        if (IN(2)) { LAUNDER(); stage_prep(C, l, gw, ngw, lane, wsh); SEAM(2); }
        if (IN(3)) { LAUNDER();
            if (bx < 128) rwk::run(lds, C, bx >> 4, (bx >> 2) & 3, bx & 3);
            else if (bx < 160) lin::gla_run(lds, C, l, (bx - 128) >> 2, (bx - 128) & 3);
            else if (bx < 192) lin::mlstm_run(lds, C, l, (bx - 160) >> 2, (bx - 160) & 3);
            else {
                LAS int* slot = (LAS int*)(lds + RING_BYTES + 512);
                unsigned* ctr = WSP(unsigned, WS_CTL) + CW_ATT + l * 64;
                constexpr int NQB = SEQ / 256, NUNIT = BATCH * NH * NQB;
                for (;;) {
                    if (tid == 0) *slot = (int)atomicAdd(ctr, 1u);
                    __syncthreads();
                    const int uidx = *slot;
                    __syncthreads();
                    if (uidx >= NUNIT) break;
                    const int qb = NQB - 1 - uidx / (BATCH * NH), bh = uidx % (BATCH * NH);
                    att::unit(lds, WSP(bf16_t, WS_AQ), WSP(bf16_t, WS_AK), WSP(bf16_t, WS_AV), WSP(bf16_t, WS_MIX), bh >> 2, bh & 3, qb);
                }
            }
            SEAM(3); }
        if (IN(4)) { LAUNDER(); stage_post(C, l, gw, ngw, lane); SEAM(4); }
        if (IN(5)) { LAUNDER();
            pg8::Gemm g{WSP(bf16_t, WS_MIX), WSP(bf16_t, WS_WOUT), DMIX, DMIX, DMIX};
            pg8::DenseOrder S{T / 256, DM / 256, G, bx, (long)256 * DMIX * 2, (long)256 * DMIX * 2};
            EpiPre1 E{l == 0 ? INF(I_X) : WSP(float, WS_X), C.out};
            pg8::gemm_phase(lds, g, S, E); SEAM(5); }
        if (IN(6)) { LAUNDER(); stage_ln1_router(C, l, gw, ngw, lane, wsh); SEAM(6); }
        if (IN(7)) { LAUNDER();
            stage_gather(C, l, gw, ngw, lane);
            pg8::Gemm g{WSP(bf16_t, WS_PB), WSP(bf16_t, WS_WP), DPLE, DPLE, DPLE};
            pg8::DenseOrder S{T / 256, DM / 256, G, bx, (long)256 * DPLE * 2, (long)256 * DPLE * 2};
            EpiPP E{WSP(bf16_t, WS_PP)};
            pg8::gemm_phase(lds, g, S, E); SEAM(7); }
        if (IN(8)) { LAUNDER();
            pg8::Gemm g{WSP(bf16_t, WS_XG), WSP(bf16_t, WS_WGU), DM, DM, DM};
            const int ntile = moe_fill_table(C, l, tbl, tid);
            pg8::MoeOrder S{tbl, ntile, 2 * DEXP / 256, G, bx, (long)256 * DM * 2, (long)256 * DM * 2, (long)2 * DEXP * DM * 2};
            EpiH E{WSP(bf16_t, WS_H)};
            pg8::gemm_phase(lds, g, S, E); SEAM(8); }
        if (IN(9)) { LAUNDER();
            pg8::Gemm g{WSP(bf16_t, WS_H), WSP(bf16_t, WS_WD), DEXP, DEXP, DEXP};
            const int ntile = moe_fill_table(C, l, tbl, tid);
            pg8::MoeOrder S{tbl, ntile, DM / 256, G, bx, (long)256 * DEXP * 2, (long)256 * DEXP * 2, (long)DM * DEXP * 2};
            EpiY E{WSP(int, WS_ROWINFO), WSP(float, WS_ROWGATE), WSP(bf16_t, WS_YBUF)};
            pg8::gemm_phase(lds, g, S, E); SEAM(9); }
        if (IN(10)) { LAUNDER();
            pg8::Gemm g{WSP(bf16_t, WS_XB), WSP(bf16_t, WS_WPG), DM, DM, DM};
            pg8::DenseOrder S{T / 256, DM / 256, G, bx, (long)256 * DM * 2, (long)256 * DM * 2};
            EpiPre2 E{C.out, WSP(bf16_t, WS_YBUF), WSP(bf16_t, WS_PP), INF(I_PLEBG) + l * DM, WSP(float, WS_X)};
            pg8::gemm_phase(lds, g, S, E); SEAM(10); }
        if (IN(11)) { LAUNDER(); stage_ln2(C, l, gw, ngw, lane); SEAM(11); }
#undef IN
#undef SEAM
    }
}

extern "C" void kernel_launch(void* const* d_in, const int* in_sizes, int n_in, void* d_out, int out_size, void* d_ws, size_t ws_size, hipStream_t stream) {
    static int grid = 0;
    if (grid == 0) {
        if (n_in != N_IN || out_size != T * DM || ws_size < WS_END) { fprintf(stderr, "kernel_launch: bad sizes n_in %d out %d ws %zu need %zu\n", n_in, out_size, ws_size, (size_t)WS_END); grid = -1; return; }
        int dev = 0, cus = 0, per_cu = 0;
        hipGetDevice(&dev); hipDeviceGetAttribute(&cus, hipDeviceAttributeMultiprocessorCount, dev);
        if (hipFuncSetAttribute((const void*)mega, hipFuncAttributeMaxDynamicSharedMemorySize, LDS_BYTES) != hipSuccess) { fprintf(stderr, "hipFuncSetAttribute failed\n"); grid = -1; return; }
        if (hipOccupancyMaxActiveBlocksPerMultiprocessor(&per_cu, (const void*)mega, NWAVES * 64, LDS_BYTES) != hipSuccess || per_cu < 1) { fprintf(stderr, "occupancy query: %d\n", per_cu); }
        (void)hipGetLastError();
        grid = cus;
    }
    if (grid < 0) return;
    hipMemsetAsync((char*)d_ws + WS_CTL, 0, CTL_BYTES, stream);
    Args a{};
    for (int i = 0; i < N_IN; ++i) a.C.in[i] = d_in[i];
    a.C.out = (float*)d_out; a.C.ws = (unsigned char*)d_ws;
#ifndef ONE_LAUNCH
    for (int ph = 0; ph < NPHASES; ++ph) { a.ph_lo = ph; a.ph_hi = ph + 1; hipLaunchKernelGGL(mega, dim3(grid), dim3(NWAVES * 64), LDS_BYTES, stream, a); }
#else
    a.ph_lo = 0; a.ph_hi = NPHASES; hipLaunchKernelGGL(mega, dim3(grid), dim3(NWAVES * 64), LDS_BYTES, stream, a);
#endif
}
#else
template <class E> static void cpu_gemm(const bf16_t* A, int lda, const bf16_t* Bt, int ldb, int K, int M, int N, const E& e, const int* base = nullptr, long estep = 0) {
    for (int row = 0; row < M; ++row) {
        const bf16_t* B = Bt;
        if (base) B = Bt + (size_t)moe_expert_of_row(base, row) * estep;
        if constexpr (E::MODE == 1) {
            for (int hc = 0; hc < N / 2; hc += 8) { float g[8], u[8];
                for (int j = 0; j < 8; ++j) { float ag = 0.f, au = 0.f; const bf16_t* bg = B + (size_t)rowmap(1, hc + j) * ldb; const bf16_t* bu = B + (size_t)rowmap(2, hc + j) * ldb;
                    for (int k = 0; k < K; ++k) { const float a = bf2f(A[(size_t)row * lda + k]); ag += a * bf2f(bg[k]); au += a * bf2f(bu[k]); } g[j] = ag; u[j] = au; }
                e.put8gu(row, hc, g, u); }
        } else if constexpr (E::PERM) {
            for (int c = 0; c < N; c += 8) { float a8[8];
                for (int j = 0; j < 8; ++j) { float acc = 0.f; for (int k = 0; k < K; ++k) acc += bf2f(A[(size_t)row * lda + k]) * bf2f(B[(size_t)(c + j) * ldb + k]); a8[j] = acc; }
                e.put8(row, c, a8); }
        } else {
            for (int c = 0; c < N; c += 4) { float a4[4];
                for (int j = 0; j < 4; ++j) { float acc = 0.f; for (int k = 0; k < K; ++k) acc += bf2f(A[(size_t)row * lda + k]) * bf2f(B[(size_t)(c + j) * ldb + k]); a4[j] = acc; }
                e.put4(row, c, a4); }
        }
    }
}
static void cpu_forward(const Ctx& C) {
    static float shbuf[4096];
    for (int l = 0; l < DEPTH; ++l) {
        stage_convert(C, l, 0, 1, 0, shbuf);
        { EpiU E{WSP(bf16_t, WS_U)}; cpu_gemm(WSP(bf16_t, WS_XB), DM, WSP(bf16_t, WS_WIN), DM, DM, T, DINP, E); }
        stage_prep(C, l, 0, 1, 0, shbuf);
        for (int b = 0; b < BATCH; ++b) for (int h = 0; h < NH; ++h) {
            for (int v = 0; v < 64; ++v) { rwkv_scan_thread(C, b, h, v); gla_scan_thread(C, b, h, v); }
            for (int e = 0; e < 65; ++e) mlstm_scan_thread(C, b, h, e);
            for (int q = 0; q < SEQ; ++q) attn_thread(C, b, h, q, q); }
        stage_post(C, l, 0, 1, 0);
        { EpiPre1 E{l == 0 ? INF(I_X) : WSP(float, WS_X), C.out}; cpu_gemm(WSP(bf16_t, WS_MIX), DMIX, WSP(bf16_t, WS_WOUT), DMIX, DMIX, T, DM, E); }
        stage_ln1_router(C, l, 0, 1, 0, shbuf);
        stage_gather(C, l, 0, 1, 0);
        { EpiPP E{WSP(bf16_t, WS_PP)}; cpu_gemm(WSP(bf16_t, WS_PB), DPLE, WSP(bf16_t, WS_WP), DPLE, DPLE, T, DM, E); }
        int base[NEXP + 1]; moe_bases(C, l, base);
        { EpiH E{WSP(bf16_t, WS_H)}; cpu_gemm(WSP(bf16_t, WS_XG), DM, WSP(bf16_t, WS_WGU), DM, DM, base[NEXP], 2 * DEXP, E, base, (long)2 * DEXP * DM); }
        { EpiY E{WSP(int, WS_ROWINFO), WSP(float, WS_ROWGATE), WSP(bf16_t, WS_YBUF)}; cpu_gemm(WSP(bf16_t, WS_H), DEXP, WSP(bf16_t, WS_WD), DEXP, DEXP, base[NEXP], DM, E, base, (long)DM * DEXP); }
        { EpiPre2 E{C.out, WSP(bf16_t, WS_YBUF), WSP(bf16_t, WS_PP), INF(I_PLEBG) + l * DM, WSP(float, WS_X)}; cpu_gemm(WSP(bf16_t, WS_XB), DM, WSP(bf16_t, WS_WPG), DM, DM, T, DM, E); }
        stage_ln2(C, l, 0, 1, 0);
    }
}
#endif
```

```cpp
#ifndef CPU_TEST
#include <hip/hip_runtime.h>
#include <cstdio>
#include <cstdint>
#define HD __device__ __forceinline__
#define HDM __device__ __forceinline__
#define LANES 64
#else
#include <cmath>
#include <cstdio>
#include <cstdint>
#include <cstring>
#include <algorithm>
#define HD static inline
#define HDM inline
#define LANES 1
#endif

#define ONE_LAUNCH 1
#ifndef CFG_SMALL
constexpr int BATCH = 8, SEQ = 4096, DM = 1024, DEPTH = 4, DPLE = 256, DEXP = 512;
#else
constexpr int BATCH = 2, SEQ = 256, DM = 128, DEPTH = 2, DPLE = 32, DEXP = 128;
#endif
constexpr int T = BATCH * SEQ;
constexpr int DMIX = 1024, GW = 256, HD64 = 64, NH = 4;
constexpr int DIN = 3128, DINP = 3328;
constexpr int UA = 0, UA_R = 0, UA_K = 256, UA_V = 512, UA_WD = 768, UA_AD = 800, UA_GD = 832, DINA = 896;
constexpr int UB = 896, UB_Q = 896, UB_K = 1024, UB_V = 1152, UB_AD = 1408, UB_G = 1424;
constexpr int UC = 1680, UC_Q = 1680, UC_K = 1936, UC_V = 2192, UC_O = 2448, UC_IG = 2704, UC_FG = 2708;
constexpr int UD = 2712, UD_CQ = 2712, UD_CKV = 2968, UD_KR = 3096;
constexpr int NEXP = 32, NGRP = 4, EPG = 8;
constexpr int MAXROWS = 2 * T + NEXP * 256;
constexpr float DN_ALPHA = 1.681792830507429f;
constexpr float LN_EPS = 1e-5f, NORM_EPS = 1e-6f, RWKV_GN_EPS = 64e-5f;
static_assert(DEPTH == 4 || DEPTH == 2, "alpha below assumes depth");
HD float dn_alpha() { return DEPTH == 4 ? 1.681792830507429f : 1.4142135623730951f; }

enum { I_X = 0, I_P, I_POS, I_WIN, I_MU, I_W0, I_WUP, I_A0, I_AUP, I_GUP, I_KK, I_KA, I_RK, I_GNG, I_GNB, I_GLA_UP, I_GLA_B, I_GLA_G,
       I_CONVW, I_CONVB, I_IB, I_FB, I_MLN_G, I_QNG, I_WUQ, I_KVNG, I_WUKV, I_WOUT, I_LN1G, I_LN1B, I_WRG, I_BRG, I_WRE, I_BRE,
       I_WG, I_WU, I_WD, I_PLEG, I_PLEBG, I_PLEW, I_LN2G, I_LN2B, N_IN };

typedef unsigned short bf16_t;
HD float bf2f(bf16_t h) { unsigned u = (unsigned)h << 16; return __builtin_bit_cast(float, u); }
HD bf16_t f2bf(float f) { unsigned u = __builtin_bit_cast(unsigned, f); return (bf16_t)((u + 0x7fffu + ((u >> 16) & 1u)) >> 16); }
HD unsigned pk2(float lo, float hi) { return (unsigned)f2bf(lo) | ((unsigned)f2bf(hi) << 16); }
typedef float f4v __attribute__((vector_size(16)));
typedef unsigned u4v __attribute__((vector_size(16)));
HD void ld8bf(const bf16_t* p, float* o) { const u4v w = *(const u4v*)p;
    for (int j = 0; j < 4; ++j) { o[2 * j] = __builtin_bit_cast(float, w[j] << 16); o[2 * j + 1] = __builtin_bit_cast(float, w[j] & 0xffff0000u); } }
HD void st8bf(bf16_t* p, const float* a) { u4v w; for (int j = 0; j < 4; ++j) w[j] = pk2(a[2 * j], a[2 * j + 1]); *(u4v*)p = w; }

constexpr size_t MiB = (size_t)1 << 20;
constexpr size_t al256(size_t x) { return (x + 255) & ~(size_t)255; }
constexpr size_t WS_CTL = 0, CTL_BYTES = 1 * MiB;
constexpr size_t WS_WIN = WS_CTL + CTL_BYTES;
constexpr size_t WS_WOUT = WS_WIN + al256((size_t)DINP * DM * 2);
constexpr size_t WS_WPG = WS_WOUT + al256((size_t)DM * DMIX * 2);
constexpr size_t WS_WP = WS_WPG + al256((size_t)DM * DM * 2);
constexpr size_t WS_WGU = WS_WP + al256((size_t)DM * DPLE * 2);
constexpr size_t WS_WD = WS_WGU + al256((size_t)NEXP * 2 * DEXP * DM * 2);
constexpr size_t WS_X = WS_WD + al256((size_t)NEXP * DM * DEXP * 2);
constexpr size_t WS_XB = WS_X + al256((size_t)T * DM * 4);
constexpr size_t WS_U = WS_XB + al256((size_t)T * DM * 2);
constexpr size_t WS_MIX = WS_U + al256((size_t)T * DINP * 2);
constexpr size_t WS_PB = WS_MIX + al256((size_t)T * DMIX * 2);
constexpr size_t WS_WUQ = WS_PB + al256((size_t)T * DPLE * 2);
constexpr size_t WS_WUKV = WS_WUQ + al256((size_t)512 * 256 * 2);
constexpr size_t WS_ROPE = WS_WUKV + al256((size_t)512 * 256 * 2);
constexpr size_t WS_RSTD = WS_ROPE + al256((size_t)T * 32 * 4);
constexpr size_t WS_SCR = WS_RSTD + al256((size_t)T * 2 * 4);
constexpr size_t TV = al256((size_t)T * GW * 4);
constexpr size_t WS_RW_R = WS_SCR, WS_RW_W = WS_RW_R + TV, WS_RW_K = WS_RW_W + TV, WS_RW_V = WS_RW_K + TV, WS_RW_A = WS_RW_V + TV,
                 WS_RW_B = WS_RW_A + TV, WS_RW_G = WS_RW_B + TV;
constexpr size_t WS_YA = WS_RW_G + TV, WS_YB = WS_YA + TV, WS_YC = WS_YB + TV;
constexpr size_t WS_DEN = WS_YC + TV;
constexpr size_t WS_QK = WS_DEN + al256((size_t)T * 4 * 4);
constexpr size_t WS_GA = WS_QK + al256((size_t)T * 512 * 4);
constexpr size_t WS_LG = WS_GA + al256((size_t)T * 128 * 4);
constexpr size_t WS_AQ = WS_LG + al256((size_t)T * 8 * 4);
constexpr size_t WS_AK = WS_AQ + al256((size_t)T * 384 * 2);
constexpr size_t WS_AV = WS_AK + al256((size_t)T * 384 * 2);
constexpr size_t WS_MIXER_END = WS_AV + al256((size_t)T * 256 * 2);
constexpr size_t WS_XG = WS_SCR;
constexpr size_t WS_H = WS_XG + al256((size_t)MAXROWS * DM * 2);
constexpr size_t WS_YBUF = WS_H + al256((size_t)MAXROWS * DEXP * 2);
constexpr size_t WS_PP = WS_YBUF + al256((size_t)2 * T * DM * 2);
constexpr size_t WS_TOKINFO = WS_PP + al256((size_t)T * DM * 2);
constexpr size_t WS_LIST = WS_TOKINFO + al256((size_t)T * 16);
constexpr size_t WS_ROWINFO = WS_LIST + al256((size_t)NEXP * T * 4);
constexpr size_t WS_ROWGATE = WS_ROWINFO + al256((size_t)MAXROWS * 4);
constexpr size_t WS_MOE_END = WS_ROWGATE + al256((size_t)MAXROWS * 4);
constexpr size_t WS_END = WS_MIXER_END > WS_MOE_END ? WS_MIXER_END : WS_MOE_END;
constexpr int CW_BAR = 4096;
constexpr int CW_ATT = 8192;
constexpr int CW_CNT = 16384;

struct Ctx {
    const void* in[N_IN];
    float* out;
    unsigned char* ws;
};
#define INF(i) ((const float*)C.in[i])
#define WSP(T_, off) ((T_*)(C.ws + (off)))

#ifndef CPU_TEST
HD float wave_sum(float v) {
#pragma unroll
    for (int o = 1; o < 64; o <<= 1) v += __shfl_xor(v, o);
    return v;
}
HD float wave_max(float v) {
#pragma unroll
    for (int o = 1; o < 64; o <<= 1) v = fmaxf(v, __shfl_xor(v, o));
    return v;
}
HD unsigned atom_add(unsigned* p, unsigned v) { return atomicAdd(p, v); }
#define WSYNC() __builtin_amdgcn_wave_barrier(); asm volatile("s_waitcnt lgkmcnt(0)" ::: "memory")
typedef __attribute__((address_space(3))) float* wsh_t;
#else
HD float wave_sum(float v) { return v; }
HD float wave_max(float v) { return v; }
HD unsigned atom_add(unsigned* p, unsigned v) { unsigned o = *p; *p += v; return o; }
#define WSYNC()
typedef float* wsh_t;
#endif
HD float sigmoidf_(float x) { return 1.f / (1.f + expf(-x)); }
HD float softplusf_(float x) { return x > 20.f ? x : (x < -20.f ? expf(x) : log1pf(expf(x))); }
HD float siluf_(float x) { return x * sigmoidf_(x); }

HD int rowmap(int mode, int n) { return mode == 0 ? n : (mode == 1 ? (n >> 7) * 256 + (n & 127) : (n >> 7) * 256 + 128 + (n & 127)); }
HD void transpose_item(const float* W, int K, int N, int ldw, bf16_t* WT, int ldk, int mode, int item, int lane, wsh_t scr) {
    const int nblk = (N + 31) / 32, kb = item / nblk, nb = item % nblk, k0 = 64 * kb, n0 = 32 * nb;
    for (int idx = lane; idx < 2048; idx += LANES) { const int kk = idx >> 5, nn = idx & 31; const int n = n0 + nn;
        scr[kk * 33 + nn] = (n < N) ? W[(size_t)(k0 + kk) * ldw + n] : 0.f; }
    WSYNC();
    for (int idx = lane; idx < 256; idx += LANES) { const int n = idx >> 3, c = idx & 7;
        unsigned o[4];
        for (int j = 0; j < 4; ++j) o[j] = pk2(scr[(8 * c + 2 * j) * 33 + n], scr[(8 * c + 2 * j + 1) * 33 + n]);
        unsigned* dst = (unsigned*)(WT + (size_t)rowmap(mode, n0 + n) * ldk + k0 + 8 * c);
        dst[0] = o[0]; dst[1] = o[1]; dst[2] = o[2]; dst[3] = o[3]; }
    WSYNC();
}
HD void stage_convert(const Ctx& C, int l, int gw, int ngw, int lane, wsh_t scr) {
    constexpr int NB_IN = DINP / 32;
    constexpr int I_IN = (DM / 64) * NB_IN, I_OUT = (DMIX / 64) * (DM / 32), I_PG = (DM / 64) * (DM / 32), I_PW = (DPLE / 64 > 0 ? DPLE / 64 : 1) * (DM / 32);
    constexpr int I_G1 = (DM / 64) * (DEXP / 32), I_D1 = (DEXP / 64) * (DM / 32);
    constexpr int NIT = I_IN + I_OUT + I_PG + I_PW + NEXP * (2 * I_G1 + I_D1);
    static_assert(DPLE % 32 == 0 && DEXP % 64 == 0, "shapes");
    for (int it = gw; it < NIT; it += ngw) {
        int r = it;
        if (r < I_IN) {
            const int nblk = NB_IN, kb = r / nblk, nb = r % nblk, k0 = 64 * kb, n0 = 32 * nb;
            const float* W = INF(I_WIN) + (size_t)l * DM * DIN; bf16_t* WT = WSP(bf16_t, WS_WIN);
            for (int idx = lane; idx < 2048; idx += LANES) { const int kk = idx >> 5, nn = idx & 31; const int n = n0 + nn;
                scr[kk * 33 + nn] = (n < DIN) ? W[(size_t)(k0 + kk) * DIN + n] : 0.f; }
            WSYNC();
            for (int idx = lane; idx < 256; idx += LANES) { const int n = idx >> 3, c = idx & 7; unsigned o[4];
                for (int j = 0; j < 4; ++j) o[j] = pk2(scr[(8 * c + 2 * j) * 33 + n], scr[(8 * c + 2 * j + 1) * 33 + n]);
                unsigned* dst = (unsigned*)(WT + (size_t)(n0 + n) * DM + k0 + 8 * c); dst[0] = o[0]; dst[1] = o[1]; dst[2] = o[2]; dst[3] = o[3]; }
            WSYNC();
            continue; }
        r -= I_IN;
        if (r < I_OUT) { transpose_item(INF(I_WOUT) + (size_t)l * DMIX * DM, DMIX, DM, DM, WSP(bf16_t, WS_WOUT), DMIX, 0, r, lane, scr); continue; } r -= I_OUT;
        if (r < I_PG) { transpose_item(INF(I_PLEG) + (size_t)l * DM * DM, DM, DM, DM, WSP(bf16_t, WS_WPG), DM, 0, r, lane, scr); continue; } r -= I_PG;
        if (r < I_PW) {
            if (DPLE >= 64) transpose_item(INF(I_PLEW) + (size_t)l * DPLE * DM, DPLE, DM, DM, WSP(bf16_t, WS_WP), DPLE, 0, r, lane, scr);
            continue; } r -= I_PW;
        const int e = r / (2 * I_G1 + I_D1); r -= e * (2 * I_G1 + I_D1);
        if (r < I_G1) { transpose_item(INF(I_WG) + ((size_t)l * NEXP + e) * DM * DEXP, DM, DEXP, DEXP, WSP(bf16_t, WS_WGU) + (size_t)e * 2 * DEXP * DM, DM, 1, r, lane, scr); continue; } r -= I_G1;
        if (r < I_G1) { transpose_item(INF(I_WU) + ((size_t)l * NEXP + e) * DM * DEXP, DM, DEXP, DEXP, WSP(bf16_t, WS_WGU) + (size_t)e * 2 * DEXP * DM, DM, 2, r, lane, scr); continue; } r -= I_G1;
        transpose_item(INF(I_WD) + ((size_t)l * NEXP + e) * DEXP * DM, DEXP, DM, DM, WSP(bf16_t, WS_WD) + (size_t)e * DM * DEXP, DEXP, 0, r, lane, scr);
    }
    {   const float* wq = INF(I_WUQ) + (size_t)l * 256 * 384; const float* gq = INF(I_QNG) + l * 256; bf16_t* o = WSP(bf16_t, WS_WUQ);
        for (int i = gw * LANES + lane; i < 512 * 256; i += ngw * LANES) { const int n = i >> 8, k = i & 255; o[i] = f2bf(n < 384 ? gq[k] * wq[(size_t)k * 384 + n] : 0.f); }
        const float* wk = INF(I_WUKV) + (size_t)l * 128 * 512; const float* gk = INF(I_KVNG) + l * 128; bf16_t* o2 = WSP(bf16_t, WS_WUKV);
        for (int i = gw * LANES + lane; i < 512 * 256; i += ngw * LANES) { const int n = i >> 8, k = i & 255; o2[i] = f2bf(k < 128 ? gk[k] * wk[(size_t)k * 512 + n] : 0.f); } }
    if (l == 0) {
        const int* pos = (const int*)C.in[I_POS]; float* rt = WSP(float, WS_ROPE);
        for (int i = gw * LANES + lane; i < T * 16; i += ngw * LANES) { const int t = i >> 4, f = i & 15; const float ang = (float)pos[t] * powf(10000.f, -(float)f / 16.f);
            rt[(size_t)t * 32 + f] = cosf(ang); rt[(size_t)t * 32 + 16 + f] = sinf(ang); } }
    {   const float* p = INF(I_P) + (size_t)l * T * DPLE; bf16_t* pb = WSP(bf16_t, WS_PB);
        const size_t n4 = (size_t)T * DPLE / 4;
        for (size_t i = (size_t)gw * LANES + lane; i < n4; i += (size_t)ngw * LANES) {
            const float* s = p + 4 * i; unsigned* d = (unsigned*)(pb + 4 * i); d[0] = pk2(s[0], s[1]); d[1] = pk2(s[2], s[3]); } }
    if (l == 0) { const float* x = INF(I_X); bf16_t* xb = WSP(bf16_t, WS_XB);
        const size_t n4 = (size_t)T * DM / 4;
        for (size_t i = (size_t)gw * LANES + lane; i < n4; i += (size_t)ngw * LANES) {
            const float* s = x + 4 * i; unsigned* d = (unsigned*)(xb + 4 * i); d[0] = pk2(s[0], s[1]); d[1] = pk2(s[2], s[3]); } }
#ifdef CFG_SMALL
    if (DPLE < 64) {
        const float* W = INF(I_PLEW) + (size_t)l * DPLE * DM; bf16_t* WT = WSP(bf16_t, WS_WP);
        for (int i = gw * LANES + lane; i < DPLE * DM; i += ngw * LANES) { const int k = i / DM, n = i % DM; WT[(size_t)n * DPLE + k] = f2bf(W[i]); } }
#endif
}

HD float ubf(const bf16_t* u, int t, int c) { return bf2f(u[(size_t)t * DINP + c]); }
HD void stage_prep(const Ctx& C, int l, int gw, int ngw, int lane, wsh_t sh) {
    const bf16_t* u = WSP(bf16_t, WS_U);
    const float* mu = INF(I_MU) + l * DINA; const float* w0 = INF(I_W0) + l * GW; const float* wup = INF(I_WUP) + l * 32 * GW;
    const float* a0 = INF(I_A0) + l * GW; const float* aup = INF(I_AUP) + l * 32 * GW; const float* gup = INF(I_GUP) + l * 64 * GW;
    const float* kkw = INF(I_KK) + l * GW; const float* kaw = INF(I_KA) + l * GW;
    const float* glaup = INF(I_GLA_UP) + l * 16 * 128; const float* glab = INF(I_GLA_B) + l * 128;
    const float* convw = INF(I_CONVW) + l * 4 * 512; const float* convb = INF(I_CONVB) + l * 512;
    const float* ib = INF(I_IB) + l * 4; const float* fb = INF(I_FB) + l * 4;
    const float* qng = INF(I_QNG) + l * 256; const float* wuq = INF(I_WUQ) + (size_t)l * 256 * 384;
    const float* kvng = INF(I_KVNG) + l * 128; const float* wukv = INF(I_WUKV) + (size_t)l * 128 * 512;
    const int* pos = (const int*)C.in[I_POS];
    float* oR = WSP(float, WS_RW_R); float* oW = WSP(float, WS_RW_W); float* oK = WSP(float, WS_RW_K); float* oV = WSP(float, WS_RW_V);
    float* oA = WSP(float, WS_RW_A); float* oB = WSP(float, WS_RW_B); float* oG = WSP(float, WS_RW_G);
    float* oQK = WSP(float, WS_QK); float* oGA = WSP(float, WS_GA); float* oLG = WSP(float, WS_LG);
    bf16_t* oAQ = WSP(bf16_t, WS_AQ); bf16_t* oAK = WSP(bf16_t, WS_AK); bf16_t* oAV = WSP(bf16_t, WS_AV);
    for (int t = gw; t < T; t += ngw) {
        const int s = t % SEQ;
        for (int j = lane; j < 128; j += LANES) { const int c = UA_WD + j; const float cur = ubf(u, t, c), prev = s > 0 ? ubf(u, t - 1, c) : 0.f;
            const float v = cur + (prev - cur) * mu[c]; sh[j] = j < 32 ? tanhf(v) : (j < 64 ? v : sigmoidf_(v)); }
        WSYNC();
        for (int h = 0; h < NH; ++h) {
            float kkraw[HD64 / LANES]; float kv_[HD64 / LANES], av_[HD64 / LANES]; float ss = 0.f;
            for (int i = 0; i < HD64 / LANES; ++i) { const int c = h * 64 + i * LANES + lane;
                float z = w0[c], za = a0[c], g = 0.f;
_Pragma("unroll 8")
                for (int j = 0; j < 32; ++j) { z += sh[j] * wup[j * GW + c]; za += sh[32 + j] * aup[j * GW + c]; }
_Pragma("unroll 8")
                for (int j = 0; j < 64; ++j) g += sh[64 + j] * gup[j * GW + c];
                const float lnl = -softplusf_(-z) - 0.5f; const float decay = expf(-expf(lnl)); const float a = sigmoidf_(za);
                float r, k, v;
                { const float cur = ubf(u, t, UA_R + c), prev = s > 0 ? ubf(u, t - 1, UA_R + c) : 0.f; r = cur + (prev - cur) * mu[UA_R + c]; }
                { const float cur = ubf(u, t, UA_K + c), prev = s > 0 ? ubf(u, t - 1, UA_K + c) : 0.f; k = cur + (prev - cur) * mu[UA_K + c]; }
                { const float cur = ubf(u, t, UA_V + c), prev = s > 0 ? ubf(u, t - 1, UA_V + c) : 0.f; v = cur + (prev - cur) * mu[UA_V + c]; }
                kkraw[i] = k * kkw[c]; ss += kkraw[i] * kkraw[i];
                kv_[i] = k * (1.f + (a - 1.f) * kaw[c]); av_[i] = a;
                const size_t o = (size_t)t * GW + c; oR[o] = r; oW[o] = decay; oK[o] = kv_[i]; oV[o] = v; oG[o] = g; }
            ss = wave_sum(ss); const float inv = 1.f / fmaxf(sqrtf(ss), 1e-12f);
            for (int i = 0; i < HD64 / LANES; ++i) { const int c = h * 64 + i * LANES + lane; const size_t o = (size_t)t * GW + c; const float kk = kkraw[i] * inv;
                oA[o] = -kk; oB[o] = kk * av_[i]; }
        }
        WSYNC();
        for (int c = lane; c < 128; c += LANES) { float z = glab[c];
            for (int j = 0; j < 16; ++j) z += ubf(u, t, UB_AD + j) * glaup[j * 128 + c];
            oGA[(size_t)t * 128 + c] = -softplusf_(-z) * (1.f / 16.f); }
        for (int c = lane; c < 512; c += LANES) { float y = convb[c];
            for (int j = 0; j < 4; ++j) { const int sp = s - 3 + j; if (sp >= 0) y += convw[j * 512 + c] * ubf(u, t - 3 + j, UC_Q + c); }
            float q = siluf_(y); if (c >= 256) q *= 0.125f; oQK[(size_t)t * 512 + c] = q; }
        for (int c = lane; c < 8; c += LANES) { const float v = ubf(u, t, UC_IG + c);
            oLG[(size_t)t * 8 + c] = c < 4 ? v + ib[c] : -softplusf_(-(v + fb[c - 4])); }
        {   float ssq = 0.f, sskv = 0.f;
            for (int j = lane; j < 256; j += LANES) { const float v = ubf(u, t, UD_CQ + j); ssq += v * v; }
            for (int j = lane; j < 128; j += LANES) { const float v = ubf(u, t, UD_CKV + j); sskv += v * v; }
            ssq = wave_sum(ssq); sskv = wave_sum(sskv);
            const float rq = 1.f / sqrtf(ssq * (1.f / 256.f) + NORM_EPS), rkv = 1.f / sqrtf(sskv * (1.f / 128.f) + NORM_EPS);
            for (int j = lane; j < 256; j += LANES) sh[j] = ubf(u, t, UD_CQ + j) * rq * qng[j];
            for (int j = lane; j < 128; j += LANES) sh[256 + j] = ubf(u, t, UD_CKV + j) * rkv * kvng[j];
            WSYNC();
            for (int n = lane; n < 384; n += LANES) { float acc = 0.f;
_Pragma("unroll 8")
                for (int k = 0; k < 256; ++k) acc += sh[k] * wuq[(size_t)k * 384 + n]; sh[384 + n] = acc; }
            for (int n = lane; n < 512; n += LANES) { float acc = 0.f;
_Pragma("unroll 8")
                for (int k = 0; k < 128; ++k) acc += sh[256 + k] * wukv[(size_t)k * 512 + n]; sh[768 + n] = acc; }
            for (int i = lane; i < 16; i += LANES) { const float invf = powf(10000.f, -(float)i / 16.f); const float ang = (float)pos[t] * invf; sh[1280 + i] = cosf(ang); sh[1296 + i] = sinf(ang); }
            for (int i = lane; i < 32; i += LANES) sh[1312 + i] = ubf(u, t, UD_KR + i);
            WSYNC();
            const float qscale = 0.10206207261596575f * 1.4426950408889634f;
            for (int idx = lane; idx < 384; idx += LANES) { const int h = idx / 96, d = idx % 96; float v;
                if (d < 64) v = sh[384 + idx];
                else { const int i = (d - 64) & 15; const float x1 = sh[384 + h * 96 + 64 + i], x2 = sh[384 + h * 96 + 80 + i]; const float c_ = sh[1280 + i], s_ = sh[1296 + i];
                    v = (d - 64) < 16 ? x1 * c_ - x2 * s_ : x1 * s_ + x2 * c_; }
                oAQ[(size_t)t * 384 + idx] = f2bf(v * qscale); }
            for (int idx = lane; idx < 384; idx += LANES) { const int h = idx / 96, d = idx % 96; float v;
                if (d < 64) v = sh[768 + h * 128 + d];
                else { const int i = (d - 64) & 15; const float x1 = sh[1312 + i], x2 = sh[1328 + i]; const float c_ = sh[1280 + i], s_ = sh[1296 + i];
                    v = (d - 64) < 16 ? x1 * c_ - x2 * s_ : x1 * s_ + x2 * c_; }
                oAK[(size_t)t * 384 + idx] = f2bf(v); }
            for (int idx = lane; idx < 256; idx += LANES) { const int h = idx / 64, d = idx % 64; oAV[(size_t)t * 256 + idx] = f2bf(sh[768 + h * 128 + 64 + d]); }
            WSYNC();
        }
    }
}

HD void rwkv_scan_thread(const Ctx& C, int b, int h, int v) {
    const float* pR = WSP(float, WS_RW_R); const float* pW = WSP(float, WS_RW_W); const float* pK = WSP(float, WS_RW_K); const float* pV = WSP(float, WS_RW_V);
    const float* pA = WSP(float, WS_RW_A); const float* pB = WSP(float, WS_RW_B); float* Y = WSP(float, WS_YA);
    float S[64];
#pragma unroll
    for (int k = 0; k < 64; ++k) S[k] = 0.f;
    for (int s = 0; s < SEQ; ++s) {
        const size_t o = ((size_t)b * SEQ + s) * GW + h * 64;
        const float vv = pV[o + v];
        float sa0 = 0.f, sa1 = 0.f, sa2 = 0.f, sa3 = 0.f;
#pragma unroll
        for (int k = 0; k < 64; k += 4) { const f4v a = *(const f4v*)(pA + o + k); sa0 += S[k] * a[0]; sa1 += S[k + 1] * a[1]; sa2 += S[k + 2] * a[2]; sa3 += S[k + 3] * a[3]; }
        const float sa = (sa0 + sa1) + (sa2 + sa3);
        float y0 = 0.f, y1 = 0.f, y2 = 0.f, y3 = 0.f;
#pragma unroll
        for (int k = 0; k < 64; k += 4) {
            const f4v w = *(const f4v*)(pW + o + k), bb = *(const f4v*)(pB + o + k), kk = *(const f4v*)(pK + o + k), r = *(const f4v*)(pR + o + k);
            S[k] = S[k] * w[0] + sa * bb[0] + vv * kk[0]; y0 += S[k] * r[0];
            S[k + 1] = S[k + 1] * w[1] + sa * bb[1] + vv * kk[1]; y1 += S[k + 1] * r[1];
            S[k + 2] = S[k + 2] * w[2] + sa * bb[2] + vv * kk[2]; y2 += S[k + 2] * r[2];
            S[k + 3] = S[k + 3] * w[3] + sa * bb[3] + vv * kk[3]; y3 += S[k + 3] * r[3];
            if ((k & 12) == 12) asm volatile("" ::: "memory"); }
        Y[o + v] = (y0 + y1) + (y2 + y3);
    }
}
HD void gla_scan_thread(const Ctx& C, int b, int h, int v) {
    const bf16_t* u = WSP(bf16_t, WS_U); const float* GA = WSP(float, WS_GA); float* Y = WSP(float, WS_YB);
    float S[32];
#pragma unroll
    for (int k = 0; k < 32; ++k) S[k] = 0.f;
    for (int s = 0; s < SEQ; ++s) {
        const int t = b * SEQ + s;
        const float vv = ubf(u, t, UB_V + h * 64 + v);
        float acc = 0.f;
#pragma unroll
        for (int k8 = 0; k8 < 32; k8 += 8) { float kf[8], qf[8];
            ld8bf(u + (size_t)t * DINP + UB_K + h * 32 + k8, kf); ld8bf(u + (size_t)t * DINP + UB_Q + h * 32 + k8, qf);
            const f4v g0 = *(const f4v*)(GA + (size_t)t * 128 + h * 32 + k8), g1 = *(const f4v*)(GA + (size_t)t * 128 + h * 32 + k8 + 4);
#pragma unroll
            for (int j = 0; j < 8; ++j) { const float a = expf(j < 4 ? g0[j & 3] : g1[j & 3]); S[k8 + j] = a * S[k8 + j] + kf[j] * vv; acc += qf[j] * S[k8 + j]; } }
        Y[(size_t)t * GW + h * 64 + v] = acc * 0.17677669529663687f;
    }
}
HD void mlstm_scan_thread(const Ctx& C, int b, int h, int e) {
    const bf16_t* u = WSP(bf16_t, WS_U); const float* QK = WSP(float, WS_QK); const float* LG = WSP(float, WS_LG);
    float* Y = WSP(float, WS_YC); float* DEN = WSP(float, WS_DEN);
    float S[64];
#pragma unroll
    for (int k = 0; k < 64; ++k) S[k] = 0.f;
    for (int s = 0; s < SEQ; ++s) {
        const int t = b * SEQ + s;
        const float ig = expf(LG[(size_t)t * 8 + h]), fg = expf(LG[(size_t)t * 8 + 4 + h]);
        const float vv = (e < 64 ? ubf(u, t, UC_V + h * 64 + e) : 1.f) * ig;
        float acc = 0.f;
#pragma unroll
        for (int k = 0; k < 64; k += 4) { const f4v kk = *(const f4v*)(QK + (size_t)t * 512 + 256 + h * 64 + k), qq = *(const f4v*)(QK + (size_t)t * 512 + h * 64 + k);
#pragma unroll
            for (int j = 0; j < 4; ++j) { S[k + j] = fg * S[k + j] + kk[j] * vv; acc += qq[j] * S[k + j]; } }
        if (e < 64) Y[(size_t)t * GW + h * 64 + e] = acc; else DEN[(size_t)t * 4 + h] = acc;
    }
}
HD void attn_thread(const Ctx& C, int b, int h, int q, int kmax  ) {
    const bf16_t* Q = WSP(bf16_t, WS_AQ); const bf16_t* K = WSP(bf16_t, WS_AK); const bf16_t* V = WSP(bf16_t, WS_AV); bf16_t* mix = WSP(bf16_t, WS_MIX);
    const int t = b * SEQ + q;
    unsigned qp[48]; float o[64];
#pragma unroll
    for (int d = 0; d < 48; d += 4) { const u4v w = *(const u4v*)(Q + (size_t)t * 384 + h * 96 + 2 * d); qp[d] = w[0]; qp[d + 1] = w[1]; qp[d + 2] = w[2]; qp[d + 3] = w[3]; }
#pragma unroll
    for (int d = 0; d < 64; ++d) o[d] = 0.f;
    float m = -1e30f, lsum = 0.f;
    for (int j = 0; j <= kmax; ++j) {
        const size_t tk = (size_t)b * SEQ + j;
        float sc0 = 0.f, sc1 = 0.f;
#pragma unroll
        for (int d = 0; d < 96; d += 8) { float kf[8]; ld8bf(K + tk * 384 + h * 96 + d, kf);
#pragma unroll
            for (int i = 0; i < 8; i += 2) { const unsigned qw = qp[(d + i) >> 1];
                sc0 += __builtin_bit_cast(float, qw << 16) * kf[i]; sc1 += __builtin_bit_cast(float, qw & 0xffff0000u) * kf[i + 1]; }
            if ((d & 24) == 24) asm volatile("" ::: "memory"); }
        const float sc = sc0 + sc1;
        if (j <= q) {
            const float mn = fmaxf(m, sc); const float corr = exp2f(m - mn), p = exp2f(sc - mn);
            lsum = lsum * corr + p;
#pragma unroll
            for (int d = 0; d < 64; d += 8) { float vf[8]; ld8bf(V + tk * 256 + h * 64 + d, vf);
#pragma unroll
                for (int i = 0; i < 8; ++i) o[d + i] = o[d + i] * corr + p * vf[i];
                if (d & 8) asm volatile("" ::: "memory"); }
            m = mn; }
    }
    const float inv = 1.f / lsum;
#pragma unroll
    for (int d = 0; d < 64; d += 8) { float a[8];
#pragma unroll
        for (int i = 0; i < 8; ++i) a[i] = o[d + i] * inv;
        st8bf(mix + (size_t)t * DMIX + 768 + h * 64 + d, a); }
}

HD void stage_post(const Ctx& C, int l, int gw, int ngw, int lane) {
    const bf16_t* u = WSP(bf16_t, WS_U); bf16_t* mix = WSP(bf16_t, WS_MIX);
    const float* YA = WSP(float, WS_YA); const float* YB = WSP(float, WS_YB); const float* YC = WSP(float, WS_YC); const float* DEN = WSP(float, WS_DEN);
    const float* pR = WSP(float, WS_RW_R); const float* pK = WSP(float, WS_RW_K); const float* pV = WSP(float, WS_RW_V); const float* pG = WSP(float, WS_RW_G);
    const float* rk = INF(I_RK) + l * GW; const float* gng = INF(I_GNG) + l * GW; const float* gnb = INF(I_GNB) + l * GW;
    const float* glag = INF(I_GLA_G) + l * GW; const float* mlng = INF(I_MLN_G) + l * GW;
    constexpr int PL = HD64 / LANES;
    for (int t = gw; t < T; t += ngw) {
        for (int h = 0; h < NH; ++h) {
            {   float y[PL], s1 = 0.f, bon = 0.f;
                for (int i = 0; i < PL; ++i) { const int c = h * 64 + i * LANES + lane; const size_t o = (size_t)t * GW + c; y[i] = YA[o]; s1 += y[i]; bon += pR[o] * pK[o] * rk[c]; }
                s1 = wave_sum(s1); bon = wave_sum(bon); const float mean = s1 * (1.f / 64.f); float s2 = 0.f;
                for (int i = 0; i < PL; ++i) { y[i] -= mean; s2 += y[i] * y[i]; }
                s2 = wave_sum(s2); const float rstd = 1.f / sqrtf(s2 * (1.f / 64.f) + RWKV_GN_EPS);
                for (int i = 0; i < PL; ++i) { const int c = h * 64 + i * LANES + lane; const size_t o = (size_t)t * GW + c;
                    const float v = (y[i] * rstd * gng[c] + gnb[c] + bon * pV[o]) * pG[o]; mix[(size_t)t * DMIX + c] = f2bf(v); } }
            {   float y[PL], s2 = 0.f;
                for (int i = 0; i < PL; ++i) { const int c = h * 64 + i * LANES + lane; y[i] = YB[(size_t)t * GW + c]; s2 += y[i] * y[i]; }
                s2 = wave_sum(s2); const float rstd = 1.f / sqrtf(s2 * (1.f / 64.f) + NORM_EPS);
                for (int i = 0; i < PL; ++i) { const int c = h * 64 + i * LANES + lane;
                    const float v = y[i] * rstd * glag[c] * siluf_(ubf(u, t, UB_G + c)); mix[(size_t)t * DMIX + 256 + c] = f2bf(v); } }
            {   const float den = DEN[(size_t)t * 4 + h]; const float dinv = 1.f / fmaxf(fabsf(den), 1.f);
                float y[PL], s1 = 0.f;
                for (int i = 0; i < PL; ++i) { const int c = h * 64 + i * LANES + lane; y[i] = YC[(size_t)t * GW + c] * dinv; s1 += y[i]; }
                s1 = wave_sum(s1); const float mean = s1 * (1.f / 64.f); float s2 = 0.f;
                for (int i = 0; i < PL; ++i) { y[i] -= mean; s2 += y[i] * y[i]; }
                s2 = wave_sum(s2); const float rstd = 1.f / sqrtf(s2 * (1.f / 64.f) + LN_EPS);
                for (int i = 0; i < PL; ++i) { const int c = h * 64 + i * LANES + lane;
                    const float v = y[i] * rstd * mlng[c] * sigmoidf_(ubf(u, t, UC_O + c)); mix[(size_t)t * DMIX + 512 + c] = f2bf(v); } }
        }
    }
}

HD void ln_row(const float* src, const float* g, const float* b, float* dstf, bf16_t* dstb, int lane, float* keep  ) {
    constexpr int PL = DM / LANES;
    float s1 = 0.f;
#pragma unroll
    for (int i = 0; i < PL; ++i) { keep[i] = src[i * LANES + lane]; s1 += keep[i]; }
    s1 = wave_sum(s1); const float mean = s1 * (1.f / DM); float s2 = 0.f;
#pragma unroll
    for (int i = 0; i < PL; ++i) { keep[i] -= mean; s2 += keep[i] * keep[i]; }
    s2 = wave_sum(s2); const float rstd = 1.f / sqrtf(s2 * (1.f / DM) + LN_EPS);
#pragma unroll
    for (int i = 0; i < PL; ++i) { const int c = i * LANES + lane; keep[i] = keep[i] * rstd * g[c] + b[c]; dstf[c] = keep[i]; dstb[c] = f2bf(keep[i]); }
}
HD void stage_ln1_router(const Ctx& C, int l, int gw, int ngw, int lane, wsh_t sh) {
    float* X1 = C.out; bf16_t* xb = WSP(bf16_t, WS_XB);
    const float* g = INF(I_LN1G) + l * DM; const float* b = INF(I_LN1B) + l * DM;
    const float* wrg = INF(I_WRG) + (size_t)l * DM * NGRP; const float* brg = INF(I_BRG) + l * NGRP;
    const float* wre = INF(I_WRE) + (size_t)l * DM * NEXP; const float* bre = INF(I_BRE) + l * NEXP;
    unsigned* cnt = WSP(unsigned, WS_CTL) + CW_CNT + l * NEXP * 64;
    int* tokinfo = WSP(int, WS_TOKINFO); int* list = WSP(int, WS_LIST);
    constexpr int PL = DM / LANES;
    for (int t = gw; t < T; t += ngw) {
        {   float keep[PL];
            ln_row(X1 + (size_t)t * DM, g, b, X1 + (size_t)t * DM, xb + (size_t)t * DM, lane, keep);
#pragma unroll
            for (int i = 0; i < PL; ++i) sh[i * LANES + lane] = keep[i]; }
        WSYNC();
        float lg[NGRP], le[NEXP];
#pragma unroll
        for (int j = 0; j < NGRP; ++j) lg[j] = 0.f;
#pragma unroll
        for (int j = 0; j < NEXP; ++j) le[j] = 0.f;
#pragma unroll 1
        for (int i = 0; i < PL; ++i) { const int c = i * LANES + lane; const float xv = sh[c];
            const f4v wg = *(const f4v*)(wrg + (size_t)c * NGRP);
#pragma unroll
            for (int j = 0; j < NGRP; ++j) lg[j] += xv * wg[j];
#pragma unroll
            for (int j = 0; j < NEXP; j += 4) { const f4v we = *(const f4v*)(wre + (size_t)c * NEXP + j);
                le[j] += xv * we[0]; le[j + 1] += xv * we[1]; le[j + 2] += xv * we[2]; le[j + 3] += xv * we[3]; } }
        WSYNC();
#pragma unroll
        for (int j = 0; j < NGRP; ++j) lg[j] = wave_sum(lg[j]) + brg[j];
#pragma unroll
        for (int j = 0; j < NEXP; ++j) le[j] = wave_sum(le[j]) + bre[j];
        int gi = 0; float gm = lg[0];
#pragma unroll
        for (int j = 1; j < NGRP; ++j) if (lg[j] > gm) { gm = lg[j]; gi = j; }
        float gs = 0.f;
#pragma unroll
        for (int j = 0; j < NGRP; ++j) gs += expf(lg[j] - gm);
        const float group_p = 1.f / gs;
        float el[EPG];
#pragma unroll
        for (int j = 0; j < EPG; ++j) { float v = le[j];
#pragma unroll
            for (int g2 = 1; g2 < NGRP; ++g2) v = (gi == g2) ? le[g2 * EPG + j] : v;
            el[j] = v; }
        int e0 = 0; float m0 = el[0];
#pragma unroll
        for (int j = 1; j < EPG; ++j) if (el[j] > m0) { m0 = el[j]; e0 = j; }
        int e1 = -1; float m1 = -3.0e38f;
#pragma unroll
        for (int j = 0; j < EPG; ++j) if (j != e0 && el[j] > m1) { m1 = el[j]; e1 = j; }
        const float p1 = expf(m1 - m0); const float g0 = group_p / (1.f + p1), g1 = group_p * p1 / (1.f + p1);
        if (lane == 0) {
            const int E0 = gi * EPG + e0, E1 = gi * EPG + e1;
            tokinfo[(size_t)t * 4 + 0] = E0; tokinfo[(size_t)t * 4 + 1] = E1;
            ((float*)tokinfo)[(size_t)t * 4 + 2] = g0; ((float*)tokinfo)[(size_t)t * 4 + 3] = g1;
            const unsigned s0 = atom_add(cnt + E0 * 64, 1u); list[(size_t)E0 * T + s0] = t * 2 + 0;
            const unsigned s1 = atom_add(cnt + E1 * 64, 1u); list[(size_t)E1 * T + s1] = t * 2 + 1;
        }
    }
}
HD void moe_bases(const Ctx& C, int l, int* base  ) {
    const unsigned* cnt = WSP(unsigned, WS_CTL) + CW_CNT + l * NEXP * 64;
    int acc = 0;
    for (int e = 0; e < NEXP; ++e) { base[e] = acc; acc += ((int)cnt[e * 64] + 255) & ~255; }
    base[NEXP] = acc;
}
HD int moe_expert_of_row(const int* base, int row) { int e = 0; for (int j = 1; j < NEXP; ++j) if (row >= base[j]) e = j; return e; }
HD int moe_lookup(const unsigned* cnt, int row, int& e, int& be, int& ce) {
    int acc = 0; e = 0; be = 0; ce = 0;
    for (int j = 0; j < NEXP; ++j) { const int c = (int)cnt[j * 64]; if (row >= acc) { e = j; be = acc; ce = c; } acc += (c + 255) & ~255; }
    return acc;
}
HD void stage_gather(const Ctx& C, int l, int gw, int ngw, int lane) {
    const unsigned* cnt = WSP(unsigned, WS_CTL) + CW_CNT + l * NEXP * 64;
    const int* list = WSP(int, WS_LIST); const int* tokinfo = WSP(int, WS_TOKINFO);
    const bf16_t* xb = WSP(bf16_t, WS_XB); bf16_t* xg = WSP(bf16_t, WS_XG); int* rowinfo = WSP(int, WS_ROWINFO); float* rowgate = WSP(float, WS_ROWGATE);
    int e, be, ce; const int total = moe_lookup(cnt, 0, e, be, ce);
    for (int row = gw; row < total; row += ngw) {
        moe_lookup(cnt, row, e, be, ce);
        const int slot = row - be;
        if (slot < ce) { const int ent = list[(size_t)e * T + slot]; const int tok = ent >> 1;
            for (int c = lane * 8; c < DM; c += LANES * 8) *(u4v*)(xg + (size_t)row * DM + c) = *(const u4v*)(xb + (size_t)tok * DM + c);
            if (lane == 0) { rowinfo[row] = ent; rowgate[row] = ((const float*)tokinfo)[(size_t)tok * 4 + 2 + (ent & 1)]; } }
        else { const u4v z = {0u, 0u, 0u, 0u}; for (int c = lane * 8; c < DM; c += LANES * 8) *(u4v*)(xg + (size_t)row * DM + c) = z;
            if (lane == 0) { rowinfo[row] = -1; rowgate[row] = 0.f; } }
    }
}
HD void stage_ln2(const Ctx& C, int l, int gw, int ngw, int lane) {
    const float* src = WSP(float, WS_X); float* dst = (l == DEPTH - 1) ? C.out : WSP(float, WS_X); bf16_t* xb = WSP(bf16_t, WS_XB);
    const float* g = INF(I_LN2G) + l * DM; const float* b = INF(I_LN2B) + l * DM;
    constexpr int PL = DM / LANES;
    for (int t = gw; t < T; t += ngw) { float keep[PL]; ln_row(src + (size_t)t * DM, g, b, dst + (size_t)t * DM, xb + (size_t)t * DM, lane, keep); }
}

struct EpiU {
    static constexpr bool PERM = true; static constexpr int MODE = 0;
    bf16_t* o;
    HDM void put8(int row, int col, const float* a) const { st8bf(o + (size_t)row * DINP + col, a); }
};
struct EpiPP {
    static constexpr bool PERM = true; static constexpr int MODE = 0;
    bf16_t* o;
    HDM void put8(int row, int col, const float* a) const { st8bf(o + (size_t)row * DM + col, a); }
};
struct EpiPre1 {
    static constexpr bool PERM = false; static constexpr int MODE = 0;
    const float* x; float* o;
    HDM void put4(int row, int col, const float* a) const { const float al = dn_alpha(); const f4v xr = *(const f4v*)(x + (size_t)row * DM + col);
        f4v r; for (int j = 0; j < 4; ++j) r[j] = al * xr[j] + a[j]; *(f4v*)(o + (size_t)row * DM + col) = r; }
};
struct EpiH {
    static constexpr bool PERM = true; static constexpr int MODE = 1;
    bf16_t* o;
    HDM void put8gu(int row, int hcol, const float* g, const float* u) const { float v[8]; for (int j = 0; j < 8; ++j) v[j] = siluf_(g[j]) * u[j];
        st8bf(o + (size_t)row * DEXP + hcol, v); }
};
struct EpiY {
    static constexpr bool PERM = true; static constexpr int MODE = 0;
    const int* rowinfo; const float* rowgate; bf16_t* o;
    HDM void put8(int row, int col, const float* a) const { const int ent = rowinfo[row]; if (ent < 0) return; const float g = rowgate[row];
        float v[8]; for (int j = 0; j < 8; ++j) v[j] = g * a[j]; st8bf(o + (size_t)ent * DM + col, v); }
};
struct EpiPre2 {
    static constexpr bool PERM = false; static constexpr int MODE = 0;
    const float* x1; const bf16_t* ybuf; const bf16_t* pp; const float* bg; float* o;
    HDM void put4(int row, int col, const float* a) const { const float al = dn_alpha(); const size_t i = (size_t)row * DM + col;
        const f4v xr = *(const f4v*)(x1 + i); const f4v bgv = *(const f4v*)(bg + col);
        const unsigned* y0 = (const unsigned*)(ybuf + (size_t)(2 * row) * DM + col); const unsigned* y1 = (const unsigned*)(ybuf + (size_t)(2 * row + 1) * DM + col); const unsigned* pq = (const unsigned*)(pp + i);
        const unsigned y00 = y0[0], y01 = y0[1], y10 = y1[0], y11 = y1[1], p0 = pq[0], p1 = pq[1];
        float yv[4] = { __builtin_bit_cast(float, y00 << 16) + __builtin_bit_cast(float, y10 << 16), __builtin_bit_cast(float, y00 & 0xffff0000u) + __builtin_bit_cast(float, y10 & 0xffff0000u),
                        __builtin_bit_cast(float, y01 << 16) + __builtin_bit_cast(float, y11 << 16), __builtin_bit_cast(float, y01 & 0xffff0000u) + __builtin_bit_cast(float, y11 & 0xffff0000u) };
        float pv[4] = { __builtin_bit_cast(float, p0 << 16), __builtin_bit_cast(float, p0 & 0xffff0000u), __builtin_bit_cast(float, p1 << 16), __builtin_bit_cast(float, p1 & 0xffff0000u) };
        f4v r; for (int j = 0; j < 4; ++j) r[j] = al * xr[j] + yv[j] + sigmoidf_(a[j] + bgv[j]) * pv[j];
        *(f4v*)(o + i) = r; }
};

#ifndef CPU_TEST
struct EpiQ {
    static constexpr bool PERM = true; static constexpr int MODE = 0;
    const float* rope; bf16_t* o;
    __device__ __forceinline__ void put8(int row, int col, const float* a) const {
        float p[8];
#pragma unroll
        for (int j = 0; j < 8; ++j) p[j] = __shfl_xor(a[j], 32);
        if (col >= 384) return;
        const float qscale = 0.10206207261596575f * 1.4426950408889634f;
        const int d0 = col % 96; float v[8];
        if (d0 < 64) {
#pragma unroll
            for (int j = 0; j < 8; ++j) v[j] = a[j] * qscale; }
        else { const int i0 = (d0 - 64) & 15; const bool x2 = (d0 - 64) >= 16; const float* rt = rope + (size_t)row * 32 + i0;
            const f4v c0 = *(const f4v*)rt, c1 = *(const f4v*)(rt + 4), s0 = *(const f4v*)(rt + 16), s1 = *(const f4v*)(rt + 20);
#pragma unroll
            for (int j = 0; j < 8; ++j) { const float c = j < 4 ? c0[j & 3] : c1[j & 3], s = j < 4 ? s0[j & 3] : s1[j & 3];
                v[j] = (x2 ? (p[j] * s + a[j] * c) : (a[j] * c - p[j] * s)) * qscale; } }
        st8bf(o + (size_t)row * 384 + col, v); }
};
struct EpiKV {
    static constexpr bool PERM = true; static constexpr int MODE = 0;
    bf16_t* k; bf16_t* v;
    __device__ __forceinline__ void put8(int row, int col, const float* a) const { const int h = col >> 7, d = col & 127;
        if (d < 64) st8bf(k + (size_t)row * 384 + h * 96 + d, a); else st8bf(v + (size_t)row * 256 + h * 64 + (d - 64), a); }
};
__device__ __forceinline__ void mla_token_pass(const Ctx& C, int gw, int ngw, int lane) {
    const bf16_t* u = WSP(bf16_t, WS_U); const float* rope = WSP(float, WS_ROPE); float* rstd = WSP(float, WS_RSTD); bf16_t* K = WSP(bf16_t, WS_AK);
    for (int t = gw; t < T; t += ngw) {
        const bf16_t* ur = u + (size_t)t * DINP;
        float ssq = 0.f, sskv = 0.f;
        { const unsigned* p = (const unsigned*)(ur + UD_CQ) + 2 * lane; const unsigned w0 = p[0], w1 = p[1];
          const float a = __builtin_bit_cast(float, w0 << 16), b = __builtin_bit_cast(float, w0 & 0xffff0000u), c = __builtin_bit_cast(float, w1 << 16), d = __builtin_bit_cast(float, w1 & 0xffff0000u);
          ssq = (a * a + b * b) + (c * c + d * d); }
        { const unsigned w0 = ((const unsigned*)(ur + UD_CKV))[lane]; const float a = __builtin_bit_cast(float, w0 << 16), b = __builtin_bit_cast(float, w0 & 0xffff0000u); sskv = a * a + b * b; }
        ssq = wave_sum(ssq); sskv = wave_sum(sskv);
        if (lane == 0) { rstd[(size_t)t * 2] = 1.f / sqrtf(ssq * (1.f / 256.f) + NORM_EPS); rstd[(size_t)t * 2 + 1] = 1.f / sqrtf(sskv * (1.f / 128.f) + NORM_EPS); }
        { const int i = lane & 15, hh = lane >> 4; const float x1 = bf2f(ur[UD_KR + i]), x2 = bf2f(ur[UD_KR + 16 + i]); const float c = rope[(size_t)t * 32 + i], s = rope[(size_t)t * 32 + 16 + i];
          bf16_t* kd = K + (size_t)t * 384 + hh * 96 + 64; kd[i] = f2bf(x1 * c - x2 * s); kd[16 + i] = f2bf(x1 * s + x2 * c); }
    }
}
__device__ __forceinline__ void rwkv_prep_coop(const Ctx& C, int l, __attribute__((address_space(3))) unsigned char* lds) {
    int tid = threadIdx.x; asm volatile("" : "+v"(tid));
    const int lane = tid & 63, w = __builtin_amdgcn_readfirstlane(tid >> 6);
    const bf16_t* u = WSP(bf16_t, WS_U);
    const float* mu = INF(I_MU) + l * DINA;
    float* oR = WSP(float, WS_RW_R); float* oW = WSP(float, WS_RW_W); float* oK = WSP(float, WS_RW_K); float* oV = WSP(float, WS_RW_V);
    float* oA = WSP(float, WS_RW_A); float* oB = WSP(float, WS_RW_B); float* oG = WSP(float, WS_RW_G);
    __attribute__((address_space(3))) float* act = (__attribute__((address_space(3))) float*)lds;
    const int h = w & 3, role = w >> 2, c = h * 64 + lane;
    float wc0[32], wc1[32];
    { const float* p0 = role == 0 ? INF(I_WUP) + l * 32 * GW + c : INF(I_GUP) + l * 64 * GW + c;
      const float* p1 = role == 0 ? INF(I_AUP) + l * 32 * GW + c : INF(I_GUP) + l * 64 * GW + 32 * GW + c;
#pragma unroll
      for (int j = 0; j < 32; ++j) { wc0[j] = p0[j * GW]; wc1[j] = p1[j * GW]; } }
    const float w0c = INF(I_W0)[l * GW + c], a0c = INF(I_A0)[l * GW + c], kkc = INF(I_KK)[l * GW + c], kac = INF(I_KA)[l * GW + c];
    const float mur = mu[UA_R + c], muk = mu[UA_K + c], muv = mu[UA_V + c];
    for (int unit = blockIdx.x; unit < T / 16; unit += gridDim.x) {
        const int t0 = unit * 16;
        { const int tk = tid >> 5, j0 = (tid & 31) * 4; const int t = t0 + tk; const bool first = (t % SEQ) == 0;
          const unsigned* pc = (const unsigned*)(u + (size_t)t * DINP + UA_WD + j0); const unsigned c0 = pc[0], c1 = pc[1];
          unsigned q0 = 0u, q1 = 0u; if (!first) { const unsigned* pp = (const unsigned*)(u + (size_t)(t - 1) * DINP + UA_WD + j0); q0 = pp[0]; q1 = pp[1]; }
          const float cur[4] = {__builtin_bit_cast(float, c0 << 16), __builtin_bit_cast(float, c0 & 0xffff0000u), __builtin_bit_cast(float, c1 << 16), __builtin_bit_cast(float, c1 & 0xffff0000u)};
          const float prv[4] = {__builtin_bit_cast(float, q0 << 16), __builtin_bit_cast(float, q0 & 0xffff0000u), __builtin_bit_cast(float, q1 << 16), __builtin_bit_cast(float, q1 & 0xffff0000u)};
          f4v o;
#pragma unroll
          for (int j = 0; j < 4; ++j) { const float v = cur[j] + (prv[j] - cur[j]) * mu[UA_WD + j0 + j]; o[j] = (j0 < 32) ? tanhf(v) : (j0 < 64 ? v : sigmoidf_(v)); }
          *(__attribute__((address_space(3))) f4v*)(act + tk * 128 + j0) = o; }
        __syncthreads();
#pragma unroll 1
        for (int tk = 0; tk < 16; ++tk) { const int t = t0 + tk; const bool first = (t % SEQ) == 0;
            const __attribute__((address_space(3))) float* ar = act + tk * 128 + (role == 0 ? 0 : 64);
            float s0 = 0.f, s1 = 0.f;
#pragma unroll
            for (int j = 0; j < 32; j += 4) { const f4v x = *(const __attribute__((address_space(3))) f4v*)(ar + j), y = *(const __attribute__((address_space(3))) f4v*)(ar + 32 + j);
                s0 += x[0] * wc0[j] + x[1] * wc0[j + 1] + x[2] * wc0[j + 2] + x[3] * wc0[j + 3]; s1 += y[0] * wc1[j] + y[1] * wc1[j + 1] + y[2] * wc1[j + 2] + y[3] * wc1[j + 3];
                if ((j & 12) == 12) asm volatile("" ::: "memory"); }
            const size_t o = (size_t)t * GW + c;
            if (role == 1) { oG[o] = s0 + s1; }
            else {
                const float z = w0c + s0, za = a0c + s1;
                const float lnl = -softplusf_(-z) - 0.5f; const float decay = __expf(-__expf(lnl)); const float a = sigmoidf_(za);
                const bf16_t* uc = u + (size_t)t * DINP + c; const bf16_t* up = uc - DINP;
                const float rc = bf2f(uc[UA_R]), kc = bf2f(uc[UA_K]), vc = bf2f(uc[UA_V]);
                const float rp = first ? 0.f : bf2f(up[UA_R]), kp = first ? 0.f : bf2f(up[UA_K]), vp = first ? 0.f : bf2f(up[UA_V]);
                const float r = rc + (rp - rc) * mur, k = kc + (kp - kc) * muk, v = vc + (vp - vc) * muv;
                const float kkraw = k * kkc; const float ss = wave_sum(kkraw * kkraw); const float kk = kkraw / fmaxf(sqrtf(ss), 1e-12f);
                oR[o] = r; oW[o] = decay; oK[o] = k * (1.f + (a - 1.f) * kac); oV[o] = v; oA[o] = -kk; oB[o] = kk * a; } }
        __syncthreads();
    }
}
#endif

#ifndef CPU_TEST
namespace pg8 {
#define PG8_LAS __attribute__((address_space(3)))
typedef short bf16x8 __attribute__((ext_vector_type(8)));
typedef float f32x4 __attribute__((ext_vector_type(4)));
constexpr int BM = 256, BK = 64, HALF = 128, HTB = HALF * BK * 2, STAGE_BYTES = 8 * HTB;
__device__ __forceinline__ int lds_byte(int r, int c) { const int st = (r >> 4) * 2 + (c >> 5), rr = r & 15, cc = c & 31, ob = rr * 64 + cc * 2; return st * 1024 + (ob ^ (((ob >> 9) & 1) << 5)); }
__device__ __forceinline__ void stage_rc(int b, int& R, int& C) { const int st = b / 1024, sb = b % 1024, swz = sb ^ (((sb >> 9) & 1) << 5); R = (st >> 1) * 16 + swz / 64; C = (st & 1) * 32 + (swz % 64) / 2; }
__device__ __forceinline__ int perm32(int rho) { const int n = rho >> 4, i = rho & 15; return 8 * (i >> 2) + 4 * n + (i & 3); }
struct Unit { int pm, pn; long aoff, boff; };
struct Gemm { const bf16_t* A; const bf16_t* Bt; int lda, ldb, K; };

template <class F> __device__ __forceinline__ void run_epi(const F& f, const f32x4 (&acc)[2][2][4][2], const Unit& u, int wr, int wc, int fr, int fq) {
#pragma unroll
    for (int ai = 0; ai < 2; ++ai)
#pragma unroll
        for (int m = 0; m < 4; ++m) { const int row = u.pm * BM + ai * HALF + wr * 64 + m * 16 + fr;
            if constexpr (F::MODE == 1) { const int hcol = u.pn * 128 + wc * 32 + 8 * fq; float g[8], up[8];
#pragma unroll
                for (int j = 0; j < 4; ++j) { g[j] = acc[ai][0][m][0][j]; g[4 + j] = acc[ai][0][m][1][j]; up[j] = acc[ai][1][m][0][j]; up[4 + j] = acc[ai][1][m][1][j]; }
                f.put8gu(row, hcol, g, up); }
            else if constexpr (F::PERM) {
#pragma unroll
                for (int bj = 0; bj < 2; ++bj) { const int col = u.pn * BM + bj * HALF + wc * 32 + 8 * fq; float a[8];
#pragma unroll
                    for (int j = 0; j < 4; ++j) { a[j] = acc[ai][bj][m][0][j]; a[4 + j] = acc[ai][bj][m][1][j]; }
                    f.put8(row, col, a); } }
            else {
#pragma unroll
                for (int bj = 0; bj < 2; ++bj)
#pragma unroll
                    for (int n = 0; n < 2; ++n) { const int col = u.pn * BM + bj * HALF + wc * 32 + 16 * n + 4 * fq; float a[4];
#pragma unroll
                        for (int j = 0; j < 4; ++j) a[j] = acc[ai][bj][m][n][j];
                        f.put4(row, col, a); } }
        }
}

template <class Epi, class Sched>
__device__ __forceinline__ void gemm_phase(PG8_LAS unsigned char* lds, const Gemm g, const Sched& S, const Epi& E) {
    int tid = threadIdx.x; asm volatile("" : "+v"(tid));
    const int wid = __builtin_amdgcn_readfirstlane(tid >> 6), lane = tid & 63, wr = wid >> 2, wc = wid & 3, fr = lane & 15, fq = lane >> 4;
    const int K = g.K, nt = K / BK;
    unsigned voffA[2], voffB[2];
#pragma unroll
    for (int i = 0; i < 2; ++i) { int R, C; stage_rc(tid * 16 + i * 8192, R, C); const int Rb = Epi::PERM ? ((R & ~31) + perm32(R & 31)) : R;
        voffA[i] = (unsigned)(R * g.lda + C) * 2u; voffB[i] = (unsigned)(Rb * g.ldb + C) * 2u; }
    const size_t kstep = (size_t)(BK * 2);
    const size_t hstepA = (size_t)HALF * g.lda * 2, hstepB = (size_t)HALF * g.ldb * 2;
    const unsigned ldsw = (unsigned)wid * 1024u;
    const int aoff = lds_byte(wr * 64 + fr, fq * 8), boff = lds_byte(wc * 32 + fr, fq * 8);
#define PG8_SA(b, h) (((b) * 2 + (h)) * HTB)
#define PG8_SB(b, h) ((4 + (b) * 2 + (h)) * HTB)
#define PG8_STAGE(bufoff, gbase, voff) do { _Pragma("unroll") for (int _i = 0; _i < 2; ++_i) \
        __builtin_amdgcn_global_load_lds((const unsigned*)((const char*)(gbase) + (voff)[_i]), (PG8_LAS unsigned*)(lds + (bufoff) + ldsw + _i * 8192), 16, 0, 0); } while (0)
#define PG8_LDA(dst, b, h) do { _Pragma("unroll") for (int m = 0; m < 4; ++m) _Pragma("unroll") for (int k = 0; k < 2; ++k) dst[m][k] = *(const PG8_LAS bf16x8*)(lds + PG8_SA(b, h) + aoff + m * 2048 + k * 1024); } while (0)
#define PG8_LDB(dst, b, h) do { _Pragma("unroll") for (int n = 0; n < 2; ++n) _Pragma("unroll") for (int k = 0; k < 2; ++k) dst[n][k] = *(const PG8_LAS bf16x8*)(lds + PG8_SB(b, h) + boff + n * 2048 + k * 1024); } while (0)
#define PG8_MMA(ai, bj, At, Bt) do { __builtin_amdgcn_s_setprio(1); _Pragma("unroll") for (int m = 0; m < 4; ++m) _Pragma("unroll") for (int n = 0; n < 2; ++n) _Pragma("unroll") for (int k = 0; k < 2; ++k) \
        acc[ai][bj][m][n] = __builtin_amdgcn_mfma_f32_16x16x32_bf16(Bt[n][k], At[m][k], acc[ai][bj][m][n], 0, 0, 0); __builtin_amdgcn_s_setprio(0); } while (0)
#define PG8_WAIT_V(n) asm volatile("s_waitcnt vmcnt(" #n ")" ::: "memory")
#define PG8_WAIT_L(n) asm volatile("s_waitcnt lgkmcnt(" #n ")" ::: "memory")
#define PG8_BAR __builtin_amdgcn_s_barrier()
#define PG8_SCHED __builtin_amdgcn_sched_barrier(0)
    Unit cur, nxt; int ui = 0;
    if (!S.next(0, cur)) return;
    f32x4 acc[2][2][4][2];
#pragma unroll
    for (int a = 0; a < 2; ++a)
#pragma unroll
        for (int b = 0; b < 2; ++b)
#pragma unroll
            for (int m = 0; m < 4; ++m)
#pragma unroll
                for (int n = 0; n < 2; ++n) acc[a][b][m][n] = (f32x4){0.f, 0.f, 0.f, 0.f};
    bf16x8 At[4][2], B0[2][2], B1[2][2];
    const char* cA = (const char*)g.A + cur.aoff; const char* cB = (const char*)g.Bt + cur.boff;
    PG8_STAGE(PG8_SB(0, 0), cB, voffB); PG8_STAGE(PG8_SA(0, 0), cA, voffA); PG8_STAGE(PG8_SB(0, 1), cB + hstepB, voffB); PG8_STAGE(PG8_SA(0, 1), cA + hstepA, voffA);
    if (wr == 1) PG8_BAR;
    PG8_WAIT_V(4); PG8_BAR;
    PG8_STAGE(PG8_SB(1, 0), cB + kstep, voffB); PG8_STAGE(PG8_SA(1, 0), cA + kstep, voffA); PG8_STAGE(PG8_SB(1, 1), cB + hstepB + kstep, voffB);
    PG8_WAIT_V(6); PG8_BAR;
    for (;;) {
        const bool has_next = S.next(ui + 1, nxt);
        const char* nA = has_next ? (const char*)g.A + nxt.aoff : cA; const char* nB = has_next ? (const char*)g.Bt + nxt.boff : cB;
_Pragma("unroll 1")
        for (int t = 0; t < nt; t += 2) {
            const bool last = (t == nt - 2);
            const char* a1 = cA + (size_t)(t + 1) * kstep;
            const char* a2 = last ? nA : cA + (size_t)(t + 2) * kstep; const char* b2 = last ? nB : cB + (size_t)(t + 2) * kstep;
            const char* a3 = a2 + kstep; const char* b3 = b2 + kstep;
            PG8_LDB(B0, 0, 0); PG8_SCHED; PG8_LDA(At, 0, 0); PG8_STAGE(PG8_SA(1, 1), a1 + hstepA, voffA);
            PG8_WAIT_L(8); PG8_BAR; PG8_WAIT_L(0); PG8_MMA(0, 0, At, B0); PG8_BAR; PG8_SCHED;
            PG8_LDB(B1, 0, 1); PG8_STAGE(PG8_SB(0, 0), b2, voffB);
            PG8_BAR; PG8_WAIT_L(0); PG8_MMA(0, 1, At, B1); PG8_BAR;
            PG8_LDA(At, 0, 1); PG8_STAGE(PG8_SA(0, 0), a2, voffA);
            PG8_BAR; PG8_WAIT_L(0); PG8_MMA(1, 0, At, B0); PG8_BAR; PG8_SCHED;
            PG8_STAGE(PG8_SB(0, 1), b2 + hstepB, voffB);
            PG8_WAIT_V(6); PG8_BAR; PG8_MMA(1, 1, At, B1); PG8_BAR;
            PG8_LDB(B0, 1, 0); PG8_SCHED; PG8_LDA(At, 1, 0); PG8_STAGE(PG8_SA(0, 1), a2 + hstepA, voffA);
            PG8_WAIT_L(8); PG8_BAR; PG8_WAIT_L(0); PG8_MMA(0, 0, At, B0); PG8_BAR; PG8_SCHED;
            PG8_LDB(B1, 1, 1); PG8_STAGE(PG8_SB(1, 0), b3, voffB);
            PG8_BAR; PG8_WAIT_L(0); PG8_MMA(0, 1, At, B1); PG8_BAR;
            PG8_LDA(At, 1, 1); PG8_STAGE(PG8_SA(1, 0), a3, voffA);
            PG8_BAR; PG8_WAIT_L(0); PG8_MMA(1, 0, At, B0); PG8_BAR; PG8_SCHED;
            PG8_STAGE(PG8_SB(1, 1), b3 + hstepB, voffB);
            PG8_WAIT_V(6); PG8_BAR; PG8_MMA(1, 1, At, B1); PG8_BAR;
        }
        run_epi(E, acc, cur, wr, wc, fr, fq);
        if (!has_next) break;
#pragma unroll
        for (int a = 0; a < 2; ++a)
#pragma unroll
            for (int b = 0; b < 2; ++b)
#pragma unroll
                for (int m = 0; m < 4; ++m)
#pragma unroll
                    for (int n = 0; n < 2; ++n) acc[a][b][m][n] = (f32x4){0.f, 0.f, 0.f, 0.f};
        cur = nxt; cA = nA; cB = nB; ++ui;
    }
    PG8_WAIT_V(0);
    if (wr == 0) PG8_BAR;
    PG8_BAR;
#undef PG8_SA
#undef PG8_SB
#undef PG8_STAGE
#undef PG8_LDA
#undef PG8_LDB
#undef PG8_MMA
#undef PG8_WAIT_V
#undef PG8_WAIT_L
#undef PG8_BAR
#undef PG8_SCHED
}
struct DenseOrder {
    int nM, nN, G, c; long astep, bstep;
    __device__ __forceinline__ bool next(int i, Unit& u) const {
        const long L = (long)i * G + c; if (L >= (long)nM * nN) return false;
        const int w = (int)L; const int nig = 8 * nN, gid = w / nig, fm = gid * 8, gsz = (nM - fm) < 8 ? (nM - fm) : 8;
        u.pm = fm + ((w % nig) % gsz); u.pn = (w % nig) / gsz; u.aoff = (long)u.pm * astep; u.boff = (long)u.pn * bstep; return true; }
};
struct MoeOrder {
    const PG8_LAS int* tbl; int nM, nN, G, c; long astep, bstep, estep;
    __device__ __forceinline__ bool next(int i, Unit& u) const {
        const long L = (long)i * G + c; if (L >= (long)nM * nN) return false;
        const int w = (int)L; u.pm = w / nN; u.pn = w % nN; const int e = tbl[u.pm];
        u.aoff = (long)u.pm * astep; u.boff = (long)e * estep + (long)u.pn * bstep; return true; }
};
}
#endif

#ifndef CPU_TEST
namespace att {
typedef short bf16x8 __attribute__((ext_vector_type(8)));
typedef short s16x4 __attribute__((ext_vector_type(4)));
typedef float f32x16 __attribute__((ext_vector_type(16)));
typedef float f32x2_t __attribute__((ext_vector_type(2))); typedef __bf16 bf16x2_t __attribute__((ext_vector_type(2)));
typedef unsigned u32x4 __attribute__((ext_vector_type(4)));
typedef unsigned u32x2 __attribute__((ext_vector_type(2)));
#define ATT_LAS __attribute__((address_space(3)))
constexpr int KP = 104, VP = 68;
constexpr int KBUF = 64 * KP * 2, VBUF = 64 * VP * 2;
constexpr int LDS_NEED = 2 * KBUF + 2 * VBUF;
__device__ __forceinline__ unsigned cvtpk(float lo, float hi) { f32x2_t v = {lo, hi}; bf16x2_t b = __builtin_convertvector(v, bf16x2_t); return __builtin_bit_cast(unsigned, b); }
__device__ __forceinline__ int crow(int r, int hi) { return (r & 3) + 8 * (r >> 2) + 4 * hi; }
__device__ __forceinline__ u32x4 scale8(const u32x4& w, float s) { u32x4 o;
#pragma unroll
    for (int j = 0; j < 4; ++j) o[j] = cvtpk(__builtin_bit_cast(float, w[j] << 16) * s, __builtin_bit_cast(float, w[j] & 0xffff0000u) * s);
    return o; }
__device__ __forceinline__ void unit(ATT_LAS unsigned char* lds, const bf16_t* Q, const bf16_t* K, const bf16_t* V, const float* rstd, bf16_t* mix, int b, int h, int qb) {
    int tid = threadIdx.x; asm volatile("" : "+v"(tid));
    const int lane = tid & 63, w = __builtin_amdgcn_readfirstlane(tid >> 6), r32 = lane & 31, hi = lane >> 5;
    const size_t tb = (size_t)b * SEQ;
    const int q = qb * 256 + w * 32 + r32;
    bf16x8 qr[6];
    { const bf16_t* qrow = Q + (tb + q) * 384 + h * 96 + 8 * hi;
      const float rq = rstd[(tb + q) * 2];
#pragma unroll
      for (int ks = 0; ks < 6; ++ks) qr[ks] = __builtin_bit_cast(bf16x8, scale8(*(const u32x4*)(qrow + 16 * ks), rq)); }
    f32x16 o0, o1;
#pragma unroll
    for (int r = 0; r < 16; ++r) { o0[r] = 0.f; o1[r] = 0.f; }
    float m = -1e30f, lsum = 0.f;
    const int NT = 4 * (qb + 1);
    const int kr0 = tid / 12, kp0 = tid % 12, kr1 = (tid + 512) / 12, kp1 = (tid + 512) % 12; const bool has1 = tid < 256;
    const int vk = tid >> 3, vp = tid & 7;
    const bf16_t* gK0 = K + (tb + kr0) * 384 + h * 96 + kp0 * 8; const bf16_t* gK1 = K + (tb + kr1) * 384 + h * 96 + kp1 * 8;
    const bf16_t* gV = V + (tb + vk) * 256 + h * 64 + vp * 8;
    u32x4 sk0, sk1, sv; sk1 = (u32x4){0u, 0u, 0u, 0u};
    const float* gR0 = rstd + (tb + kr0) * 2 + 1; const float* gR1 = rstd + (tb + kr1) * 2 + 1; const float* gRv = rstd + (tb + vk) * 2 + 1;
    float s0 = gR0[0], s1 = has1 ? gR1[0] : 0.f, s2 = gRv[0];
    sk0 = *(const u32x4*)gK0; if (has1) sk1 = *(const u32x4*)gK1; sv = *(const u32x4*)gV;
#define ATT_WRITE(buf) do { \
        if (kp0 < 8) sk0 = scale8(sk0, s0); if (kp1 < 8) sk1 = scale8(sk1, s1); sv = scale8(sv, s2); \
        *(ATT_LAS u32x4*)(lds + (buf) * KBUF + (kr0 * KP + kp0 * 8) * 2) = sk0; \
        if (has1) *(ATT_LAS u32x4*)(lds + (buf) * KBUF + (kr1 * KP + kp1 * 8) * 2) = sk1; \
        ATT_LAS unsigned short* vt_ = (ATT_LAS unsigned short*)(lds + 2 * KBUF + (buf) * VBUF); \
        _Pragma("unroll") for (int j = 0; j < 4; ++j) { vt_[(8 * vp + 2 * j) * VP + vk] = (unsigned short)(sv[j] & 0xffffu); vt_[(8 * vp + 2 * j + 1) * VP + vk] = (unsigned short)(sv[j] >> 16); } } while (0)
    ATT_WRITE(0);
    __syncthreads();
    for (int t = 0; t < NT; ++t) {
        const int buf = t & 1;
        if (t + 1 < NT) { const size_t adv = (size_t)(t + 1) * 64; sk0 = *(const u32x4*)(gK0 + adv * 384); if (has1) sk1 = *(const u32x4*)(gK1 + adv * 384); sv = *(const u32x4*)(gV + adv * 256);
            s0 = gR0[adv * 2]; if (has1) s1 = gR1[adv * 2]; s2 = gRv[adv * 2]; }
        f32x16 p0, p1;
#pragma unroll
        for (int r = 0; r < 16; ++r) { p0[r] = 0.f; p1[r] = 0.f; }
        { ATT_LAS const unsigned char* kb = lds + buf * KBUF + (r32 * KP + 8 * hi) * 2;
#pragma unroll
          for (int ks = 0; ks < 6; ++ks) { const bf16x8 a0 = *(ATT_LAS const bf16x8*)(kb + ks * 32), a1 = *(ATT_LAS const bf16x8*)(kb + 32 * KP * 2 + ks * 32);
              p0 = __builtin_amdgcn_mfma_f32_32x32x16_bf16(a0, qr[ks], p0, 0, 0, 0); p1 = __builtin_amdgcn_mfma_f32_32x32x16_bf16(a1, qr[ks], p1, 0, 0, 0); } }
        if (t >= NT - 4) {
            const int k0 = t * 64;
#pragma unroll
            for (int r = 0; r < 16; ++r) { const int kk = k0 + crow(r, hi); if (kk > q) p0[r] = -1e30f; if (kk + 32 > q) p1[r] = -1e30f; } }
        float rm = p0[0];
#pragma unroll
        for (int r = 1; r < 16; ++r) rm = fmaxf(rm, p0[r]);
#pragma unroll
        for (int r = 0; r < 16; ++r) rm = fmaxf(rm, p1[r]);
        rm = fmaxf(rm, __shfl_xor(rm, 32));
        const float mn = fmaxf(m, rm); const float alpha = __builtin_amdgcn_exp2f(m - mn); m = mn;
        float ps = 0.f;
#pragma unroll
        for (int r = 0; r < 16; ++r) { p0[r] = __builtin_amdgcn_exp2f(p0[r] - mn); p1[r] = __builtin_amdgcn_exp2f(p1[r] - mn); ps += p0[r] + p1[r]; }
        lsum = lsum * alpha + ps;
#pragma unroll
        for (int r = 0; r < 16; ++r) { o0[r] *= alpha; o1[r] *= alpha; }
        { ATT_LAS const unsigned char* vb = lds + 2 * KBUF + buf * VBUF + (r32 * VP + 4 * hi) * 2;
#pragma unroll
          for (int s = 0; s < 4; ++s) {
              u32x4 pw;
              if (s == 0) pw = (u32x4){cvtpk(p0[0], p0[1]), cvtpk(p0[2], p0[3]), cvtpk(p0[4], p0[5]), cvtpk(p0[6], p0[7])};
              else if (s == 1) pw = (u32x4){cvtpk(p0[8], p0[9]), cvtpk(p0[10], p0[11]), cvtpk(p0[12], p0[13]), cvtpk(p0[14], p0[15])};
              else if (s == 2) pw = (u32x4){cvtpk(p1[0], p1[1]), cvtpk(p1[2], p1[3]), cvtpk(p1[4], p1[5]), cvtpk(p1[6], p1[7])};
              else pw = (u32x4){cvtpk(p1[8], p1[9]), cvtpk(p1[10], p1[11]), cvtpk(p1[12], p1[13]), cvtpk(p1[14], p1[15])};
              const bf16x8 pb = __builtin_bit_cast(bf16x8, pw);
              const u32x2 a00 = *(ATT_LAS const u32x2*)(vb + s * 32), a01 = *(ATT_LAS const u32x2*)(vb + s * 32 + 16);
              const u32x2 a10 = *(ATT_LAS const u32x2*)(vb + 32 * VP * 2 + s * 32), a11 = *(ATT_LAS const u32x2*)(vb + 32 * VP * 2 + s * 32 + 16);
              const bf16x8 va0 = __builtin_bit_cast(bf16x8, (u32x4){a00[0], a00[1], a01[0], a01[1]}), va1 = __builtin_bit_cast(bf16x8, (u32x4){a10[0], a10[1], a11[0], a11[1]});
              o0 = __builtin_amdgcn_mfma_f32_32x32x16_bf16(va0, pb, o0, 0, 0, 0); o1 = __builtin_amdgcn_mfma_f32_32x32x16_bf16(va1, pb, o1, 0, 0, 0); } }
        if (t + 1 < NT) ATT_WRITE(buf ^ 1);
        __syncthreads();
    }
#undef ATT_WRITE
    lsum += __shfl_xor(lsum, 32);
    const float inv = 1.f / lsum;
    bf16_t* orow = mix + (tb + q) * DMIX + 768 + h * 64;
#pragma unroll
    for (int rg = 0; rg < 4; ++rg) {
        u32x2 w0 = {cvtpk(o0[4 * rg] * inv, o0[4 * rg + 1] * inv), cvtpk(o0[4 * rg + 2] * inv, o0[4 * rg + 3] * inv)};
        u32x2 w1 = {cvtpk(o1[4 * rg] * inv, o1[4 * rg + 1] * inv), cvtpk(o1[4 * rg + 2] * inv, o1[4 * rg + 3] * inv)};
        *(u32x2*)(orow + 8 * rg + 4 * hi) = w0; *(u32x2*)(orow + 32 + 8 * rg + 4 * hi) = w1; }
}
}
#endif

#ifndef CPU_TEST
namespace lin {
using att::bf16x8; using att::f32x16; using att::u32x4; using att::u32x2; using att::cvtpk; using att::crow;
constexpr int PT = 68;
template <int DK, int NDV> struct Lay {
    static constexpr int PQ = DK + 8;
    static constexpr int OFF_Q = 0, OFF_K = OFF_Q + 64 * PQ * 2, OFF_KH = OFF_K + 64 * PQ * 2, OFF_VT = OFF_KH + DK * PT * 2, OFF_DEC = OFF_VT + NDV * PT * 2, BUF = OFF_DEC + 256;
};
__device__ __forceinline__ bf16x8 ldA16(ATT_LAS const unsigned char* p) { return *(ATT_LAS const bf16x8*)p; }
__device__ __forceinline__ bf16x8 ldP8(ATT_LAS const unsigned char* p) { const u32x2 a = *(ATT_LAS const u32x2*)p, b = *(ATT_LAS const u32x2*)(p + 16); return __builtin_bit_cast(bf16x8, (u32x4){a[0], a[1], b[0], b[1]}); }
__device__ __forceinline__ bf16x8 pack8(const f32x16& x, int s) {
    u32x4 p;
    if (s == 0) p = (u32x4){cvtpk(x[0], x[1]), cvtpk(x[2], x[3]), cvtpk(x[4], x[5]), cvtpk(x[6], x[7])};
    else p = (u32x4){cvtpk(x[8], x[9]), cvtpk(x[10], x[11]), cvtpk(x[12], x[13]), cvtpk(x[14], x[15])};
    return __builtin_bit_cast(bf16x8, p); }
#define MF32(a, b, c) __builtin_amdgcn_mfma_f32_32x32x16_bf16((a), (b), (c), 0, 0, 0)
template <int DK, int NDV> __device__ __forceinline__ void compute(ATT_LAS const unsigned char* B, int ib, int dvb, int r32, int hi, f32x16 (&H)[DK / 32], f32x16& O) {
    typedef Lay<DK, NDV> L;
    f32x16 X[2];
#pragma unroll
    for (int r = 0; r < 16; ++r) { X[0][r] = 0.f; X[1][r] = 0.f; O[r] = 0.f; }
#pragma unroll
    for (int jb = 0; jb < 2; ++jb) if (jb <= ib) {
#pragma unroll
        for (int s = 0; s < DK / 16; ++s)
            X[jb] = MF32(ldA16(B + L::OFF_K + ((32 * jb + r32) * L::PQ + 16 * s + 8 * hi) * 2), ldA16(B + L::OFF_Q + ((32 * ib + r32) * L::PQ + 16 * s + 8 * hi) * 2), X[jb]);
        if (jb == ib) {
#pragma unroll
            for (int r = 0; r < 16; ++r) if (crow(r, hi) > r32) X[jb][r] = 0.f; } }
    bf16x8 vf[2][2];
#pragma unroll
    for (int jb = 0; jb < 2; ++jb)
#pragma unroll
        for (int s = 0; s < 2; ++s) vf[jb][s] = ldP8(B + L::OFF_VT + ((32 * dvb + r32) * PT + 32 * jb + 16 * s + 4 * hi) * 2);
#pragma unroll
    for (int jb = 0; jb < 2; ++jb) if (jb <= ib) {
#pragma unroll
        for (int s = 0; s < 2; ++s) O = MF32(pack8(X[jb], s), vf[jb][s], O); }
#pragma unroll
    for (int db = 0; db < DK / 32; ++db)
#pragma unroll
        for (int s = 0; s < 2; ++s) O = MF32(ldP8(B + L::OFF_Q + ((32 * ib + r32) * L::PQ + 32 * db + 16 * s + 4 * hi) * 2), pack8(H[db], s), O);
#pragma unroll
    for (int db = 0; db < DK / 32; ++db) {
        ATT_LAS const float* dec = (ATT_LAS const float*)(B + L::OFF_DEC);
#pragma unroll
        for (int r = 0; r < 16; ++r) H[db][r] *= dec[32 * db + crow(r, hi)];
#pragma unroll
        for (int jb = 0; jb < 2; ++jb)
#pragma unroll
            for (int s = 0; s < 2; ++s) H[db] = MF32(ldP8(B + L::OFF_KH + ((32 * db + r32) * PT + 32 * jb + 16 * s + 4 * hi) * 2), vf[jb][s], H[db]); }
}
__device__ __forceinline__ float scan64(float v, int lane) {
#pragma unroll
    for (int o = 1; o < 64; o <<= 1) { const float t = __shfl_up(v, o); if (lane >= o) v += t; }
    return v; }
__device__ __forceinline__ float bfl(unsigned w) { return __builtin_bit_cast(float, w << 16); }
__device__ __forceinline__ float bfh(unsigned w) { return __builtin_bit_cast(float, w & 0xffff0000u); }
__device__ __forceinline__ void vt_write(ATT_LAS unsigned char* B, int off_vt, int tok, int part, const u32x4& sv) {
    ATT_LAS unsigned short* vt = (ATT_LAS unsigned short*)(B + off_vt);
#pragma unroll
    for (int j = 0; j < 4; ++j) { vt[(8 * part + 2 * j) * PT + tok] = (unsigned short)(sv[j] & 0xffffu); vt[(8 * part + 2 * j + 1) * PT + tok] = (unsigned short)(sv[j] >> 16); } }

__device__ __forceinline__ void gla_run(ATT_LAS unsigned char* lds, const Ctx& C, int l, int b, int h) {
    typedef Lay<32, 64> L;
    int tid = threadIdx.x; asm volatile("" : "+v"(tid));
    const int lane = tid & 63, w = __builtin_amdgcn_readfirstlane(tid >> 6), r32 = lane & 31, hi = lane >> 5;
    const bf16_t* u = WSP(bf16_t, WS_U); float* Y = WSP(float, WS_YB);
    const float* aup = INF(I_GLA_UP) + l * 16 * 128 + h * 32 + 4 * w; const float* ab = INF(I_GLA_B) + l * 128 + h * 32 + 4 * w;
    const size_t tb = (size_t)b * SEQ;
    f32x16 H[1], O;
#pragma unroll
    for (int r = 0; r < 16; ++r) H[0][r] = 0.f;
    const int ib = w >> 1, dvb = w & 1;
    const int vtok = tid >> 3, vpart = tid & 7;
    u32x4 pa0, pa1, pv; u32x2 pq, pk;
#define GLA_FETCH(c) do { const size_t t_ = tb + (size_t)(c) * 64 + lane; const bf16_t* ur = u + t_ * DINP; \
        pa0 = *(const u32x4*)(ur + UB_AD); pa1 = *(const u32x4*)(ur + UB_AD + 8); pq = *(const u32x2*)(ur + UB_Q + h * 32 + 4 * w); pk = *(const u32x2*)(ur + UB_K + h * 32 + 4 * w); \
        pv = *(const u32x4*)(u + (tb + (size_t)(c) * 64 + vtok) * DINP + UB_V + h * 64 + vpart * 8); } while (0)
#define GLA_PREP(buf) do { ATT_LAS unsigned char* B_ = lds + (buf) * L::BUF; \
        float adv[16]; _Pragma("unroll") for (int j = 0; j < 4; ++j) { adv[2 * j] = bfl(pa0[j]); adv[2 * j + 1] = bfh(pa0[j]); adv[8 + 2 * j] = bfl(pa1[j]); adv[9 + 2 * j] = bfh(pa1[j]); } \
        const float qv[4] = {bfl(pq[0]), bfh(pq[0]), bfl(pq[1]), bfh(pq[1])}, kv[4] = {bfl(pk[0]), bfh(pk[0]), bfl(pk[1]), bfh(pk[1])}; \
        float qo[4], ko[4]; \
        _Pragma("unroll") for (int d = 0; d < 4; ++d) { float z = ab[d]; _Pragma("unroll") for (int j = 0; j < 16; ++j) z += adv[j] * aup[j * 128 + d]; \
            const float la = -softplusf_(-z) * (1.f / 16.f); const float bc = scan64(la, lane); const float be = __shfl(bc, 63); \
            qo[d] = qv[d] * __expf(bc) * 0.17677669529663687f; ko[d] = kv[d] * __expf(-bc); const float kh = kv[d] * __expf(be - bc); \
            ((ATT_LAS unsigned short*)(B_ + L::OFF_KH))[(4 * w + d) * PT + lane] = f2bf(kh); \
            if (lane == 63) ((ATT_LAS float*)(B_ + L::OFF_DEC))[4 * w + d] = __expf(be); } \
        *(ATT_LAS u32x2*)(B_ + L::OFF_Q + (lane * L::PQ + 4 * w) * 2) = (u32x2){cvtpk(qo[0], qo[1]), cvtpk(qo[2], qo[3])}; \
        *(ATT_LAS u32x2*)(B_ + L::OFF_K + (lane * L::PQ + 4 * w) * 2) = (u32x2){cvtpk(ko[0], ko[1]), cvtpk(ko[2], ko[3])}; \
        vt_write(B_, L::OFF_VT, vtok, vpart, pv); } while (0)
    constexpr int NC = SEQ / 64;
    GLA_FETCH(0); GLA_PREP(0); GLA_FETCH(1);
    __syncthreads();
    for (int c = 0; c < NC; ++c) {
        if (c + 1 < NC) { GLA_PREP((c + 1) & 1); if (c + 2 < NC) GLA_FETCH(c + 2); }
        if (w < 4) {
            compute<32, 64>(lds + (c & 1) * L::BUF, ib, dvb, r32, hi, H, O);
            float* yo = Y + (tb + (size_t)c * 64 + 32 * ib) * GW + h * 64 + 32 * dvb + r32;
#pragma unroll
            for (int r = 0; r < 16; ++r) yo[(size_t)crow(r, hi) * GW] = O[r]; }
        __syncthreads();
    }
#undef GLA_FETCH
#undef GLA_PREP
}
__device__ __forceinline__ void mlstm_run(ATT_LAS unsigned char* lds, const Ctx& C, int l, int b, int h) {
    typedef Lay<64, 96> L;
    int tid = threadIdx.x; asm volatile("" : "+v"(tid));
    const int lane = tid & 63, w = __builtin_amdgcn_readfirstlane(tid >> 6), r32 = lane & 31, hi = lane >> 5;
    const bf16_t* u = WSP(bf16_t, WS_U); float* Y = WSP(float, WS_YC); float* DEN = WSP(float, WS_DEN);
    const float* cw = INF(I_CONVW) + l * 4 * 512 + h * 64 + 8 * w; const float* cb = INF(I_CONVB) + l * 512 + h * 64 + 8 * w;
    const float ibias = INF(I_IB)[l * 4 + h], fbias = INF(I_FB)[l * 4 + h];
    const size_t tb = (size_t)b * SEQ;
    f32x16 H[2], O;
#pragma unroll
    for (int r = 0; r < 16; ++r) { H[0][r] = 0.f; H[1][r] = 0.f; }
    const int ib = w / 3, dvb = w % 3;
    const int vtok = tid >> 3, vpart = tid & 7;
    for (int i = tid; i < 32 * PT; i += 512) { const unsigned short v = (i < PT) ? (unsigned short)0x3f80 : (unsigned short)0;
        ((ATT_LAS unsigned short*)(lds + L::OFF_VT))[64 * PT + i] = v; ((ATT_LAS unsigned short*)(lds + L::BUF + L::OFF_VT))[64 * PT + i] = v; }
    u32x4 xq[4], xk[4], pg, pv;
#define ML_FETCH(c) do { const int s_ = (c) * 64 + lane; const bf16_t* ur = u + (tb + s_) * DINP; \
        _Pragma("unroll") for (int j = 0; j < 4; ++j) { const bool ok = s_ - 3 + j >= 0; const bf16_t* up = ur + (ptrdiff_t)(j - 3) * DINP; \
            xq[j] = ok ? *(const u32x4*)(up + UC_Q + h * 64 + 8 * w) : (u32x4){0u, 0u, 0u, 0u}; xk[j] = ok ? *(const u32x4*)(up + UC_K + h * 64 + 8 * w) : (u32x4){0u, 0u, 0u, 0u}; } \
        pg = *(const u32x4*)(ur + UC_IG); pv = *(const u32x4*)(u + (tb + (size_t)(c) * 64 + vtok) * DINP + UC_V + h * 64 + vpart * 8); } while (0)
#define ML_PREP(buf) do { ATT_LAS unsigned char* B_ = lds + (buf) * L::BUF; \
        const unsigned gi_ = pg[h >> 1], gf_ = pg[2 + (h >> 1)]; const float ig = ((h & 1) ? bfh(gi_) : bfl(gi_)) + ibias; const float lf = -softplusf_(-(((h & 1) ? bfh(gf_) : bfl(gf_)) + fbias)); \
        const float F = scan64(lf, lane); const float Fe = __shfl(F, 63); const float eF = __expf(F), wk = __expf(ig - F) * 0.125f, wkh = __expf(Fe - F + ig) * 0.125f; \
        float qo[8], ko[8]; \
        _Pragma("unroll") for (int ch = 0; ch < 8; ++ch) { float yq = cb[ch], yk = cb[256 + ch]; \
            _Pragma("unroll") for (int j = 0; j < 4; ++j) { const unsigned wq_ = xq[j][ch >> 1], wk_ = xk[j][ch >> 1]; \
                yq += cw[j * 512 + ch] * ((ch & 1) ? bfh(wq_) : bfl(wq_)); yk += cw[j * 512 + 256 + ch] * ((ch & 1) ? bfh(wk_) : bfl(wk_)); } \
            const float sq = siluf_(yq), sk = siluf_(yk); qo[ch] = sq * eF; ko[ch] = sk * wk; \
            ((ATT_LAS unsigned short*)(B_ + L::OFF_KH))[(8 * w + ch) * PT + lane] = f2bf(sk * wkh); } \
        *(ATT_LAS u32x4*)(B_ + L::OFF_Q + (lane * L::PQ + 8 * w) * 2) = (u32x4){cvtpk(qo[0], qo[1]), cvtpk(qo[2], qo[3]), cvtpk(qo[4], qo[5]), cvtpk(qo[6], qo[7])}; \
        *(ATT_LAS u32x4*)(B_ + L::OFF_K + (lane * L::PQ + 8 * w) * 2) = (u32x4){cvtpk(ko[0], ko[1]), cvtpk(ko[2], ko[3]), cvtpk(ko[4], ko[5]), cvtpk(ko[6], ko[7])}; \
        if (w == 0) ((ATT_LAS float*)(B_ + L::OFF_DEC))[lane] = __expf(Fe); \
        vt_write(B_, L::OFF_VT, vtok, vpart, pv); } while (0)
    constexpr int NC = SEQ / 64;
    ML_FETCH(0); ML_PREP(0); ML_FETCH(1);
    __syncthreads();
    for (int c = 0; c < NC; ++c) {
        if (c + 1 < NC) { ML_PREP((c + 1) & 1); if (c + 2 < NC) ML_FETCH(c + 2); }
        if (w < 6) {
            compute<64, 96>(lds + (c & 1) * L::BUF, ib, dvb, r32, hi, H, O);
            const size_t t0 = tb + (size_t)c * 64 + 32 * ib;
            if (dvb < 2) { float* yo = Y + t0 * GW + h * 64 + 32 * dvb + r32;
#pragma unroll
                for (int r = 0; r < 16; ++r) yo[(size_t)crow(r, hi) * GW] = O[r]; }
            else if (r32 == 0) {
#pragma unroll
                for (int r = 0; r < 16; ++r) DEN[(t0 + crow(r, hi)) * 4 + h] = O[r]; } }
        __syncthreads();
    }
#undef ML_FETCH
#undef ML_PREP
}
#undef MF32
}
#endif

#ifndef CPU_TEST
namespace rwk {
constexpr int NB = 16;
constexpr int VEC = 6 * 64;
constexpr int BUFB = NB * VEC * 4;
__device__ __forceinline__ float dpp_add(float v, int ctrl_sel) {
    int x = __builtin_bit_cast(int, v), y;
    if (ctrl_sel == 0) y = __builtin_amdgcn_update_dpp(0, x, 0xB1, 0xF, 0xF, true);
    else if (ctrl_sel == 1) y = __builtin_amdgcn_update_dpp(0, x, 0x4E, 0xF, 0xF, true);
    else if (ctrl_sel == 2) y = __builtin_amdgcn_update_dpp(0, x, 0x141, 0xF, 0xF, true);
    else y = __builtin_amdgcn_update_dpp(0, x, 0x140, 0xF, 0xF, true);
    return v + __builtin_bit_cast(float, y); }
__device__ __forceinline__ float red16(float v) { v = dpp_add(v, 0); v = dpp_add(v, 1); v = dpp_add(v, 2); v = dpp_add(v, 3); return v; }
__device__ __forceinline__ void run(ATT_LAS unsigned char* lds, const Ctx& C, int b, int h, int rg) {
    int tid = threadIdx.x; asm volatile("" : "+v"(tid));
    const int lane = tid & 63, w = __builtin_amdgcn_readfirstlane(tid >> 6);
    const float* src[6] = {WSP(float, WS_RW_A), WSP(float, WS_RW_W), WSP(float, WS_RW_B), WSP(float, WS_RW_K), WSP(float, WS_RW_R), WSP(float, WS_RW_V)};
    float* Y = WSP(float, WS_YA);
    const size_t tb = (size_t)b * SEQ;
    const int lt = tid - 256;
#define RW_LOAD(batch, buf) do { _Pragma("unroll") for (int i = 0; i < 6; ++i) { const int p = lt + 256 * i; const int st = p / 96, vc = (p % 96) >> 4, pt = p & 15; \
        const float* sp = (vc == 0 ? src[0] : vc == 1 ? src[1] : vc == 2 ? src[2] : vc == 3 ? src[3] : vc == 4 ? src[4] : src[5]); \
        const f4v v4 = *(const f4v*)(sp + (tb + (size_t)(batch) * NB + st) * GW + h * 64 + pt * 4); \
        *(ATT_LAS f4v*)(lds + (buf) * BUFB + (st * VEC + vc * 64 + pt * 4) * 4) = v4; } } while (0)
    constexpr int NBATCH = SEQ / NB;
    if (w >= 4) RW_LOAD(0, 0);
    __syncthreads();
    const int row = 16 * rg + 4 * w + (lane >> 4), cg = lane & 15;
    float S0 = 0.f, S1 = 0.f, S2 = 0.f, S3 = 0.f;
    for (int bt = 0; bt < NBATCH; ++bt) {
        if (w >= 4) { if (bt + 1 < NBATCH) RW_LOAD(bt + 1, (bt + 1) & 1); }
        else {
            ATT_LAS const float* B = (ATT_LAS const float*)(lds + (bt & 1) * BUFB);
#pragma unroll 4
            for (int st = 0; st < NB; ++st) {
                ATT_LAS const float* P = B + st * VEC;
                const f4v a = *(ATT_LAS const f4v*)(P + 4 * cg), wv = *(ATT_LAS const f4v*)(P + 64 + 4 * cg), bb = *(ATT_LAS const f4v*)(P + 128 + 4 * cg),
                          kk = *(ATT_LAS const f4v*)(P + 192 + 4 * cg), r = *(ATT_LAS const f4v*)(P + 256 + 4 * cg);
                const float vv = P[320 + row];
                const float sa = red16((S0 * a[0] + S1 * a[1]) + (S2 * a[2] + S3 * a[3]));
                S0 = S0 * wv[0] + (sa * bb[0] + vv * kk[0]); S1 = S1 * wv[1] + (sa * bb[1] + vv * kk[1]);
                S2 = S2 * wv[2] + (sa * bb[2] + vv * kk[2]); S3 = S3 * wv[3] + (sa * bb[3] + vv * kk[3]);
                const float y = red16((S0 * r[0] + S1 * r[1]) + (S2 * r[2] + S3 * r[3]));
                if (cg == 0) Y[(tb + (size_t)bt * NB + st) * GW + h * 64 + row] = y;
            }
        }
        __syncthreads();
    }
#undef RW_LOAD
}
}
#endif

constexpr int PH_PER_LAYER = 12;
constexpr int NPHASES = DEPTH * PH_PER_LAYER;

#ifndef CPU_TEST
#define XB_TMO      128
#define XB_XCNT(j)  (256  + 64 * (j))
#define XB_XSUB(j)  (1280 + 64 * (j))
#define XB_XGEN(j)  (2304 + 64 * (j))
#define XB_TOP      3328
#define XB_TOPGEN   3392
#define XCD_BAR_WORDS 3456
#define XB_SPIN_CAP (1u << 18)
#define LAS __attribute__((address_space(3)))
__device__ __forceinline__ unsigned xb_ld(unsigned* p)              { return __hip_atomic_load(p, __ATOMIC_RELAXED, __HIP_MEMORY_SCOPE_AGENT); }
__device__ __forceinline__ unsigned xb_add(unsigned* p, unsigned v) { return __hip_atomic_fetch_add(p, v, __ATOMIC_RELAXED, __HIP_MEMORY_SCOPE_AGENT); }
__device__ __forceinline__ unsigned xb_xcc_id() { return (unsigned)__builtin_amdgcn_s_getreg((3 << 11) | 20) & 0xFu; }
#define XB_SPIN(cond, bar) do { unsigned _sp = 0; while (cond) { __builtin_amdgcn_s_sleep(1); \
    if ((++_sp & 255u) == 0u) { if (xb_ld(&(bar)[XB_TMO])) break; if (_sp > XB_SPIN_CAP) { atomicAdd(&(bar)[XB_TMO], 1u); break; } } } } while (0)
struct XcdBarrier { unsigned* bar; unsigned x; volatile LAS unsigned* st; };
__device__ __forceinline__ XcdBarrier xcd_barrier_post(unsigned* bar, volatile LAS unsigned* st) {
    XcdBarrier b; b.bar = bar; b.x = xb_xcc_id(); b.st = st;
    if (threadIdx.x == 0) (void)xb_add(&bar[XB_XCNT(b.x)], 1u);
    return b;
}
__device__ __forceinline__ void xcd_barrier_complete(unsigned* bar, unsigned x, unsigned& nloc, unsigned& nx) {
    const unsigned G = gridDim.x * gridDim.y * gridDim.z;
    unsigned sum, cnt, mine, sp = 0u;
    for (;;) {
        sum = 0u; cnt = 0u; mine = 0u;
#pragma unroll
        for (unsigned j = 0; j < 16; ++j) { const unsigned c = xb_ld(&bar[XB_XCNT(j)]); sum += c; cnt += (c > 0u) ? 1u : 0u; mine = (j == x) ? c : mine; }
        if (sum == G) break;
        __builtin_amdgcn_s_sleep(1);
        if ((++sp & 255u) == 0u) { if (xb_ld(&bar[XB_TMO])) break; if (sp > XB_SPIN_CAP) { atomicAdd(&bar[XB_TMO], 1u); break; } }
    }
    nloc = mine > 0u ? mine : 1u; nx = cnt > 0u ? cnt : 1u;
}
__device__ __forceinline__ void xcd_barrier(const XcdBarrier& b) {
    asm volatile("s_waitcnt vmcnt(0)" ::: "memory");
    __syncthreads();
    if (threadIdx.x == 0) {
        unsigned* bar = b.bar;
        __builtin_amdgcn_s_waitcnt(0);
        unsigned nloc = b.st[0], nx = b.st[1];
        if (nloc == 0u) { xcd_barrier_complete(bar, b.x, nloc, nx); b.st[0] = nloc; b.st[1] = nx; }
        const unsigned old = xb_add(&bar[XB_XSUB(b.x)], 1u);
        const unsigned gen = old / nloc;
        if (old + 1u == (gen + 1u) * nloc) {
            __builtin_amdgcn_fence(__ATOMIC_RELEASE, "agent");
            asm volatile("s_waitcnt vmcnt(0)" ::: "memory");
            const unsigned og = xb_add(&bar[XB_TOP], 1u);
            const unsigned tg = og / nx;
            if (og + 1u == (tg + 1u) * nx) xb_add(&bar[XB_TOPGEN], 1u);
            else XB_SPIN(xb_ld(&bar[XB_TOPGEN]) == tg, bar);
            __builtin_amdgcn_fence(__ATOMIC_ACQUIRE, "agent");
            xb_add(&bar[XB_XGEN(b.x)], 1u);
            asm volatile("s_waitcnt vmcnt(0)" ::: "memory");
        } else {
            XB_SPIN(xb_ld(&bar[XB_XGEN(b.x)]) == gen, bar);
            __builtin_amdgcn_fence(__ATOMIC_ACQUIRE, "agent");
            asm volatile("s_waitcnt vmcnt(0)" ::: "memory");
        }
    }
    __syncthreads();
}

constexpr int NWAVES = 8;
constexpr int RING_BYTES = 131072, MISC_OFF = RING_BYTES + 320, LDS_BYTES = 147456;
struct Args { Ctx C; int ph_lo, ph_hi; };
__device__ __forceinline__ int moe_fill_table(const Ctx& C, int l, LAS int* tbl, int tid) {
    const unsigned* cnt = WSP(unsigned, WS_CTL) + CW_CNT + l * NEXP * 64;
    int e, be, ce; const int total = moe_lookup(cnt, tid * 256, e, be, ce);
    if (tid < 320) tbl[tid] = e;
    __syncthreads();
    return total >> 8;
}

__global__ void __launch_bounds__(NWAVES * 64, 2) mega(Args args) {
    extern __shared__ __attribute__((aligned(16))) unsigned char lds_raw[];
    LAS unsigned char* lds = (LAS unsigned char*)lds_raw;
    const Ctx& C = args.C;
    const int G = gridDim.x, bx = blockIdx.x;
    const int ngw = G * NWAVES;
    volatile LAS unsigned* MISC = (volatile LAS unsigned*)(lds + MISC_OFF);
    for (int i = threadIdx.x; i < (LDS_BYTES - RING_BYTES) / 4; i += NWAVES * 64) ((LAS unsigned*)(lds + RING_BYTES))[i] = 0u;
    __syncthreads();
    XcdBarrier bar = xcd_barrier_post(WSP(unsigned, WS_CTL) + CW_BAR, MISC + 8);
    LAS int* tbl = (LAS int*)(lds + RING_BYTES + 1024);
    const int lo = args.ph_lo, hi = args.ph_hi;

    for (int l = 0; l < DEPTH; ++l) {
        const int p0 = l * PH_PER_LAYER;
#ifndef PHASE_MASK
#define PHASE_MASK 0xFFF
#endif
#define IN(k) (((PHASE_MASK >> (k)) & 1) && lo <= p0 + (k) && p0 + (k) < hi)
#define LAUNDER() int tid = threadIdx.x; asm volatile("" : "+v"(tid)); const int lane = tid & 63; const int wave = __builtin_amdgcn_readfirstlane(tid >> 6); const int gw = bx * NWAVES + wave; (void)gw; (void)lane; \
        wsh_t wsh = (wsh_t)(lds + wave * 16384); (void)wsh
#define SEAM(k) do { if (p0 + (k) + 1 < hi) xcd_barrier(bar); } while (0)
        if (IN(0)) { LAUNDER(); stage_convert(C, l, gw, ngw, lane, wsh); SEAM(0); }
        if (IN(1)) { LAUNDER();
            pg8::Gemm g{WSP(bf16_t, WS_XB), WSP(bf16_t, WS_WIN), DM, DM, DM};
            pg8::DenseOrder S{T / 256, DINP / 256, G, bx, (long)256 * DM * 2, (long)256 * DM * 2};
            EpiU E{WSP(bf16_t, WS_U)};
            pg8::gemm_phase(lds, g, S, E); SEAM(1); }
        if (IN(2)) { LAUNDER();
            {   pg8::Gemm g{WSP(bf16_t, WS_U) + UD_CQ, WSP(bf16_t, WS_WUQ), DINP, 256, 256};
                pg8::DenseOrder S{T / 256, 2, G, bx, (long)256 * DINP * 2, (long)256 * 256 * 2};
                EpiQ E{WSP(float, WS_ROPE), WSP(bf16_t, WS_AQ)};
                pg8::gemm_phase(lds, g, S, E); }
            {   pg8::Gemm g{WSP(bf16_t, WS_U) + UD_CKV, WSP(bf16_t, WS_WUKV), DINP, 256, 256};
                pg8::DenseOrder S{T / 256, 2, G, bx, (long)256 * DINP * 2, (long)256 * 256 * 2};
                EpiKV E{WSP(bf16_t, WS_AK), WSP(bf16_t, WS_AV)};
                pg8::gemm_phase(lds, g, S, E); }
            __syncthreads();
            rwkv_prep_coop(C, l, lds);
            mla_token_pass(C, gw, ngw, lane);
            SEAM(2); }
        if (IN(3)) { LAUNDER();
            if (bx < 128) rwk::run(lds, C, bx >> 4, (bx >> 2) & 3, bx & 3);
            else if (bx < 160) lin::gla_run(lds, C, l, (bx - 128) >> 2, (bx - 128) & 3);
            else if (bx < 192) lin::mlstm_run(lds, C, l, (bx - 160) >> 2, (bx - 160) & 3);
            else {
                LAS int* slot = (LAS int*)(lds + RING_BYTES + 512);
                unsigned* ctr = WSP(unsigned, WS_CTL) + CW_ATT + l * 64;
                constexpr int NQB = SEQ / 256, NUNIT = BATCH * NH * NQB;
                for (;;) {
                    if (tid == 0) *slot = (int)atomicAdd(ctr, 1u);
                    __syncthreads();
                    const int uidx = *slot;
                    __syncthreads();
                    if (uidx >= NUNIT) break;
                    const int qb = NQB - 1 - uidx / (BATCH * NH), bh = uidx % (BATCH * NH);
                    att::unit(lds, WSP(bf16_t, WS_AQ), WSP(bf16_t, WS_AK), WSP(bf16_t, WS_AV), WSP(float, WS_RSTD), WSP(bf16_t, WS_MIX), bh >> 2, bh & 3, qb);
                }
            }
            SEAM(3); }
        if (IN(4)) { LAUNDER(); stage_post(C, l, gw, ngw, lane); SEAM(4); }
        if (IN(5)) { LAUNDER();
            pg8::Gemm g{WSP(bf16_t, WS_MIX), WSP(bf16_t, WS_WOUT), DMIX, DMIX, DMIX};
            pg8::DenseOrder S{T / 256, DM / 256, G, bx, (long)256 * DMIX * 2, (long)256 * DMIX * 2};
            EpiPre1 E{l == 0 ? INF(I_X) : WSP(float, WS_X), C.out};
            pg8::gemm_phase(lds, g, S, E); SEAM(5); }
        if (IN(6)) { LAUNDER(); stage_ln1_router(C, l, gw, ngw, lane, wsh); SEAM(6); }
        if (IN(7)) { LAUNDER();
            stage_gather(C, l, gw, ngw, lane);
            pg8::Gemm g{WSP(bf16_t, WS_PB), WSP(bf16_t, WS_WP), DPLE, DPLE, DPLE};
            pg8::DenseOrder S{T / 256, DM / 256, G, bx, (long)256 * DPLE * 2, (long)256 * DPLE * 2};
            EpiPP E{WSP(bf16_t, WS_PP)};
            pg8::gemm_phase(lds, g, S, E); SEAM(7); }
        if (IN(8)) { LAUNDER();
            pg8::Gemm g{WSP(bf16_t, WS_XG), WSP(bf16_t, WS_WGU), DM, DM, DM};
            const int ntile = moe_fill_table(C, l, tbl, tid);
            pg8::MoeOrder S{tbl, ntile, 2 * DEXP / 256, G, bx, (long)256 * DM * 2, (long)256 * DM * 2, (long)2 * DEXP * DM * 2};
            EpiH E{WSP(bf16_t, WS_H)};
            pg8::gemm_phase(lds, g, S, E); SEAM(8); }
        if (IN(9)) { LAUNDER();
            pg8::Gemm g{WSP(bf16_t, WS_H), WSP(bf16_t, WS_WD), DEXP, DEXP, DEXP};
            const int ntile = moe_fill_table(C, l, tbl, tid);
            pg8::MoeOrder S{tbl, ntile, DM / 256, G, bx, (long)256 * DEXP * 2, (long)256 * DEXP * 2, (long)DM * DEXP * 2};
            EpiY E{WSP(int, WS_ROWINFO), WSP(float, WS_ROWGATE), WSP(bf16_t, WS_YBUF)};
            pg8::gemm_phase(lds, g, S, E); SEAM(9); }
        if (IN(10)) { LAUNDER();
            pg8::Gemm g{WSP(bf16_t, WS_XB), WSP(bf16_t, WS_WPG), DM, DM, DM};
            pg8::DenseOrder S{T / 256, DM / 256, G, bx, (long)256 * DM * 2, (long)256 * DM * 2};
            EpiPre2 E{C.out, WSP(bf16_t, WS_YBUF), WSP(bf16_t, WS_PP), INF(I_PLEBG) + l * DM, WSP(float, WS_X)};
            pg8::gemm_phase(lds, g, S, E); SEAM(10); }
        if (IN(11)) { LAUNDER(); stage_ln2(C, l, gw, ngw, lane); SEAM(11); }
#undef IN
#undef SEAM
    }
}

extern "C" void kernel_launch(void* const* d_in, const int* in_sizes, int n_in, void* d_out, int out_size, void* d_ws, size_t ws_size, hipStream_t stream) {
    static int grid = 0;
    if (grid == 0) {
        if (n_in != N_IN || out_size != T * DM || ws_size < WS_END) { fprintf(stderr, "kernel_launch: bad sizes n_in %d out %d ws %zu need %zu\n", n_in, out_size, ws_size, (size_t)WS_END); grid = -1; return; }
        int dev = 0, cus = 0, per_cu = 0;
        hipGetDevice(&dev); hipDeviceGetAttribute(&cus, hipDeviceAttributeMultiprocessorCount, dev);
        if (hipFuncSetAttribute((const void*)mega, hipFuncAttributeMaxDynamicSharedMemorySize, LDS_BYTES) != hipSuccess) { fprintf(stderr, "hipFuncSetAttribute failed\n"); grid = -1; return; }
        if (hipOccupancyMaxActiveBlocksPerMultiprocessor(&per_cu, (const void*)mega, NWAVES * 64, LDS_BYTES) != hipSuccess || per_cu < 1) { fprintf(stderr, "occupancy query: %d\n", per_cu); }
        (void)hipGetLastError();
        grid = cus;
    }
    if (grid < 0) return;
    hipMemsetAsync((char*)d_ws + WS_CTL, 0, CTL_BYTES, stream);
    Args a{};
    for (int i = 0; i < N_IN; ++i) a.C.in[i] = d_in[i];
    a.C.out = (float*)d_out; a.C.ws = (unsigned char*)d_ws;
#ifndef ONE_LAUNCH
    for (int ph = 0; ph < NPHASES; ++ph) { a.ph_lo = ph; a.ph_hi = ph + 1; hipLaunchKernelGGL(mega, dim3(grid), dim3(NWAVES * 64), LDS_BYTES, stream, a); }
#else
    a.ph_lo = 0; a.ph_hi = NPHASES; hipLaunchKernelGGL(mega, dim3(grid), dim3(NWAVES * 64), LDS_BYTES, stream, a);
#endif
}
#else
template <class E> static void cpu_gemm(const bf16_t* A, int lda, const bf16_t* Bt, int ldb, int K, int M, int N, const E& e, const int* base = nullptr, long estep = 0) {
    for (int row = 0; row < M; ++row) {
        const bf16_t* B = Bt;
        if (base) B = Bt + (size_t)moe_expert_of_row(base, row) * estep;
        if constexpr (E::MODE == 1) {
            for (int hc = 0; hc < N / 2; hc += 8) { float g[8], u[8];
                for (int j = 0; j < 8; ++j) { float ag = 0.f, au = 0.f; const bf16_t* bg = B + (size_t)rowmap(1, hc + j) * ldb; const bf16_t* bu = B + (size_t)rowmap(2, hc + j) * ldb;
                    for (int k = 0; k < K; ++k) { const float a = bf2f(A[(size_t)row * lda + k]); ag += a * bf2f(bg[k]); au += a * bf2f(bu[k]); } g[j] = ag; u[j] = au; }
                e.put8gu(row, hc, g, u); }
        } else if constexpr (E::PERM) {
            for (int c = 0; c < N; c += 8) { float a8[8];
                for (int j = 0; j < 8; ++j) { float acc = 0.f; for (int k = 0; k < K; ++k) acc += bf2f(A[(size_t)row * lda + k]) * bf2f(B[(size_t)(c + j) * ldb + k]); a8[j] = acc; }
                e.put8(row, c, a8); }
        } else {
            for (int c = 0; c < N; c += 4) { float a4[4];
                for (int j = 0; j < 4; ++j) { float acc = 0.f; for (int k = 0; k < K; ++k) acc += bf2f(A[(size_t)row * lda + k]) * bf2f(B[(size_t)(c + j) * ldb + k]); a4[j] = acc; }
                e.put4(row, c, a4); }
        }
    }
}
static void cpu_forward(const Ctx& C) {
    static float shbuf[4096];
    for (int l = 0; l < DEPTH; ++l) {
        stage_convert(C, l, 0, 1, 0, shbuf);
        { EpiU E{WSP(bf16_t, WS_U)}; cpu_gemm(WSP(bf16_t, WS_XB), DM, WSP(bf16_t, WS_WIN), DM, DM, T, DINP, E); }
        stage_prep(C, l, 0, 1, 0, shbuf);
        for (int b = 0; b < BATCH; ++b) for (int h = 0; h < NH; ++h) {
            for (int v = 0; v < 64; ++v) { rwkv_scan_thread(C, b, h, v); gla_scan_thread(C, b, h, v); }
            for (int e = 0; e < 65; ++e) mlstm_scan_thread(C, b, h, e);
            for (int q = 0; q < SEQ; ++q) attn_thread(C, b, h, q, q); }
        stage_post(C, l, 0, 1, 0);
        { EpiPre1 E{l == 0 ? INF(I_X) : WSP(float, WS_X), C.out}; cpu_gemm(WSP(bf16_t, WS_MIX), DMIX, WSP(bf16_t, WS_WOUT), DMIX, DMIX, T, DM, E); }
        stage_ln1_router(C, l, 0, 1, 0, shbuf);
        stage_gather(C, l, 0, 1, 0);
        { EpiPP E{WSP(bf16_t, WS_PP)}; cpu_gemm(WSP(bf16_t, WS_PB), DPLE, WSP(bf16_t, WS_WP), DPLE, DPLE, T, DM, E); }
        int base[NEXP + 1]; moe_bases(C, l, base);
        { EpiH E{WSP(bf16_t, WS_H)}; cpu_gemm(WSP(bf16_t, WS_XG), DM, WSP(bf16_t, WS_WGU), DM, DM, base[NEXP], 2 * DEXP, E, base, (long)2 * DEXP * DM); }
        { EpiY E{WSP(int, WS_ROWINFO), WSP(float, WS_ROWGATE), WSP(bf16_t, WS_YBUF)}; cpu_gemm(WSP(bf16_t, WS_H), DEXP, WSP(bf16_t, WS_WD), DEXP, DEXP, base[NEXP], DM, E, base, (long)DM * DEXP); }
        { EpiPre2 E{C.out, WSP(bf16_t, WS_YBUF), WSP(bf16_t, WS_PP), INF(I_PLEBG) + l * DM, WSP(float, WS_X)}; cpu_gemm(WSP(bf16_t, WS_XB), DM, WSP(bf16_t, WS_WPG), DM, DM, T, DM, E); }
        stage_ln2(C, l, 0, 1, 0);
    }
}
#endif
```

```cpp
#ifndef CPU_TEST
#include <hip/hip_runtime.h>
#include <cstdio>
#include <cstdint>
#define HD __device__ __forceinline__
#define HDM __device__ __forceinline__
#define LANES 64
#else
#include <cmath>
#include <cstdio>
#include <cstdint>
#include <cstring>
#include <algorithm>
#define HD static inline
#define HDM inline
#define LANES 1
#endif

#define ONE_LAUNCH 1
#ifndef CFG_SMALL
constexpr int BATCH = 8, SEQ = 4096, DM = 1024, DEPTH = 4, DPLE = 256, DEXP = 512;
#else
constexpr int BATCH = 2, SEQ = 256, DM = 128, DEPTH = 2, DPLE = 32, DEXP = 128;
#endif
constexpr int T = BATCH * SEQ;
constexpr int DMIX = 1024, GW = 256, HD64 = 64, NH = 4;
constexpr int DIN = 3128, DINP = 3328;
constexpr int UA = 0, UA_R = 0, UA_K = 256, UA_V = 512, UA_WD = 768, UA_AD = 800, UA_GD = 832, DINA = 896;
constexpr int UB = 896, UB_Q = 896, UB_K = 1024, UB_V = 1152, UB_AD = 1408, UB_G = 1424;
constexpr int UC = 1680, UC_Q = 1680, UC_K = 1936, UC_V = 2192, UC_O = 2448, UC_IG = 2704, UC_FG = 2708;
constexpr int UD = 2712, UD_CQ = 2712, UD_CKV = 2968, UD_KR = 3096;
constexpr int NEXP = 32, NGRP = 4, EPG = 8;
constexpr int MAXROWS = 2 * T + NEXP * 256;
constexpr float DN_ALPHA = 1.681792830507429f;
constexpr float LN_EPS = 1e-5f, NORM_EPS = 1e-6f, RWKV_GN_EPS = 64e-5f;
static_assert(DEPTH == 4 || DEPTH == 2, "alpha below assumes depth");
HD float dn_alpha() { return DEPTH == 4 ? 1.681792830507429f : 1.4142135623730951f; }

enum { I_X = 0, I_P, I_POS, I_WIN, I_MU, I_W0, I_WUP, I_A0, I_AUP, I_GUP, I_KK, I_KA, I_RK, I_GNG, I_GNB, I_GLA_UP, I_GLA_B, I_GLA_G,
       I_CONVW, I_CONVB, I_IB, I_FB, I_MLN_G, I_QNG, I_WUQ, I_KVNG, I_WUKV, I_WOUT, I_LN1G, I_LN1B, I_WRG, I_BRG, I_WRE, I_BRE,
       I_WG, I_WU, I_WD, I_PLEG, I_PLEBG, I_PLEW, I_LN2G, I_LN2B, N_IN };

typedef unsigned short bf16_t;
HD float bf2f(bf16_t h) { unsigned u = (unsigned)h << 16; return __builtin_bit_cast(float, u); }
HD bf16_t f2bf(float f) { unsigned u = __builtin_bit_cast(unsigned, f); return (bf16_t)((u + 0x7fffu + ((u >> 16) & 1u)) >> 16); }
HD unsigned pk2(float lo, float hi) { return (unsigned)f2bf(lo) | ((unsigned)f2bf(hi) << 16); }
typedef float f4v __attribute__((vector_size(16)));
typedef unsigned u4v __attribute__((vector_size(16)));
HD void ld8bf(const bf16_t* p, float* o) { const u4v w = *(const u4v*)p;
    for (int j = 0; j < 4; ++j) { o[2 * j] = __builtin_bit_cast(float, w[j] << 16); o[2 * j + 1] = __builtin_bit_cast(float, w[j] & 0xffff0000u); } }
HD void st8bf(bf16_t* p, const float* a) { u4v w; for (int j = 0; j < 4; ++j) w[j] = pk2(a[2 * j], a[2 * j + 1]); *(u4v*)p = w; }

constexpr size_t MiB = (size_t)1 << 20;
constexpr size_t al256(size_t x) { return (x + 255) & ~(size_t)255; }
constexpr size_t WS_CTL = 0, CTL_BYTES = 1 * MiB;
constexpr size_t WS_WIN = WS_CTL + CTL_BYTES;
constexpr size_t WS_WOUT = WS_WIN + al256((size_t)DINP * DM * 2);
constexpr size_t WS_WPG = WS_WOUT + al256((size_t)DM * DMIX * 2);
constexpr size_t WS_WP = WS_WPG + al256((size_t)DM * DM * 2);
constexpr size_t WS_WGU = WS_WP + al256((size_t)DM * DPLE * 2);
constexpr size_t WS_WD = WS_WGU + al256((size_t)NEXP * 2 * DEXP * DM * 2);
constexpr size_t WS_X = WS_WD + al256((size_t)NEXP * DM * DEXP * 2);
constexpr size_t WS_XB = WS_X + al256((size_t)T * DM * 4);
constexpr size_t WS_U = WS_XB + al256((size_t)T * DM * 2);
constexpr size_t WS_MIX = WS_U + al256((size_t)T * DINP * 2);
constexpr size_t WS_PB = WS_MIX + al256((size_t)T * DMIX * 2);
constexpr size_t WS_WUQ = WS_PB + al256((size_t)T * DPLE * 2);
constexpr size_t WS_WUKV = WS_WUQ + al256((size_t)512 * 256 * 2);
constexpr size_t WS_ROPE = WS_WUKV + al256((size_t)512 * 256 * 2);
constexpr size_t WS_RSTD = WS_ROPE + al256((size_t)T * 32 * 4);
constexpr size_t WS_SCR = WS_RSTD + al256((size_t)T * 2 * 4);
constexpr size_t TV = al256((size_t)T * GW * 4);
constexpr size_t WS_RW_R = WS_SCR, WS_RW_W = WS_RW_R + TV, WS_RW_K = WS_RW_W + TV, WS_RW_V = WS_RW_K + TV, WS_RW_A = WS_RW_V + TV,
                 WS_RW_B = WS_RW_A + TV, WS_RW_G = WS_RW_B + TV;
constexpr size_t WS_YA = WS_RW_G + TV, WS_YB = WS_YA + TV, WS_YC = WS_YB + TV;
constexpr size_t WS_DEN = WS_YC + TV;
constexpr size_t WS_QK = WS_DEN + al256((size_t)T * 4 * 4);
constexpr size_t WS_GA = WS_QK + al256((size_t)T * 512 * 4);
constexpr size_t WS_LG = WS_GA + al256((size_t)T * 128 * 4);
constexpr size_t WS_AQ = WS_LG + al256((size_t)T * 8 * 4);
constexpr size_t WS_AK = WS_AQ + al256((size_t)T * 384 * 2);
constexpr size_t WS_AV = WS_AK + al256((size_t)T * 384 * 2);
constexpr size_t WS_MIXER_END = WS_AV + al256((size_t)T * 256 * 2);
constexpr size_t WS_XG = WS_SCR;
constexpr size_t WS_H = WS_XG + al256((size_t)MAXROWS * DM * 2);
constexpr size_t WS_YBUF = WS_H + al256((size_t)MAXROWS * DEXP * 2);
constexpr size_t WS_PP = WS_YBUF + al256((size_t)2 * T * DM * 2);
constexpr size_t WS_TOKINFO = WS_PP + al256((size_t)T * DM * 2);
constexpr size_t WS_LIST = WS_TOKINFO + al256((size_t)T * 16);
constexpr size_t WS_ROWINFO = WS_LIST + al256((size_t)NEXP * T * 4);
constexpr size_t WS_ROWGATE = WS_ROWINFO + al256((size_t)MAXROWS * 4);
constexpr size_t WS_MOE_END = WS_ROWGATE + al256((size_t)MAXROWS * 4);
constexpr size_t WS_END = WS_MIXER_END > WS_MOE_END ? WS_MIXER_END : WS_MOE_END;
constexpr int CW_BAR = 4096;
constexpr int CW_ATT = 8192;
constexpr int CW_CNT = 16384;

struct Ctx {
    const void* in[N_IN];
    float* out;
    unsigned char* ws;
};
#define INF(i) ((const float*)C.in[i])
#define WSP(T_, off) ((T_*)(C.ws + (off)))

#ifndef CPU_TEST
HD float wave_sum(float v) {
#pragma unroll
    for (int o = 1; o < 64; o <<= 1) v += __shfl_xor(v, o);
    return v;
}
HD float wave_max(float v) {
#pragma unroll
    for (int o = 1; o < 64; o <<= 1) v = fmaxf(v, __shfl_xor(v, o));
    return v;
}
HD unsigned atom_add(unsigned* p, unsigned v) { return atomicAdd(p, v); }
#define WSYNC() __builtin_amdgcn_wave_barrier(); asm volatile("s_waitcnt lgkmcnt(0)" ::: "memory")
typedef __attribute__((address_space(3))) float* wsh_t;
#else
HD float wave_sum(float v) { return v; }
HD float wave_max(float v) { return v; }
HD unsigned atom_add(unsigned* p, unsigned v) { unsigned o = *p; *p += v; return o; }
#define WSYNC()
typedef float* wsh_t;
#endif
HD float sigmoidf_(float x) { return 1.f / (1.f + expf(-x)); }
HD float softplusf_(float x) { return x > 20.f ? x : (x < -20.f ? expf(x) : log1pf(expf(x))); }
HD float siluf_(float x) { return x * sigmoidf_(x); }

HD int rowmap(int mode, int n) { return mode == 0 ? n : (mode == 1 ? (n >> 7) * 256 + (n & 127) : (n >> 7) * 256 + 128 + (n & 127)); }
HD void transpose_item(const float* W, int K, int N, int ldw, bf16_t* WT, int ldk, int mode, int item, int lane, wsh_t scr) {
    const int nblk = (N + 31) / 32, kb = item / nblk, nb = item % nblk, k0 = 64 * kb, n0 = 32 * nb;
    for (int idx = lane; idx < 2048; idx += LANES) { const int kk = idx >> 5, nn = idx & 31; const int n = n0 + nn;
        scr[kk * 33 + nn] = (n < N) ? W[(size_t)(k0 + kk) * ldw + n] : 0.f; }
    WSYNC();
    for (int idx = lane; idx < 256; idx += LANES) { const int n = idx >> 3, c = idx & 7;
        unsigned o[4];
        for (int j = 0; j < 4; ++j) o[j] = pk2(scr[(8 * c + 2 * j) * 33 + n], scr[(8 * c + 2 * j + 1) * 33 + n]);
        unsigned* dst = (unsigned*)(WT + (size_t)rowmap(mode, n0 + n) * ldk + k0 + 8 * c);
        dst[0] = o[0]; dst[1] = o[1]; dst[2] = o[2]; dst[3] = o[3]; }
    WSYNC();
}
HD void stage_convert(const Ctx& C, int l, int gw, int ngw, int lane, wsh_t scr) {
    constexpr int NB_IN = DINP / 32;
    constexpr int I_IN = (DM / 64) * NB_IN, I_OUT = (DMIX / 64) * (DM / 32), I_PG = (DM / 64) * (DM / 32), I_PW = (DPLE / 64 > 0 ? DPLE / 64 : 1) * (DM / 32);
    constexpr int I_G1 = (DM / 64) * (DEXP / 32), I_D1 = (DEXP / 64) * (DM / 32);
    constexpr int NIT = I_IN + I_OUT + I_PG + I_PW + NEXP * (2 * I_G1 + I_D1);
    static_assert(DPLE % 32 == 0 && DEXP % 64 == 0, "shapes");
    for (int it = gw; it < NIT; it += ngw) {
        int r = it;
        if (r < I_IN) {
            const int nblk = NB_IN, kb = r / nblk, nb = r % nblk, k0 = 64 * kb, n0 = 32 * nb;
            const float* W = INF(I_WIN) + (size_t)l * DM * DIN; bf16_t* WT = WSP(bf16_t, WS_WIN);
            for (int idx = lane; idx < 2048; idx += LANES) { const int kk = idx >> 5, nn = idx & 31; const int n = n0 + nn;
                scr[kk * 33 + nn] = (n < DIN) ? W[(size_t)(k0 + kk) * DIN + n] : 0.f; }
            WSYNC();
            for (int idx = lane; idx < 256; idx += LANES) { const int n = idx >> 3, c = idx & 7; unsigned o[4];
                for (int j = 0; j < 4; ++j) o[j] = pk2(scr[(8 * c + 2 * j) * 33 + n], scr[(8 * c + 2 * j + 1) * 33 + n]);
                unsigned* dst = (unsigned*)(WT + (size_t)(n0 + n) * DM + k0 + 8 * c); dst[0] = o[0]; dst[1] = o[1]; dst[2] = o[2]; dst[3] = o[3]; }
            WSYNC();
            continue; }
        r -= I_IN;
        if (r < I_OUT) { transpose_item(INF(I_WOUT) + (size_t)l * DMIX * DM, DMIX, DM, DM, WSP(bf16_t, WS_WOUT), DMIX, 0, r, lane, scr); continue; } r -= I_OUT;
        if (r < I_PG) { transpose_item(INF(I_PLEG) + (size_t)l * DM * DM, DM, DM, DM, WSP(bf16_t, WS_WPG), DM, 0, r, lane, scr); continue; } r -= I_PG;
        if (r < I_PW) {
            if (DPLE >= 64) transpose_item(INF(I_PLEW) + (size_t)l * DPLE * DM, DPLE, DM, DM, WSP(bf16_t, WS_WP), DPLE, 0, r, lane, scr);
            continue; } r -= I_PW;
        const int e = r / (2 * I_G1 + I_D1); r -= e * (2 * I_G1 + I_D1);
        if (r < I_G1) { transpose_item(INF(I_WG) + ((size_t)l * NEXP + e) * DM * DEXP, DM, DEXP, DEXP, WSP(bf16_t, WS_WGU) + (size_t)e * 2 * DEXP * DM, DM, 1, r, lane, scr); continue; } r -= I_G1;
        if (r < I_G1) { transpose_item(INF(I_WU) + ((size_t)l * NEXP + e) * DM * DEXP, DM, DEXP, DEXP, WSP(bf16_t, WS_WGU) + (size_t)e * 2 * DEXP * DM, DM, 2, r, lane, scr); continue; } r -= I_G1;
        transpose_item(INF(I_WD) + ((size_t)l * NEXP + e) * DEXP * DM, DEXP, DM, DM, WSP(bf16_t, WS_WD) + (size_t)e * DM * DEXP, DEXP, 0, r, lane, scr);
    }
    {   const float* wq = INF(I_WUQ) + (size_t)l * 256 * 384; const float* gq = INF(I_QNG) + l * 256; bf16_t* o = WSP(bf16_t, WS_WUQ);
        for (int i = gw * LANES + lane; i < 512 * 256; i += ngw * LANES) { const int n = i >> 8, k = i & 255; o[i] = f2bf(n < 384 ? gq[k] * wq[(size_t)k * 384 + n] : 0.f); }
        const float* wk = INF(I_WUKV) + (size_t)l * 128 * 512; const float* gk = INF(I_KVNG) + l * 128; bf16_t* o2 = WSP(bf16_t, WS_WUKV);
        for (int i = gw * LANES + lane; i < 512 * 256; i += ngw * LANES) { const int n = i >> 8, k = i & 255; o2[i] = f2bf(k < 128 ? gk[k] * wk[(size_t)k * 512 + n] : 0.f); } }
    if (l == 0) {
        const int* pos = (const int*)C.in[I_POS]; float* rt = WSP(float, WS_ROPE);
        for (int i = gw * LANES + lane; i < T * 16; i += ngw * LANES) { const int t = i >> 4, f = i & 15; const float ang = (float)pos[t] * powf(10000.f, -(float)f / 16.f);
            rt[(size_t)t * 32 + f] = cosf(ang); rt[(size_t)t * 32 + 16 + f] = sinf(ang); } }
    {   const float* p = INF(I_P) + (size_t)l * T * DPLE; bf16_t* pb = WSP(bf16_t, WS_PB);
        const size_t n4 = (size_t)T * DPLE / 4;
        for (size_t i = (size_t)gw * LANES + lane; i < n4; i += (size_t)ngw * LANES) {
            const float* s = p + 4 * i; unsigned* d = (unsigned*)(pb + 4 * i); d[0] = pk2(s[0], s[1]); d[1] = pk2(s[2], s[3]); } }
    if (l == 0) { const float* x = INF(I_X); bf16_t* xb = WSP(bf16_t, WS_XB);
        const size_t n4 = (size_t)T * DM / 4;
        for (size_t i = (size_t)gw * LANES + lane; i < n4; i += (size_t)ngw * LANES) {
            const float* s = x + 4 * i; unsigned* d = (unsigned*)(xb + 4 * i); d[0] = pk2(s[0], s[1]); d[1] = pk2(s[2], s[3]); } }
#ifdef CFG_SMALL
    if (DPLE < 64) {
        const float* W = INF(I_PLEW) + (size_t)l * DPLE * DM; bf16_t* WT = WSP(bf16_t, WS_WP);
        for (int i = gw * LANES + lane; i < DPLE * DM; i += ngw * LANES) { const int k = i / DM, n = i % DM; WT[(size_t)n * DPLE + k] = f2bf(W[i]); } }
#endif
}

HD float ubf(const bf16_t* u, int t, int c) { return bf2f(u[(size_t)t * DINP + c]); }
HD void stage_prep(const Ctx& C, int l, int gw, int ngw, int lane, wsh_t sh) {
    const bf16_t* u = WSP(bf16_t, WS_U);
    const float* mu = INF(I_MU) + l * DINA; const float* w0 = INF(I_W0) + l * GW; const float* wup = INF(I_WUP) + l * 32 * GW;
    const float* a0 = INF(I_A0) + l * GW; const float* aup = INF(I_AUP) + l * 32 * GW; const float* gup = INF(I_GUP) + l * 64 * GW;
    const float* kkw = INF(I_KK) + l * GW; const float* kaw = INF(I_KA) + l * GW;
    const float* glaup = INF(I_GLA_UP) + l * 16 * 128; const float* glab = INF(I_GLA_B) + l * 128;
    const float* convw = INF(I_CONVW) + l * 4 * 512; const float* convb = INF(I_CONVB) + l * 512;
    const float* ib = INF(I_IB) + l * 4; const float* fb = INF(I_FB) + l * 4;
    const float* qng = INF(I_QNG) + l * 256; const float* wuq = INF(I_WUQ) + (size_t)l * 256 * 384;
    const float* kvng = INF(I_KVNG) + l * 128; const float* wukv = INF(I_WUKV) + (size_t)l * 128 * 512;
    const int* pos = (const int*)C.in[I_POS];
    float* oR = WSP(float, WS_RW_R); float* oW = WSP(float, WS_RW_W); float* oK = WSP(float, WS_RW_K); float* oV = WSP(float, WS_RW_V);
    float* oA = WSP(float, WS_RW_A); float* oB = WSP(float, WS_RW_B); float* oG = WSP(float, WS_RW_G);
    float* oQK = WSP(float, WS_QK); float* oGA = WSP(float, WS_GA); float* oLG = WSP(float, WS_LG);
    bf16_t* oAQ = WSP(bf16_t, WS_AQ); bf16_t* oAK = WSP(bf16_t, WS_AK); bf16_t* oAV = WSP(bf16_t, WS_AV);
    for (int t = gw; t < T; t += ngw) {
        const int s = t % SEQ;
        for (int j = lane; j < 128; j += LANES) { const int c = UA_WD + j; const float cur = ubf(u, t, c), prev = s > 0 ? ubf(u, t - 1, c) : 0.f;
            const float v = cur + (prev - cur) * mu[c]; sh[j] = j < 32 ? tanhf(v) : (j < 64 ? v : sigmoidf_(v)); }
        WSYNC();
        for (int h = 0; h < NH; ++h) {
            float kkraw[HD64 / LANES]; float kv_[HD64 / LANES], av_[HD64 / LANES]; float ss = 0.f;
            for (int i = 0; i < HD64 / LANES; ++i) { const int c = h * 64 + i * LANES + lane;
                float z = w0[c], za = a0[c], g = 0.f;
_Pragma("unroll 8")
                for (int j = 0; j < 32; ++j) { z += sh[j] * wup[j * GW + c]; za += sh[32 + j] * aup[j * GW + c]; }
_Pragma("unroll 8")
                for (int j = 0; j < 64; ++j) g += sh[64 + j] * gup[j * GW + c];
                const float lnl = -softplusf_(-z) - 0.5f; const float decay = expf(-expf(lnl)); const float a = sigmoidf_(za);
                float r, k, v;
                { const float cur = ubf(u, t, UA_R + c), prev = s > 0 ? ubf(u, t - 1, UA_R + c) : 0.f; r = cur + (prev - cur) * mu[UA_R + c]; }
                { const float cur = ubf(u, t, UA_K + c), prev = s > 0 ? ubf(u, t - 1, UA_K + c) : 0.f; k = cur + (prev - cur) * mu[UA_K + c]; }
                { const float cur = ubf(u, t, UA_V + c), prev = s > 0 ? ubf(u, t - 1, UA_V + c) : 0.f; v = cur + (prev - cur) * mu[UA_V + c]; }
                kkraw[i] = k * kkw[c]; ss += kkraw[i] * kkraw[i];
                kv_[i] = k * (1.f + (a - 1.f) * kaw[c]); av_[i] = a;
                const size_t o = (size_t)t * GW + c; oR[o] = r; oW[o] = decay; oK[o] = kv_[i]; oV[o] = v; oG[o] = g; }
            ss = wave_sum(ss); const float inv = 1.f / fmaxf(sqrtf(ss), 1e-12f);
            for (int i = 0; i < HD64 / LANES; ++i) { const int c = h * 64 + i * LANES + lane; const size_t o = (size_t)t * GW + c; const float kk = kkraw[i] * inv;
                oA[o] = -kk; oB[o] = kk * av_[i]; }
        }
        WSYNC();
        for (int c = lane; c < 128; c += LANES) { float z = glab[c];
            for (int j = 0; j < 16; ++j) z += ubf(u, t, UB_AD + j) * glaup[j * 128 + c];
            oGA[(size_t)t * 128 + c] = -softplusf_(-z) * (1.f / 16.f); }
        for (int c = lane; c < 512; c += LANES) { float y = convb[c];
            for (int j = 0; j < 4; ++j) { const int sp = s - 3 + j; if (sp >= 0) y += convw[j * 512 + c] * ubf(u, t - 3 + j, UC_Q + c); }
            float q = siluf_(y); if (c >= 256) q *= 0.125f; oQK[(size_t)t * 512 + c] = q; }
        for (int c = lane; c < 8; c += LANES) { const float v = ubf(u, t, UC_IG + c);
            oLG[(size_t)t * 8 + c] = c < 4 ? v + ib[c] : -softplusf_(-(v + fb[c - 4])); }
        {   float ssq = 0.f, sskv = 0.f;
            for (int j = lane; j < 256; j += LANES) { const float v = ubf(u, t, UD_CQ + j); ssq += v * v; }
            for (int j = lane; j < 128; j += LANES) { const float v = ubf(u, t, UD_CKV + j); sskv += v * v; }
            ssq = wave_sum(ssq); sskv = wave_sum(sskv);
            const float rq = 1.f / sqrtf(ssq * (1.f / 256.f) + NORM_EPS), rkv = 1.f / sqrtf(sskv * (1.f / 128.f) + NORM_EPS);
            for (int j = lane; j < 256; j += LANES) sh[j] = ubf(u, t, UD_CQ + j) * rq * qng[j];
            for (int j = lane; j < 128; j += LANES) sh[256 + j] = ubf(u, t, UD_CKV + j) * rkv * kvng[j];
            WSYNC();
            for (int n = lane; n < 384; n += LANES) { float acc = 0.f;
_Pragma("unroll 8")
                for (int k = 0; k < 256; ++k) acc += sh[k] * wuq[(size_t)k * 384 + n]; sh[384 + n] = acc; }
            for (int n = lane; n < 512; n += LANES) { float acc = 0.f;
_Pragma("unroll 8")
                for (int k = 0; k < 128; ++k) acc += sh[256 + k] * wukv[(size_t)k * 512 + n]; sh[768 + n] = acc; }
            for (int i = lane; i < 16; i += LANES) { const float invf = powf(10000.f, -(float)i / 16.f); const float ang = (float)pos[t] * invf; sh[1280 + i] = cosf(ang); sh[1296 + i] = sinf(ang); }
            for (int i = lane; i < 32; i += LANES) sh[1312 + i] = ubf(u, t, UD_KR + i);
            WSYNC();
            const float qscale = 0.10206207261596575f * 1.4426950408889634f;
            for (int idx = lane; idx < 384; idx += LANES) { const int h = idx / 96, d = idx % 96; float v;
                if (d < 64) v = sh[384 + idx];
                else { const int i = (d - 64) & 15; const float x1 = sh[384 + h * 96 + 64 + i], x2 = sh[384 + h * 96 + 80 + i]; const float c_ = sh[1280 + i], s_ = sh[1296 + i];
                    v = (d - 64) < 16 ? x1 * c_ - x2 * s_ : x1 * s_ + x2 * c_; }
                oAQ[(size_t)t * 384 + idx] = f2bf(v * qscale); }
            for (int idx = lane; idx < 384; idx += LANES) { const int h = idx / 96, d = idx % 96; float v;
                if (d < 64) v = sh[768 + h * 128 + d];
                else { const int i = (d - 64) & 15; const float x1 = sh[1312 + i], x2 = sh[1328 + i]; const float c_ = sh[1280 + i], s_ = sh[1296 + i];
                    v = (d - 64) < 16 ? x1 * c_ - x2 * s_ : x1 * s_ + x2 * c_; }
                oAK[(size_t)t * 384 + idx] = f2bf(v); }
            for (int idx = lane; idx < 256; idx += LANES) { const int h = idx / 64, d = idx % 64; oAV[(size_t)t * 256 + idx] = f2bf(sh[768 + h * 128 + 64 + d]); }
            WSYNC();
        }
    }
}

HD void rwkv_scan_thread(const Ctx& C, int b, int h, int v) {
    const float* pR = WSP(float, WS_RW_R); const float* pW = WSP(float, WS_RW_W); const float* pK = WSP(float, WS_RW_K); const float* pV = WSP(float, WS_RW_V);
    const float* pA = WSP(float, WS_RW_A); const float* pB = WSP(float, WS_RW_B); float* Y = WSP(float, WS_YA);
    float S[64];
#pragma unroll
    for (int k = 0; k < 64; ++k) S[k] = 0.f;
    for (int s = 0; s < SEQ; ++s) {
        const size_t o = ((size_t)b * SEQ + s) * GW + h * 64;
        const float vv = pV[o + v];
        float sa0 = 0.f, sa1 = 0.f, sa2 = 0.f, sa3 = 0.f;
#pragma unroll
        for (int k = 0; k < 64; k += 4) { const f4v a = *(const f4v*)(pA + o + k); sa0 += S[k] * a[0]; sa1 += S[k + 1] * a[1]; sa2 += S[k + 2] * a[2]; sa3 += S[k + 3] * a[3]; }
        const float sa = (sa0 + sa1) + (sa2 + sa3);
        float y0 = 0.f, y1 = 0.f, y2 = 0.f, y3 = 0.f;
#pragma unroll
        for (int k = 0; k < 64; k += 4) {
            const f4v w = *(const f4v*)(pW + o + k), bb = *(const f4v*)(pB + o + k), kk = *(const f4v*)(pK + o + k), r = *(const f4v*)(pR + o + k);
            S[k] = S[k] * w[0] + sa * bb[0] + vv * kk[0]; y0 += S[k] * r[0];
            S[k + 1] = S[k + 1] * w[1] + sa * bb[1] + vv * kk[1]; y1 += S[k + 1] * r[1];
            S[k + 2] = S[k + 2] * w[2] + sa * bb[2] + vv * kk[2]; y2 += S[k + 2] * r[2];
            S[k + 3] = S[k + 3] * w[3] + sa * bb[3] + vv * kk[3]; y3 += S[k + 3] * r[3];
            if ((k & 12) == 12) asm volatile("" ::: "memory"); }
        Y[o + v] = (y0 + y1) + (y2 + y3);
    }
}
HD void gla_scan_thread(const Ctx& C, int b, int h, int v) {
    const bf16_t* u = WSP(bf16_t, WS_U); const float* GA = WSP(float, WS_GA); float* Y = WSP(float, WS_YB);
    float S[32];
#pragma unroll
    for (int k = 0; k < 32; ++k) S[k] = 0.f;
    for (int s = 0; s < SEQ; ++s) {
        const int t = b * SEQ + s;
        const float vv = ubf(u, t, UB_V + h * 64 + v);
        float acc = 0.f;
#pragma unroll
        for (int k8 = 0; k8 < 32; k8 += 8) { float kf[8], qf[8];
            ld8bf(u + (size_t)t * DINP + UB_K + h * 32 + k8, kf); ld8bf(u + (size_t)t * DINP + UB_Q + h * 32 + k8, qf);
            const f4v g0 = *(const f4v*)(GA + (size_t)t * 128 + h * 32 + k8), g1 = *(const f4v*)(GA + (size_t)t * 128 + h * 32 + k8 + 4);
#pragma unroll
            for (int j = 0; j < 8; ++j) { const float a = expf(j < 4 ? g0[j & 3] : g1[j & 3]); S[k8 + j] = a * S[k8 + j] + kf[j] * vv; acc += qf[j] * S[k8 + j]; } }
        Y[(size_t)t * GW + h * 64 + v] = acc * 0.17677669529663687f;
    }
}
HD void mlstm_scan_thread(const Ctx& C, int b, int h, int e) {
    const bf16_t* u = WSP(bf16_t, WS_U); const float* QK = WSP(float, WS_QK); const float* LG = WSP(float, WS_LG);
    float* Y = WSP(float, WS_YC); float* DEN = WSP(float, WS_DEN);
    float S[64];
#pragma unroll
    for (int k = 0; k < 64; ++k) S[k] = 0.f;
    for (int s = 0; s < SEQ; ++s) {
        const int t = b * SEQ + s;
        const float ig = expf(LG[(size_t)t * 8 + h]), fg = expf(LG[(size_t)t * 8 + 4 + h]);
        const float vv = (e < 64 ? ubf(u, t, UC_V + h * 64 + e) : 1.f) * ig;
        float acc = 0.f;
#pragma unroll
        for (int k = 0; k < 64; k += 4) { const f4v kk = *(const f4v*)(QK + (size_t)t * 512 + 256 + h * 64 + k), qq = *(const f4v*)(QK + (size_t)t * 512 + h * 64 + k);
#pragma unroll
            for (int j = 0; j < 4; ++j) { S[k + j] = fg * S[k + j] + kk[j] * vv; acc += qq[j] * S[k + j]; } }
        if (e < 64) Y[(size_t)t * GW + h * 64 + e] = acc; else DEN[(size_t)t * 4 + h] = acc;
    }
}
HD void attn_thread(const Ctx& C, int b, int h, int q, int kmax  ) {
    const bf16_t* Q = WSP(bf16_t, WS_AQ); const bf16_t* K = WSP(bf16_t, WS_AK); const bf16_t* V = WSP(bf16_t, WS_AV); bf16_t* mix = WSP(bf16_t, WS_MIX);
    const int t = b * SEQ + q;
    unsigned qp[48]; float o[64];
#pragma unroll
    for (int d = 0; d < 48; d += 4) { const u4v w = *(const u4v*)(Q + (size_t)t * 384 + h * 96 + 2 * d); qp[d] = w[0]; qp[d + 1] = w[1]; qp[d + 2] = w[2]; qp[d + 3] = w[3]; }
#pragma unroll
    for (int d = 0; d < 64; ++d) o[d] = 0.f;
    float m = -1e30f, lsum = 0.f;
    for (int j = 0; j <= kmax; ++j) {
        const size_t tk = (size_t)b * SEQ + j;
        float sc0 = 0.f, sc1 = 0.f;
#pragma unroll
        for (int d = 0; d < 96; d += 8) { float kf[8]; ld8bf(K + tk * 384 + h * 96 + d, kf);
#pragma unroll
            for (int i = 0; i < 8; i += 2) { const unsigned qw = qp[(d + i) >> 1];
                sc0 += __builtin_bit_cast(float, qw << 16) * kf[i]; sc1 += __builtin_bit_cast(float, qw & 0xffff0000u) * kf[i + 1]; }
            if ((d & 24) == 24) asm volatile("" ::: "memory"); }
        const float sc = sc0 + sc1;
        if (j <= q) {
            const float mn = fmaxf(m, sc); const float corr = exp2f(m - mn), p = exp2f(sc - mn);
            lsum = lsum * corr + p;
#pragma unroll
            for (int d = 0; d < 64; d += 8) { float vf[8]; ld8bf(V + tk * 256 + h * 64 + d, vf);
#pragma unroll
                for (int i = 0; i < 8; ++i) o[d + i] = o[d + i] * corr + p * vf[i];
                if (d & 8) asm volatile("" ::: "memory"); }
            m = mn; }
    }
    const float inv = 1.f / lsum;
#pragma unroll
    for (int d = 0; d < 64; d += 8) { float a[8];
#pragma unroll
        for (int i = 0; i < 8; ++i) a[i] = o[d + i] * inv;
        st8bf(mix + (size_t)t * DMIX + 768 + h * 64 + d, a); }
}

HD void stage_post(const Ctx& C, int l, int gw, int ngw, int lane) {
    const bf16_t* u = WSP(bf16_t, WS_U); bf16_t* mix = WSP(bf16_t, WS_MIX);
    const float* YA = WSP(float, WS_YA); const float* YB = WSP(float, WS_YB); const float* YC = WSP(float, WS_YC); const float* DEN = WSP(float, WS_DEN);
    const float* pR = WSP(float, WS_RW_R); const float* pK = WSP(float, WS_RW_K); const float* pV = WSP(float, WS_RW_V); const float* pG = WSP(float, WS_RW_G);
    const float* rk = INF(I_RK) + l * GW; const float* gng = INF(I_GNG) + l * GW; const float* gnb = INF(I_GNB) + l * GW;
    const float* glag = INF(I_GLA_G) + l * GW; const float* mlng = INF(I_MLN_G) + l * GW;
    constexpr int PL = HD64 / LANES;
    for (int t = gw; t < T; t += ngw) {
        for (int h = 0; h < NH; ++h) {
            {   float y[PL], s1 = 0.f, bon = 0.f;
                for (int i = 0; i < PL; ++i) { const int c = h * 64 + i * LANES + lane; const size_t o = (size_t)t * GW + c; y[i] = YA[o]; s1 += y[i]; bon += pR[o] * pK[o] * rk[c]; }
                s1 = wave_sum(s1); bon = wave_sum(bon); const float mean = s1 * (1.f / 64.f); float s2 = 0.f;
                for (int i = 0; i < PL; ++i) { y[i] -= mean; s2 += y[i] * y[i]; }
                s2 = wave_sum(s2); const float rstd = 1.f / sqrtf(s2 * (1.f / 64.f) + RWKV_GN_EPS);
                for (int i = 0; i < PL; ++i) { const int c = h * 64 + i * LANES + lane; const size_t o = (size_t)t * GW + c;
                    const float v = (y[i] * rstd * gng[c] + gnb[c] + bon * pV[o]) * pG[o]; mix[(size_t)t * DMIX + c] = f2bf(v); } }
            {   float y[PL], s2 = 0.f;
                for (int i = 0; i < PL; ++i) { const int c = h * 64 + i * LANES + lane; y[i] = YB[(size_t)t * GW + c]; s2 += y[i] * y[i]; }
                s2 = wave_sum(s2); const float rstd = 1.f / sqrtf(s2 * (1.f / 64.f) + NORM_EPS);
                for (int i = 0; i < PL; ++i) { const int c = h * 64 + i * LANES + lane;
                    const float v = y[i] * rstd * glag[c] * siluf_(ubf(u, t, UB_G + c)); mix[(size_t)t * DMIX + 256 + c] = f2bf(v); } }
            {   const float den = DEN[(size_t)t * 4 + h]; const float dinv = 1.f / fmaxf(fabsf(den), 1.f);
                float y[PL], s1 = 0.f;
                for (int i = 0; i < PL; ++i) { const int c = h * 64 + i * LANES + lane; y[i] = YC[(size_t)t * GW + c] * dinv; s1 += y[i]; }
                s1 = wave_sum(s1); const float mean = s1 * (1.f / 64.f); float s2 = 0.f;
                for (int i = 0; i < PL; ++i) { y[i] -= mean; s2 += y[i] * y[i]; }
                s2 = wave_sum(s2); const float rstd = 1.f / sqrtf(s2 * (1.f / 64.f) + LN_EPS);
                for (int i = 0; i < PL; ++i) { const int c = h * 64 + i * LANES + lane;
                    const float v = y[i] * rstd * mlng[c] * sigmoidf_(ubf(u, t, UC_O + c)); mix[(size_t)t * DMIX + 512 + c] = f2bf(v); } }
        }
    }
}

HD void ln_row(const float* src, const float* g, const float* b, float* dstf, bf16_t* dstb, int lane, float* keep  ) {
    constexpr int PL = DM / LANES;
    float s1 = 0.f;
#pragma unroll
    for (int i = 0; i < PL; ++i) { keep[i] = src[i * LANES + lane]; s1 += keep[i]; }
    s1 = wave_sum(s1); const float mean = s1 * (1.f / DM); float s2 = 0.f;
#pragma unroll
    for (int i = 0; i < PL; ++i) { keep[i] -= mean; s2 += keep[i] * keep[i]; }
    s2 = wave_sum(s2); const float rstd = 1.f / sqrtf(s2 * (1.f / DM) + LN_EPS);
#pragma unroll
    for (int i = 0; i < PL; ++i) { const int c = i * LANES + lane; keep[i] = keep[i] * rstd * g[c] + b[c]; dstf[c] = keep[i]; dstb[c] = f2bf(keep[i]); }
}
HD void stage_ln1_router(const Ctx& C, int l, int gw, int ngw, int lane, wsh_t sh) {
    float* X1 = C.out; bf16_t* xb = WSP(bf16_t, WS_XB);
    const float* g = INF(I_LN1G) + l * DM; const float* b = INF(I_LN1B) + l * DM;
    const float* wrg = INF(I_WRG) + (size_t)l * DM * NGRP; const float* brg = INF(I_BRG) + l * NGRP;
    const float* wre = INF(I_WRE) + (size_t)l * DM * NEXP; const float* bre = INF(I_BRE) + l * NEXP;
    unsigned* cnt = WSP(unsigned, WS_CTL) + CW_CNT + l * NEXP * 64;
    int* tokinfo = WSP(int, WS_TOKINFO); int* list = WSP(int, WS_LIST);
    constexpr int PL = DM / LANES;
    for (int t = gw; t < T; t += ngw) {
        {   float keep[PL];
            ln_row(X1 + (size_t)t * DM, g, b, X1 + (size_t)t * DM, xb + (size_t)t * DM, lane, keep);
#pragma unroll
            for (int i = 0; i < PL; ++i) sh[i * LANES + lane] = keep[i]; }
        WSYNC();
        float lg[NGRP], le[NEXP];
#pragma unroll
        for (int j = 0; j < NGRP; ++j) lg[j] = 0.f;
#pragma unroll
        for (int j = 0; j < NEXP; ++j) le[j] = 0.f;
#pragma unroll 1
        for (int i = 0; i < PL; ++i) { const int c = i * LANES + lane; const float xv = sh[c];
            const f4v wg = *(const f4v*)(wrg + (size_t)c * NGRP);
#pragma unroll
            for (int j = 0; j < NGRP; ++j) lg[j] += xv * wg[j];
#pragma unroll
            for (int j = 0; j < NEXP; j += 4) { const f4v we = *(const f4v*)(wre + (size_t)c * NEXP + j);
                le[j] += xv * we[0]; le[j + 1] += xv * we[1]; le[j + 2] += xv * we[2]; le[j + 3] += xv * we[3]; } }
        WSYNC();
#pragma unroll
        for (int j = 0; j < NGRP; ++j) lg[j] = wave_sum(lg[j]) + brg[j];
#pragma unroll
        for (int j = 0; j < NEXP; ++j) le[j] = wave_sum(le[j]) + bre[j];
        int gi = 0; float gm = lg[0];
#pragma unroll
        for (int j = 1; j < NGRP; ++j) if (lg[j] > gm) { gm = lg[j]; gi = j; }
        float gs = 0.f;
#pragma unroll
        for (int j = 0; j < NGRP; ++j) gs += expf(lg[j] - gm);
        const float group_p = 1.f / gs;
        float el[EPG];
#pragma unroll
        for (int j = 0; j < EPG; ++j) { float v = le[j];
#pragma unroll
            for (int g2 = 1; g2 < NGRP; ++g2) v = (gi == g2) ? le[g2 * EPG + j] : v;
            el[j] = v; }
        int e0 = 0; float m0 = el[0];
#pragma unroll
        for (int j = 1; j < EPG; ++j) if (el[j] > m0) { m0 = el[j]; e0 = j; }
        int e1 = -1; float m1 = -3.0e38f;
#pragma unroll
        for (int j = 0; j < EPG; ++j) if (j != e0 && el[j] > m1) { m1 = el[j]; e1 = j; }
        const float p1 = expf(m1 - m0); const float g0 = group_p / (1.f + p1), g1 = group_p * p1 / (1.f + p1);
        if (lane == 0) {
            const int E0 = gi * EPG + e0, E1 = gi * EPG + e1;
            tokinfo[(size_t)t * 4 + 0] = E0; tokinfo[(size_t)t * 4 + 1] = E1;
            ((float*)tokinfo)[(size_t)t * 4 + 2] = g0; ((float*)tokinfo)[(size_t)t * 4 + 3] = g1;
            const unsigned s0 = atom_add(cnt + E0 * 64, 1u); list[(size_t)E0 * T + s0] = t * 2 + 0;
            const unsigned s1 = atom_add(cnt + E1 * 64, 1u); list[(size_t)E1 * T + s1] = t * 2 + 1;
        }
    }
}
HD void moe_bases(const Ctx& C, int l, int* base  ) {
    const unsigned* cnt = WSP(unsigned, WS_CTL) + CW_CNT + l * NEXP * 64;
    int acc = 0;
    for (int e = 0; e < NEXP; ++e) { base[e] = acc; acc += ((int)cnt[e * 64] + 255) & ~255; }
    base[NEXP] = acc;
}
HD int moe_expert_of_row(const int* base, int row) { int e = 0; for (int j = 1; j < NEXP; ++j) if (row >= base[j]) e = j; return e; }
HD int moe_lookup(const unsigned* cnt, int row, int& e, int& be, int& ce) {
    int acc = 0; e = 0; be = 0; ce = 0;
    for (int j = 0; j < NEXP; ++j) { const int c = (int)cnt[j * 64]; if (row >= acc) { e = j; be = acc; ce = c; } acc += (c + 255) & ~255; }
    return acc;
}
HD void stage_gather(const Ctx& C, int l, int gw, int ngw, int lane) {
    const unsigned* cnt = WSP(unsigned, WS_CTL) + CW_CNT + l * NEXP * 64;
    const int* list = WSP(int, WS_LIST); const int* tokinfo = WSP(int, WS_TOKINFO);
    const bf16_t* xb = WSP(bf16_t, WS_XB); bf16_t* xg = WSP(bf16_t, WS_XG); int* rowinfo = WSP(int, WS_ROWINFO); float* rowgate = WSP(float, WS_ROWGATE);
    int e, be, ce; const int total = moe_lookup(cnt, 0, e, be, ce);
    for (int row = gw; row < total; row += ngw) {
        moe_lookup(cnt, row, e, be, ce);
        const int slot = row - be;
        if (slot < ce) { const int ent = list[(size_t)e * T + slot]; const int tok = ent >> 1;
            for (int c = lane * 8; c < DM; c += LANES * 8) *(u4v*)(xg + (size_t)row * DM + c) = *(const u4v*)(xb + (size_t)tok * DM + c);
            if (lane == 0) { rowinfo[row] = ent; rowgate[row] = ((const float*)tokinfo)[(size_t)tok * 4 + 2 + (ent & 1)]; } }
        else { const u4v z = {0u, 0u, 0u, 0u}; for (int c = lane * 8; c < DM; c += LANES * 8) *(u4v*)(xg + (size_t)row * DM + c) = z;
            if (lane == 0) { rowinfo[row] = -1; rowgate[row] = 0.f; } }
    }
}
HD void stage_ln2(const Ctx& C, int l, int gw, int ngw, int lane) {
    const float* src = WSP(float, WS_X); float* dst = (l == DEPTH - 1) ? C.out : WSP(float, WS_X); bf16_t* xb = WSP(bf16_t, WS_XB);
    const float* g = INF(I_LN2G) + l * DM; const float* b = INF(I_LN2B) + l * DM;
    constexpr int PL = DM / LANES;
    for (int t = gw; t < T; t += ngw) { float keep[PL]; ln_row(src + (size_t)t * DM, g, b, dst + (size_t)t * DM, xb + (size_t)t * DM, lane, keep); }
}

struct EpiU {
    static constexpr bool PERM = true; static constexpr int MODE = 0;
    bf16_t* o;
    HDM void put8(int row, int col, const float* a) const { st8bf(o + (size_t)row * DINP + col, a); }
};
struct EpiPP {
    static constexpr bool PERM = true; static constexpr int MODE = 0;
    bf16_t* o;
    HDM void put8(int row, int col, const float* a) const { st8bf(o + (size_t)row * DM + col, a); }
};
struct EpiPre1 {
    static constexpr bool PERM = false; static constexpr int MODE = 0;
    const float* x; float* o;
    HDM void put4(int row, int col, const float* a) const { const float al = dn_alpha(); const f4v xr = *(const f4v*)(x + (size_t)row * DM + col);
        f4v r; for (int j = 0; j < 4; ++j) r[j] = al * xr[j] + a[j]; *(f4v*)(o + (size_t)row * DM + col) = r; }
};
struct EpiH {
    static constexpr bool PERM = true; static constexpr int MODE = 1;
    bf16_t* o;
    HDM void put8gu(int row, int hcol, const float* g, const float* u) const { float v[8]; for (int j = 0; j < 8; ++j) v[j] = siluf_(g[j]) * u[j];
        st8bf(o + (size_t)row * DEXP + hcol, v); }
};
struct EpiY {
    static constexpr bool PERM = true; static constexpr int MODE = 0;
    const int* rowinfo; const float* rowgate; bf16_t* o;
    HDM void put8(int row, int col, const float* a) const { const int ent = rowinfo[row]; if (ent < 0) return; const float g = rowgate[row];
        float v[8]; for (int j = 0; j < 8; ++j) v[j] = g * a[j]; st8bf(o + (size_t)ent * DM + col, v); }
};
struct EpiPre2 {
    static constexpr bool PERM = false; static constexpr int MODE = 0;
    const float* x1; const bf16_t* ybuf; const bf16_t* pp; const float* bg; float* o;
    HDM void put4(int row, int col, const float* a) const { const float al = dn_alpha(); const size_t i = (size_t)row * DM + col;
        const f4v xr = *(const f4v*)(x1 + i); const f4v bgv = *(const f4v*)(bg + col);
        const unsigned* y0 = (const unsigned*)(ybuf + (size_t)(2 * row) * DM + col); const unsigned* y1 = (const unsigned*)(ybuf + (size_t)(2 * row + 1) * DM + col); const unsigned* pq = (const unsigned*)(pp + i);
        const unsigned y00 = y0[0], y01 = y0[1], y10 = y1[0], y11 = y1[1], p0 = pq[0], p1 = pq[1];
        float yv[4] = { __builtin_bit_cast(float, y00 << 16) + __builtin_bit_cast(float, y10 << 16), __builtin_bit_cast(float, y00 & 0xffff0000u) + __builtin_bit_cast(float, y10 & 0xffff0000u),
                        __builtin_bit_cast(float, y01 << 16) + __builtin_bit_cast(float, y11 << 16), __builtin_bit_cast(float, y01 & 0xffff0000u) + __builtin_bit_cast(float, y11 & 0xffff0000u) };
        float pv[4] = { __builtin_bit_cast(float, p0 << 16), __builtin_bit_cast(float, p0 & 0xffff0000u), __builtin_bit_cast(float, p1 << 16), __builtin_bit_cast(float, p1 & 0xffff0000u) };
        f4v r; for (int j = 0; j < 4; ++j) r[j] = al * xr[j] + yv[j] + sigmoidf_(a[j] + bgv[j]) * pv[j];
        *(f4v*)(o + i) = r; }
};

#ifndef CPU_TEST
struct EpiQ {
    static constexpr bool PERM = true; static constexpr int MODE = 0;
    const float* rope; bf16_t* o;
    __device__ __forceinline__ void put8(int row, int col, const float* a) const {
        float p[8];
#pragma unroll
        for (int j = 0; j < 8; ++j) p[j] = __shfl_xor(a[j], 32);
        if (col >= 384) return;
        const float qscale = 0.10206207261596575f * 1.4426950408889634f;
        const int d0 = col % 96; float v[8];
        if (d0 < 64) {
#pragma unroll
            for (int j = 0; j < 8; ++j) v[j] = a[j] * qscale; }
        else { const int i0 = (d0 - 64) & 15; const bool x2 = (d0 - 64) >= 16; const float* rt = rope + (size_t)row * 32 + i0;
            const f4v c0 = *(const f4v*)rt, c1 = *(const f4v*)(rt + 4), s0 = *(const f4v*)(rt + 16), s1 = *(const f4v*)(rt + 20);
#pragma unroll
            for (int j = 0; j < 8; ++j) { const float c = j < 4 ? c0[j & 3] : c1[j & 3], s = j < 4 ? s0[j & 3] : s1[j & 3];
                v[j] = (x2 ? (p[j] * s + a[j] * c) : (a[j] * c - p[j] * s)) * qscale; } }
        st8bf(o + (size_t)row * 384 + col, v); }
};
struct EpiKV {
    static constexpr bool PERM = true; static constexpr int MODE = 0;
    bf16_t* k; bf16_t* v;
    __device__ __forceinline__ void put8(int row, int col, const float* a) const { const int h = col >> 7, d = col & 127;
        if (d < 64) st8bf(k + (size_t)row * 384 + h * 96 + d, a); else st8bf(v + (size_t)row * 256 + h * 64 + (d - 64), a); }
};
__device__ __forceinline__ void mla_token_pass(const Ctx& C, int gw, int ngw, int lane) {
    const bf16_t* u = WSP(bf16_t, WS_U); const float* rope = WSP(float, WS_ROPE); float* rstd = WSP(float, WS_RSTD); bf16_t* K = WSP(bf16_t, WS_AK);
    for (int t = gw; t < T; t += ngw) {
        const bf16_t* ur = u + (size_t)t * DINP;
        float ssq = 0.f, sskv = 0.f;
        { const unsigned* p = (const unsigned*)(ur + UD_CQ) + 2 * lane; const unsigned w0 = p[0], w1 = p[1];
          const float a = __builtin_bit_cast(float, w0 << 16), b = __builtin_bit_cast(float, w0 & 0xffff0000u), c = __builtin_bit_cast(float, w1 << 16), d = __builtin_bit_cast(float, w1 & 0xffff0000u);
          ssq = (a * a + b * b) + (c * c + d * d); }
        { const unsigned w0 = ((const unsigned*)(ur + UD_CKV))[lane]; const float a = __builtin_bit_cast(float, w0 << 16), b = __builtin_bit_cast(float, w0 & 0xffff0000u); sskv = a * a + b * b; }
        ssq = wave_sum(ssq); sskv = wave_sum(sskv);
        if (lane == 0) { rstd[(size_t)t * 2] = 1.f / sqrtf(ssq * (1.f / 256.f) + NORM_EPS); rstd[(size_t)t * 2 + 1] = 1.f / sqrtf(sskv * (1.f / 128.f) + NORM_EPS); }
        { const int i = lane & 15, hh = lane >> 4; const float x1 = bf2f(ur[UD_KR + i]), x2 = bf2f(ur[UD_KR + 16 + i]); const float c = rope[(size_t)t * 32 + i], s = rope[(size_t)t * 32 + 16 + i];
          bf16_t* kd = K + (size_t)t * 384 + hh * 96 + 64; kd[i] = f2bf(x1 * c - x2 * s); kd[16 + i] = f2bf(x1 * s + x2 * c); }
    }
}
__device__ __forceinline__ void rwkv_prep_coop(const Ctx& C, int l, __attribute__((address_space(3))) unsigned char* lds) {
    int tid = threadIdx.x; asm volatile("" : "+v"(tid));
    const int lane = tid & 63, w = __builtin_amdgcn_readfirstlane(tid >> 6);
    const bf16_t* u = WSP(bf16_t, WS_U);
    const float* mu = INF(I_MU) + l * DINA;
    float* oR = WSP(float, WS_RW_R); float* oW = WSP(float, WS_RW_W); float* oK = WSP(float, WS_RW_K); float* oV = WSP(float, WS_RW_V);
    float* oA = WSP(float, WS_RW_A); float* oB = WSP(float, WS_RW_B); float* oG = WSP(float, WS_RW_G);
    __attribute__((address_space(3))) float* act = (__attribute__((address_space(3))) float*)lds;
    const int h = w & 3, role = w >> 2, c = h * 64 + lane;
    float wc0[32], wc1[32];
    { const float* p0 = role == 0 ? INF(I_WUP) + l * 32 * GW + c : INF(I_GUP) + l * 64 * GW + c;
      const float* p1 = role == 0 ? INF(I_AUP) + l * 32 * GW + c : INF(I_GUP) + l * 64 * GW + 32 * GW + c;
#pragma unroll
      for (int j = 0; j < 32; ++j) { wc0[j] = p0[j * GW]; wc1[j] = p1[j * GW]; } }
    const float w0c = INF(I_W0)[l * GW + c], a0c = INF(I_A0)[l * GW + c], kkc = INF(I_KK)[l * GW + c], kac = INF(I_KA)[l * GW + c];
    const float mur = mu[UA_R + c], muk = mu[UA_K + c], muv = mu[UA_V + c];
    for (int unit = blockIdx.x; unit < T / 16; unit += gridDim.x) {
        const int t0 = unit * 16;
        { const int tk = tid >> 5, j0 = (tid & 31) * 4; const int t = t0 + tk; const bool first = (t % SEQ) == 0;
          const unsigned* pc = (const unsigned*)(u + (size_t)t * DINP + UA_WD + j0); const unsigned c0 = pc[0], c1 = pc[1];
          unsigned q0 = 0u, q1 = 0u; if (!first) { const unsigned* pp = (const unsigned*)(u + (size_t)(t - 1) * DINP + UA_WD + j0); q0 = pp[0]; q1 = pp[1]; }
          const float cur[4] = {__builtin_bit_cast(float, c0 << 16), __builtin_bit_cast(float, c0 & 0xffff0000u), __builtin_bit_cast(float, c1 << 16), __builtin_bit_cast(float, c1 & 0xffff0000u)};
          const float prv[4] = {__builtin_bit_cast(float, q0 << 16), __builtin_bit_cast(float, q0 & 0xffff0000u), __builtin_bit_cast(float, q1 << 16), __builtin_bit_cast(float, q1 & 0xffff0000u)};
          f4v o;
#pragma unroll
          for (int j = 0; j < 4; ++j) { const float v = cur[j] + (prv[j] - cur[j]) * mu[UA_WD + j0 + j]; o[j] = (j0 < 32) ? tanhf(v) : (j0 < 64 ? v : sigmoidf_(v)); }
          *(__attribute__((address_space(3))) f4v*)(act + tk * 128 + j0) = o; }
        __syncthreads();
#pragma unroll 1
        for (int tk = 0; tk < 16; ++tk) { const int t = t0 + tk; const bool first = (t % SEQ) == 0;
            const __attribute__((address_space(3))) float* ar = act + tk * 128 + (role == 0 ? 0 : 64);
            float s0 = 0.f, s1 = 0.f;
#pragma unroll
            for (int j = 0; j < 32; j += 4) { const f4v x = *(const __attribute__((address_space(3))) f4v*)(ar + j), y = *(const __attribute__((address_space(3))) f4v*)(ar + 32 + j);
                s0 += x[0] * wc0[j] + x[1] * wc0[j + 1] + x[2] * wc0[j + 2] + x[3] * wc0[j + 3]; s1 += y[0] * wc1[j] + y[1] * wc1[j + 1] + y[2] * wc1[j + 2] + y[3] * wc1[j + 3];
                if ((j & 12) == 12) asm volatile("" ::: "memory"); }
            const size_t o = (size_t)t * GW + c;
            if (role == 1) { oG[o] = s0 + s1; }
            else {
                const float z = w0c + s0, za = a0c + s1;
                const float lnl = -softplusf_(-z) - 0.5f; const float decay = __expf(-__expf(lnl)); const float a = sigmoidf_(za);
                const bf16_t* uc = u + (size_t)t * DINP + c; const bf16_t* up = uc - DINP;
                const float rc = bf2f(uc[UA_R]), kc = bf2f(uc[UA_K]), vc = bf2f(uc[UA_V]);
                const float rp = first ? 0.f : bf2f(up[UA_R]), kp = first ? 0.f : bf2f(up[UA_K]), vp = first ? 0.f : bf2f(up[UA_V]);
                const float r = rc + (rp - rc) * mur, k = kc + (kp - kc) * muk, v = vc + (vp - vc) * muv;
                const float kkraw = k * kkc; const float ss = wave_sum(kkraw * kkraw); const float kk = kkraw / fmaxf(sqrtf(ss), 1e-12f);
                oR[o] = r; oW[o] = decay; oK[o] = k * (1.f + (a - 1.f) * kac); oV[o] = v; oA[o] = -kk; oB[o] = kk * a; } }
        __syncthreads();
    }
}
#endif

#ifndef CPU_TEST
__device__ __forceinline__ void ln1_router_coop(const Ctx& C, int l, __attribute__((address_space(3))) unsigned char* lds) {
    int tid = threadIdx.x; asm volatile("" : "+v"(tid));
    const int lane = tid & 63, w = __builtin_amdgcn_readfirstlane(tid >> 6);
    float* X1 = C.out; bf16_t* xb = WSP(bf16_t, WS_XB);
    const float* g = INF(I_LN1G) + l * DM; const float* b = INF(I_LN1B) + l * DM;
    const float* wrg = INF(I_WRG) + (size_t)l * DM * NGRP; const float* brg = INF(I_BRG) + l * NGRP;
    const float* wre = INF(I_WRE) + (size_t)l * DM * NEXP; const float* bre = INF(I_BRE) + l * NEXP;
    unsigned* cnt = WSP(unsigned, WS_CTL) + CW_CNT + l * NEXP * 64;
    int* tokinfo = WSP(int, WS_TOKINFO); int* list = WSP(int, WS_LIST);
    __attribute__((address_space(3))) float* part = (__attribute__((address_space(3))) float*)lds;
    for (int tb0 = blockIdx.x * 128; tb0 < T; tb0 += gridDim.x * 128) {
        for (int i = 0; i < 16; ++i) { const int t = tb0 + w * 16 + i; float keep[DM / 64];
            ln_row(X1 + (size_t)t * DM, g, b, X1 + (size_t)t * DM, xb + (size_t)t * DM, lane, keep); }
        asm volatile("s_waitcnt vmcnt(0)" ::: "memory");
        __syncthreads();
        for (int half = 0; half < 2; ++half) {
            const int t = tb0 + half * 64 + lane;
            float acc[36];
#pragma unroll
            for (int j = 0; j < 36; ++j) acc[j] = 0.f;
            const float* xr = X1 + (size_t)t * DM + 128 * w;
#pragma unroll 1
            for (int k4 = 0; k4 < 32; ++k4) {
                const f4v x = *(const f4v*)(xr + 4 * k4);
#pragma unroll
                for (int kk = 0; kk < 4; ++kk) { const int k = 128 * w + 4 * k4 + kk;
                    typedef __attribute__((address_space(4))) const float cfl; cfl* we = (cfl*)(wre + (size_t)k * NEXP); cfl* wg = (cfl*)(wrg + (size_t)k * NGRP);
#pragma unroll
                    for (int j = 0; j < 4; ++j) acc[j] += x[kk] * wg[j];
#pragma unroll
                    for (int j = 0; j < 32; ++j) acc[4 + j] += x[kk] * we[j]; } }
#pragma unroll
            for (int j = 0; j < 36; ++j) part[(w * 36 + j) * 64 + lane] = acc[j];
            __syncthreads();
            if (w == 0) {
                float lg[NGRP], le[NEXP];
#pragma unroll
                for (int j = 0; j < NGRP; ++j) { float s = brg[j];
#pragma unroll
                    for (int ww = 0; ww < 8; ++ww) s += part[(ww * 36 + j) * 64 + lane]; lg[j] = s; }
#pragma unroll
                for (int j = 0; j < NEXP; ++j) { float s = bre[j];
#pragma unroll
                    for (int ww = 0; ww < 8; ++ww) s += part[(ww * 36 + 4 + j) * 64 + lane]; le[j] = s; }
                int gi = 0; float gm = lg[0];
#pragma unroll
                for (int j = 1; j < NGRP; ++j) if (lg[j] > gm) { gm = lg[j]; gi = j; }
                float gs = 0.f;
#pragma unroll
                for (int j = 0; j < NGRP; ++j) gs += expf(lg[j] - gm);
                const float group_p = 1.f / gs;
                float el[EPG];
#pragma unroll
                for (int j = 0; j < EPG; ++j) { float v = le[j];
#pragma unroll
                    for (int g2 = 1; g2 < NGRP; ++g2) v = (gi == g2) ? le[g2 * EPG + j] : v;
                    el[j] = v; }
                int e0 = 0; float m0 = el[0];
#pragma unroll
                for (int j = 1; j < EPG; ++j) if (el[j] > m0) { m0 = el[j]; e0 = j; }
                int e1 = -1; float m1 = -3.0e38f;
#pragma unroll
                for (int j = 0; j < EPG; ++j) if (j != e0 && el[j] > m1) { m1 = el[j]; e1 = j; }
                const float p1 = expf(m1 - m0); const float g0 = group_p / (1.f + p1), g1 = group_p * p1 / (1.f + p1);
                const int E0 = gi * EPG + e0, E1 = gi * EPG + e1;
                tokinfo[(size_t)t * 4 + 0] = E0; tokinfo[(size_t)t * 4 + 1] = E1;
                ((float*)tokinfo)[(size_t)t * 4 + 2] = g0; ((float*)tokinfo)[(size_t)t * 4 + 3] = g1;
                const unsigned s0 = atomicAdd(cnt + E0 * 64, 1u); list[(size_t)E0 * T + s0] = t * 2 + 0;
                const unsigned s1 = atomicAdd(cnt + E1 * 64, 1u); list[(size_t)E1 * T + s1] = t * 2 + 1;
            }
            __syncthreads();
        }
    }
}
#endif

#ifndef CPU_TEST
namespace pg8 {
#define PG8_LAS __attribute__((address_space(3)))
typedef short bf16x8 __attribute__((ext_vector_type(8)));
typedef float f32x4 __attribute__((ext_vector_type(4)));
constexpr int BM = 256, BK = 64, HALF = 128, HTB = HALF * BK * 2, STAGE_BYTES = 8 * HTB;
__device__ __forceinline__ int lds_byte(int r, int c) { const int st = (r >> 4) * 2 + (c >> 5), rr = r & 15, cc = c & 31, ob = rr * 64 + cc * 2; return st * 1024 + (ob ^ (((ob >> 9) & 1) << 5)); }
__device__ __forceinline__ void stage_rc(int b, int& R, int& C) { const int st = b / 1024, sb = b % 1024, swz = sb ^ (((sb >> 9) & 1) << 5); R = (st >> 1) * 16 + swz / 64; C = (st & 1) * 32 + (swz % 64) / 2; }
__device__ __forceinline__ int perm32(int rho) { const int n = rho >> 4, i = rho & 15; return 8 * (i >> 2) + 4 * n + (i & 3); }
struct Unit { int pm, pn; long aoff, boff; };
struct Gemm { const bf16_t* A; const bf16_t* Bt; int lda, ldb, K; };

template <class F> __device__ __forceinline__ void run_epi(const F& f, const f32x4 (&acc)[2][2][4][2], const Unit& u, int wr, int wc, int fr, int fq) {
#pragma unroll
    for (int ai = 0; ai < 2; ++ai)
#pragma unroll
        for (int m = 0; m < 4; ++m) { const int row = u.pm * BM + ai * HALF + wr * 64 + m * 16 + fr;
            if constexpr (F::MODE == 1) { const int hcol = u.pn * 128 + wc * 32 + 8 * fq; float g[8], up[8];
#pragma unroll
                for (int j = 0; j < 4; ++j) { g[j] = acc[ai][0][m][0][j]; g[4 + j] = acc[ai][0][m][1][j]; up[j] = acc[ai][1][m][0][j]; up[4 + j] = acc[ai][1][m][1][j]; }
                f.put8gu(row, hcol, g, up); }
            else if constexpr (F::PERM) {
#pragma unroll
                for (int bj = 0; bj < 2; ++bj) { const int col = u.pn * BM + bj * HALF + wc * 32 + 8 * fq; float a[8];
#pragma unroll
                    for (int j = 0; j < 4; ++j) { a[j] = acc[ai][bj][m][0][j]; a[4 + j] = acc[ai][bj][m][1][j]; }
                    f.put8(row, col, a); } }
            else {
#pragma unroll
                for (int bj = 0; bj < 2; ++bj)
#pragma unroll
                    for (int n = 0; n < 2; ++n) { const int col = u.pn * BM + bj * HALF + wc * 32 + 16 * n + 4 * fq; float a[4];
#pragma unroll
                        for (int j = 0; j < 4; ++j) a[j] = acc[ai][bj][m][n][j];
                        f.put4(row, col, a); } }
        }
}

template <class Epi, class Sched>
__device__ __forceinline__ void gemm_phase(PG8_LAS unsigned char* lds, const Gemm g, const Sched& S, const Epi& E) {
    int tid = threadIdx.x; asm volatile("" : "+v"(tid));
    const int wid = __builtin_amdgcn_readfirstlane(tid >> 6), lane = tid & 63, wr = wid >> 2, wc = wid & 3, fr = lane & 15, fq = lane >> 4;
    const int K = g.K, nt = K / BK;
    unsigned voffA[2], voffB[2];
#pragma unroll
    for (int i = 0; i < 2; ++i) { int R, C; stage_rc(tid * 16 + i * 8192, R, C); const int Rb = Epi::PERM ? ((R & ~31) + perm32(R & 31)) : R;
        voffA[i] = (unsigned)(R * g.lda + C) * 2u; voffB[i] = (unsigned)(Rb * g.ldb + C) * 2u; }
    const size_t kstep = (size_t)(BK * 2);
    const size_t hstepA = (size_t)HALF * g.lda * 2, hstepB = (size_t)HALF * g.ldb * 2;
    const unsigned ldsw = (unsigned)wid * 1024u;
    const int aoff = lds_byte(wr * 64 + fr, fq * 8), boff = lds_byte(wc * 32 + fr, fq * 8);
#define PG8_SA(b, h) (((b) * 2 + (h)) * HTB)
#define PG8_SB(b, h) ((4 + (b) * 2 + (h)) * HTB)
#define PG8_STAGE(bufoff, gbase, voff) do { _Pragma("unroll") for (int _i = 0; _i < 2; ++_i) \
        __builtin_amdgcn_global_load_lds((const unsigned*)((const char*)(gbase) + (voff)[_i]), (PG8_LAS unsigned*)(lds + (bufoff) + ldsw + _i * 8192), 16, 0, 0); } while (0)
#define PG8_LDA(dst, b, h) do { _Pragma("unroll") for (int m = 0; m < 4; ++m) _Pragma("unroll") for (int k = 0; k < 2; ++k) dst[m][k] = *(const PG8_LAS bf16x8*)(lds + PG8_SA(b, h) + aoff + m * 2048 + k * 1024); } while (0)
#define PG8_LDB(dst, b, h) do { _Pragma("unroll") for (int n = 0; n < 2; ++n) _Pragma("unroll") for (int k = 0; k < 2; ++k) dst[n][k] = *(const PG8_LAS bf16x8*)(lds + PG8_SB(b, h) + boff + n * 2048 + k * 1024); } while (0)
#define PG8_MMA(ai, bj, At, Bt) do { __builtin_amdgcn_s_setprio(1); _Pragma("unroll") for (int m = 0; m < 4; ++m) _Pragma("unroll") for (int n = 0; n < 2; ++n) _Pragma("unroll") for (int k = 0; k < 2; ++k) \
        acc[ai][bj][m][n] = __builtin_amdgcn_mfma_f32_16x16x32_bf16(Bt[n][k], At[m][k], acc[ai][bj][m][n], 0, 0, 0); __builtin_amdgcn_s_setprio(0); } while (0)
#define PG8_WAIT_V(n) asm volatile("s_waitcnt vmcnt(" #n ")" ::: "memory")
#define PG8_WAIT_L(n) asm volatile("s_waitcnt lgkmcnt(" #n ")" ::: "memory")
#define PG8_BAR __builtin_amdgcn_s_barrier()
#define PG8_SCHED __builtin_amdgcn_sched_barrier(0)
    Unit cur, nxt; int ui = 0;
    if (!S.next(0, cur)) return;
    f32x4 acc[2][2][4][2];
#pragma unroll
    for (int a = 0; a < 2; ++a)
#pragma unroll
        for (int b = 0; b < 2; ++b)
#pragma unroll
            for (int m = 0; m < 4; ++m)
#pragma unroll
                for (int n = 0; n < 2; ++n) acc[a][b][m][n] = (f32x4){0.f, 0.f, 0.f, 0.f};
    bf16x8 At[4][2], B0[2][2], B1[2][2];
    const char* cA = (const char*)g.A + cur.aoff; const char* cB = (const char*)g.Bt + cur.boff;
    PG8_STAGE(PG8_SB(0, 0), cB, voffB); PG8_STAGE(PG8_SA(0, 0), cA, voffA); PG8_STAGE(PG8_SB(0, 1), cB + hstepB, voffB); PG8_STAGE(PG8_SA(0, 1), cA + hstepA, voffA);
    if (wr == 1) PG8_BAR;
    PG8_WAIT_V(4); PG8_BAR;
    PG8_STAGE(PG8_SB(1, 0), cB + kstep, voffB); PG8_STAGE(PG8_SA(1, 0), cA + kstep, voffA); PG8_STAGE(PG8_SB(1, 1), cB + hstepB + kstep, voffB);
    PG8_WAIT_V(6); PG8_BAR;
    for (;;) {
        const bool has_next = S.next(ui + 1, nxt);
        const char* nA = has_next ? (const char*)g.A + nxt.aoff : cA; const char* nB = has_next ? (const char*)g.Bt + nxt.boff : cB;
_Pragma("unroll 1")
        for (int t = 0; t < nt; t += 2) {
            const bool last = (t == nt - 2);
            const char* a1 = cA + (size_t)(t + 1) * kstep;
            const char* a2 = last ? nA : cA + (size_t)(t + 2) * kstep; const char* b2 = last ? nB : cB + (size_t)(t + 2) * kstep;
            const char* a3 = a2 + kstep; const char* b3 = b2 + kstep;
            PG8_LDB(B0, 0, 0); PG8_SCHED; PG8_LDA(At, 0, 0); PG8_STAGE(PG8_SA(1, 1), a1 + hstepA, voffA);
            PG8_WAIT_L(8); PG8_BAR; PG8_WAIT_L(0); PG8_MMA(0, 0, At, B0); PG8_BAR; PG8_SCHED;
            PG8_LDB(B1, 0, 1); PG8_STAGE(PG8_SB(0, 0), b2, voffB);
            PG8_BAR; PG8_WAIT_L(0); PG8_MMA(0, 1, At, B1); PG8_BAR;
            PG8_LDA(At, 0, 1); PG8_STAGE(PG8_SA(0, 0), a2, voffA);
            PG8_BAR; PG8_WAIT_L(0); PG8_MMA(1, 0, At, B0); PG8_BAR; PG8_SCHED;
            PG8_STAGE(PG8_SB(0, 1), b2 + hstepB, voffB);
            PG8_WAIT_V(6); PG8_BAR; PG8_MMA(1, 1, At, B1); PG8_BAR;
            PG8_LDB(B0, 1, 0); PG8_SCHED; PG8_LDA(At, 1, 0); PG8_STAGE(PG8_SA(0, 1), a2 + hstepA, voffA);
            PG8_WAIT_L(8); PG8_BAR; PG8_WAIT_L(0); PG8_MMA(0, 0, At, B0); PG8_BAR; PG8_SCHED;
            PG8_LDB(B1, 1, 1); PG8_STAGE(PG8_SB(1, 0), b3, voffB);
            PG8_BAR; PG8_WAIT_L(0); PG8_MMA(0, 1, At, B1); PG8_BAR;
            PG8_LDA(At, 1, 1); PG8_STAGE(PG8_SA(1, 0), a3, voffA);
            PG8_BAR; PG8_WAIT_L(0); PG8_MMA(1, 0, At, B0); PG8_BAR; PG8_SCHED;
            PG8_STAGE(PG8_SB(1, 1), b3 + hstepB, voffB);
            PG8_WAIT_V(6); PG8_BAR; PG8_MMA(1, 1, At, B1); PG8_BAR;
        }
        run_epi(E, acc, cur, wr, wc, fr, fq);
        if (!has_next) break;
#pragma unroll
        for (int a = 0; a < 2; ++a)
#pragma unroll
            for (int b = 0; b < 2; ++b)
#pragma unroll
                for (int m = 0; m < 4; ++m)
#pragma unroll
                    for (int n = 0; n < 2; ++n) acc[a][b][m][n] = (f32x4){0.f, 0.f, 0.f, 0.f};
        cur = nxt; cA = nA; cB = nB; ++ui;
    }
    PG8_WAIT_V(0);
    if (wr == 0) PG8_BAR;
    PG8_BAR;
#undef PG8_SA
#undef PG8_SB
#undef PG8_STAGE
#undef PG8_LDA
#undef PG8_LDB
#undef PG8_MMA
#undef PG8_WAIT_V
#undef PG8_WAIT_L
#undef PG8_BAR
#undef PG8_SCHED
}
struct DenseOrder {
    int nM, nN, G, c; long astep, bstep;
    __device__ __forceinline__ bool next(int i, Unit& u) const {
        const long L = (long)i * G + c; if (L >= (long)nM * nN) return false;
        const int w = (int)L; const int nig = 8 * nN, gid = w / nig, fm = gid * 8, gsz = (nM - fm) < 8 ? (nM - fm) : 8;
        u.pm = fm + ((w % nig) % gsz); u.pn = (w % nig) / gsz; u.aoff = (long)u.pm * astep; u.boff = (long)u.pn * bstep; return true; }
};
struct MoeOrder {
    const PG8_LAS int* tbl; int nM, nN, G, c; long astep, bstep, estep;
    __device__ __forceinline__ bool next(int i, Unit& u) const {
        const long L = (long)i * G + c; if (L >= (long)nM * nN) return false;
        const int w = (int)L; u.pm = w / nN; u.pn = w % nN; const int e = tbl[u.pm];
        u.aoff = (long)u.pm * astep; u.boff = (long)e * estep + (long)u.pn * bstep; return true; }
};
}
#endif

#ifndef CPU_TEST
namespace att {
typedef short bf16x8 __attribute__((ext_vector_type(8)));
typedef short s16x4 __attribute__((ext_vector_type(4)));
typedef float f32x16 __attribute__((ext_vector_type(16)));
typedef float f32x2_t __attribute__((ext_vector_type(2))); typedef __bf16 bf16x2_t __attribute__((ext_vector_type(2)));
typedef unsigned u32x4 __attribute__((ext_vector_type(4)));
typedef unsigned u32x2 __attribute__((ext_vector_type(2)));
#define ATT_LAS __attribute__((address_space(3)))
constexpr int KP = 104, VP = 68;
constexpr int KBUF = 64 * KP * 2, VBUF = 64 * VP * 2;
constexpr int LDS_NEED = 2 * KBUF + 2 * VBUF;
__device__ __forceinline__ unsigned cvtpk(float lo, float hi) { f32x2_t v = {lo, hi}; bf16x2_t b = __builtin_convertvector(v, bf16x2_t); return __builtin_bit_cast(unsigned, b); }
__device__ __forceinline__ int crow(int r, int hi) { return (r & 3) + 8 * (r >> 2) + 4 * hi; }
__device__ __forceinline__ u32x4 scale8(const u32x4& w, float s) { u32x4 o;
#pragma unroll
    for (int j = 0; j < 4; ++j) o[j] = cvtpk(__builtin_bit_cast(float, w[j] << 16) * s, __builtin_bit_cast(float, w[j] & 0xffff0000u) * s);
    return o; }
__device__ __forceinline__ void unit(ATT_LAS unsigned char* lds, const bf16_t* Q, const bf16_t* K, const bf16_t* V, const float* rstd, bf16_t* mix, int b, int h, int qb) {
    int tid = threadIdx.x; asm volatile("" : "+v"(tid));
    const int lane = tid & 63, w = __builtin_amdgcn_readfirstlane(tid >> 6), r32 = lane & 31, hi = lane >> 5;
    const size_t tb = (size_t)b * SEQ;
    const int q = qb * 256 + w * 32 + r32;
    bf16x8 qr[6];
    { const bf16_t* qrow = Q + (tb + q) * 384 + h * 96 + 8 * hi;
      const float rq = rstd[(tb + q) * 2];
#pragma unroll
      for (int ks = 0; ks < 6; ++ks) qr[ks] = __builtin_bit_cast(bf16x8, scale8(*(const u32x4*)(qrow + 16 * ks), rq)); }
    f32x16 o0, o1;
#pragma unroll
    for (int r = 0; r < 16; ++r) { o0[r] = 0.f; o1[r] = 0.f; }
    float m = -1e30f, lsum = 0.f;
    const int NT = 4 * (qb + 1);
    const int kr0 = tid / 12, kp0 = tid % 12, kr1 = (tid + 512) / 12, kp1 = (tid + 512) % 12; const bool has1 = tid < 256;
    const int vk = tid >> 3, vp = tid & 7;
    const bf16_t* gK0 = K + (tb + kr0) * 384 + h * 96 + kp0 * 8; const bf16_t* gK1 = K + (tb + kr1) * 384 + h * 96 + kp1 * 8;
    const bf16_t* gV = V + (tb + vk) * 256 + h * 64 + vp * 8;
    u32x4 sk0, sk1, sv; sk1 = (u32x4){0u, 0u, 0u, 0u};
    const float* gR0 = rstd + (tb + kr0) * 2 + 1; const float* gR1 = rstd + (tb + kr1) * 2 + 1; const float* gRv = rstd + (tb + vk) * 2 + 1;
    float s0 = gR0[0], s1 = has1 ? gR1[0] : 0.f, s2 = gRv[0];
    sk0 = *(const u32x4*)gK0; if (has1) sk1 = *(const u32x4*)gK1; sv = *(const u32x4*)gV;
#define ATT_WRITE(buf) do { \
        if (kp0 < 8) sk0 = scale8(sk0, s0); if (kp1 < 8) sk1 = scale8(sk1, s1); sv = scale8(sv, s2); \
        *(ATT_LAS u32x4*)(lds + (buf) * KBUF + (kr0 * KP + kp0 * 8) * 2) = sk0; \
        if (has1) *(ATT_LAS u32x4*)(lds + (buf) * KBUF + (kr1 * KP + kp1 * 8) * 2) = sk1; \
        ATT_LAS unsigned short* vt_ = (ATT_LAS unsigned short*)(lds + 2 * KBUF + (buf) * VBUF); \
        _Pragma("unroll") for (int j = 0; j < 4; ++j) { vt_[(8 * vp + 2 * j) * VP + vk] = (unsigned short)(sv[j] & 0xffffu); vt_[(8 * vp + 2 * j + 1) * VP + vk] = (unsigned short)(sv[j] >> 16); } } while (0)
    ATT_WRITE(0);
    __syncthreads();
    for (int t = 0; t < NT; ++t) {
        const int buf = t & 1;
        if (t + 1 < NT) { const size_t adv = (size_t)(t + 1) * 64; sk0 = *(const u32x4*)(gK0 + adv * 384); if (has1) sk1 = *(const u32x4*)(gK1 + adv * 384); sv = *(const u32x4*)(gV + adv * 256);
            s0 = gR0[adv * 2]; if (has1) s1 = gR1[adv * 2]; s2 = gRv[adv * 2]; }
        f32x16 p0, p1;
#pragma unroll
        for (int r = 0; r < 16; ++r) { p0[r] = 0.f; p1[r] = 0.f; }
        { ATT_LAS const unsigned char* kb = lds + buf * KBUF + (r32 * KP + 8 * hi) * 2;
#pragma unroll
          for (int ks = 0; ks < 6; ++ks) { const bf16x8 a0 = *(ATT_LAS const bf16x8*)(kb + ks * 32), a1 = *(ATT_LAS const bf16x8*)(kb + 32 * KP * 2 + ks * 32);
              p0 = __builtin_amdgcn_mfma_f32_32x32x16_bf16(a0, qr[ks], p0, 0, 0, 0); p1 = __builtin_amdgcn_mfma_f32_32x32x16_bf16(a1, qr[ks], p1, 0, 0, 0); } }
        if (t >= NT - 4) {
            const int k0 = t * 64;
#pragma unroll
            for (int r = 0; r < 16; ++r) { const int kk = k0 + crow(r, hi); if (kk > q) p0[r] = -1e30f; if (kk + 32 > q) p1[r] = -1e30f; } }
        float rm = p0[0];
#pragma unroll
        for (int r = 1; r < 16; ++r) rm = fmaxf(rm, p0[r]);
#pragma unroll
        for (int r = 0; r < 16; ++r) rm = fmaxf(rm, p1[r]);
        rm = fmaxf(rm, __shfl_xor(rm, 32));
        const float mn = fmaxf(m, rm); const float alpha = __builtin_amdgcn_exp2f(m - mn); m = mn;
        float ps = 0.f;
#pragma unroll
        for (int r = 0; r < 16; ++r) { p0[r] = __builtin_amdgcn_exp2f(p0[r] - mn); p1[r] = __builtin_amdgcn_exp2f(p1[r] - mn); ps += p0[r] + p1[r]; }
        lsum = lsum * alpha + ps;
#pragma unroll
        for (int r = 0; r < 16; ++r) { o0[r] *= alpha; o1[r] *= alpha; }
        { ATT_LAS const unsigned char* vb = lds + 2 * KBUF + buf * VBUF + (r32 * VP + 4 * hi) * 2;
#pragma unroll
          for (int s = 0; s < 4; ++s) {
              u32x4 pw;
              if (s == 0) pw = (u32x4){cvtpk(p0[0], p0[1]), cvtpk(p0[2], p0[3]), cvtpk(p0[4], p0[5]), cvtpk(p0[6], p0[7])};
              else if (s == 1) pw = (u32x4){cvtpk(p0[8], p0[9]), cvtpk(p0[10], p0[11]), cvtpk(p0[12], p0[13]), cvtpk(p0[14], p0[15])};
              else if (s == 2) pw = (u32x4){cvtpk(p1[0], p1[1]), cvtpk(p1[2], p1[3]), cvtpk(p1[4], p1[5]), cvtpk(p1[6], p1[7])};
              else pw = (u32x4){cvtpk(p1[8], p1[9]), cvtpk(p1[10], p1[11]), cvtpk(p1[12], p1[13]), cvtpk(p1[14], p1[15])};
              const bf16x8 pb = __builtin_bit_cast(bf16x8, pw);
              const u32x2 a00 = *(ATT_LAS const u32x2*)(vb + s * 32), a01 = *(ATT_LAS const u32x2*)(vb + s * 32 + 16);
              const u32x2 a10 = *(ATT_LAS const u32x2*)(vb + 32 * VP * 2 + s * 32), a11 = *(ATT_LAS const u32x2*)(vb + 32 * VP * 2 + s * 32 + 16);
              const bf16x8 va0 = __builtin_bit_cast(bf16x8, (u32x4){a00[0], a00[1], a01[0], a01[1]}), va1 = __builtin_bit_cast(bf16x8, (u32x4){a10[0], a10[1], a11[0], a11[1]});
              o0 = __builtin_amdgcn_mfma_f32_32x32x16_bf16(va0, pb, o0, 0, 0, 0); o1 = __builtin_amdgcn_mfma_f32_32x32x16_bf16(va1, pb, o1, 0, 0, 0); } }
        if (t + 1 < NT) ATT_WRITE(buf ^ 1);
        __syncthreads();
    }
#undef ATT_WRITE
    lsum += __shfl_xor(lsum, 32);
    const float inv = 1.f / lsum;
    bf16_t* orow = mix + (tb + q) * DMIX + 768 + h * 64;
#pragma unroll
    for (int rg = 0; rg < 4; ++rg) {
        u32x2 w0 = {cvtpk(o0[4 * rg] * inv, o0[4 * rg + 1] * inv), cvtpk(o0[4 * rg + 2] * inv, o0[4 * rg + 3] * inv)};
        u32x2 w1 = {cvtpk(o1[4 * rg] * inv, o1[4 * rg + 1] * inv), cvtpk(o1[4 * rg + 2] * inv, o1[4 * rg + 3] * inv)};
        *(u32x2*)(orow + 8 * rg + 4 * hi) = w0; *(u32x2*)(orow + 32 + 8 * rg + 4 * hi) = w1; }
}
}
#endif

#ifndef CPU_TEST
namespace lin {
using att::bf16x8; using att::f32x16; using att::u32x4; using att::u32x2; using att::cvtpk; using att::crow;
constexpr int PT = 68;
template <int DK, int NDV> struct Lay {
    static constexpr int PQ = DK + 8;
    static constexpr int OFF_Q = 0, OFF_K = OFF_Q + 64 * PQ * 2, OFF_KH = OFF_K + 64 * PQ * 2, OFF_VT = OFF_KH + DK * PT * 2, OFF_DEC = OFF_VT + NDV * PT * 2, BUF = OFF_DEC + 256;
};
__device__ __forceinline__ bf16x8 ldA16(ATT_LAS const unsigned char* p) { return *(ATT_LAS const bf16x8*)p; }
__device__ __forceinline__ bf16x8 ldP8(ATT_LAS const unsigned char* p) { const u32x2 a = *(ATT_LAS const u32x2*)p, b = *(ATT_LAS const u32x2*)(p + 16); return __builtin_bit_cast(bf16x8, (u32x4){a[0], a[1], b[0], b[1]}); }
__device__ __forceinline__ bf16x8 pack8(const f32x16& x, int s) {
    u32x4 p;
    if (s == 0) p = (u32x4){cvtpk(x[0], x[1]), cvtpk(x[2], x[3]), cvtpk(x[4], x[5]), cvtpk(x[6], x[7])};
    else p = (u32x4){cvtpk(x[8], x[9]), cvtpk(x[10], x[11]), cvtpk(x[12], x[13]), cvtpk(x[14], x[15])};
    return __builtin_bit_cast(bf16x8, p); }
#define MF32(a, b, c) __builtin_amdgcn_mfma_f32_32x32x16_bf16((a), (b), (c), 0, 0, 0)
template <int DK, int NDV> __device__ __forceinline__ void compute(ATT_LAS const unsigned char* B, int ib, int dvb, int r32, int hi, f32x16 (&H)[DK / 32], f32x16& O) {
    typedef Lay<DK, NDV> L;
    f32x16 X[2];
#pragma unroll
    for (int r = 0; r < 16; ++r) { X[0][r] = 0.f; X[1][r] = 0.f; O[r] = 0.f; }
#pragma unroll
    for (int jb = 0; jb < 2; ++jb) if (jb <= ib) {
#pragma unroll
        for (int s = 0; s < DK / 16; ++s)
            X[jb] = MF32(ldA16(B + L::OFF_K + ((32 * jb + r32) * L::PQ + 16 * s + 8 * hi) * 2), ldA16(B + L::OFF_Q + ((32 * ib + r32) * L::PQ + 16 * s + 8 * hi) * 2), X[jb]);
        if (jb == ib) {
#pragma unroll
            for (int r = 0; r < 16; ++r) if (crow(r, hi) > r32) X[jb][r] = 0.f; } }
    bf16x8 vf[2][2];
#pragma unroll
    for (int jb = 0; jb < 2; ++jb)
#pragma unroll
        for (int s = 0; s < 2; ++s) vf[jb][s] = ldP8(B + L::OFF_VT + ((32 * dvb + r32) * PT + 32 * jb + 16 * s + 4 * hi) * 2);
#pragma unroll
    for (int jb = 0; jb < 2; ++jb) if (jb <= ib) {
#pragma unroll
        for (int s = 0; s < 2; ++s) O = MF32(pack8(X[jb], s), vf[jb][s], O); }
#pragma unroll
    for (int db = 0; db < DK / 32; ++db)
#pragma unroll
        for (int s = 0; s < 2; ++s) O = MF32(ldP8(B + L::OFF_Q + ((32 * ib + r32) * L::PQ + 32 * db + 16 * s + 4 * hi) * 2), pack8(H[db], s), O);
#pragma unroll
    for (int db = 0; db < DK / 32; ++db) {
        ATT_LAS const float* dec = (ATT_LAS const float*)(B + L::OFF_DEC);
#pragma unroll
        for (int r = 0; r < 16; ++r) H[db][r] *= dec[32 * db + crow(r, hi)];
#pragma unroll
        for (int jb = 0; jb < 2; ++jb)
#pragma unroll
            for (int s = 0; s < 2; ++s) H[db] = MF32(ldP8(B + L::OFF_KH + ((32 * db + r32) * PT + 32 * jb + 16 * s + 4 * hi) * 2), vf[jb][s], H[db]); }
}
__device__ __forceinline__ float scan64(float v, int lane) {
#pragma unroll
    for (int o = 1; o < 64; o <<= 1) { const float t = __shfl_up(v, o); if (lane >= o) v += t; }
    return v; }
__device__ __forceinline__ float bfl(unsigned w) { return __builtin_bit_cast(float, w << 16); }
__device__ __forceinline__ float bfh(unsigned w) { return __builtin_bit_cast(float, w & 0xffff0000u); }
__device__ __forceinline__ void vt_write(ATT_LAS unsigned char* B, int off_vt, int tok, int part, const u32x4& sv) {
    ATT_LAS unsigned short* vt = (ATT_LAS unsigned short*)(B + off_vt);
#pragma unroll
    for (int j = 0; j < 4; ++j) { vt[(8 * part + 2 * j) * PT + tok] = (unsigned short)(sv[j] & 0xffffu); vt[(8 * part + 2 * j + 1) * PT + tok] = (unsigned short)(sv[j] >> 16); } }

__device__ __forceinline__ void gla_run(ATT_LAS unsigned char* lds, const Ctx& C, int l, int b, int h) {
    typedef Lay<32, 64> L;
    int tid = threadIdx.x; asm volatile("" : "+v"(tid));
    const int lane = tid & 63, w = __builtin_amdgcn_readfirstlane(tid >> 6), r32 = lane & 31, hi = lane >> 5;
    const bf16_t* u = WSP(bf16_t, WS_U); float* Y = WSP(float, WS_YB);
    const float* aup = INF(I_GLA_UP) + l * 16 * 128 + h * 32 + 4 * w; const float* ab = INF(I_GLA_B) + l * 128 + h * 32 + 4 * w;
    const size_t tb = (size_t)b * SEQ;
    f32x16 H[1], O;
#pragma unroll
    for (int r = 0; r < 16; ++r) H[0][r] = 0.f;
    const int ib = w >> 1, dvb = w & 1;
    const int vtok = tid >> 3, vpart = tid & 7;
    u32x4 pa0, pa1, pv; u32x2 pq, pk;
#define GLA_FETCH(c) do { const size_t t_ = tb + (size_t)(c) * 64 + lane; const bf16_t* ur = u + t_ * DINP; \
        pa0 = *(const u32x4*)(ur + UB_AD); pa1 = *(const u32x4*)(ur + UB_AD + 8); pq = *(const u32x2*)(ur + UB_Q + h * 32 + 4 * w); pk = *(const u32x2*)(ur + UB_K + h * 32 + 4 * w); \
        pv = *(const u32x4*)(u + (tb + (size_t)(c) * 64 + vtok) * DINP + UB_V + h * 64 + vpart * 8); } while (0)
#define GLA_PREP(buf) do { ATT_LAS unsigned char* B_ = lds + (buf) * L::BUF; \
        float adv[16]; _Pragma("unroll") for (int j = 0; j < 4; ++j) { adv[2 * j] = bfl(pa0[j]); adv[2 * j + 1] = bfh(pa0[j]); adv[8 + 2 * j] = bfl(pa1[j]); adv[9 + 2 * j] = bfh(pa1[j]); } \
        const float qv[4] = {bfl(pq[0]), bfh(pq[0]), bfl(pq[1]), bfh(pq[1])}, kv[4] = {bfl(pk[0]), bfh(pk[0]), bfl(pk[1]), bfh(pk[1])}; \
        float qo[4], ko[4]; \
        _Pragma("unroll") for (int d = 0; d < 4; ++d) { float z = ab[d]; _Pragma("unroll") for (int j = 0; j < 16; ++j) z += adv[j] * aup[j * 128 + d]; \
            const float la = -softplusf_(-z) * (1.f / 16.f); const float bc = scan64(la, lane); const float be = __shfl(bc, 63); \
            qo[d] = qv[d] * __expf(bc) * 0.17677669529663687f; ko[d] = kv[d] * __expf(-bc); const float kh = kv[d] * __expf(be - bc); \
            ((ATT_LAS unsigned short*)(B_ + L::OFF_KH))[(4 * w + d) * PT + lane] = f2bf(kh); \
            if (lane == 63) ((ATT_LAS float*)(B_ + L::OFF_DEC))[4 * w + d] = __expf(be); } \
        *(ATT_LAS u32x2*)(B_ + L::OFF_Q + (lane * L::PQ + 4 * w) * 2) = (u32x2){cvtpk(qo[0], qo[1]), cvtpk(qo[2], qo[3])}; \
        *(ATT_LAS u32x2*)(B_ + L::OFF_K + (lane * L::PQ + 4 * w) * 2) = (u32x2){cvtpk(ko[0], ko[1]), cvtpk(ko[2], ko[3])}; \
        vt_write(B_, L::OFF_VT, vtok, vpart, pv); } while (0)
    constexpr int NC = SEQ / 64;
    GLA_FETCH(0); GLA_PREP(0); GLA_FETCH(1);
    __syncthreads();
    for (int c = 0; c < NC; ++c) {
        if (c + 1 < NC) { GLA_PREP((c + 1) & 1); if (c + 2 < NC) GLA_FETCH(c + 2); }
        if (w < 4) {
            compute<32, 64>(lds + (c & 1) * L::BUF, ib, dvb, r32, hi, H, O);
            float* yo = Y + (tb + (size_t)c * 64 + 32 * ib) * GW + h * 64 + 32 * dvb + r32;
#pragma unroll
            for (int r = 0; r < 16; ++r) yo[(size_t)crow(r, hi) * GW] = O[r]; }
        __syncthreads();
    }
#undef GLA_FETCH
#undef GLA_PREP
}
__device__ __forceinline__ void mlstm_run(ATT_LAS unsigned char* lds, const Ctx& C, int l, int b, int h) {
    typedef Lay<64, 96> L;
    int tid = threadIdx.x; asm volatile("" : "+v"(tid));
    const int lane = tid & 63, w = __builtin_amdgcn_readfirstlane(tid >> 6), r32 = lane & 31, hi = lane >> 5;
    const bf16_t* u = WSP(bf16_t, WS_U); float* Y = WSP(float, WS_YC); float* DEN = WSP(float, WS_DEN);
    const float* cw = INF(I_CONVW) + l * 4 * 512 + h * 64 + 8 * w; const float* cb = INF(I_CONVB) + l * 512 + h * 64 + 8 * w;
    const float ibias = INF(I_IB)[l * 4 + h], fbias = INF(I_FB)[l * 4 + h];
    const size_t tb = (size_t)b * SEQ;
    f32x16 H[2], O;
#pragma unroll
    for (int r = 0; r < 16; ++r) { H[0][r] = 0.f; H[1][r] = 0.f; }
    const int ib = w / 3, dvb = w % 3;
    const int vtok = tid >> 3, vpart = tid & 7;
    for (int i = tid; i < 32 * PT; i += 512) { const unsigned short v = (i < PT) ? (unsigned short)0x3f80 : (unsigned short)0;
        ((ATT_LAS unsigned short*)(lds + L::OFF_VT))[64 * PT + i] = v; ((ATT_LAS unsigned short*)(lds + L::BUF + L::OFF_VT))[64 * PT + i] = v; }
    u32x4 xq[4], xk[4], pg, pv;
#define ML_FETCH(c) do { const int s_ = (c) * 64 + lane; const bf16_t* ur = u + (tb + s_) * DINP; \
        _Pragma("unroll") for (int j = 0; j < 4; ++j) { const bool ok = s_ - 3 + j >= 0; const bf16_t* up = ur + (ptrdiff_t)(j - 3) * DINP; \
            xq[j] = ok ? *(const u32x4*)(up + UC_Q + h * 64 + 8 * w) : (u32x4){0u, 0u, 0u, 0u}; xk[j] = ok ? *(const u32x4*)(up + UC_K + h * 64 + 8 * w) : (u32x4){0u, 0u, 0u, 0u}; } \
        pg = *(const u32x4*)(ur + UC_IG); pv = *(const u32x4*)(u + (tb + (size_t)(c) * 64 + vtok) * DINP + UC_V + h * 64 + vpart * 8); } while (0)
#define ML_PREP(buf) do { ATT_LAS unsigned char* B_ = lds + (buf) * L::BUF; \
        const unsigned gi_ = pg[h >> 1], gf_ = pg[2 + (h >> 1)]; const float ig = ((h & 1) ? bfh(gi_) : bfl(gi_)) + ibias; const float lf = -softplusf_(-(((h & 1) ? bfh(gf_) : bfl(gf_)) + fbias)); \
        const float F = scan64(lf, lane); const float Fe = __shfl(F, 63); const float eF = __expf(F), wk = __expf(ig - F) * 0.125f, wkh = __expf(Fe - F + ig) * 0.125f; \
        float qo[8], ko[8]; \
        _Pragma("unroll") for (int ch = 0; ch < 8; ++ch) { float yq = cb[ch], yk = cb[256 + ch]; \
            _Pragma("unroll") for (int j = 0; j < 4; ++j) { const unsigned wq_ = xq[j][ch >> 1], wk_ = xk[j][ch >> 1]; \
                yq += cw[j * 512 + ch] * ((ch & 1) ? bfh(wq_) : bfl(wq_)); yk += cw[j * 512 + 256 + ch] * ((ch & 1) ? bfh(wk_) : bfl(wk_)); } \
            const float sq = siluf_(yq), sk = siluf_(yk); qo[ch] = sq * eF; ko[ch] = sk * wk; \
            ((ATT_LAS unsigned short*)(B_ + L::OFF_KH))[(8 * w + ch) * PT + lane] = f2bf(sk * wkh); } \
        *(ATT_LAS u32x4*)(B_ + L::OFF_Q + (lane * L::PQ + 8 * w) * 2) = (u32x4){cvtpk(qo[0], qo[1]), cvtpk(qo[2], qo[3]), cvtpk(qo[4], qo[5]), cvtpk(qo[6], qo[7])}; \
        *(ATT_LAS u32x4*)(B_ + L::OFF_K + (lane * L::PQ + 8 * w) * 2) = (u32x4){cvtpk(ko[0], ko[1]), cvtpk(ko[2], ko[3]), cvtpk(ko[4], ko[5]), cvtpk(ko[6], ko[7])}; \
        if (w == 0) ((ATT_LAS float*)(B_ + L::OFF_DEC))[lane] = __expf(Fe); \
        vt_write(B_, L::OFF_VT, vtok, vpart, pv); } while (0)
    constexpr int NC = SEQ / 64;
    ML_FETCH(0); ML_PREP(0); ML_FETCH(1);
    __syncthreads();
    for (int c = 0; c < NC; ++c) {
        if (c + 1 < NC) { ML_PREP((c + 1) & 1); if (c + 2 < NC) ML_FETCH(c + 2); }
        if (w < 6) {
            compute<64, 96>(lds + (c & 1) * L::BUF, ib, dvb, r32, hi, H, O);
            const size_t t0 = tb + (size_t)c * 64 + 32 * ib;
            if (dvb < 2) { float* yo = Y + t0 * GW + h * 64 + 32 * dvb + r32;
#pragma unroll
                for (int r = 0; r < 16; ++r) yo[(size_t)crow(r, hi) * GW] = O[r]; }
            else if (r32 == 0) {
#pragma unroll
                for (int r = 0; r < 16; ++r) DEN[(t0 + crow(r, hi)) * 4 + h] = O[r]; } }
        __syncthreads();
    }
#undef ML_FETCH
#undef ML_PREP
}
#undef MF32
}
#endif

#ifndef CPU_TEST
namespace rwk {
constexpr int NB = 16;
constexpr int VEC = 6 * 64;
constexpr int BUFB = NB * VEC * 4;
__device__ __forceinline__ float dpp_add(float v, int ctrl_sel) {
    int x = __builtin_bit_cast(int, v), y;
    if (ctrl_sel == 0) y = __builtin_amdgcn_update_dpp(0, x, 0xB1, 0xF, 0xF, true);
    else if (ctrl_sel == 1) y = __builtin_amdgcn_update_dpp(0, x, 0x4E, 0xF, 0xF, true);
    else if (ctrl_sel == 2) y = __builtin_amdgcn_update_dpp(0, x, 0x141, 0xF, 0xF, true);
    else y = __builtin_amdgcn_update_dpp(0, x, 0x140, 0xF, 0xF, true);
    return v + __builtin_bit_cast(float, y); }
__device__ __forceinline__ float red16(float v) { v = dpp_add(v, 0); v = dpp_add(v, 1); v = dpp_add(v, 2); v = dpp_add(v, 3); return v; }
__device__ __forceinline__ void run(ATT_LAS unsigned char* lds, const Ctx& C, int b, int h, int rg) {
    int tid = threadIdx.x; asm volatile("" : "+v"(tid));
    const int lane = tid & 63, w = __builtin_amdgcn_readfirstlane(tid >> 6);
    const float* src[6] = {WSP(float, WS_RW_A), WSP(float, WS_RW_W), WSP(float, WS_RW_B), WSP(float, WS_RW_K), WSP(float, WS_RW_R), WSP(float, WS_RW_V)};
    float* Y = WSP(float, WS_YA);
    const size_t tb = (size_t)b * SEQ;
    const int lt = tid - 256;
#define RW_LOAD(batch, buf) do { _Pragma("unroll") for (int i = 0; i < 6; ++i) { const int p = lt + 256 * i; const int st = p / 96, vc = (p % 96) >> 4, pt = p & 15; \
        const float* sp = (vc == 0 ? src[0] : vc == 1 ? src[1] : vc == 2 ? src[2] : vc == 3 ? src[3] : vc == 4 ? src[4] : src[5]); \
        const f4v v4 = *(const f4v*)(sp + (tb + (size_t)(batch) * NB + st) * GW + h * 64 + pt * 4); \
        *(ATT_LAS f4v*)(lds + (buf) * BUFB + (st * VEC + vc * 64 + pt * 4) * 4) = v4; } } while (0)
    constexpr int NBATCH = SEQ / NB;
    if (w >= 4) RW_LOAD(0, 0);
    __syncthreads();
    const int row = 16 * rg + 4 * w + (lane >> 4), cg = lane & 15;
    float S0 = 0.f, S1 = 0.f, S2 = 0.f, S3 = 0.f;
    for (int bt = 0; bt < NBATCH; ++bt) {
        if (w >= 4) { if (bt + 1 < NBATCH) RW_LOAD(bt + 1, (bt + 1) & 1); }
        else {
            ATT_LAS const float* B = (ATT_LAS const float*)(lds + (bt & 1) * BUFB);
#pragma unroll 4
            for (int st = 0; st < NB; ++st) {
                ATT_LAS const float* P = B + st * VEC;
                const f4v a = *(ATT_LAS const f4v*)(P + 4 * cg), wv = *(ATT_LAS const f4v*)(P + 64 + 4 * cg), bb = *(ATT_LAS const f4v*)(P + 128 + 4 * cg),
                          kk = *(ATT_LAS const f4v*)(P + 192 + 4 * cg), r = *(ATT_LAS const f4v*)(P + 256 + 4 * cg);
                const float vv = P[320 + row];
                const float sa = red16((S0 * a[0] + S1 * a[1]) + (S2 * a[2] + S3 * a[3]));
                S0 = S0 * wv[0] + (sa * bb[0] + vv * kk[0]); S1 = S1 * wv[1] + (sa * bb[1] + vv * kk[1]);
                S2 = S2 * wv[2] + (sa * bb[2] + vv * kk[2]); S3 = S3 * wv[3] + (sa * bb[3] + vv * kk[3]);
                const float y = red16((S0 * r[0] + S1 * r[1]) + (S2 * r[2] + S3 * r[3]));
                if (cg == 0) Y[(tb + (size_t)bt * NB + st) * GW + h * 64 + row] = y;
            }
        }
        __syncthreads();
    }
#undef RW_LOAD
}
}
#endif

constexpr int PH_PER_LAYER = 12;
constexpr int NPHASES = DEPTH * PH_PER_LAYER;

#ifndef CPU_TEST
#define XB_TMO      128
#define XB_XCNT(j)  (256  + 64 * (j))
#define XB_XSUB(j)  (1280 + 64 * (j))
#define XB_XGEN(j)  (2304 + 64 * (j))
#define XB_TOP      3328
#define XB_TOPGEN   3392
#define XCD_BAR_WORDS 3456
#define XB_SPIN_CAP (1u << 18)
#define LAS __attribute__((address_space(3)))
__device__ __forceinline__ unsigned xb_ld(unsigned* p)              { return __hip_atomic_load(p, __ATOMIC_RELAXED, __HIP_MEMORY_SCOPE_AGENT); }
__device__ __forceinline__ unsigned xb_add(unsigned* p, unsigned v) { return __hip_atomic_fetch_add(p, v, __ATOMIC_RELAXED, __HIP_MEMORY_SCOPE_AGENT); }
__device__ __forceinline__ unsigned xb_xcc_id() { return (unsigned)__builtin_amdgcn_s_getreg((3 << 11) | 20) & 0xFu; }
#define XB_SPIN(cond, bar) do { unsigned _sp = 0; while (cond) { __builtin_amdgcn_s_sleep(1); \
    if ((++_sp & 255u) == 0u) { if (xb_ld(&(bar)[XB_TMO])) break; if (_sp > XB_SPIN_CAP) { atomicAdd(&(bar)[XB_TMO], 1u); break; } } } } while (0)
struct XcdBarrier { unsigned* bar; unsigned x; volatile LAS unsigned* st; };
__device__ __forceinline__ XcdBarrier xcd_barrier_post(unsigned* bar, volatile LAS unsigned* st) {
    XcdBarrier b; b.bar = bar; b.x = xb_xcc_id(); b.st = st;
    if (threadIdx.x == 0) (void)xb_add(&bar[XB_XCNT(b.x)], 1u);
    return b;
}
__device__ __forceinline__ void xcd_barrier_complete(unsigned* bar, unsigned x, unsigned& nloc, unsigned& nx) {
    const unsigned G = gridDim.x * gridDim.y * gridDim.z;
    unsigned sum, cnt, mine, sp = 0u;
    for (;;) {
        sum = 0u; cnt = 0u; mine = 0u;
#pragma unroll
        for (unsigned j = 0; j < 16; ++j) { const unsigned c = xb_ld(&bar[XB_XCNT(j)]); sum += c; cnt += (c > 0u) ? 1u : 0u; mine = (j == x) ? c : mine; }
        if (sum == G) break;
        __builtin_amdgcn_s_sleep(1);
        if ((++sp & 255u) == 0u) { if (xb_ld(&bar[XB_TMO])) break; if (sp > XB_SPIN_CAP) { atomicAdd(&bar[XB_TMO], 1u); break; } }
    }
    nloc = mine > 0u ? mine : 1u; nx = cnt > 0u ? cnt : 1u;
}
__device__ __forceinline__ void xcd_barrier(const XcdBarrier& b) {
    asm volatile("s_waitcnt vmcnt(0)" ::: "memory");
    __syncthreads();
    if (threadIdx.x == 0) {
        unsigned* bar = b.bar;
        __builtin_amdgcn_s_waitcnt(0);
        unsigned nloc = b.st[0], nx = b.st[1];
        if (nloc == 0u) { xcd_barrier_complete(bar, b.x, nloc, nx); b.st[0] = nloc; b.st[1] = nx; }
        const unsigned old = xb_add(&bar[XB_XSUB(b.x)], 1u);
        const unsigned gen = old / nloc;
        if (old + 1u == (gen + 1u) * nloc) {
            __builtin_amdgcn_fence(__ATOMIC_RELEASE, "agent");
            asm volatile("s_waitcnt vmcnt(0)" ::: "memory");
            const unsigned og = xb_add(&bar[XB_TOP], 1u);
            const unsigned tg = og / nx;
            if (og + 1u == (tg + 1u) * nx) xb_add(&bar[XB_TOPGEN], 1u);
            else XB_SPIN(xb_ld(&bar[XB_TOPGEN]) == tg, bar);
            __builtin_amdgcn_fence(__ATOMIC_ACQUIRE, "agent");
            xb_add(&bar[XB_XGEN(b.x)], 1u);
            asm volatile("s_waitcnt vmcnt(0)" ::: "memory");
        } else {
            XB_SPIN(xb_ld(&bar[XB_XGEN(b.x)]) == gen, bar);
            __builtin_amdgcn_fence(__ATOMIC_ACQUIRE, "agent");
            asm volatile("s_waitcnt vmcnt(0)" ::: "memory");
        }
    }
    __syncthreads();
}

constexpr int NWAVES = 8;
constexpr int RING_BYTES = 131072, MISC_OFF = RING_BYTES + 320, LDS_BYTES = 147456;
struct Args { Ctx C; int ph_lo, ph_hi; };
__device__ __forceinline__ int moe_fill_table(const Ctx& C, int l, LAS int* tbl, int tid) {
    const unsigned* cnt = WSP(unsigned, WS_CTL) + CW_CNT + l * NEXP * 64;
    int e, be, ce; const int total = moe_lookup(cnt, tid * 256, e, be, ce);
    if (tid < 320) tbl[tid] = e;
    __syncthreads();
    return total >> 8;
}

__global__ void __launch_bounds__(NWAVES * 64, 2) mega(Args args) {
    extern __shared__ __attribute__((aligned(16))) unsigned char lds_raw[];
    LAS unsigned char* lds = (LAS unsigned char*)lds_raw;
    const Ctx& C = args.C;
    const int G = gridDim.x, bx = blockIdx.x;
    const int ngw = G * NWAVES;
    volatile LAS unsigned* MISC = (volatile LAS unsigned*)(lds + MISC_OFF);
    for (int i = threadIdx.x; i < (LDS_BYTES - RING_BYTES) / 4; i += NWAVES * 64) ((LAS unsigned*)(lds + RING_BYTES))[i] = 0u;
    __syncthreads();
    XcdBarrier bar = xcd_barrier_post(WSP(unsigned, WS_CTL) + CW_BAR, MISC + 8);
    LAS int* tbl = (LAS int*)(lds + RING_BYTES + 1024);
    const int lo = args.ph_lo, hi = args.ph_hi;

    for (int l = 0; l < DEPTH; ++l) {
        const int p0 = l * PH_PER_LAYER;
#ifndef PHASE_MASK
#define PHASE_MASK 0xFFF
#endif
#define IN(k) (((PHASE_MASK >> (k)) & 1) && lo <= p0 + (k) && p0 + (k) < hi)
#define LAUNDER() int tid = threadIdx.x; asm volatile("" : "+v"(tid)); const int lane = tid & 63; const int wave = __builtin_amdgcn_readfirstlane(tid >> 6); const int gw = bx * NWAVES + wave; (void)gw; (void)lane; \
        wsh_t wsh = (wsh_t)(lds + wave * 16384); (void)wsh
#define SEAM(k) do { if (p0 + (k) + 1 < hi) xcd_barrier(bar); } while (0)
        if (IN(0)) { LAUNDER(); stage_convert(C, l, gw, ngw, lane, wsh); SEAM(0); }
        if (IN(1)) { LAUNDER();
            pg8::Gemm g{WSP(bf16_t, WS_XB), WSP(bf16_t, WS_WIN), DM, DM, DM};
            pg8::DenseOrder S{T / 256, DINP / 256, G, bx, (long)256 * DM * 2, (long)256 * DM * 2};
            EpiU E{WSP(bf16_t, WS_U)};
            pg8::gemm_phase(lds, g, S, E); SEAM(1); }
        if (IN(2)) { LAUNDER();
            {   pg8::Gemm g{WSP(bf16_t, WS_U) + UD_CQ, WSP(bf16_t, WS_WUQ), DINP, 256, 256};
                pg8::DenseOrder S{T / 256, 2, G, bx, (long)256 * DINP * 2, (long)256 * 256 * 2};
                EpiQ E{WSP(float, WS_ROPE), WSP(bf16_t, WS_AQ)};
                pg8::gemm_phase(lds, g, S, E); }
            {   pg8::Gemm g{WSP(bf16_t, WS_U) + UD_CKV, WSP(bf16_t, WS_WUKV), DINP, 256, 256};
                pg8::DenseOrder S{T / 256, 2, G, bx, (long)256 * DINP * 2, (long)256 * 256 * 2};
                EpiKV E{WSP(bf16_t, WS_AK), WSP(bf16_t, WS_AV)};
                pg8::gemm_phase(lds, g, S, E); }
            __syncthreads();
            rwkv_prep_coop(C, l, lds);
            mla_token_pass(C, gw, ngw, lane);
            SEAM(2); }
        if (IN(3)) { LAUNDER();
            if (bx < 128) rwk::run(lds, C, bx >> 4, (bx >> 2) & 3, bx & 3);
            else if (bx < 160) lin::gla_run(lds, C, l, (bx - 128) >> 2, (bx - 128) & 3);
            else if (bx < 192) lin::mlstm_run(lds, C, l, (bx - 160) >> 2, (bx - 160) & 3);
            else {
                LAS int* slot = (LAS int*)(lds + RING_BYTES + 512);
                unsigned* ctr = WSP(unsigned, WS_CTL) + CW_ATT + l * 64;
                constexpr int NQB = SEQ / 256, NUNIT = BATCH * NH * NQB;
                for (;;) {
                    if (tid == 0) *slot = (int)atomicAdd(ctr, 1u);
                    __syncthreads();
                    const int uidx = *slot;
                    __syncthreads();
                    if (uidx >= NUNIT) break;
                    const int qb = NQB - 1 - uidx / (BATCH * NH), bh = uidx % (BATCH * NH);
                    att::unit(lds, WSP(bf16_t, WS_AQ), WSP(bf16_t, WS_AK), WSP(bf16_t, WS_AV), WSP(float, WS_RSTD), WSP(bf16_t, WS_MIX), bh >> 2, bh & 3, qb);
                }
            }
            SEAM(3); }
        if (IN(4)) { LAUNDER(); stage_post(C, l, gw, ngw, lane); SEAM(4); }
        if (IN(5)) { LAUNDER();
            pg8::Gemm g{WSP(bf16_t, WS_MIX), WSP(bf16_t, WS_WOUT), DMIX, DMIX, DMIX};
            pg8::DenseOrder S{T / 256, DM / 256, G, bx, (long)256 * DMIX * 2, (long)256 * DMIX * 2};
            EpiPre1 E{l == 0 ? INF(I_X) : WSP(float, WS_X), C.out};
            pg8::gemm_phase(lds, g, S, E); SEAM(5); }
        if (IN(6)) { LAUNDER(); ln1_router_coop(C, l, lds); SEAM(6); }
        if (IN(7)) { LAUNDER();
            stage_gather(C, l, gw, ngw, lane);
            pg8::Gemm g{WSP(bf16_t, WS_PB), WSP(bf16_t, WS_WP), DPLE, DPLE, DPLE};
            pg8::DenseOrder S{T / 256, DM / 256, G, bx, (long)256 * DPLE * 2, (long)256 * DPLE * 2};
            EpiPP E{WSP(bf16_t, WS_PP)};
            pg8::gemm_phase(lds, g, S, E); SEAM(7); }
        if (IN(8)) { LAUNDER();
            pg8::Gemm g{WSP(bf16_t, WS_XG), WSP(bf16_t, WS_WGU), DM, DM, DM};
            const int ntile = moe_fill_table(C, l, tbl, tid);
            pg8::MoeOrder S{tbl, ntile, 2 * DEXP / 256, G, bx, (long)256 * DM * 2, (long)256 * DM * 2, (long)2 * DEXP * DM * 2};
            EpiH E{WSP(bf16_t, WS_H)};
            pg8::gemm_phase(lds, g, S, E); SEAM(8); }
        if (IN(9)) { LAUNDER();
            pg8::Gemm g{WSP(bf16_t, WS_H), WSP(bf16_t, WS_WD), DEXP, DEXP, DEXP};
            const int ntile = moe_fill_table(C, l, tbl, tid);
            pg8::MoeOrder S{tbl, ntile, DM / 256, G, bx, (long)256 * DEXP * 2, (long)256 * DEXP * 2, (long)DM * DEXP * 2};
            EpiY E{WSP(int, WS_ROWINFO), WSP(float, WS_ROWGATE), WSP(bf16_t, WS_YBUF)};
            pg8::gemm_phase(lds, g, S, E); SEAM(9); }
        if (IN(10)) { LAUNDER();
            pg8::Gemm g{WSP(bf16_t, WS_XB), WSP(bf16_t, WS_WPG), DM, DM, DM};
            pg8::DenseOrder S{T / 256, DM / 256, G, bx, (long)256 * DM * 2, (long)256 * DM * 2};
            EpiPre2 E{C.out, WSP(bf16_t, WS_YBUF), WSP(bf16_t, WS_PP), INF(I_PLEBG) + l * DM, WSP(float, WS_X)};
            pg8::gemm_phase(lds, g, S, E); SEAM(10); }
        if (IN(11)) { LAUNDER(); stage_ln2(C, l, gw, ngw, lane); SEAM(11); }
#undef IN
#undef SEAM
    }
}

extern "C" void kernel_launch(void* const* d_in, const int* in_sizes, int n_in, void* d_out, int out_size, void* d_ws, size_t ws_size, hipStream_t stream) {
    static int grid = 0;
    if (grid == 0) {
        if (n_in != N_IN || out_size != T * DM || ws_size < WS_END) { fprintf(stderr, "kernel_launch: bad sizes n_in %d out %d ws %zu need %zu\n", n_in, out_size, ws_size, (size_t)WS_END); grid = -1; return; }
        int dev = 0, cus = 0, per_cu = 0;
        hipGetDevice(&dev); hipDeviceGetAttribute(&cus, hipDeviceAttributeMultiprocessorCount, dev);
        if (hipFuncSetAttribute((const void*)mega, hipFuncAttributeMaxDynamicSharedMemorySize, LDS_BYTES) != hipSuccess) { fprintf(stderr, "hipFuncSetAttribute failed\n"); grid = -1; return; }
        if (hipOccupancyMaxActiveBlocksPerMultiprocessor(&per_cu, (const void*)mega, NWAVES * 64, LDS_BYTES) != hipSuccess || per_cu < 1) { fprintf(stderr, "occupancy query: %d\n", per_cu); }
        (void)hipGetLastError();
        grid = cus;
    }
    if (grid < 0) return;
    hipMemsetAsync((char*)d_ws + WS_CTL, 0, CTL_BYTES, stream);
    Args a{};
    for (int i = 0; i < N_IN; ++i) a.C.in[i] = d_in[i];
    a.C.out = (float*)d_out; a.C.ws = (unsigned char*)d_ws;
#ifndef ONE_LAUNCH
    for (int ph = 0; ph < NPHASES; ++ph) { a.ph_lo = ph; a.ph_hi = ph + 1; hipLaunchKernelGGL(mega, dim3(grid), dim3(NWAVES * 64), LDS_BYTES, stream, a); }
#else
    a.ph_lo = 0; a.ph_hi = NPHASES; hipLaunchKernelGGL(mega, dim3(grid), dim3(NWAVES * 64), LDS_BYTES, stream, a);
#endif
}
#else
template <class E> static void cpu_gemm(const bf16_t* A, int lda, const bf16_t* Bt, int ldb, int K, int M, int N, const E& e, const int* base = nullptr, long estep = 0) {
    for (int row = 0; row < M; ++row) {
        const bf16_t* B = Bt;
        if (base) B = Bt + (size_t)moe_expert_of_row(base, row) * estep;
        if constexpr (E::MODE == 1) {
            for (int hc = 0; hc < N / 2; hc += 8) { float g[8], u[8];
                for (int j = 0; j < 8; ++j) { float ag = 0.f, au = 0.f; const bf16_t* bg = B + (size_t)rowmap(1, hc + j) * ldb; const bf16_t* bu = B + (size_t)rowmap(2, hc + j) * ldb;
                    for (int k = 0; k < K; ++k) { const float a = bf2f(A[(size_t)row * lda + k]); ag += a * bf2f(bg[k]); au += a * bf2f(bu[k]); } g[j] = ag; u[j] = au; }
                e.put8gu(row, hc, g, u); }
        } else if constexpr (E::PERM) {
            for (int c = 0; c < N; c += 8) { float a8[8];
                for (int j = 0; j < 8; ++j) { float acc = 0.f; for (int k = 0; k < K; ++k) acc += bf2f(A[(size_t)row * lda + k]) * bf2f(B[(size_t)(c + j) * ldb + k]); a8[j] = acc; }
                e.put8(row, c, a8); }
        } else {
            for (int c = 0; c < N; c += 4) { float a4[4];
                for (int j = 0; j < 4; ++j) { float acc = 0.f; for (int k = 0; k < K; ++k) acc += bf2f(A[(size_t)row * lda + k]) * bf2f(B[(size_t)(c + j) * ldb + k]); a4[j] = acc; }
                e.put4(row, c, a4); }
        }
    }
}
static void cpu_forward(const Ctx& C) {
    static float shbuf[4096];
    for (int l = 0; l < DEPTH; ++l) {
        stage_convert(C, l, 0, 1, 0, shbuf);
        { EpiU E{WSP(bf16_t, WS_U)}; cpu_gemm(WSP(bf16_t, WS_XB), DM, WSP(bf16_t, WS_WIN), DM, DM, T, DINP, E); }
        stage_prep(C, l, 0, 1, 0, shbuf);
        for (int b = 0; b < BATCH; ++b) for (int h = 0; h < NH; ++h) {
            for (int v = 0; v < 64; ++v) { rwkv_scan_thread(C, b, h, v); gla_scan_thread(C, b, h, v); }
            for (int e = 0; e < 65; ++e) mlstm_scan_thread(C, b, h, e);
            for (int q = 0; q < SEQ; ++q) attn_thread(C, b, h, q, q); }
        stage_post(C, l, 0, 1, 0);
        { EpiPre1 E{l == 0 ? INF(I_X) : WSP(float, WS_X), C.out}; cpu_gemm(WSP(bf16_t, WS_MIX), DMIX, WSP(bf16_t, WS_WOUT), DMIX, DMIX, T, DM, E); }
        stage_ln1_router(C, l, 0, 1, 0, shbuf);
        stage_gather(C, l, 0, 1, 0);
        { EpiPP E{WSP(bf16_t, WS_PP)}; cpu_gemm(WSP(bf16_t, WS_PB), DPLE, WSP(bf16_t, WS_WP), DPLE, DPLE, T, DM, E); }
        int base[NEXP + 1]; moe_bases(C, l, base);
        { EpiH E{WSP(bf16_t, WS_H)}; cpu_gemm(WSP(bf16_t, WS_XG), DM, WSP(bf16_t, WS_WGU), DM, DM, base[NEXP], 2 * DEXP, E, base, (long)2 * DEXP * DM); }
        { EpiY E{WSP(int, WS_ROWINFO), WSP(float, WS_ROWGATE), WSP(bf16_t, WS_YBUF)}; cpu_gemm(WSP(bf16_t, WS_H), DEXP, WSP(bf16_t, WS_WD), DEXP, DEXP, base[NEXP], DM, E, base, (long)DM * DEXP); }
        { EpiPre2 E{C.out, WSP(bf16_t, WS_YBUF), WSP(bf16_t, WS_PP), INF(I_PLEBG) + l * DM, WSP(float, WS_X)}; cpu_gemm(WSP(bf16_t, WS_XB), DM, WSP(bf16_t, WS_WPG), DM, DM, T, DM, E); }
        stage_ln2(C, l, 0, 1, 0);
    }
}
#endif
```

```cpp
#ifndef CPU_TEST
#include <hip/hip_runtime.h>
#include <cstdio>
#include <cstdint>
#define HD __device__ __forceinline__
#define HDM __device__ __forceinline__
#define LANES 64
#else
#include <cmath>
#include <cstdio>
#include <cstdint>
#include <cstring>
#include <algorithm>
#define HD static inline
#define HDM inline
#define LANES 1
#endif

#define ONE_LAUNCH 1
#ifndef CFG_SMALL
constexpr int BATCH = 8, SEQ = 4096, DM = 1024, DEPTH = 4, DPLE = 256, DEXP = 512;
#else
constexpr int BATCH = 2, SEQ = 256, DM = 128, DEPTH = 2, DPLE = 32, DEXP = 128;
#endif
constexpr int T = BATCH * SEQ;
constexpr int DMIX = 1024, GW = 256, HD64 = 64, NH = 4;
constexpr int DIN = 3128, DINP = 3328;
constexpr int UA = 0, UA_R = 0, UA_K = 256, UA_V = 512, UA_WD = 768, UA_AD = 800, UA_GD = 832, DINA = 896;
constexpr int UB = 896, UB_Q = 896, UB_K = 1024, UB_V = 1152, UB_AD = 1408, UB_G = 1424;
constexpr int UC = 1680, UC_Q = 1680, UC_K = 1936, UC_V = 2192, UC_O = 2448, UC_IG = 2704, UC_FG = 2708;
constexpr int UD = 2712, UD_CQ = 2712, UD_CKV = 2968, UD_KR = 3096;
constexpr int NEXP = 32, NGRP = 4, EPG = 8;
constexpr int MAXROWS = 2 * T + NEXP * 256;
constexpr float DN_ALPHA = 1.681792830507429f;
constexpr float LN_EPS = 1e-5f, NORM_EPS = 1e-6f, RWKV_GN_EPS = 64e-5f;
static_assert(DEPTH == 4 || DEPTH == 2, "alpha below assumes depth");
HD float dn_alpha() { return DEPTH == 4 ? 1.681792830507429f : 1.4142135623730951f; }

enum { I_X = 0, I_P, I_POS, I_WIN, I_MU, I_W0, I_WUP, I_A0, I_AUP, I_GUP, I_KK, I_KA, I_RK, I_GNG, I_GNB, I_GLA_UP, I_GLA_B, I_GLA_G,
       I_CONVW, I_CONVB, I_IB, I_FB, I_MLN_G, I_QNG, I_WUQ, I_KVNG, I_WUKV, I_WOUT, I_LN1G, I_LN1B, I_WRG, I_BRG, I_WRE, I_BRE,
       I_WG, I_WU, I_WD, I_PLEG, I_PLEBG, I_PLEW, I_LN2G, I_LN2B, N_IN };

typedef unsigned short bf16_t;
HD float bf2f(bf16_t h) { unsigned u = (unsigned)h << 16; return __builtin_bit_cast(float, u); }
HD bf16_t f2bf(float f) { unsigned u = __builtin_bit_cast(unsigned, f); return (bf16_t)((u + 0x7fffu + ((u >> 16) & 1u)) >> 16); }
HD unsigned pk2(float lo, float hi) { return (unsigned)f2bf(lo) | ((unsigned)f2bf(hi) << 16); }
typedef float f4v __attribute__((vector_size(16)));
typedef unsigned u4v __attribute__((vector_size(16)));
HD void ld8bf(const bf16_t* p, float* o) { const u4v w = *(const u4v*)p;
    for (int j = 0; j < 4; ++j) { o[2 * j] = __builtin_bit_cast(float, w[j] << 16); o[2 * j + 1] = __builtin_bit_cast(float, w[j] & 0xffff0000u); } }
HD void st8bf(bf16_t* p, const float* a) { u4v w; for (int j = 0; j < 4; ++j) w[j] = pk2(a[2 * j], a[2 * j + 1]); *(u4v*)p = w; }

constexpr size_t MiB = (size_t)1 << 20;
constexpr size_t al256(size_t x) { return (x + 255) & ~(size_t)255; }
constexpr size_t WS_CTL = 0, CTL_BYTES = 1 * MiB;
constexpr size_t WS_WIN = WS_CTL + CTL_BYTES;
constexpr size_t WS_WOUT = WS_WIN + al256((size_t)DINP * DM * 2);
constexpr size_t WS_WPG = WS_WOUT + al256((size_t)DM * DMIX * 2);
constexpr size_t WS_WP = WS_WPG + al256((size_t)DM * DM * 2);
constexpr size_t WS_WGU = WS_WP + al256((size_t)DM * DPLE * 2);
constexpr size_t WS_WD = WS_WGU + al256((size_t)NEXP * 2 * DEXP * DM * 2);
constexpr size_t WS_X = WS_WD + al256((size_t)NEXP * DM * DEXP * 2);
constexpr size_t WS_XB = WS_X + al256((size_t)T * DM * 4);
constexpr size_t WS_U = WS_XB + al256((size_t)T * DM * 2);
constexpr size_t WS_MIX = WS_U + al256((size_t)T * DINP * 2);
constexpr size_t WS_PB = WS_MIX + al256((size_t)T * DMIX * 2);
constexpr size_t WS_WUQ = WS_PB + al256((size_t)T * DPLE * 2);
constexpr size_t WS_WUKV = WS_WUQ + al256((size_t)512 * 256 * 2);
constexpr size_t WS_ROPE = WS_WUKV + al256((size_t)512 * 256 * 2);
constexpr size_t WS_RSTD = WS_ROPE + al256((size_t)T * 32 * 4);
constexpr size_t WS_SCR = WS_RSTD + al256((size_t)T * 2 * 4);
constexpr size_t TV = al256((size_t)T * GW * 4);
constexpr size_t WS_RW_R = WS_SCR, WS_RW_W = WS_RW_R + TV, WS_RW_K = WS_RW_W + TV, WS_RW_V = WS_RW_K + TV, WS_RW_A = WS_RW_V + TV,
                 WS_RW_B = WS_RW_A + TV, WS_RW_G = WS_RW_B + TV;
constexpr size_t WS_RW_PL = WS_RW_R, WS_RW_RY = WS_RW_R + (size_t)16 * MiB;
constexpr size_t WS_RW_QG = WS_RW_W, WS_RW_Y0 = WS_RW_K, WS_RW_GC = WS_RW_V;
static_assert(TV >= (size_t)32 * MiB || T < 32768, "chunk buffers alias the f32 field region");
constexpr size_t WS_YA = WS_RW_G + TV, WS_YB = WS_YA + TV, WS_YC = WS_YB + TV;
constexpr size_t WS_DEN = WS_YC + TV;
constexpr size_t WS_QK = WS_DEN + al256((size_t)T * 4 * 4);
constexpr size_t WS_GA = WS_QK + al256((size_t)T * 512 * 4);
constexpr size_t WS_LG = WS_GA + al256((size_t)T * 128 * 4);
constexpr size_t WS_AQ = WS_LG + al256((size_t)T * 8 * 4);
constexpr size_t WS_AK = WS_AQ + al256((size_t)T * 384 * 2);
constexpr size_t WS_AV = WS_AK + al256((size_t)T * 384 * 2);
constexpr size_t WS_RW_GG = WS_AV + al256((size_t)T * 256 * 2);
constexpr size_t WS_RW_VS = WS_RW_GG + al256((size_t)T * 256 * 2);
constexpr size_t WS_RW_BON = WS_RW_VS + al256((size_t)T * 256 * 2);
constexpr size_t WS_MIXER_END = WS_RW_BON + al256((size_t)T * 4 * 4);
constexpr size_t WS_XG = WS_SCR;
constexpr size_t WS_H = WS_XG + al256((size_t)MAXROWS * DM * 2);
constexpr size_t WS_YBUF = WS_H + al256((size_t)MAXROWS * DEXP * 2);
constexpr size_t WS_PP = WS_YBUF + al256((size_t)2 * T * DM * 2);
constexpr size_t WS_TOKINFO = WS_PP + al256((size_t)T * DM * 2);
constexpr size_t WS_LIST = WS_TOKINFO + al256((size_t)T * 16);
constexpr size_t WS_ROWINFO = WS_LIST + al256((size_t)NEXP * T * 4);
constexpr size_t WS_ROWGATE = WS_ROWINFO + al256((size_t)MAXROWS * 4);
constexpr size_t WS_MOE_END = WS_ROWGATE + al256((size_t)MAXROWS * 4);
constexpr size_t WS_END = WS_MIXER_END > WS_MOE_END ? WS_MIXER_END : WS_MOE_END;
constexpr int CW_BAR = 4096;
constexpr int CW_ATT = 8192;
constexpr int CW_CNT = 16384;

struct Ctx {
    const void* in[N_IN];
    float* out;
    unsigned char* ws;
};
#ifndef CPU_TEST
typedef const __attribute__((address_space(4))) Ctx& CtxRef;
#else
typedef CtxRef CtxRef;
#endif
#define INF(i) ((const float*)C.in[i])
#define WSP(T_, off) ((T_*)(C.ws + (off)))

#ifndef CPU_TEST
HD float wave_sum(float v) {
#pragma unroll
    for (int o = 1; o < 64; o <<= 1) v += __shfl_xor(v, o);
    return v;
}
HD float wave_max(float v) {
#pragma unroll
    for (int o = 1; o < 64; o <<= 1) v = fmaxf(v, __shfl_xor(v, o));
    return v;
}
HD unsigned atom_add(unsigned* p, unsigned v) { return atomicAdd(p, v); }
#define WSYNC() __builtin_amdgcn_wave_barrier(); asm volatile("s_waitcnt lgkmcnt(0)" ::: "memory")
typedef __attribute__((address_space(3))) float* wsh_t;
#else
HD float wave_sum(float v) { return v; }
HD float wave_max(float v) { return v; }
HD unsigned atom_add(unsigned* p, unsigned v) { unsigned o = *p; *p += v; return o; }
#define WSYNC()
typedef float* wsh_t;
#endif
HD float sigmoidf_(float x) { return 1.f / (1.f + expf(-x)); }
HD float softplusf_(float x) { return x > 20.f ? x : (x < -20.f ? expf(x) : log1pf(expf(x))); }
HD float siluf_(float x) { return x * sigmoidf_(x); }

HD int rowmap(int mode, int n) { return mode == 0 ? n : (mode == 1 ? (n >> 7) * 256 + (n & 127) : (n >> 7) * 256 + 128 + (n & 127)); }
HD void transpose_item(const float* W, int K, int N, int ldw, bf16_t* WT, int ldk, int mode, int item, int lane, wsh_t scr) {
    const int nblk = (N + 31) / 32, kb = item / nblk, nb = item % nblk, k0 = 64 * kb, n0 = 32 * nb;
    for (int idx = lane; idx < 2048; idx += LANES) { const int kk = idx >> 5, nn = idx & 31; const int n = n0 + nn;
        scr[kk * 33 + nn] = (n < N) ? W[(size_t)(k0 + kk) * ldw + n] : 0.f; }
    WSYNC();
    for (int idx = lane; idx < 256; idx += LANES) { const int n = idx >> 3, c = idx & 7;
        unsigned o[4];
        for (int j = 0; j < 4; ++j) o[j] = pk2(scr[(8 * c + 2 * j) * 33 + n], scr[(8 * c + 2 * j + 1) * 33 + n]);
        unsigned* dst = (unsigned*)(WT + (size_t)rowmap(mode, n0 + n) * ldk + k0 + 8 * c);
        dst[0] = o[0]; dst[1] = o[1]; dst[2] = o[2]; dst[3] = o[3]; }
    WSYNC();
}
HD void stage_convert(CtxRef C, int l, int gw, int ngw, int lane, wsh_t scr) {
    constexpr int NB_IN = DINP / 32;
    constexpr int I_IN = (DM / 64) * NB_IN, I_OUT = (DMIX / 64) * (DM / 32), I_PG = (DM / 64) * (DM / 32), I_PW = (DPLE / 64 > 0 ? DPLE / 64 : 1) * (DM / 32);
    constexpr int I_G1 = (DM / 64) * (DEXP / 32), I_D1 = (DEXP / 64) * (DM / 32);
    constexpr int NIT = I_IN + I_OUT + I_PG + I_PW + NEXP * (2 * I_G1 + I_D1);
    static_assert(DPLE % 32 == 0 && DEXP % 64 == 0, "shapes");
    for (int it = gw; it < NIT; it += ngw) {
        int r = it;
        if (r < I_IN) {
            const int nblk = NB_IN, kb = r / nblk, nb = r % nblk, k0 = 64 * kb, n0 = 32 * nb;
            const float* W = INF(I_WIN) + (size_t)l * DM * DIN; bf16_t* WT = WSP(bf16_t, WS_WIN);
            for (int idx = lane; idx < 2048; idx += LANES) { const int kk = idx >> 5, nn = idx & 31; const int n = n0 + nn;
                scr[kk * 33 + nn] = (n < DIN) ? W[(size_t)(k0 + kk) * DIN + n] : 0.f; }
            WSYNC();
            for (int idx = lane; idx < 256; idx += LANES) { const int n = idx >> 3, c = idx & 7; unsigned o[4];
                for (int j = 0; j < 4; ++j) o[j] = pk2(scr[(8 * c + 2 * j) * 33 + n], scr[(8 * c + 2 * j + 1) * 33 + n]);
                unsigned* dst = (unsigned*)(WT + (size_t)(n0 + n) * DM + k0 + 8 * c); dst[0] = o[0]; dst[1] = o[1]; dst[2] = o[2]; dst[3] = o[3]; }
            WSYNC();
            continue; }
        r -= I_IN;
        if (r < I_OUT) { transpose_item(INF(I_WOUT) + (size_t)l * DMIX * DM, DMIX, DM, DM, WSP(bf16_t, WS_WOUT), DMIX, 0, r, lane, scr); continue; } r -= I_OUT;
        if (r < I_PG) { transpose_item(INF(I_PLEG) + (size_t)l * DM * DM, DM, DM, DM, WSP(bf16_t, WS_WPG), DM, 0, r, lane, scr); continue; } r -= I_PG;
        if (r < I_PW) {
            if (DPLE >= 64) transpose_item(INF(I_PLEW) + (size_t)l * DPLE * DM, DPLE, DM, DM, WSP(bf16_t, WS_WP), DPLE, 0, r, lane, scr);
            continue; } r -= I_PW;
        const int e = r / (2 * I_G1 + I_D1); r -= e * (2 * I_G1 + I_D1);
        if (r < I_G1) { transpose_item(INF(I_WG) + ((size_t)l * NEXP + e) * DM * DEXP, DM, DEXP, DEXP, WSP(bf16_t, WS_WGU) + (size_t)e * 2 * DEXP * DM, DM, 1, r, lane, scr); continue; } r -= I_G1;
        if (r < I_G1) { transpose_item(INF(I_WU) + ((size_t)l * NEXP + e) * DM * DEXP, DM, DEXP, DEXP, WSP(bf16_t, WS_WGU) + (size_t)e * 2 * DEXP * DM, DM, 2, r, lane, scr); continue; } r -= I_G1;
        transpose_item(INF(I_WD) + ((size_t)l * NEXP + e) * DEXP * DM, DEXP, DM, DM, WSP(bf16_t, WS_WD) + (size_t)e * DM * DEXP, DEXP, 0, r, lane, scr);
    }
    {   const float* wq = INF(I_WUQ) + (size_t)l * 256 * 384; const float* gq = INF(I_QNG) + l * 256; bf16_t* o = WSP(bf16_t, WS_WUQ);
        for (int i = gw * LANES + lane; i < 512 * 256; i += ngw * LANES) { const int n = i >> 8, k = i & 255; o[i] = f2bf(n < 384 ? gq[k] * wq[(size_t)k * 384 + n] : 0.f); }
        const float* wk = INF(I_WUKV) + (size_t)l * 128 * 512; const float* gk = INF(I_KVNG) + l * 128; bf16_t* o2 = WSP(bf16_t, WS_WUKV);
        for (int i = gw * LANES + lane; i < 512 * 256; i += ngw * LANES) { const int n = i >> 8, k = i & 255; o2[i] = f2bf(k < 128 ? gk[k] * wk[(size_t)k * 512 + n] : 0.f); } }
    if (l == 0) {
        const int* pos = (const int*)C.in[I_POS]; float* rt = WSP(float, WS_ROPE);
        for (int i = gw * LANES + lane; i < T * 16; i += ngw * LANES) { const int t = i >> 4, f = i & 15; const float ang = (float)pos[t] * powf(10000.f, -(float)f / 16.f);
            rt[(size_t)t * 32 + f] = cosf(ang); rt[(size_t)t * 32 + 16 + f] = sinf(ang); } }
    {   const float* p = INF(I_P) + (size_t)l * T * DPLE; bf16_t* pb = WSP(bf16_t, WS_PB);
        const size_t n4 = (size_t)T * DPLE / 4;
        for (size_t i = (size_t)gw * LANES + lane; i < n4; i += (size_t)ngw * LANES) {
            const float* s = p + 4 * i; unsigned* d = (unsigned*)(pb + 4 * i); d[0] = pk2(s[0], s[1]); d[1] = pk2(s[2], s[3]); } }
    if (l == 0) { const float* x = INF(I_X); bf16_t* xb = WSP(bf16_t, WS_XB);
        const size_t n4 = (size_t)T * DM / 4;
        for (size_t i = (size_t)gw * LANES + lane; i < n4; i += (size_t)ngw * LANES) {
            const float* s = x + 4 * i; unsigned* d = (unsigned*)(xb + 4 * i); d[0] = pk2(s[0], s[1]); d[1] = pk2(s[2], s[3]); } }
#ifdef CFG_SMALL
    if (DPLE < 64) {
        const float* W = INF(I_PLEW) + (size_t)l * DPLE * DM; bf16_t* WT = WSP(bf16_t, WS_WP);
        for (int i = gw * LANES + lane; i < DPLE * DM; i += ngw * LANES) { const int k = i / DM, n = i % DM; WT[(size_t)n * DPLE + k] = f2bf(W[i]); } }
#endif
}

HD float ubf(const bf16_t* u, int t, int c) { return bf2f(u[(size_t)t * DINP + c]); }
HD void stage_prep(CtxRef C, int l, int gw, int ngw, int lane, wsh_t sh) {
    const bf16_t* u = WSP(bf16_t, WS_U);
    const float* mu = INF(I_MU) + l * DINA; const float* w0 = INF(I_W0) + l * GW; const float* wup = INF(I_WUP) + l * 32 * GW;
    const float* a0 = INF(I_A0) + l * GW; const float* aup = INF(I_AUP) + l * 32 * GW; const float* gup = INF(I_GUP) + l * 64 * GW;
    const float* kkw = INF(I_KK) + l * GW; const float* kaw = INF(I_KA) + l * GW;
    const float* glaup = INF(I_GLA_UP) + l * 16 * 128; const float* glab = INF(I_GLA_B) + l * 128;
    const float* convw = INF(I_CONVW) + l * 4 * 512; const float* convb = INF(I_CONVB) + l * 512;
    const float* ib = INF(I_IB) + l * 4; const float* fb = INF(I_FB) + l * 4;
    const float* qng = INF(I_QNG) + l * 256; const float* wuq = INF(I_WUQ) + (size_t)l * 256 * 384;
    const float* kvng = INF(I_KVNG) + l * 128; const float* wukv = INF(I_WUKV) + (size_t)l * 128 * 512;
    const int* pos = (const int*)C.in[I_POS];
    float* oR = WSP(float, WS_RW_R); float* oW = WSP(float, WS_RW_W); float* oK = WSP(float, WS_RW_K); float* oV = WSP(float, WS_RW_V);
    float* oA = WSP(float, WS_RW_A); float* oB = WSP(float, WS_RW_B); float* oG = WSP(float, WS_RW_G);
    float* oQK = WSP(float, WS_QK); float* oGA = WSP(float, WS_GA); float* oLG = WSP(float, WS_LG);
    bf16_t* oAQ = WSP(bf16_t, WS_AQ); bf16_t* oAK = WSP(bf16_t, WS_AK); bf16_t* oAV = WSP(bf16_t, WS_AV);
    for (int t = gw; t < T; t += ngw) {
        const int s = t % SEQ;
        for (int j = lane; j < 128; j += LANES) { const int c = UA_WD + j; const float cur = ubf(u, t, c), prev = s > 0 ? ubf(u, t - 1, c) : 0.f;
            const float v = cur + (prev - cur) * mu[c]; sh[j] = j < 32 ? tanhf(v) : (j < 64 ? v : sigmoidf_(v)); }
        WSYNC();
        for (int h = 0; h < NH; ++h) {
            float kkraw[HD64 / LANES]; float kv_[HD64 / LANES], av_[HD64 / LANES]; float ss = 0.f;
            for (int i = 0; i < HD64 / LANES; ++i) { const int c = h * 64 + i * LANES + lane;
                float z = w0[c], za = a0[c], g = 0.f;
_Pragma("unroll 8")
                for (int j = 0; j < 32; ++j) { z += sh[j] * wup[j * GW + c]; za += sh[32 + j] * aup[j * GW + c]; }
_Pragma("unroll 8")
                for (int j = 0; j < 64; ++j) g += sh[64 + j] * gup[j * GW + c];
                const float lnl = -softplusf_(-z) - 0.5f; const float decay = expf(-expf(lnl)); const float a = sigmoidf_(za);
                float r, k, v;
                { const float cur = ubf(u, t, UA_R + c), prev = s > 0 ? ubf(u, t - 1, UA_R + c) : 0.f; r = cur + (prev - cur) * mu[UA_R + c]; }
                { const float cur = ubf(u, t, UA_K + c), prev = s > 0 ? ubf(u, t - 1, UA_K + c) : 0.f; k = cur + (prev - cur) * mu[UA_K + c]; }
                { const float cur = ubf(u, t, UA_V + c), prev = s > 0 ? ubf(u, t - 1, UA_V + c) : 0.f; v = cur + (prev - cur) * mu[UA_V + c]; }
                kkraw[i] = k * kkw[c]; ss += kkraw[i] * kkraw[i];
                kv_[i] = k * (1.f + (a - 1.f) * kaw[c]); av_[i] = a;
                const size_t o = (size_t)t * GW + c; oR[o] = r; oW[o] = decay; oK[o] = kv_[i]; oV[o] = v; oG[o] = g; }
            ss = wave_sum(ss); const float inv = 1.f / fmaxf(sqrtf(ss), 1e-12f);
            for (int i = 0; i < HD64 / LANES; ++i) { const int c = h * 64 + i * LANES + lane; const size_t o = (size_t)t * GW + c; const float kk = kkraw[i] * inv;
                oA[o] = -kk; oB[o] = kk * av_[i]; }
        }
        WSYNC();
        for (int c = lane; c < 128; c += LANES) { float z = glab[c];
            for (int j = 0; j < 16; ++j) z += ubf(u, t, UB_AD + j) * glaup[j * 128 + c];
            oGA[(size_t)t * 128 + c] = -softplusf_(-z) * (1.f / 16.f); }
        for (int c = lane; c < 512; c += LANES) { float y = convb[c];
            for (int j = 0; j < 4; ++j) { const int sp = s - 3 + j; if (sp >= 0) y += convw[j * 512 + c] * ubf(u, t - 3 + j, UC_Q + c); }
            float q = siluf_(y); if (c >= 256) q *= 0.125f; oQK[(size_t)t * 512 + c] = q; }
        for (int c = lane; c < 8; c += LANES) { const float v = ubf(u, t, UC_IG + c);
            oLG[(size_t)t * 8 + c] = c < 4 ? v + ib[c] : -softplusf_(-(v + fb[c - 4])); }
        {   float ssq = 0.f, sskv = 0.f;
            for (int j = lane; j < 256; j += LANES) { const float v = ubf(u, t, UD_CQ + j); ssq += v * v; }
            for (int j = lane; j < 128; j += LANES) { const float v = ubf(u, t, UD_CKV + j); sskv += v * v; }
            ssq = wave_sum(ssq); sskv = wave_sum(sskv);
            const float rq = 1.f / sqrtf(ssq * (1.f / 256.f) + NORM_EPS), rkv = 1.f / sqrtf(sskv * (1.f / 128.f) + NORM_EPS);
            for (int j = lane; j < 256; j += LANES) sh[j] = ubf(u, t, UD_CQ + j) * rq * qng[j];
            for (int j = lane; j < 128; j += LANES) sh[256 + j] = ubf(u, t, UD_CKV + j) * rkv * kvng[j];
            WSYNC();
            for (int n = lane; n < 384; n += LANES) { float acc = 0.f;
_Pragma("unroll 8")
                for (int k = 0; k < 256; ++k) acc += sh[k] * wuq[(size_t)k * 384 + n]; sh[384 + n] = acc; }
            for (int n = lane; n < 512; n += LANES) { float acc = 0.f;
_Pragma("unroll 8")
                for (int k = 0; k < 128; ++k) acc += sh[256 + k] * wukv[(size_t)k * 512 + n]; sh[768 + n] = acc; }
            for (int i = lane; i < 16; i += LANES) { const float invf = powf(10000.f, -(float)i / 16.f); const float ang = (float)pos[t] * invf; sh[1280 + i] = cosf(ang); sh[1296 + i] = sinf(ang); }
            for (int i = lane; i < 32; i += LANES) sh[1312 + i] = ubf(u, t, UD_KR + i);
            WSYNC();
            const float qscale = 0.10206207261596575f * 1.4426950408889634f;
            for (int idx = lane; idx < 384; idx += LANES) { const int h = idx / 96, d = idx % 96; float v;
                if (d < 64) v = sh[384 + idx];
                else { const int i = (d - 64) & 15; const float x1 = sh[384 + h * 96 + 64 + i], x2 = sh[384 + h * 96 + 80 + i]; const float c_ = sh[1280 + i], s_ = sh[1296 + i];
                    v = (d - 64) < 16 ? x1 * c_ - x2 * s_ : x1 * s_ + x2 * c_; }
                oAQ[(size_t)t * 384 + idx] = f2bf(v * qscale); }
            for (int idx = lane; idx < 384; idx += LANES) { const int h = idx / 96, d = idx % 96; float v;
                if (d < 64) v = sh[768 + h * 128 + d];
                else { const int i = (d - 64) & 15; const float x1 = sh[1312 + i], x2 = sh[1328 + i]; const float c_ = sh[1280 + i], s_ = sh[1296 + i];
                    v = (d - 64) < 16 ? x1 * c_ - x2 * s_ : x1 * s_ + x2 * c_; }
                oAK[(size_t)t * 384 + idx] = f2bf(v); }
            for (int idx = lane; idx < 256; idx += LANES) { const int h = idx / 64, d = idx % 64; oAV[(size_t)t * 256 + idx] = f2bf(sh[768 + h * 128 + 64 + d]); }
            WSYNC();
        }
    }
}

HD void rwkv_scan_thread(CtxRef C, int b, int h, int v) {
    const float* pR = WSP(float, WS_RW_R); const float* pW = WSP(float, WS_RW_W); const float* pK = WSP(float, WS_RW_K); const float* pV = WSP(float, WS_RW_V);
    const float* pA = WSP(float, WS_RW_A); const float* pB = WSP(float, WS_RW_B); float* Y = WSP(float, WS_YA);
    float S[64];
#pragma unroll
    for (int k = 0; k < 64; ++k) S[k] = 0.f;
    for (int s = 0; s < SEQ; ++s) {
        const size_t o = ((size_t)b * SEQ + s) * GW + h * 64;
        const float vv = pV[o + v];
        float sa0 = 0.f, sa1 = 0.f, sa2 = 0.f, sa3 = 0.f;
#pragma unroll
        for (int k = 0; k < 64; k += 4) { const f4v a = *(const f4v*)(pA + o + k); sa0 += S[k] * a[0]; sa1 += S[k + 1] * a[1]; sa2 += S[k + 2] * a[2]; sa3 += S[k + 3] * a[3]; }
        const float sa = (sa0 + sa1) + (sa2 + sa3);
        float y0 = 0.f, y1 = 0.f, y2 = 0.f, y3 = 0.f;
#pragma unroll
        for (int k = 0; k < 64; k += 4) {
            const f4v w = *(const f4v*)(pW + o + k), bb = *(const f4v*)(pB + o + k), kk = *(const f4v*)(pK + o + k), r = *(const f4v*)(pR + o + k);
            S[k] = S[k] * w[0] + sa * bb[0] + vv * kk[0]; y0 += S[k] * r[0];
            S[k + 1] = S[k + 1] * w[1] + sa * bb[1] + vv * kk[1]; y1 += S[k + 1] * r[1];
            S[k + 2] = S[k + 2] * w[2] + sa * bb[2] + vv * kk[2]; y2 += S[k + 2] * r[2];
            S[k + 3] = S[k + 3] * w[3] + sa * bb[3] + vv * kk[3]; y3 += S[k + 3] * r[3];
            if ((k & 12) == 12) asm volatile("" ::: "memory"); }
        Y[o + v] = (y0 + y1) + (y2 + y3);
    }
}
HD void gla_scan_thread(CtxRef C, int b, int h, int v) {
    const bf16_t* u = WSP(bf16_t, WS_U); const float* GA = WSP(float, WS_GA); float* Y = WSP(float, WS_YB);
    float S[32];
#pragma unroll
    for (int k = 0; k < 32; ++k) S[k] = 0.f;
    for (int s = 0; s < SEQ; ++s) {
        const int t = b * SEQ + s;
        const float vv = ubf(u, t, UB_V + h * 64 + v);
        float acc = 0.f;
#pragma unroll
        for (int k8 = 0; k8 < 32; k8 += 8) { float kf[8], qf[8];
            ld8bf(u + (size_t)t * DINP + UB_K + h * 32 + k8, kf); ld8bf(u + (size_t)t * DINP + UB_Q + h * 32 + k8, qf);
            const f4v g0 = *(const f4v*)(GA + (size_t)t * 128 + h * 32 + k8), g1 = *(const f4v*)(GA + (size_t)t * 128 + h * 32 + k8 + 4);
#pragma unroll
            for (int j = 0; j < 8; ++j) { const float a = expf(j < 4 ? g0[j & 3] : g1[j & 3]); S[k8 + j] = a * S[k8 + j] + kf[j] * vv; acc += qf[j] * S[k8 + j]; } }
        Y[(size_t)t * GW + h * 64 + v] = acc * 0.17677669529663687f;
    }
}
HD void mlstm_scan_thread(CtxRef C, int b, int h, int e) {
    const bf16_t* u = WSP(bf16_t, WS_U); const float* QK = WSP(float, WS_QK); const float* LG = WSP(float, WS_LG);
    float* Y = WSP(float, WS_YC); float* DEN = WSP(float, WS_DEN);
    float S[64];
#pragma unroll
    for (int k = 0; k < 64; ++k) S[k] = 0.f;
    for (int s = 0; s < SEQ; ++s) {
        const int t = b * SEQ + s;
        const float ig = expf(LG[(size_t)t * 8 + h]), fg = expf(LG[(size_t)t * 8 + 4 + h]);
        const float vv = (e < 64 ? ubf(u, t, UC_V + h * 64 + e) : 1.f) * ig;
        float acc = 0.f;
#pragma unroll
        for (int k = 0; k < 64; k += 4) { const f4v kk = *(const f4v*)(QK + (size_t)t * 512 + 256 + h * 64 + k), qq = *(const f4v*)(QK + (size_t)t * 512 + h * 64 + k);
#pragma unroll
            for (int j = 0; j < 4; ++j) { S[k + j] = fg * S[k + j] + kk[j] * vv; acc += qq[j] * S[k + j]; } }
        if (e < 64) Y[(size_t)t * GW + h * 64 + e] = acc; else DEN[(size_t)t * 4 + h] = acc;
    }
}
HD void attn_thread(CtxRef C, int b, int h, int q, int kmax  ) {
    const bf16_t* Q = WSP(bf16_t, WS_AQ); const bf16_t* K = WSP(bf16_t, WS_AK); const bf16_t* V = WSP(bf16_t, WS_AV); bf16_t* mix = WSP(bf16_t, WS_MIX);
    const int t = b * SEQ + q;
    unsigned qp[48]; float o[64];
#pragma unroll
    for (int d = 0; d < 48; d += 4) { const u4v w = *(const u4v*)(Q + (size_t)t * 384 + h * 96 + 2 * d); qp[d] = w[0]; qp[d + 1] = w[1]; qp[d + 2] = w[2]; qp[d + 3] = w[3]; }
#pragma unroll
    for (int d = 0; d < 64; ++d) o[d] = 0.f;
    float m = -1e30f, lsum = 0.f;
    for (int j = 0; j <= kmax; ++j) {
        const size_t tk = (size_t)b * SEQ + j;
        float sc0 = 0.f, sc1 = 0.f;
#pragma unroll
        for (int d = 0; d < 96; d += 8) { float kf[8]; ld8bf(K + tk * 384 + h * 96 + d, kf);
#pragma unroll
            for (int i = 0; i < 8; i += 2) { const unsigned qw = qp[(d + i) >> 1];
                sc0 += __builtin_bit_cast(float, qw << 16) * kf[i]; sc1 += __builtin_bit_cast(float, qw & 0xffff0000u) * kf[i + 1]; }
            if ((d & 24) == 24) asm volatile("" ::: "memory"); }
        const float sc = sc0 + sc1;
        if (j <= q) {
            const float mn = fmaxf(m, sc); const float corr = exp2f(m - mn), p = exp2f(sc - mn);
            lsum = lsum * corr + p;
#pragma unroll
            for (int d = 0; d < 64; d += 8) { float vf[8]; ld8bf(V + tk * 256 + h * 64 + d, vf);
#pragma unroll
                for (int i = 0; i < 8; ++i) o[d + i] = o[d + i] * corr + p * vf[i];
                if (d & 8) asm volatile("" ::: "memory"); }
            m = mn; }
    }
    const float inv = 1.f / lsum;
#pragma unroll
    for (int d = 0; d < 64; d += 8) { float a[8];
#pragma unroll
        for (int i = 0; i < 8; ++i) a[i] = o[d + i] * inv;
        st8bf(mix + (size_t)t * DMIX + 768 + h * 64 + d, a); }
}

HD void stage_post(CtxRef C, int l, int gw, int ngw, int lane) {
    const bf16_t* u = WSP(bf16_t, WS_U); bf16_t* mix = WSP(bf16_t, WS_MIX);
    const float* YA = WSP(float, WS_YA); const float* YB = WSP(float, WS_YB); const float* YC = WSP(float, WS_YC); const float* DEN = WSP(float, WS_DEN);
    const float* pR = WSP(float, WS_RW_R); const float* pK = WSP(float, WS_RW_K); const float* pV = WSP(float, WS_RW_V); const float* pG = WSP(float, WS_RW_G);
    const float* rk = INF(I_RK) + l * GW; const float* gng = INF(I_GNG) + l * GW; const float* gnb = INF(I_GNB) + l * GW;
    const float* glag = INF(I_GLA_G) + l * GW; const float* mlng = INF(I_MLN_G) + l * GW;
    constexpr int PL = HD64 / LANES;
    for (int t = gw; t < T; t += ngw) {
        for (int h = 0; h < NH; ++h) {
            {   float y[PL], s1 = 0.f, bon = 0.f;
#ifdef CPU_TEST
                for (int i = 0; i < PL; ++i) { const int c = h * 64 + i * LANES + lane; const size_t o = (size_t)t * GW + c; y[i] = YA[o]; s1 += y[i]; bon += pR[o] * pK[o] * rk[c]; }
                s1 = wave_sum(s1); bon = wave_sum(bon);
#else
                for (int i = 0; i < PL; ++i) { const int c = h * 64 + i * LANES + lane; y[i] = YA[(size_t)t * GW + c]; s1 += y[i]; }
                s1 = wave_sum(s1); bon = WSP(float, WS_RW_BON)[(size_t)t * 4 + h];
#endif
                const float mean = s1 * (1.f / 64.f); float s2 = 0.f;
                for (int i = 0; i < PL; ++i) { y[i] -= mean; s2 += y[i] * y[i]; }
                s2 = wave_sum(s2); const float rstd = 1.f / sqrtf(s2 * (1.f / 64.f) + RWKV_GN_EPS);
                for (int i = 0; i < PL; ++i) { const int c = h * 64 + i * LANES + lane; const size_t o = (size_t)t * GW + c;
#ifdef CPU_TEST
                    const float v = (y[i] * rstd * gng[c] + gnb[c] + bon * pV[o]) * pG[o];
#else
                    const float v = (y[i] * rstd * gng[c] + gnb[c] + bon * bf2f(WSP(bf16_t, WS_RW_VS)[o])) * bf2f(WSP(bf16_t, WS_RW_GG)[o]);
#endif
                    mix[(size_t)t * DMIX + c] = f2bf(v); } }
            {   float y[PL], s2 = 0.f;
                for (int i = 0; i < PL; ++i) { const int c = h * 64 + i * LANES + lane; y[i] = YB[(size_t)t * GW + c]; s2 += y[i] * y[i]; }
                s2 = wave_sum(s2); const float rstd = 1.f / sqrtf(s2 * (1.f / 64.f) + NORM_EPS);
                for (int i = 0; i < PL; ++i) { const int c = h * 64 + i * LANES + lane;
                    const float v = y[i] * rstd * glag[c] * siluf_(ubf(u, t, UB_G + c)); mix[(size_t)t * DMIX + 256 + c] = f2bf(v); } }
            {   const float den = DEN[(size_t)t * 4 + h]; const float dinv = 1.f / fmaxf(fabsf(den), 1.f);
                float y[PL], s1 = 0.f;
                for (int i = 0; i < PL; ++i) { const int c = h * 64 + i * LANES + lane; y[i] = YC[(size_t)t * GW + c] * dinv; s1 += y[i]; }
                s1 = wave_sum(s1); const float mean = s1 * (1.f / 64.f); float s2 = 0.f;
                for (int i = 0; i < PL; ++i) { y[i] -= mean; s2 += y[i] * y[i]; }
                s2 = wave_sum(s2); const float rstd = 1.f / sqrtf(s2 * (1.f / 64.f) + LN_EPS);
                for (int i = 0; i < PL; ++i) { const int c = h * 64 + i * LANES + lane;
                    const float v = y[i] * rstd * mlng[c] * sigmoidf_(ubf(u, t, UC_O + c)); mix[(size_t)t * DMIX + 512 + c] = f2bf(v); } }
        }
    }
}

HD void ln_row(const float* src, const float* g, const float* b, float* dstf, bf16_t* dstb, int lane, float* keep  ) {
    constexpr int PL = DM / LANES;
    float s1 = 0.f;
#pragma unroll
    for (int i = 0; i < PL; ++i) { keep[i] = src[i * LANES + lane]; s1 += keep[i]; }
    s1 = wave_sum(s1); const float mean = s1 * (1.f / DM); float s2 = 0.f;
#pragma unroll
    for (int i = 0; i < PL; ++i) { keep[i] -= mean; s2 += keep[i] * keep[i]; }
    s2 = wave_sum(s2); const float rstd = 1.f / sqrtf(s2 * (1.f / DM) + LN_EPS);
#pragma unroll
    for (int i = 0; i < PL; ++i) { const int c = i * LANES + lane; keep[i] = keep[i] * rstd * g[c] + b[c]; dstf[c] = keep[i]; dstb[c] = f2bf(keep[i]); }
}
HD void stage_ln1_router(CtxRef C, int l, int gw, int ngw, int lane, wsh_t sh) {
    float* X1 = C.out; bf16_t* xb = WSP(bf16_t, WS_XB);
    const float* g = INF(I_LN1G) + l * DM; const float* b = INF(I_LN1B) + l * DM;
    const float* wrg = INF(I_WRG) + (size_t)l * DM * NGRP; const float* brg = INF(I_BRG) + l * NGRP;
    const float* wre = INF(I_WRE) + (size_t)l * DM * NEXP; const float* bre = INF(I_BRE) + l * NEXP;
    unsigned* cnt = WSP(unsigned, WS_CTL) + CW_CNT + l * NEXP * 64;
    int* tokinfo = WSP(int, WS_TOKINFO); int* list = WSP(int, WS_LIST);
    constexpr int PL = DM / LANES;
    for (int t = gw; t < T; t += ngw) {
        {   float keep[PL];
            ln_row(X1 + (size_t)t * DM, g, b, X1 + (size_t)t * DM, xb + (size_t)t * DM, lane, keep);
#pragma unroll
            for (int i = 0; i < PL; ++i) sh[i * LANES + lane] = keep[i]; }
        WSYNC();
        float lg[NGRP], le[NEXP];
#pragma unroll
        for (int j = 0; j < NGRP; ++j) lg[j] = 0.f;
#pragma unroll
        for (int j = 0; j < NEXP; ++j) le[j] = 0.f;
#pragma unroll 1
        for (int i = 0; i < PL; ++i) { const int c = i * LANES + lane; const float xv = sh[c];
            const f4v wg = *(const f4v*)(wrg + (size_t)c * NGRP);
#pragma unroll
            for (int j = 0; j < NGRP; ++j) lg[j] += xv * wg[j];
#pragma unroll
            for (int j = 0; j < NEXP; j += 4) { const f4v we = *(const f4v*)(wre + (size_t)c * NEXP + j);
                le[j] += xv * we[0]; le[j + 1] += xv * we[1]; le[j + 2] += xv * we[2]; le[j + 3] += xv * we[3]; } }
        WSYNC();
#pragma unroll
        for (int j = 0; j < NGRP; ++j) lg[j] = wave_sum(lg[j]) + brg[j];
#pragma unroll
        for (int j = 0; j < NEXP; ++j) le[j] = wave_sum(le[j]) + bre[j];
        int gi = 0; float gm = lg[0];
#pragma unroll
        for (int j = 1; j < NGRP; ++j) if (lg[j] > gm) { gm = lg[j]; gi = j; }
        float gs = 0.f;
#pragma unroll
        for (int j = 0; j < NGRP; ++j) gs += expf(lg[j] - gm);
        const float group_p = 1.f / gs;
        float el[EPG];
#pragma unroll
        for (int j = 0; j < EPG; ++j) { float v = le[j];
#pragma unroll
            for (int g2 = 1; g2 < NGRP; ++g2) v = (gi == g2) ? le[g2 * EPG + j] : v;
            el[j] = v; }
        int e0 = 0; float m0 = el[0];
#pragma unroll
        for (int j = 1; j < EPG; ++j) if (el[j] > m0) { m0 = el[j]; e0 = j; }
        int e1 = -1; float m1 = -3.0e38f;
#pragma unroll
        for (int j = 0; j < EPG; ++j) if (j != e0 && el[j] > m1) { m1 = el[j]; e1 = j; }
        const float p1 = expf(m1 - m0); const float g0 = group_p / (1.f + p1), g1 = group_p * p1 / (1.f + p1);
        if (lane == 0) {
            const int E0 = gi * EPG + e0, E1 = gi * EPG + e1;
            tokinfo[(size_t)t * 4 + 0] = E0; tokinfo[(size_t)t * 4 + 1] = E1;
            ((float*)tokinfo)[(size_t)t * 4 + 2] = g0; ((float*)tokinfo)[(size_t)t * 4 + 3] = g1;
            const unsigned s0 = atom_add(cnt + E0 * 64, 1u); list[(size_t)E0 * T + s0] = t * 2 + 0;
            const unsigned s1 = atom_add(cnt + E1 * 64, 1u); list[(size_t)E1 * T + s1] = t * 2 + 1;
        }
    }
}
HD void moe_bases(CtxRef C, int l, int* base  ) {
    const unsigned* cnt = WSP(unsigned, WS_CTL) + CW_CNT + l * NEXP * 64;
    int acc = 0;
    for (int e = 0; e < NEXP; ++e) { base[e] = acc; acc += ((int)cnt[e * 64] + 255) & ~255; }
    base[NEXP] = acc;
}
HD int moe_expert_of_row(const int* base, int row) { int e = 0; for (int j = 1; j < NEXP; ++j) if (row >= base[j]) e = j; return e; }
HD int moe_lookup(const unsigned* cnt, int row, int& e, int& be, int& ce) {
    int acc = 0; e = 0; be = 0; ce = 0;
    for (int j = 0; j < NEXP; ++j) { const int c = (int)cnt[j * 64]; if (row >= acc) { e = j; be = acc; ce = c; } acc += (c + 255) & ~255; }
    return acc;
}
HD void stage_gather(CtxRef C, int l, int gw, int ngw, int lane) {
    const unsigned* cnt = WSP(unsigned, WS_CTL) + CW_CNT + l * NEXP * 64;
    const int* list = WSP(int, WS_LIST); const int* tokinfo = WSP(int, WS_TOKINFO);
    const bf16_t* xb = WSP(bf16_t, WS_XB); bf16_t* xg = WSP(bf16_t, WS_XG); int* rowinfo = WSP(int, WS_ROWINFO); float* rowgate = WSP(float, WS_ROWGATE);
    int e, be, ce; const int total = moe_lookup(cnt, 0, e, be, ce);
    for (int row = gw; row < total; row += ngw) {
        moe_lookup(cnt, row, e, be, ce);
        const int slot = row - be;
        if (slot < ce) { const int ent = list[(size_t)e * T + slot]; const int tok = ent >> 1;
            for (int c = lane * 8; c < DM; c += LANES * 8) *(u4v*)(xg + (size_t)row * DM + c) = *(const u4v*)(xb + (size_t)tok * DM + c);
            if (lane == 0) { rowinfo[row] = ent; rowgate[row] = ((const float*)tokinfo)[(size_t)tok * 4 + 2 + (ent & 1)]; } }
        else { const u4v z = {0u, 0u, 0u, 0u}; for (int c = lane * 8; c < DM; c += LANES * 8) *(u4v*)(xg + (size_t)row * DM + c) = z;
            if (lane == 0) { rowinfo[row] = -1; rowgate[row] = 0.f; } }
    }
}
HD void stage_ln2(CtxRef C, int l, int gw, int ngw, int lane) {
    const float* src = WSP(float, WS_X); float* dst = (l == DEPTH - 1) ? C.out : WSP(float, WS_X); bf16_t* xb = WSP(bf16_t, WS_XB);
    const float* g = INF(I_LN2G) + l * DM; const float* b = INF(I_LN2B) + l * DM;
    constexpr int PL = DM / LANES;
    for (int t = gw; t < T; t += ngw) { float keep[PL]; ln_row(src + (size_t)t * DM, g, b, dst + (size_t)t * DM, xb + (size_t)t * DM, lane, keep); }
}

struct EpiU {
    static constexpr bool PERM = true; static constexpr int MODE = 0;
    bf16_t* o;
    HDM void put8(int row, int col, const float* a) const { st8bf(o + (size_t)row * DINP + col, a); }
};
struct EpiPP {
    static constexpr bool PERM = true; static constexpr int MODE = 0;
    bf16_t* o;
    HDM void put8(int row, int col, const float* a) const { st8bf(o + (size_t)row * DM + col, a); }
};
struct EpiPre1 {
    static constexpr bool PERM = false; static constexpr int MODE = 0;
    const float* x; float* o;
    HDM void put4(int row, int col, const float* a) const { const float al = dn_alpha(); const f4v xr = *(const f4v*)(x + (size_t)row * DM + col);
        f4v r; for (int j = 0; j < 4; ++j) r[j] = al * xr[j] + a[j]; *(f4v*)(o + (size_t)row * DM + col) = r; }
};
struct EpiH {
    static constexpr bool PERM = true; static constexpr int MODE = 1;
    bf16_t* o;
    HDM void put8gu(int row, int hcol, const float* g, const float* u) const { float v[8]; for (int j = 0; j < 8; ++j) v[j] = siluf_(g[j]) * u[j];
        st8bf(o + (size_t)row * DEXP + hcol, v); }
};
struct EpiY {
    static constexpr bool PERM = true; static constexpr int MODE = 0;
    const int* rowinfo; const float* rowgate; bf16_t* o;
    HDM void put8(int row, int col, const float* a) const { const int ent = rowinfo[row]; if (ent < 0) return; const float g = rowgate[row];
        float v[8]; for (int j = 0; j < 8; ++j) v[j] = g * a[j]; st8bf(o + (size_t)ent * DM + col, v); }
};
struct EpiPre2 {
    static constexpr bool PERM = false; static constexpr int MODE = 0;
    const float* x1; const bf16_t* ybuf; const bf16_t* pp; const float* bg; float* o;
    HDM void put4(int row, int col, const float* a) const { const float al = dn_alpha(); const size_t i = (size_t)row * DM + col;
        const f4v xr = *(const f4v*)(x1 + i); const f4v bgv = *(const f4v*)(bg + col);
        const unsigned* y0 = (const unsigned*)(ybuf + (size_t)(2 * row) * DM + col); const unsigned* y1 = (const unsigned*)(ybuf + (size_t)(2 * row + 1) * DM + col); const unsigned* pq = (const unsigned*)(pp + i);
        const unsigned y00 = y0[0], y01 = y0[1], y10 = y1[0], y11 = y1[1], p0 = pq[0], p1 = pq[1];
        float yv[4] = { __builtin_bit_cast(float, y00 << 16) + __builtin_bit_cast(float, y10 << 16), __builtin_bit_cast(float, y00 & 0xffff0000u) + __builtin_bit_cast(float, y10 & 0xffff0000u),
                        __builtin_bit_cast(float, y01 << 16) + __builtin_bit_cast(float, y11 << 16), __builtin_bit_cast(float, y01 & 0xffff0000u) + __builtin_bit_cast(float, y11 & 0xffff0000u) };
        float pv[4] = { __builtin_bit_cast(float, p0 << 16), __builtin_bit_cast(float, p0 & 0xffff0000u), __builtin_bit_cast(float, p1 << 16), __builtin_bit_cast(float, p1 & 0xffff0000u) };
        f4v r; for (int j = 0; j < 4; ++j) r[j] = al * xr[j] + yv[j] + sigmoidf_(a[j] + bgv[j]) * pv[j];
        *(f4v*)(o + i) = r; }
};

#ifndef CPU_TEST
struct EpiQ {
    static constexpr bool PERM = true; static constexpr int MODE = 0;
    const float* rope; bf16_t* o;
    __device__ __forceinline__ void put8(int row, int col, const float* a) const {
        float p[8];
#pragma unroll
        for (int j = 0; j < 8; ++j) p[j] = __shfl_xor(a[j], 32);
        if (col >= 384) return;
        const float qscale = 0.10206207261596575f * 1.4426950408889634f;
        const int d0 = col % 96; float v[8];
        if (d0 < 64) {
#pragma unroll
            for (int j = 0; j < 8; ++j) v[j] = a[j] * qscale; }
        else { const int i0 = (d0 - 64) & 15; const bool x2 = (d0 - 64) >= 16; const float* rt = rope + (size_t)row * 32 + i0;
            const f4v c0 = *(const f4v*)rt, c1 = *(const f4v*)(rt + 4), s0 = *(const f4v*)(rt + 16), s1 = *(const f4v*)(rt + 20);
#pragma unroll
            for (int j = 0; j < 8; ++j) { const float c = j < 4 ? c0[j & 3] : c1[j & 3], s = j < 4 ? s0[j & 3] : s1[j & 3];
                v[j] = (x2 ? (p[j] * s + a[j] * c) : (a[j] * c - p[j] * s)) * qscale; } }
        st8bf(o + (size_t)row * 384 + col, v); }
};
struct EpiKV {
    static constexpr bool PERM = true; static constexpr int MODE = 0;
    bf16_t* k; bf16_t* v;
    __device__ __forceinline__ void put8(int row, int col, const float* a) const { const int h = col >> 7, d = col & 127;
        if (d < 64) st8bf(k + (size_t)row * 384 + h * 96 + d, a); else st8bf(v + (size_t)row * 256 + h * 64 + (d - 64), a); }
};
__device__ __forceinline__ void mla_token_pass(CtxRef C, int gw, int ngw, int lane) {
    const bf16_t* u = WSP(bf16_t, WS_U); const float* rope = WSP(float, WS_ROPE); float* rstd = WSP(float, WS_RSTD); bf16_t* K = WSP(bf16_t, WS_AK);
    for (int t = gw; t < T; t += ngw) {
        const bf16_t* ur = u + (size_t)t * DINP;
        float ssq = 0.f, sskv = 0.f;
        { const unsigned* p = (const unsigned*)(ur + UD_CQ) + 2 * lane; const unsigned w0 = p[0], w1 = p[1];
          const float a = __builtin_bit_cast(float, w0 << 16), b = __builtin_bit_cast(float, w0 & 0xffff0000u), c = __builtin_bit_cast(float, w1 << 16), d = __builtin_bit_cast(float, w1 & 0xffff0000u);
          ssq = (a * a + b * b) + (c * c + d * d); }
        { const unsigned w0 = ((const unsigned*)(ur + UD_CKV))[lane]; const float a = __builtin_bit_cast(float, w0 << 16), b = __builtin_bit_cast(float, w0 & 0xffff0000u); sskv = a * a + b * b; }
        ssq = wave_sum(ssq); sskv = wave_sum(sskv);
        if (lane == 0) { rstd[(size_t)t * 2] = 1.f / sqrtf(ssq * (1.f / 256.f) + NORM_EPS); rstd[(size_t)t * 2 + 1] = 1.f / sqrtf(sskv * (1.f / 128.f) + NORM_EPS); }
        { const int i = lane & 15, hh = lane >> 4; const float x1 = bf2f(ur[UD_KR + i]), x2 = bf2f(ur[UD_KR + 16 + i]); const float c = rope[(size_t)t * 32 + i], s = rope[(size_t)t * 32 + 16 + i];
          bf16_t* kd = K + (size_t)t * 384 + hh * 96 + 64; kd[i] = f2bf(x1 * c - x2 * s); kd[16 + i] = f2bf(x1 * s + x2 * c); }
    }
}
__device__ __forceinline__ void rwkv_prep_coop(CtxRef C, int l, __attribute__((address_space(3))) unsigned char* lds) {
    int tid = threadIdx.x; asm volatile("" : "+v"(tid));
    const int lane = tid & 63, w = __builtin_amdgcn_readfirstlane(tid >> 6);
    const bf16_t* u = WSP(bf16_t, WS_U);
    const float* mu = INF(I_MU) + l * DINA;
    float* oR = WSP(float, WS_RW_R); float* oW = WSP(float, WS_RW_W); float* oK = WSP(float, WS_RW_K); float* oV = WSP(float, WS_RW_V);
    float* oA = WSP(float, WS_RW_A); float* oB = WSP(float, WS_RW_B); float* oG = WSP(float, WS_RW_G);
    __attribute__((address_space(3))) float* act = (__attribute__((address_space(3))) float*)lds;
    const int h = w & 3, role = w >> 2, c = h * 64 + lane;
    float wc0[32], wc1[32];
    { const float* p0 = role == 0 ? INF(I_WUP) + l * 32 * GW + c : INF(I_GUP) + l * 64 * GW + c;
      const float* p1 = role == 0 ? INF(I_AUP) + l * 32 * GW + c : INF(I_GUP) + l * 64 * GW + 32 * GW + c;
#pragma unroll
      for (int j = 0; j < 32; ++j) { wc0[j] = p0[j * GW]; wc1[j] = p1[j * GW]; } }
    const float w0c = INF(I_W0)[l * GW + c], a0c = INF(I_A0)[l * GW + c], kkc = INF(I_KK)[l * GW + c], kac = INF(I_KA)[l * GW + c];
    const float mur = mu[UA_R + c], muk = mu[UA_K + c], muv = mu[UA_V + c];
    for (int unit = blockIdx.x; unit < T / 16; unit += gridDim.x) {
        const int t0 = unit * 16;
        { const int tk = tid >> 5, j0 = (tid & 31) * 4; const int t = t0 + tk; const bool first = (t % SEQ) == 0;
          const unsigned* pc = (const unsigned*)(u + (size_t)t * DINP + UA_WD + j0); const unsigned c0 = pc[0], c1 = pc[1];
          unsigned q0 = 0u, q1 = 0u; if (!first) { const unsigned* pp = (const unsigned*)(u + (size_t)(t - 1) * DINP + UA_WD + j0); q0 = pp[0]; q1 = pp[1]; }
          const float cur[4] = {__builtin_bit_cast(float, c0 << 16), __builtin_bit_cast(float, c0 & 0xffff0000u), __builtin_bit_cast(float, c1 << 16), __builtin_bit_cast(float, c1 & 0xffff0000u)};
          const float prv[4] = {__builtin_bit_cast(float, q0 << 16), __builtin_bit_cast(float, q0 & 0xffff0000u), __builtin_bit_cast(float, q1 << 16), __builtin_bit_cast(float, q1 & 0xffff0000u)};
          f4v o;
#pragma unroll
          for (int j = 0; j < 4; ++j) { const float v = cur[j] + (prv[j] - cur[j]) * mu[UA_WD + j0 + j]; o[j] = (j0 < 32) ? tanhf(v) : (j0 < 64 ? v : sigmoidf_(v)); }
          *(__attribute__((address_space(3))) f4v*)(act + tk * 128 + j0) = o; }
        __syncthreads();
#pragma unroll 1
        for (int tk = 0; tk < 16; ++tk) { const int t = t0 + tk; const bool first = (t % SEQ) == 0;
            const __attribute__((address_space(3))) float* ar = act + tk * 128 + (role == 0 ? 0 : 64);
            float s0 = 0.f, s1 = 0.f;
#pragma unroll
            for (int j = 0; j < 32; j += 4) { const f4v x = *(const __attribute__((address_space(3))) f4v*)(ar + j), y = *(const __attribute__((address_space(3))) f4v*)(ar + 32 + j);
                s0 += x[0] * wc0[j] + x[1] * wc0[j + 1] + x[2] * wc0[j + 2] + x[3] * wc0[j + 3]; s1 += y[0] * wc1[j] + y[1] * wc1[j + 1] + y[2] * wc1[j + 2] + y[3] * wc1[j + 3];
                if ((j & 12) == 12) asm volatile("" ::: "memory"); }
            const size_t o = (size_t)t * GW + c;
            if (role == 1) { oG[o] = s0 + s1; }
            else {
                const float z = w0c + s0, za = a0c + s1;
                const float lnl = -softplusf_(-z) - 0.5f; const float decay = __expf(-__expf(lnl)); const float a = sigmoidf_(za);
                const bf16_t* uc = u + (size_t)t * DINP + c; const bf16_t* up = uc - DINP;
                const float rc = bf2f(uc[UA_R]), kc = bf2f(uc[UA_K]), vc = bf2f(uc[UA_V]);
                const float rp = first ? 0.f : bf2f(up[UA_R]), kp = first ? 0.f : bf2f(up[UA_K]), vp = first ? 0.f : bf2f(up[UA_V]);
                const float r = rc + (rp - rc) * mur, k = kc + (kp - kc) * muk, v = vc + (vp - vc) * muv;
                const float kkraw = k * kkc; const float ss = wave_sum(kkraw * kkraw); const float kk = kkraw / fmaxf(sqrtf(ss), 1e-12f);
                oR[o] = r; oW[o] = decay; oK[o] = k * (1.f + (a - 1.f) * kac); oV[o] = v; oA[o] = -kk; oB[o] = kk * a; } }
        __syncthreads();
    }
}
#endif

#ifndef CPU_TEST
__device__ __forceinline__ void ln1_router_coop(CtxRef C, int l, __attribute__((address_space(3))) unsigned char* lds) {
    int tid = threadIdx.x; asm volatile("" : "+v"(tid));
    const int lane = tid & 63, w = __builtin_amdgcn_readfirstlane(tid >> 6);
    float* X1 = C.out; bf16_t* xb = WSP(bf16_t, WS_XB);
    const float* g = INF(I_LN1G) + l * DM; const float* b = INF(I_LN1B) + l * DM;
    const float* wrg = INF(I_WRG) + (size_t)l * DM * NGRP; const float* brg = INF(I_BRG) + l * NGRP;
    const float* wre = INF(I_WRE) + (size_t)l * DM * NEXP; const float* bre = INF(I_BRE) + l * NEXP;
    unsigned* cnt = WSP(unsigned, WS_CTL) + CW_CNT + l * NEXP * 64;
    int* tokinfo = WSP(int, WS_TOKINFO); int* list = WSP(int, WS_LIST);
    __attribute__((address_space(3))) float* part = (__attribute__((address_space(3))) float*)lds;
    for (int tb0 = blockIdx.x * 128; tb0 < T; tb0 += gridDim.x * 128) {
        for (int i = 0; i < 16; ++i) { const int t = tb0 + w * 16 + i; float keep[DM / 64];
            ln_row(X1 + (size_t)t * DM, g, b, X1 + (size_t)t * DM, xb + (size_t)t * DM, lane, keep); }
        asm volatile("s_waitcnt vmcnt(0)" ::: "memory");
        __syncthreads();
        for (int half = 0; half < 2; ++half) {
            const int t = tb0 + half * 64 + lane;
            float acc[36];
#pragma unroll
            for (int j = 0; j < 36; ++j) acc[j] = 0.f;
            const float* xr = X1 + (size_t)t * DM + 128 * w;
#pragma unroll 1
            for (int k4 = 0; k4 < 32; ++k4) {
                const f4v x = *(const f4v*)(xr + 4 * k4);
#pragma unroll
                for (int kk = 0; kk < 4; ++kk) { const int k = 128 * w + 4 * k4 + kk;
                    typedef __attribute__((address_space(4))) const float cfl; cfl* we = (cfl*)(wre + (size_t)k * NEXP); cfl* wg = (cfl*)(wrg + (size_t)k * NGRP);
#pragma unroll
                    for (int j = 0; j < 4; ++j) acc[j] += x[kk] * wg[j];
#pragma unroll
                    for (int j = 0; j < 32; ++j) acc[4 + j] += x[kk] * we[j]; } }
#pragma unroll
            for (int j = 0; j < 36; ++j) part[(w * 36 + j) * 64 + lane] = acc[j];
            __syncthreads();
            if (w == 0) {
                float lg[NGRP], le[NEXP];
#pragma unroll
                for (int j = 0; j < NGRP; ++j) { float s = brg[j];
#pragma unroll
                    for (int ww = 0; ww < 8; ++ww) s += part[(ww * 36 + j) * 64 + lane]; lg[j] = s; }
#pragma unroll
                for (int j = 0; j < NEXP; ++j) { float s = bre[j];
#pragma unroll
                    for (int ww = 0; ww < 8; ++ww) s += part[(ww * 36 + 4 + j) * 64 + lane]; le[j] = s; }
                int gi = 0; float gm = lg[0];
#pragma unroll
                for (int j = 1; j < NGRP; ++j) if (lg[j] > gm) { gm = lg[j]; gi = j; }
                float gs = 0.f;
#pragma unroll
                for (int j = 0; j < NGRP; ++j) gs += expf(lg[j] - gm);
                const float group_p = 1.f / gs;
                float el[EPG];
#pragma unroll
                for (int j = 0; j < EPG; ++j) { float v = le[j];
#pragma unroll
                    for (int g2 = 1; g2 < NGRP; ++g2) v = (gi == g2) ? le[g2 * EPG + j] : v;
                    el[j] = v; }
                int e0 = 0; float m0 = el[0];
#pragma unroll
                for (int j = 1; j < EPG; ++j) if (el[j] > m0) { m0 = el[j]; e0 = j; }
                int e1 = -1; float m1 = -3.0e38f;
#pragma unroll
                for (int j = 0; j < EPG; ++j) if (j != e0 && el[j] > m1) { m1 = el[j]; e1 = j; }
                const float p1 = expf(m1 - m0); const float g0 = group_p / (1.f + p1), g1 = group_p * p1 / (1.f + p1);
                const int E0 = gi * EPG + e0, E1 = gi * EPG + e1;
                tokinfo[(size_t)t * 4 + 0] = E0; tokinfo[(size_t)t * 4 + 1] = E1;
                ((float*)tokinfo)[(size_t)t * 4 + 2] = g0; ((float*)tokinfo)[(size_t)t * 4 + 3] = g1;
                const unsigned s0 = atomicAdd(cnt + E0 * 64, 1u); list[(size_t)E0 * T + s0] = t * 2 + 0;
                const unsigned s1 = atomicAdd(cnt + E1 * 64, 1u); list[(size_t)E1 * T + s1] = t * 2 + 1;
            }
            __syncthreads();
        }
    }
}
#endif

#ifndef CPU_TEST
namespace pg8 {
#define PG8_LAS __attribute__((address_space(3)))
typedef short bf16x8 __attribute__((ext_vector_type(8)));
typedef float f32x4 __attribute__((ext_vector_type(4)));
constexpr int BM = 256, BK = 64, HALF = 128, HTB = HALF * BK * 2, STAGE_BYTES = 8 * HTB;
__device__ __forceinline__ int lds_byte(int r, int c) { const int st = (r >> 4) * 2 + (c >> 5), rr = r & 15, cc = c & 31, ob = rr * 64 + cc * 2; return st * 1024 + (ob ^ (((ob >> 9) & 1) << 5)); }
__device__ __forceinline__ void stage_rc(int b, int& R, int& C) { const int st = b / 1024, sb = b % 1024, swz = sb ^ (((sb >> 9) & 1) << 5); R = (st >> 1) * 16 + swz / 64; C = (st & 1) * 32 + (swz % 64) / 2; }
__device__ __forceinline__ int perm32(int rho) { const int n = rho >> 4, i = rho & 15; return 8 * (i >> 2) + 4 * n + (i & 3); }
struct Unit { int pm, pn; long aoff, boff; };
struct Gemm { const bf16_t* A; const bf16_t* Bt; int lda, ldb, K; };

template <class F> __device__ __forceinline__ void run_epi(const F& f, const f32x4 (&acc)[2][2][4][2], const Unit& u, int wr, int wc, int fr, int fq) {
#pragma unroll
    for (int ai = 0; ai < 2; ++ai)
#pragma unroll
        for (int m = 0; m < 4; ++m) { const int row = u.pm * BM + ai * HALF + wr * 64 + m * 16 + fr;
            if constexpr (F::MODE == 1) { const int hcol = u.pn * 128 + wc * 32 + 8 * fq; float g[8], up[8];
#pragma unroll
                for (int j = 0; j < 4; ++j) { g[j] = acc[ai][0][m][0][j]; g[4 + j] = acc[ai][0][m][1][j]; up[j] = acc[ai][1][m][0][j]; up[4 + j] = acc[ai][1][m][1][j]; }
                f.put8gu(row, hcol, g, up); }
            else if constexpr (F::PERM) {
#pragma unroll
                for (int bj = 0; bj < 2; ++bj) { const int col = u.pn * BM + bj * HALF + wc * 32 + 8 * fq; float a[8];
#pragma unroll
                    for (int j = 0; j < 4; ++j) { a[j] = acc[ai][bj][m][0][j]; a[4 + j] = acc[ai][bj][m][1][j]; }
                    f.put8(row, col, a); } }
            else {
#pragma unroll
                for (int bj = 0; bj < 2; ++bj)
#pragma unroll
                    for (int n = 0; n < 2; ++n) { const int col = u.pn * BM + bj * HALF + wc * 32 + 16 * n + 4 * fq; float a[4];
#pragma unroll
                        for (int j = 0; j < 4; ++j) a[j] = acc[ai][bj][m][n][j];
                        f.put4(row, col, a); } }
        }
}

template <class Epi, class Sched>
__device__ __forceinline__ void gemm_phase(PG8_LAS unsigned char* lds, const Gemm g, const Sched& S, const Epi& E) {
    int tid = threadIdx.x; asm volatile("" : "+v"(tid));
    const int wid = __builtin_amdgcn_readfirstlane(tid >> 6), lane = tid & 63, wr = wid >> 2, wc = wid & 3, fr = lane & 15, fq = lane >> 4;
    const int K = g.K, nt = K / BK;
    unsigned voffA[2], voffB[2];
#pragma unroll
    for (int i = 0; i < 2; ++i) { int R, C; stage_rc(tid * 16 + i * 8192, R, C); const int Rb = Epi::PERM ? ((R & ~31) + perm32(R & 31)) : R;
        voffA[i] = (unsigned)(R * g.lda + C) * 2u; voffB[i] = (unsigned)(Rb * g.ldb + C) * 2u; }
    const size_t kstep = (size_t)(BK * 2);
    const size_t hstepA = (size_t)HALF * g.lda * 2, hstepB = (size_t)HALF * g.ldb * 2;
    const unsigned ldsw = (unsigned)wid * 1024u;
    const int aoff = lds_byte(wr * 64 + fr, fq * 8), boff = lds_byte(wc * 32 + fr, fq * 8);
#define PG8_SA(b, h) (((b) * 2 + (h)) * HTB)
#define PG8_SB(b, h) ((4 + (b) * 2 + (h)) * HTB)
#define PG8_STAGE(bufoff, gbase, voff) do { _Pragma("unroll") for (int _i = 0; _i < 2; ++_i) \
        __builtin_amdgcn_global_load_lds((const unsigned*)((const char*)(gbase) + (voff)[_i]), (PG8_LAS unsigned*)(lds + (bufoff) + ldsw + _i * 8192), 16, 0, 0); } while (0)
#define PG8_LDA(dst, b, h) do { _Pragma("unroll") for (int m = 0; m < 4; ++m) _Pragma("unroll") for (int k = 0; k < 2; ++k) dst[m][k] = *(const PG8_LAS bf16x8*)(lds + PG8_SA(b, h) + aoff + m * 2048 + k * 1024); } while (0)
#define PG8_LDB(dst, b, h) do { _Pragma("unroll") for (int n = 0; n < 2; ++n) _Pragma("unroll") for (int k = 0; k < 2; ++k) dst[n][k] = *(const PG8_LAS bf16x8*)(lds + PG8_SB(b, h) + boff + n * 2048 + k * 1024); } while (0)
#define PG8_MMA(ai, bj, At, Bt) do { __builtin_amdgcn_s_setprio(1); _Pragma("unroll") for (int m = 0; m < 4; ++m) _Pragma("unroll") for (int n = 0; n < 2; ++n) _Pragma("unroll") for (int k = 0; k < 2; ++k) \
        acc[ai][bj][m][n] = __builtin_amdgcn_mfma_f32_16x16x32_bf16(Bt[n][k], At[m][k], acc[ai][bj][m][n], 0, 0, 0); __builtin_amdgcn_s_setprio(0); } while (0)
#define PG8_WAIT_V(n) asm volatile("s_waitcnt vmcnt(" #n ")" ::: "memory")
#define PG8_WAIT_L(n) asm volatile("s_waitcnt lgkmcnt(" #n ")" ::: "memory")
#define PG8_BAR __builtin_amdgcn_s_barrier()
#define PG8_SCHED __builtin_amdgcn_sched_barrier(0)
    Unit cur, nxt; int ui = 0;
    if (!S.next(0, cur)) return;
    f32x4 acc[2][2][4][2];
#pragma unroll
    for (int a = 0; a < 2; ++a)
#pragma unroll
        for (int b = 0; b < 2; ++b)
#pragma unroll
            for (int m = 0; m < 4; ++m)
#pragma unroll
                for (int n = 0; n < 2; ++n) acc[a][b][m][n] = (f32x4){0.f, 0.f, 0.f, 0.f};
    bf16x8 At[4][2], B0[2][2], B1[2][2];
    const char* cA = (const char*)g.A + cur.aoff; const char* cB = (const char*)g.Bt + cur.boff;
    PG8_STAGE(PG8_SB(0, 0), cB, voffB); PG8_STAGE(PG8_SA(0, 0), cA, voffA); PG8_STAGE(PG8_SB(0, 1), cB + hstepB, voffB); PG8_STAGE(PG8_SA(0, 1), cA + hstepA, voffA);
    if (wr == 1) PG8_BAR;
    PG8_WAIT_V(4); PG8_BAR;
    PG8_STAGE(PG8_SB(1, 0), cB + kstep, voffB); PG8_STAGE(PG8_SA(1, 0), cA + kstep, voffA); PG8_STAGE(PG8_SB(1, 1), cB + hstepB + kstep, voffB);
    PG8_WAIT_V(6); PG8_BAR;
    for (;;) {
        const bool has_next = S.next(ui + 1, nxt);
        const char* nA = has_next ? (const char*)g.A + nxt.aoff : cA; const char* nB = has_next ? (const char*)g.Bt + nxt.boff : cB;
_Pragma("unroll 1")
        for (int t = 0; t < nt; t += 2) {
            const bool last = (t == nt - 2);
            const char* a1 = cA + (size_t)(t + 1) * kstep;
            const char* a2 = last ? nA : cA + (size_t)(t + 2) * kstep; const char* b2 = last ? nB : cB + (size_t)(t + 2) * kstep;
            const char* a3 = a2 + kstep; const char* b3 = b2 + kstep;
            PG8_LDB(B0, 0, 0); PG8_SCHED; PG8_LDA(At, 0, 0); PG8_STAGE(PG8_SA(1, 1), a1 + hstepA, voffA);
            PG8_WAIT_L(8); PG8_BAR; PG8_WAIT_L(0); PG8_MMA(0, 0, At, B0); PG8_BAR; PG8_SCHED;
            PG8_LDB(B1, 0, 1); PG8_STAGE(PG8_SB(0, 0), b2, voffB);
            PG8_BAR; PG8_WAIT_L(0); PG8_MMA(0, 1, At, B1); PG8_BAR;
            PG8_LDA(At, 0, 1); PG8_STAGE(PG8_SA(0, 0), a2, voffA);
            PG8_BAR; PG8_WAIT_L(0); PG8_MMA(1, 0, At, B0); PG8_BAR; PG8_SCHED;
            PG8_STAGE(PG8_SB(0, 1), b2 + hstepB, voffB);
            PG8_WAIT_V(6); PG8_BAR; PG8_MMA(1, 1, At, B1); PG8_BAR;
            PG8_LDB(B0, 1, 0); PG8_SCHED; PG8_LDA(At, 1, 0); PG8_STAGE(PG8_SA(0, 1), a2 + hstepA, voffA);
            PG8_WAIT_L(8); PG8_BAR; PG8_WAIT_L(0); PG8_MMA(0, 0, At, B0); PG8_BAR; PG8_SCHED;
            PG8_LDB(B1, 1, 1); PG8_STAGE(PG8_SB(1, 0), b3, voffB);
            PG8_BAR; PG8_WAIT_L(0); PG8_MMA(0, 1, At, B1); PG8_BAR;
            PG8_LDA(At, 1, 1); PG8_STAGE(PG8_SA(1, 0), a3, voffA);
            PG8_BAR; PG8_WAIT_L(0); PG8_MMA(1, 0, At, B0); PG8_BAR; PG8_SCHED;
            PG8_STAGE(PG8_SB(1, 1), b3 + hstepB, voffB);
            PG8_WAIT_V(6); PG8_BAR; PG8_MMA(1, 1, At, B1); PG8_BAR;
        }
        run_epi(E, acc, cur, wr, wc, fr, fq);
        if (!has_next) break;
#pragma unroll
        for (int a = 0; a < 2; ++a)
#pragma unroll
            for (int b = 0; b < 2; ++b)
#pragma unroll
                for (int m = 0; m < 4; ++m)
#pragma unroll
                    for (int n = 0; n < 2; ++n) acc[a][b][m][n] = (f32x4){0.f, 0.f, 0.f, 0.f};
        cur = nxt; cA = nA; cB = nB; ++ui;
    }
    PG8_WAIT_V(0);
    if (wr == 0) PG8_BAR;
    PG8_BAR;
#undef PG8_SA
#undef PG8_SB
#undef PG8_STAGE
#undef PG8_LDA
#undef PG8_LDB
#undef PG8_MMA
#undef PG8_WAIT_V
#undef PG8_WAIT_L
#undef PG8_BAR
#undef PG8_SCHED
}
struct DenseOrder {
    int nM, nN, G, c; long astep, bstep;
    __device__ __forceinline__ bool next(int i, Unit& u) const {
        const long L = (long)i * G + c; if (L >= (long)nM * nN) return false;
        const int w = (int)L; const int nig = 8 * nN, gid = w / nig, fm = gid * 8, gsz = (nM - fm) < 8 ? (nM - fm) : 8;
        u.pm = fm + ((w % nig) % gsz); u.pn = (w % nig) / gsz; u.aoff = (long)u.pm * astep; u.boff = (long)u.pn * bstep; return true; }
};
struct MoeOrder {
    const PG8_LAS int* tbl; int nM, nN, G, c; long astep, bstep, estep;
    __device__ __forceinline__ bool next(int i, Unit& u) const {
        const long L = (long)i * G + c; if (L >= (long)nM * nN) return false;
        const int w = (int)L; u.pm = w / nN; u.pn = w % nN; const int e = tbl[u.pm];
        u.aoff = (long)u.pm * astep; u.boff = (long)e * estep + (long)u.pn * bstep; return true; }
};
}
#endif

#ifndef CPU_TEST
namespace att {
typedef short bf16x8 __attribute__((ext_vector_type(8)));
typedef short s16x4 __attribute__((ext_vector_type(4)));
typedef float f32x16 __attribute__((ext_vector_type(16)));
typedef float f32x2_t __attribute__((ext_vector_type(2))); typedef __bf16 bf16x2_t __attribute__((ext_vector_type(2)));
typedef unsigned u32x4 __attribute__((ext_vector_type(4)));
typedef unsigned u32x2 __attribute__((ext_vector_type(2)));
#define ATT_LAS __attribute__((address_space(3)))
#define BAR_LDS() asm volatile("s_waitcnt lgkmcnt(0)\n\ts_barrier" ::: "memory")
constexpr int KP = 104, VP = 68;
constexpr int KBUF = 64 * KP * 2, VBUF = 64 * VP * 2;
constexpr int LDS_NEED = 2 * KBUF + 2 * VBUF;
__device__ __forceinline__ unsigned cvtpk(float lo, float hi) { f32x2_t v = {lo, hi}; bf16x2_t b = __builtin_convertvector(v, bf16x2_t); return __builtin_bit_cast(unsigned, b); }
__device__ __forceinline__ int crow(int r, int hi) { return (r & 3) + 8 * (r >> 2) + 4 * hi; }
__device__ __forceinline__ u32x4 scale8(const u32x4& w, float s) { u32x4 o;
#pragma unroll
    for (int j = 0; j < 4; ++j) o[j] = cvtpk(__builtin_bit_cast(float, w[j] << 16) * s, __builtin_bit_cast(float, w[j] & 0xffff0000u) * s);
    return o; }
__device__ __forceinline__ void unit(ATT_LAS unsigned char* lds, const bf16_t* Q, const bf16_t* K, const bf16_t* V, const float* rstd, bf16_t* mix, int b, int h, int qb) {
    int tid = threadIdx.x; asm volatile("" : "+v"(tid));
    const int lane = tid & 63, w = __builtin_amdgcn_readfirstlane(tid >> 6), r32 = lane & 31, hi = lane >> 5;
    const size_t tb = (size_t)b * SEQ;
    const int q = qb * 256 + w * 32 + r32;
    bf16x8 qr[6];
    { const bf16_t* qrow = Q + (tb + q) * 384 + h * 96 + 8 * hi;
      const float rq = rstd[(tb + q) * 2];
#pragma unroll
      for (int ks = 0; ks < 6; ++ks) qr[ks] = __builtin_bit_cast(bf16x8, scale8(*(const u32x4*)(qrow + 16 * ks), rq)); }
    f32x16 o0, o1;
#pragma unroll
    for (int r = 0; r < 16; ++r) { o0[r] = 0.f; o1[r] = 0.f; }
    float m = -1e30f, lsum = 0.f;
    const int NT = 4 * (qb + 1);
    const int kr0 = tid / 12, kp0 = tid % 12, kr1 = (tid + 512) / 12, kp1 = (tid + 512) % 12; const bool has1 = tid < 256;
    const int vk = tid >> 3, vp = tid & 7;
    const bf16_t* gK0 = K + (tb + kr0) * 384 + h * 96 + kp0 * 8; const bf16_t* gK1 = K + (tb + kr1) * 384 + h * 96 + kp1 * 8;
    const bf16_t* gV = V + (tb + vk) * 256 + h * 64 + vp * 8;
    u32x4 sk0, sk1, sv; sk1 = (u32x4){0u, 0u, 0u, 0u};
    const float* gR0 = rstd + (tb + kr0) * 2 + 1; const float* gR1 = rstd + (tb + kr1) * 2 + 1; const float* gRv = rstd + (tb + vk) * 2 + 1;
    float s0 = gR0[0], s1 = has1 ? gR1[0] : 0.f, s2 = gRv[0];
    sk0 = *(const u32x4*)gK0; if (has1) sk1 = *(const u32x4*)gK1; sv = *(const u32x4*)gV;
#define ATT_WRITE(buf) do { \
        if (kp0 < 8) sk0 = scale8(sk0, s0); if (kp1 < 8) sk1 = scale8(sk1, s1); sv = scale8(sv, s2); \
        *(ATT_LAS u32x4*)(lds + (buf) * KBUF + (kr0 * KP + kp0 * 8) * 2) = sk0; \
        if (has1) *(ATT_LAS u32x4*)(lds + (buf) * KBUF + (kr1 * KP + kp1 * 8) * 2) = sk1; \
        ATT_LAS unsigned short* vt_ = (ATT_LAS unsigned short*)(lds + 2 * KBUF + (buf) * VBUF); \
        _Pragma("unroll") for (int j = 0; j < 4; ++j) { vt_[(8 * vp + 2 * j) * VP + vk] = (unsigned short)(sv[j] & 0xffffu); vt_[(8 * vp + 2 * j + 1) * VP + vk] = (unsigned short)(sv[j] >> 16); } } while (0)
    ATT_WRITE(0);
    BAR_LDS();
    for (int t = 0; t < NT; ++t) {
        const int buf = t & 1;
        if (t + 1 < NT) { const size_t adv = (size_t)(t + 1) * 64; sk0 = *(const u32x4*)(gK0 + adv * 384); if (has1) sk1 = *(const u32x4*)(gK1 + adv * 384); sv = *(const u32x4*)(gV + adv * 256);
            s0 = gR0[adv * 2]; if (has1) s1 = gR1[adv * 2]; s2 = gRv[adv * 2]; }
        f32x16 p0, p1;
#pragma unroll
        for (int r = 0; r < 16; ++r) { p0[r] = 0.f; p1[r] = 0.f; }
        { ATT_LAS const unsigned char* kb = lds + buf * KBUF + (r32 * KP + 8 * hi) * 2;
#pragma unroll
          for (int ks = 0; ks < 6; ++ks) { const bf16x8 a0 = *(ATT_LAS const bf16x8*)(kb + ks * 32), a1 = *(ATT_LAS const bf16x8*)(kb + 32 * KP * 2 + ks * 32);
              p0 = __builtin_amdgcn_mfma_f32_32x32x16_bf16(a0, qr[ks], p0, 0, 0, 0); p1 = __builtin_amdgcn_mfma_f32_32x32x16_bf16(a1, qr[ks], p1, 0, 0, 0); } }
        if (t >= NT - 4) {
            const int k0 = t * 64;
#pragma unroll
            for (int r = 0; r < 16; ++r) { const int kk = k0 + crow(r, hi); if (kk > q) p0[r] = -1e30f; if (kk + 32 > q) p1[r] = -1e30f; } }
        float rm = p0[0];
#pragma unroll
        for (int r = 1; r < 16; ++r) rm = fmaxf(rm, p0[r]);
#pragma unroll
        for (int r = 0; r < 16; ++r) rm = fmaxf(rm, p1[r]);
        rm = fmaxf(rm, __shfl_xor(rm, 32));
        const float mn = fmaxf(m, rm); const float alpha = __builtin_amdgcn_exp2f(m - mn); m = mn;
        float ps = 0.f;
#pragma unroll
        for (int r = 0; r < 16; ++r) { p0[r] = __builtin_amdgcn_exp2f(p0[r] - mn); p1[r] = __builtin_amdgcn_exp2f(p1[r] - mn); ps += p0[r] + p1[r]; }
        lsum = lsum * alpha + ps;
#pragma unroll
        for (int r = 0; r < 16; ++r) { o0[r] *= alpha; o1[r] *= alpha; }
        { ATT_LAS const unsigned char* vb = lds + 2 * KBUF + buf * VBUF + (r32 * VP + 4 * hi) * 2;
#pragma unroll
          for (int s = 0; s < 4; ++s) {
              u32x4 pw;
              if (s == 0) pw = (u32x4){cvtpk(p0[0], p0[1]), cvtpk(p0[2], p0[3]), cvtpk(p0[4], p0[5]), cvtpk(p0[6], p0[7])};
              else if (s == 1) pw = (u32x4){cvtpk(p0[8], p0[9]), cvtpk(p0[10], p0[11]), cvtpk(p0[12], p0[13]), cvtpk(p0[14], p0[15])};
              else if (s == 2) pw = (u32x4){cvtpk(p1[0], p1[1]), cvtpk(p1[2], p1[3]), cvtpk(p1[4], p1[5]), cvtpk(p1[6], p1[7])};
              else pw = (u32x4){cvtpk(p1[8], p1[9]), cvtpk(p1[10], p1[11]), cvtpk(p1[12], p1[13]), cvtpk(p1[14], p1[15])};
              const bf16x8 pb = __builtin_bit_cast(bf16x8, pw);
              const u32x2 a00 = *(ATT_LAS const u32x2*)(vb + s * 32), a01 = *(ATT_LAS const u32x2*)(vb + s * 32 + 16);
              const u32x2 a10 = *(ATT_LAS const u32x2*)(vb + 32 * VP * 2 + s * 32), a11 = *(ATT_LAS const u32x2*)(vb + 32 * VP * 2 + s * 32 + 16);
              const bf16x8 va0 = __builtin_bit_cast(bf16x8, (u32x4){a00[0], a00[1], a01[0], a01[1]}), va1 = __builtin_bit_cast(bf16x8, (u32x4){a10[0], a10[1], a11[0], a11[1]});
              o0 = __builtin_amdgcn_mfma_f32_32x32x16_bf16(va0, pb, o0, 0, 0, 0); o1 = __builtin_amdgcn_mfma_f32_32x32x16_bf16(va1, pb, o1, 0, 0, 0); } }
        if (t + 1 < NT) ATT_WRITE(buf ^ 1);
        BAR_LDS();
    }
#undef ATT_WRITE
    lsum += __shfl_xor(lsum, 32);
    const float inv = 1.f / lsum;
    bf16_t* orow = mix + (tb + q) * DMIX + 768 + h * 64;
#pragma unroll
    for (int rg = 0; rg < 4; ++rg) {
        u32x2 w0 = {cvtpk(o0[4 * rg] * inv, o0[4 * rg + 1] * inv), cvtpk(o0[4 * rg + 2] * inv, o0[4 * rg + 3] * inv)};
        u32x2 w1 = {cvtpk(o1[4 * rg] * inv, o1[4 * rg + 1] * inv), cvtpk(o1[4 * rg + 2] * inv, o1[4 * rg + 3] * inv)};
        *(u32x2*)(orow + 8 * rg + 4 * hi) = w0; *(u32x2*)(orow + 32 + 8 * rg + 4 * hi) = w1; }
}
}
#endif

#ifndef CPU_TEST
namespace lin {
using att::bf16x8; using att::f32x16; using att::u32x4; using att::u32x2; using att::cvtpk; using att::crow;
constexpr int PT = 68;
template <int DK, int NDV> struct Lay {
    static constexpr int PQ = DK + 8;
    static constexpr int OFF_Q = 0, OFF_K = OFF_Q + 64 * PQ * 2, OFF_KH = OFF_K + 64 * PQ * 2, OFF_VT = OFF_KH + DK * PT * 2, OFF_DEC = OFF_VT + NDV * PT * 2, BUF = OFF_DEC + 256;
};
__device__ __forceinline__ bf16x8 ldA16(ATT_LAS const unsigned char* p) { return *(ATT_LAS const bf16x8*)p; }
__device__ __forceinline__ bf16x8 ldP8(ATT_LAS const unsigned char* p) { const u32x2 a = *(ATT_LAS const u32x2*)p, b = *(ATT_LAS const u32x2*)(p + 16); return __builtin_bit_cast(bf16x8, (u32x4){a[0], a[1], b[0], b[1]}); }
__device__ __forceinline__ bf16x8 pack8(const f32x16& x, int s) {
    u32x4 p;
    if (s == 0) p = (u32x4){cvtpk(x[0], x[1]), cvtpk(x[2], x[3]), cvtpk(x[4], x[5]), cvtpk(x[6], x[7])};
    else p = (u32x4){cvtpk(x[8], x[9]), cvtpk(x[10], x[11]), cvtpk(x[12], x[13]), cvtpk(x[14], x[15])};
    return __builtin_bit_cast(bf16x8, p); }
#define MF32(a, b, c) __builtin_amdgcn_mfma_f32_32x32x16_bf16((a), (b), (c), 0, 0, 0)
template <int DK, int NDV> __device__ __forceinline__ void compute(ATT_LAS const unsigned char* B, int ib, int dvb, int r32, int hi, f32x16 (&H)[DK / 32], f32x16& O) {
    typedef Lay<DK, NDV> L;
    f32x16 X[2];
#pragma unroll
    for (int r = 0; r < 16; ++r) { X[0][r] = 0.f; X[1][r] = 0.f; O[r] = 0.f; }
#pragma unroll
    for (int jb = 0; jb < 2; ++jb) if (jb <= ib) {
#pragma unroll
        for (int s = 0; s < DK / 16; ++s)
            X[jb] = MF32(ldA16(B + L::OFF_K + ((32 * jb + r32) * L::PQ + 16 * s + 8 * hi) * 2), ldA16(B + L::OFF_Q + ((32 * ib + r32) * L::PQ + 16 * s + 8 * hi) * 2), X[jb]);
        if (jb == ib) {
#pragma unroll
            for (int r = 0; r < 16; ++r) if (crow(r, hi) > r32) X[jb][r] = 0.f; } }
    bf16x8 vf[2][2];
#pragma unroll
    for (int jb = 0; jb < 2; ++jb)
#pragma unroll
        for (int s = 0; s < 2; ++s) vf[jb][s] = ldP8(B + L::OFF_VT + ((32 * dvb + r32) * PT + 32 * jb + 16 * s + 4 * hi) * 2);
#pragma unroll
    for (int jb = 0; jb < 2; ++jb) if (jb <= ib) {
#pragma unroll
        for (int s = 0; s < 2; ++s) O = MF32(pack8(X[jb], s), vf[jb][s], O); }
#pragma unroll
    for (int db = 0; db < DK / 32; ++db)
#pragma unroll
        for (int s = 0; s < 2; ++s) O = MF32(ldP8(B + L::OFF_Q + ((32 * ib + r32) * L::PQ + 32 * db + 16 * s + 4 * hi) * 2), pack8(H[db], s), O);
#pragma unroll
    for (int db = 0; db < DK / 32; ++db) {
        ATT_LAS const float* dec = (ATT_LAS const float*)(B + L::OFF_DEC);
#pragma unroll
        for (int r = 0; r < 16; ++r) H[db][r] *= dec[32 * db + crow(r, hi)];
#pragma unroll
        for (int jb = 0; jb < 2; ++jb)
#pragma unroll
            for (int s = 0; s < 2; ++s) H[db] = MF32(ldP8(B + L::OFF_KH + ((32 * db + r32) * PT + 32 * jb + 16 * s + 4 * hi) * 2), vf[jb][s], H[db]); }
}
__device__ __forceinline__ float scan64(float v, int lane) {
#pragma unroll
    for (int o = 1; o < 64; o <<= 1) { const float t = __shfl_up(v, o); if (lane >= o) v += t; }
    return v; }
__device__ __forceinline__ float bfl(unsigned w) { return __builtin_bit_cast(float, w << 16); }
__device__ __forceinline__ float bfh(unsigned w) { return __builtin_bit_cast(float, w & 0xffff0000u); }
__device__ __forceinline__ void vt_write(ATT_LAS unsigned char* B, int off_vt, int tok, int part, const u32x4& sv) {
    ATT_LAS unsigned short* vt = (ATT_LAS unsigned short*)(B + off_vt);
#pragma unroll
    for (int j = 0; j < 4; ++j) { vt[(8 * part + 2 * j) * PT + tok] = (unsigned short)(sv[j] & 0xffffu); vt[(8 * part + 2 * j + 1) * PT + tok] = (unsigned short)(sv[j] >> 16); } }

__device__ __forceinline__ void gla_run(ATT_LAS unsigned char* lds, CtxRef C, int l, int b, int h) {
    typedef Lay<32, 64> L;
    int tid = threadIdx.x; asm volatile("" : "+v"(tid));
    const int lane = tid & 63, w = __builtin_amdgcn_readfirstlane(tid >> 6), r32 = lane & 31, hi = lane >> 5;
    const bf16_t* u = WSP(bf16_t, WS_U); float* Y = WSP(float, WS_YB);
    const float* aup = INF(I_GLA_UP) + l * 16 * 128 + h * 32 + 4 * w; const float* ab = INF(I_GLA_B) + l * 128 + h * 32 + 4 * w;
    const size_t tb = (size_t)b * SEQ;
    f32x16 H[1], O;
#pragma unroll
    for (int r = 0; r < 16; ++r) H[0][r] = 0.f;
    const int ib = w >> 1, dvb = w & 1;
    const int vtok = tid >> 3, vpart = tid & 7;
    u32x4 pa0, pa1, pv; u32x2 pq, pk;
#define GLA_FETCH(c) do { const size_t t_ = tb + (size_t)(c) * 64 + lane; const bf16_t* ur = u + t_ * DINP; \
        pa0 = *(const u32x4*)(ur + UB_AD); pa1 = *(const u32x4*)(ur + UB_AD + 8); pq = *(const u32x2*)(ur + UB_Q + h * 32 + 4 * w); pk = *(const u32x2*)(ur + UB_K + h * 32 + 4 * w); \
        pv = *(const u32x4*)(u + (tb + (size_t)(c) * 64 + vtok) * DINP + UB_V + h * 64 + vpart * 8); } while (0)
#define GLA_PREP(buf) do { ATT_LAS unsigned char* B_ = lds + (buf) * L::BUF; \
        float adv[16]; _Pragma("unroll") for (int j = 0; j < 4; ++j) { adv[2 * j] = bfl(pa0[j]); adv[2 * j + 1] = bfh(pa0[j]); adv[8 + 2 * j] = bfl(pa1[j]); adv[9 + 2 * j] = bfh(pa1[j]); } \
        const float qv[4] = {bfl(pq[0]), bfh(pq[0]), bfl(pq[1]), bfh(pq[1])}, kv[4] = {bfl(pk[0]), bfh(pk[0]), bfl(pk[1]), bfh(pk[1])}; \
        float qo[4], ko[4]; \
        _Pragma("unroll") for (int d = 0; d < 4; ++d) { float z = ab[d]; _Pragma("unroll") for (int j = 0; j < 16; ++j) z += adv[j] * aup[j * 128 + d]; \
            const float la = -softplusf_(-z) * (1.f / 16.f); const float bc = scan64(la, lane); const float be = __shfl(bc, 63); \
            qo[d] = qv[d] * __expf(bc) * 0.17677669529663687f; ko[d] = kv[d] * __expf(-bc); const float kh = kv[d] * __expf(be - bc); \
            ((ATT_LAS unsigned short*)(B_ + L::OFF_KH))[(4 * w + d) * PT + lane] = f2bf(kh); \
            if (lane == 63) ((ATT_LAS float*)(B_ + L::OFF_DEC))[4 * w + d] = __expf(be); } \
        *(ATT_LAS u32x2*)(B_ + L::OFF_Q + (lane * L::PQ + 4 * w) * 2) = (u32x2){cvtpk(qo[0], qo[1]), cvtpk(qo[2], qo[3])}; \
        *(ATT_LAS u32x2*)(B_ + L::OFF_K + (lane * L::PQ + 4 * w) * 2) = (u32x2){cvtpk(ko[0], ko[1]), cvtpk(ko[2], ko[3])}; \
        vt_write(B_, L::OFF_VT, vtok, vpart, pv); } while (0)
    constexpr int NC = SEQ / 64;
    GLA_FETCH(0); GLA_PREP(0); GLA_FETCH(1);
    BAR_LDS();
    for (int c = 0; c < NC; ++c) {
        if (c + 1 < NC) { GLA_PREP((c + 1) & 1); if (c + 2 < NC) GLA_FETCH(c + 2); }
        if (w < 4) {
            compute<32, 64>(lds + (c & 1) * L::BUF, ib, dvb, r32, hi, H, O);
            float* yo = Y + (tb + (size_t)c * 64 + 32 * ib) * GW + h * 64 + 32 * dvb + r32;
#pragma unroll
            for (int r = 0; r < 16; ++r) yo[(size_t)crow(r, hi) * GW] = O[r]; }
        BAR_LDS();
    }
#undef GLA_FETCH
#undef GLA_PREP
}
__device__ __forceinline__ void mlstm_run(ATT_LAS unsigned char* lds, CtxRef C, int l, int b, int h) {
    typedef Lay<64, 96> L;
    int tid = threadIdx.x; asm volatile("" : "+v"(tid));
    const int lane = tid & 63, w = __builtin_amdgcn_readfirstlane(tid >> 6), r32 = lane & 31, hi = lane >> 5;
    const bf16_t* u = WSP(bf16_t, WS_U); float* Y = WSP(float, WS_YC); float* DEN = WSP(float, WS_DEN);
    const float* cw = INF(I_CONVW) + l * 4 * 512 + h * 64 + 8 * w; const float* cb = INF(I_CONVB) + l * 512 + h * 64 + 8 * w;
    const float ibias = INF(I_IB)[l * 4 + h], fbias = INF(I_FB)[l * 4 + h];
    const size_t tb = (size_t)b * SEQ;
    f32x16 H[2], O;
#pragma unroll
    for (int r = 0; r < 16; ++r) { H[0][r] = 0.f; H[1][r] = 0.f; }
    const int ib = w / 3, dvb = w % 3;
    const int vtok = tid >> 3, vpart = tid & 7;
    for (int i = tid; i < 32 * PT; i += 512) { const unsigned short v = (i < PT) ? (unsigned short)0x3f80 : (unsigned short)0;
        ((ATT_LAS unsigned short*)(lds + L::OFF_VT))[64 * PT + i] = v; ((ATT_LAS unsigned short*)(lds + L::BUF + L::OFF_VT))[64 * PT + i] = v; }
    u32x4 xq[4], xk[4], pg, pv;
#define ML_FETCH(c) do { const int s_ = (c) * 64 + lane; const bf16_t* ur = u + (tb + s_) * DINP; \
        _Pragma("unroll") for (int j = 0; j < 4; ++j) { const bool ok = s_ - 3 + j >= 0; const bf16_t* up = ur + (ptrdiff_t)(j - 3) * DINP; \
            xq[j] = ok ? *(const u32x4*)(up + UC_Q + h * 64 + 8 * w) : (u32x4){0u, 0u, 0u, 0u}; xk[j] = ok ? *(const u32x4*)(up + UC_K + h * 64 + 8 * w) : (u32x4){0u, 0u, 0u, 0u}; } \
        pg = *(const u32x4*)(ur + UC_IG); pv = *(const u32x4*)(u + (tb + (size_t)(c) * 64 + vtok) * DINP + UC_V + h * 64 + vpart * 8); } while (0)
#define ML_PREP(buf) do { ATT_LAS unsigned char* B_ = lds + (buf) * L::BUF; \
        const unsigned gi_ = pg[h >> 1], gf_ = pg[2 + (h >> 1)]; const float ig = ((h & 1) ? bfh(gi_) : bfl(gi_)) + ibias; const float lf = -softplusf_(-(((h & 1) ? bfh(gf_) : bfl(gf_)) + fbias)); \
        const float F = scan64(lf, lane); const float Fe = __shfl(F, 63); const float eF = __expf(F), wk = __expf(ig - F) * 0.125f, wkh = __expf(Fe - F + ig) * 0.125f; \
        float qo[8], ko[8]; \
        _Pragma("unroll") for (int ch = 0; ch < 8; ++ch) { float yq = cb[ch], yk = cb[256 + ch]; \
            _Pragma("unroll") for (int j = 0; j < 4; ++j) { const unsigned wq_ = xq[j][ch >> 1], wk_ = xk[j][ch >> 1]; \
                yq += cw[j * 512 + ch] * ((ch & 1) ? bfh(wq_) : bfl(wq_)); yk += cw[j * 512 + 256 + ch] * ((ch & 1) ? bfh(wk_) : bfl(wk_)); } \
            const float sq = siluf_(yq), sk = siluf_(yk); qo[ch] = sq * eF; ko[ch] = sk * wk; \
            ((ATT_LAS unsigned short*)(B_ + L::OFF_KH))[(8 * w + ch) * PT + lane] = f2bf(sk * wkh); } \
        *(ATT_LAS u32x4*)(B_ + L::OFF_Q + (lane * L::PQ + 8 * w) * 2) = (u32x4){cvtpk(qo[0], qo[1]), cvtpk(qo[2], qo[3]), cvtpk(qo[4], qo[5]), cvtpk(qo[6], qo[7])}; \
        *(ATT_LAS u32x4*)(B_ + L::OFF_K + (lane * L::PQ + 8 * w) * 2) = (u32x4){cvtpk(ko[0], ko[1]), cvtpk(ko[2], ko[3]), cvtpk(ko[4], ko[5]), cvtpk(ko[6], ko[7])}; \
        if (w == 0) ((ATT_LAS float*)(B_ + L::OFF_DEC))[lane] = __expf(Fe); \
        vt_write(B_, L::OFF_VT, vtok, vpart, pv); } while (0)
    constexpr int NC = SEQ / 64;
    ML_FETCH(0); ML_PREP(0); ML_FETCH(1);
    BAR_LDS();
    for (int c = 0; c < NC; ++c) {
        if (c + 1 < NC) { ML_PREP((c + 1) & 1); if (c + 2 < NC) ML_FETCH(c + 2); }
        if (w < 6) {
            compute<64, 96>(lds + (c & 1) * L::BUF, ib, dvb, r32, hi, H, O);
            const size_t t0 = tb + (size_t)c * 64 + 32 * ib;
            if (dvb < 2) { float* yo = Y + t0 * GW + h * 64 + 32 * dvb + r32;
#pragma unroll
                for (int r = 0; r < 16; ++r) yo[(size_t)crow(r, hi) * GW] = O[r]; }
            else if (r32 == 0) {
#pragma unroll
                for (int r = 0; r < 16; ++r) DEN[(t0 + crow(r, hi)) * 4 + h] = O[r]; } }
        BAR_LDS();
    }
#undef ML_FETCH
#undef ML_PREP
}
#undef MF32
}
#endif

#ifndef CPU_TEST
namespace rwk {
constexpr int NB = 16;
constexpr int VEC = 6 * 64;
constexpr int BUFB = NB * VEC * 4;
__device__ __forceinline__ float dpp_add(float v, int ctrl_sel) {
    int x = __builtin_bit_cast(int, v), y;
    if (ctrl_sel == 0) y = __builtin_amdgcn_update_dpp(0, x, 0xB1, 0xF, 0xF, true);
    else if (ctrl_sel == 1) y = __builtin_amdgcn_update_dpp(0, x, 0x4E, 0xF, 0xF, true);
    else if (ctrl_sel == 2) y = __builtin_amdgcn_update_dpp(0, x, 0x141, 0xF, 0xF, true);
    else y = __builtin_amdgcn_update_dpp(0, x, 0x140, 0xF, 0xF, true);
    return v + __builtin_bit_cast(float, y); }
__device__ __forceinline__ float red16(float v) { v = dpp_add(v, 0); v = dpp_add(v, 1); v = dpp_add(v, 2); v = dpp_add(v, 3); return v; }
__device__ __forceinline__ void run(ATT_LAS unsigned char* lds, CtxRef C, int b, int h, int rg) {
    int tid = threadIdx.x; asm volatile("" : "+v"(tid));
    const int lane = tid & 63, w = __builtin_amdgcn_readfirstlane(tid >> 6);
    const float* src[6] = {WSP(float, WS_RW_A), WSP(float, WS_RW_W), WSP(float, WS_RW_B), WSP(float, WS_RW_K), WSP(float, WS_RW_R), WSP(float, WS_RW_V)};
    float* Y = WSP(float, WS_YA);
    const size_t tb = (size_t)b * SEQ;
    const int lt = tid - 256;
#define RW_LOAD(batch, buf) do { _Pragma("unroll") for (int i = 0; i < 6; ++i) { const int p = lt + 256 * i; const int st = p / 96, vc = (p % 96) >> 4, pt = p & 15; \
        const float* sp = (vc == 0 ? src[0] : vc == 1 ? src[1] : vc == 2 ? src[2] : vc == 3 ? src[3] : vc == 4 ? src[4] : src[5]); \
        const f4v v4 = *(const f4v*)(sp + (tb + (size_t)(batch) * NB + st) * GW + h * 64 + pt * 4); \
        *(ATT_LAS f4v*)(lds + (buf) * BUFB + (st * VEC + vc * 64 + pt * 4) * 4) = v4; } } while (0)
    constexpr int NBATCH = SEQ / NB;
    if (w >= 4) RW_LOAD(0, 0);
    BAR_LDS();
    const int row = 16 * rg + 4 * w + (lane >> 4), cg = lane & 15;
    float S0 = 0.f, S1 = 0.f, S2 = 0.f, S3 = 0.f;
    for (int bt = 0; bt < NBATCH; ++bt) {
        if (w >= 4) { if (bt + 1 < NBATCH) RW_LOAD(bt + 1, (bt + 1) & 1); }
        else {
            ATT_LAS const float* B = (ATT_LAS const float*)(lds + (bt & 1) * BUFB);
#pragma unroll 4
            for (int st = 0; st < NB; ++st) {
                ATT_LAS const float* P = B + st * VEC;
                const f4v a = *(ATT_LAS const f4v*)(P + 4 * cg), wv = *(ATT_LAS const f4v*)(P + 64 + 4 * cg), bb = *(ATT_LAS const f4v*)(P + 128 + 4 * cg),
                          kk = *(ATT_LAS const f4v*)(P + 192 + 4 * cg), r = *(ATT_LAS const f4v*)(P + 256 + 4 * cg);
                const float vv = P[320 + row];
                const float sa = red16((S0 * a[0] + S1 * a[1]) + (S2 * a[2] + S3 * a[3]));
                S0 = S0 * wv[0] + (sa * bb[0] + vv * kk[0]); S1 = S1 * wv[1] + (sa * bb[1] + vv * kk[1]);
                S2 = S2 * wv[2] + (sa * bb[2] + vv * kk[2]); S3 = S3 * wv[3] + (sa * bb[3] + vv * kk[3]);
                const float y = red16((S0 * r[0] + S1 * r[1]) + (S2 * r[2] + S3 * r[3]));
                if (cg == 0) Y[(tb + (size_t)bt * NB + st) * GW + h * 64 + row] = y;
            }
        }
        BAR_LDS();
    }
#undef RW_LOAD
}
}
#endif

#ifndef CPU_TEST
namespace rw7 {
using att::bf16x8; using att::f32x16; using att::u32x4; using att::u32x2; using att::cvtpk; using att::crow;
using lin::ldA16; using lin::ldP8; using lin::pack8; using lin::scan64; using lin::bfl; using lin::bfh;
#define MF32(a, b, c) __builtin_amdgcn_mfma_f32_32x32x16_bf16((a), (b), (c), 0, 0, 0)
constexpr int PA = 136, PZ = 68, PW = 40, PG_ = 72;
constexpr int X_WUP = 0, X_AUP = 5120, X_GUP = 10240, X_ACT = 19456;
constexpr int O_ZB = 71680, O_ZAB = 89088, O_RED = 106496;
constexpr int I_AT = 0, I_RT = 9216, I_BT = 18432, I_KT = 27648, I_ATT = 36864, I_BTT = 45568, I_KTT = 54272, I_VT = 62976;
constexpr int O_TIMG = O_ZAB, O_L21 = O_ZAB + 9216, O_T11T = O_ZAB + 11776, O_EX = 110592, O_GC = 126976;
static_assert(I_VT + 64 * 68 * 2 <= O_ZB && O_T11T + 2560 <= O_RED && O_RED + 4096 <= O_EX && O_EX + 16384 <= O_GC && O_GC + 256 <= 131072, "rw7 LDS map");
__device__ __forceinline__ void stage1_unit(ATT_LAS unsigned char* lds, CtxRef C, int l, int b, int h, int ch) {
    const int unit = (b * 4 + h) * (SEQ / 64) + ch;
    int tid = threadIdx.x; asm volatile("" : "+v"(tid));
    const int lane = tid & 63, w = __builtin_amdgcn_readfirstlane(tid >> 6), r32 = lane & 31, hi = lane >> 5;
    const bf16_t* u = WSP(bf16_t, WS_U); const float* mu = INF(I_MU) + l * DINA;
    const size_t t0 = (size_t)b * SEQ + (size_t)ch * 64;
    const bool seq0 = (ch == 0);
    const int atok = tid >> 3, apart = tid & 7;
    u32x4 lc0, lc1, lp0, lp1;
    { const bf16_t* p = u + (t0 + atok) * DINP + UA_WD + 16 * apart; lc0 = *(const u32x4*)p; lc1 = *(const u32x4*)(p + 8);
      if (seq0 && atok == 0) { lp0 = (u32x4){0u, 0u, 0u, 0u}; lp1 = lp0; } else { lp0 = *(const u32x4*)(p - DINP); lp1 = *(const u32x4*)(p - DINP + 8); } }
    u32x4 rc, kc, vc, rp, kp, vp;
    { const bf16_t* p = u + (t0 + lane) * DINP + h * 64 + 8 * w; rc = *(const u32x4*)(p + UA_R); kc = *(const u32x4*)(p + UA_K); vc = *(const u32x4*)(p + UA_V);
      if (seq0 && lane == 0) { rp = (u32x4){0u, 0u, 0u, 0u}; kp = rp; vp = rp; } else { rp = *(const u32x4*)(p - DINP + UA_R); kp = *(const u32x4*)(p - DINP + UA_K); vp = *(const u32x4*)(p - DINP + UA_V); } }
    { const float* wup = INF(I_WUP) + l * 32 * GW + h * 64; const float* aup = INF(I_AUP) + l * 32 * GW + h * 64; const float* gup = INF(I_GUP) + l * 64 * GW + h * 64;
      for (int i = tid; i < 2048; i += 512) { const int j = i >> 6, c = i & 63;
          ((ATT_LAS unsigned short*)(lds + X_WUP))[c * PW + j] = f2bf(wup[j * GW + c]); ((ATT_LAS unsigned short*)(lds + X_AUP))[c * PW + j] = f2bf(aup[j * GW + c]); }
      for (int i = tid; i < 4096; i += 512) { const int j = i >> 6, c = i & 63; ((ATT_LAS unsigned short*)(lds + X_GUP))[c * PG_ + j] = f2bf(gup[j * GW + c]); } }
    { float o[16];
#pragma unroll
      for (int j = 0; j < 4; ++j) { const float c0 = bfl(lc0[j]), c1 = bfh(lc0[j]), c2 = bfl(lc1[j]), c3 = bfh(lc1[j]); const float p0 = bfl(lp0[j]), p1 = bfh(lp0[j]), p2 = bfl(lp1[j]), p3 = bfh(lp1[j]);
          const float* m = mu + UA_WD + 16 * apart; o[2 * j] = c0 + (p0 - c0) * m[2 * j]; o[2 * j + 1] = c1 + (p1 - c1) * m[2 * j + 1]; o[8 + 2 * j] = c2 + (p2 - c2) * m[8 + 2 * j]; o[9 + 2 * j] = c3 + (p3 - c3) * m[9 + 2 * j]; }
      if (apart < 2) {
#pragma unroll
          for (int j = 0; j < 16; ++j) o[j] = tanhf(o[j]); }
      else if (apart >= 4) {
#pragma unroll
          for (int j = 0; j < 16; ++j) o[j] = sigmoidf_(o[j]); }
      ATT_LAS unsigned char* d = lds + X_ACT + (atok * PA + 16 * apart) * 2;
      *(ATT_LAS u32x4*)d = (u32x4){cvtpk(o[0], o[1]), cvtpk(o[2], o[3]), cvtpk(o[4], o[5]), cvtpk(o[6], o[7])};
      *(ATT_LAS u32x4*)(d + 16) = (u32x4){cvtpk(o[8], o[9]), cvtpk(o[10], o[11]), cvtpk(o[12], o[13]), cvtpk(o[14], o[15])}; }
    BAR_LDS();
    { const int tb = (w & 3) >> 1, cb = w & 1; f32x16 z0, z1;
#pragma unroll
      for (int r = 0; r < 16; ++r) { z0[r] = 0.f; z1[r] = 0.f; }
      ATT_LAS const unsigned char* arow = lds + X_ACT + ((32 * tb + r32) * PA + 8 * hi) * 2;
      if (w < 4) {
#pragma unroll
          for (int s = 0; s < 2; ++s) { z0 = MF32(ldA16(arow + 32 * s), ldA16(lds + X_WUP + ((32 * cb + r32) * PW + 16 * s + 8 * hi) * 2), z0);
              z1 = MF32(ldA16(arow + 64 + 32 * s), ldA16(lds + X_AUP + ((32 * cb + r32) * PW + 16 * s + 8 * hi) * 2), z1); }
          ATT_LAS float* zb = (ATT_LAS float*)(lds + O_ZB); ATT_LAS float* zab = (ATT_LAS float*)(lds + O_ZAB);
#pragma unroll
          for (int r = 0; r < 16; ++r) { zb[(32 * tb + crow(r, hi)) * PZ + 32 * cb + r32] = z0[r]; zab[(32 * tb + crow(r, hi)) * PZ + 32 * cb + r32] = z1[r]; }
      } else {
#pragma unroll
          for (int s = 0; s < 4; ++s) z0 = MF32(ldA16(arow + 128 + 32 * s), ldA16(lds + X_GUP + ((32 * cb + r32) * PG_ + 16 * s + 8 * hi) * 2), z0);
          bf16_t* gg = WSP(bf16_t, WS_RW_GG) + (t0 + 32 * tb) * GW + h * 64 + 32 * cb + r32;
#pragma unroll
          for (int r = 0; r < 16; ++r) gg[(size_t)crow(r, hi) * GW] = f2bf(z0[r]); } }
    BAR_LDS();
    {   const int cb8 = h * 64 + 8 * w;
        const float* w0 = INF(I_W0) + l * GW + cb8; const float* a0 = INF(I_A0) + l * GW + cb8; const float* kkw = INF(I_KK) + l * GW + cb8; const float* kaw = INF(I_KA) + l * GW + cb8;
        const float* rkw = INF(I_RK) + l * GW + cb8;
        ATT_LAS const float* zb = (ATT_LAS const float*)(lds + O_ZB) + lane * PZ + 8 * w; ATT_LAS const float* zab = (ATT_LAS const float*)(lds + O_ZAB) + lane * PZ + 8 * w;
        const f4v zA = *(ATT_LAS const f4v*)zb, zB = *(ATT_LAS const f4v*)(zb + 4), yA = *(ATT_LAS const f4v*)zab, yB = *(ATT_LAS const f4v*)(zab + 4);
        float rr[8], kk_[8], vv[8], lw[8], ai[8], kq[8]; float ss = 0.f, bon = 0.f;
#pragma unroll
        for (int i = 0; i < 8; ++i) {
            const float z = w0[i] + (i < 4 ? zA[i & 3] : zB[i & 3]), za = a0[i] + (i < 4 ? yA[i & 3] : yB[i & 3]);
            lw[i] = -__expf(-softplusf_(-z) - 0.5f); ai[i] = sigmoidf_(za);
            const unsigned wr_ = rc[i >> 1], wk_ = kc[i >> 1], wv_ = vc[i >> 1], pr_ = rp[i >> 1], pk_ = kp[i >> 1], pv_ = vp[i >> 1];
            const float r_c = (i & 1) ? bfh(wr_) : bfl(wr_), k_c = (i & 1) ? bfh(wk_) : bfl(wk_), v_c = (i & 1) ? bfh(wv_) : bfl(wv_);
            const float r_p = (i & 1) ? bfh(pr_) : bfl(pr_), k_p = (i & 1) ? bfh(pk_) : bfl(pk_), v_p = (i & 1) ? bfh(pv_) : bfl(pv_);
            rr[i] = r_c + (r_p - r_c) * mu[UA_R + cb8 + i]; const float k = k_c + (k_p - k_c) * mu[UA_K + cb8 + i]; vv[i] = v_c + (v_p - v_c) * mu[UA_V + cb8 + i];
            kq[i] = k * kkw[i]; ss += kq[i] * kq[i]; kk_[i] = k * (1.f + (ai[i] - 1.f) * kaw[i]); bon += rr[i] * kk_[i] * rkw[i]; }
        ATT_LAS float* red = (ATT_LAS float*)(lds + O_RED);
        red[w * 64 + lane] = ss; red[512 + w * 64 + lane] = bon;
        BAR_LDS();
        float sst = 0.f, bont = 0.f;
#pragma unroll
        for (int ww = 0; ww < 8; ++ww) { sst += red[ww * 64 + lane]; bont += red[512 + ww * 64 + lane]; }
        const float inv = 1.f / fmaxf(sqrtf(sst), 1e-12f);
        float at8[8], rt8[8], bt8[8], kt8[8];
#pragma unroll
        for (int i = 0; i < 8; ++i) { const float Gc = scan64(lw[i], lane); const float Gp = Gc - lw[i]; const float kkn = kq[i] * inv; const float enG = __expf(-Gc);
            at8[i] = -kkn * __expf(Gp); rt8[i] = rr[i] * __expf(Gc); bt8[i] = kkn * ai[i] * enG; kt8[i] = kk_[i] * enG;
            if (lane == 63) { const float gcv = __expf(Gc); ((ATT_LAS float*)(lds + O_GC))[8 * w + i] = gcv; WSP(float, WS_RW_GC)[(size_t)unit * 64 + 8 * w + i] = gcv; } }
        { ATT_LAS unsigned char* d = lds + (lane * PG_ + 8 * w) * 2;
          *(ATT_LAS u32x4*)(d + I_AT) = (u32x4){cvtpk(at8[0], at8[1]), cvtpk(at8[2], at8[3]), cvtpk(at8[4], at8[5]), cvtpk(at8[6], at8[7])};
          *(ATT_LAS u32x4*)(d + I_RT) = (u32x4){cvtpk(rt8[0], rt8[1]), cvtpk(rt8[2], rt8[3]), cvtpk(rt8[4], rt8[5]), cvtpk(rt8[6], rt8[7])};
          *(ATT_LAS u32x4*)(d + I_BT) = (u32x4){cvtpk(bt8[0], bt8[1]), cvtpk(bt8[2], bt8[3]), cvtpk(bt8[4], bt8[5]), cvtpk(bt8[6], bt8[7])};
          *(ATT_LAS u32x4*)(d + I_KT) = (u32x4){cvtpk(kt8[0], kt8[1]), cvtpk(kt8[2], kt8[3]), cvtpk(kt8[4], kt8[5]), cvtpk(kt8[6], kt8[7])};
#pragma unroll
          for (int i = 0; i < 8; ++i) { const int o2 = ((8 * w + i) * lin::PT + lane) * 2;
              *(ATT_LAS unsigned short*)(lds + I_ATT + o2) = f2bf(at8[i]); *(ATT_LAS unsigned short*)(lds + I_BTT + o2) = f2bf(bt8[i]);
              *(ATT_LAS unsigned short*)(lds + I_KTT + o2) = f2bf(kt8[i]); *(ATT_LAS unsigned short*)(lds + I_VT + o2) = f2bf(vv[i]); } }
        const size_t o = (t0 + lane) * GW + cb8;
        if (w == 0) WSP(float, WS_RW_BON)[(t0 + lane) * 4 + h] = bont;
        *(u32x4*)(WSP(bf16_t, WS_RW_VS) + o) = (u32x4){cvtpk(vv[0], vv[1]), cvtpk(vv[2], vv[3]), cvtpk(vv[4], vv[5]), cvtpk(vv[6], vv[7])};
    }
    BAR_LDS();
#define RW_PROD(ACC, IA, IB, rb, cb, keep) do { _Pragma("unroll") for (int r_ = 0; r_ < 16; ++r_) ACC[r_] = 0.f; \
        _Pragma("unroll") for (int k_ = 0; k_ < 4; ++k_) ACC = MF32(ldA16(lds + (IA) + ((32 * (rb) + r32) * PG_ + 16 * k_ + 8 * hi) * 2), ldA16(lds + (IB) + ((32 * (cb) + r32) * PG_ + 16 * k_ + 8 * hi) * 2), ACC); \
        if ((keep) == 1) { _Pragma("unroll") for (int r_ = 0; r_ < 16; ++r_) if (!(crow(r_, hi) < r32)) ACC[r_] = 0.f; } \
        if ((keep) == 2) { _Pragma("unroll") for (int r_ = 0; r_ < 16; ++r_) if (!(crow(r_, hi) <= r32)) ACC[r_] = 0.f; } \
        if ((keep) == 3) { _Pragma("unroll") for (int r_ = 0; r_ < 16; ++r_) if (!(crow(r_, hi) > r32)) ACC[r_] = 0.f; } } while (0)
    f32x16 M00, M01, M11;
    f32x16 Z1a, Z1b;
    if (w < 4) { RW_PROD(M00, I_BT, I_RT, 0, 0, 2); RW_PROD(M01, I_BT, I_RT, 0, 1, 0); RW_PROD(M11, I_BT, I_RT, 1, 1, 2); }
    if (w == 2 || w == 3) { const int eb = w - 2; f32x16 L00, L01, L11;
        RW_PROD(L00, I_KT, I_AT, 0, 0, 1); RW_PROD(L01, I_KT, I_AT, 0, 1, 0); RW_PROD(L11, I_KT, I_AT, 1, 1, 1);
#pragma unroll
        for (int r = 0; r < 16; ++r) { Z1a[r] = 0.f; Z1b[r] = 0.f; }
#pragma unroll
        for (int k = 0; k < 2; ++k) { const bf16x8 v0 = ldP8(lds + I_VT + ((32 * eb + r32) * lin::PT + 16 * k + 4 * hi) * 2), v1 = ldP8(lds + I_VT + ((32 * eb + r32) * lin::PT + 32 + 16 * k + 4 * hi) * 2);
            Z1a = MF32(pack8(L00, k), v0, Z1a); Z1b = MF32(pack8(L01, k), v0, Z1b); Z1b = MF32(pack8(L11, k), v1, Z1b); } }
    if (w == 4 || w == 5) { const int eb = w - 4; f32x16 K00, K01, K11, Ya, Yb, KVa, KVb;
        RW_PROD(K00, I_KT, I_RT, 0, 0, 2); RW_PROD(K01, I_KT, I_RT, 0, 1, 0); RW_PROD(K11, I_KT, I_RT, 1, 1, 2);
#pragma unroll
        for (int r = 0; r < 16; ++r) { Ya[r] = 0.f; Yb[r] = 0.f; KVa[r] = 0.f; KVb[r] = 0.f; }
#pragma unroll
        for (int k = 0; k < 2; ++k) { const bf16x8 v0 = ldP8(lds + I_VT + ((32 * eb + r32) * lin::PT + 16 * k + 4 * hi) * 2), v1 = ldP8(lds + I_VT + ((32 * eb + r32) * lin::PT + 32 + 16 * k + 4 * hi) * 2);
            Ya = MF32(pack8(K00, k), v0, Ya); Yb = MF32(pack8(K01, k), v0, Yb); Yb = MF32(pack8(K11, k), v1, Yb);
            KVa = MF32(ldP8(lds + I_KTT + (r32 * lin::PT + 16 * k + 4 * hi) * 2), v0, KVa); KVa = MF32(ldP8(lds + I_KTT + (r32 * lin::PT + 32 + 16 * k + 4 * hi) * 2), v1, KVa);
            KVb = MF32(ldP8(lds + I_KTT + ((32 + r32) * lin::PT + 16 * k + 4 * hi) * 2), v0, KVb); KVb = MF32(ldP8(lds + I_KTT + ((32 + r32) * lin::PT + 32 + 16 * k + 4 * hi) * 2), v1, KVb); }
        ATT_LAS unsigned char* ex = lds + O_EX + (eb * 4 * 64 + lane) * 32;
#define RW_EXW(q_, A_) do { *(ATT_LAS u32x4*)(ex + (q_) * 2048) = (u32x4){cvtpk(A_[0], A_[1]), cvtpk(A_[2], A_[3]), cvtpk(A_[4], A_[5]), cvtpk(A_[6], A_[7])}; \
        *(ATT_LAS u32x4*)(ex + (q_) * 2048 + 16) = (u32x4){cvtpk(A_[8], A_[9]), cvtpk(A_[10], A_[11]), cvtpk(A_[12], A_[13]), cvtpk(A_[14], A_[15])}; } while (0)
        RW_EXW(0, Ya); RW_EXW(1, Yb); RW_EXW(2, KVa); RW_EXW(3, KVb);
#undef RW_EXW
    }
    if (w == 7) {
        f32x16 La, Lb, Lc;
        RW_PROD(La, I_AT, I_BT, 0, 0, 3); RW_PROD(Lb, I_AT, I_BT, 1, 0, 0); RW_PROD(Lc, I_AT, I_BT, 1, 1, 3);
        ATT_LAS float* Lbuf = (ATT_LAS float*)(lds + O_ZB);
#pragma unroll
        for (int r = 0; r < 16; ++r) { Lbuf[crow(r, hi) * PZ + r32] = La[r]; Lbuf[(32 + crow(r, hi)) * PZ + 32 + r32] = Lc[r];
            *(ATT_LAS unsigned short*)(lds + O_L21 + (crow(r, hi) * PW + r32) * 2) = f2bf(Lb[r]);
            *(ATT_LAS unsigned short*)(lds + O_TIMG + (crow(r, hi) * PG_ + 32 + r32) * 2) = 0; }
        asm volatile("s_waitcnt lgkmcnt(0)" ::: "memory");
        float Tc[32];
        { ATT_LAS const float* Lr = Lbuf + (32 * hi) * PZ + 32 * hi;
#pragma unroll
          for (int t = 0; t < 32; ++t) { float acc = (t == r32) ? 1.f : 0.f;
#pragma unroll
              for (int s4 = 0; s4 < (t + 3) / 4; ++s4) { const f4v lv = *(ATT_LAS const f4v*)(Lr + t * PZ + 4 * s4);
#pragma unroll
                  for (int j = 0; j < 4; ++j) if (4 * s4 + j < t) acc += lv[j] * Tc[4 * s4 + j]; }
              Tc[t] = acc; } }
#pragma unroll
        for (int t = 0; t < 32; ++t) *(ATT_LAS unsigned short*)(lds + O_TIMG + ((32 * hi + t) * PG_ + 32 * hi + r32) * 2) = f2bf(Tc[t]);
        if (hi == 0) {
#pragma unroll
            for (int q4 = 0; q4 < 4; ++q4) *(ATT_LAS u32x4*)(lds + O_T11T + (r32 * PW + 8 * q4) * 2) = (u32x4){cvtpk(Tc[8 * q4], Tc[8 * q4 + 1]), cvtpk(Tc[8 * q4 + 2], Tc[8 * q4 + 3]), cvtpk(Tc[8 * q4 + 4], Tc[8 * q4 + 5]), cvtpk(Tc[8 * q4 + 6], Tc[8 * q4 + 7])}; }
        asm volatile("s_waitcnt lgkmcnt(0)" ::: "memory");
        f32x16 X, T21;
#pragma unroll
        for (int r = 0; r < 16; ++r) { X[r] = 0.f; T21[r] = 0.f; }
#pragma unroll
        for (int k = 0; k < 2; ++k) X = MF32(ldA16(lds + O_L21 + (r32 * PW + 16 * k + 8 * hi) * 2), ldA16(lds + O_T11T + (r32 * PW + 16 * k + 8 * hi) * 2), X);
#pragma unroll
        for (int k = 0; k < 2; ++k) T21 = MF32(ldP8(lds + O_TIMG + ((32 + r32) * PG_ + 32 + 16 * k + 4 * hi) * 2), pack8(X, k), T21);
#pragma unroll
        for (int r = 0; r < 16; ++r) *(ATT_LAS unsigned short*)(lds + O_TIMG + ((32 + crow(r, hi)) * PG_ + r32) * 2) = f2bf(T21[r]);
    }
    BAR_LDS();
    if (w < 4) {
        const int nb = w & 1;
        ATT_LAS const float* gc = (ATT_LAS const float*)(lds + O_GC);
        f32x16 P0, P1;
#pragma unroll
        for (int r = 0; r < 16; ++r) { P0[r] = 0.f; P1[r] = 0.f; }
#pragma unroll
        for (int k = 0; k < 2; ++k) {
            const bf16x8 t00 = ldP8(lds + O_TIMG + (r32 * PG_ + 16 * k + 4 * hi) * 2), t10 = ldP8(lds + O_TIMG + ((32 + r32) * PG_ + 16 * k + 4 * hi) * 2), t11 = ldP8(lds + O_TIMG + ((32 + r32) * PG_ + 32 + 16 * k + 4 * hi) * 2);
            bf16x8 b0, b1;
            if (w < 2) { b0 = ldP8(lds + I_ATT + ((32 * nb + r32) * lin::PT + 16 * k + 4 * hi) * 2); b1 = ldP8(lds + I_ATT + ((32 * nb + r32) * lin::PT + 32 + 16 * k + 4 * hi) * 2); }
            else { b0 = pack8(Z1a, k); b1 = pack8(Z1b, k); }
            P0 = MF32(t00, b0, P0); P1 = MF32(t10, b0, P1); P1 = MF32(t11, b1, P1); }
        {   f32x16 A0, A1;
#pragma unroll
            for (int r = 0; r < 16; ++r) { A0[r] = 0.f; A1[r] = 0.f; }
#pragma unroll
            for (int k = 0; k < 2; ++k) { const bf16x8 p0 = pack8(P0, k), p1 = pack8(P1, k);
                A0 = MF32(pack8(M00, k), p0, A0); A1 = MF32(pack8(M01, k), p0, A1); A1 = MF32(pack8(M11, k), p1, A1); }
            if (w < 2) { bf16_t* RY = WSP(bf16_t, WS_RW_RY) + (size_t)unit * 4096;
#pragma unroll
                for (int r = 0; r < 16; ++r) { const int t = crow(r, hi), d = 32 * nb + r32;
                    RY[t * 64 + d] = f2bf(A0[r] + bf2f(*(ATT_LAS const unsigned short*)(lds + I_RT + (t * PG_ + d) * 2)));
                    RY[(32 + t) * 64 + d] = f2bf(A1[r] + bf2f(*(ATT_LAS const unsigned short*)(lds + I_RT + ((32 + t) * PG_ + d) * 2))); } }
            else { ATT_LAS const unsigned char* ex = lds + O_EX + (nb * 4 * 64 + lane) * 32; float* Y0G = WSP(float, WS_RW_Y0) + ((size_t)unit * 4 + nb) * 1024 + lane * 16;
#pragma unroll
                for (int r4 = 0; r4 < 16; r4 += 4) { f4v y0, y1;
#pragma unroll
                    for (int j = 0; j < 4; ++j) { const int r = r4 + j; y0[j] = A0[r] + bf2f(*(ATT_LAS const unsigned short*)(ex + 2 * r)); y1[j] = A1[r] + bf2f(*(ATT_LAS const unsigned short*)(ex + 2048 + 2 * r)); }
                    *(f4v*)(Y0G + r4) = y0; *(f4v*)(Y0G + 2048 + r4) = y1; } } }
        __builtin_amdgcn_sched_barrier(0);
        {   f32x16 B0, B1;
#pragma unroll
            for (int r = 0; r < 16; ++r) { B0[r] = 0.f; B1[r] = 0.f; }
#pragma unroll
            for (int k = 0; k < 2; ++k) { const bf16x8 p0 = pack8(P0, k), p1 = pack8(P1, k);
                B0 = MF32(ldP8(lds + I_BTT + (r32 * lin::PT + 16 * k + 4 * hi) * 2), p0, B0); B0 = MF32(ldP8(lds + I_BTT + (r32 * lin::PT + 32 + 16 * k + 4 * hi) * 2), p1, B0);
                B1 = MF32(ldP8(lds + I_BTT + ((32 + r32) * lin::PT + 16 * k + 4 * hi) * 2), p0, B1); B1 = MF32(ldP8(lds + I_BTT + ((32 + r32) * lin::PT + 32 + 16 * k + 4 * hi) * 2), p1, B1); }
            if (w < 2) { bf16_t* PLg = WSP(bf16_t, WS_RW_PL) + (size_t)unit * 4096;
#pragma unroll
                for (int r = 0; r < 16; ++r) { const int t = crow(r, hi), d = 32 * nb + r32; PLg[t * 64 + d] = f2bf(gc[t] * B0[r]); PLg[(32 + t) * 64 + d] = f2bf(gc[32 + t] * B1[r]); } }
            else { ATT_LAS const unsigned char* ex = lds + O_EX + (nb * 4 * 64 + lane) * 32; float* QG = WSP(float, WS_RW_QG) + ((size_t)unit * 4 + nb) * 1024 + lane * 16;
#pragma unroll
                for (int r4 = 0; r4 < 16; r4 += 4) { f4v q0, q1;
#pragma unroll
                    for (int j = 0; j < 4; ++j) { const int r = r4 + j; q0[j] = gc[crow(r, hi)] * (B0[r] + bf2f(*(ATT_LAS const unsigned short*)(ex + 4096 + 2 * r))); q1[j] = gc[32 + crow(r, hi)] * (B1[r] + bf2f(*(ATT_LAS const unsigned short*)(ex + 6144 + 2 * r))); }
                    *(f4v*)(QG + r4) = q0; *(f4v*)(QG + 2048 + r4) = q1; } } }
    }
    BAR_LDS();
#undef RW_PROD
}
__device__ __forceinline__ void stage2_run(ATT_LAS unsigned char* lds, CtxRef C, int b, int h) {
    int tid = threadIdx.x; asm volatile("" : "+v"(tid));
    const int lane = tid & 63, w = __builtin_amdgcn_readfirstlane(tid >> 6), r32 = lane & 31, hi = lane >> 5;
    constexpr int NC = SEQ / 64; constexpr int S2_PL = 0, S2_RY = 9216, S2_GC = 18432, S2_BUF = 18688;
    const int bh = b * 4 + h; const size_t unit0 = (size_t)bh * NC;
    const bf16_t* PLg = WSP(bf16_t, WS_RW_PL) + unit0 * 4096; const bf16_t* RYg = WSP(bf16_t, WS_RW_RY) + unit0 * 4096;
    const float* QG = WSP(float, WS_RW_QG) + unit0 * 4096; const float* Y0G = WSP(float, WS_RW_Y0) + unit0 * 4096; const float* GCg = WSP(float, WS_RW_GC) + unit0 * 64;
    float* Y = WSP(float, WS_YA);
    const int i = w >> 1, eb = w & 1, srow = tid >> 3, spart = tid & 7;
    f32x16 H0, H1, q0, q1, y0;
#pragma unroll
    for (int r = 0; r < 16; ++r) { H0[r] = 0.f; H1[r] = 0.f; }
    u32x4 spl, sry; float sgc = 0.f;
#define S2_FETCH(c) do { spl = *(const u32x4*)(PLg + (size_t)(c) * 4096 + srow * 64 + spart * 8); sry = *(const u32x4*)(RYg + (size_t)(c) * 4096 + srow * 64 + spart * 8); if (tid < 64) sgc = GCg[(c) * 64 + tid]; \
        if (w < 4) { const float* qp = QG + (size_t)(c) * 4096 + eb * 1024 + lane * 16; const float* yp = Y0G + (size_t)(c) * 4096 + (i * 2 + eb) * 1024 + lane * 16; \
            _Pragma("unroll") for (int r4 = 0; r4 < 16; r4 += 4) { const f4v a = *(const f4v*)(qp + r4), b_ = *(const f4v*)(qp + 2048 + r4), c_ = *(const f4v*)(yp + r4); \
                _Pragma("unroll") for (int j = 0; j < 4; ++j) { q0[r4 + j] = a[j]; q1[r4 + j] = b_[j]; y0[r4 + j] = c_[j]; } } } } while (0)
#define S2_WRITE(buf) do { ATT_LAS unsigned char* B_ = lds + (buf) * S2_BUF; *(ATT_LAS u32x4*)(B_ + S2_PL + (srow * PG_ + spart * 8) * 2) = spl; *(ATT_LAS u32x4*)(B_ + S2_RY + (srow * PG_ + spart * 8) * 2) = sry; \
        if (tid < 64) ((ATT_LAS float*)(B_ + S2_GC))[tid] = sgc; } while (0)
    S2_FETCH(0); S2_WRITE(0);
    BAR_LDS();
    for (int c = 0; c < NC; ++c) {
        f32x16 cq0 = q0, cq1 = q1, cy0 = y0;
        if (c + 1 < NC) S2_FETCH(c + 1);
        if (w < 4) {
            ATT_LAS const unsigned char* B_ = lds + (c & 1) * S2_BUF; ATT_LAS const float* gc = (ATT_LAS const float*)(B_ + S2_GC);
            bf16x8 hb[2][2];
#pragma unroll
            for (int k = 0; k < 2; ++k) { hb[0][k] = pack8(H0, k); hb[1][k] = pack8(H1, k); }
            f32x16 Yo = cy0;
#pragma unroll
            for (int db = 0; db < 2; ++db)
#pragma unroll
                for (int k = 0; k < 2; ++k) Yo = MF32(ldP8(B_ + S2_RY + ((32 * i + r32) * PG_ + 32 * db + 16 * k + 4 * hi) * 2), hb[db][k], Yo);
#pragma unroll
            for (int r = 0; r < 16; ++r) { H0[r] = gc[crow(r, hi)] * H0[r] + cq0[r]; H1[r] = gc[32 + crow(r, hi)] * H1[r] + cq1[r]; }
#pragma unroll
            for (int db = 0; db < 2; ++db)
#pragma unroll
                for (int k = 0; k < 2; ++k) { H0 = MF32(ldP8(B_ + S2_PL + (r32 * PG_ + 32 * db + 16 * k + 4 * hi) * 2), hb[db][k], H0); H1 = MF32(ldP8(B_ + S2_PL + ((32 + r32) * PG_ + 32 * db + 16 * k + 4 * hi) * 2), hb[db][k], H1); }
            float* yo = Y + ((size_t)b * SEQ + (size_t)c * 64 + 32 * i) * GW + h * 64 + 32 * eb + r32;
#pragma unroll
            for (int r = 0; r < 16; ++r) yo[(size_t)crow(r, hi) * GW] = Yo[r];
        }
        if (c + 1 < NC) S2_WRITE((c + 1) & 1);
        BAR_LDS();
    }
#undef S2_FETCH
#undef S2_WRITE
}
#undef MF32
}
#endif

constexpr int PH_PER_LAYER = 12;
constexpr int NPHASES = DEPTH * PH_PER_LAYER;

#ifndef CPU_TEST
#define XB_TMO      128
#define XB_XCNT(j)  (256  + 64 * (j))
#define XB_XSUB(j)  (1280 + 64 * (j))
#define XB_XGEN(j)  (2304 + 64 * (j))
#define XB_TOP      3328
#define XB_TOPGEN   3392
#define XCD_BAR_WORDS 3456
#define XB_SPIN_CAP (1u << 18)
#define LAS __attribute__((address_space(3)))
__device__ __forceinline__ unsigned xb_ld(unsigned* p)              { return __hip_atomic_load(p, __ATOMIC_RELAXED, __HIP_MEMORY_SCOPE_AGENT); }
__device__ __forceinline__ unsigned xb_add(unsigned* p, unsigned v) { return __hip_atomic_fetch_add(p, v, __ATOMIC_RELAXED, __HIP_MEMORY_SCOPE_AGENT); }
__device__ __forceinline__ unsigned xb_xcc_id() { return (unsigned)__builtin_amdgcn_s_getreg((3 << 11) | 20) & 0xFu; }
#define XB_SPIN(cond, bar) do { unsigned _sp = 0; while (cond) { __builtin_amdgcn_s_sleep(1); \
    if ((++_sp & 255u) == 0u) { if (xb_ld(&(bar)[XB_TMO])) break; if (_sp > XB_SPIN_CAP) { atomicAdd(&(bar)[XB_TMO], 1u); break; } } } } while (0)
struct XcdBarrier { unsigned* bar; unsigned x; volatile LAS unsigned* st; };
__device__ __forceinline__ XcdBarrier xcd_barrier_post(unsigned* bar, volatile LAS unsigned* st) {
    XcdBarrier b; b.bar = bar; b.x = xb_xcc_id(); b.st = st;
    if (threadIdx.x == 0) (void)xb_add(&bar[XB_XCNT(b.x)], 1u);
    return b;
}
__device__ __forceinline__ void xcd_barrier_complete(unsigned* bar, unsigned x, unsigned& nloc, unsigned& nx) {
    const unsigned G = gridDim.x * gridDim.y * gridDim.z;
    unsigned sum, cnt, mine, sp = 0u;
    for (;;) {
        sum = 0u; cnt = 0u; mine = 0u;
#pragma unroll
        for (unsigned j = 0; j < 16; ++j) { const unsigned c = xb_ld(&bar[XB_XCNT(j)]); sum += c; cnt += (c > 0u) ? 1u : 0u; mine = (j == x) ? c : mine; }
        if (sum == G) break;
        __builtin_amdgcn_s_sleep(1);
        if ((++sp & 255u) == 0u) { if (xb_ld(&bar[XB_TMO])) break; if (sp > XB_SPIN_CAP) { atomicAdd(&bar[XB_TMO], 1u); break; } }
    }
    nloc = mine > 0u ? mine : 1u; nx = cnt > 0u ? cnt : 1u;
}
__device__ __forceinline__ void xcd_barrier(const XcdBarrier& b) {
    asm volatile("s_waitcnt vmcnt(0)" ::: "memory");
    __syncthreads();
    if (threadIdx.x == 0) {
        unsigned* bar = b.bar;
        __builtin_amdgcn_s_waitcnt(0);
        unsigned nloc = b.st[0], nx = b.st[1];
        if (nloc == 0u) { xcd_barrier_complete(bar, b.x, nloc, nx); b.st[0] = nloc; b.st[1] = nx; }
        const unsigned old = xb_add(&bar[XB_XSUB(b.x)], 1u);
        const unsigned gen = old / nloc;
        if (old + 1u == (gen + 1u) * nloc) {
            __builtin_amdgcn_fence(__ATOMIC_RELEASE, "agent");
            asm volatile("s_waitcnt vmcnt(0)" ::: "memory");
            const unsigned og = xb_add(&bar[XB_TOP], 1u);
            const unsigned tg = og / nx;
            if (og + 1u == (tg + 1u) * nx) xb_add(&bar[XB_TOPGEN], 1u);
            else XB_SPIN(xb_ld(&bar[XB_TOPGEN]) == tg, bar);
            __builtin_amdgcn_fence(__ATOMIC_ACQUIRE, "agent");
            xb_add(&bar[XB_XGEN(b.x)], 1u);
            asm volatile("s_waitcnt vmcnt(0)" ::: "memory");
        } else {
            XB_SPIN(xb_ld(&bar[XB_XGEN(b.x)]) == gen, bar);
            __builtin_amdgcn_fence(__ATOMIC_ACQUIRE, "agent");
            asm volatile("s_waitcnt vmcnt(0)" ::: "memory");
        }
    }
    __syncthreads();
}

constexpr int NWAVES = 8;
constexpr int RING_BYTES = 131072, MISC_OFF = RING_BYTES + 320, LDS_BYTES = 147456;
struct Args { Ctx C; int ph_lo, ph_hi; };
__device__ __forceinline__ int moe_fill_table(CtxRef C, int l, LAS int* tbl, int tid) {
    const unsigned* cnt = WSP(unsigned, WS_CTL) + CW_CNT + l * NEXP * 64;
    int e, be, ce; const int total = moe_lookup(cnt, tid * 256, e, be, ce);
    if (tid < 320) tbl[tid] = e;
    __syncthreads();
    return total >> 8;
}

__global__ void __launch_bounds__(NWAVES * 64, 2) mega(Args args) {
    extern __shared__ __attribute__((aligned(16))) unsigned char lds_raw[];
    LAS unsigned char* lds = (LAS unsigned char*)lds_raw;
    const int G = gridDim.x, bx = blockIdx.x;
    const int ngw = G * NWAVES;
    volatile LAS unsigned* MISC = (volatile LAS unsigned*)(lds + MISC_OFF);
    for (int i = threadIdx.x; i < (LDS_BYTES - RING_BYTES) / 4; i += NWAVES * 64) ((LAS unsigned*)(lds + RING_BYTES))[i] = 0u;
    __syncthreads();
    XcdBarrier bar = xcd_barrier_post((unsigned*)(args.C.ws + WS_CTL) + CW_BAR, MISC + 8);
    LAS int* tbl = (LAS int*)(lds + RING_BYTES + 1024);
    const int lo = args.ph_lo, hi = args.ph_hi;

    for (int l = 0; l < DEPTH; ++l) {
        const int p0 = l * PH_PER_LAYER;
#ifndef PHASE_MASK
#define PHASE_MASK 0xFFF
#endif
#define IN(k) (((PHASE_MASK >> (k)) & 1) && lo <= p0 + (k) && p0 + (k) < hi)
#define LAUNDER() const __attribute__((address_space(4))) Args* ap_ = (const __attribute__((address_space(4))) Args*)__builtin_amdgcn_kernarg_segment_ptr(); asm volatile("" : "+s"(ap_)); CtxRef C = ap_->C; \
        int tid = threadIdx.x; asm volatile("" : "+v"(tid)); const int lane = tid & 63; const int wave = __builtin_amdgcn_readfirstlane(tid >> 6); const int gw = bx * NWAVES + wave; (void)gw; (void)lane; \
        wsh_t wsh = (wsh_t)(lds + wave * 16384); (void)wsh
#define SEAM(k) do { if (p0 + (k) + 1 < hi) xcd_barrier(bar); } while (0)
        if (IN(0)) { LAUNDER(); stage_convert(C, l, gw, ngw, lane, wsh); SEAM(0); }
        if (IN(1)) { LAUNDER();
            pg8::Gemm g{WSP(bf16_t, WS_XB), WSP(bf16_t, WS_WIN), DM, DM, DM};
            pg8::DenseOrder S{T / 256, DINP / 256, G, bx, (long)256 * DM * 2, (long)256 * DM * 2};
            EpiU E{WSP(bf16_t, WS_U)};
            pg8::gemm_phase(lds, g, S, E); SEAM(1); }
        if (IN(2)) { LAUNDER();
            {   pg8::Gemm g{WSP(bf16_t, WS_U) + UD_CQ, WSP(bf16_t, WS_WUQ), DINP, 256, 256};
                pg8::DenseOrder S{T / 256, 2, G, bx, (long)256 * DINP * 2, (long)256 * 256 * 2};
                EpiQ E{WSP(float, WS_ROPE), WSP(bf16_t, WS_AQ)};
                pg8::gemm_phase(lds, g, S, E); }
            {   pg8::Gemm g{WSP(bf16_t, WS_U) + UD_CKV, WSP(bf16_t, WS_WUKV), DINP, 256, 256};
                pg8::DenseOrder S{T / 256, 2, G, bx, (long)256 * DINP * 2, (long)256 * 256 * 2};
                EpiKV E{WSP(bf16_t, WS_AK), WSP(bf16_t, WS_AV)};
                pg8::gemm_phase(lds, g, S, E); }
            __syncthreads();
            for (int uu = bx; uu < BATCH * NH * (SEQ / 64); uu += G) { const int bh = uu / (SEQ / 64), ch = uu % (SEQ / 64); rw7::stage1_unit(lds, C, l, bh >> 2, bh & 3, ch); }
            mla_token_pass(C, gw, ngw, lane);
            SEAM(2); }
        if (IN(3)) { LAUNDER();
            if (bx < 32) rw7::stage2_run(lds, C, bx >> 2, bx & 3);
            else if (bx < 64) lin::gla_run(lds, C, l, (bx - 32) >> 2, (bx - 32) & 3);
            else if (bx < 96) lin::mlstm_run(lds, C, l, (bx - 64) >> 2, (bx - 64) & 3);
            else {
                LAS int* slot = (LAS int*)(lds + RING_BYTES + 512);
                unsigned* ctr = WSP(unsigned, WS_CTL) + CW_ATT + l * 64;
                constexpr int NQB = SEQ / 256, NUNIT = BATCH * NH * NQB;
                for (;;) {
                    if (tid == 0) *slot = (int)atomicAdd(ctr, 1u);
                    __syncthreads();
                    const int uidx = *slot;
                    __syncthreads();
                    if (uidx >= NUNIT) break;
                    const int qb = NQB - 1 - uidx / (BATCH * NH), bh = uidx % (BATCH * NH);
                    att::unit(lds, WSP(bf16_t, WS_AQ), WSP(bf16_t, WS_AK), WSP(bf16_t, WS_AV), WSP(float, WS_RSTD), WSP(bf16_t, WS_MIX), bh >> 2, bh & 3, qb);
                }
            }
            SEAM(3); }
        if (IN(4)) { LAUNDER(); stage_post(C, l, gw, ngw, lane); SEAM(4); }
        if (IN(5)) { LAUNDER();
            pg8::Gemm g{WSP(bf16_t, WS_MIX), WSP(bf16_t, WS_WOUT), DMIX, DMIX, DMIX};
            pg8::DenseOrder S{T / 256, DM / 256, G, bx, (long)256 * DMIX * 2, (long)256 * DMIX * 2};
            EpiPre1 E{l == 0 ? INF(I_X) : WSP(float, WS_X), C.out};
            pg8::gemm_phase(lds, g, S, E); SEAM(5); }
        if (IN(6)) { LAUNDER(); ln1_router_coop(C, l, lds); SEAM(6); }
        if (IN(7)) { LAUNDER();
            stage_gather(C, l, gw, ngw, lane);
            pg8::Gemm g{WSP(bf16_t, WS_PB), WSP(bf16_t, WS_WP), DPLE, DPLE, DPLE};
            pg8::DenseOrder S{T / 256, DM / 256, G, bx, (long)256 * DPLE * 2, (long)256 * DPLE * 2};
            EpiPP E{WSP(bf16_t, WS_PP)};
            pg8::gemm_phase(lds, g, S, E); SEAM(7); }
        if (IN(8)) { LAUNDER();
            pg8::Gemm g{WSP(bf16_t, WS_XG), WSP(bf16_t, WS_WGU), DM, DM, DM};
            const int ntile = moe_fill_table(C, l, tbl, tid);
            pg8::MoeOrder S{tbl, ntile, 2 * DEXP / 256, G, bx, (long)256 * DM * 2, (long)256 * DM * 2, (long)2 * DEXP * DM * 2};
            EpiH E{WSP(bf16_t, WS_H)};
            pg8::gemm_phase(lds, g, S, E); SEAM(8); }
        if (IN(9)) { LAUNDER();
            pg8::Gemm g{WSP(bf16_t, WS_H), WSP(bf16_t, WS_WD), DEXP, DEXP, DEXP};
            const int ntile = moe_fill_table(C, l, tbl, tid);
            pg8::MoeOrder S{tbl, ntile, DM / 256, G, bx, (long)256 * DEXP * 2, (long)256 * DEXP * 2, (long)DM * DEXP * 2};
            EpiY E{WSP(int, WS_ROWINFO), WSP(float, WS_ROWGATE), WSP(bf16_t, WS_YBUF)};
            pg8::gemm_phase(lds, g, S, E); SEAM(9); }
        if (IN(10)) { LAUNDER();
            pg8::Gemm g{WSP(bf16_t, WS_XB), WSP(bf16_t, WS_WPG), DM, DM, DM};
            pg8::DenseOrder S{T / 256, DM / 256, G, bx, (long)256 * DM * 2, (long)256 * DM * 2};
            EpiPre2 E{C.out, WSP(bf16_t, WS_YBUF), WSP(bf16_t, WS_PP), INF(I_PLEBG) + l * DM, WSP(float, WS_X)};
            pg8::gemm_phase(lds, g, S, E); SEAM(10); }
        if (IN(11)) { LAUNDER(); stage_ln2(C, l, gw, ngw, lane); SEAM(11); }
#undef IN
#undef SEAM
    }
}

extern "C" void kernel_launch(void* const* d_in, const int* in_sizes, int n_in, void* d_out, int out_size, void* d_ws, size_t ws_size, hipStream_t stream) {
    static int grid = 0;
    if (grid == 0) {
        if (n_in != N_IN || out_size != T * DM || ws_size < WS_END) { fprintf(stderr, "kernel_launch: bad sizes n_in %d out %d ws %zu need %zu\n", n_in, out_size, ws_size, (size_t)WS_END); grid = -1; return; }
        int dev = 0, cus = 0, per_cu = 0;
        hipGetDevice(&dev); hipDeviceGetAttribute(&cus, hipDeviceAttributeMultiprocessorCount, dev);
        if (hipFuncSetAttribute((const void*)mega, hipFuncAttributeMaxDynamicSharedMemorySize, LDS_BYTES) != hipSuccess) { fprintf(stderr, "hipFuncSetAttribute failed\n"); grid = -1; return; }
        if (hipOccupancyMaxActiveBlocksPerMultiprocessor(&per_cu, (const void*)mega, NWAVES * 64, LDS_BYTES) != hipSuccess || per_cu < 1) { fprintf(stderr, "occupancy query: %d\n", per_cu); }
        (void)hipGetLastError();
        grid = cus;
    }
    if (grid < 0) return;
    hipMemsetAsync((char*)d_ws + WS_CTL, 0, CTL_BYTES, stream);
    Args a{};
    for (int i = 0; i < N_IN; ++i) a.C.in[i] = d_in[i];
    a.C.out = (float*)d_out; a.C.ws = (unsigned char*)d_ws;
#ifndef ONE_LAUNCH
    for (int ph = 0; ph < NPHASES; ++ph) { a.ph_lo = ph; a.ph_hi = ph + 1; hipLaunchKernelGGL(mega, dim3(grid), dim3(NWAVES * 64), LDS_BYTES, stream, a); }
#else
    a.ph_lo = 0; a.ph_hi = NPHASES; hipLaunchKernelGGL(mega, dim3(grid), dim3(NWAVES * 64), LDS_BYTES, stream, a);
#endif
}
#else
template <class E> static void cpu_gemm(const bf16_t* A, int lda, const bf16_t* Bt, int ldb, int K, int M, int N, const E& e, const int* base = nullptr, long estep = 0) {
    for (int row = 0; row < M; ++row) {
        const bf16_t* B = Bt;
        if (base) B = Bt + (size_t)moe_expert_of_row(base, row) * estep;
        if constexpr (E::MODE == 1) {
            for (int hc = 0; hc < N / 2; hc += 8) { float g[8], u[8];
                for (int j = 0; j < 8; ++j) { float ag = 0.f, au = 0.f; const bf16_t* bg = B + (size_t)rowmap(1, hc + j) * ldb; const bf16_t* bu = B + (size_t)rowmap(2, hc + j) * ldb;
                    for (int k = 0; k < K; ++k) { const float a = bf2f(A[(size_t)row * lda + k]); ag += a * bf2f(bg[k]); au += a * bf2f(bu[k]); } g[j] = ag; u[j] = au; }
                e.put8gu(row, hc, g, u); }
        } else if constexpr (E::PERM) {
            for (int c = 0; c < N; c += 8) { float a8[8];
                for (int j = 0; j < 8; ++j) { float acc = 0.f; for (int k = 0; k < K; ++k) acc += bf2f(A[(size_t)row * lda + k]) * bf2f(B[(size_t)(c + j) * ldb + k]); a8[j] = acc; }
                e.put8(row, c, a8); }
        } else {
            for (int c = 0; c < N; c += 4) { float a4[4];
                for (int j = 0; j < 4; ++j) { float acc = 0.f; for (int k = 0; k < K; ++k) acc += bf2f(A[(size_t)row * lda + k]) * bf2f(B[(size_t)(c + j) * ldb + k]); a4[j] = acc; }
                e.put4(row, c, a4); }
        }
    }
}
static void cpu_forward(CtxRef C) {
    static float shbuf[4096];
    for (int l = 0; l < DEPTH; ++l) {
        stage_convert(C, l, 0, 1, 0, shbuf);
        { EpiU E{WSP(bf16_t, WS_U)}; cpu_gemm(WSP(bf16_t, WS_XB), DM, WSP(bf16_t, WS_WIN), DM, DM, T, DINP, E); }
        stage_prep(C, l, 0, 1, 0, shbuf);
        for (int b = 0; b < BATCH; ++b) for (int h = 0; h < NH; ++h) {
            for (int v = 0; v < 64; ++v) { rwkv_scan_thread(C, b, h, v); gla_scan_thread(C, b, h, v); }
            for (int e = 0; e < 65; ++e) mlstm_scan_thread(C, b, h, e);
            for (int q = 0; q < SEQ; ++q) attn_thread(C, b, h, q, q); }
        stage_post(C, l, 0, 1, 0);
        { EpiPre1 E{l == 0 ? INF(I_X) : WSP(float, WS_X), C.out}; cpu_gemm(WSP(bf16_t, WS_MIX), DMIX, WSP(bf16_t, WS_WOUT), DMIX, DMIX, T, DM, E); }
        stage_ln1_router(C, l, 0, 1, 0, shbuf);
        stage_gather(C, l, 0, 1, 0);
        { EpiPP E{WSP(bf16_t, WS_PP)}; cpu_gemm(WSP(bf16_t, WS_PB), DPLE, WSP(bf16_t, WS_WP), DPLE, DPLE, T, DM, E); }
        int base[NEXP + 1]; moe_bases(C, l, base);
        { EpiH E{WSP(bf16_t, WS_H)}; cpu_gemm(WSP(bf16_t, WS_XG), DM, WSP(bf16_t, WS_WGU), DM, DM, base[NEXP], 2 * DEXP, E, base, (long)2 * DEXP * DM); }
        { EpiY E{WSP(int, WS_ROWINFO), WSP(float, WS_ROWGATE), WSP(bf16_t, WS_YBUF)}; cpu_gemm(WSP(bf16_t, WS_H), DEXP, WSP(bf16_t, WS_WD), DEXP, DEXP, base[NEXP], DM, E, base, (long)DM * DEXP); }
        { EpiPre2 E{C.out, WSP(bf16_t, WS_YBUF), WSP(bf16_t, WS_PP), INF(I_PLEBG) + l * DM, WSP(float, WS_X)}; cpu_gemm(WSP(bf16_t, WS_XB), DM, WSP(bf16_t, WS_WPG), DM, DM, T, DM, E); }
        stage_ln2(C, l, 0, 1, 0);
    }
}
#endif
```

```cpp
#ifndef CPU_TEST
#include <hip/hip_runtime.h>
#include <cstdio>
#include <cstdint>
#define HD __device__ __forceinline__
#define HDM __device__ __forceinline__
#define LANES 64
#else
#include <cmath>
#include <cstdio>
#include <cstdint>
#include <cstring>
#include <algorithm>
#define HD static inline
#define HDM inline
#define LANES 1
#endif

#define ONE_LAUNCH 1
#ifndef CFG_SMALL
constexpr int BATCH = 8, SEQ = 4096, DM = 1024, DEPTH = 4, DPLE = 256, DEXP = 512;
#else
constexpr int BATCH = 2, SEQ = 256, DM = 128, DEPTH = 2, DPLE = 32, DEXP = 128;
#endif
constexpr int T = BATCH * SEQ;
constexpr int DMIX = 1024, GW = 256, HD64 = 64, NH = 4;
constexpr int DIN = 3128, DINP = 3328;
constexpr int UA = 0, UA_R = 0, UA_K = 256, UA_V = 512, UA_WD = 768, UA_AD = 800, UA_GD = 832, DINA = 896;
constexpr int UB = 896, UB_Q = 896, UB_K = 1024, UB_V = 1152, UB_AD = 1408, UB_G = 1424;
constexpr int UC = 1680, UC_Q = 1680, UC_K = 1936, UC_V = 2192, UC_O = 2448, UC_IG = 2704, UC_FG = 2708;
constexpr int UD = 2712, UD_CQ = 2712, UD_CKV = 2968, UD_KR = 3096;
constexpr int NEXP = 32, NGRP = 4, EPG = 8;
constexpr int MAXROWS = 2 * T + NEXP * 256;
constexpr float DN_ALPHA = 1.681792830507429f;
constexpr float LN_EPS = 1e-5f, NORM_EPS = 1e-6f, RWKV_GN_EPS = 64e-5f;
static_assert(DEPTH == 4 || DEPTH == 2, "alpha below assumes depth");
HD float dn_alpha() { return DEPTH == 4 ? 1.681792830507429f : 1.4142135623730951f; }

enum { I_X = 0, I_P, I_POS, I_WIN, I_MU, I_W0, I_WUP, I_A0, I_AUP, I_GUP, I_KK, I_KA, I_RK, I_GNG, I_GNB, I_GLA_UP, I_GLA_B, I_GLA_G,
       I_CONVW, I_CONVB, I_IB, I_FB, I_MLN_G, I_QNG, I_WUQ, I_KVNG, I_WUKV, I_WOUT, I_LN1G, I_LN1B, I_WRG, I_BRG, I_WRE, I_BRE,
       I_WG, I_WU, I_WD, I_PLEG, I_PLEBG, I_PLEW, I_LN2G, I_LN2B, N_IN };

typedef unsigned short bf16_t;
HD float bf2f(bf16_t h) { unsigned u = (unsigned)h << 16; return __builtin_bit_cast(float, u); }
HD bf16_t f2bf(float f) { unsigned u = __builtin_bit_cast(unsigned, f); return (bf16_t)((u + 0x7fffu + ((u >> 16) & 1u)) >> 16); }
HD unsigned pk2(float lo, float hi) { return (unsigned)f2bf(lo) | ((unsigned)f2bf(hi) << 16); }
typedef float f4v __attribute__((vector_size(16)));
typedef unsigned u4v __attribute__((vector_size(16)));
HD void ld8bf(const bf16_t* p, float* o) { const u4v w = *(const u4v*)p;
    for (int j = 0; j < 4; ++j) { o[2 * j] = __builtin_bit_cast(float, w[j] << 16); o[2 * j + 1] = __builtin_bit_cast(float, w[j] & 0xffff0000u); } }
HD void st8bf(bf16_t* p, const float* a) { u4v w; for (int j = 0; j < 4; ++j) w[j] = pk2(a[2 * j], a[2 * j + 1]); *(u4v*)p = w; }

constexpr size_t MiB = (size_t)1 << 20;
constexpr size_t al256(size_t x) { return (x + 255) & ~(size_t)255; }
constexpr size_t WS_CTL = 0, CTL_BYTES = 1 * MiB;
constexpr size_t WS_WIN = WS_CTL + CTL_BYTES;
constexpr size_t WS_WOUT = WS_WIN + al256((size_t)DINP * DM * 2);
constexpr size_t WS_WPG = WS_WOUT + al256((size_t)DM * DMIX * 2);
constexpr size_t WS_WP = WS_WPG + al256((size_t)DM * DM * 2);
constexpr size_t WS_WGU = WS_WP + al256((size_t)DM * DPLE * 2);
constexpr size_t WS_WD = WS_WGU + al256((size_t)NEXP * 2 * DEXP * DM * 2);
constexpr size_t WS_X = WS_WD + al256((size_t)NEXP * DM * DEXP * 2);
constexpr size_t WS_XB = WS_X + al256((size_t)T * DM * 4);
constexpr size_t WS_U = WS_XB + al256((size_t)T * DM * 2);
constexpr size_t WS_MIX = WS_U + al256((size_t)T * DINP * 2);
constexpr size_t WS_PB = WS_MIX + al256((size_t)T * DMIX * 2);
constexpr size_t WS_WUQ = WS_PB + al256((size_t)T * DPLE * 2);
constexpr size_t WS_WUKV = WS_WUQ + al256((size_t)512 * 256 * 2);
constexpr size_t WS_ROPE = WS_WUKV + al256((size_t)512 * 256 * 2);
constexpr size_t WS_RSTD = WS_ROPE + al256((size_t)T * 32 * 4);
constexpr size_t WS_SCR = WS_RSTD + al256((size_t)T * 2 * 4);
constexpr size_t TV = al256((size_t)T * GW * 4);
constexpr size_t WS_RW_R = WS_SCR, WS_RW_W = WS_RW_R + TV, WS_RW_K = WS_RW_W + TV, WS_RW_V = WS_RW_K + TV, WS_RW_A = WS_RW_V + TV,
                 WS_RW_B = WS_RW_A + TV, WS_RW_G = WS_RW_B + TV;
constexpr size_t WS_RW_PL = WS_RW_R, WS_RW_RY = WS_RW_R + (size_t)16 * MiB;
constexpr size_t WS_RW_QG = WS_RW_W, WS_RW_Y0 = WS_RW_K, WS_RW_GC = WS_RW_V;
static_assert(TV >= (size_t)32 * MiB || T < 32768, "chunk buffers alias the f32 field region");
constexpr size_t WS_YA = WS_RW_G + TV, WS_YB = WS_YA + TV, WS_YC = WS_YB + TV;
constexpr size_t WS_DEN = WS_YC + TV;
constexpr size_t WS_QK = WS_DEN + al256((size_t)T * 4 * 4);
constexpr size_t WS_GA = WS_QK + al256((size_t)T * 512 * 4);
constexpr size_t WS_LG = WS_GA + al256((size_t)T * 128 * 4);
constexpr size_t WS_AQ = WS_LG + al256((size_t)T * 8 * 4);
constexpr size_t WS_AK = WS_AQ + al256((size_t)T * 384 * 2);
constexpr size_t WS_AV = WS_AK + al256((size_t)T * 384 * 2);
constexpr size_t WS_RW_GG = WS_AV + al256((size_t)T * 256 * 2);
constexpr size_t WS_RW_VS = WS_RW_GG + al256((size_t)T * 256 * 2);
constexpr size_t WS_RW_BON = WS_RW_VS + al256((size_t)T * 256 * 2);
constexpr size_t WS_GLA_BLOB = WS_QK;
constexpr size_t WS_ML_BLOB = WS_RW_A;
constexpr size_t WS_MIXER_END = WS_RW_BON + al256((size_t)T * 4 * 4);
constexpr size_t WS_XG = WS_SCR;
constexpr size_t WS_H = WS_XG + al256((size_t)MAXROWS * DM * 2);
constexpr size_t WS_YBUF = WS_H + al256((size_t)MAXROWS * DEXP * 2);
constexpr size_t WS_PP = WS_YBUF + al256((size_t)2 * T * DM * 2);
constexpr size_t WS_TOKINFO = WS_PP + al256((size_t)T * DM * 2);
constexpr size_t WS_LIST = WS_TOKINFO + al256((size_t)T * 16);
constexpr size_t WS_ROWINFO = WS_LIST + al256((size_t)NEXP * T * 4);
constexpr size_t WS_ROWGATE = WS_ROWINFO + al256((size_t)MAXROWS * 4);
constexpr size_t WS_MOE_END = WS_ROWGATE + al256((size_t)MAXROWS * 4);
constexpr size_t WS_END = WS_MIXER_END > WS_MOE_END ? WS_MIXER_END : WS_MOE_END;
constexpr int CW_BAR = 4096;
constexpr int CW_ATT = 8192;
constexpr int CW_CNT = 16384;

struct Ctx {
    const void* in[N_IN];
    float* out;
    unsigned char* ws;
};
#ifndef CPU_TEST
typedef const __attribute__((address_space(4))) Ctx& CtxRef;
#else
typedef CtxRef CtxRef;
#endif
#define INF(i) ((const float*)C.in[i])
#define WSP(T_, off) ((T_*)(C.ws + (off)))

#ifndef CPU_TEST
HD float dpp_f(float v, int sel) { const int x = __builtin_bit_cast(int, v); int y;
    if (sel == 0) y = __builtin_amdgcn_update_dpp(0, x, 0xB1, 0xF, 0xF, true);
    else if (sel == 1) y = __builtin_amdgcn_update_dpp(0, x, 0x4E, 0xF, 0xF, true);
    else if (sel == 2) y = __builtin_amdgcn_update_dpp(0, x, 0x141, 0xF, 0xF, true);
    else y = __builtin_amdgcn_update_dpp(0, x, 0x140, 0xF, 0xF, true);
    return __builtin_bit_cast(float, y); }
HD float wave_sum(float v) {
    v += dpp_f(v, 0); v += dpp_f(v, 1); v += dpp_f(v, 2); v += dpp_f(v, 3);
    const int x = __builtin_bit_cast(int, v);
    return (__builtin_bit_cast(float, __builtin_amdgcn_readlane(x, 0)) + __builtin_bit_cast(float, __builtin_amdgcn_readlane(x, 16))) +
           (__builtin_bit_cast(float, __builtin_amdgcn_readlane(x, 32)) + __builtin_bit_cast(float, __builtin_amdgcn_readlane(x, 48))); }
HD float wave_max(float v) {
    v = fmaxf(v, dpp_f(v, 0)); v = fmaxf(v, dpp_f(v, 1)); v = fmaxf(v, dpp_f(v, 2)); v = fmaxf(v, dpp_f(v, 3));
    const int x = __builtin_bit_cast(int, v);
    return fmaxf(fmaxf(__builtin_bit_cast(float, __builtin_amdgcn_readlane(x, 0)), __builtin_bit_cast(float, __builtin_amdgcn_readlane(x, 16))),
                 fmaxf(__builtin_bit_cast(float, __builtin_amdgcn_readlane(x, 32)), __builtin_bit_cast(float, __builtin_amdgcn_readlane(x, 48)))); }
HD unsigned atom_add(unsigned* p, unsigned v) { return atomicAdd(p, v); }
#define WSYNC() __builtin_amdgcn_wave_barrier(); asm volatile("s_waitcnt lgkmcnt(0)" ::: "memory")
typedef __attribute__((address_space(3))) float* wsh_t;
#else
HD float wave_sum(float v) { return v; }
HD float wave_max(float v) { return v; }
HD unsigned atom_add(unsigned* p, unsigned v) { unsigned o = *p; *p += v; return o; }
#define WSYNC()
typedef float* wsh_t;
#endif
HD float sigmoidf_(float x) { return 1.f / (1.f + expf(-x)); }
#ifndef CPU_TEST
HD float softplusf_(float x) { return x > 15.f ? x : __logf(1.f + __expf(x)); }
#else
HD float softplusf_(float x) { return x > 20.f ? x : (x < -20.f ? expf(x) : log1pf(expf(x))); }
#endif
HD float siluf_(float x) { return x * sigmoidf_(x); }

HD int rowmap(int mode, int n) { return mode == 0 ? n : (mode == 1 ? (n >> 7) * 256 + (n & 127) : (n >> 7) * 256 + 128 + (n & 127)); }
HD void transpose_item(const float* W, int K, int N, int ldw, bf16_t* WT, int ldk, int mode, int item, int lane, wsh_t scr) {
    const int nblk = (N + 31) / 32, kb = item / nblk, nb = item % nblk, k0 = 64 * kb, n0 = 32 * nb;
    for (int idx = lane; idx < 2048; idx += LANES) { const int kk = idx >> 5, nn = idx & 31; const int n = n0 + nn;
        scr[kk * 33 + nn] = (n < N) ? W[(size_t)(k0 + kk) * ldw + n] : 0.f; }
    WSYNC();
    for (int idx = lane; idx < 256; idx += LANES) { const int n = idx >> 3, c = idx & 7;
        unsigned o[4];
        for (int j = 0; j < 4; ++j) o[j] = pk2(scr[(8 * c + 2 * j) * 33 + n], scr[(8 * c + 2 * j + 1) * 33 + n]);
        unsigned* dst = (unsigned*)(WT + (size_t)rowmap(mode, n0 + n) * ldk + k0 + 8 * c);
        dst[0] = o[0]; dst[1] = o[1]; dst[2] = o[2]; dst[3] = o[3]; }
    WSYNC();
}
HD void stage_convert(CtxRef C, int l, int gw, int ngw, int lane, wsh_t scr) {
    constexpr int NB_IN = DINP / 32;
    constexpr int I_IN = (DM / 64) * NB_IN, I_OUT = (DMIX / 64) * (DM / 32), I_PG = (DM / 64) * (DM / 32), I_PW = (DPLE / 64 > 0 ? DPLE / 64 : 1) * (DM / 32);
    constexpr int I_G1 = (DM / 64) * (DEXP / 32), I_D1 = (DEXP / 64) * (DM / 32);
    constexpr int NIT = I_IN + I_OUT + I_PG + I_PW + NEXP * (2 * I_G1 + I_D1);
    static_assert(DPLE % 32 == 0 && DEXP % 64 == 0, "shapes");
    for (int it = gw; it < NIT; it += ngw) {
        int r = it;
        if (r < I_IN) {
            const int nblk = NB_IN, kb = r / nblk, nb = r % nblk, k0 = 64 * kb, n0 = 32 * nb;
            const float* W = INF(I_WIN) + (size_t)l * DM * DIN; bf16_t* WT = WSP(bf16_t, WS_WIN);
            for (int idx = lane; idx < 2048; idx += LANES) { const int kk = idx >> 5, nn = idx & 31; const int n = n0 + nn;
                scr[kk * 33 + nn] = (n < DIN) ? W[(size_t)(k0 + kk) * DIN + n] : 0.f; }
            WSYNC();
            for (int idx = lane; idx < 256; idx += LANES) { const int n = idx >> 3, c = idx & 7; unsigned o[4];
                for (int j = 0; j < 4; ++j) o[j] = pk2(scr[(8 * c + 2 * j) * 33 + n], scr[(8 * c + 2 * j + 1) * 33 + n]);
                unsigned* dst = (unsigned*)(WT + (size_t)(n0 + n) * DM + k0 + 8 * c); dst[0] = o[0]; dst[1] = o[1]; dst[2] = o[2]; dst[3] = o[3]; }
            WSYNC();
            continue; }
        r -= I_IN;
        if (r < I_OUT) { transpose_item(INF(I_WOUT) + (size_t)l * DMIX * DM, DMIX, DM, DM, WSP(bf16_t, WS_WOUT), DMIX, 0, r, lane, scr); continue; } r -= I_OUT;
        if (r < I_PG) { transpose_item(INF(I_PLEG) + (size_t)l * DM * DM, DM, DM, DM, WSP(bf16_t, WS_WPG), DM, 0, r, lane, scr); continue; } r -= I_PG;
        if (r < I_PW) {
            if (DPLE >= 64) transpose_item(INF(I_PLEW) + (size_t)l * DPLE * DM, DPLE, DM, DM, WSP(bf16_t, WS_WP), DPLE, 0, r, lane, scr);
            continue; } r -= I_PW;
        const int e = r / (2 * I_G1 + I_D1); r -= e * (2 * I_G1 + I_D1);
        if (r < I_G1) { transpose_item(INF(I_WG) + ((size_t)l * NEXP + e) * DM * DEXP, DM, DEXP, DEXP, WSP(bf16_t, WS_WGU) + (size_t)e * 2 * DEXP * DM, DM, 1, r, lane, scr); continue; } r -= I_G1;
        if (r < I_G1) { transpose_item(INF(I_WU) + ((size_t)l * NEXP + e) * DM * DEXP, DM, DEXP, DEXP, WSP(bf16_t, WS_WGU) + (size_t)e * 2 * DEXP * DM, DM, 2, r, lane, scr); continue; } r -= I_G1;
        transpose_item(INF(I_WD) + ((size_t)l * NEXP + e) * DEXP * DM, DEXP, DM, DM, WSP(bf16_t, WS_WD) + (size_t)e * DM * DEXP, DEXP, 0, r, lane, scr);
    }
    {   const float* wq = INF(I_WUQ) + (size_t)l * 256 * 384; const float* gq = INF(I_QNG) + l * 256; bf16_t* o = WSP(bf16_t, WS_WUQ);
        for (int i = gw * LANES + lane; i < 512 * 256; i += ngw * LANES) { const int n = i >> 8, k = i & 255; o[i] = f2bf(n < 384 ? gq[k] * wq[(size_t)k * 384 + n] : 0.f); }
        const float* wk = INF(I_WUKV) + (size_t)l * 128 * 512; const float* gk = INF(I_KVNG) + l * 128; bf16_t* o2 = WSP(bf16_t, WS_WUKV);
        for (int i = gw * LANES + lane; i < 512 * 256; i += ngw * LANES) { const int n = i >> 8, k = i & 255; o2[i] = f2bf(k < 128 ? gk[k] * wk[(size_t)k * 512 + n] : 0.f); } }
    if (l == 0) {
        const int* pos = (const int*)C.in[I_POS]; float* rt = WSP(float, WS_ROPE);
        for (int i = gw * LANES + lane; i < T * 16; i += ngw * LANES) { const int t = i >> 4, f = i & 15; const float ang = (float)pos[t] * powf(10000.f, -(float)f / 16.f);
            rt[(size_t)t * 32 + f] = cosf(ang); rt[(size_t)t * 32 + 16 + f] = sinf(ang); } }
    {   const float* p = INF(I_P) + (size_t)l * T * DPLE; bf16_t* pb = WSP(bf16_t, WS_PB);
        const size_t n4 = (size_t)T * DPLE / 4;
        for (size_t i = (size_t)gw * LANES + lane; i < n4; i += (size_t)ngw * LANES) {
            const float* s = p + 4 * i; unsigned* d = (unsigned*)(pb + 4 * i); d[0] = pk2(s[0], s[1]); d[1] = pk2(s[2], s[3]); } }
    if (l == 0) { const float* x = INF(I_X); bf16_t* xb = WSP(bf16_t, WS_XB);
        const size_t n4 = (size_t)T * DM / 4;
        for (size_t i = (size_t)gw * LANES + lane; i < n4; i += (size_t)ngw * LANES) {
            const float* s = x + 4 * i; unsigned* d = (unsigned*)(xb + 4 * i); d[0] = pk2(s[0], s[1]); d[1] = pk2(s[2], s[3]); } }
#ifdef CFG_SMALL
    if (DPLE < 64) {
        const float* W = INF(I_PLEW) + (size_t)l * DPLE * DM; bf16_t* WT = WSP(bf16_t, WS_WP);
        for (int i = gw * LANES + lane; i < DPLE * DM; i += ngw * LANES) { const int k = i / DM, n = i % DM; WT[(size_t)n * DPLE + k] = f2bf(W[i]); } }
#endif
}

HD float ubf(const bf16_t* u, int t, int c) { return bf2f(u[(size_t)t * DINP + c]); }
HD void stage_prep(CtxRef C, int l, int gw, int ngw, int lane, wsh_t sh) {
    const bf16_t* u = WSP(bf16_t, WS_U);
    const float* mu = INF(I_MU) + l * DINA; const float* w0 = INF(I_W0) + l * GW; const float* wup = INF(I_WUP) + l * 32 * GW;
    const float* a0 = INF(I_A0) + l * GW; const float* aup = INF(I_AUP) + l * 32 * GW; const float* gup = INF(I_GUP) + l * 64 * GW;
    const float* kkw = INF(I_KK) + l * GW; const float* kaw = INF(I_KA) + l * GW;
    const float* glaup = INF(I_GLA_UP) + l * 16 * 128; const float* glab = INF(I_GLA_B) + l * 128;
    const float* convw = INF(I_CONVW) + l * 4 * 512; const float* convb = INF(I_CONVB) + l * 512;
    const float* ib = INF(I_IB) + l * 4; const float* fb = INF(I_FB) + l * 4;
    const float* qng = INF(I_QNG) + l * 256; const float* wuq = INF(I_WUQ) + (size_t)l * 256 * 384;
    const float* kvng = INF(I_KVNG) + l * 128; const float* wukv = INF(I_WUKV) + (size_t)l * 128 * 512;
    const int* pos = (const int*)C.in[I_POS];
    float* oR = WSP(float, WS_RW_R); float* oW = WSP(float, WS_RW_W); float* oK = WSP(float, WS_RW_K); float* oV = WSP(float, WS_RW_V);
    float* oA = WSP(float, WS_RW_A); float* oB = WSP(float, WS_RW_B); float* oG = WSP(float, WS_RW_G);
    float* oQK = WSP(float, WS_QK); float* oGA = WSP(float, WS_GA); float* oLG = WSP(float, WS_LG);
    bf16_t* oAQ = WSP(bf16_t, WS_AQ); bf16_t* oAK = WSP(bf16_t, WS_AK); bf16_t* oAV = WSP(bf16_t, WS_AV);
    for (int t = gw; t < T; t += ngw) {
        const int s = t % SEQ;
        for (int j = lane; j < 128; j += LANES) { const int c = UA_WD + j; const float cur = ubf(u, t, c), prev = s > 0 ? ubf(u, t - 1, c) : 0.f;
            const float v = cur + (prev - cur) * mu[c]; sh[j] = j < 32 ? tanhf(v) : (j < 64 ? v : sigmoidf_(v)); }
        WSYNC();
        for (int h = 0; h < NH; ++h) {
            float kkraw[HD64 / LANES]; float kv_[HD64 / LANES], av_[HD64 / LANES]; float ss = 0.f;
            for (int i = 0; i < HD64 / LANES; ++i) { const int c = h * 64 + i * LANES + lane;
                float z = w0[c], za = a0[c], g = 0.f;
_Pragma("unroll 8")
                for (int j = 0; j < 32; ++j) { z += sh[j] * wup[j * GW + c]; za += sh[32 + j] * aup[j * GW + c]; }
_Pragma("unroll 8")
                for (int j = 0; j < 64; ++j) g += sh[64 + j] * gup[j * GW + c];
                const float lnl = -softplusf_(-z) - 0.5f; const float decay = expf(-expf(lnl)); const float a = sigmoidf_(za);
                float r, k, v;
                { const float cur = ubf(u, t, UA_R + c), prev = s > 0 ? ubf(u, t - 1, UA_R + c) : 0.f; r = cur + (prev - cur) * mu[UA_R + c]; }
                { const float cur = ubf(u, t, UA_K + c), prev = s > 0 ? ubf(u, t - 1, UA_K + c) : 0.f; k = cur + (prev - cur) * mu[UA_K + c]; }
                { const float cur = ubf(u, t, UA_V + c), prev = s > 0 ? ubf(u, t - 1, UA_V + c) : 0.f; v = cur + (prev - cur) * mu[UA_V + c]; }
                kkraw[i] = k * kkw[c]; ss += kkraw[i] * kkraw[i];
                kv_[i] = k * (1.f + (a - 1.f) * kaw[c]); av_[i] = a;
                const size_t o = (size_t)t * GW + c; oR[o] = r; oW[o] = decay; oK[o] = kv_[i]; oV[o] = v; oG[o] = g; }
            ss = wave_sum(ss); const float inv = 1.f / fmaxf(sqrtf(ss), 1e-12f);
            for (int i = 0; i < HD64 / LANES; ++i) { const int c = h * 64 + i * LANES + lane; const size_t o = (size_t)t * GW + c; const float kk = kkraw[i] * inv;
                oA[o] = -kk; oB[o] = kk * av_[i]; }
        }
        WSYNC();
        for (int c = lane; c < 128; c += LANES) { float z = glab[c];
            for (int j = 0; j < 16; ++j) z += ubf(u, t, UB_AD + j) * glaup[j * 128 + c];
            oGA[(size_t)t * 128 + c] = -softplusf_(-z) * (1.f / 16.f); }
        for (int c = lane; c < 512; c += LANES) { float y = convb[c];
            for (int j = 0; j < 4; ++j) { const int sp = s - 3 + j; if (sp >= 0) y += convw[j * 512 + c] * ubf(u, t - 3 + j, UC_Q + c); }
            float q = siluf_(y); if (c >= 256) q *= 0.125f; oQK[(size_t)t * 512 + c] = q; }
        for (int c = lane; c < 8; c += LANES) { const float v = ubf(u, t, UC_IG + c);
            oLG[(size_t)t * 8 + c] = c < 4 ? v + ib[c] : -softplusf_(-(v + fb[c - 4])); }
        {   float ssq = 0.f, sskv = 0.f;
            for (int j = lane; j < 256; j += LANES) { const float v = ubf(u, t, UD_CQ + j); ssq += v * v; }
            for (int j = lane; j < 128; j += LANES) { const float v = ubf(u, t, UD_CKV + j); sskv += v * v; }
            ssq = wave_sum(ssq); sskv = wave_sum(sskv);
            const float rq = 1.f / sqrtf(ssq * (1.f / 256.f) + NORM_EPS), rkv = 1.f / sqrtf(sskv * (1.f / 128.f) + NORM_EPS);
            for (int j = lane; j < 256; j += LANES) sh[j] = ubf(u, t, UD_CQ + j) * rq * qng[j];
            for (int j = lane; j < 128; j += LANES) sh[256 + j] = ubf(u, t, UD_CKV + j) * rkv * kvng[j];
            WSYNC();
            for (int n = lane; n < 384; n += LANES) { float acc = 0.f;
_Pragma("unroll 8")
                for (int k = 0; k < 256; ++k) acc += sh[k] * wuq[(size_t)k * 384 + n]; sh[384 + n] = acc; }
            for (int n = lane; n < 512; n += LANES) { float acc = 0.f;
_Pragma("unroll 8")
                for (int k = 0; k < 128; ++k) acc += sh[256 + k] * wukv[(size_t)k * 512 + n]; sh[768 + n] = acc; }
            for (int i = lane; i < 16; i += LANES) { const float invf = powf(10000.f, -(float)i / 16.f); const float ang = (float)pos[t] * invf; sh[1280 + i] = cosf(ang); sh[1296 + i] = sinf(ang); }
            for (int i = lane; i < 32; i += LANES) sh[1312 + i] = ubf(u, t, UD_KR + i);
            WSYNC();
            const float qscale = 0.10206207261596575f * 1.4426950408889634f;
            for (int idx = lane; idx < 384; idx += LANES) { const int h = idx / 96, d = idx % 96; float v;
                if (d < 64) v = sh[384 + idx];
                else { const int i = (d - 64) & 15; const float x1 = sh[384 + h * 96 + 64 + i], x2 = sh[384 + h * 96 + 80 + i]; const float c_ = sh[1280 + i], s_ = sh[1296 + i];
                    v = (d - 64) < 16 ? x1 * c_ - x2 * s_ : x1 * s_ + x2 * c_; }
                oAQ[(size_t)t * 384 + idx] = f2bf(v * qscale); }
            for (int idx = lane; idx < 384; idx += LANES) { const int h = idx / 96, d = idx % 96; float v;
                if (d < 64) v = sh[768 + h * 128 + d];
                else { const int i = (d - 64) & 15; const float x1 = sh[1312 + i], x2 = sh[1328 + i]; const float c_ = sh[1280 + i], s_ = sh[1296 + i];
                    v = (d - 64) < 16 ? x1 * c_ - x2 * s_ : x1 * s_ + x2 * c_; }
                oAK[(size_t)t * 384 + idx] = f2bf(v); }
            for (int idx = lane; idx < 256; idx += LANES) { const int h = idx / 64, d = idx % 64; oAV[(size_t)t * 256 + idx] = f2bf(sh[768 + h * 128 + 64 + d]); }
            WSYNC();
        }
    }
}

HD void rwkv_scan_thread(CtxRef C, int b, int h, int v) {
    const float* pR = WSP(float, WS_RW_R); const float* pW = WSP(float, WS_RW_W); const float* pK = WSP(float, WS_RW_K); const float* pV = WSP(float, WS_RW_V);
    const float* pA = WSP(float, WS_RW_A); const float* pB = WSP(float, WS_RW_B); float* Y = WSP(float, WS_YA);
    float S[64];
#pragma unroll
    for (int k = 0; k < 64; ++k) S[k] = 0.f;
    for (int s = 0; s < SEQ; ++s) {
        const size_t o = ((size_t)b * SEQ + s) * GW + h * 64;
        const float vv = pV[o + v];
        float sa0 = 0.f, sa1 = 0.f, sa2 = 0.f, sa3 = 0.f;
#pragma unroll
        for (int k = 0; k < 64; k += 4) { const f4v a = *(const f4v*)(pA + o + k); sa0 += S[k] * a[0]; sa1 += S[k + 1] * a[1]; sa2 += S[k + 2] * a[2]; sa3 += S[k + 3] * a[3]; }
        const float sa = (sa0 + sa1) + (sa2 + sa3);
        float y0 = 0.f, y1 = 0.f, y2 = 0.f, y3 = 0.f;
#pragma unroll
        for (int k = 0; k < 64; k += 4) {
            const f4v w = *(const f4v*)(pW + o + k), bb = *(const f4v*)(pB + o + k), kk = *(const f4v*)(pK + o + k), r = *(const f4v*)(pR + o + k);
            S[k] = S[k] * w[0] + sa * bb[0] + vv * kk[0]; y0 += S[k] * r[0];
            S[k + 1] = S[k + 1] * w[1] + sa * bb[1] + vv * kk[1]; y1 += S[k + 1] * r[1];
            S[k + 2] = S[k + 2] * w[2] + sa * bb[2] + vv * kk[2]; y2 += S[k + 2] * r[2];
            S[k + 3] = S[k + 3] * w[3] + sa * bb[3] + vv * kk[3]; y3 += S[k + 3] * r[3];
            if ((k & 12) == 12) asm volatile("" ::: "memory"); }
        Y[o + v] = (y0 + y1) + (y2 + y3);
    }
}
HD void gla_scan_thread(CtxRef C, int b, int h, int v) {
    const bf16_t* u = WSP(bf16_t, WS_U); const float* GA = WSP(float, WS_GA); float* Y = WSP(float, WS_YB);
    float S[32];
#pragma unroll
    for (int k = 0; k < 32; ++k) S[k] = 0.f;
    for (int s = 0; s < SEQ; ++s) {
        const int t = b * SEQ + s;
        const float vv = ubf(u, t, UB_V + h * 64 + v);
        float acc = 0.f;
#pragma unroll
        for (int k8 = 0; k8 < 32; k8 += 8) { float kf[8], qf[8];
            ld8bf(u + (size_t)t * DINP + UB_K + h * 32 + k8, kf); ld8bf(u + (size_t)t * DINP + UB_Q + h * 32 + k8, qf);
            const f4v g0 = *(const f4v*)(GA + (size_t)t * 128 + h * 32 + k8), g1 = *(const f4v*)(GA + (size_t)t * 128 + h * 32 + k8 + 4);
#pragma unroll
            for (int j = 0; j < 8; ++j) { const float a = expf(j < 4 ? g0[j & 3] : g1[j & 3]); S[k8 + j] = a * S[k8 + j] + kf[j] * vv; acc += qf[j] * S[k8 + j]; } }
        Y[(size_t)t * GW + h * 64 + v] = acc * 0.17677669529663687f;
    }
}
HD void mlstm_scan_thread(CtxRef C, int b, int h, int e) {
    const bf16_t* u = WSP(bf16_t, WS_U); const float* QK = WSP(float, WS_QK); const float* LG = WSP(float, WS_LG);
    float* Y = WSP(float, WS_YC); float* DEN = WSP(float, WS_DEN);
    float S[64];
#pragma unroll
    for (int k = 0; k < 64; ++k) S[k] = 0.f;
    for (int s = 0; s < SEQ; ++s) {
        const int t = b * SEQ + s;
        const float ig = expf(LG[(size_t)t * 8 + h]), fg = expf(LG[(size_t)t * 8 + 4 + h]);
        const float vv = (e < 64 ? ubf(u, t, UC_V + h * 64 + e) : 1.f) * ig;
        float acc = 0.f;
#pragma unroll
        for (int k = 0; k < 64; k += 4) { const f4v kk = *(const f4v*)(QK + (size_t)t * 512 + 256 + h * 64 + k), qq = *(const f4v*)(QK + (size_t)t * 512 + h * 64 + k);
#pragma unroll
            for (int j = 0; j < 4; ++j) { S[k + j] = fg * S[k + j] + kk[j] * vv; acc += qq[j] * S[k + j]; } }
        if (e < 64) Y[(size_t)t * GW + h * 64 + e] = acc; else DEN[(size_t)t * 4 + h] = acc;
    }
}
HD void attn_thread(CtxRef C, int b, int h, int q, int kmax  ) {
    const bf16_t* Q = WSP(bf16_t, WS_AQ); const bf16_t* K = WSP(bf16_t, WS_AK); const bf16_t* V = WSP(bf16_t, WS_AV); bf16_t* mix = WSP(bf16_t, WS_MIX);
    const int t = b * SEQ + q;
    unsigned qp[48]; float o[64];
#pragma unroll
    for (int d = 0; d < 48; d += 4) { const u4v w = *(const u4v*)(Q + (size_t)t * 384 + h * 96 + 2 * d); qp[d] = w[0]; qp[d + 1] = w[1]; qp[d + 2] = w[2]; qp[d + 3] = w[3]; }
#pragma unroll
    for (int d = 0; d < 64; ++d) o[d] = 0.f;
    float m = -1e30f, lsum = 0.f;
    for (int j = 0; j <= kmax; ++j) {
        const size_t tk = (size_t)b * SEQ + j;
        float sc0 = 0.f, sc1 = 0.f;
#pragma unroll
        for (int d = 0; d < 96; d += 8) { float kf[8]; ld8bf(K + tk * 384 + h * 96 + d, kf);
#pragma unroll
            for (int i = 0; i < 8; i += 2) { const unsigned qw = qp[(d + i) >> 1];
                sc0 += __builtin_bit_cast(float, qw << 16) * kf[i]; sc1 += __builtin_bit_cast(float, qw & 0xffff0000u) * kf[i + 1]; }
            if ((d & 24) == 24) asm volatile("" ::: "memory"); }
        const float sc = sc0 + sc1;
        if (j <= q) {
            const float mn = fmaxf(m, sc); const float corr = exp2f(m - mn), p = exp2f(sc - mn);
            lsum = lsum * corr + p;
#pragma unroll
            for (int d = 0; d < 64; d += 8) { float vf[8]; ld8bf(V + tk * 256 + h * 64 + d, vf);
#pragma unroll
                for (int i = 0; i < 8; ++i) o[d + i] = o[d + i] * corr + p * vf[i];
                if (d & 8) asm volatile("" ::: "memory"); }
            m = mn; }
    }
    const float inv = 1.f / lsum;
#pragma unroll
    for (int d = 0; d < 64; d += 8) { float a[8];
#pragma unroll
        for (int i = 0; i < 8; ++i) a[i] = o[d + i] * inv;
        st8bf(mix + (size_t)t * DMIX + 768 + h * 64 + d, a); }
}

HD void stage_post(CtxRef C, int l, int gw, int ngw, int lane) {
    const bf16_t* u = WSP(bf16_t, WS_U); bf16_t* mix = WSP(bf16_t, WS_MIX);
    const float* YA = WSP(float, WS_YA); const float* YB = WSP(float, WS_YB); const float* YC = WSP(float, WS_YC); const float* DEN = WSP(float, WS_DEN);
    const float* pR = WSP(float, WS_RW_R); const float* pK = WSP(float, WS_RW_K); const float* pV = WSP(float, WS_RW_V); const float* pG = WSP(float, WS_RW_G);
    const float* rk = INF(I_RK) + l * GW; const float* gng = INF(I_GNG) + l * GW; const float* gnb = INF(I_GNB) + l * GW;
    const float* glag = INF(I_GLA_G) + l * GW; const float* mlng = INF(I_MLN_G) + l * GW;
    constexpr int PL = HD64 / LANES;
    for (int t = gw; t < T; t += ngw) {
        for (int h = 0; h < NH; ++h) {
            {   float y[PL], s1 = 0.f, bon = 0.f;
#ifdef CPU_TEST
                for (int i = 0; i < PL; ++i) { const int c = h * 64 + i * LANES + lane; const size_t o = (size_t)t * GW + c; y[i] = YA[o]; s1 += y[i]; bon += pR[o] * pK[o] * rk[c]; }
                s1 = wave_sum(s1); bon = wave_sum(bon);
#else
                for (int i = 0; i < PL; ++i) { const int c = h * 64 + i * LANES + lane; y[i] = YA[(size_t)t * GW + c]; s1 += y[i]; }
                s1 = wave_sum(s1); bon = WSP(float, WS_RW_BON)[(size_t)t * 4 + h];
#endif
                const float mean = s1 * (1.f / 64.f); float s2 = 0.f;
                for (int i = 0; i < PL; ++i) { y[i] -= mean; s2 += y[i] * y[i]; }
                s2 = wave_sum(s2); const float rstd = 1.f / sqrtf(s2 * (1.f / 64.f) + RWKV_GN_EPS);
                for (int i = 0; i < PL; ++i) { const int c = h * 64 + i * LANES + lane; const size_t o = (size_t)t * GW + c;
#ifdef CPU_TEST
                    const float v = (y[i] * rstd * gng[c] + gnb[c] + bon * pV[o]) * pG[o];
#else
                    const float v = (y[i] * rstd * gng[c] + gnb[c] + bon * bf2f(WSP(bf16_t, WS_RW_VS)[o])) * bf2f(WSP(bf16_t, WS_RW_GG)[o]);
#endif
                    mix[(size_t)t * DMIX + c] = f2bf(v); } }
            {   float y[PL], s2 = 0.f;
                for (int i = 0; i < PL; ++i) { const int c = h * 64 + i * LANES + lane; y[i] = YB[(size_t)t * GW + c]; s2 += y[i] * y[i]; }
                s2 = wave_sum(s2); const float rstd = 1.f / sqrtf(s2 * (1.f / 64.f) + NORM_EPS);
                for (int i = 0; i < PL; ++i) { const int c = h * 64 + i * LANES + lane;
                    const float v = y[i] * rstd * glag[c] * siluf_(ubf(u, t, UB_G + c)); mix[(size_t)t * DMIX + 256 + c] = f2bf(v); } }
            {   const float den = DEN[(size_t)t * 4 + h]; const float dinv = 1.f / fmaxf(fabsf(den), 1.f);
                float y[PL], s1 = 0.f;
                for (int i = 0; i < PL; ++i) { const int c = h * 64 + i * LANES + lane; y[i] = YC[(size_t)t * GW + c] * dinv; s1 += y[i]; }
                s1 = wave_sum(s1); const float mean = s1 * (1.f / 64.f); float s2 = 0.f;
                for (int i = 0; i < PL; ++i) { y[i] -= mean; s2 += y[i] * y[i]; }
                s2 = wave_sum(s2); const float rstd = 1.f / sqrtf(s2 * (1.f / 64.f) + LN_EPS);
                for (int i = 0; i < PL; ++i) { const int c = h * 64 + i * LANES + lane;
                    const float v = y[i] * rstd * mlng[c] * sigmoidf_(ubf(u, t, UC_O + c)); mix[(size_t)t * DMIX + 512 + c] = f2bf(v); } }
        }
    }
}

HD void ln_row(const float* src, const float* g, const float* b, float* dstf, bf16_t* dstb, int lane, float* keep  ) {
    constexpr int PL = DM / LANES;
    float s1 = 0.f;
#pragma unroll
    for (int i = 0; i < PL; ++i) { keep[i] = src[i * LANES + lane]; s1 += keep[i]; }
    s1 = wave_sum(s1); const float mean = s1 * (1.f / DM); float s2 = 0.f;
#pragma unroll
    for (int i = 0; i < PL; ++i) { keep[i] -= mean; s2 += keep[i] * keep[i]; }
    s2 = wave_sum(s2); const float rstd = 1.f / sqrtf(s2 * (1.f / DM) + LN_EPS);
#pragma unroll
    for (int i = 0; i < PL; ++i) { const int c = i * LANES + lane; keep[i] = keep[i] * rstd * g[c] + b[c]; dstf[c] = keep[i]; dstb[c] = f2bf(keep[i]); }
}
HD void stage_ln1_router(CtxRef C, int l, int gw, int ngw, int lane, wsh_t sh) {
    float* X1 = C.out; bf16_t* xb = WSP(bf16_t, WS_XB);
    const float* g = INF(I_LN1G) + l * DM; const float* b = INF(I_LN1B) + l * DM;
    const float* wrg = INF(I_WRG) + (size_t)l * DM * NGRP; const float* brg = INF(I_BRG) + l * NGRP;
    const float* wre = INF(I_WRE) + (size_t)l * DM * NEXP; const float* bre = INF(I_BRE) + l * NEXP;
    unsigned* cnt = WSP(unsigned, WS_CTL) + CW_CNT + l * NEXP * 64;
    int* tokinfo = WSP(int, WS_TOKINFO); int* list = WSP(int, WS_LIST);
    constexpr int PL = DM / LANES;
    for (int t = gw; t < T; t += ngw) {
        {   float keep[PL];
            ln_row(X1 + (size_t)t * DM, g, b, X1 + (size_t)t * DM, xb + (size_t)t * DM, lane, keep);
#pragma unroll
            for (int i = 0; i < PL; ++i) sh[i * LANES + lane] = keep[i]; }
        WSYNC();
        float lg[NGRP], le[NEXP];
#pragma unroll
        for (int j = 0; j < NGRP; ++j) lg[j] = 0.f;
#pragma unroll
        for (int j = 0; j < NEXP; ++j) le[j] = 0.f;
#pragma unroll 1
        for (int i = 0; i < PL; ++i) { const int c = i * LANES + lane; const float xv = sh[c];
            const f4v wg = *(const f4v*)(wrg + (size_t)c * NGRP);
#pragma unroll
            for (int j = 0; j < NGRP; ++j) lg[j] += xv * wg[j];
#pragma unroll
            for (int j = 0; j < NEXP; j += 4) { const f4v we = *(const f4v*)(wre + (size_t)c * NEXP + j);
                le[j] += xv * we[0]; le[j + 1] += xv * we[1]; le[j + 2] += xv * we[2]; le[j + 3] += xv * we[3]; } }
        WSYNC();
#pragma unroll
        for (int j = 0; j < NGRP; ++j) lg[j] = wave_sum(lg[j]) + brg[j];
#pragma unroll
        for (int j = 0; j < NEXP; ++j) le[j] = wave_sum(le[j]) + bre[j];
        int gi = 0; float gm = lg[0];
#pragma unroll
        for (int j = 1; j < NGRP; ++j) if (lg[j] > gm) { gm = lg[j]; gi = j; }
        float gs = 0.f;
#pragma unroll
        for (int j = 0; j < NGRP; ++j) gs += expf(lg[j] - gm);
        const float group_p = 1.f / gs;
        float el[EPG];
#pragma unroll
        for (int j = 0; j < EPG; ++j) { float v = le[j];
#pragma unroll
            for (int g2 = 1; g2 < NGRP; ++g2) v = (gi == g2) ? le[g2 * EPG + j] : v;
            el[j] = v; }
        int e0 = 0; float m0 = el[0];
#pragma unroll
        for (int j = 1; j < EPG; ++j) if (el[j] > m0) { m0 = el[j]; e0 = j; }
        int e1 = -1; float m1 = -3.0e38f;
#pragma unroll
        for (int j = 0; j < EPG; ++j) if (j != e0 && el[j] > m1) { m1 = el[j]; e1 = j; }
        const float p1 = expf(m1 - m0); const float g0 = group_p / (1.f + p1), g1 = group_p * p1 / (1.f + p1);
        if (lane == 0) {
            const int E0 = gi * EPG + e0, E1 = gi * EPG + e1;
            tokinfo[(size_t)t * 4 + 0] = E0; tokinfo[(size_t)t * 4 + 1] = E1;
            ((float*)tokinfo)[(size_t)t * 4 + 2] = g0; ((float*)tokinfo)[(size_t)t * 4 + 3] = g1;
            const unsigned s0 = atom_add(cnt + E0 * 64, 1u); list[(size_t)E0 * T + s0] = t * 2 + 0;
            const unsigned s1 = atom_add(cnt + E1 * 64, 1u); list[(size_t)E1 * T + s1] = t * 2 + 1;
        }
    }
}
HD void moe_bases(CtxRef C, int l, int* base  ) {
    const unsigned* cnt = WSP(unsigned, WS_CTL) + CW_CNT + l * NEXP * 64;
    int acc = 0;
    for (int e = 0; e < NEXP; ++e) { base[e] = acc; acc += ((int)cnt[e * 64] + 255) & ~255; }
    base[NEXP] = acc;
}
HD int moe_expert_of_row(const int* base, int row) { int e = 0; for (int j = 1; j < NEXP; ++j) if (row >= base[j]) e = j; return e; }
HD int moe_lookup(const unsigned* cnt, int row, int& e, int& be, int& ce) {
    int acc = 0; e = 0; be = 0; ce = 0;
    for (int j = 0; j < NEXP; ++j) { const int c = (int)cnt[j * 64]; if (row >= acc) { e = j; be = acc; ce = c; } acc += (c + 255) & ~255; }
    return acc;
}
HD void stage_gather(CtxRef C, int l, int gw, int ngw, int lane) {
    const unsigned* cnt = WSP(unsigned, WS_CTL) + CW_CNT + l * NEXP * 64;
    const int* list = WSP(int, WS_LIST); const int* tokinfo = WSP(int, WS_TOKINFO);
    const bf16_t* xb = WSP(bf16_t, WS_XB); bf16_t* xg = WSP(bf16_t, WS_XG); int* rowinfo = WSP(int, WS_ROWINFO); float* rowgate = WSP(float, WS_ROWGATE);
    int e, be, ce; const int total = moe_lookup(cnt, 0, e, be, ce);
    for (int row = gw; row < total; row += ngw) {
        moe_lookup(cnt, row, e, be, ce);
        const int slot = row - be;
        if (slot < ce) { const int ent = list[(size_t)e * T + slot]; const int tok = ent >> 1;
            for (int c = lane * 8; c < DM; c += LANES * 8) *(u4v*)(xg + (size_t)row * DM + c) = *(const u4v*)(xb + (size_t)tok * DM + c);
            if (lane == 0) { rowinfo[row] = ent; rowgate[row] = ((const float*)tokinfo)[(size_t)tok * 4 + 2 + (ent & 1)]; } }
        else { const u4v z = {0u, 0u, 0u, 0u}; for (int c = lane * 8; c < DM; c += LANES * 8) *(u4v*)(xg + (size_t)row * DM + c) = z;
            if (lane == 0) { rowinfo[row] = -1; rowgate[row] = 0.f; } }
    }
}
HD void stage_ln2(CtxRef C, int l, int gw, int ngw, int lane) {
    const float* src = WSP(float, WS_X); float* dst = (l == DEPTH - 1) ? C.out : WSP(float, WS_X); bf16_t* xb = WSP(bf16_t, WS_XB);
    const float* g = INF(I_LN2G) + l * DM; const float* b = INF(I_LN2B) + l * DM;
    constexpr int PL = DM / LANES;
    for (int t = gw; t < T; t += ngw) { float keep[PL]; ln_row(src + (size_t)t * DM, g, b, dst + (size_t)t * DM, xb + (size_t)t * DM, lane, keep); }
}

struct EpiU {
    static constexpr bool PERM = true; static constexpr int MODE = 0;
    bf16_t* o;
    HDM void put8(int row, int col, const float* a) const { st8bf(o + (size_t)row * DINP + col, a); }
};
struct EpiPP {
    static constexpr bool PERM = true; static constexpr int MODE = 0;
    bf16_t* o;
    HDM void put8(int row, int col, const float* a) const { st8bf(o + (size_t)row * DM + col, a); }
};
struct EpiPre1 {
    static constexpr bool PERM = false; static constexpr int MODE = 0;
    const float* x; float* o;
    HDM void put4(int row, int col, const float* a) const { const float al = dn_alpha(); const f4v xr = *(const f4v*)(x + (size_t)row * DM + col);
        f4v r; for (int j = 0; j < 4; ++j) r[j] = al * xr[j] + a[j]; *(f4v*)(o + (size_t)row * DM + col) = r; }
};
struct EpiH {
    static constexpr bool PERM = true; static constexpr int MODE = 1;
    bf16_t* o;
    HDM void put8gu(int row, int hcol, const float* g, const float* u) const { float v[8]; for (int j = 0; j < 8; ++j) v[j] = siluf_(g[j]) * u[j];
        st8bf(o + (size_t)row * DEXP + hcol, v); }
};
struct EpiY {
    static constexpr bool PERM = true; static constexpr int MODE = 0;
    const int* rowinfo; const float* rowgate; bf16_t* o;
    HDM void put8(int row, int col, const float* a) const { const int ent = rowinfo[row]; if (ent < 0) return; const float g = rowgate[row];
        float v[8]; for (int j = 0; j < 8; ++j) v[j] = g * a[j]; st8bf(o + (size_t)ent * DM + col, v); }
};
struct EpiPre2 {
    static constexpr bool PERM = false; static constexpr int MODE = 0;
    const float* x1; const bf16_t* ybuf; const bf16_t* pp; const float* bg; float* o;
    HDM void put4(int row, int col, const float* a) const { const float al = dn_alpha(); const size_t i = (size_t)row * DM + col;
        const f4v xr = *(const f4v*)(x1 + i); const f4v bgv = *(const f4v*)(bg + col);
        const unsigned* y0 = (const unsigned*)(ybuf + (size_t)(2 * row) * DM + col); const unsigned* y1 = (const unsigned*)(ybuf + (size_t)(2 * row + 1) * DM + col); const unsigned* pq = (const unsigned*)(pp + i);
        const unsigned y00 = y0[0], y01 = y0[1], y10 = y1[0], y11 = y1[1], p0 = pq[0], p1 = pq[1];
        float yv[4] = { __builtin_bit_cast(float, y00 << 16) + __builtin_bit_cast(float, y10 << 16), __builtin_bit_cast(float, y00 & 0xffff0000u) + __builtin_bit_cast(float, y10 & 0xffff0000u),
                        __builtin_bit_cast(float, y01 << 16) + __builtin_bit_cast(float, y11 << 16), __builtin_bit_cast(float, y01 & 0xffff0000u) + __builtin_bit_cast(float, y11 & 0xffff0000u) };
        float pv[4] = { __builtin_bit_cast(float, p0 << 16), __builtin_bit_cast(float, p0 & 0xffff0000u), __builtin_bit_cast(float, p1 << 16), __builtin_bit_cast(float, p1 & 0xffff0000u) };
        f4v r; for (int j = 0; j < 4; ++j) r[j] = al * xr[j] + yv[j] + sigmoidf_(a[j] + bgv[j]) * pv[j];
        *(f4v*)(o + i) = r; }
};

#ifndef CPU_TEST
struct EpiQ {
    static constexpr bool PERM = true; static constexpr int MODE = 0;
    const float* rope; bf16_t* o;
    __device__ __forceinline__ void put8(int row, int col, const float* a) const {
        float p[8];
#pragma unroll
        for (int j = 0; j < 8; ++j) p[j] = __shfl_xor(a[j], 32);
        if (col >= 384) return;
        const float qscale = 0.10206207261596575f * 1.4426950408889634f;
        const int d0 = col % 96; float v[8];
        if (d0 < 64) {
#pragma unroll
            for (int j = 0; j < 8; ++j) v[j] = a[j] * qscale; }
        else { const int i0 = (d0 - 64) & 15; const bool x2 = (d0 - 64) >= 16; const float* rt = rope + (size_t)row * 32 + i0;
            const f4v c0 = *(const f4v*)rt, c1 = *(const f4v*)(rt + 4), s0 = *(const f4v*)(rt + 16), s1 = *(const f4v*)(rt + 20);
#pragma unroll
            for (int j = 0; j < 8; ++j) { const float c = j < 4 ? c0[j & 3] : c1[j & 3], s = j < 4 ? s0[j & 3] : s1[j & 3];
                v[j] = (x2 ? (p[j] * s + a[j] * c) : (a[j] * c - p[j] * s)) * qscale; } }
        st8bf(o + (size_t)row * 384 + col, v); }
};
struct EpiKV {
    static constexpr bool PERM = true; static constexpr int MODE = 0;
    bf16_t* k; bf16_t* v;
    __device__ __forceinline__ void put8(int row, int col, const float* a) const { const int h = col >> 7, d = col & 127;
        if (d < 64) st8bf(k + (size_t)row * 384 + h * 96 + d, a); else st8bf(v + (size_t)row * 256 + h * 64 + (d - 64), a); }
};
__device__ __forceinline__ void mla_token_pass(CtxRef C, int gw, int ngw, int lane) {
    const bf16_t* u = WSP(bf16_t, WS_U); const float* rope = WSP(float, WS_ROPE); float* rstd = WSP(float, WS_RSTD); bf16_t* K = WSP(bf16_t, WS_AK);
    for (int t = gw; t < T; t += ngw) {
        const bf16_t* ur = u + (size_t)t * DINP;
        float ssq = 0.f, sskv = 0.f;
        { const unsigned* p = (const unsigned*)(ur + UD_CQ) + 2 * lane; const unsigned w0 = p[0], w1 = p[1];
          const float a = __builtin_bit_cast(float, w0 << 16), b = __builtin_bit_cast(float, w0 & 0xffff0000u), c = __builtin_bit_cast(float, w1 << 16), d = __builtin_bit_cast(float, w1 & 0xffff0000u);
          ssq = (a * a + b * b) + (c * c + d * d); }
        { const unsigned w0 = ((const unsigned*)(ur + UD_CKV))[lane]; const float a = __builtin_bit_cast(float, w0 << 16), b = __builtin_bit_cast(float, w0 & 0xffff0000u); sskv = a * a + b * b; }
        ssq = wave_sum(ssq); sskv = wave_sum(sskv);
        if (lane == 0) { rstd[(size_t)t * 2] = 1.f / sqrtf(ssq * (1.f / 256.f) + NORM_EPS); rstd[(size_t)t * 2 + 1] = 1.f / sqrtf(sskv * (1.f / 128.f) + NORM_EPS); }
        { const int i = lane & 15, hh = lane >> 4; const float x1 = bf2f(ur[UD_KR + i]), x2 = bf2f(ur[UD_KR + 16 + i]); const float c = rope[(size_t)t * 32 + i], s = rope[(size_t)t * 32 + 16 + i];
          bf16_t* kd = K + (size_t)t * 384 + hh * 96 + 64; kd[i] = f2bf(x1 * c - x2 * s); kd[16 + i] = f2bf(x1 * s + x2 * c); }
    }
}
__device__ __forceinline__ void rwkv_prep_coop(CtxRef C, int l, __attribute__((address_space(3))) unsigned char* lds) {
    int tid = threadIdx.x; asm volatile("" : "+v"(tid));
    const int lane = tid & 63, w = __builtin_amdgcn_readfirstlane(tid >> 6);
    const bf16_t* u = WSP(bf16_t, WS_U);
    const float* mu = INF(I_MU) + l * DINA;
    float* oR = WSP(float, WS_RW_R); float* oW = WSP(float, WS_RW_W); float* oK = WSP(float, WS_RW_K); float* oV = WSP(float, WS_RW_V);
    float* oA = WSP(float, WS_RW_A); float* oB = WSP(float, WS_RW_B); float* oG = WSP(float, WS_RW_G);
    __attribute__((address_space(3))) float* act = (__attribute__((address_space(3))) float*)lds;
    const int h = w & 3, role = w >> 2, c = h * 64 + lane;
    float wc0[32], wc1[32];
    { const float* p0 = role == 0 ? INF(I_WUP) + l * 32 * GW + c : INF(I_GUP) + l * 64 * GW + c;
      const float* p1 = role == 0 ? INF(I_AUP) + l * 32 * GW + c : INF(I_GUP) + l * 64 * GW + 32 * GW + c;
#pragma unroll
      for (int j = 0; j < 32; ++j) { wc0[j] = p0[j * GW]; wc1[j] = p1[j * GW]; } }
    const float w0c = INF(I_W0)[l * GW + c], a0c = INF(I_A0)[l * GW + c], kkc = INF(I_KK)[l * GW + c], kac = INF(I_KA)[l * GW + c];
    const float mur = mu[UA_R + c], muk = mu[UA_K + c], muv = mu[UA_V + c];
    for (int unit = blockIdx.x; unit < T / 16; unit += gridDim.x) {
        const int t0 = unit * 16;
        { const int tk = tid >> 5, j0 = (tid & 31) * 4; const int t = t0 + tk; const bool first = (t % SEQ) == 0;
          const unsigned* pc = (const unsigned*)(u + (size_t)t * DINP + UA_WD + j0); const unsigned c0 = pc[0], c1 = pc[1];
          unsigned q0 = 0u, q1 = 0u; if (!first) { const unsigned* pp = (const unsigned*)(u + (size_t)(t - 1) * DINP + UA_WD + j0); q0 = pp[0]; q1 = pp[1]; }
          const float cur[4] = {__builtin_bit_cast(float, c0 << 16), __builtin_bit_cast(float, c0 & 0xffff0000u), __builtin_bit_cast(float, c1 << 16), __builtin_bit_cast(float, c1 & 0xffff0000u)};
          const float prv[4] = {__builtin_bit_cast(float, q0 << 16), __builtin_bit_cast(float, q0 & 0xffff0000u), __builtin_bit_cast(float, q1 << 16), __builtin_bit_cast(float, q1 & 0xffff0000u)};
          f4v o;
#pragma unroll
          for (int j = 0; j < 4; ++j) { const float v = cur[j] + (prv[j] - cur[j]) * mu[UA_WD + j0 + j]; o[j] = (j0 < 32) ? tanhf(v) : (j0 < 64 ? v : sigmoidf_(v)); }
          *(__attribute__((address_space(3))) f4v*)(act + tk * 128 + j0) = o; }
        __syncthreads();
#pragma unroll 1
        for (int tk = 0; tk < 16; ++tk) { const int t = t0 + tk; const bool first = (t % SEQ) == 0;
            const __attribute__((address_space(3))) float* ar = act + tk * 128 + (role == 0 ? 0 : 64);
            float s0 = 0.f, s1 = 0.f;
#pragma unroll
            for (int j = 0; j < 32; j += 4) { const f4v x = *(const __attribute__((address_space(3))) f4v*)(ar + j), y = *(const __attribute__((address_space(3))) f4v*)(ar + 32 + j);
                s0 += x[0] * wc0[j] + x[1] * wc0[j + 1] + x[2] * wc0[j + 2] + x[3] * wc0[j + 3]; s1 += y[0] * wc1[j] + y[1] * wc1[j + 1] + y[2] * wc1[j + 2] + y[3] * wc1[j + 3];
                if ((j & 12) == 12) asm volatile("" ::: "memory"); }
            const size_t o = (size_t)t * GW + c;
            if (role == 1) { oG[o] = s0 + s1; }
            else {
                const float z = w0c + s0, za = a0c + s1;
                const float lnl = -softplusf_(-z) - 0.5f; const float decay = __expf(-__expf(lnl)); const float a = sigmoidf_(za);
                const bf16_t* uc = u + (size_t)t * DINP + c; const bf16_t* up = uc - DINP;
                const float rc = bf2f(uc[UA_R]), kc = bf2f(uc[UA_K]), vc = bf2f(uc[UA_V]);
                const float rp = first ? 0.f : bf2f(up[UA_R]), kp = first ? 0.f : bf2f(up[UA_K]), vp = first ? 0.f : bf2f(up[UA_V]);
                const float r = rc + (rp - rc) * mur, k = kc + (kp - kc) * muk, v = vc + (vp - vc) * muv;
                const float kkraw = k * kkc; const float ss = wave_sum(kkraw * kkraw); const float kk = kkraw / fmaxf(sqrtf(ss), 1e-12f);
                oR[o] = r; oW[o] = decay; oK[o] = k * (1.f + (a - 1.f) * kac); oV[o] = v; oA[o] = -kk; oB[o] = kk * a; } }
        __syncthreads();
    }
}
#endif

#ifndef CPU_TEST
template <int NT> __device__ __forceinline__ void ln_rows_v(const float* src, const float* g, const float* b, float* dstf, bf16_t* dstb, int lane) {
    f4v x[NT][4];
#pragma unroll
    for (int n = 0; n < NT; ++n)
#pragma unroll
        for (int i = 0; i < 4; ++i) x[n][i] = *(const f4v*)(src + (size_t)n * DM + (i * 64 + lane) * 4);
    float mean[NT], rstd[NT];
#pragma unroll
    for (int n = 0; n < NT; ++n) { float s = 0.f;
#pragma unroll
        for (int i = 0; i < 4; ++i) s += (x[n][i][0] + x[n][i][1]) + (x[n][i][2] + x[n][i][3]);
        mean[n] = wave_sum(s) * (1.f / DM); float q = 0.f;
#pragma unroll
        for (int i = 0; i < 4; ++i) { x[n][i] = x[n][i] - mean[n]; q += (x[n][i][0] * x[n][i][0] + x[n][i][1] * x[n][i][1]) + (x[n][i][2] * x[n][i][2] + x[n][i][3] * x[n][i][3]); }
        rstd[n] = 1.f / sqrtf(wave_sum(q) * (1.f / DM) + LN_EPS); }
#pragma unroll
    for (int i = 0; i < 4; ++i) { const int c = (i * 64 + lane) * 4; const f4v gv = *(const f4v*)(g + c), bv = *(const f4v*)(b + c);
#pragma unroll
        for (int n = 0; n < NT; ++n) { const f4v y = x[n][i] * rstd[n] * gv + bv; *(f4v*)(dstf + (size_t)n * DM + c) = y;
            *(unsigned long long*)(dstb + (size_t)n * DM + c) = (unsigned long long)pk2(y[0], y[1]) | ((unsigned long long)pk2(y[2], y[3]) << 32); } }
}
__device__ __forceinline__ void stage_ln2_v(CtxRef C, int l, int gw, int ngw, int lane) {
    const float* src = WSP(float, WS_X); float* dst = (l == DEPTH - 1) ? C.out : WSP(float, WS_X); bf16_t* xb = WSP(bf16_t, WS_XB);
    const float* g = INF(I_LN2G) + l * DM; const float* b = INF(I_LN2B) + l * DM;
    for (int t = gw * 2; t < T; t += ngw * 2) ln_rows_v<2>(src + (size_t)t * DM, g, b, dst + (size_t)t * DM, xb + (size_t)t * DM, lane);
}
__device__ __forceinline__ float row_sum16(float v) { v += dpp_f(v, 0); v += dpp_f(v, 1); v += dpp_f(v, 2); v += dpp_f(v, 3); return v; }
__device__ __forceinline__ void stage_post_v(CtxRef C, int l, int gw, int ngw, int lane) {
    const bf16_t* u = WSP(bf16_t, WS_U); bf16_t* mix = WSP(bf16_t, WS_MIX);
    const float* YA = WSP(float, WS_YA); const float* YB = WSP(float, WS_YB); const float* YC = WSP(float, WS_YC); const float* DEN = WSP(float, WS_DEN);
    const float* BON = WSP(float, WS_RW_BON); const bf16_t* VS = WSP(bf16_t, WS_RW_VS); const bf16_t* GG = WSP(bf16_t, WS_RW_GG);
    const int h = lane >> 4, c = lane * 4;
    const f4v gng = *(const f4v*)(INF(I_GNG) + l * GW + c), gnb = *(const f4v*)(INF(I_GNB) + l * GW + c), glag = *(const f4v*)(INF(I_GLA_G) + l * GW + c), mlng = *(const f4v*)(INF(I_MLN_G) + l * GW + c);
#pragma unroll 2
    for (int t = gw; t < T; t += ngw) {
        const size_t o = (size_t)t * GW + c;
        const f4v ya = *(const f4v*)(YA + o), yb = *(const f4v*)(YB + o), yc = *(const f4v*)(YC + o);
        const unsigned long long wg = *(const unsigned long long*)(GG + o), wv = *(const unsigned long long*)(VS + o);
        const unsigned long long wgate = *(const unsigned long long*)(u + (size_t)t * DINP + UB_G + c), wo = *(const unsigned long long*)(u + (size_t)t * DINP + UC_O + c);
        const float bon = BON[(size_t)t * 4 + h], den = DEN[(size_t)t * 4 + h];
#define UNP4(w_, a_) const float a_[4] = {__builtin_bit_cast(float, (unsigned)(w_) << 16), __builtin_bit_cast(float, (unsigned)(w_) & 0xffff0000u), __builtin_bit_cast(float, (unsigned)((w_) >> 32) << 16), __builtin_bit_cast(float, (unsigned)((w_) >> 32) & 0xffff0000u)}
        UNP4(wg, g4); UNP4(wv, v4); UNP4(wgate, gate4); UNP4(wo, o4);
#undef UNP4
        float oa[4], ob[4], oc[4];
        {   const float mean = row_sum16((ya[0] + ya[1]) + (ya[2] + ya[3])) * (1.f / 64.f); const f4v d = ya - mean;
            const float rstd = 1.f / sqrtf(row_sum16((d[0] * d[0] + d[1] * d[1]) + (d[2] * d[2] + d[3] * d[3])) * (1.f / 64.f) + RWKV_GN_EPS);
#pragma unroll
            for (int j = 0; j < 4; ++j) oa[j] = (d[j] * rstd * gng[j] + gnb[j] + bon * v4[j]) * g4[j]; }
        {   const float rstd = 1.f / sqrtf(row_sum16((yb[0] * yb[0] + yb[1] * yb[1]) + (yb[2] * yb[2] + yb[3] * yb[3])) * (1.f / 64.f) + NORM_EPS);
#pragma unroll
            for (int j = 0; j < 4; ++j) ob[j] = yb[j] * rstd * glag[j] * siluf_(gate4[j]); }
        {   const float dinv = 1.f / fmaxf(fabsf(den), 1.f); const f4v y = yc * dinv;
            const float mean = row_sum16((y[0] + y[1]) + (y[2] + y[3])) * (1.f / 64.f); const f4v d = y - mean;
            const float rstd = 1.f / sqrtf(row_sum16((d[0] * d[0] + d[1] * d[1]) + (d[2] * d[2] + d[3] * d[3])) * (1.f / 64.f) + LN_EPS);
#pragma unroll
            for (int j = 0; j < 4; ++j) oc[j] = d[j] * rstd * mlng[j] * sigmoidf_(o4[j]); }
        bf16_t* m = mix + (size_t)t * DMIX + c;
        *(unsigned long long*)m = (unsigned long long)pk2(oa[0], oa[1]) | ((unsigned long long)pk2(oa[2], oa[3]) << 32);
        *(unsigned long long*)(m + 256) = (unsigned long long)pk2(ob[0], ob[1]) | ((unsigned long long)pk2(ob[2], ob[3]) << 32);
        *(unsigned long long*)(m + 512) = (unsigned long long)pk2(oc[0], oc[1]) | ((unsigned long long)pk2(oc[2], oc[3]) << 32);
    }
}
__device__ __forceinline__ void stage_gather_v(CtxRef C, int l, int gw, int ngw, int lane) {
    const unsigned* cnt = WSP(unsigned, WS_CTL) + CW_CNT + l * NEXP * 64;
    const int* list = WSP(int, WS_LIST); const int* tokinfo = WSP(int, WS_TOKINFO);
    const bf16_t* xb = WSP(bf16_t, WS_XB); bf16_t* xg = WSP(bf16_t, WS_XG); int* rowinfo = WSP(int, WS_ROWINFO); float* rowgate = WSP(float, WS_ROWGATE);
    int e, be, ce; const int total = moe_lookup(cnt, 0, e, be, ce);
    for (int r0 = gw * 64; r0 < total; r0 += ngw * 64) {
        moe_lookup(cnt, r0, e, be, ce);
        const int slot = r0 - be + lane; int ent = -1; float gate = 0.f;
        if (slot < ce) { ent = list[(size_t)e * T + slot]; gate = ((const float*)tokinfo)[(size_t)(ent >> 1) * 4 + 2 + (ent & 1)]; }
        rowinfo[r0 + lane] = ent; rowgate[r0 + lane] = gate;
#pragma unroll 4
        for (int r = 0; r < 64; ++r) { const int en = __builtin_amdgcn_readlane(ent, r); bf16_t* d = xg + (size_t)(r0 + r) * DM + lane * 8;
            if (en >= 0) { const bf16_t* s = xb + (size_t)(en >> 1) * DM + lane * 8; const u4v a = *(const u4v*)s, b2 = *(const u4v*)(s + 512); *(u4v*)d = a; *(u4v*)(d + 512) = b2; }
            else { const u4v z = {0u, 0u, 0u, 0u}; *(u4v*)d = z; *(u4v*)(d + 512) = z; } }
    }
}
__device__ __forceinline__ void ln1_router_coop(CtxRef C, int l, __attribute__((address_space(3))) unsigned char* lds) {
    int tid = threadIdx.x; asm volatile("" : "+v"(tid));
    const int lane = tid & 63, w = __builtin_amdgcn_readfirstlane(tid >> 6);
    float* X1 = C.out; bf16_t* xb = WSP(bf16_t, WS_XB);
    const float* g = INF(I_LN1G) + l * DM; const float* b = INF(I_LN1B) + l * DM;
    const float* wrg = INF(I_WRG) + (size_t)l * DM * NGRP; const float* brg = INF(I_BRG) + l * NGRP;
    const float* wre = INF(I_WRE) + (size_t)l * DM * NEXP; const float* bre = INF(I_BRE) + l * NEXP;
    unsigned* cnt = WSP(unsigned, WS_CTL) + CW_CNT + l * NEXP * 64;
    int* tokinfo = WSP(int, WS_TOKINFO); int* list = WSP(int, WS_LIST);
    __attribute__((address_space(3))) float* part = (__attribute__((address_space(3))) float*)lds;
    for (int tb0 = blockIdx.x * 128; tb0 < T; tb0 += gridDim.x * 128) {
        for (int i = 0; i < 16; i += 2) { const int t = tb0 + w * 16 + i;
            ln_rows_v<2>(X1 + (size_t)t * DM, g, b, X1 + (size_t)t * DM, xb + (size_t)t * DM, lane); }
        asm volatile("s_waitcnt vmcnt(0)" ::: "memory");
        __syncthreads();
        for (int half = 0; half < 2; ++half) {
            const int t = tb0 + half * 64 + lane;
            float acc[36];
#pragma unroll
            for (int j = 0; j < 36; ++j) acc[j] = 0.f;
            const float* xr = X1 + (size_t)t * DM + 128 * w;
#pragma unroll 1
            for (int k4 = 0; k4 < 32; ++k4) {
                const f4v x = *(const f4v*)(xr + 4 * k4);
#pragma unroll
                for (int kk = 0; kk < 4; ++kk) { const int k = 128 * w + 4 * k4 + kk;
                    typedef __attribute__((address_space(4))) const float cfl; cfl* we = (cfl*)(wre + (size_t)k * NEXP); cfl* wg = (cfl*)(wrg + (size_t)k * NGRP);
#pragma unroll
                    for (int j = 0; j < 4; ++j) acc[j] += x[kk] * wg[j];
#pragma unroll
                    for (int j = 0; j < 32; ++j) acc[4 + j] += x[kk] * we[j]; } }
#pragma unroll
            for (int j = 0; j < 36; ++j) part[(w * 36 + j) * 64 + lane] = acc[j];
            __syncthreads();
            if (w == 0) {
                float lg[NGRP], le[NEXP];
#pragma unroll
                for (int j = 0; j < NGRP; ++j) { float s = brg[j];
#pragma unroll
                    for (int ww = 0; ww < 8; ++ww) s += part[(ww * 36 + j) * 64 + lane]; lg[j] = s; }
#pragma unroll
                for (int j = 0; j < NEXP; ++j) { float s = bre[j];
#pragma unroll
                    for (int ww = 0; ww < 8; ++ww) s += part[(ww * 36 + 4 + j) * 64 + lane]; le[j] = s; }
                int gi = 0; float gm = lg[0];
#pragma unroll
                for (int j = 1; j < NGRP; ++j) if (lg[j] > gm) { gm = lg[j]; gi = j; }
                float gs = 0.f;
#pragma unroll
                for (int j = 0; j < NGRP; ++j) gs += expf(lg[j] - gm);
                const float group_p = 1.f / gs;
                float el[EPG];
#pragma unroll
                for (int j = 0; j < EPG; ++j) { float v = le[j];
#pragma unroll
                    for (int g2 = 1; g2 < NGRP; ++g2) v = (gi == g2) ? le[g2 * EPG + j] : v;
                    el[j] = v; }
                int e0 = 0; float m0 = el[0];
#pragma unroll
                for (int j = 1; j < EPG; ++j) if (el[j] > m0) { m0 = el[j]; e0 = j; }
                int e1 = -1; float m1 = -3.0e38f;
#pragma unroll
                for (int j = 0; j < EPG; ++j) if (j != e0 && el[j] > m1) { m1 = el[j]; e1 = j; }
                const float p1 = expf(m1 - m0); const float g0 = group_p / (1.f + p1), g1 = group_p * p1 / (1.f + p1);
                const int E0 = gi * EPG + e0, E1 = gi * EPG + e1;
                tokinfo[(size_t)t * 4 + 0] = E0; tokinfo[(size_t)t * 4 + 1] = E1;
                ((float*)tokinfo)[(size_t)t * 4 + 2] = g0; ((float*)tokinfo)[(size_t)t * 4 + 3] = g1;
                const unsigned s0 = atomicAdd(cnt + E0 * 64, 1u); list[(size_t)E0 * T + s0] = t * 2 + 0;
                const unsigned s1 = atomicAdd(cnt + E1 * 64, 1u); list[(size_t)E1 * T + s1] = t * 2 + 1;
            }
            __syncthreads();
        }
    }
}
#endif

#ifndef CPU_TEST
namespace pg8 {
#define PG8_LAS __attribute__((address_space(3)))
typedef short bf16x8 __attribute__((ext_vector_type(8)));
typedef float f32x4 __attribute__((ext_vector_type(4)));
constexpr int BM = 256, BK = 64, HALF = 128, HTB = HALF * BK * 2, STAGE_BYTES = 8 * HTB;
__device__ __forceinline__ int lds_byte(int r, int c) { const int st = (r >> 4) * 2 + (c >> 5), rr = r & 15, cc = c & 31, ob = rr * 64 + cc * 2; return st * 1024 + (ob ^ (((ob >> 9) & 1) << 5)); }
__device__ __forceinline__ void stage_rc(int b, int& R, int& C) { const int st = b / 1024, sb = b % 1024, swz = sb ^ (((sb >> 9) & 1) << 5); R = (st >> 1) * 16 + swz / 64; C = (st & 1) * 32 + (swz % 64) / 2; }
__device__ __forceinline__ int perm32(int rho) { const int n = rho >> 4, i = rho & 15; return 8 * (i >> 2) + 4 * n + (i & 3); }
struct Unit { int pm, pn; long aoff, boff; };
struct Gemm { const bf16_t* A; const bf16_t* Bt; int lda, ldb, K; };

template <class F> __device__ __forceinline__ void run_epi(const F& f, const f32x4 (&acc)[2][2][4][2], const Unit& u, int wr, int wc, int fr, int fq) {
#pragma unroll
    for (int ai = 0; ai < 2; ++ai)
#pragma unroll
        for (int m = 0; m < 4; ++m) { const int row = u.pm * BM + ai * HALF + wr * 64 + m * 16 + fr;
            if constexpr (F::MODE == 1) { const int hcol = u.pn * 128 + wc * 32 + 8 * fq; float g[8], up[8];
#pragma unroll
                for (int j = 0; j < 4; ++j) { g[j] = acc[ai][0][m][0][j]; g[4 + j] = acc[ai][0][m][1][j]; up[j] = acc[ai][1][m][0][j]; up[4 + j] = acc[ai][1][m][1][j]; }
                f.put8gu(row, hcol, g, up); }
            else if constexpr (F::PERM) {
#pragma unroll
                for (int bj = 0; bj < 2; ++bj) { const int col = u.pn * BM + bj * HALF + wc * 32 + 8 * fq; float a[8];
#pragma unroll
                    for (int j = 0; j < 4; ++j) { a[j] = acc[ai][bj][m][0][j]; a[4 + j] = acc[ai][bj][m][1][j]; }
                    f.put8(row, col, a); } }
            else {
#pragma unroll
                for (int bj = 0; bj < 2; ++bj)
#pragma unroll
                    for (int n = 0; n < 2; ++n) { const int col = u.pn * BM + bj * HALF + wc * 32 + 16 * n + 4 * fq; float a[4];
#pragma unroll
                        for (int j = 0; j < 4; ++j) a[j] = acc[ai][bj][m][n][j];
                        f.put4(row, col, a); } }
        }
}

template <class Epi, class Sched>
__device__ __forceinline__ void gemm_phase(PG8_LAS unsigned char* lds, const Gemm g, const Sched& S, const Epi& E) {
    int tid = threadIdx.x; asm volatile("" : "+v"(tid));
    const int wid = __builtin_amdgcn_readfirstlane(tid >> 6), lane = tid & 63, wr = wid >> 2, wc = wid & 3, fr = lane & 15, fq = lane >> 4;
    const int K = g.K, nt = K / BK;
    unsigned voffA[2], voffB[2];
#pragma unroll
    for (int i = 0; i < 2; ++i) { int R, C; stage_rc(tid * 16 + i * 8192, R, C); const int Rb = Epi::PERM ? ((R & ~31) + perm32(R & 31)) : R;
        voffA[i] = (unsigned)(R * g.lda + C) * 2u; voffB[i] = (unsigned)(Rb * g.ldb + C) * 2u; }
    const size_t kstep = (size_t)(BK * 2);
    const size_t hstepA = (size_t)HALF * g.lda * 2, hstepB = (size_t)HALF * g.ldb * 2;
    const unsigned ldsw = (unsigned)wid * 1024u;
    const int aoff = lds_byte(wr * 64 + fr, fq * 8), boff = lds_byte(wc * 32 + fr, fq * 8);
#define PG8_SA(b, h) (((b) * 2 + (h)) * HTB)
#define PG8_SB(b, h) ((4 + (b) * 2 + (h)) * HTB)
#define PG8_STAGE(bufoff, gbase, voff) do { _Pragma("unroll") for (int _i = 0; _i < 2; ++_i) \
        __builtin_amdgcn_global_load_lds((const unsigned*)((const char*)(gbase) + (voff)[_i]), (PG8_LAS unsigned*)(lds + (bufoff) + ldsw + _i * 8192), 16, 0, 0); } while (0)
#define PG8_LDA(dst, b, h) do { _Pragma("unroll") for (int m = 0; m < 4; ++m) _Pragma("unroll") for (int k = 0; k < 2; ++k) dst[m][k] = *(const PG8_LAS bf16x8*)(lds + PG8_SA(b, h) + aoff + m * 2048 + k * 1024); } while (0)
#define PG8_LDB(dst, b, h) do { _Pragma("unroll") for (int n = 0; n < 2; ++n) _Pragma("unroll") for (int k = 0; k < 2; ++k) dst[n][k] = *(const PG8_LAS bf16x8*)(lds + PG8_SB(b, h) + boff + n * 2048 + k * 1024); } while (0)
#define PG8_MMA(ai, bj, At, Bt) do { __builtin_amdgcn_s_setprio(1); _Pragma("unroll") for (int m = 0; m < 4; ++m) _Pragma("unroll") for (int n = 0; n < 2; ++n) _Pragma("unroll") for (int k = 0; k < 2; ++k) \
        acc[ai][bj][m][n] = __builtin_amdgcn_mfma_f32_16x16x32_bf16(Bt[n][k], At[m][k], acc[ai][bj][m][n], 0, 0, 0); __builtin_amdgcn_s_setprio(0); } while (0)
#define PG8_WAIT_V(n) asm volatile("s_waitcnt vmcnt(" #n ")" ::: "memory")
#define PG8_WAIT_L(n) asm volatile("s_waitcnt lgkmcnt(" #n ")" ::: "memory")
#define PG8_BAR __builtin_amdgcn_s_barrier()
#define PG8_SCHED __builtin_amdgcn_sched_barrier(0)
    Unit cur, nxt; int ui = 0;
    if (!S.next(0, cur)) return;
    f32x4 acc[2][2][4][2];
#pragma unroll
    for (int a = 0; a < 2; ++a)
#pragma unroll
        for (int b = 0; b < 2; ++b)
#pragma unroll
            for (int m = 0; m < 4; ++m)
#pragma unroll
                for (int n = 0; n < 2; ++n) acc[a][b][m][n] = (f32x4){0.f, 0.f, 0.f, 0.f};
    bf16x8 At[4][2], B0[2][2], B1[2][2];
    const char* cA = (const char*)g.A + cur.aoff; const char* cB = (const char*)g.Bt + cur.boff;
    PG8_STAGE(PG8_SB(0, 0), cB, voffB); PG8_STAGE(PG8_SA(0, 0), cA, voffA); PG8_STAGE(PG8_SB(0, 1), cB + hstepB, voffB); PG8_STAGE(PG8_SA(0, 1), cA + hstepA, voffA);
    if (wr == 1) PG8_BAR;
    PG8_WAIT_V(4); PG8_BAR;
    PG8_STAGE(PG8_SB(1, 0), cB + kstep, voffB); PG8_STAGE(PG8_SA(1, 0), cA + kstep, voffA); PG8_STAGE(PG8_SB(1, 1), cB + hstepB + kstep, voffB);
    PG8_WAIT_V(6); PG8_BAR;
    for (;;) {
        const bool has_next = S.next(ui + 1, nxt);
        const char* nA = has_next ? (const char*)g.A + nxt.aoff : cA; const char* nB = has_next ? (const char*)g.Bt + nxt.boff : cB;
_Pragma("unroll 1")
        for (int t = 0; t < nt; t += 2) {
            const bool last = (t == nt - 2);
            const char* a1 = cA + (size_t)(t + 1) * kstep;
            const char* a2 = last ? nA : cA + (size_t)(t + 2) * kstep; const char* b2 = last ? nB : cB + (size_t)(t + 2) * kstep;
            const char* a3 = a2 + kstep; const char* b3 = b2 + kstep;
            PG8_LDB(B0, 0, 0); PG8_SCHED; PG8_LDA(At, 0, 0); PG8_STAGE(PG8_SA(1, 1), a1 + hstepA, voffA);
            PG8_WAIT_L(8); PG8_BAR; PG8_WAIT_L(0); PG8_MMA(0, 0, At, B0); PG8_BAR; PG8_SCHED;
            PG8_LDB(B1, 0, 1); PG8_STAGE(PG8_SB(0, 0), b2, voffB);
            PG8_BAR; PG8_WAIT_L(0); PG8_MMA(0, 1, At, B1); PG8_BAR;
            PG8_LDA(At, 0, 1); PG8_STAGE(PG8_SA(0, 0), a2, voffA);
            PG8_BAR; PG8_WAIT_L(0); PG8_MMA(1, 0, At, B0); PG8_BAR; PG8_SCHED;
            PG8_STAGE(PG8_SB(0, 1), b2 + hstepB, voffB);
            PG8_WAIT_V(6); PG8_BAR; PG8_MMA(1, 1, At, B1); PG8_BAR;
            PG8_LDB(B0, 1, 0); PG8_SCHED; PG8_LDA(At, 1, 0); PG8_STAGE(PG8_SA(0, 1), a2 + hstepA, voffA);
            PG8_WAIT_L(8); PG8_BAR; PG8_WAIT_L(0); PG8_MMA(0, 0, At, B0); PG8_BAR; PG8_SCHED;
            PG8_LDB(B1, 1, 1); PG8_STAGE(PG8_SB(1, 0), b3, voffB);
            PG8_BAR; PG8_WAIT_L(0); PG8_MMA(0, 1, At, B1); PG8_BAR;
            PG8_LDA(At, 1, 1); PG8_STAGE(PG8_SA(1, 0), a3, voffA);
            PG8_BAR; PG8_WAIT_L(0); PG8_MMA(1, 0, At, B0); PG8_BAR; PG8_SCHED;
            PG8_STAGE(PG8_SB(1, 1), b3 + hstepB, voffB);
            PG8_WAIT_V(6); PG8_BAR; PG8_MMA(1, 1, At, B1); PG8_BAR;
        }
        run_epi(E, acc, cur, wr, wc, fr, fq);
        if (!has_next) break;
#pragma unroll
        for (int a = 0; a < 2; ++a)
#pragma unroll
            for (int b = 0; b < 2; ++b)
#pragma unroll
                for (int m = 0; m < 4; ++m)
#pragma unroll
                    for (int n = 0; n < 2; ++n) acc[a][b][m][n] = (f32x4){0.f, 0.f, 0.f, 0.f};
        cur = nxt; cA = nA; cB = nB; ++ui;
    }
    PG8_WAIT_V(0);
    if (wr == 0) PG8_BAR;
    PG8_BAR;
#undef PG8_SA
#undef PG8_SB
#undef PG8_STAGE
#undef PG8_LDA
#undef PG8_LDB
#undef PG8_MMA
#undef PG8_WAIT_V
#undef PG8_WAIT_L
#undef PG8_BAR
#undef PG8_SCHED
}
struct DenseOrder {
    int nM, nN, G, c; long astep, bstep;
    __device__ __forceinline__ bool next(int i, Unit& u) const {
        const long L = (long)i * G + c; if (L >= (long)nM * nN) return false;
        const int w = (int)L; const int nig = 8 * nN, gid = w / nig, fm = gid * 8, gsz = (nM - fm) < 8 ? (nM - fm) : 8;
        u.pm = fm + ((w % nig) % gsz); u.pn = (w % nig) / gsz; u.aoff = (long)u.pm * astep; u.boff = (long)u.pn * bstep; return true; }
};
struct MoeOrder {
    const PG8_LAS int* tbl; int nM, nN, G, c; long astep, bstep, estep;
    __device__ __forceinline__ bool next(int i, Unit& u) const {
        const long L = (long)i * G + c; if (L >= (long)nM * nN) return false;
        const int w = (int)L; u.pm = w / nN; u.pn = w % nN; const int e = tbl[u.pm];
        u.aoff = (long)u.pm * astep; u.boff = (long)e * estep + (long)u.pn * bstep; return true; }
};
}
#endif

#ifndef CPU_TEST
namespace att {
typedef short bf16x8 __attribute__((ext_vector_type(8)));
typedef short s16x4 __attribute__((ext_vector_type(4)));
typedef float f32x16 __attribute__((ext_vector_type(16)));
typedef float f32x2_t __attribute__((ext_vector_type(2))); typedef __bf16 bf16x2_t __attribute__((ext_vector_type(2)));
typedef unsigned u32x4 __attribute__((ext_vector_type(4)));
typedef unsigned u32x2 __attribute__((ext_vector_type(2)));
#define ATT_LAS __attribute__((address_space(3)))
#define BAR_LDS() asm volatile("s_waitcnt lgkmcnt(0)\n\ts_barrier" ::: "memory")
constexpr int KP = 104, VP = 68;
constexpr int KBUF = 64 * KP * 2, VBUF = 64 * VP * 2;
constexpr int LDS_NEED = 2 * KBUF + 2 * VBUF;
__device__ __forceinline__ unsigned cvtpk(float lo, float hi) { f32x2_t v = {lo, hi}; bf16x2_t b = __builtin_convertvector(v, bf16x2_t); return __builtin_bit_cast(unsigned, b); }
__device__ __forceinline__ int crow(int r, int hi) { return (r & 3) + 8 * (r >> 2) + 4 * hi; }
__device__ __forceinline__ u32x4 scale8(const u32x4& w, float s) { u32x4 o;
#pragma unroll
    for (int j = 0; j < 4; ++j) o[j] = cvtpk(__builtin_bit_cast(float, w[j] << 16) * s, __builtin_bit_cast(float, w[j] & 0xffff0000u) * s);
    return o; }
__device__ __forceinline__ void unit(ATT_LAS unsigned char* lds, const bf16_t* Q, const bf16_t* K, const bf16_t* V, const float* rstd, bf16_t* mix, int b, int h, int qb) {
    int tid = threadIdx.x; asm volatile("" : "+v"(tid));
    const int lane = tid & 63, w = __builtin_amdgcn_readfirstlane(tid >> 6), r32 = lane & 31, hi = lane >> 5;
    const size_t tb = (size_t)b * SEQ;
    const int q = qb * 256 + w * 32 + r32;
    bf16x8 qr[6];
    { const bf16_t* qrow = Q + (tb + q) * 384 + h * 96 + 8 * hi;
      const float rq = rstd[(tb + q) * 2];
#pragma unroll
      for (int ks = 0; ks < 6; ++ks) qr[ks] = __builtin_bit_cast(bf16x8, scale8(*(const u32x4*)(qrow + 16 * ks), rq)); }
    f32x16 o0, o1;
#pragma unroll
    for (int r = 0; r < 16; ++r) { o0[r] = 0.f; o1[r] = 0.f; }
    float m = -1e30f, lsum = 0.f;
    const int NT = 4 * (qb + 1);
    const int kr0 = tid / 12, kp0 = tid % 12, kr1 = (tid + 512) / 12, kp1 = (tid + 512) % 12; const bool has1 = tid < 256;
    const int vk = tid >> 3, vp = tid & 7;
    const bf16_t* gK0 = K + (tb + kr0) * 384 + h * 96 + kp0 * 8; const bf16_t* gK1 = K + (tb + kr1) * 384 + h * 96 + kp1 * 8;
    const bf16_t* gV = V + (tb + vk) * 256 + h * 64 + vp * 8;
    u32x4 sk0, sk1, sv; sk1 = (u32x4){0u, 0u, 0u, 0u};
    const float* gR0 = rstd + (tb + kr0) * 2 + 1; const float* gR1 = rstd + (tb + kr1) * 2 + 1; const float* gRv = rstd + (tb + vk) * 2 + 1;
    float s0 = gR0[0], s1 = has1 ? gR1[0] : 0.f, s2 = gRv[0];
    sk0 = *(const u32x4*)gK0; if (has1) sk1 = *(const u32x4*)gK1; sv = *(const u32x4*)gV;
#define ATT_WRITE(buf) do { \
        if (kp0 < 8) sk0 = scale8(sk0, s0); if (kp1 < 8) sk1 = scale8(sk1, s1); sv = scale8(sv, s2); \
        *(ATT_LAS u32x4*)(lds + (buf) * KBUF + (kr0 * KP + kp0 * 8) * 2) = sk0; \
        if (has1) *(ATT_LAS u32x4*)(lds + (buf) * KBUF + (kr1 * KP + kp1 * 8) * 2) = sk1; \
        ATT_LAS unsigned short* vt_ = (ATT_LAS unsigned short*)(lds + 2 * KBUF + (buf) * VBUF); \
        _Pragma("unroll") for (int j = 0; j < 4; ++j) { vt_[(8 * vp + 2 * j) * VP + vk] = (unsigned short)(sv[j] & 0xffffu); vt_[(8 * vp + 2 * j + 1) * VP + vk] = (unsigned short)(sv[j] >> 16); } } while (0)
    ATT_WRITE(0);
    BAR_LDS();
    for (int t = 0; t < NT; ++t) {
        const int buf = t & 1;
        if (t + 1 < NT) { const size_t adv = (size_t)(t + 1) * 64; sk0 = *(const u32x4*)(gK0 + adv * 384); if (has1) sk1 = *(const u32x4*)(gK1 + adv * 384); sv = *(const u32x4*)(gV + adv * 256);
            s0 = gR0[adv * 2]; if (has1) s1 = gR1[adv * 2]; s2 = gRv[adv * 2]; }
        f32x16 p0, p1;
#pragma unroll
        for (int r = 0; r < 16; ++r) { p0[r] = 0.f; p1[r] = 0.f; }
        { ATT_LAS const unsigned char* kb = lds + buf * KBUF + (r32 * KP + 8 * hi) * 2;
#pragma unroll
          for (int ks = 0; ks < 6; ++ks) { const bf16x8 a0 = *(ATT_LAS const bf16x8*)(kb + ks * 32), a1 = *(ATT_LAS const bf16x8*)(kb + 32 * KP * 2 + ks * 32);
              p0 = __builtin_amdgcn_mfma_f32_32x32x16_bf16(a0, qr[ks], p0, 0, 0, 0); p1 = __builtin_amdgcn_mfma_f32_32x32x16_bf16(a1, qr[ks], p1, 0, 0, 0); } }
        if (t >= NT - 4) {
            const int k0 = t * 64;
#pragma unroll
            for (int r = 0; r < 16; ++r) { const int kk = k0 + crow(r, hi); if (kk > q) p0[r] = -1e30f; if (kk + 32 > q) p1[r] = -1e30f; } }
        float rm = p0[0];
#pragma unroll
        for (int r = 1; r < 16; ++r) rm = fmaxf(rm, p0[r]);
#pragma unroll
        for (int r = 0; r < 16; ++r) rm = fmaxf(rm, p1[r]);
        rm = fmaxf(rm, __shfl_xor(rm, 32));
        const float mn = fmaxf(m, rm); const float alpha = __builtin_amdgcn_exp2f(m - mn); m = mn;
        float ps = 0.f;
#pragma unroll
        for (int r = 0; r < 16; ++r) { p0[r] = __builtin_amdgcn_exp2f(p0[r] - mn); p1[r] = __builtin_amdgcn_exp2f(p1[r] - mn); ps += p0[r] + p1[r]; }
        lsum = lsum * alpha + ps;
#pragma unroll
        for (int r = 0; r < 16; ++r) { o0[r] *= alpha; o1[r] *= alpha; }
        { ATT_LAS const unsigned char* vb = lds + 2 * KBUF + buf * VBUF + (r32 * VP + 4 * hi) * 2;
#pragma unroll
          for (int s = 0; s < 4; ++s) {
              u32x4 pw;
              if (s == 0) pw = (u32x4){cvtpk(p0[0], p0[1]), cvtpk(p0[2], p0[3]), cvtpk(p0[4], p0[5]), cvtpk(p0[6], p0[7])};
              else if (s == 1) pw = (u32x4){cvtpk(p0[8], p0[9]), cvtpk(p0[10], p0[11]), cvtpk(p0[12], p0[13]), cvtpk(p0[14], p0[15])};
              else if (s == 2) pw = (u32x4){cvtpk(p1[0], p1[1]), cvtpk(p1[2], p1[3]), cvtpk(p1[4], p1[5]), cvtpk(p1[6], p1[7])};
              else pw = (u32x4){cvtpk(p1[8], p1[9]), cvtpk(p1[10], p1[11]), cvtpk(p1[12], p1[13]), cvtpk(p1[14], p1[15])};
              const bf16x8 pb = __builtin_bit_cast(bf16x8, pw);
              const u32x2 a00 = *(ATT_LAS const u32x2*)(vb + s * 32), a01 = *(ATT_LAS const u32x2*)(vb + s * 32 + 16);
              const u32x2 a10 = *(ATT_LAS const u32x2*)(vb + 32 * VP * 2 + s * 32), a11 = *(ATT_LAS const u32x2*)(vb + 32 * VP * 2 + s * 32 + 16);
              const bf16x8 va0 = __builtin_bit_cast(bf16x8, (u32x4){a00[0], a00[1], a01[0], a01[1]}), va1 = __builtin_bit_cast(bf16x8, (u32x4){a10[0], a10[1], a11[0], a11[1]});
              o0 = __builtin_amdgcn_mfma_f32_32x32x16_bf16(va0, pb, o0, 0, 0, 0); o1 = __builtin_amdgcn_mfma_f32_32x32x16_bf16(va1, pb, o1, 0, 0, 0); } }
        if (t + 1 < NT) ATT_WRITE(buf ^ 1);
        BAR_LDS();
    }
#undef ATT_WRITE
    lsum += __shfl_xor(lsum, 32);
    const float inv = 1.f / lsum;
    bf16_t* orow = mix + (tb + q) * DMIX + 768 + h * 64;
#pragma unroll
    for (int rg = 0; rg < 4; ++rg) {
        u32x2 w0 = {cvtpk(o0[4 * rg] * inv, o0[4 * rg + 1] * inv), cvtpk(o0[4 * rg + 2] * inv, o0[4 * rg + 3] * inv)};
        u32x2 w1 = {cvtpk(o1[4 * rg] * inv, o1[4 * rg + 1] * inv), cvtpk(o1[4 * rg + 2] * inv, o1[4 * rg + 3] * inv)};
        *(u32x2*)(orow + 8 * rg + 4 * hi) = w0; *(u32x2*)(orow + 32 + 8 * rg + 4 * hi) = w1; }
}
}
#endif

#ifndef CPU_TEST
namespace lin {
using att::bf16x8; using att::f32x16; using att::u32x4; using att::u32x2; using att::cvtpk; using att::crow;
constexpr int PT = 68;
template <int DK, int NDV> struct Lay {
    static constexpr int PQ = DK + 8;
    static constexpr int OFF_Q = 0, OFF_K = OFF_Q + 64 * PQ * 2, OFF_KH = OFF_K + 64 * PQ * 2, OFF_VT = OFF_KH + DK * PT * 2, OFF_DEC = OFF_VT + NDV * PT * 2, BUF = OFF_DEC + 256;
};
__device__ __forceinline__ bf16x8 ldA16(ATT_LAS const unsigned char* p) { return *(ATT_LAS const bf16x8*)p; }
__device__ __forceinline__ bf16x8 ldP8(ATT_LAS const unsigned char* p) { const u32x2 a = *(ATT_LAS const u32x2*)p, b = *(ATT_LAS const u32x2*)(p + 16); return __builtin_bit_cast(bf16x8, (u32x4){a[0], a[1], b[0], b[1]}); }
__device__ __forceinline__ bf16x8 pack8(const f32x16& x, int s) {
    u32x4 p;
    if (s == 0) p = (u32x4){cvtpk(x[0], x[1]), cvtpk(x[2], x[3]), cvtpk(x[4], x[5]), cvtpk(x[6], x[7])};
    else p = (u32x4){cvtpk(x[8], x[9]), cvtpk(x[10], x[11]), cvtpk(x[12], x[13]), cvtpk(x[14], x[15])};
    return __builtin_bit_cast(bf16x8, p); }
#define MF32(a, b, c) __builtin_amdgcn_mfma_f32_32x32x16_bf16((a), (b), (c), 0, 0, 0)
template <int DK, int NDV> __device__ __forceinline__ void compute(ATT_LAS const unsigned char* B, int ib, int dvb, int r32, int hi, f32x16 (&H)[DK / 32], f32x16& O) {
    typedef Lay<DK, NDV> L;
    f32x16 X[2];
#pragma unroll
    for (int r = 0; r < 16; ++r) { X[0][r] = 0.f; X[1][r] = 0.f; O[r] = 0.f; }
#pragma unroll
    for (int jb = 0; jb < 2; ++jb) if (jb <= ib) {
#pragma unroll
        for (int s = 0; s < DK / 16; ++s)
            X[jb] = MF32(ldA16(B + L::OFF_K + ((32 * jb + r32) * L::PQ + 16 * s + 8 * hi) * 2), ldA16(B + L::OFF_Q + ((32 * ib + r32) * L::PQ + 16 * s + 8 * hi) * 2), X[jb]);
        if (jb == ib) {
#pragma unroll
            for (int r = 0; r < 16; ++r) if (crow(r, hi) > r32) X[jb][r] = 0.f; } }
    bf16x8 vf[2][2];
#pragma unroll
    for (int jb = 0; jb < 2; ++jb)
#pragma unroll
        for (int s = 0; s < 2; ++s) vf[jb][s] = ldP8(B + L::OFF_VT + ((32 * dvb + r32) * PT + 32 * jb + 16 * s + 4 * hi) * 2);
#pragma unroll
    for (int jb = 0; jb < 2; ++jb) if (jb <= ib) {
#pragma unroll
        for (int s = 0; s < 2; ++s) O = MF32(pack8(X[jb], s), vf[jb][s], O); }
#pragma unroll
    for (int db = 0; db < DK / 32; ++db)
#pragma unroll
        for (int s = 0; s < 2; ++s) O = MF32(ldP8(B + L::OFF_Q + ((32 * ib + r32) * L::PQ + 32 * db + 16 * s + 4 * hi) * 2), pack8(H[db], s), O);
#pragma unroll
    for (int db = 0; db < DK / 32; ++db) {
        ATT_LAS const float* dec = (ATT_LAS const float*)(B + L::OFF_DEC);
#pragma unroll
        for (int r = 0; r < 16; ++r) H[db][r] *= dec[32 * db + crow(r, hi)];
#pragma unroll
        for (int jb = 0; jb < 2; ++jb)
#pragma unroll
            for (int s = 0; s < 2; ++s) H[db] = MF32(ldP8(B + L::OFF_KH + ((32 * db + r32) * PT + 32 * jb + 16 * s + 4 * hi) * 2), vf[jb][s], H[db]); }
}
__device__ __forceinline__ float scan64(float v, int lane) {
    { int y = __builtin_amdgcn_update_dpp(0, __builtin_bit_cast(int, v), 0x111, 0xF, 0xF, true); v += __builtin_bit_cast(float, y); }
    { int y = __builtin_amdgcn_update_dpp(0, __builtin_bit_cast(int, v), 0x112, 0xF, 0xF, true); v += __builtin_bit_cast(float, y); }
    { int y = __builtin_amdgcn_update_dpp(0, __builtin_bit_cast(int, v), 0x114, 0xF, 0xF, true); v += __builtin_bit_cast(float, y); }
    { int y = __builtin_amdgcn_update_dpp(0, __builtin_bit_cast(int, v), 0x118, 0xF, 0xF, true); v += __builtin_bit_cast(float, y); }
    const int x = __builtin_bit_cast(int, v);
    const float t0 = __builtin_bit_cast(float, __builtin_amdgcn_readlane(x, 15)), t1 = __builtin_bit_cast(float, __builtin_amdgcn_readlane(x, 31)), t2 = __builtin_bit_cast(float, __builtin_amdgcn_readlane(x, 47));
    const int row = lane >> 4;
    return v + (row >= 1 ? t0 : 0.f) + (row >= 2 ? t1 : 0.f) + (row >= 3 ? t2 : 0.f); }
__device__ __forceinline__ float bfl(unsigned w) { return __builtin_bit_cast(float, w << 16); }
__device__ __forceinline__ float bfh(unsigned w) { return __builtin_bit_cast(float, w & 0xffff0000u); }
__device__ __forceinline__ void vt_write(ATT_LAS unsigned char* B, int off_vt, int tok, int part, const u32x4& sv) {
    ATT_LAS unsigned short* vt = (ATT_LAS unsigned short*)(B + off_vt);
#pragma unroll
    for (int j = 0; j < 4; ++j) { vt[(8 * part + 2 * j) * PT + tok] = (unsigned short)(sv[j] & 0xffffu); vt[(8 * part + 2 * j + 1) * PT + tok] = (unsigned short)(sv[j] >> 16); } }

#define GLA_FETCH(c) do { const size_t t_ = tb + (size_t)(c) * 64 + lane; const bf16_t* ur = u + t_ * DINP; \
        pa0 = *(const u32x4*)(ur + UB_AD); pa1 = *(const u32x4*)(ur + UB_AD + 8); pq = *(const u32x2*)(ur + UB_Q + h * 32 + 4 * w); pk = *(const u32x2*)(ur + UB_K + h * 32 + 4 * w); \
        pv = *(const u32x4*)(u + (tb + (size_t)(c) * 64 + vtok) * DINP + UB_V + h * 64 + vpart * 8); } while (0)
#define GLA_PREP(buf) do { ATT_LAS unsigned char* B_ = lds + (buf) * L::BUF; \
        float adv[16]; _Pragma("unroll") for (int j = 0; j < 4; ++j) { adv[2 * j] = bfl(pa0[j]); adv[2 * j + 1] = bfh(pa0[j]); adv[8 + 2 * j] = bfl(pa1[j]); adv[9 + 2 * j] = bfh(pa1[j]); } \
        const float qv[4] = {bfl(pq[0]), bfh(pq[0]), bfl(pq[1]), bfh(pq[1])}, kv[4] = {bfl(pk[0]), bfh(pk[0]), bfl(pk[1]), bfh(pk[1])}; \
        float qo[4], ko[4]; \
        _Pragma("unroll") for (int d = 0; d < 4; ++d) { float z = ab[d]; _Pragma("unroll") for (int j = 0; j < 16; ++j) z += adv[j] * aup[j * 128 + d]; \
            const float la = -softplusf_(-z) * (1.f / 16.f); const float bc = scan64(la, lane); const float be = __builtin_bit_cast(float, __builtin_amdgcn_readlane(__builtin_bit_cast(int, bc), 63)); \
            qo[d] = qv[d] * __expf(bc) * 0.17677669529663687f; ko[d] = kv[d] * __expf(-bc); const float kh = kv[d] * __expf(be - bc); \
            ((ATT_LAS unsigned short*)(B_ + L::OFF_KH))[(4 * w + d) * PT + lane] = f2bf(kh); \
            if (lane == 63) ((ATT_LAS float*)(B_ + L::OFF_DEC))[4 * w + d] = __expf(be); } \
        *(ATT_LAS u32x2*)(B_ + L::OFF_Q + (lane * L::PQ + 4 * w) * 2) = (u32x2){cvtpk(qo[0], qo[1]), cvtpk(qo[2], qo[3])}; \
        *(ATT_LAS u32x2*)(B_ + L::OFF_K + (lane * L::PQ + 4 * w) * 2) = (u32x2){cvtpk(ko[0], ko[1]), cvtpk(ko[2], ko[3])}; \
        vt_write(B_, L::OFF_VT, vtok, vpart, pv); } while (0)
#define ML_FETCH(c) do { const int s_ = (c) * 64 + lane; const bf16_t* ur = u + (tb + s_) * DINP; \
        _Pragma("unroll") for (int j = 0; j < 4; ++j) { const bool ok = s_ - 3 + j >= 0; const bf16_t* up = ur + (ptrdiff_t)(j - 3) * DINP; \
            xq[j] = ok ? *(const u32x4*)(up + UC_Q + h * 64 + 8 * w) : (u32x4){0u, 0u, 0u, 0u}; xk[j] = ok ? *(const u32x4*)(up + UC_K + h * 64 + 8 * w) : (u32x4){0u, 0u, 0u, 0u}; } \
        pg = *(const u32x4*)(ur + UC_IG); pv = *(const u32x4*)(u + (tb + (size_t)(c) * 64 + vtok) * DINP + UC_V + h * 64 + vpart * 8); } while (0)
#define ML_PREP(buf) do { ATT_LAS unsigned char* B_ = lds + (buf) * L::BUF; \
        const unsigned gi_ = pg[h >> 1], gf_ = pg[2 + (h >> 1)]; const float ig = ((h & 1) ? bfh(gi_) : bfl(gi_)) + ibias; const float lf = -softplusf_(-(((h & 1) ? bfh(gf_) : bfl(gf_)) + fbias)); \
        const float F = scan64(lf, lane); const float Fe = __builtin_bit_cast(float, __builtin_amdgcn_readlane(__builtin_bit_cast(int, F), 63)); const float eF = __expf(F), wk = __expf(ig - F) * 0.125f, wkh = __expf(Fe - F + ig) * 0.125f; \
        float qo[8], ko[8]; \
        _Pragma("unroll") for (int ch = 0; ch < 8; ++ch) { float yq = cb[ch], yk = cb[256 + ch]; \
            _Pragma("unroll") for (int j = 0; j < 4; ++j) { const unsigned wq_ = xq[j][ch >> 1], wk_ = xk[j][ch >> 1]; \
                yq += cw[j * 512 + ch] * ((ch & 1) ? bfh(wq_) : bfl(wq_)); yk += cw[j * 512 + 256 + ch] * ((ch & 1) ? bfh(wk_) : bfl(wk_)); } \
            const float sq = siluf_(yq), sk = siluf_(yk); qo[ch] = sq * eF; ko[ch] = sk * wk; \
            ((ATT_LAS unsigned short*)(B_ + L::OFF_KH))[(8 * w + ch) * PT + lane] = f2bf(sk * wkh); } \
        *(ATT_LAS u32x4*)(B_ + L::OFF_Q + (lane * L::PQ + 8 * w) * 2) = (u32x4){cvtpk(qo[0], qo[1]), cvtpk(qo[2], qo[3]), cvtpk(qo[4], qo[5]), cvtpk(qo[6], qo[7])}; \
        *(ATT_LAS u32x4*)(B_ + L::OFF_K + (lane * L::PQ + 8 * w) * 2) = (u32x4){cvtpk(ko[0], ko[1]), cvtpk(ko[2], ko[3]), cvtpk(ko[4], ko[5]), cvtpk(ko[6], ko[7])}; \
        if (w == 0) ((ATT_LAS float*)(B_ + L::OFF_DEC))[lane] = __expf(Fe); \
        vt_write(B_, L::OFF_VT, vtok, vpart, pv); } while (0)
template <int MIX> __device__ __forceinline__ void stage1_units(ATT_LAS unsigned char* lds, CtxRef C, int l, int first, int stride) {
    typedef Lay<(MIX == 0 ? 32 : 64), (MIX == 0 ? 64 : 96)> L;
    int tid = threadIdx.x; asm volatile("" : "+v"(tid));
    const int lane = tid & 63, w = __builtin_amdgcn_readfirstlane(tid >> 6);
    const bf16_t* u = WSP(bf16_t, WS_U);
    const int vtok = tid >> 3, vpart = tid & 7;
    unsigned char* blobs = C.ws + (MIX == 0 ? WS_GLA_BLOB : WS_ML_BLOB);
    if (MIX == 1) { for (int i = tid; i < 32 * PT; i += 512) ((ATT_LAS unsigned short*)(lds + L::OFF_VT))[64 * PT + i] = (i < PT) ? (unsigned short)0x3f80 : (unsigned short)0; }
    constexpr int NC = SEQ / 64, NV = L::BUF / 16;
    for (int uu = first; uu < BATCH * NH * NC; uu += stride) {
        const int bh = uu / NC, c = uu % NC, h = bh & 3; const size_t tb = (size_t)(bh >> 2) * SEQ;
        if (MIX == 0) { const float* aup = INF(I_GLA_UP) + l * 16 * 128 + h * 32 + 4 * w; const float* ab = INF(I_GLA_B) + l * 128 + h * 32 + 4 * w;
            u32x4 pa0, pa1, pv; u32x2 pq, pk; GLA_FETCH(c); GLA_PREP(0); }
        else { const float* cw = INF(I_CONVW) + l * 4 * 512 + h * 64 + 8 * w; const float* cb = INF(I_CONVB) + l * 512 + h * 64 + 8 * w; const float ibias = INF(I_IB)[l * 4 + h], fbias = INF(I_FB)[l * 4 + h];
            u32x4 xq[4], xk[4], pg, pv; ML_FETCH(c); ML_PREP(0); }
        BAR_LDS();
        u32x4* dst = (u32x4*)(blobs + (size_t)uu * L::BUF);
        for (int i = tid; i < NV; i += 512) dst[i] = *(ATT_LAS const u32x4*)(lds + i * 16);
        BAR_LDS();
    }
}
template <int MIX> __device__ __forceinline__ void stage2_run(ATT_LAS unsigned char* lds, CtxRef C, int b, int h) {
    typedef Lay<(MIX == 0 ? 32 : 64), (MIX == 0 ? 64 : 96)> L;
    constexpr int DK = (MIX == 0 ? 32 : 64), NDV = (MIX == 0 ? 64 : 96), NCW = (MIX == 0 ? 4 : 6);
    int tid = threadIdx.x; asm volatile("" : "+v"(tid));
    const int lane = tid & 63, w = __builtin_amdgcn_readfirstlane(tid >> 6), r32 = lane & 31, hi = lane >> 5;
    constexpr int NC = SEQ / 64, NV = L::BUF / 16, NI = (NV + 511) / 512;
    const unsigned char* blobs = C.ws + (MIX == 0 ? WS_GLA_BLOB : WS_ML_BLOB) + (size_t)(b * 4 + h) * NC * L::BUF;
    float* Y = WSP(float, (MIX == 0 ? WS_YB : WS_YC)); float* DEN = WSP(float, WS_DEN);
    const size_t tb = (size_t)b * SEQ;
    f32x16 H[DK / 32], O;
#pragma unroll
    for (int d = 0; d < DK / 32; ++d)
#pragma unroll
        for (int r = 0; r < 16; ++r) H[d][r] = 0.f;
    const int ib = (MIX == 0) ? (w >> 1) : (w / 3), dvb = (MIX == 0) ? (w & 1) : (w % 3);
    u32x4 s0[NI], s1[NI];
#define LB_FETCH(S, c) do { const u32x4* src_ = (const u32x4*)(blobs + (size_t)(c) * L::BUF); _Pragma("unroll") for (int i = 0; i < NI; ++i) { const int ix = tid + 512 * i; if (ix < NV) S[i] = src_[ix]; } } while (0)
#define LB_WRITE(S, buf) do { _Pragma("unroll") for (int i = 0; i < NI; ++i) { const int ix = tid + 512 * i; if (ix < NV) *(ATT_LAS u32x4*)(lds + (buf) * L::BUF + ix * 16) = S[i]; } } while (0)
#define LB_STEP(c, SW) do { \
        if (w < NCW) { compute<DK, NDV>(lds + ((c) & 1) * L::BUF, ib, dvb, r32, hi, H, O); \
            const size_t t0 = tb + (size_t)(c) * 64 + 32 * ib; \
            if (MIX == 0 || dvb < 2) { float* yo = Y + t0 * GW + h * 64 + 32 * dvb + r32; _Pragma("unroll") for (int r = 0; r < 16; ++r) yo[(size_t)crow(r, hi) * GW] = O[r]; } \
            else if (r32 == 0) { _Pragma("unroll") for (int r = 0; r < 16; ++r) DEN[(t0 + crow(r, hi)) * 4 + h] = O[r]; } } \
        if ((c) + 1 < NC) { LB_WRITE(SW, ((c) + 1) & 1); if ((c) + 3 < NC) LB_FETCH(SW, (c) + 3); } \
        BAR_LDS(); } while (0)
    LB_FETCH(s0, 0); LB_FETCH(s1, 1); LB_WRITE(s0, 0); LB_FETCH(s0, 2);
    BAR_LDS();
    for (int c = 0; c < NC; c += 2) { LB_STEP(c, s1); LB_STEP(c + 1, s0); }
#undef LB_FETCH
#undef LB_WRITE
#undef LB_STEP
}
#undef GLA_FETCH
#undef GLA_PREP
#undef ML_FETCH
#undef ML_PREP
#undef MF32
}
#endif

#ifndef CPU_TEST
namespace rwk {
constexpr int NB = 16;
constexpr int VEC = 6 * 64;
constexpr int BUFB = NB * VEC * 4;
__device__ __forceinline__ float dpp_add(float v, int ctrl_sel) {
    int x = __builtin_bit_cast(int, v), y;
    if (ctrl_sel == 0) y = __builtin_amdgcn_update_dpp(0, x, 0xB1, 0xF, 0xF, true);
    else if (ctrl_sel == 1) y = __builtin_amdgcn_update_dpp(0, x, 0x4E, 0xF, 0xF, true);
    else if (ctrl_sel == 2) y = __builtin_amdgcn_update_dpp(0, x, 0x141, 0xF, 0xF, true);
    else y = __builtin_amdgcn_update_dpp(0, x, 0x140, 0xF, 0xF, true);
    return v + __builtin_bit_cast(float, y); }
__device__ __forceinline__ float red16(float v) { v = dpp_add(v, 0); v = dpp_add(v, 1); v = dpp_add(v, 2); v = dpp_add(v, 3); return v; }
__device__ __forceinline__ void run(ATT_LAS unsigned char* lds, CtxRef C, int b, int h, int rg) {
    int tid = threadIdx.x; asm volatile("" : "+v"(tid));
    const int lane = tid & 63, w = __builtin_amdgcn_readfirstlane(tid >> 6);
    const float* src[6] = {WSP(float, WS_RW_A), WSP(float, WS_RW_W), WSP(float, WS_RW_B), WSP(float, WS_RW_K), WSP(float, WS_RW_R), WSP(float, WS_RW_V)};
    float* Y = WSP(float, WS_YA);
    const size_t tb = (size_t)b * SEQ;
    const int lt = tid - 256;
#define RW_LOAD(batch, buf) do { _Pragma("unroll") for (int i = 0; i < 6; ++i) { const int p = lt + 256 * i; const int st = p / 96, vc = (p % 96) >> 4, pt = p & 15; \
        const float* sp = (vc == 0 ? src[0] : vc == 1 ? src[1] : vc == 2 ? src[2] : vc == 3 ? src[3] : vc == 4 ? src[4] : src[5]); \
        const f4v v4 = *(const f4v*)(sp + (tb + (size_t)(batch) * NB + st) * GW + h * 64 + pt * 4); \
        *(ATT_LAS f4v*)(lds + (buf) * BUFB + (st * VEC + vc * 64 + pt * 4) * 4) = v4; } } while (0)
    constexpr int NBATCH = SEQ / NB;
    if (w >= 4) RW_LOAD(0, 0);
    BAR_LDS();
    const int row = 16 * rg + 4 * w + (lane >> 4), cg = lane & 15;
    float S0 = 0.f, S1 = 0.f, S2 = 0.f, S3 = 0.f;
    for (int bt = 0; bt < NBATCH; ++bt) {
        if (w >= 4) { if (bt + 1 < NBATCH) RW_LOAD(bt + 1, (bt + 1) & 1); }
        else {
            ATT_LAS const float* B = (ATT_LAS const float*)(lds + (bt & 1) * BUFB);
#pragma unroll 4
            for (int st = 0; st < NB; ++st) {
                ATT_LAS const float* P = B + st * VEC;
                const f4v a = *(ATT_LAS const f4v*)(P + 4 * cg), wv = *(ATT_LAS const f4v*)(P + 64 + 4 * cg), bb = *(ATT_LAS const f4v*)(P + 128 + 4 * cg),
                          kk = *(ATT_LAS const f4v*)(P + 192 + 4 * cg), r = *(ATT_LAS const f4v*)(P + 256 + 4 * cg);
                const float vv = P[320 + row];
                const float sa = red16((S0 * a[0] + S1 * a[1]) + (S2 * a[2] + S3 * a[3]));
                S0 = S0 * wv[0] + (sa * bb[0] + vv * kk[0]); S1 = S1 * wv[1] + (sa * bb[1] + vv * kk[1]);
                S2 = S2 * wv[2] + (sa * bb[2] + vv * kk[2]); S3 = S3 * wv[3] + (sa * bb[3] + vv * kk[3]);
                const float y = red16((S0 * r[0] + S1 * r[1]) + (S2 * r[2] + S3 * r[3]));
                if (cg == 0) Y[(tb + (size_t)bt * NB + st) * GW + h * 64 + row] = y;
            }
        }
        BAR_LDS();
    }
#undef RW_LOAD
}
}
#endif

#ifndef CPU_TEST
namespace rw7 {
using att::bf16x8; using att::f32x16; using att::u32x4; using att::u32x2; using att::cvtpk; using att::crow;
using lin::ldA16; using lin::ldP8; using lin::pack8; using lin::scan64; using lin::bfl; using lin::bfh;
#define MF32(a, b, c) __builtin_amdgcn_mfma_f32_32x32x16_bf16((a), (b), (c), 0, 0, 0)
constexpr int PA = 136, PZ = 68, PW = 40, PG_ = 72;
constexpr int X_WUP = 0, X_AUP = 5120, X_GUP = 10240, X_ACT = 19456;
constexpr int O_ZB = 71680, O_ZAB = 89088, O_RED = 106496;
constexpr int I_AT = 0, I_RT = 9216, I_BT = 18432, I_KT = 27648, I_ATT = 36864, I_BTT = 45568, I_KTT = 54272, I_VT = 62976;
constexpr int O_TIMG = O_ZAB, O_L21 = O_ZAB + 9216, O_T11T = O_ZAB + 11776, O_EX = 110592, O_GC = 126976;
static_assert(I_VT + 64 * 68 * 2 <= O_ZB && O_T11T + 2560 <= O_RED && O_RED + 4096 <= O_EX && O_EX + 16384 <= O_GC && O_GC + 256 <= 131072, "rw7 LDS map");
__device__ __forceinline__ void stage1_unit(ATT_LAS unsigned char* lds, CtxRef C, int l, int b, int h, int ch) {
    const int unit = (b * 4 + h) * (SEQ / 64) + ch;
    int tid = threadIdx.x; asm volatile("" : "+v"(tid));
    const int lane = tid & 63, w = __builtin_amdgcn_readfirstlane(tid >> 6), r32 = lane & 31, hi = lane >> 5;
    const bf16_t* u = WSP(bf16_t, WS_U); const float* mu = INF(I_MU) + l * DINA;
    const size_t t0 = (size_t)b * SEQ + (size_t)ch * 64;
    const bool seq0 = (ch == 0);
    const int atok = tid >> 3, apart = tid & 7;
    u32x4 lc0, lc1, lp0, lp1;
    { const bf16_t* p = u + (t0 + atok) * DINP + UA_WD + 16 * apart; lc0 = *(const u32x4*)p; lc1 = *(const u32x4*)(p + 8);
      if (seq0 && atok == 0) { lp0 = (u32x4){0u, 0u, 0u, 0u}; lp1 = lp0; } else { lp0 = *(const u32x4*)(p - DINP); lp1 = *(const u32x4*)(p - DINP + 8); } }
    u32x4 rc, kc, vc, rp, kp, vp;
    { const bf16_t* p = u + (t0 + lane) * DINP + h * 64 + 8 * w; rc = *(const u32x4*)(p + UA_R); kc = *(const u32x4*)(p + UA_K); vc = *(const u32x4*)(p + UA_V);
      if (seq0 && lane == 0) { rp = (u32x4){0u, 0u, 0u, 0u}; kp = rp; vp = rp; } else { rp = *(const u32x4*)(p - DINP + UA_R); kp = *(const u32x4*)(p - DINP + UA_K); vp = *(const u32x4*)(p - DINP + UA_V); } }
    { const float* wup = INF(I_WUP) + l * 32 * GW + h * 64; const float* aup = INF(I_AUP) + l * 32 * GW + h * 64; const float* gup = INF(I_GUP) + l * 64 * GW + h * 64;
      for (int i = tid; i < 2048; i += 512) { const int j = i >> 6, c = i & 63;
          ((ATT_LAS unsigned short*)(lds + X_WUP))[c * PW + j] = f2bf(wup[j * GW + c]); ((ATT_LAS unsigned short*)(lds + X_AUP))[c * PW + j] = f2bf(aup[j * GW + c]); }
      for (int i = tid; i < 4096; i += 512) { const int j = i >> 6, c = i & 63; ((ATT_LAS unsigned short*)(lds + X_GUP))[c * PG_ + j] = f2bf(gup[j * GW + c]); } }
    { float o[16];
#pragma unroll
      for (int j = 0; j < 4; ++j) { const float c0 = bfl(lc0[j]), c1 = bfh(lc0[j]), c2 = bfl(lc1[j]), c3 = bfh(lc1[j]); const float p0 = bfl(lp0[j]), p1 = bfh(lp0[j]), p2 = bfl(lp1[j]), p3 = bfh(lp1[j]);
          const float* m = mu + UA_WD + 16 * apart; o[2 * j] = c0 + (p0 - c0) * m[2 * j]; o[2 * j + 1] = c1 + (p1 - c1) * m[2 * j + 1]; o[8 + 2 * j] = c2 + (p2 - c2) * m[8 + 2 * j]; o[9 + 2 * j] = c3 + (p3 - c3) * m[9 + 2 * j]; }
      if (apart < 2) {
#pragma unroll
          for (int j = 0; j < 16; ++j) o[j] = tanhf(o[j]); }
      else if (apart >= 4) {
#pragma unroll
          for (int j = 0; j < 16; ++j) o[j] = sigmoidf_(o[j]); }
      ATT_LAS unsigned char* d = lds + X_ACT + (atok * PA + 16 * apart) * 2;
      *(ATT_LAS u32x4*)d = (u32x4){cvtpk(o[0], o[1]), cvtpk(o[2], o[3]), cvtpk(o[4], o[5]), cvtpk(o[6], o[7])};
      *(ATT_LAS u32x4*)(d + 16) = (u32x4){cvtpk(o[8], o[9]), cvtpk(o[10], o[11]), cvtpk(o[12], o[13]), cvtpk(o[14], o[15])}; }
    BAR_LDS();
    { const int tb = (w & 3) >> 1, cb = w & 1; f32x16 z0, z1;
#pragma unroll
      for (int r = 0; r < 16; ++r) { z0[r] = 0.f; z1[r] = 0.f; }
      ATT_LAS const unsigned char* arow = lds + X_ACT + ((32 * tb + r32) * PA + 8 * hi) * 2;
      if (w < 4) {
#pragma unroll
          for (int s = 0; s < 2; ++s) { z0 = MF32(ldA16(arow + 32 * s), ldA16(lds + X_WUP + ((32 * cb + r32) * PW + 16 * s + 8 * hi) * 2), z0);
              z1 = MF32(ldA16(arow + 64 + 32 * s), ldA16(lds + X_AUP + ((32 * cb + r32) * PW + 16 * s + 8 * hi) * 2), z1); }
          ATT_LAS float* zb = (ATT_LAS float*)(lds + O_ZB); ATT_LAS float* zab = (ATT_LAS float*)(lds + O_ZAB);
#pragma unroll
          for (int r = 0; r < 16; ++r) { zb[(32 * tb + crow(r, hi)) * PZ + 32 * cb + r32] = z0[r]; zab[(32 * tb + crow(r, hi)) * PZ + 32 * cb + r32] = z1[r]; }
      } else {
#pragma unroll
          for (int s = 0; s < 4; ++s) z0 = MF32(ldA16(arow + 128 + 32 * s), ldA16(lds + X_GUP + ((32 * cb + r32) * PG_ + 16 * s + 8 * hi) * 2), z0);
          bf16_t* gg = WSP(bf16_t, WS_RW_GG) + (t0 + 32 * tb) * GW + h * 64 + 32 * cb + r32;
#pragma unroll
          for (int r = 0; r < 16; ++r) gg[(size_t)crow(r, hi) * GW] = f2bf(z0[r]); } }
    BAR_LDS();
    {   const int cb8 = h * 64 + 8 * w;
        const float* w0 = INF(I_W0) + l * GW + cb8; const float* a0 = INF(I_A0) + l * GW + cb8; const float* kkw = INF(I_KK) + l * GW + cb8; const float* kaw = INF(I_KA) + l * GW + cb8;
        const float* rkw = INF(I_RK) + l * GW + cb8;
        ATT_LAS const float* zb = (ATT_LAS const float*)(lds + O_ZB) + lane * PZ + 8 * w; ATT_LAS const float* zab = (ATT_LAS const float*)(lds + O_ZAB) + lane * PZ + 8 * w;
        const f4v zA = *(ATT_LAS const f4v*)zb, zB = *(ATT_LAS const f4v*)(zb + 4), yA = *(ATT_LAS const f4v*)zab, yB = *(ATT_LAS const f4v*)(zab + 4);
        float rr[8], kk_[8], vv[8], lw[8], ai[8], kq[8]; float ss = 0.f, bon = 0.f;
#pragma unroll
        for (int i = 0; i < 8; ++i) {
            const float z = w0[i] + (i < 4 ? zA[i & 3] : zB[i & 3]), za = a0[i] + (i < 4 ? yA[i & 3] : yB[i & 3]);
            lw[i] = -__expf(-softplusf_(-z) - 0.5f); ai[i] = sigmoidf_(za);
            const unsigned wr_ = rc[i >> 1], wk_ = kc[i >> 1], wv_ = vc[i >> 1], pr_ = rp[i >> 1], pk_ = kp[i >> 1], pv_ = vp[i >> 1];
            const float r_c = (i & 1) ? bfh(wr_) : bfl(wr_), k_c = (i & 1) ? bfh(wk_) : bfl(wk_), v_c = (i & 1) ? bfh(wv_) : bfl(wv_);
            const float r_p = (i & 1) ? bfh(pr_) : bfl(pr_), k_p = (i & 1) ? bfh(pk_) : bfl(pk_), v_p = (i & 1) ? bfh(pv_) : bfl(pv_);
            rr[i] = r_c + (r_p - r_c) * mu[UA_R + cb8 + i]; const float k = k_c + (k_p - k_c) * mu[UA_K + cb8 + i]; vv[i] = v_c + (v_p - v_c) * mu[UA_V + cb8 + i];
            kq[i] = k * kkw[i]; ss += kq[i] * kq[i]; kk_[i] = k * (1.f + (ai[i] - 1.f) * kaw[i]); bon += rr[i] * kk_[i] * rkw[i]; }
        ATT_LAS float* red = (ATT_LAS float*)(lds + O_RED);
        red[w * 64 + lane] = ss; red[512 + w * 64 + lane] = bon;
        BAR_LDS();
        float sst = 0.f, bont = 0.f;
#pragma unroll
        for (int ww = 0; ww < 8; ++ww) { sst += red[ww * 64 + lane]; bont += red[512 + ww * 64 + lane]; }
        const float inv = 1.f / fmaxf(sqrtf(sst), 1e-12f);
        float at8[8], rt8[8], bt8[8], kt8[8];
#pragma unroll
        for (int i = 0; i < 8; ++i) { const float Gc = scan64(lw[i], lane); const float Gp = Gc - lw[i]; const float kkn = kq[i] * inv; const float enG = __expf(-Gc);
            at8[i] = -kkn * __expf(Gp); rt8[i] = rr[i] * __expf(Gc); bt8[i] = kkn * ai[i] * enG; kt8[i] = kk_[i] * enG;
            if (lane == 63) { const float gcv = __expf(Gc); ((ATT_LAS float*)(lds + O_GC))[8 * w + i] = gcv; WSP(float, WS_RW_GC)[(size_t)unit * 64 + 8 * w + i] = gcv; } }
        { ATT_LAS unsigned char* d = lds + (lane * PG_ + 8 * w) * 2;
          *(ATT_LAS u32x4*)(d + I_AT) = (u32x4){cvtpk(at8[0], at8[1]), cvtpk(at8[2], at8[3]), cvtpk(at8[4], at8[5]), cvtpk(at8[6], at8[7])};
          *(ATT_LAS u32x4*)(d + I_RT) = (u32x4){cvtpk(rt8[0], rt8[1]), cvtpk(rt8[2], rt8[3]), cvtpk(rt8[4], rt8[5]), cvtpk(rt8[6], rt8[7])};
          *(ATT_LAS u32x4*)(d + I_BT) = (u32x4){cvtpk(bt8[0], bt8[1]), cvtpk(bt8[2], bt8[3]), cvtpk(bt8[4], bt8[5]), cvtpk(bt8[6], bt8[7])};
          *(ATT_LAS u32x4*)(d + I_KT) = (u32x4){cvtpk(kt8[0], kt8[1]), cvtpk(kt8[2], kt8[3]), cvtpk(kt8[4], kt8[5]), cvtpk(kt8[6], kt8[7])};
#pragma unroll
          for (int i = 0; i < 8; ++i) { const int o2 = ((8 * w + i) * lin::PT + lane) * 2;
              *(ATT_LAS unsigned short*)(lds + I_ATT + o2) = f2bf(at8[i]); *(ATT_LAS unsigned short*)(lds + I_BTT + o2) = f2bf(bt8[i]);
              *(ATT_LAS unsigned short*)(lds + I_KTT + o2) = f2bf(kt8[i]); *(ATT_LAS unsigned short*)(lds + I_VT + o2) = f2bf(vv[i]); } }
        const size_t o = (t0 + lane) * GW + cb8;
        if (w == 0) WSP(float, WS_RW_BON)[(t0 + lane) * 4 + h] = bont;
        *(u32x4*)(WSP(bf16_t, WS_RW_VS) + o) = (u32x4){cvtpk(vv[0], vv[1]), cvtpk(vv[2], vv[3]), cvtpk(vv[4], vv[5]), cvtpk(vv[6], vv[7])};
    }
    BAR_LDS();
#define RW_PROD(ACC, IA, IB, rb, cb, keep) do { _Pragma("unroll") for (int r_ = 0; r_ < 16; ++r_) ACC[r_] = 0.f; \
        _Pragma("unroll") for (int k_ = 0; k_ < 4; ++k_) ACC = MF32(ldA16(lds + (IA) + ((32 * (rb) + r32) * PG_ + 16 * k_ + 8 * hi) * 2), ldA16(lds + (IB) + ((32 * (cb) + r32) * PG_ + 16 * k_ + 8 * hi) * 2), ACC); \
        if ((keep) == 1) { _Pragma("unroll") for (int r_ = 0; r_ < 16; ++r_) if (!(crow(r_, hi) < r32)) ACC[r_] = 0.f; } \
        if ((keep) == 2) { _Pragma("unroll") for (int r_ = 0; r_ < 16; ++r_) if (!(crow(r_, hi) <= r32)) ACC[r_] = 0.f; } \
        if ((keep) == 3) { _Pragma("unroll") for (int r_ = 0; r_ < 16; ++r_) if (!(crow(r_, hi) > r32)) ACC[r_] = 0.f; } \
        __builtin_amdgcn_sched_barrier(0); } while (0)
    f32x16 M00, M01, M11;
    f32x16 Z1a, Z1b;
    if (w == 2 || w == 3) { const int eb = w - 2; f32x16 L00, L01, L11;
        RW_PROD(L00, I_KT, I_AT, 0, 0, 1); RW_PROD(L01, I_KT, I_AT, 0, 1, 0); RW_PROD(L11, I_KT, I_AT, 1, 1, 1);
#pragma unroll
        for (int r = 0; r < 16; ++r) { Z1a[r] = 0.f; Z1b[r] = 0.f; }
#pragma unroll
        for (int k = 0; k < 2; ++k) { const bf16x8 v0 = ldP8(lds + I_VT + ((32 * eb + r32) * lin::PT + 16 * k + 4 * hi) * 2), v1 = ldP8(lds + I_VT + ((32 * eb + r32) * lin::PT + 32 + 16 * k + 4 * hi) * 2);
            Z1a = MF32(pack8(L00, k), v0, Z1a); Z1b = MF32(pack8(L01, k), v0, Z1b); Z1b = MF32(pack8(L11, k), v1, Z1b); } }
    if (w == 4 || w == 5) { const int eb = w - 4; f32x16 K00, K01, K11, Ya, Yb, KVa, KVb;
        RW_PROD(K00, I_KT, I_RT, 0, 0, 2); RW_PROD(K01, I_KT, I_RT, 0, 1, 0); RW_PROD(K11, I_KT, I_RT, 1, 1, 2);
#pragma unroll
        for (int r = 0; r < 16; ++r) { Ya[r] = 0.f; Yb[r] = 0.f; KVa[r] = 0.f; KVb[r] = 0.f; }
#pragma unroll
        for (int k = 0; k < 2; ++k) { const bf16x8 v0 = ldP8(lds + I_VT + ((32 * eb + r32) * lin::PT + 16 * k + 4 * hi) * 2), v1 = ldP8(lds + I_VT + ((32 * eb + r32) * lin::PT + 32 + 16 * k + 4 * hi) * 2);
            Ya = MF32(pack8(K00, k), v0, Ya); Yb = MF32(pack8(K01, k), v0, Yb); Yb = MF32(pack8(K11, k), v1, Yb);
            KVa = MF32(ldP8(lds + I_KTT + (r32 * lin::PT + 16 * k + 4 * hi) * 2), v0, KVa); KVa = MF32(ldP8(lds + I_KTT + (r32 * lin::PT + 32 + 16 * k + 4 * hi) * 2), v1, KVa);
            KVb = MF32(ldP8(lds + I_KTT + ((32 + r32) * lin::PT + 16 * k + 4 * hi) * 2), v0, KVb); KVb = MF32(ldP8(lds + I_KTT + ((32 + r32) * lin::PT + 32 + 16 * k + 4 * hi) * 2), v1, KVb); }
        ATT_LAS unsigned char* ex = lds + O_EX + (eb * 4 * 64 + lane) * 32;
#define RW_EXW(q_, A_) do { *(ATT_LAS u32x4*)(ex + (q_) * 2048) = (u32x4){cvtpk(A_[0], A_[1]), cvtpk(A_[2], A_[3]), cvtpk(A_[4], A_[5]), cvtpk(A_[6], A_[7])}; \
        *(ATT_LAS u32x4*)(ex + (q_) * 2048 + 16) = (u32x4){cvtpk(A_[8], A_[9]), cvtpk(A_[10], A_[11]), cvtpk(A_[12], A_[13]), cvtpk(A_[14], A_[15])}; } while (0)
        RW_EXW(0, Ya); RW_EXW(1, Yb); RW_EXW(2, KVa); RW_EXW(3, KVb);
#undef RW_EXW
    }
    if (w == 7) {
        f32x16 La, Lb, Lc;
        RW_PROD(La, I_AT, I_BT, 0, 0, 3); RW_PROD(Lb, I_AT, I_BT, 1, 0, 0); RW_PROD(Lc, I_AT, I_BT, 1, 1, 3);
        ATT_LAS float* Lbuf = (ATT_LAS float*)(lds + O_ZB);
#pragma unroll
        for (int r = 0; r < 16; ++r) { Lbuf[crow(r, hi) * PZ + r32] = La[r]; Lbuf[(32 + crow(r, hi)) * PZ + 32 + r32] = Lc[r];
            *(ATT_LAS unsigned short*)(lds + O_L21 + (crow(r, hi) * PW + r32) * 2) = f2bf(Lb[r]);
            *(ATT_LAS unsigned short*)(lds + O_TIMG + (crow(r, hi) * PG_ + 32 + r32) * 2) = 0; }
        asm volatile("s_waitcnt lgkmcnt(0)" ::: "memory");
        float Tc[32];
        { ATT_LAS const float* Lr = Lbuf + (32 * hi) * PZ + 32 * hi;
#pragma unroll
          for (int t = 0; t < 32; ++t) { float acc = (t == r32) ? 1.f : 0.f;
#pragma unroll
              for (int s4 = 0; s4 < (t + 3) / 4; ++s4) { const f4v lv = *(ATT_LAS const f4v*)(Lr + t * PZ + 4 * s4);
#pragma unroll
                  for (int j = 0; j < 4; ++j) if (4 * s4 + j < t) acc += lv[j] * Tc[4 * s4 + j]; }
              Tc[t] = acc; } }
#pragma unroll
        for (int t = 0; t < 32; ++t) *(ATT_LAS unsigned short*)(lds + O_TIMG + ((32 * hi + t) * PG_ + 32 * hi + r32) * 2) = f2bf(Tc[t]);
        if (hi == 0) {
#pragma unroll
            for (int q4 = 0; q4 < 4; ++q4) *(ATT_LAS u32x4*)(lds + O_T11T + (r32 * PW + 8 * q4) * 2) = (u32x4){cvtpk(Tc[8 * q4], Tc[8 * q4 + 1]), cvtpk(Tc[8 * q4 + 2], Tc[8 * q4 + 3]), cvtpk(Tc[8 * q4 + 4], Tc[8 * q4 + 5]), cvtpk(Tc[8 * q4 + 6], Tc[8 * q4 + 7])}; }
        asm volatile("s_waitcnt lgkmcnt(0)" ::: "memory");
        f32x16 X, T21;
#pragma unroll
        for (int r = 0; r < 16; ++r) { X[r] = 0.f; T21[r] = 0.f; }
#pragma unroll
        for (int k = 0; k < 2; ++k) X = MF32(ldA16(lds + O_L21 + (r32 * PW + 16 * k + 8 * hi) * 2), ldA16(lds + O_T11T + (r32 * PW + 16 * k + 8 * hi) * 2), X);
#pragma unroll
        for (int k = 0; k < 2; ++k) T21 = MF32(ldP8(lds + O_TIMG + ((32 + r32) * PG_ + 32 + 16 * k + 4 * hi) * 2), pack8(X, k), T21);
#pragma unroll
        for (int r = 0; r < 16; ++r) *(ATT_LAS unsigned short*)(lds + O_TIMG + ((32 + crow(r, hi)) * PG_ + r32) * 2) = f2bf(T21[r]);
    }
    BAR_LDS();
    if (w < 4) {
        const int nb = w & 1;
        ATT_LAS const float* gc = (ATT_LAS const float*)(lds + O_GC);
        f32x16 P0, P1;
#pragma unroll
        for (int r = 0; r < 16; ++r) { P0[r] = 0.f; P1[r] = 0.f; }
#pragma unroll
        for (int k = 0; k < 2; ++k) {
            const bf16x8 t00 = ldP8(lds + O_TIMG + (r32 * PG_ + 16 * k + 4 * hi) * 2), t10 = ldP8(lds + O_TIMG + ((32 + r32) * PG_ + 16 * k + 4 * hi) * 2), t11 = ldP8(lds + O_TIMG + ((32 + r32) * PG_ + 32 + 16 * k + 4 * hi) * 2);
            bf16x8 b0, b1;
            if (w < 2) { b0 = ldP8(lds + I_ATT + ((32 * nb + r32) * lin::PT + 16 * k + 4 * hi) * 2); b1 = ldP8(lds + I_ATT + ((32 * nb + r32) * lin::PT + 32 + 16 * k + 4 * hi) * 2); }
            else { b0 = pack8(Z1a, k); b1 = pack8(Z1b, k); }
            P0 = MF32(t00, b0, P0); P1 = MF32(t10, b0, P1); P1 = MF32(t11, b1, P1); }
        {   RW_PROD(M00, I_BT, I_RT, 0, 0, 2); RW_PROD(M01, I_BT, I_RT, 0, 1, 0); RW_PROD(M11, I_BT, I_RT, 1, 1, 2);
            f32x16 A0, A1;
#pragma unroll
            for (int r = 0; r < 16; ++r) { A0[r] = 0.f; A1[r] = 0.f; }
#pragma unroll
            for (int k = 0; k < 2; ++k) { const bf16x8 p0 = pack8(P0, k), p1 = pack8(P1, k);
                A0 = MF32(pack8(M00, k), p0, A0); A1 = MF32(pack8(M01, k), p0, A1); A1 = MF32(pack8(M11, k), p1, A1); }
            if (w < 2) { bf16_t* RY = WSP(bf16_t, WS_RW_RY) + (size_t)unit * 4096;
#pragma unroll
                for (int r = 0; r < 16; ++r) { const int t = crow(r, hi), d = 32 * nb + r32;
                    RY[t * 64 + d] = f2bf(A0[r] + bf2f(*(ATT_LAS const unsigned short*)(lds + I_RT + (t * PG_ + d) * 2)));
                    RY[(32 + t) * 64 + d] = f2bf(A1[r] + bf2f(*(ATT_LAS const unsigned short*)(lds + I_RT + ((32 + t) * PG_ + d) * 2))); } }
            else { ATT_LAS const unsigned char* ex = lds + O_EX + (nb * 4 * 64 + lane) * 32; float* Y0G = WSP(float, WS_RW_Y0) + ((size_t)unit * 4 + nb) * 1024 + lane * 16;
#pragma unroll
                for (int r4 = 0; r4 < 16; r4 += 4) { f4v y0, y1;
#pragma unroll
                    for (int j = 0; j < 4; ++j) { const int r = r4 + j; y0[j] = A0[r] + bf2f(*(ATT_LAS const unsigned short*)(ex + 2 * r)); y1[j] = A1[r] + bf2f(*(ATT_LAS const unsigned short*)(ex + 2048 + 2 * r)); }
                    *(f4v*)(Y0G + r4) = y0; *(f4v*)(Y0G + 2048 + r4) = y1; } } }
        __builtin_amdgcn_sched_barrier(0);
        {   f32x16 B0, B1;
#pragma unroll
            for (int r = 0; r < 16; ++r) { B0[r] = 0.f; B1[r] = 0.f; }
#pragma unroll
            for (int k = 0; k < 2; ++k) { const bf16x8 p0 = pack8(P0, k), p1 = pack8(P1, k);
                B0 = MF32(ldP8(lds + I_BTT + (r32 * lin::PT + 16 * k + 4 * hi) * 2), p0, B0); B0 = MF32(ldP8(lds + I_BTT + (r32 * lin::PT + 32 + 16 * k + 4 * hi) * 2), p1, B0);
                B1 = MF32(ldP8(lds + I_BTT + ((32 + r32) * lin::PT + 16 * k + 4 * hi) * 2), p0, B1); B1 = MF32(ldP8(lds + I_BTT + ((32 + r32) * lin::PT + 32 + 16 * k + 4 * hi) * 2), p1, B1); }
            if (w < 2) { bf16_t* PLg = WSP(bf16_t, WS_RW_PL) + (size_t)unit * 4096;
#pragma unroll
                for (int r = 0; r < 16; ++r) { const int t = crow(r, hi), d = 32 * nb + r32; PLg[t * 64 + d] = f2bf(gc[t] * B0[r]); PLg[(32 + t) * 64 + d] = f2bf(gc[32 + t] * B1[r]); } }
            else { ATT_LAS const unsigned char* ex = lds + O_EX + (nb * 4 * 64 + lane) * 32; float* QG = WSP(float, WS_RW_QG) + ((size_t)unit * 4 + nb) * 1024 + lane * 16;
#pragma unroll
                for (int r4 = 0; r4 < 16; r4 += 4) { f4v q0, q1;
#pragma unroll
                    for (int j = 0; j < 4; ++j) { const int r = r4 + j; q0[j] = gc[crow(r, hi)] * (B0[r] + bf2f(*(ATT_LAS const unsigned short*)(ex + 4096 + 2 * r))); q1[j] = gc[32 + crow(r, hi)] * (B1[r] + bf2f(*(ATT_LAS const unsigned short*)(ex + 6144 + 2 * r))); }
                    *(f4v*)(QG + r4) = q0; *(f4v*)(QG + 2048 + r4) = q1; } } }
    }
    BAR_LDS();
#undef RW_PROD
}
__device__ __forceinline__ void stage2_run(ATT_LAS unsigned char* lds, CtxRef C, int b, int h) {
    int tid = threadIdx.x; asm volatile("" : "+v"(tid));
    const int lane = tid & 63, w = __builtin_amdgcn_readfirstlane(tid >> 6), r32 = lane & 31, hi = lane >> 5;
    constexpr int NC = SEQ / 64; constexpr int S2_PL = 0, S2_RY = 9216, S2_GC = 18432, S2_BUF = 18688;
    const int bh = b * 4 + h; const size_t unit0 = (size_t)bh * NC;
    const bf16_t* PLg = WSP(bf16_t, WS_RW_PL) + unit0 * 4096; const bf16_t* RYg = WSP(bf16_t, WS_RW_RY) + unit0 * 4096;
    const float* QG = WSP(float, WS_RW_QG) + unit0 * 4096; const float* Y0G = WSP(float, WS_RW_Y0) + unit0 * 4096; const float* GCg = WSP(float, WS_RW_GC) + unit0 * 64;
    float* Y = WSP(float, WS_YA);
    const int i = w >> 1, eb = w & 1, srow = tid >> 3, spart = tid & 7;
    f32x16 H0, H1, q0, q1, y0;
#pragma unroll
    for (int r = 0; r < 16; ++r) { H0[r] = 0.f; H1[r] = 0.f; }
    u32x4 spl, sry; float sgc = 0.f;
#define S2_FETCH_IMG(c) do { spl = *(const u32x4*)(PLg + (size_t)(c) * 4096 + srow * 64 + spart * 8); sry = *(const u32x4*)(RYg + (size_t)(c) * 4096 + srow * 64 + spart * 8); if (tid < 64) sgc = GCg[(c) * 64 + tid]; } while (0)
#define S2_FETCH_ACC(c) do { if (w < 4) { const float* qp = QG + (size_t)(c) * 4096 + eb * 1024 + lane * 16; const float* yp = Y0G + (size_t)(c) * 4096 + (i * 2 + eb) * 1024 + lane * 16; \
            _Pragma("unroll") for (int r4 = 0; r4 < 16; r4 += 4) { const f4v a = *(const f4v*)(qp + r4), b_ = *(const f4v*)(qp + 2048 + r4), c_ = *(const f4v*)(yp + r4); \
                _Pragma("unroll") for (int j = 0; j < 4; ++j) { q0[r4 + j] = a[j]; q1[r4 + j] = b_[j]; y0[r4 + j] = c_[j]; } } } } while (0)
#define S2_WRITE(buf) do { ATT_LAS unsigned char* B_ = lds + (buf) * S2_BUF; *(ATT_LAS u32x4*)(B_ + S2_PL + (srow * PG_ + spart * 8) * 2) = spl; *(ATT_LAS u32x4*)(B_ + S2_RY + (srow * PG_ + spart * 8) * 2) = sry; \
        if (tid < 64) ((ATT_LAS float*)(B_ + S2_GC))[tid] = sgc; } while (0)
    S2_FETCH_IMG(0); S2_FETCH_ACC(0); S2_WRITE(0);
    BAR_LDS();
    for (int c = 0; c < NC; ++c) {
        if (c + 1 < NC) S2_FETCH_IMG(c + 1);
        if (w < 4) {
            ATT_LAS const unsigned char* B_ = lds + (c & 1) * S2_BUF; ATT_LAS const float* gc = (ATT_LAS const float*)(B_ + S2_GC);
            bf16x8 hb[2][2];
#pragma unroll
            for (int k = 0; k < 2; ++k) { hb[0][k] = pack8(H0, k); hb[1][k] = pack8(H1, k); }
            f32x16 Yo = y0;
#pragma unroll
            for (int r = 0; r < 16; ++r) { H0[r] = gc[crow(r, hi)] * H0[r] + q0[r]; H1[r] = gc[32 + crow(r, hi)] * H1[r] + q1[r]; }
            __builtin_amdgcn_sched_barrier(0);
            if (c + 1 < NC) S2_FETCH_ACC(c + 1);
#pragma unroll
            for (int db = 0; db < 2; ++db)
#pragma unroll
                for (int k = 0; k < 2; ++k) Yo = MF32(ldP8(B_ + S2_RY + ((32 * i + r32) * PG_ + 32 * db + 16 * k + 4 * hi) * 2), hb[db][k], Yo);
#pragma unroll
            for (int db = 0; db < 2; ++db)
#pragma unroll
                for (int k = 0; k < 2; ++k) { H0 = MF32(ldP8(B_ + S2_PL + (r32 * PG_ + 32 * db + 16 * k + 4 * hi) * 2), hb[db][k], H0); H1 = MF32(ldP8(B_ + S2_PL + ((32 + r32) * PG_ + 32 * db + 16 * k + 4 * hi) * 2), hb[db][k], H1); }
            float* yo = Y + ((size_t)b * SEQ + (size_t)c * 64 + 32 * i) * GW + h * 64 + 32 * eb + r32;
#pragma unroll
            for (int r = 0; r < 16; ++r) yo[(size_t)crow(r, hi) * GW] = Yo[r];
        }
        if (c + 1 < NC) S2_WRITE((c + 1) & 1);
        BAR_LDS();
    }
#undef S2_FETCH_IMG
#undef S2_FETCH_ACC
#undef S2_WRITE
}
#undef MF32
}
#endif

constexpr int PH_PER_LAYER = 13;
constexpr int NPHASES = DEPTH * PH_PER_LAYER;

#ifndef CPU_TEST
#define XB_TMO      128
#define XB_XCNT(j)  (256  + 64 * (j))
#define XB_XSUB(j)  (1280 + 64 * (j))
#define XB_XGEN(j)  (2304 + 64 * (j))
#define XB_TOP      3328
#define XB_TOPGEN   3392
#define XCD_BAR_WORDS 3456
#define XB_SPIN_CAP (1u << 18)
#define LAS __attribute__((address_space(3)))
__device__ __forceinline__ unsigned xb_ld(unsigned* p)              { return __hip_atomic_load(p, __ATOMIC_RELAXED, __HIP_MEMORY_SCOPE_AGENT); }
__device__ __forceinline__ unsigned xb_add(unsigned* p, unsigned v) { return __hip_atomic_fetch_add(p, v, __ATOMIC_RELAXED, __HIP_MEMORY_SCOPE_AGENT); }
__device__ __forceinline__ unsigned xb_xcc_id() { return (unsigned)__builtin_amdgcn_s_getreg((3 << 11) | 20) & 0xFu; }
#define XB_SPIN(cond, bar) do { unsigned _sp = 0; while (cond) { __builtin_amdgcn_s_sleep(1); \
    if ((++_sp & 255u) == 0u) { if (xb_ld(&(bar)[XB_TMO])) break; if (_sp > XB_SPIN_CAP) { atomicAdd(&(bar)[XB_TMO], 1u); break; } } } } while (0)
struct XcdBarrier { unsigned* bar; unsigned x; volatile LAS unsigned* st; };
__device__ __forceinline__ XcdBarrier xcd_barrier_post(unsigned* bar, volatile LAS unsigned* st) {
    XcdBarrier b; b.bar = bar; b.x = xb_xcc_id(); b.st = st;
    if (threadIdx.x == 0) (void)xb_add(&bar[XB_XCNT(b.x)], 1u);
    return b;
}
__device__ __forceinline__ void xcd_barrier_complete(unsigned* bar, unsigned x, unsigned& nloc, unsigned& nx) {
    const unsigned G = gridDim.x * gridDim.y * gridDim.z;
    unsigned sum, cnt, mine, sp = 0u;
    for (;;) {
        sum = 0u; cnt = 0u; mine = 0u;
#pragma unroll
        for (unsigned j = 0; j < 16; ++j) { const unsigned c = xb_ld(&bar[XB_XCNT(j)]); sum += c; cnt += (c > 0u) ? 1u : 0u; mine = (j == x) ? c : mine; }
        if (sum == G) break;
        __builtin_amdgcn_s_sleep(1);
        if ((++sp & 255u) == 0u) { if (xb_ld(&bar[XB_TMO])) break; if (sp > XB_SPIN_CAP) { atomicAdd(&bar[XB_TMO], 1u); break; } }
    }
    nloc = mine > 0u ? mine : 1u; nx = cnt > 0u ? cnt : 1u;
}
__device__ __forceinline__ void xcd_barrier(const XcdBarrier& b) {
    asm volatile("s_waitcnt vmcnt(0)" ::: "memory");
    __syncthreads();
    if (threadIdx.x == 0) {
        unsigned* bar = b.bar;
        __builtin_amdgcn_s_waitcnt(0);
        unsigned nloc = b.st[0], nx = b.st[1];
        if (nloc == 0u) { xcd_barrier_complete(bar, b.x, nloc, nx); b.st[0] = nloc; b.st[1] = nx; }
        const unsigned old = xb_add(&bar[XB_XSUB(b.x)], 1u);
        const unsigned gen = old / nloc;
        if (old + 1u == (gen + 1u) * nloc) {
            __builtin_amdgcn_fence(__ATOMIC_RELEASE, "agent");
            asm volatile("s_waitcnt vmcnt(0)" ::: "memory");
            const unsigned og = xb_add(&bar[XB_TOP], 1u);
            const unsigned tg = og / nx;
            if (og + 1u == (tg + 1u) * nx) xb_add(&bar[XB_TOPGEN], 1u);
            else XB_SPIN(xb_ld(&bar[XB_TOPGEN]) == tg, bar);
            __builtin_amdgcn_fence(__ATOMIC_ACQUIRE, "agent");
            xb_add(&bar[XB_XGEN(b.x)], 1u);
            asm volatile("s_waitcnt vmcnt(0)" ::: "memory");
        } else {
            XB_SPIN(xb_ld(&bar[XB_XGEN(b.x)]) == gen, bar);
            __builtin_amdgcn_fence(__ATOMIC_ACQUIRE, "agent");
            asm volatile("s_waitcnt vmcnt(0)" ::: "memory");
        }
    }
    __syncthreads();
}

constexpr int NWAVES = 8;
constexpr int RING_BYTES = 131072, MISC_OFF = RING_BYTES + 320, LDS_BYTES = 147456;
struct Args { Ctx C; int ph_lo, ph_hi; };
__device__ __forceinline__ int moe_fill_table(CtxRef C, int l, LAS int* tbl, int tid) {
    const unsigned* cnt = WSP(unsigned, WS_CTL) + CW_CNT + l * NEXP * 64;
    int e, be, ce; const int total = moe_lookup(cnt, tid * 256, e, be, ce);
    if (tid < 320) tbl[tid] = e;
    __syncthreads();
    return total >> 8;
}

__global__ void __launch_bounds__(NWAVES * 64, 2) mega(Args args) {
    extern __shared__ __attribute__((aligned(16))) unsigned char lds_raw[];
    LAS unsigned char* lds = (LAS unsigned char*)lds_raw;
    const int G = gridDim.x, bx = blockIdx.x;
    const int ngw = G * NWAVES;
    volatile LAS unsigned* MISC = (volatile LAS unsigned*)(lds + MISC_OFF);
    for (int i = threadIdx.x; i < (LDS_BYTES - RING_BYTES) / 4; i += NWAVES * 64) ((LAS unsigned*)(lds + RING_BYTES))[i] = 0u;
    __syncthreads();
    XcdBarrier bar = xcd_barrier_post((unsigned*)(args.C.ws + WS_CTL) + CW_BAR, MISC + 8);
    LAS int* tbl = (LAS int*)(lds + RING_BYTES + 1024);
    const int lo = args.ph_lo, hi = args.ph_hi;

    for (int l = 0; l < DEPTH; ++l) {
        const int p0 = l * PH_PER_LAYER;
#ifndef PHASE_MASK
#define PHASE_MASK 0x1FFF
#endif
#define IN(k) (((PHASE_MASK >> (k)) & 1) && lo <= p0 + (k) && p0 + (k) < hi)
#define LAUNDER() const __attribute__((address_space(4))) Args* ap_ = (const __attribute__((address_space(4))) Args*)__builtin_amdgcn_kernarg_segment_ptr(); asm volatile("" : "+s"(ap_)); CtxRef C = ap_->C; \
        int bxl_ = blockIdx.x; asm volatile("" : "+s"(bxl_)); const int bx = bxl_;     \
        int tid = threadIdx.x; asm volatile("" : "+v"(tid)); const int lane = tid & 63; const int wave = __builtin_amdgcn_readfirstlane(tid >> 6); const int gw = bx * NWAVES + wave; (void)gw; (void)lane; \
        wsh_t wsh = (wsh_t)(lds + wave * 16384); (void)wsh
#define SEAM(k) do { if (p0 + (k) + 1 < hi) xcd_barrier(bar); } while (0)
        if (IN(0)) { LAUNDER(); stage_convert(C, l, gw, ngw, lane, wsh); SEAM(0); }
        if (IN(1)) { LAUNDER();
            pg8::Gemm g{WSP(bf16_t, WS_XB), WSP(bf16_t, WS_WIN), DM, DM, DM};
            pg8::DenseOrder S{T / 256, DINP / 256, G, bx, (long)256 * DM * 2, (long)256 * DM * 2};
            EpiU E{WSP(bf16_t, WS_U)};
            pg8::gemm_phase(lds, g, S, E); SEAM(1); }
        if (IN(2)) { LAUNDER();
            {   pg8::Gemm g{WSP(bf16_t, WS_U) + UD_CQ, WSP(bf16_t, WS_WUQ), DINP, 256, 256};
                pg8::DenseOrder S{T / 256, 2, G, bx, (long)256 * DINP * 2, (long)256 * 256 * 2};
                EpiQ E{WSP(float, WS_ROPE), WSP(bf16_t, WS_AQ)};
                pg8::gemm_phase(lds, g, S, E); }
            {   pg8::Gemm g{WSP(bf16_t, WS_U) + UD_CKV, WSP(bf16_t, WS_WUKV), DINP, 256, 256};
                pg8::DenseOrder S{T / 256, 2, G, bx, (long)256 * DINP * 2, (long)256 * 256 * 2};
                EpiKV E{WSP(bf16_t, WS_AK), WSP(bf16_t, WS_AV)};
                pg8::gemm_phase(lds, g, S, E); }
            __syncthreads();
            mla_token_pass(C, gw, ngw, lane);
            SEAM(2); }
        if (IN(3)) { LAUNDER();
            lin::stage1_units<0>(lds, C, l, bx, G);
            lin::stage1_units<1>(lds, C, l, bx, G);
            for (int uu = bx; uu < BATCH * NH * (SEQ / 64); uu += G) { const int bh = uu / (SEQ / 64), ch = uu % (SEQ / 64); rw7::stage1_unit(lds, C, l, bh >> 2, bh & 3, ch); }
            SEAM(3); }
        if (IN(4)) { LAUNDER();
            if (bx < 32) rw7::stage2_run(lds, C, bx >> 2, bx & 3);
            else if (bx < 64) lin::stage2_run<0>(lds, C, (bx - 32) >> 2, (bx - 32) & 3);
            else if (bx < 96) lin::stage2_run<1>(lds, C, (bx - 64) >> 2, (bx - 64) & 3);
            else {
                LAS int* slot = (LAS int*)(lds + RING_BYTES + 512);
                unsigned* ctr = WSP(unsigned, WS_CTL) + CW_ATT + l * 64;
                constexpr int NQB = SEQ / 256, NUNIT = BATCH * NH * NQB;
                for (;;) {
                    if (tid == 0) *slot = (int)atomicAdd(ctr, 1u);
                    __syncthreads();
                    const int uidx = *slot;
                    __syncthreads();
                    if (uidx >= NUNIT) break;
                    const int qb = NQB - 1 - uidx / (BATCH * NH), bh = uidx % (BATCH * NH);
                    att::unit(lds, WSP(bf16_t, WS_AQ), WSP(bf16_t, WS_AK), WSP(bf16_t, WS_AV), WSP(float, WS_RSTD), WSP(bf16_t, WS_MIX), bh >> 2, bh & 3, qb);
                }
            }
            SEAM(4); }
        if (IN(5)) { LAUNDER(); stage_post_v(C, l, gw, ngw, lane); SEAM(5); }
        if (IN(6)) { LAUNDER();
            pg8::Gemm g{WSP(bf16_t, WS_MIX), WSP(bf16_t, WS_WOUT), DMIX, DMIX, DMIX};
            pg8::DenseOrder S{T / 256, DM / 256, G, bx, (long)256 * DMIX * 2, (long)256 * DMIX * 2};
            EpiPre1 E{l == 0 ? INF(I_X) : WSP(float, WS_X), C.out};
            pg8::gemm_phase(lds, g, S, E); SEAM(6); }
        if (IN(7)) { LAUNDER(); ln1_router_coop(C, l, lds); SEAM(7); }
        if (IN(8)) { LAUNDER();
            stage_gather_v(C, l, gw, ngw, lane);
            pg8::Gemm g{WSP(bf16_t, WS_PB), WSP(bf16_t, WS_WP), DPLE, DPLE, DPLE};
            pg8::DenseOrder S{T / 256, DM / 256, G, bx, (long)256 * DPLE * 2, (long)256 * DPLE * 2};
            EpiPP E{WSP(bf16_t, WS_PP)};
            pg8::gemm_phase(lds, g, S, E); SEAM(8); }
        if (IN(9)) { LAUNDER();
            pg8::Gemm g{WSP(bf16_t, WS_XG), WSP(bf16_t, WS_WGU), DM, DM, DM};
            const int ntile = moe_fill_table(C, l, tbl, tid);
            pg8::MoeOrder S{tbl, ntile, 2 * DEXP / 256, G, bx, (long)256 * DM * 2, (long)256 * DM * 2, (long)2 * DEXP * DM * 2};
            EpiH E{WSP(bf16_t, WS_H)};
            pg8::gemm_phase(lds, g, S, E); SEAM(9); }
        if (IN(10)) { LAUNDER();
            pg8::Gemm g{WSP(bf16_t, WS_H), WSP(bf16_t, WS_WD), DEXP, DEXP, DEXP};
            const int ntile = moe_fill_table(C, l, tbl, tid);
            pg8::MoeOrder S{tbl, ntile, DM / 256, G, bx, (long)256 * DEXP * 2, (long)256 * DEXP * 2, (long)DM * DEXP * 2};
            EpiY E{WSP(int, WS_ROWINFO), WSP(float, WS_ROWGATE), WSP(bf16_t, WS_YBUF)};
            pg8::gemm_phase(lds, g, S, E); SEAM(10); }
        if (IN(11)) { LAUNDER();
            pg8::Gemm g{WSP(bf16_t, WS_XB), WSP(bf16_t, WS_WPG), DM, DM, DM};
            pg8::DenseOrder S{T / 256, DM / 256, G, bx, (long)256 * DM * 2, (long)256 * DM * 2};
            EpiPre2 E{C.out, WSP(bf16_t, WS_YBUF), WSP(bf16_t, WS_PP), INF(I_PLEBG) + l * DM, WSP(float, WS_X)};
            pg8::gemm_phase(lds, g, S, E); SEAM(11); }
        if (IN(12)) { LAUNDER(); stage_ln2_v(C, l, gw, ngw, lane); SEAM(12); }
#undef IN
#undef SEAM
    }
}

extern "C" void kernel_launch(void* const* d_in, const int* in_sizes, int n_in, void* d_out, int out_size, void* d_ws, size_t ws_size, hipStream_t stream) {
    static int grid = 0;
    if (grid == 0) {
        if (n_in != N_IN || out_size != T * DM || ws_size < WS_END) { fprintf(stderr, "kernel_launch: bad sizes n_in %d out %d ws %zu need %zu\n", n_in, out_size, ws_size, (size_t)WS_END); grid = -1; return; }
        int dev = 0, cus = 0, per_cu = 0;
        hipGetDevice(&dev); hipDeviceGetAttribute(&cus, hipDeviceAttributeMultiprocessorCount, dev);
        if (hipFuncSetAttribute((const void*)mega, hipFuncAttributeMaxDynamicSharedMemorySize, LDS_BYTES) != hipSuccess) { fprintf(stderr, "hipFuncSetAttribute failed\n"); grid = -1; return; }
        if (hipOccupancyMaxActiveBlocksPerMultiprocessor(&per_cu, (const void*)mega, NWAVES * 64, LDS_BYTES) != hipSuccess || per_cu < 1) { fprintf(stderr, "occupancy query: %d\n", per_cu); }
        (void)hipGetLastError();
        grid = cus;
    }
    if (grid < 0) return;
    hipMemsetAsync((char*)d_ws + WS_CTL, 0, CTL_BYTES, stream);
    Args a{};
    for (int i = 0; i < N_IN; ++i) a.C.in[i] = d_in[i];
    a.C.out = (float*)d_out; a.C.ws = (unsigned char*)d_ws;
#ifndef ONE_LAUNCH
    for (int ph = 0; ph < NPHASES; ++ph) { a.ph_lo = ph; a.ph_hi = ph + 1; hipLaunchKernelGGL(mega, dim3(grid), dim3(NWAVES * 64), LDS_BYTES, stream, a); }
#else
    a.ph_lo = 0; a.ph_hi = NPHASES; hipLaunchKernelGGL(mega, dim3(grid), dim3(NWAVES * 64), LDS_BYTES, stream, a);
#endif
}
#else
template <class E> static void cpu_gemm(const bf16_t* A, int lda, const bf16_t* Bt, int ldb, int K, int M, int N, const E& e, const int* base = nullptr, long estep = 0) {
    for (int row = 0; row < M; ++row) {
        const bf16_t* B = Bt;
        if (base) B = Bt + (size_t)moe_expert_of_row(base, row) * estep;
        if constexpr (E::MODE == 1) {
            for (int hc = 0; hc < N / 2; hc += 8) { float g[8], u[8];
                for (int j = 0; j < 8; ++j) { float ag = 0.f, au = 0.f; const bf16_t* bg = B + (size_t)rowmap(1, hc + j) * ldb; const bf16_t* bu = B + (size_t)rowmap(2, hc + j) * ldb;
                    for (int k = 0; k < K; ++k) { const float a = bf2f(A[(size_t)row * lda + k]); ag += a * bf2f(bg[k]); au += a * bf2f(bu[k]); } g[j] = ag; u[j] = au; }
                e.put8gu(row, hc, g, u); }
        } else if constexpr (E::PERM) {
            for (int c = 0; c < N; c += 8) { float a8[8];
                for (int j = 0; j < 8; ++j) { float acc = 0.f; for (int k = 0; k < K; ++k) acc += bf2f(A[(size_t)row * lda + k]) * bf2f(B[(size_t)(c + j) * ldb + k]); a8[j] = acc; }
                e.put8(row, c, a8); }
        } else {
            for (int c = 0; c < N; c += 4) { float a4[4];
                for (int j = 0; j < 4; ++j) { float acc = 0.f; for (int k = 0; k < K; ++k) acc += bf2f(A[(size_t)row * lda + k]) * bf2f(B[(size_t)(c + j) * ldb + k]); a4[j] = acc; }
                e.put4(row, c, a4); }
        }
    }
}
static void cpu_forward(CtxRef C) {
    static float shbuf[4096];
    for (int l = 0; l < DEPTH; ++l) {
        stage_convert(C, l, 0, 1, 0, shbuf);
        { EpiU E{WSP(bf16_t, WS_U)}; cpu_gemm(WSP(bf16_t, WS_XB), DM, WSP(bf16_t, WS_WIN), DM, DM, T, DINP, E); }
        stage_prep(C, l, 0, 1, 0, shbuf);
        for (int b = 0; b < BATCH; ++b) for (int h = 0; h < NH; ++h) {
            for (int v = 0; v < 64; ++v) { rwkv_scan_thread(C, b, h, v); gla_scan_thread(C, b, h, v); }
            for (int e = 0; e < 65; ++e) mlstm_scan_thread(C, b, h, e);
            for (int q = 0; q < SEQ; ++q) attn_thread(C, b, h, q, q); }
        stage_post(C, l, 0, 1, 0);
        { EpiPre1 E{l == 0 ? INF(I_X) : WSP(float, WS_X), C.out}; cpu_gemm(WSP(bf16_t, WS_MIX), DMIX, WSP(bf16_t, WS_WOUT), DMIX, DMIX, T, DM, E); }
        stage_ln1_router(C, l, 0, 1, 0, shbuf);
        stage_gather(C, l, 0, 1, 0);
        { EpiPP E{WSP(bf16_t, WS_PP)}; cpu_gemm(WSP(bf16_t, WS_PB), DPLE, WSP(bf16_t, WS_WP), DPLE, DPLE, T, DM, E); }
        int base[NEXP + 1]; moe_bases(C, l, base);
        { EpiH E{WSP(bf16_t, WS_H)}; cpu_gemm(WSP(bf16_t, WS_XG), DM, WSP(bf16_t, WS_WGU), DM, DM, base[NEXP], 2 * DEXP, E, base, (long)2 * DEXP * DM); }
        { EpiY E{WSP(int, WS_ROWINFO), WSP(float, WS_ROWGATE), WSP(bf16_t, WS_YBUF)}; cpu_gemm(WSP(bf16_t, WS_H), DEXP, WSP(bf16_t, WS_WD), DEXP, DEXP, base[NEXP], DM, E, base, (long)DM * DEXP); }
        { EpiPre2 E{C.out, WSP(bf16_t, WS_YBUF), WSP(bf16_t, WS_PP), INF(I_PLEBG) + l * DM, WSP(float, WS_X)}; cpu_gemm(WSP(bf16_t, WS_XB), DM, WSP(bf16_t, WS_WPG), DM, DM, T, DM, E); }
        stage_ln2(C, l, 0, 1, 0);
    }
}
#endif
```

```cpp
#ifndef CPU_TEST
#include <hip/hip_runtime.h>
#include <cstdio>
#include <cstdint>
#define HD __device__ __forceinline__
#define HDM __device__ __forceinline__
#define LANES 64
#else
#include <cmath>
#include <cstdio>
#include <cstdint>
#include <cstring>
#include <algorithm>
#define HD static inline
#define HDM inline
#define LANES 1
#endif

#define ONE_LAUNCH 1
#ifndef CFG_SMALL
constexpr int BATCH = 8, SEQ = 4096, DM = 1024, DEPTH = 4, DPLE = 256, DEXP = 512;
#else
constexpr int BATCH = 2, SEQ = 256, DM = 128, DEPTH = 2, DPLE = 32, DEXP = 128;
#endif
constexpr int T = BATCH * SEQ;
constexpr int DMIX = 1024, GW = 256, HD64 = 64, NH = 4;
constexpr int DIN = 3128, DINP = 3328;
constexpr int UA = 0, UA_R = 0, UA_K = 256, UA_V = 512, UA_WD = 768, UA_AD = 800, UA_GD = 832, DINA = 896;
constexpr int UB = 896, UB_Q = 896, UB_K = 1024, UB_V = 1152, UB_AD = 1408, UB_G = 1424;
constexpr int UC = 1680, UC_Q = 1680, UC_K = 1936, UC_V = 2192, UC_O = 2448, UC_IG = 2704, UC_FG = 2708;
constexpr int UD = 2712, UD_CQ = 2712, UD_CKV = 2968, UD_KR = 3096;
constexpr int NEXP = 32, NGRP = 4, EPG = 8;
constexpr int MAXROWS = 2 * T + NEXP * 256;
constexpr float DN_ALPHA = 1.681792830507429f;
constexpr float LN_EPS = 1e-5f, NORM_EPS = 1e-6f, RWKV_GN_EPS = 64e-5f;
static_assert(DEPTH == 4 || DEPTH == 2, "alpha below assumes depth");
HD float dn_alpha() { return DEPTH == 4 ? 1.681792830507429f : 1.4142135623730951f; }

enum { I_X = 0, I_P, I_POS, I_WIN, I_MU, I_W0, I_WUP, I_A0, I_AUP, I_GUP, I_KK, I_KA, I_RK, I_GNG, I_GNB, I_GLA_UP, I_GLA_B, I_GLA_G,
       I_CONVW, I_CONVB, I_IB, I_FB, I_MLN_G, I_QNG, I_WUQ, I_KVNG, I_WUKV, I_WOUT, I_LN1G, I_LN1B, I_WRG, I_BRG, I_WRE, I_BRE,
       I_WG, I_WU, I_WD, I_PLEG, I_PLEBG, I_PLEW, I_LN2G, I_LN2B, N_IN };

typedef unsigned short bf16_t;
HD float bf2f(bf16_t h) { unsigned u = (unsigned)h << 16; return __builtin_bit_cast(float, u); }
HD bf16_t f2bf(float f) { unsigned u = __builtin_bit_cast(unsigned, f); return (bf16_t)((u + 0x7fffu + ((u >> 16) & 1u)) >> 16); }
#ifndef CPU_TEST
HD unsigned pk2(float lo, float hi) { typedef float f2_t __attribute__((ext_vector_type(2))); typedef __bf16 b2_t __attribute__((ext_vector_type(2)));
    f2_t v = {lo, hi}; b2_t b = __builtin_convertvector(v, b2_t); return __builtin_bit_cast(unsigned, b); }
#else
HD unsigned pk2(float lo, float hi) { return (unsigned)f2bf(lo) | ((unsigned)f2bf(hi) << 16); }
#endif
typedef float f4v __attribute__((vector_size(16)));
typedef unsigned u4v __attribute__((vector_size(16)));
HD void ld8bf(const bf16_t* p, float* o) { const u4v w = *(const u4v*)p;
    for (int j = 0; j < 4; ++j) { o[2 * j] = __builtin_bit_cast(float, w[j] << 16); o[2 * j + 1] = __builtin_bit_cast(float, w[j] & 0xffff0000u); } }
HD void st8bf(bf16_t* p, const float* a) { u4v w; for (int j = 0; j < 4; ++j) w[j] = pk2(a[2 * j], a[2 * j + 1]); *(u4v*)p = w; }

constexpr size_t MiB = (size_t)1 << 20;
constexpr size_t al256(size_t x) { return (x + 255) & ~(size_t)255; }
constexpr size_t WS_CTL = 0, CTL_BYTES = 1 * MiB;
constexpr size_t WS_WIN = WS_CTL + CTL_BYTES;
constexpr size_t WS_WOUT = WS_WIN + al256((size_t)DINP * DM * 2);
constexpr size_t WS_WPG = WS_WOUT + al256((size_t)DM * DMIX * 2);
constexpr size_t WS_WP = WS_WPG + al256((size_t)DM * DM * 2);
constexpr size_t WS_WGU = WS_WP + al256((size_t)DM * DPLE * 2);
constexpr size_t WS_WD = WS_WGU + al256((size_t)NEXP * 2 * DEXP * DM * 2);
constexpr size_t WS_X = WS_WD + al256((size_t)NEXP * DM * DEXP * 2);
constexpr size_t WS_XB = WS_X + al256((size_t)T * DM * 4);
constexpr size_t WS_U = WS_XB + al256((size_t)T * DM * 2);
constexpr size_t WS_MIX = WS_U + al256((size_t)T * DINP * 2);
constexpr size_t WS_PB = WS_MIX + al256((size_t)T * DMIX * 2);
constexpr size_t WS_WUQ = WS_PB + al256((size_t)T * DPLE * 2);
constexpr size_t WS_WUKV = WS_WUQ + al256((size_t)512 * 256 * 2);
constexpr size_t WS_ROPE = WS_WUKV + al256((size_t)512 * 256 * 2);
constexpr size_t WS_RSTD = WS_ROPE + al256((size_t)T * 32 * 4);
constexpr size_t WS_SCR = WS_RSTD + al256((size_t)T * 2 * 4);
constexpr size_t TV = al256((size_t)T * GW * 4);
constexpr size_t WS_RW_R = WS_SCR, WS_RW_W = WS_RW_R + TV, WS_RW_K = WS_RW_W + TV, WS_RW_V = WS_RW_K + TV, WS_RW_A = WS_RW_V + TV,
                 WS_RW_B = WS_RW_A + TV, WS_RW_G = WS_RW_B + TV;
constexpr size_t WS_RW_PL = WS_RW_R, WS_RW_RY = WS_RW_R + (size_t)16 * MiB;
constexpr size_t WS_RW_QG = WS_RW_W, WS_RW_Y0 = WS_RW_K, WS_RW_GC = WS_RW_V;
static_assert(TV >= (size_t)32 * MiB || T < 32768, "chunk buffers alias the f32 field region");
constexpr size_t WS_YA = WS_RW_G + TV, WS_YB = WS_YA + TV, WS_YC = WS_YB + TV;
constexpr size_t WS_DEN = WS_YC + TV;
constexpr size_t WS_QK = WS_DEN + al256((size_t)T * 4 * 4);
constexpr size_t WS_GA = WS_QK + al256((size_t)T * 512 * 4);
constexpr size_t WS_LG = WS_GA + al256((size_t)T * 128 * 4);
constexpr size_t WS_AQ = WS_LG + al256((size_t)T * 8 * 4);
constexpr size_t WS_AK = WS_AQ + al256((size_t)T * 384 * 2);
constexpr size_t WS_AV = WS_AK + al256((size_t)T * 384 * 2);
constexpr size_t WS_RW_GG = WS_AV + al256((size_t)T * 256 * 2);
constexpr size_t WS_RW_VS = WS_RW_GG + al256((size_t)T * 256 * 2);
constexpr size_t WS_RW_BON = WS_RW_VS + al256((size_t)T * 256 * 2);
constexpr size_t WS_GLA_BLOB = WS_QK;
constexpr size_t WS_ML_BLOB = WS_RW_A;
constexpr size_t WS_MIXER_END = WS_RW_BON + al256((size_t)T * 4 * 4);
constexpr size_t WS_XG = WS_SCR;
constexpr size_t WS_H = WS_XG + al256((size_t)MAXROWS * DM * 2);
constexpr size_t WS_YBUF = WS_H + al256((size_t)MAXROWS * DEXP * 2);
constexpr size_t WS_PP = WS_YBUF + al256((size_t)2 * T * DM * 2);
constexpr size_t WS_TOKINFO = WS_PP + al256((size_t)T * DM * 2);
constexpr size_t WS_LIST = WS_TOKINFO + al256((size_t)T * 16);
constexpr size_t WS_ROWINFO = WS_LIST + al256((size_t)NEXP * T * 4);
constexpr size_t WS_ROWGATE = WS_ROWINFO + al256((size_t)MAXROWS * 4);
constexpr size_t WS_MOE_END = WS_ROWGATE + al256((size_t)MAXROWS * 4);
constexpr size_t WS_END = WS_MIXER_END > WS_MOE_END ? WS_MIXER_END : WS_MOE_END;
constexpr int CW_BAR = 4096;
constexpr int CW_ATT = 8192;
constexpr int CW_CNT = 16384;

struct Ctx {
    const void* in[N_IN];
    float* out;
    unsigned char* ws;
};
#ifndef CPU_TEST
typedef const __attribute__((address_space(4))) Ctx& CtxRef;
#else
typedef CtxRef CtxRef;
#endif
#define INF(i) ((const float*)C.in[i])
#define WSP(T_, off) ((T_*)(C.ws + (off)))

#ifndef CPU_TEST
HD float dpp_f(float v, int sel) { const int x = __builtin_bit_cast(int, v); int y;
    if (sel == 0) y = __builtin_amdgcn_update_dpp(0, x, 0xB1, 0xF, 0xF, true);
    else if (sel == 1) y = __builtin_amdgcn_update_dpp(0, x, 0x4E, 0xF, 0xF, true);
    else if (sel == 2) y = __builtin_amdgcn_update_dpp(0, x, 0x141, 0xF, 0xF, true);
    else y = __builtin_amdgcn_update_dpp(0, x, 0x140, 0xF, 0xF, true);
    return __builtin_bit_cast(float, y); }
HD float wave_sum(float v) {
    v += dpp_f(v, 0); v += dpp_f(v, 1); v += dpp_f(v, 2); v += dpp_f(v, 3);
    const int x = __builtin_bit_cast(int, v);
    return (__builtin_bit_cast(float, __builtin_amdgcn_readlane(x, 0)) + __builtin_bit_cast(float, __builtin_amdgcn_readlane(x, 16))) +
           (__builtin_bit_cast(float, __builtin_amdgcn_readlane(x, 32)) + __builtin_bit_cast(float, __builtin_amdgcn_readlane(x, 48))); }
HD float wave_max(float v) {
    v = fmaxf(v, dpp_f(v, 0)); v = fmaxf(v, dpp_f(v, 1)); v = fmaxf(v, dpp_f(v, 2)); v = fmaxf(v, dpp_f(v, 3));
    const int x = __builtin_bit_cast(int, v);
    return fmaxf(fmaxf(__builtin_bit_cast(float, __builtin_amdgcn_readlane(x, 0)), __builtin_bit_cast(float, __builtin_amdgcn_readlane(x, 16))),
                 fmaxf(__builtin_bit_cast(float, __builtin_amdgcn_readlane(x, 32)), __builtin_bit_cast(float, __builtin_amdgcn_readlane(x, 48)))); }
HD unsigned atom_add(unsigned* p, unsigned v) { return atomicAdd(p, v); }
#define WSYNC() __builtin_amdgcn_wave_barrier(); asm volatile("s_waitcnt lgkmcnt(0)" ::: "memory")
typedef __attribute__((address_space(3))) float* wsh_t;
#else
HD float wave_sum(float v) { return v; }
HD float wave_max(float v) { return v; }
HD unsigned atom_add(unsigned* p, unsigned v) { unsigned o = *p; *p += v; return o; }
#define WSYNC()
typedef float* wsh_t;
#endif
HD float sigmoidf_(float x) { return 1.f / (1.f + expf(-x)); }
#ifndef CPU_TEST
HD float softplusf_(float x) { return x > 15.f ? x : __logf(1.f + __expf(x)); }
#else
HD float softplusf_(float x) { return x > 20.f ? x : (x < -20.f ? expf(x) : log1pf(expf(x))); }
#endif
HD float siluf_(float x) { return x * sigmoidf_(x); }

HD int rowmap(int mode, int n) { return mode == 0 ? n : (mode == 1 ? (n >> 7) * 256 + (n & 127) : (n >> 7) * 256 + 128 + (n & 127)); }
HD void transpose_item(const float* W, int K, int N, int ldw, bf16_t* WT, int ldk, int mode, int item, int lane, wsh_t scr) {
    const int nblk = (N + 31) / 32, kb = item / nblk, nb = item % nblk, k0 = 64 * kb, n0 = 32 * nb;
    for (int idx = lane; idx < 2048; idx += LANES) { const int kk = idx >> 5, nn = idx & 31; const int n = n0 + nn;
        scr[kk * 33 + nn] = (n < N) ? W[(size_t)(k0 + kk) * ldw + n] : 0.f; }
    WSYNC();
    for (int idx = lane; idx < 256; idx += LANES) { const int n = idx >> 3, c = idx & 7;
        unsigned o[4];
        for (int j = 0; j < 4; ++j) o[j] = pk2(scr[(8 * c + 2 * j) * 33 + n], scr[(8 * c + 2 * j + 1) * 33 + n]);
        unsigned* dst = (unsigned*)(WT + (size_t)rowmap(mode, n0 + n) * ldk + k0 + 8 * c);
        dst[0] = o[0]; dst[1] = o[1]; dst[2] = o[2]; dst[3] = o[3]; }
    WSYNC();
}
HD void stage_convert(CtxRef C, int l, int gw, int ngw, int lane, wsh_t scr) {
    constexpr int NB_IN = DINP / 32;
    constexpr int I_IN = (DM / 64) * NB_IN, I_OUT = (DMIX / 64) * (DM / 32), I_PG = (DM / 64) * (DM / 32), I_PW = (DPLE / 64 > 0 ? DPLE / 64 : 1) * (DM / 32);
    constexpr int I_G1 = (DM / 64) * (DEXP / 32), I_D1 = (DEXP / 64) * (DM / 32);
    constexpr int NIT = I_IN + I_OUT + I_PG + I_PW + NEXP * (2 * I_G1 + I_D1);
    static_assert(DPLE % 32 == 0 && DEXP % 64 == 0, "shapes");
    for (int it = gw; it < NIT; it += ngw) {
        int r = it;
        if (r < I_IN) {
            const int nblk = NB_IN, kb = r / nblk, nb = r % nblk, k0 = 64 * kb, n0 = 32 * nb;
            const float* W = INF(I_WIN) + (size_t)l * DM * DIN; bf16_t* WT = WSP(bf16_t, WS_WIN);
            for (int idx = lane; idx < 2048; idx += LANES) { const int kk = idx >> 5, nn = idx & 31; const int n = n0 + nn;
                scr[kk * 33 + nn] = (n < DIN) ? W[(size_t)(k0 + kk) * DIN + n] : 0.f; }
            WSYNC();
            for (int idx = lane; idx < 256; idx += LANES) { const int n = idx >> 3, c = idx & 7; unsigned o[4];
                for (int j = 0; j < 4; ++j) o[j] = pk2(scr[(8 * c + 2 * j) * 33 + n], scr[(8 * c + 2 * j + 1) * 33 + n]);
                unsigned* dst = (unsigned*)(WT + (size_t)(n0 + n) * DM + k0 + 8 * c); dst[0] = o[0]; dst[1] = o[1]; dst[2] = o[2]; dst[3] = o[3]; }
            WSYNC();
            continue; }
        r -= I_IN;
        if (r < I_OUT) { transpose_item(INF(I_WOUT) + (size_t)l * DMIX * DM, DMIX, DM, DM, WSP(bf16_t, WS_WOUT), DMIX, 0, r, lane, scr); continue; } r -= I_OUT;
        if (r < I_PG) { transpose_item(INF(I_PLEG) + (size_t)l * DM * DM, DM, DM, DM, WSP(bf16_t, WS_WPG), DM, 0, r, lane, scr); continue; } r -= I_PG;
        if (r < I_PW) {
            if (DPLE >= 64) transpose_item(INF(I_PLEW) + (size_t)l * DPLE * DM, DPLE, DM, DM, WSP(bf16_t, WS_WP), DPLE, 0, r, lane, scr);
            continue; } r -= I_PW;
        const int e = r / (2 * I_G1 + I_D1); r -= e * (2 * I_G1 + I_D1);
        if (r < I_G1) { transpose_item(INF(I_WG) + ((size_t)l * NEXP + e) * DM * DEXP, DM, DEXP, DEXP, WSP(bf16_t, WS_WGU) + (size_t)e * 2 * DEXP * DM, DM, 1, r, lane, scr); continue; } r -= I_G1;
        if (r < I_G1) { transpose_item(INF(I_WU) + ((size_t)l * NEXP + e) * DM * DEXP, DM, DEXP, DEXP, WSP(bf16_t, WS_WGU) + (size_t)e * 2 * DEXP * DM, DM, 2, r, lane, scr); continue; } r -= I_G1;
        transpose_item(INF(I_WD) + ((size_t)l * NEXP + e) * DEXP * DM, DEXP, DM, DM, WSP(bf16_t, WS_WD) + (size_t)e * DM * DEXP, DEXP, 0, r, lane, scr);
    }
    {   const float* wq = INF(I_WUQ) + (size_t)l * 256 * 384; const float* gq = INF(I_QNG) + l * 256; bf16_t* o = WSP(bf16_t, WS_WUQ);
        for (int i = gw * LANES + lane; i < 512 * 256; i += ngw * LANES) { const int n = i >> 8, k = i & 255; o[i] = f2bf(n < 384 ? gq[k] * wq[(size_t)k * 384 + n] : 0.f); }
        const float* wk = INF(I_WUKV) + (size_t)l * 128 * 512; const float* gk = INF(I_KVNG) + l * 128; bf16_t* o2 = WSP(bf16_t, WS_WUKV);
        for (int i = gw * LANES + lane; i < 512 * 256; i += ngw * LANES) { const int n = i >> 8, k = i & 255; o2[i] = f2bf(k < 128 ? gk[k] * wk[(size_t)k * 512 + n] : 0.f); } }
    if (l == 0) {
        const int* pos = (const int*)C.in[I_POS]; float* rt = WSP(float, WS_ROPE);
        for (int i = gw * LANES + lane; i < T * 16; i += ngw * LANES) { const int t = i >> 4, f = i & 15; const float ang = (float)pos[t] * powf(10000.f, -(float)f / 16.f);
            rt[(size_t)t * 32 + f] = cosf(ang); rt[(size_t)t * 32 + 16 + f] = sinf(ang); } }
    {   const float* p = INF(I_P) + (size_t)l * T * DPLE; bf16_t* pb = WSP(bf16_t, WS_PB);
        const size_t n4 = (size_t)T * DPLE / 4;
        for (size_t i = (size_t)gw * LANES + lane; i < n4; i += (size_t)ngw * LANES) {
            const float* s = p + 4 * i; unsigned* d = (unsigned*)(pb + 4 * i); d[0] = pk2(s[0], s[1]); d[1] = pk2(s[2], s[3]); } }
    if (l == 0) { const float* x = INF(I_X); bf16_t* xb = WSP(bf16_t, WS_XB);
        const size_t n4 = (size_t)T * DM / 4;
        for (size_t i = (size_t)gw * LANES + lane; i < n4; i += (size_t)ngw * LANES) {
            const float* s = x + 4 * i; unsigned* d = (unsigned*)(xb + 4 * i); d[0] = pk2(s[0], s[1]); d[1] = pk2(s[2], s[3]); } }
#ifdef CFG_SMALL
    if (DPLE < 64) {
        const float* W = INF(I_PLEW) + (size_t)l * DPLE * DM; bf16_t* WT = WSP(bf16_t, WS_WP);
        for (int i = gw * LANES + lane; i < DPLE * DM; i += ngw * LANES) { const int k = i / DM, n = i % DM; WT[(size_t)n * DPLE + k] = f2bf(W[i]); } }
#endif
}

HD float ubf(const bf16_t* u, int t, int c) { return bf2f(u[(size_t)t * DINP + c]); }
HD void stage_prep(CtxRef C, int l, int gw, int ngw, int lane, wsh_t sh) {
    const bf16_t* u = WSP(bf16_t, WS_U);
    const float* mu = INF(I_MU) + l * DINA; const float* w0 = INF(I_W0) + l * GW; const float* wup = INF(I_WUP) + l * 32 * GW;
    const float* a0 = INF(I_A0) + l * GW; const float* aup = INF(I_AUP) + l * 32 * GW; const float* gup = INF(I_GUP) + l * 64 * GW;
    const float* kkw = INF(I_KK) + l * GW; const float* kaw = INF(I_KA) + l * GW;
    const float* glaup = INF(I_GLA_UP) + l * 16 * 128; const float* glab = INF(I_GLA_B) + l * 128;
    const float* convw = INF(I_CONVW) + l * 4 * 512; const float* convb = INF(I_CONVB) + l * 512;
    const float* ib = INF(I_IB) + l * 4; const float* fb = INF(I_FB) + l * 4;
    const float* qng = INF(I_QNG) + l * 256; const float* wuq = INF(I_WUQ) + (size_t)l * 256 * 384;
    const float* kvng = INF(I_KVNG) + l * 128; const float* wukv = INF(I_WUKV) + (size_t)l * 128 * 512;
    const int* pos = (const int*)C.in[I_POS];
    float* oR = WSP(float, WS_RW_R); float* oW = WSP(float, WS_RW_W); float* oK = WSP(float, WS_RW_K); float* oV = WSP(float, WS_RW_V);
    float* oA = WSP(float, WS_RW_A); float* oB = WSP(float, WS_RW_B); float* oG = WSP(float, WS_RW_G);
    float* oQK = WSP(float, WS_QK); float* oGA = WSP(float, WS_GA); float* oLG = WSP(float, WS_LG);
    bf16_t* oAQ = WSP(bf16_t, WS_AQ); bf16_t* oAK = WSP(bf16_t, WS_AK); bf16_t* oAV = WSP(bf16_t, WS_AV);
    for (int t = gw; t < T; t += ngw) {
        const int s = t % SEQ;
        for (int j = lane; j < 128; j += LANES) { const int c = UA_WD + j; const float cur = ubf(u, t, c), prev = s > 0 ? ubf(u, t - 1, c) : 0.f;
            const float v = cur + (prev - cur) * mu[c]; sh[j] = j < 32 ? tanhf(v) : (j < 64 ? v : sigmoidf_(v)); }
        WSYNC();
        for (int h = 0; h < NH; ++h) {
            float kkraw[HD64 / LANES]; float kv_[HD64 / LANES], av_[HD64 / LANES]; float ss = 0.f;
            for (int i = 0; i < HD64 / LANES; ++i) { const int c = h * 64 + i * LANES + lane;
                float z = w0[c], za = a0[c], g = 0.f;
_Pragma("unroll 8")
                for (int j = 0; j < 32; ++j) { z += sh[j] * wup[j * GW + c]; za += sh[32 + j] * aup[j * GW + c]; }
_Pragma("unroll 8")
                for (int j = 0; j < 64; ++j) g += sh[64 + j] * gup[j * GW + c];
                const float lnl = -softplusf_(-z) - 0.5f; const float decay = expf(-expf(lnl)); const float a = sigmoidf_(za);
                float r, k, v;
                { const float cur = ubf(u, t, UA_R + c), prev = s > 0 ? ubf(u, t - 1, UA_R + c) : 0.f; r = cur + (prev - cur) * mu[UA_R + c]; }
                { const float cur = ubf(u, t, UA_K + c), prev = s > 0 ? ubf(u, t - 1, UA_K + c) : 0.f; k = cur + (prev - cur) * mu[UA_K + c]; }
                { const float cur = ubf(u, t, UA_V + c), prev = s > 0 ? ubf(u, t - 1, UA_V + c) : 0.f; v = cur + (prev - cur) * mu[UA_V + c]; }
                kkraw[i] = k * kkw[c]; ss += kkraw[i] * kkraw[i];
                kv_[i] = k * (1.f + (a - 1.f) * kaw[c]); av_[i] = a;
                const size_t o = (size_t)t * GW + c; oR[o] = r; oW[o] = decay; oK[o] = kv_[i]; oV[o] = v; oG[o] = g; }
            ss = wave_sum(ss); const float inv = 1.f / fmaxf(sqrtf(ss), 1e-12f);
            for (int i = 0; i < HD64 / LANES; ++i) { const int c = h * 64 + i * LANES + lane; const size_t o = (size_t)t * GW + c; const float kk = kkraw[i] * inv;
                oA[o] = -kk; oB[o] = kk * av_[i]; }
        }
        WSYNC();
        for (int c = lane; c < 128; c += LANES) { float z = glab[c];
            for (int j = 0; j < 16; ++j) z += ubf(u, t, UB_AD + j) * glaup[j * 128 + c];
            oGA[(size_t)t * 128 + c] = -softplusf_(-z) * (1.f / 16.f); }
        for (int c = lane; c < 512; c += LANES) { float y = convb[c];
            for (int j = 0; j < 4; ++j) { const int sp = s - 3 + j; if (sp >= 0) y += convw[j * 512 + c] * ubf(u, t - 3 + j, UC_Q + c); }
            float q = siluf_(y); if (c >= 256) q *= 0.125f; oQK[(size_t)t * 512 + c] = q; }
        for (int c = lane; c < 8; c += LANES) { const float v = ubf(u, t, UC_IG + c);
            oLG[(size_t)t * 8 + c] = c < 4 ? v + ib[c] : -softplusf_(-(v + fb[c - 4])); }
        {   float ssq = 0.f, sskv = 0.f;
            for (int j = lane; j < 256; j += LANES) { const float v = ubf(u, t, UD_CQ + j); ssq += v * v; }
            for (int j = lane; j < 128; j += LANES) { const float v = ubf(u, t, UD_CKV + j); sskv += v * v; }
            ssq = wave_sum(ssq); sskv = wave_sum(sskv);
            const float rq = 1.f / sqrtf(ssq * (1.f / 256.f) + NORM_EPS), rkv = 1.f / sqrtf(sskv * (1.f / 128.f) + NORM_EPS);
            for (int j = lane; j < 256; j += LANES) sh[j] = ubf(u, t, UD_CQ + j) * rq * qng[j];
            for (int j = lane; j < 128; j += LANES) sh[256 + j] = ubf(u, t, UD_CKV + j) * rkv * kvng[j];
            WSYNC();
            for (int n = lane; n < 384; n += LANES) { float acc = 0.f;
_Pragma("unroll 8")
                for (int k = 0; k < 256; ++k) acc += sh[k] * wuq[(size_t)k * 384 + n]; sh[384 + n] = acc; }
            for (int n = lane; n < 512; n += LANES) { float acc = 0.f;
_Pragma("unroll 8")
                for (int k = 0; k < 128; ++k) acc += sh[256 + k] * wukv[(size_t)k * 512 + n]; sh[768 + n] = acc; }
            for (int i = lane; i < 16; i += LANES) { const float invf = powf(10000.f, -(float)i / 16.f); const float ang = (float)pos[t] * invf; sh[1280 + i] = cosf(ang); sh[1296 + i] = sinf(ang); }
            for (int i = lane; i < 32; i += LANES) sh[1312 + i] = ubf(u, t, UD_KR + i);
            WSYNC();
            const float qscale = 0.10206207261596575f * 1.4426950408889634f;
            for (int idx = lane; idx < 384; idx += LANES) { const int h = idx / 96, d = idx % 96; float v;
                if (d < 64) v = sh[384 + idx];
                else { const int i = (d - 64) & 15; const float x1 = sh[384 + h * 96 + 64 + i], x2 = sh[384 + h * 96 + 80 + i]; const float c_ = sh[1280 + i], s_ = sh[1296 + i];
                    v = (d - 64) < 16 ? x1 * c_ - x2 * s_ : x1 * s_ + x2 * c_; }
                oAQ[(size_t)t * 384 + idx] = f2bf(v * qscale); }
            for (int idx = lane; idx < 384; idx += LANES) { const int h = idx / 96, d = idx % 96; float v;
                if (d < 64) v = sh[768 + h * 128 + d];
                else { const int i = (d - 64) & 15; const float x1 = sh[1312 + i], x2 = sh[1328 + i]; const float c_ = sh[1280 + i], s_ = sh[1296 + i];
                    v = (d - 64) < 16 ? x1 * c_ - x2 * s_ : x1 * s_ + x2 * c_; }
                oAK[(size_t)t * 384 + idx] = f2bf(v); }
            for (int idx = lane; idx < 256; idx += LANES) { const int h = idx / 64, d = idx % 64; oAV[(size_t)t * 256 + idx] = f2bf(sh[768 + h * 128 + 64 + d]); }
            WSYNC();
        }
    }
}

HD void rwkv_scan_thread(CtxRef C, int b, int h, int v) {
    const float* pR = WSP(float, WS_RW_R); const float* pW = WSP(float, WS_RW_W); const float* pK = WSP(float, WS_RW_K); const float* pV = WSP(float, WS_RW_V);
    const float* pA = WSP(float, WS_RW_A); const float* pB = WSP(float, WS_RW_B); float* Y = WSP(float, WS_YA);
    float S[64];
#pragma unroll
    for (int k = 0; k < 64; ++k) S[k] = 0.f;
    for (int s = 0; s < SEQ; ++s) {
        const size_t o = ((size_t)b * SEQ + s) * GW + h * 64;
        const float vv = pV[o + v];
        float sa0 = 0.f, sa1 = 0.f, sa2 = 0.f, sa3 = 0.f;
#pragma unroll
        for (int k = 0; k < 64; k += 4) { const f4v a = *(const f4v*)(pA + o + k); sa0 += S[k] * a[0]; sa1 += S[k + 1] * a[1]; sa2 += S[k + 2] * a[2]; sa3 += S[k + 3] * a[3]; }
        const float sa = (sa0 + sa1) + (sa2 + sa3);
        float y0 = 0.f, y1 = 0.f, y2 = 0.f, y3 = 0.f;
#pragma unroll
        for (int k = 0; k < 64; k += 4) {
            const f4v w = *(const f4v*)(pW + o + k), bb = *(const f4v*)(pB + o + k), kk = *(const f4v*)(pK + o + k), r = *(const f4v*)(pR + o + k);
            S[k] = S[k] * w[0] + sa * bb[0] + vv * kk[0]; y0 += S[k] * r[0];
            S[k + 1] = S[k + 1] * w[1] + sa * bb[1] + vv * kk[1]; y1 += S[k + 1] * r[1];
            S[k + 2] = S[k + 2] * w[2] + sa * bb[2] + vv * kk[2]; y2 += S[k + 2] * r[2];
            S[k + 3] = S[k + 3] * w[3] + sa * bb[3] + vv * kk[3]; y3 += S[k + 3] * r[3];
            if ((k & 12) == 12) asm volatile("" ::: "memory"); }
        Y[o + v] = (y0 + y1) + (y2 + y3);
    }
}
HD void gla_scan_thread(CtxRef C, int b, int h, int v) {
    const bf16_t* u = WSP(bf16_t, WS_U); const float* GA = WSP(float, WS_GA); float* Y = WSP(float, WS_YB);
    float S[32];
#pragma unroll
    for (int k = 0; k < 32; ++k) S[k] = 0.f;
    for (int s = 0; s < SEQ; ++s) {
        const int t = b * SEQ + s;
        const float vv = ubf(u, t, UB_V + h * 64 + v);
        float acc = 0.f;
#pragma unroll
        for (int k8 = 0; k8 < 32; k8 += 8) { float kf[8], qf[8];
            ld8bf(u + (size_t)t * DINP + UB_K + h * 32 + k8, kf); ld8bf(u + (size_t)t * DINP + UB_Q + h * 32 + k8, qf);
            const f4v g0 = *(const f4v*)(GA + (size_t)t * 128 + h * 32 + k8), g1 = *(const f4v*)(GA + (size_t)t * 128 + h * 32 + k8 + 4);
#pragma unroll
            for (int j = 0; j < 8; ++j) { const float a = expf(j < 4 ? g0[j & 3] : g1[j & 3]); S[k8 + j] = a * S[k8 + j] + kf[j] * vv; acc += qf[j] * S[k8 + j]; } }
        Y[(size_t)t * GW + h * 64 + v] = acc * 0.17677669529663687f;
    }
}
HD void mlstm_scan_thread(CtxRef C, int b, int h, int e) {
    const bf16_t* u = WSP(bf16_t, WS_U); const float* QK = WSP(float, WS_QK); const float* LG = WSP(float, WS_LG);
    float* Y = WSP(float, WS_YC); float* DEN = WSP(float, WS_DEN);
    float S[64];
#pragma unroll
    for (int k = 0; k < 64; ++k) S[k] = 0.f;
    for (int s = 0; s < SEQ; ++s) {
        const int t = b * SEQ + s;
        const float ig = expf(LG[(size_t)t * 8 + h]), fg = expf(LG[(size_t)t * 8 + 4 + h]);
        const float vv = (e < 64 ? ubf(u, t, UC_V + h * 64 + e) : 1.f) * ig;
        float acc = 0.f;
#pragma unroll
        for (int k = 0; k < 64; k += 4) { const f4v kk = *(const f4v*)(QK + (size_t)t * 512 + 256 + h * 64 + k), qq = *(const f4v*)(QK + (size_t)t * 512 + h * 64 + k);
#pragma unroll
            for (int j = 0; j < 4; ++j) { S[k + j] = fg * S[k + j] + kk[j] * vv; acc += qq[j] * S[k + j]; } }
        if (e < 64) Y[(size_t)t * GW + h * 64 + e] = acc; else DEN[(size_t)t * 4 + h] = acc;
    }
}
HD void attn_thread(CtxRef C, int b, int h, int q, int kmax  ) {
    const bf16_t* Q = WSP(bf16_t, WS_AQ); const bf16_t* K = WSP(bf16_t, WS_AK); const bf16_t* V = WSP(bf16_t, WS_AV); bf16_t* mix = WSP(bf16_t, WS_MIX);
    const int t = b * SEQ + q;
    unsigned qp[48]; float o[64];
#pragma unroll
    for (int d = 0; d < 48; d += 4) { const u4v w = *(const u4v*)(Q + (size_t)t * 384 + h * 96 + 2 * d); qp[d] = w[0]; qp[d + 1] = w[1]; qp[d + 2] = w[2]; qp[d + 3] = w[3]; }
#pragma unroll
    for (int d = 0; d < 64; ++d) o[d] = 0.f;
    float m = -1e30f, lsum = 0.f;
    for (int j = 0; j <= kmax; ++j) {
        const size_t tk = (size_t)b * SEQ + j;
        float sc0 = 0.f, sc1 = 0.f;
#pragma unroll
        for (int d = 0; d < 96; d += 8) { float kf[8]; ld8bf(K + tk * 384 + h * 96 + d, kf);
#pragma unroll
            for (int i = 0; i < 8; i += 2) { const unsigned qw = qp[(d + i) >> 1];
                sc0 += __builtin_bit_cast(float, qw << 16) * kf[i]; sc1 += __builtin_bit_cast(float, qw & 0xffff0000u) * kf[i + 1]; }
            if ((d & 24) == 24) asm volatile("" ::: "memory"); }
        const float sc = sc0 + sc1;
        if (j <= q) {
            const float mn = fmaxf(m, sc); const float corr = exp2f(m - mn), p = exp2f(sc - mn);
            lsum = lsum * corr + p;
#pragma unroll
            for (int d = 0; d < 64; d += 8) { float vf[8]; ld8bf(V + tk * 256 + h * 64 + d, vf);
#pragma unroll
                for (int i = 0; i < 8; ++i) o[d + i] = o[d + i] * corr + p * vf[i];
                if (d & 8) asm volatile("" ::: "memory"); }
            m = mn; }
    }
    const float inv = 1.f / lsum;
#pragma unroll
    for (int d = 0; d < 64; d += 8) { float a[8];
#pragma unroll
        for (int i = 0; i < 8; ++i) a[i] = o[d + i] * inv;
        st8bf(mix + (size_t)t * DMIX + 768 + h * 64 + d, a); }
}

HD void stage_post(CtxRef C, int l, int gw, int ngw, int lane) {
    const bf16_t* u = WSP(bf16_t, WS_U); bf16_t* mix = WSP(bf16_t, WS_MIX);
    const float* YA = WSP(float, WS_YA); const float* YB = WSP(float, WS_YB); const float* YC = WSP(float, WS_YC); const float* DEN = WSP(float, WS_DEN);
    const float* pR = WSP(float, WS_RW_R); const float* pK = WSP(float, WS_RW_K); const float* pV = WSP(float, WS_RW_V); const float* pG = WSP(float, WS_RW_G);
    const float* rk = INF(I_RK) + l * GW; const float* gng = INF(I_GNG) + l * GW; const float* gnb = INF(I_GNB) + l * GW;
    const float* glag = INF(I_GLA_G) + l * GW; const float* mlng = INF(I_MLN_G) + l * GW;
    constexpr int PL = HD64 / LANES;
    for (int t = gw; t < T; t += ngw) {
        for (int h = 0; h < NH; ++h) {
            {   float y[PL], s1 = 0.f, bon = 0.f;
#ifdef CPU_TEST
                for (int i = 0; i < PL; ++i) { const int c = h * 64 + i * LANES + lane; const size_t o = (size_t)t * GW + c; y[i] = YA[o]; s1 += y[i]; bon += pR[o] * pK[o] * rk[c]; }
                s1 = wave_sum(s1); bon = wave_sum(bon);
#else
                for (int i = 0; i < PL; ++i) { const int c = h * 64 + i * LANES + lane; y[i] = YA[(size_t)t * GW + c]; s1 += y[i]; }
                s1 = wave_sum(s1); bon = WSP(float, WS_RW_BON)[(size_t)t * 4 + h];
#endif
                const float mean = s1 * (1.f / 64.f); float s2 = 0.f;
                for (int i = 0; i < PL; ++i) { y[i] -= mean; s2 += y[i] * y[i]; }
                s2 = wave_sum(s2); const float rstd = 1.f / sqrtf(s2 * (1.f / 64.f) + RWKV_GN_EPS);
                for (int i = 0; i < PL; ++i) { const int c = h * 64 + i * LANES + lane; const size_t o = (size_t)t * GW + c;
#ifdef CPU_TEST
                    const float v = (y[i] * rstd * gng[c] + gnb[c] + bon * pV[o]) * pG[o];
#else
                    const float v = (y[i] * rstd * gng[c] + gnb[c] + bon * bf2f(WSP(bf16_t, WS_RW_VS)[o])) * bf2f(WSP(bf16_t, WS_RW_GG)[o]);
#endif
                    mix[(size_t)t * DMIX + c] = f2bf(v); } }
            {   float y[PL], s2 = 0.f;
                for (int i = 0; i < PL; ++i) { const int c = h * 64 + i * LANES + lane; y[i] = YB[(size_t)t * GW + c]; s2 += y[i] * y[i]; }
                s2 = wave_sum(s2); const float rstd = 1.f / sqrtf(s2 * (1.f / 64.f) + NORM_EPS);
                for (int i = 0; i < PL; ++i) { const int c = h * 64 + i * LANES + lane;
                    const float v = y[i] * rstd * glag[c] * siluf_(ubf(u, t, UB_G + c)); mix[(size_t)t * DMIX + 256 + c] = f2bf(v); } }
            {   const float den = DEN[(size_t)t * 4 + h]; const float dinv = 1.f / fmaxf(fabsf(den), 1.f);
                float y[PL], s1 = 0.f;
                for (int i = 0; i < PL; ++i) { const int c = h * 64 + i * LANES + lane; y[i] = YC[(size_t)t * GW + c] * dinv; s1 += y[i]; }
                s1 = wave_sum(s1); const float mean = s1 * (1.f / 64.f); float s2 = 0.f;
                for (int i = 0; i < PL; ++i) { y[i] -= mean; s2 += y[i] * y[i]; }
                s2 = wave_sum(s2); const float rstd = 1.f / sqrtf(s2 * (1.f / 64.f) + LN_EPS);
                for (int i = 0; i < PL; ++i) { const int c = h * 64 + i * LANES + lane;
                    const float v = y[i] * rstd * mlng[c] * sigmoidf_(ubf(u, t, UC_O + c)); mix[(size_t)t * DMIX + 512 + c] = f2bf(v); } }
        }
    }
}

HD void ln_row(const float* src, const float* g, const float* b, float* dstf, bf16_t* dstb, int lane, float* keep  ) {
    constexpr int PL = DM / LANES;
    float s1 = 0.f;
#pragma unroll
    for (int i = 0; i < PL; ++i) { keep[i] = src[i * LANES + lane]; s1 += keep[i]; }
    s1 = wave_sum(s1); const float mean = s1 * (1.f / DM); float s2 = 0.f;
#pragma unroll
    for (int i = 0; i < PL; ++i) { keep[i] -= mean; s2 += keep[i] * keep[i]; }
    s2 = wave_sum(s2); const float rstd = 1.f / sqrtf(s2 * (1.f / DM) + LN_EPS);
#pragma unroll
    for (int i = 0; i < PL; ++i) { const int c = i * LANES + lane; keep[i] = keep[i] * rstd * g[c] + b[c]; dstf[c] = keep[i]; dstb[c] = f2bf(keep[i]); }
}
HD void stage_ln1_router(CtxRef C, int l, int gw, int ngw, int lane, wsh_t sh) {
    float* X1 = C.out; bf16_t* xb = WSP(bf16_t, WS_XB);
    const float* g = INF(I_LN1G) + l * DM; const float* b = INF(I_LN1B) + l * DM;
    const float* wrg = INF(I_WRG) + (size_t)l * DM * NGRP; const float* brg = INF(I_BRG) + l * NGRP;
    const float* wre = INF(I_WRE) + (size_t)l * DM * NEXP; const float* bre = INF(I_BRE) + l * NEXP;
    unsigned* cnt = WSP(unsigned, WS_CTL) + CW_CNT + l * NEXP * 64;
    int* tokinfo = WSP(int, WS_TOKINFO); int* list = WSP(int, WS_LIST);
    constexpr int PL = DM / LANES;
    for (int t = gw; t < T; t += ngw) {
        {   float keep[PL];
            ln_row(X1 + (size_t)t * DM, g, b, X1 + (size_t)t * DM, xb + (size_t)t * DM, lane, keep);
#pragma unroll
            for (int i = 0; i < PL; ++i) sh[i * LANES + lane] = keep[i]; }
        WSYNC();
        float lg[NGRP], le[NEXP];
#pragma unroll
        for (int j = 0; j < NGRP; ++j) lg[j] = 0.f;
#pragma unroll
        for (int j = 0; j < NEXP; ++j) le[j] = 0.f;
#pragma unroll 1
        for (int i = 0; i < PL; ++i) { const int c = i * LANES + lane; const float xv = sh[c];
            const f4v wg = *(const f4v*)(wrg + (size_t)c * NGRP);
#pragma unroll
            for (int j = 0; j < NGRP; ++j) lg[j] += xv * wg[j];
#pragma unroll
            for (int j = 0; j < NEXP; j += 4) { const f4v we = *(const f4v*)(wre + (size_t)c * NEXP + j);
                le[j] += xv * we[0]; le[j + 1] += xv * we[1]; le[j + 2] += xv * we[2]; le[j + 3] += xv * we[3]; } }
        WSYNC();
#pragma unroll
        for (int j = 0; j < NGRP; ++j) lg[j] = wave_sum(lg[j]) + brg[j];
#pragma unroll
        for (int j = 0; j < NEXP; ++j) le[j] = wave_sum(le[j]) + bre[j];
        int gi = 0; float gm = lg[0];
#pragma unroll
        for (int j = 1; j < NGRP; ++j) if (lg[j] > gm) { gm = lg[j]; gi = j; }
        float gs = 0.f;
#pragma unroll
        for (int j = 0; j < NGRP; ++j) gs += expf(lg[j] - gm);
        const float group_p = 1.f / gs;
        float el[EPG];
#pragma unroll
        for (int j = 0; j < EPG; ++j) { float v = le[j];
#pragma unroll
            for (int g2 = 1; g2 < NGRP; ++g2) v = (gi == g2) ? le[g2 * EPG + j] : v;
            el[j] = v; }
        int e0 = 0; float m0 = el[0];
#pragma unroll
        for (int j = 1; j < EPG; ++j) if (el[j] > m0) { m0 = el[j]; e0 = j; }
        int e1 = -1; float m1 = -3.0e38f;
#pragma unroll
        for (int j = 0; j < EPG; ++j) if (j != e0 && el[j] > m1) { m1 = el[j]; e1 = j; }
        const float p1 = expf(m1 - m0); const float g0 = group_p / (1.f + p1), g1 = group_p * p1 / (1.f + p1);
        if (lane == 0) {
            const int E0 = gi * EPG + e0, E1 = gi * EPG + e1;
            tokinfo[(size_t)t * 4 + 0] = E0; tokinfo[(size_t)t * 4 + 1] = E1;
            ((float*)tokinfo)[(size_t)t * 4 + 2] = g0; ((float*)tokinfo)[(size_t)t * 4 + 3] = g1;
            const unsigned s0 = atom_add(cnt + E0 * 64, 1u); list[(size_t)E0 * T + s0] = t * 2 + 0;
            const unsigned s1 = atom_add(cnt + E1 * 64, 1u); list[(size_t)E1 * T + s1] = t * 2 + 1;
        }
    }
}
HD void moe_bases(CtxRef C, int l, int* base  ) {
    const unsigned* cnt = WSP(unsigned, WS_CTL) + CW_CNT + l * NEXP * 64;
    int acc = 0;
    for (int e = 0; e < NEXP; ++e) { base[e] = acc; acc += ((int)cnt[e * 64] + 255) & ~255; }
    base[NEXP] = acc;
}
HD int moe_expert_of_row(const int* base, int row) { int e = 0; for (int j = 1; j < NEXP; ++j) if (row >= base[j]) e = j; return e; }
HD int moe_lookup(const unsigned* cnt, int row, int& e, int& be, int& ce) {
    int acc = 0; e = 0; be = 0; ce = 0;
    for (int j = 0; j < NEXP; ++j) { const int c = (int)cnt[j * 64]; if (row >= acc) { e = j; be = acc; ce = c; } acc += (c + 255) & ~255; }
    return acc;
}
HD void stage_gather(CtxRef C, int l, int gw, int ngw, int lane) {
    const unsigned* cnt = WSP(unsigned, WS_CTL) + CW_CNT + l * NEXP * 64;
    const int* list = WSP(int, WS_LIST); const int* tokinfo = WSP(int, WS_TOKINFO);
    const bf16_t* xb = WSP(bf16_t, WS_XB); bf16_t* xg = WSP(bf16_t, WS_XG); int* rowinfo = WSP(int, WS_ROWINFO); float* rowgate = WSP(float, WS_ROWGATE);
    int e, be, ce; const int total = moe_lookup(cnt, 0, e, be, ce);
    for (int row = gw; row < total; row += ngw) {
        moe_lookup(cnt, row, e, be, ce);
        const int slot = row - be;
        if (slot < ce) { const int ent = list[(size_t)e * T + slot]; const int tok = ent >> 1;
            for (int c = lane * 8; c < DM; c += LANES * 8) *(u4v*)(xg + (size_t)row * DM + c) = *(const u4v*)(xb + (size_t)tok * DM + c);
            if (lane == 0) { rowinfo[row] = ent; rowgate[row] = ((const float*)tokinfo)[(size_t)tok * 4 + 2 + (ent & 1)]; } }
        else { const u4v z = {0u, 0u, 0u, 0u}; for (int c = lane * 8; c < DM; c += LANES * 8) *(u4v*)(xg + (size_t)row * DM + c) = z;
            if (lane == 0) { rowinfo[row] = -1; rowgate[row] = 0.f; } }
    }
}
HD void stage_ln2(CtxRef C, int l, int gw, int ngw, int lane) {
    const float* src = WSP(float, WS_X); float* dst = (l == DEPTH - 1) ? C.out : WSP(float, WS_X); bf16_t* xb = WSP(bf16_t, WS_XB);
    const float* g = INF(I_LN2G) + l * DM; const float* b = INF(I_LN2B) + l * DM;
    constexpr int PL = DM / LANES;
    for (int t = gw; t < T; t += ngw) { float keep[PL]; ln_row(src + (size_t)t * DM, g, b, dst + (size_t)t * DM, xb + (size_t)t * DM, lane, keep); }
}

struct EpiU {
    static constexpr bool PERM = true; static constexpr int MODE = 0;
    bf16_t* o;
    HDM void put8(int row, int col, const float* a) const { st8bf(o + (size_t)row * DINP + col, a); }
};
struct EpiPP {
    static constexpr bool PERM = true; static constexpr int MODE = 0;
    bf16_t* o;
    HDM void put8(int row, int col, const float* a) const { st8bf(o + (size_t)row * DM + col, a); }
};
struct EpiPre1 {
    static constexpr bool PERM = false; static constexpr int MODE = 0;
    const float* x; float* o;
    HDM void put4(int row, int col, const float* a) const { const float al = dn_alpha(); const f4v xr = *(const f4v*)(x + (size_t)row * DM + col);
        f4v r; for (int j = 0; j < 4; ++j) r[j] = al * xr[j] + a[j]; *(f4v*)(o + (size_t)row * DM + col) = r; }
};
struct EpiH {
    static constexpr bool PERM = true; static constexpr int MODE = 1;
    bf16_t* o;
    HDM void put8gu(int row, int hcol, const float* g, const float* u) const { float v[8]; for (int j = 0; j < 8; ++j) v[j] = siluf_(g[j]) * u[j];
        st8bf(o + (size_t)row * DEXP + hcol, v); }
};
struct EpiY {
    static constexpr bool PERM = true; static constexpr int MODE = 0;
    const int* rowinfo; const float* rowgate; bf16_t* o;
    HDM void put8(int row, int col, const float* a) const { const int ent = rowinfo[row]; if (ent < 0) return; const float g = rowgate[row];
        float v[8]; for (int j = 0; j < 8; ++j) v[j] = g * a[j]; st8bf(o + (size_t)ent * DM + col, v); }
};
struct EpiPre2 {
    static constexpr bool PERM = false; static constexpr int MODE = 0;
    const float* x1; const bf16_t* ybuf; const bf16_t* pp; const float* bg; float* o;
    HDM void put4(int row, int col, const float* a) const { const float al = dn_alpha(); const size_t i = (size_t)row * DM + col;
        const f4v xr = *(const f4v*)(x1 + i); const f4v bgv = *(const f4v*)(bg + col);
        const unsigned* y0 = (const unsigned*)(ybuf + (size_t)(2 * row) * DM + col); const unsigned* y1 = (const unsigned*)(ybuf + (size_t)(2 * row + 1) * DM + col); const unsigned* pq = (const unsigned*)(pp + i);
        const unsigned y00 = y0[0], y01 = y0[1], y10 = y1[0], y11 = y1[1], p0 = pq[0], p1 = pq[1];
        float yv[4] = { __builtin_bit_cast(float, y00 << 16) + __builtin_bit_cast(float, y10 << 16), __builtin_bit_cast(float, y00 & 0xffff0000u) + __builtin_bit_cast(float, y10 & 0xffff0000u),
                        __builtin_bit_cast(float, y01 << 16) + __builtin_bit_cast(float, y11 << 16), __builtin_bit_cast(float, y01 & 0xffff0000u) + __builtin_bit_cast(float, y11 & 0xffff0000u) };
        float pv[4] = { __builtin_bit_cast(float, p0 << 16), __builtin_bit_cast(float, p0 & 0xffff0000u), __builtin_bit_cast(float, p1 << 16), __builtin_bit_cast(float, p1 & 0xffff0000u) };
        f4v r; for (int j = 0; j < 4; ++j) r[j] = al * xr[j] + yv[j] + sigmoidf_(a[j] + bgv[j]) * pv[j];
        *(f4v*)(o + i) = r; }
};

#ifndef CPU_TEST
struct EpiQ {
    static constexpr bool PERM = true; static constexpr int MODE = 0;
    const float* rope; bf16_t* o;
    __device__ __forceinline__ void put8(int row, int col, const float* a) const {
        float p[8];
#pragma unroll
        for (int j = 0; j < 8; ++j) p[j] = __shfl_xor(a[j], 32);
        if (col >= 384) return;
        const float qscale = 0.10206207261596575f * 1.4426950408889634f;
        const int d0 = col % 96; float v[8];
        if (d0 < 64) {
#pragma unroll
            for (int j = 0; j < 8; ++j) v[j] = a[j] * qscale; }
        else { const int i0 = (d0 - 64) & 15; const bool x2 = (d0 - 64) >= 16; const float* rt = rope + (size_t)row * 32 + i0;
            const f4v c0 = *(const f4v*)rt, c1 = *(const f4v*)(rt + 4), s0 = *(const f4v*)(rt + 16), s1 = *(const f4v*)(rt + 20);
#pragma unroll
            for (int j = 0; j < 8; ++j) { const float c = j < 4 ? c0[j & 3] : c1[j & 3], s = j < 4 ? s0[j & 3] : s1[j & 3];
                v[j] = (x2 ? (p[j] * s + a[j] * c) : (a[j] * c - p[j] * s)) * qscale; } }
        st8bf(o + (size_t)row * 384 + col, v); }
};
struct EpiKV {
    static constexpr bool PERM = true; static constexpr int MODE = 0;
    bf16_t* k; bf16_t* v;
    __device__ __forceinline__ void put8(int row, int col, const float* a) const { const int h = col >> 7, d = col & 127;
        if (d < 64) st8bf(k + (size_t)row * 384 + h * 96 + d, a); else st8bf(v + (size_t)row * 256 + h * 64 + (d - 64), a); }
};
__device__ __forceinline__ void mla_token_pass(CtxRef C, int gw, int ngw, int lane) {
    const bf16_t* u = WSP(bf16_t, WS_U); const float* rope = WSP(float, WS_ROPE); float* rstd = WSP(float, WS_RSTD); bf16_t* K = WSP(bf16_t, WS_AK);
    for (int t = gw; t < T; t += ngw) {
        const bf16_t* ur = u + (size_t)t * DINP;
        float ssq = 0.f, sskv = 0.f;
        { const unsigned* p = (const unsigned*)(ur + UD_CQ) + 2 * lane; const unsigned w0 = p[0], w1 = p[1];
          const float a = __builtin_bit_cast(float, w0 << 16), b = __builtin_bit_cast(float, w0 & 0xffff0000u), c = __builtin_bit_cast(float, w1 << 16), d = __builtin_bit_cast(float, w1 & 0xffff0000u);
          ssq = (a * a + b * b) + (c * c + d * d); }
        { const unsigned w0 = ((const unsigned*)(ur + UD_CKV))[lane]; const float a = __builtin_bit_cast(float, w0 << 16), b = __builtin_bit_cast(float, w0 & 0xffff0000u); sskv = a * a + b * b; }
        ssq = wave_sum(ssq); sskv = wave_sum(sskv);
        if (lane == 0) { rstd[(size_t)t * 2] = 1.f / sqrtf(ssq * (1.f / 256.f) + NORM_EPS); rstd[(size_t)t * 2 + 1] = 1.f / sqrtf(sskv * (1.f / 128.f) + NORM_EPS); }
        { const int i = lane & 15, hh = lane >> 4; const float x1 = bf2f(ur[UD_KR + i]), x2 = bf2f(ur[UD_KR + 16 + i]); const float c = rope[(size_t)t * 32 + i], s = rope[(size_t)t * 32 + 16 + i];
          bf16_t* kd = K + (size_t)t * 384 + hh * 96 + 64; kd[i] = f2bf(x1 * c - x2 * s); kd[16 + i] = f2bf(x1 * s + x2 * c); }
    }
}
__device__ __forceinline__ void rwkv_prep_coop(CtxRef C, int l, __attribute__((address_space(3))) unsigned char* lds) {
    int tid = threadIdx.x; asm volatile("" : "+v"(tid));
    const int lane = tid & 63, w = __builtin_amdgcn_readfirstlane(tid >> 6);
    const bf16_t* u = WSP(bf16_t, WS_U);
    const float* mu = INF(I_MU) + l * DINA;
    float* oR = WSP(float, WS_RW_R); float* oW = WSP(float, WS_RW_W); float* oK = WSP(float, WS_RW_K); float* oV = WSP(float, WS_RW_V);
    float* oA = WSP(float, WS_RW_A); float* oB = WSP(float, WS_RW_B); float* oG = WSP(float, WS_RW_G);
    __attribute__((address_space(3))) float* act = (__attribute__((address_space(3))) float*)lds;
    const int h = w & 3, role = w >> 2, c = h * 64 + lane;
    float wc0[32], wc1[32];
    { const float* p0 = role == 0 ? INF(I_WUP) + l * 32 * GW + c : INF(I_GUP) + l * 64 * GW + c;
      const float* p1 = role == 0 ? INF(I_AUP) + l * 32 * GW + c : INF(I_GUP) + l * 64 * GW + 32 * GW + c;
#pragma unroll
      for (int j = 0; j < 32; ++j) { wc0[j] = p0[j * GW]; wc1[j] = p1[j * GW]; } }
    const float w0c = INF(I_W0)[l * GW + c], a0c = INF(I_A0)[l * GW + c], kkc = INF(I_KK)[l * GW + c], kac = INF(I_KA)[l * GW + c];
    const float mur = mu[UA_R + c], muk = mu[UA_K + c], muv = mu[UA_V + c];
    for (int unit = blockIdx.x; unit < T / 16; unit += gridDim.x) {
        const int t0 = unit * 16;
        { const int tk = tid >> 5, j0 = (tid & 31) * 4; const int t = t0 + tk; const bool first = (t % SEQ) == 0;
          const unsigned* pc = (const unsigned*)(u + (size_t)t * DINP + UA_WD + j0); const unsigned c0 = pc[0], c1 = pc[1];
          unsigned q0 = 0u, q1 = 0u; if (!first) { const unsigned* pp = (const unsigned*)(u + (size_t)(t - 1) * DINP + UA_WD + j0); q0 = pp[0]; q1 = pp[1]; }
          const float cur[4] = {__builtin_bit_cast(float, c0 << 16), __builtin_bit_cast(float, c0 & 0xffff0000u), __builtin_bit_cast(float, c1 << 16), __builtin_bit_cast(float, c1 & 0xffff0000u)};
          const float prv[4] = {__builtin_bit_cast(float, q0 << 16), __builtin_bit_cast(float, q0 & 0xffff0000u), __builtin_bit_cast(float, q1 << 16), __builtin_bit_cast(float, q1 & 0xffff0000u)};
          f4v o;
#pragma unroll
          for (int j = 0; j < 4; ++j) { const float v = cur[j] + (prv[j] - cur[j]) * mu[UA_WD + j0 + j]; o[j] = (j0 < 32) ? tanhf(v) : (j0 < 64 ? v : sigmoidf_(v)); }
          *(__attribute__((address_space(3))) f4v*)(act + tk * 128 + j0) = o; }
        __syncthreads();
#pragma unroll 1
        for (int tk = 0; tk < 16; ++tk) { const int t = t0 + tk; const bool first = (t % SEQ) == 0;
            const __attribute__((address_space(3))) float* ar = act + tk * 128 + (role == 0 ? 0 : 64);
            float s0 = 0.f, s1 = 0.f;
#pragma unroll
            for (int j = 0; j < 32; j += 4) { const f4v x = *(const __attribute__((address_space(3))) f4v*)(ar + j), y = *(const __attribute__((address_space(3))) f4v*)(ar + 32 + j);
                s0 += x[0] * wc0[j] + x[1] * wc0[j + 1] + x[2] * wc0[j + 2] + x[3] * wc0[j + 3]; s1 += y[0] * wc1[j] + y[1] * wc1[j + 1] + y[2] * wc1[j + 2] + y[3] * wc1[j + 3];
                if ((j & 12) == 12) asm volatile("" ::: "memory"); }
            const size_t o = (size_t)t * GW + c;
            if (role == 1) { oG[o] = s0 + s1; }
            else {
                const float z = w0c + s0, za = a0c + s1;
                const float lnl = -softplusf_(-z) - 0.5f; const float decay = __expf(-__expf(lnl)); const float a = sigmoidf_(za);
                const bf16_t* uc = u + (size_t)t * DINP + c; const bf16_t* up = uc - DINP;
                const float rc = bf2f(uc[UA_R]), kc = bf2f(uc[UA_K]), vc = bf2f(uc[UA_V]);
                const float rp = first ? 0.f : bf2f(up[UA_R]), kp = first ? 0.f : bf2f(up[UA_K]), vp = first ? 0.f : bf2f(up[UA_V]);
                const float r = rc + (rp - rc) * mur, k = kc + (kp - kc) * muk, v = vc + (vp - vc) * muv;
                const float kkraw = k * kkc; const float ss = wave_sum(kkraw * kkraw); const float kk = kkraw / fmaxf(sqrtf(ss), 1e-12f);
                oR[o] = r; oW[o] = decay; oK[o] = k * (1.f + (a - 1.f) * kac); oV[o] = v; oA[o] = -kk; oB[o] = kk * a; } }
        __syncthreads();
    }
}
#endif

#ifndef CPU_TEST
template <int NT> __device__ __forceinline__ void ln_rows_v(const float* src, const float* g, const float* b, float* dstf, bf16_t* dstb, int lane) {
    f4v x[NT][4];
#pragma unroll
    for (int n = 0; n < NT; ++n)
#pragma unroll
        for (int i = 0; i < 4; ++i) x[n][i] = *(const f4v*)(src + (size_t)n * DM + (i * 64 + lane) * 4);
    float mean[NT], rstd[NT];
#pragma unroll
    for (int n = 0; n < NT; ++n) { float s = 0.f;
#pragma unroll
        for (int i = 0; i < 4; ++i) s += (x[n][i][0] + x[n][i][1]) + (x[n][i][2] + x[n][i][3]);
        mean[n] = wave_sum(s) * (1.f / DM); float q = 0.f;
#pragma unroll
        for (int i = 0; i < 4; ++i) { x[n][i] = x[n][i] - mean[n]; q += (x[n][i][0] * x[n][i][0] + x[n][i][1] * x[n][i][1]) + (x[n][i][2] * x[n][i][2] + x[n][i][3] * x[n][i][3]); }
        rstd[n] = 1.f / sqrtf(wave_sum(q) * (1.f / DM) + LN_EPS); }
#pragma unroll
    for (int i = 0; i < 4; ++i) { const int c = (i * 64 + lane) * 4; const f4v gv = *(const f4v*)(g + c), bv = *(const f4v*)(b + c);
#pragma unroll
        for (int n = 0; n < NT; ++n) { const f4v y = x[n][i] * rstd[n] * gv + bv; *(f4v*)(dstf + (size_t)n * DM + c) = y;
            *(unsigned long long*)(dstb + (size_t)n * DM + c) = (unsigned long long)pk2(y[0], y[1]) | ((unsigned long long)pk2(y[2], y[3]) << 32); } }
}
__device__ __forceinline__ void stage_ln2_v(CtxRef C, int l, int gw, int ngw, int lane) {
    const float* src = WSP(float, WS_X); float* dst = (l == DEPTH - 1) ? C.out : WSP(float, WS_X); bf16_t* xb = WSP(bf16_t, WS_XB);
    const float* g = INF(I_LN2G) + l * DM; const float* b = INF(I_LN2B) + l * DM;
    for (int t = gw * 2; t < T; t += ngw * 2) ln_rows_v<2>(src + (size_t)t * DM, g, b, dst + (size_t)t * DM, xb + (size_t)t * DM, lane);
}
__device__ __forceinline__ float row_sum16(float v) { v += dpp_f(v, 0); v += dpp_f(v, 1); v += dpp_f(v, 2); v += dpp_f(v, 3); return v; }
__device__ __forceinline__ void stage_post_v(CtxRef C, int l, int gw, int ngw, int lane) {
    const bf16_t* u = WSP(bf16_t, WS_U); bf16_t* mix = WSP(bf16_t, WS_MIX);
    const float* YA = WSP(float, WS_YA); const float* YB = WSP(float, WS_YB); const float* YC = WSP(float, WS_YC); const float* DEN = WSP(float, WS_DEN);
    const float* BON = WSP(float, WS_RW_BON); const bf16_t* VS = WSP(bf16_t, WS_RW_VS); const bf16_t* GG = WSP(bf16_t, WS_RW_GG);
    const int h = lane >> 4, c = lane * 4;
    const f4v gng = *(const f4v*)(INF(I_GNG) + l * GW + c), gnb = *(const f4v*)(INF(I_GNB) + l * GW + c), glag = *(const f4v*)(INF(I_GLA_G) + l * GW + c), mlng = *(const f4v*)(INF(I_MLN_G) + l * GW + c);
#pragma unroll 2
    for (int t = gw; t < T; t += ngw) {
        const size_t o = (size_t)t * GW + c;
        const f4v ya = *(const f4v*)(YA + o), yb = *(const f4v*)(YB + o), yc = *(const f4v*)(YC + o);
        const unsigned long long wg = *(const unsigned long long*)(GG + o), wv = *(const unsigned long long*)(VS + o);
        const unsigned long long wgate = *(const unsigned long long*)(u + (size_t)t * DINP + UB_G + c), wo = *(const unsigned long long*)(u + (size_t)t * DINP + UC_O + c);
        const float bon = BON[(size_t)t * 4 + h], den = DEN[(size_t)t * 4 + h];
#define UNP4(w_, a_) const float a_[4] = {__builtin_bit_cast(float, (unsigned)(w_) << 16), __builtin_bit_cast(float, (unsigned)(w_) & 0xffff0000u), __builtin_bit_cast(float, (unsigned)((w_) >> 32) << 16), __builtin_bit_cast(float, (unsigned)((w_) >> 32) & 0xffff0000u)}
        UNP4(wg, g4); UNP4(wv, v4); UNP4(wgate, gate4); UNP4(wo, o4);
#undef UNP4
        float oa[4], ob[4], oc[4];
        {   const float mean = row_sum16((ya[0] + ya[1]) + (ya[2] + ya[3])) * (1.f / 64.f); const f4v d = ya - mean;
            const float rstd = 1.f / sqrtf(row_sum16((d[0] * d[0] + d[1] * d[1]) + (d[2] * d[2] + d[3] * d[3])) * (1.f / 64.f) + RWKV_GN_EPS);
#pragma unroll
            for (int j = 0; j < 4; ++j) oa[j] = (d[j] * rstd * gng[j] + gnb[j] + bon * v4[j]) * g4[j]; }
        {   const float rstd = 1.f / sqrtf(row_sum16((yb[0] * yb[0] + yb[1] * yb[1]) + (yb[2] * yb[2] + yb[3] * yb[3])) * (1.f / 64.f) + NORM_EPS);
#pragma unroll
            for (int j = 0; j < 4; ++j) ob[j] = yb[j] * rstd * glag[j] * siluf_(gate4[j]); }
        {   const float dinv = 1.f / fmaxf(fabsf(den), 1.f); const f4v y = yc * dinv;
            const float mean = row_sum16((y[0] + y[1]) + (y[2] + y[3])) * (1.f / 64.f); const f4v d = y - mean;
            const float rstd = 1.f / sqrtf(row_sum16((d[0] * d[0] + d[1] * d[1]) + (d[2] * d[2] + d[3] * d[3])) * (1.f / 64.f) + LN_EPS);
#pragma unroll
            for (int j = 0; j < 4; ++j) oc[j] = d[j] * rstd * mlng[j] * sigmoidf_(o4[j]); }
        bf16_t* m = mix + (size_t)t * DMIX + c;
        *(unsigned long long*)m = (unsigned long long)pk2(oa[0], oa[1]) | ((unsigned long long)pk2(oa[2], oa[3]) << 32);
        *(unsigned long long*)(m + 256) = (unsigned long long)pk2(ob[0], ob[1]) | ((unsigned long long)pk2(ob[2], ob[3]) << 32);
        *(unsigned long long*)(m + 512) = (unsigned long long)pk2(oc[0], oc[1]) | ((unsigned long long)pk2(oc[2], oc[3]) << 32);
    }
}
__device__ __forceinline__ void stage_gather_v(CtxRef C, int l, int gw, int ngw, int lane) {
    const unsigned* cnt = WSP(unsigned, WS_CTL) + CW_CNT + l * NEXP * 64;
    const int* list = WSP(int, WS_LIST); const int* tokinfo = WSP(int, WS_TOKINFO);
    const bf16_t* xb = WSP(bf16_t, WS_XB); bf16_t* xg = WSP(bf16_t, WS_XG); int* rowinfo = WSP(int, WS_ROWINFO); float* rowgate = WSP(float, WS_ROWGATE);
    int e, be, ce; const int total = moe_lookup(cnt, 0, e, be, ce);
    for (int r0 = gw * 64; r0 < total; r0 += ngw * 64) {
        moe_lookup(cnt, r0, e, be, ce);
        const int slot = r0 - be + lane; int ent = -1; float gate = 0.f;
        if (slot < ce) { ent = list[(size_t)e * T + slot]; gate = ((const float*)tokinfo)[(size_t)(ent >> 1) * 4 + 2 + (ent & 1)]; }
        rowinfo[r0 + lane] = ent; rowgate[r0 + lane] = gate;
#pragma unroll 4
        for (int r = 0; r < 64; ++r) { const int en = __builtin_amdgcn_readlane(ent, r); bf16_t* d = xg + (size_t)(r0 + r) * DM + lane * 8;
            if (en >= 0) { const bf16_t* s = xb + (size_t)(en >> 1) * DM + lane * 8; const u4v a = *(const u4v*)s, b2 = *(const u4v*)(s + 512); *(u4v*)d = a; *(u4v*)(d + 512) = b2; }
            else { const u4v z = {0u, 0u, 0u, 0u}; *(u4v*)d = z; *(u4v*)(d + 512) = z; } }
    }
}
__device__ __forceinline__ void ln1_router_coop(CtxRef C, int l, __attribute__((address_space(3))) unsigned char* lds) {
    int tid = threadIdx.x; asm volatile("" : "+v"(tid));
    const int lane = tid & 63, w = __builtin_amdgcn_readfirstlane(tid >> 6);
    float* X1 = C.out; bf16_t* xb = WSP(bf16_t, WS_XB);
    const float* g = INF(I_LN1G) + l * DM; const float* b = INF(I_LN1B) + l * DM;
    const float* wrg = INF(I_WRG) + (size_t)l * DM * NGRP; const float* brg = INF(I_BRG) + l * NGRP;
    const float* wre = INF(I_WRE) + (size_t)l * DM * NEXP; const float* bre = INF(I_BRE) + l * NEXP;
    unsigned* cnt = WSP(unsigned, WS_CTL) + CW_CNT + l * NEXP * 64;
    int* tokinfo = WSP(int, WS_TOKINFO); int* list = WSP(int, WS_LIST);
    __attribute__((address_space(3))) float* part = (__attribute__((address_space(3))) float*)lds;
    for (int tb0 = blockIdx.x * 128; tb0 < T; tb0 += gridDim.x * 128) {
        for (int i = 0; i < 16; i += 2) { const int t = tb0 + w * 16 + i;
            ln_rows_v<2>(X1 + (size_t)t * DM, g, b, X1 + (size_t)t * DM, xb + (size_t)t * DM, lane); }
        asm volatile("s_waitcnt vmcnt(0)" ::: "memory");
        __syncthreads();
        for (int half = 0; half < 2; ++half) {
            const int t = tb0 + half * 64 + lane;
            float acc[36];
#pragma unroll
            for (int j = 0; j < 36; ++j) acc[j] = 0.f;
            const float* xr = X1 + (size_t)t * DM + 128 * w;
#pragma unroll 1
            for (int k4 = 0; k4 < 32; ++k4) {
                const f4v x = *(const f4v*)(xr + 4 * k4);
#pragma unroll
                for (int kk = 0; kk < 4; ++kk) { const int k = 128 * w + 4 * k4 + kk;
                    typedef __attribute__((address_space(4))) const float cfl; cfl* we = (cfl*)(wre + (size_t)k * NEXP); cfl* wg = (cfl*)(wrg + (size_t)k * NGRP);
#pragma unroll
                    for (int j = 0; j < 4; ++j) acc[j] += x[kk] * wg[j];
#pragma unroll
                    for (int j = 0; j < 32; ++j) acc[4 + j] += x[kk] * we[j]; } }
#pragma unroll
            for (int j = 0; j < 36; ++j) part[(w * 36 + j) * 64 + lane] = acc[j];
            __syncthreads();
            if (w == 0) {
                float lg[NGRP], le[NEXP];
#pragma unroll
                for (int j = 0; j < NGRP; ++j) { float s = brg[j];
#pragma unroll
                    for (int ww = 0; ww < 8; ++ww) s += part[(ww * 36 + j) * 64 + lane]; lg[j] = s; }
#pragma unroll
                for (int j = 0; j < NEXP; ++j) { float s = bre[j];
#pragma unroll
                    for (int ww = 0; ww < 8; ++ww) s += part[(ww * 36 + 4 + j) * 64 + lane]; le[j] = s; }
                int gi = 0; float gm = lg[0];
#pragma unroll
                for (int j = 1; j < NGRP; ++j) if (lg[j] > gm) { gm = lg[j]; gi = j; }
                float gs = 0.f;
#pragma unroll
                for (int j = 0; j < NGRP; ++j) gs += expf(lg[j] - gm);
                const float group_p = 1.f / gs;
                float el[EPG];
#pragma unroll
                for (int j = 0; j < EPG; ++j) { float v = le[j];
#pragma unroll
                    for (int g2 = 1; g2 < NGRP; ++g2) v = (gi == g2) ? le[g2 * EPG + j] : v;
                    el[j] = v; }
                int e0 = 0; float m0 = el[0];
#pragma unroll
                for (int j = 1; j < EPG; ++j) if (el[j] > m0) { m0 = el[j]; e0 = j; }
                int e1 = -1; float m1 = -3.0e38f;
#pragma unroll
                for (int j = 0; j < EPG; ++j) if (j != e0 && el[j] > m1) { m1 = el[j]; e1 = j; }
                const float p1 = expf(m1 - m0); const float g0 = group_p / (1.f + p1), g1 = group_p * p1 / (1.f + p1);
                const int E0 = gi * EPG + e0, E1 = gi * EPG + e1;
                tokinfo[(size_t)t * 4 + 0] = E0; tokinfo[(size_t)t * 4 + 1] = E1;
                ((float*)tokinfo)[(size_t)t * 4 + 2] = g0; ((float*)tokinfo)[(size_t)t * 4 + 3] = g1;
                const unsigned s0 = atomicAdd(cnt + E0 * 64, 1u); list[(size_t)E0 * T + s0] = t * 2 + 0;
                const unsigned s1 = atomicAdd(cnt + E1 * 64, 1u); list[(size_t)E1 * T + s1] = t * 2 + 1;
            }
            __syncthreads();
        }
    }
}
#endif

#ifndef CPU_TEST
namespace pg8 {
#define PG8_LAS __attribute__((address_space(3)))
typedef short bf16x8 __attribute__((ext_vector_type(8)));
typedef float f32x4 __attribute__((ext_vector_type(4)));
constexpr int BM = 256, BK = 64, HALF = 128, HTB = HALF * BK * 2, STAGE_BYTES = 8 * HTB;
__device__ __forceinline__ int lds_byte(int r, int c) { const int st = (r >> 4) * 2 + (c >> 5), rr = r & 15, cc = c & 31, ob = rr * 64 + cc * 2; return st * 1024 + (ob ^ (((ob >> 9) & 1) << 5)); }
__device__ __forceinline__ void stage_rc(int b, int& R, int& C) { const int st = b / 1024, sb = b % 1024, swz = sb ^ (((sb >> 9) & 1) << 5); R = (st >> 1) * 16 + swz / 64; C = (st & 1) * 32 + (swz % 64) / 2; }
__device__ __forceinline__ int perm32(int rho) { const int n = rho >> 4, i = rho & 15; return 8 * (i >> 2) + 4 * n + (i & 3); }
struct Unit { int pm, pn; long aoff, boff; };
struct Gemm { const bf16_t* A; const bf16_t* Bt; int lda, ldb, K; };

template <class F> __device__ __forceinline__ void run_epi(const F& f, const f32x4 (&acc)[2][2][4][2], const Unit& u, int wr, int wc, int fr, int fq) {
#pragma unroll
    for (int ai = 0; ai < 2; ++ai)
#pragma unroll
        for (int m = 0; m < 4; ++m) { const int row = u.pm * BM + ai * HALF + wr * 64 + m * 16 + fr;
            if constexpr (F::MODE == 1) { const int hcol = u.pn * 128 + wc * 32 + 8 * fq; float g[8], up[8];
#pragma unroll
                for (int j = 0; j < 4; ++j) { g[j] = acc[ai][0][m][0][j]; g[4 + j] = acc[ai][0][m][1][j]; up[j] = acc[ai][1][m][0][j]; up[4 + j] = acc[ai][1][m][1][j]; }
                f.put8gu(row, hcol, g, up); }
            else if constexpr (F::PERM) {
#pragma unroll
                for (int bj = 0; bj < 2; ++bj) { const int col = u.pn * BM + bj * HALF + wc * 32 + 8 * fq; float a[8];
#pragma unroll
                    for (int j = 0; j < 4; ++j) { a[j] = acc[ai][bj][m][0][j]; a[4 + j] = acc[ai][bj][m][1][j]; }
                    f.put8(row, col, a); } }
            else {
#pragma unroll
                for (int bj = 0; bj < 2; ++bj)
#pragma unroll
                    for (int n = 0; n < 2; ++n) { const int col = u.pn * BM + bj * HALF + wc * 32 + 16 * n + 4 * fq; float a[4];
#pragma unroll
                        for (int j = 0; j < 4; ++j) a[j] = acc[ai][bj][m][n][j];
                        f.put4(row, col, a); } }
        }
}

template <class Epi, class Sched>
__device__ __forceinline__ void gemm_phase(PG8_LAS unsigned char* lds, const Gemm g, const Sched& S, const Epi& E) {
    int tid = threadIdx.x; asm volatile("" : "+v"(tid));
    const int wid = __builtin_amdgcn_readfirstlane(tid >> 6), lane = tid & 63, wr = wid >> 2, wc = wid & 3, fr = lane & 15, fq = lane >> 4;
    const int K = g.K, nt = K / BK;
    unsigned voffA[2], voffB[2];
#pragma unroll
    for (int i = 0; i < 2; ++i) { int R, C; stage_rc(tid * 16 + i * 8192, R, C); const int Rb = Epi::PERM ? ((R & ~31) + perm32(R & 31)) : R;
        voffA[i] = (unsigned)(R * g.lda + C) * 2u; voffB[i] = (unsigned)(Rb * g.ldb + C) * 2u; }
    const size_t kstep = (size_t)(BK * 2);
    const size_t hstepA = (size_t)HALF * g.lda * 2, hstepB = (size_t)HALF * g.ldb * 2;
    const unsigned ldsw = (unsigned)wid * 1024u;
    const int aoff = lds_byte(wr * 64 + fr, fq * 8), boff = lds_byte(wc * 32 + fr, fq * 8);
#define PG8_SA(b, h) (((b) * 2 + (h)) * HTB)
#define PG8_SB(b, h) ((4 + (b) * 2 + (h)) * HTB)
#define PG8_STAGE(bufoff, gbase, voff) do { _Pragma("unroll") for (int _i = 0; _i < 2; ++_i) \
        __builtin_amdgcn_global_load_lds((const unsigned*)((const char*)(gbase) + (voff)[_i]), (PG8_LAS unsigned*)(lds + (bufoff) + ldsw + _i * 8192), 16, 0, 0); } while (0)
#define PG8_LDA(dst, b, h) do { _Pragma("unroll") for (int m = 0; m < 4; ++m) _Pragma("unroll") for (int k = 0; k < 2; ++k) dst[m][k] = *(const PG8_LAS bf16x8*)(lds + PG8_SA(b, h) + aoff + m * 2048 + k * 1024); } while (0)
#define PG8_LDB(dst, b, h) do { _Pragma("unroll") for (int n = 0; n < 2; ++n) _Pragma("unroll") for (int k = 0; k < 2; ++k) dst[n][k] = *(const PG8_LAS bf16x8*)(lds + PG8_SB(b, h) + boff + n * 2048 + k * 1024); } while (0)
#define PG8_MMA(ai, bj, At, Bt) do { __builtin_amdgcn_s_setprio(1); _Pragma("unroll") for (int m = 0; m < 4; ++m) _Pragma("unroll") for (int n = 0; n < 2; ++n) _Pragma("unroll") for (int k = 0; k < 2; ++k) \
        acc[ai][bj][m][n] = __builtin_amdgcn_mfma_f32_16x16x32_bf16(Bt[n][k], At[m][k], acc[ai][bj][m][n], 0, 0, 0); __builtin_amdgcn_s_setprio(0); } while (0)
#define PG8_WAIT_V(n) asm volatile("s_waitcnt vmcnt(" #n ")" ::: "memory")
#define PG8_WAIT_L(n) asm volatile("s_waitcnt lgkmcnt(" #n ")" ::: "memory")
#define PG8_BAR __builtin_amdgcn_s_barrier()
#define PG8_SCHED __builtin_amdgcn_sched_barrier(0)
    Unit cur, nxt; int ui = 0;
    if (!S.next(0, cur)) return;
    f32x4 acc[2][2][4][2];
#pragma unroll
    for (int a = 0; a < 2; ++a)
#pragma unroll
        for (int b = 0; b < 2; ++b)
#pragma unroll
            for (int m = 0; m < 4; ++m)
#pragma unroll
                for (int n = 0; n < 2; ++n) acc[a][b][m][n] = (f32x4){0.f, 0.f, 0.f, 0.f};
    bf16x8 At[4][2], B0[2][2], B1[2][2];
    const char* cA = (const char*)g.A + cur.aoff; const char* cB = (const char*)g.Bt + cur.boff;
    PG8_STAGE(PG8_SB(0, 0), cB, voffB); PG8_STAGE(PG8_SB(0, 1), cB + hstepB, voffB); PG8_STAGE(PG8_SA(0, 0), cA, voffA); PG8_STAGE(PG8_SA(0, 1), cA + hstepA, voffA);
    if (wr == 1) PG8_BAR;
    PG8_WAIT_V(2); PG8_BAR;
    PG8_STAGE(PG8_SB(1, 0), cB + kstep, voffB); PG8_STAGE(PG8_SA(1, 0), cA + kstep, voffA); PG8_STAGE(PG8_SB(1, 1), cB + hstepB + kstep, voffB);
    PG8_WAIT_V(6); PG8_BAR;
    for (;;) {
        const bool has_next = S.next(ui + 1, nxt);
        const char* nA = has_next ? (const char*)g.A + nxt.aoff : cA; const char* nB = has_next ? (const char*)g.Bt + nxt.boff : cB;
_Pragma("unroll 1")
        for (int t = 0; t < nt; t += 2) {
            const bool last = (t == nt - 2);
            const char* a1 = cA + (size_t)(t + 1) * kstep;
            const char* a2 = last ? nA : cA + (size_t)(t + 2) * kstep; const char* b2 = last ? nB : cB + (size_t)(t + 2) * kstep;
            const char* a3 = a2 + kstep; const char* b3 = b2 + kstep;
            PG8_LDB(B0, 0, 0); PG8_LDB(B1, 0, 1); PG8_SCHED; PG8_LDA(At, 0, 0); PG8_STAGE(PG8_SA(1, 1), a1 + hstepA, voffA);
            PG8_WAIT_V(8); PG8_WAIT_L(0); PG8_BAR; PG8_MMA(0, 0, At, B0); PG8_MMA(0, 1, At, B1); PG8_BAR; PG8_SCHED;
            PG8_LDA(At, 0, 1); PG8_STAGE(PG8_SB(0, 0), b2, voffB); PG8_STAGE(PG8_SB(0, 1), b2 + hstepB, voffB); PG8_STAGE(PG8_SA(0, 0), a2, voffA);
            PG8_WAIT_V(8); PG8_WAIT_L(0); PG8_BAR; PG8_MMA(1, 0, At, B0); PG8_MMA(1, 1, At, B1); PG8_BAR; PG8_SCHED;
            PG8_LDB(B0, 1, 0); PG8_LDB(B1, 1, 1); PG8_SCHED; PG8_LDA(At, 1, 0); PG8_STAGE(PG8_SA(0, 1), a2 + hstepA, voffA);
            PG8_WAIT_V(8); PG8_WAIT_L(0); PG8_BAR; PG8_MMA(0, 0, At, B0); PG8_MMA(0, 1, At, B1); PG8_BAR; PG8_SCHED;
            PG8_LDA(At, 1, 1); PG8_STAGE(PG8_SB(1, 0), b3, voffB); PG8_STAGE(PG8_SB(1, 1), b3 + hstepB, voffB); PG8_STAGE(PG8_SA(1, 0), a3, voffA);
            PG8_WAIT_V(8); PG8_WAIT_L(0); PG8_BAR; PG8_MMA(1, 0, At, B0); PG8_MMA(1, 1, At, B1); PG8_BAR; PG8_SCHED;
        }
        if (wr == 0) PG8_BAR;
        run_epi(E, acc, cur, wr, wc, fr, fq);
        if (!has_next) break;
#pragma unroll
        for (int a = 0; a < 2; ++a)
#pragma unroll
            for (int b = 0; b < 2; ++b)
#pragma unroll
                for (int m = 0; m < 4; ++m)
#pragma unroll
                    for (int n = 0; n < 2; ++n) acc[a][b][m][n] = (f32x4){0.f, 0.f, 0.f, 0.f};
        cur = nxt; cA = nA; cB = nB; ++ui;
        if (wr == 1) PG8_BAR;
    }
    PG8_WAIT_V(0);
    PG8_BAR;
#undef PG8_SA
#undef PG8_SB
#undef PG8_STAGE
#undef PG8_LDA
#undef PG8_LDB
#undef PG8_MMA
#undef PG8_WAIT_V
#undef PG8_WAIT_L
#undef PG8_BAR
#undef PG8_SCHED
}
struct DenseOrder {
    int nM, nN, G, c; long astep, bstep;
    __device__ __forceinline__ bool next(int i, Unit& u) const {
        const long L = (long)i * G + c; if (L >= (long)nM * nN) return false;
        const int w = (int)L; const int nig = 8 * nN, gid = w / nig, fm = gid * 8, gsz = (nM - fm) < 8 ? (nM - fm) : 8;
        u.pm = fm + ((w % nig) % gsz); u.pn = (w % nig) / gsz; u.aoff = (long)u.pm * astep; u.boff = (long)u.pn * bstep; return true; }
};
struct MoeOrder {
    const PG8_LAS int* tbl; int nM, nN, G, c; long astep, bstep, estep;
    __device__ __forceinline__ bool next(int i, Unit& u) const {
        const long L = (long)i * G + c; if (L >= (long)nM * nN) return false;
        const int w = (int)L; u.pm = w / nN; u.pn = w % nN; const int e = tbl[u.pm];
        u.aoff = (long)u.pm * astep; u.boff = (long)e * estep + (long)u.pn * bstep; return true; }
};
}
#endif

#ifndef CPU_TEST
namespace att {
typedef short bf16x8 __attribute__((ext_vector_type(8)));
typedef short s16x4 __attribute__((ext_vector_type(4)));
typedef float f32x16 __attribute__((ext_vector_type(16)));
typedef float f32x2_t __attribute__((ext_vector_type(2))); typedef __bf16 bf16x2_t __attribute__((ext_vector_type(2)));
typedef unsigned u32x4 __attribute__((ext_vector_type(4)));
typedef unsigned u32x2 __attribute__((ext_vector_type(2)));
#define ATT_LAS __attribute__((address_space(3)))
#define BAR_LDS() asm volatile("s_waitcnt lgkmcnt(0)\n\ts_barrier" ::: "memory")
constexpr int KP = 104, VP = 68;
constexpr int KBUF = 64 * KP * 2, VBUF = 64 * VP * 2;
constexpr int LDS_NEED = 2 * KBUF + 2 * VBUF;
__device__ __forceinline__ unsigned cvtpk(float lo, float hi) { f32x2_t v = {lo, hi}; bf16x2_t b = __builtin_convertvector(v, bf16x2_t); return __builtin_bit_cast(unsigned, b); }
__device__ __forceinline__ int crow(int r, int hi) { return (r & 3) + 8 * (r >> 2) + 4 * hi; }
__device__ __forceinline__ u32x4 scale8(const u32x4& w, float s) { u32x4 o;
#pragma unroll
    for (int j = 0; j < 4; ++j) o[j] = cvtpk(__builtin_bit_cast(float, w[j] << 16) * s, __builtin_bit_cast(float, w[j] & 0xffff0000u) * s);
    return o; }
__device__ __forceinline__ void unit(ATT_LAS unsigned char* lds, const bf16_t* Q, const bf16_t* K, const bf16_t* V, const float* rstd, bf16_t* mix, int b, int h, int qb) {
    int tid = threadIdx.x; asm volatile("" : "+v"(tid));
    const int lane = tid & 63, w = __builtin_amdgcn_readfirstlane(tid >> 6), r32 = lane & 31, hi = lane >> 5;
    const size_t tb = (size_t)b * SEQ;
    const int q = qb * 256 + w * 32 + r32;
    bf16x8 qr[6];
    { const bf16_t* qrow = Q + (tb + q) * 384 + h * 96 + 8 * hi;
      const float rq = rstd[(tb + q) * 2];
#pragma unroll
      for (int ks = 0; ks < 6; ++ks) qr[ks] = __builtin_bit_cast(bf16x8, scale8(*(const u32x4*)(qrow + 16 * ks), rq)); }
    f32x16 o0, o1;
#pragma unroll
    for (int r = 0; r < 16; ++r) { o0[r] = 0.f; o1[r] = 0.f; }
    float m = -1e30f, lsum = 0.f;
    const int NT = 4 * (qb + 1);
    const int kr0 = tid / 12, kp0 = tid % 12, kr1 = (tid + 512) / 12, kp1 = (tid + 512) % 12; const bool has1 = tid < 256;
    const int vk = tid >> 3, vp = tid & 7;
    const bf16_t* gK0 = K + (tb + kr0) * 384 + h * 96 + kp0 * 8; const bf16_t* gK1 = K + (tb + kr1) * 384 + h * 96 + kp1 * 8;
    const bf16_t* gV = V + (tb + vk) * 256 + h * 64 + vp * 8;
    u32x4 sk0, sk1, sv; sk1 = (u32x4){0u, 0u, 0u, 0u};
    const float* gR0 = rstd + (tb + kr0) * 2 + 1; const float* gR1 = rstd + (tb + kr1) * 2 + 1; const float* gRv = rstd + (tb + vk) * 2 + 1;
    float s0 = gR0[0], s1 = has1 ? gR1[0] : 0.f, s2 = gRv[0];
    sk0 = *(const u32x4*)gK0; if (has1) sk1 = *(const u32x4*)gK1; sv = *(const u32x4*)gV;
#define ATT_WRITE(buf) do { \
        if (kp0 < 8) sk0 = scale8(sk0, s0); if (kp1 < 8) sk1 = scale8(sk1, s1); sv = scale8(sv, s2); \
        *(ATT_LAS u32x4*)(lds + (buf) * KBUF + (kr0 * KP + kp0 * 8) * 2) = sk0; \
        if (has1) *(ATT_LAS u32x4*)(lds + (buf) * KBUF + (kr1 * KP + kp1 * 8) * 2) = sk1; \
        ATT_LAS unsigned short* vt_ = (ATT_LAS unsigned short*)(lds + 2 * KBUF + (buf) * VBUF); \
        _Pragma("unroll") for (int j = 0; j < 4; ++j) { vt_[(8 * vp + 2 * j) * VP + vk] = (unsigned short)(sv[j] & 0xffffu); vt_[(8 * vp + 2 * j + 1) * VP + vk] = (unsigned short)(sv[j] >> 16); } } while (0)
    ATT_WRITE(0);
    BAR_LDS();
    for (int t = 0; t < NT; ++t) {
        const int buf = t & 1;
        if (t + 1 < NT) { const size_t adv = (size_t)(t + 1) * 64; sk0 = *(const u32x4*)(gK0 + adv * 384); if (has1) sk1 = *(const u32x4*)(gK1 + adv * 384); sv = *(const u32x4*)(gV + adv * 256);
            s0 = gR0[adv * 2]; if (has1) s1 = gR1[adv * 2]; s2 = gRv[adv * 2]; }
        f32x16 p0, p1;
#pragma unroll
        for (int r = 0; r < 16; ++r) { p0[r] = 0.f; p1[r] = 0.f; }
        { ATT_LAS const unsigned char* kb = lds + buf * KBUF + (r32 * KP + 8 * hi) * 2;
#pragma unroll
          for (int ks = 0; ks < 6; ++ks) { const bf16x8 a0 = *(ATT_LAS const bf16x8*)(kb + ks * 32), a1 = *(ATT_LAS const bf16x8*)(kb + 32 * KP * 2 + ks * 32);
              p0 = __builtin_amdgcn_mfma_f32_32x32x16_bf16(a0, qr[ks], p0, 0, 0, 0); p1 = __builtin_amdgcn_mfma_f32_32x32x16_bf16(a1, qr[ks], p1, 0, 0, 0); } }
        if (t >= NT - 4) {
            const int k0 = t * 64;
#pragma unroll
            for (int r = 0; r < 16; ++r) { const int kk = k0 + crow(r, hi); if (kk > q) p0[r] = -1e30f; if (kk + 32 > q) p1[r] = -1e30f; } }
        float rm = p0[0];
#pragma unroll
        for (int r = 1; r < 16; ++r) rm = fmaxf(rm, p0[r]);
#pragma unroll
        for (int r = 0; r < 16; ++r) rm = fmaxf(rm, p1[r]);
        rm = fmaxf(rm, __shfl_xor(rm, 32));
        const float mn = fmaxf(m, rm); const float alpha = __builtin_amdgcn_exp2f(m - mn); m = mn;
        float ps = 0.f;
#pragma unroll
        for (int r = 0; r < 16; ++r) { p0[r] = __builtin_amdgcn_exp2f(p0[r] - mn); p1[r] = __builtin_amdgcn_exp2f(p1[r] - mn); ps += p0[r] + p1[r]; }
        lsum = lsum * alpha + ps;
#pragma unroll
        for (int r = 0; r < 16; ++r) { o0[r] *= alpha; o1[r] *= alpha; }
        { ATT_LAS const unsigned char* vb = lds + 2 * KBUF + buf * VBUF + (r32 * VP + 4 * hi) * 2;
#pragma unroll
          for (int s = 0; s < 4; ++s) {
              u32x4 pw;
              if (s == 0) pw = (u32x4){cvtpk(p0[0], p0[1]), cvtpk(p0[2], p0[3]), cvtpk(p0[4], p0[5]), cvtpk(p0[6], p0[7])};
              else if (s == 1) pw = (u32x4){cvtpk(p0[8], p0[9]), cvtpk(p0[10], p0[11]), cvtpk(p0[12], p0[13]), cvtpk(p0[14], p0[15])};
              else if (s == 2) pw = (u32x4){cvtpk(p1[0], p1[1]), cvtpk(p1[2], p1[3]), cvtpk(p1[4], p1[5]), cvtpk(p1[6], p1[7])};
              else pw = (u32x4){cvtpk(p1[8], p1[9]), cvtpk(p1[10], p1[11]), cvtpk(p1[12], p1[13]), cvtpk(p1[14], p1[15])};
              const bf16x8 pb = __builtin_bit_cast(bf16x8, pw);
              const u32x2 a00 = *(ATT_LAS const u32x2*)(vb + s * 32), a01 = *(ATT_LAS const u32x2*)(vb + s * 32 + 16);
              const u32x2 a10 = *(ATT_LAS const u32x2*)(vb + 32 * VP * 2 + s * 32), a11 = *(ATT_LAS const u32x2*)(vb + 32 * VP * 2 + s * 32 + 16);
              const bf16x8 va0 = __builtin_bit_cast(bf16x8, (u32x4){a00[0], a00[1], a01[0], a01[1]}), va1 = __builtin_bit_cast(bf16x8, (u32x4){a10[0], a10[1], a11[0], a11[1]});
              o0 = __builtin_amdgcn_mfma_f32_32x32x16_bf16(va0, pb, o0, 0, 0, 0); o1 = __builtin_amdgcn_mfma_f32_32x32x16_bf16(va1, pb, o1, 0, 0, 0); } }
        if (t + 1 < NT) ATT_WRITE(buf ^ 1);
        BAR_LDS();
    }
#undef ATT_WRITE
    lsum += __shfl_xor(lsum, 32);
    const float inv = 1.f / lsum;
    bf16_t* orow = mix + (tb + q) * DMIX + 768 + h * 64;
#pragma unroll
    for (int rg = 0; rg < 4; ++rg) {
        u32x2 w0 = {cvtpk(o0[4 * rg] * inv, o0[4 * rg + 1] * inv), cvtpk(o0[4 * rg + 2] * inv, o0[4 * rg + 3] * inv)};
        u32x2 w1 = {cvtpk(o1[4 * rg] * inv, o1[4 * rg + 1] * inv), cvtpk(o1[4 * rg + 2] * inv, o1[4 * rg + 3] * inv)};
        *(u32x2*)(orow + 8 * rg + 4 * hi) = w0; *(u32x2*)(orow + 32 + 8 * rg + 4 * hi) = w1; }
}
}
#endif

#ifndef CPU_TEST
namespace lin {
using att::bf16x8; using att::f32x16; using att::u32x4; using att::u32x2; using att::cvtpk; using att::crow;
constexpr int PT = 68;
template <int DK, int NDV> struct Lay {
    static constexpr int PQ = DK + 8;
    static constexpr int OFF_Q = 0, OFF_K = OFF_Q + 64 * PQ * 2, OFF_KH = OFF_K + 64 * PQ * 2, OFF_VT = OFF_KH + DK * PT * 2, OFF_DEC = OFF_VT + NDV * PT * 2, BUF = OFF_DEC + 256;
};
__device__ __forceinline__ bf16x8 ldA16(ATT_LAS const unsigned char* p) { return *(ATT_LAS const bf16x8*)p; }
__device__ __forceinline__ bf16x8 ldP8(ATT_LAS const unsigned char* p) { const u32x2 a = *(ATT_LAS const u32x2*)p, b = *(ATT_LAS const u32x2*)(p + 16); return __builtin_bit_cast(bf16x8, (u32x4){a[0], a[1], b[0], b[1]}); }
__device__ __forceinline__ bf16x8 pack8(const f32x16& x, int s) {
    u32x4 p;
    if (s == 0) p = (u32x4){cvtpk(x[0], x[1]), cvtpk(x[2], x[3]), cvtpk(x[4], x[5]), cvtpk(x[6], x[7])};
    else p = (u32x4){cvtpk(x[8], x[9]), cvtpk(x[10], x[11]), cvtpk(x[12], x[13]), cvtpk(x[14], x[15])};
    return __builtin_bit_cast(bf16x8, p); }
#define MF32(a, b, c) __builtin_amdgcn_mfma_f32_32x32x16_bf16((a), (b), (c), 0, 0, 0)
template <int DK, int NDV> __device__ __forceinline__ void compute(ATT_LAS const unsigned char* B, int ib, int dvb, int r32, int hi, f32x16 (&H)[DK / 32], f32x16& O) {
    typedef Lay<DK, NDV> L;
    f32x16 X[2];
#pragma unroll
    for (int r = 0; r < 16; ++r) { X[0][r] = 0.f; X[1][r] = 0.f; O[r] = 0.f; }
#pragma unroll
    for (int jb = 0; jb < 2; ++jb) if (jb <= ib) {
#pragma unroll
        for (int s = 0; s < DK / 16; ++s)
            X[jb] = MF32(ldA16(B + L::OFF_K + ((32 * jb + r32) * L::PQ + 16 * s + 8 * hi) * 2), ldA16(B + L::OFF_Q + ((32 * ib + r32) * L::PQ + 16 * s + 8 * hi) * 2), X[jb]);
        if (jb == ib) {
#pragma unroll
            for (int r = 0; r < 16; ++r) if (crow(r, hi) > r32) X[jb][r] = 0.f; } }
    bf16x8 vf[2][2];
#pragma unroll
    for (int jb = 0; jb < 2; ++jb)
#pragma unroll
        for (int s = 0; s < 2; ++s) vf[jb][s] = ldP8(B + L::OFF_VT + ((32 * dvb + r32) * PT + 32 * jb + 16 * s + 4 * hi) * 2);
#pragma unroll
    for (int jb = 0; jb < 2; ++jb) if (jb <= ib) {
#pragma unroll
        for (int s = 0; s < 2; ++s) O = MF32(pack8(X[jb], s), vf[jb][s], O); }
#pragma unroll
    for (int db = 0; db < DK / 32; ++db)
#pragma unroll
        for (int s = 0; s < 2; ++s) O = MF32(ldP8(B + L::OFF_Q + ((32 * ib + r32) * L::PQ + 32 * db + 16 * s + 4 * hi) * 2), pack8(H[db], s), O);
#pragma unroll
    for (int db = 0; db < DK / 32; ++db) {
        ATT_LAS const float* dec = (ATT_LAS const float*)(B + L::OFF_DEC);
#pragma unroll
        for (int r = 0; r < 16; ++r) H[db][r] *= dec[32 * db + crow(r, hi)];
#pragma unroll
        for (int jb = 0; jb < 2; ++jb)
#pragma unroll
            for (int s = 0; s < 2; ++s) H[db] = MF32(ldP8(B + L::OFF_KH + ((32 * db + r32) * PT + 32 * jb + 16 * s + 4 * hi) * 2), vf[jb][s], H[db]); }
}
__device__ __forceinline__ float scan64(float v, int lane) {
    { int y = __builtin_amdgcn_update_dpp(0, __builtin_bit_cast(int, v), 0x111, 0xF, 0xF, true); v += __builtin_bit_cast(float, y); }
    { int y = __builtin_amdgcn_update_dpp(0, __builtin_bit_cast(int, v), 0x112, 0xF, 0xF, true); v += __builtin_bit_cast(float, y); }
    { int y = __builtin_amdgcn_update_dpp(0, __builtin_bit_cast(int, v), 0x114, 0xF, 0xF, true); v += __builtin_bit_cast(float, y); }
    { int y = __builtin_amdgcn_update_dpp(0, __builtin_bit_cast(int, v), 0x118, 0xF, 0xF, true); v += __builtin_bit_cast(float, y); }
    const int x = __builtin_bit_cast(int, v);
    const float t0 = __builtin_bit_cast(float, __builtin_amdgcn_readlane(x, 15)), t1 = __builtin_bit_cast(float, __builtin_amdgcn_readlane(x, 31)), t2 = __builtin_bit_cast(float, __builtin_amdgcn_readlane(x, 47));
    const int row = lane >> 4;
    return v + (row >= 1 ? t0 : 0.f) + (row >= 2 ? t1 : 0.f) + (row >= 3 ? t2 : 0.f); }
__device__ __forceinline__ float bfl(unsigned w) { return __builtin_bit_cast(float, w << 16); }
__device__ __forceinline__ float bfh(unsigned w) { return __builtin_bit_cast(float, w & 0xffff0000u); }
__device__ __forceinline__ void vt_write(ATT_LAS unsigned char* B, int off_vt, int tok, int part, const u32x4& sv) {
    ATT_LAS unsigned short* vt = (ATT_LAS unsigned short*)(B + off_vt);
#pragma unroll
    for (int j = 0; j < 4; ++j) { vt[(8 * part + 2 * j) * PT + tok] = (unsigned short)(sv[j] & 0xffffu); vt[(8 * part + 2 * j + 1) * PT + tok] = (unsigned short)(sv[j] >> 16); } }

#define GLA_FETCH(c) do { const size_t t_ = tb + (size_t)(c) * 64 + lane; const bf16_t* ur = u + t_ * DINP; \
        pa0 = *(const u32x4*)(ur + UB_AD); pa1 = *(const u32x4*)(ur + UB_AD + 8); pq = *(const u32x2*)(ur + UB_Q + h * 32 + 4 * w); pk = *(const u32x2*)(ur + UB_K + h * 32 + 4 * w); \
        pv = *(const u32x4*)(u + (tb + (size_t)(c) * 64 + vtok) * DINP + UB_V + h * 64 + vpart * 8); } while (0)
#define GLA_PREP(buf) do { ATT_LAS unsigned char* B_ = lds + (buf) * L::BUF; \
        float adv[16]; _Pragma("unroll") for (int j = 0; j < 4; ++j) { adv[2 * j] = bfl(pa0[j]); adv[2 * j + 1] = bfh(pa0[j]); adv[8 + 2 * j] = bfl(pa1[j]); adv[9 + 2 * j] = bfh(pa1[j]); } \
        const float qv[4] = {bfl(pq[0]), bfh(pq[0]), bfl(pq[1]), bfh(pq[1])}, kv[4] = {bfl(pk[0]), bfh(pk[0]), bfl(pk[1]), bfh(pk[1])}; \
        float qo[4], ko[4]; \
        _Pragma("unroll") for (int d = 0; d < 4; ++d) { float z = ab[d]; _Pragma("unroll") for (int j = 0; j < 16; ++j) z += adv[j] * aup[j * 128 + d]; \
            const float la = -softplusf_(-z) * (1.f / 16.f); const float bc = scan64(la, lane); const float be = __builtin_bit_cast(float, __builtin_amdgcn_readlane(__builtin_bit_cast(int, bc), 63)); \
            qo[d] = qv[d] * __expf(bc) * 0.17677669529663687f; ko[d] = kv[d] * __expf(-bc); const float kh = kv[d] * __expf(be - bc); \
            ((ATT_LAS unsigned short*)(B_ + L::OFF_KH))[(4 * w + d) * PT + lane] = f2bf(kh); \
            if (lane == 63) ((ATT_LAS float*)(B_ + L::OFF_DEC))[4 * w + d] = __expf(be); } \
        *(ATT_LAS u32x2*)(B_ + L::OFF_Q + (lane * L::PQ + 4 * w) * 2) = (u32x2){cvtpk(qo[0], qo[1]), cvtpk(qo[2], qo[3])}; \
        *(ATT_LAS u32x2*)(B_ + L::OFF_K + (lane * L::PQ + 4 * w) * 2) = (u32x2){cvtpk(ko[0], ko[1]), cvtpk(ko[2], ko[3])}; \
        vt_write(B_, L::OFF_VT, vtok, vpart, pv); } while (0)
#define ML_FETCH(c) do { const int s_ = (c) * 64 + lane; const bf16_t* ur = u + (tb + s_) * DINP; \
        _Pragma("unroll") for (int j = 0; j < 4; ++j) { const bool ok = s_ - 3 + j >= 0; const bf16_t* up = ur + (ptrdiff_t)(j - 3) * DINP; \
            xq[j] = ok ? *(const u32x4*)(up + UC_Q + h * 64 + 8 * w) : (u32x4){0u, 0u, 0u, 0u}; xk[j] = ok ? *(const u32x4*)(up + UC_K + h * 64 + 8 * w) : (u32x4){0u, 0u, 0u, 0u}; } \
        pg = *(const u32x4*)(ur + UC_IG); pv = *(const u32x4*)(u + (tb + (size_t)(c) * 64 + vtok) * DINP + UC_V + h * 64 + vpart * 8); } while (0)
#define ML_PREP(buf) do { ATT_LAS unsigned char* B_ = lds + (buf) * L::BUF; \
        const unsigned gi_ = pg[h >> 1], gf_ = pg[2 + (h >> 1)]; const float ig = ((h & 1) ? bfh(gi_) : bfl(gi_)) + ibias; const float lf = -softplusf_(-(((h & 1) ? bfh(gf_) : bfl(gf_)) + fbias)); \
        const float F = scan64(lf, lane); const float Fe = __builtin_bit_cast(float, __builtin_amdgcn_readlane(__builtin_bit_cast(int, F), 63)); const float eF = __expf(F), wk = __expf(ig - F) * 0.125f, wkh = __expf(Fe - F + ig) * 0.125f; \
        float qo[8], ko[8]; \
        _Pragma("unroll") for (int ch = 0; ch < 8; ++ch) { float yq = cb[ch], yk = cb[256 + ch]; \
            _Pragma("unroll") for (int j = 0; j < 4; ++j) { const unsigned wq_ = xq[j][ch >> 1], wk_ = xk[j][ch >> 1]; \
                yq += cw[j * 512 + ch] * ((ch & 1) ? bfh(wq_) : bfl(wq_)); yk += cw[j * 512 + 256 + ch] * ((ch & 1) ? bfh(wk_) : bfl(wk_)); } \
            const float sq = siluf_(yq), sk = siluf_(yk); qo[ch] = sq * eF; ko[ch] = sk * wk; \
            ((ATT_LAS unsigned short*)(B_ + L::OFF_KH))[(8 * w + ch) * PT + lane] = f2bf(sk * wkh); } \
        *(ATT_LAS u32x4*)(B_ + L::OFF_Q + (lane * L::PQ + 8 * w) * 2) = (u32x4){cvtpk(qo[0], qo[1]), cvtpk(qo[2], qo[3]), cvtpk(qo[4], qo[5]), cvtpk(qo[6], qo[7])}; \
        *(ATT_LAS u32x4*)(B_ + L::OFF_K + (lane * L::PQ + 8 * w) * 2) = (u32x4){cvtpk(ko[0], ko[1]), cvtpk(ko[2], ko[3]), cvtpk(ko[4], ko[5]), cvtpk(ko[6], ko[7])}; \
        if (w == 0) ((ATT_LAS float*)(B_ + L::OFF_DEC))[lane] = __expf(Fe); \
        vt_write(B_, L::OFF_VT, vtok, vpart, pv); } while (0)
template <int MIX> __device__ __forceinline__ void stage1_units(ATT_LAS unsigned char* lds, CtxRef C, int l, int first, int stride) {
    typedef Lay<(MIX == 0 ? 32 : 64), (MIX == 0 ? 64 : 96)> L;
    int tid = threadIdx.x; asm volatile("" : "+v"(tid));
    const int lane = tid & 63, w = __builtin_amdgcn_readfirstlane(tid >> 6);
    const bf16_t* u = WSP(bf16_t, WS_U);
    const int vtok = tid >> 3, vpart = tid & 7;
    unsigned char* blobs = C.ws + (MIX == 0 ? WS_GLA_BLOB : WS_ML_BLOB);
    if (MIX == 1) { for (int i = tid; i < 32 * PT; i += 512) ((ATT_LAS unsigned short*)(lds + L::OFF_VT))[64 * PT + i] = (i < PT) ? (unsigned short)0x3f80 : (unsigned short)0; }
    constexpr int NC = SEQ / 64, NV = L::BUF / 16;
    for (int uu = first; uu < BATCH * NH * NC; uu += stride) {
        const int bh = uu / NC, c = uu % NC, h = bh & 3; const size_t tb = (size_t)(bh >> 2) * SEQ;
        if (MIX == 0) { const float* aup = INF(I_GLA_UP) + l * 16 * 128 + h * 32 + 4 * w; const float* ab = INF(I_GLA_B) + l * 128 + h * 32 + 4 * w;
            u32x4 pa0, pa1, pv; u32x2 pq, pk; GLA_FETCH(c); GLA_PREP(0); }
        else { const float* cw = INF(I_CONVW) + l * 4 * 512 + h * 64 + 8 * w; const float* cb = INF(I_CONVB) + l * 512 + h * 64 + 8 * w; const float ibias = INF(I_IB)[l * 4 + h], fbias = INF(I_FB)[l * 4 + h];
            u32x4 xq[4], xk[4], pg, pv; ML_FETCH(c); ML_PREP(0); }
        BAR_LDS();
        u32x4* dst = (u32x4*)(blobs + (size_t)uu * L::BUF);
        for (int i = tid; i < NV; i += 512) dst[i] = *(ATT_LAS const u32x4*)(lds + i * 16);
        BAR_LDS();
    }
}
template <int MIX> __device__ __forceinline__ void stage2_run(ATT_LAS unsigned char* lds, CtxRef C, int b, int h) {
    typedef Lay<(MIX == 0 ? 32 : 64), (MIX == 0 ? 64 : 96)> L;
    constexpr int DK = (MIX == 0 ? 32 : 64), NDV = (MIX == 0 ? 64 : 96), NCW = (MIX == 0 ? 4 : 6);
    int tid = threadIdx.x; asm volatile("" : "+v"(tid));
    const int lane = tid & 63, w = __builtin_amdgcn_readfirstlane(tid >> 6), r32 = lane & 31, hi = lane >> 5;
    constexpr int NC = SEQ / 64, NV = L::BUF / 16, NI = (NV + 511) / 512;
    const unsigned char* blobs = C.ws + (MIX == 0 ? WS_GLA_BLOB : WS_ML_BLOB) + (size_t)(b * 4 + h) * NC * L::BUF;
    float* Y = WSP(float, (MIX == 0 ? WS_YB : WS_YC)); float* DEN = WSP(float, WS_DEN);
    const size_t tb = (size_t)b * SEQ;
    f32x16 H[DK / 32], O;
#pragma unroll
    for (int d = 0; d < DK / 32; ++d)
#pragma unroll
        for (int r = 0; r < 16; ++r) H[d][r] = 0.f;
    const int ib = (MIX == 0) ? (w >> 1) : (w / 3), dvb = (MIX == 0) ? (w & 1) : (w % 3);
    u32x4 s0[NI], s1[NI];
#define LB_FETCH(S, c) do { const u32x4* src_ = (const u32x4*)(blobs + (size_t)(c) * L::BUF); _Pragma("unroll") for (int i = 0; i < NI; ++i) { const int ix = tid + 512 * i; if (ix < NV) S[i] = src_[ix]; } } while (0)
#define LB_WRITE(S, buf) do { _Pragma("unroll") for (int i = 0; i < NI; ++i) { const int ix = tid + 512 * i; if (ix < NV) *(ATT_LAS u32x4*)(lds + (buf) * L::BUF + ix * 16) = S[i]; } } while (0)
#define LB_STEP(c, SW) do { \
        if (w < NCW) { compute<DK, NDV>(lds + ((c) & 1) * L::BUF, ib, dvb, r32, hi, H, O); \
            const size_t t0 = tb + (size_t)(c) * 64 + 32 * ib; \
            if (MIX == 0 || dvb < 2) { float* yo = Y + t0 * GW + h * 64 + 32 * dvb + r32; _Pragma("unroll") for (int r = 0; r < 16; ++r) yo[(size_t)crow(r, hi) * GW] = O[r]; } \
            else if (r32 == 0) { _Pragma("unroll") for (int r = 0; r < 16; ++r) DEN[(t0 + crow(r, hi)) * 4 + h] = O[r]; } } \
        if ((c) + 1 < NC) { LB_WRITE(SW, ((c) + 1) & 1); if ((c) + 3 < NC) LB_FETCH(SW, (c) + 3); } \
        BAR_LDS(); } while (0)
    LB_FETCH(s0, 0); LB_FETCH(s1, 1); LB_WRITE(s0, 0); LB_FETCH(s0, 2);
    BAR_LDS();
    for (int c = 0; c < NC; c += 2) { LB_STEP(c, s1); LB_STEP(c + 1, s0); }
#undef LB_FETCH
#undef LB_WRITE
#undef LB_STEP
}
#undef GLA_FETCH
#undef GLA_PREP
#undef ML_FETCH
#undef ML_PREP
#undef MF32
}
#endif

#ifndef CPU_TEST
namespace rwk {
constexpr int NB = 16;
constexpr int VEC = 6 * 64;
constexpr int BUFB = NB * VEC * 4;
__device__ __forceinline__ float dpp_add(float v, int ctrl_sel) {
    int x = __builtin_bit_cast(int, v), y;
    if (ctrl_sel == 0) y = __builtin_amdgcn_update_dpp(0, x, 0xB1, 0xF, 0xF, true);
    else if (ctrl_sel == 1) y = __builtin_amdgcn_update_dpp(0, x, 0x4E, 0xF, 0xF, true);
    else if (ctrl_sel == 2) y = __builtin_amdgcn_update_dpp(0, x, 0x141, 0xF, 0xF, true);
    else y = __builtin_amdgcn_update_dpp(0, x, 0x140, 0xF, 0xF, true);
    return v + __builtin_bit_cast(float, y); }
__device__ __forceinline__ float red16(float v) { v = dpp_add(v, 0); v = dpp_add(v, 1); v = dpp_add(v, 2); v = dpp_add(v, 3); return v; }
__device__ __forceinline__ void run(ATT_LAS unsigned char* lds, CtxRef C, int b, int h, int rg) {
    int tid = threadIdx.x; asm volatile("" : "+v"(tid));
    const int lane = tid & 63, w = __builtin_amdgcn_readfirstlane(tid >> 6);
    const float* src[6] = {WSP(float, WS_RW_A), WSP(float, WS_RW_W), WSP(float, WS_RW_B), WSP(float, WS_RW_K), WSP(float, WS_RW_R), WSP(float, WS_RW_V)};
    float* Y = WSP(float, WS_YA);
    const size_t tb = (size_t)b * SEQ;
    const int lt = tid - 256;
#define RW_LOAD(batch, buf) do { _Pragma("unroll") for (int i = 0; i < 6; ++i) { const int p = lt + 256 * i; const int st = p / 96, vc = (p % 96) >> 4, pt = p & 15; \
        const float* sp = (vc == 0 ? src[0] : vc == 1 ? src[1] : vc == 2 ? src[2] : vc == 3 ? src[3] : vc == 4 ? src[4] : src[5]); \
        const f4v v4 = *(const f4v*)(sp + (tb + (size_t)(batch) * NB + st) * GW + h * 64 + pt * 4); \
        *(ATT_LAS f4v*)(lds + (buf) * BUFB + (st * VEC + vc * 64 + pt * 4) * 4) = v4; } } while (0)
    constexpr int NBATCH = SEQ / NB;
    if (w >= 4) RW_LOAD(0, 0);
    BAR_LDS();
    const int row = 16 * rg + 4 * w + (lane >> 4), cg = lane & 15;
    float S0 = 0.f, S1 = 0.f, S2 = 0.f, S3 = 0.f;
    for (int bt = 0; bt < NBATCH; ++bt) {
        if (w >= 4) { if (bt + 1 < NBATCH) RW_LOAD(bt + 1, (bt + 1) & 1); }
        else {
            ATT_LAS const float* B = (ATT_LAS const float*)(lds + (bt & 1) * BUFB);
#pragma unroll 4
            for (int st = 0; st < NB; ++st) {
                ATT_LAS const float* P = B + st * VEC;
                const f4v a = *(ATT_LAS const f4v*)(P + 4 * cg), wv = *(ATT_LAS const f4v*)(P + 64 + 4 * cg), bb = *(ATT_LAS const f4v*)(P + 128 + 4 * cg),
                          kk = *(ATT_LAS const f4v*)(P + 192 + 4 * cg), r = *(ATT_LAS const f4v*)(P + 256 + 4 * cg);
                const float vv = P[320 + row];
                const float sa = red16((S0 * a[0] + S1 * a[1]) + (S2 * a[2] + S3 * a[3]));
                S0 = S0 * wv[0] + (sa * bb[0] + vv * kk[0]); S1 = S1 * wv[1] + (sa * bb[1] + vv * kk[1]);
                S2 = S2 * wv[2] + (sa * bb[2] + vv * kk[2]); S3 = S3 * wv[3] + (sa * bb[3] + vv * kk[3]);
                const float y = red16((S0 * r[0] + S1 * r[1]) + (S2 * r[2] + S3 * r[3]));
                if (cg == 0) Y[(tb + (size_t)bt * NB + st) * GW + h * 64 + row] = y;
            }
        }
        BAR_LDS();
    }
#undef RW_LOAD
}
}
#endif

#ifndef CPU_TEST
namespace rw7 {
using att::bf16x8; using att::f32x16; using att::u32x4; using att::u32x2; using att::cvtpk; using att::crow;
using lin::ldA16; using lin::ldP8; using lin::pack8; using lin::scan64; using lin::bfl; using lin::bfh;
#define MF32(a, b, c) __builtin_amdgcn_mfma_f32_32x32x16_bf16((a), (b), (c), 0, 0, 0)
constexpr int PA = 136, PZ = 68, PW = 40, PG_ = 72;
constexpr int X_WUP = 0, X_AUP = 5120, X_GUP = 10240, X_ACT = 19456;
constexpr int O_ZB = 71680, O_ZAB = 89088, O_RED = 106496;
constexpr int I_AT = 0, I_RT = 9216, I_BT = 18432, I_KT = 27648, I_ATT = 36864, I_BTT = 45568, I_KTT = 54272, I_VT = 62976;
constexpr int O_TIMG = O_ZAB, O_L21 = O_ZAB + 9216, O_T11T = O_ZAB + 11776, O_EX = 110592, O_GC = 126976;
static_assert(I_VT + 64 * 68 * 2 <= O_ZB && O_T11T + 2560 <= O_RED && O_RED + 4096 <= O_EX && O_EX + 16384 <= O_GC && O_GC + 256 <= 131072, "rw7 LDS map");
__device__ __forceinline__ void stage1_unit(ATT_LAS unsigned char* lds, CtxRef C, int l, int b, int h, int ch) {
    const int unit = (b * 4 + h) * (SEQ / 64) + ch;
    int tid = threadIdx.x; asm volatile("" : "+v"(tid));
    const int lane = tid & 63, w = __builtin_amdgcn_readfirstlane(tid >> 6), r32 = lane & 31, hi = lane >> 5;
    const bf16_t* u = WSP(bf16_t, WS_U); const float* mu = INF(I_MU) + l * DINA;
    const size_t t0 = (size_t)b * SEQ + (size_t)ch * 64;
    const bool seq0 = (ch == 0);
    const int atok = tid >> 3, apart = tid & 7;
    u32x4 lc0, lc1, lp0, lp1;
    { const bf16_t* p = u + (t0 + atok) * DINP + UA_WD + 16 * apart; lc0 = *(const u32x4*)p; lc1 = *(const u32x4*)(p + 8);
      if (seq0 && atok == 0) { lp0 = (u32x4){0u, 0u, 0u, 0u}; lp1 = lp0; } else { lp0 = *(const u32x4*)(p - DINP); lp1 = *(const u32x4*)(p - DINP + 8); } }
    u32x4 rc, kc, vc, rp, kp, vp;
    { const bf16_t* p = u + (t0 + lane) * DINP + h * 64 + 8 * w; rc = *(const u32x4*)(p + UA_R); kc = *(const u32x4*)(p + UA_K); vc = *(const u32x4*)(p + UA_V);
      if (seq0 && lane == 0) { rp = (u32x4){0u, 0u, 0u, 0u}; kp = rp; vp = rp; } else { rp = *(const u32x4*)(p - DINP + UA_R); kp = *(const u32x4*)(p - DINP + UA_K); vp = *(const u32x4*)(p - DINP + UA_V); } }
    { const float* wup = INF(I_WUP) + l * 32 * GW + h * 64; const float* aup = INF(I_AUP) + l * 32 * GW + h * 64; const float* gup = INF(I_GUP) + l * 64 * GW + h * 64;
      for (int i = tid; i < 2048; i += 512) { const int j = i >> 6, c = i & 63;
          ((ATT_LAS unsigned short*)(lds + X_WUP))[c * PW + j] = f2bf(wup[j * GW + c]); ((ATT_LAS unsigned short*)(lds + X_AUP))[c * PW + j] = f2bf(aup[j * GW + c]); }
      for (int i = tid; i < 4096; i += 512) { const int j = i >> 6, c = i & 63; ((ATT_LAS unsigned short*)(lds + X_GUP))[c * PG_ + j] = f2bf(gup[j * GW + c]); } }
    { float o[16];
#pragma unroll
      for (int j = 0; j < 4; ++j) { const float c0 = bfl(lc0[j]), c1 = bfh(lc0[j]), c2 = bfl(lc1[j]), c3 = bfh(lc1[j]); const float p0 = bfl(lp0[j]), p1 = bfh(lp0[j]), p2 = bfl(lp1[j]), p3 = bfh(lp1[j]);
          const float* m = mu + UA_WD + 16 * apart; o[2 * j] = c0 + (p0 - c0) * m[2 * j]; o[2 * j + 1] = c1 + (p1 - c1) * m[2 * j + 1]; o[8 + 2 * j] = c2 + (p2 - c2) * m[8 + 2 * j]; o[9 + 2 * j] = c3 + (p3 - c3) * m[9 + 2 * j]; }
      if (apart < 2) {
#pragma unroll
          for (int j = 0; j < 16; ++j) o[j] = tanhf(o[j]); }
      else if (apart >= 4) {
#pragma unroll
          for (int j = 0; j < 16; ++j) o[j] = sigmoidf_(o[j]); }
      ATT_LAS unsigned char* d = lds + X_ACT + (atok * PA + 16 * apart) * 2;
      *(ATT_LAS u32x4*)d = (u32x4){cvtpk(o[0], o[1]), cvtpk(o[2], o[3]), cvtpk(o[4], o[5]), cvtpk(o[6], o[7])};
      *(ATT_LAS u32x4*)(d + 16) = (u32x4){cvtpk(o[8], o[9]), cvtpk(o[10], o[11]), cvtpk(o[12], o[13]), cvtpk(o[14], o[15])}; }
    BAR_LDS();
    { const int tb = (w & 3) >> 1, cb = w & 1; f32x16 z0, z1;
#pragma unroll
      for (int r = 0; r < 16; ++r) { z0[r] = 0.f; z1[r] = 0.f; }
      ATT_LAS const unsigned char* arow = lds + X_ACT + ((32 * tb + r32) * PA + 8 * hi) * 2;
      if (w < 4) {
#pragma unroll
          for (int s = 0; s < 2; ++s) { z0 = MF32(ldA16(arow + 32 * s), ldA16(lds + X_WUP + ((32 * cb + r32) * PW + 16 * s + 8 * hi) * 2), z0);
              z1 = MF32(ldA16(arow + 64 + 32 * s), ldA16(lds + X_AUP + ((32 * cb + r32) * PW + 16 * s + 8 * hi) * 2), z1); }
          ATT_LAS float* zb = (ATT_LAS float*)(lds + O_ZB); ATT_LAS float* zab = (ATT_LAS float*)(lds + O_ZAB);
#pragma unroll
          for (int r = 0; r < 16; ++r) { zb[(32 * tb + crow(r, hi)) * PZ + 32 * cb + r32] = z0[r]; zab[(32 * tb + crow(r, hi)) * PZ + 32 * cb + r32] = z1[r]; }
      } else {
#pragma unroll
          for (int s = 0; s < 4; ++s) z0 = MF32(ldA16(arow + 128 + 32 * s), ldA16(lds + X_GUP + ((32 * cb + r32) * PG_ + 16 * s + 8 * hi) * 2), z0);
          bf16_t* gg = WSP(bf16_t, WS_RW_GG) + (t0 + 32 * tb) * GW + h * 64 + 32 * cb + r32;
#pragma unroll
          for (int r = 0; r < 16; ++r) gg[(size_t)crow(r, hi) * GW] = f2bf(z0[r]); } }
    BAR_LDS();
    {   const int cb8 = h * 64 + 8 * w;
        const float* w0 = INF(I_W0) + l * GW + cb8; const float* a0 = INF(I_A0) + l * GW + cb8; const float* kkw = INF(I_KK) + l * GW + cb8; const float* kaw = INF(I_KA) + l * GW + cb8;
        const float* rkw = INF(I_RK) + l * GW + cb8;
        ATT_LAS const float* zb = (ATT_LAS const float*)(lds + O_ZB) + lane * PZ + 8 * w; ATT_LAS const float* zab = (ATT_LAS const float*)(lds + O_ZAB) + lane * PZ + 8 * w;
        const f4v zA = *(ATT_LAS const f4v*)zb, zB = *(ATT_LAS const f4v*)(zb + 4), yA = *(ATT_LAS const f4v*)zab, yB = *(ATT_LAS const f4v*)(zab + 4);
        float rr[8], kk_[8], vv[8], lw[8], ai[8], kq[8]; float ss = 0.f, bon = 0.f;
#pragma unroll
        for (int i = 0; i < 8; ++i) {
            const float z = w0[i] + (i < 4 ? zA[i & 3] : zB[i & 3]), za = a0[i] + (i < 4 ? yA[i & 3] : yB[i & 3]);
            lw[i] = -__expf(-softplusf_(-z) - 0.5f); ai[i] = sigmoidf_(za);
            const unsigned wr_ = rc[i >> 1], wk_ = kc[i >> 1], wv_ = vc[i >> 1], pr_ = rp[i >> 1], pk_ = kp[i >> 1], pv_ = vp[i >> 1];
            const float r_c = (i & 1) ? bfh(wr_) : bfl(wr_), k_c = (i & 1) ? bfh(wk_) : bfl(wk_), v_c = (i & 1) ? bfh(wv_) : bfl(wv_);
            const float r_p = (i & 1) ? bfh(pr_) : bfl(pr_), k_p = (i & 1) ? bfh(pk_) : bfl(pk_), v_p = (i & 1) ? bfh(pv_) : bfl(pv_);
            rr[i] = r_c + (r_p - r_c) * mu[UA_R + cb8 + i]; const float k = k_c + (k_p - k_c) * mu[UA_K + cb8 + i]; vv[i] = v_c + (v_p - v_c) * mu[UA_V + cb8 + i];
            kq[i] = k * kkw[i]; ss += kq[i] * kq[i]; kk_[i] = k * (1.f + (ai[i] - 1.f) * kaw[i]); bon += rr[i] * kk_[i] * rkw[i]; }
        ATT_LAS float* red = (ATT_LAS float*)(lds + O_RED);
        red[w * 64 + lane] = ss; red[512 + w * 64 + lane] = bon;
        BAR_LDS();
        float sst = 0.f, bont = 0.f;
#pragma unroll
        for (int ww = 0; ww < 8; ++ww) { sst += red[ww * 64 + lane]; bont += red[512 + ww * 64 + lane]; }
        const float inv = 1.f / fmaxf(sqrtf(sst), 1e-12f);
        float at8[8], rt8[8], bt8[8], kt8[8];
#pragma unroll
        for (int i = 0; i < 8; ++i) { const float Gc = scan64(lw[i], lane); const float Gp = Gc - lw[i]; const float kkn = kq[i] * inv; const float enG = __expf(-Gc);
            at8[i] = -kkn * __expf(Gp); rt8[i] = rr[i] * __expf(Gc); bt8[i] = kkn * ai[i] * enG; kt8[i] = kk_[i] * enG;
            if (lane == 63) { const float gcv = __expf(Gc); ((ATT_LAS float*)(lds + O_GC))[8 * w + i] = gcv; WSP(float, WS_RW_GC)[(size_t)unit * 64 + 8 * w + i] = gcv; } }
        { ATT_LAS unsigned char* d = lds + (lane * PG_ + 8 * w) * 2;
          *(ATT_LAS u32x4*)(d + I_AT) = (u32x4){cvtpk(at8[0], at8[1]), cvtpk(at8[2], at8[3]), cvtpk(at8[4], at8[5]), cvtpk(at8[6], at8[7])};
          *(ATT_LAS u32x4*)(d + I_RT) = (u32x4){cvtpk(rt8[0], rt8[1]), cvtpk(rt8[2], rt8[3]), cvtpk(rt8[4], rt8[5]), cvtpk(rt8[6], rt8[7])};
          *(ATT_LAS u32x4*)(d + I_BT) = (u32x4){cvtpk(bt8[0], bt8[1]), cvtpk(bt8[2], bt8[3]), cvtpk(bt8[4], bt8[5]), cvtpk(bt8[6], bt8[7])};
          *(ATT_LAS u32x4*)(d + I_KT) = (u32x4){cvtpk(kt8[0], kt8[1]), cvtpk(kt8[2], kt8[3]), cvtpk(kt8[4], kt8[5]), cvtpk(kt8[6], kt8[7])};
#pragma unroll
          for (int i = 0; i < 8; ++i) { const int o2 = ((8 * w + i) * lin::PT + lane) * 2;
              *(ATT_LAS unsigned short*)(lds + I_ATT + o2) = f2bf(at8[i]); *(ATT_LAS unsigned short*)(lds + I_BTT + o2) = f2bf(bt8[i]);
              *(ATT_LAS unsigned short*)(lds + I_KTT + o2) = f2bf(kt8[i]); *(ATT_LAS unsigned short*)(lds + I_VT + o2) = f2bf(vv[i]); } }
        const size_t o = (t0 + lane) * GW + cb8;
        if (w == 0) WSP(float, WS_RW_BON)[(t0 + lane) * 4 + h] = bont;
        *(u32x4*)(WSP(bf16_t, WS_RW_VS) + o) = (u32x4){cvtpk(vv[0], vv[1]), cvtpk(vv[2], vv[3]), cvtpk(vv[4], vv[5]), cvtpk(vv[6], vv[7])};
    }
    BAR_LDS();
#define RW_PROD(ACC, IA, IB, rb, cb, keep) do { _Pragma("unroll") for (int r_ = 0; r_ < 16; ++r_) ACC[r_] = 0.f; \
        _Pragma("unroll") for (int k_ = 0; k_ < 4; ++k_) ACC = MF32(ldA16(lds + (IA) + ((32 * (rb) + r32) * PG_ + 16 * k_ + 8 * hi) * 2), ldA16(lds + (IB) + ((32 * (cb) + r32) * PG_ + 16 * k_ + 8 * hi) * 2), ACC); \
        if ((keep) == 1) { _Pragma("unroll") for (int r_ = 0; r_ < 16; ++r_) if (!(crow(r_, hi) < r32)) ACC[r_] = 0.f; } \
        if ((keep) == 2) { _Pragma("unroll") for (int r_ = 0; r_ < 16; ++r_) if (!(crow(r_, hi) <= r32)) ACC[r_] = 0.f; } \
        if ((keep) == 3) { _Pragma("unroll") for (int r_ = 0; r_ < 16; ++r_) if (!(crow(r_, hi) > r32)) ACC[r_] = 0.f; } \
        __builtin_amdgcn_sched_barrier(0); } while (0)
    f32x16 M00, M01, M11;
    f32x16 Z1a, Z1b;
    if (w == 2 || w == 3) { const int eb = w - 2; f32x16 L00, L01, L11;
        RW_PROD(L00, I_KT, I_AT, 0, 0, 1); RW_PROD(L01, I_KT, I_AT, 0, 1, 0); RW_PROD(L11, I_KT, I_AT, 1, 1, 1);
#pragma unroll
        for (int r = 0; r < 16; ++r) { Z1a[r] = 0.f; Z1b[r] = 0.f; }
#pragma unroll
        for (int k = 0; k < 2; ++k) { const bf16x8 v0 = ldP8(lds + I_VT + ((32 * eb + r32) * lin::PT + 16 * k + 4 * hi) * 2), v1 = ldP8(lds + I_VT + ((32 * eb + r32) * lin::PT + 32 + 16 * k + 4 * hi) * 2);
            Z1a = MF32(pack8(L00, k), v0, Z1a); Z1b = MF32(pack8(L01, k), v0, Z1b); Z1b = MF32(pack8(L11, k), v1, Z1b); } }
    if (w == 4 || w == 5) { const int eb = w - 4; f32x16 K00, K01, K11, Ya, Yb, KVa, KVb;
        RW_PROD(K00, I_KT, I_RT, 0, 0, 2); RW_PROD(K01, I_KT, I_RT, 0, 1, 0); RW_PROD(K11, I_KT, I_RT, 1, 1, 2);
#pragma unroll
        for (int r = 0; r < 16; ++r) { Ya[r] = 0.f; Yb[r] = 0.f; KVa[r] = 0.f; KVb[r] = 0.f; }
#pragma unroll
        for (int k = 0; k < 2; ++k) { const bf16x8 v0 = ldP8(lds + I_VT + ((32 * eb + r32) * lin::PT + 16 * k + 4 * hi) * 2), v1 = ldP8(lds + I_VT + ((32 * eb + r32) * lin::PT + 32 + 16 * k + 4 * hi) * 2);
            Ya = MF32(pack8(K00, k), v0, Ya); Yb = MF32(pack8(K01, k), v0, Yb); Yb = MF32(pack8(K11, k), v1, Yb);
            KVa = MF32(ldP8(lds + I_KTT + (r32 * lin::PT + 16 * k + 4 * hi) * 2), v0, KVa); KVa = MF32(ldP8(lds + I_KTT + (r32 * lin::PT + 32 + 16 * k + 4 * hi) * 2), v1, KVa);
            KVb = MF32(ldP8(lds + I_KTT + ((32 + r32) * lin::PT + 16 * k + 4 * hi) * 2), v0, KVb); KVb = MF32(ldP8(lds + I_KTT + ((32 + r32) * lin::PT + 32 + 16 * k + 4 * hi) * 2), v1, KVb); }
        ATT_LAS unsigned char* ex = lds + O_EX + (eb * 4 * 64 + lane) * 32;
#define RW_EXW(q_, A_) do { *(ATT_LAS u32x4*)(ex + (q_) * 2048) = (u32x4){cvtpk(A_[0], A_[1]), cvtpk(A_[2], A_[3]), cvtpk(A_[4], A_[5]), cvtpk(A_[6], A_[7])}; \
        *(ATT_LAS u32x4*)(ex + (q_) * 2048 + 16) = (u32x4){cvtpk(A_[8], A_[9]), cvtpk(A_[10], A_[11]), cvtpk(A_[12], A_[13]), cvtpk(A_[14], A_[15])}; } while (0)
        RW_EXW(0, Ya); RW_EXW(1, Yb); RW_EXW(2, KVa); RW_EXW(3, KVb);
#undef RW_EXW
    }
    if (w == 7) {
        f32x16 La, Lb, Lc;
        RW_PROD(La, I_AT, I_BT, 0, 0, 3); RW_PROD(Lb, I_AT, I_BT, 1, 0, 0); RW_PROD(Lc, I_AT, I_BT, 1, 1, 3);
        ATT_LAS float* Lbuf = (ATT_LAS float*)(lds + O_ZB);
#pragma unroll
        for (int r = 0; r < 16; ++r) { Lbuf[crow(r, hi) * PZ + r32] = La[r]; Lbuf[(32 + crow(r, hi)) * PZ + 32 + r32] = Lc[r];
            *(ATT_LAS unsigned short*)(lds + O_L21 + (crow(r, hi) * PW + r32) * 2) = f2bf(Lb[r]);
            *(ATT_LAS unsigned short*)(lds + O_TIMG + (crow(r, hi) * PG_ + 32 + r32) * 2) = 0; }
        asm volatile("s_waitcnt lgkmcnt(0)" ::: "memory");
        float Tc[32];
        { ATT_LAS const float* Lr = Lbuf + (32 * hi) * PZ + 32 * hi;
#pragma unroll
          for (int t = 0; t < 32; ++t) { float acc = (t == r32) ? 1.f : 0.f;
#pragma unroll
              for (int s4 = 0; s4 < (t + 3) / 4; ++s4) { const f4v lv = *(ATT_LAS const f4v*)(Lr + t * PZ + 4 * s4);
#pragma unroll
                  for (int j = 0; j < 4; ++j) if (4 * s4 + j < t) acc += lv[j] * Tc[4 * s4 + j]; }
              Tc[t] = acc; } }
#pragma unroll
        for (int t = 0; t < 32; ++t) *(ATT_LAS unsigned short*)(lds + O_TIMG + ((32 * hi + t) * PG_ + 32 * hi + r32) * 2) = f2bf(Tc[t]);
        if (hi == 0) {
#pragma unroll
            for (int q4 = 0; q4 < 4; ++q4) *(ATT_LAS u32x4*)(lds + O_T11T + (r32 * PW + 8 * q4) * 2) = (u32x4){cvtpk(Tc[8 * q4], Tc[8 * q4 + 1]), cvtpk(Tc[8 * q4 + 2], Tc[8 * q4 + 3]), cvtpk(Tc[8 * q4 + 4], Tc[8 * q4 + 5]), cvtpk(Tc[8 * q4 + 6], Tc[8 * q4 + 7])}; }
        asm volatile("s_waitcnt lgkmcnt(0)" ::: "memory");
        f32x16 X, T21;
#pragma unroll
        for (int r = 0; r < 16; ++r) { X[r] = 0.f; T21[r] = 0.f; }
#pragma unroll
        for (int k = 0; k < 2; ++k) X = MF32(ldA16(lds + O_L21 + (r32 * PW + 16 * k + 8 * hi) * 2), ldA16(lds + O_T11T + (r32 * PW + 16 * k + 8 * hi) * 2), X);
#pragma unroll
        for (int k = 0; k < 2; ++k) T21 = MF32(ldP8(lds + O_TIMG + ((32 + r32) * PG_ + 32 + 16 * k + 4 * hi) * 2), pack8(X, k), T21);
#pragma unroll
        for (int r = 0; r < 16; ++r) *(ATT_LAS unsigned short*)(lds + O_TIMG + ((32 + crow(r, hi)) * PG_ + r32) * 2) = f2bf(T21[r]);
    }
    BAR_LDS();
    if (w < 4) {
        const int nb = w & 1;
        ATT_LAS const float* gc = (ATT_LAS const float*)(lds + O_GC);
        f32x16 P0, P1;
#pragma unroll
        for (int r = 0; r < 16; ++r) { P0[r] = 0.f; P1[r] = 0.f; }
#pragma unroll
        for (int k = 0; k < 2; ++k) {
            const bf16x8 t00 = ldP8(lds + O_TIMG + (r32 * PG_ + 16 * k + 4 * hi) * 2), t10 = ldP8(lds + O_TIMG + ((32 + r32) * PG_ + 16 * k + 4 * hi) * 2), t11 = ldP8(lds + O_TIMG + ((32 + r32) * PG_ + 32 + 16 * k + 4 * hi) * 2);
            bf16x8 b0, b1;
            if (w < 2) { b0 = ldP8(lds + I_ATT + ((32 * nb + r32) * lin::PT + 16 * k + 4 * hi) * 2); b1 = ldP8(lds + I_ATT + ((32 * nb + r32) * lin::PT + 32 + 16 * k + 4 * hi) * 2); }
            else { b0 = pack8(Z1a, k); b1 = pack8(Z1b, k); }
            P0 = MF32(t00, b0, P0); P1 = MF32(t10, b0, P1); P1 = MF32(t11, b1, P1); }
        {   RW_PROD(M00, I_BT, I_RT, 0, 0, 2); RW_PROD(M01, I_BT, I_RT, 0, 1, 0); RW_PROD(M11, I_BT, I_RT, 1, 1, 2);
            f32x16 A0, A1;
#pragma unroll
            for (int r = 0; r < 16; ++r) { A0[r] = 0.f; A1[r] = 0.f; }
#pragma unroll
            for (int k = 0; k < 2; ++k) { const bf16x8 p0 = pack8(P0, k), p1 = pack8(P1, k);
                A0 = MF32(pack8(M00, k), p0, A0); A1 = MF32(pack8(M01, k), p0, A1); A1 = MF32(pack8(M11, k), p1, A1); }
            if (w < 2) { bf16_t* RY = WSP(bf16_t, WS_RW_RY) + (size_t)unit * 4096;
#pragma unroll
                for (int r = 0; r < 16; ++r) { const int t = crow(r, hi), d = 32 * nb + r32;
                    RY[t * 64 + d] = f2bf(A0[r] + bf2f(*(ATT_LAS const unsigned short*)(lds + I_RT + (t * PG_ + d) * 2)));
                    RY[(32 + t) * 64 + d] = f2bf(A1[r] + bf2f(*(ATT_LAS const unsigned short*)(lds + I_RT + ((32 + t) * PG_ + d) * 2))); } }
            else { ATT_LAS const unsigned char* ex = lds + O_EX + (nb * 4 * 64 + lane) * 32; float* Y0G = WSP(float, WS_RW_Y0) + ((size_t)unit * 4 + nb) * 1024 + lane * 16;
#pragma unroll
                for (int r4 = 0; r4 < 16; r4 += 4) { f4v y0, y1;
#pragma unroll
                    for (int j = 0; j < 4; ++j) { const int r = r4 + j; y0[j] = A0[r] + bf2f(*(ATT_LAS const unsigned short*)(ex + 2 * r)); y1[j] = A1[r] + bf2f(*(ATT_LAS const unsigned short*)(ex + 2048 + 2 * r)); }
                    *(f4v*)(Y0G + r4) = y0; *(f4v*)(Y0G + 2048 + r4) = y1; } } }
        __builtin_amdgcn_sched_barrier(0);
        {   f32x16 B0, B1;
#pragma unroll
            for (int r = 0; r < 16; ++r) { B0[r] = 0.f; B1[r] = 0.f; }
#pragma unroll
            for (int k = 0; k < 2; ++k) { const bf16x8 p0 = pack8(P0, k), p1 = pack8(P1, k);
                B0 = MF32(ldP8(lds + I_BTT + (r32 * lin::PT + 16 * k + 4 * hi) * 2), p0, B0); B0 = MF32(ldP8(lds + I_BTT + (r32 * lin::PT + 32 + 16 * k + 4 * hi) * 2), p1, B0);
                B1 = MF32(ldP8(lds + I_BTT + ((32 + r32) * lin::PT + 16 * k + 4 * hi) * 2), p0, B1); B1 = MF32(ldP8(lds + I_BTT + ((32 + r32) * lin::PT + 32 + 16 * k + 4 * hi) * 2), p1, B1); }
            if (w < 2) { bf16_t* PLg = WSP(bf16_t, WS_RW_PL) + (size_t)unit * 4096;
#pragma unroll
                for (int r = 0; r < 16; ++r) { const int t = crow(r, hi), d = 32 * nb + r32; PLg[t * 64 + d] = f2bf(gc[t] * B0[r]); PLg[(32 + t) * 64 + d] = f2bf(gc[32 + t] * B1[r]); } }
            else { ATT_LAS const unsigned char* ex = lds + O_EX + (nb * 4 * 64 + lane) * 32; float* QG = WSP(float, WS_RW_QG) + ((size_t)unit * 4 + nb) * 1024 + lane * 16;
#pragma unroll
                for (int r4 = 0; r4 < 16; r4 += 4) { f4v q0, q1;
#pragma unroll
                    for (int j = 0; j < 4; ++j) { const int r = r4 + j; q0[j] = gc[crow(r, hi)] * (B0[r] + bf2f(*(ATT_LAS const unsigned short*)(ex + 4096 + 2 * r))); q1[j] = gc[32 + crow(r, hi)] * (B1[r] + bf2f(*(ATT_LAS const unsigned short*)(ex + 6144 + 2 * r))); }
                    *(f4v*)(QG + r4) = q0; *(f4v*)(QG + 2048 + r4) = q1; } } }
    }
    BAR_LDS();
#undef RW_PROD
}
__device__ __forceinline__ void stage2_run(ATT_LAS unsigned char* lds, CtxRef C, int b, int h) {
    int tid = threadIdx.x; asm volatile("" : "+v"(tid));
    const int lane = tid & 63, w = __builtin_amdgcn_readfirstlane(tid >> 6), r32 = lane & 31, hi = lane >> 5;
    constexpr int NC = SEQ / 64; constexpr int S2_PL = 0, S2_RY = 9216, S2_GC = 18432, S2_BUF = 18688;
    const int bh = b * 4 + h; const size_t unit0 = (size_t)bh * NC;
    const bf16_t* PLg = WSP(bf16_t, WS_RW_PL) + unit0 * 4096; const bf16_t* RYg = WSP(bf16_t, WS_RW_RY) + unit0 * 4096;
    const float* QG = WSP(float, WS_RW_QG) + unit0 * 4096; const float* Y0G = WSP(float, WS_RW_Y0) + unit0 * 4096; const float* GCg = WSP(float, WS_RW_GC) + unit0 * 64;
    float* Y = WSP(float, WS_YA);
    const int i = w >> 1, eb = w & 1, srow = tid >> 3, spart = tid & 7;
    f32x16 H0, H1, q0, q1, y0;
#pragma unroll
    for (int r = 0; r < 16; ++r) { H0[r] = 0.f; H1[r] = 0.f; }
    u32x4 spl, sry; float sgc = 0.f;
#define S2_FETCH_IMG(c) do { spl = *(const u32x4*)(PLg + (size_t)(c) * 4096 + srow * 64 + spart * 8); sry = *(const u32x4*)(RYg + (size_t)(c) * 4096 + srow * 64 + spart * 8); if (tid < 64) sgc = GCg[(c) * 64 + tid]; } while (0)
#define S2_FETCH_ACC(c) do { if (w < 4) { const float* qp = QG + (size_t)(c) * 4096 + eb * 1024 + lane * 16; const float* yp = Y0G + (size_t)(c) * 4096 + (i * 2 + eb) * 1024 + lane * 16; \
            _Pragma("unroll") for (int r4 = 0; r4 < 16; r4 += 4) { const f4v a = *(const f4v*)(qp + r4), b_ = *(const f4v*)(qp + 2048 + r4), c_ = *(const f4v*)(yp + r4); \
                _Pragma("unroll") for (int j = 0; j < 4; ++j) { q0[r4 + j] = a[j]; q1[r4 + j] = b_[j]; y0[r4 + j] = c_[j]; } } } } while (0)
#define S2_WRITE(buf) do { ATT_LAS unsigned char* B_ = lds + (buf) * S2_BUF; *(ATT_LAS u32x4*)(B_ + S2_PL + (srow * PG_ + spart * 8) * 2) = spl; *(ATT_LAS u32x4*)(B_ + S2_RY + (srow * PG_ + spart * 8) * 2) = sry; \
        if (tid < 64) ((ATT_LAS float*)(B_ + S2_GC))[tid] = sgc; } while (0)
    S2_FETCH_IMG(0); S2_FETCH_ACC(0); S2_WRITE(0);
    BAR_LDS();
    for (int c = 0; c < NC; ++c) {
        if (c + 1 < NC) S2_FETCH_IMG(c + 1);
        if (w < 4) {
            ATT_LAS const unsigned char* B_ = lds + (c & 1) * S2_BUF; ATT_LAS const float* gc = (ATT_LAS const float*)(B_ + S2_GC);
            bf16x8 hb[2][2];
#pragma unroll
            for (int k = 0; k < 2; ++k) { hb[0][k] = pack8(H0, k); hb[1][k] = pack8(H1, k); }
            f32x16 Yo = y0;
#pragma unroll
            for (int r = 0; r < 16; ++r) { H0[r] = gc[crow(r, hi)] * H0[r] + q0[r]; H1[r] = gc[32 + crow(r, hi)] * H1[r] + q1[r]; }
            __builtin_amdgcn_sched_barrier(0);
            if (c + 1 < NC) S2_FETCH_ACC(c + 1);
#pragma unroll
            for (int db = 0; db < 2; ++db)
#pragma unroll
                for (int k = 0; k < 2; ++k) Yo = MF32(ldP8(B_ + S2_RY + ((32 * i + r32) * PG_ + 32 * db + 16 * k + 4 * hi) * 2), hb[db][k], Yo);
#pragma unroll
            for (int db = 0; db < 2; ++db)
#pragma unroll
                for (int k = 0; k < 2; ++k) { H0 = MF32(ldP8(B_ + S2_PL + (r32 * PG_ + 32 * db + 16 * k + 4 * hi) * 2), hb[db][k], H0); H1 = MF32(ldP8(B_ + S2_PL + ((32 + r32) * PG_ + 32 * db + 16 * k + 4 * hi) * 2), hb[db][k], H1); }
            float* yo = Y + ((size_t)b * SEQ + (size_t)c * 64 + 32 * i) * GW + h * 64 + 32 * eb + r32;
#pragma unroll
            for (int r = 0; r < 16; ++r) yo[(size_t)crow(r, hi) * GW] = Yo[r];
        }
        if (c + 1 < NC) S2_WRITE((c + 1) & 1);
        BAR_LDS();
    }
#undef S2_FETCH_IMG
#undef S2_FETCH_ACC
#undef S2_WRITE
}
#undef MF32
}
#endif

constexpr int PH_PER_LAYER = 13;
constexpr int NPHASES = DEPTH * PH_PER_LAYER;

#ifndef CPU_TEST
#define XB_TMO      128
#define XB_XCNT(j)  (256  + 64 * (j))
#define XB_XSUB(j)  (1280 + 64 * (j))
#define XB_XGEN(j)  (2304 + 64 * (j))
#define XB_TOP      3328
#define XB_TOPGEN   3392
#define XCD_BAR_WORDS 3456
#define XB_SPIN_CAP (1u << 18)
#define LAS __attribute__((address_space(3)))
__device__ __forceinline__ unsigned xb_ld(unsigned* p)              { return __hip_atomic_load(p, __ATOMIC_RELAXED, __HIP_MEMORY_SCOPE_AGENT); }
__device__ __forceinline__ unsigned xb_add(unsigned* p, unsigned v) { return __hip_atomic_fetch_add(p, v, __ATOMIC_RELAXED, __HIP_MEMORY_SCOPE_AGENT); }
__device__ __forceinline__ unsigned xb_xcc_id() { return (unsigned)__builtin_amdgcn_s_getreg((3 << 11) | 20) & 0xFu; }
#define XB_SPIN(cond, bar) do { unsigned _sp = 0; while (cond) { __builtin_amdgcn_s_sleep(1); \
    if ((++_sp & 255u) == 0u) { if (xb_ld(&(bar)[XB_TMO])) break; if (_sp > XB_SPIN_CAP) { atomicAdd(&(bar)[XB_TMO], 1u); break; } } } } while (0)
struct XcdBarrier { unsigned* bar; unsigned x; volatile LAS unsigned* st; };
__device__ __forceinline__ XcdBarrier xcd_barrier_post(unsigned* bar, volatile LAS unsigned* st) {
    XcdBarrier b; b.bar = bar; b.x = xb_xcc_id(); b.st = st;
    if (threadIdx.x == 0) (void)xb_add(&bar[XB_XCNT(b.x)], 1u);
    return b;
}
__device__ __forceinline__ void xcd_barrier_complete(unsigned* bar, unsigned x, unsigned& nloc, unsigned& nx) {
    const unsigned G = gridDim.x * gridDim.y * gridDim.z;
    unsigned sum, cnt, mine, sp = 0u;
    for (;;) {
        sum = 0u; cnt = 0u; mine = 0u;
#pragma unroll
        for (unsigned j = 0; j < 16; ++j) { const unsigned c = xb_ld(&bar[XB_XCNT(j)]); sum += c; cnt += (c > 0u) ? 1u : 0u; mine = (j == x) ? c : mine; }
        if (sum == G) break;
        __builtin_amdgcn_s_sleep(1);
        if ((++sp & 255u) == 0u) { if (xb_ld(&bar[XB_TMO])) break; if (sp > XB_SPIN_CAP) { atomicAdd(&bar[XB_TMO], 1u); break; } }
    }
    nloc = mine > 0u ? mine : 1u; nx = cnt > 0u ? cnt : 1u;
}
__device__ __forceinline__ void xcd_barrier(const XcdBarrier& b) {
    asm volatile("s_waitcnt vmcnt(0)" ::: "memory");
    __syncthreads();
    if (threadIdx.x == 0) {
        unsigned* bar = b.bar;
        __builtin_amdgcn_s_waitcnt(0);
        unsigned nloc = b.st[0], nx = b.st[1];
        if (nloc == 0u) { xcd_barrier_complete(bar, b.x, nloc, nx); b.st[0] = nloc; b.st[1] = nx; }
        const unsigned old = xb_add(&bar[XB_XSUB(b.x)], 1u);
        const unsigned gen = old / nloc;
        if (old + 1u == (gen + 1u) * nloc) {
            __builtin_amdgcn_fence(__ATOMIC_RELEASE, "agent");
            asm volatile("s_waitcnt vmcnt(0)" ::: "memory");
            const unsigned og = xb_add(&bar[XB_TOP], 1u);
            const unsigned tg = og / nx;
            if (og + 1u == (tg + 1u) * nx) xb_add(&bar[XB_TOPGEN], 1u);
            else XB_SPIN(xb_ld(&bar[XB_TOPGEN]) == tg, bar);
            __builtin_amdgcn_fence(__ATOMIC_ACQUIRE, "agent");
            xb_add(&bar[XB_XGEN(b.x)], 1u);
            asm volatile("s_waitcnt vmcnt(0)" ::: "memory");
        } else {
            XB_SPIN(xb_ld(&bar[XB_XGEN(b.x)]) == gen, bar);
            __builtin_amdgcn_fence(__ATOMIC_ACQUIRE, "agent");
            asm volatile("s_waitcnt vmcnt(0)" ::: "memory");
        }
    }
    __syncthreads();
}

constexpr int NWAVES = 8;
constexpr int RING_BYTES = 131072, MISC_OFF = RING_BYTES + 320, LDS_BYTES = 147456;
struct Args { Ctx C; int ph_lo, ph_hi; };
__device__ __forceinline__ int moe_fill_table(CtxRef C, int l, LAS int* tbl, int tid) {
    const unsigned* cnt = WSP(unsigned, WS_CTL) + CW_CNT + l * NEXP * 64;
    int e, be, ce; const int total = moe_lookup(cnt, tid * 256, e, be, ce);
    if (tid < 320) tbl[tid] = e;
    __syncthreads();
    return total >> 8;
}

__global__ void __launch_bounds__(NWAVES * 64, 2) mega(Args args) {
    extern __shared__ __attribute__((aligned(16))) unsigned char lds_raw[];
    LAS unsigned char* lds = (LAS unsigned char*)lds_raw;
    const int G = gridDim.x, bx = blockIdx.x;
    const int ngw = G * NWAVES;
    volatile LAS unsigned* MISC = (volatile LAS unsigned*)(lds + MISC_OFF);
    for (int i = threadIdx.x; i < (LDS_BYTES - RING_BYTES) / 4; i += NWAVES * 64) ((LAS unsigned*)(lds + RING_BYTES))[i] = 0u;
    __syncthreads();
    XcdBarrier bar = xcd_barrier_post((unsigned*)(args.C.ws + WS_CTL) + CW_BAR, MISC + 8);
    LAS int* tbl = (LAS int*)(lds + RING_BYTES + 1024);
    const int lo = args.ph_lo, hi = args.ph_hi;

    for (int l = 0; l < DEPTH; ++l) {
        const int p0 = l * PH_PER_LAYER;
#ifndef PHASE_MASK
#define PHASE_MASK 0x1FFF
#endif
#define IN(k) (((PHASE_MASK >> (k)) & 1) && lo <= p0 + (k) && p0 + (k) < hi)
#define LAUNDER() const __attribute__((address_space(4))) Args* ap_ = (const __attribute__((address_space(4))) Args*)__builtin_amdgcn_kernarg_segment_ptr(); asm volatile("" : "+s"(ap_)); CtxRef C = ap_->C; \
        int bxl_ = blockIdx.x; asm volatile("" : "+s"(bxl_)); const int bx = bxl_;     \
        int tid = threadIdx.x; asm volatile("" : "+v"(tid)); const int lane = tid & 63; const int wave = __builtin_amdgcn_readfirstlane(tid >> 6); const int gw = bx * NWAVES + wave; (void)gw; (void)lane; \
        wsh_t wsh = (wsh_t)(lds + wave * 16384); (void)wsh
#define SEAM(k) do { if (p0 + (k) + 1 < hi) xcd_barrier(bar); } while (0)
        if (IN(0)) { LAUNDER(); stage_convert(C, l, gw, ngw, lane, wsh); SEAM(0); }
        if (IN(1)) { LAUNDER();
            pg8::Gemm g{WSP(bf16_t, WS_XB), WSP(bf16_t, WS_WIN), DM, DM, DM};
            pg8::DenseOrder S{T / 256, DINP / 256, G, bx, (long)256 * DM * 2, (long)256 * DM * 2};
            EpiU E{WSP(bf16_t, WS_U)};
            pg8::gemm_phase(lds, g, S, E); SEAM(1); }
        if (IN(2)) { LAUNDER();
            {   pg8::Gemm g{WSP(bf16_t, WS_U) + UD_CQ, WSP(bf16_t, WS_WUQ), DINP, 256, 256};
                pg8::DenseOrder S{T / 256, 2, G, bx, (long)256 * DINP * 2, (long)256 * 256 * 2};
                EpiQ E{WSP(float, WS_ROPE), WSP(bf16_t, WS_AQ)};
                pg8::gemm_phase(lds, g, S, E); }
            {   pg8::Gemm g{WSP(bf16_t, WS_U) + UD_CKV, WSP(bf16_t, WS_WUKV), DINP, 256, 256};
                pg8::DenseOrder S{T / 256, 2, G, bx, (long)256 * DINP * 2, (long)256 * 256 * 2};
                EpiKV E{WSP(bf16_t, WS_AK), WSP(bf16_t, WS_AV)};
                pg8::gemm_phase(lds, g, S, E); }
            __syncthreads();
            mla_token_pass(C, gw, ngw, lane);
            SEAM(2); }
        if (IN(3)) { LAUNDER();
            lin::stage1_units<0>(lds, C, l, bx, G);
            lin::stage1_units<1>(lds, C, l, bx, G);
            for (int uu = bx; uu < BATCH * NH * (SEQ / 64); uu += G) { const int bh = uu / (SEQ / 64), ch = uu % (SEQ / 64); rw7::stage1_unit(lds, C, l, bh >> 2, bh & 3, ch); }
            SEAM(3); }
        if (IN(4)) { LAUNDER();
            if (bx < 32) rw7::stage2_run(lds, C, bx >> 2, bx & 3);
            else if (bx < 64) lin::stage2_run<0>(lds, C, (bx - 32) >> 2, (bx - 32) & 3);
            else if (bx < 96) lin::stage2_run<1>(lds, C, (bx - 64) >> 2, (bx - 64) & 3);
            else {
                LAS int* slot = (LAS int*)(lds + RING_BYTES + 512);
                unsigned* ctr = WSP(unsigned, WS_CTL) + CW_ATT + l * 64;
                constexpr int NQB = SEQ / 256, NUNIT = BATCH * NH * NQB;
                for (;;) {
                    if (tid == 0) *slot = (int)atomicAdd(ctr, 1u);
                    __syncthreads();
                    const int uidx = *slot;
                    __syncthreads();
                    if (uidx >= NUNIT) break;
                    const int qb = NQB - 1 - uidx / (BATCH * NH), bh = uidx % (BATCH * NH);
                    att::unit(lds, WSP(bf16_t, WS_AQ), WSP(bf16_t, WS_AK), WSP(bf16_t, WS_AV), WSP(float, WS_RSTD), WSP(bf16_t, WS_MIX), bh >> 2, bh & 3, qb);
                }
            }
            SEAM(4); }
        if (IN(5)) { LAUNDER(); stage_post_v(C, l, gw, ngw, lane); SEAM(5); }
        if (IN(6)) { LAUNDER();
            pg8::Gemm g{WSP(bf16_t, WS_MIX), WSP(bf16_t, WS_WOUT), DMIX, DMIX, DMIX};
            pg8::DenseOrder S{T / 256, DM / 256, G, bx, (long)256 * DMIX * 2, (long)256 * DMIX * 2};
            EpiPre1 E{l == 0 ? INF(I_X) : WSP(float, WS_X), C.out};
            pg8::gemm_phase(lds, g, S, E); SEAM(6); }
        if (IN(7)) { LAUNDER(); ln1_router_coop(C, l, lds); SEAM(7); }
        if (IN(8)) { LAUNDER();
            stage_gather_v(C, l, gw, ngw, lane);
            pg8::Gemm g{WSP(bf16_t, WS_PB), WSP(bf16_t, WS_WP), DPLE, DPLE, DPLE};
            pg8::DenseOrder S{T / 256, DM / 256, G, bx, (long)256 * DPLE * 2, (long)256 * DPLE * 2};
            EpiPP E{WSP(bf16_t, WS_PP)};
            pg8::gemm_phase(lds, g, S, E); SEAM(8); }
        if (IN(9)) { LAUNDER();
            pg8::Gemm g{WSP(bf16_t, WS_XG), WSP(bf16_t, WS_WGU), DM, DM, DM};
            const int ntile = moe_fill_table(C, l, tbl, tid);
            pg8::MoeOrder S{tbl, ntile, 2 * DEXP / 256, G, bx, (long)256 * DM * 2, (long)256 * DM * 2, (long)2 * DEXP * DM * 2};
            EpiH E{WSP(bf16_t, WS_H)};
            pg8::gemm_phase(lds, g, S, E); SEAM(9); }
        if (IN(10)) { LAUNDER();
            pg8::Gemm g{WSP(bf16_t, WS_H), WSP(bf16_t, WS_WD), DEXP, DEXP, DEXP};
            const int ntile = moe_fill_table(C, l, tbl, tid);
            pg8::MoeOrder S{tbl, ntile, DM / 256, G, bx, (long)256 * DEXP * 2, (long)256 * DEXP * 2, (long)DM * DEXP * 2};
            EpiY E{WSP(int, WS_ROWINFO), WSP(float, WS_ROWGATE), WSP(bf16_t, WS_YBUF)};
            pg8::gemm_phase(lds, g, S, E); SEAM(10); }
        if (IN(11)) { LAUNDER();
            pg8::Gemm g{WSP(bf16_t, WS_XB), WSP(bf16_t, WS_WPG), DM, DM, DM};
            pg8::DenseOrder S{T / 256, DM / 256, G, bx, (long)256 * DM * 2, (long)256 * DM * 2};
            EpiPre2 E{C.out, WSP(bf16_t, WS_YBUF), WSP(bf16_t, WS_PP), INF(I_PLEBG) + l * DM, WSP(float, WS_X)};
            pg8::gemm_phase(lds, g, S, E); SEAM(11); }
        if (IN(12)) { LAUNDER(); stage_ln2_v(C, l, gw, ngw, lane); SEAM(12); }
#undef IN
#undef SEAM
    }
}

extern "C" void kernel_launch(void* const* d_in, const int* in_sizes, int n_in, void* d_out, int out_size, void* d_ws, size_t ws_size, hipStream_t stream) {
    static int grid = 0;
    if (grid == 0) {
        if (n_in != N_IN || out_size != T * DM || ws_size < WS_END) { fprintf(stderr, "kernel_launch: bad sizes n_in %d out %d ws %zu need %zu\n", n_in, out_size, ws_size, (size_t)WS_END); grid = -1; return; }
        int dev = 0, cus = 0, per_cu = 0;
        hipGetDevice(&dev); hipDeviceGetAttribute(&cus, hipDeviceAttributeMultiprocessorCount, dev);
        if (hipFuncSetAttribute((const void*)mega, hipFuncAttributeMaxDynamicSharedMemorySize, LDS_BYTES) != hipSuccess) { fprintf(stderr, "hipFuncSetAttribute failed\n"); grid = -1; return; }
        if (hipOccupancyMaxActiveBlocksPerMultiprocessor(&per_cu, (const void*)mega, NWAVES * 64, LDS_BYTES) != hipSuccess || per_cu < 1) { fprintf(stderr, "occupancy query: %d\n", per_cu); }
        (void)hipGetLastError();
        grid = cus;
    }
    if (grid < 0) return;
    hipMemsetAsync((char*)d_ws + WS_CTL, 0, CTL_BYTES, stream);
    Args a{};
    for (int i = 0; i < N_IN; ++i) a.C.in[i] = d_in[i];
    a.C.out = (float*)d_out; a.C.ws = (unsigned char*)d_ws;
#ifndef ONE_LAUNCH
    for (int ph = 0; ph < NPHASES; ++ph) { a.ph_lo = ph; a.ph_hi = ph + 1; hipLaunchKernelGGL(mega, dim3(grid), dim3(NWAVES * 64), LDS_BYTES, stream, a); }
#else
    a.ph_lo = 0; a.ph_hi = NPHASES; hipLaunchKernelGGL(mega, dim3(grid), dim3(NWAVES * 64), LDS_BYTES, stream, a);
#endif
}
#else
template <class E> static void cpu_gemm(const bf16_t* A, int lda, const bf16_t* Bt, int ldb, int K, int M, int N, const E& e, const int* base = nullptr, long estep = 0) {
    for (int row = 0; row < M; ++row) {
        const bf16_t* B = Bt;
        if (base) B = Bt + (size_t)moe_expert_of_row(base, row) * estep;
        if constexpr (E::MODE == 1) {
            for (int hc = 0; hc < N / 2; hc += 8) { float g[8], u[8];
                for (int j = 0; j < 8; ++j) { float ag = 0.f, au = 0.f; const bf16_t* bg = B + (size_t)rowmap(1, hc + j) * ldb; const bf16_t* bu = B + (size_t)rowmap(2, hc + j) * ldb;
                    for (int k = 0; k < K; ++k) { const float a = bf2f(A[(size_t)row * lda + k]); ag += a * bf2f(bg[k]); au += a * bf2f(bu[k]); } g[j] = ag; u[j] = au; }
                e.put8gu(row, hc, g, u); }
        } else if constexpr (E::PERM) {
            for (int c = 0; c < N; c += 8) { float a8[8];
                for (int j = 0; j < 8; ++j) { float acc = 0.f; for (int k = 0; k < K; ++k) acc += bf2f(A[(size_t)row * lda + k]) * bf2f(B[(size_t)(c + j) * ldb + k]); a8[j] = acc; }
                e.put8(row, c, a8); }
        } else {
            for (int c = 0; c < N; c += 4) { float a4[4];
                for (int j = 0; j < 4; ++j) { float acc = 0.f; for (int k = 0; k < K; ++k) acc += bf2f(A[(size_t)row * lda + k]) * bf2f(B[(size_t)(c + j) * ldb + k]); a4[j] = acc; }
                e.put4(row, c, a4); }
        }
    }
}
static void cpu_forward(CtxRef C) {
    static float shbuf[4096];
    for (int l = 0; l < DEPTH; ++l) {
        stage_convert(C, l, 0, 1, 0, shbuf);
        { EpiU E{WSP(bf16_t, WS_U)}; cpu_gemm(WSP(bf16_t, WS_XB), DM, WSP(bf16_t, WS_WIN), DM, DM, T, DINP, E); }
        stage_prep(C, l, 0, 1, 0, shbuf);
        for (int b = 0; b < BATCH; ++b) for (int h = 0; h < NH; ++h) {
            for (int v = 0; v < 64; ++v) { rwkv_scan_thread(C, b, h, v); gla_scan_thread(C, b, h, v); }
            for (int e = 0; e < 65; ++e) mlstm_scan_thread(C, b, h, e);
            for (int q = 0; q < SEQ; ++q) attn_thread(C, b, h, q, q); }
        stage_post(C, l, 0, 1, 0);
        { EpiPre1 E{l == 0 ? INF(I_X) : WSP(float, WS_X), C.out}; cpu_gemm(WSP(bf16_t, WS_MIX), DMIX, WSP(bf16_t, WS_WOUT), DMIX, DMIX, T, DM, E); }
        stage_ln1_router(C, l, 0, 1, 0, shbuf);
        stage_gather(C, l, 0, 1, 0);
        { EpiPP E{WSP(bf16_t, WS_PP)}; cpu_gemm(WSP(bf16_t, WS_PB), DPLE, WSP(bf16_t, WS_WP), DPLE, DPLE, T, DM, E); }
        int base[NEXP + 1]; moe_bases(C, l, base);
        { EpiH E{WSP(bf16_t, WS_H)}; cpu_gemm(WSP(bf16_t, WS_XG), DM, WSP(bf16_t, WS_WGU), DM, DM, base[NEXP], 2 * DEXP, E, base, (long)2 * DEXP * DM); }
        { EpiY E{WSP(int, WS_ROWINFO), WSP(float, WS_ROWGATE), WSP(bf16_t, WS_YBUF)}; cpu_gemm(WSP(bf16_t, WS_H), DEXP, WSP(bf16_t, WS_WD), DEXP, DEXP, base[NEXP], DM, E, base, (long)DM * DEXP); }
        { EpiPre2 E{C.out, WSP(bf16_t, WS_YBUF), WSP(bf16_t, WS_PP), INF(I_PLEBG) + l * DM, WSP(float, WS_X)}; cpu_gemm(WSP(bf16_t, WS_XB), DM, WSP(bf16_t, WS_WPG), DM, DM, T, DM, E); }
        stage_ln2(C, l, 0, 1, 0);
    }
}
#endif
```

```cpp
#ifndef CPU_TEST
#include <hip/hip_runtime.h>
#include <cstdio>
#include <cstdint>
#define HD __device__ __forceinline__
#define HDM __device__ __forceinline__
#define LANES 64
#else
#include <cmath>
#include <cstdio>
#include <cstdint>
#include <cstring>
#include <algorithm>
#define HD static inline
#define HDM inline
#define LANES 1
#endif

#define ONE_LAUNCH 1
#ifndef CFG_SMALL
constexpr int BATCH = 8, SEQ = 4096, DM = 1024, DEPTH = 4, DPLE = 256, DEXP = 512;
#else
constexpr int BATCH = 2, SEQ = 256, DM = 128, DEPTH = 2, DPLE = 32, DEXP = 128;
#endif
constexpr int T = BATCH * SEQ;
constexpr int DMIX = 1024, GW = 256, HD64 = 64, NH = 4;
constexpr int DIN = 3128, DINP = 3328;
constexpr int UA = 0, UA_R = 0, UA_K = 256, UA_V = 512, UA_WD = 768, UA_AD = 800, UA_GD = 832, DINA = 896;
constexpr int UB = 896, UB_Q = 896, UB_K = 1024, UB_V = 1152, UB_AD = 1408, UB_G = 1424;
constexpr int UC = 1680, UC_Q = 1680, UC_K = 1936, UC_V = 2192, UC_O = 2448, UC_IG = 2704, UC_FG = 2708;
constexpr int UD = 2712, UD_CQ = 2712, UD_CKV = 2968, UD_KR = 3096;
constexpr int NEXP = 32, NGRP = 4, EPG = 8;
constexpr int MAXROWS = 2 * T + NEXP * 256;
constexpr float DN_ALPHA = 1.681792830507429f;
constexpr float LN_EPS = 1e-5f, NORM_EPS = 1e-6f, RWKV_GN_EPS = 64e-5f;
static_assert(DEPTH == 4 || DEPTH == 2, "alpha below assumes depth");
HD float dn_alpha() { return DEPTH == 4 ? 1.681792830507429f : 1.4142135623730951f; }

enum { I_X = 0, I_P, I_POS, I_WIN, I_MU, I_W0, I_WUP, I_A0, I_AUP, I_GUP, I_KK, I_KA, I_RK, I_GNG, I_GNB, I_GLA_UP, I_GLA_B, I_GLA_G,
       I_CONVW, I_CONVB, I_IB, I_FB, I_MLN_G, I_QNG, I_WUQ, I_KVNG, I_WUKV, I_WOUT, I_LN1G, I_LN1B, I_WRG, I_BRG, I_WRE, I_BRE,
       I_WG, I_WU, I_WD, I_PLEG, I_PLEBG, I_PLEW, I_LN2G, I_LN2B, N_IN };

typedef unsigned short bf16_t;
HD float bf2f(bf16_t h) { unsigned u = (unsigned)h << 16; return __builtin_bit_cast(float, u); }
HD bf16_t f2bf(float f) { unsigned u = __builtin_bit_cast(unsigned, f); return (bf16_t)((u + 0x7fffu + ((u >> 16) & 1u)) >> 16); }
#ifndef CPU_TEST
HD unsigned pk2(float lo, float hi) { typedef float f2_t __attribute__((ext_vector_type(2))); typedef __bf16 b2_t __attribute__((ext_vector_type(2)));
    f2_t v = {lo, hi}; b2_t b = __builtin_convertvector(v, b2_t); return __builtin_bit_cast(unsigned, b); }
#else
HD unsigned pk2(float lo, float hi) { return (unsigned)f2bf(lo) | ((unsigned)f2bf(hi) << 16); }
#endif
typedef float f4v __attribute__((vector_size(16)));
typedef unsigned u4v __attribute__((vector_size(16)));
HD void ld8bf(const bf16_t* p, float* o) { const u4v w = *(const u4v*)p;
    for (int j = 0; j < 4; ++j) { o[2 * j] = __builtin_bit_cast(float, w[j] << 16); o[2 * j + 1] = __builtin_bit_cast(float, w[j] & 0xffff0000u); } }
HD void st8bf(bf16_t* p, const float* a) { u4v w; for (int j = 0; j < 4; ++j) w[j] = pk2(a[2 * j], a[2 * j + 1]); *(u4v*)p = w; }

constexpr size_t MiB = (size_t)1 << 20;
constexpr size_t al256(size_t x) { return (x + 255) & ~(size_t)255; }
constexpr size_t WS_CTL = 0, CTL_BYTES = 1 * MiB;
constexpr size_t WS_WIN = WS_CTL + CTL_BYTES;
constexpr size_t WS_WOUT = WS_WIN + al256((size_t)DINP * DM * 2);
constexpr size_t WS_WPG = WS_WOUT + al256((size_t)DM * DMIX * 2);
constexpr size_t WS_WP = WS_WPG + al256((size_t)DM * DM * 2);
constexpr size_t WS_WGU = WS_WP + al256((size_t)DM * DPLE * 2);
constexpr size_t WS_WD = WS_WGU + al256((size_t)NEXP * 2 * DEXP * DM * 2);
constexpr size_t WS_X = WS_WD + al256((size_t)NEXP * DM * DEXP * 2);
constexpr size_t WS_XB = WS_X + al256((size_t)T * DM * 4);
constexpr size_t WS_U = WS_XB + al256((size_t)T * DM * 2);
constexpr size_t WS_MIX = WS_U + al256((size_t)T * DINP * 2);
constexpr size_t WS_PB = WS_MIX + al256((size_t)T * DMIX * 2);
constexpr size_t WS_WUQ = WS_PB + al256((size_t)T * DPLE * 2);
constexpr size_t WS_WUKV = WS_WUQ + al256((size_t)512 * 256 * 2);
constexpr size_t WS_ROPE = WS_WUKV + al256((size_t)512 * 256 * 2);
constexpr size_t WS_RSTD = WS_ROPE + al256((size_t)T * 32 * 4);
constexpr size_t WS_RWW = WS_RSTD + al256((size_t)T * 2 * 4);
constexpr size_t WS_SCR = WS_RWW + al256((size_t)4 * 19456);
constexpr size_t TV = al256((size_t)T * GW * 4);
constexpr size_t WS_RW_R = WS_SCR, WS_RW_W = WS_RW_R + TV, WS_RW_K = WS_RW_W + TV, WS_RW_V = WS_RW_K + TV, WS_RW_A = WS_RW_V + TV,
                 WS_RW_B = WS_RW_A + TV, WS_RW_G = WS_RW_B + TV;
constexpr size_t WS_RW_PL = WS_RW_R, WS_RW_RY = WS_RW_R + (size_t)16 * MiB;
constexpr size_t WS_RW_QG = WS_RW_W, WS_RW_Y0 = WS_RW_K, WS_RW_GC = WS_RW_V;
static_assert(TV >= (size_t)32 * MiB || T < 32768, "chunk buffers alias the f32 field region");
constexpr size_t WS_YA = WS_RW_G + TV, WS_YB = WS_YA + TV, WS_YC = WS_YB + TV;
constexpr size_t WS_DEN = WS_YC + TV;
constexpr size_t WS_QK = WS_DEN + al256((size_t)T * 4 * 4);
constexpr size_t WS_GA = WS_QK + al256((size_t)T * 512 * 4);
constexpr size_t WS_LG = WS_GA + al256((size_t)T * 128 * 4);
constexpr size_t WS_AQ = WS_LG + al256((size_t)T * 8 * 4);
constexpr size_t WS_AK = WS_AQ + al256((size_t)T * 384 * 2);
constexpr size_t WS_AV = WS_AK + al256((size_t)T * 384 * 2);
constexpr size_t WS_RW_GG = WS_AV + al256((size_t)T * 256 * 2);
constexpr size_t WS_RW_VS = WS_RW_GG + al256((size_t)T * 256 * 2);
constexpr size_t WS_RW_BON = WS_RW_VS + al256((size_t)T * 256 * 2);
constexpr size_t WS_GLA_BLOB = WS_QK;
constexpr size_t WS_ML_BLOB = WS_RW_A;
constexpr size_t WS_MIXER_END = WS_RW_BON + al256((size_t)T * 4 * 4);
constexpr size_t WS_XG = WS_SCR;
constexpr size_t WS_H = WS_XG + al256((size_t)MAXROWS * DM * 2);
constexpr size_t WS_YBUF = WS_H + al256((size_t)MAXROWS * DEXP * 2);
constexpr size_t WS_PP = WS_YBUF + al256((size_t)2 * T * DM * 2);
constexpr size_t WS_TOKINFO = WS_PP + al256((size_t)T * DM * 2);
constexpr size_t WS_LIST = WS_TOKINFO + al256((size_t)T * 16);
constexpr size_t WS_ROWINFO = WS_LIST + al256((size_t)NEXP * T * 4);
constexpr size_t WS_ROWGATE = WS_ROWINFO + al256((size_t)MAXROWS * 4);
constexpr size_t WS_MOE_END = WS_ROWGATE + al256((size_t)MAXROWS * 4);
constexpr size_t WS_END = WS_MIXER_END > WS_MOE_END ? WS_MIXER_END : WS_MOE_END;
constexpr int CW_BAR = 4096;
constexpr int CW_ATT = 8192;
constexpr int CW_CNT = 16384;

struct Ctx {
    const void* in[N_IN];
    float* out;
    unsigned char* ws;
};
#ifndef CPU_TEST
typedef const __attribute__((address_space(4))) Ctx& CtxRef;
#else
typedef const Ctx& CtxRef;
#endif
#define INF(i) ((const float*)C.in[i])
#define WSP(T_, off) ((T_*)(C.ws + (off)))

#ifndef CPU_TEST
HD float dpp_f(float v, int sel) { const int x = __builtin_bit_cast(int, v); int y;
    if (sel == 0) y = __builtin_amdgcn_update_dpp(0, x, 0xB1, 0xF, 0xF, true);
    else if (sel == 1) y = __builtin_amdgcn_update_dpp(0, x, 0x4E, 0xF, 0xF, true);
    else if (sel == 2) y = __builtin_amdgcn_update_dpp(0, x, 0x141, 0xF, 0xF, true);
    else y = __builtin_amdgcn_update_dpp(0, x, 0x140, 0xF, 0xF, true);
    return __builtin_bit_cast(float, y); }
HD float wave_sum(float v) {
    v += dpp_f(v, 0); v += dpp_f(v, 1); v += dpp_f(v, 2); v += dpp_f(v, 3);
    const int x = __builtin_bit_cast(int, v);
    return (__builtin_bit_cast(float, __builtin_amdgcn_readlane(x, 0)) + __builtin_bit_cast(float, __builtin_amdgcn_readlane(x, 16))) +
           (__builtin_bit_cast(float, __builtin_amdgcn_readlane(x, 32)) + __builtin_bit_cast(float, __builtin_amdgcn_readlane(x, 48))); }
HD float wave_max(float v) {
    v = fmaxf(v, dpp_f(v, 0)); v = fmaxf(v, dpp_f(v, 1)); v = fmaxf(v, dpp_f(v, 2)); v = fmaxf(v, dpp_f(v, 3));
    const int x = __builtin_bit_cast(int, v);
    return fmaxf(fmaxf(__builtin_bit_cast(float, __builtin_amdgcn_readlane(x, 0)), __builtin_bit_cast(float, __builtin_amdgcn_readlane(x, 16))),
                 fmaxf(__builtin_bit_cast(float, __builtin_amdgcn_readlane(x, 32)), __builtin_bit_cast(float, __builtin_amdgcn_readlane(x, 48)))); }
HD unsigned atom_add(unsigned* p, unsigned v) { return atomicAdd(p, v); }
#define WSYNC() __builtin_amdgcn_wave_barrier(); asm volatile("s_waitcnt lgkmcnt(0)" ::: "memory")
typedef __attribute__((address_space(3))) float* wsh_t;
#else
HD float wave_sum(float v) { return v; }
HD float wave_max(float v) { return v; }
HD unsigned atom_add(unsigned* p, unsigned v) { unsigned o = *p; *p += v; return o; }
#define WSYNC()
typedef float* wsh_t;
#endif
#ifndef CPU_TEST
HD float sigmoidf_(float x) { return __builtin_amdgcn_rcpf(1.f + __expf(-x)); }
HD float tanhf_(float x) { const float xc = fminf(fmaxf(x, -15.f), 15.f); return 1.f - 2.f * __builtin_amdgcn_rcpf(1.f + __expf(2.f * xc)); }
#else
HD float sigmoidf_(float x) { return 1.f / (1.f + expf(-x)); }
HD float tanhf_(float x) { return tanhf(x); }
#endif
#ifndef CPU_TEST
HD float softplusf_(float x) { return x > 15.f ? x : __logf(1.f + __expf(x)); }
#else
HD float softplusf_(float x) { return x > 20.f ? x : (x < -20.f ? expf(x) : log1pf(expf(x))); }
#endif
HD float siluf_(float x) { return x * sigmoidf_(x); }

HD int rowmap(int mode, int n) { return mode == 0 ? n : (mode == 1 ? (n >> 7) * 256 + (n & 127) : (n >> 7) * 256 + 128 + (n & 127)); }
HD void transpose_item(const float* W, int K, int N, int ldw, bf16_t* WT, int ldk, int mode, int item, int lane, wsh_t scr) {
    const int nblk = (N + 31) / 32, kb = item / nblk, nb = item % nblk, k0 = 64 * kb, n0 = 32 * nb;
    for (int idx = lane; idx < 2048; idx += LANES) { const int kk = idx >> 5, nn = idx & 31; const int n = n0 + nn;
        scr[kk * 33 + nn] = (n < N) ? W[(size_t)(k0 + kk) * ldw + n] : 0.f; }
    WSYNC();
    for (int idx = lane; idx < 256; idx += LANES) { const int n = idx >> 3, c = idx & 7;
        unsigned o[4];
        for (int j = 0; j < 4; ++j) o[j] = pk2(scr[(8 * c + 2 * j) * 33 + n], scr[(8 * c + 2 * j + 1) * 33 + n]);
        unsigned* dst = (unsigned*)(WT + (size_t)rowmap(mode, n0 + n) * ldk + k0 + 8 * c);
        dst[0] = o[0]; dst[1] = o[1]; dst[2] = o[2]; dst[3] = o[3]; }
    WSYNC();
}
HD void stage_convert(CtxRef C, int l, int gw, int ngw, int lane, wsh_t scr) {
    constexpr int NB_IN = DINP / 32;
    constexpr int I_IN = (DM / 64) * NB_IN, I_OUT = (DMIX / 64) * (DM / 32), I_PG = (DM / 64) * (DM / 32), I_PW = (DPLE / 64 > 0 ? DPLE / 64 : 1) * (DM / 32);
    constexpr int I_G1 = (DM / 64) * (DEXP / 32), I_D1 = (DEXP / 64) * (DM / 32);
    constexpr int NIT = I_IN + I_OUT + I_PG + I_PW + NEXP * (2 * I_G1 + I_D1);
    static_assert(DPLE % 32 == 0 && DEXP % 64 == 0, "shapes");
    for (int it = gw; it < NIT; it += ngw) {
        int r = it;
        if (r < I_IN) {
            const int nblk = NB_IN, kb = r / nblk, nb = r % nblk, k0 = 64 * kb, n0 = 32 * nb;
            const float* W = INF(I_WIN) + (size_t)l * DM * DIN; bf16_t* WT = WSP(bf16_t, WS_WIN);
            for (int idx = lane; idx < 2048; idx += LANES) { const int kk = idx >> 5, nn = idx & 31; const int n = n0 + nn;
                scr[kk * 33 + nn] = (n < DIN) ? W[(size_t)(k0 + kk) * DIN + n] : 0.f; }
            WSYNC();
            for (int idx = lane; idx < 256; idx += LANES) { const int n = idx >> 3, c = idx & 7; unsigned o[4];
                for (int j = 0; j < 4; ++j) o[j] = pk2(scr[(8 * c + 2 * j) * 33 + n], scr[(8 * c + 2 * j + 1) * 33 + n]);
                unsigned* dst = (unsigned*)(WT + (size_t)(n0 + n) * DM + k0 + 8 * c); dst[0] = o[0]; dst[1] = o[1]; dst[2] = o[2]; dst[3] = o[3]; }
            WSYNC();
            continue; }
        r -= I_IN;
        if (r < I_OUT) { transpose_item(INF(I_WOUT) + (size_t)l * DMIX * DM, DMIX, DM, DM, WSP(bf16_t, WS_WOUT), DMIX, 0, r, lane, scr); continue; } r -= I_OUT;
        if (r < I_PG) { transpose_item(INF(I_PLEG) + (size_t)l * DM * DM, DM, DM, DM, WSP(bf16_t, WS_WPG), DM, 0, r, lane, scr); continue; } r -= I_PG;
        if (r < I_PW) {
            if (DPLE >= 64) transpose_item(INF(I_PLEW) + (size_t)l * DPLE * DM, DPLE, DM, DM, WSP(bf16_t, WS_WP), DPLE, 0, r, lane, scr);
            continue; } r -= I_PW;
        const int e = r / (2 * I_G1 + I_D1); r -= e * (2 * I_G1 + I_D1);
        if (r < I_G1) { transpose_item(INF(I_WG) + ((size_t)l * NEXP + e) * DM * DEXP, DM, DEXP, DEXP, WSP(bf16_t, WS_WGU) + (size_t)e * 2 * DEXP * DM, DM, 1, r, lane, scr); continue; } r -= I_G1;
        if (r < I_G1) { transpose_item(INF(I_WU) + ((size_t)l * NEXP + e) * DM * DEXP, DM, DEXP, DEXP, WSP(bf16_t, WS_WGU) + (size_t)e * 2 * DEXP * DM, DM, 2, r, lane, scr); continue; } r -= I_G1;
        transpose_item(INF(I_WD) + ((size_t)l * NEXP + e) * DEXP * DM, DEXP, DM, DM, WSP(bf16_t, WS_WD) + (size_t)e * DM * DEXP, DEXP, 0, r, lane, scr);
    }
    {   const float* wq = INF(I_WUQ) + (size_t)l * 256 * 384; const float* gq = INF(I_QNG) + l * 256; bf16_t* o = WSP(bf16_t, WS_WUQ);
        for (int i = gw * LANES + lane; i < 512 * 256; i += ngw * LANES) { const int n = i >> 8, k = i & 255; o[i] = f2bf(n < 384 ? gq[k] * wq[(size_t)k * 384 + n] : 0.f); }
        const float* wk = INF(I_WUKV) + (size_t)l * 128 * 512; const float* gk = INF(I_KVNG) + l * 128; bf16_t* o2 = WSP(bf16_t, WS_WUKV);
        for (int i = gw * LANES + lane; i < 512 * 256; i += ngw * LANES) { const int n = i >> 8, k = i & 255; o2[i] = f2bf(k < 128 ? gk[k] * wk[(size_t)k * 512 + n] : 0.f); } }
    {
        const float* wup = INF(I_WUP) + l * 32 * GW; const float* aup = INF(I_AUP) + l * 32 * GW; const float* gup = INF(I_GUP) + l * 64 * GW; bf16_t* o = WSP(bf16_t, WS_RWW);
        for (int i = gw * LANES + lane; i < 4 * 9728; i += ngw * LANES) { const int h = i / 9728, r = i % 9728; float v = 0.f;
            if (r < 2560) { const int c = r / 40, j = r % 40; if (j < 32) v = wup[j * GW + h * 64 + c]; }
            else if (r < 5120) { const int c = (r - 2560) / 40, j = (r - 2560) % 40; if (j < 32) v = aup[j * GW + h * 64 + c]; }
            else { const int c = (r - 5120) / 72, j = (r - 5120) % 72; if (j < 64) v = gup[j * GW + h * 64 + c]; }
            o[i] = f2bf(v); } }
    if (l == 0) {
        const int* pos = (const int*)C.in[I_POS]; float* rt = WSP(float, WS_ROPE);
        for (int i = gw * LANES + lane; i < T * 16; i += ngw * LANES) { const int t = i >> 4, f = i & 15; const float ang = (float)pos[t] * powf(10000.f, -(float)f / 16.f);
            rt[(size_t)t * 32 + f] = cosf(ang); rt[(size_t)t * 32 + 16 + f] = sinf(ang); } }
    {   const float* p = INF(I_P) + (size_t)l * T * DPLE; bf16_t* pb = WSP(bf16_t, WS_PB);
        const size_t n4 = (size_t)T * DPLE / 4;
        for (size_t i = (size_t)gw * LANES + lane; i < n4; i += (size_t)ngw * LANES) {
            const float* s = p + 4 * i; unsigned* d = (unsigned*)(pb + 4 * i); d[0] = pk2(s[0], s[1]); d[1] = pk2(s[2], s[3]); } }
    if (l == 0) { const float* x = INF(I_X); bf16_t* xb = WSP(bf16_t, WS_XB);
        const size_t n4 = (size_t)T * DM / 4;
        for (size_t i = (size_t)gw * LANES + lane; i < n4; i += (size_t)ngw * LANES) {
            const float* s = x + 4 * i; unsigned* d = (unsigned*)(xb + 4 * i); d[0] = pk2(s[0], s[1]); d[1] = pk2(s[2], s[3]); } }
#ifdef CFG_SMALL
    if (DPLE < 64) {
        const float* W = INF(I_PLEW) + (size_t)l * DPLE * DM; bf16_t* WT = WSP(bf16_t, WS_WP);
        for (int i = gw * LANES + lane; i < DPLE * DM; i += ngw * LANES) { const int k = i / DM, n = i % DM; WT[(size_t)n * DPLE + k] = f2bf(W[i]); } }
#endif
}

HD float ubf(const bf16_t* u, int t, int c) { return bf2f(u[(size_t)t * DINP + c]); }
HD void stage_prep(CtxRef C, int l, int gw, int ngw, int lane, wsh_t sh) {
    const bf16_t* u = WSP(bf16_t, WS_U);
    const float* mu = INF(I_MU) + l * DINA; const float* w0 = INF(I_W0) + l * GW; const float* wup = INF(I_WUP) + l * 32 * GW;
    const float* a0 = INF(I_A0) + l * GW; const float* aup = INF(I_AUP) + l * 32 * GW; const float* gup = INF(I_GUP) + l * 64 * GW;
    const float* kkw = INF(I_KK) + l * GW; const float* kaw = INF(I_KA) + l * GW;
    const float* glaup = INF(I_GLA_UP) + l * 16 * 128; const float* glab = INF(I_GLA_B) + l * 128;
    const float* convw = INF(I_CONVW) + l * 4 * 512; const float* convb = INF(I_CONVB) + l * 512;
    const float* ib = INF(I_IB) + l * 4; const float* fb = INF(I_FB) + l * 4;
    const float* qng = INF(I_QNG) + l * 256; const float* wuq = INF(I_WUQ) + (size_t)l * 256 * 384;
    const float* kvng = INF(I_KVNG) + l * 128; const float* wukv = INF(I_WUKV) + (size_t)l * 128 * 512;
    const int* pos = (const int*)C.in[I_POS];
    float* oR = WSP(float, WS_RW_R); float* oW = WSP(float, WS_RW_W); float* oK = WSP(float, WS_RW_K); float* oV = WSP(float, WS_RW_V);
    float* oA = WSP(float, WS_RW_A); float* oB = WSP(float, WS_RW_B); float* oG = WSP(float, WS_RW_G);
    float* oQK = WSP(float, WS_QK); float* oGA = WSP(float, WS_GA); float* oLG = WSP(float, WS_LG);
    bf16_t* oAQ = WSP(bf16_t, WS_AQ); bf16_t* oAK = WSP(bf16_t, WS_AK); bf16_t* oAV = WSP(bf16_t, WS_AV);
    for (int t = gw; t < T; t += ngw) {
        const int s = t % SEQ;
        for (int j = lane; j < 128; j += LANES) { const int c = UA_WD + j; const float cur = ubf(u, t, c), prev = s > 0 ? ubf(u, t - 1, c) : 0.f;
            const float v = cur + (prev - cur) * mu[c]; sh[j] = j < 32 ? tanhf(v) : (j < 64 ? v : sigmoidf_(v)); }
        WSYNC();
        for (int h = 0; h < NH; ++h) {
            float kkraw[HD64 / LANES]; float kv_[HD64 / LANES], av_[HD64 / LANES]; float ss = 0.f;
            for (int i = 0; i < HD64 / LANES; ++i) { const int c = h * 64 + i * LANES + lane;
                float z = w0[c], za = a0[c], g = 0.f;
_Pragma("unroll 8")
                for (int j = 0; j < 32; ++j) { z += sh[j] * wup[j * GW + c]; za += sh[32 + j] * aup[j * GW + c]; }
_Pragma("unroll 8")
                for (int j = 0; j < 64; ++j) g += sh[64 + j] * gup[j * GW + c];
                const float lnl = -softplusf_(-z) - 0.5f; const float decay = expf(-expf(lnl)); const float a = sigmoidf_(za);
                float r, k, v;
                { const float cur = ubf(u, t, UA_R + c), prev = s > 0 ? ubf(u, t - 1, UA_R + c) : 0.f; r = cur + (prev - cur) * mu[UA_R + c]; }
                { const float cur = ubf(u, t, UA_K + c), prev = s > 0 ? ubf(u, t - 1, UA_K + c) : 0.f; k = cur + (prev - cur) * mu[UA_K + c]; }
                { const float cur = ubf(u, t, UA_V + c), prev = s > 0 ? ubf(u, t - 1, UA_V + c) : 0.f; v = cur + (prev - cur) * mu[UA_V + c]; }
                kkraw[i] = k * kkw[c]; ss += kkraw[i] * kkraw[i];
                kv_[i] = k * (1.f + (a - 1.f) * kaw[c]); av_[i] = a;
                const size_t o = (size_t)t * GW + c; oR[o] = r; oW[o] = decay; oK[o] = kv_[i]; oV[o] = v; oG[o] = g; }
            ss = wave_sum(ss); const float inv = 1.f / fmaxf(sqrtf(ss), 1e-12f);
            for (int i = 0; i < HD64 / LANES; ++i) { const int c = h * 64 + i * LANES + lane; const size_t o = (size_t)t * GW + c; const float kk = kkraw[i] * inv;
                oA[o] = -kk; oB[o] = kk * av_[i]; }
        }
        WSYNC();
        for (int c = lane; c < 128; c += LANES) { float z = glab[c];
            for (int j = 0; j < 16; ++j) z += ubf(u, t, UB_AD + j) * glaup[j * 128 + c];
            oGA[(size_t)t * 128 + c] = -softplusf_(-z) * (1.f / 16.f); }
        for (int c = lane; c < 512; c += LANES) { float y = convb[c];
            for (int j = 0; j < 4; ++j) { const int sp = s - 3 + j; if (sp >= 0) y += convw[j * 512 + c] * ubf(u, t - 3 + j, UC_Q + c); }
            float q = siluf_(y); if (c >= 256) q *= 0.125f; oQK[(size_t)t * 512 + c] = q; }
        for (int c = lane; c < 8; c += LANES) { const float v = ubf(u, t, UC_IG + c);
            oLG[(size_t)t * 8 + c] = c < 4 ? v + ib[c] : -softplusf_(-(v + fb[c - 4])); }
        {   float ssq = 0.f, sskv = 0.f;
            for (int j = lane; j < 256; j += LANES) { const float v = ubf(u, t, UD_CQ + j); ssq += v * v; }
            for (int j = lane; j < 128; j += LANES) { const float v = ubf(u, t, UD_CKV + j); sskv += v * v; }
            ssq = wave_sum(ssq); sskv = wave_sum(sskv);
            const float rq = 1.f / sqrtf(ssq * (1.f / 256.f) + NORM_EPS), rkv = 1.f / sqrtf(sskv * (1.f / 128.f) + NORM_EPS);
            for (int j = lane; j < 256; j += LANES) sh[j] = ubf(u, t, UD_CQ + j) * rq * qng[j];
            for (int j = lane; j < 128; j += LANES) sh[256 + j] = ubf(u, t, UD_CKV + j) * rkv * kvng[j];
            WSYNC();
            for (int n = lane; n < 384; n += LANES) { float acc = 0.f;
_Pragma("unroll 8")
                for (int k = 0; k < 256; ++k) acc += sh[k] * wuq[(size_t)k * 384 + n]; sh[384 + n] = acc; }
            for (int n = lane; n < 512; n += LANES) { float acc = 0.f;
_Pragma("unroll 8")
                for (int k = 0; k < 128; ++k) acc += sh[256 + k] * wukv[(size_t)k * 512 + n]; sh[768 + n] = acc; }
            for (int i = lane; i < 16; i += LANES) { const float invf = powf(10000.f, -(float)i / 16.f); const float ang = (float)pos[t] * invf; sh[1280 + i] = cosf(ang); sh[1296 + i] = sinf(ang); }
            for (int i = lane; i < 32; i += LANES) sh[1312 + i] = ubf(u, t, UD_KR + i);
            WSYNC();
            const float qscale = 0.10206207261596575f * 1.4426950408889634f;
            for (int idx = lane; idx < 384; idx += LANES) { const int h = idx / 96, d = idx % 96; float v;
                if (d < 64) v = sh[384 + idx];
                else { const int i = (d - 64) & 15; const float x1 = sh[384 + h * 96 + 64 + i], x2 = sh[384 + h * 96 + 80 + i]; const float c_ = sh[1280 + i], s_ = sh[1296 + i];
                    v = (d - 64) < 16 ? x1 * c_ - x2 * s_ : x1 * s_ + x2 * c_; }
                oAQ[(size_t)t * 384 + idx] = f2bf(v * qscale); }
            for (int idx = lane; idx < 384; idx += LANES) { const int h = idx / 96, d = idx % 96; float v;
                if (d < 64) v = sh[768 + h * 128 + d];
                else { const int i = (d - 64) & 15; const float x1 = sh[1312 + i], x2 = sh[1328 + i]; const float c_ = sh[1280 + i], s_ = sh[1296 + i];
                    v = (d - 64) < 16 ? x1 * c_ - x2 * s_ : x1 * s_ + x2 * c_; }
                oAK[(size_t)t * 384 + idx] = f2bf(v); }
            for (int idx = lane; idx < 256; idx += LANES) { const int h = idx / 64, d = idx % 64; oAV[(size_t)t * 256 + idx] = f2bf(sh[768 + h * 128 + 64 + d]); }
            WSYNC();
        }
    }
}

HD void rwkv_scan_thread(CtxRef C, int b, int h, int v) {
    const float* pR = WSP(float, WS_RW_R); const float* pW = WSP(float, WS_RW_W); const float* pK = WSP(float, WS_RW_K); const float* pV = WSP(float, WS_RW_V);
    const float* pA = WSP(float, WS_RW_A); const float* pB = WSP(float, WS_RW_B); float* Y = WSP(float, WS_YA);
    float S[64];
#pragma unroll
    for (int k = 0; k < 64; ++k) S[k] = 0.f;
    for (int s = 0; s < SEQ; ++s) {
        const size_t o = ((size_t)b * SEQ + s) * GW + h * 64;
        const float vv = pV[o + v];
        float sa0 = 0.f, sa1 = 0.f, sa2 = 0.f, sa3 = 0.f;
#pragma unroll
        for (int k = 0; k < 64; k += 4) { const f4v a = *(const f4v*)(pA + o + k); sa0 += S[k] * a[0]; sa1 += S[k + 1] * a[1]; sa2 += S[k + 2] * a[2]; sa3 += S[k + 3] * a[3]; }
        const float sa = (sa0 + sa1) + (sa2 + sa3);
        float y0 = 0.f, y1 = 0.f, y2 = 0.f, y3 = 0.f;
#pragma unroll
        for (int k = 0; k < 64; k += 4) {
            const f4v w = *(const f4v*)(pW + o + k), bb = *(const f4v*)(pB + o + k), kk = *(const f4v*)(pK + o + k), r = *(const f4v*)(pR + o + k);
            S[k] = S[k] * w[0] + sa * bb[0] + vv * kk[0]; y0 += S[k] * r[0];
            S[k + 1] = S[k + 1] * w[1] + sa * bb[1] + vv * kk[1]; y1 += S[k + 1] * r[1];
            S[k + 2] = S[k + 2] * w[2] + sa * bb[2] + vv * kk[2]; y2 += S[k + 2] * r[2];
            S[k + 3] = S[k + 3] * w[3] + sa * bb[3] + vv * kk[3]; y3 += S[k + 3] * r[3];
            if ((k & 12) == 12) asm volatile("" ::: "memory"); }
        Y[o + v] = (y0 + y1) + (y2 + y3);
    }
}
HD void gla_scan_thread(CtxRef C, int b, int h, int v) {
    const bf16_t* u = WSP(bf16_t, WS_U); const float* GA = WSP(float, WS_GA); float* Y = WSP(float, WS_YB);
    float S[32];
#pragma unroll
    for (int k = 0; k < 32; ++k) S[k] = 0.f;
    for (int s = 0; s < SEQ; ++s) {
        const int t = b * SEQ + s;
        const float vv = ubf(u, t, UB_V + h * 64 + v);
        float acc = 0.f;
#pragma unroll
        for (int k8 = 0; k8 < 32; k8 += 8) { float kf[8], qf[8];
            ld8bf(u + (size_t)t * DINP + UB_K + h * 32 + k8, kf); ld8bf(u + (size_t)t * DINP + UB_Q + h * 32 + k8, qf);
            const f4v g0 = *(const f4v*)(GA + (size_t)t * 128 + h * 32 + k8), g1 = *(const f4v*)(GA + (size_t)t * 128 + h * 32 + k8 + 4);
#pragma unroll
            for (int j = 0; j < 8; ++j) { const float a = expf(j < 4 ? g0[j & 3] : g1[j & 3]); S[k8 + j] = a * S[k8 + j] + kf[j] * vv; acc += qf[j] * S[k8 + j]; } }
        Y[(size_t)t * GW + h * 64 + v] = acc * 0.17677669529663687f;
    }
}
HD void mlstm_scan_thread(CtxRef C, int b, int h, int e) {
    const bf16_t* u = WSP(bf16_t, WS_U); const float* QK = WSP(float, WS_QK); const float* LG = WSP(float, WS_LG);
    float* Y = WSP(float, WS_YC); float* DEN = WSP(float, WS_DEN);
    float S[64];
#pragma unroll
    for (int k = 0; k < 64; ++k) S[k] = 0.f;
    for (int s = 0; s < SEQ; ++s) {
        const int t = b * SEQ + s;
        const float ig = expf(LG[(size_t)t * 8 + h]), fg = expf(LG[(size_t)t * 8 + 4 + h]);
        const float vv = (e < 64 ? ubf(u, t, UC_V + h * 64 + e) : 1.f) * ig;
        float acc = 0.f;
#pragma unroll
        for (int k = 0; k < 64; k += 4) { const f4v kk = *(const f4v*)(QK + (size_t)t * 512 + 256 + h * 64 + k), qq = *(const f4v*)(QK + (size_t)t * 512 + h * 64 + k);
#pragma unroll
            for (int j = 0; j < 4; ++j) { S[k + j] = fg * S[k + j] + kk[j] * vv; acc += qq[j] * S[k + j]; } }
        if (e < 64) Y[(size_t)t * GW + h * 64 + e] = acc; else DEN[(size_t)t * 4 + h] = acc;
    }
}
HD void attn_thread(CtxRef C, int b, int h, int q, int kmax  ) {
    const bf16_t* Q = WSP(bf16_t, WS_AQ); const bf16_t* K = WSP(bf16_t, WS_AK); const bf16_t* V = WSP(bf16_t, WS_AV); bf16_t* mix = WSP(bf16_t, WS_MIX);
    const int t = b * SEQ + q;
    unsigned qp[48]; float o[64];
#pragma unroll
    for (int d = 0; d < 48; d += 4) { const u4v w = *(const u4v*)(Q + (size_t)t * 384 + h * 96 + 2 * d); qp[d] = w[0]; qp[d + 1] = w[1]; qp[d + 2] = w[2]; qp[d + 3] = w[3]; }
#pragma unroll
    for (int d = 0; d < 64; ++d) o[d] = 0.f;
    float m = -1e30f, lsum = 0.f;
    for (int j = 0; j <= kmax; ++j) {
        const size_t tk = (size_t)b * SEQ + j;
        float sc0 = 0.f, sc1 = 0.f;
#pragma unroll
        for (int d = 0; d < 96; d += 8) { float kf[8]; ld8bf(K + tk * 384 + h * 96 + d, kf);
#pragma unroll
            for (int i = 0; i < 8; i += 2) { const unsigned qw = qp[(d + i) >> 1];
                sc0 += __builtin_bit_cast(float, qw << 16) * kf[i]; sc1 += __builtin_bit_cast(float, qw & 0xffff0000u) * kf[i + 1]; }
            if ((d & 24) == 24) asm volatile("" ::: "memory"); }
        const float sc = sc0 + sc1;
        if (j <= q) {
            const float mn = fmaxf(m, sc); const float corr = exp2f(m - mn), p = exp2f(sc - mn);
            lsum = lsum * corr + p;
#pragma unroll
            for (int d = 0; d < 64; d += 8) { float vf[8]; ld8bf(V + tk * 256 + h * 64 + d, vf);
#pragma unroll
                for (int i = 0; i < 8; ++i) o[d + i] = o[d + i] * corr + p * vf[i];
                if (d & 8) asm volatile("" ::: "memory"); }
            m = mn; }
    }
    const float inv = 1.f / lsum;
#pragma unroll
    for (int d = 0; d < 64; d += 8) { float a[8];
#pragma unroll
        for (int i = 0; i < 8; ++i) a[i] = o[d + i] * inv;
        st8bf(mix + (size_t)t * DMIX + 768 + h * 64 + d, a); }
}

HD void stage_post(CtxRef C, int l, int gw, int ngw, int lane) {
    const bf16_t* u = WSP(bf16_t, WS_U); bf16_t* mix = WSP(bf16_t, WS_MIX);
    const float* YA = WSP(float, WS_YA); const float* YB = WSP(float, WS_YB); const float* YC = WSP(float, WS_YC); const float* DEN = WSP(float, WS_DEN);
    const float* pR = WSP(float, WS_RW_R); const float* pK = WSP(float, WS_RW_K); const float* pV = WSP(float, WS_RW_V); const float* pG = WSP(float, WS_RW_G);
    const float* rk = INF(I_RK) + l * GW; const float* gng = INF(I_GNG) + l * GW; const float* gnb = INF(I_GNB) + l * GW;
    const float* glag = INF(I_GLA_G) + l * GW; const float* mlng = INF(I_MLN_G) + l * GW;
    constexpr int PL = HD64 / LANES;
    for (int t = gw; t < T; t += ngw) {
        for (int h = 0; h < NH; ++h) {
            {   float y[PL], s1 = 0.f, bon = 0.f;
#ifdef CPU_TEST
                for (int i = 0; i < PL; ++i) { const int c = h * 64 + i * LANES + lane; const size_t o = (size_t)t * GW + c; y[i] = YA[o]; s1 += y[i]; bon += pR[o] * pK[o] * rk[c]; }
                s1 = wave_sum(s1); bon = wave_sum(bon);
#else
                for (int i = 0; i < PL; ++i) { const int c = h * 64 + i * LANES + lane; y[i] = YA[(size_t)t * GW + c]; s1 += y[i]; }
                s1 = wave_sum(s1); bon = WSP(float, WS_RW_BON)[(size_t)t * 4 + h];
#endif
                const float mean = s1 * (1.f / 64.f); float s2 = 0.f;
                for (int i = 0; i < PL; ++i) { y[i] -= mean; s2 += y[i] * y[i]; }
                s2 = wave_sum(s2); const float rstd = 1.f / sqrtf(s2 * (1.f / 64.f) + RWKV_GN_EPS);
                for (int i = 0; i < PL; ++i) { const int c = h * 64 + i * LANES + lane; const size_t o = (size_t)t * GW + c;
#ifdef CPU_TEST
                    const float v = (y[i] * rstd * gng[c] + gnb[c] + bon * pV[o]) * pG[o];
#else
                    const float v = (y[i] * rstd * gng[c] + gnb[c] + bon * bf2f(WSP(bf16_t, WS_RW_VS)[o])) * bf2f(WSP(bf16_t, WS_RW_GG)[o]);
#endif
                    mix[(size_t)t * DMIX + c] = f2bf(v); } }
            {   float y[PL], s2 = 0.f;
                for (int i = 0; i < PL; ++i) { const int c = h * 64 + i * LANES + lane; y[i] = YB[(size_t)t * GW + c]; s2 += y[i] * y[i]; }
                s2 = wave_sum(s2); const float rstd = 1.f / sqrtf(s2 * (1.f / 64.f) + NORM_EPS);
                for (int i = 0; i < PL; ++i) { const int c = h * 64 + i * LANES + lane;
                    const float v = y[i] * rstd * glag[c] * siluf_(ubf(u, t, UB_G + c)); mix[(size_t)t * DMIX + 256 + c] = f2bf(v); } }
            {   const float den = DEN[(size_t)t * 4 + h]; const float dinv = 1.f / fmaxf(fabsf(den), 1.f);
                float y[PL], s1 = 0.f;
                for (int i = 0; i < PL; ++i) { const int c = h * 64 + i * LANES + lane; y[i] = YC[(size_t)t * GW + c] * dinv; s1 += y[i]; }
                s1 = wave_sum(s1); const float mean = s1 * (1.f / 64.f); float s2 = 0.f;
                for (int i = 0; i < PL; ++i) { y[i] -= mean; s2 += y[i] * y[i]; }
                s2 = wave_sum(s2); const float rstd = 1.f / sqrtf(s2 * (1.f / 64.f) + LN_EPS);
                for (int i = 0; i < PL; ++i) { const int c = h * 64 + i * LANES + lane;
                    const float v = y[i] * rstd * mlng[c] * sigmoidf_(ubf(u, t, UC_O + c)); mix[(size_t)t * DMIX + 512 + c] = f2bf(v); } }
        }
    }
}

HD void ln_row(const float* src, const float* g, const float* b, float* dstf, bf16_t* dstb, int lane, float* keep  ) {
    constexpr int PL = DM / LANES;
    float s1 = 0.f;
#pragma unroll
    for (int i = 0; i < PL; ++i) { keep[i] = src[i * LANES + lane]; s1 += keep[i]; }
    s1 = wave_sum(s1); const float mean = s1 * (1.f / DM); float s2 = 0.f;
#pragma unroll
    for (int i = 0; i < PL; ++i) { keep[i] -= mean; s2 += keep[i] * keep[i]; }
    s2 = wave_sum(s2); const float rstd = 1.f / sqrtf(s2 * (1.f / DM) + LN_EPS);
#pragma unroll
    for (int i = 0; i < PL; ++i) { const int c = i * LANES + lane; keep[i] = keep[i] * rstd * g[c] + b[c]; dstf[c] = keep[i]; dstb[c] = f2bf(keep[i]); }
}
HD void stage_ln1_router(CtxRef C, int l, int gw, int ngw, int lane, wsh_t sh) {
    float* X1 = C.out; bf16_t* xb = WSP(bf16_t, WS_XB);
    const float* g = INF(I_LN1G) + l * DM; const float* b = INF(I_LN1B) + l * DM;
    const float* wrg = INF(I_WRG) + (size_t)l * DM * NGRP; const float* brg = INF(I_BRG) + l * NGRP;
    const float* wre = INF(I_WRE) + (size_t)l * DM * NEXP; const float* bre = INF(I_BRE) + l * NEXP;
    unsigned* cnt = WSP(unsigned, WS_CTL) + CW_CNT + l * NEXP * 64;
    int* tokinfo = WSP(int, WS_TOKINFO); int* list = WSP(int, WS_LIST);
    constexpr int PL = DM / LANES;
    for (int t = gw; t < T; t += ngw) {
        {   float keep[PL];
            ln_row(X1 + (size_t)t * DM, g, b, X1 + (size_t)t * DM, xb + (size_t)t * DM, lane, keep);
#pragma unroll
            for (int i = 0; i < PL; ++i) sh[i * LANES + lane] = keep[i]; }
        WSYNC();
        float lg[NGRP], le[NEXP];
#pragma unroll
        for (int j = 0; j < NGRP; ++j) lg[j] = 0.f;
#pragma unroll
        for (int j = 0; j < NEXP; ++j) le[j] = 0.f;
#pragma unroll 1
        for (int i = 0; i < PL; ++i) { const int c = i * LANES + lane; const float xv = sh[c];
            const f4v wg = *(const f4v*)(wrg + (size_t)c * NGRP);
#pragma unroll
            for (int j = 0; j < NGRP; ++j) lg[j] += xv * wg[j];
#pragma unroll
            for (int j = 0; j < NEXP; j += 4) { const f4v we = *(const f4v*)(wre + (size_t)c * NEXP + j);
                le[j] += xv * we[0]; le[j + 1] += xv * we[1]; le[j + 2] += xv * we[2]; le[j + 3] += xv * we[3]; } }
        WSYNC();
#pragma unroll
        for (int j = 0; j < NGRP; ++j) lg[j] = wave_sum(lg[j]) + brg[j];
#pragma unroll
        for (int j = 0; j < NEXP; ++j) le[j] = wave_sum(le[j]) + bre[j];
        int gi = 0; float gm = lg[0];
#pragma unroll
        for (int j = 1; j < NGRP; ++j) if (lg[j] > gm) { gm = lg[j]; gi = j; }
        float gs = 0.f;
#pragma unroll
        for (int j = 0; j < NGRP; ++j) gs += expf(lg[j] - gm);
        const float group_p = 1.f / gs;
        float el[EPG];
#pragma unroll
        for (int j = 0; j < EPG; ++j) { float v = le[j];
#pragma unroll
            for (int g2 = 1; g2 < NGRP; ++g2) v = (gi == g2) ? le[g2 * EPG + j] : v;
            el[j] = v; }
        int e0 = 0; float m0 = el[0];
#pragma unroll
        for (int j = 1; j < EPG; ++j) if (el[j] > m0) { m0 = el[j]; e0 = j; }
        int e1 = -1; float m1 = -3.0e38f;
#pragma unroll
        for (int j = 0; j < EPG; ++j) if (j != e0 && el[j] > m1) { m1 = el[j]; e1 = j; }
        const float p1 = expf(m1 - m0); const float g0 = group_p / (1.f + p1), g1 = group_p * p1 / (1.f + p1);
        if (lane == 0) {
            const int E0 = gi * EPG + e0, E1 = gi * EPG + e1;
            tokinfo[(size_t)t * 4 + 0] = E0; tokinfo[(size_t)t * 4 + 1] = E1;
            ((float*)tokinfo)[(size_t)t * 4 + 2] = g0; ((float*)tokinfo)[(size_t)t * 4 + 3] = g1;
            const unsigned s0 = atom_add(cnt + E0 * 64, 1u); list[(size_t)E0 * T + s0] = t * 2 + 0;
            const unsigned s1 = atom_add(cnt + E1 * 64, 1u); list[(size_t)E1 * T + s1] = t * 2 + 1;
        }
    }
}
HD void moe_bases(CtxRef C, int l, int* base  ) {
    const unsigned* cnt = WSP(unsigned, WS_CTL) + CW_CNT + l * NEXP * 64;
    int acc = 0;
    for (int e = 0; e < NEXP; ++e) { base[e] = acc; acc += ((int)cnt[e * 64] + 255) & ~255; }
    base[NEXP] = acc;
}
HD int moe_expert_of_row(const int* base, int row) { int e = 0; for (int j = 1; j < NEXP; ++j) if (row >= base[j]) e = j; return e; }
HD int moe_lookup(const unsigned* cnt, int row, int& e, int& be, int& ce) {
    int acc = 0; e = 0; be = 0; ce = 0;
    for (int j = 0; j < NEXP; ++j) { const int c = (int)cnt[j * 64]; if (row >= acc) { e = j; be = acc; ce = c; } acc += (c + 255) & ~255; }
    return acc;
}
HD void stage_gather(CtxRef C, int l, int gw, int ngw, int lane) {
    const unsigned* cnt = WSP(unsigned, WS_CTL) + CW_CNT + l * NEXP * 64;
    const int* list = WSP(int, WS_LIST); const int* tokinfo = WSP(int, WS_TOKINFO);
    const bf16_t* xb = WSP(bf16_t, WS_XB); bf16_t* xg = WSP(bf16_t, WS_XG); int* rowinfo = WSP(int, WS_ROWINFO); float* rowgate = WSP(float, WS_ROWGATE);
    int e, be, ce; const int total = moe_lookup(cnt, 0, e, be, ce);
    for (int row = gw; row < total; row += ngw) {
        moe_lookup(cnt, row, e, be, ce);
        const int slot = row - be;
        if (slot < ce) { const int ent = list[(size_t)e * T + slot]; const int tok = ent >> 1;
            for (int c = lane * 8; c < DM; c += LANES * 8) *(u4v*)(xg + (size_t)row * DM + c) = *(const u4v*)(xb + (size_t)tok * DM + c);
            if (lane == 0) { rowinfo[row] = ent; rowgate[row] = ((const float*)tokinfo)[(size_t)tok * 4 + 2 + (ent & 1)]; } }
        else { const u4v z = {0u, 0u, 0u, 0u}; for (int c = lane * 8; c < DM; c += LANES * 8) *(u4v*)(xg + (size_t)row * DM + c) = z;
            if (lane == 0) { rowinfo[row] = -1; rowgate[row] = 0.f; } }
    }
}
HD void stage_ln2(CtxRef C, int l, int gw, int ngw, int lane) {
    const float* src = WSP(float, WS_X); float* dst = (l == DEPTH - 1) ? C.out : WSP(float, WS_X); bf16_t* xb = WSP(bf16_t, WS_XB);
    const float* g = INF(I_LN2G) + l * DM; const float* b = INF(I_LN2B) + l * DM;
    constexpr int PL = DM / LANES;
    for (int t = gw; t < T; t += ngw) { float keep[PL]; ln_row(src + (size_t)t * DM, g, b, dst + (size_t)t * DM, xb + (size_t)t * DM, lane, keep); }
}

struct EpiU {
    static constexpr bool PERM = true; static constexpr int MODE = 0;
    bf16_t* o;
    HDM void put8(int row, int col, const float* a) const { st8bf(o + (size_t)row * DINP + col, a); }
};
struct EpiPP {
    static constexpr bool PERM = true; static constexpr int MODE = 0;
    bf16_t* o;
    HDM void put8(int row, int col, const float* a) const { st8bf(o + (size_t)row * DM + col, a); }
};
struct EpiPre1 {
    static constexpr bool PERM = false; static constexpr int MODE = 0;
    const float* x; float* o;
    HDM void put4(int row, int col, const float* a) const { const float al = dn_alpha(); const f4v xr = *(const f4v*)(x + (size_t)row * DM + col);
        f4v r; for (int j = 0; j < 4; ++j) r[j] = al * xr[j] + a[j]; *(f4v*)(o + (size_t)row * DM + col) = r; }
};
struct EpiH {
    static constexpr bool PERM = true; static constexpr int MODE = 1;
    bf16_t* o;
    HDM void put8gu(int row, int hcol, const float* g, const float* u) const { float v[8]; for (int j = 0; j < 8; ++j) v[j] = siluf_(g[j]) * u[j];
        st8bf(o + (size_t)row * DEXP + hcol, v); }
};
struct EpiY {
    static constexpr bool PERM = true; static constexpr int MODE = 0;
    const int* rowinfo; const float* rowgate; bf16_t* o;
    HDM void put8(int row, int col, const float* a) const { const int ent = rowinfo[row]; if (ent < 0) return; const float g = rowgate[row];
        float v[8]; for (int j = 0; j < 8; ++j) v[j] = g * a[j]; st8bf(o + (size_t)ent * DM + col, v); }
};
struct EpiPre2 {
    static constexpr bool PERM = false; static constexpr int MODE = 0;
    const float* x1; const bf16_t* ybuf; const bf16_t* pp; const float* bg; float* o;
    HDM void put4(int row, int col, const float* a) const { const float al = dn_alpha(); const size_t i = (size_t)row * DM + col;
        const f4v xr = *(const f4v*)(x1 + i); const f4v bgv = *(const f4v*)(bg + col);
        const unsigned* y0 = (const unsigned*)(ybuf + (size_t)(2 * row) * DM + col); const unsigned* y1 = (const unsigned*)(ybuf + (size_t)(2 * row + 1) * DM + col); const unsigned* pq = (const unsigned*)(pp + i);
        const unsigned y00 = y0[0], y01 = y0[1], y10 = y1[0], y11 = y1[1], p0 = pq[0], p1 = pq[1];
        float yv[4] = { __builtin_bit_cast(float, y00 << 16) + __builtin_bit_cast(float, y10 << 16), __builtin_bit_cast(float, y00 & 0xffff0000u) + __builtin_bit_cast(float, y10 & 0xffff0000u),
                        __builtin_bit_cast(float, y01 << 16) + __builtin_bit_cast(float, y11 << 16), __builtin_bit_cast(float, y01 & 0xffff0000u) + __builtin_bit_cast(float, y11 & 0xffff0000u) };
        float pv[4] = { __builtin_bit_cast(float, p0 << 16), __builtin_bit_cast(float, p0 & 0xffff0000u), __builtin_bit_cast(float, p1 << 16), __builtin_bit_cast(float, p1 & 0xffff0000u) };
        f4v r; for (int j = 0; j < 4; ++j) r[j] = al * xr[j] + yv[j] + sigmoidf_(a[j] + bgv[j]) * pv[j];
        *(f4v*)(o + i) = r; }
};

#ifndef CPU_TEST
struct EpiQ {
    static constexpr bool PERM = true; static constexpr int MODE = 0;
    const float* rope; bf16_t* o;
    __device__ __forceinline__ void put8(int row, int col, const float* a) const {
        float p[8];
#pragma unroll
        for (int j = 0; j < 8; ++j) p[j] = __shfl_xor(a[j], 32);
        if (col >= 384) return;
        const float qscale = 0.10206207261596575f * 1.4426950408889634f;
        const int d0 = col % 96; float v[8];
        if (d0 < 64) {
#pragma unroll
            for (int j = 0; j < 8; ++j) v[j] = a[j] * qscale; }
        else { const int i0 = (d0 - 64) & 15; const bool x2 = (d0 - 64) >= 16; const float* rt = rope + (size_t)row * 32 + i0;
            const f4v c0 = *(const f4v*)rt, c1 = *(const f4v*)(rt + 4), s0 = *(const f4v*)(rt + 16), s1 = *(const f4v*)(rt + 20);
#pragma unroll
            for (int j = 0; j < 8; ++j) { const float c = j < 4 ? c0[j & 3] : c1[j & 3], s = j < 4 ? s0[j & 3] : s1[j & 3];
                v[j] = (x2 ? (p[j] * s + a[j] * c) : (a[j] * c - p[j] * s)) * qscale; } }
        st8bf(o + (size_t)row * 384 + col, v); }
};
struct EpiKV {
    static constexpr bool PERM = true; static constexpr int MODE = 0;
    bf16_t* k; bf16_t* v;
    __device__ __forceinline__ void put8(int row, int col, const float* a) const { const int h = col >> 7, d = col & 127;
        if (d < 64) st8bf(k + (size_t)row * 384 + h * 96 + d, a); else st8bf(v + (size_t)row * 256 + h * 64 + (d - 64), a); }
};
__device__ __forceinline__ void mla_token_pass(CtxRef C, int gw, int ngw, int lane) {
    const bf16_t* u = WSP(bf16_t, WS_U); const float* rope = WSP(float, WS_ROPE); float* rstd = WSP(float, WS_RSTD); bf16_t* K = WSP(bf16_t, WS_AK);
    for (int t = gw; t < T; t += ngw) {
        const bf16_t* ur = u + (size_t)t * DINP;
        float ssq = 0.f, sskv = 0.f;
        { const unsigned* p = (const unsigned*)(ur + UD_CQ) + 2 * lane; const unsigned w0 = p[0], w1 = p[1];
          const float a = __builtin_bit_cast(float, w0 << 16), b = __builtin_bit_cast(float, w0 & 0xffff0000u), c = __builtin_bit_cast(float, w1 << 16), d = __builtin_bit_cast(float, w1 & 0xffff0000u);
          ssq = (a * a + b * b) + (c * c + d * d); }
        { const unsigned w0 = ((const unsigned*)(ur + UD_CKV))[lane]; const float a = __builtin_bit_cast(float, w0 << 16), b = __builtin_bit_cast(float, w0 & 0xffff0000u); sskv = a * a + b * b; }
        ssq = wave_sum(ssq); sskv = wave_sum(sskv);
        if (lane == 0) { rstd[(size_t)t * 2] = 1.f / sqrtf(ssq * (1.f / 256.f) + NORM_EPS); rstd[(size_t)t * 2 + 1] = 1.f / sqrtf(sskv * (1.f / 128.f) + NORM_EPS); }
        { const int i = lane & 15, hh = lane >> 4; const float x1 = bf2f(ur[UD_KR + i]), x2 = bf2f(ur[UD_KR + 16 + i]); const float c = rope[(size_t)t * 32 + i], s = rope[(size_t)t * 32 + 16 + i];
          bf16_t* kd = K + (size_t)t * 384 + hh * 96 + 64; kd[i] = f2bf(x1 * c - x2 * s); kd[16 + i] = f2bf(x1 * s + x2 * c); }
    }
}
__device__ __forceinline__ void rwkv_prep_coop(CtxRef C, int l, __attribute__((address_space(3))) unsigned char* lds) {
    int tid = threadIdx.x; asm volatile("" : "+v"(tid));
    const int lane = tid & 63, w = __builtin_amdgcn_readfirstlane(tid >> 6);
    const bf16_t* u = WSP(bf16_t, WS_U);
    const float* mu = INF(I_MU) + l * DINA;
    float* oR = WSP(float, WS_RW_R); float* oW = WSP(float, WS_RW_W); float* oK = WSP(float, WS_RW_K); float* oV = WSP(float, WS_RW_V);
    float* oA = WSP(float, WS_RW_A); float* oB = WSP(float, WS_RW_B); float* oG = WSP(float, WS_RW_G);
    __attribute__((address_space(3))) float* act = (__attribute__((address_space(3))) float*)lds;
    const int h = w & 3, role = w >> 2, c = h * 64 + lane;
    float wc0[32], wc1[32];
    { const float* p0 = role == 0 ? INF(I_WUP) + l * 32 * GW + c : INF(I_GUP) + l * 64 * GW + c;
      const float* p1 = role == 0 ? INF(I_AUP) + l * 32 * GW + c : INF(I_GUP) + l * 64 * GW + 32 * GW + c;
#pragma unroll
      for (int j = 0; j < 32; ++j) { wc0[j] = p0[j * GW]; wc1[j] = p1[j * GW]; } }
    const float w0c = INF(I_W0)[l * GW + c], a0c = INF(I_A0)[l * GW + c], kkc = INF(I_KK)[l * GW + c], kac = INF(I_KA)[l * GW + c];
    const float mur = mu[UA_R + c], muk = mu[UA_K + c], muv = mu[UA_V + c];
    for (int unit = blockIdx.x; unit < T / 16; unit += gridDim.x) {
        const int t0 = unit * 16;
        { const int tk = tid >> 5, j0 = (tid & 31) * 4; const int t = t0 + tk; const bool first = (t % SEQ) == 0;
          const unsigned* pc = (const unsigned*)(u + (size_t)t * DINP + UA_WD + j0); const unsigned c0 = pc[0], c1 = pc[1];
          unsigned q0 = 0u, q1 = 0u; if (!first) { const unsigned* pp = (const unsigned*)(u + (size_t)(t - 1) * DINP + UA_WD + j0); q0 = pp[0]; q1 = pp[1]; }
          const float cur[4] = {__builtin_bit_cast(float, c0 << 16), __builtin_bit_cast(float, c0 & 0xffff0000u), __builtin_bit_cast(float, c1 << 16), __builtin_bit_cast(float, c1 & 0xffff0000u)};
          const float prv[4] = {__builtin_bit_cast(float, q0 << 16), __builtin_bit_cast(float, q0 & 0xffff0000u), __builtin_bit_cast(float, q1 << 16), __builtin_bit_cast(float, q1 & 0xffff0000u)};
          f4v o;
#pragma unroll
          for (int j = 0; j < 4; ++j) { const float v = cur[j] + (prv[j] - cur[j]) * mu[UA_WD + j0 + j]; o[j] = (j0 < 32) ? tanhf(v) : (j0 < 64 ? v : sigmoidf_(v)); }
          *(__attribute__((address_space(3))) f4v*)(act + tk * 128 + j0) = o; }
        __syncthreads();
#pragma unroll 1
        for (int tk = 0; tk < 16; ++tk) { const int t = t0 + tk; const bool first = (t % SEQ) == 0;
            const __attribute__((address_space(3))) float* ar = act + tk * 128 + (role == 0 ? 0 : 64);
            float s0 = 0.f, s1 = 0.f;
#pragma unroll
            for (int j = 0; j < 32; j += 4) { const f4v x = *(const __attribute__((address_space(3))) f4v*)(ar + j), y = *(const __attribute__((address_space(3))) f4v*)(ar + 32 + j);
                s0 += x[0] * wc0[j] + x[1] * wc0[j + 1] + x[2] * wc0[j + 2] + x[3] * wc0[j + 3]; s1 += y[0] * wc1[j] + y[1] * wc1[j + 1] + y[2] * wc1[j + 2] + y[3] * wc1[j + 3];
                if ((j & 12) == 12) asm volatile("" ::: "memory"); }
            const size_t o = (size_t)t * GW + c;
            if (role == 1) { oG[o] = s0 + s1; }
            else {
                const float z = w0c + s0, za = a0c + s1;
                const float lnl = -softplusf_(-z) - 0.5f; const float decay = __expf(-__expf(lnl)); const float a = sigmoidf_(za);
                const bf16_t* uc = u + (size_t)t * DINP + c; const bf16_t* up = uc - DINP;
                const float rc = bf2f(uc[UA_R]), kc = bf2f(uc[UA_K]), vc = bf2f(uc[UA_V]);
                const float rp = first ? 0.f : bf2f(up[UA_R]), kp = first ? 0.f : bf2f(up[UA_K]), vp = first ? 0.f : bf2f(up[UA_V]);
                const float r = rc + (rp - rc) * mur, k = kc + (kp - kc) * muk, v = vc + (vp - vc) * muv;
                const float kkraw = k * kkc; const float ss = wave_sum(kkraw * kkraw); const float kk = kkraw / fmaxf(sqrtf(ss), 1e-12f);
                oR[o] = r; oW[o] = decay; oK[o] = k * (1.f + (a - 1.f) * kac); oV[o] = v; oA[o] = -kk; oB[o] = kk * a; } }
        __syncthreads();
    }
}
#endif

#ifndef CPU_TEST
template <int NT> __device__ __forceinline__ void ln_rows_v(const float* src, const float* g, const float* b, float* dstf, bf16_t* dstb, int lane) {
    f4v x[NT][4];
#pragma unroll
    for (int n = 0; n < NT; ++n)
#pragma unroll
        for (int i = 0; i < 4; ++i) x[n][i] = *(const f4v*)(src + (size_t)n * DM + (i * 64 + lane) * 4);
    float mean[NT], rstd[NT];
#pragma unroll
    for (int n = 0; n < NT; ++n) { float s = 0.f;
#pragma unroll
        for (int i = 0; i < 4; ++i) s += (x[n][i][0] + x[n][i][1]) + (x[n][i][2] + x[n][i][3]);
        mean[n] = wave_sum(s) * (1.f / DM); float q = 0.f;
#pragma unroll
        for (int i = 0; i < 4; ++i) { x[n][i] = x[n][i] - mean[n]; q += (x[n][i][0] * x[n][i][0] + x[n][i][1] * x[n][i][1]) + (x[n][i][2] * x[n][i][2] + x[n][i][3] * x[n][i][3]); }
        rstd[n] = 1.f / sqrtf(wave_sum(q) * (1.f / DM) + LN_EPS); }
#pragma unroll
    for (int i = 0; i < 4; ++i) { const int c = (i * 64 + lane) * 4; const f4v gv = *(const f4v*)(g + c), bv = *(const f4v*)(b + c);
#pragma unroll
        for (int n = 0; n < NT; ++n) { const f4v y = x[n][i] * rstd[n] * gv + bv; *(f4v*)(dstf + (size_t)n * DM + c) = y;
            *(unsigned long long*)(dstb + (size_t)n * DM + c) = (unsigned long long)pk2(y[0], y[1]) | ((unsigned long long)pk2(y[2], y[3]) << 32); } }
}
__device__ __forceinline__ void stage_ln2_v(CtxRef C, int l, int gw, int ngw, int lane) {
    const float* src = WSP(float, WS_X); float* dst = (l == DEPTH - 1) ? C.out : WSP(float, WS_X); bf16_t* xb = WSP(bf16_t, WS_XB);
    const float* g = INF(I_LN2G) + l * DM; const float* b = INF(I_LN2B) + l * DM;
    for (int t = gw * 2; t < T; t += ngw * 2) ln_rows_v<2>(src + (size_t)t * DM, g, b, dst + (size_t)t * DM, xb + (size_t)t * DM, lane);
}
__device__ __forceinline__ float row_sum16(float v) { v += dpp_f(v, 0); v += dpp_f(v, 1); v += dpp_f(v, 2); v += dpp_f(v, 3); return v; }
__device__ __forceinline__ void stage_post_v(CtxRef C, int l, int gw, int ngw, int lane) {
    const bf16_t* u = WSP(bf16_t, WS_U); bf16_t* mix = WSP(bf16_t, WS_MIX);
    const float* YA = WSP(float, WS_YA); const float* YB = WSP(float, WS_YB); const float* YC = WSP(float, WS_YC); const float* DEN = WSP(float, WS_DEN);
    const float* BON = WSP(float, WS_RW_BON); const bf16_t* VS = WSP(bf16_t, WS_RW_VS); const bf16_t* GG = WSP(bf16_t, WS_RW_GG);
    const int h = lane >> 4, c = lane * 4;
    const f4v gng = *(const f4v*)(INF(I_GNG) + l * GW + c), gnb = *(const f4v*)(INF(I_GNB) + l * GW + c), glag = *(const f4v*)(INF(I_GLA_G) + l * GW + c), mlng = *(const f4v*)(INF(I_MLN_G) + l * GW + c);
#pragma unroll 2
    for (int t = gw; t < T; t += ngw) {
        const size_t o = (size_t)t * GW + c;
        const f4v ya = *(const f4v*)(YA + o), yb = *(const f4v*)(YB + o), yc = *(const f4v*)(YC + o);
        const unsigned long long wg = *(const unsigned long long*)(GG + o), wv = *(const unsigned long long*)(VS + o);
        const unsigned long long wgate = *(const unsigned long long*)(u + (size_t)t * DINP + UB_G + c), wo = *(const unsigned long long*)(u + (size_t)t * DINP + UC_O + c);
        const float bon = BON[(size_t)t * 4 + h], den = DEN[(size_t)t * 4 + h];
#define UNP4(w_, a_) const float a_[4] = {__builtin_bit_cast(float, (unsigned)(w_) << 16), __builtin_bit_cast(float, (unsigned)(w_) & 0xffff0000u), __builtin_bit_cast(float, (unsigned)((w_) >> 32) << 16), __builtin_bit_cast(float, (unsigned)((w_) >> 32) & 0xffff0000u)}
        UNP4(wg, g4); UNP4(wv, v4); UNP4(wgate, gate4); UNP4(wo, o4);
#undef UNP4
        float oa[4], ob[4], oc[4];
        {   const float mean = row_sum16((ya[0] + ya[1]) + (ya[2] + ya[3])) * (1.f / 64.f); const f4v d = ya - mean;
            const float rstd = 1.f / sqrtf(row_sum16((d[0] * d[0] + d[1] * d[1]) + (d[2] * d[2] + d[3] * d[3])) * (1.f / 64.f) + RWKV_GN_EPS);
#pragma unroll
            for (int j = 0; j < 4; ++j) oa[j] = (d[j] * rstd * gng[j] + gnb[j] + bon * v4[j]) * g4[j]; }
        {   const float rstd = 1.f / sqrtf(row_sum16((yb[0] * yb[0] + yb[1] * yb[1]) + (yb[2] * yb[2] + yb[3] * yb[3])) * (1.f / 64.f) + NORM_EPS);
#pragma unroll
            for (int j = 0; j < 4; ++j) ob[j] = yb[j] * rstd * glag[j] * siluf_(gate4[j]); }
        {   const float dinv = 1.f / fmaxf(fabsf(den), 1.f); const f4v y = yc * dinv;
            const float mean = row_sum16((y[0] + y[1]) + (y[2] + y[3])) * (1.f / 64.f); const f4v d = y - mean;
            const float rstd = 1.f / sqrtf(row_sum16((d[0] * d[0] + d[1] * d[1]) + (d[2] * d[2] + d[3] * d[3])) * (1.f / 64.f) + LN_EPS);
#pragma unroll
            for (int j = 0; j < 4; ++j) oc[j] = d[j] * rstd * mlng[j] * sigmoidf_(o4[j]); }
        bf16_t* m = mix + (size_t)t * DMIX + c;
        *(unsigned long long*)m = (unsigned long long)pk2(oa[0], oa[1]) | ((unsigned long long)pk2(oa[2], oa[3]) << 32);
        *(unsigned long long*)(m + 256) = (unsigned long long)pk2(ob[0], ob[1]) | ((unsigned long long)pk2(ob[2], ob[3]) << 32);
        *(unsigned long long*)(m + 512) = (unsigned long long)pk2(oc[0], oc[1]) | ((unsigned long long)pk2(oc[2], oc[3]) << 32);
    }
}
__device__ __forceinline__ void stage_gather_v(CtxRef C, int l, int gw, int ngw, int lane) {
    const unsigned* cnt = WSP(unsigned, WS_CTL) + CW_CNT + l * NEXP * 64;
    const int* list = WSP(int, WS_LIST); const int* tokinfo = WSP(int, WS_TOKINFO);
    const bf16_t* xb = WSP(bf16_t, WS_XB); bf16_t* xg = WSP(bf16_t, WS_XG); int* rowinfo = WSP(int, WS_ROWINFO); float* rowgate = WSP(float, WS_ROWGATE);
    int e, be, ce; const int total = moe_lookup(cnt, 0, e, be, ce);
    for (int r0 = gw * 64; r0 < total; r0 += ngw * 64) {
        moe_lookup(cnt, r0, e, be, ce);
        const int slot = r0 - be + lane; int ent = -1; float gate = 0.f;
        if (slot < ce) { ent = list[(size_t)e * T + slot]; gate = ((const float*)tokinfo)[(size_t)(ent >> 1) * 4 + 2 + (ent & 1)]; }
        rowinfo[r0 + lane] = ent; rowgate[r0 + lane] = gate;
#pragma unroll 4
        for (int r = 0; r < 64; ++r) { const int en = __builtin_amdgcn_readlane(ent, r); bf16_t* d = xg + (size_t)(r0 + r) * DM + lane * 8;
            if (en >= 0) { const bf16_t* s = xb + (size_t)(en >> 1) * DM + lane * 8; const u4v a = *(const u4v*)s, b2 = *(const u4v*)(s + 512); *(u4v*)d = a; *(u4v*)(d + 512) = b2; }
            else { const u4v z = {0u, 0u, 0u, 0u}; *(u4v*)d = z; *(u4v*)(d + 512) = z; } }
    }
}
__device__ __forceinline__ void ln1_router_coop(CtxRef C, int l, __attribute__((address_space(3))) unsigned char* lds) {
    int tid = threadIdx.x; asm volatile("" : "+v"(tid));
    const int lane = tid & 63, w = __builtin_amdgcn_readfirstlane(tid >> 6);
    float* X1 = C.out; bf16_t* xb = WSP(bf16_t, WS_XB);
    const float* g = INF(I_LN1G) + l * DM; const float* b = INF(I_LN1B) + l * DM;
    const float* wrg = INF(I_WRG) + (size_t)l * DM * NGRP; const float* brg = INF(I_BRG) + l * NGRP;
    const float* wre = INF(I_WRE) + (size_t)l * DM * NEXP; const float* bre = INF(I_BRE) + l * NEXP;
    unsigned* cnt = WSP(unsigned, WS_CTL) + CW_CNT + l * NEXP * 64;
    int* tokinfo = WSP(int, WS_TOKINFO); int* list = WSP(int, WS_LIST);
    __attribute__((address_space(3))) float* part = (__attribute__((address_space(3))) float*)lds;
    for (int tb0 = blockIdx.x * 128; tb0 < T; tb0 += gridDim.x * 128) {
        for (int i = 0; i < 16; i += 2) { const int t = tb0 + w * 16 + i;
            ln_rows_v<2>(X1 + (size_t)t * DM, g, b, X1 + (size_t)t * DM, xb + (size_t)t * DM, lane); }
        asm volatile("s_waitcnt vmcnt(0)" ::: "memory");
        __syncthreads();
        for (int half = 0; half < 2; ++half) {
            const int t = tb0 + half * 64 + lane;
            float acc[36];
#pragma unroll
            for (int j = 0; j < 36; ++j) acc[j] = 0.f;
            const float* xr = X1 + (size_t)t * DM + 128 * w;
#pragma unroll 1
            for (int k4 = 0; k4 < 32; ++k4) {
                const f4v x = *(const f4v*)(xr + 4 * k4);
#pragma unroll
                for (int kk = 0; kk < 4; ++kk) { const int k = 128 * w + 4 * k4 + kk;
                    typedef __attribute__((address_space(4))) const float cfl; cfl* we = (cfl*)(wre + (size_t)k * NEXP); cfl* wg = (cfl*)(wrg + (size_t)k * NGRP);
#pragma unroll
                    for (int j = 0; j < 4; ++j) acc[j] += x[kk] * wg[j];
#pragma unroll
                    for (int j = 0; j < 32; ++j) acc[4 + j] += x[kk] * we[j]; } }
#pragma unroll
            for (int j = 0; j < 36; ++j) part[(w * 36 + j) * 64 + lane] = acc[j];
            __syncthreads();
            if (w == 0) {
                float lg[NGRP], le[NEXP];
#pragma unroll
                for (int j = 0; j < NGRP; ++j) { float s = brg[j];
#pragma unroll
                    for (int ww = 0; ww < 8; ++ww) s += part[(ww * 36 + j) * 64 + lane]; lg[j] = s; }
#pragma unroll
                for (int j = 0; j < NEXP; ++j) { float s = bre[j];
#pragma unroll
                    for (int ww = 0; ww < 8; ++ww) s += part[(ww * 36 + 4 + j) * 64 + lane]; le[j] = s; }
                int gi = 0; float gm = lg[0];
#pragma unroll
                for (int j = 1; j < NGRP; ++j) if (lg[j] > gm) { gm = lg[j]; gi = j; }
                float gs = 0.f;
#pragma unroll
                for (int j = 0; j < NGRP; ++j) gs += expf(lg[j] - gm);
                const float group_p = 1.f / gs;
                float el[EPG];
#pragma unroll
                for (int j = 0; j < EPG; ++j) { float v = le[j];
#pragma unroll
                    for (int g2 = 1; g2 < NGRP; ++g2) v = (gi == g2) ? le[g2 * EPG + j] : v;
                    el[j] = v; }
                int e0 = 0; float m0 = el[0];
#pragma unroll
                for (int j = 1; j < EPG; ++j) if (el[j] > m0) { m0 = el[j]; e0 = j; }
                int e1 = -1; float m1 = -3.0e38f;
#pragma unroll
                for (int j = 0; j < EPG; ++j) if (j != e0 && el[j] > m1) { m1 = el[j]; e1 = j; }
                const float p1 = expf(m1 - m0); const float g0 = group_p / (1.f + p1), g1 = group_p * p1 / (1.f + p1);
                const int E0 = gi * EPG + e0, E1 = gi * EPG + e1;
                tokinfo[(size_t)t * 4 + 0] = E0; tokinfo[(size_t)t * 4 + 1] = E1;
                ((float*)tokinfo)[(size_t)t * 4 + 2] = g0; ((float*)tokinfo)[(size_t)t * 4 + 3] = g1;
                const unsigned s0 = atomicAdd(cnt + E0 * 64, 1u); list[(size_t)E0 * T + s0] = t * 2 + 0;
                const unsigned s1 = atomicAdd(cnt + E1 * 64, 1u); list[(size_t)E1 * T + s1] = t * 2 + 1;
            }
            __syncthreads();
        }
    }
}
#endif

#ifndef CPU_TEST
namespace pg8 {
#define PG8_LAS __attribute__((address_space(3)))
typedef short bf16x8 __attribute__((ext_vector_type(8)));
typedef float f32x4 __attribute__((ext_vector_type(4)));
constexpr int BM = 256, BK = 64, HALF = 128, HTB = HALF * BK * 2, STAGE_BYTES = 8 * HTB;
__device__ __forceinline__ int lds_byte(int r, int c) { const int st = (r >> 4) * 2 + (c >> 5), rr = r & 15, cc = c & 31, ob = rr * 64 + cc * 2; return st * 1024 + (ob ^ (((ob >> 9) & 1) << 5)); }
__device__ __forceinline__ void stage_rc(int b, int& R, int& C) { const int st = b / 1024, sb = b % 1024, swz = sb ^ (((sb >> 9) & 1) << 5); R = (st >> 1) * 16 + swz / 64; C = (st & 1) * 32 + (swz % 64) / 2; }
__device__ __forceinline__ int perm32(int rho) { const int n = rho >> 4, i = rho & 15; return 8 * (i >> 2) + 4 * n + (i & 3); }
struct Unit { int pm, pn; long aoff, boff; };
struct Gemm { const bf16_t* A; const bf16_t* Bt; int lda, ldb, K; };

template <class F> __device__ __forceinline__ void run_epi(const F& f, const f32x4 (&acc)[2][2][4][2], const Unit& u, int wr, int wc, int fr, int fq) {
#pragma unroll
    for (int ai = 0; ai < 2; ++ai)
#pragma unroll
        for (int m = 0; m < 4; ++m) { const int row = u.pm * BM + ai * HALF + wr * 64 + m * 16 + fr;
            if constexpr (F::MODE == 1) { const int hcol = u.pn * 128 + wc * 32 + 8 * fq; float g[8], up[8];
#pragma unroll
                for (int j = 0; j < 4; ++j) { g[j] = acc[ai][0][m][0][j]; g[4 + j] = acc[ai][0][m][1][j]; up[j] = acc[ai][1][m][0][j]; up[4 + j] = acc[ai][1][m][1][j]; }
                f.put8gu(row, hcol, g, up); }
            else if constexpr (F::PERM) {
#pragma unroll
                for (int bj = 0; bj < 2; ++bj) { const int col = u.pn * BM + bj * HALF + wc * 32 + 8 * fq; float a[8];
#pragma unroll
                    for (int j = 0; j < 4; ++j) { a[j] = acc[ai][bj][m][0][j]; a[4 + j] = acc[ai][bj][m][1][j]; }
                    f.put8(row, col, a); } }
            else {
#pragma unroll
                for (int bj = 0; bj < 2; ++bj)
#pragma unroll
                    for (int n = 0; n < 2; ++n) { const int col = u.pn * BM + bj * HALF + wc * 32 + 16 * n + 4 * fq; float a[4];
#pragma unroll
                        for (int j = 0; j < 4; ++j) a[j] = acc[ai][bj][m][n][j];
                        f.put4(row, col, a); } }
        }
}

template <class Epi, class Sched>
__device__ __forceinline__ void gemm_phase(PG8_LAS unsigned char* lds, const Gemm g, const Sched& S, const Epi& E) {
    int tid = threadIdx.x; asm volatile("" : "+v"(tid));
    const int wid = __builtin_amdgcn_readfirstlane(tid >> 6), lane = tid & 63, wr = wid >> 2, wc = wid & 3, fr = lane & 15, fq = lane >> 4;
    const int K = g.K, nt = K / BK;
    unsigned voffA[2], voffB[2];
#pragma unroll
    for (int i = 0; i < 2; ++i) { int R, C; stage_rc(tid * 16 + i * 8192, R, C); const int Rb = Epi::PERM ? ((R & ~31) + perm32(R & 31)) : R;
        voffA[i] = (unsigned)(R * g.lda + C) * 2u; voffB[i] = (unsigned)(Rb * g.ldb + C) * 2u; }
    const size_t kstep = (size_t)(BK * 2);
    const size_t hstepA = (size_t)HALF * g.lda * 2, hstepB = (size_t)HALF * g.ldb * 2;
    const unsigned ldsw = (unsigned)wid * 1024u;
    const int aoff = lds_byte(wr * 64 + fr, fq * 8), boff = lds_byte(wc * 32 + fr, fq * 8);
#define PG8_SA(b, h) (((b) * 2 + (h)) * HTB)
#define PG8_SB(b, h) ((4 + (b) * 2 + (h)) * HTB)
#define PG8_STAGE(bufoff, gbase, voff) do { _Pragma("unroll") for (int _i = 0; _i < 2; ++_i) \
        __builtin_amdgcn_global_load_lds((const unsigned*)((const char*)(gbase) + (voff)[_i]), (PG8_LAS unsigned*)(lds + (bufoff) + ldsw + _i * 8192), 16, 0, 0); } while (0)
#define PG8_LDA(dst, b, h) do { _Pragma("unroll") for (int m = 0; m < 4; ++m) _Pragma("unroll") for (int k = 0; k < 2; ++k) dst[m][k] = *(const PG8_LAS bf16x8*)(lds + PG8_SA(b, h) + aoff + m * 2048 + k * 1024); } while (0)
#define PG8_LDB(dst, b, h) do { _Pragma("unroll") for (int n = 0; n < 2; ++n) _Pragma("unroll") for (int k = 0; k < 2; ++k) dst[n][k] = *(const PG8_LAS bf16x8*)(lds + PG8_SB(b, h) + boff + n * 2048 + k * 1024); } while (0)
#define PG8_MMA(ai, bj, At, Bt) do { __builtin_amdgcn_s_setprio(1); _Pragma("unroll") for (int m = 0; m < 4; ++m) _Pragma("unroll") for (int n = 0; n < 2; ++n) _Pragma("unroll") for (int k = 0; k < 2; ++k) \
        acc[ai][bj][m][n] = __builtin_amdgcn_mfma_f32_16x16x32_bf16(Bt[n][k], At[m][k], acc[ai][bj][m][n], 0, 0, 0); __builtin_amdgcn_s_setprio(0); } while (0)
#define PG8_WAIT_V(n) asm volatile("s_waitcnt vmcnt(" #n ")" ::: "memory")
#define PG8_WAIT_L(n) asm volatile("s_waitcnt lgkmcnt(" #n ")" ::: "memory")
#define PG8_BAR __builtin_amdgcn_s_barrier()
#define PG8_SCHED __builtin_amdgcn_sched_barrier(0)
    Unit cur, nxt; int ui = 0;
    if (!S.next(0, cur)) return;
    f32x4 acc[2][2][4][2];
#pragma unroll
    for (int a = 0; a < 2; ++a)
#pragma unroll
        for (int b = 0; b < 2; ++b)
#pragma unroll
            for (int m = 0; m < 4; ++m)
#pragma unroll
                for (int n = 0; n < 2; ++n) acc[a][b][m][n] = (f32x4){0.f, 0.f, 0.f, 0.f};
    bf16x8 At[4][2], B0[2][2], B1[2][2];
    const char* cA = (const char*)g.A + cur.aoff; const char* cB = (const char*)g.Bt + cur.boff;
    PG8_STAGE(PG8_SB(0, 0), cB, voffB); PG8_STAGE(PG8_SB(0, 1), cB + hstepB, voffB); PG8_STAGE(PG8_SA(0, 0), cA, voffA); PG8_STAGE(PG8_SA(0, 1), cA + hstepA, voffA);
    if (wr == 1) PG8_BAR;
    PG8_WAIT_V(2); PG8_BAR;
    PG8_STAGE(PG8_SB(1, 0), cB + kstep, voffB); PG8_STAGE(PG8_SA(1, 0), cA + kstep, voffA); PG8_STAGE(PG8_SB(1, 1), cB + hstepB + kstep, voffB);
    PG8_WAIT_V(6); PG8_BAR;
    for (;;) {
        const bool has_next = S.next(ui + 1, nxt);
        const char* nA = has_next ? (const char*)g.A + nxt.aoff : cA; const char* nB = has_next ? (const char*)g.Bt + nxt.boff : cB;
_Pragma("unroll 1")
        for (int t = 0; t < nt; t += 2) {
            const bool last = (t == nt - 2);
            const char* a1 = cA + (size_t)(t + 1) * kstep;
            const char* a2 = last ? nA : cA + (size_t)(t + 2) * kstep; const char* b2 = last ? nB : cB + (size_t)(t + 2) * kstep;
            const char* a3 = a2 + kstep; const char* b3 = b2 + kstep;
            PG8_LDB(B0, 0, 0); PG8_LDB(B1, 0, 1); PG8_SCHED; PG8_LDA(At, 0, 0); PG8_STAGE(PG8_SA(1, 1), a1 + hstepA, voffA);
            PG8_WAIT_V(8); PG8_WAIT_L(0); PG8_BAR; PG8_MMA(0, 0, At, B0); PG8_MMA(0, 1, At, B1); PG8_BAR; PG8_SCHED;
            PG8_LDA(At, 0, 1); PG8_STAGE(PG8_SB(0, 0), b2, voffB); PG8_STAGE(PG8_SB(0, 1), b2 + hstepB, voffB); PG8_STAGE(PG8_SA(0, 0), a2, voffA);
            PG8_WAIT_V(8); PG8_WAIT_L(0); PG8_BAR; PG8_MMA(1, 0, At, B0); PG8_MMA(1, 1, At, B1); PG8_BAR; PG8_SCHED;
            PG8_LDB(B0, 1, 0); PG8_LDB(B1, 1, 1); PG8_SCHED; PG8_LDA(At, 1, 0); PG8_STAGE(PG8_SA(0, 1), a2 + hstepA, voffA);
            PG8_WAIT_V(8); PG8_WAIT_L(0); PG8_BAR; PG8_MMA(0, 0, At, B0); PG8_MMA(0, 1, At, B1); PG8_BAR; PG8_SCHED;
            PG8_LDA(At, 1, 1); PG8_STAGE(PG8_SB(1, 0), b3, voffB); PG8_STAGE(PG8_SB(1, 1), b3 + hstepB, voffB); PG8_STAGE(PG8_SA(1, 0), a3, voffA);
            PG8_WAIT_V(8); PG8_WAIT_L(0); PG8_BAR; PG8_MMA(1, 0, At, B0); PG8_MMA(1, 1, At, B1); PG8_BAR; PG8_SCHED;
        }
        if (wr == 0) PG8_BAR;
        run_epi(E, acc, cur, wr, wc, fr, fq);
        if (!has_next) break;
#pragma unroll
        for (int a = 0; a < 2; ++a)
#pragma unroll
            for (int b = 0; b < 2; ++b)
#pragma unroll
                for (int m = 0; m < 4; ++m)
#pragma unroll
                    for (int n = 0; n < 2; ++n) acc[a][b][m][n] = (f32x4){0.f, 0.f, 0.f, 0.f};
        cur = nxt; cA = nA; cB = nB; ++ui;
        if (wr == 1) PG8_BAR;
    }
    PG8_WAIT_V(0);
    PG8_BAR;
#undef PG8_SA
#undef PG8_SB
#undef PG8_STAGE
#undef PG8_LDA
#undef PG8_LDB
#undef PG8_MMA
#undef PG8_WAIT_V
#undef PG8_WAIT_L
#undef PG8_BAR
#undef PG8_SCHED
}
struct DenseOrder {
    int nM, nN, G, c; long astep, bstep;
    __device__ __forceinline__ bool next(int i, Unit& u) const {
        const long L = (long)i * G + c; if (L >= (long)nM * nN) return false;
        const int w = (int)L; const int nig = 8 * nN, gid = w / nig, fm = gid * 8, gsz = (nM - fm) < 8 ? (nM - fm) : 8;
        u.pm = fm + ((w % nig) % gsz); u.pn = (w % nig) / gsz; u.aoff = (long)u.pm * astep; u.boff = (long)u.pn * bstep; return true; }
};
struct MoeOrder {
    const PG8_LAS int* tbl; int nM, nN, G, c; long astep, bstep, estep;
    __device__ __forceinline__ bool next(int i, Unit& u) const {
        const long L = (long)i * G + c; if (L >= (long)nM * nN) return false;
        const int w = (int)L; u.pm = w / nN; u.pn = w % nN; const int e = tbl[u.pm];
        u.aoff = (long)u.pm * astep; u.boff = (long)e * estep + (long)u.pn * bstep; return true; }
};
}
#endif

#ifndef CPU_TEST
namespace att {
typedef short bf16x8 __attribute__((ext_vector_type(8)));
typedef short s16x4 __attribute__((ext_vector_type(4)));
typedef float f32x16 __attribute__((ext_vector_type(16)));
typedef float f32x2_t __attribute__((ext_vector_type(2))); typedef __bf16 bf16x2_t __attribute__((ext_vector_type(2)));
typedef unsigned u32x4 __attribute__((ext_vector_type(4)));
typedef unsigned u32x2 __attribute__((ext_vector_type(2)));
#define ATT_LAS __attribute__((address_space(3)))
#define BAR_LDS() asm volatile("s_waitcnt lgkmcnt(0)\n\ts_barrier" ::: "memory")
constexpr int KP = 104, VP = 68;
constexpr int KBUF = 64 * KP * 2, VBUF = 64 * VP * 2;
constexpr int LDS_NEED = 2 * KBUF + 2 * VBUF;
__device__ __forceinline__ unsigned cvtpk(float lo, float hi) { f32x2_t v = {lo, hi}; bf16x2_t b = __builtin_convertvector(v, bf16x2_t); return __builtin_bit_cast(unsigned, b); }
__device__ __forceinline__ int crow(int r, int hi) { return (r & 3) + 8 * (r >> 2) + 4 * hi; }
__device__ __forceinline__ u32x4 scale8(const u32x4& w, float s) { u32x4 o;
#pragma unroll
    for (int j = 0; j < 4; ++j) o[j] = cvtpk(__builtin_bit_cast(float, w[j] << 16) * s, __builtin_bit_cast(float, w[j] & 0xffff0000u) * s);
    return o; }
__device__ __forceinline__ void unit(ATT_LAS unsigned char* lds, const bf16_t* Q, const bf16_t* K, const bf16_t* V, const float* rstd, bf16_t* mix, int b, int h, int qb) {
    int tid = threadIdx.x; asm volatile("" : "+v"(tid));
    const int lane = tid & 63, w = __builtin_amdgcn_readfirstlane(tid >> 6), r32 = lane & 31, hi = lane >> 5;
    const size_t tb = (size_t)b * SEQ;
    const int q = qb * 256 + w * 32 + r32;
    bf16x8 qr[6];
    { const bf16_t* qrow = Q + (tb + q) * 384 + h * 96 + 8 * hi;
      const float rq = rstd[(tb + q) * 2];
#pragma unroll
      for (int ks = 0; ks < 6; ++ks) qr[ks] = __builtin_bit_cast(bf16x8, scale8(*(const u32x4*)(qrow + 16 * ks), rq)); }
    f32x16 o0, o1;
#pragma unroll
    for (int r = 0; r < 16; ++r) { o0[r] = 0.f; o1[r] = 0.f; }
    float m = -1e30f, lsum = 0.f;
    const int NT = 4 * (qb + 1);
    const int kr0 = tid / 12, kp0 = tid % 12, kr1 = (tid + 512) / 12, kp1 = (tid + 512) % 12; const bool has1 = tid < 256;
    const int vk = tid >> 3, vp = tid & 7;
    const bf16_t* gK0 = K + (tb + kr0) * 384 + h * 96 + kp0 * 8; const bf16_t* gK1 = K + (tb + kr1) * 384 + h * 96 + kp1 * 8;
    const bf16_t* gV = V + (tb + vk) * 256 + h * 64 + vp * 8;
    u32x4 sk0, sk1, sv; sk1 = (u32x4){0u, 0u, 0u, 0u};
    const float* gR0 = rstd + (tb + kr0) * 2 + 1; const float* gR1 = rstd + (tb + kr1) * 2 + 1; const float* gRv = rstd + (tb + vk) * 2 + 1;
    float s0 = gR0[0], s1 = has1 ? gR1[0] : 0.f, s2 = gRv[0];
    sk0 = *(const u32x4*)gK0; if (has1) sk1 = *(const u32x4*)gK1; sv = *(const u32x4*)gV;
#define ATT_WRITE(buf) do { \
        if (kp0 < 8) sk0 = scale8(sk0, s0); if (kp1 < 8) sk1 = scale8(sk1, s1); sv = scale8(sv, s2); \
        *(ATT_LAS u32x4*)(lds + (buf) * KBUF + (kr0 * KP + kp0 * 8) * 2) = sk0; \
        if (has1) *(ATT_LAS u32x4*)(lds + (buf) * KBUF + (kr1 * KP + kp1 * 8) * 2) = sk1; \
        ATT_LAS unsigned short* vt_ = (ATT_LAS unsigned short*)(lds + 2 * KBUF + (buf) * VBUF); \
        _Pragma("unroll") for (int j = 0; j < 4; ++j) { vt_[(8 * vp + 2 * j) * VP + vk] = (unsigned short)(sv[j] & 0xffffu); vt_[(8 * vp + 2 * j + 1) * VP + vk] = (unsigned short)(sv[j] >> 16); } } while (0)
    ATT_WRITE(0);
    BAR_LDS();
    for (int t = 0; t < NT; ++t) {
        const int buf = t & 1;
        if (t + 1 < NT) { const size_t adv = (size_t)(t + 1) * 64; sk0 = *(const u32x4*)(gK0 + adv * 384); if (has1) sk1 = *(const u32x4*)(gK1 + adv * 384); sv = *(const u32x4*)(gV + adv * 256);
            s0 = gR0[adv * 2]; if (has1) s1 = gR1[adv * 2]; s2 = gRv[adv * 2]; }
        f32x16 p0, p1;
#pragma unroll
        for (int r = 0; r < 16; ++r) { p0[r] = 0.f; p1[r] = 0.f; }
        { ATT_LAS const unsigned char* kb = lds + buf * KBUF + (r32 * KP + 8 * hi) * 2;
#pragma unroll
          for (int ks = 0; ks < 6; ++ks) { const bf16x8 a0 = *(ATT_LAS const bf16x8*)(kb + ks * 32), a1 = *(ATT_LAS const bf16x8*)(kb + 32 * KP * 2 + ks * 32);
              p0 = __builtin_amdgcn_mfma_f32_32x32x16_bf16(a0, qr[ks], p0, 0, 0, 0); p1 = __builtin_amdgcn_mfma_f32_32x32x16_bf16(a1, qr[ks], p1, 0, 0, 0); } }
        if (t >= NT - 4) {
            const int k0 = t * 64;
#pragma unroll
            for (int r = 0; r < 16; ++r) { const int kk = k0 + crow(r, hi); if (kk > q) p0[r] = -1e30f; if (kk + 32 > q) p1[r] = -1e30f; } }
        float rm = p0[0];
#pragma unroll
        for (int r = 1; r < 16; ++r) rm = fmaxf(rm, p0[r]);
#pragma unroll
        for (int r = 0; r < 16; ++r) rm = fmaxf(rm, p1[r]);
        rm = fmaxf(rm, __shfl_xor(rm, 32));
        const float mn = fmaxf(m, rm); const float alpha = __builtin_amdgcn_exp2f(m - mn); m = mn;
        float ps = 0.f;
#pragma unroll
        for (int r = 0; r < 16; ++r) { p0[r] = __builtin_amdgcn_exp2f(p0[r] - mn); p1[r] = __builtin_amdgcn_exp2f(p1[r] - mn); ps += p0[r] + p1[r]; }
        lsum = lsum * alpha + ps;
#pragma unroll
        for (int r = 0; r < 16; ++r) { o0[r] *= alpha; o1[r] *= alpha; }
        { ATT_LAS const unsigned char* vb = lds + 2 * KBUF + buf * VBUF + (r32 * VP + 4 * hi) * 2;
#pragma unroll
          for (int s = 0; s < 4; ++s) {
              u32x4 pw;
              if (s == 0) pw = (u32x4){cvtpk(p0[0], p0[1]), cvtpk(p0[2], p0[3]), cvtpk(p0[4], p0[5]), cvtpk(p0[6], p0[7])};
              else if (s == 1) pw = (u32x4){cvtpk(p0[8], p0[9]), cvtpk(p0[10], p0[11]), cvtpk(p0[12], p0[13]), cvtpk(p0[14], p0[15])};
              else if (s == 2) pw = (u32x4){cvtpk(p1[0], p1[1]), cvtpk(p1[2], p1[3]), cvtpk(p1[4], p1[5]), cvtpk(p1[6], p1[7])};
              else pw = (u32x4){cvtpk(p1[8], p1[9]), cvtpk(p1[10], p1[11]), cvtpk(p1[12], p1[13]), cvtpk(p1[14], p1[15])};
              const bf16x8 pb = __builtin_bit_cast(bf16x8, pw);
              const u32x2 a00 = *(ATT_LAS const u32x2*)(vb + s * 32), a01 = *(ATT_LAS const u32x2*)(vb + s * 32 + 16);
              const u32x2 a10 = *(ATT_LAS const u32x2*)(vb + 32 * VP * 2 + s * 32), a11 = *(ATT_LAS const u32x2*)(vb + 32 * VP * 2 + s * 32 + 16);
              const bf16x8 va0 = __builtin_bit_cast(bf16x8, (u32x4){a00[0], a00[1], a01[0], a01[1]}), va1 = __builtin_bit_cast(bf16x8, (u32x4){a10[0], a10[1], a11[0], a11[1]});
              o0 = __builtin_amdgcn_mfma_f32_32x32x16_bf16(va0, pb, o0, 0, 0, 0); o1 = __builtin_amdgcn_mfma_f32_32x32x16_bf16(va1, pb, o1, 0, 0, 0); } }
        if (t + 1 < NT) ATT_WRITE(buf ^ 1);
        BAR_LDS();
    }
#undef ATT_WRITE
    lsum += __shfl_xor(lsum, 32);
    const float inv = 1.f / lsum;
    bf16_t* orow = mix + (tb + q) * DMIX + 768 + h * 64;
#pragma unroll
    for (int rg = 0; rg < 4; ++rg) {
        u32x2 w0 = {cvtpk(o0[4 * rg] * inv, o0[4 * rg + 1] * inv), cvtpk(o0[4 * rg + 2] * inv, o0[4 * rg + 3] * inv)};
        u32x2 w1 = {cvtpk(o1[4 * rg] * inv, o1[4 * rg + 1] * inv), cvtpk(o1[4 * rg + 2] * inv, o1[4 * rg + 3] * inv)};
        *(u32x2*)(orow + 8 * rg + 4 * hi) = w0; *(u32x2*)(orow + 32 + 8 * rg + 4 * hi) = w1; }
}
}
#endif

#ifndef CPU_TEST
namespace lin {
using att::bf16x8; using att::f32x16; using att::u32x4; using att::u32x2; using att::cvtpk; using att::crow;
constexpr int PT = 68;
template <int DK, int NDV> struct Lay {
    static constexpr int PQ = DK + 8;
    static constexpr int OFF_Q = 0, OFF_K = OFF_Q + 64 * PQ * 2, OFF_KH = OFF_K + 64 * PQ * 2, OFF_VT = OFF_KH + DK * PT * 2, OFF_DEC = OFF_VT + NDV * PT * 2, BUF = OFF_DEC + 256;
};
__device__ __forceinline__ bf16x8 ldA16(ATT_LAS const unsigned char* p) { return *(ATT_LAS const bf16x8*)p; }
__device__ __forceinline__ bf16x8 ldP8(ATT_LAS const unsigned char* p) { const u32x2 a = *(ATT_LAS const u32x2*)p, b = *(ATT_LAS const u32x2*)(p + 16); return __builtin_bit_cast(bf16x8, (u32x4){a[0], a[1], b[0], b[1]}); }
__device__ __forceinline__ bf16x8 pack8(const f32x16& x, int s) {
    u32x4 p;
    if (s == 0) p = (u32x4){cvtpk(x[0], x[1]), cvtpk(x[2], x[3]), cvtpk(x[4], x[5]), cvtpk(x[6], x[7])};
    else p = (u32x4){cvtpk(x[8], x[9]), cvtpk(x[10], x[11]), cvtpk(x[12], x[13]), cvtpk(x[14], x[15])};
    return __builtin_bit_cast(bf16x8, p); }
#define MF32(a, b, c) __builtin_amdgcn_mfma_f32_32x32x16_bf16((a), (b), (c), 0, 0, 0)
template <int DK, int NDV> __device__ __forceinline__ void compute(ATT_LAS const unsigned char* B, int ib, int dvb, int r32, int hi, f32x16 (&H)[DK / 32], f32x16& O) {
    typedef Lay<DK, NDV> L;
    f32x16 X[2];
#pragma unroll
    for (int r = 0; r < 16; ++r) { X[0][r] = 0.f; X[1][r] = 0.f; O[r] = 0.f; }
#pragma unroll
    for (int jb = 0; jb < 2; ++jb) if (jb <= ib) {
#pragma unroll
        for (int s = 0; s < DK / 16; ++s)
            X[jb] = MF32(ldA16(B + L::OFF_K + ((32 * jb + r32) * L::PQ + 16 * s + 8 * hi) * 2), ldA16(B + L::OFF_Q + ((32 * ib + r32) * L::PQ + 16 * s + 8 * hi) * 2), X[jb]);
        if (jb == ib) {
#pragma unroll
            for (int r = 0; r < 16; ++r) if (crow(r, hi) > r32) X[jb][r] = 0.f; } }
    bf16x8 vf[2][2];
#pragma unroll
    for (int jb = 0; jb < 2; ++jb)
#pragma unroll
        for (int s = 0; s < 2; ++s) vf[jb][s] = ldP8(B + L::OFF_VT + ((32 * dvb + r32) * PT + 32 * jb + 16 * s + 4 * hi) * 2);
#pragma unroll
    for (int jb = 0; jb < 2; ++jb) if (jb <= ib) {
#pragma unroll
        for (int s = 0; s < 2; ++s) O = MF32(pack8(X[jb], s), vf[jb][s], O); }
#pragma unroll
    for (int db = 0; db < DK / 32; ++db)
#pragma unroll
        for (int s = 0; s < 2; ++s) O = MF32(ldP8(B + L::OFF_Q + ((32 * ib + r32) * L::PQ + 32 * db + 16 * s + 4 * hi) * 2), pack8(H[db], s), O);
#pragma unroll
    for (int db = 0; db < DK / 32; ++db) {
        ATT_LAS const float* dec = (ATT_LAS const float*)(B + L::OFF_DEC);
#pragma unroll
        for (int r = 0; r < 16; ++r) H[db][r] *= dec[32 * db + crow(r, hi)];
#pragma unroll
        for (int jb = 0; jb < 2; ++jb)
#pragma unroll
            for (int s = 0; s < 2; ++s) H[db] = MF32(ldP8(B + L::OFF_KH + ((32 * db + r32) * PT + 32 * jb + 16 * s + 4 * hi) * 2), vf[jb][s], H[db]); }
}
__device__ __forceinline__ float scan64(float v, int lane) {
    { int y = __builtin_amdgcn_update_dpp(0, __builtin_bit_cast(int, v), 0x111, 0xF, 0xF, true); v += __builtin_bit_cast(float, y); }
    { int y = __builtin_amdgcn_update_dpp(0, __builtin_bit_cast(int, v), 0x112, 0xF, 0xF, true); v += __builtin_bit_cast(float, y); }
    { int y = __builtin_amdgcn_update_dpp(0, __builtin_bit_cast(int, v), 0x114, 0xF, 0xF, true); v += __builtin_bit_cast(float, y); }
    { int y = __builtin_amdgcn_update_dpp(0, __builtin_bit_cast(int, v), 0x118, 0xF, 0xF, true); v += __builtin_bit_cast(float, y); }
    const int x = __builtin_bit_cast(int, v);
    const float t0 = __builtin_bit_cast(float, __builtin_amdgcn_readlane(x, 15)), t1 = __builtin_bit_cast(float, __builtin_amdgcn_readlane(x, 31)), t2 = __builtin_bit_cast(float, __builtin_amdgcn_readlane(x, 47));
    const int row = lane >> 4;
    return v + (row >= 1 ? t0 : 0.f) + (row >= 2 ? t1 : 0.f) + (row >= 3 ? t2 : 0.f); }
__device__ __forceinline__ float bfl(unsigned w) { return __builtin_bit_cast(float, w << 16); }
__device__ __forceinline__ float bfh(unsigned w) { return __builtin_bit_cast(float, w & 0xffff0000u); }
__device__ __forceinline__ void vt_write(ATT_LAS unsigned char* B, int off_vt, int tok, int part, const u32x4& sv) {
    ATT_LAS unsigned short* vt = (ATT_LAS unsigned short*)(B + off_vt);
#pragma unroll
    for (int j = 0; j < 4; ++j) { vt[(8 * part + 2 * j) * PT + tok] = (unsigned short)(sv[j] & 0xffffu); vt[(8 * part + 2 * j + 1) * PT + tok] = (unsigned short)(sv[j] >> 16); } }

#define GLA_FETCH(c) do { const size_t t_ = tb + (size_t)(c) * 64 + lane; const bf16_t* ur = u + t_ * DINP; \
        pa0 = *(const u32x4*)(ur + UB_AD); pa1 = *(const u32x4*)(ur + UB_AD + 8); pq = *(const u32x2*)(ur + UB_Q + h * 32 + 4 * w); pk = *(const u32x2*)(ur + UB_K + h * 32 + 4 * w); \
        pv = *(const u32x4*)(u + (tb + (size_t)(c) * 64 + vtok) * DINP + UB_V + h * 64 + vpart * 8); } while (0)
#define GLA_PREP(buf) do { ATT_LAS unsigned char* B_ = lds + (buf) * L::BUF; \
        float adv[16]; _Pragma("unroll") for (int j = 0; j < 4; ++j) { adv[2 * j] = bfl(pa0[j]); adv[2 * j + 1] = bfh(pa0[j]); adv[8 + 2 * j] = bfl(pa1[j]); adv[9 + 2 * j] = bfh(pa1[j]); } \
        const float qv[4] = {bfl(pq[0]), bfh(pq[0]), bfl(pq[1]), bfh(pq[1])}, kv[4] = {bfl(pk[0]), bfh(pk[0]), bfl(pk[1]), bfh(pk[1])}; \
        float qo[4], ko[4]; \
        _Pragma("unroll") for (int d = 0; d < 4; ++d) { float z = ab[d]; _Pragma("unroll") for (int j = 0; j < 16; ++j) z += adv[j] * aup[j * 128 + d]; \
            const float la = -softplusf_(-z) * (1.f / 16.f); const float bc = scan64(la, lane); const float be = __builtin_bit_cast(float, __builtin_amdgcn_readlane(__builtin_bit_cast(int, bc), 63)); \
            qo[d] = qv[d] * __expf(bc) * 0.17677669529663687f; ko[d] = kv[d] * __expf(-bc); const float kh = kv[d] * __expf(be - bc); \
            ((ATT_LAS unsigned short*)(B_ + L::OFF_KH))[(4 * w + d) * PT + lane] = f2bf(kh); \
            if (lane == 63) ((ATT_LAS float*)(B_ + L::OFF_DEC))[4 * w + d] = __expf(be); } \
        *(ATT_LAS u32x2*)(B_ + L::OFF_Q + (lane * L::PQ + 4 * w) * 2) = (u32x2){cvtpk(qo[0], qo[1]), cvtpk(qo[2], qo[3])}; \
        *(ATT_LAS u32x2*)(B_ + L::OFF_K + (lane * L::PQ + 4 * w) * 2) = (u32x2){cvtpk(ko[0], ko[1]), cvtpk(ko[2], ko[3])}; \
        vt_write(B_, L::OFF_VT, vtok, vpart, pv); } while (0)
#define ML_FETCH(c) do { const int s_ = (c) * 64 + lane; const bf16_t* ur = u + (tb + s_) * DINP; \
        _Pragma("unroll") for (int j = 0; j < 4; ++j) { const bool ok = s_ - 3 + j >= 0; const bf16_t* up = ur + (ptrdiff_t)(j - 3) * DINP; \
            xq[j] = ok ? *(const u32x4*)(up + UC_Q + h * 64 + 8 * w) : (u32x4){0u, 0u, 0u, 0u}; xk[j] = ok ? *(const u32x4*)(up + UC_K + h * 64 + 8 * w) : (u32x4){0u, 0u, 0u, 0u}; } \
        pg = *(const u32x4*)(ur + UC_IG); pv = *(const u32x4*)(u + (tb + (size_t)(c) * 64 + vtok) * DINP + UC_V + h * 64 + vpart * 8); } while (0)
#define ML_PREP(buf) do { ATT_LAS unsigned char* B_ = lds + (buf) * L::BUF; \
        const unsigned gi_ = pg[h >> 1], gf_ = pg[2 + (h >> 1)]; const float ig = ((h & 1) ? bfh(gi_) : bfl(gi_)) + ibias; const float lf = -softplusf_(-(((h & 1) ? bfh(gf_) : bfl(gf_)) + fbias)); \
        const float F = scan64(lf, lane); const float Fe = __builtin_bit_cast(float, __builtin_amdgcn_readlane(__builtin_bit_cast(int, F), 63)); const float eF = __expf(F), wk = __expf(ig - F) * 0.125f, wkh = __expf(Fe - F + ig) * 0.125f; \
        float qo[8], ko[8]; \
        _Pragma("unroll") for (int ch = 0; ch < 8; ++ch) { float yq = cb[ch], yk = cb[256 + ch]; \
            _Pragma("unroll") for (int j = 0; j < 4; ++j) { const unsigned wq_ = xq[j][ch >> 1], wk_ = xk[j][ch >> 1]; \
                yq += cw[j * 512 + ch] * ((ch & 1) ? bfh(wq_) : bfl(wq_)); yk += cw[j * 512 + 256 + ch] * ((ch & 1) ? bfh(wk_) : bfl(wk_)); } \
            const float sq = siluf_(yq), sk = siluf_(yk); qo[ch] = sq * eF; ko[ch] = sk * wk; \
            ((ATT_LAS unsigned short*)(B_ + L::OFF_KH))[(8 * w + ch) * PT + lane] = f2bf(sk * wkh); } \
        *(ATT_LAS u32x4*)(B_ + L::OFF_Q + (lane * L::PQ + 8 * w) * 2) = (u32x4){cvtpk(qo[0], qo[1]), cvtpk(qo[2], qo[3]), cvtpk(qo[4], qo[5]), cvtpk(qo[6], qo[7])}; \
        *(ATT_LAS u32x4*)(B_ + L::OFF_K + (lane * L::PQ + 8 * w) * 2) = (u32x4){cvtpk(ko[0], ko[1]), cvtpk(ko[2], ko[3]), cvtpk(ko[4], ko[5]), cvtpk(ko[6], ko[7])}; \
        if (w == 0) ((ATT_LAS float*)(B_ + L::OFF_DEC))[lane] = __expf(Fe); \
        vt_write(B_, L::OFF_VT, vtok, vpart, pv); } while (0)
#define GLA_FETCHX(tb_, h_, c_) do { const size_t t_ = (tb_) + (size_t)(c_) * 64 + lane; const bf16_t* ur = u + t_ * DINP; \
        pa0 = *(const u32x4*)(ur + UB_AD); pa1 = *(const u32x4*)(ur + UB_AD + 8); pq = *(const u32x2*)(ur + UB_Q + (h_) * 32 + 4 * w); pk = *(const u32x2*)(ur + UB_K + (h_) * 32 + 4 * w); \
        pv = *(const u32x4*)(u + ((tb_) + (size_t)(c_) * 64 + vtok) * DINP + UB_V + (h_) * 64 + vpart * 8); } while (0)
#define ML_FETCHX(tb_, h_, c_) do { const int s_ = (c_) * 64 + lane; const bf16_t* ur = u + ((tb_) + s_) * DINP; \
        _Pragma("unroll") for (int j = 0; j < 4; ++j) { const bool ok = s_ - 3 + j >= 0; const bf16_t* up = ur + (ptrdiff_t)(j - 3) * DINP; \
            xq[j] = ok ? *(const u32x4*)(up + UC_Q + (h_) * 64 + 8 * w) : (u32x4){0u, 0u, 0u, 0u}; xk[j] = ok ? *(const u32x4*)(up + UC_K + (h_) * 64 + 8 * w) : (u32x4){0u, 0u, 0u, 0u}; } \
        pg = *(const u32x4*)(ur + UC_IG); pv = *(const u32x4*)(u + ((tb_) + (size_t)(c_) * 64 + vtok) * DINP + UC_V + (h_) * 64 + vpart * 8); } while (0)
template <int MIX> __device__ __forceinline__ void stage1_units(ATT_LAS unsigned char* lds, CtxRef C, int l, int first, int stride) {
    typedef Lay<(MIX == 0 ? 32 : 64), (MIX == 0 ? 64 : 96)> L;
    int tid = threadIdx.x; asm volatile("" : "+v"(tid));
    const int lane = tid & 63, w = __builtin_amdgcn_readfirstlane(tid >> 6);
    const bf16_t* u = WSP(bf16_t, WS_U);
    const int vtok = tid >> 3, vpart = tid & 7;
    unsigned char* blobs = C.ws + (MIX == 0 ? WS_GLA_BLOB : WS_ML_BLOB);
    if (MIX == 1) { for (int i = tid; i < 32 * PT; i += 512) ((ATT_LAS unsigned short*)(lds + L::OFF_VT))[64 * PT + i] = (i < PT) ? (unsigned short)0x3f80 : (unsigned short)0; }
    constexpr int NC = SEQ / 64, NV = L::BUF / 16, NU = BATCH * NH * NC;
    u32x4 pa0, pa1, pv, pg, xq[4], xk[4]; u32x2 pq, pk;
    if (first < NU) { const int bh = first / NC, c = first % NC; const size_t tb = (size_t)(bh >> 2) * SEQ;
        if (MIX == 0) GLA_FETCHX(tb, bh & 3, c); else ML_FETCHX(tb, bh & 3, c); }
    for (int uu = first; uu < NU; uu += stride) {
        const int bh = uu / NC, h = bh & 3;
        if (MIX == 0) { const float* aup = INF(I_GLA_UP) + l * 16 * 128 + h * 32 + 4 * w; const float* ab = INF(I_GLA_B) + l * 128 + h * 32 + 4 * w; GLA_PREP(0); }
        else { const float* cw = INF(I_CONVW) + l * 4 * 512 + h * 64 + 8 * w; const float* cb = INF(I_CONVB) + l * 512 + h * 64 + 8 * w; const float ibias = INF(I_IB)[l * 4 + h], fbias = INF(I_FB)[l * 4 + h]; ML_PREP(0); }
        { const int un = uu + stride; if (un < NU) { const int bhn = un / NC, cn = un % NC; const size_t tbn = (size_t)(bhn >> 2) * SEQ;
            if (MIX == 0) GLA_FETCHX(tbn, bhn & 3, cn); else ML_FETCHX(tbn, bhn & 3, cn); } }
        BAR_LDS();
        u32x4* dst = (u32x4*)(blobs + (size_t)uu * L::BUF);
        for (int i = tid; i < NV; i += 512) dst[i] = *(ATT_LAS const u32x4*)(lds + i * 16);
        BAR_LDS();
    }
}
template <int MIX> __device__ __forceinline__ void stage2_run(ATT_LAS unsigned char* lds, CtxRef C, int b, int h) {
    typedef Lay<(MIX == 0 ? 32 : 64), (MIX == 0 ? 64 : 96)> L;
    constexpr int DK = (MIX == 0 ? 32 : 64), NDV = (MIX == 0 ? 64 : 96), NCW = (MIX == 0 ? 4 : 6);
    int tid = threadIdx.x; asm volatile("" : "+v"(tid));
    const int lane = tid & 63, w = __builtin_amdgcn_readfirstlane(tid >> 6), r32 = lane & 31, hi = lane >> 5;
    constexpr int NC = SEQ / 64, NV = L::BUF / 16, NI = (NV + 511) / 512;
    const unsigned char* blobs = C.ws + (MIX == 0 ? WS_GLA_BLOB : WS_ML_BLOB) + (size_t)(b * 4 + h) * NC * L::BUF;
    float* Y = WSP(float, (MIX == 0 ? WS_YB : WS_YC)); float* DEN = WSP(float, WS_DEN);
    const size_t tb = (size_t)b * SEQ;
    f32x16 H[DK / 32], O;
#pragma unroll
    for (int d = 0; d < DK / 32; ++d)
#pragma unroll
        for (int r = 0; r < 16; ++r) H[d][r] = 0.f;
    const int ib = (MIX == 0) ? (w >> 1) : (w / 3), dvb = (MIX == 0) ? (w & 1) : (w % 3);
    u32x4 s0[NI], s1[NI];
#define LB_FETCH(S, c) do { const u32x4* src_ = (const u32x4*)(blobs + (size_t)(c) * L::BUF); _Pragma("unroll") for (int i = 0; i < NI; ++i) { const int ix = tid + 512 * i; if (ix < NV) S[i] = src_[ix]; } } while (0)
#define LB_WRITE(S, buf) do { _Pragma("unroll") for (int i = 0; i < NI; ++i) { const int ix = tid + 512 * i; if (ix < NV) *(ATT_LAS u32x4*)(lds + (buf) * L::BUF + ix * 16) = S[i]; } } while (0)
#define LB_STEP(c, SW) do { \
        if (w < NCW) { compute<DK, NDV>(lds + ((c) & 1) * L::BUF, ib, dvb, r32, hi, H, O); \
            const size_t t0 = tb + (size_t)(c) * 64 + 32 * ib; \
            if (MIX == 0 || dvb < 2) { float* yo = Y + t0 * GW + h * 64 + 32 * dvb + r32; _Pragma("unroll") for (int r = 0; r < 16; ++r) yo[(size_t)crow(r, hi) * GW] = O[r]; } \
            else if (r32 == 0) { _Pragma("unroll") for (int r = 0; r < 16; ++r) DEN[(t0 + crow(r, hi)) * 4 + h] = O[r]; } } \
        if ((c) + 1 < NC) { LB_WRITE(SW, ((c) + 1) & 1); if ((c) + 3 < NC) LB_FETCH(SW, (c) + 3); } \
        BAR_LDS(); } while (0)
    LB_FETCH(s0, 0); LB_FETCH(s1, 1); LB_WRITE(s0, 0); LB_FETCH(s0, 2);
    BAR_LDS();
    for (int c = 0; c < NC; c += 2) { LB_STEP(c, s1); LB_STEP(c + 1, s0); }
#undef LB_FETCH
#undef LB_WRITE
#undef LB_STEP
}
#undef GLA_FETCH
#undef GLA_PREP
#undef ML_FETCH
#undef ML_PREP
#undef GLA_FETCHX
#undef ML_FETCHX
#undef MF32
}
#endif

#ifndef CPU_TEST
namespace rwk {
constexpr int NB = 16;
constexpr int VEC = 6 * 64;
constexpr int BUFB = NB * VEC * 4;
__device__ __forceinline__ float dpp_add(float v, int ctrl_sel) {
    int x = __builtin_bit_cast(int, v), y;
    if (ctrl_sel == 0) y = __builtin_amdgcn_update_dpp(0, x, 0xB1, 0xF, 0xF, true);
    else if (ctrl_sel == 1) y = __builtin_amdgcn_update_dpp(0, x, 0x4E, 0xF, 0xF, true);
    else if (ctrl_sel == 2) y = __builtin_amdgcn_update_dpp(0, x, 0x141, 0xF, 0xF, true);
    else y = __builtin_amdgcn_update_dpp(0, x, 0x140, 0xF, 0xF, true);
    return v + __builtin_bit_cast(float, y); }
__device__ __forceinline__ float red16(float v) { v = dpp_add(v, 0); v = dpp_add(v, 1); v = dpp_add(v, 2); v = dpp_add(v, 3); return v; }
__device__ __forceinline__ void run(ATT_LAS unsigned char* lds, CtxRef C, int b, int h, int rg) {
    int tid = threadIdx.x; asm volatile("" : "+v"(tid));
    const int lane = tid & 63, w = __builtin_amdgcn_readfirstlane(tid >> 6);
    const float* src[6] = {WSP(float, WS_RW_A), WSP(float, WS_RW_W), WSP(float, WS_RW_B), WSP(float, WS_RW_K), WSP(float, WS_RW_R), WSP(float, WS_RW_V)};
    float* Y = WSP(float, WS_YA);
    const size_t tb = (size_t)b * SEQ;
    const int lt = tid - 256;
#define RW_LOAD(batch, buf) do { _Pragma("unroll") for (int i = 0; i < 6; ++i) { const int p = lt + 256 * i; const int st = p / 96, vc = (p % 96) >> 4, pt = p & 15; \
        const float* sp = (vc == 0 ? src[0] : vc == 1 ? src[1] : vc == 2 ? src[2] : vc == 3 ? src[3] : vc == 4 ? src[4] : src[5]); \
        const f4v v4 = *(const f4v*)(sp + (tb + (size_t)(batch) * NB + st) * GW + h * 64 + pt * 4); \
        *(ATT_LAS f4v*)(lds + (buf) * BUFB + (st * VEC + vc * 64 + pt * 4) * 4) = v4; } } while (0)
    constexpr int NBATCH = SEQ / NB;
    if (w >= 4) RW_LOAD(0, 0);
    BAR_LDS();
    const int row = 16 * rg + 4 * w + (lane >> 4), cg = lane & 15;
    float S0 = 0.f, S1 = 0.f, S2 = 0.f, S3 = 0.f;
    for (int bt = 0; bt < NBATCH; ++bt) {
        if (w >= 4) { if (bt + 1 < NBATCH) RW_LOAD(bt + 1, (bt + 1) & 1); }
        else {
            ATT_LAS const float* B = (ATT_LAS const float*)(lds + (bt & 1) * BUFB);
#pragma unroll 4
            for (int st = 0; st < NB; ++st) {
                ATT_LAS const float* P = B + st * VEC;
                const f4v a = *(ATT_LAS const f4v*)(P + 4 * cg), wv = *(ATT_LAS const f4v*)(P + 64 + 4 * cg), bb = *(ATT_LAS const f4v*)(P + 128 + 4 * cg),
                          kk = *(ATT_LAS const f4v*)(P + 192 + 4 * cg), r = *(ATT_LAS const f4v*)(P + 256 + 4 * cg);
                const float vv = P[320 + row];
                const float sa = red16((S0 * a[0] + S1 * a[1]) + (S2 * a[2] + S3 * a[3]));
                S0 = S0 * wv[0] + (sa * bb[0] + vv * kk[0]); S1 = S1 * wv[1] + (sa * bb[1] + vv * kk[1]);
                S2 = S2 * wv[2] + (sa * bb[2] + vv * kk[2]); S3 = S3 * wv[3] + (sa * bb[3] + vv * kk[3]);
                const float y = red16((S0 * r[0] + S1 * r[1]) + (S2 * r[2] + S3 * r[3]));
                if (cg == 0) Y[(tb + (size_t)bt * NB + st) * GW + h * 64 + row] = y;
            }
        }
        BAR_LDS();
    }
#undef RW_LOAD
}
}
#endif

#ifndef CPU_TEST
namespace rw7 {
using att::bf16x8; using att::f32x16; using att::u32x4; using att::u32x2; using att::cvtpk; using att::crow;
using lin::ldA16; using lin::ldP8; using lin::pack8; using lin::scan64; using lin::bfl; using lin::bfh;
#define MF32(a, b, c) __builtin_amdgcn_mfma_f32_32x32x16_bf16((a), (b), (c), 0, 0, 0)
constexpr int PA = 136, PZ = 68, PW = 40, PG_ = 72;
constexpr int X_WUP = 0, X_AUP = 5120, X_GUP = 10240, X_ACT = 19456;
constexpr int O_ZB = 71680, O_ZAB = 89088, O_RED = 106496;
constexpr int I_AT = 0, I_RT = 9216, I_BT = 18432, I_KT = 27648, I_ATT = 36864, I_BTT = 45568, I_KTT = 54272, I_VT = 62976;
constexpr int O_TIMG = O_ZAB, O_L21 = O_ZAB + 9216, O_T11T = O_ZAB + 11776, O_EX = 110592, O_GC = 126976;
static_assert(I_VT + 64 * 68 * 2 <= O_ZB && O_T11T + 2560 <= O_RED && O_RED + 4096 <= O_EX && O_EX + 16384 <= O_GC && O_GC + 256 <= 131072, "rw7 LDS map");
__device__ __forceinline__ void stage1_unit(ATT_LAS unsigned char* lds, CtxRef C, int l, int b, int h, int ch) {
    const int unit = (b * 4 + h) * (SEQ / 64) + ch;
    int tid = threadIdx.x; asm volatile("" : "+v"(tid));
    const int lane = tid & 63, w = __builtin_amdgcn_readfirstlane(tid >> 6), r32 = lane & 31, hi = lane >> 5;
    const bf16_t* u = WSP(bf16_t, WS_U); const float* mu = INF(I_MU) + l * DINA;
    const size_t t0 = (size_t)b * SEQ + (size_t)ch * 64;
    const bool seq0 = (ch == 0);
    const int atok = tid >> 3, apart = tid & 7;
    u32x4 lc0, lc1, lp0, lp1;
    { const bf16_t* p = u + (t0 + atok) * DINP + UA_WD + 16 * apart; lc0 = *(const u32x4*)p; lc1 = *(const u32x4*)(p + 8);
      if (seq0 && atok == 0) { lp0 = (u32x4){0u, 0u, 0u, 0u}; lp1 = lp0; } else { lp0 = *(const u32x4*)(p - DINP); lp1 = *(const u32x4*)(p - DINP + 8); } }
    u32x4 rc, kc, vc, rp, kp, vp;
    { const bf16_t* p = u + (t0 + lane) * DINP + h * 64 + 8 * w; rc = *(const u32x4*)(p + UA_R); kc = *(const u32x4*)(p + UA_K); vc = *(const u32x4*)(p + UA_V);
      if (seq0 && lane == 0) { rp = (u32x4){0u, 0u, 0u, 0u}; kp = rp; vp = rp; } else { rp = *(const u32x4*)(p - DINP + UA_R); kp = *(const u32x4*)(p - DINP + UA_K); vp = *(const u32x4*)(p - DINP + UA_V); } }
    { const u32x4* wsrc = (const u32x4*)(C.ws + WS_RWW + (size_t)h * 19456);
#pragma unroll
      for (int i = 0; i < 3; ++i) { const int ix = tid + 512 * i; if (ix < 1216) *(ATT_LAS u32x4*)(lds + X_WUP + ix * 16) = wsrc[ix]; } }
    { float o[16];
#pragma unroll
      for (int j = 0; j < 4; ++j) { const float c0 = bfl(lc0[j]), c1 = bfh(lc0[j]), c2 = bfl(lc1[j]), c3 = bfh(lc1[j]); const float p0 = bfl(lp0[j]), p1 = bfh(lp0[j]), p2 = bfl(lp1[j]), p3 = bfh(lp1[j]);
          const float* m = mu + UA_WD + 16 * apart; o[2 * j] = c0 + (p0 - c0) * m[2 * j]; o[2 * j + 1] = c1 + (p1 - c1) * m[2 * j + 1]; o[8 + 2 * j] = c2 + (p2 - c2) * m[8 + 2 * j]; o[9 + 2 * j] = c3 + (p3 - c3) * m[9 + 2 * j]; }
      if (apart < 2) {
#pragma unroll
          for (int j = 0; j < 16; ++j) o[j] = tanhf_(o[j]); }
      else if (apart >= 4) {
#pragma unroll
          for (int j = 0; j < 16; ++j) o[j] = sigmoidf_(o[j]); }
      ATT_LAS unsigned char* d = lds + X_ACT + (atok * PA + 16 * apart) * 2;
      *(ATT_LAS u32x4*)d = (u32x4){cvtpk(o[0], o[1]), cvtpk(o[2], o[3]), cvtpk(o[4], o[5]), cvtpk(o[6], o[7])};
      *(ATT_LAS u32x4*)(d + 16) = (u32x4){cvtpk(o[8], o[9]), cvtpk(o[10], o[11]), cvtpk(o[12], o[13]), cvtpk(o[14], o[15])}; }
    BAR_LDS();
    { const int tb = (w & 3) >> 1, cb = w & 1; f32x16 z0, z1;
#pragma unroll
      for (int r = 0; r < 16; ++r) { z0[r] = 0.f; z1[r] = 0.f; }
      ATT_LAS const unsigned char* arow = lds + X_ACT + ((32 * tb + r32) * PA + 8 * hi) * 2;
      if (w < 4) {
#pragma unroll
          for (int s = 0; s < 2; ++s) { z0 = MF32(ldA16(arow + 32 * s), ldA16(lds + X_WUP + ((32 * cb + r32) * PW + 16 * s + 8 * hi) * 2), z0);
              z1 = MF32(ldA16(arow + 64 + 32 * s), ldA16(lds + X_AUP + ((32 * cb + r32) * PW + 16 * s + 8 * hi) * 2), z1); }
          ATT_LAS float* zb = (ATT_LAS float*)(lds + O_ZB); ATT_LAS float* zab = (ATT_LAS float*)(lds + O_ZAB);
#pragma unroll
          for (int r = 0; r < 16; ++r) { zb[(32 * tb + crow(r, hi)) * PZ + 32 * cb + r32] = z0[r]; zab[(32 * tb + crow(r, hi)) * PZ + 32 * cb + r32] = z1[r]; }
      } else {
#pragma unroll
          for (int s = 0; s < 4; ++s) z0 = MF32(ldA16(arow + 128 + 32 * s), ldA16(lds + X_GUP + ((32 * cb + r32) * PG_ + 16 * s + 8 * hi) * 2), z0);
          bf16_t* gg = WSP(bf16_t, WS_RW_GG) + (t0 + 32 * tb) * GW + h * 64 + 32 * cb + r32;
#pragma unroll
          for (int r = 0; r < 16; ++r) gg[(size_t)crow(r, hi) * GW] = f2bf(z0[r]); } }
    BAR_LDS();
    {   const int cb8 = h * 64 + 8 * w;
        const float* w0 = INF(I_W0) + l * GW + cb8; const float* a0 = INF(I_A0) + l * GW + cb8; const float* kkw = INF(I_KK) + l * GW + cb8; const float* kaw = INF(I_KA) + l * GW + cb8;
        const float* rkw = INF(I_RK) + l * GW + cb8;
        ATT_LAS const float* zb = (ATT_LAS const float*)(lds + O_ZB) + lane * PZ + 8 * w; ATT_LAS const float* zab = (ATT_LAS const float*)(lds + O_ZAB) + lane * PZ + 8 * w;
        const f4v zA = *(ATT_LAS const f4v*)zb, zB = *(ATT_LAS const f4v*)(zb + 4), yA = *(ATT_LAS const f4v*)zab, yB = *(ATT_LAS const f4v*)(zab + 4);
        float rr[8], kk_[8], vv[8], lw[8], ai[8], kq[8]; float ss = 0.f, bon = 0.f;
#pragma unroll
        for (int i = 0; i < 8; ++i) {
            const float z = w0[i] + (i < 4 ? zA[i & 3] : zB[i & 3]), za = a0[i] + (i < 4 ? yA[i & 3] : yB[i & 3]);
            lw[i] = -__expf(-softplusf_(-z) - 0.5f); ai[i] = sigmoidf_(za);
            const unsigned wr_ = rc[i >> 1], wk_ = kc[i >> 1], wv_ = vc[i >> 1], pr_ = rp[i >> 1], pk_ = kp[i >> 1], pv_ = vp[i >> 1];
            const float r_c = (i & 1) ? bfh(wr_) : bfl(wr_), k_c = (i & 1) ? bfh(wk_) : bfl(wk_), v_c = (i & 1) ? bfh(wv_) : bfl(wv_);
            const float r_p = (i & 1) ? bfh(pr_) : bfl(pr_), k_p = (i & 1) ? bfh(pk_) : bfl(pk_), v_p = (i & 1) ? bfh(pv_) : bfl(pv_);
            rr[i] = r_c + (r_p - r_c) * mu[UA_R + cb8 + i]; const float k = k_c + (k_p - k_c) * mu[UA_K + cb8 + i]; vv[i] = v_c + (v_p - v_c) * mu[UA_V + cb8 + i];
            kq[i] = k * kkw[i]; ss += kq[i] * kq[i]; kk_[i] = k * (1.f + (ai[i] - 1.f) * kaw[i]); bon += rr[i] * kk_[i] * rkw[i]; }
        ATT_LAS float* red = (ATT_LAS float*)(lds + O_RED);
        red[w * 64 + lane] = ss; red[512 + w * 64 + lane] = bon;
        BAR_LDS();
        float sst = 0.f, bont = 0.f;
#pragma unroll
        for (int ww = 0; ww < 8; ++ww) { sst += red[ww * 64 + lane]; bont += red[512 + ww * 64 + lane]; }
        const float inv = 1.f / fmaxf(sqrtf(sst), 1e-12f);
        float at8[8], rt8[8], bt8[8], kt8[8];
#pragma unroll
        for (int i = 0; i < 8; ++i) { const float Gc = scan64(lw[i], lane); const float Gp = Gc - lw[i]; const float kkn = kq[i] * inv; const float enG = __expf(-Gc);
            at8[i] = -kkn * __expf(Gp); rt8[i] = rr[i] * __expf(Gc); bt8[i] = kkn * ai[i] * enG; kt8[i] = kk_[i] * enG;
            if (lane == 63) { const float gcv = __expf(Gc); ((ATT_LAS float*)(lds + O_GC))[8 * w + i] = gcv; WSP(float, WS_RW_GC)[(size_t)unit * 64 + 8 * w + i] = gcv; } }
        { ATT_LAS unsigned char* d = lds + (lane * PG_ + 8 * w) * 2;
          *(ATT_LAS u32x4*)(d + I_AT) = (u32x4){cvtpk(at8[0], at8[1]), cvtpk(at8[2], at8[3]), cvtpk(at8[4], at8[5]), cvtpk(at8[6], at8[7])};
          *(ATT_LAS u32x4*)(d + I_RT) = (u32x4){cvtpk(rt8[0], rt8[1]), cvtpk(rt8[2], rt8[3]), cvtpk(rt8[4], rt8[5]), cvtpk(rt8[6], rt8[7])};
          *(ATT_LAS u32x4*)(d + I_BT) = (u32x4){cvtpk(bt8[0], bt8[1]), cvtpk(bt8[2], bt8[3]), cvtpk(bt8[4], bt8[5]), cvtpk(bt8[6], bt8[7])};
          *(ATT_LAS u32x4*)(d + I_KT) = (u32x4){cvtpk(kt8[0], kt8[1]), cvtpk(kt8[2], kt8[3]), cvtpk(kt8[4], kt8[5]), cvtpk(kt8[6], kt8[7])};
#pragma unroll
          for (int i = 0; i < 8; ++i) { const int o2 = ((8 * w + i) * lin::PT + lane) * 2;
              *(ATT_LAS unsigned short*)(lds + I_ATT + o2) = f2bf(at8[i]); *(ATT_LAS unsigned short*)(lds + I_BTT + o2) = f2bf(bt8[i]);
              *(ATT_LAS unsigned short*)(lds + I_KTT + o2) = f2bf(kt8[i]); *(ATT_LAS unsigned short*)(lds + I_VT + o2) = f2bf(vv[i]); } }
        const size_t o = (t0 + lane) * GW + cb8;
        if (w == 0) WSP(float, WS_RW_BON)[(t0 + lane) * 4 + h] = bont;
        *(u32x4*)(WSP(bf16_t, WS_RW_VS) + o) = (u32x4){cvtpk(vv[0], vv[1]), cvtpk(vv[2], vv[3]), cvtpk(vv[4], vv[5]), cvtpk(vv[6], vv[7])};
    }
    BAR_LDS();
#define RW_PROD(ACC, IA, IB, rb, cb, keep) do { _Pragma("unroll") for (int r_ = 0; r_ < 16; ++r_) ACC[r_] = 0.f; \
        _Pragma("unroll") for (int k_ = 0; k_ < 4; ++k_) ACC = MF32(ldA16(lds + (IA) + ((32 * (rb) + r32) * PG_ + 16 * k_ + 8 * hi) * 2), ldA16(lds + (IB) + ((32 * (cb) + r32) * PG_ + 16 * k_ + 8 * hi) * 2), ACC); \
        if ((keep) == 1) { _Pragma("unroll") for (int r_ = 0; r_ < 16; ++r_) if (!(crow(r_, hi) < r32)) ACC[r_] = 0.f; } \
        if ((keep) == 2) { _Pragma("unroll") for (int r_ = 0; r_ < 16; ++r_) if (!(crow(r_, hi) <= r32)) ACC[r_] = 0.f; } \
        if ((keep) == 3) { _Pragma("unroll") for (int r_ = 0; r_ < 16; ++r_) if (!(crow(r_, hi) > r32)) ACC[r_] = 0.f; } \
        __builtin_amdgcn_sched_barrier(0); } while (0)
    f32x16 M00, M01, M11;
    f32x16 Z1a, Z1b;
    if (w == 2 || w == 3) { const int eb = w - 2; f32x16 L00, L01, L11;
        RW_PROD(L00, I_KT, I_AT, 0, 0, 1); RW_PROD(L01, I_KT, I_AT, 0, 1, 0); RW_PROD(L11, I_KT, I_AT, 1, 1, 1);
#pragma unroll
        for (int r = 0; r < 16; ++r) { Z1a[r] = 0.f; Z1b[r] = 0.f; }
#pragma unroll
        for (int k = 0; k < 2; ++k) { const bf16x8 v0 = ldP8(lds + I_VT + ((32 * eb + r32) * lin::PT + 16 * k + 4 * hi) * 2), v1 = ldP8(lds + I_VT + ((32 * eb + r32) * lin::PT + 32 + 16 * k + 4 * hi) * 2);
            Z1a = MF32(pack8(L00, k), v0, Z1a); Z1b = MF32(pack8(L01, k), v0, Z1b); Z1b = MF32(pack8(L11, k), v1, Z1b); } }
    if (w == 4 || w == 5) { const int eb = w - 4; f32x16 K00, K01, K11, Ya, Yb, KVa, KVb;
        RW_PROD(K00, I_KT, I_RT, 0, 0, 2); RW_PROD(K01, I_KT, I_RT, 0, 1, 0); RW_PROD(K11, I_KT, I_RT, 1, 1, 2);
#pragma unroll
        for (int r = 0; r < 16; ++r) { Ya[r] = 0.f; Yb[r] = 0.f; KVa[r] = 0.f; KVb[r] = 0.f; }
#pragma unroll
        for (int k = 0; k < 2; ++k) { const bf16x8 v0 = ldP8(lds + I_VT + ((32 * eb + r32) * lin::PT + 16 * k + 4 * hi) * 2), v1 = ldP8(lds + I_VT + ((32 * eb + r32) * lin::PT + 32 + 16 * k + 4 * hi) * 2);
            Ya = MF32(pack8(K00, k), v0, Ya); Yb = MF32(pack8(K01, k), v0, Yb); Yb = MF32(pack8(K11, k), v1, Yb);
            KVa = MF32(ldP8(lds + I_KTT + (r32 * lin::PT + 16 * k + 4 * hi) * 2), v0, KVa); KVa = MF32(ldP8(lds + I_KTT + (r32 * lin::PT + 32 + 16 * k + 4 * hi) * 2), v1, KVa);
            KVb = MF32(ldP8(lds + I_KTT + ((32 + r32) * lin::PT + 16 * k + 4 * hi) * 2), v0, KVb); KVb = MF32(ldP8(lds + I_KTT + ((32 + r32) * lin::PT + 32 + 16 * k + 4 * hi) * 2), v1, KVb); }
        ATT_LAS unsigned char* ex = lds + O_EX + (eb * 4 * 64 + lane) * 32;
#define RW_EXW(q_, A_) do { *(ATT_LAS u32x4*)(ex + (q_) * 2048) = (u32x4){cvtpk(A_[0], A_[1]), cvtpk(A_[2], A_[3]), cvtpk(A_[4], A_[5]), cvtpk(A_[6], A_[7])}; \
        *(ATT_LAS u32x4*)(ex + (q_) * 2048 + 16) = (u32x4){cvtpk(A_[8], A_[9]), cvtpk(A_[10], A_[11]), cvtpk(A_[12], A_[13]), cvtpk(A_[14], A_[15])}; } while (0)
        RW_EXW(0, Ya); RW_EXW(1, Yb); RW_EXW(2, KVa); RW_EXW(3, KVb);
#undef RW_EXW
    }
    if (w == 7) {
        f32x16 La, Lb, Lc;
        RW_PROD(La, I_AT, I_BT, 0, 0, 3); RW_PROD(Lb, I_AT, I_BT, 1, 0, 0); RW_PROD(Lc, I_AT, I_BT, 1, 1, 3);
        ATT_LAS float* Lbuf = (ATT_LAS float*)(lds + O_ZB);
#pragma unroll
        for (int r = 0; r < 16; ++r) { Lbuf[crow(r, hi) * PZ + r32] = La[r]; Lbuf[(32 + crow(r, hi)) * PZ + 32 + r32] = Lc[r];
            *(ATT_LAS unsigned short*)(lds + O_L21 + (crow(r, hi) * PW + r32) * 2) = f2bf(Lb[r]);
            *(ATT_LAS unsigned short*)(lds + O_TIMG + (crow(r, hi) * PG_ + 32 + r32) * 2) = 0; }
        asm volatile("s_waitcnt lgkmcnt(0)" ::: "memory");
        float Tc[32];
        { ATT_LAS const float* Lr = Lbuf + (32 * hi) * PZ + 32 * hi;
#pragma unroll
          for (int t = 0; t < 32; ++t) { float acc = (t == r32) ? 1.f : 0.f;
#pragma unroll
              for (int s4 = 0; s4 < (t + 3) / 4; ++s4) { const f4v lv = *(ATT_LAS const f4v*)(Lr + t * PZ + 4 * s4);
#pragma unroll
                  for (int j = 0; j < 4; ++j) if (4 * s4 + j < t) acc += lv[j] * Tc[4 * s4 + j]; }
              Tc[t] = acc; } }
#pragma unroll
        for (int t = 0; t < 32; ++t) *(ATT_LAS unsigned short*)(lds + O_TIMG + ((32 * hi + t) * PG_ + 32 * hi + r32) * 2) = f2bf(Tc[t]);
        if (hi == 0) {
#pragma unroll
            for (int q4 = 0; q4 < 4; ++q4) *(ATT_LAS u32x4*)(lds + O_T11T + (r32 * PW + 8 * q4) * 2) = (u32x4){cvtpk(Tc[8 * q4], Tc[8 * q4 + 1]), cvtpk(Tc[8 * q4 + 2], Tc[8 * q4 + 3]), cvtpk(Tc[8 * q4 + 4], Tc[8 * q4 + 5]), cvtpk(Tc[8 * q4 + 6], Tc[8 * q4 + 7])}; }
        asm volatile("s_waitcnt lgkmcnt(0)" ::: "memory");
        f32x16 X, T21;
#pragma unroll
        for (int r = 0; r < 16; ++r) { X[r] = 0.f; T21[r] = 0.f; }
#pragma unroll
        for (int k = 0; k < 2; ++k) X = MF32(ldA16(lds + O_L21 + (r32 * PW + 16 * k + 8 * hi) * 2), ldA16(lds + O_T11T + (r32 * PW + 16 * k + 8 * hi) * 2), X);
#pragma unroll
        for (int k = 0; k < 2; ++k) T21 = MF32(ldP8(lds + O_TIMG + ((32 + r32) * PG_ + 32 + 16 * k + 4 * hi) * 2), pack8(X, k), T21);
#pragma unroll
        for (int r = 0; r < 16; ++r) *(ATT_LAS unsigned short*)(lds + O_TIMG + ((32 + crow(r, hi)) * PG_ + r32) * 2) = f2bf(T21[r]);
    }
    BAR_LDS();
    if (w < 4) {
        const int nb = w & 1;
        ATT_LAS const float* gc = (ATT_LAS const float*)(lds + O_GC);
        f32x16 P0, P1;
#pragma unroll
        for (int r = 0; r < 16; ++r) { P0[r] = 0.f; P1[r] = 0.f; }
#pragma unroll
        for (int k = 0; k < 2; ++k) {
            const bf16x8 t00 = ldP8(lds + O_TIMG + (r32 * PG_ + 16 * k + 4 * hi) * 2), t10 = ldP8(lds + O_TIMG + ((32 + r32) * PG_ + 16 * k + 4 * hi) * 2), t11 = ldP8(lds + O_TIMG + ((32 + r32) * PG_ + 32 + 16 * k + 4 * hi) * 2);
            bf16x8 b0, b1;
            if (w < 2) { b0 = ldP8(lds + I_ATT + ((32 * nb + r32) * lin::PT + 16 * k + 4 * hi) * 2); b1 = ldP8(lds + I_ATT + ((32 * nb + r32) * lin::PT + 32 + 16 * k + 4 * hi) * 2); }
            else { b0 = pack8(Z1a, k); b1 = pack8(Z1b, k); }
            P0 = MF32(t00, b0, P0); P1 = MF32(t10, b0, P1); P1 = MF32(t11, b1, P1); }
        {   RW_PROD(M00, I_BT, I_RT, 0, 0, 2); RW_PROD(M01, I_BT, I_RT, 0, 1, 0); RW_PROD(M11, I_BT, I_RT, 1, 1, 2);
            f32x16 A0, A1;
#pragma unroll
            for (int r = 0; r < 16; ++r) { A0[r] = 0.f; A1[r] = 0.f; }
#pragma unroll
            for (int k = 0; k < 2; ++k) { const bf16x8 p0 = pack8(P0, k), p1 = pack8(P1, k);
                A0 = MF32(pack8(M00, k), p0, A0); A1 = MF32(pack8(M01, k), p0, A1); A1 = MF32(pack8(M11, k), p1, A1); }
            if (w < 2) { bf16_t* RY = WSP(bf16_t, WS_RW_RY) + (size_t)unit * 4096;
#pragma unroll
                for (int r = 0; r < 16; ++r) { const int t = crow(r, hi), d = 32 * nb + r32;
                    RY[t * 64 + d] = f2bf(A0[r] + bf2f(*(ATT_LAS const unsigned short*)(lds + I_RT + (t * PG_ + d) * 2)));
                    RY[(32 + t) * 64 + d] = f2bf(A1[r] + bf2f(*(ATT_LAS const unsigned short*)(lds + I_RT + ((32 + t) * PG_ + d) * 2))); } }
            else { ATT_LAS const unsigned char* ex = lds + O_EX + (nb * 4 * 64 + lane) * 32; float* Y0G = WSP(float, WS_RW_Y0) + ((size_t)unit * 4 + nb) * 1024 + lane * 16;
#pragma unroll
                for (int r4 = 0; r4 < 16; r4 += 4) { f4v y0, y1;
#pragma unroll
                    for (int j = 0; j < 4; ++j) { const int r = r4 + j; y0[j] = A0[r] + bf2f(*(ATT_LAS const unsigned short*)(ex + 2 * r)); y1[j] = A1[r] + bf2f(*(ATT_LAS const unsigned short*)(ex + 2048 + 2 * r)); }
                    *(f4v*)(Y0G + r4) = y0; *(f4v*)(Y0G + 2048 + r4) = y1; } } }
        __builtin_amdgcn_sched_barrier(0);
        {   f32x16 B0, B1;
#pragma unroll
            for (int r = 0; r < 16; ++r) { B0[r] = 0.f; B1[r] = 0.f; }
#pragma unroll
            for (int k = 0; k < 2; ++k) { const bf16x8 p0 = pack8(P0, k), p1 = pack8(P1, k);
                B0 = MF32(ldP8(lds + I_BTT + (r32 * lin::PT + 16 * k + 4 * hi) * 2), p0, B0); B0 = MF32(ldP8(lds + I_BTT + (r32 * lin::PT + 32 + 16 * k + 4 * hi) * 2), p1, B0);
                B1 = MF32(ldP8(lds + I_BTT + ((32 + r32) * lin::PT + 16 * k + 4 * hi) * 2), p0, B1); B1 = MF32(ldP8(lds + I_BTT + ((32 + r32) * lin::PT + 32 + 16 * k + 4 * hi) * 2), p1, B1); }
            if (w < 2) { bf16_t* PLg = WSP(bf16_t, WS_RW_PL) + (size_t)unit * 4096;
#pragma unroll
                for (int r = 0; r < 16; ++r) { const int t = crow(r, hi), d = 32 * nb + r32; PLg[t * 64 + d] = f2bf(gc[t] * B0[r]); PLg[(32 + t) * 64 + d] = f2bf(gc[32 + t] * B1[r]); } }
            else { ATT_LAS const unsigned char* ex = lds + O_EX + (nb * 4 * 64 + lane) * 32; float* QG = WSP(float, WS_RW_QG) + ((size_t)unit * 4 + nb) * 1024 + lane * 16;
#pragma unroll
                for (int r4 = 0; r4 < 16; r4 += 4) { f4v q0, q1;
#pragma unroll
                    for (int j = 0; j < 4; ++j) { const int r = r4 + j; q0[j] = gc[crow(r, hi)] * (B0[r] + bf2f(*(ATT_LAS const unsigned short*)(ex + 4096 + 2 * r))); q1[j] = gc[32 + crow(r, hi)] * (B1[r] + bf2f(*(ATT_LAS const unsigned short*)(ex + 6144 + 2 * r))); }
                    *(f4v*)(QG + r4) = q0; *(f4v*)(QG + 2048 + r4) = q1; } } }
    }
    BAR_LDS();
#undef RW_PROD
}
__device__ __forceinline__ void stage2_run(ATT_LAS unsigned char* lds, CtxRef C, int b, int h) {
    int tid = threadIdx.x; asm volatile("" : "+v"(tid));
    const int lane = tid & 63, w = __builtin_amdgcn_readfirstlane(tid >> 6), r32 = lane & 31, hi = lane >> 5;
    constexpr int NC = SEQ / 64; constexpr int S2_PL = 0, S2_RY = 9216, S2_GC = 18432, S2_BUF = 18688;
    const int bh = b * 4 + h; const size_t unit0 = (size_t)bh * NC;
    const bf16_t* PLg = WSP(bf16_t, WS_RW_PL) + unit0 * 4096; const bf16_t* RYg = WSP(bf16_t, WS_RW_RY) + unit0 * 4096;
    const float* QG = WSP(float, WS_RW_QG) + unit0 * 4096; const float* Y0G = WSP(float, WS_RW_Y0) + unit0 * 4096; const float* GCg = WSP(float, WS_RW_GC) + unit0 * 64;
    float* Y = WSP(float, WS_YA);
    const int i = w >> 1, eb = w & 1, srow = tid >> 3, spart = tid & 7;
    f32x16 H0, H1, q0, q1, y0;
#pragma unroll
    for (int r = 0; r < 16; ++r) { H0[r] = 0.f; H1[r] = 0.f; }
    u32x4 spl, sry; float sgc = 0.f;
#define S2_FETCH_IMG(c) do { spl = *(const u32x4*)(PLg + (size_t)(c) * 4096 + srow * 64 + spart * 8); sry = *(const u32x4*)(RYg + (size_t)(c) * 4096 + srow * 64 + spart * 8); if (tid < 64) sgc = GCg[(c) * 64 + tid]; } while (0)
#define S2_FETCH_ACC(c) do { if (w < 4) { const float* qp = QG + (size_t)(c) * 4096 + eb * 1024 + lane * 16; const float* yp = Y0G + (size_t)(c) * 4096 + (i * 2 + eb) * 1024 + lane * 16; \
            _Pragma("unroll") for (int r4 = 0; r4 < 16; r4 += 4) { const f4v a = *(const f4v*)(qp + r4), b_ = *(const f4v*)(qp + 2048 + r4), c_ = *(const f4v*)(yp + r4); \
                _Pragma("unroll") for (int j = 0; j < 4; ++j) { q0[r4 + j] = a[j]; q1[r4 + j] = b_[j]; y0[r4 + j] = c_[j]; } } } } while (0)
#define S2_WRITE(buf) do { ATT_LAS unsigned char* B_ = lds + (buf) * S2_BUF; *(ATT_LAS u32x4*)(B_ + S2_PL + (srow * PG_ + spart * 8) * 2) = spl; *(ATT_LAS u32x4*)(B_ + S2_RY + (srow * PG_ + spart * 8) * 2) = sry; \
        if (tid < 64) ((ATT_LAS float*)(B_ + S2_GC))[tid] = sgc; } while (0)
    S2_FETCH_IMG(0); S2_FETCH_ACC(0); S2_WRITE(0);
    BAR_LDS();
    for (int c = 0; c < NC; ++c) {
        if (c + 1 < NC) S2_FETCH_IMG(c + 1);
        if (w < 4) {
            ATT_LAS const unsigned char* B_ = lds + (c & 1) * S2_BUF; ATT_LAS const float* gc = (ATT_LAS const float*)(B_ + S2_GC);
            bf16x8 hb[2][2];
#pragma unroll
            for (int k = 0; k < 2; ++k) { hb[0][k] = pack8(H0, k); hb[1][k] = pack8(H1, k); }
            f32x16 Yo = y0;
#pragma unroll
            for (int r = 0; r < 16; ++r) { H0[r] = gc[crow(r, hi)] * H0[r] + q0[r]; H1[r] = gc[32 + crow(r, hi)] * H1[r] + q1[r]; }
            __builtin_amdgcn_sched_barrier(0);
            if (c + 1 < NC) S2_FETCH_ACC(c + 1);
#pragma unroll
            for (int db = 0; db < 2; ++db)
#pragma unroll
                for (int k = 0; k < 2; ++k) Yo = MF32(ldP8(B_ + S2_RY + ((32 * i + r32) * PG_ + 32 * db + 16 * k + 4 * hi) * 2), hb[db][k], Yo);
#pragma unroll
            for (int db = 0; db < 2; ++db)
#pragma unroll
                for (int k = 0; k < 2; ++k) { H0 = MF32(ldP8(B_ + S2_PL + (r32 * PG_ + 32 * db + 16 * k + 4 * hi) * 2), hb[db][k], H0); H1 = MF32(ldP8(B_ + S2_PL + ((32 + r32) * PG_ + 32 * db + 16 * k + 4 * hi) * 2), hb[db][k], H1); }
            float* yo = Y + ((size_t)b * SEQ + (size_t)c * 64 + 32 * i) * GW + h * 64 + 32 * eb + r32;
#pragma unroll
            for (int r = 0; r < 16; ++r) yo[(size_t)crow(r, hi) * GW] = Yo[r];
        }
        if (c + 1 < NC) S2_WRITE((c + 1) & 1);
        BAR_LDS();
    }
#undef S2_FETCH_IMG
#undef S2_FETCH_ACC
#undef S2_WRITE
}
#undef MF32
}
#endif

constexpr int PH_PER_LAYER = 13;
constexpr int NPHASES = DEPTH * PH_PER_LAYER;

#ifndef CPU_TEST
#define XB_TMO      128
#define XB_XCNT(j)  (256  + 64 * (j))
#define XB_XSUB(j)  (1280 + 64 * (j))
#define XB_XGEN(j)  (2304 + 64 * (j))
#define XB_TOP      3328
#define XB_TOPGEN   3392
#define XCD_BAR_WORDS 3456
#define XB_SPIN_CAP (1u << 18)
#define LAS __attribute__((address_space(3)))
__device__ __forceinline__ unsigned xb_ld(unsigned* p)              { return __hip_atomic_load(p, __ATOMIC_RELAXED, __HIP_MEMORY_SCOPE_AGENT); }
__device__ __forceinline__ unsigned xb_add(unsigned* p, unsigned v) { return __hip_atomic_fetch_add(p, v, __ATOMIC_RELAXED, __HIP_MEMORY_SCOPE_AGENT); }
__device__ __forceinline__ unsigned xb_xcc_id() { return (unsigned)__builtin_amdgcn_s_getreg((3 << 11) | 20) & 0xFu; }
#define XB_SPIN(cond, bar) do { unsigned _sp = 0; while (cond) { __builtin_amdgcn_s_sleep(1); \
    if ((++_sp & 255u) == 0u) { if (xb_ld(&(bar)[XB_TMO])) break; if (_sp > XB_SPIN_CAP) { atomicAdd(&(bar)[XB_TMO], 1u); break; } } } } while (0)
struct XcdBarrier { unsigned* bar; unsigned x; volatile LAS unsigned* st; };
__device__ __forceinline__ XcdBarrier xcd_barrier_post(unsigned* bar, volatile LAS unsigned* st) {
    XcdBarrier b; b.bar = bar; b.x = xb_xcc_id(); b.st = st;
    if (threadIdx.x == 0) (void)xb_add(&bar[XB_XCNT(b.x)], 1u);
    return b;
}
__device__ __forceinline__ void xcd_barrier_complete(unsigned* bar, unsigned x, unsigned& nloc, unsigned& nx) {
    const unsigned G = gridDim.x * gridDim.y * gridDim.z;
    unsigned sum, cnt, mine, sp = 0u;
    for (;;) {
        sum = 0u; cnt = 0u; mine = 0u;
#pragma unroll
        for (unsigned j = 0; j < 16; ++j) { const unsigned c = xb_ld(&bar[XB_XCNT(j)]); sum += c; cnt += (c > 0u) ? 1u : 0u; mine = (j == x) ? c : mine; }
        if (sum == G) break;
        __builtin_amdgcn_s_sleep(1);
        if ((++sp & 255u) == 0u) { if (xb_ld(&bar[XB_TMO])) break; if (sp > XB_SPIN_CAP) { atomicAdd(&bar[XB_TMO], 1u); break; } }
    }
    nloc = mine > 0u ? mine : 1u; nx = cnt > 0u ? cnt : 1u;
}
__device__ __forceinline__ void xcd_barrier(const XcdBarrier& b) {
    asm volatile("s_waitcnt vmcnt(0)" ::: "memory");
    __syncthreads();
    if (threadIdx.x == 0) {
        unsigned* bar = b.bar;
        __builtin_amdgcn_s_waitcnt(0);
        unsigned nloc = b.st[0], nx = b.st[1];
        if (nloc == 0u) { xcd_barrier_complete(bar, b.x, nloc, nx); b.st[0] = nloc; b.st[1] = nx; }
        const unsigned old = xb_add(&bar[XB_XSUB(b.x)], 1u);
        const unsigned gen = old / nloc;
        if (old + 1u == (gen + 1u) * nloc) {
            __builtin_amdgcn_fence(__ATOMIC_RELEASE, "agent");
            asm volatile("s_waitcnt vmcnt(0)" ::: "memory");
            const unsigned og = xb_add(&bar[XB_TOP], 1u);
            const unsigned tg = og / nx;
            if (og + 1u == (tg + 1u) * nx) xb_add(&bar[XB_TOPGEN], 1u);
            else XB_SPIN(xb_ld(&bar[XB_TOPGEN]) == tg, bar);
            __builtin_amdgcn_fence(__ATOMIC_ACQUIRE, "agent");
            xb_add(&bar[XB_XGEN(b.x)], 1u);
            asm volatile("s_waitcnt vmcnt(0)" ::: "memory");
        } else {
            XB_SPIN(xb_ld(&bar[XB_XGEN(b.x)]) == gen, bar);
            __builtin_amdgcn_fence(__ATOMIC_ACQUIRE, "agent");
            asm volatile("s_waitcnt vmcnt(0)" ::: "memory");
        }
    }
    __syncthreads();
}

constexpr int NWAVES = 8;
constexpr int RING_BYTES = 131072, MISC_OFF = RING_BYTES + 320, LDS_BYTES = 147456;
struct Args { Ctx C; int ph_lo, ph_hi; };
__device__ __forceinline__ int moe_fill_table(CtxRef C, int l, LAS int* tbl, int tid) {
    const unsigned* cnt = WSP(unsigned, WS_CTL) + CW_CNT + l * NEXP * 64;
    int e, be, ce; const int total = moe_lookup(cnt, tid * 256, e, be, ce);
    if (tid < 320) tbl[tid] = e;
    __syncthreads();
    return total >> 8;
}

__global__ void __launch_bounds__(NWAVES * 64, 2) mega(Args args) {
    extern __shared__ __attribute__((aligned(16))) unsigned char lds_raw[];
    LAS unsigned char* lds = (LAS unsigned char*)lds_raw;
    const int G = gridDim.x, bx = blockIdx.x;
    const int ngw = G * NWAVES;
    volatile LAS unsigned* MISC = (volatile LAS unsigned*)(lds + MISC_OFF);
    for (int i = threadIdx.x; i < (LDS_BYTES - RING_BYTES) / 4; i += NWAVES * 64) ((LAS unsigned*)(lds + RING_BYTES))[i] = 0u;
    __syncthreads();
    XcdBarrier bar = xcd_barrier_post((unsigned*)(args.C.ws + WS_CTL) + CW_BAR, MISC + 8);
    LAS int* tbl = (LAS int*)(lds + RING_BYTES + 1024);
    const int lo = args.ph_lo, hi = args.ph_hi;

    for (int l = 0; l < DEPTH; ++l) {
        const int p0 = l * PH_PER_LAYER;
#ifndef PHASE_MASK
#define PHASE_MASK 0x1FFF
#endif
#define IN(k) (((PHASE_MASK >> (k)) & 1) && lo <= p0 + (k) && p0 + (k) < hi)
#define LAUNDER() const __attribute__((address_space(4))) Args* ap_ = (const __attribute__((address_space(4))) Args*)__builtin_amdgcn_kernarg_segment_ptr(); asm volatile("" : "+s"(ap_)); CtxRef C = ap_->C; \
        int bxl_ = blockIdx.x; asm volatile("" : "+s"(bxl_)); const int bx = bxl_;     \
        int tid = threadIdx.x; asm volatile("" : "+v"(tid)); const int lane = tid & 63; const int wave = __builtin_amdgcn_readfirstlane(tid >> 6); const int gw = bx * NWAVES + wave; (void)gw; (void)lane; \
        wsh_t wsh = (wsh_t)(lds + wave * 16384); (void)wsh
#define SEAM(k) do { if (p0 + (k) + 1 < hi) xcd_barrier(bar); } while (0)
        if (IN(0)) { LAUNDER(); stage_convert(C, l, gw, ngw, lane, wsh); SEAM(0); }
        if (IN(1)) { LAUNDER();
            pg8::Gemm g{WSP(bf16_t, WS_XB), WSP(bf16_t, WS_WIN), DM, DM, DM};
            pg8::DenseOrder S{T / 256, DINP / 256, G, bx, (long)256 * DM * 2, (long)256 * DM * 2};
            EpiU E{WSP(bf16_t, WS_U)};
            pg8::gemm_phase(lds, g, S, E); SEAM(1); }
        if (IN(2)) { LAUNDER();
            {   pg8::Gemm g{WSP(bf16_t, WS_U) + UD_CQ, WSP(bf16_t, WS_WUQ), DINP, 256, 256};
                pg8::DenseOrder S{T / 256, 2, G, bx, (long)256 * DINP * 2, (long)256 * 256 * 2};
                EpiQ E{WSP(float, WS_ROPE), WSP(bf16_t, WS_AQ)};
                pg8::gemm_phase(lds, g, S, E); }
            {   pg8::Gemm g{WSP(bf16_t, WS_U) + UD_CKV, WSP(bf16_t, WS_WUKV), DINP, 256, 256};
                pg8::DenseOrder S{T / 256, 2, G, bx, (long)256 * DINP * 2, (long)256 * 256 * 2};
                EpiKV E{WSP(bf16_t, WS_AK), WSP(bf16_t, WS_AV)};
                pg8::gemm_phase(lds, g, S, E); }
            __syncthreads();
            mla_token_pass(C, gw, ngw, lane);
            SEAM(2); }
        if (IN(3)) { LAUNDER();
            lin::stage1_units<0>(lds, C, l, bx, G);
            lin::stage1_units<1>(lds, C, l, bx, G);
            for (int uu = bx; uu < BATCH * NH * (SEQ / 64); uu += G) { const int bh = uu / (SEQ / 64), ch = uu % (SEQ / 64); rw7::stage1_unit(lds, C, l, bh >> 2, bh & 3, ch); }
            SEAM(3); }
        if (IN(4)) { LAUNDER();
            if (bx < 32) rw7::stage2_run(lds, C, bx >> 2, bx & 3);
            else if (bx < 64) lin::stage2_run<0>(lds, C, (bx - 32) >> 2, (bx - 32) & 3);
            else if (bx < 96) lin::stage2_run<1>(lds, C, (bx - 64) >> 2, (bx - 64) & 3);
            else {
                LAS int* slot = (LAS int*)(lds + RING_BYTES + 512);
                unsigned* ctr = WSP(unsigned, WS_CTL) + CW_ATT + l * 64;
                constexpr int NQB = SEQ / 256, NUNIT = BATCH * NH * NQB;
                for (;;) {
                    if (tid == 0) *slot = (int)atomicAdd(ctr, 1u);
                    __syncthreads();
                    const int uidx = *slot;
                    __syncthreads();
                    if (uidx >= NUNIT) break;
                    const int qb = NQB - 1 - uidx / (BATCH * NH), bh = uidx % (BATCH * NH);
                    att::unit(lds, WSP(bf16_t, WS_AQ), WSP(bf16_t, WS_AK), WSP(bf16_t, WS_AV), WSP(float, WS_RSTD), WSP(bf16_t, WS_MIX), bh >> 2, bh & 3, qb);
                }
            }
            SEAM(4); }
        if (IN(5)) { LAUNDER(); stage_post_v(C, l, gw, ngw, lane); SEAM(5); }
        if (IN(6)) { LAUNDER();
            pg8::Gemm g{WSP(bf16_t, WS_MIX), WSP(bf16_t, WS_WOUT), DMIX, DMIX, DMIX};
            pg8::DenseOrder S{T / 256, DM / 256, G, bx, (long)256 * DMIX * 2, (long)256 * DMIX * 2};
            EpiPre1 E{l == 0 ? INF(I_X) : WSP(float, WS_X), C.out};
            pg8::gemm_phase(lds, g, S, E); SEAM(6); }
        if (IN(7)) { LAUNDER(); ln1_router_coop(C, l, lds); SEAM(7); }
        if (IN(8)) { LAUNDER();
            stage_gather_v(C, l, gw, ngw, lane);
            pg8::Gemm g{WSP(bf16_t, WS_PB), WSP(bf16_t, WS_WP), DPLE, DPLE, DPLE};
            pg8::DenseOrder S{T / 256, DM / 256, G, bx, (long)256 * DPLE * 2, (long)256 * DPLE * 2};
            EpiPP E{WSP(bf16_t, WS_PP)};
            pg8::gemm_phase(lds, g, S, E); SEAM(8); }
        if (IN(9)) { LAUNDER();
            pg8::Gemm g{WSP(bf16_t, WS_XG), WSP(bf16_t, WS_WGU), DM, DM, DM};
            const int ntile = moe_fill_table(C, l, tbl, tid);
            pg8::MoeOrder S{tbl, ntile, 2 * DEXP / 256, G, bx, (long)256 * DM * 2, (long)256 * DM * 2, (long)2 * DEXP * DM * 2};
            EpiH E{WSP(bf16_t, WS_H)};
            pg8::gemm_phase(lds, g, S, E); SEAM(9); }
        if (IN(10)) { LAUNDER();
            pg8::Gemm g{WSP(bf16_t, WS_H), WSP(bf16_t, WS_WD), DEXP, DEXP, DEXP};
            const int ntile = moe_fill_table(C, l, tbl, tid);
            pg8::MoeOrder S{tbl, ntile, DM / 256, G, bx, (long)256 * DEXP * 2, (long)256 * DEXP * 2, (long)DM * DEXP * 2};
            EpiY E{WSP(int, WS_ROWINFO), WSP(float, WS_ROWGATE), WSP(bf16_t, WS_YBUF)};
            pg8::gemm_phase(lds, g, S, E); SEAM(10); }
        if (IN(11)) { LAUNDER();
            pg8::Gemm g{WSP(bf16_t, WS_XB), WSP(bf16_t, WS_WPG), DM, DM, DM};
            pg8::DenseOrder S{T / 256, DM / 256, G, bx, (long)256 * DM * 2, (long)256 * DM * 2};
            EpiPre2 E{C.out, WSP(bf16_t, WS_YBUF), WSP(bf16_t, WS_PP), INF(I_PLEBG) + l * DM, WSP(float, WS_X)};
            pg8::gemm_phase(lds, g, S, E); SEAM(11); }
        if (IN(12)) { LAUNDER(); stage_ln2_v(C, l, gw, ngw, lane); SEAM(12); }
#undef IN
#undef SEAM
    }
}

extern "C" void kernel_launch(void* const* d_in, const int* in_sizes, int n_in, void* d_out, int out_size, void* d_ws, size_t ws_size, hipStream_t stream) {
    static int grid = 0;
    if (grid == 0) {
        if (n_in != N_IN || out_size != T * DM || ws_size < WS_END) { fprintf(stderr, "kernel_launch: bad sizes n_in %d out %d ws %zu need %zu\n", n_in, out_size, ws_size, (size_t)WS_END); grid = -1; return; }
        int dev = 0, cus = 0, per_cu = 0;
        hipGetDevice(&dev); hipDeviceGetAttribute(&cus, hipDeviceAttributeMultiprocessorCount, dev);
        if (hipFuncSetAttribute((const void*)mega, hipFuncAttributeMaxDynamicSharedMemorySize, LDS_BYTES) != hipSuccess) { fprintf(stderr, "hipFuncSetAttribute failed\n"); grid = -1; return; }
        if (hipOccupancyMaxActiveBlocksPerMultiprocessor(&per_cu, (const void*)mega, NWAVES * 64, LDS_BYTES) != hipSuccess || per_cu < 1) { fprintf(stderr, "occupancy query: %d\n", per_cu); }
        (void)hipGetLastError();
        grid = cus;
    }
    if (grid < 0) return;
    hipMemsetAsync((char*)d_ws + WS_CTL, 0, CTL_BYTES, stream);
    Args a{};
    for (int i = 0; i < N_IN; ++i) a.C.in[i] = d_in[i];
    a.C.out = (float*)d_out; a.C.ws = (unsigned char*)d_ws;
#ifndef ONE_LAUNCH
    for (int ph = 0; ph < NPHASES; ++ph) { a.ph_lo = ph; a.ph_hi = ph + 1; hipLaunchKernelGGL(mega, dim3(grid), dim3(NWAVES * 64), LDS_BYTES, stream, a); }
#else
    a.ph_lo = 0; a.ph_hi = NPHASES; hipLaunchKernelGGL(mega, dim3(grid), dim3(NWAVES * 64), LDS_BYTES, stream, a);
#endif
}
#else
template <class E> static void cpu_gemm(const bf16_t* A, int lda, const bf16_t* Bt, int ldb, int K, int M, int N, const E& e, const int* base = nullptr, long estep = 0) {
    for (int row = 0; row < M; ++row) {
        const bf16_t* B = Bt;
        if (base) B = Bt + (size_t)moe_expert_of_row(base, row) * estep;
        if constexpr (E::MODE == 1) {
            for (int hc = 0; hc < N / 2; hc += 8) { float g[8], u[8];
                for (int j = 0; j < 8; ++j) { float ag = 0.f, au = 0.f; const bf16_t* bg = B + (size_t)rowmap(1, hc + j) * ldb; const bf16_t* bu = B + (size_t)rowmap(2, hc + j) * ldb;
                    for (int k = 0; k < K; ++k) { const float a = bf2f(A[(size_t)row * lda + k]); ag += a * bf2f(bg[k]); au += a * bf2f(bu[k]); } g[j] = ag; u[j] = au; }
                e.put8gu(row, hc, g, u); }
        } else if constexpr (E::PERM) {
            for (int c = 0; c < N; c += 8) { float a8[8];
                for (int j = 0; j < 8; ++j) { float acc = 0.f; for (int k = 0; k < K; ++k) acc += bf2f(A[(size_t)row * lda + k]) * bf2f(B[(size_t)(c + j) * ldb + k]); a8[j] = acc; }
                e.put8(row, c, a8); }
        } else {
            for (int c = 0; c < N; c += 4) { float a4[4];
                for (int j = 0; j < 4; ++j) { float acc = 0.f; for (int k = 0; k < K; ++k) acc += bf2f(A[(size_t)row * lda + k]) * bf2f(B[(size_t)(c + j) * ldb + k]); a4[j] = acc; }
                e.put4(row, c, a4); }
        }
    }
}
static void cpu_forward(CtxRef C) {
    static float shbuf[4096];
    for (int l = 0; l < DEPTH; ++l) {
        stage_convert(C, l, 0, 1, 0, shbuf);
        { EpiU E{WSP(bf16_t, WS_U)}; cpu_gemm(WSP(bf16_t, WS_XB), DM, WSP(bf16_t, WS_WIN), DM, DM, T, DINP, E); }
        stage_prep(C, l, 0, 1, 0, shbuf);
        for (int b = 0; b < BATCH; ++b) for (int h = 0; h < NH; ++h) {
            for (int v = 0; v < 64; ++v) { rwkv_scan_thread(C, b, h, v); gla_scan_thread(C, b, h, v); }
            for (int e = 0; e < 65; ++e) mlstm_scan_thread(C, b, h, e);
            for (int q = 0; q < SEQ; ++q) attn_thread(C, b, h, q, q); }
        stage_post(C, l, 0, 1, 0);
        { EpiPre1 E{l == 0 ? INF(I_X) : WSP(float, WS_X), C.out}; cpu_gemm(WSP(bf16_t, WS_MIX), DMIX, WSP(bf16_t, WS_WOUT), DMIX, DMIX, T, DM, E); }
        stage_ln1_router(C, l, 0, 1, 0, shbuf);
        stage_gather(C, l, 0, 1, 0);
        { EpiPP E{WSP(bf16_t, WS_PP)}; cpu_gemm(WSP(bf16_t, WS_PB), DPLE, WSP(bf16_t, WS_WP), DPLE, DPLE, T, DM, E); }
        int base[NEXP + 1]; moe_bases(C, l, base);
        { EpiH E{WSP(bf16_t, WS_H)}; cpu_gemm(WSP(bf16_t, WS_XG), DM, WSP(bf16_t, WS_WGU), DM, DM, base[NEXP], 2 * DEXP, E, base, (long)2 * DEXP * DM); }
        { EpiY E{WSP(int, WS_ROWINFO), WSP(float, WS_ROWGATE), WSP(bf16_t, WS_YBUF)}; cpu_gemm(WSP(bf16_t, WS_H), DEXP, WSP(bf16_t, WS_WD), DEXP, DEXP, base[NEXP], DM, E, base, (long)DM * DEXP); }
        { EpiPre2 E{C.out, WSP(bf16_t, WS_YBUF), WSP(bf16_t, WS_PP), INF(I_PLEBG) + l * DM, WSP(float, WS_X)}; cpu_gemm(WSP(bf16_t, WS_XB), DM, WSP(bf16_t, WS_WPG), DM, DM, T, DM, E); }
        stage_ln2(C, l, 0, 1, 0);
    }
}
#endif
```

```cpp
#ifndef CPU_TEST
#include <hip/hip_runtime.h>
#include <cstdio>
#include <cstdint>
#define HD __device__ __forceinline__
#define HDM __device__ __forceinline__
#define LANES 64
#else
#include <cmath>
#include <cstdio>
#include <cstdint>
#include <cstring>
#include <algorithm>
#define HD static inline
#define HDM inline
#define LANES 1
#endif

#define ONE_LAUNCH 1
#ifndef CFG_SMALL
constexpr int BATCH = 8, SEQ = 4096, DM = 1024, DEPTH = 4, DPLE = 256, DEXP = 512;
#else
constexpr int BATCH = 2, SEQ = 256, DM = 128, DEPTH = 2, DPLE = 32, DEXP = 128;
#endif
constexpr int T = BATCH * SEQ;
constexpr int DMIX = 1024, GW = 256, HD64 = 64, NH = 4;
constexpr int DIN = 3128, DINP = 3328;
constexpr int UA = 0, UA_R = 0, UA_K = 256, UA_V = 512, UA_WD = 768, UA_AD = 800, UA_GD = 832, DINA = 896;
constexpr int UB = 896, UB_Q = 896, UB_K = 1024, UB_V = 1152, UB_AD = 1408, UB_G = 1424;
constexpr int UC = 1680, UC_Q = 1680, UC_K = 1936, UC_V = 2192, UC_O = 2448, UC_IG = 2704, UC_FG = 2708;
constexpr int UD = 2712, UD_CQ = 2712, UD_CKV = 2968, UD_KR = 3096;
constexpr int NEXP = 32, NGRP = 4, EPG = 8;
constexpr int MAXROWS = 2 * T + NEXP * 256;
constexpr float DN_ALPHA = 1.681792830507429f;
constexpr float LN_EPS = 1e-5f, NORM_EPS = 1e-6f, RWKV_GN_EPS = 64e-5f;
static_assert(DEPTH == 4 || DEPTH == 2, "alpha below assumes depth");
HD float dn_alpha() { return DEPTH == 4 ? 1.681792830507429f : 1.4142135623730951f; }

enum { I_X = 0, I_P, I_POS, I_WIN, I_MU, I_W0, I_WUP, I_A0, I_AUP, I_GUP, I_KK, I_KA, I_RK, I_GNG, I_GNB, I_GLA_UP, I_GLA_B, I_GLA_G,
       I_CONVW, I_CONVB, I_IB, I_FB, I_MLN_G, I_QNG, I_WUQ, I_KVNG, I_WUKV, I_WOUT, I_LN1G, I_LN1B, I_WRG, I_BRG, I_WRE, I_BRE,
       I_WG, I_WU, I_WD, I_PLEG, I_PLEBG, I_PLEW, I_LN2G, I_LN2B, N_IN };

typedef unsigned short bf16_t;
HD float bf2f(bf16_t h) { unsigned u = (unsigned)h << 16; return __builtin_bit_cast(float, u); }
HD bf16_t f2bf(float f) { unsigned u = __builtin_bit_cast(unsigned, f); return (bf16_t)((u + 0x7fffu + ((u >> 16) & 1u)) >> 16); }
#ifndef CPU_TEST
HD unsigned pk2(float lo, float hi) { typedef float f2_t __attribute__((ext_vector_type(2))); typedef __bf16 b2_t __attribute__((ext_vector_type(2)));
    f2_t v = {lo, hi}; b2_t b = __builtin_convertvector(v, b2_t); return __builtin_bit_cast(unsigned, b); }
#else
HD unsigned pk2(float lo, float hi) { return (unsigned)f2bf(lo) | ((unsigned)f2bf(hi) << 16); }
#endif
typedef float f4v __attribute__((vector_size(16)));
typedef unsigned u4v __attribute__((vector_size(16)));
HD void ld8bf(const bf16_t* p, float* o) { const u4v w = *(const u4v*)p;
    for (int j = 0; j < 4; ++j) { o[2 * j] = __builtin_bit_cast(float, w[j] << 16); o[2 * j + 1] = __builtin_bit_cast(float, w[j] & 0xffff0000u); } }
HD void st8bf(bf16_t* p, const float* a) { u4v w; for (int j = 0; j < 4; ++j) w[j] = pk2(a[2 * j], a[2 * j + 1]); *(u4v*)p = w; }

constexpr size_t MiB = (size_t)1 << 20;
constexpr size_t al256(size_t x) { return (x + 255) & ~(size_t)255; }
constexpr size_t WS_CTL = 0, CTL_BYTES = 1 * MiB;
constexpr size_t WS_WIN = WS_CTL + CTL_BYTES;
constexpr size_t WS_WOUT = WS_WIN + al256((size_t)DINP * DM * 2);
constexpr size_t WS_WPG = WS_WOUT + al256((size_t)DM * DMIX * 2);
constexpr size_t WS_WP = WS_WPG + al256((size_t)DM * DM * 2);
constexpr size_t WS_WGU = WS_WP + al256((size_t)DM * DPLE * 2);
constexpr size_t WS_WD = WS_WGU + al256((size_t)NEXP * 2 * DEXP * DM * 2);
constexpr size_t WS_X = WS_WD + al256((size_t)NEXP * DM * DEXP * 2);
constexpr size_t WS_XB = WS_X + al256((size_t)T * DM * 4);
constexpr size_t WS_U = WS_XB + al256((size_t)T * DM * 2);
constexpr size_t WS_MIX = WS_U + al256((size_t)T * DINP * 2);
constexpr size_t WS_PB = WS_MIX + al256((size_t)T * DMIX * 2);
constexpr size_t WS_WUQ = WS_PB + al256((size_t)T * DPLE * 2);
constexpr size_t WS_WUKV = WS_WUQ + al256((size_t)512 * 256 * 2);
constexpr size_t WS_ROPE = WS_WUKV + al256((size_t)512 * 256 * 2);
constexpr size_t WS_RSTD = WS_ROPE + al256((size_t)T * 32 * 4);
constexpr size_t WS_RWW = WS_RSTD + al256((size_t)T * 2 * 4);
constexpr size_t WS_SCR = WS_RWW + al256((size_t)4 * 19456);
constexpr size_t TV = al256((size_t)T * GW * 4);
constexpr size_t WS_RW_R = WS_SCR, WS_RW_W = WS_RW_R + TV, WS_RW_K = WS_RW_W + TV, WS_RW_V = WS_RW_K + TV, WS_RW_A = WS_RW_V + TV,
                 WS_RW_B = WS_RW_A + TV, WS_RW_G = WS_RW_B + TV;
constexpr size_t WS_RW_PL = WS_RW_R, WS_RW_RY = WS_RW_R + (size_t)16 * MiB;
constexpr size_t WS_RW_QG = WS_RW_W, WS_RW_Y0 = WS_RW_K, WS_RW_GC = WS_RW_V;
static_assert(TV >= (size_t)32 * MiB || T < 32768, "chunk buffers alias the f32 field region");
constexpr size_t WS_YA = WS_RW_G + TV, WS_YB = WS_YA + TV, WS_YC = WS_YB + TV;
constexpr size_t WS_DEN = WS_YC + TV;
constexpr size_t WS_QK = WS_DEN + al256((size_t)T * 4 * 4);
constexpr size_t WS_GA = WS_QK + al256((size_t)T * 512 * 4);
constexpr size_t WS_LG = WS_GA + al256((size_t)T * 128 * 4);
constexpr size_t WS_AQ = WS_LG + al256((size_t)T * 8 * 4);
constexpr size_t WS_AK = WS_AQ + al256((size_t)T * 384 * 2);
constexpr size_t WS_AV = WS_AK + al256((size_t)T * 384 * 2);
constexpr size_t WS_RW_GG = WS_AV + al256((size_t)T * 256 * 2);
constexpr size_t WS_RW_VS = WS_RW_GG + al256((size_t)T * 256 * 2);
constexpr size_t WS_RW_BON = WS_RW_VS + al256((size_t)T * 256 * 2);
constexpr size_t WS_GLA_BLOB = WS_QK;
constexpr size_t WS_ML_BLOB = WS_RW_A;
constexpr size_t WS_MIXER_END = WS_RW_BON + al256((size_t)T * 4 * 4);
constexpr size_t WS_XG = WS_SCR;
constexpr size_t WS_H = WS_XG + al256((size_t)MAXROWS * DM * 2);
constexpr size_t WS_YBUF = WS_H + al256((size_t)MAXROWS * DEXP * 2);
constexpr size_t WS_PP = WS_YBUF + al256((size_t)2 * T * DM * 2);
constexpr size_t WS_TOKINFO = WS_PP + al256((size_t)T * DM * 2);
constexpr size_t WS_LIST = WS_TOKINFO + al256((size_t)T * 16);
constexpr size_t WS_ROWINFO = WS_LIST + al256((size_t)NEXP * T * 4);
constexpr size_t WS_ROWGATE = WS_ROWINFO + al256((size_t)MAXROWS * 4);
constexpr size_t WS_MOE_END = WS_ROWGATE + al256((size_t)MAXROWS * 4);
constexpr size_t WS_END = WS_MIXER_END > WS_MOE_END ? WS_MIXER_END : WS_MOE_END;
constexpr int CW_BAR = 4096;
constexpr int CW_CVQ = 12288;
constexpr int CW_ATT = 8192;
constexpr int CW_CNT = 16384;

struct Ctx {
    const void* in[N_IN];
    float* out;
    unsigned char* ws;
};
#ifndef CPU_TEST
typedef const __attribute__((address_space(4))) Ctx& CtxRef;
#else
typedef const Ctx& CtxRef;
#endif
#define INF(i) ((const float*)C.in[i])
#define WSP(T_, off) ((T_*)(C.ws + (off)))

#ifndef CPU_TEST
HD float dpp_f(float v, int sel) { const int x = __builtin_bit_cast(int, v); int y;
    if (sel == 0) y = __builtin_amdgcn_update_dpp(0, x, 0xB1, 0xF, 0xF, true);
    else if (sel == 1) y = __builtin_amdgcn_update_dpp(0, x, 0x4E, 0xF, 0xF, true);
    else if (sel == 2) y = __builtin_amdgcn_update_dpp(0, x, 0x141, 0xF, 0xF, true);
    else y = __builtin_amdgcn_update_dpp(0, x, 0x140, 0xF, 0xF, true);
    return __builtin_bit_cast(float, y); }
HD float wave_sum(float v) {
    v += dpp_f(v, 0); v += dpp_f(v, 1); v += dpp_f(v, 2); v += dpp_f(v, 3);
    const int x = __builtin_bit_cast(int, v);
    return (__builtin_bit_cast(float, __builtin_amdgcn_readlane(x, 0)) + __builtin_bit_cast(float, __builtin_amdgcn_readlane(x, 16))) +
           (__builtin_bit_cast(float, __builtin_amdgcn_readlane(x, 32)) + __builtin_bit_cast(float, __builtin_amdgcn_readlane(x, 48))); }
HD float wave_max(float v) {
    v = fmaxf(v, dpp_f(v, 0)); v = fmaxf(v, dpp_f(v, 1)); v = fmaxf(v, dpp_f(v, 2)); v = fmaxf(v, dpp_f(v, 3));
    const int x = __builtin_bit_cast(int, v);
    return fmaxf(fmaxf(__builtin_bit_cast(float, __builtin_amdgcn_readlane(x, 0)), __builtin_bit_cast(float, __builtin_amdgcn_readlane(x, 16))),
                 fmaxf(__builtin_bit_cast(float, __builtin_amdgcn_readlane(x, 32)), __builtin_bit_cast(float, __builtin_amdgcn_readlane(x, 48)))); }
HD unsigned atom_add(unsigned* p, unsigned v) { return atomicAdd(p, v); }
#define WSYNC() __builtin_amdgcn_wave_barrier(); asm volatile("s_waitcnt lgkmcnt(0)" ::: "memory")
typedef __attribute__((address_space(3))) float* wsh_t;
#else
HD float wave_sum(float v) { return v; }
HD float wave_max(float v) { return v; }
HD unsigned atom_add(unsigned* p, unsigned v) { unsigned o = *p; *p += v; return o; }
#define WSYNC()
typedef float* wsh_t;
#endif
#ifndef CPU_TEST
HD float sigmoidf_(float x) { return __builtin_amdgcn_rcpf(1.f + __expf(-x)); }
HD float tanhf_(float x) { const float xc = fminf(fmaxf(x, -15.f), 15.f); return 1.f - 2.f * __builtin_amdgcn_rcpf(1.f + __expf(2.f * xc)); }
#else
HD float sigmoidf_(float x) { return 1.f / (1.f + expf(-x)); }
HD float tanhf_(float x) { return tanhf(x); }
#endif
#ifndef CPU_TEST
HD float softplusf_(float x) { return x > 15.f ? x : __logf(1.f + __expf(x)); }
#else
HD float softplusf_(float x) { return x > 20.f ? x : (x < -20.f ? expf(x) : log1pf(expf(x))); }
#endif
HD float siluf_(float x) { return x * sigmoidf_(x); }

HD int rowmap(int mode, int n) { return mode == 0 ? n : (mode == 1 ? (n >> 7) * 256 + (n & 127) : (n >> 7) * 256 + 128 + (n & 127)); }
HD void transpose_item(const float* W, int K, int N, int ldw, bf16_t* WT, int ldk, int mode, int item, int lane, wsh_t scr) {
    const int nblk = (N + 31) / 32, kb = item / nblk, nb = item % nblk, k0 = 64 * kb, n0 = 32 * nb;
    for (int idx = lane; idx < 2048; idx += LANES) { const int kk = idx >> 5, nn = idx & 31; const int n = n0 + nn;
        scr[kk * 33 + nn] = (n < N) ? W[(size_t)(k0 + kk) * ldw + n] : 0.f; }
    WSYNC();
    for (int idx = lane; idx < 256; idx += LANES) { const int n = idx >> 3, c = idx & 7;
        unsigned o[4];
        for (int j = 0; j < 4; ++j) o[j] = pk2(scr[(8 * c + 2 * j) * 33 + n], scr[(8 * c + 2 * j + 1) * 33 + n]);
        unsigned* dst = (unsigned*)(WT + (size_t)rowmap(mode, n0 + n) * ldk + k0 + 8 * c);
        dst[0] = o[0]; dst[1] = o[1]; dst[2] = o[2]; dst[3] = o[3]; }
    WSYNC();
}
HD void stage_convert(CtxRef C, int l, int gw, int ngw, int lane, wsh_t scr) {
    constexpr int NB_IN = DINP / 32;
    constexpr int I_IN = (DM / 64) * NB_IN, I_OUT = (DMIX / 64) * (DM / 32), I_PG = (DM / 64) * (DM / 32), I_PW = (DPLE / 64 > 0 ? DPLE / 64 : 1) * (DM / 32);
    constexpr int I_G1 = (DM / 64) * (DEXP / 32), I_D1 = (DEXP / 64) * (DM / 32);
#ifndef CPU_TEST
    constexpr int NIT = I_IN + I_OUT + I_PG + I_PW;
#else
    constexpr int NIT = I_IN + I_OUT + I_PG + I_PW + NEXP * (2 * I_G1 + I_D1);
#endif
    static_assert(DPLE % 32 == 0 && DEXP % 64 == 0, "shapes");
    for (int it = gw; it < NIT; it += ngw) {
        int r = it;
        if (r < I_IN) {
            const int nblk = NB_IN, kb = r / nblk, nb = r % nblk, k0 = 64 * kb, n0 = 32 * nb;
            const float* W = INF(I_WIN) + (size_t)l * DM * DIN; bf16_t* WT = WSP(bf16_t, WS_WIN);
            for (int idx = lane; idx < 2048; idx += LANES) { const int kk = idx >> 5, nn = idx & 31; const int n = n0 + nn;
                scr[kk * 33 + nn] = (n < DIN) ? W[(size_t)(k0 + kk) * DIN + n] : 0.f; }
            WSYNC();
            for (int idx = lane; idx < 256; idx += LANES) { const int n = idx >> 3, c = idx & 7; unsigned o[4];
                for (int j = 0; j < 4; ++j) o[j] = pk2(scr[(8 * c + 2 * j) * 33 + n], scr[(8 * c + 2 * j + 1) * 33 + n]);
                unsigned* dst = (unsigned*)(WT + (size_t)(n0 + n) * DM + k0 + 8 * c); dst[0] = o[0]; dst[1] = o[1]; dst[2] = o[2]; dst[3] = o[3]; }
            WSYNC();
            continue; }
        r -= I_IN;
        if (r < I_OUT) { transpose_item(INF(I_WOUT) + (size_t)l * DMIX * DM, DMIX, DM, DM, WSP(bf16_t, WS_WOUT), DMIX, 0, r, lane, scr); continue; } r -= I_OUT;
        if (r < I_PG) { transpose_item(INF(I_PLEG) + (size_t)l * DM * DM, DM, DM, DM, WSP(bf16_t, WS_WPG), DM, 0, r, lane, scr); continue; } r -= I_PG;
        if (r < I_PW) {
            if (DPLE >= 64) transpose_item(INF(I_PLEW) + (size_t)l * DPLE * DM, DPLE, DM, DM, WSP(bf16_t, WS_WP), DPLE, 0, r, lane, scr);
            continue; } r -= I_PW;
        const int e = r / (2 * I_G1 + I_D1); r -= e * (2 * I_G1 + I_D1);
        if (r < I_G1) { transpose_item(INF(I_WG) + ((size_t)l * NEXP + e) * DM * DEXP, DM, DEXP, DEXP, WSP(bf16_t, WS_WGU) + (size_t)e * 2 * DEXP * DM, DM, 1, r, lane, scr); continue; } r -= I_G1;
        if (r < I_G1) { transpose_item(INF(I_WU) + ((size_t)l * NEXP + e) * DM * DEXP, DM, DEXP, DEXP, WSP(bf16_t, WS_WGU) + (size_t)e * 2 * DEXP * DM, DM, 2, r, lane, scr); continue; } r -= I_G1;
        transpose_item(INF(I_WD) + ((size_t)l * NEXP + e) * DEXP * DM, DEXP, DM, DM, WSP(bf16_t, WS_WD) + (size_t)e * DM * DEXP, DEXP, 0, r, lane, scr);
    }
    {   const float* wq = INF(I_WUQ) + (size_t)l * 256 * 384; const float* gq = INF(I_QNG) + l * 256; bf16_t* o = WSP(bf16_t, WS_WUQ);
        for (int i = gw * LANES + lane; i < 512 * 256; i += ngw * LANES) { const int n = i >> 8, k = i & 255; o[i] = f2bf(n < 384 ? gq[k] * wq[(size_t)k * 384 + n] : 0.f); }
        const float* wk = INF(I_WUKV) + (size_t)l * 128 * 512; const float* gk = INF(I_KVNG) + l * 128; bf16_t* o2 = WSP(bf16_t, WS_WUKV);
        for (int i = gw * LANES + lane; i < 512 * 256; i += ngw * LANES) { const int n = i >> 8, k = i & 255; o2[i] = f2bf(k < 128 ? gk[k] * wk[(size_t)k * 512 + n] : 0.f); } }
    {
        const float* wup = INF(I_WUP) + l * 32 * GW; const float* aup = INF(I_AUP) + l * 32 * GW; const float* gup = INF(I_GUP) + l * 64 * GW; bf16_t* o = WSP(bf16_t, WS_RWW);
        for (int i = gw * LANES + lane; i < 4 * 9728; i += ngw * LANES) { const int h = i / 9728, r = i % 9728; float v = 0.f;
            if (r < 2560) { const int c = r / 40, j = r % 40; if (j < 32) v = wup[j * GW + h * 64 + c]; }
            else if (r < 5120) { const int c = (r - 2560) / 40, j = (r - 2560) % 40; if (j < 32) v = aup[j * GW + h * 64 + c]; }
            else { const int c = (r - 5120) / 72, j = (r - 5120) % 72; if (j < 64) v = gup[j * GW + h * 64 + c]; }
            o[i] = f2bf(v); } }
    if (l == 0) {
        const int* pos = (const int*)C.in[I_POS]; float* rt = WSP(float, WS_ROPE);
        for (int i = gw * LANES + lane; i < T * 16; i += ngw * LANES) { const int t = i >> 4, f = i & 15; const float ang = (float)pos[t] * powf(10000.f, -(float)f / 16.f);
            rt[(size_t)t * 32 + f] = cosf(ang); rt[(size_t)t * 32 + 16 + f] = sinf(ang); } }
    {   const float* p = INF(I_P) + (size_t)l * T * DPLE; bf16_t* pb = WSP(bf16_t, WS_PB);
        const size_t n4 = (size_t)T * DPLE / 4;
        for (size_t i = (size_t)gw * LANES + lane; i < n4; i += (size_t)ngw * LANES) {
            const float* s = p + 4 * i; unsigned* d = (unsigned*)(pb + 4 * i); d[0] = pk2(s[0], s[1]); d[1] = pk2(s[2], s[3]); } }
    if (l == 0) { const float* x = INF(I_X); bf16_t* xb = WSP(bf16_t, WS_XB);
        const size_t n4 = (size_t)T * DM / 4;
        for (size_t i = (size_t)gw * LANES + lane; i < n4; i += (size_t)ngw * LANES) {
            const float* s = x + 4 * i; unsigned* d = (unsigned*)(xb + 4 * i); d[0] = pk2(s[0], s[1]); d[1] = pk2(s[2], s[3]); } }
#ifdef CFG_SMALL
    if (DPLE < 64) {
        const float* W = INF(I_PLEW) + (size_t)l * DPLE * DM; bf16_t* WT = WSP(bf16_t, WS_WP);
        for (int i = gw * LANES + lane; i < DPLE * DM; i += ngw * LANES) { const int k = i / DM, n = i % DM; WT[(size_t)n * DPLE + k] = f2bf(W[i]); } }
#endif
}

HD float ubf(const bf16_t* u, int t, int c) { return bf2f(u[(size_t)t * DINP + c]); }
HD void stage_prep(CtxRef C, int l, int gw, int ngw, int lane, wsh_t sh) {
    const bf16_t* u = WSP(bf16_t, WS_U);
    const float* mu = INF(I_MU) + l * DINA; const float* w0 = INF(I_W0) + l * GW; const float* wup = INF(I_WUP) + l * 32 * GW;
    const float* a0 = INF(I_A0) + l * GW; const float* aup = INF(I_AUP) + l * 32 * GW; const float* gup = INF(I_GUP) + l * 64 * GW;
    const float* kkw = INF(I_KK) + l * GW; const float* kaw = INF(I_KA) + l * GW;
    const float* glaup = INF(I_GLA_UP) + l * 16 * 128; const float* glab = INF(I_GLA_B) + l * 128;
    const float* convw = INF(I_CONVW) + l * 4 * 512; const float* convb = INF(I_CONVB) + l * 512;
    const float* ib = INF(I_IB) + l * 4; const float* fb = INF(I_FB) + l * 4;
    const float* qng = INF(I_QNG) + l * 256; const float* wuq = INF(I_WUQ) + (size_t)l * 256 * 384;
    const float* kvng = INF(I_KVNG) + l * 128; const float* wukv = INF(I_WUKV) + (size_t)l * 128 * 512;
    const int* pos = (const int*)C.in[I_POS];
    float* oR = WSP(float, WS_RW_R); float* oW = WSP(float, WS_RW_W); float* oK = WSP(float, WS_RW_K); float* oV = WSP(float, WS_RW_V);
    float* oA = WSP(float, WS_RW_A); float* oB = WSP(float, WS_RW_B); float* oG = WSP(float, WS_RW_G);
    float* oQK = WSP(float, WS_QK); float* oGA = WSP(float, WS_GA); float* oLG = WSP(float, WS_LG);
    bf16_t* oAQ = WSP(bf16_t, WS_AQ); bf16_t* oAK = WSP(bf16_t, WS_AK); bf16_t* oAV = WSP(bf16_t, WS_AV);
    for (int t = gw; t < T; t += ngw) {
        const int s = t % SEQ;
        for (int j = lane; j < 128; j += LANES) { const int c = UA_WD + j; const float cur = ubf(u, t, c), prev = s > 0 ? ubf(u, t - 1, c) : 0.f;
            const float v = cur + (prev - cur) * mu[c]; sh[j] = j < 32 ? tanhf(v) : (j < 64 ? v : sigmoidf_(v)); }
        WSYNC();
        for (int h = 0; h < NH; ++h) {
            float kkraw[HD64 / LANES]; float kv_[HD64 / LANES], av_[HD64 / LANES]; float ss = 0.f;
            for (int i = 0; i < HD64 / LANES; ++i) { const int c = h * 64 + i * LANES + lane;
                float z = w0[c], za = a0[c], g = 0.f;
_Pragma("unroll 8")
                for (int j = 0; j < 32; ++j) { z += sh[j] * wup[j * GW + c]; za += sh[32 + j] * aup[j * GW + c]; }
_Pragma("unroll 8")
                for (int j = 0; j < 64; ++j) g += sh[64 + j] * gup[j * GW + c];
                const float lnl = -softplusf_(-z) - 0.5f; const float decay = expf(-expf(lnl)); const float a = sigmoidf_(za);
                float r, k, v;
                { const float cur = ubf(u, t, UA_R + c), prev = s > 0 ? ubf(u, t - 1, UA_R + c) : 0.f; r = cur + (prev - cur) * mu[UA_R + c]; }
                { const float cur = ubf(u, t, UA_K + c), prev = s > 0 ? ubf(u, t - 1, UA_K + c) : 0.f; k = cur + (prev - cur) * mu[UA_K + c]; }
                { const float cur = ubf(u, t, UA_V + c), prev = s > 0 ? ubf(u, t - 1, UA_V + c) : 0.f; v = cur + (prev - cur) * mu[UA_V + c]; }
                kkraw[i] = k * kkw[c]; ss += kkraw[i] * kkraw[i];
                kv_[i] = k * (1.f + (a - 1.f) * kaw[c]); av_[i] = a;
                const size_t o = (size_t)t * GW + c; oR[o] = r; oW[o] = decay; oK[o] = kv_[i]; oV[o] = v; oG[o] = g; }
            ss = wave_sum(ss); const float inv = 1.f / fmaxf(sqrtf(ss), 1e-12f);
            for (int i = 0; i < HD64 / LANES; ++i) { const int c = h * 64 + i * LANES + lane; const size_t o = (size_t)t * GW + c; const float kk = kkraw[i] * inv;
                oA[o] = -kk; oB[o] = kk * av_[i]; }
        }
        WSYNC();
        for (int c = lane; c < 128; c += LANES) { float z = glab[c];
            for (int j = 0; j < 16; ++j) z += ubf(u, t, UB_AD + j) * glaup[j * 128 + c];
            oGA[(size_t)t * 128 + c] = -softplusf_(-z) * (1.f / 16.f); }
        for (int c = lane; c < 512; c += LANES) { float y = convb[c];
            for (int j = 0; j < 4; ++j) { const int sp = s - 3 + j; if (sp >= 0) y += convw[j * 512 + c] * ubf(u, t - 3 + j, UC_Q + c); }
            float q = siluf_(y); if (c >= 256) q *= 0.125f; oQK[(size_t)t * 512 + c] = q; }
        for (int c = lane; c < 8; c += LANES) { const float v = ubf(u, t, UC_IG + c);
            oLG[(size_t)t * 8 + c] = c < 4 ? v + ib[c] : -softplusf_(-(v + fb[c - 4])); }
        {   float ssq = 0.f, sskv = 0.f;
            for (int j = lane; j < 256; j += LANES) { const float v = ubf(u, t, UD_CQ + j); ssq += v * v; }
            for (int j = lane; j < 128; j += LANES) { const float v = ubf(u, t, UD_CKV + j); sskv += v * v; }
            ssq = wave_sum(ssq); sskv = wave_sum(sskv);
            const float rq = 1.f / sqrtf(ssq * (1.f / 256.f) + NORM_EPS), rkv = 1.f / sqrtf(sskv * (1.f / 128.f) + NORM_EPS);
            for (int j = lane; j < 256; j += LANES) sh[j] = ubf(u, t, UD_CQ + j) * rq * qng[j];
            for (int j = lane; j < 128; j += LANES) sh[256 + j] = ubf(u, t, UD_CKV + j) * rkv * kvng[j];
            WSYNC();
            for (int n = lane; n < 384; n += LANES) { float acc = 0.f;
_Pragma("unroll 8")
                for (int k = 0; k < 256; ++k) acc += sh[k] * wuq[(size_t)k * 384 + n]; sh[384 + n] = acc; }
            for (int n = lane; n < 512; n += LANES) { float acc = 0.f;
_Pragma("unroll 8")
                for (int k = 0; k < 128; ++k) acc += sh[256 + k] * wukv[(size_t)k * 512 + n]; sh[768 + n] = acc; }
            for (int i = lane; i < 16; i += LANES) { const float invf = powf(10000.f, -(float)i / 16.f); const float ang = (float)pos[t] * invf; sh[1280 + i] = cosf(ang); sh[1296 + i] = sinf(ang); }
            for (int i = lane; i < 32; i += LANES) sh[1312 + i] = ubf(u, t, UD_KR + i);
            WSYNC();
            const float qscale = 0.10206207261596575f * 1.4426950408889634f;
            for (int idx = lane; idx < 384; idx += LANES) { const int h = idx / 96, d = idx % 96; float v;
                if (d < 64) v = sh[384 + idx];
                else { const int i = (d - 64) & 15; const float x1 = sh[384 + h * 96 + 64 + i], x2 = sh[384 + h * 96 + 80 + i]; const float c_ = sh[1280 + i], s_ = sh[1296 + i];
                    v = (d - 64) < 16 ? x1 * c_ - x2 * s_ : x1 * s_ + x2 * c_; }
                oAQ[(size_t)t * 384 + idx] = f2bf(v * qscale); }
            for (int idx = lane; idx < 384; idx += LANES) { const int h = idx / 96, d = idx % 96; float v;
                if (d < 64) v = sh[768 + h * 128 + d];
                else { const int i = (d - 64) & 15; const float x1 = sh[1312 + i], x2 = sh[1328 + i]; const float c_ = sh[1280 + i], s_ = sh[1296 + i];
                    v = (d - 64) < 16 ? x1 * c_ - x2 * s_ : x1 * s_ + x2 * c_; }
                oAK[(size_t)t * 384 + idx] = f2bf(v); }
            for (int idx = lane; idx < 256; idx += LANES) { const int h = idx / 64, d = idx % 64; oAV[(size_t)t * 256 + idx] = f2bf(sh[768 + h * 128 + 64 + d]); }
            WSYNC();
        }
    }
}

HD void rwkv_scan_thread(CtxRef C, int b, int h, int v) {
    const float* pR = WSP(float, WS_RW_R); const float* pW = WSP(float, WS_RW_W); const float* pK = WSP(float, WS_RW_K); const float* pV = WSP(float, WS_RW_V);
    const float* pA = WSP(float, WS_RW_A); const float* pB = WSP(float, WS_RW_B); float* Y = WSP(float, WS_YA);
    float S[64];
#pragma unroll
    for (int k = 0; k < 64; ++k) S[k] = 0.f;
    for (int s = 0; s < SEQ; ++s) {
        const size_t o = ((size_t)b * SEQ + s) * GW + h * 64;
        const float vv = pV[o + v];
        float sa0 = 0.f, sa1 = 0.f, sa2 = 0.f, sa3 = 0.f;
#pragma unroll
        for (int k = 0; k < 64; k += 4) { const f4v a = *(const f4v*)(pA + o + k); sa0 += S[k] * a[0]; sa1 += S[k + 1] * a[1]; sa2 += S[k + 2] * a[2]; sa3 += S[k + 3] * a[3]; }
        const float sa = (sa0 + sa1) + (sa2 + sa3);
        float y0 = 0.f, y1 = 0.f, y2 = 0.f, y3 = 0.f;
#pragma unroll
        for (int k = 0; k < 64; k += 4) {
            const f4v w = *(const f4v*)(pW + o + k), bb = *(const f4v*)(pB + o + k), kk = *(const f4v*)(pK + o + k), r = *(const f4v*)(pR + o + k);
            S[k] = S[k] * w[0] + sa * bb[0] + vv * kk[0]; y0 += S[k] * r[0];
            S[k + 1] = S[k + 1] * w[1] + sa * bb[1] + vv * kk[1]; y1 += S[k + 1] * r[1];
            S[k + 2] = S[k + 2] * w[2] + sa * bb[2] + vv * kk[2]; y2 += S[k + 2] * r[2];
            S[k + 3] = S[k + 3] * w[3] + sa * bb[3] + vv * kk[3]; y3 += S[k + 3] * r[3];
            if ((k & 12) == 12) asm volatile("" ::: "memory"); }
        Y[o + v] = (y0 + y1) + (y2 + y3);
    }
}
HD void gla_scan_thread(CtxRef C, int b, int h, int v) {
    const bf16_t* u = WSP(bf16_t, WS_U); const float* GA = WSP(float, WS_GA); float* Y = WSP(float, WS_YB);
    float S[32];
#pragma unroll
    for (int k = 0; k < 32; ++k) S[k] = 0.f;
    for (int s = 0; s < SEQ; ++s) {
        const int t = b * SEQ + s;
        const float vv = ubf(u, t, UB_V + h * 64 + v);
        float acc = 0.f;
#pragma unroll
        for (int k8 = 0; k8 < 32; k8 += 8) { float kf[8], qf[8];
            ld8bf(u + (size_t)t * DINP + UB_K + h * 32 + k8, kf); ld8bf(u + (size_t)t * DINP + UB_Q + h * 32 + k8, qf);
            const f4v g0 = *(const f4v*)(GA + (size_t)t * 128 + h * 32 + k8), g1 = *(const f4v*)(GA + (size_t)t * 128 + h * 32 + k8 + 4);
#pragma unroll
            for (int j = 0; j < 8; ++j) { const float a = expf(j < 4 ? g0[j & 3] : g1[j & 3]); S[k8 + j] = a * S[k8 + j] + kf[j] * vv; acc += qf[j] * S[k8 + j]; } }
        Y[(size_t)t * GW + h * 64 + v] = acc * 0.17677669529663687f;
    }
}
HD void mlstm_scan_thread(CtxRef C, int b, int h, int e) {
    const bf16_t* u = WSP(bf16_t, WS_U); const float* QK = WSP(float, WS_QK); const float* LG = WSP(float, WS_LG);
    float* Y = WSP(float, WS_YC); float* DEN = WSP(float, WS_DEN);
    float S[64];
#pragma unroll
    for (int k = 0; k < 64; ++k) S[k] = 0.f;
    for (int s = 0; s < SEQ; ++s) {
        const int t = b * SEQ + s;
        const float ig = expf(LG[(size_t)t * 8 + h]), fg = expf(LG[(size_t)t * 8 + 4 + h]);
        const float vv = (e < 64 ? ubf(u, t, UC_V + h * 64 + e) : 1.f) * ig;
        float acc = 0.f;
#pragma unroll
        for (int k = 0; k < 64; k += 4) { const f4v kk = *(const f4v*)(QK + (size_t)t * 512 + 256 + h * 64 + k), qq = *(const f4v*)(QK + (size_t)t * 512 + h * 64 + k);
#pragma unroll
            for (int j = 0; j < 4; ++j) { S[k + j] = fg * S[k + j] + kk[j] * vv; acc += qq[j] * S[k + j]; } }
        if (e < 64) Y[(size_t)t * GW + h * 64 + e] = acc; else DEN[(size_t)t * 4 + h] = acc;
    }
}
HD void attn_thread(CtxRef C, int b, int h, int q, int kmax  ) {
    const bf16_t* Q = WSP(bf16_t, WS_AQ); const bf16_t* K = WSP(bf16_t, WS_AK); const bf16_t* V = WSP(bf16_t, WS_AV); bf16_t* mix = WSP(bf16_t, WS_MIX);
    const int t = b * SEQ + q;
    unsigned qp[48]; float o[64];
#pragma unroll
    for (int d = 0; d < 48; d += 4) { const u4v w = *(const u4v*)(Q + (size_t)t * 384 + h * 96 + 2 * d); qp[d] = w[0]; qp[d + 1] = w[1]; qp[d + 2] = w[2]; qp[d + 3] = w[3]; }
#pragma unroll
    for (int d = 0; d < 64; ++d) o[d] = 0.f;
    float m = -1e30f, lsum = 0.f;
    for (int j = 0; j <= kmax; ++j) {
        const size_t tk = (size_t)b * SEQ + j;
        float sc0 = 0.f, sc1 = 0.f;
#pragma unroll
        for (int d = 0; d < 96; d += 8) { float kf[8]; ld8bf(K + tk * 384 + h * 96 + d, kf);
#pragma unroll
            for (int i = 0; i < 8; i += 2) { const unsigned qw = qp[(d + i) >> 1];
                sc0 += __builtin_bit_cast(float, qw << 16) * kf[i]; sc1 += __builtin_bit_cast(float, qw & 0xffff0000u) * kf[i + 1]; }
            if ((d & 24) == 24) asm volatile("" ::: "memory"); }
        const float sc = sc0 + sc1;
        if (j <= q) {
            const float mn = fmaxf(m, sc); const float corr = exp2f(m - mn), p = exp2f(sc - mn);
            lsum = lsum * corr + p;
#pragma unroll
            for (int d = 0; d < 64; d += 8) { float vf[8]; ld8bf(V + tk * 256 + h * 64 + d, vf);
#pragma unroll
                for (int i = 0; i < 8; ++i) o[d + i] = o[d + i] * corr + p * vf[i];
                if (d & 8) asm volatile("" ::: "memory"); }
            m = mn; }
    }
    const float inv = 1.f / lsum;
#pragma unroll
    for (int d = 0; d < 64; d += 8) { float a[8];
#pragma unroll
        for (int i = 0; i < 8; ++i) a[i] = o[d + i] * inv;
        st8bf(mix + (size_t)t * DMIX + 768 + h * 64 + d, a); }
}

HD void stage_post(CtxRef C, int l, int gw, int ngw, int lane) {
    const bf16_t* u = WSP(bf16_t, WS_U); bf16_t* mix = WSP(bf16_t, WS_MIX);
    const float* YA = WSP(float, WS_YA); const float* YB = WSP(float, WS_YB); const float* YC = WSP(float, WS_YC); const float* DEN = WSP(float, WS_DEN);
    const float* pR = WSP(float, WS_RW_R); const float* pK = WSP(float, WS_RW_K); const float* pV = WSP(float, WS_RW_V); const float* pG = WSP(float, WS_RW_G);
    const float* rk = INF(I_RK) + l * GW; const float* gng = INF(I_GNG) + l * GW; const float* gnb = INF(I_GNB) + l * GW;
    const float* glag = INF(I_GLA_G) + l * GW; const float* mlng = INF(I_MLN_G) + l * GW;
    constexpr int PL = HD64 / LANES;
    for (int t = gw; t < T; t += ngw) {
        for (int h = 0; h < NH; ++h) {
            {   float y[PL], s1 = 0.f, bon = 0.f;
#ifdef CPU_TEST
                for (int i = 0; i < PL; ++i) { const int c = h * 64 + i * LANES + lane; const size_t o = (size_t)t * GW + c; y[i] = YA[o]; s1 += y[i]; bon += pR[o] * pK[o] * rk[c]; }
                s1 = wave_sum(s1); bon = wave_sum(bon);
#else
                for (int i = 0; i < PL; ++i) { const int c = h * 64 + i * LANES + lane; y[i] = YA[(size_t)t * GW + c]; s1 += y[i]; }
                s1 = wave_sum(s1); bon = WSP(float, WS_RW_BON)[(size_t)t * 4 + h];
#endif
                const float mean = s1 * (1.f / 64.f); float s2 = 0.f;
                for (int i = 0; i < PL; ++i) { y[i] -= mean; s2 += y[i] * y[i]; }
                s2 = wave_sum(s2); const float rstd = 1.f / sqrtf(s2 * (1.f / 64.f) + RWKV_GN_EPS);
                for (int i = 0; i < PL; ++i) { const int c = h * 64 + i * LANES + lane; const size_t o = (size_t)t * GW + c;
#ifdef CPU_TEST
                    const float v = (y[i] * rstd * gng[c] + gnb[c] + bon * pV[o]) * pG[o];
#else
                    const float v = (y[i] * rstd * gng[c] + gnb[c] + bon * bf2f(WSP(bf16_t, WS_RW_VS)[o])) * bf2f(WSP(bf16_t, WS_RW_GG)[o]);
#endif
                    mix[(size_t)t * DMIX + c] = f2bf(v); } }
            {   float y[PL], s2 = 0.f;
                for (int i = 0; i < PL; ++i) { const int c = h * 64 + i * LANES + lane; y[i] = YB[(size_t)t * GW + c]; s2 += y[i] * y[i]; }
                s2 = wave_sum(s2); const float rstd = 1.f / sqrtf(s2 * (1.f / 64.f) + NORM_EPS);
                for (int i = 0; i < PL; ++i) { const int c = h * 64 + i * LANES + lane;
                    const float v = y[i] * rstd * glag[c] * siluf_(ubf(u, t, UB_G + c)); mix[(size_t)t * DMIX + 256 + c] = f2bf(v); } }
            {   const float den = DEN[(size_t)t * 4 + h]; const float dinv = 1.f / fmaxf(fabsf(den), 1.f);
                float y[PL], s1 = 0.f;
                for (int i = 0; i < PL; ++i) { const int c = h * 64 + i * LANES + lane; y[i] = YC[(size_t)t * GW + c] * dinv; s1 += y[i]; }
                s1 = wave_sum(s1); const float mean = s1 * (1.f / 64.f); float s2 = 0.f;
                for (int i = 0; i < PL; ++i) { y[i] -= mean; s2 += y[i] * y[i]; }
                s2 = wave_sum(s2); const float rstd = 1.f / sqrtf(s2 * (1.f / 64.f) + LN_EPS);
                for (int i = 0; i < PL; ++i) { const int c = h * 64 + i * LANES + lane;
                    const float v = y[i] * rstd * mlng[c] * sigmoidf_(ubf(u, t, UC_O + c)); mix[(size_t)t * DMIX + 512 + c] = f2bf(v); } }
        }
    }
}

HD void ln_row(const float* src, const float* g, const float* b, float* dstf, bf16_t* dstb, int lane, float* keep  ) {
    constexpr int PL = DM / LANES;
    float s1 = 0.f;
#pragma unroll
    for (int i = 0; i < PL; ++i) { keep[i] = src[i * LANES + lane]; s1 += keep[i]; }
    s1 = wave_sum(s1); const float mean = s1 * (1.f / DM); float s2 = 0.f;
#pragma unroll
    for (int i = 0; i < PL; ++i) { keep[i] -= mean; s2 += keep[i] * keep[i]; }
    s2 = wave_sum(s2); const float rstd = 1.f / sqrtf(s2 * (1.f / DM) + LN_EPS);
#pragma unroll
    for (int i = 0; i < PL; ++i) { const int c = i * LANES + lane; keep[i] = keep[i] * rstd * g[c] + b[c]; dstf[c] = keep[i]; dstb[c] = f2bf(keep[i]); }
}
HD void stage_ln1_router(CtxRef C, int l, int gw, int ngw, int lane, wsh_t sh) {
    float* X1 = C.out; bf16_t* xb = WSP(bf16_t, WS_XB);
    const float* g = INF(I_LN1G) + l * DM; const float* b = INF(I_LN1B) + l * DM;
    const float* wrg = INF(I_WRG) + (size_t)l * DM * NGRP; const float* brg = INF(I_BRG) + l * NGRP;
    const float* wre = INF(I_WRE) + (size_t)l * DM * NEXP; const float* bre = INF(I_BRE) + l * NEXP;
    unsigned* cnt = WSP(unsigned, WS_CTL) + CW_CNT + l * NEXP * 64;
    int* tokinfo = WSP(int, WS_TOKINFO); int* list = WSP(int, WS_LIST);
    constexpr int PL = DM / LANES;
    for (int t = gw; t < T; t += ngw) {
        {   float keep[PL];
            ln_row(X1 + (size_t)t * DM, g, b, X1 + (size_t)t * DM, xb + (size_t)t * DM, lane, keep);
#pragma unroll
            for (int i = 0; i < PL; ++i) sh[i * LANES + lane] = keep[i]; }
        WSYNC();
        float lg[NGRP], le[NEXP];
#pragma unroll
        for (int j = 0; j < NGRP; ++j) lg[j] = 0.f;
#pragma unroll
        for (int j = 0; j < NEXP; ++j) le[j] = 0.f;
#pragma unroll 1
        for (int i = 0; i < PL; ++i) { const int c = i * LANES + lane; const float xv = sh[c];
            const f4v wg = *(const f4v*)(wrg + (size_t)c * NGRP);
#pragma unroll
            for (int j = 0; j < NGRP; ++j) lg[j] += xv * wg[j];
#pragma unroll
            for (int j = 0; j < NEXP; j += 4) { const f4v we = *(const f4v*)(wre + (size_t)c * NEXP + j);
                le[j] += xv * we[0]; le[j + 1] += xv * we[1]; le[j + 2] += xv * we[2]; le[j + 3] += xv * we[3]; } }
        WSYNC();
#pragma unroll
        for (int j = 0; j < NGRP; ++j) lg[j] = wave_sum(lg[j]) + brg[j];
#pragma unroll
        for (int j = 0; j < NEXP; ++j) le[j] = wave_sum(le[j]) + bre[j];
        int gi = 0; float gm = lg[0];
#pragma unroll
        for (int j = 1; j < NGRP; ++j) if (lg[j] > gm) { gm = lg[j]; gi = j; }
        float gs = 0.f;
#pragma unroll
        for (int j = 0; j < NGRP; ++j) gs += expf(lg[j] - gm);
        const float group_p = 1.f / gs;
        float el[EPG];
#pragma unroll
        for (int j = 0; j < EPG; ++j) { float v = le[j];
#pragma unroll
            for (int g2 = 1; g2 < NGRP; ++g2) v = (gi == g2) ? le[g2 * EPG + j] : v;
            el[j] = v; }
        int e0 = 0; float m0 = el[0];
#pragma unroll
        for (int j = 1; j < EPG; ++j) if (el[j] > m0) { m0 = el[j]; e0 = j; }
        int e1 = -1; float m1 = -3.0e38f;
#pragma unroll
        for (int j = 0; j < EPG; ++j) if (j != e0 && el[j] > m1) { m1 = el[j]; e1 = j; }
        const float p1 = expf(m1 - m0); const float g0 = group_p / (1.f + p1), g1 = group_p * p1 / (1.f + p1);
        if (lane == 0) {
            const int E0 = gi * EPG + e0, E1 = gi * EPG + e1;
            tokinfo[(size_t)t * 4 + 0] = E0; tokinfo[(size_t)t * 4 + 1] = E1;
            ((float*)tokinfo)[(size_t)t * 4 + 2] = g0; ((float*)tokinfo)[(size_t)t * 4 + 3] = g1;
            const unsigned s0 = atom_add(cnt + E0 * 64, 1u); list[(size_t)E0 * T + s0] = t * 2 + 0;
            const unsigned s1 = atom_add(cnt + E1 * 64, 1u); list[(size_t)E1 * T + s1] = t * 2 + 1;
        }
    }
}
HD void moe_bases(CtxRef C, int l, int* base  ) {
    const unsigned* cnt = WSP(unsigned, WS_CTL) + CW_CNT + l * NEXP * 64;
    int acc = 0;
    for (int e = 0; e < NEXP; ++e) { base[e] = acc; acc += ((int)cnt[e * 64] + 255) & ~255; }
    base[NEXP] = acc;
}
HD int moe_expert_of_row(const int* base, int row) { int e = 0; for (int j = 1; j < NEXP; ++j) if (row >= base[j]) e = j; return e; }
HD int moe_lookup(const unsigned* cnt, int row, int& e, int& be, int& ce) {
    int acc = 0; e = 0; be = 0; ce = 0;
    for (int j = 0; j < NEXP; ++j) { const int c = (int)cnt[j * 64]; if (row >= acc) { e = j; be = acc; ce = c; } acc += (c + 255) & ~255; }
    return acc;
}
HD void stage_gather(CtxRef C, int l, int gw, int ngw, int lane) {
    const unsigned* cnt = WSP(unsigned, WS_CTL) + CW_CNT + l * NEXP * 64;
    const int* list = WSP(int, WS_LIST); const int* tokinfo = WSP(int, WS_TOKINFO);
    const bf16_t* xb = WSP(bf16_t, WS_XB); bf16_t* xg = WSP(bf16_t, WS_XG); int* rowinfo = WSP(int, WS_ROWINFO); float* rowgate = WSP(float, WS_ROWGATE);
    int e, be, ce; const int total = moe_lookup(cnt, 0, e, be, ce);
    for (int row = gw; row < total; row += ngw) {
        moe_lookup(cnt, row, e, be, ce);
        const int slot = row - be;
        if (slot < ce) { const int ent = list[(size_t)e * T + slot]; const int tok = ent >> 1;
            for (int c = lane * 8; c < DM; c += LANES * 8) *(u4v*)(xg + (size_t)row * DM + c) = *(const u4v*)(xb + (size_t)tok * DM + c);
            if (lane == 0) { rowinfo[row] = ent; rowgate[row] = ((const float*)tokinfo)[(size_t)tok * 4 + 2 + (ent & 1)]; } }
        else { const u4v z = {0u, 0u, 0u, 0u}; for (int c = lane * 8; c < DM; c += LANES * 8) *(u4v*)(xg + (size_t)row * DM + c) = z;
            if (lane == 0) { rowinfo[row] = -1; rowgate[row] = 0.f; } }
    }
}
HD void stage_ln2(CtxRef C, int l, int gw, int ngw, int lane) {
    const float* src = WSP(float, WS_X); float* dst = (l == DEPTH - 1) ? C.out : WSP(float, WS_X); bf16_t* xb = WSP(bf16_t, WS_XB);
    const float* g = INF(I_LN2G) + l * DM; const float* b = INF(I_LN2B) + l * DM;
    constexpr int PL = DM / LANES;
    for (int t = gw; t < T; t += ngw) { float keep[PL]; ln_row(src + (size_t)t * DM, g, b, dst + (size_t)t * DM, xb + (size_t)t * DM, lane, keep); }
}

struct EpiU {
    static constexpr bool PERM = true; static constexpr int MODE = 0;
    bf16_t* o;
    HDM void put8(int row, int col, const float* a) const { st8bf(o + (size_t)row * DINP + col, a); }
};
struct EpiPP {
    static constexpr bool PERM = true; static constexpr int MODE = 0;
    bf16_t* o;
    HDM void put8(int row, int col, const float* a) const { st8bf(o + (size_t)row * DM + col, a); }
};
struct EpiPre1 {
    static constexpr bool PERM = false; static constexpr int MODE = 0;
    const float* x; float* o;
    HDM void put4(int row, int col, const float* a) const { const float al = dn_alpha(); const f4v xr = *(const f4v*)(x + (size_t)row * DM + col);
        f4v r; for (int j = 0; j < 4; ++j) r[j] = al * xr[j] + a[j]; *(f4v*)(o + (size_t)row * DM + col) = r; }
};
struct EpiH {
    static constexpr bool PERM = true; static constexpr int MODE = 1;
    bf16_t* o;
    HDM void put8gu(int row, int hcol, const float* g, const float* u) const { float v[8]; for (int j = 0; j < 8; ++j) v[j] = siluf_(g[j]) * u[j];
        st8bf(o + (size_t)row * DEXP + hcol, v); }
};
struct EpiY {
    static constexpr bool PERM = true; static constexpr int MODE = 0;
    const int* rowinfo; const float* rowgate; bf16_t* o;
    HDM void put8(int row, int col, const float* a) const { const int ent = rowinfo[row]; if (ent < 0) return; const float g = rowgate[row];
        float v[8]; for (int j = 0; j < 8; ++j) v[j] = g * a[j]; st8bf(o + (size_t)ent * DM + col, v); }
};
struct EpiPre2 {
    static constexpr bool PERM = false; static constexpr int MODE = 0;
    const float* x1; const bf16_t* ybuf; const bf16_t* pp; const float* bg; float* o;
    HDM void put4(int row, int col, const float* a) const { const float al = dn_alpha(); const size_t i = (size_t)row * DM + col;
        const f4v xr = *(const f4v*)(x1 + i); const f4v bgv = *(const f4v*)(bg + col);
        const unsigned* y0 = (const unsigned*)(ybuf + (size_t)(2 * row) * DM + col); const unsigned* y1 = (const unsigned*)(ybuf + (size_t)(2 * row + 1) * DM + col); const unsigned* pq = (const unsigned*)(pp + i);
        const unsigned y00 = y0[0], y01 = y0[1], y10 = y1[0], y11 = y1[1], p0 = pq[0], p1 = pq[1];
        float yv[4] = { __builtin_bit_cast(float, y00 << 16) + __builtin_bit_cast(float, y10 << 16), __builtin_bit_cast(float, y00 & 0xffff0000u) + __builtin_bit_cast(float, y10 & 0xffff0000u),
                        __builtin_bit_cast(float, y01 << 16) + __builtin_bit_cast(float, y11 << 16), __builtin_bit_cast(float, y01 & 0xffff0000u) + __builtin_bit_cast(float, y11 & 0xffff0000u) };
        float pv[4] = { __builtin_bit_cast(float, p0 << 16), __builtin_bit_cast(float, p0 & 0xffff0000u), __builtin_bit_cast(float, p1 << 16), __builtin_bit_cast(float, p1 & 0xffff0000u) };
        f4v r; for (int j = 0; j < 4; ++j) r[j] = al * xr[j] + yv[j] + sigmoidf_(a[j] + bgv[j]) * pv[j];
        *(f4v*)(o + i) = r; }
};

#ifndef CPU_TEST
struct CvItem { const float* W; bf16_t* WT; int ldw, ldk, mode, k0, n0; };
__device__ __forceinline__ bool cv_decode(CtxRef C, int l, int r, CvItem& it) {
    constexpr int I_G1 = (DM / 64) * (DEXP / 32), I_D1 = (DEXP / 64) * (DM / 32), PER_E = 2 * I_G1 + I_D1;
    if (r >= NEXP * PER_E) return false;
    const int e = r / PER_E; r -= e * PER_E;
    if (r < 2 * I_G1) { const bool up = r >= I_G1; if (up) r -= I_G1; it.W = INF(up ? I_WU : I_WG) + ((size_t)l * NEXP + e) * DM * DEXP; it.WT = WSP(bf16_t, WS_WGU) + (size_t)e * 2 * DEXP * DM; it.ldw = DEXP; it.ldk = DM; it.mode = up ? 2 : 1;
        const int nblk = DEXP / 32; it.k0 = 64 * (r / nblk); it.n0 = 32 * (r % nblk); }
    else { r -= 2 * I_G1; it.W = INF(I_WD) + ((size_t)l * NEXP + e) * DEXP * DM; it.WT = WSP(bf16_t, WS_WD) + (size_t)e * DM * DEXP; it.ldw = DM; it.ldk = DEXP; it.mode = 0;
        const int nblk = DM / 32; it.k0 = 64 * (r / nblk); it.n0 = 32 * (r % nblk); }
    return true;
}
__device__ __forceinline__ void convert_moe_queue(CtxRef C, int l, int lane, wsh_t scr) {
    unsigned* ctr = WSP(unsigned, WS_CTL) + CW_CVQ + l * 64;
    const int lr = lane >> 3, lc = (lane & 7) * 4;
    constexpr int CHUNK = 16;
    f4v ld[8]; CvItem cur, nxt; bool have; int nextid = 0, endid = 0;
#define CV_GRAB(IT, OK) do { if (nextid == endid) { unsigned b_ = 0; if (lane == 0) b_ = atomicAdd(ctr, (unsigned)CHUNK); nextid = __builtin_amdgcn_readfirstlane((int)b_); endid = nextid + CHUNK; } OK = cv_decode(C, l, nextid, IT); ++nextid; } while (0)
#define CV_LOAD(IT) do { _Pragma("unroll") for (int i = 0; i < 8; ++i) ld[i] = *(const f4v*)((IT).W + (size_t)((IT).k0 + lr + 8 * i) * (IT).ldw + (IT).n0 + lc); } while (0)
    CV_GRAB(cur, have);
    if (have) CV_LOAD(cur);
    while (have) {
#pragma unroll
        for (int i = 0; i < 8; ++i) { const int kk = lr + 8 * i;
#pragma unroll
            for (int j = 0; j < 4; ++j) scr[kk * 33 + lc + j] = ld[i][j]; }
        bool hn; CV_GRAB(nxt, hn);
        if (hn) CV_LOAD(nxt);
        WSYNC();
#pragma unroll
        for (int q = 0; q < 4; ++q) { const int idx = lane + 64 * q; const int n = idx >> 3, c = idx & 7;
            u4v o;
#pragma unroll
            for (int j = 0; j < 4; ++j) o[j] = pk2(scr[(8 * c + 2 * j) * 33 + n], scr[(8 * c + 2 * j + 1) * 33 + n]);
            *(u4v*)(cur.WT + (size_t)rowmap(cur.mode, cur.n0 + n) * cur.ldk + cur.k0 + 8 * c) = o; }
        WSYNC();
        cur = nxt; have = hn;
    }
#undef CV_GRAB
#undef CV_LOAD
}
#endif

#ifndef CPU_TEST
struct EpiQ {
    static constexpr bool PERM = true; static constexpr int MODE = 0;
    const float* rope; bf16_t* o;
    __device__ __forceinline__ void put8(int row, int col, const float* a) const {
        float p[8];
#pragma unroll
        for (int j = 0; j < 8; ++j) p[j] = __shfl_xor(a[j], 32);
        if (col >= 384) return;
        const float qscale = 0.10206207261596575f * 1.4426950408889634f;
        const int d0 = col % 96; float v[8];
        if (d0 < 64) {
#pragma unroll
            for (int j = 0; j < 8; ++j) v[j] = a[j] * qscale; }
        else { const int i0 = (d0 - 64) & 15; const bool x2 = (d0 - 64) >= 16; const float* rt = rope + (size_t)row * 32 + i0;
            const f4v c0 = *(const f4v*)rt, c1 = *(const f4v*)(rt + 4), s0 = *(const f4v*)(rt + 16), s1 = *(const f4v*)(rt + 20);
#pragma unroll
            for (int j = 0; j < 8; ++j) { const float c = j < 4 ? c0[j & 3] : c1[j & 3], s = j < 4 ? s0[j & 3] : s1[j & 3];
                v[j] = (x2 ? (p[j] * s + a[j] * c) : (a[j] * c - p[j] * s)) * qscale; } }
        st8bf(o + (size_t)row * 384 + col, v); }
};
struct EpiKV {
    static constexpr bool PERM = true; static constexpr int MODE = 0;
    bf16_t* k; bf16_t* v;
    __device__ __forceinline__ void put8(int row, int col, const float* a) const { const int h = col >> 7, d = col & 127;
        if (d < 64) st8bf(k + (size_t)row * 384 + h * 96 + d, a); else st8bf(v + (size_t)row * 256 + h * 64 + (d - 64), a); }
};
__device__ __forceinline__ void mla_token_pass(CtxRef C, int gw, int ngw, int lane) {
    const bf16_t* u = WSP(bf16_t, WS_U); const float* rope = WSP(float, WS_ROPE); bf16_t* K = WSP(bf16_t, WS_AK); bf16_t* Q = WSP(bf16_t, WS_AQ); bf16_t* V = WSP(bf16_t, WS_AV);
    for (int t = gw; t < T; t += ngw) {
        const bf16_t* ur = u + (size_t)t * DINP;
        u4v qv = {0u, 0u, 0u, 0u}, kv = {0u, 0u, 0u, 0u};
        bf16_t* qp = Q + (size_t)t * 384 + lane * 8; if (lane < 48) qv = *(const u4v*)qp;
        bf16_t* kp = (lane < 32) ? K + (size_t)t * 384 + (lane >> 3) * 96 + (lane & 7) * 8 : V + (size_t)t * 256 + (lane - 32) * 8; kv = *(const u4v*)kp;
        float ssq = 0.f, sskv = 0.f;
        { const unsigned* p = (const unsigned*)(ur + UD_CQ) + 2 * lane; const unsigned w0 = p[0], w1 = p[1];
          const float a = __builtin_bit_cast(float, w0 << 16), b = __builtin_bit_cast(float, w0 & 0xffff0000u), c = __builtin_bit_cast(float, w1 << 16), d = __builtin_bit_cast(float, w1 & 0xffff0000u);
          ssq = (a * a + b * b) + (c * c + d * d); }
        { const unsigned w0 = ((const unsigned*)(ur + UD_CKV))[lane]; const float a = __builtin_bit_cast(float, w0 << 16), b = __builtin_bit_cast(float, w0 & 0xffff0000u); sskv = a * a + b * b; }
        const int i = lane & 15, hh = lane >> 4; const float x1 = bf2f(ur[UD_KR + i]), x2 = bf2f(ur[UD_KR + 16 + i]); const float c = rope[(size_t)t * 32 + i], s = rope[(size_t)t * 32 + 16 + i];
        ssq = wave_sum(ssq); sskv = wave_sum(sskv);
        const float rq = 1.f / sqrtf(ssq * (1.f / 256.f) + NORM_EPS), rkv = 1.f / sqrtf(sskv * (1.f / 128.f) + NORM_EPS);
        if (lane < 48) { u4v o;
#pragma unroll
            for (int j = 0; j < 4; ++j) o[j] = pk2(__builtin_bit_cast(float, qv[j] << 16) * rq, __builtin_bit_cast(float, qv[j] & 0xffff0000u) * rq);
            *(u4v*)qp = o; }
        { u4v o;
#pragma unroll
          for (int j = 0; j < 4; ++j) o[j] = pk2(__builtin_bit_cast(float, kv[j] << 16) * rkv, __builtin_bit_cast(float, kv[j] & 0xffff0000u) * rkv);
          *(u4v*)kp = o; }
        { bf16_t* kd = K + (size_t)t * 384 + hh * 96 + 64; kd[i] = f2bf(x1 * c - x2 * s); kd[16 + i] = f2bf(x1 * s + x2 * c); }
    }
}
__device__ __forceinline__ void rwkv_prep_coop(CtxRef C, int l, __attribute__((address_space(3))) unsigned char* lds) {
    int tid = threadIdx.x; asm volatile("" : "+v"(tid));
    const int lane = tid & 63, w = __builtin_amdgcn_readfirstlane(tid >> 6);
    const bf16_t* u = WSP(bf16_t, WS_U);
    const float* mu = INF(I_MU) + l * DINA;
    float* oR = WSP(float, WS_RW_R); float* oW = WSP(float, WS_RW_W); float* oK = WSP(float, WS_RW_K); float* oV = WSP(float, WS_RW_V);
    float* oA = WSP(float, WS_RW_A); float* oB = WSP(float, WS_RW_B); float* oG = WSP(float, WS_RW_G);
    __attribute__((address_space(3))) float* act = (__attribute__((address_space(3))) float*)lds;
    const int h = w & 3, role = w >> 2, c = h * 64 + lane;
    float wc0[32], wc1[32];
    { const float* p0 = role == 0 ? INF(I_WUP) + l * 32 * GW + c : INF(I_GUP) + l * 64 * GW + c;
      const float* p1 = role == 0 ? INF(I_AUP) + l * 32 * GW + c : INF(I_GUP) + l * 64 * GW + 32 * GW + c;
#pragma unroll
      for (int j = 0; j < 32; ++j) { wc0[j] = p0[j * GW]; wc1[j] = p1[j * GW]; } }
    const float w0c = INF(I_W0)[l * GW + c], a0c = INF(I_A0)[l * GW + c], kkc = INF(I_KK)[l * GW + c], kac = INF(I_KA)[l * GW + c];
    const float mur = mu[UA_R + c], muk = mu[UA_K + c], muv = mu[UA_V + c];
    for (int unit = blockIdx.x; unit < T / 16; unit += gridDim.x) {
        const int t0 = unit * 16;
        { const int tk = tid >> 5, j0 = (tid & 31) * 4; const int t = t0 + tk; const bool first = (t % SEQ) == 0;
          const unsigned* pc = (const unsigned*)(u + (size_t)t * DINP + UA_WD + j0); const unsigned c0 = pc[0], c1 = pc[1];
          unsigned q0 = 0u, q1 = 0u; if (!first) { const unsigned* pp = (const unsigned*)(u + (size_t)(t - 1) * DINP + UA_WD + j0); q0 = pp[0]; q1 = pp[1]; }
          const float cur[4] = {__builtin_bit_cast(float, c0 << 16), __builtin_bit_cast(float, c0 & 0xffff0000u), __builtin_bit_cast(float, c1 << 16), __builtin_bit_cast(float, c1 & 0xffff0000u)};
          const float prv[4] = {__builtin_bit_cast(float, q0 << 16), __builtin_bit_cast(float, q0 & 0xffff0000u), __builtin_bit_cast(float, q1 << 16), __builtin_bit_cast(float, q1 & 0xffff0000u)};
          f4v o;
#pragma unroll
          for (int j = 0; j < 4; ++j) { const float v = cur[j] + (prv[j] - cur[j]) * mu[UA_WD + j0 + j]; o[j] = (j0 < 32) ? tanhf(v) : (j0 < 64 ? v : sigmoidf_(v)); }
          *(__attribute__((address_space(3))) f4v*)(act + tk * 128 + j0) = o; }
        __syncthreads();
#pragma unroll 1
        for (int tk = 0; tk < 16; ++tk) { const int t = t0 + tk; const bool first = (t % SEQ) == 0;
            const __attribute__((address_space(3))) float* ar = act + tk * 128 + (role == 0 ? 0 : 64);
            float s0 = 0.f, s1 = 0.f;
#pragma unroll
            for (int j = 0; j < 32; j += 4) { const f4v x = *(const __attribute__((address_space(3))) f4v*)(ar + j), y = *(const __attribute__((address_space(3))) f4v*)(ar + 32 + j);
                s0 += x[0] * wc0[j] + x[1] * wc0[j + 1] + x[2] * wc0[j + 2] + x[3] * wc0[j + 3]; s1 += y[0] * wc1[j] + y[1] * wc1[j + 1] + y[2] * wc1[j + 2] + y[3] * wc1[j + 3];
                if ((j & 12) == 12) asm volatile("" ::: "memory"); }
            const size_t o = (size_t)t * GW + c;
            if (role == 1) { oG[o] = s0 + s1; }
            else {
                const float z = w0c + s0, za = a0c + s1;
                const float lnl = -softplusf_(-z) - 0.5f; const float decay = __expf(-__expf(lnl)); const float a = sigmoidf_(za);
                const bf16_t* uc = u + (size_t)t * DINP + c; const bf16_t* up = uc - DINP;
                const float rc = bf2f(uc[UA_R]), kc = bf2f(uc[UA_K]), vc = bf2f(uc[UA_V]);
                const float rp = first ? 0.f : bf2f(up[UA_R]), kp = first ? 0.f : bf2f(up[UA_K]), vp = first ? 0.f : bf2f(up[UA_V]);
                const float r = rc + (rp - rc) * mur, k = kc + (kp - kc) * muk, v = vc + (vp - vc) * muv;
                const float kkraw = k * kkc; const float ss = wave_sum(kkraw * kkraw); const float kk = kkraw / fmaxf(sqrtf(ss), 1e-12f);
                oR[o] = r; oW[o] = decay; oK[o] = k * (1.f + (a - 1.f) * kac); oV[o] = v; oA[o] = -kk; oB[o] = kk * a; } }
        __syncthreads();
    }
}
#endif

#ifndef CPU_TEST
template <int NT> __device__ __forceinline__ void ln_rows_v(const float* src, const float* g, const float* b, float* dstf, bf16_t* dstb, int lane) {
    f4v x[NT][4];
#pragma unroll
    for (int n = 0; n < NT; ++n)
#pragma unroll
        for (int i = 0; i < 4; ++i) x[n][i] = *(const f4v*)(src + (size_t)n * DM + (i * 64 + lane) * 4);
    float mean[NT], rstd[NT];
#pragma unroll
    for (int n = 0; n < NT; ++n) { float s = 0.f;
#pragma unroll
        for (int i = 0; i < 4; ++i) s += (x[n][i][0] + x[n][i][1]) + (x[n][i][2] + x[n][i][3]);
        mean[n] = wave_sum(s) * (1.f / DM); float q = 0.f;
#pragma unroll
        for (int i = 0; i < 4; ++i) { x[n][i] = x[n][i] - mean[n]; q += (x[n][i][0] * x[n][i][0] + x[n][i][1] * x[n][i][1]) + (x[n][i][2] * x[n][i][2] + x[n][i][3] * x[n][i][3]); }
        rstd[n] = 1.f / sqrtf(wave_sum(q) * (1.f / DM) + LN_EPS); }
#pragma unroll
    for (int i = 0; i < 4; ++i) { const int c = (i * 64 + lane) * 4; const f4v gv = *(const f4v*)(g + c), bv = *(const f4v*)(b + c);
#pragma unroll
        for (int n = 0; n < NT; ++n) { const f4v y = x[n][i] * rstd[n] * gv + bv; *(f4v*)(dstf + (size_t)n * DM + c) = y;
            *(unsigned long long*)(dstb + (size_t)n * DM + c) = (unsigned long long)pk2(y[0], y[1]) | ((unsigned long long)pk2(y[2], y[3]) << 32); } }
}
__device__ __forceinline__ void stage_ln2_v(CtxRef C, int l, int gw, int ngw, int lane) {
    const float* src = WSP(float, WS_X); float* dst = (l == DEPTH - 1) ? C.out : WSP(float, WS_X); bf16_t* xb = WSP(bf16_t, WS_XB);
    const float* g = INF(I_LN2G) + l * DM; const float* b = INF(I_LN2B) + l * DM;
    for (int t = gw * 2; t < T; t += ngw * 2) ln_rows_v<2>(src + (size_t)t * DM, g, b, dst + (size_t)t * DM, xb + (size_t)t * DM, lane);
}
__device__ __forceinline__ float row_sum16(float v) { v += dpp_f(v, 0); v += dpp_f(v, 1); v += dpp_f(v, 2); v += dpp_f(v, 3); return v; }
__device__ __forceinline__ void stage_post_v(CtxRef C, int l, int gw, int ngw, int lane) {
    const bf16_t* u = WSP(bf16_t, WS_U); bf16_t* mix = WSP(bf16_t, WS_MIX);
    const float* YA = WSP(float, WS_YA); const float* YB = WSP(float, WS_YB); const float* YC = WSP(float, WS_YC); const float* DEN = WSP(float, WS_DEN);
    const float* BON = WSP(float, WS_RW_BON); const bf16_t* VS = WSP(bf16_t, WS_RW_VS); const bf16_t* GG = WSP(bf16_t, WS_RW_GG);
    const int h = lane >> 4, c = lane * 4;
    const f4v gng = *(const f4v*)(INF(I_GNG) + l * GW + c), gnb = *(const f4v*)(INF(I_GNB) + l * GW + c), glag = *(const f4v*)(INF(I_GLA_G) + l * GW + c), mlng = *(const f4v*)(INF(I_MLN_G) + l * GW + c);
#pragma unroll 2
    for (int t = gw; t < T; t += ngw) {
        const size_t o = (size_t)t * GW + c;
        const f4v ya = *(const f4v*)(YA + o), yb = *(const f4v*)(YB + o), yc = *(const f4v*)(YC + o);
        const unsigned long long wg = *(const unsigned long long*)(GG + o), wv = *(const unsigned long long*)(VS + o);
        const unsigned long long wgate = *(const unsigned long long*)(u + (size_t)t * DINP + UB_G + c), wo = *(const unsigned long long*)(u + (size_t)t * DINP + UC_O + c);
        const float bon = BON[(size_t)t * 4 + h], den = DEN[(size_t)t * 4 + h];
#define UNP4(w_, a_) const float a_[4] = {__builtin_bit_cast(float, (unsigned)(w_) << 16), __builtin_bit_cast(float, (unsigned)(w_) & 0xffff0000u), __builtin_bit_cast(float, (unsigned)((w_) >> 32) << 16), __builtin_bit_cast(float, (unsigned)((w_) >> 32) & 0xffff0000u)}
        UNP4(wg, g4); UNP4(wv, v4); UNP4(wgate, gate4); UNP4(wo, o4);
#undef UNP4
        float oa[4], ob[4], oc[4];
        {   const float mean = row_sum16((ya[0] + ya[1]) + (ya[2] + ya[3])) * (1.f / 64.f); const f4v d = ya - mean;
            const float rstd = 1.f / sqrtf(row_sum16((d[0] * d[0] + d[1] * d[1]) + (d[2] * d[2] + d[3] * d[3])) * (1.f / 64.f) + RWKV_GN_EPS);
#pragma unroll
            for (int j = 0; j < 4; ++j) oa[j] = (d[j] * rstd * gng[j] + gnb[j] + bon * v4[j]) * g4[j]; }
        {   const float rstd = 1.f / sqrtf(row_sum16((yb[0] * yb[0] + yb[1] * yb[1]) + (yb[2] * yb[2] + yb[3] * yb[3])) * (1.f / 64.f) + NORM_EPS);
#pragma unroll
            for (int j = 0; j < 4; ++j) ob[j] = yb[j] * rstd * glag[j] * siluf_(gate4[j]); }
        {   const float dinv = 1.f / fmaxf(fabsf(den), 1.f); const f4v y = yc * dinv;
            const float mean = row_sum16((y[0] + y[1]) + (y[2] + y[3])) * (1.f / 64.f); const f4v d = y - mean;
            const float rstd = 1.f / sqrtf(row_sum16((d[0] * d[0] + d[1] * d[1]) + (d[2] * d[2] + d[3] * d[3])) * (1.f / 64.f) + LN_EPS);
#pragma unroll
            for (int j = 0; j < 4; ++j) oc[j] = d[j] * rstd * mlng[j] * sigmoidf_(o4[j]); }
        bf16_t* m = mix + (size_t)t * DMIX + c;
        *(unsigned long long*)m = (unsigned long long)pk2(oa[0], oa[1]) | ((unsigned long long)pk2(oa[2], oa[3]) << 32);
        *(unsigned long long*)(m + 256) = (unsigned long long)pk2(ob[0], ob[1]) | ((unsigned long long)pk2(ob[2], ob[3]) << 32);
        *(unsigned long long*)(m + 512) = (unsigned long long)pk2(oc[0], oc[1]) | ((unsigned long long)pk2(oc[2], oc[3]) << 32);
    }
}
__device__ __forceinline__ void stage_gather_v(CtxRef C, int l, int gw, int ngw, int lane) {
    const unsigned* cnt = WSP(unsigned, WS_CTL) + CW_CNT + l * NEXP * 64;
    const int* list = WSP(int, WS_LIST); const int* tokinfo = WSP(int, WS_TOKINFO);
    const bf16_t* xb = WSP(bf16_t, WS_XB); bf16_t* xg = WSP(bf16_t, WS_XG); int* rowinfo = WSP(int, WS_ROWINFO); float* rowgate = WSP(float, WS_ROWGATE);
    int e, be, ce; const int total = moe_lookup(cnt, 0, e, be, ce);
    for (int r0 = gw * 64; r0 < total; r0 += ngw * 64) {
        moe_lookup(cnt, r0, e, be, ce);
        const int slot = r0 - be + lane; int ent = -1; float gate = 0.f;
        if (slot < ce) { ent = list[(size_t)e * T + slot]; gate = ((const float*)tokinfo)[(size_t)(ent >> 1) * 4 + 2 + (ent & 1)]; }
        rowinfo[r0 + lane] = ent; rowgate[r0 + lane] = gate;
#pragma unroll 4
        for (int r = 0; r < 64; ++r) { const int en = __builtin_amdgcn_readlane(ent, r); bf16_t* d = xg + (size_t)(r0 + r) * DM + lane * 8;
            if (en >= 0) { const bf16_t* s = xb + (size_t)(en >> 1) * DM + lane * 8; const u4v a = *(const u4v*)s, b2 = *(const u4v*)(s + 512); *(u4v*)d = a; *(u4v*)(d + 512) = b2; }
            else { const u4v z = {0u, 0u, 0u, 0u}; *(u4v*)d = z; *(u4v*)(d + 512) = z; } }
    }
}
__device__ __forceinline__ void ln1_router_coop(CtxRef C, int l, __attribute__((address_space(3))) unsigned char* lds) {
    int tid = threadIdx.x; asm volatile("" : "+v"(tid));
    const int lane = tid & 63, w = __builtin_amdgcn_readfirstlane(tid >> 6);
    float* X1 = C.out; bf16_t* xb = WSP(bf16_t, WS_XB);
    const float* g = INF(I_LN1G) + l * DM; const float* b = INF(I_LN1B) + l * DM;
    const float* wrg = INF(I_WRG) + (size_t)l * DM * NGRP; const float* brg = INF(I_BRG) + l * NGRP;
    const float* wre = INF(I_WRE) + (size_t)l * DM * NEXP; const float* bre = INF(I_BRE) + l * NEXP;
    unsigned* cnt = WSP(unsigned, WS_CTL) + CW_CNT + l * NEXP * 64;
    int* tokinfo = WSP(int, WS_TOKINFO); int* list = WSP(int, WS_LIST);
    __attribute__((address_space(3))) float* part = (__attribute__((address_space(3))) float*)lds;
    for (int tb0 = blockIdx.x * 128; tb0 < T; tb0 += gridDim.x * 128) {
        for (int i = 0; i < 16; i += 2) { const int t = tb0 + w * 16 + i;
            ln_rows_v<2>(X1 + (size_t)t * DM, g, b, X1 + (size_t)t * DM, xb + (size_t)t * DM, lane); }
        asm volatile("s_waitcnt vmcnt(0)" ::: "memory");
        __syncthreads();
        for (int half = 0; half < 2; ++half) {
            const int t = tb0 + half * 64 + lane;
            float acc[36];
#pragma unroll
            for (int j = 0; j < 36; ++j) acc[j] = 0.f;
            const float* xr = X1 + (size_t)t * DM + 128 * w;
#pragma unroll 1
            for (int k4 = 0; k4 < 32; ++k4) {
                const f4v x = *(const f4v*)(xr + 4 * k4);
#pragma unroll
                for (int kk = 0; kk < 4; ++kk) { const int k = 128 * w + 4 * k4 + kk;
                    typedef __attribute__((address_space(4))) const float cfl; cfl* we = (cfl*)(wre + (size_t)k * NEXP); cfl* wg = (cfl*)(wrg + (size_t)k * NGRP);
#pragma unroll
                    for (int j = 0; j < 4; ++j) acc[j] += x[kk] * wg[j];
#pragma unroll
                    for (int j = 0; j < 32; ++j) acc[4 + j] += x[kk] * we[j]; } }
#pragma unroll
            for (int j = 0; j < 36; ++j) part[(w * 36 + j) * 64 + lane] = acc[j];
            __syncthreads();
            if (w == 0) {
                float lg[NGRP], le[NEXP];
#pragma unroll
                for (int j = 0; j < NGRP; ++j) { float s = brg[j];
#pragma unroll
                    for (int ww = 0; ww < 8; ++ww) s += part[(ww * 36 + j) * 64 + lane]; lg[j] = s; }
#pragma unroll
                for (int j = 0; j < NEXP; ++j) { float s = bre[j];
#pragma unroll
                    for (int ww = 0; ww < 8; ++ww) s += part[(ww * 36 + 4 + j) * 64 + lane]; le[j] = s; }
                int gi = 0; float gm = lg[0];
#pragma unroll
                for (int j = 1; j < NGRP; ++j) if (lg[j] > gm) { gm = lg[j]; gi = j; }
                float gs = 0.f;
#pragma unroll
                for (int j = 0; j < NGRP; ++j) gs += expf(lg[j] - gm);
                const float group_p = 1.f / gs;
                float el[EPG];
#pragma unroll
                for (int j = 0; j < EPG; ++j) { float v = le[j];
#pragma unroll
                    for (int g2 = 1; g2 < NGRP; ++g2) v = (gi == g2) ? le[g2 * EPG + j] : v;
                    el[j] = v; }
                int e0 = 0; float m0 = el[0];
#pragma unroll
                for (int j = 1; j < EPG; ++j) if (el[j] > m0) { m0 = el[j]; e0 = j; }
                int e1 = -1; float m1 = -3.0e38f;
#pragma unroll
                for (int j = 0; j < EPG; ++j) if (j != e0 && el[j] > m1) { m1 = el[j]; e1 = j; }
                const float p1 = expf(m1 - m0); const float g0 = group_p / (1.f + p1), g1 = group_p * p1 / (1.f + p1);
                const int E0 = gi * EPG + e0, E1 = gi * EPG + e1;
                tokinfo[(size_t)t * 4 + 0] = E0; tokinfo[(size_t)t * 4 + 1] = E1;
                ((float*)tokinfo)[(size_t)t * 4 + 2] = g0; ((float*)tokinfo)[(size_t)t * 4 + 3] = g1;
                const unsigned s0 = atomicAdd(cnt + E0 * 64, 1u); list[(size_t)E0 * T + s0] = t * 2 + 0;
                const unsigned s1 = atomicAdd(cnt + E1 * 64, 1u); list[(size_t)E1 * T + s1] = t * 2 + 1;
            }
            __syncthreads();
        }
    }
}
#endif

#ifndef CPU_TEST
namespace pg8 {
#define PG8_LAS __attribute__((address_space(3)))
typedef short bf16x8 __attribute__((ext_vector_type(8)));
typedef float f32x4 __attribute__((ext_vector_type(4)));
constexpr int BM = 256, BK = 64, HALF = 128, HTB = HALF * BK * 2, STAGE_BYTES = 8 * HTB;
__device__ __forceinline__ int lds_byte(int r, int c) { const int st = (r >> 4) * 2 + (c >> 5), rr = r & 15, cc = c & 31, ob = rr * 64 + cc * 2; return st * 1024 + (ob ^ (((ob >> 9) & 1) << 5)); }
__device__ __forceinline__ void stage_rc(int b, int& R, int& C) { const int st = b / 1024, sb = b % 1024, swz = sb ^ (((sb >> 9) & 1) << 5); R = (st >> 1) * 16 + swz / 64; C = (st & 1) * 32 + (swz % 64) / 2; }
__device__ __forceinline__ int perm32(int rho) { const int n = rho >> 4, i = rho & 15; return 8 * (i >> 2) + 4 * n + (i & 3); }
struct Unit { int pm, pn; long aoff, boff; };
struct Gemm { const bf16_t* A; const bf16_t* Bt; int lda, ldb, K; };

template <class F> __device__ __forceinline__ void run_epi(const F& f, const f32x4 (&acc)[2][2][4][2], const Unit& u, int wr, int wc, int fr, int fq) {
#pragma unroll
    for (int ai = 0; ai < 2; ++ai)
#pragma unroll
        for (int m = 0; m < 4; ++m) { const int row = u.pm * BM + ai * HALF + wr * 64 + m * 16 + fr;
            if constexpr (F::MODE == 1) { const int hcol = u.pn * 128 + wc * 32 + 8 * fq; float g[8], up[8];
#pragma unroll
                for (int j = 0; j < 4; ++j) { g[j] = acc[ai][0][m][0][j]; g[4 + j] = acc[ai][0][m][1][j]; up[j] = acc[ai][1][m][0][j]; up[4 + j] = acc[ai][1][m][1][j]; }
                f.put8gu(row, hcol, g, up); }
            else if constexpr (F::PERM) {
#pragma unroll
                for (int bj = 0; bj < 2; ++bj) { const int col = u.pn * BM + bj * HALF + wc * 32 + 8 * fq; float a[8];
#pragma unroll
                    for (int j = 0; j < 4; ++j) { a[j] = acc[ai][bj][m][0][j]; a[4 + j] = acc[ai][bj][m][1][j]; }
                    f.put8(row, col, a); } }
            else {
#pragma unroll
                for (int bj = 0; bj < 2; ++bj)
#pragma unroll
                    for (int n = 0; n < 2; ++n) { const int col = u.pn * BM + bj * HALF + wc * 32 + 16 * n + 4 * fq; float a[4];
#pragma unroll
                        for (int j = 0; j < 4; ++j) a[j] = acc[ai][bj][m][n][j];
                        f.put4(row, col, a); } }
        }
}

template <class Epi, class Sched>
__device__ __forceinline__ void gemm_phase(PG8_LAS unsigned char* lds, const Gemm g, const Sched& S, const Epi& E) {
    int tid = threadIdx.x; asm volatile("" : "+v"(tid));
    const int wid = __builtin_amdgcn_readfirstlane(tid >> 6), lane = tid & 63, wr = wid >> 2, wc = wid & 3, fr = lane & 15, fq = lane >> 4;
    const int K = g.K, nt = K / BK;
    unsigned voffA[2], voffB[2];
#pragma unroll
    for (int i = 0; i < 2; ++i) { int R, C; stage_rc(tid * 16 + i * 8192, R, C); const int Rb = Epi::PERM ? ((R & ~31) + perm32(R & 31)) : R;
        voffA[i] = (unsigned)(R * g.lda + C) * 2u; voffB[i] = (unsigned)(Rb * g.ldb + C) * 2u; }
    const size_t kstep = (size_t)(BK * 2);
    const size_t hstepA = (size_t)HALF * g.lda * 2, hstepB = (size_t)HALF * g.ldb * 2;
    const unsigned ldsw = (unsigned)wid * 1024u;
    const int aoff = lds_byte(wr * 64 + fr, fq * 8), boff = lds_byte(wc * 32 + fr, fq * 8);
#define PG8_SA(b, h) (((b) * 2 + (h)) * HTB)
#define PG8_SB(b, h) ((4 + (b) * 2 + (h)) * HTB)
#define PG8_STAGE(bufoff, gbase, voff) do { _Pragma("unroll") for (int _i = 0; _i < 2; ++_i) \
        __builtin_amdgcn_global_load_lds((const unsigned*)((const char*)(gbase) + (voff)[_i]), (PG8_LAS unsigned*)(lds + (bufoff) + ldsw + _i * 8192), 16, 0, 0); } while (0)
#define PG8_LDA(dst, b, h) do { _Pragma("unroll") for (int m = 0; m < 4; ++m) _Pragma("unroll") for (int k = 0; k < 2; ++k) dst[m][k] = *(const PG8_LAS bf16x8*)(lds + PG8_SA(b, h) + aoff + m * 2048 + k * 1024); } while (0)
#define PG8_LDB(dst, b, h) do { _Pragma("unroll") for (int n = 0; n < 2; ++n) _Pragma("unroll") for (int k = 0; k < 2; ++k) dst[n][k] = *(const PG8_LAS bf16x8*)(lds + PG8_SB(b, h) + boff + n * 2048 + k * 1024); } while (0)
#define PG8_MMA(ai, bj, At, Bt) do { __builtin_amdgcn_s_setprio(1); _Pragma("unroll") for (int m = 0; m < 4; ++m) _Pragma("unroll") for (int n = 0; n < 2; ++n) _Pragma("unroll") for (int k = 0; k < 2; ++k) \
        acc[ai][bj][m][n] = __builtin_amdgcn_mfma_f32_16x16x32_bf16(Bt[n][k], At[m][k], acc[ai][bj][m][n], 0, 0, 0); __builtin_amdgcn_s_setprio(0); } while (0)
#define PG8_WAIT_V(n) asm volatile("s_waitcnt vmcnt(" #n ")" ::: "memory")
#define PG8_WAIT_L(n) asm volatile("s_waitcnt lgkmcnt(" #n ")" ::: "memory")
#define PG8_BAR __builtin_amdgcn_s_barrier()
#define PG8_SCHED __builtin_amdgcn_sched_barrier(0)
    Unit cur, nxt; int ui = 0;
    if (!S.next(0, cur)) return;
    f32x4 acc[2][2][4][2];
#pragma unroll
    for (int a = 0; a < 2; ++a)
#pragma unroll
        for (int b = 0; b < 2; ++b)
#pragma unroll
            for (int m = 0; m < 4; ++m)
#pragma unroll
                for (int n = 0; n < 2; ++n) acc[a][b][m][n] = (f32x4){0.f, 0.f, 0.f, 0.f};
    bf16x8 At[4][2], B0[2][2], B1[2][2];
    const char* cA = (const char*)g.A + cur.aoff; const char* cB = (const char*)g.Bt + cur.boff;
    PG8_STAGE(PG8_SB(0, 0), cB, voffB); PG8_STAGE(PG8_SB(0, 1), cB + hstepB, voffB); PG8_STAGE(PG8_SA(0, 0), cA, voffA); PG8_STAGE(PG8_SA(0, 1), cA + hstepA, voffA);
    if (wr == 1) PG8_BAR;
    PG8_WAIT_V(2); PG8_BAR;
    PG8_STAGE(PG8_SB(1, 0), cB + kstep, voffB); PG8_STAGE(PG8_SA(1, 0), cA + kstep, voffA); PG8_STAGE(PG8_SB(1, 1), cB + hstepB + kstep, voffB);
    PG8_WAIT_V(6); PG8_BAR;
    for (;;) {
        const bool has_next = S.next(ui + 1, nxt);
        const char* nA = has_next ? (const char*)g.A + nxt.aoff : cA; const char* nB = has_next ? (const char*)g.Bt + nxt.boff : cB;
_Pragma("unroll 1")
        for (int t = 0; t < nt; t += 2) {
            const bool last = (t == nt - 2);
            const char* a1 = cA + (size_t)(t + 1) * kstep;
            const char* a2 = last ? nA : cA + (size_t)(t + 2) * kstep; const char* b2 = last ? nB : cB + (size_t)(t + 2) * kstep;
            const char* a3 = a2 + kstep; const char* b3 = b2 + kstep;
            PG8_LDB(B0, 0, 0); PG8_LDB(B1, 0, 1); PG8_SCHED; PG8_LDA(At, 0, 0); PG8_STAGE(PG8_SA(1, 1), a1 + hstepA, voffA);
            PG8_WAIT_V(8); PG8_WAIT_L(0); PG8_BAR; PG8_MMA(0, 0, At, B0); PG8_MMA(0, 1, At, B1); PG8_BAR; PG8_SCHED;
            PG8_LDA(At, 0, 1); PG8_STAGE(PG8_SB(0, 0), b2, voffB); PG8_STAGE(PG8_SB(0, 1), b2 + hstepB, voffB); PG8_STAGE(PG8_SA(0, 0), a2, voffA);
            PG8_WAIT_V(8); PG8_WAIT_L(0); PG8_BAR; PG8_MMA(1, 0, At, B0); PG8_MMA(1, 1, At, B1); PG8_BAR; PG8_SCHED;
            PG8_LDB(B0, 1, 0); PG8_LDB(B1, 1, 1); PG8_SCHED; PG8_LDA(At, 1, 0); PG8_STAGE(PG8_SA(0, 1), a2 + hstepA, voffA);
            PG8_WAIT_V(8); PG8_WAIT_L(0); PG8_BAR; PG8_MMA(0, 0, At, B0); PG8_MMA(0, 1, At, B1); PG8_BAR; PG8_SCHED;
            PG8_LDA(At, 1, 1); PG8_STAGE(PG8_SB(1, 0), b3, voffB); PG8_STAGE(PG8_SB(1, 1), b3 + hstepB, voffB); PG8_STAGE(PG8_SA(1, 0), a3, voffA);
            PG8_WAIT_V(8); PG8_WAIT_L(0); PG8_BAR; PG8_MMA(1, 0, At, B0); PG8_MMA(1, 1, At, B1); PG8_BAR; PG8_SCHED;
        }
        if (wr == 0) PG8_BAR;
        run_epi(E, acc, cur, wr, wc, fr, fq);
        if (!has_next) break;
#pragma unroll
        for (int a = 0; a < 2; ++a)
#pragma unroll
            for (int b = 0; b < 2; ++b)
#pragma unroll
                for (int m = 0; m < 4; ++m)
#pragma unroll
                    for (int n = 0; n < 2; ++n) acc[a][b][m][n] = (f32x4){0.f, 0.f, 0.f, 0.f};
        cur = nxt; cA = nA; cB = nB; ++ui;
        if (wr == 1) PG8_BAR;
    }
    PG8_WAIT_V(0);
    PG8_BAR;
#undef PG8_SA
#undef PG8_SB
#undef PG8_STAGE
#undef PG8_LDA
#undef PG8_LDB
#undef PG8_MMA
#undef PG8_WAIT_V
#undef PG8_WAIT_L
#undef PG8_BAR
#undef PG8_SCHED
}
struct DenseOrder {
    int nM, nN, G, c; long astep, bstep;
    __device__ __forceinline__ bool next(int i, Unit& u) const {
        const long L = (long)i * G + c; if (L >= (long)nM * nN) return false;
        const int w = (int)L; const int nig = 8 * nN, gid = w / nig, fm = gid * 8, gsz = (nM - fm) < 8 ? (nM - fm) : 8;
        u.pm = fm + ((w % nig) % gsz); u.pn = (w % nig) / gsz; u.aoff = (long)u.pm * astep; u.boff = (long)u.pn * bstep; return true; }
};
struct MoeOrder {
    const PG8_LAS int* tbl; int nM, nN, G, c; long astep, bstep, estep;
    __device__ __forceinline__ bool next(int i, Unit& u) const {
        const long L = (long)i * G + c; if (L >= (long)nM * nN) return false;
        const int w = (int)L; u.pm = w / nN; u.pn = w % nN; const int e = tbl[u.pm];
        u.aoff = (long)u.pm * astep; u.boff = (long)e * estep + (long)u.pn * bstep; return true; }
};
}
#endif

#ifndef CPU_TEST
namespace att {
typedef short bf16x8 __attribute__((ext_vector_type(8)));
typedef short s16x4 __attribute__((ext_vector_type(4)));
typedef float f32x16 __attribute__((ext_vector_type(16)));
typedef float f32x2_t __attribute__((ext_vector_type(2))); typedef __bf16 bf16x2_t __attribute__((ext_vector_type(2)));
typedef unsigned u32x4 __attribute__((ext_vector_type(4)));
typedef unsigned u32x2 __attribute__((ext_vector_type(2)));
#define ATT_LAS __attribute__((address_space(3)))
#define BAR_LDS() asm volatile("s_waitcnt lgkmcnt(0)\n\ts_barrier" ::: "memory")
constexpr int KP = 104, VP = 68;
constexpr int KBUF = 64 * KP * 2, VBUF = 64 * VP * 2;
constexpr int LDS_NEED = 2 * KBUF + 2 * VBUF;
__device__ __forceinline__ unsigned cvtpk(float lo, float hi) { f32x2_t v = {lo, hi}; bf16x2_t b = __builtin_convertvector(v, bf16x2_t); return __builtin_bit_cast(unsigned, b); }
__device__ __forceinline__ int crow(int r, int hi) { return (r & 3) + 8 * (r >> 2) + 4 * hi; }
__device__ __forceinline__ u32x4 scale8(const u32x4& w, float s) { u32x4 o;
#pragma unroll
    for (int j = 0; j < 4; ++j) o[j] = cvtpk(__builtin_bit_cast(float, w[j] << 16) * s, __builtin_bit_cast(float, w[j] & 0xffff0000u) * s);
    return o; }
__device__ __forceinline__ void unit(ATT_LAS unsigned char* lds, const bf16_t* Q, const bf16_t* K, const bf16_t* V, const float* rstd, bf16_t* mix, int b, int h, int qb) {
    int tid = threadIdx.x; asm volatile("" : "+v"(tid));
    const int lane = tid & 63, w = __builtin_amdgcn_readfirstlane(tid >> 6), r32 = lane & 31, hi = lane >> 5;
    const size_t tb = (size_t)b * SEQ;
    const int q = qb * 256 + w * 32 + r32;
    bf16x8 qr[6];
    { const bf16_t* qrow = Q + (tb + q) * 384 + h * 96 + 8 * hi;
#pragma unroll
      for (int ks = 0; ks < 6; ++ks) qr[ks] = *(const bf16x8*)(qrow + 16 * ks); }
    f32x16 o0, o1;
#pragma unroll
    for (int r = 0; r < 16; ++r) { o0[r] = 0.f; o1[r] = 0.f; }
    float lsum = 0.f;
    const int NT = 4 * (qb + 1);
    const int kr0 = tid / 12, kp0 = tid % 12, kr1 = (tid + 512) / 12, kp1 = (tid + 512) % 12; const bool has1 = tid < 256;
    const int vk = tid >> 3, vp = tid & 7;
    const bf16_t* gK0 = K + (tb + kr0) * 384 + h * 96 + kp0 * 8; const bf16_t* gK1 = has1 ? K + (tb + kr1) * 384 + h * 96 + kp1 * 8 : gK0;
    const bf16_t* gV = V + (tb + vk) * 256 + h * 64 + vp * 8;
    struct StageSet { u32x4 k0, k1, v; };
    StageSet SA, SB; SA.k1 = (u32x4){0u, 0u, 0u, 0u}; SB.k1 = SA.k1;
#define ATT_LOAD(S, tile) do { const size_t adv = (size_t)(tile) * 64; S.k0 = *(const u32x4*)(gK0 + adv * 384); S.k1 = *(const u32x4*)(gK1 + adv * 384); S.v = *(const u32x4*)(gV + adv * 256); } while (0)
#define ATT_WRITE(S, buf) do { \
        *(ATT_LAS u32x4*)(lds + (buf) * KBUF + (kr0 * KP + kp0 * 8) * 2) = S.k0; \
        if (has1) *(ATT_LAS u32x4*)(lds + (buf) * KBUF + (kr1 * KP + kp1 * 8) * 2) = S.k1; \
        ATT_LAS unsigned short* vt_ = (ATT_LAS unsigned short*)(lds + 2 * KBUF + (buf) * VBUF); \
        _Pragma("unroll") for (int j = 0; j < 4; ++j) { vt_[(8 * vp + 2 * j) * VP + vk] = (unsigned short)(S.v[j] & 0xffffu); vt_[(8 * vp + 2 * j + 1) * VP + vk] = (unsigned short)(S.v[j] >> 16); } } while (0)
    ATT_LOAD(SA, 0); ATT_WRITE(SA, 0); ATT_LOAD(SB, 1); ATT_LOAD(SA, 2);
    BAR_LDS();
    float mref = 0.f;
    f32x16 negm;
#pragma unroll
    for (int r = 0; r < 16; ++r) negm[r] = 0.f;
#define ATT_STEP(t, SW) do { const int buf = (t) & 1; \
          \
        bf16x8 kf0[6], kf1[6]; \
        { ATT_LAS const unsigned char* kb = lds + buf * KBUF + (r32 * KP + 8 * hi) * 2; \
          _Pragma("unroll") for (int ks = 0; ks < 6; ++ks) { kf0[ks] = *(ATT_LAS const bf16x8*)(kb + ks * 32); kf1[ks] = *(ATT_LAS const bf16x8*)(kb + 32 * KP * 2 + ks * 32); } } \
        __builtin_amdgcn_sched_barrier(0); \
        f32x16 p0 = __builtin_amdgcn_mfma_f32_32x32x16_bf16(kf0[0], qr[0], negm, 0, 0, 0), p1 = __builtin_amdgcn_mfma_f32_32x32x16_bf16(kf1[0], qr[0], negm, 0, 0, 0); \
        _Pragma("unroll") for (int ks = 1; ks < 6; ++ks) { p0 = __builtin_amdgcn_mfma_f32_32x32x16_bf16(kf0[ks], qr[ks], p0, 0, 0, 0); p1 = __builtin_amdgcn_mfma_f32_32x32x16_bf16(kf1[ks], qr[ks], p1, 0, 0, 0); } \
        u32x2 vr[4][4]; \
        { ATT_LAS const unsigned char* vb = lds + 2 * KBUF + buf * VBUF + (r32 * VP + 4 * hi) * 2; \
          _Pragma("unroll") for (int s = 0; s < 4; ++s) { vr[s][0] = *(ATT_LAS const u32x2*)(vb + s * 32); vr[s][1] = *(ATT_LAS const u32x2*)(vb + s * 32 + 16); \
              vr[s][2] = *(ATT_LAS const u32x2*)(vb + 32 * VP * 2 + s * 32); vr[s][3] = *(ATT_LAS const u32x2*)(vb + 32 * VP * 2 + s * 32 + 16); } } \
        __builtin_amdgcn_sched_barrier(0); \
        if ((t) >= NT - 4) { const int k0 = (t) * 64; \
            _Pragma("unroll") for (int r = 0; r < 16; ++r) { const int kk = k0 + crow(r, hi); if (kk > q) p0[r] = -1e30f; if (kk + 32 > q) p1[r] = -1e30f; } } \
        float rm = __builtin_fmaxf(p0[0], p1[0]), rm2 = __builtin_fmaxf(p0[1], p1[1]); \
        _Pragma("unroll") for (int r = 2; r < 16; r += 2) { rm = __builtin_fmaxf(__builtin_fmaxf(rm, p0[r]), p1[r]); rm2 = __builtin_fmaxf(__builtin_fmaxf(rm2, p0[r + 1]), p1[r + 1]); } \
        rm = __builtin_fmaxf(rm, rm2); \
        { auto rr = __builtin_amdgcn_permlane32_swap(__float_as_uint(rm), __float_as_uint(rm), false, false); rm = fmaxf(__uint_as_float(rr[0]), __uint_as_float(rr[1])); } \
        if ((t) == 0 || __any(rm > 8.f)) { const float dl = ((t) == 0) ? rm : fmaxf(rm, 0.f); mref += dl; const float f = __builtin_amdgcn_exp2f(-dl); lsum *= f; \
            _Pragma("unroll") for (int r = 0; r < 16; ++r) { p0[r] -= dl; p1[r] -= dl; o0[r] *= f; o1[r] *= f; negm[r] = -mref; } } \
        float ps = 0.f; \
        _Pragma("unroll") for (int r = 0; r < 16; ++r) { p0[r] = __builtin_amdgcn_exp2f(p0[r]); p1[r] = __builtin_amdgcn_exp2f(p1[r]); ps += p0[r] + p1[r]; } \
        lsum += ps; \
        _Pragma("unroll") for (int s = 0; s < 4; ++s) { \
              u32x4 pw; \
              if (s == 0) pw = (u32x4){cvtpk(p0[0], p0[1]), cvtpk(p0[2], p0[3]), cvtpk(p0[4], p0[5]), cvtpk(p0[6], p0[7])}; \
              else if (s == 1) pw = (u32x4){cvtpk(p0[8], p0[9]), cvtpk(p0[10], p0[11]), cvtpk(p0[12], p0[13]), cvtpk(p0[14], p0[15])}; \
              else if (s == 2) pw = (u32x4){cvtpk(p1[0], p1[1]), cvtpk(p1[2], p1[3]), cvtpk(p1[4], p1[5]), cvtpk(p1[6], p1[7])}; \
              else pw = (u32x4){cvtpk(p1[8], p1[9]), cvtpk(p1[10], p1[11]), cvtpk(p1[12], p1[13]), cvtpk(p1[14], p1[15])}; \
              const bf16x8 pb = __builtin_bit_cast(bf16x8, pw); \
              const bf16x8 va0 = __builtin_bit_cast(bf16x8, (u32x4){vr[s][0][0], vr[s][0][1], vr[s][1][0], vr[s][1][1]}), va1 = __builtin_bit_cast(bf16x8, (u32x4){vr[s][2][0], vr[s][2][1], vr[s][3][0], vr[s][3][1]}); \
              o0 = __builtin_amdgcn_mfma_f32_32x32x16_bf16(va0, pb, o0, 0, 0, 0); o1 = __builtin_amdgcn_mfma_f32_32x32x16_bf16(va1, pb, o1, 0, 0, 0); } \
        if ((t) + 1 < NT) ATT_WRITE(SW, buf ^ 1); \
        ATT_LOAD(SW, ((t) + 3 < NT) ? (t) + 3 : NT - 1);            \
        BAR_LDS(); } while (0)
    for (int t = 0; t < NT; t += 2) { ATT_STEP(t, SB); ATT_STEP(t + 1, SA); }
#undef ATT_STEP
#undef ATT_LOAD
#undef ATT_WRITE
    { auto rr = __builtin_amdgcn_permlane32_swap(__float_as_uint(lsum), __float_as_uint(lsum), false, false); lsum = __uint_as_float(rr[0]) + __uint_as_float(rr[1]); }
    const float inv = 1.f / lsum;
    bf16_t* orow = mix + (tb + q) * DMIX + 768 + h * 64;
#pragma unroll
    for (int rg = 0; rg < 4; ++rg) {
        u32x2 w0 = {cvtpk(o0[4 * rg] * inv, o0[4 * rg + 1] * inv), cvtpk(o0[4 * rg + 2] * inv, o0[4 * rg + 3] * inv)};
        u32x2 w1 = {cvtpk(o1[4 * rg] * inv, o1[4 * rg + 1] * inv), cvtpk(o1[4 * rg + 2] * inv, o1[4 * rg + 3] * inv)};
        *(u32x2*)(orow + 8 * rg + 4 * hi) = w0; *(u32x2*)(orow + 32 + 8 * rg + 4 * hi) = w1; }
}
}
#endif

#ifndef CPU_TEST
namespace lin {
using att::bf16x8; using att::f32x16; using att::u32x4; using att::u32x2; using att::cvtpk; using att::crow;
constexpr int PT = 68;
template <int DK, int NDV> struct Lay {
    static constexpr int PQ = DK + 8;
    static constexpr int OFF_Q = 0, OFF_K = OFF_Q + 64 * PQ * 2, OFF_KH = OFF_K + 64 * PQ * 2, OFF_VT = OFF_KH + DK * PT * 2, OFF_DEC = OFF_VT + NDV * PT * 2, BUF = OFF_DEC + 256;
};
__device__ __forceinline__ bf16x8 ldA16(ATT_LAS const unsigned char* p) { return *(ATT_LAS const bf16x8*)p; }
__device__ __forceinline__ bf16x8 ldP8(ATT_LAS const unsigned char* p) { const u32x2 a = *(ATT_LAS const u32x2*)p, b = *(ATT_LAS const u32x2*)(p + 16); return __builtin_bit_cast(bf16x8, (u32x4){a[0], a[1], b[0], b[1]}); }
__device__ __forceinline__ bf16x8 pack8(const f32x16& x, int s) {
    u32x4 p;
    if (s == 0) p = (u32x4){cvtpk(x[0], x[1]), cvtpk(x[2], x[3]), cvtpk(x[4], x[5]), cvtpk(x[6], x[7])};
    else p = (u32x4){cvtpk(x[8], x[9]), cvtpk(x[10], x[11]), cvtpk(x[12], x[13]), cvtpk(x[14], x[15])};
    return __builtin_bit_cast(bf16x8, p); }
#define MF32(a, b, c) __builtin_amdgcn_mfma_f32_32x32x16_bf16((a), (b), (c), 0, 0, 0)
template <int DK, int NDV> __device__ __forceinline__ void compute(ATT_LAS const unsigned char* B, int ib, int dvb, int r32, int hi, f32x16 (&H)[DK / 32], f32x16& O) {
    typedef Lay<DK, NDV> L;
    f32x16 X[2];
#pragma unroll
    for (int r = 0; r < 16; ++r) { X[0][r] = 0.f; X[1][r] = 0.f; O[r] = 0.f; }
#pragma unroll
    for (int jb = 0; jb < 2; ++jb) if (jb <= ib) {
#pragma unroll
        for (int s = 0; s < DK / 16; ++s)
            X[jb] = MF32(ldA16(B + L::OFF_K + ((32 * jb + r32) * L::PQ + 16 * s + 8 * hi) * 2), ldA16(B + L::OFF_Q + ((32 * ib + r32) * L::PQ + 16 * s + 8 * hi) * 2), X[jb]);
        if (jb == ib) {
#pragma unroll
            for (int r = 0; r < 16; ++r) if (crow(r, hi) > r32) X[jb][r] = 0.f; } }
    bf16x8 vf[2][2];
#pragma unroll
    for (int jb = 0; jb < 2; ++jb)
#pragma unroll
        for (int s = 0; s < 2; ++s) vf[jb][s] = ldP8(B + L::OFF_VT + ((32 * dvb + r32) * PT + 32 * jb + 16 * s + 4 * hi) * 2);
#pragma unroll
    for (int jb = 0; jb < 2; ++jb) if (jb <= ib) {
#pragma unroll
        for (int s = 0; s < 2; ++s) O = MF32(pack8(X[jb], s), vf[jb][s], O); }
#pragma unroll
    for (int db = 0; db < DK / 32; ++db)
#pragma unroll
        for (int s = 0; s < 2; ++s) O = MF32(ldP8(B + L::OFF_Q + ((32 * ib + r32) * L::PQ + 32 * db + 16 * s + 4 * hi) * 2), pack8(H[db], s), O);
#pragma unroll
    for (int db = 0; db < DK / 32; ++db) {
        ATT_LAS const float* dec = (ATT_LAS const float*)(B + L::OFF_DEC);
#pragma unroll
        for (int r = 0; r < 16; ++r) H[db][r] *= dec[32 * db + crow(r, hi)];
#pragma unroll
        for (int jb = 0; jb < 2; ++jb)
#pragma unroll
            for (int s = 0; s < 2; ++s) H[db] = MF32(ldP8(B + L::OFF_KH + ((32 * db + r32) * PT + 32 * jb + 16 * s + 4 * hi) * 2), vf[jb][s], H[db]); }
}
__device__ __forceinline__ float scan64(float v, int lane) {
    { int y = __builtin_amdgcn_update_dpp(0, __builtin_bit_cast(int, v), 0x111, 0xF, 0xF, true); v += __builtin_bit_cast(float, y); }
    { int y = __builtin_amdgcn_update_dpp(0, __builtin_bit_cast(int, v), 0x112, 0xF, 0xF, true); v += __builtin_bit_cast(float, y); }
    { int y = __builtin_amdgcn_update_dpp(0, __builtin_bit_cast(int, v), 0x114, 0xF, 0xF, true); v += __builtin_bit_cast(float, y); }
    { int y = __builtin_amdgcn_update_dpp(0, __builtin_bit_cast(int, v), 0x118, 0xF, 0xF, true); v += __builtin_bit_cast(float, y); }
    const int x = __builtin_bit_cast(int, v);
    const float t0 = __builtin_bit_cast(float, __builtin_amdgcn_readlane(x, 15)), t1 = __builtin_bit_cast(float, __builtin_amdgcn_readlane(x, 31)), t2 = __builtin_bit_cast(float, __builtin_amdgcn_readlane(x, 47));
    const int row = lane >> 4;
    return v + (row >= 1 ? t0 : 0.f) + (row >= 2 ? t1 : 0.f) + (row >= 3 ? t2 : 0.f); }
__device__ __forceinline__ float bfl(unsigned w) { return __builtin_bit_cast(float, w << 16); }
__device__ __forceinline__ float bfh(unsigned w) { return __builtin_bit_cast(float, w & 0xffff0000u); }
__device__ __forceinline__ void vt_write(ATT_LAS unsigned char* B, int off_vt, int tok, int part, const u32x4& sv) {
    ATT_LAS unsigned short* vt = (ATT_LAS unsigned short*)(B + off_vt);
#pragma unroll
    for (int j = 0; j < 4; ++j) { vt[(8 * part + 2 * j) * PT + tok] = (unsigned short)(sv[j] & 0xffffu); vt[(8 * part + 2 * j + 1) * PT + tok] = (unsigned short)(sv[j] >> 16); } }

#define GLA_FETCH(c) do { const size_t t_ = tb + (size_t)(c) * 64 + lane; const bf16_t* ur = u + t_ * DINP; \
        pa0 = *(const u32x4*)(ur + UB_AD); pa1 = *(const u32x4*)(ur + UB_AD + 8); pq = *(const u32x2*)(ur + UB_Q + h * 32 + 4 * w); pk = *(const u32x2*)(ur + UB_K + h * 32 + 4 * w); \
        pv = *(const u32x4*)(u + (tb + (size_t)(c) * 64 + vtok) * DINP + UB_V + h * 64 + vpart * 8); } while (0)
#define GLA_PREP(buf) do { ATT_LAS unsigned char* B_ = lds + (buf) * L::BUF; \
        float adv[16]; _Pragma("unroll") for (int j = 0; j < 4; ++j) { adv[2 * j] = bfl(pa0[j]); adv[2 * j + 1] = bfh(pa0[j]); adv[8 + 2 * j] = bfl(pa1[j]); adv[9 + 2 * j] = bfh(pa1[j]); } \
        const float qv[4] = {bfl(pq[0]), bfh(pq[0]), bfl(pq[1]), bfh(pq[1])}, kv[4] = {bfl(pk[0]), bfh(pk[0]), bfl(pk[1]), bfh(pk[1])}; \
        float qo[4], ko[4]; \
        _Pragma("unroll") for (int d = 0; d < 4; ++d) { float z = ab[d]; _Pragma("unroll") for (int j = 0; j < 16; ++j) z += adv[j] * aup[j * 128 + d]; \
            const float la = -softplusf_(-z) * (1.f / 16.f); const float bc = scan64(la, lane); const float be = __builtin_bit_cast(float, __builtin_amdgcn_readlane(__builtin_bit_cast(int, bc), 63)); \
            qo[d] = qv[d] * __expf(bc) * 0.17677669529663687f; ko[d] = kv[d] * __expf(-bc); const float kh = kv[d] * __expf(be - bc); \
            ((ATT_LAS unsigned short*)(B_ + L::OFF_KH))[(4 * w + d) * PT + lane] = f2bf(kh); \
            if (lane == 63) ((ATT_LAS float*)(B_ + L::OFF_DEC))[4 * w + d] = __expf(be); } \
        *(ATT_LAS u32x2*)(B_ + L::OFF_Q + (lane * L::PQ + 4 * w) * 2) = (u32x2){cvtpk(qo[0], qo[1]), cvtpk(qo[2], qo[3])}; \
        *(ATT_LAS u32x2*)(B_ + L::OFF_K + (lane * L::PQ + 4 * w) * 2) = (u32x2){cvtpk(ko[0], ko[1]), cvtpk(ko[2], ko[3])}; \
        vt_write(B_, L::OFF_VT, vtok, vpart, pv); } while (0)
#define ML_FETCH(c) do { const int s_ = (c) * 64 + lane; const bf16_t* ur = u + (tb + s_) * DINP; \
        _Pragma("unroll") for (int j = 0; j < 4; ++j) { const bool ok = s_ - 3 + j >= 0; const bf16_t* up = ur + (ptrdiff_t)(j - 3) * DINP; \
            xq[j] = ok ? *(const u32x4*)(up + UC_Q + h * 64 + 8 * w) : (u32x4){0u, 0u, 0u, 0u}; xk[j] = ok ? *(const u32x4*)(up + UC_K + h * 64 + 8 * w) : (u32x4){0u, 0u, 0u, 0u}; } \
        pg = *(const u32x4*)(ur + UC_IG); pv = *(const u32x4*)(u + (tb + (size_t)(c) * 64 + vtok) * DINP + UC_V + h * 64 + vpart * 8); } while (0)
#define ML_PREP(buf) do { ATT_LAS unsigned char* B_ = lds + (buf) * L::BUF; \
        const unsigned gi_ = pg[h >> 1], gf_ = pg[2 + (h >> 1)]; const float ig = ((h & 1) ? bfh(gi_) : bfl(gi_)) + ibias; const float lf = -softplusf_(-(((h & 1) ? bfh(gf_) : bfl(gf_)) + fbias)); \
        const float F = scan64(lf, lane); const float Fe = __builtin_bit_cast(float, __builtin_amdgcn_readlane(__builtin_bit_cast(int, F), 63)); const float eF = __expf(F), wk = __expf(ig - F) * 0.125f, wkh = __expf(Fe - F + ig) * 0.125f; \
        float qo[8], ko[8]; \
        _Pragma("unroll") for (int ch = 0; ch < 8; ++ch) { float yq = cb[ch], yk = cb[256 + ch]; \
            _Pragma("unroll") for (int j = 0; j < 4; ++j) { const unsigned wq_ = xq[j][ch >> 1], wk_ = xk[j][ch >> 1]; \
                yq += cw[j * 512 + ch] * ((ch & 1) ? bfh(wq_) : bfl(wq_)); yk += cw[j * 512 + 256 + ch] * ((ch & 1) ? bfh(wk_) : bfl(wk_)); } \
            const float sq = siluf_(yq), sk = siluf_(yk); qo[ch] = sq * eF; ko[ch] = sk * wk; \
            ((ATT_LAS unsigned short*)(B_ + L::OFF_KH))[(8 * w + ch) * PT + lane] = f2bf(sk * wkh); } \
        *(ATT_LAS u32x4*)(B_ + L::OFF_Q + (lane * L::PQ + 8 * w) * 2) = (u32x4){cvtpk(qo[0], qo[1]), cvtpk(qo[2], qo[3]), cvtpk(qo[4], qo[5]), cvtpk(qo[6], qo[7])}; \
        *(ATT_LAS u32x4*)(B_ + L::OFF_K + (lane * L::PQ + 8 * w) * 2) = (u32x4){cvtpk(ko[0], ko[1]), cvtpk(ko[2], ko[3]), cvtpk(ko[4], ko[5]), cvtpk(ko[6], ko[7])}; \
        if (w == 0) ((ATT_LAS float*)(B_ + L::OFF_DEC))[lane] = __expf(Fe); \
        vt_write(B_, L::OFF_VT, vtok, vpart, pv); } while (0)
#define GLA_FETCHX(tb_, h_, c_) do { const size_t t_ = (tb_) + (size_t)(c_) * 64 + lane; const bf16_t* ur = u + t_ * DINP; \
        pa0 = *(const u32x4*)(ur + UB_AD); pa1 = *(const u32x4*)(ur + UB_AD + 8); pq = *(const u32x2*)(ur + UB_Q + (h_) * 32 + 4 * w); pk = *(const u32x2*)(ur + UB_K + (h_) * 32 + 4 * w); \
        pv = *(const u32x4*)(u + ((tb_) + (size_t)(c_) * 64 + vtok) * DINP + UB_V + (h_) * 64 + vpart * 8); } while (0)
#define ML_FETCHX(tb_, h_, c_) do { const int s_ = (c_) * 64 + lane; const bf16_t* ur = u + ((tb_) + s_) * DINP; \
        _Pragma("unroll") for (int j = 0; j < 4; ++j) { const bool ok = s_ - 3 + j >= 0; const bf16_t* up = ur + (ptrdiff_t)(j - 3) * DINP; \
            xq[j] = ok ? *(const u32x4*)(up + UC_Q + (h_) * 64 + 8 * w) : (u32x4){0u, 0u, 0u, 0u}; xk[j] = ok ? *(const u32x4*)(up + UC_K + (h_) * 64 + 8 * w) : (u32x4){0u, 0u, 0u, 0u}; } \
        pg = *(const u32x4*)(ur + UC_IG); pv = *(const u32x4*)(u + ((tb_) + (size_t)(c_) * 64 + vtok) * DINP + UC_V + (h_) * 64 + vpart * 8); } while (0)
template <int MIX> __device__ __forceinline__ void stage1_units(ATT_LAS unsigned char* lds, CtxRef C, int l, int first, int stride) {
    typedef Lay<(MIX == 0 ? 32 : 64), (MIX == 0 ? 64 : 96)> L;
    int tid = threadIdx.x; asm volatile("" : "+v"(tid));
    const int lane = tid & 63, w = __builtin_amdgcn_readfirstlane(tid >> 6);
    const bf16_t* u = WSP(bf16_t, WS_U);
    const int vtok = tid >> 3, vpart = tid & 7;
    unsigned char* blobs = C.ws + (MIX == 0 ? WS_GLA_BLOB : WS_ML_BLOB);
    if (MIX == 1) { for (int i = tid; i < 32 * PT; i += 512) ((ATT_LAS unsigned short*)(lds + L::OFF_VT))[64 * PT + i] = (i < PT) ? (unsigned short)0x3f80 : (unsigned short)0; }
    constexpr int NC = SEQ / 64, NV = L::BUF / 16, NU = BATCH * NH * NC;
    u32x4 pa0, pa1, pv, pg, xq[4], xk[4]; u32x2 pq, pk;
    if (first < NU) { const int bh = first / NC, c = first % NC; const size_t tb = (size_t)(bh >> 2) * SEQ;
        if (MIX == 0) GLA_FETCHX(tb, bh & 3, c); else ML_FETCHX(tb, bh & 3, c); }
    for (int uu = first; uu < NU; uu += stride) {
        const int bh = uu / NC, h = bh & 3;
        if (MIX == 0) { const float* aup = INF(I_GLA_UP) + l * 16 * 128 + h * 32 + 4 * w; const float* ab = INF(I_GLA_B) + l * 128 + h * 32 + 4 * w; GLA_PREP(0); }
        else { const float* cw = INF(I_CONVW) + l * 4 * 512 + h * 64 + 8 * w; const float* cb = INF(I_CONVB) + l * 512 + h * 64 + 8 * w; const float ibias = INF(I_IB)[l * 4 + h], fbias = INF(I_FB)[l * 4 + h]; ML_PREP(0); }
        { const int un = uu + stride; if (un < NU) { const int bhn = un / NC, cn = un % NC; const size_t tbn = (size_t)(bhn >> 2) * SEQ;
            if (MIX == 0) GLA_FETCHX(tbn, bhn & 3, cn); else ML_FETCHX(tbn, bhn & 3, cn); } }
        BAR_LDS();
        u32x4* dst = (u32x4*)(blobs + (size_t)uu * L::BUF);
        for (int i = tid; i < NV; i += 512) dst[i] = *(ATT_LAS const u32x4*)(lds + i * 16);
        BAR_LDS();
    }
}
template <int MIX> __device__ __forceinline__ void stage2_run(ATT_LAS unsigned char* lds, CtxRef C, int b, int h) {
    typedef Lay<(MIX == 0 ? 32 : 64), (MIX == 0 ? 64 : 96)> L;
    constexpr int DK = (MIX == 0 ? 32 : 64), NDV = (MIX == 0 ? 64 : 96), NCW = (MIX == 0 ? 4 : 6);
    int tid = threadIdx.x; asm volatile("" : "+v"(tid));
    const int lane = tid & 63, w = __builtin_amdgcn_readfirstlane(tid >> 6), r32 = lane & 31, hi = lane >> 5;
    constexpr int NC = SEQ / 64, NV = L::BUF / 16, NI = (NV + 511) / 512;
    const unsigned char* blobs = C.ws + (MIX == 0 ? WS_GLA_BLOB : WS_ML_BLOB) + (size_t)(b * 4 + h) * NC * L::BUF;
    float* Y = WSP(float, (MIX == 0 ? WS_YB : WS_YC)); float* DEN = WSP(float, WS_DEN);
    const size_t tb = (size_t)b * SEQ;
    f32x16 H[DK / 32], O;
#pragma unroll
    for (int d = 0; d < DK / 32; ++d)
#pragma unroll
        for (int r = 0; r < 16; ++r) H[d][r] = 0.f;
    const int ib = (MIX == 0) ? (w >> 1) : (w / 3), dvb = (MIX == 0) ? (w & 1) : (w % 3);
    u32x4 s0[NI], s1[NI];
#define LB_FETCH(S, c) do { const u32x4* src_ = (const u32x4*)(blobs + (size_t)(c) * L::BUF); _Pragma("unroll") for (int i = 0; i < NI; ++i) { const int ix = tid + 512 * i; if (ix < NV) S[i] = src_[ix]; } } while (0)
#define LB_WRITE(S, buf) do { _Pragma("unroll") for (int i = 0; i < NI; ++i) { const int ix = tid + 512 * i; if (ix < NV) *(ATT_LAS u32x4*)(lds + (buf) * L::BUF + ix * 16) = S[i]; } } while (0)
#define LB_STEP(c, SW) do { \
        if (w < NCW) { compute<DK, NDV>(lds + ((c) & 1) * L::BUF, ib, dvb, r32, hi, H, O); \
            const size_t t0 = tb + (size_t)(c) * 64 + 32 * ib; \
            if (MIX == 0 || dvb < 2) { float* yo = Y + t0 * GW + h * 64 + 32 * dvb + r32; _Pragma("unroll") for (int r = 0; r < 16; ++r) yo[(size_t)crow(r, hi) * GW] = O[r]; } \
            else if (r32 == 0) { _Pragma("unroll") for (int r = 0; r < 16; ++r) DEN[(t0 + crow(r, hi)) * 4 + h] = O[r]; } } \
        if ((c) + 1 < NC) { LB_WRITE(SW, ((c) + 1) & 1); if ((c) + 3 < NC) LB_FETCH(SW, (c) + 3); } \
        BAR_LDS(); } while (0)
    LB_FETCH(s0, 0); LB_FETCH(s1, 1); LB_WRITE(s0, 0); LB_FETCH(s0, 2);
    BAR_LDS();
    for (int c = 0; c < NC; c += 2) { LB_STEP(c, s1); LB_STEP(c + 1, s0); }
#undef LB_FETCH
#undef LB_WRITE
#undef LB_STEP
}
#undef GLA_FETCH
#undef GLA_PREP
#undef ML_FETCH
#undef ML_PREP
#undef GLA_FETCHX
#undef ML_FETCHX
#undef MF32
}
#endif

#ifndef CPU_TEST
namespace rwk {
constexpr int NB = 16;
constexpr int VEC = 6 * 64;
constexpr int BUFB = NB * VEC * 4;
__device__ __forceinline__ float dpp_add(float v, int ctrl_sel) {
    int x = __builtin_bit_cast(int, v), y;
    if (ctrl_sel == 0) y = __builtin_amdgcn_update_dpp(0, x, 0xB1, 0xF, 0xF, true);
    else if (ctrl_sel == 1) y = __builtin_amdgcn_update_dpp(0, x, 0x4E, 0xF, 0xF, true);
    else if (ctrl_sel == 2) y = __builtin_amdgcn_update_dpp(0, x, 0x141, 0xF, 0xF, true);
    else y = __builtin_amdgcn_update_dpp(0, x, 0x140, 0xF, 0xF, true);
    return v + __builtin_bit_cast(float, y); }
__device__ __forceinline__ float red16(float v) { v = dpp_add(v, 0); v = dpp_add(v, 1); v = dpp_add(v, 2); v = dpp_add(v, 3); return v; }
__device__ __forceinline__ void run(ATT_LAS unsigned char* lds, CtxRef C, int b, int h, int rg) {
    int tid = threadIdx.x; asm volatile("" : "+v"(tid));
    const int lane = tid & 63, w = __builtin_amdgcn_readfirstlane(tid >> 6);
    const float* src[6] = {WSP(float, WS_RW_A), WSP(float, WS_RW_W), WSP(float, WS_RW_B), WSP(float, WS_RW_K), WSP(float, WS_RW_R), WSP(float, WS_RW_V)};
    float* Y = WSP(float, WS_YA);
    const size_t tb = (size_t)b * SEQ;
    const int lt = tid - 256;
#define RW_LOAD(batch, buf) do { _Pragma("unroll") for (int i = 0; i < 6; ++i) { const int p = lt + 256 * i; const int st = p / 96, vc = (p % 96) >> 4, pt = p & 15; \
        const float* sp = (vc == 0 ? src[0] : vc == 1 ? src[1] : vc == 2 ? src[2] : vc == 3 ? src[3] : vc == 4 ? src[4] : src[5]); \
        const f4v v4 = *(const f4v*)(sp + (tb + (size_t)(batch) * NB + st) * GW + h * 64 + pt * 4); \
        *(ATT_LAS f4v*)(lds + (buf) * BUFB + (st * VEC + vc * 64 + pt * 4) * 4) = v4; } } while (0)
    constexpr int NBATCH = SEQ / NB;
    if (w >= 4) RW_LOAD(0, 0);
    BAR_LDS();
    const int row = 16 * rg + 4 * w + (lane >> 4), cg = lane & 15;
    float S0 = 0.f, S1 = 0.f, S2 = 0.f, S3 = 0.f;
    for (int bt = 0; bt < NBATCH; ++bt) {
        if (w >= 4) { if (bt + 1 < NBATCH) RW_LOAD(bt + 1, (bt + 1) & 1); }
        else {
            ATT_LAS const float* B = (ATT_LAS const float*)(lds + (bt & 1) * BUFB);
#pragma unroll 4
            for (int st = 0; st < NB; ++st) {
                ATT_LAS const float* P = B + st * VEC;
                const f4v a = *(ATT_LAS const f4v*)(P + 4 * cg), wv = *(ATT_LAS const f4v*)(P + 64 + 4 * cg), bb = *(ATT_LAS const f4v*)(P + 128 + 4 * cg),
                          kk = *(ATT_LAS const f4v*)(P + 192 + 4 * cg), r = *(ATT_LAS const f4v*)(P + 256 + 4 * cg);
                const float vv = P[320 + row];
                const float sa = red16((S0 * a[0] + S1 * a[1]) + (S2 * a[2] + S3 * a[3]));
                S0 = S0 * wv[0] + (sa * bb[0] + vv * kk[0]); S1 = S1 * wv[1] + (sa * bb[1] + vv * kk[1]);
                S2 = S2 * wv[2] + (sa * bb[2] + vv * kk[2]); S3 = S3 * wv[3] + (sa * bb[3] + vv * kk[3]);
                const float y = red16((S0 * r[0] + S1 * r[1]) + (S2 * r[2] + S3 * r[3]));
                if (cg == 0) Y[(tb + (size_t)bt * NB + st) * GW + h * 64 + row] = y;
            }
        }
        BAR_LDS();
    }
#undef RW_LOAD
}
}
#endif

#ifndef CPU_TEST
namespace rw7 {
using att::bf16x8; using att::f32x16; using att::u32x4; using att::u32x2; using att::cvtpk; using att::crow;
using lin::ldA16; using lin::ldP8; using lin::pack8; using lin::scan64; using lin::bfl; using lin::bfh;
#define MF32(a, b, c) __builtin_amdgcn_mfma_f32_32x32x16_bf16((a), (b), (c), 0, 0, 0)
constexpr int PA = 136, PZ = 68, PW = 40, PG_ = 72;
constexpr int X_WUP = 0, X_AUP = 5120, X_GUP = 10240, X_ACT = 19456;
constexpr int O_ZB = 71680, O_ZAB = 89088, O_RED = 106496;
constexpr int I_AT = 0, I_RT = 9216, I_BT = 18432, I_KT = 27648, I_ATT = 36864, I_BTT = 45568, I_KTT = 54272, I_VT = 62976;
constexpr int O_TIMG = O_ZAB, O_L21 = O_ZAB + 9216, O_T11T = O_ZAB + 11776, O_EX = 110592, O_GC = 126976;
static_assert(I_VT + 64 * 68 * 2 <= O_ZB && O_T11T + 2560 <= O_RED && O_RED + 4096 <= O_EX && O_EX + 16384 <= O_GC && O_GC + 256 <= 131072, "rw7 LDS map");
__device__ __forceinline__ void stage1_unit(ATT_LAS unsigned char* lds, CtxRef C, int l, int b, int h, int ch) {
    const int unit = (b * 4 + h) * (SEQ / 64) + ch;
    int tid = threadIdx.x; asm volatile("" : "+v"(tid));
    const int lane = tid & 63, w = __builtin_amdgcn_readfirstlane(tid >> 6), r32 = lane & 31, hi = lane >> 5;
    const bf16_t* u = WSP(bf16_t, WS_U); const float* mu = INF(I_MU) + l * DINA;
    const size_t t0 = (size_t)b * SEQ + (size_t)ch * 64;
    const bool seq0 = (ch == 0);
    const int atok = tid >> 3, apart = tid & 7;
    u32x4 lc0, lc1, lp0, lp1;
    { const bf16_t* p = u + (t0 + atok) * DINP + UA_WD + 16 * apart; lc0 = *(const u32x4*)p; lc1 = *(const u32x4*)(p + 8);
      if (seq0 && atok == 0) { lp0 = (u32x4){0u, 0u, 0u, 0u}; lp1 = lp0; } else { lp0 = *(const u32x4*)(p - DINP); lp1 = *(const u32x4*)(p - DINP + 8); } }
    u32x4 rc, kc, vc, rp, kp, vp;
    { const bf16_t* p = u + (t0 + lane) * DINP + h * 64 + 8 * w; rc = *(const u32x4*)(p + UA_R); kc = *(const u32x4*)(p + UA_K); vc = *(const u32x4*)(p + UA_V);
      if (seq0 && lane == 0) { rp = (u32x4){0u, 0u, 0u, 0u}; kp = rp; vp = rp; } else { rp = *(const u32x4*)(p - DINP + UA_R); kp = *(const u32x4*)(p - DINP + UA_K); vp = *(const u32x4*)(p - DINP + UA_V); } }
    { const u32x4* wsrc = (const u32x4*)(C.ws + WS_RWW + (size_t)h * 19456);
#pragma unroll
      for (int i = 0; i < 3; ++i) { const int ix = tid + 512 * i; if (ix < 1216) *(ATT_LAS u32x4*)(lds + X_WUP + ix * 16) = wsrc[ix]; } }
    { float o[16];
#pragma unroll
      for (int j = 0; j < 4; ++j) { const float c0 = bfl(lc0[j]), c1 = bfh(lc0[j]), c2 = bfl(lc1[j]), c3 = bfh(lc1[j]); const float p0 = bfl(lp0[j]), p1 = bfh(lp0[j]), p2 = bfl(lp1[j]), p3 = bfh(lp1[j]);
          const float* m = mu + UA_WD + 16 * apart; o[2 * j] = c0 + (p0 - c0) * m[2 * j]; o[2 * j + 1] = c1 + (p1 - c1) * m[2 * j + 1]; o[8 + 2 * j] = c2 + (p2 - c2) * m[8 + 2 * j]; o[9 + 2 * j] = c3 + (p3 - c3) * m[9 + 2 * j]; }
      if (apart < 2) {
#pragma unroll
          for (int j = 0; j < 16; ++j) o[j] = tanhf_(o[j]); }
      else if (apart >= 4) {
#pragma unroll
          for (int j = 0; j < 16; ++j) o[j] = sigmoidf_(o[j]); }
      ATT_LAS unsigned char* d = lds + X_ACT + (atok * PA + 16 * apart) * 2;
      *(ATT_LAS u32x4*)d = (u32x4){cvtpk(o[0], o[1]), cvtpk(o[2], o[3]), cvtpk(o[4], o[5]), cvtpk(o[6], o[7])};
      *(ATT_LAS u32x4*)(d + 16) = (u32x4){cvtpk(o[8], o[9]), cvtpk(o[10], o[11]), cvtpk(o[12], o[13]), cvtpk(o[14], o[15])}; }
    BAR_LDS();
    { const int tb = (w & 3) >> 1, cb = w & 1; f32x16 z0, z1;
#pragma unroll
      for (int r = 0; r < 16; ++r) { z0[r] = 0.f; z1[r] = 0.f; }
      ATT_LAS const unsigned char* arow = lds + X_ACT + ((32 * tb + r32) * PA + 8 * hi) * 2;
      if (w < 4) {
#pragma unroll
          for (int s = 0; s < 2; ++s) { z0 = MF32(ldA16(arow + 32 * s), ldA16(lds + X_WUP + ((32 * cb + r32) * PW + 16 * s + 8 * hi) * 2), z0);
              z1 = MF32(ldA16(arow + 64 + 32 * s), ldA16(lds + X_AUP + ((32 * cb + r32) * PW + 16 * s + 8 * hi) * 2), z1); }
          ATT_LAS float* zb = (ATT_LAS float*)(lds + O_ZB); ATT_LAS float* zab = (ATT_LAS float*)(lds + O_ZAB);
#pragma unroll
          for (int r = 0; r < 16; ++r) { zb[(32 * tb + crow(r, hi)) * PZ + 32 * cb + r32] = z0[r]; zab[(32 * tb + crow(r, hi)) * PZ + 32 * cb + r32] = z1[r]; }
      } else {
#pragma unroll
          for (int s = 0; s < 4; ++s) z0 = MF32(ldA16(arow + 128 + 32 * s), ldA16(lds + X_GUP + ((32 * cb + r32) * PG_ + 16 * s + 8 * hi) * 2), z0);
          bf16_t* gg = WSP(bf16_t, WS_RW_GG) + (t0 + 32 * tb) * GW + h * 64 + 32 * cb + r32;
#pragma unroll
          for (int r = 0; r < 16; ++r) gg[(size_t)crow(r, hi) * GW] = f2bf(z0[r]); } }
    BAR_LDS();
    {   const int cb8 = h * 64 + 8 * w;
        const float* w0 = INF(I_W0) + l * GW + cb8; const float* a0 = INF(I_A0) + l * GW + cb8; const float* kkw = INF(I_KK) + l * GW + cb8; const float* kaw = INF(I_KA) + l * GW + cb8;
        const float* rkw = INF(I_RK) + l * GW + cb8;
        ATT_LAS const float* zb = (ATT_LAS const float*)(lds + O_ZB) + lane * PZ + 8 * w; ATT_LAS const float* zab = (ATT_LAS const float*)(lds + O_ZAB) + lane * PZ + 8 * w;
        const f4v zA = *(ATT_LAS const f4v*)zb, zB = *(ATT_LAS const f4v*)(zb + 4), yA = *(ATT_LAS const f4v*)zab, yB = *(ATT_LAS const f4v*)(zab + 4);
        float rr[8], kk_[8], vv[8], lw[8], ai[8], kq[8]; float ss = 0.f, bon = 0.f;
#pragma unroll
        for (int i = 0; i < 8; ++i) {
            const float z = w0[i] + (i < 4 ? zA[i & 3] : zB[i & 3]), za = a0[i] + (i < 4 ? yA[i & 3] : yB[i & 3]);
            lw[i] = -__expf(-softplusf_(-z) - 0.5f); ai[i] = sigmoidf_(za);
            const unsigned wr_ = rc[i >> 1], wk_ = kc[i >> 1], wv_ = vc[i >> 1], pr_ = rp[i >> 1], pk_ = kp[i >> 1], pv_ = vp[i >> 1];
            const float r_c = (i & 1) ? bfh(wr_) : bfl(wr_), k_c = (i & 1) ? bfh(wk_) : bfl(wk_), v_c = (i & 1) ? bfh(wv_) : bfl(wv_);
            const float r_p = (i & 1) ? bfh(pr_) : bfl(pr_), k_p = (i & 1) ? bfh(pk_) : bfl(pk_), v_p = (i & 1) ? bfh(pv_) : bfl(pv_);
            rr[i] = r_c + (r_p - r_c) * mu[UA_R + cb8 + i]; const float k = k_c + (k_p - k_c) * mu[UA_K + cb8 + i]; vv[i] = v_c + (v_p - v_c) * mu[UA_V + cb8 + i];
            kq[i] = k * kkw[i]; ss += kq[i] * kq[i]; kk_[i] = k * (1.f + (ai[i] - 1.f) * kaw[i]); bon += rr[i] * kk_[i] * rkw[i]; }
        ATT_LAS float* red = (ATT_LAS float*)(lds + O_RED);
        red[w * 64 + lane] = ss; red[512 + w * 64 + lane] = bon;
        BAR_LDS();
        float sst = 0.f, bont = 0.f;
#pragma unroll
        for (int ww = 0; ww < 8; ++ww) { sst += red[ww * 64 + lane]; bont += red[512 + ww * 64 + lane]; }
        const float inv = 1.f / fmaxf(sqrtf(sst), 1e-12f);
        float at8[8], rt8[8], bt8[8], kt8[8];
#pragma unroll
        for (int i = 0; i < 8; ++i) { const float Gc = scan64(lw[i], lane); const float Gp = Gc - lw[i]; const float kkn = kq[i] * inv; const float enG = __expf(-Gc);
            at8[i] = -kkn * __expf(Gp); rt8[i] = rr[i] * __expf(Gc); bt8[i] = kkn * ai[i] * enG; kt8[i] = kk_[i] * enG;
            if (lane == 63) { const float gcv = __expf(Gc); ((ATT_LAS float*)(lds + O_GC))[8 * w + i] = gcv; WSP(float, WS_RW_GC)[(size_t)unit * 64 + 8 * w + i] = gcv; } }
        { ATT_LAS unsigned char* d = lds + (lane * PG_ + 8 * w) * 2;
          *(ATT_LAS u32x4*)(d + I_AT) = (u32x4){cvtpk(at8[0], at8[1]), cvtpk(at8[2], at8[3]), cvtpk(at8[4], at8[5]), cvtpk(at8[6], at8[7])};
          *(ATT_LAS u32x4*)(d + I_RT) = (u32x4){cvtpk(rt8[0], rt8[1]), cvtpk(rt8[2], rt8[3]), cvtpk(rt8[4], rt8[5]), cvtpk(rt8[6], rt8[7])};
          *(ATT_LAS u32x4*)(d + I_BT) = (u32x4){cvtpk(bt8[0], bt8[1]), cvtpk(bt8[2], bt8[3]), cvtpk(bt8[4], bt8[5]), cvtpk(bt8[6], bt8[7])};
          *(ATT_LAS u32x4*)(d + I_KT) = (u32x4){cvtpk(kt8[0], kt8[1]), cvtpk(kt8[2], kt8[3]), cvtpk(kt8[4], kt8[5]), cvtpk(kt8[6], kt8[7])};
#pragma unroll
          for (int i = 0; i < 8; ++i) { const int o2 = ((8 * w + i) * lin::PT + lane) * 2;
              *(ATT_LAS unsigned short*)(lds + I_ATT + o2) = f2bf(at8[i]); *(ATT_LAS unsigned short*)(lds + I_BTT + o2) = f2bf(bt8[i]);
              *(ATT_LAS unsigned short*)(lds + I_KTT + o2) = f2bf(kt8[i]); *(ATT_LAS unsigned short*)(lds + I_VT + o2) = f2bf(vv[i]); } }
        const size_t o = (t0 + lane) * GW + cb8;
        if (w == 0) WSP(float, WS_RW_BON)[(t0 + lane) * 4 + h] = bont;
        *(u32x4*)(WSP(bf16_t, WS_RW_VS) + o) = (u32x4){cvtpk(vv[0], vv[1]), cvtpk(vv[2], vv[3]), cvtpk(vv[4], vv[5]), cvtpk(vv[6], vv[7])};
    }
    BAR_LDS();
#define RW_PROD(ACC, IA, IB, rb, cb, keep) do { _Pragma("unroll") for (int r_ = 0; r_ < 16; ++r_) ACC[r_] = 0.f; \
        _Pragma("unroll") for (int k_ = 0; k_ < 4; ++k_) ACC = MF32(ldA16(lds + (IA) + ((32 * (rb) + r32) * PG_ + 16 * k_ + 8 * hi) * 2), ldA16(lds + (IB) + ((32 * (cb) + r32) * PG_ + 16 * k_ + 8 * hi) * 2), ACC); \
        if ((keep) == 1) { _Pragma("unroll") for (int r_ = 0; r_ < 16; ++r_) if (!(crow(r_, hi) < r32)) ACC[r_] = 0.f; } \
        if ((keep) == 2) { _Pragma("unroll") for (int r_ = 0; r_ < 16; ++r_) if (!(crow(r_, hi) <= r32)) ACC[r_] = 0.f; } \
        if ((keep) == 3) { _Pragma("unroll") for (int r_ = 0; r_ < 16; ++r_) if (!(crow(r_, hi) > r32)) ACC[r_] = 0.f; } \
        __builtin_amdgcn_sched_barrier(0); } while (0)
    f32x16 M00, M01, M11;
    f32x16 Z1a, Z1b;
    if (w == 2 || w == 3) { const int eb = w - 2; f32x16 L00, L01, L11;
        RW_PROD(L00, I_KT, I_AT, 0, 0, 1); RW_PROD(L01, I_KT, I_AT, 0, 1, 0); RW_PROD(L11, I_KT, I_AT, 1, 1, 1);
#pragma unroll
        for (int r = 0; r < 16; ++r) { Z1a[r] = 0.f; Z1b[r] = 0.f; }
#pragma unroll
        for (int k = 0; k < 2; ++k) { const bf16x8 v0 = ldP8(lds + I_VT + ((32 * eb + r32) * lin::PT + 16 * k + 4 * hi) * 2), v1 = ldP8(lds + I_VT + ((32 * eb + r32) * lin::PT + 32 + 16 * k + 4 * hi) * 2);
            Z1a = MF32(pack8(L00, k), v0, Z1a); Z1b = MF32(pack8(L01, k), v0, Z1b); Z1b = MF32(pack8(L11, k), v1, Z1b); } }
    if (w == 4 || w == 5) { const int eb = w - 4; f32x16 K00, K01, K11, Ya, Yb, KVa, KVb;
        RW_PROD(K00, I_KT, I_RT, 0, 0, 2); RW_PROD(K01, I_KT, I_RT, 0, 1, 0); RW_PROD(K11, I_KT, I_RT, 1, 1, 2);
#pragma unroll
        for (int r = 0; r < 16; ++r) { Ya[r] = 0.f; Yb[r] = 0.f; KVa[r] = 0.f; KVb[r] = 0.f; }
#pragma unroll
        for (int k = 0; k < 2; ++k) { const bf16x8 v0 = ldP8(lds + I_VT + ((32 * eb + r32) * lin::PT + 16 * k + 4 * hi) * 2), v1 = ldP8(lds + I_VT + ((32 * eb + r32) * lin::PT + 32 + 16 * k + 4 * hi) * 2);
            Ya = MF32(pack8(K00, k), v0, Ya); Yb = MF32(pack8(K01, k), v0, Yb); Yb = MF32(pack8(K11, k), v1, Yb);
            KVa = MF32(ldP8(lds + I_KTT + (r32 * lin::PT + 16 * k + 4 * hi) * 2), v0, KVa); KVa = MF32(ldP8(lds + I_KTT + (r32 * lin::PT + 32 + 16 * k + 4 * hi) * 2), v1, KVa);
            KVb = MF32(ldP8(lds + I_KTT + ((32 + r32) * lin::PT + 16 * k + 4 * hi) * 2), v0, KVb); KVb = MF32(ldP8(lds + I_KTT + ((32 + r32) * lin::PT + 32 + 16 * k + 4 * hi) * 2), v1, KVb); }
        ATT_LAS unsigned char* ex = lds + O_EX + (eb * 4 * 64 + lane) * 32;
#define RW_EXW(q_, A_) do { *(ATT_LAS u32x4*)(ex + (q_) * 2048) = (u32x4){cvtpk(A_[0], A_[1]), cvtpk(A_[2], A_[3]), cvtpk(A_[4], A_[5]), cvtpk(A_[6], A_[7])}; \
        *(ATT_LAS u32x4*)(ex + (q_) * 2048 + 16) = (u32x4){cvtpk(A_[8], A_[9]), cvtpk(A_[10], A_[11]), cvtpk(A_[12], A_[13]), cvtpk(A_[14], A_[15])}; } while (0)
        RW_EXW(0, Ya); RW_EXW(1, Yb); RW_EXW(2, KVa); RW_EXW(3, KVb);
#undef RW_EXW
    }
    if (w == 7) {
        f32x16 La, Lb, Lc;
        RW_PROD(La, I_AT, I_BT, 0, 0, 3); RW_PROD(Lb, I_AT, I_BT, 1, 0, 0); RW_PROD(Lc, I_AT, I_BT, 1, 1, 3);
        ATT_LAS float* Lbuf = (ATT_LAS float*)(lds + O_ZB);
#pragma unroll
        for (int r = 0; r < 16; ++r) { Lbuf[crow(r, hi) * PZ + r32] = La[r]; Lbuf[(32 + crow(r, hi)) * PZ + 32 + r32] = Lc[r];
            *(ATT_LAS unsigned short*)(lds + O_L21 + (crow(r, hi) * PW + r32) * 2) = f2bf(Lb[r]);
            *(ATT_LAS unsigned short*)(lds + O_TIMG + (crow(r, hi) * PG_ + 32 + r32) * 2) = 0; }
        asm volatile("s_waitcnt lgkmcnt(0)" ::: "memory");
        float Tc[32];
        { ATT_LAS const float* Lr = Lbuf + (32 * hi) * PZ + 32 * hi;
#pragma unroll
          for (int t = 0; t < 32; ++t) { float acc = (t == r32) ? 1.f : 0.f;
#pragma unroll
              for (int s4 = 0; s4 < (t + 3) / 4; ++s4) { const f4v lv = *(ATT_LAS const f4v*)(Lr + t * PZ + 4 * s4);
#pragma unroll
                  for (int j = 0; j < 4; ++j) if (4 * s4 + j < t) acc += lv[j] * Tc[4 * s4 + j]; }
              Tc[t] = acc; } }
#pragma unroll
        for (int t = 0; t < 32; ++t) *(ATT_LAS unsigned short*)(lds + O_TIMG + ((32 * hi + t) * PG_ + 32 * hi + r32) * 2) = f2bf(Tc[t]);
        if (hi == 0) {
#pragma unroll
            for (int q4 = 0; q4 < 4; ++q4) *(ATT_LAS u32x4*)(lds + O_T11T + (r32 * PW + 8 * q4) * 2) = (u32x4){cvtpk(Tc[8 * q4], Tc[8 * q4 + 1]), cvtpk(Tc[8 * q4 + 2], Tc[8 * q4 + 3]), cvtpk(Tc[8 * q4 + 4], Tc[8 * q4 + 5]), cvtpk(Tc[8 * q4 + 6], Tc[8 * q4 + 7])}; }
        asm volatile("s_waitcnt lgkmcnt(0)" ::: "memory");
        f32x16 X, T21;
#pragma unroll
        for (int r = 0; r < 16; ++r) { X[r] = 0.f; T21[r] = 0.f; }
#pragma unroll
        for (int k = 0; k < 2; ++k) X = MF32(ldA16(lds + O_L21 + (r32 * PW + 16 * k + 8 * hi) * 2), ldA16(lds + O_T11T + (r32 * PW + 16 * k + 8 * hi) * 2), X);
#pragma unroll
        for (int k = 0; k < 2; ++k) T21 = MF32(ldP8(lds + O_TIMG + ((32 + r32) * PG_ + 32 + 16 * k + 4 * hi) * 2), pack8(X, k), T21);
#pragma unroll
        for (int r = 0; r < 16; ++r) *(ATT_LAS unsigned short*)(lds + O_TIMG + ((32 + crow(r, hi)) * PG_ + r32) * 2) = f2bf(T21[r]);
    }
    BAR_LDS();
    if (w < 4) {
        const int nb = w & 1;
        ATT_LAS const float* gc = (ATT_LAS const float*)(lds + O_GC);
        f32x16 P0, P1;
#pragma unroll
        for (int r = 0; r < 16; ++r) { P0[r] = 0.f; P1[r] = 0.f; }
#pragma unroll
        for (int k = 0; k < 2; ++k) {
            const bf16x8 t00 = ldP8(lds + O_TIMG + (r32 * PG_ + 16 * k + 4 * hi) * 2), t10 = ldP8(lds + O_TIMG + ((32 + r32) * PG_ + 16 * k + 4 * hi) * 2), t11 = ldP8(lds + O_TIMG + ((32 + r32) * PG_ + 32 + 16 * k + 4 * hi) * 2);
            bf16x8 b0, b1;
            if (w < 2) { b0 = ldP8(lds + I_ATT + ((32 * nb + r32) * lin::PT + 16 * k + 4 * hi) * 2); b1 = ldP8(lds + I_ATT + ((32 * nb + r32) * lin::PT + 32 + 16 * k + 4 * hi) * 2); }
            else { b0 = pack8(Z1a, k); b1 = pack8(Z1b, k); }
            P0 = MF32(t00, b0, P0); P1 = MF32(t10, b0, P1); P1 = MF32(t11, b1, P1); }
        {   RW_PROD(M00, I_BT, I_RT, 0, 0, 2); RW_PROD(M01, I_BT, I_RT, 0, 1, 0); RW_PROD(M11, I_BT, I_RT, 1, 1, 2);
            f32x16 A0, A1;
#pragma unroll
            for (int r = 0; r < 16; ++r) { A0[r] = 0.f; A1[r] = 0.f; }
#pragma unroll
            for (int k = 0; k < 2; ++k) { const bf16x8 p0 = pack8(P0, k), p1 = pack8(P1, k);
                A0 = MF32(pack8(M00, k), p0, A0); A1 = MF32(pack8(M01, k), p0, A1); A1 = MF32(pack8(M11, k), p1, A1); }
            if (w < 2) { bf16_t* RY = WSP(bf16_t, WS_RW_RY) + (size_t)unit * 4096;
#pragma unroll
                for (int r = 0; r < 16; ++r) { const int t = crow(r, hi), d = 32 * nb + r32;
                    RY[t * 64 + d] = f2bf(A0[r] + bf2f(*(ATT_LAS const unsigned short*)(lds + I_RT + (t * PG_ + d) * 2)));
                    RY[(32 + t) * 64 + d] = f2bf(A1[r] + bf2f(*(ATT_LAS const unsigned short*)(lds + I_RT + ((32 + t) * PG_ + d) * 2))); } }
            else { ATT_LAS const unsigned char* ex = lds + O_EX + (nb * 4 * 64 + lane) * 32; float* Y0G = WSP(float, WS_RW_Y0) + ((size_t)unit * 4 + nb) * 1024 + lane * 16;
#pragma unroll
                for (int r4 = 0; r4 < 16; r4 += 4) { f4v y0, y1;
#pragma unroll
                    for (int j = 0; j < 4; ++j) { const int r = r4 + j; y0[j] = A0[r] + bf2f(*(ATT_LAS const unsigned short*)(ex + 2 * r)); y1[j] = A1[r] + bf2f(*(ATT_LAS const unsigned short*)(ex + 2048 + 2 * r)); }
                    *(f4v*)(Y0G + r4) = y0; *(f4v*)(Y0G + 2048 + r4) = y1; } } }
        __builtin_amdgcn_sched_barrier(0);
        {   f32x16 B0, B1;
#pragma unroll
            for (int r = 0; r < 16; ++r) { B0[r] = 0.f; B1[r] = 0.f; }
#pragma unroll
            for (int k = 0; k < 2; ++k) { const bf16x8 p0 = pack8(P0, k), p1 = pack8(P1, k);
                B0 = MF32(ldP8(lds + I_BTT + (r32 * lin::PT + 16 * k + 4 * hi) * 2), p0, B0); B0 = MF32(ldP8(lds + I_BTT + (r32 * lin::PT + 32 + 16 * k + 4 * hi) * 2), p1, B0);
                B1 = MF32(ldP8(lds + I_BTT + ((32 + r32) * lin::PT + 16 * k + 4 * hi) * 2), p0, B1); B1 = MF32(ldP8(lds + I_BTT + ((32 + r32) * lin::PT + 32 + 16 * k + 4 * hi) * 2), p1, B1); }
            if (w < 2) { bf16_t* PLg = WSP(bf16_t, WS_RW_PL) + (size_t)unit * 4096;
#pragma unroll
                for (int r = 0; r < 16; ++r) { const int t = crow(r, hi), d = 32 * nb + r32; PLg[t * 64 + d] = f2bf(gc[t] * B0[r]); PLg[(32 + t) * 64 + d] = f2bf(gc[32 + t] * B1[r]); } }
            else { ATT_LAS const unsigned char* ex = lds + O_EX + (nb * 4 * 64 + lane) * 32; float* QG = WSP(float, WS_RW_QG) + ((size_t)unit * 4 + nb) * 1024 + lane * 16;
#pragma unroll
                for (int r4 = 0; r4 < 16; r4 += 4) { f4v q0, q1;
#pragma unroll
                    for (int j = 0; j < 4; ++j) { const int r = r4 + j; q0[j] = gc[crow(r, hi)] * (B0[r] + bf2f(*(ATT_LAS const unsigned short*)(ex + 4096 + 2 * r))); q1[j] = gc[32 + crow(r, hi)] * (B1[r] + bf2f(*(ATT_LAS const unsigned short*)(ex + 6144 + 2 * r))); }
                    *(f4v*)(QG + r4) = q0; *(f4v*)(QG + 2048 + r4) = q1; } } }
    }
    BAR_LDS();
#undef RW_PROD
}
__device__ __forceinline__ void stage2_run(ATT_LAS unsigned char* lds, CtxRef C, int b, int h) {
    int tid = threadIdx.x; asm volatile("" : "+v"(tid));
    const int lane = tid & 63, w = __builtin_amdgcn_readfirstlane(tid >> 6), r32 = lane & 31, hi = lane >> 5;
    constexpr int NC = SEQ / 64; constexpr int S2_PL = 0, S2_RY = 9216, S2_GC = 18432, S2_BUF = 18688;
    const int bh = b * 4 + h; const size_t unit0 = (size_t)bh * NC;
    const bf16_t* PLg = WSP(bf16_t, WS_RW_PL) + unit0 * 4096; const bf16_t* RYg = WSP(bf16_t, WS_RW_RY) + unit0 * 4096;
    const float* QG = WSP(float, WS_RW_QG) + unit0 * 4096; const float* Y0G = WSP(float, WS_RW_Y0) + unit0 * 4096; const float* GCg = WSP(float, WS_RW_GC) + unit0 * 64;
    float* Y = WSP(float, WS_YA);
    const int i = w >> 1, eb = w & 1, srow = tid >> 3, spart = tid & 7;
    f32x16 H0, H1, q0, q1, y0;
#pragma unroll
    for (int r = 0; r < 16; ++r) { H0[r] = 0.f; H1[r] = 0.f; }
    u32x4 spl, sry; float sgc = 0.f;
#define S2_FETCH_IMG(c) do { spl = *(const u32x4*)(PLg + (size_t)(c) * 4096 + srow * 64 + spart * 8); sry = *(const u32x4*)(RYg + (size_t)(c) * 4096 + srow * 64 + spart * 8); if (tid < 64) sgc = GCg[(c) * 64 + tid]; } while (0)
#define S2_FETCH_ACC(c) do { if (w < 4) { const float* qp = QG + (size_t)(c) * 4096 + eb * 1024 + lane * 16; const float* yp = Y0G + (size_t)(c) * 4096 + (i * 2 + eb) * 1024 + lane * 16; \
            _Pragma("unroll") for (int r4 = 0; r4 < 16; r4 += 4) { const f4v a = *(const f4v*)(qp + r4), b_ = *(const f4v*)(qp + 2048 + r4), c_ = *(const f4v*)(yp + r4); \
                _Pragma("unroll") for (int j = 0; j < 4; ++j) { q0[r4 + j] = a[j]; q1[r4 + j] = b_[j]; y0[r4 + j] = c_[j]; } } } } while (0)
#define S2_WRITE(buf) do { ATT_LAS unsigned char* B_ = lds + (buf) * S2_BUF; *(ATT_LAS u32x4*)(B_ + S2_PL + (srow * PG_ + spart * 8) * 2) = spl; *(ATT_LAS u32x4*)(B_ + S2_RY + (srow * PG_ + spart * 8) * 2) = sry; \
        if (tid < 64) ((ATT_LAS float*)(B_ + S2_GC))[tid] = sgc; } while (0)
    S2_FETCH_IMG(0); S2_FETCH_ACC(0); S2_WRITE(0);
    BAR_LDS();
    for (int c = 0; c < NC; ++c) {
        if (c + 1 < NC) S2_FETCH_IMG(c + 1);
        if (w < 4) {
            ATT_LAS const unsigned char* B_ = lds + (c & 1) * S2_BUF; ATT_LAS const float* gc = (ATT_LAS const float*)(B_ + S2_GC);
            bf16x8 hb[2][2];
#pragma unroll
            for (int k = 0; k < 2; ++k) { hb[0][k] = pack8(H0, k); hb[1][k] = pack8(H1, k); }
            f32x16 Yo = y0;
#pragma unroll
            for (int r = 0; r < 16; ++r) { H0[r] = gc[crow(r, hi)] * H0[r] + q0[r]; H1[r] = gc[32 + crow(r, hi)] * H1[r] + q1[r]; }
            __builtin_amdgcn_sched_barrier(0);
            if (c + 1 < NC) S2_FETCH_ACC(c + 1);
#pragma unroll
            for (int db = 0; db < 2; ++db)
#pragma unroll
                for (int k = 0; k < 2; ++k) Yo = MF32(ldP8(B_ + S2_RY + ((32 * i + r32) * PG_ + 32 * db + 16 * k + 4 * hi) * 2), hb[db][k], Yo);
#pragma unroll
            for (int db = 0; db < 2; ++db)
#pragma unroll
                for (int k = 0; k < 2; ++k) { H0 = MF32(ldP8(B_ + S2_PL + (r32 * PG_ + 32 * db + 16 * k + 4 * hi) * 2), hb[db][k], H0); H1 = MF32(ldP8(B_ + S2_PL + ((32 + r32) * PG_ + 32 * db + 16 * k + 4 * hi) * 2), hb[db][k], H1); }
            float* yo = Y + ((size_t)b * SEQ + (size_t)c * 64 + 32 * i) * GW + h * 64 + 32 * eb + r32;
#pragma unroll
            for (int r = 0; r < 16; ++r) yo[(size_t)crow(r, hi) * GW] = Yo[r];
        }
        if (c + 1 < NC) S2_WRITE((c + 1) & 1);
        BAR_LDS();
    }
#undef S2_FETCH_IMG
#undef S2_FETCH_ACC
#undef S2_WRITE
}
#undef MF32
}
#endif

constexpr int PH_PER_LAYER = 13;
constexpr int NPHASES = DEPTH * PH_PER_LAYER;

#ifndef CPU_TEST
#define XB_TMO      128
#define XB_XCNT(j)  (256  + 64 * (j))
#define XB_XSUB(j)  (1280 + 64 * (j))
#define XB_XGEN(j)  (2304 + 64 * (j))
#define XB_TOP      3328
#define XB_TOPGEN   3392
#define XCD_BAR_WORDS 3456
#define XB_SPIN_CAP (1u << 18)
#define LAS __attribute__((address_space(3)))
__device__ __forceinline__ unsigned xb_ld(unsigned* p)              { return __hip_atomic_load(p, __ATOMIC_RELAXED, __HIP_MEMORY_SCOPE_AGENT); }
__device__ __forceinline__ unsigned xb_add(unsigned* p, unsigned v) { return __hip_atomic_fetch_add(p, v, __ATOMIC_RELAXED, __HIP_MEMORY_SCOPE_AGENT); }
__device__ __forceinline__ unsigned xb_xcc_id() { return (unsigned)__builtin_amdgcn_s_getreg((3 << 11) | 20) & 0xFu; }
#define XB_SPIN(cond, bar) do { unsigned _sp = 0; while (cond) { __builtin_amdgcn_s_sleep(1); \
    if ((++_sp & 255u) == 0u) { if (xb_ld(&(bar)[XB_TMO])) break; if (_sp > XB_SPIN_CAP) { atomicAdd(&(bar)[XB_TMO], 1u); break; } } } } while (0)
struct XcdBarrier { unsigned* bar; unsigned x; volatile LAS unsigned* st; };
__device__ __forceinline__ XcdBarrier xcd_barrier_post(unsigned* bar, volatile LAS unsigned* st) {
    XcdBarrier b; b.bar = bar; b.x = xb_xcc_id(); b.st = st;
    if (threadIdx.x == 0) (void)xb_add(&bar[XB_XCNT(b.x)], 1u);
    return b;
}
__device__ __forceinline__ void xcd_barrier_complete(unsigned* bar, unsigned x, unsigned& nloc, unsigned& nx) {
    const unsigned G = gridDim.x * gridDim.y * gridDim.z;
    unsigned sum, cnt, mine, sp = 0u;
    for (;;) {
        sum = 0u; cnt = 0u; mine = 0u;
#pragma unroll
        for (unsigned j = 0; j < 16; ++j) { const unsigned c = xb_ld(&bar[XB_XCNT(j)]); sum += c; cnt += (c > 0u) ? 1u : 0u; mine = (j == x) ? c : mine; }
        if (sum == G) break;
        __builtin_amdgcn_s_sleep(1);
        if ((++sp & 255u) == 0u) { if (xb_ld(&bar[XB_TMO])) break; if (sp > XB_SPIN_CAP) { atomicAdd(&bar[XB_TMO], 1u); break; } }
    }
    nloc = mine > 0u ? mine : 1u; nx = cnt > 0u ? cnt : 1u;
}
__device__ __forceinline__ void xcd_barrier(const XcdBarrier& b) {
    asm volatile("s_waitcnt vmcnt(0)" ::: "memory");
    __syncthreads();
    if (threadIdx.x == 0) {
        unsigned* bar = b.bar;
        __builtin_amdgcn_s_waitcnt(0);
        unsigned nloc = b.st[0], nx = b.st[1];
        if (nloc == 0u) { xcd_barrier_complete(bar, b.x, nloc, nx); b.st[0] = nloc; b.st[1] = nx; }
        const unsigned old = xb_add(&bar[XB_XSUB(b.x)], 1u);
        const unsigned gen = old / nloc;
        if (old + 1u == (gen + 1u) * nloc) {
            __builtin_amdgcn_fence(__ATOMIC_RELEASE, "agent");
            asm volatile("s_waitcnt vmcnt(0)" ::: "memory");
            const unsigned og = xb_add(&bar[XB_TOP], 1u);
            const unsigned tg = og / nx;
            if (og + 1u == (tg + 1u) * nx) xb_add(&bar[XB_TOPGEN], 1u);
            else XB_SPIN(xb_ld(&bar[XB_TOPGEN]) == tg, bar);
            __builtin_amdgcn_fence(__ATOMIC_ACQUIRE, "agent");
            xb_add(&bar[XB_XGEN(b.x)], 1u);
            asm volatile("s_waitcnt vmcnt(0)" ::: "memory");
        } else {
            XB_SPIN(xb_ld(&bar[XB_XGEN(b.x)]) == gen, bar);
            __builtin_amdgcn_fence(__ATOMIC_ACQUIRE, "agent");
            asm volatile("s_waitcnt vmcnt(0)" ::: "memory");
        }
    }
    __syncthreads();
}

constexpr int NWAVES = 8;
constexpr int RING_BYTES = 131072, MISC_OFF = RING_BYTES + 320, LDS_BYTES = 147456;
struct Args { Ctx C; int ph_lo, ph_hi; };
__device__ __forceinline__ int moe_fill_table(CtxRef C, int l, LAS int* tbl, int tid) {
    const unsigned* cnt = WSP(unsigned, WS_CTL) + CW_CNT + l * NEXP * 64;
    int e, be, ce; const int total = moe_lookup(cnt, tid * 256, e, be, ce);
    if (tid < 320) tbl[tid] = e;
    __syncthreads();
    return total >> 8;
}

__global__ void __launch_bounds__(NWAVES * 64, 2) mega(Args args) {
    extern __shared__ __attribute__((aligned(16))) unsigned char lds_raw[];
    LAS unsigned char* lds = (LAS unsigned char*)lds_raw;
    const int G = gridDim.x, bx = blockIdx.x;
    const int ngw = G * NWAVES;
    volatile LAS unsigned* MISC = (volatile LAS unsigned*)(lds + MISC_OFF);
    for (int i = threadIdx.x; i < (LDS_BYTES - RING_BYTES) / 4; i += NWAVES * 64) ((LAS unsigned*)(lds + RING_BYTES))[i] = 0u;
    __syncthreads();
    XcdBarrier bar = xcd_barrier_post((unsigned*)(args.C.ws + WS_CTL) + CW_BAR, MISC + 8);
    LAS int* tbl = (LAS int*)(lds + RING_BYTES + 1024);
    const int lo = args.ph_lo, hi = args.ph_hi;

    for (int l = 0; l < DEPTH; ++l) {
        const int p0 = l * PH_PER_LAYER;
#ifndef PHASE_MASK
#define PHASE_MASK 0x1FFF
#endif
#define IN(k) (((PHASE_MASK >> (k)) & 1) && lo <= p0 + (k) && p0 + (k) < hi)
#define LAUNDER() const __attribute__((address_space(4))) Args* ap_ = (const __attribute__((address_space(4))) Args*)__builtin_amdgcn_kernarg_segment_ptr(); asm volatile("" : "+s"(ap_)); CtxRef C = ap_->C; \
        int bxl_ = blockIdx.x; asm volatile("" : "+s"(bxl_)); const int bx = bxl_;     \
        int tid = threadIdx.x; asm volatile("" : "+v"(tid)); const int lane = tid & 63; const int wave = __builtin_amdgcn_readfirstlane(tid >> 6); const int gw = bx * NWAVES + wave; (void)gw; (void)lane; \
        wsh_t wsh = (wsh_t)(lds + wave * 16384); (void)wsh
#define SEAM(k) do { if (p0 + (k) + 1 < hi) xcd_barrier(bar); } while (0)
        if (IN(0)) { LAUNDER(); stage_convert(C, l, gw, ngw, lane, wsh); SEAM(0); }
        if (IN(1)) { LAUNDER();
            pg8::Gemm g{WSP(bf16_t, WS_XB), WSP(bf16_t, WS_WIN), DM, DM, DM};
            pg8::DenseOrder S{T / 256, DINP / 256, G, bx, (long)256 * DM * 2, (long)256 * DM * 2};
            EpiU E{WSP(bf16_t, WS_U)};
            pg8::gemm_phase(lds, g, S, E); SEAM(1); }
        if (IN(2)) { LAUNDER();
            {   pg8::Gemm g{WSP(bf16_t, WS_U) + UD_CQ, WSP(bf16_t, WS_WUQ), DINP, 256, 256};
                pg8::DenseOrder S{T / 256, 2, G, bx, (long)256 * DINP * 2, (long)256 * 256 * 2};
                EpiQ E{WSP(float, WS_ROPE), WSP(bf16_t, WS_AQ)};
                pg8::gemm_phase(lds, g, S, E); }
            {   pg8::Gemm g{WSP(bf16_t, WS_U) + UD_CKV, WSP(bf16_t, WS_WUKV), DINP, 256, 256};
                pg8::DenseOrder S{T / 256, 2, G, bx, (long)256 * DINP * 2, (long)256 * 256 * 2};
                EpiKV E{WSP(bf16_t, WS_AK), WSP(bf16_t, WS_AV)};
                pg8::gemm_phase(lds, g, S, E); }
            __syncthreads();
            SEAM(2); }
        if (IN(3)) { LAUNDER();
            mla_token_pass(C, gw, ngw, lane);
            __syncthreads();
            lin::stage1_units<0>(lds, C, l, bx, G);
            lin::stage1_units<1>(lds, C, l, bx, G);
            for (int uu = bx; uu < BATCH * NH * (SEQ / 64); uu += G) { const int bh = uu / (SEQ / 64), ch = uu % (SEQ / 64); rw7::stage1_unit(lds, C, l, bh >> 2, bh & 3, ch); }
            SEAM(3); }
        if (IN(4)) { LAUNDER();
            if (bx < 32) rw7::stage2_run(lds, C, bx >> 2, bx & 3);
            else if (bx < 64) lin::stage2_run<0>(lds, C, (bx - 32) >> 2, (bx - 32) & 3);
            else if (bx < 96) lin::stage2_run<1>(lds, C, (bx - 64) >> 2, (bx - 64) & 3);
            else {
                LAS int* slot = (LAS int*)(lds + RING_BYTES + 512);
                unsigned* ctr = WSP(unsigned, WS_CTL) + CW_ATT + l * 64;
                constexpr int NQB = SEQ / 256, NUNIT = BATCH * NH * NQB;
                for (;;) {
                    if (tid == 0) *slot = (int)atomicAdd(ctr, 1u);
                    __syncthreads();
                    const int uidx = *slot;
                    __syncthreads();
                    if (uidx >= NUNIT) break;
                    const int qb = NQB - 1 - uidx / (BATCH * NH), bh = uidx % (BATCH * NH);
                    att::unit(lds, WSP(bf16_t, WS_AQ), WSP(bf16_t, WS_AK), WSP(bf16_t, WS_AV), WSP(float, WS_RSTD), WSP(bf16_t, WS_MIX), bh >> 2, bh & 3, qb);
                }
            }
            __syncthreads();
            convert_moe_queue(C, l, lane, wsh);
            SEAM(4); }
        if (IN(5)) { LAUNDER(); stage_post_v(C, l, gw, ngw, lane); SEAM(5); }
        if (IN(6)) { LAUNDER();
            pg8::Gemm g{WSP(bf16_t, WS_MIX), WSP(bf16_t, WS_WOUT), DMIX, DMIX, DMIX};
            pg8::DenseOrder S{T / 256, DM / 256, G, bx, (long)256 * DMIX * 2, (long)256 * DMIX * 2};
            EpiPre1 E{l == 0 ? INF(I_X) : WSP(float, WS_X), C.out};
            pg8::gemm_phase(lds, g, S, E); SEAM(6); }
        if (IN(7)) { LAUNDER(); ln1_router_coop(C, l, lds); SEAM(7); }
        if (IN(8)) { LAUNDER();
            stage_gather_v(C, l, gw, ngw, lane);
            pg8::Gemm g{WSP(bf16_t, WS_PB), WSP(bf16_t, WS_WP), DPLE, DPLE, DPLE};
            pg8::DenseOrder S{T / 256, DM / 256, G, bx, (long)256 * DPLE * 2, (long)256 * DPLE * 2};
            EpiPP E{WSP(bf16_t, WS_PP)};
            pg8::gemm_phase(lds, g, S, E); SEAM(8); }
        if (IN(9)) { LAUNDER();
            pg8::Gemm g{WSP(bf16_t, WS_XG), WSP(bf16_t, WS_WGU), DM, DM, DM};
            const int ntile = moe_fill_table(C, l, tbl, tid);
            pg8::MoeOrder S{tbl, ntile, 2 * DEXP / 256, G, bx, (long)256 * DM * 2, (long)256 * DM * 2, (long)2 * DEXP * DM * 2};
            EpiH E{WSP(bf16_t, WS_H)};
            pg8::gemm_phase(lds, g, S, E); SEAM(9); }
        if (IN(10)) { LAUNDER();
            pg8::Gemm g{WSP(bf16_t, WS_H), WSP(bf16_t, WS_WD), DEXP, DEXP, DEXP};
            const int ntile = moe_fill_table(C, l, tbl, tid);
            pg8::MoeOrder S{tbl, ntile, DM / 256, G, bx, (long)256 * DEXP * 2, (long)256 * DEXP * 2, (long)DM * DEXP * 2};
            EpiY E{WSP(int, WS_ROWINFO), WSP(float, WS_ROWGATE), WSP(bf16_t, WS_YBUF)};
            pg8::gemm_phase(lds, g, S, E); SEAM(10); }
        if (IN(11)) { LAUNDER();
            pg8::Gemm g{WSP(bf16_t, WS_XB), WSP(bf16_t, WS_WPG), DM, DM, DM};
            pg8::DenseOrder S{T / 256, DM / 256, G, bx, (long)256 * DM * 2, (long)256 * DM * 2};
            EpiPre2 E{C.out, WSP(bf16_t, WS_YBUF), WSP(bf16_t, WS_PP), INF(I_PLEBG) + l * DM, WSP(float, WS_X)};
            pg8::gemm_phase(lds, g, S, E); SEAM(11); }
        if (IN(12)) { LAUNDER(); stage_ln2_v(C, l, gw, ngw, lane); SEAM(12); }
#undef IN
#undef SEAM
    }
}

extern "C" void kernel_launch(void* const* d_in, const int* in_sizes, int n_in, void* d_out, int out_size, void* d_ws, size_t ws_size, hipStream_t stream) {
    static int grid = 0;
    if (grid == 0) {
        if (n_in != N_IN || out_size != T * DM || ws_size < WS_END) { fprintf(stderr, "kernel_launch: bad sizes n_in %d out %d ws %zu need %zu\n", n_in, out_size, ws_size, (size_t)WS_END); grid = -1; return; }
        int dev = 0, cus = 0, per_cu = 0;
        hipGetDevice(&dev); hipDeviceGetAttribute(&cus, hipDeviceAttributeMultiprocessorCount, dev);
        if (hipFuncSetAttribute((const void*)mega, hipFuncAttributeMaxDynamicSharedMemorySize, LDS_BYTES) != hipSuccess) { fprintf(stderr, "hipFuncSetAttribute failed\n"); grid = -1; return; }
        if (hipOccupancyMaxActiveBlocksPerMultiprocessor(&per_cu, (const void*)mega, NWAVES * 64, LDS_BYTES) != hipSuccess || per_cu < 1) { fprintf(stderr, "occupancy query: %d\n", per_cu); }
        (void)hipGetLastError();
        grid = cus;
    }
    if (grid < 0) return;
    hipMemsetAsync((char*)d_ws + WS_CTL, 0, CTL_BYTES, stream);
    Args a{};
    for (int i = 0; i < N_IN; ++i) a.C.in[i] = d_in[i];
    a.C.out = (float*)d_out; a.C.ws = (unsigned char*)d_ws;
#ifndef ONE_LAUNCH
    for (int ph = 0; ph < NPHASES; ++ph) { a.ph_lo = ph; a.ph_hi = ph + 1; hipLaunchKernelGGL(mega, dim3(grid), dim3(NWAVES * 64), LDS_BYTES, stream, a); }
#else
    a.ph_lo = 0; a.ph_hi = NPHASES; hipLaunchKernelGGL(mega, dim3(grid), dim3(NWAVES * 64), LDS_BYTES, stream, a);
#endif
}
#else
template <class E> static void cpu_gemm(const bf16_t* A, int lda, const bf16_t* Bt, int ldb, int K, int M, int N, const E& e, const int* base = nullptr, long estep = 0) {
    for (int row = 0; row < M; ++row) {
        const bf16_t* B = Bt;
        if (base) B = Bt + (size_t)moe_expert_of_row(base, row) * estep;
        if constexpr (E::MODE == 1) {
            for (int hc = 0; hc < N / 2; hc += 8) { float g[8], u[8];
                for (int j = 0; j < 8; ++j) { float ag = 0.f, au = 0.f; const bf16_t* bg = B + (size_t)rowmap(1, hc + j) * ldb; const bf16_t* bu = B + (size_t)rowmap(2, hc + j) * ldb;
                    for (int k = 0; k < K; ++k) { const float a = bf2f(A[(size_t)row * lda + k]); ag += a * bf2f(bg[k]); au += a * bf2f(bu[k]); } g[j] = ag; u[j] = au; }
                e.put8gu(row, hc, g, u); }
        } else if constexpr (E::PERM) {
            for (int c = 0; c < N; c += 8) { float a8[8];
                for (int j = 0; j < 8; ++j) { float acc = 0.f; for (int k = 0; k < K; ++k) acc += bf2f(A[(size_t)row * lda + k]) * bf2f(B[(size_t)(c + j) * ldb + k]); a8[j] = acc; }
                e.put8(row, c, a8); }
        } else {
            for (int c = 0; c < N; c += 4) { float a4[4];
                for (int j = 0; j < 4; ++j) { float acc = 0.f; for (int k = 0; k < K; ++k) acc += bf2f(A[(size_t)row * lda + k]) * bf2f(B[(size_t)(c + j) * ldb + k]); a4[j] = acc; }
                e.put4(row, c, a4); }
        }
    }
}
static void cpu_forward(CtxRef C) {
    static float shbuf[4096];
    for (int l = 0; l < DEPTH; ++l) {
        stage_convert(C, l, 0, 1, 0, shbuf);
        { EpiU E{WSP(bf16_t, WS_U)}; cpu_gemm(WSP(bf16_t, WS_XB), DM, WSP(bf16_t, WS_WIN), DM, DM, T, DINP, E); }
        stage_prep(C, l, 0, 1, 0, shbuf);
        for (int b = 0; b < BATCH; ++b) for (int h = 0; h < NH; ++h) {
            for (int v = 0; v < 64; ++v) { rwkv_scan_thread(C, b, h, v); gla_scan_thread(C, b, h, v); }
            for (int e = 0; e < 65; ++e) mlstm_scan_thread(C, b, h, e);
            for (int q = 0; q < SEQ; ++q) attn_thread(C, b, h, q, q); }
        stage_post(C, l, 0, 1, 0);
        { EpiPre1 E{l == 0 ? INF(I_X) : WSP(float, WS_X), C.out}; cpu_gemm(WSP(bf16_t, WS_MIX), DMIX, WSP(bf16_t, WS_WOUT), DMIX, DMIX, T, DM, E); }
        stage_ln1_router(C, l, 0, 1, 0, shbuf);
        stage_gather(C, l, 0, 1, 0);
        { EpiPP E{WSP(bf16_t, WS_PP)}; cpu_gemm(WSP(bf16_t, WS_PB), DPLE, WSP(bf16_t, WS_WP), DPLE, DPLE, T, DM, E); }
        int base[NEXP + 1]; moe_bases(C, l, base);
        { EpiH E{WSP(bf16_t, WS_H)}; cpu_gemm(WSP(bf16_t, WS_XG), DM, WSP(bf16_t, WS_WGU), DM, DM, base[NEXP], 2 * DEXP, E, base, (long)2 * DEXP * DM); }
        { EpiY E{WSP(int, WS_ROWINFO), WSP(float, WS_ROWGATE), WSP(bf16_t, WS_YBUF)}; cpu_gemm(WSP(bf16_t, WS_H), DEXP, WSP(bf16_t, WS_WD), DEXP, DEXP, base[NEXP], DM, E, base, (long)DM * DEXP); }
        { EpiPre2 E{C.out, WSP(bf16_t, WS_YBUF), WSP(bf16_t, WS_PP), INF(I_PLEBG) + l * DM, WSP(float, WS_X)}; cpu_gemm(WSP(bf16_t, WS_XB), DM, WSP(bf16_t, WS_WPG), DM, DM, T, DM, E); }
        stage_ln2(C, l, 0, 1, 0);
    }
}
#endif
```

```cpp
#ifndef CPU_TEST
#include <hip/hip_runtime.h>
#include <cstdio>
#include <cstdint>
#define HD __device__ __forceinline__
#define HDM __device__ __forceinline__
#define LANES 64
#else
#include <cmath>
#include <cstdio>
#include <cstdint>
#include <cstring>
#include <algorithm>
#define HD static inline
#define HDM inline
#define LANES 1
#endif

#define ONE_LAUNCH 1
#ifndef CFG_SMALL
constexpr int BATCH = 8, SEQ = 4096, DM = 1024, DEPTH = 4, DPLE = 256, DEXP = 512;
#else
constexpr int BATCH = 2, SEQ = 256, DM = 128, DEPTH = 2, DPLE = 32, DEXP = 128;
#endif
constexpr int T = BATCH * SEQ;
constexpr int DMIX = 1024, GW = 256, HD64 = 64, NH = 4;
constexpr int DIN = 3128, DINP = 3328;
constexpr int UA = 0, UA_R = 0, UA_K = 256, UA_V = 512, UA_WD = 768, UA_AD = 800, UA_GD = 832, DINA = 896;
constexpr int UB = 896, UB_Q = 896, UB_K = 1024, UB_V = 1152, UB_AD = 1408, UB_G = 1424;
constexpr int UC = 1680, UC_Q = 1680, UC_K = 1936, UC_V = 2192, UC_O = 2448, UC_IG = 2704, UC_FG = 2708;
constexpr int UD = 2712, UD_CQ = 2712, UD_CKV = 2968, UD_KR = 3096;
constexpr int NEXP = 32, NGRP = 4, EPG = 8;
constexpr int MAXROWS = 2 * T + NEXP * 256;
constexpr float DN_ALPHA = 1.681792830507429f;
constexpr float LN_EPS = 1e-5f, NORM_EPS = 1e-6f, RWKV_GN_EPS = 64e-5f;
static_assert(DEPTH == 4 || DEPTH == 2, "alpha below assumes depth");
HD float dn_alpha() { return DEPTH == 4 ? 1.681792830507429f : 1.4142135623730951f; }

enum { I_X = 0, I_P, I_POS, I_WIN, I_MU, I_W0, I_WUP, I_A0, I_AUP, I_GUP, I_KK, I_KA, I_RK, I_GNG, I_GNB, I_GLA_UP, I_GLA_B, I_GLA_G,
       I_CONVW, I_CONVB, I_IB, I_FB, I_MLN_G, I_QNG, I_WUQ, I_KVNG, I_WUKV, I_WOUT, I_LN1G, I_LN1B, I_WRG, I_BRG, I_WRE, I_BRE,
       I_WG, I_WU, I_WD, I_PLEG, I_PLEBG, I_PLEW, I_LN2G, I_LN2B, N_IN };

typedef unsigned short bf16_t;
HD float bf2f(bf16_t h) { unsigned u = (unsigned)h << 16; return __builtin_bit_cast(float, u); }
HD bf16_t f2bf(float f) { unsigned u = __builtin_bit_cast(unsigned, f); return (bf16_t)((u + 0x7fffu + ((u >> 16) & 1u)) >> 16); }
#ifndef CPU_TEST
HD unsigned pk2(float lo, float hi) { typedef float f2_t __attribute__((ext_vector_type(2))); typedef __bf16 b2_t __attribute__((ext_vector_type(2)));
    f2_t v = {lo, hi}; b2_t b = __builtin_convertvector(v, b2_t); return __builtin_bit_cast(unsigned, b); }
#else
HD unsigned pk2(float lo, float hi) { return (unsigned)f2bf(lo) | ((unsigned)f2bf(hi) << 16); }
#endif
typedef float f4v __attribute__((vector_size(16)));
typedef unsigned u4v __attribute__((vector_size(16)));
HD void ld8bf(const bf16_t* p, float* o) { const u4v w = *(const u4v*)p;
    for (int j = 0; j < 4; ++j) { o[2 * j] = __builtin_bit_cast(float, w[j] << 16); o[2 * j + 1] = __builtin_bit_cast(float, w[j] & 0xffff0000u); } }
HD void st8bf(bf16_t* p, const float* a) { u4v w; for (int j = 0; j < 4; ++j) w[j] = pk2(a[2 * j], a[2 * j + 1]); *(u4v*)p = w; }

constexpr size_t MiB = (size_t)1 << 20;
constexpr size_t al256(size_t x) { return (x + 255) & ~(size_t)255; }
constexpr size_t WS_CTL = 0, CTL_BYTES = 1 * MiB;
constexpr size_t WS_WIN = WS_CTL + CTL_BYTES;
constexpr size_t WS_WOUT = WS_WIN + al256((size_t)DINP * DM * 2);
constexpr size_t WS_WPG = WS_WOUT + al256((size_t)DM * DMIX * 2);
constexpr size_t WS_WP = WS_WPG + al256((size_t)DM * DM * 2);
constexpr size_t WS_WGU = WS_WP + al256((size_t)DM * DPLE * 2);
constexpr size_t WS_WD = WS_WGU + al256((size_t)NEXP * 2 * DEXP * DM * 2);
constexpr size_t WS_X = WS_WD + al256((size_t)NEXP * DM * DEXP * 2);
constexpr size_t WS_XB = WS_X + al256((size_t)T * DM * 4);
constexpr size_t WS_U = WS_XB + al256((size_t)T * DM * 2);
constexpr size_t WS_MIX = WS_U + al256((size_t)T * DINP * 2);
constexpr size_t WS_PB = WS_MIX + al256((size_t)T * DMIX * 2);
constexpr size_t WS_WUQ = WS_PB + al256((size_t)T * DPLE * 2);
constexpr size_t WS_WUKV = WS_WUQ + al256((size_t)512 * 256 * 2);
constexpr size_t WS_ROPE = WS_WUKV + al256((size_t)512 * 256 * 2);
constexpr size_t WS_RSTD = WS_ROPE + al256((size_t)T * 32 * 4);
constexpr size_t WS_RWW = WS_RSTD + al256((size_t)T * 2 * 4);
constexpr size_t WS_SCR = WS_RWW + al256((size_t)4 * 19456);
constexpr size_t TV = al256((size_t)T * GW * 4);
constexpr size_t WS_RW_R = WS_SCR, WS_RW_W = WS_RW_R + TV, WS_RW_K = WS_RW_W + TV, WS_RW_V = WS_RW_K + TV, WS_RW_A = WS_RW_V + TV,
                 WS_RW_B = WS_RW_A + TV, WS_RW_G = WS_RW_B + TV;
constexpr size_t WS_RW_PL = WS_RW_R, WS_RW_RY = WS_RW_R + (size_t)16 * MiB;
constexpr size_t WS_RW_QG = WS_RW_W, WS_RW_Y0 = WS_RW_K, WS_RW_GC = WS_RW_V;
static_assert(TV >= (size_t)32 * MiB || T < 32768, "chunk buffers alias the f32 field region");
constexpr size_t WS_YA = WS_RW_G + TV, WS_YB = WS_YA + TV, WS_YC = WS_YB + TV;
constexpr size_t WS_DEN = WS_YC + TV;
constexpr size_t WS_QK = WS_DEN + al256((size_t)T * 4 * 4);
constexpr size_t WS_GA = WS_QK + al256((size_t)T * 512 * 4);
constexpr size_t WS_LG = WS_GA + al256((size_t)T * 128 * 4);
constexpr size_t WS_AQ = WS_LG + al256((size_t)T * 8 * 4);
constexpr size_t WS_AK = WS_AQ + al256((size_t)T * 384 * 2);
constexpr size_t WS_AV = WS_AK + al256((size_t)T * 384 * 2);
constexpr size_t WS_RW_GG = WS_AV + al256((size_t)T * 256 * 2);
constexpr size_t WS_RW_VS = WS_RW_GG + al256((size_t)T * 256 * 2);
constexpr size_t WS_RW_BON = WS_RW_VS + al256((size_t)T * 256 * 2);
constexpr size_t WS_GLA_BLOB = WS_QK;
constexpr size_t WS_ML_BLOB = WS_RW_A;
constexpr size_t WS_MIXER_END = WS_RW_BON + al256((size_t)T * 4 * 4);
constexpr size_t WS_XG = WS_SCR;
constexpr size_t WS_H = WS_XG + al256((size_t)MAXROWS * DM * 2);
constexpr size_t WS_YBUF = WS_H + al256((size_t)MAXROWS * DEXP * 2);
constexpr size_t WS_PP = WS_YBUF + al256((size_t)2 * T * DM * 2);
constexpr size_t WS_TOKINFO = WS_PP + al256((size_t)T * DM * 2);
constexpr size_t WS_LIST = WS_TOKINFO + al256((size_t)T * 16);
constexpr size_t WS_ROWINFO = WS_LIST + al256((size_t)NEXP * T * 4);
constexpr size_t WS_ROWGATE = WS_ROWINFO + al256((size_t)MAXROWS * 4);
constexpr size_t WS_MOE_END = WS_ROWGATE + al256((size_t)MAXROWS * 4);
constexpr size_t WS_END = WS_MIXER_END > WS_MOE_END ? WS_MIXER_END : WS_MOE_END;
constexpr int CW_BAR = 4096;
constexpr int CW_CVQ = 12288;
constexpr int CW_ATT = 8192;
constexpr int CW_CNT = 16384;

struct Ctx {
    const void* in[N_IN];
    float* out;
    unsigned char* ws;
};
#ifndef CPU_TEST
typedef const __attribute__((address_space(4))) Ctx& CtxRef;
#else
typedef const Ctx& CtxRef;
#endif
#define INF(i) ((const float*)C.in[i])
#define WSP(T_, off) ((T_*)(C.ws + (off)))

#ifndef CPU_TEST
HD float dpp_f(float v, int sel) { const int x = __builtin_bit_cast(int, v); int y;
    if (sel == 0) y = __builtin_amdgcn_update_dpp(0, x, 0xB1, 0xF, 0xF, true);
    else if (sel == 1) y = __builtin_amdgcn_update_dpp(0, x, 0x4E, 0xF, 0xF, true);
    else if (sel == 2) y = __builtin_amdgcn_update_dpp(0, x, 0x141, 0xF, 0xF, true);
    else y = __builtin_amdgcn_update_dpp(0, x, 0x140, 0xF, 0xF, true);
    return __builtin_bit_cast(float, y); }
HD float wave_sum(float v) {
    v += dpp_f(v, 0); v += dpp_f(v, 1); v += dpp_f(v, 2); v += dpp_f(v, 3);
    const int x = __builtin_bit_cast(int, v);
    return (__builtin_bit_cast(float, __builtin_amdgcn_readlane(x, 0)) + __builtin_bit_cast(float, __builtin_amdgcn_readlane(x, 16))) +
           (__builtin_bit_cast(float, __builtin_amdgcn_readlane(x, 32)) + __builtin_bit_cast(float, __builtin_amdgcn_readlane(x, 48))); }
HD float wave_max(float v) {
    v = fmaxf(v, dpp_f(v, 0)); v = fmaxf(v, dpp_f(v, 1)); v = fmaxf(v, dpp_f(v, 2)); v = fmaxf(v, dpp_f(v, 3));
    const int x = __builtin_bit_cast(int, v);
    return fmaxf(fmaxf(__builtin_bit_cast(float, __builtin_amdgcn_readlane(x, 0)), __builtin_bit_cast(float, __builtin_amdgcn_readlane(x, 16))),
                 fmaxf(__builtin_bit_cast(float, __builtin_amdgcn_readlane(x, 32)), __builtin_bit_cast(float, __builtin_amdgcn_readlane(x, 48)))); }
HD unsigned atom_add(unsigned* p, unsigned v) { return atomicAdd(p, v); }
#define WSYNC() __builtin_amdgcn_wave_barrier(); asm volatile("s_waitcnt lgkmcnt(0)" ::: "memory")
typedef __attribute__((address_space(3))) float* wsh_t;
#else
HD float wave_sum(float v) { return v; }
HD float wave_max(float v) { return v; }
HD unsigned atom_add(unsigned* p, unsigned v) { unsigned o = *p; *p += v; return o; }
#define WSYNC()
typedef float* wsh_t;
#endif
#ifndef CPU_TEST
HD float sigmoidf_(float x) { return __builtin_amdgcn_rcpf(1.f + __expf(-x)); }
HD float tanhf_(float x) { const float xc = fminf(fmaxf(x, -15.f), 15.f); return 1.f - 2.f * __builtin_amdgcn_rcpf(1.f + __expf(2.f * xc)); }
#else
HD float sigmoidf_(float x) { return 1.f / (1.f + expf(-x)); }
HD float tanhf_(float x) { return tanhf(x); }
#endif
#ifndef CPU_TEST
HD float softplusf_(float x) { return x > 15.f ? x : __logf(1.f + __expf(x)); }
#else
HD float softplusf_(float x) { return x > 20.f ? x : (x < -20.f ? expf(x) : log1pf(expf(x))); }
#endif
HD float siluf_(float x) { return x * sigmoidf_(x); }

HD int rowmap(int mode, int n) { return mode == 0 ? n : (mode == 1 ? (n >> 7) * 256 + (n & 127) : (n >> 7) * 256 + 128 + (n & 127)); }
HD void transpose_item(const float* W, int K, int N, int ldw, bf16_t* WT, int ldk, int mode, int item, int lane, wsh_t scr) {
    const int nblk = (N + 31) / 32, kb = item / nblk, nb = item % nblk, k0 = 64 * kb, n0 = 32 * nb;
    for (int idx = lane; idx < 2048; idx += LANES) { const int kk = idx >> 5, nn = idx & 31; const int n = n0 + nn;
        scr[kk * 33 + nn] = (n < N) ? W[(size_t)(k0 + kk) * ldw + n] : 0.f; }
    WSYNC();
    for (int idx = lane; idx < 256; idx += LANES) { const int n = idx >> 3, c = idx & 7;
        unsigned o[4];
        for (int j = 0; j < 4; ++j) o[j] = pk2(scr[(8 * c + 2 * j) * 33 + n], scr[(8 * c + 2 * j + 1) * 33 + n]);
        unsigned* dst = (unsigned*)(WT + (size_t)rowmap(mode, n0 + n) * ldk + k0 + 8 * c);
        dst[0] = o[0]; dst[1] = o[1]; dst[2] = o[2]; dst[3] = o[3]; }
    WSYNC();
}
HD void stage_convert(CtxRef C, int l, int gw, int ngw, int lane, wsh_t scr) {
    constexpr int NB_IN = DINP / 32;
    constexpr int I_IN = (DM / 64) * NB_IN, I_OUT = (DMIX / 64) * (DM / 32), I_PG = (DM / 64) * (DM / 32), I_PW = (DPLE / 64 > 0 ? DPLE / 64 : 1) * (DM / 32);
    constexpr int I_G1 = (DM / 64) * (DEXP / 32), I_D1 = (DEXP / 64) * (DM / 32);
#ifndef CPU_TEST
    constexpr int NIT = I_IN + I_OUT + I_PG + I_PW;
#else
    constexpr int NIT = I_IN + I_OUT + I_PG + I_PW + NEXP * (2 * I_G1 + I_D1);
#endif
    static_assert(DPLE % 32 == 0 && DEXP % 64 == 0, "shapes");
    for (int it = gw; it < NIT; it += ngw) {
        int r = it;
        if (r < I_IN) {
            const int nblk = NB_IN, kb = r / nblk, nb = r % nblk, k0 = 64 * kb, n0 = 32 * nb;
            const float* W = INF(I_WIN) + (size_t)l * DM * DIN; bf16_t* WT = WSP(bf16_t, WS_WIN);
            for (int idx = lane; idx < 2048; idx += LANES) { const int kk = idx >> 5, nn = idx & 31; const int n = n0 + nn;
                scr[kk * 33 + nn] = (n < DIN) ? W[(size_t)(k0 + kk) * DIN + n] : 0.f; }
            WSYNC();
            for (int idx = lane; idx < 256; idx += LANES) { const int n = idx >> 3, c = idx & 7; unsigned o[4];
                for (int j = 0; j < 4; ++j) o[j] = pk2(scr[(8 * c + 2 * j) * 33 + n], scr[(8 * c + 2 * j + 1) * 33 + n]);
                unsigned* dst = (unsigned*)(WT + (size_t)(n0 + n) * DM + k0 + 8 * c); dst[0] = o[0]; dst[1] = o[1]; dst[2] = o[2]; dst[3] = o[3]; }
            WSYNC();
            continue; }
        r -= I_IN;
        if (r < I_OUT) { transpose_item(INF(I_WOUT) + (size_t)l * DMIX * DM, DMIX, DM, DM, WSP(bf16_t, WS_WOUT), DMIX, 0, r, lane, scr); continue; } r -= I_OUT;
        if (r < I_PG) { transpose_item(INF(I_PLEG) + (size_t)l * DM * DM, DM, DM, DM, WSP(bf16_t, WS_WPG), DM, 0, r, lane, scr); continue; } r -= I_PG;
        if (r < I_PW) {
            if (DPLE >= 64) transpose_item(INF(I_PLEW) + (size_t)l * DPLE * DM, DPLE, DM, DM, WSP(bf16_t, WS_WP), DPLE, 0, r, lane, scr);
            continue; } r -= I_PW;
        const int e = r / (2 * I_G1 + I_D1); r -= e * (2 * I_G1 + I_D1);
        if (r < I_G1) { transpose_item(INF(I_WG) + ((size_t)l * NEXP + e) * DM * DEXP, DM, DEXP, DEXP, WSP(bf16_t, WS_WGU) + (size_t)e * 2 * DEXP * DM, DM, 1, r, lane, scr); continue; } r -= I_G1;
        if (r < I_G1) { transpose_item(INF(I_WU) + ((size_t)l * NEXP + e) * DM * DEXP, DM, DEXP, DEXP, WSP(bf16_t, WS_WGU) + (size_t)e * 2 * DEXP * DM, DM, 2, r, lane, scr); continue; } r -= I_G1;
        transpose_item(INF(I_WD) + ((size_t)l * NEXP + e) * DEXP * DM, DEXP, DM, DM, WSP(bf16_t, WS_WD) + (size_t)e * DM * DEXP, DEXP, 0, r, lane, scr);
    }
    {   const float* wq = INF(I_WUQ) + (size_t)l * 256 * 384; const float* gq = INF(I_QNG) + l * 256; bf16_t* o = WSP(bf16_t, WS_WUQ);
        for (int i = gw * LANES + lane; i < 512 * 256; i += ngw * LANES) { const int n = i >> 8, k = i & 255; o[i] = f2bf(n < 384 ? gq[k] * wq[(size_t)k * 384 + n] : 0.f); }
        const float* wk = INF(I_WUKV) + (size_t)l * 128 * 512; const float* gk = INF(I_KVNG) + l * 128; bf16_t* o2 = WSP(bf16_t, WS_WUKV);
        for (int i = gw * LANES + lane; i < 512 * 256; i += ngw * LANES) { const int n = i >> 8, k = i & 255; o2[i] = f2bf(k < 128 ? gk[k] * wk[(size_t)k * 512 + n] : 0.f); } }
    {
        const float* wup = INF(I_WUP) + l * 32 * GW; const float* aup = INF(I_AUP) + l * 32 * GW; const float* gup = INF(I_GUP) + l * 64 * GW; bf16_t* o = WSP(bf16_t, WS_RWW);
        for (int i = gw * LANES + lane; i < 4 * 9728; i += ngw * LANES) { const int h = i / 9728, r = i % 9728; float v = 0.f;
            if (r < 2560) { const int c = r / 40, j = r % 40; if (j < 32) v = wup[j * GW + h * 64 + c]; }
            else if (r < 5120) { const int c = (r - 2560) / 40, j = (r - 2560) % 40; if (j < 32) v = aup[j * GW + h * 64 + c]; }
            else { const int c = (r - 5120) / 72, j = (r - 5120) % 72; if (j < 64) v = gup[j * GW + h * 64 + c]; }
            o[i] = f2bf(v); } }
    if (l == 0) {
        const int* pos = (const int*)C.in[I_POS]; float* rt = WSP(float, WS_ROPE);
        for (int i = gw * LANES + lane; i < T * 16; i += ngw * LANES) { const int t = i >> 4, f = i & 15; const float ang = (float)pos[t] * powf(10000.f, -(float)f / 16.f);
            rt[(size_t)t * 32 + f] = cosf(ang); rt[(size_t)t * 32 + 16 + f] = sinf(ang); } }
    {   const float* p = INF(I_P) + (size_t)l * T * DPLE; bf16_t* pb = WSP(bf16_t, WS_PB);
        const size_t n4 = (size_t)T * DPLE / 4;
        for (size_t i = (size_t)gw * LANES + lane; i < n4; i += (size_t)ngw * LANES) {
            const float* s = p + 4 * i; unsigned* d = (unsigned*)(pb + 4 * i); d[0] = pk2(s[0], s[1]); d[1] = pk2(s[2], s[3]); } }
    if (l == 0) { const float* x = INF(I_X); bf16_t* xb = WSP(bf16_t, WS_XB);
        const size_t n4 = (size_t)T * DM / 4;
        for (size_t i = (size_t)gw * LANES + lane; i < n4; i += (size_t)ngw * LANES) {
            const float* s = x + 4 * i; unsigned* d = (unsigned*)(xb + 4 * i); d[0] = pk2(s[0], s[1]); d[1] = pk2(s[2], s[3]); } }
#ifdef CFG_SMALL
    if (DPLE < 64) {
        const float* W = INF(I_PLEW) + (size_t)l * DPLE * DM; bf16_t* WT = WSP(bf16_t, WS_WP);
        for (int i = gw * LANES + lane; i < DPLE * DM; i += ngw * LANES) { const int k = i / DM, n = i % DM; WT[(size_t)n * DPLE + k] = f2bf(W[i]); } }
#endif
}

HD float ubf(const bf16_t* u, int t, int c) { return bf2f(u[(size_t)t * DINP + c]); }
HD void stage_prep(CtxRef C, int l, int gw, int ngw, int lane, wsh_t sh) {
    const bf16_t* u = WSP(bf16_t, WS_U);
    const float* mu = INF(I_MU) + l * DINA; const float* w0 = INF(I_W0) + l * GW; const float* wup = INF(I_WUP) + l * 32 * GW;
    const float* a0 = INF(I_A0) + l * GW; const float* aup = INF(I_AUP) + l * 32 * GW; const float* gup = INF(I_GUP) + l * 64 * GW;
    const float* kkw = INF(I_KK) + l * GW; const float* kaw = INF(I_KA) + l * GW;
    const float* glaup = INF(I_GLA_UP) + l * 16 * 128; const float* glab = INF(I_GLA_B) + l * 128;
    const float* convw = INF(I_CONVW) + l * 4 * 512; const float* convb = INF(I_CONVB) + l * 512;
    const float* ib = INF(I_IB) + l * 4; const float* fb = INF(I_FB) + l * 4;
    const float* qng = INF(I_QNG) + l * 256; const float* wuq = INF(I_WUQ) + (size_t)l * 256 * 384;
    const float* kvng = INF(I_KVNG) + l * 128; const float* wukv = INF(I_WUKV) + (size_t)l * 128 * 512;
    const int* pos = (const int*)C.in[I_POS];
    float* oR = WSP(float, WS_RW_R); float* oW = WSP(float, WS_RW_W); float* oK = WSP(float, WS_RW_K); float* oV = WSP(float, WS_RW_V);
    float* oA = WSP(float, WS_RW_A); float* oB = WSP(float, WS_RW_B); float* oG = WSP(float, WS_RW_G);
    float* oQK = WSP(float, WS_QK); float* oGA = WSP(float, WS_GA); float* oLG = WSP(float, WS_LG);
    bf16_t* oAQ = WSP(bf16_t, WS_AQ); bf16_t* oAK = WSP(bf16_t, WS_AK); bf16_t* oAV = WSP(bf16_t, WS_AV);
    for (int t = gw; t < T; t += ngw) {
        const int s = t % SEQ;
        for (int j = lane; j < 128; j += LANES) { const int c = UA_WD + j; const float cur = ubf(u, t, c), prev = s > 0 ? ubf(u, t - 1, c) : 0.f;
            const float v = cur + (prev - cur) * mu[c]; sh[j] = j < 32 ? tanhf(v) : (j < 64 ? v : sigmoidf_(v)); }
        WSYNC();
        for (int h = 0; h < NH; ++h) {
            float kkraw[HD64 / LANES]; float kv_[HD64 / LANES], av_[HD64 / LANES]; float ss = 0.f;
            for (int i = 0; i < HD64 / LANES; ++i) { const int c = h * 64 + i * LANES + lane;
                float z = w0[c], za = a0[c], g = 0.f;
_Pragma("unroll 8")
                for (int j = 0; j < 32; ++j) { z += sh[j] * wup[j * GW + c]; za += sh[32 + j] * aup[j * GW + c]; }
_Pragma("unroll 8")
                for (int j = 0; j < 64; ++j) g += sh[64 + j] * gup[j * GW + c];
                const float lnl = -softplusf_(-z) - 0.5f; const float decay = expf(-expf(lnl)); const float a = sigmoidf_(za);
                float r, k, v;
                { const float cur = ubf(u, t, UA_R + c), prev = s > 0 ? ubf(u, t - 1, UA_R + c) : 0.f; r = cur + (prev - cur) * mu[UA_R + c]; }
                { const float cur = ubf(u, t, UA_K + c), prev = s > 0 ? ubf(u, t - 1, UA_K + c) : 0.f; k = cur + (prev - cur) * mu[UA_K + c]; }
                { const float cur = ubf(u, t, UA_V + c), prev = s > 0 ? ubf(u, t - 1, UA_V + c) : 0.f; v = cur + (prev - cur) * mu[UA_V + c]; }
                kkraw[i] = k * kkw[c]; ss += kkraw[i] * kkraw[i];
                kv_[i] = k * (1.f + (a - 1.f) * kaw[c]); av_[i] = a;
                const size_t o = (size_t)t * GW + c; oR[o] = r; oW[o] = decay; oK[o] = kv_[i]; oV[o] = v; oG[o] = g; }
            ss = wave_sum(ss); const float inv = 1.f / fmaxf(sqrtf(ss), 1e-12f);
            for (int i = 0; i < HD64 / LANES; ++i) { const int c = h * 64 + i * LANES + lane; const size_t o = (size_t)t * GW + c; const float kk = kkraw[i] * inv;
                oA[o] = -kk; oB[o] = kk * av_[i]; }
        }
        WSYNC();
        for (int c = lane; c < 128; c += LANES) { float z = glab[c];
            for (int j = 0; j < 16; ++j) z += ubf(u, t, UB_AD + j) * glaup[j * 128 + c];
            oGA[(size_t)t * 128 + c] = -softplusf_(-z) * (1.f / 16.f); }
        for (int c = lane; c < 512; c += LANES) { float y = convb[c];
            for (int j = 0; j < 4; ++j) { const int sp = s - 3 + j; if (sp >= 0) y += convw[j * 512 + c] * ubf(u, t - 3 + j, UC_Q + c); }
            float q = siluf_(y); if (c >= 256) q *= 0.125f; oQK[(size_t)t * 512 + c] = q; }
        for (int c = lane; c < 8; c += LANES) { const float v = ubf(u, t, UC_IG + c);
            oLG[(size_t)t * 8 + c] = c < 4 ? v + ib[c] : -softplusf_(-(v + fb[c - 4])); }
        {   float ssq = 0.f, sskv = 0.f;
            for (int j = lane; j < 256; j += LANES) { const float v = ubf(u, t, UD_CQ + j); ssq += v * v; }
            for (int j = lane; j < 128; j += LANES) { const float v = ubf(u, t, UD_CKV + j); sskv += v * v; }
            ssq = wave_sum(ssq); sskv = wave_sum(sskv);
            const float rq = 1.f / sqrtf(ssq * (1.f / 256.f) + NORM_EPS), rkv = 1.f / sqrtf(sskv * (1.f / 128.f) + NORM_EPS);
            for (int j = lane; j < 256; j += LANES) sh[j] = ubf(u, t, UD_CQ + j) * rq * qng[j];
            for (int j = lane; j < 128; j += LANES) sh[256 + j] = ubf(u, t, UD_CKV + j) * rkv * kvng[j];
            WSYNC();
            for (int n = lane; n < 384; n += LANES) { float acc = 0.f;
_Pragma("unroll 8")
                for (int k = 0; k < 256; ++k) acc += sh[k] * wuq[(size_t)k * 384 + n]; sh[384 + n] = acc; }
            for (int n = lane; n < 512; n += LANES) { float acc = 0.f;
_Pragma("unroll 8")
                for (int k = 0; k < 128; ++k) acc += sh[256 + k] * wukv[(size_t)k * 512 + n]; sh[768 + n] = acc; }
            for (int i = lane; i < 16; i += LANES) { const float invf = powf(10000.f, -(float)i / 16.f); const float ang = (float)pos[t] * invf; sh[1280 + i] = cosf(ang); sh[1296 + i] = sinf(ang); }
            for (int i = lane; i < 32; i += LANES) sh[1312 + i] = ubf(u, t, UD_KR + i);
            WSYNC();
            const float qscale = 0.10206207261596575f * 1.4426950408889634f;
            for (int idx = lane; idx < 384; idx += LANES) { const int h = idx / 96, d = idx % 96; float v;
                if (d < 64) v = sh[384 + idx];
                else { const int i = (d - 64) & 15; const float x1 = sh[384 + h * 96 + 64 + i], x2 = sh[384 + h * 96 + 80 + i]; const float c_ = sh[1280 + i], s_ = sh[1296 + i];
                    v = (d - 64) < 16 ? x1 * c_ - x2 * s_ : x1 * s_ + x2 * c_; }
                oAQ[(size_t)t * 384 + idx] = f2bf(v * qscale); }
            for (int idx = lane; idx < 384; idx += LANES) { const int h = idx / 96, d = idx % 96; float v;
                if (d < 64) v = sh[768 + h * 128 + d];
                else { const int i = (d - 64) & 15; const float x1 = sh[1312 + i], x2 = sh[1328 + i]; const float c_ = sh[1280 + i], s_ = sh[1296 + i];
                    v = (d - 64) < 16 ? x1 * c_ - x2 * s_ : x1 * s_ + x2 * c_; }
                oAK[(size_t)t * 384 + idx] = f2bf(v); }
            for (int idx = lane; idx < 256; idx += LANES) { const int h = idx / 64, d = idx % 64; oAV[(size_t)t * 256 + idx] = f2bf(sh[768 + h * 128 + 64 + d]); }
            WSYNC();
        }
    }
}

HD void rwkv_scan_thread(CtxRef C, int b, int h, int v) {
    const float* pR = WSP(float, WS_RW_R); const float* pW = WSP(float, WS_RW_W); const float* pK = WSP(float, WS_RW_K); const float* pV = WSP(float, WS_RW_V);
    const float* pA = WSP(float, WS_RW_A); const float* pB = WSP(float, WS_RW_B); float* Y = WSP(float, WS_YA);
    float S[64];
#pragma unroll
    for (int k = 0; k < 64; ++k) S[k] = 0.f;
    for (int s = 0; s < SEQ; ++s) {
        const size_t o = ((size_t)b * SEQ + s) * GW + h * 64;
        const float vv = pV[o + v];
        float sa0 = 0.f, sa1 = 0.f, sa2 = 0.f, sa3 = 0.f;
#pragma unroll
        for (int k = 0; k < 64; k += 4) { const f4v a = *(const f4v*)(pA + o + k); sa0 += S[k] * a[0]; sa1 += S[k + 1] * a[1]; sa2 += S[k + 2] * a[2]; sa3 += S[k + 3] * a[3]; }
        const float sa = (sa0 + sa1) + (sa2 + sa3);
        float y0 = 0.f, y1 = 0.f, y2 = 0.f, y3 = 0.f;
#pragma unroll
        for (int k = 0; k < 64; k += 4) {
            const f4v w = *(const f4v*)(pW + o + k), bb = *(const f4v*)(pB + o + k), kk = *(const f4v*)(pK + o + k), r = *(const f4v*)(pR + o + k);
            S[k] = S[k] * w[0] + sa * bb[0] + vv * kk[0]; y0 += S[k] * r[0];
            S[k + 1] = S[k + 1] * w[1] + sa * bb[1] + vv * kk[1]; y1 += S[k + 1] * r[1];
            S[k + 2] = S[k + 2] * w[2] + sa * bb[2] + vv * kk[2]; y2 += S[k + 2] * r[2];
            S[k + 3] = S[k + 3] * w[3] + sa * bb[3] + vv * kk[3]; y3 += S[k + 3] * r[3];
            if ((k & 12) == 12) asm volatile("" ::: "memory"); }
        Y[o + v] = (y0 + y1) + (y2 + y3);
    }
}
HD void gla_scan_thread(CtxRef C, int b, int h, int v) {
    const bf16_t* u = WSP(bf16_t, WS_U); const float* GA = WSP(float, WS_GA); float* Y = WSP(float, WS_YB);
    float S[32];
#pragma unroll
    for (int k = 0; k < 32; ++k) S[k] = 0.f;
    for (int s = 0; s < SEQ; ++s) {
        const int t = b * SEQ + s;
        const float vv = ubf(u, t, UB_V + h * 64 + v);
        float acc = 0.f;
#pragma unroll
        for (int k8 = 0; k8 < 32; k8 += 8) { float kf[8], qf[8];
            ld8bf(u + (size_t)t * DINP + UB_K + h * 32 + k8, kf); ld8bf(u + (size_t)t * DINP + UB_Q + h * 32 + k8, qf);
            const f4v g0 = *(const f4v*)(GA + (size_t)t * 128 + h * 32 + k8), g1 = *(const f4v*)(GA + (size_t)t * 128 + h * 32 + k8 + 4);
#pragma unroll
            for (int j = 0; j < 8; ++j) { const float a = expf(j < 4 ? g0[j & 3] : g1[j & 3]); S[k8 + j] = a * S[k8 + j] + kf[j] * vv; acc += qf[j] * S[k8 + j]; } }
        Y[(size_t)t * GW + h * 64 + v] = acc * 0.17677669529663687f;
    }
}
HD void mlstm_scan_thread(CtxRef C, int b, int h, int e) {
    const bf16_t* u = WSP(bf16_t, WS_U); const float* QK = WSP(float, WS_QK); const float* LG = WSP(float, WS_LG);
    float* Y = WSP(float, WS_YC); float* DEN = WSP(float, WS_DEN);
    float S[64];
#pragma unroll
    for (int k = 0; k < 64; ++k) S[k] = 0.f;
    for (int s = 0; s < SEQ; ++s) {
        const int t = b * SEQ + s;
        const float ig = expf(LG[(size_t)t * 8 + h]), fg = expf(LG[(size_t)t * 8 + 4 + h]);
        const float vv = (e < 64 ? ubf(u, t, UC_V + h * 64 + e) : 1.f) * ig;
        float acc = 0.f;
#pragma unroll
        for (int k = 0; k < 64; k += 4) { const f4v kk = *(const f4v*)(QK + (size_t)t * 512 + 256 + h * 64 + k), qq = *(const f4v*)(QK + (size_t)t * 512 + h * 64 + k);
#pragma unroll
            for (int j = 0; j < 4; ++j) { S[k + j] = fg * S[k + j] + kk[j] * vv; acc += qq[j] * S[k + j]; } }
        if (e < 64) Y[(size_t)t * GW + h * 64 + e] = acc; else DEN[(size_t)t * 4 + h] = acc;
    }
}
HD void attn_thread(CtxRef C, int b, int h, int q, int kmax  ) {
    const bf16_t* Q = WSP(bf16_t, WS_AQ); const bf16_t* K = WSP(bf16_t, WS_AK); const bf16_t* V = WSP(bf16_t, WS_AV); bf16_t* mix = WSP(bf16_t, WS_MIX);
    const int t = b * SEQ + q;
    unsigned qp[48]; float o[64];
#pragma unroll
    for (int d = 0; d < 48; d += 4) { const u4v w = *(const u4v*)(Q + (size_t)t * 384 + h * 96 + 2 * d); qp[d] = w[0]; qp[d + 1] = w[1]; qp[d + 2] = w[2]; qp[d + 3] = w[3]; }
#pragma unroll
    for (int d = 0; d < 64; ++d) o[d] = 0.f;
    float m = -1e30f, lsum = 0.f;
    for (int j = 0; j <= kmax; ++j) {
        const size_t tk = (size_t)b * SEQ + j;
        float sc0 = 0.f, sc1 = 0.f;
#pragma unroll
        for (int d = 0; d < 96; d += 8) { float kf[8]; ld8bf(K + tk * 384 + h * 96 + d, kf);
#pragma unroll
            for (int i = 0; i < 8; i += 2) { const unsigned qw = qp[(d + i) >> 1];
                sc0 += __builtin_bit_cast(float, qw << 16) * kf[i]; sc1 += __builtin_bit_cast(float, qw & 0xffff0000u) * kf[i + 1]; }
            if ((d & 24) == 24) asm volatile("" ::: "memory"); }
        const float sc = sc0 + sc1;
        if (j <= q) {
            const float mn = fmaxf(m, sc); const float corr = exp2f(m - mn), p = exp2f(sc - mn);
            lsum = lsum * corr + p;
#pragma unroll
            for (int d = 0; d < 64; d += 8) { float vf[8]; ld8bf(V + tk * 256 + h * 64 + d, vf);
#pragma unroll
                for (int i = 0; i < 8; ++i) o[d + i] = o[d + i] * corr + p * vf[i];
                if (d & 8) asm volatile("" ::: "memory"); }
            m = mn; }
    }
    const float inv = 1.f / lsum;
#pragma unroll
    for (int d = 0; d < 64; d += 8) { float a[8];
#pragma unroll
        for (int i = 0; i < 8; ++i) a[i] = o[d + i] * inv;
        st8bf(mix + (size_t)t * DMIX + 768 + h * 64 + d, a); }
}

HD void stage_post(CtxRef C, int l, int gw, int ngw, int lane) {
    const bf16_t* u = WSP(bf16_t, WS_U); bf16_t* mix = WSP(bf16_t, WS_MIX);
    const float* YA = WSP(float, WS_YA); const float* YB = WSP(float, WS_YB); const float* YC = WSP(float, WS_YC); const float* DEN = WSP(float, WS_DEN);
    const float* pR = WSP(float, WS_RW_R); const float* pK = WSP(float, WS_RW_K); const float* pV = WSP(float, WS_RW_V); const float* pG = WSP(float, WS_RW_G);
    const float* rk = INF(I_RK) + l * GW; const float* gng = INF(I_GNG) + l * GW; const float* gnb = INF(I_GNB) + l * GW;
    const float* glag = INF(I_GLA_G) + l * GW; const float* mlng = INF(I_MLN_G) + l * GW;
    constexpr int PL = HD64 / LANES;
    for (int t = gw; t < T; t += ngw) {
        for (int h = 0; h < NH; ++h) {
            {   float y[PL], s1 = 0.f, bon = 0.f;
#ifdef CPU_TEST
                for (int i = 0; i < PL; ++i) { const int c = h * 64 + i * LANES + lane; const size_t o = (size_t)t * GW + c; y[i] = YA[o]; s1 += y[i]; bon += pR[o] * pK[o] * rk[c]; }
                s1 = wave_sum(s1); bon = wave_sum(bon);
#else
                for (int i = 0; i < PL; ++i) { const int c = h * 64 + i * LANES + lane; y[i] = YA[(size_t)t * GW + c]; s1 += y[i]; }
                s1 = wave_sum(s1); bon = WSP(float, WS_RW_BON)[(size_t)t * 4 + h];
#endif
                const float mean = s1 * (1.f / 64.f); float s2 = 0.f;
                for (int i = 0; i < PL; ++i) { y[i] -= mean; s2 += y[i] * y[i]; }
                s2 = wave_sum(s2); const float rstd = 1.f / sqrtf(s2 * (1.f / 64.f) + RWKV_GN_EPS);
                for (int i = 0; i < PL; ++i) { const int c = h * 64 + i * LANES + lane; const size_t o = (size_t)t * GW + c;
#ifdef CPU_TEST
                    const float v = (y[i] * rstd * gng[c] + gnb[c] + bon * pV[o]) * pG[o];
#else
                    const float v = (y[i] * rstd * gng[c] + gnb[c] + bon * bf2f(WSP(bf16_t, WS_RW_VS)[o])) * bf2f(WSP(bf16_t, WS_RW_GG)[o]);
#endif
                    mix[(size_t)t * DMIX + c] = f2bf(v); } }
            {   float y[PL], s2 = 0.f;
                for (int i = 0; i < PL; ++i) { const int c = h * 64 + i * LANES + lane; y[i] = YB[(size_t)t * GW + c]; s2 += y[i] * y[i]; }
                s2 = wave_sum(s2); const float rstd = 1.f / sqrtf(s2 * (1.f / 64.f) + NORM_EPS);
                for (int i = 0; i < PL; ++i) { const int c = h * 64 + i * LANES + lane;
                    const float v = y[i] * rstd * glag[c] * siluf_(ubf(u, t, UB_G + c)); mix[(size_t)t * DMIX + 256 + c] = f2bf(v); } }
            {   const float den = DEN[(size_t)t * 4 + h]; const float dinv = 1.f / fmaxf(fabsf(den), 1.f);
                float y[PL], s1 = 0.f;
                for (int i = 0; i < PL; ++i) { const int c = h * 64 + i * LANES + lane; y[i] = YC[(size_t)t * GW + c] * dinv; s1 += y[i]; }
                s1 = wave_sum(s1); const float mean = s1 * (1.f / 64.f); float s2 = 0.f;
                for (int i = 0; i < PL; ++i) { y[i] -= mean; s2 += y[i] * y[i]; }
                s2 = wave_sum(s2); const float rstd = 1.f / sqrtf(s2 * (1.f / 64.f) + LN_EPS);
                for (int i = 0; i < PL; ++i) { const int c = h * 64 + i * LANES + lane;
                    const float v = y[i] * rstd * mlng[c] * sigmoidf_(ubf(u, t, UC_O + c)); mix[(size_t)t * DMIX + 512 + c] = f2bf(v); } }
        }
    }
}

HD void ln_row(const float* src, const float* g, const float* b, float* dstf, bf16_t* dstb, int lane, float* keep  ) {
    constexpr int PL = DM / LANES;
    float s1 = 0.f;
#pragma unroll
    for (int i = 0; i < PL; ++i) { keep[i] = src[i * LANES + lane]; s1 += keep[i]; }
    s1 = wave_sum(s1); const float mean = s1 * (1.f / DM); float s2 = 0.f;
#pragma unroll
    for (int i = 0; i < PL; ++i) { keep[i] -= mean; s2 += keep[i] * keep[i]; }
    s2 = wave_sum(s2); const float rstd = 1.f / sqrtf(s2 * (1.f / DM) + LN_EPS);
#pragma unroll
    for (int i = 0; i < PL; ++i) { const int c = i * LANES + lane; keep[i] = keep[i] * rstd * g[c] + b[c]; dstf[c] = keep[i]; dstb[c] = f2bf(keep[i]); }
}
HD void stage_ln1_router(CtxRef C, int l, int gw, int ngw, int lane, wsh_t sh) {
    float* X1 = C.out; bf16_t* xb = WSP(bf16_t, WS_XB);
    const float* g = INF(I_LN1G) + l * DM; const float* b = INF(I_LN1B) + l * DM;
    const float* wrg = INF(I_WRG) + (size_t)l * DM * NGRP; const float* brg = INF(I_BRG) + l * NGRP;
    const float* wre = INF(I_WRE) + (size_t)l * DM * NEXP; const float* bre = INF(I_BRE) + l * NEXP;
    unsigned* cnt = WSP(unsigned, WS_CTL) + CW_CNT + l * NEXP * 64;
    int* tokinfo = WSP(int, WS_TOKINFO); int* list = WSP(int, WS_LIST);
    constexpr int PL = DM / LANES;
    for (int t = gw; t < T; t += ngw) {
        {   float keep[PL];
            ln_row(X1 + (size_t)t * DM, g, b, X1 + (size_t)t * DM, xb + (size_t)t * DM, lane, keep);
#pragma unroll
            for (int i = 0; i < PL; ++i) sh[i * LANES + lane] = keep[i]; }
        WSYNC();
        float lg[NGRP], le[NEXP];
#pragma unroll
        for (int j = 0; j < NGRP; ++j) lg[j] = 0.f;
#pragma unroll
        for (int j = 0; j < NEXP; ++j) le[j] = 0.f;
#pragma unroll 1
        for (int i = 0; i < PL; ++i) { const int c = i * LANES + lane; const float xv = sh[c];
            const f4v wg = *(const f4v*)(wrg + (size_t)c * NGRP);
#pragma unroll
            for (int j = 0; j < NGRP; ++j) lg[j] += xv * wg[j];
#pragma unroll
            for (int j = 0; j < NEXP; j += 4) { const f4v we = *(const f4v*)(wre + (size_t)c * NEXP + j);
                le[j] += xv * we[0]; le[j + 1] += xv * we[1]; le[j + 2] += xv * we[2]; le[j + 3] += xv * we[3]; } }
        WSYNC();
#pragma unroll
        for (int j = 0; j < NGRP; ++j) lg[j] = wave_sum(lg[j]) + brg[j];
#pragma unroll
        for (int j = 0; j < NEXP; ++j) le[j] = wave_sum(le[j]) + bre[j];
        int gi = 0; float gm = lg[0];
#pragma unroll
        for (int j = 1; j < NGRP; ++j) if (lg[j] > gm) { gm = lg[j]; gi = j; }
        float gs = 0.f;
#pragma unroll
        for (int j = 0; j < NGRP; ++j) gs += expf(lg[j] - gm);
        const float group_p = 1.f / gs;
        float el[EPG];
#pragma unroll
        for (int j = 0; j < EPG; ++j) { float v = le[j];
#pragma unroll
            for (int g2 = 1; g2 < NGRP; ++g2) v = (gi == g2) ? le[g2 * EPG + j] : v;
            el[j] = v; }
        int e0 = 0; float m0 = el[0];
#pragma unroll
        for (int j = 1; j < EPG; ++j) if (el[j] > m0) { m0 = el[j]; e0 = j; }
        int e1 = -1; float m1 = -3.0e38f;
#pragma unroll
        for (int j = 0; j < EPG; ++j) if (j != e0 && el[j] > m1) { m1 = el[j]; e1 = j; }
        const float p1 = expf(m1 - m0); const float g0 = group_p / (1.f + p1), g1 = group_p * p1 / (1.f + p1);
        if (lane == 0) {
            const int E0 = gi * EPG + e0, E1 = gi * EPG + e1;
            tokinfo[(size_t)t * 4 + 0] = E0; tokinfo[(size_t)t * 4 + 1] = E1;
            ((float*)tokinfo)[(size_t)t * 4 + 2] = g0; ((float*)tokinfo)[(size_t)t * 4 + 3] = g1;
            const unsigned s0 = atom_add(cnt + E0 * 64, 1u); list[(size_t)E0 * T + s0] = t * 2 + 0;
            const unsigned s1 = atom_add(cnt + E1 * 64, 1u); list[(size_t)E1 * T + s1] = t * 2 + 1;
        }
    }
}
HD void moe_bases(CtxRef C, int l, int* base  ) {
    const unsigned* cnt = WSP(unsigned, WS_CTL) + CW_CNT + l * NEXP * 64;
    int acc = 0;
    for (int e = 0; e < NEXP; ++e) { base[e] = acc; acc += ((int)cnt[e * 64] + 255) & ~255; }
    base[NEXP] = acc;
}
HD int moe_expert_of_row(const int* base, int row) { int e = 0; for (int j = 1; j < NEXP; ++j) if (row >= base[j]) e = j; return e; }
HD int moe_lookup(const unsigned* cnt, int row, int& e, int& be, int& ce) {
    int acc = 0; e = 0; be = 0; ce = 0;
    for (int j = 0; j < NEXP; ++j) { const int c = (int)cnt[j * 64]; if (row >= acc) { e = j; be = acc; ce = c; } acc += (c + 255) & ~255; }
    return acc;
}
HD void stage_gather(CtxRef C, int l, int gw, int ngw, int lane) {
    const unsigned* cnt = WSP(unsigned, WS_CTL) + CW_CNT + l * NEXP * 64;
    const int* list = WSP(int, WS_LIST); const int* tokinfo = WSP(int, WS_TOKINFO);
    const bf16_t* xb = WSP(bf16_t, WS_XB); bf16_t* xg = WSP(bf16_t, WS_XG); int* rowinfo = WSP(int, WS_ROWINFO); float* rowgate = WSP(float, WS_ROWGATE);
    int e, be, ce; const int total = moe_lookup(cnt, 0, e, be, ce);
    for (int row = gw; row < total; row += ngw) {
        moe_lookup(cnt, row, e, be, ce);
        const int slot = row - be;
        if (slot < ce) { const int ent = list[(size_t)e * T + slot]; const int tok = ent >> 1;
            for (int c = lane * 8; c < DM; c += LANES * 8) *(u4v*)(xg + (size_t)row * DM + c) = *(const u4v*)(xb + (size_t)tok * DM + c);
            if (lane == 0) { rowinfo[row] = ent; rowgate[row] = ((const float*)tokinfo)[(size_t)tok * 4 + 2 + (ent & 1)]; } }
        else { const u4v z = {0u, 0u, 0u, 0u}; for (int c = lane * 8; c < DM; c += LANES * 8) *(u4v*)(xg + (size_t)row * DM + c) = z;
            if (lane == 0) { rowinfo[row] = -1; rowgate[row] = 0.f; } }
    }
}
HD void stage_ln2(CtxRef C, int l, int gw, int ngw, int lane) {
    const float* src = WSP(float, WS_X); float* dst = (l == DEPTH - 1) ? C.out : WSP(float, WS_X); bf16_t* xb = WSP(bf16_t, WS_XB);
    const float* g = INF(I_LN2G) + l * DM; const float* b = INF(I_LN2B) + l * DM;
    constexpr int PL = DM / LANES;
    for (int t = gw; t < T; t += ngw) { float keep[PL]; ln_row(src + (size_t)t * DM, g, b, dst + (size_t)t * DM, xb + (size_t)t * DM, lane, keep); }
}

struct EpiU {
    static constexpr bool PERM = true; static constexpr int MODE = 0;
    bf16_t* o;
    HDM void put8(int row, int col, const float* a) const { st8bf(o + (size_t)row * DINP + col, a); }
};
struct EpiPP {
    static constexpr bool PERM = true; static constexpr int MODE = 0;
    bf16_t* o;
    HDM void put8(int row, int col, const float* a) const { st8bf(o + (size_t)row * DM + col, a); }
};
struct EpiPre1 {
    static constexpr bool PERM = false; static constexpr int MODE = 0;
    const float* x; float* o;
    HDM void put4(int row, int col, const float* a) const { const float al = dn_alpha(); const f4v xr = *(const f4v*)(x + (size_t)row * DM + col);
        f4v r; for (int j = 0; j < 4; ++j) r[j] = al * xr[j] + a[j]; *(f4v*)(o + (size_t)row * DM + col) = r; }
};
struct EpiH {
    static constexpr bool PERM = true; static constexpr int MODE = 1;
    bf16_t* o;
    HDM void put8gu(int row, int hcol, const float* g, const float* u) const { float v[8]; for (int j = 0; j < 8; ++j) v[j] = siluf_(g[j]) * u[j];
        st8bf(o + (size_t)row * DEXP + hcol, v); }
};
struct EpiY {
    static constexpr bool PERM = true; static constexpr int MODE = 0;
    const int* rowinfo; const float* rowgate; bf16_t* o;
    HDM void put8(int row, int col, const float* a) const { const int ent = rowinfo[row]; if (ent < 0) return; const float g = rowgate[row];
        float v[8]; for (int j = 0; j < 8; ++j) v[j] = g * a[j]; st8bf(o + (size_t)ent * DM + col, v); }
};
struct EpiPre2 {
    static constexpr bool PERM = false; static constexpr int MODE = 0;
    const float* x1; const bf16_t* ybuf; const bf16_t* pp; const float* bg; float* o;
    HDM void put4(int row, int col, const float* a) const { const float al = dn_alpha(); const size_t i = (size_t)row * DM + col;
        const f4v xr = *(const f4v*)(x1 + i); const f4v bgv = *(const f4v*)(bg + col);
        const unsigned* y0 = (const unsigned*)(ybuf + (size_t)(2 * row) * DM + col); const unsigned* y1 = (const unsigned*)(ybuf + (size_t)(2 * row + 1) * DM + col); const unsigned* pq = (const unsigned*)(pp + i);
        const unsigned y00 = y0[0], y01 = y0[1], y10 = y1[0], y11 = y1[1], p0 = pq[0], p1 = pq[1];
        float yv[4] = { __builtin_bit_cast(float, y00 << 16) + __builtin_bit_cast(float, y10 << 16), __builtin_bit_cast(float, y00 & 0xffff0000u) + __builtin_bit_cast(float, y10 & 0xffff0000u),
                        __builtin_bit_cast(float, y01 << 16) + __builtin_bit_cast(float, y11 << 16), __builtin_bit_cast(float, y01 & 0xffff0000u) + __builtin_bit_cast(float, y11 & 0xffff0000u) };
        float pv[4] = { __builtin_bit_cast(float, p0 << 16), __builtin_bit_cast(float, p0 & 0xffff0000u), __builtin_bit_cast(float, p1 << 16), __builtin_bit_cast(float, p1 & 0xffff0000u) };
        f4v r; for (int j = 0; j < 4; ++j) r[j] = al * xr[j] + yv[j] + sigmoidf_(a[j] + bgv[j]) * pv[j];
        *(f4v*)(o + i) = r; }
};

#ifndef CPU_TEST
struct CvItem { const float* W; bf16_t* WT; int ldw, ldk, mode, k0, n0; };
__device__ __forceinline__ bool cv_decode(CtxRef C, int l, int r, CvItem& it) {
    constexpr int I_G1 = (DM / 64) * (DEXP / 32), I_D1 = (DEXP / 64) * (DM / 32), PER_E = 2 * I_G1 + I_D1;
    if (r >= NEXP * PER_E) return false;
    const int e = r / PER_E; r -= e * PER_E;
    if (r < 2 * I_G1) { const bool up = r >= I_G1; if (up) r -= I_G1; it.W = INF(up ? I_WU : I_WG) + ((size_t)l * NEXP + e) * DM * DEXP; it.WT = WSP(bf16_t, WS_WGU) + (size_t)e * 2 * DEXP * DM; it.ldw = DEXP; it.ldk = DM; it.mode = up ? 2 : 1;
        const int nblk = DEXP / 32; it.k0 = 64 * (r / nblk); it.n0 = 32 * (r % nblk); }
    else { r -= 2 * I_G1; it.W = INF(I_WD) + ((size_t)l * NEXP + e) * DEXP * DM; it.WT = WSP(bf16_t, WS_WD) + (size_t)e * DM * DEXP; it.ldw = DM; it.ldk = DEXP; it.mode = 0;
        const int nblk = DM / 32; it.k0 = 64 * (r / nblk); it.n0 = 32 * (r % nblk); }
    return true;
}
__device__ __forceinline__ void convert_moe_queue(CtxRef C, int l, int lane, wsh_t scr) {
    unsigned* ctr = WSP(unsigned, WS_CTL) + CW_CVQ + l * 64;
    const int lr = lane >> 3, lc = (lane & 7) * 4;
    constexpr int CHUNK = 16;
    f4v ld[8]; CvItem cur, nxt; bool have; int nextid = 0, endid = 0;
#define CV_GRAB(IT, OK) do { if (nextid == endid) { unsigned b_ = 0; if (lane == 0) b_ = atomicAdd(ctr, (unsigned)CHUNK); nextid = __builtin_amdgcn_readfirstlane((int)b_); endid = nextid + CHUNK; } OK = cv_decode(C, l, nextid, IT); ++nextid; } while (0)
#define CV_LOAD(IT) do { _Pragma("unroll") for (int i = 0; i < 8; ++i) ld[i] = *(const f4v*)((IT).W + (size_t)((IT).k0 + lr + 8 * i) * (IT).ldw + (IT).n0 + lc); } while (0)
    CV_GRAB(cur, have);
    if (have) CV_LOAD(cur);
    while (have) {
#pragma unroll
        for (int i = 0; i < 8; ++i) { const int kk = lr + 8 * i;
#pragma unroll
            for (int j = 0; j < 4; ++j) scr[kk * 33 + lc + j] = ld[i][j]; }
        bool hn; CV_GRAB(nxt, hn);
        if (hn) CV_LOAD(nxt);
        WSYNC();
#pragma unroll
        for (int q = 0; q < 4; ++q) { const int idx = lane + 64 * q; const int n = idx >> 3, c = idx & 7;
            u4v o;
#pragma unroll
            for (int j = 0; j < 4; ++j) o[j] = pk2(scr[(8 * c + 2 * j) * 33 + n], scr[(8 * c + 2 * j + 1) * 33 + n]);
            *(u4v*)(cur.WT + (size_t)rowmap(cur.mode, cur.n0 + n) * cur.ldk + cur.k0 + 8 * c) = o; }
        WSYNC();
        cur = nxt; have = hn;
    }
#undef CV_GRAB
#undef CV_LOAD
}
#endif

#ifndef CPU_TEST
struct EpiQ {
    static constexpr bool PERM = true; static constexpr int MODE = 0;
    const float* rope; bf16_t* o;
    __device__ __forceinline__ void put8(int row, int col, const float* a) const {
        float p[8];
#pragma unroll
        for (int j = 0; j < 8; ++j) p[j] = __shfl_xor(a[j], 32);
        if (col >= 384) return;
        const float qscale = 0.10206207261596575f * 1.4426950408889634f;
        const int d0 = col % 96; float v[8];
        if (d0 < 64) {
#pragma unroll
            for (int j = 0; j < 8; ++j) v[j] = a[j] * qscale; }
        else { const int i0 = (d0 - 64) & 15; const bool x2 = (d0 - 64) >= 16; const float* rt = rope + (size_t)row * 32 + i0;
            const f4v c0 = *(const f4v*)rt, c1 = *(const f4v*)(rt + 4), s0 = *(const f4v*)(rt + 16), s1 = *(const f4v*)(rt + 20);
#pragma unroll
            for (int j = 0; j < 8; ++j) { const float c = j < 4 ? c0[j & 3] : c1[j & 3], s = j < 4 ? s0[j & 3] : s1[j & 3];
                v[j] = (x2 ? (p[j] * s + a[j] * c) : (a[j] * c - p[j] * s)) * qscale; } }
        st8bf(o + (size_t)row * 384 + col, v); }
};
struct EpiKV {
    static constexpr bool PERM = true; static constexpr int MODE = 0;
    bf16_t* k; bf16_t* v;
    __device__ __forceinline__ void put8(int row, int col, const float* a) const { const int h = col >> 7, d = col & 127;
        if (d < 64) st8bf(k + (size_t)row * 384 + h * 96 + d, a); else st8bf(v + (size_t)row * 256 + h * 64 + (d - 64), a); }
};
__device__ __forceinline__ void mla_token_pass(CtxRef C, int gw, int ngw, int lane) {
    const bf16_t* u = WSP(bf16_t, WS_U); const float* rope = WSP(float, WS_ROPE); bf16_t* K = WSP(bf16_t, WS_AK); bf16_t* Q = WSP(bf16_t, WS_AQ); bf16_t* V = WSP(bf16_t, WS_AV);
    for (int t = gw; t < T; t += ngw) {
        const bf16_t* ur = u + (size_t)t * DINP;
        u4v qv = {0u, 0u, 0u, 0u}, kv = {0u, 0u, 0u, 0u};
        bf16_t* qp = Q + (size_t)t * 384 + lane * 8; if (lane < 48) qv = *(const u4v*)qp;
        bf16_t* kp = (lane < 32) ? K + (size_t)t * 384 + (lane >> 3) * 96 + (lane & 7) * 8 : V + (size_t)t * 256 + (lane - 32) * 8; kv = *(const u4v*)kp;
        float ssq = 0.f, sskv = 0.f;
        { const unsigned* p = (const unsigned*)(ur + UD_CQ) + 2 * lane; const unsigned w0 = p[0], w1 = p[1];
          const float a = __builtin_bit_cast(float, w0 << 16), b = __builtin_bit_cast(float, w0 & 0xffff0000u), c = __builtin_bit_cast(float, w1 << 16), d = __builtin_bit_cast(float, w1 & 0xffff0000u);
          ssq = (a * a + b * b) + (c * c + d * d); }
        { const unsigned w0 = ((const unsigned*)(ur + UD_CKV))[lane]; const float a = __builtin_bit_cast(float, w0 << 16), b = __builtin_bit_cast(float, w0 & 0xffff0000u); sskv = a * a + b * b; }
        const int i = lane & 15, hh = lane >> 4; const float x1 = bf2f(ur[UD_KR + i]), x2 = bf2f(ur[UD_KR + 16 + i]); const float c = rope[(size_t)t * 32 + i], s = rope[(size_t)t * 32 + 16 + i];
        ssq = wave_sum(ssq); sskv = wave_sum(sskv);
        const float rq = 1.f / sqrtf(ssq * (1.f / 256.f) + NORM_EPS), rkv = 1.f / sqrtf(sskv * (1.f / 128.f) + NORM_EPS);
        if (lane < 48) { u4v o;
#pragma unroll
            for (int j = 0; j < 4; ++j) o[j] = pk2(__builtin_bit_cast(float, qv[j] << 16) * rq, __builtin_bit_cast(float, qv[j] & 0xffff0000u) * rq);
            *(u4v*)qp = o; }
        { u4v o;
#pragma unroll
          for (int j = 0; j < 4; ++j) o[j] = pk2(__builtin_bit_cast(float, kv[j] << 16) * rkv, __builtin_bit_cast(float, kv[j] & 0xffff0000u) * rkv);
          *(u4v*)kp = o; }
        { bf16_t* kd = K + (size_t)t * 384 + hh * 96 + 64; kd[i] = f2bf(x1 * c - x2 * s); kd[16 + i] = f2bf(x1 * s + x2 * c); }
    }
}
__device__ __forceinline__ void rwkv_prep_coop(CtxRef C, int l, __attribute__((address_space(3))) unsigned char* lds) {
    int tid = threadIdx.x; asm volatile("" : "+v"(tid));
    const int lane = tid & 63, w = __builtin_amdgcn_readfirstlane(tid >> 6);
    const bf16_t* u = WSP(bf16_t, WS_U);
    const float* mu = INF(I_MU) + l * DINA;
    float* oR = WSP(float, WS_RW_R); float* oW = WSP(float, WS_RW_W); float* oK = WSP(float, WS_RW_K); float* oV = WSP(float, WS_RW_V);
    float* oA = WSP(float, WS_RW_A); float* oB = WSP(float, WS_RW_B); float* oG = WSP(float, WS_RW_G);
    __attribute__((address_space(3))) float* act = (__attribute__((address_space(3))) float*)lds;
    const int h = w & 3, role = w >> 2, c = h * 64 + lane;
    float wc0[32], wc1[32];
    { const float* p0 = role == 0 ? INF(I_WUP) + l * 32 * GW + c : INF(I_GUP) + l * 64 * GW + c;
      const float* p1 = role == 0 ? INF(I_AUP) + l * 32 * GW + c : INF(I_GUP) + l * 64 * GW + 32 * GW + c;
#pragma unroll
      for (int j = 0; j < 32; ++j) { wc0[j] = p0[j * GW]; wc1[j] = p1[j * GW]; } }
    const float w0c = INF(I_W0)[l * GW + c], a0c = INF(I_A0)[l * GW + c], kkc = INF(I_KK)[l * GW + c], kac = INF(I_KA)[l * GW + c];
    const float mur = mu[UA_R + c], muk = mu[UA_K + c], muv = mu[UA_V + c];
    for (int unit = blockIdx.x; unit < T / 16; unit += gridDim.x) {
        const int t0 = unit * 16;
        { const int tk = tid >> 5, j0 = (tid & 31) * 4; const int t = t0 + tk; const bool first = (t % SEQ) == 0;
          const unsigned* pc = (const unsigned*)(u + (size_t)t * DINP + UA_WD + j0); const unsigned c0 = pc[0], c1 = pc[1];
          unsigned q0 = 0u, q1 = 0u; if (!first) { const unsigned* pp = (const unsigned*)(u + (size_t)(t - 1) * DINP + UA_WD + j0); q0 = pp[0]; q1 = pp[1]; }
          const float cur[4] = {__builtin_bit_cast(float, c0 << 16), __builtin_bit_cast(float, c0 & 0xffff0000u), __builtin_bit_cast(float, c1 << 16), __builtin_bit_cast(float, c1 & 0xffff0000u)};
          const float prv[4] = {__builtin_bit_cast(float, q0 << 16), __builtin_bit_cast(float, q0 & 0xffff0000u), __builtin_bit_cast(float, q1 << 16), __builtin_bit_cast(float, q1 & 0xffff0000u)};
          f4v o;
#pragma unroll
          for (int j = 0; j < 4; ++j) { const float v = cur[j] + (prv[j] - cur[j]) * mu[UA_WD + j0 + j]; o[j] = (j0 < 32) ? tanhf(v) : (j0 < 64 ? v : sigmoidf_(v)); }
          *(__attribute__((address_space(3))) f4v*)(act + tk * 128 + j0) = o; }
        __syncthreads();
#pragma unroll 1
        for (int tk = 0; tk < 16; ++tk) { const int t = t0 + tk; const bool first = (t % SEQ) == 0;
            const __attribute__((address_space(3))) float* ar = act + tk * 128 + (role == 0 ? 0 : 64);
            float s0 = 0.f, s1 = 0.f;
#pragma unroll
            for (int j = 0; j < 32; j += 4) { const f4v x = *(const __attribute__((address_space(3))) f4v*)(ar + j), y = *(const __attribute__((address_space(3))) f4v*)(ar + 32 + j);
                s0 += x[0] * wc0[j] + x[1] * wc0[j + 1] + x[2] * wc0[j + 2] + x[3] * wc0[j + 3]; s1 += y[0] * wc1[j] + y[1] * wc1[j + 1] + y[2] * wc1[j + 2] + y[3] * wc1[j + 3];
                if ((j & 12) == 12) asm volatile("" ::: "memory"); }
            const size_t o = (size_t)t * GW + c;
            if (role == 1) { oG[o] = s0 + s1; }
            else {
                const float z = w0c + s0, za = a0c + s1;
                const float lnl = -softplusf_(-z) - 0.5f; const float decay = __expf(-__expf(lnl)); const float a = sigmoidf_(za);
                const bf16_t* uc = u + (size_t)t * DINP + c; const bf16_t* up = uc - DINP;
                const float rc = bf2f(uc[UA_R]), kc = bf2f(uc[UA_K]), vc = bf2f(uc[UA_V]);
                const float rp = first ? 0.f : bf2f(up[UA_R]), kp = first ? 0.f : bf2f(up[UA_K]), vp = first ? 0.f : bf2f(up[UA_V]);
                const float r = rc + (rp - rc) * mur, k = kc + (kp - kc) * muk, v = vc + (vp - vc) * muv;
                const float kkraw = k * kkc; const float ss = wave_sum(kkraw * kkraw); const float kk = kkraw / fmaxf(sqrtf(ss), 1e-12f);
                oR[o] = r; oW[o] = decay; oK[o] = k * (1.f + (a - 1.f) * kac); oV[o] = v; oA[o] = -kk; oB[o] = kk * a; } }
        __syncthreads();
    }
}
#endif

#ifndef CPU_TEST
template <int NT> __device__ __forceinline__ void ln_rows_v(const float* src, const float* g, const float* b, float* dstf, bf16_t* dstb, int lane) {
    f4v x[NT][4];
#pragma unroll
    for (int n = 0; n < NT; ++n)
#pragma unroll
        for (int i = 0; i < 4; ++i) x[n][i] = *(const f4v*)(src + (size_t)n * DM + (i * 64 + lane) * 4);
    float mean[NT], rstd[NT];
#pragma unroll
    for (int n = 0; n < NT; ++n) { float s = 0.f;
#pragma unroll
        for (int i = 0; i < 4; ++i) s += (x[n][i][0] + x[n][i][1]) + (x[n][i][2] + x[n][i][3]);
        mean[n] = wave_sum(s) * (1.f / DM); float q = 0.f;
#pragma unroll
        for (int i = 0; i < 4; ++i) { x[n][i] = x[n][i] - mean[n]; q += (x[n][i][0] * x[n][i][0] + x[n][i][1] * x[n][i][1]) + (x[n][i][2] * x[n][i][2] + x[n][i][3] * x[n][i][3]); }
        rstd[n] = 1.f / sqrtf(wave_sum(q) * (1.f / DM) + LN_EPS); }
#pragma unroll
    for (int i = 0; i < 4; ++i) { const int c = (i * 64 + lane) * 4; const f4v gv = *(const f4v*)(g + c), bv = *(const f4v*)(b + c);
#pragma unroll
        for (int n = 0; n < NT; ++n) { const f4v y = x[n][i] * rstd[n] * gv + bv; *(f4v*)(dstf + (size_t)n * DM + c) = y;
            *(unsigned long long*)(dstb + (size_t)n * DM + c) = (unsigned long long)pk2(y[0], y[1]) | ((unsigned long long)pk2(y[2], y[3]) << 32); } }
}
__device__ __forceinline__ void stage_ln2_v(CtxRef C, int l, int gw, int ngw, int lane) {
    const float* src = WSP(float, WS_X); float* dst = (l == DEPTH - 1) ? C.out : WSP(float, WS_X); bf16_t* xb = WSP(bf16_t, WS_XB);
    const float* g = INF(I_LN2G) + l * DM; const float* b = INF(I_LN2B) + l * DM;
    for (int t = gw * 2; t < T; t += ngw * 2) ln_rows_v<2>(src + (size_t)t * DM, g, b, dst + (size_t)t * DM, xb + (size_t)t * DM, lane);
}
__device__ __forceinline__ float row_sum16(float v) { v += dpp_f(v, 0); v += dpp_f(v, 1); v += dpp_f(v, 2); v += dpp_f(v, 3); return v; }
__device__ __forceinline__ void stage_post_v(CtxRef C, int l, int gw, int ngw, int lane) {
    const bf16_t* u = WSP(bf16_t, WS_U); bf16_t* mix = WSP(bf16_t, WS_MIX);
    const float* YA = WSP(float, WS_YA); const float* YB = WSP(float, WS_YB); const float* YC = WSP(float, WS_YC); const float* DEN = WSP(float, WS_DEN);
    const float* BON = WSP(float, WS_RW_BON); const bf16_t* VS = WSP(bf16_t, WS_RW_VS); const bf16_t* GG = WSP(bf16_t, WS_RW_GG);
    const int h = lane >> 4, c = lane * 4;
    const f4v gng = *(const f4v*)(INF(I_GNG) + l * GW + c), gnb = *(const f4v*)(INF(I_GNB) + l * GW + c), glag = *(const f4v*)(INF(I_GLA_G) + l * GW + c), mlng = *(const f4v*)(INF(I_MLN_G) + l * GW + c);
#pragma unroll 2
    for (int t = gw; t < T; t += ngw) {
        const size_t o = (size_t)t * GW + c;
        const f4v ya = *(const f4v*)(YA + o), yb = *(const f4v*)(YB + o), yc = *(const f4v*)(YC + o);
        const unsigned long long wg = *(const unsigned long long*)(GG + o), wv = *(const unsigned long long*)(VS + o);
        const unsigned long long wgate = *(const unsigned long long*)(u + (size_t)t * DINP + UB_G + c), wo = *(const unsigned long long*)(u + (size_t)t * DINP + UC_O + c);
        const float bon = BON[(size_t)t * 4 + h], den = DEN[(size_t)t * 4 + h];
#define UNP4(w_, a_) const float a_[4] = {__builtin_bit_cast(float, (unsigned)(w_) << 16), __builtin_bit_cast(float, (unsigned)(w_) & 0xffff0000u), __builtin_bit_cast(float, (unsigned)((w_) >> 32) << 16), __builtin_bit_cast(float, (unsigned)((w_) >> 32) & 0xffff0000u)}
        UNP4(wg, g4); UNP4(wv, v4); UNP4(wgate, gate4); UNP4(wo, o4);
#undef UNP4
        float oa[4], ob[4], oc[4];
        {   const float mean = row_sum16((ya[0] + ya[1]) + (ya[2] + ya[3])) * (1.f / 64.f); const f4v d = ya - mean;
            const float rstd = 1.f / sqrtf(row_sum16((d[0] * d[0] + d[1] * d[1]) + (d[2] * d[2] + d[3] * d[3])) * (1.f / 64.f) + RWKV_GN_EPS);
#pragma unroll
            for (int j = 0; j < 4; ++j) oa[j] = (d[j] * rstd * gng[j] + gnb[j] + bon * v4[j]) * g4[j]; }
        {   const float rstd = 1.f / sqrtf(row_sum16((yb[0] * yb[0] + yb[1] * yb[1]) + (yb[2] * yb[2] + yb[3] * yb[3])) * (1.f / 64.f) + NORM_EPS);
#pragma unroll
            for (int j = 0; j < 4; ++j) ob[j] = yb[j] * rstd * glag[j] * siluf_(gate4[j]); }
        {   const float dinv = 1.f / fmaxf(fabsf(den), 1.f); const f4v y = yc * dinv;
            const float mean = row_sum16((y[0] + y[1]) + (y[2] + y[3])) * (1.f / 64.f); const f4v d = y - mean;
            const float rstd = 1.f / sqrtf(row_sum16((d[0] * d[0] + d[1] * d[1]) + (d[2] * d[2] + d[3] * d[3])) * (1.f / 64.f) + LN_EPS);
#pragma unroll
            for (int j = 0; j < 4; ++j) oc[j] = d[j] * rstd * mlng[j] * sigmoidf_(o4[j]); }
        bf16_t* m = mix + (size_t)t * DMIX + c;
        *(unsigned long long*)m = (unsigned long long)pk2(oa[0], oa[1]) | ((unsigned long long)pk2(oa[2], oa[3]) << 32);
        *(unsigned long long*)(m + 256) = (unsigned long long)pk2(ob[0], ob[1]) | ((unsigned long long)pk2(ob[2], ob[3]) << 32);
        *(unsigned long long*)(m + 512) = (unsigned long long)pk2(oc[0], oc[1]) | ((unsigned long long)pk2(oc[2], oc[3]) << 32);
    }
}
__device__ __forceinline__ void stage_gather_v(CtxRef C, int l, int gw, int ngw, int lane) {
    const unsigned* cnt = WSP(unsigned, WS_CTL) + CW_CNT + l * NEXP * 64;
    const int* list = WSP(int, WS_LIST); const int* tokinfo = WSP(int, WS_TOKINFO);
    const bf16_t* xb = WSP(bf16_t, WS_XB); bf16_t* xg = WSP(bf16_t, WS_XG); int* rowinfo = WSP(int, WS_ROWINFO); float* rowgate = WSP(float, WS_ROWGATE);
    int e, be, ce; const int total = moe_lookup(cnt, 0, e, be, ce);
    for (int r0 = gw * 64; r0 < total; r0 += ngw * 64) {
        moe_lookup(cnt, r0, e, be, ce);
        const int slot = r0 - be + lane; int ent = -1; float gate = 0.f;
        if (slot < ce) { ent = list[(size_t)e * T + slot]; gate = ((const float*)tokinfo)[(size_t)(ent >> 1) * 4 + 2 + (ent & 1)]; }
        rowinfo[r0 + lane] = ent; rowgate[r0 + lane] = gate;
    }
}
__device__ __forceinline__ void ln1_router_coop(CtxRef C, int l, __attribute__((address_space(3))) unsigned char* lds) {
    int tid = threadIdx.x; asm volatile("" : "+v"(tid));
    const int lane = tid & 63, w = __builtin_amdgcn_readfirstlane(tid >> 6);
    float* X1 = C.out; bf16_t* xb = WSP(bf16_t, WS_XB);
    const float* g = INF(I_LN1G) + l * DM; const float* b = INF(I_LN1B) + l * DM;
    const float* wrg = INF(I_WRG) + (size_t)l * DM * NGRP; const float* brg = INF(I_BRG) + l * NGRP;
    const float* wre = INF(I_WRE) + (size_t)l * DM * NEXP; const float* bre = INF(I_BRE) + l * NEXP;
    unsigned* cnt = WSP(unsigned, WS_CTL) + CW_CNT + l * NEXP * 64;
    int* tokinfo = WSP(int, WS_TOKINFO); int* list = WSP(int, WS_LIST);
    __attribute__((address_space(3))) float* part = (__attribute__((address_space(3))) float*)lds;
    for (int tb0 = blockIdx.x * 128; tb0 < T; tb0 += gridDim.x * 128) {
        for (int i = 0; i < 16; i += 2) { const int t = tb0 + w * 16 + i;
            ln_rows_v<2>(X1 + (size_t)t * DM, g, b, X1 + (size_t)t * DM, xb + (size_t)t * DM, lane); }
        asm volatile("s_waitcnt vmcnt(0)" ::: "memory");
        __syncthreads();
        for (int half = 0; half < 2; ++half) {
            const int t = tb0 + half * 64 + lane;
            float acc[36];
#pragma unroll
            for (int j = 0; j < 36; ++j) acc[j] = 0.f;
            const float* xr = X1 + (size_t)t * DM + 128 * w;
#pragma unroll 1
            for (int k4 = 0; k4 < 32; ++k4) {
                const f4v x = *(const f4v*)(xr + 4 * k4);
#pragma unroll
                for (int kk = 0; kk < 4; ++kk) { const int k = 128 * w + 4 * k4 + kk;
                    typedef __attribute__((address_space(4))) const float cfl; cfl* we = (cfl*)(wre + (size_t)k * NEXP); cfl* wg = (cfl*)(wrg + (size_t)k * NGRP);
#pragma unroll
                    for (int j = 0; j < 4; ++j) acc[j] += x[kk] * wg[j];
#pragma unroll
                    for (int j = 0; j < 32; ++j) acc[4 + j] += x[kk] * we[j]; } }
#pragma unroll
            for (int j = 0; j < 36; ++j) part[(w * 36 + j) * 64 + lane] = acc[j];
            __syncthreads();
            if (w == 0) {
                float lg[NGRP], le[NEXP];
#pragma unroll
                for (int j = 0; j < NGRP; ++j) { float s = brg[j];
#pragma unroll
                    for (int ww = 0; ww < 8; ++ww) s += part[(ww * 36 + j) * 64 + lane]; lg[j] = s; }
#pragma unroll
                for (int j = 0; j < NEXP; ++j) { float s = bre[j];
#pragma unroll
                    for (int ww = 0; ww < 8; ++ww) s += part[(ww * 36 + 4 + j) * 64 + lane]; le[j] = s; }
                int gi = 0; float gm = lg[0];
#pragma unroll
                for (int j = 1; j < NGRP; ++j) if (lg[j] > gm) { gm = lg[j]; gi = j; }
                float gs = 0.f;
#pragma unroll
                for (int j = 0; j < NGRP; ++j) gs += expf(lg[j] - gm);
                const float group_p = 1.f / gs;
                float el[EPG];
#pragma unroll
                for (int j = 0; j < EPG; ++j) { float v = le[j];
#pragma unroll
                    for (int g2 = 1; g2 < NGRP; ++g2) v = (gi == g2) ? le[g2 * EPG + j] : v;
                    el[j] = v; }
                int e0 = 0; float m0 = el[0];
#pragma unroll
                for (int j = 1; j < EPG; ++j) if (el[j] > m0) { m0 = el[j]; e0 = j; }
                int e1 = -1; float m1 = -3.0e38f;
#pragma unroll
                for (int j = 0; j < EPG; ++j) if (j != e0 && el[j] > m1) { m1 = el[j]; e1 = j; }
                const float p1 = expf(m1 - m0); const float g0 = group_p / (1.f + p1), g1 = group_p * p1 / (1.f + p1);
                const int E0 = gi * EPG + e0, E1 = gi * EPG + e1;
                tokinfo[(size_t)t * 4 + 0] = E0; tokinfo[(size_t)t * 4 + 1] = E1;
                ((float*)tokinfo)[(size_t)t * 4 + 2] = g0; ((float*)tokinfo)[(size_t)t * 4 + 3] = g1;
                const unsigned s0 = atomicAdd(cnt + E0 * 64, 1u); list[(size_t)E0 * T + s0] = t * 2 + 0;
                const unsigned s1 = atomicAdd(cnt + E1 * 64, 1u); list[(size_t)E1 * T + s1] = t * 2 + 1;
            }
            __syncthreads();
        }
    }
}
#endif

#ifndef CPU_TEST
namespace pg8 {
#define PG8_LAS __attribute__((address_space(3)))
typedef short bf16x8 __attribute__((ext_vector_type(8)));
typedef float f32x4 __attribute__((ext_vector_type(4)));
constexpr int BM = 256, BK = 64, HALF = 128, HTB = HALF * BK * 2, STAGE_BYTES = 8 * HTB;
__device__ __forceinline__ int lds_byte(int r, int c) { const int st = (r >> 4) * 2 + (c >> 5), rr = r & 15, cc = c & 31, ob = rr * 64 + cc * 2; return st * 1024 + (ob ^ (((ob >> 9) & 1) << 5)); }
__device__ __forceinline__ void stage_rc(int b, int& R, int& C) { const int st = b / 1024, sb = b % 1024, swz = sb ^ (((sb >> 9) & 1) << 5); R = (st >> 1) * 16 + swz / 64; C = (st & 1) * 32 + (swz % 64) / 2; }
__device__ __forceinline__ int perm32(int rho) { const int n = rho >> 4, i = rho & 15; return 8 * (i >> 2) + 4 * n + (i & 3); }
struct Unit { int pm, pn; long aoff, boff; };
struct Gemm { const bf16_t* A; const bf16_t* Bt; int lda, ldb, K; };

template <class F> __device__ __forceinline__ void run_epi(const F& f, const f32x4 (&acc)[2][2][4][2], const Unit& u, int wr, int wc, int fr, int fq) {
#pragma unroll
    for (int ai = 0; ai < 2; ++ai)
#pragma unroll
        for (int m = 0; m < 4; ++m) { const int row = u.pm * BM + ai * HALF + wr * 64 + m * 16 + fr;
            if constexpr (F::MODE == 1) { const int hcol = u.pn * 128 + wc * 32 + 8 * fq; float g[8], up[8];
#pragma unroll
                for (int j = 0; j < 4; ++j) { g[j] = acc[ai][0][m][0][j]; g[4 + j] = acc[ai][0][m][1][j]; up[j] = acc[ai][1][m][0][j]; up[4 + j] = acc[ai][1][m][1][j]; }
                f.put8gu(row, hcol, g, up); }
            else if constexpr (F::PERM) {
#pragma unroll
                for (int bj = 0; bj < 2; ++bj) { const int col = u.pn * BM + bj * HALF + wc * 32 + 8 * fq; float a[8];
#pragma unroll
                    for (int j = 0; j < 4; ++j) { a[j] = acc[ai][bj][m][0][j]; a[4 + j] = acc[ai][bj][m][1][j]; }
                    f.put8(row, col, a); } }
            else {
#pragma unroll
                for (int bj = 0; bj < 2; ++bj)
#pragma unroll
                    for (int n = 0; n < 2; ++n) { const int col = u.pn * BM + bj * HALF + wc * 32 + 16 * n + 4 * fq; float a[4];
#pragma unroll
                        for (int j = 0; j < 4; ++j) a[j] = acc[ai][bj][m][n][j];
                        f.put4(row, col, a); } }
        }
}

template <class Epi, class Sched, bool GATHER = false>
__device__ __forceinline__ void gemm_phase(PG8_LAS unsigned char* lds, const Gemm g, const Sched& S, const Epi& E, const PG8_LAS int* rowtok = nullptr) {
    int tid = threadIdx.x; asm volatile("" : "+v"(tid));
    const int wid = __builtin_amdgcn_readfirstlane(tid >> 6), lane = tid & 63, wr = wid >> 2, wc = wid & 3, fr = lane & 15, fq = lane >> 4;
    const int K = g.K, nt = K / BK;
    unsigned voffA[2], voffB[2]; int rowA[2];
#pragma unroll
    for (int i = 0; i < 2; ++i) { int R, C; stage_rc(tid * 16 + i * 8192, R, C); const int Rb = Epi::PERM ? ((R & ~31) + perm32(R & 31)) : R;
        voffA[i] = GATHER ? (unsigned)C * 2u : (unsigned)(R * g.lda + C) * 2u; voffB[i] = (unsigned)(Rb * g.ldb + C) * 2u; rowA[i] = R; }
    unsigned gc[2][2], gn[2][2];
#define PG8_GOFF(dst, uidx) do { _Pragma("unroll") for (int h_ = 0; h_ < 2; ++h_) _Pragma("unroll") for (int i_ = 0; i_ < 2; ++i_) \
        dst[h_][i_] = (unsigned)rowtok[(uidx) * 256 + 128 * h_ + rowA[i_]] * (unsigned)(g.lda * 2) + voffA[i_]; } while (0)
#define PG8_STAGEA(bufoff, kptr, h, NX) do { if constexpr (GATHER) { _Pragma("unroll") for (int _i = 0; _i < 2; ++_i) \
            __builtin_amdgcn_global_load_lds((const unsigned*)((const char*)(kptr) + ((NX) ? gn[h][_i] : gc[h][_i])), (PG8_LAS unsigned*)(lds + (bufoff) + ldsw + _i * 8192), 16, 0, 0); } \
        else PG8_STAGE(bufoff, (const char*)(kptr) + ((h) ? hstepA : 0), voffA); } while (0)
    const size_t kstep = (size_t)(BK * 2);
    const size_t hstepA = (size_t)HALF * g.lda * 2, hstepB = (size_t)HALF * g.ldb * 2;
    const unsigned ldsw = (unsigned)wid * 1024u;
    const int aoff = lds_byte(wr * 64 + fr, fq * 8), boff = lds_byte(wc * 32 + fr, fq * 8);
#define PG8_SA(b, h) (((b) * 2 + (h)) * HTB)
#define PG8_SB(b, h) ((4 + (b) * 2 + (h)) * HTB)
#define PG8_STAGE(bufoff, gbase, voff) do { _Pragma("unroll") for (int _i = 0; _i < 2; ++_i) \
        __builtin_amdgcn_global_load_lds((const unsigned*)((const char*)(gbase) + (voff)[_i]), (PG8_LAS unsigned*)(lds + (bufoff) + ldsw + _i * 8192), 16, 0, 0); } while (0)
#define PG8_LDA(dst, b, h) do { _Pragma("unroll") for (int m = 0; m < 4; ++m) _Pragma("unroll") for (int k = 0; k < 2; ++k) dst[m][k] = *(const PG8_LAS bf16x8*)(lds + PG8_SA(b, h) + aoff + m * 2048 + k * 1024); } while (0)
#define PG8_LDB(dst, b, h) do { _Pragma("unroll") for (int n = 0; n < 2; ++n) _Pragma("unroll") for (int k = 0; k < 2; ++k) dst[n][k] = *(const PG8_LAS bf16x8*)(lds + PG8_SB(b, h) + boff + n * 2048 + k * 1024); } while (0)
#define PG8_MMA(ai, bj, At, Bt) do { __builtin_amdgcn_s_setprio(1); _Pragma("unroll") for (int m = 0; m < 4; ++m) _Pragma("unroll") for (int n = 0; n < 2; ++n) _Pragma("unroll") for (int k = 0; k < 2; ++k) \
        acc[ai][bj][m][n] = __builtin_amdgcn_mfma_f32_16x16x32_bf16(Bt[n][k], At[m][k], acc[ai][bj][m][n], 0, 0, 0); __builtin_amdgcn_s_setprio(0); } while (0)
#define PG8_WAIT_V(n) asm volatile("s_waitcnt vmcnt(" #n ")" ::: "memory")
#define PG8_WAIT_L(n) asm volatile("s_waitcnt lgkmcnt(" #n ")" ::: "memory")
#define PG8_BAR __builtin_amdgcn_s_barrier()
#define PG8_SCHED __builtin_amdgcn_sched_barrier(0)
    Unit cur, nxt; int ui = 0;
    if (!S.next(0, cur)) return;
    f32x4 acc[2][2][4][2];
#pragma unroll
    for (int a = 0; a < 2; ++a)
#pragma unroll
        for (int b = 0; b < 2; ++b)
#pragma unroll
            for (int m = 0; m < 4; ++m)
#pragma unroll
                for (int n = 0; n < 2; ++n) acc[a][b][m][n] = (f32x4){0.f, 0.f, 0.f, 0.f};
    bf16x8 At[4][2], B0[2][2], B1[2][2];
    const char* cA = (const char*)g.A + cur.aoff; const char* cB = (const char*)g.Bt + cur.boff;
    if constexpr (GATHER) { PG8_GOFF(gc, 0); }
    PG8_STAGE(PG8_SB(0, 0), cB, voffB); PG8_STAGE(PG8_SB(0, 1), cB + hstepB, voffB); PG8_STAGEA(PG8_SA(0, 0), cA, 0, false); PG8_STAGEA(PG8_SA(0, 1), cA, 1, false);
    if (wr == 1) PG8_BAR;
    PG8_WAIT_V(2); PG8_BAR;
    PG8_STAGE(PG8_SB(1, 0), cB + kstep, voffB); PG8_STAGEA(PG8_SA(1, 0), cA + kstep, 0, false); PG8_STAGE(PG8_SB(1, 1), cB + hstepB + kstep, voffB);
    PG8_WAIT_V(6); PG8_BAR;
    for (;;) {
        const bool has_next = S.next(ui + 1, nxt);
        const char* nA = has_next ? (const char*)g.A + nxt.aoff : cA; const char* nB = has_next ? (const char*)g.Bt + nxt.boff : cB;
        if constexpr (GATHER) { if (has_next) { PG8_GOFF(gn, ui + 1); } else { _Pragma("unroll") for (int h_ = 0; h_ < 2; ++h_) _Pragma("unroll") for (int i_ = 0; i_ < 2; ++i_) gn[h_][i_] = gc[h_][i_]; } }
_Pragma("unroll 1")
        for (int t = 0; t < nt; t += 2) {
            const bool last = (t == nt - 2);
            const char* a1 = cA + (size_t)(t + 1) * kstep;
            const char* a2 = last ? nA : cA + (size_t)(t + 2) * kstep; const char* b2 = last ? nB : cB + (size_t)(t + 2) * kstep;
            const char* a3 = a2 + kstep; const char* b3 = b2 + kstep;
            PG8_LDB(B0, 0, 0); PG8_LDB(B1, 0, 1); PG8_SCHED; PG8_LDA(At, 0, 0); PG8_STAGEA(PG8_SA(1, 1), a1, 1, false);
            PG8_WAIT_V(8); PG8_WAIT_L(0); PG8_BAR; PG8_MMA(0, 0, At, B0); PG8_MMA(0, 1, At, B1); PG8_BAR; PG8_SCHED;
            PG8_LDA(At, 0, 1); PG8_STAGE(PG8_SB(0, 0), b2, voffB); PG8_STAGE(PG8_SB(0, 1), b2 + hstepB, voffB); PG8_STAGEA(PG8_SA(0, 0), a2, 0, last);
            PG8_WAIT_V(8); PG8_WAIT_L(0); PG8_BAR; PG8_MMA(1, 0, At, B0); PG8_MMA(1, 1, At, B1); PG8_BAR; PG8_SCHED;
            PG8_LDB(B0, 1, 0); PG8_LDB(B1, 1, 1); PG8_SCHED; PG8_LDA(At, 1, 0); PG8_STAGEA(PG8_SA(0, 1), a2, 1, last);
            PG8_WAIT_V(8); PG8_WAIT_L(0); PG8_BAR; PG8_MMA(0, 0, At, B0); PG8_MMA(0, 1, At, B1); PG8_BAR; PG8_SCHED;
            PG8_LDA(At, 1, 1); PG8_STAGE(PG8_SB(1, 0), b3, voffB); PG8_STAGE(PG8_SB(1, 1), b3 + hstepB, voffB); PG8_STAGEA(PG8_SA(1, 0), a3, 0, last);
            PG8_WAIT_V(8); PG8_WAIT_L(0); PG8_BAR; PG8_MMA(1, 0, At, B0); PG8_MMA(1, 1, At, B1); PG8_BAR; PG8_SCHED;
        }
        if (wr == 0) PG8_BAR;
        run_epi(E, acc, cur, wr, wc, fr, fq);
        if (!has_next) break;
#pragma unroll
        for (int a = 0; a < 2; ++a)
#pragma unroll
            for (int b = 0; b < 2; ++b)
#pragma unroll
                for (int m = 0; m < 4; ++m)
#pragma unroll
                    for (int n = 0; n < 2; ++n) acc[a][b][m][n] = (f32x4){0.f, 0.f, 0.f, 0.f};
        cur = nxt; cA = nA; cB = nB; ++ui;
        if constexpr (GATHER) { _Pragma("unroll") for (int h_ = 0; h_ < 2; ++h_) _Pragma("unroll") for (int i_ = 0; i_ < 2; ++i_) gc[h_][i_] = gn[h_][i_]; }
        if (wr == 1) PG8_BAR;
    }
    PG8_WAIT_V(0);
    PG8_BAR;
#undef PG8_GOFF
#undef PG8_STAGEA
#undef PG8_SA
#undef PG8_SB
#undef PG8_STAGE
#undef PG8_LDA
#undef PG8_LDB
#undef PG8_MMA
#undef PG8_WAIT_V
#undef PG8_WAIT_L
#undef PG8_BAR
#undef PG8_SCHED
}
struct DenseOrder {
    int nM, nN, G, c; long astep, bstep;
    __device__ __forceinline__ bool next(int i, Unit& u) const {
        const long L = (long)i * G + c; if (L >= (long)nM * nN) return false;
        const int w = (int)L; const int nig = 8 * nN, gid = w / nig, fm = gid * 8, gsz = (nM - fm) < 8 ? (nM - fm) : 8;
        u.pm = fm + ((w % nig) % gsz); u.pn = (w % nig) / gsz; u.aoff = (long)u.pm * astep; u.boff = (long)u.pn * bstep; return true; }
};
struct MoeOrder {
    const PG8_LAS int* tbl; int nM, nN, G, c; long astep, bstep, estep;
    __device__ __forceinline__ bool next(int i, Unit& u) const {
        const long L = (long)i * G + c; if (L >= (long)nM * nN) return false;
        const int w = (int)L; u.pm = w / nN; u.pn = w % nN; const int e = tbl[u.pm];
        u.aoff = (long)u.pm * astep; u.boff = (long)e * estep + (long)u.pn * bstep; return true; }
};
}
#endif

#ifndef CPU_TEST
namespace att {
typedef short bf16x8 __attribute__((ext_vector_type(8)));
typedef short s16x4 __attribute__((ext_vector_type(4)));
typedef float f32x16 __attribute__((ext_vector_type(16)));
typedef float f32x2_t __attribute__((ext_vector_type(2))); typedef __bf16 bf16x2_t __attribute__((ext_vector_type(2)));
typedef unsigned u32x4 __attribute__((ext_vector_type(4)));
typedef unsigned u32x2 __attribute__((ext_vector_type(2)));
#define ATT_LAS __attribute__((address_space(3)))
#define BAR_LDS() asm volatile("s_waitcnt lgkmcnt(0)\n\ts_barrier" ::: "memory")
constexpr int KP = 104, VP = 68;
constexpr int KBUF = 64 * KP * 2, VBUF = 64 * VP * 2;
constexpr int LDS_NEED = 2 * KBUF + 2 * VBUF;
__device__ __forceinline__ unsigned cvtpk(float lo, float hi) { f32x2_t v = {lo, hi}; bf16x2_t b = __builtin_convertvector(v, bf16x2_t); return __builtin_bit_cast(unsigned, b); }
__device__ __forceinline__ int crow(int r, int hi) { return (r & 3) + 8 * (r >> 2) + 4 * hi; }
__device__ __forceinline__ u32x4 scale8(const u32x4& w, float s) { u32x4 o;
#pragma unroll
    for (int j = 0; j < 4; ++j) o[j] = cvtpk(__builtin_bit_cast(float, w[j] << 16) * s, __builtin_bit_cast(float, w[j] & 0xffff0000u) * s);
    return o; }
__device__ __forceinline__ void unit(ATT_LAS unsigned char* lds, const bf16_t* Q, const bf16_t* K, const bf16_t* V, const float* rstd, bf16_t* mix, int b, int h, int qb) {
    int tid = threadIdx.x; asm volatile("" : "+v"(tid));
    const int lane = tid & 63, w = __builtin_amdgcn_readfirstlane(tid >> 6), r32 = lane & 31, hi = lane >> 5;
    const size_t tb = (size_t)b * SEQ;
    const int q = qb * 256 + w * 32 + r32;
    bf16x8 qr[6];
    { const bf16_t* qrow = Q + (tb + q) * 384 + h * 96 + 8 * hi;
#pragma unroll
      for (int ks = 0; ks < 6; ++ks) qr[ks] = *(const bf16x8*)(qrow + 16 * ks); }
    f32x16 o0, o1;
#pragma unroll
    for (int r = 0; r < 16; ++r) { o0[r] = 0.f; o1[r] = 0.f; }
    float lsum = 0.f;
    const int NT = 4 * (qb + 1);
    const int kr0 = tid / 12, kp0 = tid % 12, kr1 = (tid + 512) / 12, kp1 = (tid + 512) % 12; const bool has1 = tid < 256;
    const int vk = tid >> 3, vp = tid & 7;
    const bf16_t* gK0 = K + (tb + kr0) * 384 + h * 96 + kp0 * 8; const bf16_t* gK1 = has1 ? K + (tb + kr1) * 384 + h * 96 + kp1 * 8 : gK0;
    const bf16_t* gV = V + (tb + vk) * 256 + h * 64 + vp * 8;
    struct StageSet { u32x4 k0, k1, v; };
    StageSet SA, SB; SA.k1 = (u32x4){0u, 0u, 0u, 0u}; SB.k1 = SA.k1;
#define ATT_LOAD(S, tile) do { const size_t adv = (size_t)(tile) * 64; S.k0 = *(const u32x4*)(gK0 + adv * 384); S.k1 = *(const u32x4*)(gK1 + adv * 384); S.v = *(const u32x4*)(gV + adv * 256); } while (0)
#define ATT_WRITE(S, buf) do { \
        *(ATT_LAS u32x4*)(lds + (buf) * KBUF + (kr0 * KP + kp0 * 8) * 2) = S.k0; \
        if (has1) *(ATT_LAS u32x4*)(lds + (buf) * KBUF + (kr1 * KP + kp1 * 8) * 2) = S.k1; \
        ATT_LAS unsigned short* vt_ = (ATT_LAS unsigned short*)(lds + 2 * KBUF + (buf) * VBUF); \
        _Pragma("unroll") for (int j = 0; j < 4; ++j) { vt_[(8 * vp + 2 * j) * VP + vk] = (unsigned short)(S.v[j] & 0xffffu); vt_[(8 * vp + 2 * j + 1) * VP + vk] = (unsigned short)(S.v[j] >> 16); } } while (0)
    ATT_LOAD(SA, 0); ATT_WRITE(SA, 0); ATT_LOAD(SB, 1); ATT_LOAD(SA, 2);
    BAR_LDS();
    float mref = 0.f;
    f32x16 negm;
#pragma unroll
    for (int r = 0; r < 16; ++r) negm[r] = 0.f;
#define ATT_STEP(t, SW) do { const int buf = (t) & 1; \
          \
        bf16x8 kf0[6], kf1[6]; \
        { ATT_LAS const unsigned char* kb = lds + buf * KBUF + (r32 * KP + 8 * hi) * 2; \
          _Pragma("unroll") for (int ks = 0; ks < 6; ++ks) { kf0[ks] = *(ATT_LAS const bf16x8*)(kb + ks * 32); kf1[ks] = *(ATT_LAS const bf16x8*)(kb + 32 * KP * 2 + ks * 32); } } \
        __builtin_amdgcn_sched_barrier(0); \
        f32x16 p0 = __builtin_amdgcn_mfma_f32_32x32x16_bf16(kf0[0], qr[0], negm, 0, 0, 0), p1 = __builtin_amdgcn_mfma_f32_32x32x16_bf16(kf1[0], qr[0], negm, 0, 0, 0); \
        _Pragma("unroll") for (int ks = 1; ks < 6; ++ks) { p0 = __builtin_amdgcn_mfma_f32_32x32x16_bf16(kf0[ks], qr[ks], p0, 0, 0, 0); p1 = __builtin_amdgcn_mfma_f32_32x32x16_bf16(kf1[ks], qr[ks], p1, 0, 0, 0); } \
        u32x2 vr[4][4]; \
        { ATT_LAS const unsigned char* vb = lds + 2 * KBUF + buf * VBUF + (r32 * VP + 4 * hi) * 2; \
          _Pragma("unroll") for (int s = 0; s < 4; ++s) { vr[s][0] = *(ATT_LAS const u32x2*)(vb + s * 32); vr[s][1] = *(ATT_LAS const u32x2*)(vb + s * 32 + 16); \
              vr[s][2] = *(ATT_LAS const u32x2*)(vb + 32 * VP * 2 + s * 32); vr[s][3] = *(ATT_LAS const u32x2*)(vb + 32 * VP * 2 + s * 32 + 16); } } \
        __builtin_amdgcn_sched_barrier(0); \
        if ((t) >= NT - 4) { const int k0 = (t) * 64; \
            _Pragma("unroll") for (int r = 0; r < 16; ++r) { const int kk = k0 + crow(r, hi); if (kk > q) p0[r] = -1e30f; if (kk + 32 > q) p1[r] = -1e30f; } } \
        float rm = __builtin_fmaxf(p0[0], p1[0]), rm2 = __builtin_fmaxf(p0[1], p1[1]); \
        _Pragma("unroll") for (int r = 2; r < 16; r += 2) { rm = __builtin_fmaxf(__builtin_fmaxf(rm, p0[r]), p1[r]); rm2 = __builtin_fmaxf(__builtin_fmaxf(rm2, p0[r + 1]), p1[r + 1]); } \
        rm = __builtin_fmaxf(rm, rm2); \
        { auto rr = __builtin_amdgcn_permlane32_swap(__float_as_uint(rm), __float_as_uint(rm), false, false); rm = fmaxf(__uint_as_float(rr[0]), __uint_as_float(rr[1])); } \
        if ((t) == 0 || __any(rm > 8.f)) { const float dl = ((t) == 0) ? rm : fmaxf(rm, 0.f); mref += dl; const float f = __builtin_amdgcn_exp2f(-dl); lsum *= f; \
            _Pragma("unroll") for (int r = 0; r < 16; ++r) { p0[r] -= dl; p1[r] -= dl; o0[r] *= f; o1[r] *= f; negm[r] = -mref; } } \
        float ps = 0.f; \
        _Pragma("unroll") for (int r = 0; r < 16; ++r) { p0[r] = __builtin_amdgcn_exp2f(p0[r]); p1[r] = __builtin_amdgcn_exp2f(p1[r]); ps += p0[r] + p1[r]; } \
        lsum += ps; \
        _Pragma("unroll") for (int s = 0; s < 4; ++s) { \
              u32x4 pw; \
              if (s == 0) pw = (u32x4){cvtpk(p0[0], p0[1]), cvtpk(p0[2], p0[3]), cvtpk(p0[4], p0[5]), cvtpk(p0[6], p0[7])}; \
              else if (s == 1) pw = (u32x4){cvtpk(p0[8], p0[9]), cvtpk(p0[10], p0[11]), cvtpk(p0[12], p0[13]), cvtpk(p0[14], p0[15])}; \
              else if (s == 2) pw = (u32x4){cvtpk(p1[0], p1[1]), cvtpk(p1[2], p1[3]), cvtpk(p1[4], p1[5]), cvtpk(p1[6], p1[7])}; \
              else pw = (u32x4){cvtpk(p1[8], p1[9]), cvtpk(p1[10], p1[11]), cvtpk(p1[12], p1[13]), cvtpk(p1[14], p1[15])}; \
              const bf16x8 pb = __builtin_bit_cast(bf16x8, pw); \
              const bf16x8 va0 = __builtin_bit_cast(bf16x8, (u32x4){vr[s][0][0], vr[s][0][1], vr[s][1][0], vr[s][1][1]}), va1 = __builtin_bit_cast(bf16x8, (u32x4){vr[s][2][0], vr[s][2][1], vr[s][3][0], vr[s][3][1]}); \
              o0 = __builtin_amdgcn_mfma_f32_32x32x16_bf16(va0, pb, o0, 0, 0, 0); o1 = __builtin_amdgcn_mfma_f32_32x32x16_bf16(va1, pb, o1, 0, 0, 0); } \
        if ((t) + 1 < NT) ATT_WRITE(SW, buf ^ 1); \
        ATT_LOAD(SW, ((t) + 3 < NT) ? (t) + 3 : NT - 1);            \
        BAR_LDS(); } while (0)
    for (int t = 0; t < NT; t += 2) { ATT_STEP(t, SB); ATT_STEP(t + 1, SA); }
#undef ATT_STEP
#undef ATT_LOAD
#undef ATT_WRITE
    { auto rr = __builtin_amdgcn_permlane32_swap(__float_as_uint(lsum), __float_as_uint(lsum), false, false); lsum = __uint_as_float(rr[0]) + __uint_as_float(rr[1]); }
    const float inv = 1.f / lsum;
    bf16_t* orow = mix + (tb + q) * DMIX + 768 + h * 64;
#pragma unroll
    for (int rg = 0; rg < 4; ++rg) {
        u32x2 w0 = {cvtpk(o0[4 * rg] * inv, o0[4 * rg + 1] * inv), cvtpk(o0[4 * rg + 2] * inv, o0[4 * rg + 3] * inv)};
        u32x2 w1 = {cvtpk(o1[4 * rg] * inv, o1[4 * rg + 1] * inv), cvtpk(o1[4 * rg + 2] * inv, o1[4 * rg + 3] * inv)};
        *(u32x2*)(orow + 8 * rg + 4 * hi) = w0; *(u32x2*)(orow + 32 + 8 * rg + 4 * hi) = w1; }
}
}
#endif

#ifndef CPU_TEST
namespace lin {
using att::bf16x8; using att::f32x16; using att::u32x4; using att::u32x2; using att::cvtpk; using att::crow;
constexpr int PT = 68;
template <int DK, int NDV> struct Lay {
    static constexpr int PQ = DK + 8;
    static constexpr int OFF_Q = 0, OFF_K = OFF_Q + 64 * PQ * 2, OFF_KH = OFF_K + 64 * PQ * 2, OFF_VT = OFF_KH + DK * PT * 2, OFF_DEC = OFF_VT + NDV * PT * 2, BUF = OFF_DEC + 256;
};
__device__ __forceinline__ bf16x8 ldA16(ATT_LAS const unsigned char* p) { return *(ATT_LAS const bf16x8*)p; }
__device__ __forceinline__ bf16x8 ldP8(ATT_LAS const unsigned char* p) { const u32x2 a = *(ATT_LAS const u32x2*)p, b = *(ATT_LAS const u32x2*)(p + 16); return __builtin_bit_cast(bf16x8, (u32x4){a[0], a[1], b[0], b[1]}); }
__device__ __forceinline__ bf16x8 pack8(const f32x16& x, int s) {
    u32x4 p;
    if (s == 0) p = (u32x4){cvtpk(x[0], x[1]), cvtpk(x[2], x[3]), cvtpk(x[4], x[5]), cvtpk(x[6], x[7])};
    else p = (u32x4){cvtpk(x[8], x[9]), cvtpk(x[10], x[11]), cvtpk(x[12], x[13]), cvtpk(x[14], x[15])};
    return __builtin_bit_cast(bf16x8, p); }
#define MF32(a, b, c) __builtin_amdgcn_mfma_f32_32x32x16_bf16((a), (b), (c), 0, 0, 0)
template <int DK, int NDV> __device__ __forceinline__ void compute(ATT_LAS const unsigned char* B, int ib, int dvb, int r32, int hi, f32x16 (&H)[DK / 32], f32x16& O) {
    typedef Lay<DK, NDV> L;
    f32x16 X[2];
#pragma unroll
    for (int r = 0; r < 16; ++r) { X[0][r] = 0.f; X[1][r] = 0.f; O[r] = 0.f; }
#pragma unroll
    for (int jb = 0; jb < 2; ++jb) if (jb <= ib) {
#pragma unroll
        for (int s = 0; s < DK / 16; ++s)
            X[jb] = MF32(ldA16(B + L::OFF_K + ((32 * jb + r32) * L::PQ + 16 * s + 8 * hi) * 2), ldA16(B + L::OFF_Q + ((32 * ib + r32) * L::PQ + 16 * s + 8 * hi) * 2), X[jb]);
        if (jb == ib) {
#pragma unroll
            for (int r = 0; r < 16; ++r) if (crow(r, hi) > r32) X[jb][r] = 0.f; } }
    bf16x8 vf[2][2];
#pragma unroll
    for (int jb = 0; jb < 2; ++jb)
#pragma unroll
        for (int s = 0; s < 2; ++s) vf[jb][s] = ldP8(B + L::OFF_VT + ((32 * dvb + r32) * PT + 32 * jb + 16 * s + 4 * hi) * 2);
#pragma unroll
    for (int jb = 0; jb < 2; ++jb) if (jb <= ib) {
#pragma unroll
        for (int s = 0; s < 2; ++s) O = MF32(pack8(X[jb], s), vf[jb][s], O); }
#pragma unroll
    for (int db = 0; db < DK / 32; ++db)
#pragma unroll
        for (int s = 0; s < 2; ++s) O = MF32(ldP8(B + L::OFF_Q + ((32 * ib + r32) * L::PQ + 32 * db + 16 * s + 4 * hi) * 2), pack8(H[db], s), O);
#pragma unroll
    for (int db = 0; db < DK / 32; ++db) {
        ATT_LAS const float* dec = (ATT_LAS const float*)(B + L::OFF_DEC);
#pragma unroll
        for (int r = 0; r < 16; ++r) H[db][r] *= dec[32 * db + crow(r, hi)];
#pragma unroll
        for (int jb = 0; jb < 2; ++jb)
#pragma unroll
            for (int s = 0; s < 2; ++s) H[db] = MF32(ldP8(B + L::OFF_KH + ((32 * db + r32) * PT + 32 * jb + 16 * s + 4 * hi) * 2), vf[jb][s], H[db]); }
}
__device__ __forceinline__ float scan64(float v, int lane) {
    { int y = __builtin_amdgcn_update_dpp(0, __builtin_bit_cast(int, v), 0x111, 0xF, 0xF, true); v += __builtin_bit_cast(float, y); }
    { int y = __builtin_amdgcn_update_dpp(0, __builtin_bit_cast(int, v), 0x112, 0xF, 0xF, true); v += __builtin_bit_cast(float, y); }
    { int y = __builtin_amdgcn_update_dpp(0, __builtin_bit_cast(int, v), 0x114, 0xF, 0xF, true); v += __builtin_bit_cast(float, y); }
    { int y = __builtin_amdgcn_update_dpp(0, __builtin_bit_cast(int, v), 0x118, 0xF, 0xF, true); v += __builtin_bit_cast(float, y); }
    const int x = __builtin_bit_cast(int, v);
    const float t0 = __builtin_bit_cast(float, __builtin_amdgcn_readlane(x, 15)), t1 = __builtin_bit_cast(float, __builtin_amdgcn_readlane(x, 31)), t2 = __builtin_bit_cast(float, __builtin_amdgcn_readlane(x, 47));
    const int row = lane >> 4;
    return v + (row >= 1 ? t0 : 0.f) + (row >= 2 ? t1 : 0.f) + (row >= 3 ? t2 : 0.f); }
__device__ __forceinline__ float bfl(unsigned w) { return __builtin_bit_cast(float, w << 16); }
__device__ __forceinline__ float bfh(unsigned w) { return __builtin_bit_cast(float, w & 0xffff0000u); }
__device__ __forceinline__ void vt_write(ATT_LAS unsigned char* B, int off_vt, int tok, int part, const u32x4& sv) {
    ATT_LAS unsigned short* vt = (ATT_LAS unsigned short*)(B + off_vt);
#pragma unroll
    for (int j = 0; j < 4; ++j) { vt[(8 * part + 2 * j) * PT + tok] = (unsigned short)(sv[j] & 0xffffu); vt[(8 * part + 2 * j + 1) * PT + tok] = (unsigned short)(sv[j] >> 16); } }

#define GLA_FETCH(c) do { const size_t t_ = tb + (size_t)(c) * 64 + lane; const bf16_t* ur = u + t_ * DINP; \
        pa0 = *(const u32x4*)(ur + UB_AD); pa1 = *(const u32x4*)(ur + UB_AD + 8); pq = *(const u32x2*)(ur + UB_Q + h * 32 + 4 * w); pk = *(const u32x2*)(ur + UB_K + h * 32 + 4 * w); \
        pv = *(const u32x4*)(u + (tb + (size_t)(c) * 64 + vtok) * DINP + UB_V + h * 64 + vpart * 8); } while (0)
#define GLA_PREP(buf) do { ATT_LAS unsigned char* B_ = lds + (buf) * L::BUF; \
        float adv[16]; _Pragma("unroll") for (int j = 0; j < 4; ++j) { adv[2 * j] = bfl(pa0[j]); adv[2 * j + 1] = bfh(pa0[j]); adv[8 + 2 * j] = bfl(pa1[j]); adv[9 + 2 * j] = bfh(pa1[j]); } \
        const float qv[4] = {bfl(pq[0]), bfh(pq[0]), bfl(pq[1]), bfh(pq[1])}, kv[4] = {bfl(pk[0]), bfh(pk[0]), bfl(pk[1]), bfh(pk[1])}; \
        float qo[4], ko[4]; \
        _Pragma("unroll") for (int d = 0; d < 4; ++d) { float z = ab[d]; _Pragma("unroll") for (int j = 0; j < 16; ++j) z += adv[j] * aup[j * 128 + d]; \
            const float la = -softplusf_(-z) * (1.f / 16.f); const float bc = scan64(la, lane); const float be = __builtin_bit_cast(float, __builtin_amdgcn_readlane(__builtin_bit_cast(int, bc), 63)); \
            qo[d] = qv[d] * __expf(bc) * 0.17677669529663687f; ko[d] = kv[d] * __expf(-bc); const float kh = kv[d] * __expf(be - bc); \
            ((ATT_LAS unsigned short*)(B_ + L::OFF_KH))[(4 * w + d) * PT + lane] = f2bf(kh); \
            if (lane == 63) ((ATT_LAS float*)(B_ + L::OFF_DEC))[4 * w + d] = __expf(be); } \
        *(ATT_LAS u32x2*)(B_ + L::OFF_Q + (lane * L::PQ + 4 * w) * 2) = (u32x2){cvtpk(qo[0], qo[1]), cvtpk(qo[2], qo[3])}; \
        *(ATT_LAS u32x2*)(B_ + L::OFF_K + (lane * L::PQ + 4 * w) * 2) = (u32x2){cvtpk(ko[0], ko[1]), cvtpk(ko[2], ko[3])}; \
        vt_write(B_, L::OFF_VT, vtok, vpart, pv); } while (0)
#define ML_FETCH(c) do { const int s_ = (c) * 64 + lane; const bf16_t* ur = u + (tb + s_) * DINP; \
        _Pragma("unroll") for (int j = 0; j < 4; ++j) { const bool ok = s_ - 3 + j >= 0; const bf16_t* up = ur + (ptrdiff_t)(j - 3) * DINP; \
            xq[j] = ok ? *(const u32x4*)(up + UC_Q + h * 64 + 8 * w) : (u32x4){0u, 0u, 0u, 0u}; xk[j] = ok ? *(const u32x4*)(up + UC_K + h * 64 + 8 * w) : (u32x4){0u, 0u, 0u, 0u}; } \
        pg = *(const u32x4*)(ur + UC_IG); pv = *(const u32x4*)(u + (tb + (size_t)(c) * 64 + vtok) * DINP + UC_V + h * 64 + vpart * 8); } while (0)
#define ML_PREP(buf) do { ATT_LAS unsigned char* B_ = lds + (buf) * L::BUF; \
        const unsigned gi_ = pg[h >> 1], gf_ = pg[2 + (h >> 1)]; const float ig = ((h & 1) ? bfh(gi_) : bfl(gi_)) + ibias; const float lf = -softplusf_(-(((h & 1) ? bfh(gf_) : bfl(gf_)) + fbias)); \
        const float F = scan64(lf, lane); const float Fe = __builtin_bit_cast(float, __builtin_amdgcn_readlane(__builtin_bit_cast(int, F), 63)); const float eF = __expf(F), wk = __expf(ig - F) * 0.125f, wkh = __expf(Fe - F + ig) * 0.125f; \
        float qo[8], ko[8]; \
        _Pragma("unroll") for (int ch = 0; ch < 8; ++ch) { float yq = cb[ch], yk = cb[256 + ch]; \
            _Pragma("unroll") for (int j = 0; j < 4; ++j) { const unsigned wq_ = xq[j][ch >> 1], wk_ = xk[j][ch >> 1]; \
                yq += cw[j * 512 + ch] * ((ch & 1) ? bfh(wq_) : bfl(wq_)); yk += cw[j * 512 + 256 + ch] * ((ch & 1) ? bfh(wk_) : bfl(wk_)); } \
            const float sq = siluf_(yq), sk = siluf_(yk); qo[ch] = sq * eF; ko[ch] = sk * wk; \
            ((ATT_LAS unsigned short*)(B_ + L::OFF_KH))[(8 * w + ch) * PT + lane] = f2bf(sk * wkh); } \
        *(ATT_LAS u32x4*)(B_ + L::OFF_Q + (lane * L::PQ + 8 * w) * 2) = (u32x4){cvtpk(qo[0], qo[1]), cvtpk(qo[2], qo[3]), cvtpk(qo[4], qo[5]), cvtpk(qo[6], qo[7])}; \
        *(ATT_LAS u32x4*)(B_ + L::OFF_K + (lane * L::PQ + 8 * w) * 2) = (u32x4){cvtpk(ko[0], ko[1]), cvtpk(ko[2], ko[3]), cvtpk(ko[4], ko[5]), cvtpk(ko[6], ko[7])}; \
        if (w == 0) ((ATT_LAS float*)(B_ + L::OFF_DEC))[lane] = __expf(Fe); \
        vt_write(B_, L::OFF_VT, vtok, vpart, pv); } while (0)
#define GLA_FETCHX(tb_, h_, c_) do { const size_t t_ = (tb_) + (size_t)(c_) * 64 + lane; const bf16_t* ur = u + t_ * DINP; \
        pa0 = *(const u32x4*)(ur + UB_AD); pa1 = *(const u32x4*)(ur + UB_AD + 8); pq = *(const u32x2*)(ur + UB_Q + (h_) * 32 + 4 * w); pk = *(const u32x2*)(ur + UB_K + (h_) * 32 + 4 * w); \
        pv = *(const u32x4*)(u + ((tb_) + (size_t)(c_) * 64 + vtok) * DINP + UB_V + (h_) * 64 + vpart * 8); } while (0)
#define ML_FETCHX(tb_, h_, c_) do { const int s_ = (c_) * 64 + lane; const bf16_t* ur = u + ((tb_) + s_) * DINP; \
        _Pragma("unroll") for (int j = 0; j < 4; ++j) { const bool ok = s_ - 3 + j >= 0; const bf16_t* up = ur + (ptrdiff_t)(j - 3) * DINP; \
            xq[j] = ok ? *(const u32x4*)(up + UC_Q + (h_) * 64 + 8 * w) : (u32x4){0u, 0u, 0u, 0u}; xk[j] = ok ? *(const u32x4*)(up + UC_K + (h_) * 64 + 8 * w) : (u32x4){0u, 0u, 0u, 0u}; } \
        pg = *(const u32x4*)(ur + UC_IG); pv = *(const u32x4*)(u + ((tb_) + (size_t)(c_) * 64 + vtok) * DINP + UC_V + (h_) * 64 + vpart * 8); } while (0)
template <int MIX> __device__ __forceinline__ void stage1_units(ATT_LAS unsigned char* lds, CtxRef C, int l, int first, int stride) {
    typedef Lay<(MIX == 0 ? 32 : 64), (MIX == 0 ? 64 : 96)> L;
    int tid = threadIdx.x; asm volatile("" : "+v"(tid));
    const int lane = tid & 63, w = __builtin_amdgcn_readfirstlane(tid >> 6);
    const bf16_t* u = WSP(bf16_t, WS_U);
    const int vtok = tid >> 3, vpart = tid & 7;
    unsigned char* blobs = C.ws + (MIX == 0 ? WS_GLA_BLOB : WS_ML_BLOB);
    if (MIX == 1) { for (int i = tid; i < 32 * PT; i += 512) ((ATT_LAS unsigned short*)(lds + L::OFF_VT))[64 * PT + i] = (i < PT) ? (unsigned short)0x3f80 : (unsigned short)0; }
    constexpr int NC = SEQ / 64, NV = L::BUF / 16, NU = BATCH * NH * NC;
    u32x4 pa0, pa1, pv, pg, xq[4], xk[4]; u32x2 pq, pk;
    if (first < NU) { const int bh = first / NC, c = first % NC; const size_t tb = (size_t)(bh >> 2) * SEQ;
        if (MIX == 0) GLA_FETCHX(tb, bh & 3, c); else ML_FETCHX(tb, bh & 3, c); }
    for (int uu = first; uu < NU; uu += stride) {
        const int bh = uu / NC, h = bh & 3;
        if (MIX == 0) { const float* aup = INF(I_GLA_UP) + l * 16 * 128 + h * 32 + 4 * w; const float* ab = INF(I_GLA_B) + l * 128 + h * 32 + 4 * w; GLA_PREP(0); }
        else { const float* cw = INF(I_CONVW) + l * 4 * 512 + h * 64 + 8 * w; const float* cb = INF(I_CONVB) + l * 512 + h * 64 + 8 * w; const float ibias = INF(I_IB)[l * 4 + h], fbias = INF(I_FB)[l * 4 + h]; ML_PREP(0); }
        { const int un = uu + stride; if (un < NU) { const int bhn = un / NC, cn = un % NC; const size_t tbn = (size_t)(bhn >> 2) * SEQ;
            if (MIX == 0) GLA_FETCHX(tbn, bhn & 3, cn); else ML_FETCHX(tbn, bhn & 3, cn); } }
        BAR_LDS();
        u32x4* dst = (u32x4*)(blobs + (size_t)uu * L::BUF);
        for (int i = tid; i < NV; i += 512) dst[i] = *(ATT_LAS const u32x4*)(lds + i * 16);
        BAR_LDS();
    }
}
template <int MIX> __device__ __forceinline__ void stage2_run(ATT_LAS unsigned char* lds, CtxRef C, int b, int h) {
    typedef Lay<(MIX == 0 ? 32 : 64), (MIX == 0 ? 64 : 96)> L;
    constexpr int DK = (MIX == 0 ? 32 : 64), NDV = (MIX == 0 ? 64 : 96), NCW = (MIX == 0 ? 4 : 6);
    int tid = threadIdx.x; asm volatile("" : "+v"(tid));
    const int lane = tid & 63, w = __builtin_amdgcn_readfirstlane(tid >> 6), r32 = lane & 31, hi = lane >> 5;
    constexpr int NC = SEQ / 64, NV = L::BUF / 16, NI = (NV + 511) / 512;
    const unsigned char* blobs = C.ws + (MIX == 0 ? WS_GLA_BLOB : WS_ML_BLOB) + (size_t)(b * 4 + h) * NC * L::BUF;
    float* Y = WSP(float, (MIX == 0 ? WS_YB : WS_YC)); float* DEN = WSP(float, WS_DEN);
    const size_t tb = (size_t)b * SEQ;
    f32x16 H[DK / 32], O;
#pragma unroll
    for (int d = 0; d < DK / 32; ++d)
#pragma unroll
        for (int r = 0; r < 16; ++r) H[d][r] = 0.f;
    const int ib = (MIX == 0) ? (w >> 1) : (w / 3), dvb = (MIX == 0) ? (w & 1) : (w % 3);
    u32x4 s0[NI], s1[NI];
#define LB_FETCH(S, c) do { const u32x4* src_ = (const u32x4*)(blobs + (size_t)(c) * L::BUF); _Pragma("unroll") for (int i = 0; i < NI; ++i) { const int ix = tid + 512 * i; if (ix < NV) S[i] = src_[ix]; } } while (0)
#define LB_WRITE(S, buf) do { _Pragma("unroll") for (int i = 0; i < NI; ++i) { const int ix = tid + 512 * i; if (ix < NV) *(ATT_LAS u32x4*)(lds + (buf) * L::BUF + ix * 16) = S[i]; } } while (0)
#define LB_STEP(c, SW) do { \
        if (w < NCW) { compute<DK, NDV>(lds + ((c) & 1) * L::BUF, ib, dvb, r32, hi, H, O); \
            const size_t t0 = tb + (size_t)(c) * 64 + 32 * ib; \
            if (MIX == 0 || dvb < 2) { float* yo = Y + t0 * GW + h * 64 + 32 * dvb + r32; _Pragma("unroll") for (int r = 0; r < 16; ++r) yo[(size_t)crow(r, hi) * GW] = O[r]; } \
            else if (r32 == 0) { _Pragma("unroll") for (int r = 0; r < 16; ++r) DEN[(t0 + crow(r, hi)) * 4 + h] = O[r]; } } \
        if ((c) + 1 < NC) { LB_WRITE(SW, ((c) + 1) & 1); if ((c) + 3 < NC) LB_FETCH(SW, (c) + 3); } \
        BAR_LDS(); } while (0)
    LB_FETCH(s0, 0); LB_FETCH(s1, 1); LB_WRITE(s0, 0); LB_FETCH(s0, 2);
    BAR_LDS();
    for (int c = 0; c < NC; c += 2) { LB_STEP(c, s1); LB_STEP(c + 1, s0); }
#undef LB_FETCH
#undef LB_WRITE
#undef LB_STEP
}
#undef GLA_FETCH
#undef GLA_PREP
#undef ML_FETCH
#undef ML_PREP
#undef GLA_FETCHX
#undef ML_FETCHX
#undef MF32
}
#endif

#ifndef CPU_TEST
namespace rwk {
constexpr int NB = 16;
constexpr int VEC = 6 * 64;
constexpr int BUFB = NB * VEC * 4;
__device__ __forceinline__ float dpp_add(float v, int ctrl_sel) {
    int x = __builtin_bit_cast(int, v), y;
    if (ctrl_sel == 0) y = __builtin_amdgcn_update_dpp(0, x, 0xB1, 0xF, 0xF, true);
    else if (ctrl_sel == 1) y = __builtin_amdgcn_update_dpp(0, x, 0x4E, 0xF, 0xF, true);
    else if (ctrl_sel == 2) y = __builtin_amdgcn_update_dpp(0, x, 0x141, 0xF, 0xF, true);
    else y = __builtin_amdgcn_update_dpp(0, x, 0x140, 0xF, 0xF, true);
    return v + __builtin_bit_cast(float, y); }
__device__ __forceinline__ float red16(float v) { v = dpp_add(v, 0); v = dpp_add(v, 1); v = dpp_add(v, 2); v = dpp_add(v, 3); return v; }
__device__ __forceinline__ void run(ATT_LAS unsigned char* lds, CtxRef C, int b, int h, int rg) {
    int tid = threadIdx.x; asm volatile("" : "+v"(tid));
    const int lane = tid & 63, w = __builtin_amdgcn_readfirstlane(tid >> 6);
    const float* src[6] = {WSP(float, WS_RW_A), WSP(float, WS_RW_W), WSP(float, WS_RW_B), WSP(float, WS_RW_K), WSP(float, WS_RW_R), WSP(float, WS_RW_V)};
    float* Y = WSP(float, WS_YA);
    const size_t tb = (size_t)b * SEQ;
    const int lt = tid - 256;
#define RW_LOAD(batch, buf) do { _Pragma("unroll") for (int i = 0; i < 6; ++i) { const int p = lt + 256 * i; const int st = p / 96, vc = (p % 96) >> 4, pt = p & 15; \
        const float* sp = (vc == 0 ? src[0] : vc == 1 ? src[1] : vc == 2 ? src[2] : vc == 3 ? src[3] : vc == 4 ? src[4] : src[5]); \
        const f4v v4 = *(const f4v*)(sp + (tb + (size_t)(batch) * NB + st) * GW + h * 64 + pt * 4); \
        *(ATT_LAS f4v*)(lds + (buf) * BUFB + (st * VEC + vc * 64 + pt * 4) * 4) = v4; } } while (0)
    constexpr int NBATCH = SEQ / NB;
    if (w >= 4) RW_LOAD(0, 0);
    BAR_LDS();
    const int row = 16 * rg + 4 * w + (lane >> 4), cg = lane & 15;
    float S0 = 0.f, S1 = 0.f, S2 = 0.f, S3 = 0.f;
    for (int bt = 0; bt < NBATCH; ++bt) {
        if (w >= 4) { if (bt + 1 < NBATCH) RW_LOAD(bt + 1, (bt + 1) & 1); }
        else {
            ATT_LAS const float* B = (ATT_LAS const float*)(lds + (bt & 1) * BUFB);
#pragma unroll 4
            for (int st = 0; st < NB; ++st) {
                ATT_LAS const float* P = B + st * VEC;
                const f4v a = *(ATT_LAS const f4v*)(P + 4 * cg), wv = *(ATT_LAS const f4v*)(P + 64 + 4 * cg), bb = *(ATT_LAS const f4v*)(P + 128 + 4 * cg),
                          kk = *(ATT_LAS const f4v*)(P + 192 + 4 * cg), r = *(ATT_LAS const f4v*)(P + 256 + 4 * cg);
                const float vv = P[320 + row];
                const float sa = red16((S0 * a[0] + S1 * a[1]) + (S2 * a[2] + S3 * a[3]));
                S0 = S0 * wv[0] + (sa * bb[0] + vv * kk[0]); S1 = S1 * wv[1] + (sa * bb[1] + vv * kk[1]);
                S2 = S2 * wv[2] + (sa * bb[2] + vv * kk[2]); S3 = S3 * wv[3] + (sa * bb[3] + vv * kk[3]);
                const float y = red16((S0 * r[0] + S1 * r[1]) + (S2 * r[2] + S3 * r[3]));
                if (cg == 0) Y[(tb + (size_t)bt * NB + st) * GW + h * 64 + row] = y;
            }
        }
        BAR_LDS();
    }
#undef RW_LOAD
}
}
#endif

#ifndef CPU_TEST
namespace rw7 {
using att::bf16x8; using att::f32x16; using att::u32x4; using att::u32x2; using att::cvtpk; using att::crow;
using lin::ldA16; using lin::ldP8; using lin::pack8; using lin::scan64; using lin::bfl; using lin::bfh;
#define MF32(a, b, c) __builtin_amdgcn_mfma_f32_32x32x16_bf16((a), (b), (c), 0, 0, 0)
constexpr int PA = 136, PZ = 68, PW = 40, PG_ = 72;
constexpr int X_WUP = 0, X_AUP = 5120, X_GUP = 10240, X_ACT = 19456;
constexpr int O_ZB = 71680, O_ZAB = 89088, O_RED = 106496;
constexpr int I_AT = 0, I_RT = 9216, I_BT = 18432, I_KT = 27648, I_ATT = 36864, I_BTT = 45568, I_KTT = 54272, I_VT = 62976;
constexpr int O_TIMG = O_ZAB, O_L21 = O_ZAB + 9216, O_T11T = O_ZAB + 11776, O_EX = 110592, O_GC = 126976;
static_assert(I_VT + 64 * 68 * 2 <= O_ZB && O_T11T + 2560 <= O_RED && O_RED + 4096 <= O_EX && O_EX + 16384 <= O_GC && O_GC + 256 <= 131072, "rw7 LDS map");
__device__ __forceinline__ void stage1_unit(ATT_LAS unsigned char* lds, CtxRef C, int l, int b, int h, int ch) {
    const int unit = (b * 4 + h) * (SEQ / 64) + ch;
    int tid = threadIdx.x; asm volatile("" : "+v"(tid));
    const int lane = tid & 63, w = __builtin_amdgcn_readfirstlane(tid >> 6), r32 = lane & 31, hi = lane >> 5;
    const bf16_t* u = WSP(bf16_t, WS_U); const float* mu = INF(I_MU) + l * DINA;
    const size_t t0 = (size_t)b * SEQ + (size_t)ch * 64;
    const bool seq0 = (ch == 0);
    const int atok = tid >> 3, apart = tid & 7;
    u32x4 lc0, lc1, lp0, lp1;
    { const bf16_t* p = u + (t0 + atok) * DINP + UA_WD + 16 * apart; lc0 = *(const u32x4*)p; lc1 = *(const u32x4*)(p + 8);
      if (seq0 && atok == 0) { lp0 = (u32x4){0u, 0u, 0u, 0u}; lp1 = lp0; } else { lp0 = *(const u32x4*)(p - DINP); lp1 = *(const u32x4*)(p - DINP + 8); } }
    u32x4 rc, kc, vc, rp, kp, vp;
    { const bf16_t* p = u + (t0 + lane) * DINP + h * 64 + 8 * w; rc = *(const u32x4*)(p + UA_R); kc = *(const u32x4*)(p + UA_K); vc = *(const u32x4*)(p + UA_V);
      if (seq0 && lane == 0) { rp = (u32x4){0u, 0u, 0u, 0u}; kp = rp; vp = rp; } else { rp = *(const u32x4*)(p - DINP + UA_R); kp = *(const u32x4*)(p - DINP + UA_K); vp = *(const u32x4*)(p - DINP + UA_V); } }
    { const u32x4* wsrc = (const u32x4*)(C.ws + WS_RWW + (size_t)h * 19456);
#pragma unroll
      for (int i = 0; i < 3; ++i) { const int ix = tid + 512 * i; if (ix < 1216) *(ATT_LAS u32x4*)(lds + X_WUP + ix * 16) = wsrc[ix]; } }
    { float o[16];
#pragma unroll
      for (int j = 0; j < 4; ++j) { const float c0 = bfl(lc0[j]), c1 = bfh(lc0[j]), c2 = bfl(lc1[j]), c3 = bfh(lc1[j]); const float p0 = bfl(lp0[j]), p1 = bfh(lp0[j]), p2 = bfl(lp1[j]), p3 = bfh(lp1[j]);
          const float* m = mu + UA_WD + 16 * apart; o[2 * j] = c0 + (p0 - c0) * m[2 * j]; o[2 * j + 1] = c1 + (p1 - c1) * m[2 * j + 1]; o[8 + 2 * j] = c2 + (p2 - c2) * m[8 + 2 * j]; o[9 + 2 * j] = c3 + (p3 - c3) * m[9 + 2 * j]; }
      if (apart < 2) {
#pragma unroll
          for (int j = 0; j < 16; ++j) o[j] = tanhf_(o[j]); }
      else if (apart >= 4) {
#pragma unroll
          for (int j = 0; j < 16; ++j) o[j] = sigmoidf_(o[j]); }
      ATT_LAS unsigned char* d = lds + X_ACT + (atok * PA + 16 * apart) * 2;
      *(ATT_LAS u32x4*)d = (u32x4){cvtpk(o[0], o[1]), cvtpk(o[2], o[3]), cvtpk(o[4], o[5]), cvtpk(o[6], o[7])};
      *(ATT_LAS u32x4*)(d + 16) = (u32x4){cvtpk(o[8], o[9]), cvtpk(o[10], o[11]), cvtpk(o[12], o[13]), cvtpk(o[14], o[15])}; }
    BAR_LDS();
    { const int tb = (w & 3) >> 1, cb = w & 1; f32x16 z0, z1;
#pragma unroll
      for (int r = 0; r < 16; ++r) { z0[r] = 0.f; z1[r] = 0.f; }
      ATT_LAS const unsigned char* arow = lds + X_ACT + ((32 * tb + r32) * PA + 8 * hi) * 2;
      if (w < 4) {
#pragma unroll
          for (int s = 0; s < 2; ++s) { z0 = MF32(ldA16(arow + 32 * s), ldA16(lds + X_WUP + ((32 * cb + r32) * PW + 16 * s + 8 * hi) * 2), z0);
              z1 = MF32(ldA16(arow + 64 + 32 * s), ldA16(lds + X_AUP + ((32 * cb + r32) * PW + 16 * s + 8 * hi) * 2), z1); }
          ATT_LAS float* zb = (ATT_LAS float*)(lds + O_ZB); ATT_LAS float* zab = (ATT_LAS float*)(lds + O_ZAB);
#pragma unroll
          for (int r = 0; r < 16; ++r) { zb[(32 * tb + crow(r, hi)) * PZ + 32 * cb + r32] = z0[r]; zab[(32 * tb + crow(r, hi)) * PZ + 32 * cb + r32] = z1[r]; }
      } else {
#pragma unroll
          for (int s = 0; s < 4; ++s) z0 = MF32(ldA16(arow + 128 + 32 * s), ldA16(lds + X_GUP + ((32 * cb + r32) * PG_ + 16 * s + 8 * hi) * 2), z0);
          bf16_t* gg = WSP(bf16_t, WS_RW_GG) + (t0 + 32 * tb) * GW + h * 64 + 32 * cb + r32;
#pragma unroll
          for (int r = 0; r < 16; ++r) gg[(size_t)crow(r, hi) * GW] = f2bf(z0[r]); } }
    BAR_LDS();
    {   const int cb8 = h * 64 + 8 * w;
        const float* w0 = INF(I_W0) + l * GW + cb8; const float* a0 = INF(I_A0) + l * GW + cb8; const float* kkw = INF(I_KK) + l * GW + cb8; const float* kaw = INF(I_KA) + l * GW + cb8;
        const float* rkw = INF(I_RK) + l * GW + cb8;
        ATT_LAS const float* zb = (ATT_LAS const float*)(lds + O_ZB) + lane * PZ + 8 * w; ATT_LAS const float* zab = (ATT_LAS const float*)(lds + O_ZAB) + lane * PZ + 8 * w;
        const f4v zA = *(ATT_LAS const f4v*)zb, zB = *(ATT_LAS const f4v*)(zb + 4), yA = *(ATT_LAS const f4v*)zab, yB = *(ATT_LAS const f4v*)(zab + 4);
        float rr[8], kk_[8], vv[8], lw[8], ai[8], kq[8]; float ss = 0.f, bon = 0.f;
#pragma unroll
        for (int i = 0; i < 8; ++i) {
            const float z = w0[i] + (i < 4 ? zA[i & 3] : zB[i & 3]), za = a0[i] + (i < 4 ? yA[i & 3] : yB[i & 3]);
            lw[i] = -__expf(-softplusf_(-z) - 0.5f); ai[i] = sigmoidf_(za);
            const unsigned wr_ = rc[i >> 1], wk_ = kc[i >> 1], wv_ = vc[i >> 1], pr_ = rp[i >> 1], pk_ = kp[i >> 1], pv_ = vp[i >> 1];
            const float r_c = (i & 1) ? bfh(wr_) : bfl(wr_), k_c = (i & 1) ? bfh(wk_) : bfl(wk_), v_c = (i & 1) ? bfh(wv_) : bfl(wv_);
            const float r_p = (i & 1) ? bfh(pr_) : bfl(pr_), k_p = (i & 1) ? bfh(pk_) : bfl(pk_), v_p = (i & 1) ? bfh(pv_) : bfl(pv_);
            rr[i] = r_c + (r_p - r_c) * mu[UA_R + cb8 + i]; const float k = k_c + (k_p - k_c) * mu[UA_K + cb8 + i]; vv[i] = v_c + (v_p - v_c) * mu[UA_V + cb8 + i];
            kq[i] = k * kkw[i]; ss += kq[i] * kq[i]; kk_[i] = k * (1.f + (ai[i] - 1.f) * kaw[i]); bon += rr[i] * kk_[i] * rkw[i]; }
        ATT_LAS float* red = (ATT_LAS float*)(lds + O_RED);
        red[w * 64 + lane] = ss; red[512 + w * 64 + lane] = bon;
        BAR_LDS();
        float sst = 0.f, bont = 0.f;
#pragma unroll
        for (int ww = 0; ww < 8; ++ww) { sst += red[ww * 64 + lane]; bont += red[512 + ww * 64 + lane]; }
        const float inv = 1.f / fmaxf(sqrtf(sst), 1e-12f);
        float at8[8], rt8[8], bt8[8], kt8[8];
#pragma unroll
        for (int i = 0; i < 8; ++i) { const float Gc = scan64(lw[i], lane); const float Gp = Gc - lw[i]; const float kkn = kq[i] * inv; const float enG = __expf(-Gc);
            at8[i] = -kkn * __expf(Gp); rt8[i] = rr[i] * __expf(Gc); bt8[i] = kkn * ai[i] * enG; kt8[i] = kk_[i] * enG;
            if (lane == 63) { const float gcv = __expf(Gc); ((ATT_LAS float*)(lds + O_GC))[8 * w + i] = gcv; WSP(float, WS_RW_GC)[(size_t)unit * 64 + 8 * w + i] = gcv; } }
        { ATT_LAS unsigned char* d = lds + (lane * PG_ + 8 * w) * 2;
          *(ATT_LAS u32x4*)(d + I_AT) = (u32x4){cvtpk(at8[0], at8[1]), cvtpk(at8[2], at8[3]), cvtpk(at8[4], at8[5]), cvtpk(at8[6], at8[7])};
          *(ATT_LAS u32x4*)(d + I_RT) = (u32x4){cvtpk(rt8[0], rt8[1]), cvtpk(rt8[2], rt8[3]), cvtpk(rt8[4], rt8[5]), cvtpk(rt8[6], rt8[7])};
          *(ATT_LAS u32x4*)(d + I_BT) = (u32x4){cvtpk(bt8[0], bt8[1]), cvtpk(bt8[2], bt8[3]), cvtpk(bt8[4], bt8[5]), cvtpk(bt8[6], bt8[7])};
          *(ATT_LAS u32x4*)(d + I_KT) = (u32x4){cvtpk(kt8[0], kt8[1]), cvtpk(kt8[2], kt8[3]), cvtpk(kt8[4], kt8[5]), cvtpk(kt8[6], kt8[7])};
#pragma unroll
          for (int i = 0; i < 8; ++i) { const int o2 = ((8 * w + i) * lin::PT + lane) * 2;
              *(ATT_LAS unsigned short*)(lds + I_ATT + o2) = f2bf(at8[i]); *(ATT_LAS unsigned short*)(lds + I_BTT + o2) = f2bf(bt8[i]);
              *(ATT_LAS unsigned short*)(lds + I_KTT + o2) = f2bf(kt8[i]); *(ATT_LAS unsigned short*)(lds + I_VT + o2) = f2bf(vv[i]); } }
        const size_t o = (t0 + lane) * GW + cb8;
        if (w == 0) WSP(float, WS_RW_BON)[(t0 + lane) * 4 + h] = bont;
        *(u32x4*)(WSP(bf16_t, WS_RW_VS) + o) = (u32x4){cvtpk(vv[0], vv[1]), cvtpk(vv[2], vv[3]), cvtpk(vv[4], vv[5]), cvtpk(vv[6], vv[7])};
    }
    BAR_LDS();
#define RW_PROD(ACC, IA, IB, rb, cb, keep) do { _Pragma("unroll") for (int r_ = 0; r_ < 16; ++r_) ACC[r_] = 0.f; \
        _Pragma("unroll") for (int k_ = 0; k_ < 4; ++k_) ACC = MF32(ldA16(lds + (IA) + ((32 * (rb) + r32) * PG_ + 16 * k_ + 8 * hi) * 2), ldA16(lds + (IB) + ((32 * (cb) + r32) * PG_ + 16 * k_ + 8 * hi) * 2), ACC); \
        if ((keep) == 1) { _Pragma("unroll") for (int r_ = 0; r_ < 16; ++r_) if (!(crow(r_, hi) < r32)) ACC[r_] = 0.f; } \
        if ((keep) == 2) { _Pragma("unroll") for (int r_ = 0; r_ < 16; ++r_) if (!(crow(r_, hi) <= r32)) ACC[r_] = 0.f; } \
        if ((keep) == 3) { _Pragma("unroll") for (int r_ = 0; r_ < 16; ++r_) if (!(crow(r_, hi) > r32)) ACC[r_] = 0.f; } \
        __builtin_amdgcn_sched_barrier(0); } while (0)
    f32x16 M00, M01, M11;
    f32x16 Z1a, Z1b;
    if (w == 2 || w == 3) { const int eb = w - 2; f32x16 L00, L01, L11;
        RW_PROD(L00, I_KT, I_AT, 0, 0, 1); RW_PROD(L01, I_KT, I_AT, 0, 1, 0); RW_PROD(L11, I_KT, I_AT, 1, 1, 1);
#pragma unroll
        for (int r = 0; r < 16; ++r) { Z1a[r] = 0.f; Z1b[r] = 0.f; }
#pragma unroll
        for (int k = 0; k < 2; ++k) { const bf16x8 v0 = ldP8(lds + I_VT + ((32 * eb + r32) * lin::PT + 16 * k + 4 * hi) * 2), v1 = ldP8(lds + I_VT + ((32 * eb + r32) * lin::PT + 32 + 16 * k + 4 * hi) * 2);
            Z1a = MF32(pack8(L00, k), v0, Z1a); Z1b = MF32(pack8(L01, k), v0, Z1b); Z1b = MF32(pack8(L11, k), v1, Z1b); } }
    if (w == 4 || w == 5) { const int eb = w - 4; f32x16 K00, K01, K11, Ya, Yb, KVa, KVb;
        RW_PROD(K00, I_KT, I_RT, 0, 0, 2); RW_PROD(K01, I_KT, I_RT, 0, 1, 0); RW_PROD(K11, I_KT, I_RT, 1, 1, 2);
#pragma unroll
        for (int r = 0; r < 16; ++r) { Ya[r] = 0.f; Yb[r] = 0.f; KVa[r] = 0.f; KVb[r] = 0.f; }
#pragma unroll
        for (int k = 0; k < 2; ++k) { const bf16x8 v0 = ldP8(lds + I_VT + ((32 * eb + r32) * lin::PT + 16 * k + 4 * hi) * 2), v1 = ldP8(lds + I_VT + ((32 * eb + r32) * lin::PT + 32 + 16 * k + 4 * hi) * 2);
            Ya = MF32(pack8(K00, k), v0, Ya); Yb = MF32(pack8(K01, k), v0, Yb); Yb = MF32(pack8(K11, k), v1, Yb);
            KVa = MF32(ldP8(lds + I_KTT + (r32 * lin::PT + 16 * k + 4 * hi) * 2), v0, KVa); KVa = MF32(ldP8(lds + I_KTT + (r32 * lin::PT + 32 + 16 * k + 4 * hi) * 2), v1, KVa);
            KVb = MF32(ldP8(lds + I_KTT + ((32 + r32) * lin::PT + 16 * k + 4 * hi) * 2), v0, KVb); KVb = MF32(ldP8(lds + I_KTT + ((32 + r32) * lin::PT + 32 + 16 * k + 4 * hi) * 2), v1, KVb); }
        ATT_LAS unsigned char* ex = lds + O_EX + (eb * 4 * 64 + lane) * 32;
#define RW_EXW(q_, A_) do { *(ATT_LAS u32x4*)(ex + (q_) * 2048) = (u32x4){cvtpk(A_[0], A_[1]), cvtpk(A_[2], A_[3]), cvtpk(A_[4], A_[5]), cvtpk(A_[6], A_[7])}; \
        *(ATT_LAS u32x4*)(ex + (q_) * 2048 + 16) = (u32x4){cvtpk(A_[8], A_[9]), cvtpk(A_[10], A_[11]), cvtpk(A_[12], A_[13]), cvtpk(A_[14], A_[15])}; } while (0)
        RW_EXW(0, Ya); RW_EXW(1, Yb); RW_EXW(2, KVa); RW_EXW(3, KVb);
#undef RW_EXW
    }
    if (w == 7) {
        f32x16 La, Lb, Lc;
        RW_PROD(La, I_AT, I_BT, 0, 0, 3); RW_PROD(Lb, I_AT, I_BT, 1, 0, 0); RW_PROD(Lc, I_AT, I_BT, 1, 1, 3);
        ATT_LAS float* Lbuf = (ATT_LAS float*)(lds + O_ZB);
#pragma unroll
        for (int r = 0; r < 16; ++r) { Lbuf[crow(r, hi) * PZ + r32] = La[r]; Lbuf[(32 + crow(r, hi)) * PZ + 32 + r32] = Lc[r];
            *(ATT_LAS unsigned short*)(lds + O_L21 + (crow(r, hi) * PW + r32) * 2) = f2bf(Lb[r]);
            *(ATT_LAS unsigned short*)(lds + O_TIMG + (crow(r, hi) * PG_ + 32 + r32) * 2) = 0; }
        asm volatile("s_waitcnt lgkmcnt(0)" ::: "memory");
        float Tc[32];
        { ATT_LAS const float* Lr = Lbuf + (32 * hi) * PZ + 32 * hi;
#pragma unroll
          for (int t = 0; t < 32; ++t) { float acc = (t == r32) ? 1.f : 0.f;
#pragma unroll
              for (int s4 = 0; s4 < (t + 3) / 4; ++s4) { const f4v lv = *(ATT_LAS const f4v*)(Lr + t * PZ + 4 * s4);
#pragma unroll
                  for (int j = 0; j < 4; ++j) if (4 * s4 + j < t) acc += lv[j] * Tc[4 * s4 + j]; }
              Tc[t] = acc; } }
#pragma unroll
        for (int t = 0; t < 32; ++t) *(ATT_LAS unsigned short*)(lds + O_TIMG + ((32 * hi + t) * PG_ + 32 * hi + r32) * 2) = f2bf(Tc[t]);
        if (hi == 0) {
#pragma unroll
            for (int q4 = 0; q4 < 4; ++q4) *(ATT_LAS u32x4*)(lds + O_T11T + (r32 * PW + 8 * q4) * 2) = (u32x4){cvtpk(Tc[8 * q4], Tc[8 * q4 + 1]), cvtpk(Tc[8 * q4 + 2], Tc[8 * q4 + 3]), cvtpk(Tc[8 * q4 + 4], Tc[8 * q4 + 5]), cvtpk(Tc[8 * q4 + 6], Tc[8 * q4 + 7])}; }
        asm volatile("s_waitcnt lgkmcnt(0)" ::: "memory");
        f32x16 X, T21;
#pragma unroll
        for (int r = 0; r < 16; ++r) { X[r] = 0.f; T21[r] = 0.f; }
#pragma unroll
        for (int k = 0; k < 2; ++k) X = MF32(ldA16(lds + O_L21 + (r32 * PW + 16 * k + 8 * hi) * 2), ldA16(lds + O_T11T + (r32 * PW + 16 * k + 8 * hi) * 2), X);
#pragma unroll
        for (int k = 0; k < 2; ++k) T21 = MF32(ldP8(lds + O_TIMG + ((32 + r32) * PG_ + 32 + 16 * k + 4 * hi) * 2), pack8(X, k), T21);
#pragma unroll
        for (int r = 0; r < 16; ++r) *(ATT_LAS unsigned short*)(lds + O_TIMG + ((32 + crow(r, hi)) * PG_ + r32) * 2) = f2bf(T21[r]);
    }
    BAR_LDS();
    if (w < 4) {
        const int nb = w & 1;
        ATT_LAS const float* gc = (ATT_LAS const float*)(lds + O_GC);
        f32x16 P0, P1;
#pragma unroll
        for (int r = 0; r < 16; ++r) { P0[r] = 0.f; P1[r] = 0.f; }
#pragma unroll
        for (int k = 0; k < 2; ++k) {
            const bf16x8 t00 = ldP8(lds + O_TIMG + (r32 * PG_ + 16 * k + 4 * hi) * 2), t10 = ldP8(lds + O_TIMG + ((32 + r32) * PG_ + 16 * k + 4 * hi) * 2), t11 = ldP8(lds + O_TIMG + ((32 + r32) * PG_ + 32 + 16 * k + 4 * hi) * 2);
            bf16x8 b0, b1;
            if (w < 2) { b0 = ldP8(lds + I_ATT + ((32 * nb + r32) * lin::PT + 16 * k + 4 * hi) * 2); b1 = ldP8(lds + I_ATT + ((32 * nb + r32) * lin::PT + 32 + 16 * k + 4 * hi) * 2); }
            else { b0 = pack8(Z1a, k); b1 = pack8(Z1b, k); }
            P0 = MF32(t00, b0, P0); P1 = MF32(t10, b0, P1); P1 = MF32(t11, b1, P1); }
        {   RW_PROD(M00, I_BT, I_RT, 0, 0, 2); RW_PROD(M01, I_BT, I_RT, 0, 1, 0); RW_PROD(M11, I_BT, I_RT, 1, 1, 2);
            f32x16 A0, A1;
#pragma unroll
            for (int r = 0; r < 16; ++r) { A0[r] = 0.f; A1[r] = 0.f; }
#pragma unroll
            for (int k = 0; k < 2; ++k) { const bf16x8 p0 = pack8(P0, k), p1 = pack8(P1, k);
                A0 = MF32(pack8(M00, k), p0, A0); A1 = MF32(pack8(M01, k), p0, A1); A1 = MF32(pack8(M11, k), p1, A1); }
            if (w < 2) { bf16_t* RY = WSP(bf16_t, WS_RW_RY) + (size_t)unit * 4096;
#pragma unroll
                for (int r = 0; r < 16; ++r) { const int t = crow(r, hi), d = 32 * nb + r32;
                    RY[t * 64 + d] = f2bf(A0[r] + bf2f(*(ATT_LAS const unsigned short*)(lds + I_RT + (t * PG_ + d) * 2)));
                    RY[(32 + t) * 64 + d] = f2bf(A1[r] + bf2f(*(ATT_LAS const unsigned short*)(lds + I_RT + ((32 + t) * PG_ + d) * 2))); } }
            else { ATT_LAS const unsigned char* ex = lds + O_EX + (nb * 4 * 64 + lane) * 32; float* Y0G = WSP(float, WS_RW_Y0) + ((size_t)unit * 4 + nb) * 1024 + lane * 16;
#pragma unroll
                for (int r4 = 0; r4 < 16; r4 += 4) { f4v y0, y1;
#pragma unroll
                    for (int j = 0; j < 4; ++j) { const int r = r4 + j; y0[j] = A0[r] + bf2f(*(ATT_LAS const unsigned short*)(ex + 2 * r)); y1[j] = A1[r] + bf2f(*(ATT_LAS const unsigned short*)(ex + 2048 + 2 * r)); }
                    *(f4v*)(Y0G + r4) = y0; *(f4v*)(Y0G + 2048 + r4) = y1; } } }
        __builtin_amdgcn_sched_barrier(0);
        {   f32x16 B0, B1;
#pragma unroll
            for (int r = 0; r < 16; ++r) { B0[r] = 0.f; B1[r] = 0.f; }
#pragma unroll
            for (int k = 0; k < 2; ++k) { const bf16x8 p0 = pack8(P0, k), p1 = pack8(P1, k);
                B0 = MF32(ldP8(lds + I_BTT + (r32 * lin::PT + 16 * k + 4 * hi) * 2), p0, B0); B0 = MF32(ldP8(lds + I_BTT + (r32 * lin::PT + 32 + 16 * k + 4 * hi) * 2), p1, B0);
                B1 = MF32(ldP8(lds + I_BTT + ((32 + r32) * lin::PT + 16 * k + 4 * hi) * 2), p0, B1); B1 = MF32(ldP8(lds + I_BTT + ((32 + r32) * lin::PT + 32 + 16 * k + 4 * hi) * 2), p1, B1); }
            if (w < 2) { bf16_t* PLg = WSP(bf16_t, WS_RW_PL) + (size_t)unit * 4096;
#pragma unroll
                for (int r = 0; r < 16; ++r) { const int t = crow(r, hi), d = 32 * nb + r32; PLg[t * 64 + d] = f2bf(gc[t] * B0[r]); PLg[(32 + t) * 64 + d] = f2bf(gc[32 + t] * B1[r]); } }
            else { ATT_LAS const unsigned char* ex = lds + O_EX + (nb * 4 * 64 + lane) * 32; float* QG = WSP(float, WS_RW_QG) + ((size_t)unit * 4 + nb) * 1024 + lane * 16;
#pragma unroll
                for (int r4 = 0; r4 < 16; r4 += 4) { f4v q0, q1;
#pragma unroll
                    for (int j = 0; j < 4; ++j) { const int r = r4 + j; q0[j] = gc[crow(r, hi)] * (B0[r] + bf2f(*(ATT_LAS const unsigned short*)(ex + 4096 + 2 * r))); q1[j] = gc[32 + crow(r, hi)] * (B1[r] + bf2f(*(ATT_LAS const unsigned short*)(ex + 6144 + 2 * r))); }
                    *(f4v*)(QG + r4) = q0; *(f4v*)(QG + 2048 + r4) = q1; } } }
    }
    BAR_LDS();
#undef RW_PROD
}
__device__ __forceinline__ void stage2_run(ATT_LAS unsigned char* lds, CtxRef C, int b, int h) {
    int tid = threadIdx.x; asm volatile("" : "+v"(tid));
    const int lane = tid & 63, w = __builtin_amdgcn_readfirstlane(tid >> 6), r32 = lane & 31, hi = lane >> 5;
    constexpr int NC = SEQ / 64; constexpr int S2_PL = 0, S2_RY = 9216, S2_GC = 18432, S2_BUF = 18688;
    const int bh = b * 4 + h; const size_t unit0 = (size_t)bh * NC;
    const bf16_t* PLg = WSP(bf16_t, WS_RW_PL) + unit0 * 4096; const bf16_t* RYg = WSP(bf16_t, WS_RW_RY) + unit0 * 4096;
    const float* QG = WSP(float, WS_RW_QG) + unit0 * 4096; const float* Y0G = WSP(float, WS_RW_Y0) + unit0 * 4096; const float* GCg = WSP(float, WS_RW_GC) + unit0 * 64;
    float* Y = WSP(float, WS_YA);
    const int i = w >> 1, eb = w & 1, srow = tid >> 3, spart = tid & 7;
    f32x16 H0, H1, q0, q1, y0;
#pragma unroll
    for (int r = 0; r < 16; ++r) { H0[r] = 0.f; H1[r] = 0.f; }
    u32x4 spl, sry; float sgc = 0.f;
#define S2_FETCH_IMG(c) do { spl = *(const u32x4*)(PLg + (size_t)(c) * 4096 + srow * 64 + spart * 8); sry = *(const u32x4*)(RYg + (size_t)(c) * 4096 + srow * 64 + spart * 8); if (tid < 64) sgc = GCg[(c) * 64 + tid]; } while (0)
#define S2_FETCH_ACC(c) do { if (w < 4) { const float* qp = QG + (size_t)(c) * 4096 + eb * 1024 + lane * 16; const float* yp = Y0G + (size_t)(c) * 4096 + (i * 2 + eb) * 1024 + lane * 16; \
            _Pragma("unroll") for (int r4 = 0; r4 < 16; r4 += 4) { const f4v a = *(const f4v*)(qp + r4), b_ = *(const f4v*)(qp + 2048 + r4), c_ = *(const f4v*)(yp + r4); \
                _Pragma("unroll") for (int j = 0; j < 4; ++j) { q0[r4 + j] = a[j]; q1[r4 + j] = b_[j]; y0[r4 + j] = c_[j]; } } } } while (0)
#define S2_WRITE(buf) do { ATT_LAS unsigned char* B_ = lds + (buf) * S2_BUF; *(ATT_LAS u32x4*)(B_ + S2_PL + (srow * PG_ + spart * 8) * 2) = spl; *(ATT_LAS u32x4*)(B_ + S2_RY + (srow * PG_ + spart * 8) * 2) = sry; \
        if (tid < 64) ((ATT_LAS float*)(B_ + S2_GC))[tid] = sgc; } while (0)
    S2_FETCH_IMG(0); S2_FETCH_ACC(0); S2_WRITE(0);
    BAR_LDS();
    for (int c = 0; c < NC; ++c) {
        if (c + 1 < NC) S2_FETCH_IMG(c + 1);
        if (w < 4) {
            ATT_LAS const unsigned char* B_ = lds + (c & 1) * S2_BUF; ATT_LAS const float* gc = (ATT_LAS const float*)(B_ + S2_GC);
            bf16x8 hb[2][2];
#pragma unroll
            for (int k = 0; k < 2; ++k) { hb[0][k] = pack8(H0, k); hb[1][k] = pack8(H1, k); }
            f32x16 Yo = y0;
#pragma unroll
            for (int r = 0; r < 16; ++r) { H0[r] = gc[crow(r, hi)] * H0[r] + q0[r]; H1[r] = gc[32 + crow(r, hi)] * H1[r] + q1[r]; }
            __builtin_amdgcn_sched_barrier(0);
            if (c + 1 < NC) S2_FETCH_ACC(c + 1);
#pragma unroll
            for (int db = 0; db < 2; ++db)
#pragma unroll
                for (int k = 0; k < 2; ++k) Yo = MF32(ldP8(B_ + S2_RY + ((32 * i + r32) * PG_ + 32 * db + 16 * k + 4 * hi) * 2), hb[db][k], Yo);
#pragma unroll
            for (int db = 0; db < 2; ++db)
#pragma unroll
                for (int k = 0; k < 2; ++k) { H0 = MF32(ldP8(B_ + S2_PL + (r32 * PG_ + 32 * db + 16 * k + 4 * hi) * 2), hb[db][k], H0); H1 = MF32(ldP8(B_ + S2_PL + ((32 + r32) * PG_ + 32 * db + 16 * k + 4 * hi) * 2), hb[db][k], H1); }
            float* yo = Y + ((size_t)b * SEQ + (size_t)c * 64 + 32 * i) * GW + h * 64 + 32 * eb + r32;
#pragma unroll
            for (int r = 0; r < 16; ++r) yo[(size_t)crow(r, hi) * GW] = Yo[r];
        }
        if (c + 1 < NC) S2_WRITE((c + 1) & 1);
        BAR_LDS();
    }
#undef S2_FETCH_IMG
#undef S2_FETCH_ACC
#undef S2_WRITE
}
#undef MF32
}
#endif

constexpr int PH_PER_LAYER = 13;
constexpr int NPHASES = DEPTH * PH_PER_LAYER;

#ifndef CPU_TEST
#define XB_TMO      128
#define XB_XCNT(j)  (256  + 64 * (j))
#define XB_XSUB(j)  (1280 + 64 * (j))
#define XB_XGEN(j)  (2304 + 64 * (j))
#define XB_TOP      3328
#define XB_TOPGEN   3392
#define XCD_BAR_WORDS 3456
#define XB_SPIN_CAP (1u << 18)
#define LAS __attribute__((address_space(3)))
__device__ __forceinline__ unsigned xb_ld(unsigned* p)              { return __hip_atomic_load(p, __ATOMIC_RELAXED, __HIP_MEMORY_SCOPE_AGENT); }
__device__ __forceinline__ unsigned xb_add(unsigned* p, unsigned v) { return __hip_atomic_fetch_add(p, v, __ATOMIC_RELAXED, __HIP_MEMORY_SCOPE_AGENT); }
__device__ __forceinline__ unsigned xb_xcc_id() { return (unsigned)__builtin_amdgcn_s_getreg((3 << 11) | 20) & 0xFu; }
#define XB_SPIN(cond, bar) do { unsigned _sp = 0; while (cond) { __builtin_amdgcn_s_sleep(1); \
    if ((++_sp & 255u) == 0u) { if (xb_ld(&(bar)[XB_TMO])) break; if (_sp > XB_SPIN_CAP) { atomicAdd(&(bar)[XB_TMO], 1u); break; } } } } while (0)
struct XcdBarrier { unsigned* bar; unsigned x; volatile LAS unsigned* st; };
__device__ __forceinline__ XcdBarrier xcd_barrier_post(unsigned* bar, volatile LAS unsigned* st) {
    XcdBarrier b; b.bar = bar; b.x = xb_xcc_id(); b.st = st;
    if (threadIdx.x == 0) (void)xb_add(&bar[XB_XCNT(b.x)], 1u);
    return b;
}
__device__ __forceinline__ void xcd_barrier_complete(unsigned* bar, unsigned x, unsigned& nloc, unsigned& nx) {
    const unsigned G = gridDim.x * gridDim.y * gridDim.z;
    unsigned sum, cnt, mine, sp = 0u;
    for (;;) {
        sum = 0u; cnt = 0u; mine = 0u;
#pragma unroll
        for (unsigned j = 0; j < 16; ++j) { const unsigned c = xb_ld(&bar[XB_XCNT(j)]); sum += c; cnt += (c > 0u) ? 1u : 0u; mine = (j == x) ? c : mine; }
        if (sum == G) break;
        __builtin_amdgcn_s_sleep(1);
        if ((++sp & 255u) == 0u) { if (xb_ld(&bar[XB_TMO])) break; if (sp > XB_SPIN_CAP) { atomicAdd(&bar[XB_TMO], 1u); break; } }
    }
    nloc = mine > 0u ? mine : 1u; nx = cnt > 0u ? cnt : 1u;
}
__device__ __forceinline__ void xcd_barrier(const XcdBarrier& b) {
    asm volatile("s_waitcnt vmcnt(0)" ::: "memory");
    __syncthreads();
    if (threadIdx.x == 0) {
        unsigned* bar = b.bar;
        __builtin_amdgcn_s_waitcnt(0);
        unsigned nloc = b.st[0], nx = b.st[1];
        if (nloc == 0u) { xcd_barrier_complete(bar, b.x, nloc, nx); b.st[0] = nloc; b.st[1] = nx; }
        const unsigned old = xb_add(&bar[XB_XSUB(b.x)], 1u);
        const unsigned gen = old / nloc;
        if (old + 1u == (gen + 1u) * nloc) {
            __builtin_amdgcn_fence(__ATOMIC_RELEASE, "agent");
            asm volatile("s_waitcnt vmcnt(0)" ::: "memory");
            const unsigned og = xb_add(&bar[XB_TOP], 1u);
            const unsigned tg = og / nx;
            if (og + 1u == (tg + 1u) * nx) xb_add(&bar[XB_TOPGEN], 1u);
            else XB_SPIN(xb_ld(&bar[XB_TOPGEN]) == tg, bar);
            __builtin_amdgcn_fence(__ATOMIC_ACQUIRE, "agent");
            xb_add(&bar[XB_XGEN(b.x)], 1u);
            asm volatile("s_waitcnt vmcnt(0)" ::: "memory");
        } else {
            XB_SPIN(xb_ld(&bar[XB_XGEN(b.x)]) == gen, bar);
            __builtin_amdgcn_fence(__ATOMIC_ACQUIRE, "agent");
            asm volatile("s_waitcnt vmcnt(0)" ::: "memory");
        }
    }
    __syncthreads();
}

constexpr int NWAVES = 8;
constexpr int RING_BYTES = 131072, MISC_OFF = RING_BYTES + 320, LDS_BYTES = 147456;
struct Args { Ctx C; int ph_lo, ph_hi; };
__device__ __forceinline__ int moe_fill_table(CtxRef C, int l, LAS int* tbl, int tid) {
    const unsigned* cnt = WSP(unsigned, WS_CTL) + CW_CNT + l * NEXP * 64;
    int e, be, ce; const int total = moe_lookup(cnt, tid * 256, e, be, ce);
    if (tid < 320) tbl[tid] = e;
    __syncthreads();
    return total >> 8;
}

__global__ void __launch_bounds__(NWAVES * 64, 2) mega(Args args) {
    extern __shared__ __attribute__((aligned(16))) unsigned char lds_raw[];
    LAS unsigned char* lds = (LAS unsigned char*)lds_raw;
    const int G = gridDim.x, bx = blockIdx.x;
    const int ngw = G * NWAVES;
    volatile LAS unsigned* MISC = (volatile LAS unsigned*)(lds + MISC_OFF);
    for (int i = threadIdx.x; i < (LDS_BYTES - RING_BYTES) / 4; i += NWAVES * 64) ((LAS unsigned*)(lds + RING_BYTES))[i] = 0u;
    __syncthreads();
    XcdBarrier bar = xcd_barrier_post((unsigned*)(args.C.ws + WS_CTL) + CW_BAR, MISC + 8);
    LAS int* tbl = (LAS int*)(lds + RING_BYTES + 1024);
    const int lo = args.ph_lo, hi = args.ph_hi;

    for (int l = 0; l < DEPTH; ++l) {
        const int p0 = l * PH_PER_LAYER;
#ifndef PHASE_MASK
#define PHASE_MASK 0x1FFF
#endif
#define IN(k) (((PHASE_MASK >> (k)) & 1) && lo <= p0 + (k) && p0 + (k) < hi)
#define LAUNDER() const __attribute__((address_space(4))) Args* ap_ = (const __attribute__((address_space(4))) Args*)__builtin_amdgcn_kernarg_segment_ptr(); asm volatile("" : "+s"(ap_)); CtxRef C = ap_->C; \
        int bxl_ = blockIdx.x; asm volatile("" : "+s"(bxl_)); const int bx = bxl_;     \
        int tid = threadIdx.x; asm volatile("" : "+v"(tid)); const int lane = tid & 63; const int wave = __builtin_amdgcn_readfirstlane(tid >> 6); const int gw = bx * NWAVES + wave; (void)gw; (void)lane; \
        wsh_t wsh = (wsh_t)(lds + wave * 16384); (void)wsh
#define SEAM(k) do { if (p0 + (k) + 1 < hi) xcd_barrier(bar); } while (0)
        if (IN(0)) { LAUNDER(); stage_convert(C, l, gw, ngw, lane, wsh); SEAM(0); }
        if (IN(1)) { LAUNDER();
            pg8::Gemm g{WSP(bf16_t, WS_XB), WSP(bf16_t, WS_WIN), DM, DM, DM};
            pg8::DenseOrder S{T / 256, DINP / 256, G, bx, (long)256 * DM * 2, (long)256 * DM * 2};
            EpiU E{WSP(bf16_t, WS_U)};
            pg8::gemm_phase(lds, g, S, E); SEAM(1); }
        if (IN(2)) { LAUNDER();
            {   pg8::Gemm g{WSP(bf16_t, WS_U) + UD_CQ, WSP(bf16_t, WS_WUQ), DINP, 256, 256};
                pg8::DenseOrder S{T / 256, 2, G, bx, (long)256 * DINP * 2, (long)256 * 256 * 2};
                EpiQ E{WSP(float, WS_ROPE), WSP(bf16_t, WS_AQ)};
                pg8::gemm_phase(lds, g, S, E); }
            {   pg8::Gemm g{WSP(bf16_t, WS_U) + UD_CKV, WSP(bf16_t, WS_WUKV), DINP, 256, 256};
                pg8::DenseOrder S{T / 256, 2, G, bx, (long)256 * DINP * 2, (long)256 * 256 * 2};
                EpiKV E{WSP(bf16_t, WS_AK), WSP(bf16_t, WS_AV)};
                pg8::gemm_phase(lds, g, S, E); }
            __syncthreads();
            SEAM(2); }
        if (IN(3)) { LAUNDER();
            mla_token_pass(C, gw, ngw, lane);
            __syncthreads();
            lin::stage1_units<0>(lds, C, l, bx, G);
            lin::stage1_units<1>(lds, C, l, bx, G);
            for (int uu = bx; uu < BATCH * NH * (SEQ / 64); uu += G) { const int bh = uu / (SEQ / 64), ch = uu % (SEQ / 64); rw7::stage1_unit(lds, C, l, bh >> 2, bh & 3, ch); }
            SEAM(3); }
        if (IN(4)) { LAUNDER();
            if (bx < 32) rw7::stage2_run(lds, C, bx >> 2, bx & 3);
            else if (bx < 64) lin::stage2_run<0>(lds, C, (bx - 32) >> 2, (bx - 32) & 3);
            else if (bx < 96) lin::stage2_run<1>(lds, C, (bx - 64) >> 2, (bx - 64) & 3);
            else {
                LAS int* slot = (LAS int*)(lds + RING_BYTES + 512);
                unsigned* ctr = WSP(unsigned, WS_CTL) + CW_ATT + l * 64;
                constexpr int NQB = SEQ / 256, NUNIT = BATCH * NH * NQB;
                for (;;) {
                    if (tid == 0) *slot = (int)atomicAdd(ctr, 1u);
                    __syncthreads();
                    const int uidx = *slot;
                    __syncthreads();
                    if (uidx >= NUNIT) break;
                    const int qb = NQB - 1 - uidx / (BATCH * NH), bh = uidx % (BATCH * NH);
                    att::unit(lds, WSP(bf16_t, WS_AQ), WSP(bf16_t, WS_AK), WSP(bf16_t, WS_AV), WSP(float, WS_RSTD), WSP(bf16_t, WS_MIX), bh >> 2, bh & 3, qb);
                }
            }
            __syncthreads();
            convert_moe_queue(C, l, lane, wsh);
            SEAM(4); }
        if (IN(5)) { LAUNDER(); stage_post_v(C, l, gw, ngw, lane); SEAM(5); }
        if (IN(6)) { LAUNDER();
            pg8::Gemm g{WSP(bf16_t, WS_MIX), WSP(bf16_t, WS_WOUT), DMIX, DMIX, DMIX};
            pg8::DenseOrder S{T / 256, DM / 256, G, bx, (long)256 * DMIX * 2, (long)256 * DMIX * 2};
            EpiPre1 E{l == 0 ? INF(I_X) : WSP(float, WS_X), C.out};
            pg8::gemm_phase(lds, g, S, E); SEAM(6); }
        if (IN(7)) { LAUNDER(); ln1_router_coop(C, l, lds); SEAM(7); }
        if (IN(8)) { LAUNDER();
            stage_gather_v(C, l, gw, ngw, lane);
            pg8::Gemm g{WSP(bf16_t, WS_PB), WSP(bf16_t, WS_WP), DPLE, DPLE, DPLE};
            pg8::DenseOrder S{T / 256, DM / 256, G, bx, (long)256 * DPLE * 2, (long)256 * DPLE * 2};
            EpiPP E{WSP(bf16_t, WS_PP)};
            pg8::gemm_phase(lds, g, S, E); SEAM(8); }
        if (IN(9)) { LAUNDER();
            pg8::Gemm g{WSP(bf16_t, WS_XB), WSP(bf16_t, WS_WGU), DM, DM, DM};
            const int ntile = moe_fill_table(C, l, tbl, tid);
            pg8::MoeOrder S{tbl, ntile, 2 * DEXP / 256, G, bx, 0L, (long)256 * DM * 2, (long)2 * DEXP * DM * 2};
            LAS int* rowtok = (LAS int*)(lds + RING_BYTES + 4096);
            { const int* rowinfo = WSP(int, WS_ROWINFO);
              for (int i = 0; i < 5; ++i) { pg8::Unit uu_; if (!S.next(i, uu_)) break; if (tid < 256) { const int ent = rowinfo[uu_.pm * 256 + tid]; rowtok[i * 256 + tid] = ent < 0 ? 0 : (ent >> 1); } } }
            __syncthreads();
            EpiH E{WSP(bf16_t, WS_H)};
            pg8::gemm_phase<EpiH, pg8::MoeOrder, true>(lds, g, S, E, rowtok); SEAM(9); }
        if (IN(10)) { LAUNDER();
            pg8::Gemm g{WSP(bf16_t, WS_H), WSP(bf16_t, WS_WD), DEXP, DEXP, DEXP};
            const int ntile = moe_fill_table(C, l, tbl, tid);
            pg8::MoeOrder S{tbl, ntile, DM / 256, G, bx, (long)256 * DEXP * 2, (long)256 * DEXP * 2, (long)DM * DEXP * 2};
            EpiY E{WSP(int, WS_ROWINFO), WSP(float, WS_ROWGATE), WSP(bf16_t, WS_YBUF)};
            pg8::gemm_phase(lds, g, S, E); SEAM(10); }
        if (IN(11)) { LAUNDER();
            pg8::Gemm g{WSP(bf16_t, WS_XB), WSP(bf16_t, WS_WPG), DM, DM, DM};
            pg8::DenseOrder S{T / 256, DM / 256, G, bx, (long)256 * DM * 2, (long)256 * DM * 2};
            EpiPre2 E{C.out, WSP(bf16_t, WS_YBUF), WSP(bf16_t, WS_PP), INF(I_PLEBG) + l * DM, WSP(float, WS_X)};
            pg8::gemm_phase(lds, g, S, E); SEAM(11); }
        if (IN(12)) { LAUNDER(); stage_ln2_v(C, l, gw, ngw, lane); SEAM(12); }
#undef IN
#undef SEAM
    }
}

extern "C" void kernel_launch(void* const* d_in, const int* in_sizes, int n_in, void* d_out, int out_size, void* d_ws, size_t ws_size, hipStream_t stream) {
    static int grid = 0;
    if (grid == 0) {
        if (n_in != N_IN || out_size != T * DM || ws_size < WS_END) { fprintf(stderr, "kernel_launch: bad sizes n_in %d out %d ws %zu need %zu\n", n_in, out_size, ws_size, (size_t)WS_END); grid = -1; return; }
        int dev = 0, cus = 0, per_cu = 0;
        hipGetDevice(&dev); hipDeviceGetAttribute(&cus, hipDeviceAttributeMultiprocessorCount, dev);
        if (hipFuncSetAttribute((const void*)mega, hipFuncAttributeMaxDynamicSharedMemorySize, LDS_BYTES) != hipSuccess) { fprintf(stderr, "hipFuncSetAttribute failed\n"); grid = -1; return; }
        if (hipOccupancyMaxActiveBlocksPerMultiprocessor(&per_cu, (const void*)mega, NWAVES * 64, LDS_BYTES) != hipSuccess || per_cu < 1) { fprintf(stderr, "occupancy query: %d\n", per_cu); }
        (void)hipGetLastError();
        grid = cus;
    }
    if (grid < 0) return;
    hipMemsetAsync((char*)d_ws + WS_CTL, 0, CTL_BYTES, stream);
    Args a{};
    for (int i = 0; i < N_IN; ++i) a.C.in[i] = d_in[i];
    a.C.out = (float*)d_out; a.C.ws = (unsigned char*)d_ws;
#ifndef ONE_LAUNCH
    for (int ph = 0; ph < NPHASES; ++ph) { a.ph_lo = ph; a.ph_hi = ph + 1; hipLaunchKernelGGL(mega, dim3(grid), dim3(NWAVES * 64), LDS_BYTES, stream, a); }
#else
    a.ph_lo = 0; a.ph_hi = NPHASES; hipLaunchKernelGGL(mega, dim3(grid), dim3(NWAVES * 64), LDS_BYTES, stream, a);
#endif
}
#else
template <class E> static void cpu_gemm(const bf16_t* A, int lda, const bf16_t* Bt, int ldb, int K, int M, int N, const E& e, const int* base = nullptr, long estep = 0) {
    for (int row = 0; row < M; ++row) {
        const bf16_t* B = Bt;
        if (base) B = Bt + (size_t)moe_expert_of_row(base, row) * estep;
        if constexpr (E::MODE == 1) {
            for (int hc = 0; hc < N / 2; hc += 8) { float g[8], u[8];
                for (int j = 0; j < 8; ++j) { float ag = 0.f, au = 0.f; const bf16_t* bg = B + (size_t)rowmap(1, hc + j) * ldb; const bf16_t* bu = B + (size_t)rowmap(2, hc + j) * ldb;
                    for (int k = 0; k < K; ++k) { const float a = bf2f(A[(size_t)row * lda + k]); ag += a * bf2f(bg[k]); au += a * bf2f(bu[k]); } g[j] = ag; u[j] = au; }
                e.put8gu(row, hc, g, u); }
        } else if constexpr (E::PERM) {
            for (int c = 0; c < N; c += 8) { float a8[8];
                for (int j = 0; j < 8; ++j) { float acc = 0.f; for (int k = 0; k < K; ++k) acc += bf2f(A[(size_t)row * lda + k]) * bf2f(B[(size_t)(c + j) * ldb + k]); a8[j] = acc; }
                e.put8(row, c, a8); }
        } else {
            for (int c = 0; c < N; c += 4) { float a4[4];
                for (int j = 0; j < 4; ++j) { float acc = 0.f; for (int k = 0; k < K; ++k) acc += bf2f(A[(size_t)row * lda + k]) * bf2f(B[(size_t)(c + j) * ldb + k]); a4[j] = acc; }
                e.put4(row, c, a4); }
        }
    }
}
static void cpu_forward(CtxRef C) {
    static float shbuf[4096];
    for (int l = 0; l < DEPTH; ++l) {
        stage_convert(C, l, 0, 1, 0, shbuf);
        { EpiU E{WSP(bf16_t, WS_U)}; cpu_gemm(WSP(bf16_t, WS_XB), DM, WSP(bf16_t, WS_WIN), DM, DM, T, DINP, E); }
        stage_prep(C, l, 0, 1, 0, shbuf);
        for (int b = 0; b < BATCH; ++b) for (int h = 0; h < NH; ++h) {
            for (int v = 0; v < 64; ++v) { rwkv_scan_thread(C, b, h, v); gla_scan_thread(C, b, h, v); }
            for (int e = 0; e < 65; ++e) mlstm_scan_thread(C, b, h, e);
            for (int q = 0; q < SEQ; ++q) attn_thread(C, b, h, q, q); }
        stage_post(C, l, 0, 1, 0);
        { EpiPre1 E{l == 0 ? INF(I_X) : WSP(float, WS_X), C.out}; cpu_gemm(WSP(bf16_t, WS_MIX), DMIX, WSP(bf16_t, WS_WOUT), DMIX, DMIX, T, DM, E); }
        stage_ln1_router(C, l, 0, 1, 0, shbuf);
        stage_gather(C, l, 0, 1, 0);
        { EpiPP E{WSP(bf16_t, WS_PP)}; cpu_gemm(WSP(bf16_t, WS_PB), DPLE, WSP(bf16_t, WS_WP), DPLE, DPLE, T, DM, E); }
        int base[NEXP + 1]; moe_bases(C, l, base);
        { EpiH E{WSP(bf16_t, WS_H)}; cpu_gemm(WSP(bf16_t, WS_XG), DM, WSP(bf16_t, WS_WGU), DM, DM, base[NEXP], 2 * DEXP, E, base, (long)2 * DEXP * DM); }
        { EpiY E{WSP(int, WS_ROWINFO), WSP(float, WS_ROWGATE), WSP(bf16_t, WS_YBUF)}; cpu_gemm(WSP(bf16_t, WS_H), DEXP, WSP(bf16_t, WS_WD), DEXP, DEXP, base[NEXP], DM, E, base, (long)DM * DEXP); }
        { EpiPre2 E{C.out, WSP(bf16_t, WS_YBUF), WSP(bf16_t, WS_PP), INF(I_PLEBG) + l * DM, WSP(float, WS_X)}; cpu_gemm(WSP(bf16_t, WS_XB), DM, WSP(bf16_t, WS_WPG), DM, DM, T, DM, E); }
        stage_ln2(C, l, 0, 1, 0);
    }
}
#endif
```
